# Optimizing an MI355X kernel written in HIP

```python
import math
import jax, jax.numpy as jnp
from jax import lax
import numpy as np

D_MODEL = 1024
BATCH = 8
SEQ = 2048
DEPTH = 2

HEAD_DIM = 64
FOX_HEADS = 4
SB_HEADS = 4
MLA_HEADS = 4
MLA_Q_RANK = 256
MLA_KV_RANK = 128
MLA_NOPE_DIM = 64
MLA_ROPE_DIM = 32
MLA_V_DIM = 128
ROPE_THETA = 10000.0
BLOCK_Q = 128
FOX_W = FOX_HEADS * HEAD_DIM
SB_W = SB_HEADS * HEAD_DIM
MLA_W = MLA_HEADS * MLA_V_DIM
MIX_W = FOX_W + SB_W + MLA_W
IN_SPLITS = (FOX_W, FOX_W, FOX_W, FOX_HEADS, SB_W, SB_W, SB_W, MLA_Q_RANK, MLA_KV_RANK, MLA_ROPE_DIM)
IN_W = sum(IN_SPLITS)

PEER_HEADS = 8
PEER_NKEYS = 128
PEER_EXPERTS = PEER_NKEYS * PEER_NKEYS
PEER_QDIM = 128
PEER_TOPK = 16
TOKEN_CHUNK = 128

PLE_DIM = 256
EPS = 1e-6

kernel_name = "hymba_fox_stickbreak_mla_peer_trunk"


def rms_norm(x, g):
    xf = x.astype(jnp.float32)
    y = xf * lax.rsqrt(jnp.mean(xf * xf, axis=-1, keepdims=True) + EPS)
    return (y * g.astype(jnp.float32)).astype(x.dtype)


def apply_rope(x, pos):
    half = MLA_ROPE_DIM // 2
    inv_freq = ROPE_THETA ** (-jnp.arange(half, dtype=jnp.float32) / half)
    ang = pos.astype(jnp.float32)[..., None] * inv_freq
    ang = ang.reshape(ang.shape[:2] + (1,) * (x.ndim - 3) + (half,))
    cos, sin = jnp.cos(ang), jnp.sin(ang)
    xf = x.astype(jnp.float32)
    x1, x2 = xf[..., :half], xf[..., half:]
    return jnp.concatenate([x1 * cos - x2 * sin, x1 * sin + x2 * cos], axis=-1).astype(x.dtype)


def _split_heads(t, n_heads):
    b, s, _ = t.shape
    return t.reshape(b, s, n_heads, -1).transpose(0, 2, 1, 3)


def _merge_blocks(out):
    nb, b, h, bq, d = out.shape
    return out.transpose(1, 0, 3, 2, 4).reshape(b, nb * bq, h * d)


def causal_softmax_attention(q, k, v, scale, cum_log_f=None):
    s_len = q.shape[2]
    kpos = jnp.arange(s_len)

    def block(i):
        start = i * BLOCK_Q
        qb = lax.dynamic_slice_in_dim(q, start, BLOCK_Q, axis=2)
        qpos = start + jnp.arange(BLOCK_Q)
        logits = jnp.einsum('bhqd,bhkd->bhqk', qb, k, preferred_element_type=jnp.float32) * scale
        if cum_log_f is not None:
            fq = lax.dynamic_slice_in_dim(cum_log_f, start, BLOCK_Q, axis=2)
            logits = logits + fq[..., :, None] - cum_log_f[..., None, :]
        logits = jnp.where(kpos[None, :] <= qpos[:, None], logits, -jnp.inf)
        w = jax.nn.softmax(logits, axis=-1)
        return jnp.einsum('bhqk,bhkd->bhqd', w.astype(v.dtype), v)

    return _merge_blocks(lax.map(block, jnp.arange(s_len // BLOCK_Q)))


def stick_breaking_attention(q, k, v):
    s_len = q.shape[2]
    kpos = jnp.arange(s_len)
    scale = HEAD_DIM ** -0.5

    def block(i):
        start = i * BLOCK_Q
        qb = lax.dynamic_slice_in_dim(q, start, BLOCK_Q, axis=2)
        qpos = start + jnp.arange(BLOCK_Q)
        z = jnp.einsum('bhqd,bhkd->bhqk', qb, k, preferred_element_type=jnp.float32) * scale
        strict = kpos[None, :] < qpos[:, None]
        log_beta = jax.nn.log_sigmoid(z)
        log_one_minus = jnp.where(strict, jax.nn.log_sigmoid(-z), 0.0)
        rest = lax.cumsum(log_one_minus, axis=3, reverse=True) - log_one_minus
        w = jnp.where(strict, jnp.exp(log_beta + rest), 0.0)
        return jnp.einsum('bhqk,bhkd->bhqd', w.astype(v.dtype), v)

    return _merge_blocks(lax.map(block, jnp.arange(s_len // BLOCK_Q)))


def mla_attention(c_q, c_kv, k_rope, pos, q_norm_g, w_uq, kv_norm_g, w_ukv):
    b, s, _ = c_q.shape
    q = (rms_norm(c_q, q_norm_g) @ w_uq).reshape(b, s, MLA_HEADS, MLA_NOPE_DIM + MLA_ROPE_DIM)
    q_nope, q_rot = q[..., :MLA_NOPE_DIM], q[..., MLA_NOPE_DIM:]
    q_rot = apply_rope(q_rot, pos)
    kv = (rms_norm(c_kv, kv_norm_g) @ w_ukv).reshape(b, s, MLA_HEADS, MLA_NOPE_DIM + MLA_V_DIM)
    k_nope, v = kv[..., :MLA_NOPE_DIM], kv[..., MLA_NOPE_DIM:]
    k_rot = jnp.broadcast_to(apply_rope(k_rope, pos)[:, :, None, :], (b, s, MLA_HEADS, MLA_ROPE_DIM))
    q_full = jnp.concatenate([q_nope, q_rot], axis=-1).transpose(0, 2, 1, 3)
    k_full = jnp.concatenate([k_nope, k_rot], axis=-1).transpose(0, 2, 1, 3)
    v = v.transpose(0, 2, 1, 3)
    return causal_softmax_attention(q_full, k_full, v, (MLA_NOPE_DIM + MLA_ROPE_DIM) ** -0.5)


def token_mixer(h, pos, w_in, b_forget, q_norm_g, w_uq, kv_norm_g, w_ukv, out_norm_g, w_o):
    proj = h @ w_in
    offsets = [int(o) for o in np.cumsum(IN_SPLITS)[:-1]]
    fq, fk, fv, f_logit, sq, sk, sv, c_q, c_kv, k_rope = jnp.split(proj, offsets, axis=-1)
    log_f = jax.nn.log_sigmoid(f_logit.astype(jnp.float32) + b_forget.astype(jnp.float32))
    cum_log_f = jnp.cumsum(log_f, axis=1).transpose(0, 2, 1)
    y_fox = causal_softmax_attention(_split_heads(fq, FOX_HEADS), _split_heads(fk, FOX_HEADS),
                                     _split_heads(fv, FOX_HEADS), HEAD_DIM ** -0.5, cum_log_f)
    y_sb = stick_breaking_attention(_split_heads(sq, SB_HEADS), _split_heads(sk, SB_HEADS),
                                    _split_heads(sv, SB_HEADS))
    y_mla = mla_attention(c_q, c_kv, k_rope, pos, q_norm_g, w_uq, kv_norm_g, w_ukv)
    g_fox, g_sb, g_mla = jnp.split(out_norm_g, [FOX_W, FOX_W + SB_W])
    y = jnp.concatenate([rms_norm(y_fox, g_fox), rms_norm(y_sb, g_sb), rms_norm(y_mla, g_mla)], axis=-1)
    return y @ w_o


def peer_ffn(h, w_query, sub_keys, expert_u, expert_v):
    b, s, d = h.shape
    n_chunks = (b * s) // TOKEN_CHUNK
    half = PEER_QDIM // 2

    def chunk(xc):
        c = xc.shape[0]
        q = (xc @ w_query).reshape(c, PEER_HEADS, 2, half)
        scores = jnp.einsum('chpd,hpnd->chpn', q, sub_keys, preferred_element_type=jnp.float32)
        s1, i1 = lax.top_k(scores[:, :, 0], PEER_TOPK)
        s2, i2 = lax.top_k(scores[:, :, 1], PEER_TOPK)
        cand_s = (s1[..., :, None] + s2[..., None, :]).reshape(c, PEER_HEADS, PEER_TOPK * PEER_TOPK)
        cand_id = (i1[..., :, None] * PEER_NKEYS + i2[..., None, :]).reshape(c, PEER_HEADS, PEER_TOPK * PEER_TOPK)
        top_s, top_j = lax.top_k(cand_s, PEER_TOPK)
        ids = jnp.take_along_axis(cand_id, top_j, axis=-1)
        gate = jax.nn.softmax(top_s, axis=-1)
        u = expert_u[ids]
        pre = jnp.einsum('chkd,cd->chk', u, xc, preferred_element_type=jnp.float32)
        act = gate * jax.nn.gelu(pre, approximate=False)
        return jnp.einsum('chk,chkd->cd', act.astype(expert_v.dtype), expert_v[ids])

    out = lax.map(chunk, h.reshape(n_chunks, TOKEN_CHUNK, d))
    return out.reshape(b, s, d)


def per_layer_embedding(h, p_i, w_ple, ple_norm_g, w_ple_gate):
    gate = jax.nn.sigmoid((rms_norm(h, ple_norm_g) @ w_ple_gate).astype(jnp.float32))
    return (gate * (p_i @ w_ple).astype(jnp.float32)).astype(h.dtype)


def setup_inputs(seed: int = 0) -> dict:
    key = jax.random.key(seed)
    ks = jax.random.split(key, 24)
    f32 = jnp.float32

    def normal(k, shape, scale):
        return jax.random.normal(k, shape, f32) * scale

    def gain(k, shape):
        return 1.0 + 0.02 * jax.random.normal(k, shape, f32)

    return {
        "x": normal(ks[0], (BATCH, SEQ, D_MODEL), 1.0),
        "p": normal(ks[1], (DEPTH, BATCH, SEQ, PLE_DIM), 1.0),
        "positions": jnp.broadcast_to(jnp.arange(SEQ, dtype=jnp.int32), (BATCH, SEQ)),
        "norm_mix_g": gain(ks[2], (DEPTH, D_MODEL)),
        "w_in": normal(ks[3], (DEPTH, D_MODEL, IN_W), D_MODEL ** -0.5),
        "b_forget": jax.random.uniform(ks[4], (DEPTH, FOX_HEADS), f32, 1.0, 5.0),
        "mla_q_norm_g": gain(ks[5], (DEPTH, MLA_Q_RANK)),
        "w_uq": normal(ks[6], (DEPTH, MLA_Q_RANK, MLA_HEADS * (MLA_NOPE_DIM + MLA_ROPE_DIM)), MLA_Q_RANK ** -0.5),
        "mla_kv_norm_g": gain(ks[7], (DEPTH, MLA_KV_RANK)),
        "w_ukv": normal(ks[8], (DEPTH, MLA_KV_RANK, MLA_HEADS * (MLA_NOPE_DIM + MLA_V_DIM)), MLA_KV_RANK ** -0.5),
        "mix_out_norm_g": gain(ks[9], (DEPTH, MIX_W)),
        "w_o": normal(ks[10], (DEPTH, MIX_W, D_MODEL), MIX_W ** -0.5),
        "norm_ffn_g": gain(ks[11], (DEPTH, D_MODEL)),
        "peer_w_query": normal(ks[12], (DEPTH, D_MODEL, PEER_HEADS * PEER_QDIM), D_MODEL ** -0.5),
        "peer_sub_keys": normal(ks[13], (DEPTH, PEER_HEADS, 2, PEER_NKEYS, PEER_QDIM // 2), (PEER_QDIM // 2) ** -0.5),
        "peer_u": normal(ks[14], (DEPTH, PEER_EXPERTS, D_MODEL), D_MODEL ** -0.5),
        "peer_v": normal(ks[15], (DEPTH, PEER_EXPERTS, D_MODEL), PEER_HEADS ** -0.5),
        "w_ple": normal(ks[16], (DEPTH, PLE_DIM, D_MODEL), PLE_DIM ** -0.5),
        "ple_norm_g": gain(ks[17], (DEPTH, D_MODEL)),
        "w_ple_gate": normal(ks[18], (DEPTH, D_MODEL, D_MODEL), D_MODEL ** -0.5),
        "final_norm_g": gain(ks[19], (D_MODEL,)),
    }


def reference(x, p, positions, norm_mix_g, w_in, b_forget, mla_q_norm_g, w_uq, mla_kv_norm_g, w_ukv,
              mix_out_norm_g, w_o, norm_ffn_g, peer_w_query, peer_sub_keys, peer_u, peer_v,
              w_ple, ple_norm_g, w_ple_gate, final_norm_g):
    h = x
    for i in range(DEPTH):
        h = h + token_mixer(rms_norm(h, norm_mix_g[i]), positions, w_in[i], b_forget[i],
                            mla_q_norm_g[i], w_uq[i], mla_kv_norm_g[i], w_ukv[i],
                            mix_out_norm_g[i], w_o[i])
        h = h + peer_ffn(rms_norm(h, norm_ffn_g[i]), peer_w_query[i], peer_sub_keys[i], peer_u[i], peer_v[i])
        h = h + per_layer_embedding(h, p[i], w_ple[i], ple_norm_g[i], w_ple_gate[i])
    return rms_norm(h, final_norm_g)
```

```cpp
#include <hip/hip_runtime.h>
#include <math.h>
#include <stdint.h>

#define D_MODEL 1024
#define BATCH 8
#define SEQ 2048
#define TOK (BATCH * SEQ)
#define DEPTH 2
#define IN_W 1956
#define EPS 1e-6f

__global__ void rmsnorm_k(const float* __restrict__ in, int ldi, const float* __restrict__ g,
                          float* __restrict__ out, int ldo, int W, int rows) {
    int wave = (blockIdx.x * blockDim.x + threadIdx.x) >> 6;
    int lane = threadIdx.x & 63;
    if (wave >= rows) return;
    const float* r = in + (size_t)wave * ldi;
    float ss = 0.f;
    for (int c = lane; c < W; c += 64) { float v = r[c]; ss += v * v; }
    for (int o = 32; o > 0; o >>= 1) ss += __shfl_xor(ss, o);
    float sc = rsqrtf(ss / (float)W + EPS);
    float* w = out + (size_t)wave * ldo;
    for (int c = lane; c < W; c += 64) w[c] = r[c] * sc * g[c];
}

template <int ACC>
__global__ void __launch_bounds__(256) gemm_k(const float* __restrict__ A, int lda, const float* __restrict__ W, int ldw,
                                              float* __restrict__ C, int ldc, int M, int N, int K) {
    __shared__ float As[16][65];
    __shared__ float Ws[16][65];
    int tx = threadIdx.x & 15, ty = threadIdx.x >> 4;
    int m0 = blockIdx.y * 64, n0 = blockIdx.x * 64;
    float acc[4][4];
#pragma unroll
    for (int i = 0; i < 4; ++i)
#pragma unroll
        for (int j = 0; j < 4; ++j) acc[i][j] = 0.f;
    for (int k0 = 0; k0 < K; k0 += 16) {
#pragma unroll
        for (int i = 0; i < 4; ++i) {
            int e = threadIdx.x + i * 256;
            int r = e >> 4, c = e & 15;
            As[c][r] = A[(size_t)(m0 + r) * lda + k0 + c];
        }
#pragma unroll
        for (int i = 0; i < 4; ++i) {
            int e = threadIdx.x + i * 256;
            int r = e >> 6, c = e & 63;
            int n = n0 + c;
            Ws[r][c] = (n < N) ? W[(size_t)(k0 + r) * ldw + n] : 0.f;
        }
        __syncthreads();
#pragma unroll
        for (int kk = 0; kk < 16; ++kk) {
            float a[4], b[4];
#pragma unroll
            for (int i = 0; i < 4; ++i) a[i] = As[kk][ty * 4 + i];
#pragma unroll
            for (int j = 0; j < 4; ++j) b[j] = Ws[kk][tx * 4 + j];
#pragma unroll
            for (int i = 0; i < 4; ++i)
#pragma unroll
                for (int j = 0; j < 4; ++j) acc[i][j] += a[i] * b[j];
        }
        __syncthreads();
    }
#pragma unroll
    for (int i = 0; i < 4; ++i)
#pragma unroll
        for (int j = 0; j < 4; ++j) {
            int m = m0 + ty * 4 + i, n = n0 + tx * 4 + j;
            if (n < N) {
                if (ACC) C[(size_t)m * ldc + n] += acc[i][j];
                else C[(size_t)m * ldc + n] = acc[i][j];
            }
        }
}

__device__ __forceinline__ float log_sigmoid_f(float z) {
    return fminf(z, 0.f) - log1pf(expf(-fabsf(z)));
}

__global__ void cumf_k(const float* __restrict__ proj, const float* __restrict__ bf, float* __restrict__ cumF) {
    int i = blockIdx.x * blockDim.x + threadIdx.x;
    if (i >= BATCH * 4) return;
    int b = i >> 2, h = i & 3;
    float acc = 0.f;
    for (int s = 0; s < SEQ; ++s) {
        float z = proj[(size_t)(b * SEQ + s) * IN_W + 768 + h] + bf[h];
        acc += log_sigmoid_f(z);
        cumF[(size_t)i * SEQ + s] = acc;
    }
}

__global__ void mla_prep_k(float* __restrict__ mq, const float* __restrict__ mkv, const float* __restrict__ proj,
                           const int* __restrict__ pos, float* __restrict__ kfull, float* __restrict__ vfull) {
    int t = blockIdx.x;
    float p = (float)pos[t];
    int tid = threadIdx.x;
    if (tid < 64) {
        int h = tid >> 4, i = tid & 15;
        float inv = powf(10000.0f, -(float)i / 16.0f);
        float ang = p * inv;
        float c = cosf(ang), s = sinf(ang);
        float* q = mq + (size_t)t * 384 + h * 96 + 64;
        float x1 = q[i], x2 = q[i + 16];
        q[i] = x1 * c - x2 * s;
        q[i + 16] = x1 * s + x2 * c;
    }
    __shared__ float kr[32];
    if (tid >= 64 && tid < 80) {
        int i = tid - 64;
        float inv = powf(10000.0f, -(float)i / 16.0f);
        float ang = p * inv;
        float c = cosf(ang), s = sinf(ang);
        const float* k = proj + (size_t)t * IN_W + 1924;
        float x1 = k[i], x2 = k[i + 16];
        kr[i] = x1 * c - x2 * s;
        kr[i + 16] = x1 * s + x2 * c;
    }
    __syncthreads();
    for (int e = tid; e < 4 * 96; e += 256) {
        int h = e / 96, d = e % 96;
        float v = (d < 64) ? mkv[(size_t)t * 768 + h * 192 + d] : kr[d - 64];
        kfull[(size_t)t * 384 + e] = v;
    }
    for (int e = tid; e < 4 * 128; e += 256) {
        int h = e >> 7, d = e & 127;
        vfull[(size_t)t * 512 + e] = mkv[(size_t)t * 768 + h * 192 + 64 + d];
    }
}

template <int MODE, int DK, int DV>
__global__ void __launch_bounds__(256) attn_k(const float* __restrict__ Q, int ldq, const float* __restrict__ Kp, int ldk,
                                              const float* __restrict__ V, int ldv, const float* __restrict__ cumF,
                                              float* __restrict__ Y, int ldy, float scale) {
    int lane = threadIdx.x & 63, w = threadIdx.x >> 6;
    int qi = blockIdx.x * 4 + w, h = blockIdx.y, b = blockIdx.z;
    const float* q = Q + (size_t)(b * SEQ + qi) * ldq + h * DK;
    const float* kb = Kp + (size_t)(b * SEQ) * ldk + h * DK;
    const float* vb = V + (size_t)(b * SEQ) * ldv + h * DV;
    float* y = Y + (size_t)(b * SEQ + qi) * ldy + h * DV;
    constexpr int NV = DV / 64;
    float o[DV];
#pragma unroll
    for (int d = 0; d < DV; ++d) o[d] = 0.f;
    float qr[DK];
#pragma unroll
    for (int d = 0; d < DK; ++d) qr[d] = q[d];
    if (MODE == 1) {
        float R = 0.f;
        int nk = qi;
        int nch = (nk + 63) / 64;
        for (int c = nch - 1; c >= 0; --c) {
            int j = c * 64 + lane;
            bool valid = j < nk;
            float z = 0.f;
            if (valid) {
                const float* kr = kb + (size_t)j * ldk;
#pragma unroll
                for (int d = 0; d < DK; ++d) z += qr[d] * kr[d];
                z *= scale;
            }
            float lsig = valid ? log_sigmoid_f(z) : 0.f;
            float lneg = valid ? log_sigmoid_f(-z) : 0.f;
            float incl = lneg;
            for (int off = 1; off < 64; off <<= 1) {
                float t = __shfl_down(incl, off);
                if (lane + off < 64) incl += t;
            }
            float rest = incl - lneg + R;
            float tot = __shfl(incl, 0);
            R += tot;
            float wgt = valid ? expf(lsig + rest) : 0.f;
            if (valid) {
                const float* vr = vb + (size_t)j * ldv;
#pragma unroll
                for (int d = 0; d < DV; ++d) o[d] += wgt * vr[d];
            }
        }
#pragma unroll
        for (int d = 0; d < DV; ++d) {
            float v = o[d];
            for (int off = 32; off > 0; off >>= 1) v += __shfl_xor(v, off);
            o[d] = v;
        }
    } else {
        int nk = qi + 1;
        float m = -INFINITY, l = 0.f;
        float Fq = (MODE == 0) ? cumF[(size_t)(b * 4 + h) * SEQ + qi] : 0.f;
        for (int j = lane; j < nk; j += 64) {
            const float* kr = kb + (size_t)j * ldk;
            float z = 0.f;
#pragma unroll
            for (int d = 0; d < DK; ++d) z += qr[d] * kr[d];
            z *= scale;
            if (MODE == 0) z += Fq - cumF[(size_t)(b * 4 + h) * SEQ + j];
            float mn = fmaxf(m, z);
            float a = expf(m - mn);
            float pz = expf(z - mn);
            l = l * a + pz;
            const float* vr = vb + (size_t)j * ldv;
#pragma unroll
            for (int d = 0; d < DV; ++d) o[d] = o[d] * a + pz * vr[d];
            m = mn;
        }
        float mg = m;
        for (int off = 32; off > 0; off >>= 1) mg = fmaxf(mg, __shfl_xor(mg, off));
        float a = (m == -INFINITY) ? 0.f : expf(m - mg);
        l *= a;
        for (int off = 32; off > 0; off >>= 1) l += __shfl_xor(l, off);
        float inv = 1.f / l;
#pragma unroll
        for (int d = 0; d < DV; ++d) {
            float v = o[d] * a;
            for (int off = 32; off > 0; off >>= 1) v += __shfl_xor(v, off);
            o[d] = v * inv;
        }
    }
#pragma unroll
    for (int d = 0; d < DV; ++d) {
        if ((d & 63) == lane) y[d] = o[d];
    }
    (void)NV;
}

__global__ void __launch_bounds__(256) peer_k(const float* __restrict__ xc  , const float* __restrict__ pq  ,
                                              const float* __restrict__ subk  , const float* __restrict__ U,
                                              const float* __restrict__ Vt, float* __restrict__ h  ) {
    __shared__ float q[1024];
    __shared__ float x[1024];
    __shared__ float sc[16][128];
    __shared__ float ts[16][16];
    __shared__ int ti[16][16];
    __shared__ float cand[8][256];
    __shared__ float tops[8][16];
    __shared__ int ids[128];
    __shared__ float gate[128];
    __shared__ float act[128];
    int t = blockIdx.x, tid = threadIdx.x;
    for (int e = tid; e < 1024; e += 256) { q[e] = pq[(size_t)t * 1024 + e]; x[e] = xc[(size_t)t * 1024 + e]; }
    __syncthreads();
    for (int e = tid; e < 2048; e += 256) {
        int hp = e >> 7, n = e & 127;
        const float* kk = subk + ((size_t)hp * 128 + n) * 64;
        const float* qq = q + hp * 64;
        float s = 0.f;
        for (int d = 0; d < 64; ++d) s += qq[d] * kk[d];
        sc[hp][n] = s;
    }
    __syncthreads();
    if (tid < 16) {
        for (int k = 0; k < 16; ++k) {
            float best = -INFINITY; int bi = 0;
            for (int n = 0; n < 128; ++n) {
                float v = sc[tid][n];
                if (v > best) { best = v; bi = n; }
            }
            sc[tid][bi] = -INFINITY;
            ts[tid][k] = best; ti[tid][k] = bi;
        }
    }
    __syncthreads();
    for (int e = tid; e < 2048; e += 256) {
        int hh = e >> 8, c = e & 255;
        cand[hh][c] = ts[hh * 2][c >> 4] + ts[hh * 2 + 1][c & 15];
    }
    __syncthreads();
    if (tid < 8) {
        int hh = tid;
        for (int k = 0; k < 16; ++k) {
            float best = -INFINITY; int bj = 0;
            for (int c = 0; c < 256; ++c) {
                float v = cand[hh][c];
                if (v > best) { best = v; bj = c; }
            }
            cand[hh][bj] = -INFINITY;
            tops[hh][k] = best;
            ids[hh * 16 + k] = ti[hh * 2][bj >> 4] * 128 + ti[hh * 2 + 1][bj & 15];
        }
        float mx = tops[hh][0];
        float sum = 0.f;
        for (int k = 0; k < 16; ++k) sum += expf(tops[hh][k] - mx);
        for (int k = 0; k < 16; ++k) gate[hh * 16 + k] = expf(tops[hh][k] - mx) / sum;
    }
    __syncthreads();
    {
        int w = tid >> 6, lane = tid & 63;
        for (int i = 0; i < 32; ++i) {
            int pk = w * 32 + i;
            const float* ur = U + (size_t)ids[pk] * 1024;
            float s = 0.f;
            for (int d = lane; d < 1024; d += 64) s += ur[d] * x[d];
            for (int off = 32; off > 0; off >>= 1) s += __shfl_xor(s, off);
            if (lane == 0) {
                float g = 0.5f * s * (1.f + erff(s * 0.70710678118654752f));
                act[pk] = gate[pk] * g;
            }
        }
    }
    __syncthreads();
    for (int d = tid; d < 1024; d += 256) {
        float o = 0.f;
        for (int pk = 0; pk < 128; ++pk) o += act[pk] * Vt[(size_t)ids[pk] * 1024 + d];
        h[(size_t)t * 1024 + d] += o;
    }
}

__global__ void ple_k(float* __restrict__ h, const float* __restrict__ G, const float* __restrict__ P, size_t n) {
    size_t i = (size_t)blockIdx.x * blockDim.x + threadIdx.x;
    if (i < n) {
        float g = 1.f / (1.f + expf(-G[i]));
        h[i] += g * P[i];
    }
}

extern "C" void kernel_launch(void* const* d_in, const int* in_sizes, int n_in, void* d_out, int out_size, void* d_ws,
                              size_t ws_size, hipStream_t stream) {
    const float* x = (const float*)d_in[0];
    const float* p = (const float*)d_in[1];
    const int* pos = (const int*)d_in[2];
    const float* norm_mix_g = (const float*)d_in[3];
    const float* w_in = (const float*)d_in[4];
    const float* b_forget = (const float*)d_in[5];
    const float* mla_q_norm_g = (const float*)d_in[6];
    const float* w_uq = (const float*)d_in[7];
    const float* mla_kv_norm_g = (const float*)d_in[8];
    const float* w_ukv = (const float*)d_in[9];
    const float* mix_out_norm_g = (const float*)d_in[10];
    const float* w_o = (const float*)d_in[11];
    const float* norm_ffn_g = (const float*)d_in[12];
    const float* peer_w_query = (const float*)d_in[13];
    const float* peer_sub_keys = (const float*)d_in[14];
    const float* peer_u = (const float*)d_in[15];
    const float* peer_v = (const float*)d_in[16];
    const float* w_ple = (const float*)d_in[17];
    const float* ple_norm_g = (const float*)d_in[18];
    const float* w_ple_gate = (const float*)d_in[19];
    const float* final_norm_g = (const float*)d_in[20];
    float* out = (float*)d_out;

    float* ws = (float*)d_ws;
    size_t off = 0;
    auto alloc = [&](size_t n) { float* r = ws + off; off += (n + 63) & ~(size_t)63; return r; };
    float* h = out;
    float* hn = alloc((size_t)TOK * 1024);
    float* proj = alloc((size_t)TOK * IN_W);
    float* cumF = alloc((size_t)BATCH * 4 * SEQ);
    float* cn = alloc((size_t)TOK * 256);
    float* mq = alloc((size_t)TOK * 384);
    float* mkv = alloc((size_t)TOK * 768);
    float* kfull = alloc((size_t)TOK * 384);
    float* vfull = alloc((size_t)TOK * 512);
    float* y = alloc((size_t)TOK * 1024);
    float* yn = hn;
    float* pq = y;
    float* G = proj;
    float* P = y;

    hipMemcpyAsync(h, x, (size_t)TOK * 1024 * 4, hipMemcpyDeviceToDevice, stream);
    const int RB = TOK / 4;
    for (int L = 0; L < DEPTH; ++L) {
        rmsnorm_k<<<RB, 256, 0, stream>>>(h, 1024, norm_mix_g + L * 1024, hn, 1024, 1024, TOK);
        gemm_k<0><<<dim3((IN_W + 63) / 64, TOK / 64), 256, 0, stream>>>(hn, 1024, w_in + (size_t)L * 1024 * IN_W, IN_W, proj, IN_W, TOK, IN_W, 1024);
        cumf_k<<<1, 32, 0, stream>>>(proj, b_forget + L * 4, cumF);
        rmsnorm_k<<<RB, 256, 0, stream>>>(proj + 1540, IN_W, mla_q_norm_g + L * 256, cn, 256, 256, TOK);
        gemm_k<0><<<dim3(384 / 64, TOK / 64), 256, 0, stream>>>(cn, 256, w_uq + (size_t)L * 256 * 384, 384, mq, 384, TOK, 384, 256);
        rmsnorm_k<<<RB, 256, 0, stream>>>(proj + 1796, IN_W, mla_kv_norm_g + L * 128, cn, 128, 128, TOK);
        gemm_k<0><<<dim3(768 / 64, TOK / 64), 256, 0, stream>>>(cn, 128, w_ukv + (size_t)L * 128 * 768, 768, mkv, 768, TOK, 768, 128);
        mla_prep_k<<<TOK, 256, 0, stream>>>(mq, mkv, proj, pos, kfull, vfull);
        attn_k<0, 64, 64><<<dim3(SEQ / 4, 4, BATCH), 256, 0, stream>>>(proj + 0, IN_W, proj + 256, IN_W, proj + 512, IN_W, cumF, y + 0, 1024, 0.125f);
        attn_k<1, 64, 64><<<dim3(SEQ / 4, 4, BATCH), 256, 0, stream>>>(proj + 772, IN_W, proj + 1028, IN_W, proj + 1284, IN_W, cumF, y + 256, 1024, 0.125f);
        attn_k<2, 96, 128><<<dim3(SEQ / 4, 4, BATCH), 256, 0, stream>>>(mq, 384, kfull, 384, vfull, 512, cumF, y + 512, 1024, 0.10206207261596577f);
        rmsnorm_k<<<RB, 256, 0, stream>>>(y + 0, 1024, mix_out_norm_g + L * 1024 + 0, yn + 0, 1024, 256, TOK);
        rmsnorm_k<<<RB, 256, 0, stream>>>(y + 256, 1024, mix_out_norm_g + L * 1024 + 256, yn + 256, 1024, 256, TOK);
        rmsnorm_k<<<RB, 256, 0, stream>>>(y + 512, 1024, mix_out_norm_g + L * 1024 + 512, yn + 512, 1024, 512, TOK);
        gemm_k<1><<<dim3(1024 / 64, TOK / 64), 256, 0, stream>>>(yn, 1024, w_o + (size_t)L * 1024 * 1024, 1024, h, 1024, TOK, 1024, 1024);
        rmsnorm_k<<<RB, 256, 0, stream>>>(h, 1024, norm_ffn_g + L * 1024, hn, 1024, 1024, TOK);
        gemm_k<0><<<dim3(1024 / 64, TOK / 64), 256, 0, stream>>>(hn, 1024, peer_w_query + (size_t)L * 1024 * 1024, 1024, pq, 1024, TOK, 1024, 1024);
        peer_k<<<TOK, 256, 0, stream>>>(hn, pq, peer_sub_keys + (size_t)L * 8 * 2 * 128 * 64, peer_u + (size_t)L * 16384 * 1024,
                                        peer_v + (size_t)L * 16384 * 1024, h);
        rmsnorm_k<<<RB, 256, 0, stream>>>(h, 1024, ple_norm_g + L * 1024, hn, 1024, 1024, TOK);
        gemm_k<0><<<dim3(1024 / 64, TOK / 64), 256, 0, stream>>>(hn, 1024, w_ple_gate + (size_t)L * 1024 * 1024, 1024, G, 1024, TOK, 1024, 1024);
        gemm_k<0><<<dim3(1024 / 64, TOK / 64), 256, 0, stream>>>(p + (size_t)L * TOK * 256, 256, w_ple + (size_t)L * 256 * 1024, 1024, P, 1024, TOK, 1024, 256);
        ple_k<<<(TOK * 1024) / 256, 256, 0, stream>>>(h, G, P, (size_t)TOK * 1024);
    }
    rmsnorm_k<<<RB, 256, 0, stream>>>(h, 1024, final_norm_g, out, 1024, 1024, TOK);
}
```

```cpp
#include <hip/hip_runtime.h>
#include <hip/hip_cooperative_groups.h>
#include <cstdio>
#include <cstdint>
#include <math.h>
#include <climits>
namespace cg = cooperative_groups;

typedef __bf16 bf16;
typedef __bf16 bf16x8 __attribute__((ext_vector_type(8)));
typedef __bf16 bf16x4 __attribute__((ext_vector_type(4)));
typedef __bf16 bf16x2 __attribute__((ext_vector_type(2)));
typedef float f32x16 __attribute__((ext_vector_type(16)));
typedef float f32x4 __attribute__((ext_vector_type(4)));
typedef float f32x2 __attribute__((ext_vector_type(2)));
typedef unsigned u32x4 __attribute__((ext_vector_type(4)));
typedef unsigned u32x2 __attribute__((ext_vector_type(2)));

#define SEQ 2048
#define BATCH 8
#define TOK 16384
#define DM 1024
#define IN_W 1956
#define NEXP 16384
#define EPSF 1e-6f
#define LOG2E 1.4426950408889634f
#define NTHR 256
#define LDS_BYTES 65536

constexpr size_t MBy = 1ull << 20;
constexpr size_t OFF_UB = 0;
constexpr size_t OFF_VB = 64 * MBy;
constexpr size_t OFF_WIN = 128 * MBy;
constexpr size_t OFF_WO = 136 * MBy;
constexpr size_t OFF_WQ = 140 * MBy;
constexpr size_t OFF_WG = 144 * MBy;
constexpr size_t OFF_WP = 148 * MBy;
constexpr size_t OFF_WUQ = 149 * MBy;
constexpr size_t OFF_WUKV = 149 * MBy + 512 * 1024;
constexpr size_t OFF_SKB = 150 * MBy;
constexpr size_t OFF_CS = 151 * MBy;
constexpr size_t OFF_SS0 = 153 * MBy;
constexpr size_t OFF_SSA = 154 * MBy;
constexpr size_t OFF_SSP = 157 * MBy;
constexpr size_t OFF_HB0 = 158 * MBy;
constexpr size_t OFF_HB1 = 190 * MBy;
constexpr size_t OFF_FQ = 222 * MBy;
constexpr size_t OFF_FK = 230 * MBy;
constexpr size_t OFF_FVT = 238 * MBy;
constexpr size_t OFF_SQ = 246 * MBy;
constexpr size_t OFF_SKK = 254 * MBy;
constexpr size_t OFF_SVT = 262 * MBy;
constexpr size_t OFF_CQ = 270 * MBy;
constexpr size_t OFF_CKV = 278 * MBy;
constexpr size_t OFF_FLOG = 282 * MBy;
constexpr size_t OFF_CUMF = 283 * MBy;
constexpr size_t OFF_MQ = 284 * MBy;
constexpr size_t OFF_MK = 296 * MBy;
constexpr size_t OFF_MVT = 308 * MBy;
constexpr size_t OFF_Y = 324 * MBy;
constexpr size_t OFF_PQ = 356 * MBy;
constexpr size_t OFF_IDS = 388 * MBy;
constexpr size_t OFF_GATE = 396 * MBy;
constexpr size_t OFF_BAR = 404 * MBy;
constexpr size_t OFF_CNT = OFF_BAR + 1024;
constexpr size_t OFF_SSY = 405 * MBy;
constexpr size_t WS_END = 408 * MBy;

struct Params {
    const float* x; const float* p; const int* pos;
    const float* norm_mix_g; const float* w_in; const float* b_forget; const float* mla_q_norm_g; const float* w_uq;
    const float* mla_kv_norm_g; const float* w_ukv; const float* mix_out_norm_g; const float* w_o; const float* norm_ffn_g;
    const float* w_query; const float* sub_keys; const float* peer_u; const float* peer_v; const float* w_ple;
    const float* ple_norm_g; const float* w_ple_gate; const float* final_norm_g;
    float* out; char* ws;
};

__shared__ __attribute__((aligned(16))) char smem[LDS_BYTES];

__device__ __forceinline__ int opaque_tid() { int t = threadIdx.x; asm volatile("" : "+v"(t)); return t; }
template <typename T> __device__ __forceinline__ T* opq(T* p) { asm volatile("" : "+s"(p)); return p; }

__device__ __forceinline__ unsigned pack2(float a, float b) {
    f32x2 v = {a, b};
    bf16x2 r = __builtin_convertvector(v, bf16x2);
    return __builtin_bit_cast(unsigned, r);
}
__device__ __forceinline__ float bflo(unsigned u) { return __uint_as_float(u << 16); }
__device__ __forceinline__ float bfhi(unsigned u) { return __uint_as_float(u & 0xffff0000u); }
__device__ __forceinline__ float wave_sum(float v) {
#pragma unroll
    for (int o = 32; o > 0; o >>= 1) v += __shfl_xor(v, o);
    return v;
}
__device__ __forceinline__ float fexp2(float x) { return __builtin_amdgcn_exp2f(x); }
__device__ __forceinline__ float flog2(float x) { return __builtin_amdgcn_logf(x); }
__device__ __forceinline__ float log_sigmoid_f(float z) { return fminf(z, 0.f) - log1pf(expf(-fabsf(z))); }

struct WJob { const float* src; int lds; int K; int Np; bf16* dst; const float* gain; int map; };

__device__ __forceinline__ int src_col_map(int map, int c) {
    if (map == 0) return c;
    if (map == 1) {
        if (c < 768) return c;
        if (c < 1952) return c + 4;
        if (c < 1956) return c - 1952 + 768;
        return -1;
    }
    if (c < 256) return 192 * (c >> 6) + (c & 63);
    int e = c - 256;
    return 192 * (e >> 7) + 64 + (e & 127);
}

__device__ __forceinline__ void wconv_tile(const WJob& j, int tile) {
    float* tl = (float*)smem;
    int ktiles = j.K >> 5;
    int nt = tile / ktiles, kt = tile % ktiles;
    int n0 = nt * 32, k0 = kt * 32;
    int tx = opaque_tid() & 31, ty = opaque_tid() >> 5;
    int sc = src_col_map(j.map, n0 + tx);
#pragma unroll
    for (int i = 0; i < 4; ++i) {
        int k = k0 + ty + 8 * i;
        float v = 0.f;
        if (sc >= 0) v = j.src[(size_t)k * j.lds + sc] * (j.gain ? j.gain[k] : 1.f);
        tl[(ty + 8 * i) * 33 + tx] = v;
    }
    __syncthreads();
#pragma unroll
    for (int i = 0; i < 4; ++i) {
        int n = n0 + ty + 8 * i;
        j.dst[(size_t)n * j.K + k0 + tx] = (bf16)tl[tx * 33 + ty + 8 * i];
    }
    __syncthreads();
}

__device__ __forceinline__ void phase0(const Params& P) {
    char* ws = opq(P.ws);
    const int G = gridDim.x, bid = blockIdx.x, tid = opaque_tid();
    {
        const int NCH = 4 * 8192;
        for (int it = bid; it < NCH; it += G) {
            int tb = it >> 13, ch = it & 8191;
            const float* src = (tb < 2 ? P.peer_u : P.peer_v) + (size_t)(tb & 1) * NEXP * DM + (size_t)ch * 2048;
            bf16* dst = (bf16*)(ws + (tb < 2 ? OFF_UB : OFF_VB)) + (size_t)(tb & 1) * NEXP * DM + (size_t)ch * 2048;
            const float4* s4 = (const float4*)src + tid * 2;
            float4 a = s4[0], b = s4[1];
            uint4 o;
            o.x = pack2(a.x, a.y); o.y = pack2(a.z, a.w); o.z = pack2(b.x, b.y); o.w = pack2(b.z, b.w);
            ((uint4*)dst)[tid] = o;
        }
    }
    {
        for (int L = 0; L < 2; ++L) {
            WJob jobs[7];
            jobs[0] = {P.w_in + (size_t)L * 1024 * IN_W, IN_W, 1024, 2048, (bf16*)(ws + OFF_WIN) + (size_t)L * 2048 * 1024, P.norm_mix_g + L * 1024, 1};
            jobs[1] = {P.w_o + (size_t)L * 1024 * 1024, 1024, 1024, 1024, (bf16*)(ws + OFF_WO) + (size_t)L * 1024 * 1024, P.mix_out_norm_g + L * 1024, 0};
            jobs[2] = {P.w_query + (size_t)L * 1024 * 1024, 1024, 1024, 1024, (bf16*)(ws + OFF_WQ) + (size_t)L * 1024 * 1024, P.norm_ffn_g + L * 1024, 0};
            jobs[3] = {P.w_ple_gate + (size_t)L * 1024 * 1024, 1024, 1024, 1024, (bf16*)(ws + OFF_WG) + (size_t)L * 1024 * 1024, P.ple_norm_g + L * 1024, 0};
            jobs[4] = {P.w_ple + (size_t)L * 256 * 1024, 1024, 256, 1024, (bf16*)(ws + OFF_WP) + (size_t)L * 1024 * 256, nullptr, 0};
            jobs[5] = {P.w_uq + (size_t)L * 256 * 384, 384, 256, 384, (bf16*)(ws + OFF_WUQ) + (size_t)L * 384 * 256, P.mla_q_norm_g + L * 256, 0};
            jobs[6] = {P.w_ukv + (size_t)L * 128 * 768, 768, 128, 768, (bf16*)(ws + OFF_WUKV) + (size_t)L * 768 * 128, P.mla_kv_norm_g + L * 128, 2};
#pragma unroll
            for (int q = 0; q < 7; ++q) {
                int nt = (jobs[q].Np >> 5) * (jobs[q].K >> 5);
                for (int it = bid; it < nt; it += G) wconv_tile(jobs[q], it);
            }
        }
    }
    {
        const float* src = P.sub_keys;
        bf16* dst = (bf16*)(ws + OFF_SKB);
        for (int i = bid * NTHR + tid; i < 262144 / 2; i += G * NTHR) {
            float2 v = ((const float2*)src)[i];
            ((unsigned*)dst)[i] = pack2(v.x, v.y);
        }
    }
    {
        bf16* hb = (bf16*)(ws + OFF_HB0);
        float* ss0 = (float*)(ws + OFF_SSA);
        int w = tid >> 6, l = tid & 63;
        for (int row = bid * 4 + w; row < TOK; row += G * 4) {
            const float4* xr = (const float4*)(P.x + (size_t)row * DM);
            float ss = 0.f;
#pragma unroll
            for (int i = 0; i < 2; ++i) {
                float4 a = xr[i * 128 + l * 2], b = xr[i * 128 + l * 2 + 1];
                ss += a.x * a.x + a.y * a.y + a.z * a.z + a.w * a.w + b.x * b.x + b.y * b.y + b.z * b.z + b.w * b.w;
                uint4 o;
                o.x = pack2(a.x, a.y); o.y = pack2(a.z, a.w); o.z = pack2(b.x, b.y); o.w = pack2(b.z, b.w);
                ((uint4*)(hb + (size_t)row * DM))[i * 64 + l] = o;
            }
            ss = wave_sum(ss);
            if (l == 0) {
                *(float4*)(ss0 + (size_t)row * 8) = make_float4(ss, 0.f, 0.f, 0.f);
                *(float4*)(ss0 + (size_t)row * 8 + 4) = make_float4(0.f, 0.f, 0.f, 0.f);
            }
        }
    }
    {
        float* cs = (float*)(ws + OFF_CS);
        for (int i = bid * NTHR + tid; i < TOK * 16; i += G * NTHR) {
            int t = i >> 4, k = i & 15;
            float inv = powf(10000.0f, -(float)k / 16.0f);
            float ang = (float)P.pos[t] * inv;
            cs[2 * i] = cosf(ang);
            cs[2 * i + 1] = sinf(ang);
        }
    }
}

template <int AMODE, typename SF>
__device__ __forceinline__ void gemm_core(f32x16 (&acc)[2][2], const void* Ap, int lda, const bf16* Bt, int ldb, int K,
                                          int m0, int n0, SF scalef) {
    const int tid = opaque_tid(), w = tid >> 6, l = tid & 63, r = l & 31, hh = l >> 5;
    const int wm = w >> 1, wn = w & 1;
    const int lc = tid & 7, lr = tid >> 3;
    u32x4 ra[4], rb[4];
    auto gload = [&](int k0) {
#pragma unroll
        for (int i = 0; i < 4; ++i) {
            int row = lr + 32 * i;
            if (AMODE == 1) {
                const float4* s = (const float4*)((const float*)Ap + (size_t)(m0 + row) * lda + k0 + lc * 8);
                float4 a = s[0], b = s[1];
                ra[i].x = pack2(a.x, a.y); ra[i].y = pack2(a.z, a.w); ra[i].z = pack2(b.x, b.y); ra[i].w = pack2(b.z, b.w);
            } else {
                ra[i] = *(const u32x4*)((const bf16*)Ap + (size_t)(m0 + row) * lda + k0 + lc * 8);
                if (AMODE == 2) {
                    float sc = scalef(i, k0);
                    ra[i].x = pack2(bflo(ra[i].x) * sc, bfhi(ra[i].x) * sc);
                    ra[i].y = pack2(bflo(ra[i].y) * sc, bfhi(ra[i].y) * sc);
                    ra[i].z = pack2(bflo(ra[i].z) * sc, bfhi(ra[i].z) * sc);
                    ra[i].w = pack2(bflo(ra[i].w) * sc, bfhi(ra[i].w) * sc);
                }
            }
            rb[i] = *(const u32x4*)(Bt + (size_t)(n0 + row) * ldb + k0 + lc * 8);
        }
    };
    auto lwrite = [&](int buf) {
        char* base = smem + buf * 32768;
#pragma unroll
        for (int i = 0; i < 4; ++i) {
            int row = lr + 32 * i;
            int off = row * 128 + ((lc ^ (row & 7)) << 4);
            *(u32x4*)(base + off) = ra[i];
            *(u32x4*)(base + 16384 + off) = rb[i];
        }
    };
    const int nk = K >> 6;
    gload(0);
    lwrite(0);
    __syncthreads();
    for (int kt = 0; kt < nk; ++kt) {
        if (kt + 1 < nk) gload((kt + 1) << 6);
        const char* base = smem + (kt & 1) * 32768;
#pragma unroll
        for (int s = 0; s < 4; ++s) {
            int ch = ((2 * s + hh) ^ (r & 7)) << 4;
            bf16x8 af[2], bfr[2];
#pragma unroll
            for (int i = 0; i < 2; ++i) af[i] = *(const bf16x8*)(base + (wm * 64 + i * 32 + r) * 128 + ch);
#pragma unroll
            for (int j = 0; j < 2; ++j) bfr[j] = *(const bf16x8*)(base + 16384 + (wn * 64 + j * 32 + r) * 128 + ch);
#pragma unroll
            for (int i = 0; i < 2; ++i)
#pragma unroll
                for (int j = 0; j < 2; ++j) acc[i][j] = __builtin_amdgcn_mfma_f32_32x32x16_bf16(af[i], bfr[j], acc[i][j], 0, 0, 0);
        }
        if (kt + 1 < nk) lwrite((kt + 1) & 1);
        __syncthreads();
    }
}
__device__ __forceinline__ float row_rs8(const float* part, int row) {
    float4 a = *(const float4*)(part + (size_t)row * 8), b = *(const float4*)(part + (size_t)row * 8 + 4);
    float ss = ((a.x + a.y) + (a.z + a.w)) + ((b.x + b.y) + (b.z + b.w));
    return rsqrtf(ss * (1.f / 1024.f) + EPSF);
}
struct NoScale { __device__ __forceinline__ float operator()(int, int) const { return 1.f; } };

#define ZERO_ACC(acc)                                  \
    _Pragma("unroll") for (int _i = 0; _i < 2; ++_i)   \
    _Pragma("unroll") for (int _j = 0; _j < 2; ++_j)   \
    _Pragma("unroll") for (int _r = 0; _r < 16; ++_r) acc[_i][_j][_r] = 0.f;


__device__ __forceinline__ void phase_proj(const Params& P, int L, const bf16* hb, const float* ssrow) {
    char* ws = opq(P.ws);
    const bf16* Bt = (const bf16*)(ws + OFF_WIN) + (size_t)L * 2048 * 1024;
    bf16* fq = (bf16*)(ws + OFF_FQ); bf16* fk = (bf16*)(ws + OFF_FK); bf16* fvt = (bf16*)(ws + OFF_FVT);
    bf16* sq = (bf16*)(ws + OFF_SQ); bf16* sk = (bf16*)(ws + OFF_SKK); bf16* svt = (bf16*)(ws + OFF_SVT);
    bf16* cq = (bf16*)(ws + OFF_CQ); bf16* ckv = (bf16*)(ws + OFF_CKV);
    float* flog = (float*)(ws + OFF_FLOG);
    bf16* mk = (bf16*)(ws + OFF_MK);
    const float* cs = (const float*)(ws + OFF_CS);
    const int tid = opaque_tid(), w = tid >> 6, l = tid & 63, hh = l >> 5, wm = w >> 1, wn = w & 1;
    for (int tile = blockIdx.x; tile < 128 * 16; tile += gridDim.x) {
        int mt = tile >> 4, nt = tile & 15;
        int m0 = mt * 128, n0 = nt * 128;
        f32x16 acc[2][2];
        ZERO_ACC(acc);
        gemm_core<0>(acc, hb, 1024, Bt, 1024, 1024, m0, n0, NoScale());
#pragma unroll
        for (int i = 0; i < 2; ++i) {
            float rs[16];
#pragma unroll
            for (int rr = 0; rr < 16; ++rr) {
                int row = m0 + wm * 64 + i * 32 + (rr & 3) + 8 * (rr >> 2) + 4 * hh;
                rs[rr] = row_rs8(ssrow, row);
            }
#pragma unroll
            for (int j = 0; j < 2; ++j) {
                int col = n0 + wn * 64 + j * 32 + (l & 31);
                int rbase = m0 + wm * 64 + i * 32 + 4 * hh;
                if (nt < 14 && nt != 4 && nt != 5 && nt != 10 && nt != 11) {
                    bf16* dst; int ld, c;
                    if (nt < 2) { dst = fq; ld = 256; c = col; }
                    else if (nt < 4) { dst = fk; ld = 256; c = col - 256; }
                    else if (nt < 8) { dst = sq; ld = 256; c = col - 768; }
                    else if (nt < 10) { dst = sk; ld = 256; c = col - 1024; }
                    else if (nt < 14) { dst = cq; ld = 256; c = col - 1536; }
                    if (nt == 14) { dst = ckv; ld = 128; c = col - 1792; }
#pragma unroll
                    for (int rr = 0; rr < 16; ++rr) {
                        int row = rbase + (rr & 3) + 8 * (rr >> 2);
                        dst[(size_t)row * ld + c] = (bf16)(acc[i][j][rr] * rs[rr]);
                    }
                } else if (nt == 14) {
                    int c = col - 1792;
#pragma unroll
                    for (int rr = 0; rr < 16; ++rr) {
                        int row = rbase + (rr & 3) + 8 * (rr >> 2);
                        ckv[(size_t)row * 128 + c] = (bf16)(acc[i][j][rr] * rs[rr]);
                    }
                } else if (nt == 4 || nt == 5 || nt == 10 || nt == 11) {
                    bf16* vt = (nt < 6) ? fvt : svt;
                    int c = col - ((nt < 6) ? 512 : 1280);
                    int b = m0 >> 11;
                    int s0 = (rbase & 2047);
                    bf16* base = vt + ((size_t)(b * 256 + c)) * SEQ + s0;
#pragma unroll
                    for (int g = 0; g < 4; ++g) {
                        uint2 o;
                        o.x = pack2(acc[i][j][4 * g] * rs[4 * g], acc[i][j][4 * g + 1] * rs[4 * g + 1]);
                        o.y = pack2(acc[i][j][4 * g + 2] * rs[4 * g + 2], acc[i][j][4 * g + 3] * rs[4 * g + 3]);
                        *(uint2*)(base + 8 * g) = o;
                    }
                } else {
                    if (wn == 0 && j == 0) {
                        int ci = l & 31, pi = ci & 15;
#pragma unroll
                        for (int rr = 0; rr < 16; ++rr) {
                            int row = rbase + (rr & 3) + 8 * (rr >> 2);
                            float v = acc[i][j][rr] * rs[rr];
                            float pv = __shfl_xor(v, 16);
                            float2 c_s = *(const float2*)(cs + ((size_t)row * 16 + pi) * 2);
                            float o = (ci < 16) ? (v * c_s.x - pv * c_s.y) : (pv * c_s.y + v * c_s.x);
                            bf16 ob = (bf16)o;
#pragma unroll
                            for (int h = 0; h < 4; ++h) mk[(size_t)row * 384 + h * 96 + 64 + ci] = ob;
                        }
                    } else if (wn == 0 && j == 1) {
                        int c = (l & 31);
                        if (c < 4) {
#pragma unroll
                            for (int rr = 0; rr < 16; ++rr) {
                                int row = rbase + (rr & 3) + 8 * (rr >> 2);
                                flog[(size_t)row * 4 + c] = acc[i][j][rr] * rs[rr];
                            }
                        }
                    }
                }
            }
        }
    }
}

struct RowScale4 { float s[4]; __device__ __forceinline__ float operator()(int i, int) const { return s[i]; } };

template <int KW>
__device__ __forceinline__ RowScale4 row_rms_prepass(const bf16* A, int lda, int m0) {
    const int tid = opaque_tid(), lc = tid & 7, lr = tid >> 3;
    RowScale4 rs;
#pragma unroll
    for (int i = 0; i < 4; ++i) {
        float ss = 0.f;
#pragma unroll
        for (int k0 = 0; k0 < KW; k0 += 64) {
            uint4 v = *(const uint4*)(A + (size_t)(m0 + lr + 32 * i) * lda + k0 + lc * 8);
            float a;
            a = bflo(v.x); ss += a * a; a = bfhi(v.x); ss += a * a;
            a = bflo(v.y); ss += a * a; a = bfhi(v.y); ss += a * a;
            a = bflo(v.z); ss += a * a; a = bfhi(v.z); ss += a * a;
            a = bflo(v.w); ss += a * a; a = bfhi(v.w); ss += a * a;
        }
        ss += __shfl_xor(ss, 1); ss += __shfl_xor(ss, 2); ss += __shfl_xor(ss, 4);
        rs.s[i] = rsqrtf(ss * (1.f / (float)KW) + EPSF);
    }
    return rs;
}

__device__ __forceinline__ void phase_mla_up(const Params& P, int L) {
    char* ws = opq(P.ws);
    const bf16* cq = (const bf16*)(ws + OFF_CQ); const bf16* ckv = (const bf16*)(ws + OFF_CKV);
    const bf16* wuq = (const bf16*)(ws + OFF_WUQ) + (size_t)L * 384 * 256;
    const bf16* wukv = (const bf16*)(ws + OFF_WUKV) + (size_t)L * 768 * 128;
    bf16* mq = (bf16*)(ws + OFF_MQ); bf16* mk = (bf16*)(ws + OFF_MK); bf16* mvt = (bf16*)(ws + OFF_MVT);
    const float* cs = (const float*)(ws + OFF_CS);
    const float* flog = (const float*)(ws + OFF_FLOG);
    float* cumF = (float*)(ws + OFF_CUMF);
    const int tid = opaque_tid(), w = tid >> 6, l = tid & 63, hh = l >> 5, wm = w >> 1, wn = w & 1;
    const int NQ = 128 * 3, NKV = 128 * 6, NCF = 8;
    for (int item = blockIdx.x; item < NQ + NKV + NCF; item += gridDim.x) {
        if (item < NQ) {
            int mt = item / 3, nt = item % 3;
            int m0 = mt * 128, n0 = nt * 128;
            RowScale4 rs = row_rms_prepass<256>(cq, 256, m0);
            f32x16 acc[2][2];
            ZERO_ACC(acc);
            gemm_core<2>(acc, cq, 256, wuq, 256, 256, m0, n0, rs);
#pragma unroll
            for (int i = 0; i < 2; ++i)
#pragma unroll
                for (int j = 0; j < 2; ++j) {
                    int c0 = n0 + wn * 64 + j * 32;
                    int col = c0 + (l & 31);
                    int rbase = m0 + wm * 64 + i * 32 + 4 * hh;
                    bool rot = (c0 % 96) == 64;
                    int ci = l & 31, pi = ci & 15;
#pragma unroll
                    for (int rr = 0; rr < 16; ++rr) {
                        int row = rbase + (rr & 3) + 8 * (rr >> 2);
                        float v = acc[i][j][rr];
                        if (rot) {
                            float pv = __shfl_xor(v, 16);
                            float2 c_s = *(const float2*)(cs + ((size_t)row * 16 + pi) * 2);
                            v = (ci < 16) ? (v * c_s.x - pv * c_s.y) : (pv * c_s.y + v * c_s.x);
                        }
                        mq[(size_t)row * 384 + col] = (bf16)v;
                    }
                }
        } else if (item < NQ + NKV) {
            int it2 = item - NQ;
            int mt = it2 / 6, nt = it2 % 6;
            int m0 = mt * 128, n0 = nt * 128;
            RowScale4 rs = row_rms_prepass<128>(ckv, 128, m0);
            f32x16 acc[2][2];
            ZERO_ACC(acc);
            gemm_core<2>(acc, ckv, 128, wukv, 128, 128, m0, n0, rs);
#pragma unroll
            for (int i = 0; i < 2; ++i)
#pragma unroll
                for (int j = 0; j < 2; ++j) {
                    int col = n0 + wn * 64 + j * 32 + (l & 31);
                    int rbase = m0 + wm * 64 + i * 32 + 4 * hh;
                    if (nt < 2) {
                        int dcol = (col >> 6) * 96 + (col & 63);
#pragma unroll
                        for (int rr = 0; rr < 16; ++rr) {
                            int row = rbase + (rr & 3) + 8 * (rr >> 2);
                            mk[(size_t)row * 384 + dcol] = (bf16)acc[i][j][rr];
                        }
                    } else {
                        int e = col - 256;
                        int b = m0 >> 11;
                        int s0 = rbase & 2047;
                        bf16* base = mvt + ((size_t)(b * 512 + e)) * SEQ + s0;
#pragma unroll
                        for (int g = 0; g < 4; ++g) {
                            uint2 o;
                            o.x = pack2(acc[i][j][4 * g], acc[i][j][4 * g + 1]);
                            o.y = pack2(acc[i][j][4 * g + 2], acc[i][j][4 * g + 3]);
                            *(uint2*)(base + 8 * g) = o;
                        }
                    }
                }
        } else {
            int seq = (item - NQ - NKV) * 4 + w;
            int b = seq >> 2, h = seq & 3;
            float bfv = P.b_forget[L * 4 + h];
            float vals[32];
            float run = 0.f;
#pragma unroll
            for (int i = 0; i < 32; ++i) {
                int s = l * 32 + i;
                float z = flog[((size_t)b * SEQ + s) * 4 + h] + bfv;
                run += log_sigmoid_f(z);
                vals[i] = run;
            }
            float tot = run, incl = tot;
#pragma unroll
            for (int o = 1; o < 64; o <<= 1) {
                float t = __shfl_up(incl, o);
                if (l >= o) incl += t;
            }
            float excl = incl - tot;
#pragma unroll
            for (int i = 0; i < 32; ++i) cumF[(size_t)seq * SEQ + l * 32 + i] = vals[i] + excl;
        }
    }
}

template <int MODE, int DK, int DV>
__device__ __forceinline__ void attn_item(const bf16* __restrict__ Q, int ldq, const bf16* __restrict__ Kg, int ldk,
                          const bf16* __restrict__ Vt, const float* __restrict__ cumF, bf16* __restrict__ Y,
                          float* __restrict__ ssy, int b, int h, int qb, float c1) {
    constexpr int KSTR = DK * 2 + 16;
    constexpr int VSTR = 144;
    constexpr int KBYTES = 64 * KSTR, VBYTES = DV * VSTR;
    constexpr int BUF = (KBYTES + VBYTES + 256 + 255) & ~255;
    static_assert(2 * BUF <= LDS_BYTES - 64, "lds");
    constexpr int KCH = DK / 8, KPT = (64 * KCH) / 256, VPT = (DV * 8) / 256;
    const int tid = opaque_tid(), w = tid >> 6, l = tid & 63, r = l & 31, hh = l >> 5;
    const int q0 = qb * 128;
    const int qrow = q0 + 32 * w + r;
    const size_t tok = (size_t)b * SEQ + qrow;
    const int bh = b * 4 + h;
    bf16x8 qf[DK / 16];
#pragma unroll
    for (int s = 0; s < DK / 16; ++s) qf[s] = *(const bf16x8*)(Q + tok * ldq + h * DK + 16 * s + 8 * hh);
    f32x16 o[DV / 32];
    const f32x16 zero16 = {0.f, 0.f, 0.f, 0.f, 0.f, 0.f, 0.f, 0.f, 0.f, 0.f, 0.f, 0.f, 0.f, 0.f, 0.f, 0.f};
#pragma unroll
    for (int d = 0; d < DV / 32; ++d) o[d] = zero16;
    float m = -1e30f, lsum = 0.f, R = 0.f;
    float Fq = 0.f;
    if (MODE == 0) Fq = cumF[(size_t)bh * SEQ + qrow] * LOG2E;
    const int nkt = (q0 + 128) >> 6;
    u32x4 kreg[KPT], vreg[VPT];
    float4 freg = {0.f, 0.f, 0.f, 0.f};
    auto gload = [&](int kt) {
#pragma unroll
        for (int i = 0; i < KPT; ++i) {
            int e = tid + 256 * i;
            int row = e / KCH, ch = e % KCH;
            kreg[i] = *(const u32x4*)(Kg + ((size_t)b * SEQ + kt * 64 + row) * ldk + h * DK + ch * 8);
        }
#pragma unroll
        for (int i = 0; i < VPT; ++i) {
            int e = tid + 256 * i;
            int row = e >> 3, ch = e & 7;
            vreg[i] = *(const u32x4*)(Vt + ((size_t)bh * DV + row) * SEQ + kt * 64 + ch * 8);
        }
        if (MODE == 0 && tid < 16) freg = *(const float4*)(cumF + (size_t)bh * SEQ + kt * 64 + tid * 4);
    };
    auto lwrite = [&](int buf) {
        char* base = smem + buf * BUF;
#pragma unroll
        for (int i = 0; i < KPT; ++i) {
            int e = tid + 256 * i;
            int row = e / KCH, ch = e % KCH;
            *(u32x4*)(base + row * KSTR + ch * 16) = kreg[i];
        }
#pragma unroll
        for (int i = 0; i < VPT; ++i) {
            int e = tid + 256 * i;
            int row = e >> 3, ch = e & 7;
            *(u32x4*)(base + KBYTES + row * VSTR + ch * 16) = vreg[i];
        }
        if (MODE == 0 && tid < 16) *(float4*)(base + KBYTES + VBYTES + tid * 16) = freg;
    };
    const int prow = (r & 0x13) | ((r & 4) << 1) | ((r & 8) >> 1);
    gload(MODE == 1 ? nkt - 1 : 0);
    lwrite(0);
    __syncthreads();
    for (int it = 0; it < nkt; ++it) {
        const int kt = (MODE == 1) ? (nkt - 1 - it) : it;
        if (it + 1 < nkt) gload((MODE == 1) ? (kt - 1) : (kt + 1));
        const char* base = smem + (it & 1) * BUF;
        const bool active = (kt * 64) <= (q0 + 32 * w + 31);
        if (active) {
            const bool needmask = (kt * 64 + 63) >= (q0 + 32 * w);
            f32x16 s[2];
#pragma unroll
            for (int sub = 0; sub < 2; ++sub) {
                s[sub] = zero16;
#pragma unroll
                for (int ks = 0; ks < DK / 16; ++ks) {
                    bf16x8 kf = *(const bf16x8*)(base + (sub * 32 + prow) * KSTR + (2 * ks + hh) * 16);
                    s[sub] = __builtin_amdgcn_mfma_f32_32x32x16_bf16(kf, qf[ks], s[sub], 0, 0, 0);
                }
            }
            bf16x8 pf[2][2];
            if (MODE != 1) {
                const float* Ft = (const float*)(base + KBYTES + VBYTES);
                float mx = -INFINITY;
                float tv[2][16];
#pragma unroll
                for (int sub = 0; sub < 2; ++sub)
#pragma unroll
                    for (int a = 0; a < 2; ++a) {
                        int kofs = sub * 32 + 16 * a + 8 * hh;
                        float fk[8];
                        if (MODE == 0) {
                            float4 f0 = *(const float4*)(Ft + kofs), f1 = *(const float4*)(Ft + kofs + 4);
                            fk[0] = f0.x; fk[1] = f0.y; fk[2] = f0.z; fk[3] = f0.w; fk[4] = f1.x; fk[5] = f1.y; fk[6] = f1.z; fk[7] = f1.w;
                        }
#pragma unroll
                        for (int j = 0; j < 8; ++j) {
                            int rr = 8 * a + j;
                            float v = s[sub][rr] * c1;
                            if (MODE == 0) v += Fq - fk[j] * LOG2E;
                            if (needmask && (kt * 64 + kofs + j > qrow)) v = -INFINITY;
                            tv[sub][rr] = v;
                            mx = fmaxf(mx, v);
                        }
                    }
                mx = fmaxf(mx, __shfl_xor(mx, 32));
                float mnew = fmaxf(m, mx);
                float alpha = fexp2(m - mnew);
                float rsum = 0.f;
#pragma unroll
                for (int sub = 0; sub < 2; ++sub)
#pragma unroll
                    for (int a = 0; a < 2; ++a) {
                        float pv[8];
#pragma unroll
                        for (int j = 0; j < 8; ++j) { pv[j] = fexp2(tv[sub][8 * a + j] - mnew); rsum += pv[j]; }
                        uint4 u;
                        u.x = pack2(pv[0], pv[1]); u.y = pack2(pv[2], pv[3]); u.z = pack2(pv[4], pv[5]); u.w = pack2(pv[6], pv[7]);
                        pf[sub][a] = __builtin_bit_cast(bf16x8, u);
                    }
                rsum += __shfl_xor(rsum, 32);
                lsum = lsum * alpha + rsum;
                m = mnew;
#pragma unroll
                for (int d = 0; d < DV / 32; ++d) o[d] = o[d] * alpha;
            } else {
#pragma unroll
                for (int sb = 0; sb < 2; ++sb) {
                    const int sub = 1 - sb;
                    float lsig[16], lneg[16];
                    float A0 = 0.f, A1 = 0.f;
#pragma unroll
                    for (int rr = 0; rr < 16; ++rr) {
                        int key = kt * 64 + sub * 32 + 16 * (rr >> 3) + 8 * hh + (rr & 7);
                        bool valid = key < qrow;
                        float z = s[sub][rr] * c1;
                        float e = fexp2(-fabsf(z));
                        float l1p = flog2(1.f + e);
                        float ls = fminf(z, 0.f) - l1p;
                        float ln = valid ? (ls - z) : 0.f;
                        lsig[rr] = valid ? ls : -INFINITY;
                        lneg[rr] = ln;
                        if (rr < 8) A0 += ln; else A1 += ln;
                    }
                    float B0 = __shfl_xor(A0, 32), B1 = __shfl_xor(A1, 32);
                    float base1 = (hh == 0) ? (R + B1) : R;
                    float base0 = (hh == 0) ? (R + B1 + A1 + B0) : (R + A1 + B1);
                    float wv[16];
                    float run = base1;
#pragma unroll
                    for (int j = 7; j >= 0; --j) { wv[8 + j] = fexp2(lsig[8 + j] + run); run += lneg[8 + j]; }
                    run = base0;
#pragma unroll
                    for (int j = 7; j >= 0; --j) { wv[j] = fexp2(lsig[j] + run); run += lneg[j]; }
                    R += A0 + A1 + B0 + B1;
#pragma unroll
                    for (int a = 0; a < 2; ++a) {
                        uint4 u;
                        u.x = pack2(wv[8 * a], wv[8 * a + 1]); u.y = pack2(wv[8 * a + 2], wv[8 * a + 3]);
                        u.z = pack2(wv[8 * a + 4], wv[8 * a + 5]); u.w = pack2(wv[8 * a + 6], wv[8 * a + 7]);
                        pf[sub][a] = __builtin_bit_cast(bf16x8, u);
                    }
                }
            }
#pragma unroll
            for (int d = 0; d < DV / 32; ++d)
#pragma unroll
                for (int sub = 0; sub < 2; ++sub)
#pragma unroll
                    for (int a = 0; a < 2; ++a) {
                        bf16x8 vf = *(const bf16x8*)(base + KBYTES + (d * 32 + r) * VSTR + (sub * 32 + 16 * a + 8 * hh) * 2);
                        o[d] = __builtin_amdgcn_mfma_f32_32x32x16_bf16(vf, pf[sub][a], o[d], 0, 0, 0);
                    }
        }
        if (it + 1 < nkt) lwrite((it + 1) & 1);
        __syncthreads();
    }
    float inv = (MODE == 1) ? 1.f : (1.f / lsum);
    float ssq = 0.f;
#pragma unroll
    for (int d = 0; d < DV / 32; ++d)
#pragma unroll
        for (int g = 0; g < 4; ++g) {
            float v0 = o[d][4 * g] * inv, v1 = o[d][4 * g + 1] * inv, v2 = o[d][4 * g + 2] * inv, v3 = o[d][4 * g + 3] * inv;
            ssq += v0 * v0 + v1 * v1 + v2 * v2 + v3 * v3;
            uint2 u; u.x = pack2(v0, v1); u.y = pack2(v2, v3);
            *(uint2*)(Y + tok * 1024 + h * DV + d * 32 + 8 * g + 4 * hh) = u;
        }
    ssq += __shfl_xor(ssq, 32);
    if (hh == 0) ssy[tok * 16 + h] = ssq;
}

__device__ __forceinline__ void phase_attn(const Params& P, int L) {
    char* ws = opq(P.ws);
    int* cnt = (int*)(ws + OFF_CNT) + L * 64;
    int* s_item = (int*)(smem + LDS_BYTES - 16);
    const float* cumF = (const float*)(ws + OFF_CUMF);
    bf16* Y = (bf16*)(ws + OFF_Y);
    float* ssy = (float*)(ws + OFF_SSY) + (size_t)L * TOK * 16;
    for (;;) {
        if (opaque_tid() == 0) *s_item = atomicAdd(cnt, 1);
        __syncthreads();
        int item = *s_item;
        __syncthreads();
        if (item >= 1536) break;
        int qb = 15 - item / 96;
        int rem = item % 96;
        int type = rem >> 5, bh = rem & 31;
        int b = bh >> 2, h = bh & 3;
        if (type == 0) {
            attn_item<2, 96, 128>((const bf16*)(ws + OFF_MQ), 384, (const bf16*)(ws + OFF_MK), 384, (const bf16*)(ws + OFF_MVT), cumF,
                                  Y + 512, ssy + 8, b, h, qb, 0.10206207261596577f * LOG2E);
        } else if (type == 1) {
            attn_item<1, 64, 64>((const bf16*)(ws + OFF_SQ), 256, (const bf16*)(ws + OFF_SKK), 256, (const bf16*)(ws + OFF_SVT), cumF,
                                 Y + 256, ssy + 4, b, h, qb, 0.125f * LOG2E);
        } else {
            attn_item<0, 64, 64>((const bf16*)(ws + OFF_FQ), 256, (const bf16*)(ws + OFF_FK), 256, (const bf16*)(ws + OFF_FVT), cumF,
                                 Y + 0, ssy + 0, b, h, qb, 0.125f * LOG2E);
        }
    }
}

__device__ __forceinline__ void rowss_flush(float (&part)[2][16], float* gss, int m0, int nt) {
    float* lss = (float*)smem;
    const int tid = opaque_tid(), w = tid >> 6, l = tid & 63, hh = l >> 5, wm = w >> 1, wn = w & 1;
#pragma unroll
    for (int i = 0; i < 2; ++i)
#pragma unroll
        for (int rr = 0; rr < 16; ++rr) {
            float v = part[i][rr];
            v += __shfl_xor(v, 1); v += __shfl_xor(v, 2); v += __shfl_xor(v, 4); v += __shfl_xor(v, 8); v += __shfl_xor(v, 16);
            if ((l & 31) == 0) lss[wn * 128 + wm * 64 + i * 32 + (rr & 3) + 8 * (rr >> 2) + 4 * hh] = v;
        }
    __syncthreads();
    if (tid < 128) gss[(size_t)(m0 + tid) * 8 + nt] = lss[tid] + lss[128 + tid];
    __syncthreads();
}

struct GroupScale {
    float s0[4], s1[4], s2[4];
    __device__ __forceinline__ float operator()(int i, int k0) const {
        float a = s0[i], b = s1[i], c = s2[i];
        float sel = (k0 < 256) ? 1.f : 0.f, sel2 = (k0 >= 256 && k0 < 512) ? 1.f : 0.f;
        return a * sel + b * sel2 + c * (1.f - sel - sel2);
    }
};

__device__ __forceinline__ void phase_wo(const Params& P, int L, const float* hin, bf16* hb_out, float* ss_out) {
    char* ws = opq(P.ws);
    const bf16* Y = (const bf16*)(ws + OFF_Y);
    const bf16* Bt = (const bf16*)(ws + OFF_WO) + (size_t)L * 1024 * 1024;
    const float* ssy = (const float*)(ws + OFF_SSY) + (size_t)L * TOK * 16;
    const int tid = opaque_tid(), w = tid >> 6, l = tid & 63, hh = l >> 5, wm = w >> 1, wn = w & 1;
    for (int tile = blockIdx.x; tile < 128 * 8; tile += gridDim.x) {
        int mt = tile >> 3, nt = tile & 7;
        int m0 = mt * 128, n0 = nt * 128;
        GroupScale gs;
#pragma unroll
        for (int i = 0; i < 4; ++i) {
            int row = m0 + (tid >> 3) + 32 * i;
            float4 v0 = *(const float4*)(ssy + (size_t)row * 16), v1 = *(const float4*)(ssy + (size_t)row * 16 + 4), v2 = *(const float4*)(ssy + (size_t)row * 16 + 8);
            gs.s0[i] = rsqrtf(((v0.x + v0.y) + (v0.z + v0.w)) * (1.f / 256.f) + EPSF);
            gs.s1[i] = rsqrtf(((v1.x + v1.y) + (v1.z + v1.w)) * (1.f / 256.f) + EPSF);
            gs.s2[i] = rsqrtf(((v2.x + v2.y) + (v2.z + v2.w)) * (1.f / 512.f) + EPSF);
        }
        f32x16 acc[2][2];
        ZERO_ACC(acc);
        gemm_core<2>(acc, Y, 1024, Bt, 1024, 1024, m0, n0, gs);
        float part[2][16];
#pragma unroll
        for (int i = 0; i < 2; ++i) {
#pragma unroll
            for (int rr = 0; rr < 16; ++rr) part[i][rr] = 0.f;
#pragma unroll
            for (int j = 0; j < 2; ++j) {
                int col = n0 + wn * 64 + j * 32 + (l & 31);
                int rbase = m0 + wm * 64 + i * 32 + 4 * hh;
#pragma unroll
                for (int rr = 0; rr < 16; ++rr) {
                    int row = rbase + (rr & 3) + 8 * (rr >> 2);
                    size_t idx = (size_t)row * 1024 + col;
                    float v = hin[idx] + acc[i][j][rr];
                    P.out[idx] = v;
                    hb_out[idx] = (bf16)v;
                    part[i][rr] += v * v;
                }
            }
        }
        rowss_flush(part, ss_out, m0, nt);
    }
}

__device__ __forceinline__ void phase_pq(const Params& P, int L, const bf16* hb, const float* ssrow) {
    char* ws = opq(P.ws);
    const bf16* Bt = (const bf16*)(ws + OFF_WQ) + (size_t)L * 1024 * 1024;
    bf16* pq = (bf16*)(ws + OFF_PQ);
    const int tid = opaque_tid(), w = tid >> 6, l = tid & 63, hh = l >> 5, wm = w >> 1, wn = w & 1;
    for (int tile = blockIdx.x; tile < 128 * 8; tile += gridDim.x) {
        int mt = tile >> 3, nt = tile & 7;
        int m0 = mt * 128, n0 = nt * 128;
        f32x16 acc[2][2];
        ZERO_ACC(acc);
        gemm_core<0>(acc, hb, 1024, Bt, 1024, 1024, m0, n0, NoScale());
#pragma unroll
        for (int i = 0; i < 2; ++i) {
            int rbase = m0 + wm * 64 + i * 32 + 4 * hh;
#pragma unroll
            for (int rr = 0; rr < 16; ++rr) {
                int row = rbase + (rr & 3) + 8 * (rr >> 2);
                float rs = row_rs8(ssrow, row);
#pragma unroll
                for (int j = 0; j < 2; ++j) {
                    int col = n0 + wn * 64 + j * 32 + (l & 31);
                    pq[(size_t)row * 1024 + col] = (bf16)(acc[i][j][rr] * rs);
                }
            }
        }
    }
}

__device__ __forceinline__ void cswap(int& a, int& b) { int mx = max(a, b), mn = min(a, b); a = mx; b = mn; }
__device__ __forceinline__ void bitonic_sort16(int (&v)[16]) {
#pragma unroll
    for (int k = 2; k <= 16; k <<= 1)
#pragma unroll
        for (int j = k >> 1; j > 0; j >>= 1)
#pragma unroll
            for (int i = 0; i < 16; ++i) {
                int q = i ^ j;
                if (q > i) {
                    if ((i & k) == 0) cswap(v[i], v[q]); else cswap(v[q], v[i]);
                }
            }
}
__device__ __forceinline__ void merge_top16(int (&Lv)[16], const int (&Rv)[16]) {
#pragma unroll
    for (int i = 0; i < 16; ++i) Lv[i] = max(Lv[i], Rv[15 - i]);
#pragma unroll
    for (int j = 8; j > 0; j >>= 1)
#pragma unroll
        for (int i = 0; i < 16; ++i) {
            int q = i ^ j;
            if (q > i) cswap(Lv[i], Lv[q]);
        }
}
__device__ __forceinline__ int f2key(float v, int low, int mask) {
    int b = __float_as_int(v);
    b ^= (b >> 31) & 0x7fffffff;
    return (b & ~mask) | low;
}
__device__ __forceinline__ float key2f(int k, int mask) {
    int b = k & ~mask;
    b ^= (b >> 31) & 0x7fffffff;
    return __int_as_float(b);
}

__device__ __forceinline__ void phase_topk(const Params& P, int L) {
    char* ws = opq(P.ws);
    const bf16* pq = (const bf16*)(ws + OFF_PQ);
    const bf16* skb = (const bf16*)(ws + OFF_SKB) + (size_t)L * 16 * 128 * 64;
    int* ids = (int*)(ws + OFF_IDS);
    float* gates = (float*)(ws + OFF_GATE);
    float* sc = (float*)smem;
    int* Lq = (int*)(smem + 64 * 129 * 4);
    int* Fin = Lq + 4 * 64 * 16;
    const int tid = opaque_tid(), w = tid >> 6, l = tid & 63, r = l & 31, hh = l >> 5;
    for (int item = blockIdx.x; item < TOK / 64; item += gridDim.x) {
        const int t0 = item * 64;
        for (int h = 0; h < 8; ++h) {
            for (int p = 0; p < 2; ++p) {
                const int hp = h * 2 + p;
                f32x16 acc[2];
#pragma unroll
                for (int j = 0; j < 2; ++j)
#pragma unroll
                    for (int rr = 0; rr < 16; ++rr) acc[j][rr] = 0.f;
#pragma unroll
                for (int s = 0; s < 4; ++s) {
                    bf16x8 af = *(const bf16x8*)(skb + ((size_t)hp * 128 + 32 * w + r) * 64 + 16 * s + 8 * hh);
#pragma unroll
                    for (int j = 0; j < 2; ++j) {
                        bf16x8 bfr = *(const bf16x8*)(pq + (size_t)(t0 + 32 * j + r) * 1024 + hp * 64 + 16 * s + 8 * hh);
                        acc[j] = __builtin_amdgcn_mfma_f32_32x32x16_bf16(af, bfr, acc[j], 0, 0, 0);
                    }
                }
#pragma unroll
                for (int j = 0; j < 2; ++j)
#pragma unroll
                    for (int rr = 0; rr < 16; ++rr) {
                        int key = 32 * w + (rr & 3) + 8 * (rr >> 2) + 4 * hh;
                        sc[(32 * j + r) * 129 + key] = acc[j][rr];
                    }
                __syncthreads();
                {
                    const int token = l, quarter = w;
                    int A[16], B[16];
#pragma unroll
                    for (int i = 0; i < 16; ++i) {
                        int n = quarter * 32 + i;
                        A[i] = f2key(sc[token * 129 + n], 127 - n, 127);
                        B[i] = f2key(sc[token * 129 + n + 16], 127 - (n + 16), 127);
                    }
                    bitonic_sort16(A);
                    bitonic_sort16(B);
                    merge_top16(A, B);
#pragma unroll
                    for (int i = 0; i < 16; ++i) Lq[(quarter * 64 + token) * 16 + i] = A[i];
                    __syncthreads();
                    if ((quarter & 1) == 0) {
#pragma unroll
                        for (int i = 0; i < 16; ++i) B[i] = Lq[((quarter + 1) * 64 + token) * 16 + i];
                        merge_top16(A, B);
                        if (quarter == 2) {
#pragma unroll
                            for (int i = 0; i < 16; ++i) Lq[(2 * 64 + token) * 16 + i] = A[i];
                        }
                    }
                    __syncthreads();
                    if (quarter == 0) {
#pragma unroll
                        for (int i = 0; i < 16; ++i) B[i] = Lq[(2 * 64 + token) * 16 + i];
                        merge_top16(A, B);
#pragma unroll
                        for (int i = 0; i < 16; ++i) Fin[(p * 64 + token) * 16 + i] = A[i];
                    }
                    __syncthreads();
                }
            }
            if (w == 0) {
                const int token = l;
                float s1[16], s2[16];
#pragma unroll
                for (int i = 0; i < 16; ++i) {
                    s1[i] = key2f(Fin[(0 * 64 + token) * 16 + i], 127);
                    s2[i] = key2f(Fin[(1 * 64 + token) * 16 + i], 127);
                }
                int Lc[16], X[16];
#pragma unroll
                for (int b2 = 0; b2 < 16; ++b2) Lc[b2] = f2key(s1[0] + s2[b2], 255 - b2, 255);
#pragma unroll
                for (int a = 1; a < 16; ++a) X[a - 1] = f2key(s1[a] + s2[0], 255 - a * 16, 255);
                X[15] = INT_MIN;
                merge_top16(Lc, X);
                {
                    int c = 0;
#pragma unroll
                    for (int b2 = 1; b2 <= 7; ++b2) X[c++] = f2key(s1[1] + s2[b2], 255 - (16 + b2), 255);
#pragma unroll
                    for (int b2 = 1; b2 <= 4; ++b2) X[c++] = f2key(s1[2] + s2[b2], 255 - (32 + b2), 255);
#pragma unroll
                    for (int b2 = 1; b2 <= 3; ++b2) X[c++] = f2key(s1[3] + s2[b2], 255 - (48 + b2), 255);
#pragma unroll
                    for (int b2 = 1; b2 <= 2; ++b2) X[c++] = f2key(s1[4] + s2[b2], 255 - (64 + b2), 255);
                }
                bitonic_sort16(X);
                merge_top16(Lc, X);
                X[0] = f2key(s1[5] + s2[1], 255 - (80 + 1), 255);
                X[1] = f2key(s1[6] + s2[1], 255 - (96 + 1), 255);
                X[2] = f2key(s1[7] + s2[1], 255 - (112 + 1), 255);
#pragma unroll
                for (int i = 3; i < 16; ++i) X[i] = INT_MIN;
                merge_top16(Lc, X);
                float mx = key2f(Lc[0], 255);
                float ev[16], sum = 0.f;
#pragma unroll
                for (int k = 0; k < 16; ++k) { ev[k] = __expf(key2f(Lc[k], 255) - mx); sum += ev[k]; }
                float inv = 1.f / sum;
                size_t ob = (size_t)(t0 + token) * 128 + h * 16;
#pragma unroll
                for (int k = 0; k < 16; ++k) {
                    int cidx = 255 - (Lc[k] & 255);
                    int a = cidx >> 4, b2 = cidx & 15;
                    int i1 = 127 - (Fin[(0 * 64 + token) * 16 + a] & 127);
                    int i2 = 127 - (Fin[(1 * 64 + token) * 16 + b2] & 127);
                    ids[ob + k] = i1 * 128 + i2;
                    gates[ob + k] = ev[k] * inv;
                }
            }
            __syncthreads();
        }
    }
}

__device__ __forceinline__ float gelu_exact(float x) { return 0.5f * x * (1.f + erff(x * 0.70710678118654752f)); }

__device__ __forceinline__ void phase_gather(const Params& P, int L, bf16* hb_out, const float* ss_ffn, float* ss_ple) {
    char* ws = opq(P.ws);
    const bf16* Ub = (const bf16*)(ws + OFF_UB) + (size_t)L * NEXP * DM;
    const bf16* Vb = (const bf16*)(ws + OFF_VB) + (size_t)L * NEXP * DM;
    const int* ids = (const int*)(ws + OFF_IDS);
    const float* gates = (const float*)(ws + OFF_GATE);
    const float* g = P.norm_ffn_g + L * 1024;
    const int tid = opaque_tid(), w = tid >> 6, l = tid & 63;
    float gv[16];
    {
        const float4* g4 = (const float4*)g;
        float4 a = g4[l * 2], b = g4[l * 2 + 1], c = g4[128 + l * 2], d = g4[128 + l * 2 + 1];
        gv[0] = a.x; gv[1] = a.y; gv[2] = a.z; gv[3] = a.w; gv[4] = b.x; gv[5] = b.y; gv[6] = b.z; gv[7] = b.w;
        gv[8] = c.x; gv[9] = c.y; gv[10] = c.z; gv[11] = c.w; gv[12] = d.x; gv[13] = d.y; gv[14] = d.z; gv[15] = d.w;
    }
    for (int t = blockIdx.x * 4 + w; t < TOK; t += gridDim.x * 4) {
        float hv[16], xv[16];
        {
            const float4* h4 = (const float4*)(P.out + (size_t)t * 1024);
            float4 a = h4[l * 2], b = h4[l * 2 + 1], c = h4[128 + l * 2], d = h4[128 + l * 2 + 1];
            hv[0] = a.x; hv[1] = a.y; hv[2] = a.z; hv[3] = a.w; hv[4] = b.x; hv[5] = b.y; hv[6] = b.z; hv[7] = b.w;
            hv[8] = c.x; hv[9] = c.y; hv[10] = c.z; hv[11] = c.w; hv[12] = d.x; hv[13] = d.y; hv[14] = d.z; hv[15] = d.w;
        }
        float rs = row_rs8(ss_ffn, t);
#pragma unroll
        for (int i = 0; i < 16; ++i) xv[i] = hv[i] * rs * gv[i];
        int idA = ids[(size_t)t * 128 + l], idB = ids[(size_t)t * 128 + 64 + l];
        float gA = gates[(size_t)t * 128 + l], gB = gates[(size_t)t * 128 + 64 + l];
        float preA = 0.f, preB = 0.f;
        auto dot_half = [&](int idv, float& pre) {
#pragma unroll 4
            for (int k = 0; k < 64; ++k) {
                int id = __builtin_amdgcn_readlane(idv, k);
                const uint4* row = (const uint4*)(Ub + (size_t)id * 1024);
                uint4 u0 = row[l], u1 = row[64 + l];
                float s = 0.f;
                s += bflo(u0.x) * xv[0] + bfhi(u0.x) * xv[1] + bflo(u0.y) * xv[2] + bfhi(u0.y) * xv[3];
                s += bflo(u0.z) * xv[4] + bfhi(u0.z) * xv[5] + bflo(u0.w) * xv[6] + bfhi(u0.w) * xv[7];
                s += bflo(u1.x) * xv[8] + bfhi(u1.x) * xv[9] + bflo(u1.y) * xv[10] + bfhi(u1.y) * xv[11];
                s += bflo(u1.z) * xv[12] + bfhi(u1.z) * xv[13] + bflo(u1.w) * xv[14] + bfhi(u1.w) * xv[15];
                s = wave_sum(s);
                if (l == k) pre = s;
            }
        };
        dot_half(idA, preA);
        dot_half(idB, preB);
        float actA = gA * gelu_exact(preA), actB = gB * gelu_exact(preB);
        float ov[16];
#pragma unroll
        for (int i = 0; i < 16; ++i) ov[i] = 0.f;
        auto acc_half = [&](int idv, float actv) {
#pragma unroll 4
            for (int k = 0; k < 64; ++k) {
                int id = __builtin_amdgcn_readlane(idv, k);
                float a = __builtin_bit_cast(float, __builtin_amdgcn_readlane(__builtin_bit_cast(int, actv), k));
                const uint4* row = (const uint4*)(Vb + (size_t)id * 1024);
                uint4 u0 = row[l], u1 = row[64 + l];
                ov[0] += a * bflo(u0.x); ov[1] += a * bfhi(u0.x); ov[2] += a * bflo(u0.y); ov[3] += a * bfhi(u0.y);
                ov[4] += a * bflo(u0.z); ov[5] += a * bfhi(u0.z); ov[6] += a * bflo(u0.w); ov[7] += a * bfhi(u0.w);
                ov[8] += a * bflo(u1.x); ov[9] += a * bfhi(u1.x); ov[10] += a * bflo(u1.y); ov[11] += a * bfhi(u1.y);
                ov[12] += a * bflo(u1.z); ov[13] += a * bfhi(u1.z); ov[14] += a * bflo(u1.w); ov[15] += a * bfhi(u1.w);
            }
        };
        acc_half(idA, actA);
        acc_half(idB, actB);
        float ss = 0.f;
#pragma unroll
        for (int i = 0; i < 16; ++i) { hv[i] += ov[i]; ss += hv[i] * hv[i]; }
        ss = wave_sum(ss);
        if (l == 0) ss_ple[t] = ss;
        float4* o4 = (float4*)(P.out + (size_t)t * 1024);
        o4[l * 2] = make_float4(hv[0], hv[1], hv[2], hv[3]);
        o4[l * 2 + 1] = make_float4(hv[4], hv[5], hv[6], hv[7]);
        o4[128 + l * 2] = make_float4(hv[8], hv[9], hv[10], hv[11]);
        o4[128 + l * 2 + 1] = make_float4(hv[12], hv[13], hv[14], hv[15]);
        uint4 b0, b1;
        b0.x = pack2(hv[0], hv[1]); b0.y = pack2(hv[2], hv[3]); b0.z = pack2(hv[4], hv[5]); b0.w = pack2(hv[6], hv[7]);
        b1.x = pack2(hv[8], hv[9]); b1.y = pack2(hv[10], hv[11]); b1.z = pack2(hv[12], hv[13]); b1.w = pack2(hv[14], hv[15]);
        uint4* hb4 = (uint4*)(hb_out + (size_t)t * 1024);
        hb4[l] = b0;
        hb4[64 + l] = b1;
    }
}

__device__ __forceinline__ void phase_ple(const Params& P, int L, const bf16* hb_in, bf16* hb_out, const float* ss_ple, float* ss_out) {
    char* ws = opq(P.ws);
    const bf16* Wg = (const bf16*)(ws + OFF_WG) + (size_t)L * 1024 * 1024;
    const bf16* Wp = (const bf16*)(ws + OFF_WP) + (size_t)L * 1024 * 256;
    const float* pin = P.p + (size_t)L * TOK * 256;
    const int tid = opaque_tid(), w = tid >> 6, l = tid & 63, hh = l >> 5, wm = w >> 1, wn = w & 1;
    for (int tile = blockIdx.x; tile < 128 * 8; tile += gridDim.x) {
        int mt = tile >> 3, nt = tile & 7;
        int m0 = mt * 128, n0 = nt * 128;
        f32x16 acc1[2][2], acc2[2][2];
        ZERO_ACC(acc1);
        ZERO_ACC(acc2);
        gemm_core<0>(acc1, hb_in, 1024, Wg, 1024, 1024, m0, n0, NoScale());
        gemm_core<1>(acc2, pin, 256, Wp, 256, 256, m0, n0, NoScale());
        float part[2][16];
#pragma unroll
        for (int i = 0; i < 2; ++i) {
            int rbase = m0 + wm * 64 + i * 32 + 4 * hh;
#pragma unroll
            for (int rr = 0; rr < 16; ++rr) {
                int row = rbase + (rr & 3) + 8 * (rr >> 2);
                float rs = rsqrtf(ss_ple[row] * (1.f / 1024.f) + EPSF);
                float ps = 0.f;
#pragma unroll
                for (int j = 0; j < 2; ++j) {
                    int col = n0 + wn * 64 + j * 32 + (l & 31);
                    size_t idx = (size_t)row * 1024 + col;
                    float gte = 1.f / (1.f + __expf(-acc1[i][j][rr] * rs));
                    float v = P.out[idx] + gte * acc2[i][j][rr];
                    P.out[idx] = v;
                    hb_out[idx] = (bf16)v;
                    ps += v * v;
                }
                part[i][rr] = ps;
            }
        }
        rowss_flush(part, ss_out, m0, nt);
    }
}

__device__ __forceinline__ void phase_final(const Params& P, const float* ss) {
    const int tid = opaque_tid(), w = tid >> 6, l = tid & 63;
    const float4* g4 = (const float4*)P.final_norm_g;
    for (int t = blockIdx.x * 4 + w; t < TOK; t += gridDim.x * 4) {
        float rs = row_rs8(ss, t);
        float4* o4 = (float4*)(P.out + (size_t)t * 1024);
#pragma unroll
        for (int i = 0; i < 4; ++i) {
            float4 v = o4[i * 64 + l], g = g4[i * 64 + l];
            v.x *= rs * g.x; v.y *= rs * g.y; v.z *= rs * g.z; v.w *= rs * g.w;
            o4[i * 64 + l] = v;
        }
    }
}

__device__ __forceinline__ void grid_barrier(unsigned* bar) {
    asm volatile("s_waitcnt vmcnt(0)" ::: "memory");
    __syncthreads();
    if (threadIdx.x == 0) {
        __builtin_amdgcn_fence(__ATOMIC_RELEASE, "agent");
        asm volatile("s_waitcnt vmcnt(0)" ::: "memory");
        const unsigned G = gridDim.x;
        unsigned old = __hip_atomic_fetch_add(bar, 1u, __ATOMIC_RELAXED, __HIP_MEMORY_SCOPE_AGENT);
        unsigned target = (old / G + 1u) * G;
        while (__hip_atomic_load(bar, __ATOMIC_RELAXED, __HIP_MEMORY_SCOPE_AGENT) < target) __builtin_amdgcn_s_sleep(2);
        __builtin_amdgcn_fence(__ATOMIC_ACQUIRE, "agent");
        asm volatile("s_waitcnt vmcnt(0)" ::: "memory");
    }
    __syncthreads();
}

__global__ void __launch_bounds__(NTHR, 2) hymba_megakernel(Params P) {
    cg::grid_group grid = cg::this_grid();
    char* ws = opq(P.ws);
    float* ssa = (float*)(ws + OFF_SSA);
    float* ssp = (float*)(ws + OFF_SSP);
    bf16* hb[2] = {(bf16*)(ws + OFF_HB0), (bf16*)(ws + OFF_HB1)};
    unsigned* bar = (unsigned*)(ws + OFF_BAR);
    phase0(P);
    asm volatile("s_waitcnt vmcnt(0)" ::: "memory");
    __syncthreads();
    grid.sync();
    grid_barrier(bar);
    int cur = 0;
    for (int L = 0; L < 2; ++L) {
        const float* ss_mix = (L == 0) ? ssa : (ssa + 3 * TOK * 8);
        float* ss_ffn = ssa + (size_t)(1 + L) * TOK * 8;
        float* ss_next = (L == 0) ? (ssa + 3 * TOK * 8) : (ssa + 4 * TOK * 8);
        phase_proj(P, L, hb[cur], ss_mix);
        grid_barrier(bar);
        phase_mla_up(P, L);
        grid_barrier(bar);
        phase_attn(P, L);
        grid_barrier(bar);
        phase_wo(P, L, (L == 0) ? P.x : P.out, hb[cur ^ 1], ss_ffn);
        grid_barrier(bar);
        phase_pq(P, L, hb[cur ^ 1], ss_ffn);
        grid_barrier(bar);
        phase_topk(P, L);
        grid_barrier(bar);
        phase_gather(P, L, hb[cur], ss_ffn, ssp + L * TOK);
        grid_barrier(bar);
        phase_ple(P, L, hb[cur], hb[cur ^ 1], ssp + L * TOK, ss_next);
        grid_barrier(bar);
        cur ^= 1;
    }
    phase_final(P, ssa + 4 * TOK * 8);
}

extern "C" void kernel_launch(void* const* d_in, const int* in_sizes, int n_in, void* d_out, int out_size, void* d_ws,
                              size_t ws_size, hipStream_t stream) {
    static int grid_blocks = 0;
    if (!grid_blocks) {
        int dev = 0, cus = 0, per_cu = 0;
        hipGetDevice(&dev);
        hipDeviceGetAttribute(&cus, hipDeviceAttributeMultiprocessorCount, dev);
        hipOccupancyMaxActiveBlocksPerMultiprocessor(&per_cu, hymba_megakernel, NTHR, 0);
        if (per_cu > 2) per_cu = 2;
        if (per_cu < 1) per_cu = 1;
        grid_blocks = cus * per_cu;
        if (ws_size < WS_END) fprintf(stderr, "workspace too small: %zu < %zu\n", ws_size, (size_t)WS_END);
    }
    Params P{};
    P.x = (const float*)d_in[0]; P.p = (const float*)d_in[1]; P.pos = (const int*)d_in[2];
    P.norm_mix_g = (const float*)d_in[3]; P.w_in = (const float*)d_in[4]; P.b_forget = (const float*)d_in[5];
    P.mla_q_norm_g = (const float*)d_in[6]; P.w_uq = (const float*)d_in[7]; P.mla_kv_norm_g = (const float*)d_in[8];
    P.w_ukv = (const float*)d_in[9]; P.mix_out_norm_g = (const float*)d_in[10]; P.w_o = (const float*)d_in[11];
    P.norm_ffn_g = (const float*)d_in[12]; P.w_query = (const float*)d_in[13]; P.sub_keys = (const float*)d_in[14];
    P.peer_u = (const float*)d_in[15]; P.peer_v = (const float*)d_in[16]; P.w_ple = (const float*)d_in[17];
    P.ple_norm_g = (const float*)d_in[18]; P.w_ple_gate = (const float*)d_in[19]; P.final_norm_g = (const float*)d_in[20];
    P.out = (float*)d_out; P.ws = (char*)d_ws;
    hipMemsetAsync((char*)d_ws + OFF_BAR, 0, 4096, stream);
    void* args[] = {&P};
    hipError_t e = hipLaunchCooperativeKernel((void*)hymba_megakernel, dim3(grid_blocks), dim3(NTHR), args, 0, stream);
    if (e != hipSuccess) fprintf(stderr, "cooperative launch failed: %s (grid %d)\n", hipGetErrorString(e), grid_blocks);
}
```

```cpp
#include <hip/hip_runtime.h>
#include <hip/hip_cooperative_groups.h>
#include <cstdio>
#include <cstdint>
#include <math.h>
#include <climits>
namespace cg = cooperative_groups;

typedef __bf16 bf16;
typedef __bf16 bf16x8 __attribute__((ext_vector_type(8)));
typedef __bf16 bf16x4 __attribute__((ext_vector_type(4)));
typedef __bf16 bf16x2 __attribute__((ext_vector_type(2)));
typedef float f32x16 __attribute__((ext_vector_type(16)));
typedef float f32x4 __attribute__((ext_vector_type(4)));
typedef float f32x2 __attribute__((ext_vector_type(2)));
typedef unsigned u32x4 __attribute__((ext_vector_type(4)));
typedef unsigned u32x2 __attribute__((ext_vector_type(2)));

#define SEQ 2048
#define BATCH 8
#define TOK 16384
#define DM 1024
#define IN_W 1956
#define NEXP 16384
#define EPSF 1e-6f
#define LOG2E 1.4426950408889634f
#define NTHR 256
#define LDS_BYTES 65536

constexpr size_t MBy = 1ull << 20;
constexpr size_t OFF_UB = 0;
constexpr size_t OFF_VB = 32 * MBy;
constexpr size_t OFF_PART = 64 * MBy;
constexpr size_t OFF_WIN = 128 * MBy;
constexpr size_t OFF_WO = 136 * MBy;
constexpr size_t OFF_WQ = 140 * MBy;
constexpr size_t OFF_WG = 144 * MBy;
constexpr size_t OFF_WP = 148 * MBy;
constexpr size_t OFF_WUQ = 149 * MBy;
constexpr size_t OFF_WUKV = 149 * MBy + 512 * 1024;
constexpr size_t OFF_SKB = 150 * MBy;
constexpr size_t OFF_CS = 151 * MBy;
constexpr size_t OFF_TSC = 153 * MBy;
constexpr size_t OFF_SSA = 154 * MBy;
constexpr size_t OFF_SSP = 157 * MBy;
constexpr size_t OFF_HB0 = 158 * MBy;
constexpr size_t OFF_HB1 = 190 * MBy;
constexpr size_t OFF_FQ = 222 * MBy;
constexpr size_t OFF_FK = 230 * MBy;
constexpr size_t OFF_FVT = 238 * MBy;
constexpr size_t OFF_SQ = 246 * MBy;
constexpr size_t OFF_SKK = 254 * MBy;
constexpr size_t OFF_SVT = 262 * MBy;
constexpr size_t OFF_CQ = 270 * MBy;
constexpr size_t OFF_CKV = 278 * MBy;
constexpr size_t OFF_FLOG = 282 * MBy;
constexpr size_t OFF_CUMF = 283 * MBy;
constexpr size_t OFF_MQ = 284 * MBy;
constexpr size_t OFF_MK = 296 * MBy;
constexpr size_t OFF_MVT = 308 * MBy;
constexpr size_t OFF_Y = 324 * MBy;
constexpr size_t OFF_PQ = 356 * MBy;
constexpr size_t OFF_IDS = 388 * MBy;
constexpr size_t OFF_GATE = 396 * MBy;
constexpr size_t OFF_BAR = 404 * MBy;
constexpr size_t OFF_CNT = OFF_BAR + 1024;
constexpr size_t OFF_SSY = 405 * MBy;
constexpr size_t WS_END = 408 * MBy;

struct Params {
    const float* x; const float* p; const int* pos;
    const float* norm_mix_g; const float* w_in; const float* b_forget; const float* mla_q_norm_g; const float* w_uq;
    const float* mla_kv_norm_g; const float* w_ukv; const float* mix_out_norm_g; const float* w_o; const float* norm_ffn_g;
    const float* w_query; const float* sub_keys; const float* peer_u; const float* peer_v; const float* w_ple;
    const float* ple_norm_g; const float* w_ple_gate; const float* final_norm_g;
    float* out; char* ws;
};

__shared__ __attribute__((aligned(16))) char smem[LDS_BYTES];

__device__ __forceinline__ int opaque_tid() { int t = threadIdx.x; asm volatile("" : "+v"(t)); return t; }
template <typename T> __device__ __forceinline__ T* opq(T* p) { asm volatile("" : "+s"(p)); return p; }

__device__ __forceinline__ unsigned pack2(float a, float b) {
    f32x2 v = {a, b};
    bf16x2 r = __builtin_convertvector(v, bf16x2);
    return __builtin_bit_cast(unsigned, r);
}
__device__ __forceinline__ float bflo(unsigned u) { return __uint_as_float(u << 16); }
__device__ __forceinline__ float bfhi(unsigned u) { return __uint_as_float(u & 0xffff0000u); }
__device__ __forceinline__ float wave_sum(float v) {
#pragma unroll
    for (int o = 32; o > 0; o >>= 1) v += __shfl_xor(v, o);
    return v;
}
__device__ __forceinline__ float fexp2(float x) { return __builtin_amdgcn_exp2f(x); }
__device__ __forceinline__ float flog2(float x) { return __builtin_amdgcn_logf(x); }
__device__ __forceinline__ float log_sigmoid_f(float z) { return fminf(z, 0.f) - log1pf(expf(-fabsf(z))); }

struct WJob { const float* src; int lds; int K; int Np; bf16* dst; const float* gain; int map; };

__device__ __forceinline__ int src_col_map(int map, int c) {
    if (map == 0) return c;
    if (map == 1) {
        if (c < 768) return c;
        if (c < 1952) return c + 4;
        if (c < 1956) return c - 1952 + 768;
        return -1;
    }
    if (c < 256) return 192 * (c >> 6) + (c & 63);
    int e = c - 256;
    return 192 * (e >> 7) + 64 + (e & 127);
}

__device__ __forceinline__ void wconv_tile(const WJob& j, int tile) {
    float* tl = (float*)smem;
    int ktiles = j.K >> 5;
    int nt = tile / ktiles, kt = tile % ktiles;
    int n0 = nt * 32, k0 = kt * 32;
    int tx = opaque_tid() & 31, ty = opaque_tid() >> 5;
    int sc = src_col_map(j.map, n0 + tx);
#pragma unroll
    for (int i = 0; i < 4; ++i) {
        int k = k0 + ty + 8 * i;
        float v = 0.f;
        if (sc >= 0) v = j.src[(size_t)k * j.lds + sc] * (j.gain ? j.gain[k] : 1.f);
        tl[(ty + 8 * i) * 33 + tx] = v;
    }
    __syncthreads();
#pragma unroll
    for (int i = 0; i < 4; ++i) {
        int n = n0 + ty + 8 * i;
        j.dst[(size_t)n * j.K + k0 + tx] = (bf16)tl[tx * 33 + ty + 8 * i];
    }
    __syncthreads();
}

__device__ __forceinline__ void phase0(const Params& P) {
    char* ws = opq(P.ws);
    const int G = gridDim.x, bid = blockIdx.x, tid = opaque_tid();
    {
        const int w = tid >> 6, l = tid & 63;
        float* tsc = (float*)(ws + OFF_TSC);
        for (int it = bid * 4 + w; it < 4 * NEXP; it += G * 4) {
            int tb = it >> 14, e = it & (NEXP - 1);
            const float* src = (tb < 2 ? P.peer_u : P.peer_v) + ((size_t)(tb & 1) * NEXP + e) * DM + l * 16;
            unsigned char* dst = (unsigned char*)(ws + (tb < 2 ? OFF_UB : OFF_VB)) + (size_t)(tb & 1) * NEXP * DM;
            float4 a = ((const float4*)src)[0], b = ((const float4*)src)[1], c = ((const float4*)src)[2], d = ((const float4*)src)[3];
            float am = fmaxf(fmaxf(fmaxf(fabsf(a.x), fabsf(a.y)), fmaxf(fabsf(a.z), fabsf(a.w))), fmaxf(fmaxf(fabsf(b.x), fabsf(b.y)), fmaxf(fabsf(b.z), fabsf(b.w))));
            am = fmaxf(am, fmaxf(fmaxf(fmaxf(fabsf(c.x), fabsf(c.y)), fmaxf(fabsf(c.z), fabsf(c.w))), fmaxf(fmaxf(fabsf(d.x), fabsf(d.y)), fmaxf(fabsf(d.z), fabsf(d.w)))));
#pragma unroll
            for (int o = 32; o > 0; o >>= 1) am = fmaxf(am, __shfl_xor(am, o));
            int eb = ((__float_as_int(am) >> 23) & 0xff) - 127;
            eb = max(-100, min(100, eb));
            if (am == 0.f) eb = 7;
            float sc = __int_as_float((127 + 7 - eb) << 23), isc = __int_as_float((127 + eb - 7) << 23);
            int w0 = 0, w1 = 0, w2 = 0, w3 = 0;
            w0 = __builtin_amdgcn_cvt_pk_fp8_f32(a.x * sc, a.y * sc, w0, false); w0 = __builtin_amdgcn_cvt_pk_fp8_f32(a.z * sc, a.w * sc, w0, true);
            w1 = __builtin_amdgcn_cvt_pk_fp8_f32(b.x * sc, b.y * sc, w1, false); w1 = __builtin_amdgcn_cvt_pk_fp8_f32(b.z * sc, b.w * sc, w1, true);
            w2 = __builtin_amdgcn_cvt_pk_fp8_f32(c.x * sc, c.y * sc, w2, false); w2 = __builtin_amdgcn_cvt_pk_fp8_f32(c.z * sc, c.w * sc, w2, true);
            w3 = __builtin_amdgcn_cvt_pk_fp8_f32(d.x * sc, d.y * sc, w3, false); w3 = __builtin_amdgcn_cvt_pk_fp8_f32(d.z * sc, d.w * sc, w3, true);
            u32x4 o4 = {(unsigned)w0, (unsigned)w1, (unsigned)w2, (unsigned)w3};
            *(u32x4*)(dst + ((size_t)(l >> 3) * NEXP + e) * 128 + (l & 7) * 16) = o4;
            if (l == 0) tsc[tb * NEXP + e] = isc;
        }
    }
    {
        for (int L = 0; L < 2; ++L) {
            WJob jobs[7];
            jobs[0] = {P.w_in + (size_t)L * 1024 * IN_W, IN_W, 1024, 2048, (bf16*)(ws + OFF_WIN) + (size_t)L * 2048 * 1024, P.norm_mix_g + L * 1024, 1};
            jobs[1] = {P.w_o + (size_t)L * 1024 * 1024, 1024, 1024, 1024, (bf16*)(ws + OFF_WO) + (size_t)L * 1024 * 1024, P.mix_out_norm_g + L * 1024, 0};
            jobs[2] = {P.w_query + (size_t)L * 1024 * 1024, 1024, 1024, 1024, (bf16*)(ws + OFF_WQ) + (size_t)L * 1024 * 1024, P.norm_ffn_g + L * 1024, 0};
            jobs[3] = {P.w_ple_gate + (size_t)L * 1024 * 1024, 1024, 1024, 1024, (bf16*)(ws + OFF_WG) + (size_t)L * 1024 * 1024, P.ple_norm_g + L * 1024, 0};
            jobs[4] = {P.w_ple + (size_t)L * 256 * 1024, 1024, 256, 1024, (bf16*)(ws + OFF_WP) + (size_t)L * 1024 * 256, nullptr, 0};
            jobs[5] = {P.w_uq + (size_t)L * 256 * 384, 384, 256, 384, (bf16*)(ws + OFF_WUQ) + (size_t)L * 384 * 256, P.mla_q_norm_g + L * 256, 0};
            jobs[6] = {P.w_ukv + (size_t)L * 128 * 768, 768, 128, 768, (bf16*)(ws + OFF_WUKV) + (size_t)L * 768 * 128, P.mla_kv_norm_g + L * 128, 2};
#pragma unroll
            for (int q = 0; q < 7; ++q) {
                int nt = (jobs[q].Np >> 5) * (jobs[q].K >> 5);
                for (int it = bid; it < nt; it += G) wconv_tile(jobs[q], it);
            }
        }
    }
    {
        const float* src = P.sub_keys;
        bf16* dst = (bf16*)(ws + OFF_SKB);
        for (int i = bid * NTHR + tid; i < 262144 / 2; i += G * NTHR) {
            float2 v = ((const float2*)src)[i];
            ((unsigned*)dst)[i] = pack2(v.x, v.y);
        }
    }
    {
        bf16* hb = (bf16*)(ws + OFF_HB0);
        float* ss0 = (float*)(ws + OFF_SSA);
        int w = tid >> 6, l = tid & 63;
        for (int row = bid * 4 + w; row < TOK; row += G * 4) {
            const float4* xr = (const float4*)(P.x + (size_t)row * DM);
            float ss = 0.f;
#pragma unroll
            for (int i = 0; i < 2; ++i) {
                float4 a = xr[i * 128 + l * 2], b = xr[i * 128 + l * 2 + 1];
                ss += a.x * a.x + a.y * a.y + a.z * a.z + a.w * a.w + b.x * b.x + b.y * b.y + b.z * b.z + b.w * b.w;
                uint4 o;
                o.x = pack2(a.x, a.y); o.y = pack2(a.z, a.w); o.z = pack2(b.x, b.y); o.w = pack2(b.z, b.w);
                ((uint4*)(hb + (size_t)row * DM))[i * 64 + l] = o;
            }
            ss = wave_sum(ss);
            if (l == 0) {
                *(float4*)(ss0 + (size_t)row * 8) = make_float4(ss, 0.f, 0.f, 0.f);
                *(float4*)(ss0 + (size_t)row * 8 + 4) = make_float4(0.f, 0.f, 0.f, 0.f);
            }
        }
    }
    {
        float* cs = (float*)(ws + OFF_CS);
        for (int i = bid * NTHR + tid; i < TOK * 16; i += G * NTHR) {
            int t = i >> 4, k = i & 15;
            float inv = powf(10000.0f, -(float)k / 16.0f);
            float ang = (float)P.pos[t] * inv;
            cs[2 * i] = cosf(ang);
            cs[2 * i + 1] = sinf(ang);
        }
    }
}

template <int AMODE, typename SF>
__device__ __forceinline__ void gemm_core(f32x16 (&acc)[2][2], const void* Ap, int lda, const bf16* Bt, int ldb, int K,
                                          int m0, int n0, SF scalef) {
    const int tid = opaque_tid(), w = tid >> 6, l = tid & 63, r = l & 31, hh = l >> 5;
    const int wm = w >> 1, wn = w & 1;
    const int lc = tid & 7, lr = tid >> 3;
    u32x4 ra[4], rb[4];
    auto gload = [&](int k0) {
#pragma unroll
        for (int i = 0; i < 4; ++i) {
            int row = lr + 32 * i;
            if (AMODE == 1) {
                const float4* s = (const float4*)((const float*)Ap + (size_t)(m0 + row) * lda + k0 + lc * 8);
                float4 a = s[0], b = s[1];
                ra[i].x = pack2(a.x, a.y); ra[i].y = pack2(a.z, a.w); ra[i].z = pack2(b.x, b.y); ra[i].w = pack2(b.z, b.w);
            } else {
                ra[i] = *(const u32x4*)((const bf16*)Ap + (size_t)(m0 + row) * lda + k0 + lc * 8);
                if (AMODE == 2) {
                    float sc = scalef(i, k0);
                    ra[i].x = pack2(bflo(ra[i].x) * sc, bfhi(ra[i].x) * sc);
                    ra[i].y = pack2(bflo(ra[i].y) * sc, bfhi(ra[i].y) * sc);
                    ra[i].z = pack2(bflo(ra[i].z) * sc, bfhi(ra[i].z) * sc);
                    ra[i].w = pack2(bflo(ra[i].w) * sc, bfhi(ra[i].w) * sc);
                }
            }
            rb[i] = *(const u32x4*)(Bt + (size_t)(n0 + row) * ldb + k0 + lc * 8);
        }
    };
    auto lwrite = [&](int buf) {
        char* base = smem + buf * 32768;
#pragma unroll
        for (int i = 0; i < 4; ++i) {
            int row = lr + 32 * i;
            int off = row * 128 + ((lc ^ (row & 7)) << 4);
            *(u32x4*)(base + off) = ra[i];
            *(u32x4*)(base + 16384 + off) = rb[i];
        }
    };
    const int nk = K >> 6;
    gload(0);
    lwrite(0);
    __syncthreads();
    for (int kt = 0; kt < nk; ++kt) {
        if (kt + 1 < nk) gload((kt + 1) << 6);
        const char* base = smem + (kt & 1) * 32768;
#pragma unroll
        for (int s = 0; s < 4; ++s) {
            int ch = ((2 * s + hh) ^ (r & 7)) << 4;
            bf16x8 af[2], bfr[2];
#pragma unroll
            for (int i = 0; i < 2; ++i) af[i] = *(const bf16x8*)(base + (wm * 64 + i * 32 + r) * 128 + ch);
#pragma unroll
            for (int j = 0; j < 2; ++j) bfr[j] = *(const bf16x8*)(base + 16384 + (wn * 64 + j * 32 + r) * 128 + ch);
#pragma unroll
            for (int i = 0; i < 2; ++i)
#pragma unroll
                for (int j = 0; j < 2; ++j) acc[i][j] = __builtin_amdgcn_mfma_f32_32x32x16_bf16(af[i], bfr[j], acc[i][j], 0, 0, 0);
        }
        if (kt + 1 < nk) lwrite((kt + 1) & 1);
        __syncthreads();
    }
}
__device__ __forceinline__ float row_rs8(const float* part, int row) {
    float4 a = *(const float4*)(part + (size_t)row * 8), b = *(const float4*)(part + (size_t)row * 8 + 4);
    float ss = ((a.x + a.y) + (a.z + a.w)) + ((b.x + b.y) + (b.z + b.w));
    return rsqrtf(ss * (1.f / 1024.f) + EPSF);
}
struct NoScale { __device__ __forceinline__ float operator()(int, int) const { return 1.f; } };

#define ZERO_ACC(acc)                                  \
    _Pragma("unroll") for (int _i = 0; _i < 2; ++_i)   \
    _Pragma("unroll") for (int _j = 0; _j < 2; ++_j)   \
    _Pragma("unroll") for (int _r = 0; _r < 16; ++_r) acc[_i][_j][_r] = 0.f;


__device__ __forceinline__ void phase_proj(const Params& P, int L, const bf16* hb, const float* ssrow) {
    char* ws = opq(P.ws);
    const bf16* Bt = (const bf16*)(ws + OFF_WIN) + (size_t)L * 2048 * 1024;
    bf16* fq = (bf16*)(ws + OFF_FQ); bf16* fk = (bf16*)(ws + OFF_FK); bf16* fvt = (bf16*)(ws + OFF_FVT);
    bf16* sq = (bf16*)(ws + OFF_SQ); bf16* sk = (bf16*)(ws + OFF_SKK); bf16* svt = (bf16*)(ws + OFF_SVT);
    bf16* cq = (bf16*)(ws + OFF_CQ); bf16* ckv = (bf16*)(ws + OFF_CKV);
    float* flog = (float*)(ws + OFF_FLOG);
    bf16* mk = (bf16*)(ws + OFF_MK);
    const float* cs = (const float*)(ws + OFF_CS);
    const int tid = opaque_tid(), w = tid >> 6, l = tid & 63, hh = l >> 5, wm = w >> 1, wn = w & 1;
    for (int tile = blockIdx.x; tile < 128 * 16; tile += gridDim.x) {
        int mt = tile >> 4, nt = tile & 15;
        int m0 = mt * 128, n0 = nt * 128;
        f32x16 acc[2][2];
        ZERO_ACC(acc);
        gemm_core<0>(acc, hb, 1024, Bt, 1024, 1024, m0, n0, NoScale());
#pragma unroll
        for (int i = 0; i < 2; ++i) {
            float rs[16];
#pragma unroll
            for (int rr = 0; rr < 16; ++rr) {
                int row = m0 + wm * 64 + i * 32 + (rr & 3) + 8 * (rr >> 2) + 4 * hh;
                rs[rr] = row_rs8(ssrow, row);
            }
#pragma unroll
            for (int j = 0; j < 2; ++j) {
                int col = n0 + wn * 64 + j * 32 + (l & 31);
                int rbase = m0 + wm * 64 + i * 32 + 4 * hh;
                if (nt < 14 && nt != 4 && nt != 5 && nt != 10 && nt != 11) {
                    bf16* dst; int ld, c;
                    if (nt < 2) { dst = fq; ld = 256; c = col; }
                    else if (nt < 4) { dst = fk; ld = 256; c = col - 256; }
                    else if (nt < 8) { dst = sq; ld = 256; c = col - 768; }
                    else if (nt < 10) { dst = sk; ld = 256; c = col - 1024; }
                    else if (nt < 14) { dst = cq; ld = 256; c = col - 1536; }
                    if (nt == 14) { dst = ckv; ld = 128; c = col - 1792; }
#pragma unroll
                    for (int rr = 0; rr < 16; ++rr) {
                        int row = rbase + (rr & 3) + 8 * (rr >> 2);
                        dst[(size_t)row * ld + c] = (bf16)(acc[i][j][rr] * rs[rr]);
                    }
                } else if (nt == 14) {
                    int c = col - 1792;
#pragma unroll
                    for (int rr = 0; rr < 16; ++rr) {
                        int row = rbase + (rr & 3) + 8 * (rr >> 2);
                        ckv[(size_t)row * 128 + c] = (bf16)(acc[i][j][rr] * rs[rr]);
                    }
                } else if (nt == 4 || nt == 5 || nt == 10 || nt == 11) {
                    bf16* vt = (nt < 6) ? fvt : svt;
                    int c = col - ((nt < 6) ? 512 : 1280);
                    int b = m0 >> 11;
                    int s0 = (rbase & 2047);
                    bf16* base = vt + ((size_t)(b * 256 + c)) * SEQ + s0;
#pragma unroll
                    for (int g = 0; g < 4; ++g) {
                        uint2 o;
                        o.x = pack2(acc[i][j][4 * g] * rs[4 * g], acc[i][j][4 * g + 1] * rs[4 * g + 1]);
                        o.y = pack2(acc[i][j][4 * g + 2] * rs[4 * g + 2], acc[i][j][4 * g + 3] * rs[4 * g + 3]);
                        *(uint2*)(base + 8 * g) = o;
                    }
                } else {
                    if (wn == 0 && j == 0) {
                        int ci = l & 31, pi = ci & 15;
#pragma unroll
                        for (int rr = 0; rr < 16; ++rr) {
                            int row = rbase + (rr & 3) + 8 * (rr >> 2);
                            float v = acc[i][j][rr] * rs[rr];
                            float pv = __shfl_xor(v, 16);
                            float2 c_s = *(const float2*)(cs + ((size_t)row * 16 + pi) * 2);
                            float o = (ci < 16) ? (v * c_s.x - pv * c_s.y) : (pv * c_s.y + v * c_s.x);
                            bf16 ob = (bf16)o;
#pragma unroll
                            for (int h = 0; h < 4; ++h) mk[(size_t)row * 384 + h * 96 + 64 + ci] = ob;
                        }
                    } else if (wn == 0 && j == 1) {
                        int c = (l & 31);
                        if (c < 4) {
#pragma unroll
                            for (int rr = 0; rr < 16; ++rr) {
                                int row = rbase + (rr & 3) + 8 * (rr >> 2);
                                flog[(size_t)row * 4 + c] = acc[i][j][rr] * rs[rr];
                            }
                        }
                    }
                }
            }
        }
    }
}

struct RowScale4 { float s[4]; __device__ __forceinline__ float operator()(int i, int) const { return s[i]; } };

template <int KW>
__device__ __forceinline__ RowScale4 row_rms_prepass(const bf16* A, int lda, int m0) {
    const int tid = opaque_tid(), lc = tid & 7, lr = tid >> 3;
    RowScale4 rs;
#pragma unroll
    for (int i = 0; i < 4; ++i) {
        float ss = 0.f;
#pragma unroll
        for (int k0 = 0; k0 < KW; k0 += 64) {
            uint4 v = *(const uint4*)(A + (size_t)(m0 + lr + 32 * i) * lda + k0 + lc * 8);
            float a;
            a = bflo(v.x); ss += a * a; a = bfhi(v.x); ss += a * a;
            a = bflo(v.y); ss += a * a; a = bfhi(v.y); ss += a * a;
            a = bflo(v.z); ss += a * a; a = bfhi(v.z); ss += a * a;
            a = bflo(v.w); ss += a * a; a = bfhi(v.w); ss += a * a;
        }
        ss += __shfl_xor(ss, 1); ss += __shfl_xor(ss, 2); ss += __shfl_xor(ss, 4);
        rs.s[i] = rsqrtf(ss * (1.f / (float)KW) + EPSF);
    }
    return rs;
}

__device__ __forceinline__ void phase_mla_up(const Params& P, int L) {
    char* ws = opq(P.ws);
    const bf16* cq = (const bf16*)(ws + OFF_CQ); const bf16* ckv = (const bf16*)(ws + OFF_CKV);
    const bf16* wuq = (const bf16*)(ws + OFF_WUQ) + (size_t)L * 384 * 256;
    const bf16* wukv = (const bf16*)(ws + OFF_WUKV) + (size_t)L * 768 * 128;
    bf16* mq = (bf16*)(ws + OFF_MQ); bf16* mk = (bf16*)(ws + OFF_MK); bf16* mvt = (bf16*)(ws + OFF_MVT);
    const float* cs = (const float*)(ws + OFF_CS);
    const float* flog = (const float*)(ws + OFF_FLOG);
    float* cumF = (float*)(ws + OFF_CUMF);
    const int tid = opaque_tid(), w = tid >> 6, l = tid & 63, hh = l >> 5, wm = w >> 1, wn = w & 1;
    const int NQ = 128 * 3, NKV = 128 * 6, NCF = 8;
    for (int item = blockIdx.x; item < NQ + NKV + NCF; item += gridDim.x) {
        if (item < NQ) {
            int mt = item / 3, nt = item % 3;
            int m0 = mt * 128, n0 = nt * 128;
            RowScale4 rs = row_rms_prepass<256>(cq, 256, m0);
            f32x16 acc[2][2];
            ZERO_ACC(acc);
            gemm_core<2>(acc, cq, 256, wuq, 256, 256, m0, n0, rs);
#pragma unroll
            for (int i = 0; i < 2; ++i)
#pragma unroll
                for (int j = 0; j < 2; ++j) {
                    int c0 = n0 + wn * 64 + j * 32;
                    int col = c0 + (l & 31);
                    int rbase = m0 + wm * 64 + i * 32 + 4 * hh;
                    bool rot = (c0 % 96) == 64;
                    int ci = l & 31, pi = ci & 15;
#pragma unroll
                    for (int rr = 0; rr < 16; ++rr) {
                        int row = rbase + (rr & 3) + 8 * (rr >> 2);
                        float v = acc[i][j][rr];
                        if (rot) {
                            float pv = __shfl_xor(v, 16);
                            float2 c_s = *(const float2*)(cs + ((size_t)row * 16 + pi) * 2);
                            v = (ci < 16) ? (v * c_s.x - pv * c_s.y) : (pv * c_s.y + v * c_s.x);
                        }
                        mq[(size_t)row * 384 + col] = (bf16)v;
                    }
                }
        } else if (item < NQ + NKV) {
            int it2 = item - NQ;
            int mt = it2 / 6, nt = it2 % 6;
            int m0 = mt * 128, n0 = nt * 128;
            RowScale4 rs = row_rms_prepass<128>(ckv, 128, m0);
            f32x16 acc[2][2];
            ZERO_ACC(acc);
            gemm_core<2>(acc, ckv, 128, wukv, 128, 128, m0, n0, rs);
#pragma unroll
            for (int i = 0; i < 2; ++i)
#pragma unroll
                for (int j = 0; j < 2; ++j) {
                    int col = n0 + wn * 64 + j * 32 + (l & 31);
                    int rbase = m0 + wm * 64 + i * 32 + 4 * hh;
                    if (nt < 2) {
                        int dcol = (col >> 6) * 96 + (col & 63);
#pragma unroll
                        for (int rr = 0; rr < 16; ++rr) {
                            int row = rbase + (rr & 3) + 8 * (rr >> 2);
                            mk[(size_t)row * 384 + dcol] = (bf16)acc[i][j][rr];
                        }
                    } else {
                        int e = col - 256;
                        int b = m0 >> 11;
                        int s0 = rbase & 2047;
                        bf16* base = mvt + ((size_t)(b * 512 + e)) * SEQ + s0;
#pragma unroll
                        for (int g = 0; g < 4; ++g) {
                            uint2 o;
                            o.x = pack2(acc[i][j][4 * g], acc[i][j][4 * g + 1]);
                            o.y = pack2(acc[i][j][4 * g + 2], acc[i][j][4 * g + 3]);
                            *(uint2*)(base + 8 * g) = o;
                        }
                    }
                }
        } else {
            int seq = (item - NQ - NKV) * 4 + w;
            int b = seq >> 2, h = seq & 3;
            float bfv = P.b_forget[L * 4 + h];
            float vals[32];
            float run = 0.f;
#pragma unroll
            for (int i = 0; i < 32; ++i) {
                int s = l * 32 + i;
                float z = flog[((size_t)b * SEQ + s) * 4 + h] + bfv;
                run += log_sigmoid_f(z);
                vals[i] = run;
            }
            float tot = run, incl = tot;
#pragma unroll
            for (int o = 1; o < 64; o <<= 1) {
                float t = __shfl_up(incl, o);
                if (l >= o) incl += t;
            }
            float excl = incl - tot;
#pragma unroll
            for (int i = 0; i < 32; ++i) cumF[(size_t)seq * SEQ + l * 32 + i] = vals[i] + excl;
        }
    }
}

template <int MODE, int DK, int DV>
__device__ __forceinline__ void attn_item(const bf16* __restrict__ Q, int ldq, const bf16* __restrict__ Kg, int ldk,
                          const bf16* __restrict__ Vt, const float* __restrict__ cumF, bf16* __restrict__ Y,
                          float* __restrict__ ssy, int b, int h, int qb, float c1) {
    constexpr int KSTR = DK * 2 + 16;
    constexpr int VSTR = 144;
    constexpr int KBYTES = 64 * KSTR, VBYTES = DV * VSTR;
    constexpr int BUF = (KBYTES + VBYTES + 256 + 255) & ~255;
    static_assert(2 * BUF <= LDS_BYTES - 64, "lds");
    constexpr int KCH = DK / 8, KPT = (64 * KCH) / 256, VPT = (DV * 8) / 256;
    const int tid = opaque_tid(), w = tid >> 6, l = tid & 63, r = l & 31, hh = l >> 5;
    const int q0 = qb * 128;
    const int qrow = q0 + 32 * w + r;
    const size_t tok = (size_t)b * SEQ + qrow;
    const int bh = b * 4 + h;
    bf16x8 qf[DK / 16];
#pragma unroll
    for (int s = 0; s < DK / 16; ++s) qf[s] = *(const bf16x8*)(Q + tok * ldq + h * DK + 16 * s + 8 * hh);
    f32x16 o[DV / 32];
    const f32x16 zero16 = {0.f, 0.f, 0.f, 0.f, 0.f, 0.f, 0.f, 0.f, 0.f, 0.f, 0.f, 0.f, 0.f, 0.f, 0.f, 0.f};
#pragma unroll
    for (int d = 0; d < DV / 32; ++d) o[d] = zero16;
    float m = -1e30f, lsum = 0.f, R = 0.f;
    float Fq = 0.f;
    if (MODE == 0) Fq = cumF[(size_t)bh * SEQ + qrow] * LOG2E;
    const int nkt = (q0 + 128) >> 6;
    u32x4 kreg[KPT], vreg[VPT];
    float4 freg = {0.f, 0.f, 0.f, 0.f};
    auto gload = [&](int kt) {
#pragma unroll
        for (int i = 0; i < KPT; ++i) {
            int e = tid + 256 * i;
            int row = e / KCH, ch = e % KCH;
            kreg[i] = *(const u32x4*)(Kg + ((size_t)b * SEQ + kt * 64 + row) * ldk + h * DK + ch * 8);
        }
#pragma unroll
        for (int i = 0; i < VPT; ++i) {
            int e = tid + 256 * i;
            int row = e >> 3, ch = e & 7;
            vreg[i] = *(const u32x4*)(Vt + ((size_t)bh * DV + row) * SEQ + kt * 64 + ch * 8);
        }
        if (MODE == 0 && tid < 16) freg = *(const float4*)(cumF + (size_t)bh * SEQ + kt * 64 + tid * 4);
    };
    auto lwrite = [&](int buf) {
        char* base = smem + buf * BUF;
#pragma unroll
        for (int i = 0; i < KPT; ++i) {
            int e = tid + 256 * i;
            int row = e / KCH, ch = e % KCH;
            *(u32x4*)(base + row * KSTR + ch * 16) = kreg[i];
        }
#pragma unroll
        for (int i = 0; i < VPT; ++i) {
            int e = tid + 256 * i;
            int row = e >> 3, ch = e & 7;
            *(u32x4*)(base + KBYTES + row * VSTR + ch * 16) = vreg[i];
        }
        if (MODE == 0 && tid < 16) *(float4*)(base + KBYTES + VBYTES + tid * 16) = freg;
    };
    const int prow = (r & 0x13) | ((r & 4) << 1) | ((r & 8) >> 1);
    gload(MODE == 1 ? nkt - 1 : 0);
    lwrite(0);
    __syncthreads();
    for (int it = 0; it < nkt; ++it) {
        const int kt = (MODE == 1) ? (nkt - 1 - it) : it;
        if (it + 1 < nkt) gload((MODE == 1) ? (kt - 1) : (kt + 1));
        const char* base = smem + (it & 1) * BUF;
        const bool active = (kt * 64) <= (q0 + 32 * w + 31);
        if (active) {
            const bool needmask = (kt * 64 + 63) >= (q0 + 32 * w);
            f32x16 s[2];
#pragma unroll
            for (int sub = 0; sub < 2; ++sub) {
                s[sub] = zero16;
#pragma unroll
                for (int ks = 0; ks < DK / 16; ++ks) {
                    bf16x8 kf = *(const bf16x8*)(base + (sub * 32 + prow) * KSTR + (2 * ks + hh) * 16);
                    s[sub] = __builtin_amdgcn_mfma_f32_32x32x16_bf16(kf, qf[ks], s[sub], 0, 0, 0);
                }
            }
            bf16x8 pf[2][2];
            if (MODE != 1) {
                const float* Ft = (const float*)(base + KBYTES + VBYTES);
                float mx = -INFINITY;
                float tv[2][16];
#pragma unroll
                for (int sub = 0; sub < 2; ++sub)
#pragma unroll
                    for (int a = 0; a < 2; ++a) {
                        int kofs = sub * 32 + 16 * a + 8 * hh;
                        float fk[8];
                        if (MODE == 0) {
                            float4 f0 = *(const float4*)(Ft + kofs), f1 = *(const float4*)(Ft + kofs + 4);
                            fk[0] = f0.x; fk[1] = f0.y; fk[2] = f0.z; fk[3] = f0.w; fk[4] = f1.x; fk[5] = f1.y; fk[6] = f1.z; fk[7] = f1.w;
                        }
#pragma unroll
                        for (int j = 0; j < 8; ++j) {
                            int rr = 8 * a + j;
                            float v = s[sub][rr] * c1;
                            if (MODE == 0) v += Fq - fk[j] * LOG2E;
                            if (needmask && (kt * 64 + kofs + j > qrow)) v = -INFINITY;
                            tv[sub][rr] = v;
                            mx = fmaxf(mx, v);
                        }
                    }
                mx = fmaxf(mx, __shfl_xor(mx, 32));
                float mnew = fmaxf(m, mx);
                float alpha = fexp2(m - mnew);
                float rsum = 0.f;
#pragma unroll
                for (int sub = 0; sub < 2; ++sub)
#pragma unroll
                    for (int a = 0; a < 2; ++a) {
                        float pv[8];
#pragma unroll
                        for (int j = 0; j < 8; ++j) { pv[j] = fexp2(tv[sub][8 * a + j] - mnew); rsum += pv[j]; }
                        uint4 u;
                        u.x = pack2(pv[0], pv[1]); u.y = pack2(pv[2], pv[3]); u.z = pack2(pv[4], pv[5]); u.w = pack2(pv[6], pv[7]);
                        pf[sub][a] = __builtin_bit_cast(bf16x8, u);
                    }
                rsum += __shfl_xor(rsum, 32);
                lsum = lsum * alpha + rsum;
                m = mnew;
#pragma unroll
                for (int d = 0; d < DV / 32; ++d) o[d] = o[d] * alpha;
            } else {
#pragma unroll
                for (int sb = 0; sb < 2; ++sb) {
                    const int sub = 1 - sb;
                    float lsig[16], lneg[16];
                    float A0 = 0.f, A1 = 0.f;
#pragma unroll
                    for (int rr = 0; rr < 16; ++rr) {
                        int key = kt * 64 + sub * 32 + 16 * (rr >> 3) + 8 * hh + (rr & 7);
                        bool valid = key < qrow;
                        float z = s[sub][rr] * c1;
                        float e = fexp2(-fabsf(z));
                        float l1p = flog2(1.f + e);
                        float ls = fminf(z, 0.f) - l1p;
                        float ln = valid ? (ls - z) : 0.f;
                        lsig[rr] = valid ? ls : -INFINITY;
                        lneg[rr] = ln;
                        if (rr < 8) A0 += ln; else A1 += ln;
                    }
                    float B0 = __shfl_xor(A0, 32), B1 = __shfl_xor(A1, 32);
                    float base1 = (hh == 0) ? (R + B1) : R;
                    float base0 = (hh == 0) ? (R + B1 + A1 + B0) : (R + A1 + B1);
                    float wv[16];
                    float run = base1;
#pragma unroll
                    for (int j = 7; j >= 0; --j) { wv[8 + j] = fexp2(lsig[8 + j] + run); run += lneg[8 + j]; }
                    run = base0;
#pragma unroll
                    for (int j = 7; j >= 0; --j) { wv[j] = fexp2(lsig[j] + run); run += lneg[j]; }
                    R += A0 + A1 + B0 + B1;
#pragma unroll
                    for (int a = 0; a < 2; ++a) {
                        uint4 u;
                        u.x = pack2(wv[8 * a], wv[8 * a + 1]); u.y = pack2(wv[8 * a + 2], wv[8 * a + 3]);
                        u.z = pack2(wv[8 * a + 4], wv[8 * a + 5]); u.w = pack2(wv[8 * a + 6], wv[8 * a + 7]);
                        pf[sub][a] = __builtin_bit_cast(bf16x8, u);
                    }
                }
            }
#pragma unroll
            for (int d = 0; d < DV / 32; ++d)
#pragma unroll
                for (int sub = 0; sub < 2; ++sub)
#pragma unroll
                    for (int a = 0; a < 2; ++a) {
                        bf16x8 vf = *(const bf16x8*)(base + KBYTES + (d * 32 + r) * VSTR + (sub * 32 + 16 * a + 8 * hh) * 2);
                        o[d] = __builtin_amdgcn_mfma_f32_32x32x16_bf16(vf, pf[sub][a], o[d], 0, 0, 0);
                    }
        }
        if (it + 1 < nkt) lwrite((it + 1) & 1);
        __syncthreads();
    }
    float inv = (MODE == 1) ? 1.f : (1.f / lsum);
    float ssq = 0.f;
#pragma unroll
    for (int d = 0; d < DV / 32; ++d)
#pragma unroll
        for (int g = 0; g < 4; ++g) {
            float v0 = o[d][4 * g] * inv, v1 = o[d][4 * g + 1] * inv, v2 = o[d][4 * g + 2] * inv, v3 = o[d][4 * g + 3] * inv;
            ssq += v0 * v0 + v1 * v1 + v2 * v2 + v3 * v3;
            uint2 u; u.x = pack2(v0, v1); u.y = pack2(v2, v3);
            *(uint2*)(Y + tok * 1024 + h * DV + d * 32 + 8 * g + 4 * hh) = u;
        }
    ssq += __shfl_xor(ssq, 32);
    if (hh == 0) ssy[tok * 16 + h] = ssq;
}

__device__ __forceinline__ void phase_attn(const Params& P, int L) {
    char* ws = opq(P.ws);
    int* cnt = (int*)(ws + OFF_CNT) + L * 64;
    int* s_item = (int*)(smem + LDS_BYTES - 16);
    const float* cumF = (const float*)(ws + OFF_CUMF);
    bf16* Y = (bf16*)(ws + OFF_Y);
    float* ssy = (float*)(ws + OFF_SSY) + (size_t)L * TOK * 16;
    for (;;) {
        if (opaque_tid() == 0) *s_item = atomicAdd(cnt, 1);
        __syncthreads();
        int item = *s_item;
        __syncthreads();
        if (item >= 1536) break;
        int qb = 15 - item / 96;
        int rem = item % 96;
        int type = rem >> 5, bh = rem & 31;
        int b = bh >> 2, h = bh & 3;
        if (type == 0) {
            attn_item<2, 96, 128>((const bf16*)(ws + OFF_MQ), 384, (const bf16*)(ws + OFF_MK), 384, (const bf16*)(ws + OFF_MVT), cumF,
                                  Y + 512, ssy + 8, b, h, qb, 0.10206207261596577f * LOG2E);
        } else if (type == 1) {
            attn_item<1, 64, 64>((const bf16*)(ws + OFF_SQ), 256, (const bf16*)(ws + OFF_SKK), 256, (const bf16*)(ws + OFF_SVT), cumF,
                                 Y + 256, ssy + 4, b, h, qb, 0.125f * LOG2E);
        } else {
            attn_item<0, 64, 64>((const bf16*)(ws + OFF_FQ), 256, (const bf16*)(ws + OFF_FK), 256, (const bf16*)(ws + OFF_FVT), cumF,
                                 Y + 0, ssy + 0, b, h, qb, 0.125f * LOG2E);
        }
    }
}

__device__ __forceinline__ void rowss_flush(float (&part)[2][16], float* gss, int m0, int nt) {
    float* lss = (float*)smem;
    const int tid = opaque_tid(), w = tid >> 6, l = tid & 63, hh = l >> 5, wm = w >> 1, wn = w & 1;
#pragma unroll
    for (int i = 0; i < 2; ++i)
#pragma unroll
        for (int rr = 0; rr < 16; ++rr) {
            float v = part[i][rr];
            v += __shfl_xor(v, 1); v += __shfl_xor(v, 2); v += __shfl_xor(v, 4); v += __shfl_xor(v, 8); v += __shfl_xor(v, 16);
            if ((l & 31) == 0) lss[wn * 128 + wm * 64 + i * 32 + (rr & 3) + 8 * (rr >> 2) + 4 * hh] = v;
        }
    __syncthreads();
    if (tid < 128) gss[(size_t)(m0 + tid) * 8 + nt] = lss[tid] + lss[128 + tid];
    __syncthreads();
}

struct GroupScale {
    float s0[4], s1[4], s2[4];
    __device__ __forceinline__ float operator()(int i, int k0) const {
        float a = s0[i], b = s1[i], c = s2[i];
        float sel = (k0 < 256) ? 1.f : 0.f, sel2 = (k0 >= 256 && k0 < 512) ? 1.f : 0.f;
        return a * sel + b * sel2 + c * (1.f - sel - sel2);
    }
};

__device__ __forceinline__ void phase_wo(const Params& P, int L, const float* hin, bf16* hb_out, float* ss_out) {
    char* ws = opq(P.ws);
    const bf16* Y = (const bf16*)(ws + OFF_Y);
    const bf16* Bt = (const bf16*)(ws + OFF_WO) + (size_t)L * 1024 * 1024;
    const float* ssy = (const float*)(ws + OFF_SSY) + (size_t)L * TOK * 16;
    const int tid = opaque_tid(), w = tid >> 6, l = tid & 63, hh = l >> 5, wm = w >> 1, wn = w & 1;
    for (int tile = blockIdx.x; tile < 128 * 8; tile += gridDim.x) {
        int mt = tile >> 3, nt = tile & 7;
        int m0 = mt * 128, n0 = nt * 128;
        GroupScale gs;
#pragma unroll
        for (int i = 0; i < 4; ++i) {
            int row = m0 + (tid >> 3) + 32 * i;
            float4 v0 = *(const float4*)(ssy + (size_t)row * 16), v1 = *(const float4*)(ssy + (size_t)row * 16 + 4), v2 = *(const float4*)(ssy + (size_t)row * 16 + 8);
            gs.s0[i] = rsqrtf(((v0.x + v0.y) + (v0.z + v0.w)) * (1.f / 256.f) + EPSF);
            gs.s1[i] = rsqrtf(((v1.x + v1.y) + (v1.z + v1.w)) * (1.f / 256.f) + EPSF);
            gs.s2[i] = rsqrtf(((v2.x + v2.y) + (v2.z + v2.w)) * (1.f / 512.f) + EPSF);
        }
        f32x16 acc[2][2];
        ZERO_ACC(acc);
        gemm_core<2>(acc, Y, 1024, Bt, 1024, 1024, m0, n0, gs);
        float part[2][16];
#pragma unroll
        for (int i = 0; i < 2; ++i) {
#pragma unroll
            for (int rr = 0; rr < 16; ++rr) part[i][rr] = 0.f;
#pragma unroll
            for (int j = 0; j < 2; ++j) {
                int col = n0 + wn * 64 + j * 32 + (l & 31);
                int rbase = m0 + wm * 64 + i * 32 + 4 * hh;
#pragma unroll
                for (int rr = 0; rr < 16; ++rr) {
                    int row = rbase + (rr & 3) + 8 * (rr >> 2);
                    size_t idx = (size_t)row * 1024 + col;
                    float v = hin[idx] + acc[i][j][rr];
                    P.out[idx] = v;
                    hb_out[idx] = (bf16)v;
                    part[i][rr] += v * v;
                }
            }
        }
        rowss_flush(part, ss_out, m0, nt);
    }
}

__device__ __forceinline__ void phase_pq(const Params& P, int L, const bf16* hb, const float* ssrow) {
    char* ws = opq(P.ws);
    const bf16* Bt = (const bf16*)(ws + OFF_WQ) + (size_t)L * 1024 * 1024;
    bf16* pq = (bf16*)(ws + OFF_PQ);
    const int tid = opaque_tid(), w = tid >> 6, l = tid & 63, hh = l >> 5, wm = w >> 1, wn = w & 1;
    for (int tile = blockIdx.x; tile < 128 * 8; tile += gridDim.x) {
        int mt = tile >> 3, nt = tile & 7;
        int m0 = mt * 128, n0 = nt * 128;
        f32x16 acc[2][2];
        ZERO_ACC(acc);
        gemm_core<0>(acc, hb, 1024, Bt, 1024, 1024, m0, n0, NoScale());
#pragma unroll
        for (int i = 0; i < 2; ++i) {
            int rbase = m0 + wm * 64 + i * 32 + 4 * hh;
#pragma unroll
            for (int rr = 0; rr < 16; ++rr) {
                int row = rbase + (rr & 3) + 8 * (rr >> 2);
                float rs = row_rs8(ssrow, row);
#pragma unroll
                for (int j = 0; j < 2; ++j) {
                    int col = n0 + wn * 64 + j * 32 + (l & 31);
                    pq[(size_t)row * 1024 + col] = (bf16)(acc[i][j][rr] * rs);
                }
            }
        }
    }
}

__device__ __forceinline__ void cswap(int& a, int& b) { int mx = max(a, b), mn = min(a, b); a = mx; b = mn; }
__device__ __forceinline__ void bitonic_sort16(int (&v)[16]) {
#pragma unroll
    for (int k = 2; k <= 16; k <<= 1)
#pragma unroll
        for (int j = k >> 1; j > 0; j >>= 1)
#pragma unroll
            for (int i = 0; i < 16; ++i) {
                int q = i ^ j;
                if (q > i) {
                    if ((i & k) == 0) cswap(v[i], v[q]); else cswap(v[q], v[i]);
                }
            }
}
__device__ __forceinline__ void merge_top16(int (&Lv)[16], const int (&Rv)[16]) {
#pragma unroll
    for (int i = 0; i < 16; ++i) Lv[i] = max(Lv[i], Rv[15 - i]);
#pragma unroll
    for (int j = 8; j > 0; j >>= 1)
#pragma unroll
        for (int i = 0; i < 16; ++i) {
            int q = i ^ j;
            if (q > i) cswap(Lv[i], Lv[q]);
        }
}
__device__ __forceinline__ int f2key(float v, int low, int mask) {
    int b = __float_as_int(v);
    b ^= (b >> 31) & 0x7fffffff;
    return (b & ~mask) | low;
}
__device__ __forceinline__ float key2f(int k, int mask) {
    int b = k & ~mask;
    b ^= (b >> 31) & 0x7fffffff;
    return __int_as_float(b);
}

__device__ __forceinline__ void phase_topk(const Params& P, int L) {
    char* ws = opq(P.ws);
    const bf16* pq = (const bf16*)(ws + OFF_PQ);
    const bf16* skb = (const bf16*)(ws + OFF_SKB) + (size_t)L * 16 * 128 * 64;
    int* ids = (int*)(ws + OFF_IDS);
    float* gates = (float*)(ws + OFF_GATE);
    float* sc = (float*)smem;
    int* Lq = (int*)(smem + 64 * 129 * 4);
    int* Fin = Lq + 4 * 64 * 16;
    const int tid = opaque_tid(), w = tid >> 6, l = tid & 63, r = l & 31, hh = l >> 5;
    for (int item = blockIdx.x; item < TOK / 64; item += gridDim.x) {
        const int t0 = item * 64;
        for (int h = 0; h < 8; ++h) {
            for (int p = 0; p < 2; ++p) {
                const int hp = h * 2 + p;
                f32x16 acc[2];
#pragma unroll
                for (int j = 0; j < 2; ++j)
#pragma unroll
                    for (int rr = 0; rr < 16; ++rr) acc[j][rr] = 0.f;
#pragma unroll
                for (int s = 0; s < 4; ++s) {
                    bf16x8 af = *(const bf16x8*)(skb + ((size_t)hp * 128 + 32 * w + r) * 64 + 16 * s + 8 * hh);
#pragma unroll
                    for (int j = 0; j < 2; ++j) {
                        bf16x8 bfr = *(const bf16x8*)(pq + (size_t)(t0 + 32 * j + r) * 1024 + hp * 64 + 16 * s + 8 * hh);
                        acc[j] = __builtin_amdgcn_mfma_f32_32x32x16_bf16(af, bfr, acc[j], 0, 0, 0);
                    }
                }
#pragma unroll
                for (int j = 0; j < 2; ++j)
#pragma unroll
                    for (int rr = 0; rr < 16; ++rr) {
                        int key = 32 * w + (rr & 3) + 8 * (rr >> 2) + 4 * hh;
                        sc[(32 * j + r) * 129 + key] = acc[j][rr];
                    }
                __syncthreads();
                {
                    const int token = l, quarter = w;
                    int A[16], B[16];
#pragma unroll
                    for (int i = 0; i < 16; ++i) {
                        int n = quarter * 32 + i;
                        A[i] = f2key(sc[token * 129 + n], 127 - n, 127);
                        B[i] = f2key(sc[token * 129 + n + 16], 127 - (n + 16), 127);
                    }
                    bitonic_sort16(A);
                    bitonic_sort16(B);
                    merge_top16(A, B);
#pragma unroll
                    for (int i = 0; i < 16; ++i) Lq[(quarter * 64 + token) * 16 + i] = A[i];
                    __syncthreads();
                    if ((quarter & 1) == 0) {
#pragma unroll
                        for (int i = 0; i < 16; ++i) B[i] = Lq[((quarter + 1) * 64 + token) * 16 + i];
                        merge_top16(A, B);
                        if (quarter == 2) {
#pragma unroll
                            for (int i = 0; i < 16; ++i) Lq[(2 * 64 + token) * 16 + i] = A[i];
                        }
                    }
                    __syncthreads();
                    if (quarter == 0) {
#pragma unroll
                        for (int i = 0; i < 16; ++i) B[i] = Lq[(2 * 64 + token) * 16 + i];
                        merge_top16(A, B);
#pragma unroll
                        for (int i = 0; i < 16; ++i) Fin[(p * 64 + token) * 16 + i] = A[i];
                    }
                    __syncthreads();
                }
            }
            if (w == 0) {
                const int token = l;
                float s1[16], s2[16];
#pragma unroll
                for (int i = 0; i < 16; ++i) {
                    s1[i] = key2f(Fin[(0 * 64 + token) * 16 + i], 127);
                    s2[i] = key2f(Fin[(1 * 64 + token) * 16 + i], 127);
                }
                int Lc[16], X[16];
#pragma unroll
                for (int b2 = 0; b2 < 16; ++b2) Lc[b2] = f2key(s1[0] + s2[b2], 255 - b2, 255);
#pragma unroll
                for (int a = 1; a < 16; ++a) X[a - 1] = f2key(s1[a] + s2[0], 255 - a * 16, 255);
                X[15] = INT_MIN;
                merge_top16(Lc, X);
                {
                    int c = 0;
#pragma unroll
                    for (int b2 = 1; b2 <= 7; ++b2) X[c++] = f2key(s1[1] + s2[b2], 255 - (16 + b2), 255);
#pragma unroll
                    for (int b2 = 1; b2 <= 4; ++b2) X[c++] = f2key(s1[2] + s2[b2], 255 - (32 + b2), 255);
#pragma unroll
                    for (int b2 = 1; b2 <= 3; ++b2) X[c++] = f2key(s1[3] + s2[b2], 255 - (48 + b2), 255);
#pragma unroll
                    for (int b2 = 1; b2 <= 2; ++b2) X[c++] = f2key(s1[4] + s2[b2], 255 - (64 + b2), 255);
                }
                bitonic_sort16(X);
                merge_top16(Lc, X);
                X[0] = f2key(s1[5] + s2[1], 255 - (80 + 1), 255);
                X[1] = f2key(s1[6] + s2[1], 255 - (96 + 1), 255);
                X[2] = f2key(s1[7] + s2[1], 255 - (112 + 1), 255);
#pragma unroll
                for (int i = 3; i < 16; ++i) X[i] = INT_MIN;
                merge_top16(Lc, X);
                float mx = key2f(Lc[0], 255);
                float ev[16], sum = 0.f;
#pragma unroll
                for (int k = 0; k < 16; ++k) { ev[k] = __expf(key2f(Lc[k], 255) - mx); sum += ev[k]; }
                float inv = 1.f / sum;
                size_t ob = (size_t)(t0 + token) * 128 + h * 16;
#pragma unroll
                for (int k = 0; k < 16; ++k) {
                    int cidx = 255 - (Lc[k] & 255);
                    int a = cidx >> 4, b2 = cidx & 15;
                    int i1 = 127 - (Fin[(0 * 64 + token) * 16 + a] & 127);
                    int i2 = 127 - (Fin[(1 * 64 + token) * 16 + b2] & 127);
                    ids[ob + k] = i1 * 128 + i2;
                    gates[ob + k] = ev[k] * inv;
                }
            }
            __syncthreads();
        }
    }
}

__device__ __forceinline__ float gelu_exact(float x) { return 0.5f * x * (1.f + erff(x * 0.70710678118654752f)); }

__device__ __forceinline__ void dec16(const u32x4& v, float (&f)[16]) {
    f32x2 t;
    t = __builtin_amdgcn_cvt_pk_f32_fp8((int)v.x, false); f[0] = t.x; f[1] = t.y;
    t = __builtin_amdgcn_cvt_pk_f32_fp8((int)v.x, true);  f[2] = t.x; f[3] = t.y;
    t = __builtin_amdgcn_cvt_pk_f32_fp8((int)v.y, false); f[4] = t.x; f[5] = t.y;
    t = __builtin_amdgcn_cvt_pk_f32_fp8((int)v.y, true);  f[6] = t.x; f[7] = t.y;
    t = __builtin_amdgcn_cvt_pk_f32_fp8((int)v.z, false); f[8] = t.x; f[9] = t.y;
    t = __builtin_amdgcn_cvt_pk_f32_fp8((int)v.z, true);  f[10] = t.x; f[11] = t.y;
    t = __builtin_amdgcn_cvt_pk_f32_fp8((int)v.w, false); f[12] = t.x; f[13] = t.y;
    t = __builtin_amdgcn_cvt_pk_f32_fp8((int)v.w, true);  f[14] = t.x; f[15] = t.y;
}

__device__ __forceinline__ void phase_gather_u(const Params& P, int L, const float* ss_ffn) {
    char* ws = opq(P.ws);
    const unsigned char* U8 = (const unsigned char*)(ws + OFF_UB) + (size_t)L * NEXP * DM;
    float* part = (float*)(ws + OFF_PART);
    const int* ids = (const int*)(ws + OFF_IDS);
    const float* hin = opq(P.out);
    const int tid = opaque_tid(), w = tid >> 6, l = tid & 63, c = l & 7, gq = l >> 3;
    const int j = blockIdx.x & 7, rk = blockIdx.x >> 3, nb = gridDim.x >> 3;
    if (rk >= nb) return;
    float gv[16];
    {
        const float4* g4 = (const float4*)(P.norm_ffn_g + L * 1024 + 128 * j + 16 * c);
#pragma unroll
        for (int q = 0; q < 4; ++q) { float4 t = g4[q]; gv[4 * q] = t.x; gv[4 * q + 1] = t.y; gv[4 * q + 2] = t.z; gv[4 * q + 3] = t.w; }
    }
    const unsigned char* ubase = U8 + (size_t)j * NEXP * 128 + c * 16;
    for (int t = rk * 4 + w; t < TOK; t += nb * 4) {
        float rs = row_rs8(ss_ffn, t);
        float xv[16];
        {
            const float4* h4 = (const float4*)(hin + (size_t)t * 1024 + 128 * j + 16 * c);
#pragma unroll
            for (int q = 0; q < 4; ++q) { float4 v = h4[q]; xv[4 * q] = v.x * rs * gv[4 * q]; xv[4 * q + 1] = v.y * rs * gv[4 * q + 1]; xv[4 * q + 2] = v.z * rs * gv[4 * q + 2]; xv[4 * q + 3] = v.w * rs * gv[4 * q + 3]; }
        }
        int idv[16];
        {
            const int4* i4 = (const int4*)(ids + (size_t)t * 128 + 16 * gq);
#pragma unroll
            for (int q = 0; q < 4; ++q) { int4 v = i4[q]; idv[4 * q] = v.x; idv[4 * q + 1] = v.y; idv[4 * q + 2] = v.z; idv[4 * q + 3] = v.w; }
        }
        u32x4 rv[16];
#pragma unroll
        for (int i = 0; i < 16; ++i) rv[i] = *(const u32x4*)(ubase + (size_t)idv[i] * 128);
        float pr[16];
#pragma unroll
        for (int i = 0; i < 16; ++i) {
            float f[16];
            dec16(rv[i], f);
            float s0 = 0.f, s1 = 0.f;
#pragma unroll
            for (int e = 0; e < 16; e += 2) { s0 += f[e] * xv[e]; s1 += f[e + 1] * xv[e + 1]; }
            float sacc = s0 + s1;
            sacc += __shfl_xor(sacc, 1); sacc += __shfl_xor(sacc, 2); sacc += __shfl_xor(sacc, 4);
            pr[i] = sacc;
        }
        if (c == 0) {
            float4* o4 = (float4*)(part + ((size_t)j * TOK + t) * 128 + 16 * gq);
#pragma unroll
            for (int q = 0; q < 4; ++q) o4[q] = make_float4(pr[4 * q], pr[4 * q + 1], pr[4 * q + 2], pr[4 * q + 3]);
        }
    }
}

__device__ __forceinline__ void phase_gather_act(const Params& P, int L) {
    char* ws = opq(P.ws);
    const float* part = (const float*)(ws + OFF_PART);
    const int* ids = (const int*)(ws + OFF_IDS);
    float* gates = (float*)(ws + OFF_GATE);
    const float* uinv = (const float*)(ws + OFF_TSC) + L * NEXP;
    const float* vinv = (const float*)(ws + OFF_TSC) + (2 + L) * NEXP;
    const int tid = opaque_tid(), w = tid >> 6, l = tid & 63;
    for (int t = blockIdx.x * 4 + w; t < TOK; t += gridDim.x * 4) {
#pragma unroll
        for (int hsel = 0; hsel < 2; ++hsel) {
            int k = l + 64 * hsel;
            float sacc = 0.f;
#pragma unroll
            for (int j = 0; j < 8; ++j) sacc += part[((size_t)j * TOK + t) * 128 + k];
            int id = ids[(size_t)t * 128 + k];
            float pre = sacc * uinv[id];
            gates[(size_t)t * 128 + k] = gates[(size_t)t * 128 + k] * gelu_exact(pre) * vinv[id];
        }
    }
}

__device__ __forceinline__ void phase_gather_v(const Params& P, int L, bf16* hb_out, float* ss_ple) {
    char* ws = opq(P.ws);
    const unsigned char* V8 = (const unsigned char*)(ws + OFF_VB) + (size_t)L * NEXP * DM;
    const int* ids = (const int*)(ws + OFF_IDS);
    const float* act = (const float*)(ws + OFF_GATE);
    float* hio = opq(P.out);
    const int tid = opaque_tid(), w = tid >> 6, l = tid & 63, c = l & 7, gq = l >> 3;
    const int j = blockIdx.x & 7, rk = blockIdx.x >> 3, nb = gridDim.x >> 3;
    if (rk >= nb) return;
    const unsigned char* vbase = V8 + (size_t)j * NEXP * 128 + c * 16;
    for (int t = rk * 4 + w; t < TOK; t += nb * 4) {
        int idv[16];
        float av[16];
        {
            const int4* i4 = (const int4*)(ids + (size_t)t * 128 + 16 * gq);
            const float4* a4 = (const float4*)(act + (size_t)t * 128 + 16 * gq);
#pragma unroll
            for (int q = 0; q < 4; ++q) {
                int4 v = i4[q]; idv[4 * q] = v.x; idv[4 * q + 1] = v.y; idv[4 * q + 2] = v.z; idv[4 * q + 3] = v.w;
                float4 a = a4[q]; av[4 * q] = a.x; av[4 * q + 1] = a.y; av[4 * q + 2] = a.z; av[4 * q + 3] = a.w;
            }
        }
        u32x4 rv[16];
#pragma unroll
        for (int i = 0; i < 16; ++i) rv[i] = *(const u32x4*)(vbase + (size_t)idv[i] * 128);
        float acc[16];
#pragma unroll
        for (int e = 0; e < 16; ++e) acc[e] = 0.f;
#pragma unroll
        for (int i = 0; i < 16; ++i) {
            float f[16];
            dec16(rv[i], f);
#pragma unroll
            for (int e = 0; e < 16; ++e) acc[e] += av[i] * f[e];
        }
#pragma unroll
        for (int e = 0; e < 16; ++e) {
            float v = acc[e];
            v += __shfl_xor(v, 8); v += __shfl_xor(v, 16); v += __shfl_xor(v, 32);
            acc[e] = v;
        }
        float ssq = 0.f;
        if (gq == 0) {
            float4* h4 = (float4*)(hio + (size_t)t * 1024 + 128 * j + 16 * c);
            float hv[16];
#pragma unroll
            for (int q = 0; q < 4; ++q) {
                float4 v = h4[q];
                hv[4 * q] = v.x + acc[4 * q]; hv[4 * q + 1] = v.y + acc[4 * q + 1]; hv[4 * q + 2] = v.z + acc[4 * q + 2]; hv[4 * q + 3] = v.w + acc[4 * q + 3];
                h4[q] = make_float4(hv[4 * q], hv[4 * q + 1], hv[4 * q + 2], hv[4 * q + 3]);
            }
#pragma unroll
            for (int e = 0; e < 16; ++e) ssq += hv[e] * hv[e];
            u32x4 b0 = {pack2(hv[0], hv[1]), pack2(hv[2], hv[3]), pack2(hv[4], hv[5]), pack2(hv[6], hv[7])};
            u32x4 b1 = {pack2(hv[8], hv[9]), pack2(hv[10], hv[11]), pack2(hv[12], hv[13]), pack2(hv[14], hv[15])};
            u32x4* hb4 = (u32x4*)(hb_out + (size_t)t * 1024 + 128 * j + 16 * c);
            hb4[0] = b0; hb4[1] = b1;
        }
        ssq += __shfl_xor(ssq, 1); ssq += __shfl_xor(ssq, 2); ssq += __shfl_xor(ssq, 4);
        if (l == 0) ss_ple[(size_t)t * 8 + j] = ssq;
    }
}

__device__ __forceinline__ void phase_ple(const Params& P, int L, const bf16* hb_in, bf16* hb_out, const float* ss_ple, float* ss_out) {
    char* ws = opq(P.ws);
    const bf16* Wg = (const bf16*)(ws + OFF_WG) + (size_t)L * 1024 * 1024;
    const bf16* Wp = (const bf16*)(ws + OFF_WP) + (size_t)L * 1024 * 256;
    const float* pin = P.p + (size_t)L * TOK * 256;
    const int tid = opaque_tid(), w = tid >> 6, l = tid & 63, hh = l >> 5, wm = w >> 1, wn = w & 1;
    for (int tile = blockIdx.x; tile < 128 * 8; tile += gridDim.x) {
        int mt = tile >> 3, nt = tile & 7;
        int m0 = mt * 128, n0 = nt * 128;
        f32x16 acc1[2][2], acc2[2][2];
        ZERO_ACC(acc1);
        ZERO_ACC(acc2);
        gemm_core<0>(acc1, hb_in, 1024, Wg, 1024, 1024, m0, n0, NoScale());
        gemm_core<1>(acc2, pin, 256, Wp, 256, 256, m0, n0, NoScale());
        float part[2][16];
#pragma unroll
        for (int i = 0; i < 2; ++i) {
            int rbase = m0 + wm * 64 + i * 32 + 4 * hh;
#pragma unroll
            for (int rr = 0; rr < 16; ++rr) {
                int row = rbase + (rr & 3) + 8 * (rr >> 2);
                float rs = row_rs8(ss_ple, row);
                float ps = 0.f;
#pragma unroll
                for (int j = 0; j < 2; ++j) {
                    int col = n0 + wn * 64 + j * 32 + (l & 31);
                    size_t idx = (size_t)row * 1024 + col;
                    float gte = 1.f / (1.f + __expf(-acc1[i][j][rr] * rs));
                    float v = P.out[idx] + gte * acc2[i][j][rr];
                    P.out[idx] = v;
                    hb_out[idx] = (bf16)v;
                    ps += v * v;
                }
                part[i][rr] = ps;
            }
        }
        rowss_flush(part, ss_out, m0, nt);
    }
}

__device__ __forceinline__ void phase_final(const Params& P, const float* ss) {
    const int tid = opaque_tid(), w = tid >> 6, l = tid & 63;
    const float4* g4 = (const float4*)P.final_norm_g;
    for (int t = blockIdx.x * 4 + w; t < TOK; t += gridDim.x * 4) {
        float rs = row_rs8(ss, t);
        float4* o4 = (float4*)(P.out + (size_t)t * 1024);
#pragma unroll
        for (int i = 0; i < 4; ++i) {
            float4 v = o4[i * 64 + l], g = g4[i * 64 + l];
            v.x *= rs * g.x; v.y *= rs * g.y; v.z *= rs * g.z; v.w *= rs * g.w;
            o4[i * 64 + l] = v;
        }
    }
}

__device__ __forceinline__ void grid_barrier(unsigned* bar) {
    asm volatile("s_waitcnt vmcnt(0)" ::: "memory");
    __syncthreads();
    if (threadIdx.x == 0) {
        __builtin_amdgcn_fence(__ATOMIC_RELEASE, "agent");
        asm volatile("s_waitcnt vmcnt(0)" ::: "memory");
        const unsigned G = gridDim.x;
        unsigned old = __hip_atomic_fetch_add(bar, 1u, __ATOMIC_RELAXED, __HIP_MEMORY_SCOPE_AGENT);
        unsigned target = (old / G + 1u) * G;
        while (__hip_atomic_load(bar, __ATOMIC_RELAXED, __HIP_MEMORY_SCOPE_AGENT) < target) __builtin_amdgcn_s_sleep(2);
        __builtin_amdgcn_fence(__ATOMIC_ACQUIRE, "agent");
        asm volatile("s_waitcnt vmcnt(0)" ::: "memory");
    }
    __syncthreads();
}

__global__ void __launch_bounds__(NTHR, 2) hymba_megakernel(Params P) {
    cg::grid_group grid = cg::this_grid();
    char* ws = opq(P.ws);
    float* ssa = (float*)(ws + OFF_SSA);
    bf16* hb[2] = {(bf16*)(ws + OFF_HB0), (bf16*)(ws + OFF_HB1)};
    unsigned* bar = (unsigned*)(ws + OFF_BAR);
    phase0(P);
    asm volatile("s_waitcnt vmcnt(0)" ::: "memory");
    __syncthreads();
    grid.sync();
    grid_barrier(bar);
    int cur = 0;
    for (int L = 0; L < 2; ++L) {
        const float* ss_mix = (L == 0) ? ssa : (ssa + 3 * TOK * 8);
        float* ss_ffn = ssa + (size_t)(1 + L) * TOK * 8;
        float* ss_next = (L == 0) ? (ssa + 3 * TOK * 8) : (ssa + 4 * TOK * 8);
        phase_proj(P, L, hb[cur], ss_mix);
        grid_barrier(bar);
        phase_mla_up(P, L);
        grid_barrier(bar);
        phase_attn(P, L);
        grid_barrier(bar);
        phase_wo(P, L, (L == 0) ? P.x : P.out, hb[cur ^ 1], ss_ffn);
        grid_barrier(bar);
        phase_pq(P, L, hb[cur ^ 1], ss_ffn);
        grid_barrier(bar);
        phase_topk(P, L);
        grid_barrier(bar);
        float* ss_ple = ssa + (size_t)(5 + L) * TOK * 8;
        phase_gather_u(P, L, ss_ffn);
        grid_barrier(bar);
        phase_gather_act(P, L);
        grid_barrier(bar);
        phase_gather_v(P, L, hb[cur], ss_ple);
        grid_barrier(bar);
        phase_ple(P, L, hb[cur], hb[cur ^ 1], ss_ple, ss_next);
        grid_barrier(bar);
        cur ^= 1;
    }
    phase_final(P, ssa + 4 * TOK * 8);
}

extern "C" void kernel_launch(void* const* d_in, const int* in_sizes, int n_in, void* d_out, int out_size, void* d_ws,
                              size_t ws_size, hipStream_t stream) {
    static int grid_blocks = 0;
    if (!grid_blocks) {
        int dev = 0, cus = 0, per_cu = 0;
        hipGetDevice(&dev);
        hipDeviceGetAttribute(&cus, hipDeviceAttributeMultiprocessorCount, dev);
        hipOccupancyMaxActiveBlocksPerMultiprocessor(&per_cu, hymba_megakernel, NTHR, 0);
        if (per_cu > 2) per_cu = 2;
        if (per_cu < 1) per_cu = 1;
        grid_blocks = cus * per_cu;
        if (ws_size < WS_END) fprintf(stderr, "workspace too small: %zu < %zu\n", ws_size, (size_t)WS_END);
    }
    Params P{};
    P.x = (const float*)d_in[0]; P.p = (const float*)d_in[1]; P.pos = (const int*)d_in[2];
    P.norm_mix_g = (const float*)d_in[3]; P.w_in = (const float*)d_in[4]; P.b_forget = (const float*)d_in[5];
    P.mla_q_norm_g = (const float*)d_in[6]; P.w_uq = (const float*)d_in[7]; P.mla_kv_norm_g = (const float*)d_in[8];
    P.w_ukv = (const float*)d_in[9]; P.mix_out_norm_g = (const float*)d_in[10]; P.w_o = (const float*)d_in[11];
    P.norm_ffn_g = (const float*)d_in[12]; P.w_query = (const float*)d_in[13]; P.sub_keys = (const float*)d_in[14];
    P.peer_u = (const float*)d_in[15]; P.peer_v = (const float*)d_in[16]; P.w_ple = (const float*)d_in[17];
    P.ple_norm_g = (const float*)d_in[18]; P.w_ple_gate = (const float*)d_in[19]; P.final_norm_g = (const float*)d_in[20];
    P.out = (float*)d_out; P.ws = (char*)d_ws;
    hipMemsetAsync((char*)d_ws + OFF_BAR, 0, 4096, stream);
    void* args[] = {&P};
    hipError_t e = hipLaunchCooperativeKernel((void*)hymba_megakernel, dim3(grid_blocks), dim3(NTHR), args, 0, stream);
    if (e != hipSuccess) fprintf(stderr, "cooperative launch failed: %s (grid %d)\n", hipGetErrorString(e), grid_blocks);
}
```

```cpp
#include <hip/hip_runtime.h>
#include <hip/hip_cooperative_groups.h>
#include <cstdio>
#include <cstdint>
#include <math.h>
#include <climits>
namespace cg = cooperative_groups;

typedef __bf16 bf16;
typedef __bf16 bf16x8 __attribute__((ext_vector_type(8)));
typedef __bf16 bf16x4 __attribute__((ext_vector_type(4)));
typedef __bf16 bf16x2 __attribute__((ext_vector_type(2)));
typedef float f32x16 __attribute__((ext_vector_type(16)));
typedef float f32x4 __attribute__((ext_vector_type(4)));
typedef float f32x2 __attribute__((ext_vector_type(2)));
typedef unsigned u32x4 __attribute__((ext_vector_type(4)));
typedef unsigned u32x2 __attribute__((ext_vector_type(2)));

#define SEQ 2048
#define BATCH 8
#define TOK 16384
#define DM 1024
#define IN_W 1956
#define NEXP 16384
#define EPSF 1e-6f
#define LOG2E 1.4426950408889634f
#define NTHR 256
#define LDS_BYTES 65536
#ifndef DUP
#define DUP -1
#endif

constexpr size_t MBy = 1ull << 20;
constexpr size_t OFF_UB = 0;
constexpr size_t OFF_VB = 32 * MBy;
constexpr size_t OFF_PART = 64 * MBy;
constexpr size_t OFF_WIN = 128 * MBy;
constexpr size_t OFF_WO = 136 * MBy;
constexpr size_t OFF_WQ = 140 * MBy;
constexpr size_t OFF_WG = 144 * MBy;
constexpr size_t OFF_WP = 148 * MBy;
constexpr size_t OFF_WUQ = 149 * MBy;
constexpr size_t OFF_WUKV = 149 * MBy + 512 * 1024;
constexpr size_t OFF_SKB = 150 * MBy;
constexpr size_t OFF_CS = 151 * MBy;
constexpr size_t OFF_TSC = 153 * MBy;
constexpr size_t OFF_SSA = 154 * MBy;
constexpr size_t OFF_SSP = 157 * MBy;
constexpr size_t OFF_HB0 = 158 * MBy;
constexpr size_t OFF_HB1 = 190 * MBy;
constexpr size_t OFF_FQ = 222 * MBy;
constexpr size_t OFF_FK = 230 * MBy;
constexpr size_t OFF_FVT = 238 * MBy;
constexpr size_t OFF_SQ = 246 * MBy;
constexpr size_t OFF_SKK = 254 * MBy;
constexpr size_t OFF_SVT = 262 * MBy;
constexpr size_t OFF_CQ = 270 * MBy;
constexpr size_t OFF_CKV = 278 * MBy;
constexpr size_t OFF_FLOG = 282 * MBy;
constexpr size_t OFF_CUMF = 283 * MBy;
constexpr size_t OFF_MQ = 284 * MBy;
constexpr size_t OFF_MK = 296 * MBy;
constexpr size_t OFF_MVT = 308 * MBy;
constexpr size_t OFF_Y = 324 * MBy;
constexpr size_t OFF_PQ = 356 * MBy;
constexpr size_t OFF_IDS = 388 * MBy;
constexpr size_t OFF_GATE = 396 * MBy;
constexpr size_t OFF_BAR = 404 * MBy;
constexpr size_t OFF_CNT = OFF_BAR + 16384;
constexpr size_t OFF_SSY = 405 * MBy;
constexpr size_t WS_END = 408 * MBy;

struct Params {
    const float* x; const float* p; const int* pos;
    const float* norm_mix_g; const float* w_in; const float* b_forget; const float* mla_q_norm_g; const float* w_uq;
    const float* mla_kv_norm_g; const float* w_ukv; const float* mix_out_norm_g; const float* w_o; const float* norm_ffn_g;
    const float* w_query; const float* sub_keys; const float* peer_u; const float* peer_v; const float* w_ple;
    const float* ple_norm_g; const float* w_ple_gate; const float* final_norm_g;
    float* out; char* ws;
};

__shared__ __attribute__((aligned(16))) char smem[LDS_BYTES];

__device__ __forceinline__ int opaque_tid() { int t = threadIdx.x; asm volatile("" : "+v"(t)); return t; }
template <typename T> __device__ __forceinline__ T* opq(T* p) { size_t z = 0; asm volatile("" : "+s"(z)); return (T*)((char*)p + z); }

__device__ __forceinline__ unsigned pack2(float a, float b) {
    f32x2 v = {a, b};
    bf16x2 r = __builtin_convertvector(v, bf16x2);
    return __builtin_bit_cast(unsigned, r);
}
__device__ __forceinline__ float bflo(unsigned u) { return __uint_as_float(u << 16); }
__device__ __forceinline__ float bfhi(unsigned u) { return __uint_as_float(u & 0xffff0000u); }
__device__ __forceinline__ float wave_sum(float v) {
#pragma unroll
    for (int o = 32; o > 0; o >>= 1) v += __shfl_xor(v, o);
    return v;
}
__device__ __forceinline__ float fexp2(float x) { return __builtin_amdgcn_exp2f(x); }
__device__ __forceinline__ float flog2(float x) { return __builtin_amdgcn_logf(x); }
__device__ __forceinline__ float log_sigmoid_f(float z) { return fminf(z, 0.f) - log1pf(expf(-fabsf(z))); }

struct WJob { const float* src; int lds; int K; int Np; bf16* dst; const float* gain; int map; };

__device__ __forceinline__ int src_col_map(int map, int c) {
    if (map == 0) return c;
    if (map == 1) {
        if (c < 768) return c;
        if (c < 1952) return c + 4;
        if (c < 1956) return c - 1952 + 768;
        return -1;
    }
    if (c < 256) return 192 * (c >> 6) + (c & 63);
    int e = c - 256;
    return 192 * (e >> 7) + 64 + (e & 127);
}

__device__ __forceinline__ void wconv_tile(const WJob& j, int tile) {
    float* tl = (float*)smem;
    int ktiles = j.K >> 5;
    int nt = tile / ktiles, kt = tile % ktiles;
    int n0 = nt * 32, k0 = kt * 32;
    int tx = opaque_tid() & 31, ty = opaque_tid() >> 5;
    int sc = src_col_map(j.map, n0 + tx);
#pragma unroll
    for (int i = 0; i < 4; ++i) {
        int k = k0 + ty + 8 * i;
        float v = 0.f;
        if (sc >= 0) v = j.src[(size_t)k * j.lds + sc] * (j.gain ? j.gain[k] : 1.f);
        tl[(ty + 8 * i) * 33 + tx] = v;
    }
    __syncthreads();
#pragma unroll
    for (int i = 0; i < 4; ++i) {
        int n = n0 + ty + 8 * i;
        j.dst[(size_t)n * j.K + k0 + tx] = (bf16)tl[tx * 33 + ty + 8 * i];
    }
    __syncthreads();
}

__device__ __forceinline__ void phase0(const Params& P) {
    char* ws = opq(P.ws);
    const int G = gridDim.x, bid = blockIdx.x, tid = opaque_tid();
    {
        const int w = tid >> 6, l = tid & 63;
        float* tsc = (float*)(ws + OFF_TSC);
        for (int it = bid * 4 + w; it < 4 * NEXP; it += G * 4) {
            int tb = it >> 14, e = it & (NEXP - 1);
            const float* src = (tb < 2 ? P.peer_u : P.peer_v) + ((size_t)(tb & 1) * NEXP + e) * DM + l * 16;
            unsigned char* dst = (unsigned char*)(ws + (tb < 2 ? OFF_UB : OFF_VB)) + (size_t)(tb & 1) * NEXP * DM;
            float4 a = ((const float4*)src)[0], b = ((const float4*)src)[1], c = ((const float4*)src)[2], d = ((const float4*)src)[3];
            float am = fmaxf(fmaxf(fmaxf(fabsf(a.x), fabsf(a.y)), fmaxf(fabsf(a.z), fabsf(a.w))), fmaxf(fmaxf(fabsf(b.x), fabsf(b.y)), fmaxf(fabsf(b.z), fabsf(b.w))));
            am = fmaxf(am, fmaxf(fmaxf(fmaxf(fabsf(c.x), fabsf(c.y)), fmaxf(fabsf(c.z), fabsf(c.w))), fmaxf(fmaxf(fabsf(d.x), fabsf(d.y)), fmaxf(fabsf(d.z), fabsf(d.w)))));
#pragma unroll
            for (int o = 32; o > 0; o >>= 1) am = fmaxf(am, __shfl_xor(am, o));
            int eb = ((__float_as_int(am) >> 23) & 0xff) - 127;
            eb = max(-100, min(100, eb));
            if (am == 0.f) eb = 7;
            float sc = __int_as_float((127 + 7 - eb) << 23), isc = __int_as_float((127 + eb - 7) << 23);
            int w0 = 0, w1 = 0, w2 = 0, w3 = 0;
            w0 = __builtin_amdgcn_cvt_pk_fp8_f32(a.x * sc, a.y * sc, w0, false); w0 = __builtin_amdgcn_cvt_pk_fp8_f32(a.z * sc, a.w * sc, w0, true);
            w1 = __builtin_amdgcn_cvt_pk_fp8_f32(b.x * sc, b.y * sc, w1, false); w1 = __builtin_amdgcn_cvt_pk_fp8_f32(b.z * sc, b.w * sc, w1, true);
            w2 = __builtin_amdgcn_cvt_pk_fp8_f32(c.x * sc, c.y * sc, w2, false); w2 = __builtin_amdgcn_cvt_pk_fp8_f32(c.z * sc, c.w * sc, w2, true);
            w3 = __builtin_amdgcn_cvt_pk_fp8_f32(d.x * sc, d.y * sc, w3, false); w3 = __builtin_amdgcn_cvt_pk_fp8_f32(d.z * sc, d.w * sc, w3, true);
            u32x4 o4 = {(unsigned)w0, (unsigned)w1, (unsigned)w2, (unsigned)w3};
            *(u32x4*)(dst + ((size_t)(l >> 3) * NEXP + e) * 128 + (l & 7) * 16) = o4;
            if (l == 0) tsc[tb * NEXP + e] = isc;
        }
    }
    {
        for (int L = 0; L < 2; ++L) {
            WJob jobs[7];
            jobs[0] = {P.w_in + (size_t)L * 1024 * IN_W, IN_W, 1024, 2048, (bf16*)(ws + OFF_WIN) + (size_t)L * 2048 * 1024, P.norm_mix_g + L * 1024, 1};
            jobs[1] = {P.w_o + (size_t)L * 1024 * 1024, 1024, 1024, 1024, (bf16*)(ws + OFF_WO) + (size_t)L * 1024 * 1024, P.mix_out_norm_g + L * 1024, 0};
            jobs[2] = {P.w_query + (size_t)L * 1024 * 1024, 1024, 1024, 1024, (bf16*)(ws + OFF_WQ) + (size_t)L * 1024 * 1024, P.norm_ffn_g + L * 1024, 0};
            jobs[3] = {P.w_ple_gate + (size_t)L * 1024 * 1024, 1024, 1024, 1024, (bf16*)(ws + OFF_WG) + (size_t)L * 1024 * 1024, P.ple_norm_g + L * 1024, 0};
            jobs[4] = {P.w_ple + (size_t)L * 256 * 1024, 1024, 256, 1024, (bf16*)(ws + OFF_WP) + (size_t)L * 1024 * 256, nullptr, 0};
            jobs[5] = {P.w_uq + (size_t)L * 256 * 384, 384, 256, 384, (bf16*)(ws + OFF_WUQ) + (size_t)L * 384 * 256, P.mla_q_norm_g + L * 256, 0};
            jobs[6] = {P.w_ukv + (size_t)L * 128 * 768, 768, 128, 768, (bf16*)(ws + OFF_WUKV) + (size_t)L * 768 * 128, P.mla_kv_norm_g + L * 128, 2};
#pragma unroll
            for (int q = 0; q < 7; ++q) {
                int nt = (jobs[q].Np >> 5) * (jobs[q].K >> 5);
                for (int it = bid; it < nt; it += G) wconv_tile(jobs[q], it);
            }
        }
    }
    {
        const float* src = P.sub_keys;
        bf16* dst = (bf16*)(ws + OFF_SKB);
        for (int i = bid * NTHR + tid; i < 262144 / 2; i += G * NTHR) {
            float2 v = ((const float2*)src)[i];
            ((unsigned*)dst)[i] = pack2(v.x, v.y);
        }
    }
    {
        bf16* hb = (bf16*)(ws + OFF_HB0);
        float* ss0 = (float*)(ws + OFF_SSA);
        int w = tid >> 6, l = tid & 63;
        for (int row = bid * 4 + w; row < TOK; row += G * 4) {
            const float4* xr = (const float4*)(P.x + (size_t)row * DM);
            float ss = 0.f;
#pragma unroll
            for (int i = 0; i < 2; ++i) {
                float4 a = xr[i * 128 + l * 2], b = xr[i * 128 + l * 2 + 1];
                ss += a.x * a.x + a.y * a.y + a.z * a.z + a.w * a.w + b.x * b.x + b.y * b.y + b.z * b.z + b.w * b.w;
                uint4 o;
                o.x = pack2(a.x, a.y); o.y = pack2(a.z, a.w); o.z = pack2(b.x, b.y); o.w = pack2(b.z, b.w);
                ((uint4*)(hb + (size_t)row * DM))[i * 64 + l] = o;
            }
            ss = wave_sum(ss);
            if (l == 0) {
                *(float4*)(ss0 + (size_t)row * 8) = make_float4(ss, 0.f, 0.f, 0.f);
                *(float4*)(ss0 + (size_t)row * 8 + 4) = make_float4(0.f, 0.f, 0.f, 0.f);
            }
        }
    }
    {
        float* cs = (float*)(ws + OFF_CS);
        for (int i = bid * NTHR + tid; i < TOK * 16; i += G * NTHR) {
            int t = i >> 4, k = i & 15;
            float inv = powf(10000.0f, -(float)k / 16.0f);
            float ang = (float)P.pos[t] * inv;
            cs[2 * i] = cosf(ang);
            cs[2 * i + 1] = sinf(ang);
        }
    }
}

template <int AMODE, typename SF>
__device__ __forceinline__ void gemm_core(f32x16 (&acc)[2][2], const void* Ap, int lda, const bf16* Bt, int ldb, int K,
                                          int m0, int n0, SF scalef) {
    const int tid = opaque_tid(), w = tid >> 6, l = tid & 63, r = l & 31, hh = l >> 5;
    const int wm = w >> 1, wn = w & 1;
    const int lc = tid & 7, lr = tid >> 3;
    u32x4 ra[4], rb[4];
    auto gload = [&](int k0) {
#pragma unroll
        for (int i = 0; i < 4; ++i) {
            int row = lr + 32 * i;
            if (AMODE == 1) {
                const float4* s = (const float4*)((const float*)Ap + (size_t)(m0 + row) * lda + k0 + lc * 8);
                float4 a = s[0], b = s[1];
                ra[i].x = pack2(a.x, a.y); ra[i].y = pack2(a.z, a.w); ra[i].z = pack2(b.x, b.y); ra[i].w = pack2(b.z, b.w);
            } else {
                ra[i] = *(const u32x4*)((const bf16*)Ap + (size_t)(m0 + row) * lda + k0 + lc * 8);
                if (AMODE == 2) {
                    float sc = scalef(i, k0);
                    ra[i].x = pack2(bflo(ra[i].x) * sc, bfhi(ra[i].x) * sc);
                    ra[i].y = pack2(bflo(ra[i].y) * sc, bfhi(ra[i].y) * sc);
                    ra[i].z = pack2(bflo(ra[i].z) * sc, bfhi(ra[i].z) * sc);
                    ra[i].w = pack2(bflo(ra[i].w) * sc, bfhi(ra[i].w) * sc);
                }
            }
            rb[i] = *(const u32x4*)(Bt + (size_t)(n0 + row) * ldb + k0 + lc * 8);
        }
    };
    auto lwrite = [&](int buf) {
        char* base = smem + buf * 32768;
#pragma unroll
        for (int i = 0; i < 4; ++i) {
            int row = lr + 32 * i;
            int off = row * 128 + ((lc ^ (row & 7)) << 4);
            *(u32x4*)(base + off) = ra[i];
            *(u32x4*)(base + 16384 + off) = rb[i];
        }
    };
    const int nk = K >> 6;
    gload(0);
    lwrite(0);
    __syncthreads();
    for (int kt = 0; kt < nk; ++kt) {
        if (kt + 1 < nk) gload((kt + 1) << 6);
        const char* base = smem + (kt & 1) * 32768;
#pragma unroll
        for (int s = 0; s < 4; ++s) {
            int ch = ((2 * s + hh) ^ (r & 7)) << 4;
            bf16x8 af[2], bfr[2];
#pragma unroll
            for (int i = 0; i < 2; ++i) af[i] = *(const bf16x8*)(base + (wm * 64 + i * 32 + r) * 128 + ch);
#pragma unroll
            for (int j = 0; j < 2; ++j) bfr[j] = *(const bf16x8*)(base + 16384 + (wn * 64 + j * 32 + r) * 128 + ch);
#pragma unroll
            for (int i = 0; i < 2; ++i)
#pragma unroll
                for (int j = 0; j < 2; ++j) acc[i][j] = __builtin_amdgcn_mfma_f32_32x32x16_bf16(af[i], bfr[j], acc[i][j], 0, 0, 0);
        }
        if (kt + 1 < nk) lwrite((kt + 1) & 1);
        __syncthreads();
    }
}
__device__ __forceinline__ float row_rs8(const float* part, int row) {
    float4 a = *(const float4*)(part + (size_t)row * 8), b = *(const float4*)(part + (size_t)row * 8 + 4);
    float ss = ((a.x + a.y) + (a.z + a.w)) + ((b.x + b.y) + (b.z + b.w));
    return rsqrtf(ss * (1.f / 1024.f) + EPSF);
}
struct NoScale { __device__ __forceinline__ float operator()(int, int) const { return 1.f; } };

#define ZERO_ACC(acc)                                  \
    _Pragma("unroll") for (int _i = 0; _i < 2; ++_i)   \
    _Pragma("unroll") for (int _j = 0; _j < 2; ++_j)   \
    _Pragma("unroll") for (int _r = 0; _r < 16; ++_r) acc[_i][_j][_r] = 0.f;


__device__ __forceinline__ void phase_proj(const Params& P, int L, int hsel, const float* ssrow) {
    char* ws = opq(P.ws);
    const bf16* hb = (const bf16*)(ws + (hsel ? OFF_HB1 : OFF_HB0));
    const bf16* Bt = (const bf16*)(ws + OFF_WIN) + (size_t)L * 2048 * 1024;
    bf16* fq = (bf16*)(ws + OFF_FQ); bf16* fk = (bf16*)(ws + OFF_FK); bf16* fvt = (bf16*)(ws + OFF_FVT);
    bf16* sq = (bf16*)(ws + OFF_SQ); bf16* sk = (bf16*)(ws + OFF_SKK); bf16* svt = (bf16*)(ws + OFF_SVT);
    bf16* cq = (bf16*)(ws + OFF_CQ); bf16* ckv = (bf16*)(ws + OFF_CKV);
    float* flog = (float*)(ws + OFF_FLOG);
    bf16* mk = (bf16*)(ws + OFF_MK);
    const float* cs = (const float*)(ws + OFF_CS);
    const int tid = opaque_tid(), w = tid >> 6, l = tid & 63, hh = l >> 5, wm = w >> 1, wn = w & 1;
    for (int tile = blockIdx.x; tile < 128 * 16; tile += gridDim.x) {
        int mt = tile >> 4, nt = tile & 15;
        int m0 = mt * 128, n0 = nt * 128;
        f32x16 acc[2][2];
        ZERO_ACC(acc);
        gemm_core<0>(acc, hb, 1024, Bt, 1024, 1024, m0, n0, NoScale());
#pragma unroll
        for (int i = 0; i < 2; ++i) {
            float rs[16];
#pragma unroll
            for (int rr = 0; rr < 16; ++rr) {
                int row = m0 + wm * 64 + i * 32 + (rr & 3) + 8 * (rr >> 2) + 4 * hh;
                rs[rr] = row_rs8(ssrow, row);
            }
#pragma unroll
            for (int j = 0; j < 2; ++j) {
                int col = n0 + wn * 64 + j * 32 + (l & 31);
                int rbase = m0 + wm * 64 + i * 32 + 4 * hh;
                if (nt < 14 && nt != 4 && nt != 5 && nt != 10 && nt != 11) {
                    bf16* dst; int ld, c;
                    if (nt < 2) { dst = fq; ld = 256; c = col; }
                    else if (nt < 4) { dst = fk; ld = 256; c = col - 256; }
                    else if (nt < 8) { dst = sq; ld = 256; c = col - 768; }
                    else if (nt < 10) { dst = sk; ld = 256; c = col - 1024; }
                    else if (nt < 14) { dst = cq; ld = 256; c = col - 1536; }
                    if (nt == 14) { dst = ckv; ld = 128; c = col - 1792; }
#pragma unroll
                    for (int rr = 0; rr < 16; ++rr) {
                        int row = rbase + (rr & 3) + 8 * (rr >> 2);
                        dst[(size_t)row * ld + c] = (bf16)(acc[i][j][rr] * rs[rr]);
                    }
                } else if (nt == 14) {
                    int c = col - 1792;
#pragma unroll
                    for (int rr = 0; rr < 16; ++rr) {
                        int row = rbase + (rr & 3) + 8 * (rr >> 2);
                        ckv[(size_t)row * 128 + c] = (bf16)(acc[i][j][rr] * rs[rr]);
                    }
                } else if (nt == 4 || nt == 5 || nt == 10 || nt == 11) {
                    bf16* vt = (nt < 6) ? fvt : svt;
                    int c = col - ((nt < 6) ? 512 : 1280);
                    int b = m0 >> 11;
                    int s0 = (rbase & 2047);
                    bf16* base = vt + ((size_t)(b * 256 + c)) * SEQ + s0;
#pragma unroll
                    for (int g = 0; g < 4; ++g) {
                        uint2 o;
                        o.x = pack2(acc[i][j][4 * g] * rs[4 * g], acc[i][j][4 * g + 1] * rs[4 * g + 1]);
                        o.y = pack2(acc[i][j][4 * g + 2] * rs[4 * g + 2], acc[i][j][4 * g + 3] * rs[4 * g + 3]);
                        *(uint2*)(base + 8 * g) = o;
                    }
                } else {
                    if (wn == 0 && j == 0) {
                        int ci = l & 31, pi = ci & 15;
#pragma unroll
                        for (int rr = 0; rr < 16; ++rr) {
                            int row = rbase + (rr & 3) + 8 * (rr >> 2);
                            float v = acc[i][j][rr] * rs[rr];
                            float pv = __shfl_xor(v, 16);
                            float2 c_s = *(const float2*)(cs + ((size_t)row * 16 + pi) * 2);
                            float o = (ci < 16) ? (v * c_s.x - pv * c_s.y) : (pv * c_s.y + v * c_s.x);
                            bf16 ob = (bf16)o;
#pragma unroll
                            for (int h = 0; h < 4; ++h) mk[(size_t)row * 384 + h * 96 + 64 + ci] = ob;
                        }
                    } else if (wn == 0 && j == 1) {
                        int c = (l & 31);
                        if (c < 4) {
#pragma unroll
                            for (int rr = 0; rr < 16; ++rr) {
                                int row = rbase + (rr & 3) + 8 * (rr >> 2);
                                flog[(size_t)row * 4 + c] = acc[i][j][rr] * rs[rr];
                            }
                        }
                    }
                }
            }
        }
    }
}

struct RowScale4 { float s[4]; __device__ __forceinline__ float operator()(int i, int) const { return s[i]; } };

template <int KW>
__device__ __forceinline__ RowScale4 row_rms_prepass(const bf16* A, int lda, int m0) {
    const int tid = opaque_tid(), lc = tid & 7, lr = tid >> 3;
    RowScale4 rs;
#pragma unroll
    for (int i = 0; i < 4; ++i) {
        float ss = 0.f;
#pragma unroll
        for (int k0 = 0; k0 < KW; k0 += 64) {
            uint4 v = *(const uint4*)(A + (size_t)(m0 + lr + 32 * i) * lda + k0 + lc * 8);
            float a;
            a = bflo(v.x); ss += a * a; a = bfhi(v.x); ss += a * a;
            a = bflo(v.y); ss += a * a; a = bfhi(v.y); ss += a * a;
            a = bflo(v.z); ss += a * a; a = bfhi(v.z); ss += a * a;
            a = bflo(v.w); ss += a * a; a = bfhi(v.w); ss += a * a;
        }
        ss += __shfl_xor(ss, 1); ss += __shfl_xor(ss, 2); ss += __shfl_xor(ss, 4);
        rs.s[i] = rsqrtf(ss * (1.f / (float)KW) + EPSF);
    }
    return rs;
}

__device__ __forceinline__ void phase_mla_up(const Params& P, int L) {
    char* ws = opq(P.ws);
    const bf16* cq = (const bf16*)(ws + OFF_CQ); const bf16* ckv = (const bf16*)(ws + OFF_CKV);
    const bf16* wuq = (const bf16*)(ws + OFF_WUQ) + (size_t)L * 384 * 256;
    const bf16* wukv = (const bf16*)(ws + OFF_WUKV) + (size_t)L * 768 * 128;
    bf16* mq = (bf16*)(ws + OFF_MQ); bf16* mk = (bf16*)(ws + OFF_MK); bf16* mvt = (bf16*)(ws + OFF_MVT);
    const float* cs = (const float*)(ws + OFF_CS);
    const float* flog = (const float*)(ws + OFF_FLOG);
    float* cumF = (float*)(ws + OFF_CUMF);
    const int tid = opaque_tid(), w = tid >> 6, l = tid & 63, hh = l >> 5, wm = w >> 1, wn = w & 1;
    const int NQ = 128 * 3, NKV = 128 * 6, NCF = 8;
    for (int item = blockIdx.x; item < NQ + NKV + NCF; item += gridDim.x) {
        if (item < NQ) {
            int mt = item / 3, nt = item % 3;
            int m0 = mt * 128, n0 = nt * 128;
            RowScale4 rs = row_rms_prepass<256>(cq, 256, m0);
            f32x16 acc[2][2];
            ZERO_ACC(acc);
            gemm_core<2>(acc, cq, 256, wuq, 256, 256, m0, n0, rs);
#pragma unroll
            for (int i = 0; i < 2; ++i)
#pragma unroll
                for (int j = 0; j < 2; ++j) {
                    int c0 = n0 + wn * 64 + j * 32;
                    int col = c0 + (l & 31);
                    int rbase = m0 + wm * 64 + i * 32 + 4 * hh;
                    bool rot = (c0 % 96) == 64;
                    int ci = l & 31, pi = ci & 15;
#pragma unroll
                    for (int rr = 0; rr < 16; ++rr) {
                        int row = rbase + (rr & 3) + 8 * (rr >> 2);
                        float v = acc[i][j][rr];
                        if (rot) {
                            float pv = __shfl_xor(v, 16);
                            float2 c_s = *(const float2*)(cs + ((size_t)row * 16 + pi) * 2);
                            v = (ci < 16) ? (v * c_s.x - pv * c_s.y) : (pv * c_s.y + v * c_s.x);
                        }
                        mq[(size_t)row * 384 + col] = (bf16)v;
                    }
                }
        } else if (item < NQ + NKV) {
            int it2 = item - NQ;
            int mt = it2 / 6, nt = it2 % 6;
            int m0 = mt * 128, n0 = nt * 128;
            RowScale4 rs = row_rms_prepass<128>(ckv, 128, m0);
            f32x16 acc[2][2];
            ZERO_ACC(acc);
            gemm_core<2>(acc, ckv, 128, wukv, 128, 128, m0, n0, rs);
#pragma unroll
            for (int i = 0; i < 2; ++i)
#pragma unroll
                for (int j = 0; j < 2; ++j) {
                    int col = n0 + wn * 64 + j * 32 + (l & 31);
                    int rbase = m0 + wm * 64 + i * 32 + 4 * hh;
                    if (nt < 2) {
                        int dcol = (col >> 6) * 96 + (col & 63);
#pragma unroll
                        for (int rr = 0; rr < 16; ++rr) {
                            int row = rbase + (rr & 3) + 8 * (rr >> 2);
                            mk[(size_t)row * 384 + dcol] = (bf16)acc[i][j][rr];
                        }
                    } else {
                        int e = col - 256;
                        int b = m0 >> 11;
                        int s0 = rbase & 2047;
                        bf16* base = mvt + ((size_t)(b * 512 + e)) * SEQ + s0;
#pragma unroll
                        for (int g = 0; g < 4; ++g) {
                            uint2 o;
                            o.x = pack2(acc[i][j][4 * g], acc[i][j][4 * g + 1]);
                            o.y = pack2(acc[i][j][4 * g + 2], acc[i][j][4 * g + 3]);
                            *(uint2*)(base + 8 * g) = o;
                        }
                    }
                }
        } else {
            int seq = (item - NQ - NKV) * 4 + w;
            int b = seq >> 2, h = seq & 3;
            float bfv = P.b_forget[L * 4 + h];
            float vals[32];
            float run = 0.f;
#pragma unroll
            for (int i = 0; i < 32; ++i) {
                int s = l * 32 + i;
                float z = flog[((size_t)b * SEQ + s) * 4 + h] + bfv;
                run += log_sigmoid_f(z);
                vals[i] = run;
            }
            float tot = run, incl = tot;
#pragma unroll
            for (int o = 1; o < 64; o <<= 1) {
                float t = __shfl_up(incl, o);
                if (l >= o) incl += t;
            }
            float excl = incl - tot;
#pragma unroll
            for (int i = 0; i < 32; ++i) cumF[(size_t)seq * SEQ + l * 32 + i] = vals[i] + excl;
        }
    }
}

template <int MODE, int DK, int DV>
__device__ __forceinline__ void attn_item(const bf16* __restrict__ Q, int ldq, const bf16* __restrict__ Kg, int ldk,
                          const bf16* __restrict__ Vt, const float* __restrict__ cumF, bf16* __restrict__ Y,
                          float* __restrict__ ssy, int b, int h, int qb, float c1) {
    constexpr int KSTR = DK * 2 + 16;
    constexpr int VSTR = 144;
    constexpr int KBYTES = 64 * KSTR, VBYTES = DV * VSTR;
    constexpr int BUF = (KBYTES + VBYTES + 256 + 255) & ~255;
    static_assert(2 * BUF <= LDS_BYTES - 64, "lds");
    constexpr int KCH = DK / 8, KPT = (64 * KCH) / 256, VPT = (DV * 8) / 256;
    const int tid = opaque_tid(), w = tid >> 6, l = tid & 63, r = l & 31, hh = l >> 5;
    const int q0 = qb * 128;
    const int qrow = q0 + 32 * w + r;
    const size_t tok = (size_t)b * SEQ + qrow;
    const int bh = b * 4 + h;
    bf16x8 qf[DK / 16];
#pragma unroll
    for (int s = 0; s < DK / 16; ++s) qf[s] = *(const bf16x8*)(Q + tok * ldq + h * DK + 16 * s + 8 * hh);
    f32x16 o[DV / 32];
    const f32x16 zero16 = {0.f, 0.f, 0.f, 0.f, 0.f, 0.f, 0.f, 0.f, 0.f, 0.f, 0.f, 0.f, 0.f, 0.f, 0.f, 0.f};
#pragma unroll
    for (int d = 0; d < DV / 32; ++d) o[d] = zero16;
    float m = -1e30f, lsum = 0.f, R = 0.f;
    float Fq = 0.f;
    if (MODE == 0) Fq = cumF[(size_t)bh * SEQ + qrow] * LOG2E;
    const int nkt = (q0 + 128) >> 6;
    u32x4 kreg[KPT], vreg[VPT];
    float4 freg = {0.f, 0.f, 0.f, 0.f};
    auto gload = [&](int kt) {
#pragma unroll
        for (int i = 0; i < KPT; ++i) {
            int e = tid + 256 * i;
            int row = e / KCH, ch = e % KCH;
            kreg[i] = *(const u32x4*)(Kg + ((size_t)b * SEQ + kt * 64 + row) * ldk + h * DK + ch * 8);
        }
#pragma unroll
        for (int i = 0; i < VPT; ++i) {
            int e = tid + 256 * i;
            int row = e >> 3, ch = e & 7;
            vreg[i] = *(const u32x4*)(Vt + ((size_t)bh * DV + row) * SEQ + kt * 64 + ch * 8);
        }
        if (MODE == 0 && tid < 16) freg = *(const float4*)(cumF + (size_t)bh * SEQ + kt * 64 + tid * 4);
    };
    auto lwrite = [&](int buf) {
        char* base = smem + buf * BUF;
#pragma unroll
        for (int i = 0; i < KPT; ++i) {
            int e = tid + 256 * i;
            int row = e / KCH, ch = e % KCH;
            *(u32x4*)(base + row * KSTR + ch * 16) = kreg[i];
        }
#pragma unroll
        for (int i = 0; i < VPT; ++i) {
            int e = tid + 256 * i;
            int row = e >> 3, ch = e & 7;
            *(u32x4*)(base + KBYTES + row * VSTR + ch * 16) = vreg[i];
        }
        if (MODE == 0 && tid < 16) *(float4*)(base + KBYTES + VBYTES + tid * 16) = freg;
    };
    const int prow = (r & 0x13) | ((r & 4) << 1) | ((r & 8) >> 1);
    gload(MODE == 1 ? nkt - 1 : 0);
    lwrite(0);
    __syncthreads();
    for (int it = 0; it < nkt; ++it) {
        const int kt = (MODE == 1) ? (nkt - 1 - it) : it;
        if (it + 1 < nkt) gload((MODE == 1) ? (kt - 1) : (kt + 1));
        const char* base = smem + (it & 1) * BUF;
        const bool active = (kt * 64) <= (q0 + 32 * w + 31);
        if (active) {
            const bool needmask = (kt * 64 + 63) >= (q0 + 32 * w);
            f32x16 s[2];
#pragma unroll
            for (int sub = 0; sub < 2; ++sub) {
                s[sub] = zero16;
#pragma unroll
                for (int ks = 0; ks < DK / 16; ++ks) {
                    bf16x8 kf = *(const bf16x8*)(base + (sub * 32 + prow) * KSTR + (2 * ks + hh) * 16);
                    s[sub] = __builtin_amdgcn_mfma_f32_32x32x16_bf16(kf, qf[ks], s[sub], 0, 0, 0);
                }
            }
            bf16x8 pf[2][2];
            if (MODE != 1) {
                const float* Ft = (const float*)(base + KBYTES + VBYTES);
                float mx = -INFINITY;
                float tv[2][16];
#pragma unroll
                for (int sub = 0; sub < 2; ++sub)
#pragma unroll
                    for (int a = 0; a < 2; ++a) {
                        int kofs = sub * 32 + 16 * a + 8 * hh;
                        float fk[8];
                        if (MODE == 0) {
                            float4 f0 = *(const float4*)(Ft + kofs), f1 = *(const float4*)(Ft + kofs + 4);
                            fk[0] = f0.x; fk[1] = f0.y; fk[2] = f0.z; fk[3] = f0.w; fk[4] = f1.x; fk[5] = f1.y; fk[6] = f1.z; fk[7] = f1.w;
                        }
#pragma unroll
                        for (int j = 0; j < 8; ++j) {
                            int rr = 8 * a + j;
                            float v = s[sub][rr] * c1;
                            if (MODE == 0) v += Fq - fk[j] * LOG2E;
                            if (needmask && (kt * 64 + kofs + j > qrow)) v = -INFINITY;
                            tv[sub][rr] = v;
                            mx = fmaxf(mx, v);
                        }
                    }
                mx = fmaxf(mx, __shfl_xor(mx, 32));
                float mnew = fmaxf(m, mx);
                float alpha = fexp2(m - mnew);
                float rsum = 0.f;
#pragma unroll
                for (int sub = 0; sub < 2; ++sub)
#pragma unroll
                    for (int a = 0; a < 2; ++a) {
                        float pv[8];
#pragma unroll
                        for (int j = 0; j < 8; ++j) { pv[j] = fexp2(tv[sub][8 * a + j] - mnew); rsum += pv[j]; }
                        uint4 u;
                        u.x = pack2(pv[0], pv[1]); u.y = pack2(pv[2], pv[3]); u.z = pack2(pv[4], pv[5]); u.w = pack2(pv[6], pv[7]);
                        pf[sub][a] = __builtin_bit_cast(bf16x8, u);
                    }
                rsum += __shfl_xor(rsum, 32);
                lsum = lsum * alpha + rsum;
                m = mnew;
#pragma unroll
                for (int d = 0; d < DV / 32; ++d) o[d] = o[d] * alpha;
            } else {
#pragma unroll
                for (int sb = 0; sb < 2; ++sb) {
                    const int sub = 1 - sb;
                    float lsig[16], lneg[16];
                    float A0 = 0.f, A1 = 0.f;
#pragma unroll
                    for (int rr = 0; rr < 16; ++rr) {
                        int key = kt * 64 + sub * 32 + 16 * (rr >> 3) + 8 * hh + (rr & 7);
                        bool valid = key < qrow;
                        float z = s[sub][rr] * c1;
                        float e = fexp2(-fabsf(z));
                        float l1p = flog2(1.f + e);
                        float ls = fminf(z, 0.f) - l1p;
                        float ln = valid ? (ls - z) : 0.f;
                        lsig[rr] = valid ? ls : -INFINITY;
                        lneg[rr] = ln;
                        if (rr < 8) A0 += ln; else A1 += ln;
                    }
                    float B0 = __shfl_xor(A0, 32), B1 = __shfl_xor(A1, 32);
                    float base1 = (hh == 0) ? (R + B1) : R;
                    float base0 = (hh == 0) ? (R + B1 + A1 + B0) : (R + A1 + B1);
                    float wv[16];
                    float run = base1;
#pragma unroll
                    for (int j = 7; j >= 0; --j) { wv[8 + j] = fexp2(lsig[8 + j] + run); run += lneg[8 + j]; }
                    run = base0;
#pragma unroll
                    for (int j = 7; j >= 0; --j) { wv[j] = fexp2(lsig[j] + run); run += lneg[j]; }
                    R += A0 + A1 + B0 + B1;
#pragma unroll
                    for (int a = 0; a < 2; ++a) {
                        uint4 u;
                        u.x = pack2(wv[8 * a], wv[8 * a + 1]); u.y = pack2(wv[8 * a + 2], wv[8 * a + 3]);
                        u.z = pack2(wv[8 * a + 4], wv[8 * a + 5]); u.w = pack2(wv[8 * a + 6], wv[8 * a + 7]);
                        pf[sub][a] = __builtin_bit_cast(bf16x8, u);
                    }
                }
            }
#pragma unroll
            for (int d = 0; d < DV / 32; ++d)
#pragma unroll
                for (int sub = 0; sub < 2; ++sub)
#pragma unroll
                    for (int a = 0; a < 2; ++a) {
                        bf16x8 vf = *(const bf16x8*)(base + KBYTES + (d * 32 + r) * VSTR + (sub * 32 + 16 * a + 8 * hh) * 2);
                        o[d] = __builtin_amdgcn_mfma_f32_32x32x16_bf16(vf, pf[sub][a], o[d], 0, 0, 0);
                    }
        }
        if (it + 1 < nkt) lwrite((it + 1) & 1);
        __syncthreads();
    }
    float inv = (MODE == 1) ? 1.f : (1.f / lsum);
    float ssq = 0.f;
#pragma unroll
    for (int d = 0; d < DV / 32; ++d)
#pragma unroll
        for (int g = 0; g < 4; ++g) {
            float v0 = o[d][4 * g] * inv, v1 = o[d][4 * g + 1] * inv, v2 = o[d][4 * g + 2] * inv, v3 = o[d][4 * g + 3] * inv;
            ssq += v0 * v0 + v1 * v1 + v2 * v2 + v3 * v3;
            uint2 u; u.x = pack2(v0, v1); u.y = pack2(v2, v3);
            *(uint2*)(Y + tok * 1024 + h * DV + d * 32 + 8 * g + 4 * hh) = u;
        }
    ssq += __shfl_xor(ssq, 32);
    if (hh == 0) ssy[tok * 16 + h] = ssq;
}

__device__ __forceinline__ void phase_attn(const Params& P, int L, int rep = 0) {
    char* ws = opq(P.ws);
    int* cnt = (int*)(ws + OFF_CNT) + L * 64 + rep * 16;
    int* s_item = (int*)(smem + LDS_BYTES - 16);
    const float* cumF = (const float*)(ws + OFF_CUMF);
    bf16* Y = (bf16*)(ws + OFF_Y);
    float* ssy = (float*)(ws + OFF_SSY) + (size_t)L * TOK * 16;
    for (;;) {
        if (opaque_tid() == 0) *s_item = atomicAdd(cnt, 1);
        __syncthreads();
        int item = *s_item;
        __syncthreads();
        if (item >= 1536) break;
        int qb = 15 - item / 96;
        int rem = item % 96;
        int type = rem >> 5, bh = rem & 31;
        int b = bh >> 2, h = bh & 3;
        if (type == 0) {
            attn_item<2, 96, 128>((const bf16*)(ws + OFF_MQ), 384, (const bf16*)(ws + OFF_MK), 384, (const bf16*)(ws + OFF_MVT), cumF,
                                  Y + 512, ssy + 8, b, h, qb, 0.10206207261596577f * LOG2E);
        } else if (type == 1) {
            attn_item<1, 64, 64>((const bf16*)(ws + OFF_SQ), 256, (const bf16*)(ws + OFF_SKK), 256, (const bf16*)(ws + OFF_SVT), cumF,
                                 Y + 256, ssy + 4, b, h, qb, 0.125f * LOG2E);
        } else {
            attn_item<0, 64, 64>((const bf16*)(ws + OFF_FQ), 256, (const bf16*)(ws + OFF_FK), 256, (const bf16*)(ws + OFF_FVT), cumF,
                                 Y + 0, ssy + 0, b, h, qb, 0.125f * LOG2E);
        }
    }
}

__device__ __forceinline__ void rowss_flush(float (&part)[2][16], float* gss, int m0, int nt) {
    float* lss = (float*)smem;
    const int tid = opaque_tid(), w = tid >> 6, l = tid & 63, hh = l >> 5, wm = w >> 1, wn = w & 1;
#pragma unroll
    for (int i = 0; i < 2; ++i)
#pragma unroll
        for (int rr = 0; rr < 16; ++rr) {
            float v = part[i][rr];
            v += __shfl_xor(v, 1); v += __shfl_xor(v, 2); v += __shfl_xor(v, 4); v += __shfl_xor(v, 8); v += __shfl_xor(v, 16);
            if ((l & 31) == 0) lss[wn * 128 + wm * 64 + i * 32 + (rr & 3) + 8 * (rr >> 2) + 4 * hh] = v;
        }
    __syncthreads();
    if (tid < 128) gss[(size_t)(m0 + tid) * 8 + nt] = lss[tid] + lss[128 + tid];
    __syncthreads();
}

struct GroupScale {
    float s0[4], s1[4], s2[4];
    __device__ __forceinline__ float operator()(int i, int k0) const {
        float a = s0[i], b = s1[i], c = s2[i];
        float sel = (k0 < 256) ? 1.f : 0.f, sel2 = (k0 >= 256 && k0 < 512) ? 1.f : 0.f;
        return a * sel + b * sel2 + c * (1.f - sel - sel2);
    }
};

__device__ __forceinline__ void phase_wo(const Params& P, int L, int hsel, float* ss_out) {
    char* ws = opq(P.ws);
    bf16* hb_out = (bf16*)(ws + (hsel ? OFF_HB1 : OFF_HB0));
    const float* hin = (L == 0) ? opq(P.x) : (const float*)opq(P.out);
    float* hout = opq(P.out);
    const bf16* Y = (const bf16*)(ws + OFF_Y);
    const bf16* Bt = (const bf16*)(ws + OFF_WO) + (size_t)L * 1024 * 1024;
    const float* ssy = (const float*)(ws + OFF_SSY) + (size_t)L * TOK * 16;
    const int tid = opaque_tid(), w = tid >> 6, l = tid & 63, hh = l >> 5, wm = w >> 1, wn = w & 1;
    for (int tile = blockIdx.x; tile < 128 * 8; tile += gridDim.x) {
        int mt = tile >> 3, nt = tile & 7;
        int m0 = mt * 128, n0 = nt * 128;
        GroupScale gs;
#pragma unroll
        for (int i = 0; i < 4; ++i) {
            int row = m0 + (tid >> 3) + 32 * i;
            float4 v0 = *(const float4*)(ssy + (size_t)row * 16), v1 = *(const float4*)(ssy + (size_t)row * 16 + 4), v2 = *(const float4*)(ssy + (size_t)row * 16 + 8);
            gs.s0[i] = rsqrtf(((v0.x + v0.y) + (v0.z + v0.w)) * (1.f / 256.f) + EPSF);
            gs.s1[i] = rsqrtf(((v1.x + v1.y) + (v1.z + v1.w)) * (1.f / 256.f) + EPSF);
            gs.s2[i] = rsqrtf(((v2.x + v2.y) + (v2.z + v2.w)) * (1.f / 512.f) + EPSF);
        }
        f32x16 acc[2][2];
        ZERO_ACC(acc);
        gemm_core<2>(acc, Y, 1024, Bt, 1024, 1024, m0, n0, gs);
        float part[2][16];
#pragma unroll
        for (int i = 0; i < 2; ++i) {
#pragma unroll
            for (int rr = 0; rr < 16; ++rr) part[i][rr] = 0.f;
#pragma unroll
            for (int j = 0; j < 2; ++j) {
                int col = n0 + wn * 64 + j * 32 + (l & 31);
                int rbase = m0 + wm * 64 + i * 32 + 4 * hh;
#pragma unroll
                for (int rr = 0; rr < 16; ++rr) {
                    int row = rbase + (rr & 3) + 8 * (rr >> 2);
                    size_t idx = (size_t)row * 1024 + col;
                    float v = hin[idx] + acc[i][j][rr];
                    hout[idx] = v;
                    hb_out[idx] = (bf16)v;
                    part[i][rr] += v * v;
                }
            }
        }
        rowss_flush(part, ss_out, m0, nt);
    }
}

__device__ __forceinline__ void phase_pq(const Params& P, int L, int hsel, const float* ssrow) {
    char* ws = opq(P.ws);
    const bf16* hb = (const bf16*)(ws + (hsel ? OFF_HB1 : OFF_HB0));
    const bf16* Bt = (const bf16*)(ws + OFF_WQ) + (size_t)L * 1024 * 1024;
    bf16* pq = (bf16*)(ws + OFF_PQ);
    const int tid = opaque_tid(), w = tid >> 6, l = tid & 63, hh = l >> 5, wm = w >> 1, wn = w & 1;
    for (int tile = blockIdx.x; tile < 128 * 8; tile += gridDim.x) {
        int mt = tile >> 3, nt = tile & 7;
        int m0 = mt * 128, n0 = nt * 128;
        f32x16 acc[2][2];
        ZERO_ACC(acc);
        gemm_core<0>(acc, hb, 1024, Bt, 1024, 1024, m0, n0, NoScale());
#pragma unroll
        for (int i = 0; i < 2; ++i) {
            int rbase = m0 + wm * 64 + i * 32 + 4 * hh;
#pragma unroll
            for (int rr = 0; rr < 16; ++rr) {
                int row = rbase + (rr & 3) + 8 * (rr >> 2);
                float rs = row_rs8(ssrow, row);
#pragma unroll
                for (int j = 0; j < 2; ++j) {
                    int col = n0 + wn * 64 + j * 32 + (l & 31);
                    pq[(size_t)row * 1024 + col] = (bf16)(acc[i][j][rr] * rs);
                }
            }
        }
    }
}

__device__ __forceinline__ void cswap(int& a, int& b) { int mx = max(a, b), mn = min(a, b); a = mx; b = mn; }
__device__ __forceinline__ void bitonic_sort16(int (&v)[16]) {
#pragma unroll
    for (int k = 2; k <= 16; k <<= 1)
#pragma unroll
        for (int j = k >> 1; j > 0; j >>= 1)
#pragma unroll
            for (int i = 0; i < 16; ++i) {
                int q = i ^ j;
                if (q > i) {
                    if ((i & k) == 0) cswap(v[i], v[q]); else cswap(v[q], v[i]);
                }
            }
}
__device__ __forceinline__ void merge_top16(int (&Lv)[16], const int (&Rv)[16]) {
#pragma unroll
    for (int i = 0; i < 16; ++i) Lv[i] = max(Lv[i], Rv[15 - i]);
#pragma unroll
    for (int j = 8; j > 0; j >>= 1)
#pragma unroll
        for (int i = 0; i < 16; ++i) {
            int q = i ^ j;
            if (q > i) cswap(Lv[i], Lv[q]);
        }
}
__device__ __forceinline__ int f2key(float v, int low, int mask) {
    int b = __float_as_int(v);
    b ^= (b >> 31) & 0x7fffffff;
    return (b & ~mask) | low;
}
__device__ __forceinline__ float key2f(int k, int mask) {
    int b = k & ~mask;
    b ^= (b >> 31) & 0x7fffffff;
    return __int_as_float(b);
}

__device__ __forceinline__ void phase_topk(const Params& P, int L) {
    char* ws = opq(P.ws);
    const bf16* pq = (const bf16*)(ws + OFF_PQ);
    const bf16* skb = (const bf16*)(ws + OFF_SKB) + (size_t)L * 16 * 128 * 64;
    int* ids = (int*)(ws + OFF_IDS);
    float* gates = (float*)(ws + OFF_GATE);
    float* sc = (float*)smem;
    int* Lq = (int*)(smem + 64 * 129 * 4);
    int* Fin = Lq + 4 * 64 * 16;
    const int tid = opaque_tid(), w = tid >> 6, l = tid & 63, r = l & 31, hh = l >> 5;
    for (int item = blockIdx.x; item < TOK / 64; item += gridDim.x) {
        const int t0 = item * 64;
        for (int h = 0; h < 8; ++h) {
            for (int p = 0; p < 2; ++p) {
                const int hp = h * 2 + p;
                f32x16 acc[2];
#pragma unroll
                for (int j = 0; j < 2; ++j)
#pragma unroll
                    for (int rr = 0; rr < 16; ++rr) acc[j][rr] = 0.f;
#pragma unroll
                for (int s = 0; s < 4; ++s) {
                    bf16x8 af = *(const bf16x8*)(skb + ((size_t)hp * 128 + 32 * w + r) * 64 + 16 * s + 8 * hh);
#pragma unroll
                    for (int j = 0; j < 2; ++j) {
                        bf16x8 bfr = *(const bf16x8*)(pq + (size_t)(t0 + 32 * j + r) * 1024 + hp * 64 + 16 * s + 8 * hh);
                        acc[j] = __builtin_amdgcn_mfma_f32_32x32x16_bf16(af, bfr, acc[j], 0, 0, 0);
                    }
                }
#pragma unroll
                for (int j = 0; j < 2; ++j)
#pragma unroll
                    for (int rr = 0; rr < 16; ++rr) {
                        int key = 32 * w + (rr & 3) + 8 * (rr >> 2) + 4 * hh;
                        sc[(32 * j + r) * 129 + key] = acc[j][rr];
                    }
                __syncthreads();
                {
                    const int token = l, quarter = w;
                    int A[16], B[16];
#pragma unroll
                    for (int i = 0; i < 16; ++i) {
                        int n = quarter * 32 + i;
                        A[i] = f2key(sc[token * 129 + n], 127 - n, 127);
                        B[i] = f2key(sc[token * 129 + n + 16], 127 - (n + 16), 127);
                    }
                    bitonic_sort16(A);
                    bitonic_sort16(B);
                    merge_top16(A, B);
#pragma unroll
                    for (int i = 0; i < 16; ++i) Lq[(quarter * 64 + token) * 16 + i] = A[i];
                    __syncthreads();
                    if ((quarter & 1) == 0) {
#pragma unroll
                        for (int i = 0; i < 16; ++i) B[i] = Lq[((quarter + 1) * 64 + token) * 16 + i];
                        merge_top16(A, B);
                        if (quarter == 2) {
#pragma unroll
                            for (int i = 0; i < 16; ++i) Lq[(2 * 64 + token) * 16 + i] = A[i];
                        }
                    }
                    __syncthreads();
                    if (quarter == 0) {
#pragma unroll
                        for (int i = 0; i < 16; ++i) B[i] = Lq[(2 * 64 + token) * 16 + i];
                        merge_top16(A, B);
#pragma unroll
                        for (int i = 0; i < 16; ++i) Fin[(p * 64 + token) * 16 + i] = A[i];
                    }
                    __syncthreads();
                }
            }
            if (w == 0) {
                const int token = l;
                float s1[16], s2[16];
#pragma unroll
                for (int i = 0; i < 16; ++i) {
                    s1[i] = key2f(Fin[(0 * 64 + token) * 16 + i], 127);
                    s2[i] = key2f(Fin[(1 * 64 + token) * 16 + i], 127);
                }
                int Lc[16], X[16];
#pragma unroll
                for (int b2 = 0; b2 < 16; ++b2) Lc[b2] = f2key(s1[0] + s2[b2], 255 - b2, 255);
#pragma unroll
                for (int a = 1; a < 16; ++a) X[a - 1] = f2key(s1[a] + s2[0], 255 - a * 16, 255);
                X[15] = INT_MIN;
                merge_top16(Lc, X);
                {
                    int c = 0;
#pragma unroll
                    for (int b2 = 1; b2 <= 7; ++b2) X[c++] = f2key(s1[1] + s2[b2], 255 - (16 + b2), 255);
#pragma unroll
                    for (int b2 = 1; b2 <= 4; ++b2) X[c++] = f2key(s1[2] + s2[b2], 255 - (32 + b2), 255);
#pragma unroll
                    for (int b2 = 1; b2 <= 3; ++b2) X[c++] = f2key(s1[3] + s2[b2], 255 - (48 + b2), 255);
#pragma unroll
                    for (int b2 = 1; b2 <= 2; ++b2) X[c++] = f2key(s1[4] + s2[b2], 255 - (64 + b2), 255);
                }
                bitonic_sort16(X);
                merge_top16(Lc, X);
                X[0] = f2key(s1[5] + s2[1], 255 - (80 + 1), 255);
                X[1] = f2key(s1[6] + s2[1], 255 - (96 + 1), 255);
                X[2] = f2key(s1[7] + s2[1], 255 - (112 + 1), 255);
#pragma unroll
                for (int i = 3; i < 16; ++i) X[i] = INT_MIN;
                merge_top16(Lc, X);
                float mx = key2f(Lc[0], 255);
                float ev[16], sum = 0.f;
#pragma unroll
                for (int k = 0; k < 16; ++k) { ev[k] = __expf(key2f(Lc[k], 255) - mx); sum += ev[k]; }
                float inv = 1.f / sum;
                size_t ob = (size_t)(t0 + token) * 128 + h * 16;
#pragma unroll
                for (int k = 0; k < 16; ++k) {
                    int cidx = 255 - (Lc[k] & 255);
                    int a = cidx >> 4, b2 = cidx & 15;
                    int i1 = 127 - (Fin[(0 * 64 + token) * 16 + a] & 127);
                    int i2 = 127 - (Fin[(1 * 64 + token) * 16 + b2] & 127);
                    ids[ob + k] = i1 * 128 + i2;
                    gates[ob + k] = ev[k] * inv;
                }
            }
            __syncthreads();
        }
    }
}

__device__ __forceinline__ float gelu_exact(float x) { return 0.5f * x * (1.f + erff(x * 0.70710678118654752f)); }

__device__ __forceinline__ void dec16(const u32x4& v, float (&f)[16]) {
    f32x2 t;
    t = __builtin_amdgcn_cvt_pk_f32_fp8((int)v.x, false); f[0] = t.x; f[1] = t.y;
    t = __builtin_amdgcn_cvt_pk_f32_fp8((int)v.x, true);  f[2] = t.x; f[3] = t.y;
    t = __builtin_amdgcn_cvt_pk_f32_fp8((int)v.y, false); f[4] = t.x; f[5] = t.y;
    t = __builtin_amdgcn_cvt_pk_f32_fp8((int)v.y, true);  f[6] = t.x; f[7] = t.y;
    t = __builtin_amdgcn_cvt_pk_f32_fp8((int)v.z, false); f[8] = t.x; f[9] = t.y;
    t = __builtin_amdgcn_cvt_pk_f32_fp8((int)v.z, true);  f[10] = t.x; f[11] = t.y;
    t = __builtin_amdgcn_cvt_pk_f32_fp8((int)v.w, false); f[12] = t.x; f[13] = t.y;
    t = __builtin_amdgcn_cvt_pk_f32_fp8((int)v.w, true);  f[14] = t.x; f[15] = t.y;
}

__device__ __forceinline__ void phase_gather_u(const Params& P, int L, const float* ss_ffn) {
    char* ws = opq(P.ws);
    const unsigned char* U8 = (const unsigned char*)(ws + OFF_UB) + (size_t)L * NEXP * DM;
    float* part = (float*)(ws + OFF_PART);
    const int* ids = (const int*)(ws + OFF_IDS);
    const float* hin = opq(P.out);
    const int tid = opaque_tid(), w = tid >> 6, l = tid & 63, c = l & 7, gq = l >> 3;
    const int j = blockIdx.x & 7, rk = blockIdx.x >> 3, nb = gridDim.x >> 3;
    if (rk >= nb) return;
    float gv[16];
    {
        const float4* g4 = (const float4*)(P.norm_ffn_g + L * 1024 + 128 * j + 16 * c);
#pragma unroll
        for (int q = 0; q < 4; ++q) { float4 t = g4[q]; gv[4 * q] = t.x; gv[4 * q + 1] = t.y; gv[4 * q + 2] = t.z; gv[4 * q + 3] = t.w; }
    }
    const unsigned char* ubase = U8 + (size_t)j * NEXP * 128 + c * 16;
    for (int t = rk * 4 + w; t < TOK; t += nb * 4) {
        float rs = row_rs8(ss_ffn, t);
        float xv[16];
        {
            const float4* h4 = (const float4*)(hin + (size_t)t * 1024 + 128 * j + 16 * c);
#pragma unroll
            for (int q = 0; q < 4; ++q) { float4 v = h4[q]; xv[4 * q] = v.x * rs * gv[4 * q]; xv[4 * q + 1] = v.y * rs * gv[4 * q + 1]; xv[4 * q + 2] = v.z * rs * gv[4 * q + 2]; xv[4 * q + 3] = v.w * rs * gv[4 * q + 3]; }
        }
        int idv[16];
        {
            const int4* i4 = (const int4*)(ids + (size_t)t * 128 + 16 * gq);
#pragma unroll
            for (int q = 0; q < 4; ++q) { int4 v = i4[q]; idv[4 * q] = v.x; idv[4 * q + 1] = v.y; idv[4 * q + 2] = v.z; idv[4 * q + 3] = v.w; }
        }
        u32x4 rv[16];
#pragma unroll
        for (int i = 0; i < 16; ++i) rv[i] = *(const u32x4*)(ubase + (size_t)idv[i] * 128);
        float pr[16];
#pragma unroll
        for (int i = 0; i < 16; ++i) {
            float f[16];
            dec16(rv[i], f);
            float s0 = 0.f, s1 = 0.f;
#pragma unroll
            for (int e = 0; e < 16; e += 2) { s0 += f[e] * xv[e]; s1 += f[e + 1] * xv[e + 1]; }
            float sacc = s0 + s1;
            sacc += __shfl_xor(sacc, 1); sacc += __shfl_xor(sacc, 2); sacc += __shfl_xor(sacc, 4);
            pr[i] = sacc;
        }
        if (c == 0) {
            float4* o4 = (float4*)(part + ((size_t)j * TOK + t) * 128 + 16 * gq);
#pragma unroll
            for (int q = 0; q < 4; ++q) o4[q] = make_float4(pr[4 * q], pr[4 * q + 1], pr[4 * q + 2], pr[4 * q + 3]);
        }
    }
}

__device__ __forceinline__ void phase_gather_act(const Params& P, int L) {
    char* ws = opq(P.ws);
    const float* part = (const float*)(ws + OFF_PART);
    const int* ids = (const int*)(ws + OFF_IDS);
    float* gates = (float*)(ws + OFF_GATE);
    const float* uinv = (const float*)(ws + OFF_TSC) + L * NEXP;
    const float* vinv = (const float*)(ws + OFF_TSC) + (2 + L) * NEXP;
    const int tid = opaque_tid(), w = tid >> 6, l = tid & 63;
    for (int t = blockIdx.x * 4 + w; t < TOK; t += gridDim.x * 4) {
#pragma unroll
        for (int hsel = 0; hsel < 2; ++hsel) {
            int k = l + 64 * hsel;
            float sacc = 0.f;
#pragma unroll
            for (int j = 0; j < 8; ++j) sacc += part[((size_t)j * TOK + t) * 128 + k];
            int id = ids[(size_t)t * 128 + k];
            float pre = sacc * uinv[id];
            gates[(size_t)t * 128 + k] = gates[(size_t)t * 128 + k] * gelu_exact(pre) * vinv[id];
        }
    }
}

__device__ __forceinline__ void phase_gather_v(const Params& P, int L, int hsel, float* ss_ple) {
    char* ws = opq(P.ws);
    bf16* hb_out = (bf16*)(ws + (hsel ? OFF_HB1 : OFF_HB0));
    const unsigned char* V8 = (const unsigned char*)(ws + OFF_VB) + (size_t)L * NEXP * DM;
    const int* ids = (const int*)(ws + OFF_IDS);
    const float* act = (const float*)(ws + OFF_GATE);
    float* hio = opq(P.out);
    const int tid = opaque_tid(), w = tid >> 6, l = tid & 63, c = l & 7, gq = l >> 3;
    const int j = blockIdx.x & 7, rk = blockIdx.x >> 3, nb = gridDim.x >> 3;
    if (rk >= nb) return;
    const unsigned char* vbase = V8 + (size_t)j * NEXP * 128 + c * 16;
    for (int t = rk * 4 + w; t < TOK; t += nb * 4) {
        int idv[16];
        float av[16];
        {
            const int4* i4 = (const int4*)(ids + (size_t)t * 128 + 16 * gq);
            const float4* a4 = (const float4*)(act + (size_t)t * 128 + 16 * gq);
#pragma unroll
            for (int q = 0; q < 4; ++q) {
                int4 v = i4[q]; idv[4 * q] = v.x; idv[4 * q + 1] = v.y; idv[4 * q + 2] = v.z; idv[4 * q + 3] = v.w;
                float4 a = a4[q]; av[4 * q] = a.x; av[4 * q + 1] = a.y; av[4 * q + 2] = a.z; av[4 * q + 3] = a.w;
            }
        }
        u32x4 rv[16];
#pragma unroll
        for (int i = 0; i < 16; ++i) rv[i] = *(const u32x4*)(vbase + (size_t)idv[i] * 128);
        float acc[16];
#pragma unroll
        for (int e = 0; e < 16; ++e) acc[e] = 0.f;
#pragma unroll
        for (int i = 0; i < 16; ++i) {
            float f[16];
            dec16(rv[i], f);
#pragma unroll
            for (int e = 0; e < 16; ++e) acc[e] += av[i] * f[e];
        }
#pragma unroll
        for (int e = 0; e < 16; ++e) {
            float v = acc[e];
            v += __shfl_xor(v, 8); v += __shfl_xor(v, 16); v += __shfl_xor(v, 32);
            acc[e] = v;
        }
        float ssq = 0.f;
        if (gq == 0) {
            float4* h4 = (float4*)(hio + (size_t)t * 1024 + 128 * j + 16 * c);
            float hv[16];
#pragma unroll
            for (int q = 0; q < 4; ++q) {
                float4 v = h4[q];
                hv[4 * q] = v.x + acc[4 * q]; hv[4 * q + 1] = v.y + acc[4 * q + 1]; hv[4 * q + 2] = v.z + acc[4 * q + 2]; hv[4 * q + 3] = v.w + acc[4 * q + 3];
                h4[q] = make_float4(hv[4 * q], hv[4 * q + 1], hv[4 * q + 2], hv[4 * q + 3]);
            }
#pragma unroll
            for (int e = 0; e < 16; ++e) ssq += hv[e] * hv[e];
            u32x4 b0 = {pack2(hv[0], hv[1]), pack2(hv[2], hv[3]), pack2(hv[4], hv[5]), pack2(hv[6], hv[7])};
            u32x4 b1 = {pack2(hv[8], hv[9]), pack2(hv[10], hv[11]), pack2(hv[12], hv[13]), pack2(hv[14], hv[15])};
            u32x4* hb4 = (u32x4*)(hb_out + (size_t)t * 1024 + 128 * j + 16 * c);
            hb4[0] = b0; hb4[1] = b1;
        }
        ssq += __shfl_xor(ssq, 1); ssq += __shfl_xor(ssq, 2); ssq += __shfl_xor(ssq, 4);
        if (l == 0) ss_ple[(size_t)t * 8 + j] = ssq;
    }
}

__device__ __forceinline__ void phase_ple(const Params& P, int L, int hsel, const float* ss_ple, float* ss_out) {
    char* ws = opq(P.ws);
    const bf16* hb_in = (const bf16*)(ws + (hsel ? OFF_HB1 : OFF_HB0));
    bf16* hb_out = (bf16*)(ws + (hsel ? OFF_HB0 : OFF_HB1));
    float* hio = opq(P.out);
    const float* pin = opq(P.p) + (size_t)L * TOK * 256;
    const bf16* Wg = (const bf16*)(ws + OFF_WG) + (size_t)L * 1024 * 1024;
    const bf16* Wp = (const bf16*)(ws + OFF_WP) + (size_t)L * 1024 * 256;
    const int tid = opaque_tid(), w = tid >> 6, l = tid & 63, hh = l >> 5, wm = w >> 1, wn = w & 1;
    for (int tile = blockIdx.x; tile < 128 * 8; tile += gridDim.x) {
        int mt = tile >> 3, nt = tile & 7;
        int m0 = mt * 128, n0 = nt * 128;
        f32x16 acc1[2][2], acc2[2][2];
        ZERO_ACC(acc1);
        ZERO_ACC(acc2);
        gemm_core<0>(acc1, hb_in, 1024, Wg, 1024, 1024, m0, n0, NoScale());
        gemm_core<1>(acc2, pin, 256, Wp, 256, 256, m0, n0, NoScale());
        float part[2][16];
#pragma unroll
        for (int i = 0; i < 2; ++i) {
            int rbase = m0 + wm * 64 + i * 32 + 4 * hh;
#pragma unroll
            for (int rr = 0; rr < 16; ++rr) {
                int row = rbase + (rr & 3) + 8 * (rr >> 2);
                float rs = row_rs8(ss_ple, row);
                float ps = 0.f;
#pragma unroll
                for (int j = 0; j < 2; ++j) {
                    int col = n0 + wn * 64 + j * 32 + (l & 31);
                    size_t idx = (size_t)row * 1024 + col;
                    float gte = 1.f / (1.f + __expf(-acc1[i][j][rr] * rs));
                    float v = hio[idx] + gte * acc2[i][j][rr];
                    hio[idx] = v;
                    hb_out[idx] = (bf16)v;
                    ps += v * v;
                }
                part[i][rr] = ps;
            }
        }
        rowss_flush(part, ss_out, m0, nt);
    }
}

__device__ __forceinline__ void phase_final(const Params& P, const float* ss) {
    float* hio = opq(P.out);
    const int tid = opaque_tid(), w = tid >> 6, l = tid & 63;
    const float4* g4 = (const float4*)P.final_norm_g;
    for (int t = blockIdx.x * 4 + w; t < TOK; t += gridDim.x * 4) {
        float rs = row_rs8(ss, t);
        float4* o4 = (float4*)(hio + (size_t)t * 1024);
#pragma unroll
        for (int i = 0; i < 4; ++i) {
            float4 v = o4[i * 64 + l], g = g4[i * 64 + l];
            v.x *= rs * g.x; v.y *= rs * g.y; v.z *= rs * g.z; v.w *= rs * g.w;
            o4[i * 64 + l] = v;
        }
    }
}

#define XB_TMO      128
#define XB_XCNT(j)  (256  + 64 * (j))
#define XB_XSUB(j)  (1280 + 64 * (j))
#define XB_XGEN(j)  (2304 + 64 * (j))
#define XB_TOP      3328
#define XB_TOPGEN   3392
#define XCD_BAR_WORDS 3456
#define XB_SPIN_CAP (1u << 22)
__device__ __forceinline__ unsigned xb_ld(unsigned* p) { return __hip_atomic_load(p, __ATOMIC_RELAXED, __HIP_MEMORY_SCOPE_AGENT); }
__device__ __forceinline__ unsigned xb_add(unsigned* p, unsigned v) { return __hip_atomic_fetch_add(p, v, __ATOMIC_RELAXED, __HIP_MEMORY_SCOPE_AGENT); }
__device__ __forceinline__ unsigned xb_xcc_id() { return (unsigned)__builtin_amdgcn_s_getreg((3 << 11) | 20) & 0xFu; }
#define XB_SPIN(cond, bar) do { unsigned _sp = 0; while (cond) { __builtin_amdgcn_s_sleep(1); \
    if ((++_sp & 255u) == 0u) { if (xb_ld(&(bar)[XB_TMO])) break; if (_sp > XB_SPIN_CAP) { atomicAdd(&(bar)[XB_TMO], 1u); break; } } } } while (0)
struct XcdBarrier { unsigned* bar; unsigned x, nloc, nx; };
__device__ __forceinline__ XcdBarrier xcd_barrier_post(unsigned* bar) {
    XcdBarrier b; b.bar = bar; b.x = xb_xcc_id(); b.nloc = 0u; b.nx = 0u;
    if (threadIdx.x == 0) (void)xb_add(&bar[XB_XCNT(b.x)], 1u);
    return b;
}
__device__ __forceinline__ void xcd_barrier_complete(unsigned* bar, unsigned x, unsigned& nloc, unsigned& nx) {
    const unsigned G = gridDim.x;
    unsigned sum, cnt, mine, sp = 0u;
    for (;;) {
        sum = 0u; cnt = 0u; mine = 0u;
#pragma unroll
        for (unsigned j = 0; j < 16; ++j) { const unsigned c = xb_ld(&bar[XB_XCNT(j)]); sum += c; cnt += (c > 0u) ? 1u : 0u; mine = (j == x) ? c : mine; }
        if (sum == G) break;
        __builtin_amdgcn_s_sleep(1);
        if ((++sp & 255u) == 0u) { if (xb_ld(&bar[XB_TMO])) break; if (sp > XB_SPIN_CAP) { atomicAdd(&bar[XB_TMO], 1u); break; } }
    }
    nloc = mine > 0u ? mine : 1u; nx = cnt > 0u ? cnt : 1u;
}
__device__ __forceinline__ void grid_barrier(XcdBarrier& b) {
    asm volatile("s_waitcnt vmcnt(0)" ::: "memory");
    __syncthreads();
    if (threadIdx.x == 0) {
        unsigned* bar = b.bar;
        __builtin_amdgcn_s_waitcnt(0);
        if (b.nloc == 0u) xcd_barrier_complete(bar, b.x, b.nloc, b.nx);
        const unsigned nloc = b.nloc, nx = b.nx;
        const unsigned old = xb_add(&bar[XB_XSUB(b.x)], 1u);
        const unsigned gen = old / nloc;
        if (old + 1u == (gen + 1u) * nloc) {
            __builtin_amdgcn_fence(__ATOMIC_RELEASE, "agent");
            asm volatile("s_waitcnt vmcnt(0)" ::: "memory");
            const unsigned og = xb_add(&bar[XB_TOP], 1u);
            const unsigned tg = og / nx;
            if (og + 1u == (tg + 1u) * nx) xb_add(&bar[XB_TOPGEN], 1u);
            else XB_SPIN(xb_ld(&bar[XB_TOPGEN]) == tg, bar);
            __builtin_amdgcn_fence(__ATOMIC_ACQUIRE, "agent");
            xb_add(&bar[XB_XGEN(b.x)], 1u);
            asm volatile("s_waitcnt vmcnt(0)" ::: "memory");
        } else {
            XB_SPIN(xb_ld(&bar[XB_XGEN(b.x)]) == gen, bar);
            __builtin_amdgcn_fence(__ATOMIC_ACQUIRE, "agent");
            asm volatile("s_waitcnt vmcnt(0)" ::: "memory");
        }
    }
    __syncthreads();
}

__global__ void __launch_bounds__(NTHR, 2) hymba_megakernel(Params P) {
    cg::grid_group grid = cg::this_grid();
    char* ws = opq(P.ws);
    float* ssa = (float*)(ws + OFF_SSA);
    XcdBarrier bar = xcd_barrier_post((unsigned*)(ws + OFF_BAR));
#define BAR() do { grid_barrier(bar); if (DUP == 20) grid_barrier(bar); } while (0)
    phase0(P);
    if (DUP == 0) { asm volatile("s_waitcnt vmcnt(0)" ::: "memory"); __syncthreads(); grid_barrier(bar); phase0(P); }
    asm volatile("s_waitcnt vmcnt(0)" ::: "memory");
    __syncthreads();
    grid.sync();
    BAR();
    int cur = 0;
    for (int L = 0; L < 2; ++L) {
        const float* ss_mix = (L == 0) ? ssa : (ssa + 3 * TOK * 8);
        float* ss_ffn = ssa + (size_t)(1 + L) * TOK * 8;
        float* ss_next = (L == 0) ? (ssa + 3 * TOK * 8) : (ssa + 4 * TOK * 8);
        float* ss_ple = ssa + (size_t)(5 + L) * TOK * 8;
        phase_proj(P, L, cur, ss_mix);
        BAR();
        if (DUP == 1) { phase_proj(P, L, cur, ss_mix); BAR(); }
        phase_mla_up(P, L);
        BAR();
        if (DUP == 2) { phase_mla_up(P, L); BAR(); }
        phase_attn(P, L, 0);
        BAR();
        if (DUP == 3) { phase_attn(P, L, 1); BAR(); }
        phase_wo(P, L, cur ^ 1, ss_ffn);
        BAR();
        if (DUP == 4 && L == 0) { phase_wo(P, L, cur ^ 1, ss_ffn); BAR(); }
        phase_pq(P, L, cur ^ 1, ss_ffn);
        BAR();
        if (DUP == 5) { phase_pq(P, L, cur ^ 1, ss_ffn); BAR(); }
        phase_topk(P, L);
        BAR();
        if (DUP == 6) { phase_topk(P, L); BAR(); }
        phase_gather_u(P, L, ss_ffn);
        BAR();
        if (DUP == 7) { phase_gather_u(P, L, ss_ffn); BAR(); }
        phase_gather_act(P, L);
        BAR();
        phase_gather_v(P, L, cur, ss_ple);
        BAR();
        phase_ple(P, L, cur, ss_ple, ss_next);
        BAR();
        cur ^= 1;
    }
    phase_final(P, ssa + 4 * TOK * 8);
}

extern "C" void kernel_launch(void* const* d_in, const int* in_sizes, int n_in, void* d_out, int out_size, void* d_ws,
                              size_t ws_size, hipStream_t stream) {
    static int grid_blocks = 0;
    if (!grid_blocks) {
        int dev = 0, cus = 0, per_cu = 0;
        hipGetDevice(&dev);
        hipDeviceGetAttribute(&cus, hipDeviceAttributeMultiprocessorCount, dev);
        hipOccupancyMaxActiveBlocksPerMultiprocessor(&per_cu, hymba_megakernel, NTHR, 0);
        if (per_cu > 2) per_cu = 2;
        if (per_cu < 1) per_cu = 1;
        grid_blocks = cus * per_cu;
        if (ws_size < WS_END) fprintf(stderr, "workspace too small: %zu < %zu\n", ws_size, (size_t)WS_END);
    }
    Params P{};
    P.x = (const float*)d_in[0]; P.p = (const float*)d_in[1]; P.pos = (const int*)d_in[2];
    P.norm_mix_g = (const float*)d_in[3]; P.w_in = (const float*)d_in[4]; P.b_forget = (const float*)d_in[5];
    P.mla_q_norm_g = (const float*)d_in[6]; P.w_uq = (const float*)d_in[7]; P.mla_kv_norm_g = (const float*)d_in[8];
    P.w_ukv = (const float*)d_in[9]; P.mix_out_norm_g = (const float*)d_in[10]; P.w_o = (const float*)d_in[11];
    P.norm_ffn_g = (const float*)d_in[12]; P.w_query = (const float*)d_in[13]; P.sub_keys = (const float*)d_in[14];
    P.peer_u = (const float*)d_in[15]; P.peer_v = (const float*)d_in[16]; P.w_ple = (const float*)d_in[17];
    P.ple_norm_g = (const float*)d_in[18]; P.w_ple_gate = (const float*)d_in[19]; P.final_norm_g = (const float*)d_in[20];
    P.out = (float*)d_out; P.ws = (char*)d_ws;
    hipMemsetAsync((char*)d_ws + OFF_BAR, 0, 16384 + 4096, stream);
    void* args[] = {&P};
    hipError_t e = hipLaunchCooperativeKernel((void*)hymba_megakernel, dim3(grid_blocks), dim3(NTHR), args, 0, stream);
    if (e != hipSuccess) fprintf(stderr, "cooperative launch failed: %s (grid %d)\n", hipGetErrorString(e), grid_blocks);
}
```

```cpp
#include <hip/hip_runtime.h>
#include <hip/hip_cooperative_groups.h>
#include <cstdio>
#include <cstdint>
#include <math.h>
#include <climits>
namespace cg = cooperative_groups;

typedef __bf16 bf16;
typedef __bf16 bf16x8 __attribute__((ext_vector_type(8)));
typedef __bf16 bf16x4 __attribute__((ext_vector_type(4)));
typedef __bf16 bf16x2 __attribute__((ext_vector_type(2)));
typedef float f32x16 __attribute__((ext_vector_type(16)));
typedef float f32x4 __attribute__((ext_vector_type(4)));
typedef float f32x2 __attribute__((ext_vector_type(2)));
typedef unsigned u32x4 __attribute__((ext_vector_type(4)));
typedef unsigned u32x2 __attribute__((ext_vector_type(2)));

#define SEQ 2048
#define BATCH 8
#define TOK 16384
#define DM 1024
#define IN_W 1956
#define NEXP 16384
#define EPSF 1e-6f
#define LOG2E 1.4426950408889634f
#define NTHR 256
#define LDS_BYTES 65536
#ifndef DUP
#define DUP -1
#endif

constexpr size_t MBy = 1ull << 20;
constexpr size_t OFF_UB = 0;
constexpr size_t OFF_VB = 32 * MBy;
constexpr size_t OFF_PART = 64 * MBy;
constexpr size_t OFF_WIN = 128 * MBy;
constexpr size_t OFF_WO = 136 * MBy;
constexpr size_t OFF_WQ = 140 * MBy;
constexpr size_t OFF_WG = 144 * MBy;
constexpr size_t OFF_WP = 148 * MBy;
constexpr size_t OFF_WUQ = 149 * MBy;
constexpr size_t OFF_WUKV = 149 * MBy + 512 * 1024;
constexpr size_t OFF_SKB = 150 * MBy;
constexpr size_t OFF_CS = 151 * MBy;
constexpr size_t OFF_TSC = 153 * MBy;
constexpr size_t OFF_SSA = 154 * MBy;
constexpr size_t OFF_SSP = 157 * MBy;
constexpr size_t OFF_HB0 = 158 * MBy;
constexpr size_t OFF_HB1 = 190 * MBy;
constexpr size_t OFF_FQ = 222 * MBy;
constexpr size_t OFF_FK = 230 * MBy;
constexpr size_t OFF_FVT = 238 * MBy;
constexpr size_t OFF_SQ = 246 * MBy;
constexpr size_t OFF_SKK = 254 * MBy;
constexpr size_t OFF_SVT = 262 * MBy;
constexpr size_t OFF_CQ = 270 * MBy;
constexpr size_t OFF_CKV = 278 * MBy;
constexpr size_t OFF_FLOG = 282 * MBy;
constexpr size_t OFF_CUMF = 283 * MBy;
constexpr size_t OFF_MQ = 284 * MBy;
constexpr size_t OFF_MK = 296 * MBy;
constexpr size_t OFF_MVT = 308 * MBy;
constexpr size_t OFF_Y = 324 * MBy;
constexpr size_t OFF_PQ = 356 * MBy;
constexpr size_t OFF_IDS = 388 * MBy;
constexpr size_t OFF_GATE = 396 * MBy;
constexpr size_t OFF_BAR = 404 * MBy;
constexpr size_t OFF_CNT = OFF_BAR + 16384;
constexpr size_t OFF_SSY = 405 * MBy;
constexpr size_t WS_END = 408 * MBy;

struct Params {
    const float* x; const float* p; const int* pos;
    const float* norm_mix_g; const float* w_in; const float* b_forget; const float* mla_q_norm_g; const float* w_uq;
    const float* mla_kv_norm_g; const float* w_ukv; const float* mix_out_norm_g; const float* w_o; const float* norm_ffn_g;
    const float* w_query; const float* sub_keys; const float* peer_u; const float* peer_v; const float* w_ple;
    const float* ple_norm_g; const float* w_ple_gate; const float* final_norm_g;
    float* out; char* ws;
};

__shared__ __attribute__((aligned(16))) char smem[LDS_BYTES];

__device__ __forceinline__ int opaque_tid() { int t = threadIdx.x; asm volatile("" : "+v"(t)); return t; }
template <typename T> __device__ __forceinline__ T* opq(T* p) { size_t z = 0; asm volatile("" : "+s"(z)); return (T*)((char*)p + z); }

__device__ __forceinline__ unsigned pack2(float a, float b) {
    f32x2 v = {a, b};
    bf16x2 r = __builtin_convertvector(v, bf16x2);
    return __builtin_bit_cast(unsigned, r);
}
__device__ __forceinline__ float bflo(unsigned u) { return __uint_as_float(u << 16); }
__device__ __forceinline__ float bfhi(unsigned u) { return __uint_as_float(u & 0xffff0000u); }
__device__ __forceinline__ float wave_sum(float v) {
#pragma unroll
    for (int o = 32; o > 0; o >>= 1) v += __shfl_xor(v, o);
    return v;
}
template <int CTRL> __device__ __forceinline__ float dpp_add(float v) {
    return v + __builtin_bit_cast(float, __builtin_amdgcn_update_dpp(0, __builtin_bit_cast(int, v), CTRL, 0xf, 0xf, true));
}
__device__ __forceinline__ float sum8_dpp(float v) { v = dpp_add<0xB1>(v); v = dpp_add<0x4E>(v); v = dpp_add<0x141>(v); return v; }
__device__ __forceinline__ float sumg_dpp(float v) {
    v = dpp_add<0x128>(v);
    float a = v, b = v;
    asm volatile("s_nop 1\n\tv_permlane16_swap_b32 %0, %1\n\ts_nop 1" : "+v"(a), "+v"(b));
    v = a + b;
    a = v; b = v;
    asm volatile("s_nop 1\n\tv_permlane32_swap_b32 %0, %1\n\ts_nop 1" : "+v"(a), "+v"(b));
    return a + b;
}
__device__ __forceinline__ float fexp2(float x) { return __builtin_amdgcn_exp2f(x); }
__device__ __forceinline__ float flog2(float x) { return __builtin_amdgcn_logf(x); }
__device__ __forceinline__ float log_sigmoid_f(float z) { return fminf(z, 0.f) - log1pf(expf(-fabsf(z))); }

struct WJob { const float* src; int lds; int K; int Np; bf16* dst; const float* gain; int map; };

__device__ __forceinline__ int src_col_map(int map, int c) {
    if (map == 0) return c;
    if (map == 1) {
        if (c < 768) return c;
        if (c < 1952) return c + 4;
        if (c < 1956) return c - 1952 + 768;
        return -1;
    }
    if (c < 256) return 192 * (c >> 6) + (c & 63);
    int e = c - 256;
    return 192 * (e >> 7) + 64 + (e & 127);
}

__device__ __forceinline__ void wconv_tile(const WJob& j, int tile) {
    float* tl = (float*)smem;
    int ktiles = j.K >> 5;
    int nt = tile / ktiles, kt = tile % ktiles;
    int n0 = nt * 32, k0 = kt * 32;
    int tx = opaque_tid() & 31, ty = opaque_tid() >> 5;
    int sc = src_col_map(j.map, n0 + tx);
#pragma unroll
    for (int i = 0; i < 4; ++i) {
        int k = k0 + ty + 8 * i;
        float v = 0.f;
        if (sc >= 0) v = j.src[(size_t)k * j.lds + sc] * (j.gain ? j.gain[k] : 1.f);
        tl[(ty + 8 * i) * 33 + tx] = v;
    }
    __syncthreads();
#pragma unroll
    for (int i = 0; i < 4; ++i) {
        int n = n0 + ty + 8 * i;
        j.dst[(size_t)n * j.K + k0 + tx] = (bf16)tl[tx * 33 + ty + 8 * i];
    }
    __syncthreads();
}

__device__ __forceinline__ void phase0(const Params& P) {
    char* ws = opq(P.ws);
    const int G = gridDim.x, bid = blockIdx.x, tid = opaque_tid();
    {
        const int w = tid >> 6, l = tid & 63;
        float* tsc = (float*)(ws + OFF_TSC);
        for (int it = bid * 4 + w; it < 4 * NEXP; it += G * 4) {
            int tb = it >> 14, e = it & (NEXP - 1);
            const float* src = (tb < 2 ? P.peer_u : P.peer_v) + ((size_t)(tb & 1) * NEXP + e) * DM + l * 16;
            unsigned char* dst = (unsigned char*)(ws + (tb < 2 ? OFF_UB : OFF_VB)) + (size_t)(tb & 1) * NEXP * DM;
            float4 a = ((const float4*)src)[0], b = ((const float4*)src)[1], c = ((const float4*)src)[2], d = ((const float4*)src)[3];
            if (tb < 2) {
                const float4* g4 = (const float4*)(P.norm_ffn_g + (tb & 1) * 1024 + l * 16);
                float4 g0 = g4[0], g1 = g4[1], g2 = g4[2], g3 = g4[3];
                a.x *= g0.x; a.y *= g0.y; a.z *= g0.z; a.w *= g0.w; b.x *= g1.x; b.y *= g1.y; b.z *= g1.z; b.w *= g1.w;
                c.x *= g2.x; c.y *= g2.y; c.z *= g2.z; c.w *= g2.w; d.x *= g3.x; d.y *= g3.y; d.z *= g3.z; d.w *= g3.w;
            }
            float am = fmaxf(fmaxf(fmaxf(fabsf(a.x), fabsf(a.y)), fmaxf(fabsf(a.z), fabsf(a.w))), fmaxf(fmaxf(fabsf(b.x), fabsf(b.y)), fmaxf(fabsf(b.z), fabsf(b.w))));
            am = fmaxf(am, fmaxf(fmaxf(fmaxf(fabsf(c.x), fabsf(c.y)), fmaxf(fabsf(c.z), fabsf(c.w))), fmaxf(fmaxf(fabsf(d.x), fabsf(d.y)), fmaxf(fabsf(d.z), fabsf(d.w)))));
#pragma unroll
            for (int o = 32; o > 0; o >>= 1) am = fmaxf(am, __shfl_xor(am, o));
            int eb = ((__float_as_int(am) >> 23) & 0xff) - 127;
            eb = max(-100, min(100, eb));
            if (am == 0.f) eb = 7;
            float sc = __int_as_float((127 + 7 - eb) << 23), isc = __int_as_float((127 + eb - 7) << 23);
            int w0 = 0, w1 = 0, w2 = 0, w3 = 0;
            w0 = __builtin_amdgcn_cvt_pk_fp8_f32(a.x * sc, a.y * sc, w0, false); w0 = __builtin_amdgcn_cvt_pk_fp8_f32(a.z * sc, a.w * sc, w0, true);
            w1 = __builtin_amdgcn_cvt_pk_fp8_f32(b.x * sc, b.y * sc, w1, false); w1 = __builtin_amdgcn_cvt_pk_fp8_f32(b.z * sc, b.w * sc, w1, true);
            w2 = __builtin_amdgcn_cvt_pk_fp8_f32(c.x * sc, c.y * sc, w2, false); w2 = __builtin_amdgcn_cvt_pk_fp8_f32(c.z * sc, c.w * sc, w2, true);
            w3 = __builtin_amdgcn_cvt_pk_fp8_f32(d.x * sc, d.y * sc, w3, false); w3 = __builtin_amdgcn_cvt_pk_fp8_f32(d.z * sc, d.w * sc, w3, true);
            u32x4 o4 = {(unsigned)w0, (unsigned)w1, (unsigned)w2, (unsigned)w3};
            *(u32x4*)(dst + ((size_t)(l >> 3) * NEXP + e) * 128 + (l & 7) * 16) = o4;
            if (l == 0) tsc[tb * NEXP + e] = isc;
        }
    }
    {
        for (int L = 0; L < 2; ++L) {
            WJob jobs[7];
            jobs[0] = {P.w_in + (size_t)L * 1024 * IN_W, IN_W, 1024, 2048, (bf16*)(ws + OFF_WIN) + (size_t)L * 2048 * 1024, P.norm_mix_g + L * 1024, 1};
            jobs[1] = {P.w_o + (size_t)L * 1024 * 1024, 1024, 1024, 1024, (bf16*)(ws + OFF_WO) + (size_t)L * 1024 * 1024, P.mix_out_norm_g + L * 1024, 0};
            jobs[2] = {P.w_query + (size_t)L * 1024 * 1024, 1024, 1024, 1024, (bf16*)(ws + OFF_WQ) + (size_t)L * 1024 * 1024, P.norm_ffn_g + L * 1024, 0};
            jobs[3] = {P.w_ple_gate + (size_t)L * 1024 * 1024, 1024, 1024, 1024, (bf16*)(ws + OFF_WG) + (size_t)L * 1024 * 1024, P.ple_norm_g + L * 1024, 0};
            jobs[4] = {P.w_ple + (size_t)L * 256 * 1024, 1024, 256, 1024, (bf16*)(ws + OFF_WP) + (size_t)L * 1024 * 256, nullptr, 0};
            jobs[5] = {P.w_uq + (size_t)L * 256 * 384, 384, 256, 384, (bf16*)(ws + OFF_WUQ) + (size_t)L * 384 * 256, P.mla_q_norm_g + L * 256, 0};
            jobs[6] = {P.w_ukv + (size_t)L * 128 * 768, 768, 128, 768, (bf16*)(ws + OFF_WUKV) + (size_t)L * 768 * 128, P.mla_kv_norm_g + L * 128, 2};
#pragma unroll
            for (int q = 0; q < 7; ++q) {
                int nt = (jobs[q].Np >> 5) * (jobs[q].K >> 5);
                for (int it = bid; it < nt; it += G) wconv_tile(jobs[q], it);
            }
        }
    }
    {
        const float* src = P.sub_keys;
        bf16* dst = (bf16*)(ws + OFF_SKB);
        for (int i = bid * NTHR + tid; i < 262144 / 2; i += G * NTHR) {
            float2 v = ((const float2*)src)[i];
            ((unsigned*)dst)[i] = pack2(v.x, v.y);
        }
    }
    {
        bf16* hb = (bf16*)(ws + OFF_HB0);
        float* ss0 = (float*)(ws + OFF_SSA);
        int w = tid >> 6, l = tid & 63;
        for (int row = bid * 4 + w; row < TOK; row += G * 4) {
            const float4* xr = (const float4*)(P.x + (size_t)row * DM);
            float ss = 0.f;
#pragma unroll
            for (int i = 0; i < 2; ++i) {
                float4 a = xr[i * 128 + l * 2], b = xr[i * 128 + l * 2 + 1];
                ss += a.x * a.x + a.y * a.y + a.z * a.z + a.w * a.w + b.x * b.x + b.y * b.y + b.z * b.z + b.w * b.w;
                uint4 o;
                o.x = pack2(a.x, a.y); o.y = pack2(a.z, a.w); o.z = pack2(b.x, b.y); o.w = pack2(b.z, b.w);
                ((uint4*)(hb + (size_t)row * DM))[i * 64 + l] = o;
            }
            ss = wave_sum(ss);
            if (l == 0) {
                *(float4*)(ss0 + (size_t)row * 8) = make_float4(ss, 0.f, 0.f, 0.f);
                *(float4*)(ss0 + (size_t)row * 8 + 4) = make_float4(0.f, 0.f, 0.f, 0.f);
            }
        }
    }
    {
        float* cs = (float*)(ws + OFF_CS);
        for (int i = bid * NTHR + tid; i < TOK * 16; i += G * NTHR) {
            int t = i >> 4, k = i & 15;
            float inv = powf(10000.0f, -(float)k / 16.0f);
            float ang = (float)P.pos[t] * inv;
            cs[2 * i] = cosf(ang);
            cs[2 * i + 1] = sinf(ang);
        }
    }
}

template <int AMODE, typename SF>
__device__ __forceinline__ void gemm_core(f32x16 (&acc)[2][2], const void* Ap, int lda, const bf16* Bt, int ldb, int K,
                                          int m0, int n0, SF scalef) {
    const int tid = opaque_tid(), w = tid >> 6, l = tid & 63, r = l & 31, hh = l >> 5;
    const int wm = w >> 1, wn = w & 1;
    const int lc = tid & 7, lr = tid >> 3;
    u32x4 ra[4], rb[4];
    auto gload = [&](int k0) {
#pragma unroll
        for (int i = 0; i < 4; ++i) {
            int row = lr + 32 * i;
            if (AMODE == 1) {
                const float4* s = (const float4*)((const float*)Ap + (size_t)(m0 + row) * lda + k0 + lc * 8);
                float4 a = s[0], b = s[1];
                ra[i].x = pack2(a.x, a.y); ra[i].y = pack2(a.z, a.w); ra[i].z = pack2(b.x, b.y); ra[i].w = pack2(b.z, b.w);
            } else {
                ra[i] = *(const u32x4*)((const bf16*)Ap + (size_t)(m0 + row) * lda + k0 + lc * 8);
                if (AMODE == 2) {
                    float sc = scalef(i, k0);
                    ra[i].x = pack2(bflo(ra[i].x) * sc, bfhi(ra[i].x) * sc);
                    ra[i].y = pack2(bflo(ra[i].y) * sc, bfhi(ra[i].y) * sc);
                    ra[i].z = pack2(bflo(ra[i].z) * sc, bfhi(ra[i].z) * sc);
                    ra[i].w = pack2(bflo(ra[i].w) * sc, bfhi(ra[i].w) * sc);
                }
            }
            rb[i] = *(const u32x4*)(Bt + (size_t)(n0 + row) * ldb + k0 + lc * 8);
        }
    };
    auto lwrite = [&](int buf) {
        char* base = smem + buf * 32768;
#pragma unroll
        for (int i = 0; i < 4; ++i) {
            int row = lr + 32 * i;
            int off = row * 128 + ((lc ^ (row & 7)) << 4);
            *(u32x4*)(base + off) = ra[i];
            *(u32x4*)(base + 16384 + off) = rb[i];
        }
    };
    const int nk = K >> 6;
    gload(0);
    lwrite(0);
    __syncthreads();
    for (int kt = 0; kt < nk; ++kt) {
        if (kt + 1 < nk) gload((kt + 1) << 6);
        const char* base = smem + (kt & 1) * 32768;
#pragma unroll
        for (int s = 0; s < 4; ++s) {
            int ch = ((2 * s + hh) ^ (r & 7)) << 4;
            bf16x8 af[2], bfr[2];
#pragma unroll
            for (int i = 0; i < 2; ++i) af[i] = *(const bf16x8*)(base + (wm * 64 + i * 32 + r) * 128 + ch);
#pragma unroll
            for (int j = 0; j < 2; ++j) bfr[j] = *(const bf16x8*)(base + 16384 + (wn * 64 + j * 32 + r) * 128 + ch);
#pragma unroll
            for (int i = 0; i < 2; ++i)
#pragma unroll
                for (int j = 0; j < 2; ++j) acc[i][j] = __builtin_amdgcn_mfma_f32_32x32x16_bf16(af[i], bfr[j], acc[i][j], 0, 0, 0);
        }
        if (kt + 1 < nk) lwrite((kt + 1) & 1);
        __syncthreads();
    }
}
__device__ __forceinline__ float row_rs8(const float* part, int row) {
    float4 a = *(const float4*)(part + (size_t)row * 8), b = *(const float4*)(part + (size_t)row * 8 + 4);
    float ss = ((a.x + a.y) + (a.z + a.w)) + ((b.x + b.y) + (b.z + b.w));
    return rsqrtf(ss * (1.f / 1024.f) + EPSF);
}
struct NoScale { __device__ __forceinline__ float operator()(int, int) const { return 1.f; } };

#define ZERO_ACC(acc)                                  \
    _Pragma("unroll") for (int _i = 0; _i < 2; ++_i)   \
    _Pragma("unroll") for (int _j = 0; _j < 2; ++_j)   \
    _Pragma("unroll") for (int _r = 0; _r < 16; ++_r) acc[_i][_j][_r] = 0.f;


__device__ __forceinline__ void phase_proj(const Params& P, int L, int hsel, const float* ssrow) {
    char* ws = opq(P.ws);
    const bf16* hb = (const bf16*)(ws + (hsel ? OFF_HB1 : OFF_HB0));
    const bf16* Bt = (const bf16*)(ws + OFF_WIN) + (size_t)L * 2048 * 1024;
    bf16* fq = (bf16*)(ws + OFF_FQ); bf16* fk = (bf16*)(ws + OFF_FK); bf16* fvt = (bf16*)(ws + OFF_FVT);
    bf16* sq = (bf16*)(ws + OFF_SQ); bf16* sk = (bf16*)(ws + OFF_SKK); bf16* svt = (bf16*)(ws + OFF_SVT);
    bf16* cq = (bf16*)(ws + OFF_CQ); bf16* ckv = (bf16*)(ws + OFF_CKV);
    float* flog = (float*)(ws + OFF_FLOG);
    bf16* mk = (bf16*)(ws + OFF_MK);
    const float* cs = (const float*)(ws + OFF_CS);
    const int tid = opaque_tid(), w = tid >> 6, l = tid & 63, hh = l >> 5, wm = w >> 1, wn = w & 1;
    for (int tile = blockIdx.x; tile < 128 * 16; tile += gridDim.x) {
        int mt = tile >> 4, nt = tile & 15;
        int m0 = mt * 128, n0 = nt * 128;
        f32x16 acc[2][2];
        ZERO_ACC(acc);
        gemm_core<0>(acc, hb, 1024, Bt, 1024, 1024, m0, n0, NoScale());
#pragma unroll
        for (int i = 0; i < 2; ++i) {
            float rs[16];
#pragma unroll
            for (int rr = 0; rr < 16; ++rr) {
                int row = m0 + wm * 64 + i * 32 + (rr & 3) + 8 * (rr >> 2) + 4 * hh;
                rs[rr] = row_rs8(ssrow, row);
            }
#pragma unroll
            for (int j = 0; j < 2; ++j) {
                int col = n0 + wn * 64 + j * 32 + (l & 31);
                int rbase = m0 + wm * 64 + i * 32 + 4 * hh;
                if (nt < 14 && nt != 4 && nt != 5 && nt != 10 && nt != 11) {
                    bf16* dst; int ld, c;
                    if (nt < 2) { dst = fq; ld = 256; c = col; }
                    else if (nt < 4) { dst = fk; ld = 256; c = col - 256; }
                    else if (nt < 8) { dst = sq; ld = 256; c = col - 768; }
                    else if (nt < 10) { dst = sk; ld = 256; c = col - 1024; }
                    else if (nt < 14) { dst = cq; ld = 256; c = col - 1536; }
                    if (nt == 14) { dst = ckv; ld = 128; c = col - 1792; }
#pragma unroll
                    for (int rr = 0; rr < 16; ++rr) {
                        int row = rbase + (rr & 3) + 8 * (rr >> 2);
                        dst[(size_t)row * ld + c] = (bf16)(acc[i][j][rr] * rs[rr]);
                    }
                } else if (nt == 14) {
                    int c = col - 1792;
#pragma unroll
                    for (int rr = 0; rr < 16; ++rr) {
                        int row = rbase + (rr & 3) + 8 * (rr >> 2);
                        ckv[(size_t)row * 128 + c] = (bf16)(acc[i][j][rr] * rs[rr]);
                    }
                } else if (nt == 4 || nt == 5 || nt == 10 || nt == 11) {
                    bf16* vt = (nt < 6) ? fvt : svt;
                    int c = col - ((nt < 6) ? 512 : 1280);
                    int b = m0 >> 11;
                    int s0 = (rbase & 2047);
                    bf16* base = vt + ((size_t)(b * 256 + c)) * SEQ + s0;
#pragma unroll
                    for (int g = 0; g < 4; ++g) {
                        uint2 o;
                        o.x = pack2(acc[i][j][4 * g] * rs[4 * g], acc[i][j][4 * g + 1] * rs[4 * g + 1]);
                        o.y = pack2(acc[i][j][4 * g + 2] * rs[4 * g + 2], acc[i][j][4 * g + 3] * rs[4 * g + 3]);
                        *(uint2*)(base + 8 * g) = o;
                    }
                } else {
                    if (wn == 0 && j == 0) {
                        int ci = l & 31, pi = ci & 15;
#pragma unroll
                        for (int rr = 0; rr < 16; ++rr) {
                            int row = rbase + (rr & 3) + 8 * (rr >> 2);
                            float v = acc[i][j][rr] * rs[rr];
                            float pv = __shfl_xor(v, 16);
                            float2 c_s = *(const float2*)(cs + ((size_t)row * 16 + pi) * 2);
                            float o = (ci < 16) ? (v * c_s.x - pv * c_s.y) : (pv * c_s.y + v * c_s.x);
                            bf16 ob = (bf16)o;
#pragma unroll
                            for (int h = 0; h < 4; ++h) mk[(size_t)row * 384 + h * 96 + 64 + ci] = ob;
                        }
                    } else if (wn == 0 && j == 1) {
                        int c = (l & 31);
                        if (c < 4) {
#pragma unroll
                            for (int rr = 0; rr < 16; ++rr) {
                                int row = rbase + (rr & 3) + 8 * (rr >> 2);
                                flog[(size_t)row * 4 + c] = acc[i][j][rr] * rs[rr];
                            }
                        }
                    }
                }
            }
        }
    }
}

struct RowScale4 { float s[4]; __device__ __forceinline__ float operator()(int i, int) const { return s[i]; } };

template <int KW>
__device__ __forceinline__ RowScale4 row_rms_prepass(const bf16* A, int lda, int m0) {
    const int tid = opaque_tid(), lc = tid & 7, lr = tid >> 3;
    RowScale4 rs;
#pragma unroll
    for (int i = 0; i < 4; ++i) {
        float ss = 0.f;
#pragma unroll
        for (int k0 = 0; k0 < KW; k0 += 64) {
            uint4 v = *(const uint4*)(A + (size_t)(m0 + lr + 32 * i) * lda + k0 + lc * 8);
            float a;
            a = bflo(v.x); ss += a * a; a = bfhi(v.x); ss += a * a;
            a = bflo(v.y); ss += a * a; a = bfhi(v.y); ss += a * a;
            a = bflo(v.z); ss += a * a; a = bfhi(v.z); ss += a * a;
            a = bflo(v.w); ss += a * a; a = bfhi(v.w); ss += a * a;
        }
        ss += __shfl_xor(ss, 1); ss += __shfl_xor(ss, 2); ss += __shfl_xor(ss, 4);
        rs.s[i] = rsqrtf(ss * (1.f / (float)KW) + EPSF);
    }
    return rs;
}

__device__ __forceinline__ void phase_mla_up(const Params& P, int L) {
    char* ws = opq(P.ws);
    const bf16* cq = (const bf16*)(ws + OFF_CQ); const bf16* ckv = (const bf16*)(ws + OFF_CKV);
    const bf16* wuq = (const bf16*)(ws + OFF_WUQ) + (size_t)L * 384 * 256;
    const bf16* wukv = (const bf16*)(ws + OFF_WUKV) + (size_t)L * 768 * 128;
    bf16* mq = (bf16*)(ws + OFF_MQ); bf16* mk = (bf16*)(ws + OFF_MK); bf16* mvt = (bf16*)(ws + OFF_MVT);
    const float* cs = (const float*)(ws + OFF_CS);
    const float* flog = (const float*)(ws + OFF_FLOG);
    float* cumF = (float*)(ws + OFF_CUMF);
    const int tid = opaque_tid(), w = tid >> 6, l = tid & 63, hh = l >> 5, wm = w >> 1, wn = w & 1;
    const int NQ = 128 * 3, NKV = 128 * 6, NCF = 8;
    for (int item = blockIdx.x; item < NQ + NKV + NCF; item += gridDim.x) {
        if (item < NQ) {
            int mt = item / 3, nt = item % 3;
            int m0 = mt * 128, n0 = nt * 128;
            RowScale4 rs = row_rms_prepass<256>(cq, 256, m0);
            f32x16 acc[2][2];
            ZERO_ACC(acc);
            gemm_core<2>(acc, cq, 256, wuq, 256, 256, m0, n0, rs);
#pragma unroll
            for (int i = 0; i < 2; ++i)
#pragma unroll
                for (int j = 0; j < 2; ++j) {
                    int c0 = n0 + wn * 64 + j * 32;
                    int col = c0 + (l & 31);
                    int rbase = m0 + wm * 64 + i * 32 + 4 * hh;
                    bool rot = (c0 % 96) == 64;
                    int ci = l & 31, pi = ci & 15;
#pragma unroll
                    for (int rr = 0; rr < 16; ++rr) {
                        int row = rbase + (rr & 3) + 8 * (rr >> 2);
                        float v = acc[i][j][rr];
                        if (rot) {
                            float pv = __shfl_xor(v, 16);
                            float2 c_s = *(const float2*)(cs + ((size_t)row * 16 + pi) * 2);
                            v = (ci < 16) ? (v * c_s.x - pv * c_s.y) : (pv * c_s.y + v * c_s.x);
                        }
                        mq[(size_t)row * 384 + col] = (bf16)v;
                    }
                }
        } else if (item < NQ + NKV) {
            int it2 = item - NQ;
            int mt = it2 / 6, nt = it2 % 6;
            int m0 = mt * 128, n0 = nt * 128;
            RowScale4 rs = row_rms_prepass<128>(ckv, 128, m0);
            f32x16 acc[2][2];
            ZERO_ACC(acc);
            gemm_core<2>(acc, ckv, 128, wukv, 128, 128, m0, n0, rs);
#pragma unroll
            for (int i = 0; i < 2; ++i)
#pragma unroll
                for (int j = 0; j < 2; ++j) {
                    int col = n0 + wn * 64 + j * 32 + (l & 31);
                    int rbase = m0 + wm * 64 + i * 32 + 4 * hh;
                    if (nt < 2) {
                        int dcol = (col >> 6) * 96 + (col & 63);
#pragma unroll
                        for (int rr = 0; rr < 16; ++rr) {
                            int row = rbase + (rr & 3) + 8 * (rr >> 2);
                            mk[(size_t)row * 384 + dcol] = (bf16)acc[i][j][rr];
                        }
                    } else {
                        int e = col - 256;
                        int b = m0 >> 11;
                        int s0 = rbase & 2047;
                        bf16* base = mvt + ((size_t)(b * 512 + e)) * SEQ + s0;
#pragma unroll
                        for (int g = 0; g < 4; ++g) {
                            uint2 o;
                            o.x = pack2(acc[i][j][4 * g], acc[i][j][4 * g + 1]);
                            o.y = pack2(acc[i][j][4 * g + 2], acc[i][j][4 * g + 3]);
                            *(uint2*)(base + 8 * g) = o;
                        }
                    }
                }
        } else {
            int seq = (item - NQ - NKV) * 4 + w;
            int b = seq >> 2, h = seq & 3;
            float bfv = P.b_forget[L * 4 + h];
            float vals[32];
            float run = 0.f;
#pragma unroll
            for (int i = 0; i < 32; ++i) {
                int s = l * 32 + i;
                float z = flog[((size_t)b * SEQ + s) * 4 + h] + bfv;
                run += log_sigmoid_f(z);
                vals[i] = run;
            }
            float tot = run, incl = tot;
#pragma unroll
            for (int o = 1; o < 64; o <<= 1) {
                float t = __shfl_up(incl, o);
                if (l >= o) incl += t;
            }
            float excl = incl - tot;
#pragma unroll
            for (int i = 0; i < 32; ++i) cumF[(size_t)seq * SEQ + l * 32 + i] = vals[i] + excl;
        }
    }
}

template <int MODE, int DK, int DV>
__device__ __forceinline__ void attn_item(const bf16* __restrict__ Q, int ldq, const bf16* __restrict__ Kg, int ldk,
                          const bf16* __restrict__ Vt, const float* __restrict__ cumF, bf16* __restrict__ Y,
                          float* __restrict__ ssy, int b, int h, int qb, float c1) {
    constexpr int KSTR = DK * 2 + 16;
    constexpr int VSTR = 144;
    constexpr int KBYTES = 64 * KSTR, VBYTES = DV * VSTR;
    constexpr int BUF = (KBYTES + VBYTES + 256 + 255) & ~255;
    static_assert(2 * BUF <= LDS_BYTES - 64, "lds");
    constexpr int KCH = DK / 8, KPT = (64 * KCH) / 256, VPT = (DV * 8) / 256;
    const int tid = opaque_tid(), w = tid >> 6, l = tid & 63, r = l & 31, hh = l >> 5;
    const int q0 = qb * 128;
    const int qrow = q0 + 32 * w + r;
    const size_t tok = (size_t)b * SEQ + qrow;
    const int bh = b * 4 + h;
    bf16x8 qf[DK / 16];
#pragma unroll
    for (int s = 0; s < DK / 16; ++s) qf[s] = *(const bf16x8*)(Q + tok * ldq + h * DK + 16 * s + 8 * hh);
    f32x16 o[DV / 32];
    const f32x16 zero16 = {0.f, 0.f, 0.f, 0.f, 0.f, 0.f, 0.f, 0.f, 0.f, 0.f, 0.f, 0.f, 0.f, 0.f, 0.f, 0.f};
#pragma unroll
    for (int d = 0; d < DV / 32; ++d) o[d] = zero16;
    float m = -1e30f, lsum = 0.f, R = 0.f;
    float Fq = 0.f;
    if (MODE == 0) Fq = cumF[(size_t)bh * SEQ + qrow] * LOG2E;
    const int nkt = (q0 + 128) >> 6;
    u32x4 kreg[KPT], vreg[VPT];
    float4 freg = {0.f, 0.f, 0.f, 0.f};
    auto gload = [&](int kt) {
#pragma unroll
        for (int i = 0; i < KPT; ++i) {
            int e = tid + 256 * i;
            int row = e / KCH, ch = e % KCH;
            kreg[i] = *(const u32x4*)(Kg + ((size_t)b * SEQ + kt * 64 + row) * ldk + h * DK + ch * 8);
        }
#pragma unroll
        for (int i = 0; i < VPT; ++i) {
            int e = tid + 256 * i;
            int row = e >> 3, ch = e & 7;
            vreg[i] = *(const u32x4*)(Vt + ((size_t)bh * DV + row) * SEQ + kt * 64 + ch * 8);
        }
        if (MODE == 0 && tid < 16) freg = *(const float4*)(cumF + (size_t)bh * SEQ + kt * 64 + tid * 4);
    };
    auto lwrite = [&](int buf) {
        char* base = smem + buf * BUF;
#pragma unroll
        for (int i = 0; i < KPT; ++i) {
            int e = tid + 256 * i;
            int row = e / KCH, ch = e % KCH;
            *(u32x4*)(base + row * KSTR + ch * 16) = kreg[i];
        }
#pragma unroll
        for (int i = 0; i < VPT; ++i) {
            int e = tid + 256 * i;
            int row = e >> 3, ch = e & 7;
            *(u32x4*)(base + KBYTES + row * VSTR + ch * 16) = vreg[i];
        }
        if (MODE == 0 && tid < 16) *(float4*)(base + KBYTES + VBYTES + tid * 16) = freg;
    };
    const int prow = (r & 0x13) | ((r & 4) << 1) | ((r & 8) >> 1);
    gload(MODE == 1 ? nkt - 1 : 0);
    lwrite(0);
    __syncthreads();
    for (int it = 0; it < nkt; ++it) {
        const int kt = (MODE == 1) ? (nkt - 1 - it) : it;
        if (it + 1 < nkt) gload((MODE == 1) ? (kt - 1) : (kt + 1));
        const char* base = smem + (it & 1) * BUF;
        const bool active = (kt * 64) <= (q0 + 32 * w + 31);
        if (active) {
            const bool needmask = (kt * 64 + 63) >= (q0 + 32 * w);
            f32x16 s[2];
#pragma unroll
            for (int sub = 0; sub < 2; ++sub) {
                s[sub] = zero16;
#pragma unroll
                for (int ks = 0; ks < DK / 16; ++ks) {
                    bf16x8 kf = *(const bf16x8*)(base + (sub * 32 + prow) * KSTR + (2 * ks + hh) * 16);
                    s[sub] = __builtin_amdgcn_mfma_f32_32x32x16_bf16(kf, qf[ks], s[sub], 0, 0, 0);
                }
            }
            bf16x8 pf[2][2];
            if (MODE != 1) {
                const float* Ft = (const float*)(base + KBYTES + VBYTES);
                float mx = -INFINITY;
                float tv[2][16];
#pragma unroll
                for (int sub = 0; sub < 2; ++sub)
#pragma unroll
                    for (int a = 0; a < 2; ++a) {
                        int kofs = sub * 32 + 16 * a + 8 * hh;
                        float fk[8];
                        if (MODE == 0) {
                            float4 f0 = *(const float4*)(Ft + kofs), f1 = *(const float4*)(Ft + kofs + 4);
                            fk[0] = f0.x; fk[1] = f0.y; fk[2] = f0.z; fk[3] = f0.w; fk[4] = f1.x; fk[5] = f1.y; fk[6] = f1.z; fk[7] = f1.w;
                        }
#pragma unroll
                        for (int j = 0; j < 8; ++j) {
                            int rr = 8 * a + j;
                            float v = s[sub][rr] * c1;
                            if (MODE == 0) v += Fq - fk[j] * LOG2E;
                            if (needmask && (kt * 64 + kofs + j > qrow)) v = -INFINITY;
                            tv[sub][rr] = v;
                            mx = fmaxf(mx, v);
                        }
                    }
                mx = fmaxf(mx, __shfl_xor(mx, 32));
                float mnew = fmaxf(m, mx);
                float alpha = fexp2(m - mnew);
                float rsum = 0.f;
#pragma unroll
                for (int sub = 0; sub < 2; ++sub)
#pragma unroll
                    for (int a = 0; a < 2; ++a) {
                        float pv[8];
#pragma unroll
                        for (int j = 0; j < 8; ++j) { pv[j] = fexp2(tv[sub][8 * a + j] - mnew); rsum += pv[j]; }
                        uint4 u;
                        u.x = pack2(pv[0], pv[1]); u.y = pack2(pv[2], pv[3]); u.z = pack2(pv[4], pv[5]); u.w = pack2(pv[6], pv[7]);
                        pf[sub][a] = __builtin_bit_cast(bf16x8, u);
                    }
                rsum += __shfl_xor(rsum, 32);
                lsum = lsum * alpha + rsum;
                m = mnew;
#pragma unroll
                for (int d = 0; d < DV / 32; ++d) o[d] = o[d] * alpha;
            } else {
#pragma unroll
                for (int sb = 0; sb < 2; ++sb) {
                    const int sub = 1 - sb;
                    float lsig[16], lneg[16];
                    float A0 = 0.f, A1 = 0.f;
#pragma unroll
                    for (int rr = 0; rr < 16; ++rr) {
                        int key = kt * 64 + sub * 32 + 16 * (rr >> 3) + 8 * hh + (rr & 7);
                        bool valid = key < qrow;
                        float z = s[sub][rr] * c1;
                        float e = fexp2(-fabsf(z));
                        float l1p = flog2(1.f + e);
                        float ls = fminf(z, 0.f) - l1p;
                        float ln = valid ? (ls - z) : 0.f;
                        lsig[rr] = valid ? ls : -INFINITY;
                        lneg[rr] = ln;
                        if (rr < 8) A0 += ln; else A1 += ln;
                    }
                    float B0 = __shfl_xor(A0, 32), B1 = __shfl_xor(A1, 32);
                    float base1 = (hh == 0) ? (R + B1) : R;
                    float base0 = (hh == 0) ? (R + B1 + A1 + B0) : (R + A1 + B1);
                    float wv[16];
                    float run = base1;
#pragma unroll
                    for (int j = 7; j >= 0; --j) { wv[8 + j] = fexp2(lsig[8 + j] + run); run += lneg[8 + j]; }
                    run = base0;
#pragma unroll
                    for (int j = 7; j >= 0; --j) { wv[j] = fexp2(lsig[j] + run); run += lneg[j]; }
                    R += A0 + A1 + B0 + B1;
#pragma unroll
                    for (int a = 0; a < 2; ++a) {
                        uint4 u;
                        u.x = pack2(wv[8 * a], wv[8 * a + 1]); u.y = pack2(wv[8 * a + 2], wv[8 * a + 3]);
                        u.z = pack2(wv[8 * a + 4], wv[8 * a + 5]); u.w = pack2(wv[8 * a + 6], wv[8 * a + 7]);
                        pf[sub][a] = __builtin_bit_cast(bf16x8, u);
                    }
                }
            }
#pragma unroll
            for (int d = 0; d < DV / 32; ++d)
#pragma unroll
                for (int sub = 0; sub < 2; ++sub)
#pragma unroll
                    for (int a = 0; a < 2; ++a) {
                        bf16x8 vf = *(const bf16x8*)(base + KBYTES + (d * 32 + r) * VSTR + (sub * 32 + 16 * a + 8 * hh) * 2);
                        o[d] = __builtin_amdgcn_mfma_f32_32x32x16_bf16(vf, pf[sub][a], o[d], 0, 0, 0);
                    }
        }
        if (it + 1 < nkt) lwrite((it + 1) & 1);
        __syncthreads();
    }
    float inv = (MODE == 1) ? 1.f : (1.f / lsum);
    float ssq = 0.f;
#pragma unroll
    for (int d = 0; d < DV / 32; ++d)
#pragma unroll
        for (int g = 0; g < 4; ++g) {
            float v0 = o[d][4 * g] * inv, v1 = o[d][4 * g + 1] * inv, v2 = o[d][4 * g + 2] * inv, v3 = o[d][4 * g + 3] * inv;
            ssq += v0 * v0 + v1 * v1 + v2 * v2 + v3 * v3;
            uint2 u; u.x = pack2(v0, v1); u.y = pack2(v2, v3);
            *(uint2*)(Y + tok * 1024 + h * DV + d * 32 + 8 * g + 4 * hh) = u;
        }
    ssq += __shfl_xor(ssq, 32);
    if (hh == 0) ssy[tok * 16 + h] = ssq;
}

__device__ __forceinline__ void phase_attn(const Params& P, int L, int rep = 0) {
    char* ws = opq(P.ws);
    int* cnt = (int*)(ws + OFF_CNT) + L * 64 + rep * 16;
    int* s_item = (int*)(smem + LDS_BYTES - 16);
    const float* cumF = (const float*)(ws + OFF_CUMF);
    bf16* Y = (bf16*)(ws + OFF_Y);
    float* ssy = (float*)(ws + OFF_SSY) + (size_t)L * TOK * 16;
    for (;;) {
        if (opaque_tid() == 0) *s_item = atomicAdd(cnt, 1);
        __syncthreads();
        int item = *s_item;
        __syncthreads();
        if (item >= 1536) break;
        int qb = 15 - item / 96;
        int rem = item % 96;
        int type = rem >> 5, bh = rem & 31;
        int b = bh >> 2, h = bh & 3;
        if (type == 0) {
            attn_item<2, 96, 128>((const bf16*)(ws + OFF_MQ), 384, (const bf16*)(ws + OFF_MK), 384, (const bf16*)(ws + OFF_MVT), cumF,
                                  Y + 512, ssy + 8, b, h, qb, 0.10206207261596577f * LOG2E);
        } else if (type == 1) {
            attn_item<1, 64, 64>((const bf16*)(ws + OFF_SQ), 256, (const bf16*)(ws + OFF_SKK), 256, (const bf16*)(ws + OFF_SVT), cumF,
                                 Y + 256, ssy + 4, b, h, qb, 0.125f * LOG2E);
        } else {
            attn_item<0, 64, 64>((const bf16*)(ws + OFF_FQ), 256, (const bf16*)(ws + OFF_FK), 256, (const bf16*)(ws + OFF_FVT), cumF,
                                 Y + 0, ssy + 0, b, h, qb, 0.125f * LOG2E);
        }
    }
}

__device__ __forceinline__ void rowss_flush(float (&part)[2][16], float* gss, int m0, int nt) {
    float* lss = (float*)smem;
    const int tid = opaque_tid(), w = tid >> 6, l = tid & 63, hh = l >> 5, wm = w >> 1, wn = w & 1;
#pragma unroll
    for (int i = 0; i < 2; ++i)
#pragma unroll
        for (int rr = 0; rr < 16; ++rr) {
            float v = part[i][rr];
            v += __shfl_xor(v, 1); v += __shfl_xor(v, 2); v += __shfl_xor(v, 4); v += __shfl_xor(v, 8); v += __shfl_xor(v, 16);
            if ((l & 31) == 0) lss[wn * 128 + wm * 64 + i * 32 + (rr & 3) + 8 * (rr >> 2) + 4 * hh] = v;
        }
    __syncthreads();
    if (tid < 128) gss[(size_t)(m0 + tid) * 8 + nt] = lss[tid] + lss[128 + tid];
    __syncthreads();
}

struct GroupScale {
    float s0[4], s1[4], s2[4];
    __device__ __forceinline__ float operator()(int i, int k0) const {
        float a = s0[i], b = s1[i], c = s2[i];
        float sel = (k0 < 256) ? 1.f : 0.f, sel2 = (k0 >= 256 && k0 < 512) ? 1.f : 0.f;
        return a * sel + b * sel2 + c * (1.f - sel - sel2);
    }
};

__device__ __forceinline__ void phase_wo(const Params& P, int L, int hsel, float* ss_out) {
    char* ws = opq(P.ws);
    bf16* hb_out = (bf16*)(ws + (hsel ? OFF_HB1 : OFF_HB0));
    const float* hin = (L == 0) ? opq(P.x) : (const float*)opq(P.out);
    float* hout = opq(P.out);
    const bf16* Y = (const bf16*)(ws + OFF_Y);
    const bf16* Bt = (const bf16*)(ws + OFF_WO) + (size_t)L * 1024 * 1024;
    const float* ssy = (const float*)(ws + OFF_SSY) + (size_t)L * TOK * 16;
    const int tid = opaque_tid(), w = tid >> 6, l = tid & 63, hh = l >> 5, wm = w >> 1, wn = w & 1;
    for (int tile = blockIdx.x; tile < 128 * 8; tile += gridDim.x) {
        int mt = tile >> 3, nt = tile & 7;
        int m0 = mt * 128, n0 = nt * 128;
        GroupScale gs;
#pragma unroll
        for (int i = 0; i < 4; ++i) {
            int row = m0 + (tid >> 3) + 32 * i;
            float4 v0 = *(const float4*)(ssy + (size_t)row * 16), v1 = *(const float4*)(ssy + (size_t)row * 16 + 4), v2 = *(const float4*)(ssy + (size_t)row * 16 + 8);
            gs.s0[i] = rsqrtf(((v0.x + v0.y) + (v0.z + v0.w)) * (1.f / 256.f) + EPSF);
            gs.s1[i] = rsqrtf(((v1.x + v1.y) + (v1.z + v1.w)) * (1.f / 256.f) + EPSF);
            gs.s2[i] = rsqrtf(((v2.x + v2.y) + (v2.z + v2.w)) * (1.f / 512.f) + EPSF);
        }
        f32x16 acc[2][2];
        ZERO_ACC(acc);
        gemm_core<2>(acc, Y, 1024, Bt, 1024, 1024, m0, n0, gs);
        float part[2][16];
#pragma unroll
        for (int i = 0; i < 2; ++i) {
#pragma unroll
            for (int rr = 0; rr < 16; ++rr) part[i][rr] = 0.f;
#pragma unroll
            for (int j = 0; j < 2; ++j) {
                int col = n0 + wn * 64 + j * 32 + (l & 31);
                int rbase = m0 + wm * 64 + i * 32 + 4 * hh;
#pragma unroll
                for (int rr = 0; rr < 16; ++rr) {
                    int row = rbase + (rr & 3) + 8 * (rr >> 2);
                    size_t idx = (size_t)row * 1024 + col;
                    float v = hin[idx] + acc[i][j][rr];
                    hout[idx] = v;
                    hb_out[idx] = (bf16)v;
                    part[i][rr] += v * v;
                }
            }
        }
        rowss_flush(part, ss_out, m0, nt);
    }
}

__device__ __forceinline__ void phase_pq(const Params& P, int L, int hsel, const float* ssrow) {
    char* ws = opq(P.ws);
    const bf16* hb = (const bf16*)(ws + (hsel ? OFF_HB1 : OFF_HB0));
    const bf16* Bt = (const bf16*)(ws + OFF_WQ) + (size_t)L * 1024 * 1024;
    bf16* pq = (bf16*)(ws + OFF_PQ);
    const int tid = opaque_tid(), w = tid >> 6, l = tid & 63, hh = l >> 5, wm = w >> 1, wn = w & 1;
    for (int tile = blockIdx.x; tile < 128 * 8; tile += gridDim.x) {
        int mt = tile >> 3, nt = tile & 7;
        int m0 = mt * 128, n0 = nt * 128;
        f32x16 acc[2][2];
        ZERO_ACC(acc);
        gemm_core<0>(acc, hb, 1024, Bt, 1024, 1024, m0, n0, NoScale());
#pragma unroll
        for (int i = 0; i < 2; ++i) {
            int rbase = m0 + wm * 64 + i * 32 + 4 * hh;
#pragma unroll
            for (int rr = 0; rr < 16; ++rr) {
                int row = rbase + (rr & 3) + 8 * (rr >> 2);
                float rs = row_rs8(ssrow, row);
#pragma unroll
                for (int j = 0; j < 2; ++j) {
                    int col = n0 + wn * 64 + j * 32 + (l & 31);
                    pq[(size_t)row * 1024 + col] = (bf16)(acc[i][j][rr] * rs);
                }
            }
        }
    }
}

__device__ __forceinline__ void cswap(int& a, int& b) { int mx = max(a, b), mn = min(a, b); a = mx; b = mn; }
__device__ __forceinline__ void bitonic_sort16(int (&v)[16]) {
#pragma unroll
    for (int k = 2; k <= 16; k <<= 1)
#pragma unroll
        for (int j = k >> 1; j > 0; j >>= 1)
#pragma unroll
            for (int i = 0; i < 16; ++i) {
                int q = i ^ j;
                if (q > i) {
                    if ((i & k) == 0) cswap(v[i], v[q]); else cswap(v[q], v[i]);
                }
            }
}
__device__ __forceinline__ void merge_top16(int (&Lv)[16], const int (&Rv)[16]) {
#pragma unroll
    for (int i = 0; i < 16; ++i) Lv[i] = max(Lv[i], Rv[15 - i]);
#pragma unroll
    for (int j = 8; j > 0; j >>= 1)
#pragma unroll
        for (int i = 0; i < 16; ++i) {
            int q = i ^ j;
            if (q > i) cswap(Lv[i], Lv[q]);
        }
}
__device__ __forceinline__ int f2key(float v, int low, int mask) {
    int b = __float_as_int(v);
    b ^= (b >> 31) & 0x7fffffff;
    return (b & ~mask) | low;
}
__device__ __forceinline__ float key2f(int k, int mask) {
    int b = k & ~mask;
    b ^= (b >> 31) & 0x7fffffff;
    return __int_as_float(b);
}

__device__ __forceinline__ void phase_topk(const Params& P, int L) {
    char* ws = opq(P.ws);
    const bf16* pq = (const bf16*)(ws + OFF_PQ);
    const bf16* skb = (const bf16*)(ws + OFF_SKB) + (size_t)L * 16 * 128 * 64;
    unsigned short* ids = (unsigned short*)(ws + OFF_IDS);
    float* gates = (float*)(ws + OFF_GATE);
    float* sc = (float*)smem;
    int* Lq = (int*)(smem + 64 * 129 * 4);
    int* Fin = Lq + 4 * 64 * 16;
    const int tid = opaque_tid(), w = tid >> 6, l = tid & 63, r = l & 31, hh = l >> 5;
    for (int item = blockIdx.x; item < TOK / 64; item += gridDim.x) {
        const int t0 = item * 64;
        for (int h = 0; h < 8; ++h) {
            for (int p = 0; p < 2; ++p) {
                const int hp = h * 2 + p;
                f32x16 acc[2];
#pragma unroll
                for (int j = 0; j < 2; ++j)
#pragma unroll
                    for (int rr = 0; rr < 16; ++rr) acc[j][rr] = 0.f;
#pragma unroll
                for (int s = 0; s < 4; ++s) {
                    bf16x8 af = *(const bf16x8*)(skb + ((size_t)hp * 128 + 32 * w + r) * 64 + 16 * s + 8 * hh);
#pragma unroll
                    for (int j = 0; j < 2; ++j) {
                        bf16x8 bfr = *(const bf16x8*)(pq + (size_t)(t0 + 32 * j + r) * 1024 + hp * 64 + 16 * s + 8 * hh);
                        acc[j] = __builtin_amdgcn_mfma_f32_32x32x16_bf16(af, bfr, acc[j], 0, 0, 0);
                    }
                }
#pragma unroll
                for (int j = 0; j < 2; ++j)
#pragma unroll
                    for (int rr = 0; rr < 16; ++rr) {
                        int key = 32 * w + (rr & 3) + 8 * (rr >> 2) + 4 * hh;
                        sc[(32 * j + r) * 129 + key] = acc[j][rr];
                    }
                __syncthreads();
                {
                    const int token = l, quarter = w;
                    int A[16], B[16];
#pragma unroll
                    for (int i = 0; i < 16; ++i) {
                        int n = quarter * 32 + i;
                        A[i] = f2key(sc[token * 129 + n], 127 - n, 127);
                        B[i] = f2key(sc[token * 129 + n + 16], 127 - (n + 16), 127);
                    }
                    bitonic_sort16(A);
                    bitonic_sort16(B);
                    merge_top16(A, B);
#pragma unroll
                    for (int i = 0; i < 16; ++i) Lq[(quarter * 64 + token) * 16 + i] = A[i];
                    __syncthreads();
                    if ((quarter & 1) == 0) {
#pragma unroll
                        for (int i = 0; i < 16; ++i) B[i] = Lq[((quarter + 1) * 64 + token) * 16 + i];
                        merge_top16(A, B);
                        if (quarter == 2) {
#pragma unroll
                            for (int i = 0; i < 16; ++i) Lq[(2 * 64 + token) * 16 + i] = A[i];
                        }
                    }
                    __syncthreads();
                    if (quarter == 0) {
#pragma unroll
                        for (int i = 0; i < 16; ++i) B[i] = Lq[(2 * 64 + token) * 16 + i];
                        merge_top16(A, B);
#pragma unroll
                        for (int i = 0; i < 16; ++i) Fin[(p * 64 + token) * 16 + i] = A[i];
                    }
                    __syncthreads();
                }
            }
            if (w == 0) {
                const int token = l;
                float s1[16], s2[16];
#pragma unroll
                for (int i = 0; i < 16; ++i) {
                    s1[i] = key2f(Fin[(0 * 64 + token) * 16 + i], 127);
                    s2[i] = key2f(Fin[(1 * 64 + token) * 16 + i], 127);
                }
                int Lc[16], X[16];
#pragma unroll
                for (int b2 = 0; b2 < 16; ++b2) Lc[b2] = f2key(s1[0] + s2[b2], 255 - b2, 255);
#pragma unroll
                for (int a = 1; a < 16; ++a) X[a - 1] = f2key(s1[a] + s2[0], 255 - a * 16, 255);
                X[15] = INT_MIN;
                merge_top16(Lc, X);
                {
                    int c = 0;
#pragma unroll
                    for (int b2 = 1; b2 <= 7; ++b2) X[c++] = f2key(s1[1] + s2[b2], 255 - (16 + b2), 255);
#pragma unroll
                    for (int b2 = 1; b2 <= 4; ++b2) X[c++] = f2key(s1[2] + s2[b2], 255 - (32 + b2), 255);
#pragma unroll
                    for (int b2 = 1; b2 <= 3; ++b2) X[c++] = f2key(s1[3] + s2[b2], 255 - (48 + b2), 255);
#pragma unroll
                    for (int b2 = 1; b2 <= 2; ++b2) X[c++] = f2key(s1[4] + s2[b2], 255 - (64 + b2), 255);
                }
                bitonic_sort16(X);
                merge_top16(Lc, X);
                X[0] = f2key(s1[5] + s2[1], 255 - (80 + 1), 255);
                X[1] = f2key(s1[6] + s2[1], 255 - (96 + 1), 255);
                X[2] = f2key(s1[7] + s2[1], 255 - (112 + 1), 255);
#pragma unroll
                for (int i = 3; i < 16; ++i) X[i] = INT_MIN;
                merge_top16(Lc, X);
                float mx = key2f(Lc[0], 255);
                float ev[16], sum = 0.f;
#pragma unroll
                for (int k = 0; k < 16; ++k) { ev[k] = __expf(key2f(Lc[k], 255) - mx); sum += ev[k]; }
                float inv = 1.f / sum;
                size_t ob = (size_t)(t0 + token) * 128 + h * 16;
#pragma unroll
                for (int k = 0; k < 16; ++k) {
                    int cidx = 255 - (Lc[k] & 255);
                    int a = cidx >> 4, b2 = cidx & 15;
                    int i1 = 127 - (Fin[(0 * 64 + token) * 16 + a] & 127);
                    int i2 = 127 - (Fin[(1 * 64 + token) * 16 + b2] & 127);
                    ids[ob + k] = (unsigned short)(i1 * 128 + i2);
                    gates[ob + k] = ev[k] * inv;
                }
            }
            __syncthreads();
        }
    }
}

__device__ __forceinline__ float gelu_exact(float x) { return 0.5f * x * (1.f + erff(x * 0.70710678118654752f)); }

__device__ __forceinline__ void dec16(const u32x4& v, float (&f)[16]) {
    f32x2 t;
    t = __builtin_amdgcn_cvt_pk_f32_fp8((int)v.x, false); f[0] = t.x; f[1] = t.y;
    t = __builtin_amdgcn_cvt_pk_f32_fp8((int)v.x, true);  f[2] = t.x; f[3] = t.y;
    t = __builtin_amdgcn_cvt_pk_f32_fp8((int)v.y, false); f[4] = t.x; f[5] = t.y;
    t = __builtin_amdgcn_cvt_pk_f32_fp8((int)v.y, true);  f[6] = t.x; f[7] = t.y;
    t = __builtin_amdgcn_cvt_pk_f32_fp8((int)v.z, false); f[8] = t.x; f[9] = t.y;
    t = __builtin_amdgcn_cvt_pk_f32_fp8((int)v.z, true);  f[10] = t.x; f[11] = t.y;
    t = __builtin_amdgcn_cvt_pk_f32_fp8((int)v.w, false); f[12] = t.x; f[13] = t.y;
    t = __builtin_amdgcn_cvt_pk_f32_fp8((int)v.w, true);  f[14] = t.x; f[15] = t.y;
}

__device__ __forceinline__ int idof16(const u32x4 (&q)[2], int i) {
    unsigned wv = (i >> 1) == 0 ? q[0].x : (i >> 1) == 1 ? q[0].y : (i >> 1) == 2 ? q[0].z : (i >> 1) == 3 ? q[0].w
                : (i >> 1) == 4 ? q[1].x : (i >> 1) == 5 ? q[1].y : (i >> 1) == 6 ? q[1].z : q[1].w;
    return (i & 1) ? (int)(wv >> 16) : (int)(wv & 0xffffu);
}
__device__ __forceinline__ void phase_gather_u(const Params& P, int L) {
    char* ws = opq(P.ws);
    const unsigned char* U8 = (const unsigned char*)(ws + OFF_UB) + (size_t)L * NEXP * DM;
    float* part = (float*)(ws + OFF_PART);
    const unsigned short* ids = (const unsigned short*)(ws + OFF_IDS);
    const float* hin = opq(P.out);
    const int tid = opaque_tid(), w = tid >> 6, l = tid & 63, c = l & 7, gq = l >> 3;
    const int j = blockIdx.x & 7, rk = blockIdx.x >> 3, nb = gridDim.x >> 3;
    if (rk >= nb) return;
    const unsigned char* ubase = U8 + (size_t)j * NEXP * 128 + c * 16;
    const int stride = nb * 4;
    int t = rk * 4 + w;
    if (t >= TOK) return;
    u32x4 idA[2], idB[2];
    u32x4 rv[16];
    f32x4 hA[4], hB[4];
    auto load_ids = [&](int tt, u32x4 (&idq)[2]) {
        const u32x4* i4 = (const u32x4*)(ids + (size_t)tt * 128 + 16 * gq);
        idq[0] = i4[0]; idq[1] = i4[1];
    };
    auto load_hx = [&](int tt, f32x4 (&hx)[4]) {
        const f32x4* h4 = (const f32x4*)(hin + (size_t)tt * 1024 + 128 * j + 16 * c);
#pragma unroll
        for (int q = 0; q < 4; ++q) hx[q] = h4[q];
    };
    auto step = [&](int tcur, int tnext, int tnext2, const u32x4 (&idn)[2], u32x4 (&idl)[2], const f32x4 (&hc)[4], f32x4 (&hn)[4]) {
        load_ids(tnext2, idl);
        load_hx(tnext, hn);
        __builtin_amdgcn_sched_barrier(0);
        float pr[16];
#pragma unroll
        for (int i = 0; i < 16; ++i) {
            float f[16];
            asm volatile("" : "+v"(rv[i].x), "+v"(rv[i].y), "+v"(rv[i].z), "+v"(rv[i].w));
            dec16(rv[i], f);
            rv[i] = *(const u32x4*)(ubase + (size_t)idof16(idn, i) * 128);
            __builtin_amdgcn_sched_barrier(0);
            float s0 = 0.f, s1 = 0.f;
#pragma unroll
            for (int q = 0; q < 4; ++q) {
                s0 += f[4 * q] * hc[q].x; s1 += f[4 * q + 1] * hc[q].y; s0 += f[4 * q + 2] * hc[q].z; s1 += f[4 * q + 3] * hc[q].w;
            }
            float sacc = s0 + s1;
            asm volatile("" : "+v"(sacc));
            pr[i] = sacc;
        }
#pragma unroll
        for (int i = 0; i < 16; ++i) pr[i] = sum8_dpp(pr[i]);
        if (c == 0) {
            f32x4* o4 = (f32x4*)(part + ((size_t)j * TOK + tcur) * 128 + 16 * gq);
#pragma unroll
            for (int q = 0; q < 4; ++q) { f32x4 o = {pr[4 * q], pr[4 * q + 1], pr[4 * q + 2], pr[4 * q + 3]}; o4[q] = o; }
        }
    };
    auto clampt = [&](int tt, int fb) { return tt < TOK ? tt : fb; };
    load_ids(t, idA);
#pragma unroll
    for (int i = 0; i < 16; ++i) rv[i] = *(const u32x4*)(ubase + (size_t)idof16(idA, i) * 128);
    load_hx(t, hA);
    load_ids(clampt(t + stride, t), idB);
    for (;;) {
        int tn = t + stride, tn2 = t + 2 * stride;
        step(t, clampt(tn, t), clampt(tn2, t), idB, idA, hA, hB);
        if (tn >= TOK) break;
        t = tn; tn = t + stride; tn2 = t + 2 * stride;
        step(t, clampt(tn, t), clampt(tn2, t), idA, idB, hB, hA);
        if (tn >= TOK) break;
        t = tn;
    }
}

__device__ __forceinline__ void phase_gather_act(const Params& P, int L, const float* ss_ffn) {
    char* ws = opq(P.ws);
    const float* part = (const float*)(ws + OFF_PART);
    const unsigned short* ids = (const unsigned short*)(ws + OFF_IDS);
    float* gates = (float*)(ws + OFF_GATE);
    const float* uinv = (const float*)(ws + OFF_TSC) + L * NEXP;
    const float* vinv = (const float*)(ws + OFF_TSC) + (2 + L) * NEXP;
    const int tid = opaque_tid(), w = tid >> 6, l = tid & 63;
    for (int t = blockIdx.x * 4 + w; t < TOK; t += gridDim.x * 4) {
        float rs = row_rs8(ss_ffn, t);
#pragma unroll
        for (int hsel = 0; hsel < 2; ++hsel) {
            int k = l + 64 * hsel;
            float sacc = 0.f;
#pragma unroll
            for (int j = 0; j < 8; ++j) sacc += part[((size_t)j * TOK + t) * 128 + k];
            int id = ids[(size_t)t * 128 + k];
            float pre = sacc * rs * uinv[id];
            gates[(size_t)t * 128 + k] = gates[(size_t)t * 128 + k] * gelu_exact(pre) * vinv[id];
        }
    }
}

__device__ __forceinline__ void phase_gather_v(const Params& P, int L, int hsel, float* ss_ple) {
    char* ws = opq(P.ws);
    bf16* hb_out = (bf16*)(ws + (hsel ? OFF_HB1 : OFF_HB0));
    const unsigned char* V8 = (const unsigned char*)(ws + OFF_VB) + (size_t)L * NEXP * DM;
    const unsigned short* ids = (const unsigned short*)(ws + OFF_IDS);
    const float* act = (const float*)(ws + OFF_GATE);
    float* hio = opq(P.out);
    const int tid = opaque_tid(), w = tid >> 6, l = tid & 63, c = l & 7, gq = l >> 3;
    const int j = blockIdx.x & 7, rk = blockIdx.x >> 3, nb = gridDim.x >> 3;
    if (rk >= nb) return;
    const unsigned char* vbase = V8 + (size_t)j * NEXP * 128 + c * 16;
    const int stride = nb * 4;
    int t = rk * 4 + w;
    if (t >= TOK) return;
    u32x4 idA[2], idB[2];
    u32x4 rv[16];
    f32x4 aA[4], aB[4];
    auto load_ids = [&](int tt, u32x4 (&idq)[2]) {
        const u32x4* i4 = (const u32x4*)(ids + (size_t)tt * 128 + 16 * gq);
        idq[0] = i4[0]; idq[1] = i4[1];
    };
    auto load_a = [&](int tt, f32x4 (&ax)[4]) {
        const f32x4* a4 = (const f32x4*)(act + (size_t)tt * 128 + 16 * gq);
#pragma unroll
        for (int q = 0; q < 4; ++q) ax[q] = a4[q];
    };
    auto step = [&](int tcur, int tnext, int tnext2, const u32x4 (&idn)[2], u32x4 (&idl)[2], const f32x4 (&ac)[4], f32x4 (&an)[4]) {
        load_ids(tnext2, idl);
        load_a(tnext, an);
        __builtin_amdgcn_sched_barrier(0);
        float acc[16];
#pragma unroll
        for (int e = 0; e < 16; ++e) acc[e] = 0.f;
#pragma unroll
        for (int i = 0; i < 16; ++i) {
            float f[16];
            asm volatile("" : "+v"(rv[i].x), "+v"(rv[i].y), "+v"(rv[i].z), "+v"(rv[i].w));
            dec16(rv[i], f);
            rv[i] = *(const u32x4*)(vbase + (size_t)idof16(idn, i) * 128);
            __builtin_amdgcn_sched_barrier(0);
            const float a = (i & 3) == 0 ? ac[i >> 2].x : (i & 3) == 1 ? ac[i >> 2].y : (i & 3) == 2 ? ac[i >> 2].z : ac[i >> 2].w;
#pragma unroll
            for (int e = 0; e < 16; ++e) acc[e] += a * f[e];
            asm volatile("" : "+v"(acc[0]), "+v"(acc[1]), "+v"(acc[2]), "+v"(acc[3]), "+v"(acc[4]), "+v"(acc[5]), "+v"(acc[6]), "+v"(acc[7]),
                              "+v"(acc[8]), "+v"(acc[9]), "+v"(acc[10]), "+v"(acc[11]), "+v"(acc[12]), "+v"(acc[13]), "+v"(acc[14]), "+v"(acc[15]));
        }
#pragma unroll
        for (int e = 0; e < 16; ++e) acc[e] = sumg_dpp(acc[e]);
        float ssq = 0.f;
        if (gq == 0) {
            f32x4* h4 = (f32x4*)(hio + (size_t)tcur * 1024 + 128 * j + 16 * c);
            float hv[16];
#pragma unroll
            for (int q = 0; q < 4; ++q) {
                f32x4 v = h4[q];
                hv[4 * q] = v.x + acc[4 * q]; hv[4 * q + 1] = v.y + acc[4 * q + 1]; hv[4 * q + 2] = v.z + acc[4 * q + 2]; hv[4 * q + 3] = v.w + acc[4 * q + 3];
                f32x4 o = {hv[4 * q], hv[4 * q + 1], hv[4 * q + 2], hv[4 * q + 3]};
                h4[q] = o;
            }
#pragma unroll
            for (int e = 0; e < 16; ++e) ssq += hv[e] * hv[e];
            u32x4 b0 = {pack2(hv[0], hv[1]), pack2(hv[2], hv[3]), pack2(hv[4], hv[5]), pack2(hv[6], hv[7])};
            u32x4 b1 = {pack2(hv[8], hv[9]), pack2(hv[10], hv[11]), pack2(hv[12], hv[13]), pack2(hv[14], hv[15])};
            u32x4* hb4 = (u32x4*)(hb_out + (size_t)tcur * 1024 + 128 * j + 16 * c);
            hb4[0] = b0; hb4[1] = b1;
        }
        ssq = sum8_dpp(ssq);
        if (l == 0) ss_ple[(size_t)tcur * 8 + j] = ssq;
    };
    auto clampt = [&](int tt, int fb) { return tt < TOK ? tt : fb; };
    load_ids(t, idA);
#pragma unroll
    for (int i = 0; i < 16; ++i) rv[i] = *(const u32x4*)(vbase + (size_t)idof16(idA, i) * 128);
    load_a(t, aA);
    load_ids(clampt(t + stride, t), idB);
    for (;;) {
        int tn = t + stride, tn2 = t + 2 * stride;
        step(t, clampt(tn, t), clampt(tn2, t), idB, idA, aA, aB);
        if (tn >= TOK) break;
        t = tn; tn = t + stride; tn2 = t + 2 * stride;
        step(t, clampt(tn, t), clampt(tn2, t), idA, idB, aB, aA);
        if (tn >= TOK) break;
        t = tn;
    }
}

__device__ __forceinline__ void phase_ple(const Params& P, int L, int hsel, const float* ss_ple, float* ss_out) {
    char* ws = opq(P.ws);
    const bf16* hb_in = (const bf16*)(ws + (hsel ? OFF_HB1 : OFF_HB0));
    bf16* hb_out = (bf16*)(ws + (hsel ? OFF_HB0 : OFF_HB1));
    float* hio = opq(P.out);
    const float* pin = opq(P.p) + (size_t)L * TOK * 256;
    const bf16* Wg = (const bf16*)(ws + OFF_WG) + (size_t)L * 1024 * 1024;
    const bf16* Wp = (const bf16*)(ws + OFF_WP) + (size_t)L * 1024 * 256;
    const int tid = opaque_tid(), w = tid >> 6, l = tid & 63, hh = l >> 5, wm = w >> 1, wn = w & 1;
    for (int tile = blockIdx.x; tile < 128 * 8; tile += gridDim.x) {
        int mt = tile >> 3, nt = tile & 7;
        int m0 = mt * 128, n0 = nt * 128;
        f32x16 acc1[2][2], acc2[2][2];
        ZERO_ACC(acc1);
        ZERO_ACC(acc2);
        gemm_core<0>(acc1, hb_in, 1024, Wg, 1024, 1024, m0, n0, NoScale());
        gemm_core<1>(acc2, pin, 256, Wp, 256, 256, m0, n0, NoScale());
        float part[2][16];
#pragma unroll
        for (int i = 0; i < 2; ++i) {
            int rbase = m0 + wm * 64 + i * 32 + 4 * hh;
#pragma unroll
            for (int rr = 0; rr < 16; ++rr) {
                int row = rbase + (rr & 3) + 8 * (rr >> 2);
                float rs = row_rs8(ss_ple, row);
                float ps = 0.f;
#pragma unroll
                for (int j = 0; j < 2; ++j) {
                    int col = n0 + wn * 64 + j * 32 + (l & 31);
                    size_t idx = (size_t)row * 1024 + col;
                    float gte = 1.f / (1.f + __expf(-acc1[i][j][rr] * rs));
                    float v = hio[idx] + gte * acc2[i][j][rr];
                    hio[idx] = v;
                    hb_out[idx] = (bf16)v;
                    ps += v * v;
                }
                part[i][rr] = ps;
            }
        }
        rowss_flush(part, ss_out, m0, nt);
    }
}

__device__ __forceinline__ void phase_final(const Params& P, const float* ss) {
    float* hio = opq(P.out);
    const int tid = opaque_tid(), w = tid >> 6, l = tid & 63;
    const float4* g4 = (const float4*)P.final_norm_g;
    for (int t = blockIdx.x * 4 + w; t < TOK; t += gridDim.x * 4) {
        float rs = row_rs8(ss, t);
        float4* o4 = (float4*)(hio + (size_t)t * 1024);
#pragma unroll
        for (int i = 0; i < 4; ++i) {
            float4 v = o4[i * 64 + l], g = g4[i * 64 + l];
            v.x *= rs * g.x; v.y *= rs * g.y; v.z *= rs * g.z; v.w *= rs * g.w;
            o4[i * 64 + l] = v;
        }
    }
}

#define XB_TMO      128
#define XB_XCNT(j)  (256  + 64 * (j))
#define XB_XSUB(j)  (1280 + 64 * (j))
#define XB_XGEN(j)  (2304 + 64 * (j))
#define XB_TOP      3328
#define XB_TOPGEN   3392
#define XCD_BAR_WORDS 3456
#define XB_SPIN_CAP (1u << 22)
__device__ __forceinline__ unsigned xb_ld(unsigned* p) { return __hip_atomic_load(p, __ATOMIC_RELAXED, __HIP_MEMORY_SCOPE_AGENT); }
__device__ __forceinline__ unsigned xb_add(unsigned* p, unsigned v) { return __hip_atomic_fetch_add(p, v, __ATOMIC_RELAXED, __HIP_MEMORY_SCOPE_AGENT); }
__device__ __forceinline__ unsigned xb_xcc_id() { return (unsigned)__builtin_amdgcn_s_getreg((3 << 11) | 20) & 0xFu; }
#define XB_SPIN(cond, bar) do { unsigned _sp = 0; while (cond) { __builtin_amdgcn_s_sleep(1); \
    if ((++_sp & 255u) == 0u) { if (xb_ld(&(bar)[XB_TMO])) break; if (_sp > XB_SPIN_CAP) { atomicAdd(&(bar)[XB_TMO], 1u); break; } } } } while (0)
struct XcdBarrier { unsigned* bar; unsigned x, nloc, nx; };
__device__ __forceinline__ XcdBarrier xcd_barrier_post(unsigned* bar) {
    XcdBarrier b; b.bar = bar; b.x = xb_xcc_id(); b.nloc = 0u; b.nx = 0u;
    if (threadIdx.x == 0) (void)xb_add(&bar[XB_XCNT(b.x)], 1u);
    return b;
}
__device__ __forceinline__ void xcd_barrier_complete(unsigned* bar, unsigned x, unsigned& nloc, unsigned& nx) {
    const unsigned G = gridDim.x;
    unsigned sum, cnt, mine, sp = 0u;
    for (;;) {
        sum = 0u; cnt = 0u; mine = 0u;
#pragma unroll
        for (unsigned j = 0; j < 16; ++j) { const unsigned c = xb_ld(&bar[XB_XCNT(j)]); sum += c; cnt += (c > 0u) ? 1u : 0u; mine = (j == x) ? c : mine; }
        if (sum == G) break;
        __builtin_amdgcn_s_sleep(1);
        if ((++sp & 255u) == 0u) { if (xb_ld(&bar[XB_TMO])) break; if (sp > XB_SPIN_CAP) { atomicAdd(&bar[XB_TMO], 1u); break; } }
    }
    nloc = mine > 0u ? mine : 1u; nx = cnt > 0u ? cnt : 1u;
}
__device__ __forceinline__ void grid_barrier(XcdBarrier& b) {
    asm volatile("s_waitcnt vmcnt(0)" ::: "memory");
    __syncthreads();
    if (threadIdx.x == 0) {
        unsigned* bar = b.bar;
        __builtin_amdgcn_s_waitcnt(0);
        if (b.nloc == 0u) xcd_barrier_complete(bar, b.x, b.nloc, b.nx);
        const unsigned nloc = b.nloc, nx = b.nx;
        const unsigned old = xb_add(&bar[XB_XSUB(b.x)], 1u);
        const unsigned gen = old / nloc;
        if (old + 1u == (gen + 1u) * nloc) {
            __builtin_amdgcn_fence(__ATOMIC_RELEASE, "agent");
            asm volatile("s_waitcnt vmcnt(0)" ::: "memory");
            const unsigned og = xb_add(&bar[XB_TOP], 1u);
            const unsigned tg = og / nx;
            if (og + 1u == (tg + 1u) * nx) xb_add(&bar[XB_TOPGEN], 1u);
            else XB_SPIN(xb_ld(&bar[XB_TOPGEN]) == tg, bar);
            __builtin_amdgcn_fence(__ATOMIC_ACQUIRE, "agent");
            xb_add(&bar[XB_XGEN(b.x)], 1u);
            asm volatile("s_waitcnt vmcnt(0)" ::: "memory");
        } else {
            XB_SPIN(xb_ld(&bar[XB_XGEN(b.x)]) == gen, bar);
            __builtin_amdgcn_fence(__ATOMIC_ACQUIRE, "agent");
            asm volatile("s_waitcnt vmcnt(0)" ::: "memory");
        }
    }
    __syncthreads();
}

__global__ void __launch_bounds__(NTHR, 2) hymba_megakernel(Params P) {
    cg::grid_group grid = cg::this_grid();
    char* ws = opq(P.ws);
    float* ssa = (float*)(ws + OFF_SSA);
    XcdBarrier bar = xcd_barrier_post((unsigned*)(ws + OFF_BAR));
#define BAR() do { grid_barrier(bar); if (DUP == 20) grid_barrier(bar); } while (0)
    phase0(P);
    if (DUP == 0) { asm volatile("s_waitcnt vmcnt(0)" ::: "memory"); __syncthreads(); grid_barrier(bar); phase0(P); }
    asm volatile("s_waitcnt vmcnt(0)" ::: "memory");
    __syncthreads();
    grid.sync();
    BAR();
    int cur = 0;
    for (int L = 0; L < 2; ++L) {
        const float* ss_mix = (L == 0) ? ssa : (ssa + 3 * TOK * 8);
        float* ss_ffn = ssa + (size_t)(1 + L) * TOK * 8;
        float* ss_next = (L == 0) ? (ssa + 3 * TOK * 8) : (ssa + 4 * TOK * 8);
        float* ss_ple = ssa + (size_t)(5 + L) * TOK * 8;
        phase_proj(P, L, cur, ss_mix);
        BAR();
        if (DUP == 1) { phase_proj(P, L, cur, ss_mix); BAR(); }
        phase_mla_up(P, L);
        BAR();
        if (DUP == 2) { phase_mla_up(P, L); BAR(); }
        phase_attn(P, L, 0);
        BAR();
        if (DUP == 3) { phase_attn(P, L, 1); BAR(); }
        phase_wo(P, L, cur ^ 1, ss_ffn);
        BAR();
        if (DUP == 4 && L == 0) { phase_wo(P, L, cur ^ 1, ss_ffn); BAR(); }
        phase_pq(P, L, cur ^ 1, ss_ffn);
        BAR();
        if (DUP == 5) { phase_pq(P, L, cur ^ 1, ss_ffn); BAR(); }
        phase_topk(P, L);
        BAR();
        if (DUP == 6) { phase_topk(P, L); BAR(); }
        phase_gather_u(P, L);
        BAR();
        if (DUP == 7) { phase_gather_u(P, L); BAR(); }
        phase_gather_act(P, L, ss_ffn);
        BAR();
        phase_gather_v(P, L, cur, ss_ple);
        BAR();
        phase_ple(P, L, cur, ss_ple, ss_next);
        BAR();
        cur ^= 1;
    }
    phase_final(P, ssa + 4 * TOK * 8);
}

extern "C" void kernel_launch(void* const* d_in, const int* in_sizes, int n_in, void* d_out, int out_size, void* d_ws,
                              size_t ws_size, hipStream_t stream) {
    static int grid_blocks = 0;
    if (!grid_blocks) {
        int dev = 0, cus = 0, per_cu = 0;
        hipGetDevice(&dev);
        hipDeviceGetAttribute(&cus, hipDeviceAttributeMultiprocessorCount, dev);
        hipOccupancyMaxActiveBlocksPerMultiprocessor(&per_cu, hymba_megakernel, NTHR, 0);
        if (per_cu > 2) per_cu = 2;
        if (per_cu < 1) per_cu = 1;
        grid_blocks = cus * per_cu;
        if (ws_size < WS_END) fprintf(stderr, "workspace too small: %zu < %zu\n", ws_size, (size_t)WS_END);
    }
    Params P{};
    P.x = (const float*)d_in[0]; P.p = (const float*)d_in[1]; P.pos = (const int*)d_in[2];
    P.norm_mix_g = (const float*)d_in[3]; P.w_in = (const float*)d_in[4]; P.b_forget = (const float*)d_in[5];
    P.mla_q_norm_g = (const float*)d_in[6]; P.w_uq = (const float*)d_in[7]; P.mla_kv_norm_g = (const float*)d_in[8];
    P.w_ukv = (const float*)d_in[9]; P.mix_out_norm_g = (const float*)d_in[10]; P.w_o = (const float*)d_in[11];
    P.norm_ffn_g = (const float*)d_in[12]; P.w_query = (const float*)d_in[13]; P.sub_keys = (const float*)d_in[14];
    P.peer_u = (const float*)d_in[15]; P.peer_v = (const float*)d_in[16]; P.w_ple = (const float*)d_in[17];
    P.ple_norm_g = (const float*)d_in[18]; P.w_ple_gate = (const float*)d_in[19]; P.final_norm_g = (const float*)d_in[20];
    P.out = (float*)d_out; P.ws = (char*)d_ws;
    hipMemsetAsync((char*)d_ws + OFF_BAR, 0, 16384 + 4096, stream);
    void* args[] = {&P};
    hipError_t e = hipLaunchCooperativeKernel((void*)hymba_megakernel, dim3(grid_blocks), dim3(NTHR), args, 0, stream);
    if (e != hipSuccess) fprintf(stderr, "cooperative launch failed: %s (grid %d)\n", hipGetErrorString(e), grid_blocks);
}
```

```cpp
#include <hip/hip_runtime.h>
#include <hip/hip_cooperative_groups.h>
#include <cstdio>
#include <cstdint>
#include <math.h>
#include <climits>
namespace cg = cooperative_groups;

typedef __bf16 bf16;
typedef __bf16 bf16x8 __attribute__((ext_vector_type(8)));
typedef __bf16 bf16x4 __attribute__((ext_vector_type(4)));
typedef __bf16 bf16x2 __attribute__((ext_vector_type(2)));
typedef float f32x16 __attribute__((ext_vector_type(16)));
typedef float f32x4 __attribute__((ext_vector_type(4)));
typedef float f32x2 __attribute__((ext_vector_type(2)));
typedef unsigned u32x4 __attribute__((ext_vector_type(4)));
typedef unsigned u32x2 __attribute__((ext_vector_type(2)));

#define SEQ 2048
#define BATCH 8
#define TOK 16384
#define DM 1024
#define IN_W 1956
#define NEXP 16384
#define EPSF 1e-6f
#define LOG2E 1.4426950408889634f
#define NTHR 256
#define LDS_BYTES 65536
#ifndef DUP
#define DUP -1
#endif

constexpr size_t MBy = 1ull << 20;
constexpr size_t OFF_UB = 0;
constexpr size_t OFF_VB = 32 * MBy;
constexpr size_t OFF_PART = 64 * MBy;
constexpr size_t OFF_WIN = 128 * MBy;
constexpr size_t OFF_WO = 136 * MBy;
constexpr size_t OFF_WQ = 140 * MBy;
constexpr size_t OFF_WG = 144 * MBy;
constexpr size_t OFF_WP = 148 * MBy;
constexpr size_t OFF_WUQ = 149 * MBy;
constexpr size_t OFF_WUKV = 149 * MBy + 512 * 1024;
constexpr size_t OFF_SKB = 150 * MBy;
constexpr size_t OFF_CS = 151 * MBy;
constexpr size_t OFF_TSC = 153 * MBy;
constexpr size_t OFF_SSA = 154 * MBy;
constexpr size_t OFF_SSP = 157 * MBy;
constexpr size_t OFF_HB0 = 158 * MBy;
constexpr size_t OFF_HB1 = 190 * MBy;
constexpr size_t OFF_FQ = 222 * MBy;
constexpr size_t OFF_FK = 230 * MBy;
constexpr size_t OFF_FVT = 238 * MBy;
constexpr size_t OFF_SQ = 246 * MBy;
constexpr size_t OFF_SKK = 254 * MBy;
constexpr size_t OFF_SVT = 262 * MBy;
constexpr size_t OFF_CQ = 270 * MBy;
constexpr size_t OFF_CKV = 278 * MBy;
constexpr size_t OFF_FLOG = 282 * MBy;
constexpr size_t OFF_CUMF = 283 * MBy;
constexpr size_t OFF_MQ = 284 * MBy;
constexpr size_t OFF_MK = 296 * MBy;
constexpr size_t OFF_MVT = 308 * MBy;
constexpr size_t OFF_Y = 324 * MBy;
constexpr size_t OFF_PQ = 356 * MBy;
constexpr size_t OFF_IDS = 388 * MBy;
constexpr size_t OFF_GATE = 396 * MBy;
constexpr size_t OFF_BAR = 404 * MBy;
constexpr size_t OFF_CNT = OFF_BAR + 16384;
constexpr size_t OFF_SSY = 405 * MBy;
constexpr size_t WS_END = 408 * MBy;

struct Params {
    const float* x; const float* p; const int* pos;
    const float* norm_mix_g; const float* w_in; const float* b_forget; const float* mla_q_norm_g; const float* w_uq;
    const float* mla_kv_norm_g; const float* w_ukv; const float* mix_out_norm_g; const float* w_o; const float* norm_ffn_g;
    const float* w_query; const float* sub_keys; const float* peer_u; const float* peer_v; const float* w_ple;
    const float* ple_norm_g; const float* w_ple_gate; const float* final_norm_g;
    float* out; char* ws;
};

__shared__ __attribute__((aligned(16))) char smem[LDS_BYTES];

__device__ __forceinline__ int opaque_tid() { int t = threadIdx.x; asm volatile("" : "+v"(t)); return t; }
template <typename T> __device__ __forceinline__ T* opq(T* p) { size_t z = 0; asm volatile("" : "+s"(z)); return (T*)((char*)p + z); }

__device__ __forceinline__ unsigned pack2(float a, float b) {
    f32x2 v = {a, b};
    bf16x2 r = __builtin_convertvector(v, bf16x2);
    return __builtin_bit_cast(unsigned, r);
}
__device__ __forceinline__ float bflo(unsigned u) { return __uint_as_float(u << 16); }
__device__ __forceinline__ float bfhi(unsigned u) { return __uint_as_float(u & 0xffff0000u); }
__device__ __forceinline__ float wave_sum(float v) {
#pragma unroll
    for (int o = 32; o > 0; o >>= 1) v += __shfl_xor(v, o);
    return v;
}
template <int CTRL> __device__ __forceinline__ float dpp_add(float v) {
    return v + __builtin_bit_cast(float, __builtin_amdgcn_update_dpp(0, __builtin_bit_cast(int, v), CTRL, 0xf, 0xf, true));
}
__device__ __forceinline__ float sum8_dpp(float v) { v = dpp_add<0xB1>(v); v = dpp_add<0x4E>(v); v = dpp_add<0x141>(v); return v; }
__device__ __forceinline__ float sumg_dpp(float v) {
    v = dpp_add<0x128>(v);
    float a = v, b = v;
    asm volatile("s_nop 1\n\tv_permlane16_swap_b32 %0, %1\n\ts_nop 1" : "+v"(a), "+v"(b));
    v = a + b;
    a = v; b = v;
    asm volatile("s_nop 1\n\tv_permlane32_swap_b32 %0, %1\n\ts_nop 1" : "+v"(a), "+v"(b));
    return a + b;
}
__device__ __forceinline__ float fexp2(float x) { return __builtin_amdgcn_exp2f(x); }
__device__ __forceinline__ float flog2(float x) { return __builtin_amdgcn_logf(x); }
__device__ __forceinline__ float log_sigmoid_f(float z) { return fminf(z, 0.f) - log1pf(expf(-fabsf(z))); }

struct WJob { const float* src; int lds; int K; int Np; bf16* dst; const float* gain; int map; };

__device__ __forceinline__ int src_col_map(int map, int c) {
    if (map == 0) return c;
    if (map == 1) {
        if (c < 768) return c;
        if (c < 1952) return c + 4;
        if (c < 1956) return c - 1952 + 768;
        return -1;
    }
    if (c < 256) return 192 * (c >> 6) + (c & 63);
    int e = c - 256;
    return 192 * (e >> 7) + 64 + (e & 127);
}

__device__ __forceinline__ void wconv_tile(const WJob& j, int tile) {
    float* tl = (float*)smem;
    int ktiles = j.K >> 5;
    int nt = tile / ktiles, kt = tile % ktiles;
    int n0 = nt * 32, k0 = kt * 32;
    int tx = opaque_tid() & 31, ty = opaque_tid() >> 5;
    int sc = src_col_map(j.map, n0 + tx);
#pragma unroll
    for (int i = 0; i < 4; ++i) {
        int k = k0 + ty + 8 * i;
        float v = 0.f;
        if (sc >= 0) v = j.src[(size_t)k * j.lds + sc] * (j.gain ? j.gain[k] : 1.f);
        tl[(ty + 8 * i) * 33 + tx] = v;
    }
    __syncthreads();
#pragma unroll
    for (int i = 0; i < 4; ++i) {
        int n = n0 + ty + 8 * i;
        j.dst[(size_t)n * j.K + k0 + tx] = (bf16)tl[tx * 33 + ty + 8 * i];
    }
    __syncthreads();
}

__device__ __forceinline__ void phase0(const Params& P) {
    char* ws = opq(P.ws);
    const int G = gridDim.x, bid = blockIdx.x, tid = opaque_tid();
    {
        const int w = tid >> 6, l = tid & 63;
        float* tsc = (float*)(ws + OFF_TSC);
        for (int it = bid * 4 + w; it < 4 * NEXP; it += G * 4) {
            int tb = it >> 14, e = it & (NEXP - 1);
            const float* src = (tb < 2 ? P.peer_u : P.peer_v) + ((size_t)(tb & 1) * NEXP + e) * DM + l * 16;
            unsigned char* dst = (unsigned char*)(ws + (tb < 2 ? OFF_UB : OFF_VB)) + (size_t)(tb & 1) * NEXP * DM;
            float4 a = ((const float4*)src)[0], b = ((const float4*)src)[1], c = ((const float4*)src)[2], d = ((const float4*)src)[3];
            if (tb < 2) {
                const float4* g4 = (const float4*)(P.norm_ffn_g + (tb & 1) * 1024 + l * 16);
                float4 g0 = g4[0], g1 = g4[1], g2 = g4[2], g3 = g4[3];
                a.x *= g0.x; a.y *= g0.y; a.z *= g0.z; a.w *= g0.w; b.x *= g1.x; b.y *= g1.y; b.z *= g1.z; b.w *= g1.w;
                c.x *= g2.x; c.y *= g2.y; c.z *= g2.z; c.w *= g2.w; d.x *= g3.x; d.y *= g3.y; d.z *= g3.z; d.w *= g3.w;
            }
            float am = fmaxf(fmaxf(fmaxf(fabsf(a.x), fabsf(a.y)), fmaxf(fabsf(a.z), fabsf(a.w))), fmaxf(fmaxf(fabsf(b.x), fabsf(b.y)), fmaxf(fabsf(b.z), fabsf(b.w))));
            am = fmaxf(am, fmaxf(fmaxf(fmaxf(fabsf(c.x), fabsf(c.y)), fmaxf(fabsf(c.z), fabsf(c.w))), fmaxf(fmaxf(fabsf(d.x), fabsf(d.y)), fmaxf(fabsf(d.z), fabsf(d.w)))));
#pragma unroll
            for (int o = 32; o > 0; o >>= 1) am = fmaxf(am, __shfl_xor(am, o));
            int eb = ((__float_as_int(am) >> 23) & 0xff) - 127;
            eb = max(-100, min(100, eb));
            if (am == 0.f) eb = 7;
            float sc = __int_as_float((127 + 7 - eb) << 23), isc = __int_as_float((127 + eb - 7) << 23);
            int w0 = 0, w1 = 0, w2 = 0, w3 = 0;
            w0 = __builtin_amdgcn_cvt_pk_fp8_f32(a.x * sc, a.y * sc, w0, false); w0 = __builtin_amdgcn_cvt_pk_fp8_f32(a.z * sc, a.w * sc, w0, true);
            w1 = __builtin_amdgcn_cvt_pk_fp8_f32(b.x * sc, b.y * sc, w1, false); w1 = __builtin_amdgcn_cvt_pk_fp8_f32(b.z * sc, b.w * sc, w1, true);
            w2 = __builtin_amdgcn_cvt_pk_fp8_f32(c.x * sc, c.y * sc, w2, false); w2 = __builtin_amdgcn_cvt_pk_fp8_f32(c.z * sc, c.w * sc, w2, true);
            w3 = __builtin_amdgcn_cvt_pk_fp8_f32(d.x * sc, d.y * sc, w3, false); w3 = __builtin_amdgcn_cvt_pk_fp8_f32(d.z * sc, d.w * sc, w3, true);
            u32x4 o4 = {(unsigned)w0, (unsigned)w1, (unsigned)w2, (unsigned)w3};
            *(u32x4*)(dst + ((size_t)(l >> 3) * NEXP + e) * 128 + (l & 7) * 16) = o4;
            if (l == 0) tsc[tb * NEXP + e] = isc;
        }
    }
    {
        for (int L = 0; L < 2; ++L) {
            WJob jobs[7];
            jobs[0] = {P.w_in + (size_t)L * 1024 * IN_W, IN_W, 1024, 2048, (bf16*)(ws + OFF_WIN) + (size_t)L * 2048 * 1024, P.norm_mix_g + L * 1024, 1};
            jobs[1] = {P.w_o + (size_t)L * 1024 * 1024, 1024, 1024, 1024, (bf16*)(ws + OFF_WO) + (size_t)L * 1024 * 1024, P.mix_out_norm_g + L * 1024, 0};
            jobs[2] = {P.w_query + (size_t)L * 1024 * 1024, 1024, 1024, 1024, (bf16*)(ws + OFF_WQ) + (size_t)L * 1024 * 1024, P.norm_ffn_g + L * 1024, 0};
            jobs[3] = {P.w_ple_gate + (size_t)L * 1024 * 1024, 1024, 1024, 1024, (bf16*)(ws + OFF_WG) + (size_t)L * 1024 * 1024, P.ple_norm_g + L * 1024, 0};
            jobs[4] = {P.w_ple + (size_t)L * 256 * 1024, 1024, 256, 1024, (bf16*)(ws + OFF_WP) + (size_t)L * 1024 * 256, nullptr, 0};
            jobs[5] = {P.w_uq + (size_t)L * 256 * 384, 384, 256, 384, (bf16*)(ws + OFF_WUQ) + (size_t)L * 384 * 256, P.mla_q_norm_g + L * 256, 0};
            jobs[6] = {P.w_ukv + (size_t)L * 128 * 768, 768, 128, 768, (bf16*)(ws + OFF_WUKV) + (size_t)L * 768 * 128, P.mla_kv_norm_g + L * 128, 2};
#pragma unroll
            for (int q = 0; q < 7; ++q) {
                int nt = (jobs[q].Np >> 5) * (jobs[q].K >> 5);
                for (int it = bid; it < nt; it += G) wconv_tile(jobs[q], it);
            }
        }
    }
    {
        const float* src = P.sub_keys;
        bf16* dst = (bf16*)(ws + OFF_SKB);
        for (int i = bid * NTHR + tid; i < 262144 / 2; i += G * NTHR) {
            float2 v = ((const float2*)src)[i];
            ((unsigned*)dst)[i] = pack2(v.x, v.y);
        }
    }
    {
        bf16* hb = (bf16*)(ws + OFF_HB0);
        float* ss0 = (float*)(ws + OFF_SSA);
        int w = tid >> 6, l = tid & 63;
        for (int row = bid * 4 + w; row < TOK; row += G * 4) {
            const float4* xr = (const float4*)(P.x + (size_t)row * DM);
            float ss = 0.f;
#pragma unroll
            for (int i = 0; i < 2; ++i) {
                float4 a = xr[i * 128 + l * 2], b = xr[i * 128 + l * 2 + 1];
                ss += a.x * a.x + a.y * a.y + a.z * a.z + a.w * a.w + b.x * b.x + b.y * b.y + b.z * b.z + b.w * b.w;
                uint4 o;
                o.x = pack2(a.x, a.y); o.y = pack2(a.z, a.w); o.z = pack2(b.x, b.y); o.w = pack2(b.z, b.w);
                ((uint4*)(hb + (size_t)row * DM))[i * 64 + l] = o;
            }
            ss = wave_sum(ss);
            if (l == 0) {
                *(float4*)(ss0 + (size_t)row * 8) = make_float4(ss, 0.f, 0.f, 0.f);
                *(float4*)(ss0 + (size_t)row * 8 + 4) = make_float4(0.f, 0.f, 0.f, 0.f);
            }
        }
    }
    {
        float* cs = (float*)(ws + OFF_CS);
        for (int i = bid * NTHR + tid; i < TOK * 16; i += G * NTHR) {
            int t = i >> 4, k = i & 15;
            float inv = powf(10000.0f, -(float)k / 16.0f);
            float ang = (float)P.pos[t] * inv;
            cs[2 * i] = cosf(ang);
            cs[2 * i + 1] = sinf(ang);
        }
    }
}

__device__ __forceinline__ int tile_off(int row, int chunk) {
    int line = row >> 1;
    return line * 256 + (((((row & 1) << 3) | chunk) ^ (line & 15)) << 4);
}
template <int AMODE, typename SF>
__device__ __forceinline__ void gemm_core(f32x16 (&acc)[2][2], const void* Ap, int lda, const bf16* Bt, int ldb, int K,
                                          int m0, int n0, SF scalef) {
    const int tid = opaque_tid(), w = tid >> 6, l = tid & 63, r = l & 31, hh = l >> 5;
    const int wm = w >> 1, wn = w & 1;
    const int lc = tid & 7, lr = tid >> 3;
    const int dp = (tid & 15) ^ (tid >> 4);
    const int drow = 2 * (tid >> 4) + (dp >> 3), dgc = (dp & 7) * 8;
    u32x4 ra[4];
    auto gloadA = [&](int k0) {
#pragma unroll
        for (int i = 0; i < 4; ++i) {
            int row = lr + 32 * i;
            if (AMODE == 1) {
                const float4* s = (const float4*)((const float*)Ap + (size_t)(m0 + row) * lda + k0 + lc * 8);
                float4 a = s[0], b = s[1];
                ra[i].x = pack2(a.x, a.y); ra[i].y = pack2(a.z, a.w); ra[i].z = pack2(b.x, b.y); ra[i].w = pack2(b.z, b.w);
            } else {
                ra[i] = *(const u32x4*)((const bf16*)Ap + (size_t)(m0 + row) * lda + k0 + lc * 8);
                float sc = scalef(i, k0);
                ra[i].x = pack2(bflo(ra[i].x) * sc, bfhi(ra[i].x) * sc);
                ra[i].y = pack2(bflo(ra[i].y) * sc, bfhi(ra[i].y) * sc);
                ra[i].z = pack2(bflo(ra[i].z) * sc, bfhi(ra[i].z) * sc);
                ra[i].w = pack2(bflo(ra[i].w) * sc, bfhi(ra[i].w) * sc);
            }
        }
    };
    auto lwriteA = [&](int buf) {
        char* base = smem + buf * 32768;
#pragma unroll
        for (int i = 0; i < 4; ++i) *(u32x4*)(base + tile_off(lr + 32 * i, lc)) = ra[i];
    };
    auto dma = [&](int buf, int k0) {
        char* base = smem + buf * 32768 + tid * 16;
#pragma unroll
        for (int i = 0; i < 4; ++i) {
            int row = drow + 32 * i;
            if (AMODE == 0)
                __builtin_amdgcn_global_load_lds((const unsigned*)((const bf16*)Ap + (size_t)(m0 + row) * lda + k0 + dgc), (unsigned*)(base + i * 4096), 16, 0, 0);
            __builtin_amdgcn_global_load_lds((const unsigned*)(Bt + (size_t)(n0 + row) * ldb + k0 + dgc), (unsigned*)(base + 16384 + i * 4096), 16, 0, 0);
        }
    };
    int offA[2], offB[2];
#pragma unroll
    for (int i = 0; i < 2; ++i) { offA[i] = ((wm * 64 + i * 32 + r) >> 1) * 256; offB[i] = 16384 + ((wn * 64 + i * 32 + r) >> 1) * 256; }
    const int pbase = ((r & 1) << 3), lx = (r >> 1) & 15;
    const int nk = K >> 6;
    dma(0, 0);
    if (AMODE != 0) { gloadA(0); lwriteA(0); }
    asm volatile("s_waitcnt vmcnt(0)" ::: "memory");
    __syncthreads();
    for (int kt = 0; kt < nk; ++kt) {
        if (kt + 1 < nk) {
            dma((kt + 1) & 1, (kt + 1) << 6);
            if (AMODE != 0) gloadA((kt + 1) << 6);
        }
        const char* base = smem + (kt & 1) * 32768;
#pragma unroll
        for (int s = 0; s < 4; ++s) {
            int ch = (((pbase | (2 * s + hh)) ^ lx) << 4);
            bf16x8 af[2], bfr[2];
#pragma unroll
            for (int i = 0; i < 2; ++i) af[i] = *(const bf16x8*)(base + offA[i] + ch);
#pragma unroll
            for (int j = 0; j < 2; ++j) bfr[j] = *(const bf16x8*)(base + offB[j] + ch);
#pragma unroll
            for (int i = 0; i < 2; ++i)
#pragma unroll
                for (int j = 0; j < 2; ++j) acc[i][j] = __builtin_amdgcn_mfma_f32_32x32x16_bf16(af[i], bfr[j], acc[i][j], 0, 0, 0);
        }
        if (AMODE != 0 && kt + 1 < nk) lwriteA((kt + 1) & 1);
        asm volatile("s_waitcnt vmcnt(0)" ::: "memory");
        __syncthreads();
    }
}
__device__ __forceinline__ float row_rs8(const float* part, int row) {
    float4 a = *(const float4*)(part + (size_t)row * 8), b = *(const float4*)(part + (size_t)row * 8 + 4);
    float ss = ((a.x + a.y) + (a.z + a.w)) + ((b.x + b.y) + (b.z + b.w));
    return rsqrtf(ss * (1.f / 1024.f) + EPSF);
}
__device__ __forceinline__ bool xcd_tile(int it, int MT, int NT, int& mt, int& nt) {
    const int G = gridDim.x, bid = blockIdx.x;
    if ((G & 7) == 0 && (MT & 7) == 0) {
        const int nbx = G >> 3, q = (bid >> 3) + it * nbx, per = (MT >> 3) * NT;
        if (q >= per) return false;
        mt = (bid & 7) * (MT >> 3) + q / NT; nt = q % NT;
        return true;
    }
    const int q = bid + it * G;
    if (q >= MT * NT) return false;
    mt = q / NT; nt = q % NT;
    return true;
}
struct NoScale { __device__ __forceinline__ float operator()(int, int) const { return 1.f; } };

#define ZERO_ACC(acc)                                  \
    _Pragma("unroll") for (int _i = 0; _i < 2; ++_i)   \
    _Pragma("unroll") for (int _j = 0; _j < 2; ++_j)   \
    _Pragma("unroll") for (int _r = 0; _r < 16; ++_r) acc[_i][_j][_r] = 0.f;


__device__ __forceinline__ void phase_proj(const Params& P, int L, int hsel, const float* ssrow) {
    char* ws = opq(P.ws);
    const bf16* hb = (const bf16*)(ws + (hsel ? OFF_HB1 : OFF_HB0));
    const bf16* Bt = (const bf16*)(ws + OFF_WIN) + (size_t)L * 2048 * 1024;
    bf16* fq = (bf16*)(ws + OFF_FQ); bf16* fk = (bf16*)(ws + OFF_FK); bf16* fvt = (bf16*)(ws + OFF_FVT);
    bf16* sq = (bf16*)(ws + OFF_SQ); bf16* sk = (bf16*)(ws + OFF_SKK); bf16* svt = (bf16*)(ws + OFF_SVT);
    bf16* cq = (bf16*)(ws + OFF_CQ); bf16* ckv = (bf16*)(ws + OFF_CKV);
    float* flog = (float*)(ws + OFF_FLOG);
    bf16* mk = (bf16*)(ws + OFF_MK);
    const float* cs = (const float*)(ws + OFF_CS);
    const int tid = opaque_tid(), w = tid >> 6, l = tid & 63, hh = l >> 5, wm = w >> 1, wn = w & 1;
    for (int it = 0;; ++it) {
        int mt, nt;
        if (!xcd_tile(it, 128, 16, mt, nt)) break;
        int m0 = mt * 128, n0 = nt * 128;
        f32x16 acc[2][2];
        ZERO_ACC(acc);
        gemm_core<0>(acc, hb, 1024, Bt, 1024, 1024, m0, n0, NoScale());
#pragma unroll
        for (int i = 0; i < 2; ++i) {
            float rs[16];
#pragma unroll
            for (int rr = 0; rr < 16; ++rr) {
                int row = m0 + wm * 64 + i * 32 + (rr & 3) + 8 * (rr >> 2) + 4 * hh;
                rs[rr] = row_rs8(ssrow, row);
            }
#pragma unroll
            for (int j = 0; j < 2; ++j) {
                int col = n0 + wn * 64 + j * 32 + (l & 31);
                int rbase = m0 + wm * 64 + i * 32 + 4 * hh;
                if (nt < 14 && nt != 4 && nt != 5 && nt != 10 && nt != 11) {
                    bf16* dst; int ld, c;
                    if (nt < 2) { dst = fq; ld = 256; c = col; }
                    else if (nt < 4) { dst = fk; ld = 256; c = col - 256; }
                    else if (nt < 8) { dst = sq; ld = 256; c = col - 768; }
                    else if (nt < 10) { dst = sk; ld = 256; c = col - 1024; }
                    else if (nt < 14) { dst = cq; ld = 256; c = col - 1536; }
                    if (nt == 14) { dst = ckv; ld = 128; c = col - 1792; }
#pragma unroll
                    for (int rr = 0; rr < 16; ++rr) {
                        int row = rbase + (rr & 3) + 8 * (rr >> 2);
                        dst[(size_t)row * ld + c] = (bf16)(acc[i][j][rr] * rs[rr]);
                    }
                } else if (nt == 14) {
                    int c = col - 1792;
#pragma unroll
                    for (int rr = 0; rr < 16; ++rr) {
                        int row = rbase + (rr & 3) + 8 * (rr >> 2);
                        ckv[(size_t)row * 128 + c] = (bf16)(acc[i][j][rr] * rs[rr]);
                    }
                } else if (nt == 4 || nt == 5 || nt == 10 || nt == 11) {
                    bf16* vt = (nt < 6) ? fvt : svt;
                    int c = col - ((nt < 6) ? 512 : 1280);
                    int b = m0 >> 11;
                    int s0 = (rbase & 2047);
                    bf16* base = vt + ((size_t)(b * 256 + c)) * SEQ + s0;
#pragma unroll
                    for (int g = 0; g < 4; ++g) {
                        uint2 o;
                        o.x = pack2(acc[i][j][4 * g] * rs[4 * g], acc[i][j][4 * g + 1] * rs[4 * g + 1]);
                        o.y = pack2(acc[i][j][4 * g + 2] * rs[4 * g + 2], acc[i][j][4 * g + 3] * rs[4 * g + 3]);
                        *(uint2*)(base + 8 * g) = o;
                    }
                } else {
                    if (wn == 0 && j == 0) {
                        int ci = l & 31, pi = ci & 15;
#pragma unroll
                        for (int rr = 0; rr < 16; ++rr) {
                            int row = rbase + (rr & 3) + 8 * (rr >> 2);
                            float v = acc[i][j][rr] * rs[rr];
                            float pv = __shfl_xor(v, 16);
                            float2 c_s = *(const float2*)(cs + ((size_t)row * 16 + pi) * 2);
                            float o = (ci < 16) ? (v * c_s.x - pv * c_s.y) : (pv * c_s.y + v * c_s.x);
                            bf16 ob = (bf16)o;
#pragma unroll
                            for (int h = 0; h < 4; ++h) mk[(size_t)row * 384 + h * 96 + 64 + ci] = ob;
                        }
                    } else if (wn == 0 && j == 1) {
                        int c = (l & 31);
                        if (c < 4) {
#pragma unroll
                            for (int rr = 0; rr < 16; ++rr) {
                                int row = rbase + (rr & 3) + 8 * (rr >> 2);
                                flog[(size_t)row * 4 + c] = acc[i][j][rr] * rs[rr];
                            }
                        }
                    }
                }
            }
        }
    }
}

struct RowScale4 { float s[4]; __device__ __forceinline__ float operator()(int i, int) const { return s[i]; } };

template <int KW>
__device__ __forceinline__ RowScale4 row_rms_prepass(const bf16* A, int lda, int m0) {
    const int tid = opaque_tid(), lc = tid & 7, lr = tid >> 3;
    RowScale4 rs;
#pragma unroll
    for (int i = 0; i < 4; ++i) {
        float ss = 0.f;
#pragma unroll
        for (int k0 = 0; k0 < KW; k0 += 64) {
            uint4 v = *(const uint4*)(A + (size_t)(m0 + lr + 32 * i) * lda + k0 + lc * 8);
            float a;
            a = bflo(v.x); ss += a * a; a = bfhi(v.x); ss += a * a;
            a = bflo(v.y); ss += a * a; a = bfhi(v.y); ss += a * a;
            a = bflo(v.z); ss += a * a; a = bfhi(v.z); ss += a * a;
            a = bflo(v.w); ss += a * a; a = bfhi(v.w); ss += a * a;
        }
        ss += __shfl_xor(ss, 1); ss += __shfl_xor(ss, 2); ss += __shfl_xor(ss, 4);
        rs.s[i] = rsqrtf(ss * (1.f / (float)KW) + EPSF);
    }
    return rs;
}

__device__ __forceinline__ void phase_mla_up(const Params& P, int L) {
    char* ws = opq(P.ws);
    const bf16* cq = (const bf16*)(ws + OFF_CQ); const bf16* ckv = (const bf16*)(ws + OFF_CKV);
    const bf16* wuq = (const bf16*)(ws + OFF_WUQ) + (size_t)L * 384 * 256;
    const bf16* wukv = (const bf16*)(ws + OFF_WUKV) + (size_t)L * 768 * 128;
    bf16* mq = (bf16*)(ws + OFF_MQ); bf16* mk = (bf16*)(ws + OFF_MK); bf16* mvt = (bf16*)(ws + OFF_MVT);
    const float* cs = (const float*)(ws + OFF_CS);
    const float* flog = (const float*)(ws + OFF_FLOG);
    float* cumF = (float*)(ws + OFF_CUMF);
    const int tid = opaque_tid(), w = tid >> 6, l = tid & 63, hh = l >> 5, wm = w >> 1, wn = w & 1;
    const int NQ = 128 * 3, NKV = 128 * 6, NCF = 8;
    for (int item = blockIdx.x; item < NQ + NKV + NCF; item += gridDim.x) {
        if (item < NQ) {
            int mt = item / 3, nt = item % 3;
            int m0 = mt * 128, n0 = nt * 128;
            RowScale4 rs = row_rms_prepass<256>(cq, 256, m0);
            f32x16 acc[2][2];
            ZERO_ACC(acc);
            gemm_core<2>(acc, cq, 256, wuq, 256, 256, m0, n0, rs);
#pragma unroll
            for (int i = 0; i < 2; ++i)
#pragma unroll
                for (int j = 0; j < 2; ++j) {
                    int c0 = n0 + wn * 64 + j * 32;
                    int col = c0 + (l & 31);
                    int rbase = m0 + wm * 64 + i * 32 + 4 * hh;
                    bool rot = (c0 % 96) == 64;
                    int ci = l & 31, pi = ci & 15;
#pragma unroll
                    for (int rr = 0; rr < 16; ++rr) {
                        int row = rbase + (rr & 3) + 8 * (rr >> 2);
                        float v = acc[i][j][rr];
                        if (rot) {
                            float pv = __shfl_xor(v, 16);
                            float2 c_s = *(const float2*)(cs + ((size_t)row * 16 + pi) * 2);
                            v = (ci < 16) ? (v * c_s.x - pv * c_s.y) : (pv * c_s.y + v * c_s.x);
                        }
                        mq[(size_t)row * 384 + col] = (bf16)v;
                    }
                }
        } else if (item < NQ + NKV) {
            int it2 = item - NQ;
            int mt = it2 / 6, nt = it2 % 6;
            int m0 = mt * 128, n0 = nt * 128;
            RowScale4 rs = row_rms_prepass<128>(ckv, 128, m0);
            f32x16 acc[2][2];
            ZERO_ACC(acc);
            gemm_core<2>(acc, ckv, 128, wukv, 128, 128, m0, n0, rs);
#pragma unroll
            for (int i = 0; i < 2; ++i)
#pragma unroll
                for (int j = 0; j < 2; ++j) {
                    int col = n0 + wn * 64 + j * 32 + (l & 31);
                    int rbase = m0 + wm * 64 + i * 32 + 4 * hh;
                    if (nt < 2) {
                        int dcol = (col >> 6) * 96 + (col & 63);
#pragma unroll
                        for (int rr = 0; rr < 16; ++rr) {
                            int row = rbase + (rr & 3) + 8 * (rr >> 2);
                            mk[(size_t)row * 384 + dcol] = (bf16)acc[i][j][rr];
                        }
                    } else {
                        int e = col - 256;
                        int b = m0 >> 11;
                        int s0 = rbase & 2047;
                        bf16* base = mvt + ((size_t)(b * 512 + e)) * SEQ + s0;
#pragma unroll
                        for (int g = 0; g < 4; ++g) {
                            uint2 o;
                            o.x = pack2(acc[i][j][4 * g], acc[i][j][4 * g + 1]);
                            o.y = pack2(acc[i][j][4 * g + 2], acc[i][j][4 * g + 3]);
                            *(uint2*)(base + 8 * g) = o;
                        }
                    }
                }
        } else {
            int seq = (item - NQ - NKV) * 4 + w;
            int b = seq >> 2, h = seq & 3;
            float bfv = P.b_forget[L * 4 + h];
            float vals[32];
            float run = 0.f;
#pragma unroll
            for (int i = 0; i < 32; ++i) {
                int s = l * 32 + i;
                float z = flog[((size_t)b * SEQ + s) * 4 + h] + bfv;
                run += log_sigmoid_f(z);
                vals[i] = run;
            }
            float tot = run, incl = tot;
#pragma unroll
            for (int o = 1; o < 64; o <<= 1) {
                float t = __shfl_up(incl, o);
                if (l >= o) incl += t;
            }
            float excl = incl - tot;
#pragma unroll
            for (int i = 0; i < 32; ++i) cumF[(size_t)seq * SEQ + l * 32 + i] = vals[i] + excl;
        }
    }
}

template <int MODE, int DK, int DV>
__device__ __forceinline__ void attn_item(const bf16* __restrict__ Q, int ldq, const bf16* __restrict__ Kg, int ldk,
                          const bf16* __restrict__ Vt, const float* __restrict__ cumF, bf16* __restrict__ Y,
                          float* __restrict__ ssy, int b, int h, int qb, float c1) {
    constexpr int KSTR = DK * 2 + 16;
    constexpr int VSTR = 144;
    constexpr int KBYTES = 64 * KSTR, VBYTES = DV * VSTR;
    constexpr int BUF = (KBYTES + VBYTES + 256 + 255) & ~255;
    static_assert(2 * BUF <= LDS_BYTES - 64, "lds");
    constexpr int KCH = DK / 8, KPT = (64 * KCH) / 256, VPT = (DV * 8) / 256;
    const int tid = opaque_tid(), w = tid >> 6, l = tid & 63, r = l & 31, hh = l >> 5;
    const int q0 = qb * 128;
    const int qrow = q0 + 32 * w + r;
    const size_t tok = (size_t)b * SEQ + qrow;
    const int bh = b * 4 + h;
    bf16x8 qf[DK / 16];
#pragma unroll
    for (int s = 0; s < DK / 16; ++s) qf[s] = *(const bf16x8*)(Q + tok * ldq + h * DK + 16 * s + 8 * hh);
    f32x16 o[DV / 32];
    const f32x16 zero16 = {0.f, 0.f, 0.f, 0.f, 0.f, 0.f, 0.f, 0.f, 0.f, 0.f, 0.f, 0.f, 0.f, 0.f, 0.f, 0.f};
#pragma unroll
    for (int d = 0; d < DV / 32; ++d) o[d] = zero16;
    float m = -1e30f, lsum = 0.f, R = 0.f;
    float Fq = 0.f;
    if (MODE == 0) Fq = cumF[(size_t)bh * SEQ + qrow] * LOG2E;
    const int nkt = (q0 + 128) >> 6;
    u32x4 kreg[KPT], vreg[VPT];
    float4 freg = {0.f, 0.f, 0.f, 0.f};
    auto gload = [&](int kt) {
#pragma unroll
        for (int i = 0; i < KPT; ++i) {
            int e = tid + 256 * i;
            int row = e / KCH, ch = e % KCH;
            kreg[i] = *(const u32x4*)(Kg + ((size_t)b * SEQ + kt * 64 + row) * ldk + h * DK + ch * 8);
        }
#pragma unroll
        for (int i = 0; i < VPT; ++i) {
            int e = tid + 256 * i;
            int row = e >> 3, ch = e & 7;
            vreg[i] = *(const u32x4*)(Vt + ((size_t)bh * DV + row) * SEQ + kt * 64 + ch * 8);
        }
        if (MODE == 0 && tid < 16) freg = *(const float4*)(cumF + (size_t)bh * SEQ + kt * 64 + tid * 4);
    };
    auto lwrite = [&](int buf) {
        char* base = smem + buf * BUF;
#pragma unroll
        for (int i = 0; i < KPT; ++i) {
            int e = tid + 256 * i;
            int row = e / KCH, ch = e % KCH;
            *(u32x4*)(base + row * KSTR + ch * 16) = kreg[i];
        }
#pragma unroll
        for (int i = 0; i < VPT; ++i) {
            int e = tid + 256 * i;
            int row = e >> 3, ch = e & 7;
            *(u32x4*)(base + KBYTES + row * VSTR + ch * 16) = vreg[i];
        }
        if (MODE == 0 && tid < 16) *(float4*)(base + KBYTES + VBYTES + tid * 16) = freg;
    };
    const int prow = (r & 0x13) | ((r & 4) << 1) | ((r & 8) >> 1);
    gload(MODE == 1 ? nkt - 1 : 0);
    lwrite(0);
    __syncthreads();
    for (int it = 0; it < nkt; ++it) {
        const int kt = (MODE == 1) ? (nkt - 1 - it) : it;
        if (it + 1 < nkt) gload((MODE == 1) ? (kt - 1) : (kt + 1));
        const char* base = smem + (it & 1) * BUF;
        const bool active = (kt * 64) <= (q0 + 32 * w + 31);
        if (active) {
            const bool needmask = (kt * 64 + 63) >= (q0 + 32 * w);
            f32x16 s[2];
#pragma unroll
            for (int sub = 0; sub < 2; ++sub) {
                s[sub] = zero16;
#pragma unroll
                for (int ks = 0; ks < DK / 16; ++ks) {
                    bf16x8 kf = *(const bf16x8*)(base + (sub * 32 + prow) * KSTR + (2 * ks + hh) * 16);
                    s[sub] = __builtin_amdgcn_mfma_f32_32x32x16_bf16(kf, qf[ks], s[sub], 0, 0, 0);
                }
            }
            bf16x8 pf[2][2];
            if (MODE != 1) {
                const float* Ft = (const float*)(base + KBYTES + VBYTES);
                float mx = -INFINITY;
                float tv[2][16];
#pragma unroll
                for (int sub = 0; sub < 2; ++sub)
#pragma unroll
                    for (int a = 0; a < 2; ++a) {
                        int kofs = sub * 32 + 16 * a + 8 * hh;
                        float fk[8];
                        if (MODE == 0) {
                            float4 f0 = *(const float4*)(Ft + kofs), f1 = *(const float4*)(Ft + kofs + 4);
                            fk[0] = f0.x; fk[1] = f0.y; fk[2] = f0.z; fk[3] = f0.w; fk[4] = f1.x; fk[5] = f1.y; fk[6] = f1.z; fk[7] = f1.w;
                        }
#pragma unroll
                        for (int j = 0; j < 8; ++j) {
                            int rr = 8 * a + j;
                            float v = s[sub][rr] * c1;
                            if (MODE == 0) v += Fq - fk[j] * LOG2E;
                            if (needmask && (kt * 64 + kofs + j > qrow)) v = -INFINITY;
                            tv[sub][rr] = v;
                            mx = fmaxf(mx, v);
                        }
                    }
                mx = fmaxf(mx, __shfl_xor(mx, 32));
                float mnew = fmaxf(m, mx);
                float alpha = fexp2(m - mnew);
                float rsum = 0.f;
#pragma unroll
                for (int sub = 0; sub < 2; ++sub)
#pragma unroll
                    for (int a = 0; a < 2; ++a) {
                        float pv[8];
#pragma unroll
                        for (int j = 0; j < 8; ++j) { pv[j] = fexp2(tv[sub][8 * a + j] - mnew); rsum += pv[j]; }
                        uint4 u;
                        u.x = pack2(pv[0], pv[1]); u.y = pack2(pv[2], pv[3]); u.z = pack2(pv[4], pv[5]); u.w = pack2(pv[6], pv[7]);
                        pf[sub][a] = __builtin_bit_cast(bf16x8, u);
                    }
                rsum += __shfl_xor(rsum, 32);
                lsum = lsum * alpha + rsum;
                m = mnew;
#pragma unroll
                for (int d = 0; d < DV / 32; ++d) o[d] = o[d] * alpha;
            } else {
#pragma unroll
                for (int sb = 0; sb < 2; ++sb) {
                    const int sub = 1 - sb;
                    float lsig[16], lneg[16];
                    float A0 = 0.f, A1 = 0.f;
#pragma unroll
                    for (int rr = 0; rr < 16; ++rr) {
                        int key = kt * 64 + sub * 32 + 16 * (rr >> 3) + 8 * hh + (rr & 7);
                        bool valid = key < qrow;
                        float z = s[sub][rr] * c1;
                        float e = fexp2(-fabsf(z));
                        float l1p = flog2(1.f + e);
                        float ls = fminf(z, 0.f) - l1p;
                        float ln = valid ? (ls - z) : 0.f;
                        lsig[rr] = valid ? ls : -INFINITY;
                        lneg[rr] = ln;
                        if (rr < 8) A0 += ln; else A1 += ln;
                    }
                    float B0 = __shfl_xor(A0, 32), B1 = __shfl_xor(A1, 32);
                    float base1 = (hh == 0) ? (R + B1) : R;
                    float base0 = (hh == 0) ? (R + B1 + A1 + B0) : (R + A1 + B1);
                    float wv[16];
                    float run = base1;
#pragma unroll
                    for (int j = 7; j >= 0; --j) { wv[8 + j] = fexp2(lsig[8 + j] + run); run += lneg[8 + j]; }
                    run = base0;
#pragma unroll
                    for (int j = 7; j >= 0; --j) { wv[j] = fexp2(lsig[j] + run); run += lneg[j]; }
                    R += A0 + A1 + B0 + B1;
#pragma unroll
                    for (int a = 0; a < 2; ++a) {
                        uint4 u;
                        u.x = pack2(wv[8 * a], wv[8 * a + 1]); u.y = pack2(wv[8 * a + 2], wv[8 * a + 3]);
                        u.z = pack2(wv[8 * a + 4], wv[8 * a + 5]); u.w = pack2(wv[8 * a + 6], wv[8 * a + 7]);
                        pf[sub][a] = __builtin_bit_cast(bf16x8, u);
                    }
                }
            }
#pragma unroll
            for (int d = 0; d < DV / 32; ++d)
#pragma unroll
                for (int sub = 0; sub < 2; ++sub)
#pragma unroll
                    for (int a = 0; a < 2; ++a) {
                        bf16x8 vf = *(const bf16x8*)(base + KBYTES + (d * 32 + r) * VSTR + (sub * 32 + 16 * a + 8 * hh) * 2);
                        o[d] = __builtin_amdgcn_mfma_f32_32x32x16_bf16(vf, pf[sub][a], o[d], 0, 0, 0);
                    }
        }
        if (it + 1 < nkt) lwrite((it + 1) & 1);
        __syncthreads();
    }
    float inv = (MODE == 1) ? 1.f : (1.f / lsum);
    float ssq = 0.f;
#pragma unroll
    for (int d = 0; d < DV / 32; ++d)
#pragma unroll
        for (int g = 0; g < 4; ++g) {
            float v0 = o[d][4 * g] * inv, v1 = o[d][4 * g + 1] * inv, v2 = o[d][4 * g + 2] * inv, v3 = o[d][4 * g + 3] * inv;
            ssq += v0 * v0 + v1 * v1 + v2 * v2 + v3 * v3;
            uint2 u; u.x = pack2(v0, v1); u.y = pack2(v2, v3);
            *(uint2*)(Y + tok * 1024 + h * DV + d * 32 + 8 * g + 4 * hh) = u;
        }
    ssq += __shfl_xor(ssq, 32);
    if (hh == 0) ssy[tok * 16 + h] = ssq;
}

__device__ __forceinline__ void phase_attn(const Params& P, int L, int rep = 0) {
    char* ws = opq(P.ws);
    int* cnt = (int*)(ws + OFF_CNT) + L * 64 + rep * 16;
    int* s_item = (int*)(smem + LDS_BYTES - 16);
    const float* cumF = (const float*)(ws + OFF_CUMF);
    bf16* Y = (bf16*)(ws + OFF_Y);
    float* ssy = (float*)(ws + OFF_SSY) + (size_t)L * TOK * 16;
    for (;;) {
        if (opaque_tid() == 0) *s_item = atomicAdd(cnt, 1);
        __syncthreads();
        int item = *s_item;
        __syncthreads();
        if (item >= 1536) break;
        int qb = 15 - item / 96;
        int rem = item % 96;
        int type = rem >> 5, bh = rem & 31;
        int b = bh >> 2, h = bh & 3;
        if (type == 0) {
            attn_item<2, 96, 128>((const bf16*)(ws + OFF_MQ), 384, (const bf16*)(ws + OFF_MK), 384, (const bf16*)(ws + OFF_MVT), cumF,
                                  Y + 512, ssy + 8, b, h, qb, 0.10206207261596577f * LOG2E);
        } else if (type == 1) {
            attn_item<1, 64, 64>((const bf16*)(ws + OFF_SQ), 256, (const bf16*)(ws + OFF_SKK), 256, (const bf16*)(ws + OFF_SVT), cumF,
                                 Y + 256, ssy + 4, b, h, qb, 0.125f * LOG2E);
        } else {
            attn_item<0, 64, 64>((const bf16*)(ws + OFF_FQ), 256, (const bf16*)(ws + OFF_FK), 256, (const bf16*)(ws + OFF_FVT), cumF,
                                 Y + 0, ssy + 0, b, h, qb, 0.125f * LOG2E);
        }
    }
}

__device__ __forceinline__ void rowss_flush(float (&part)[2][16], float* gss, int m0, int nt) {
    float* lss = (float*)smem;
    const int tid = opaque_tid(), w = tid >> 6, l = tid & 63, hh = l >> 5, wm = w >> 1, wn = w & 1;
#pragma unroll
    for (int i = 0; i < 2; ++i)
#pragma unroll
        for (int rr = 0; rr < 16; ++rr) {
            float v = part[i][rr];
            v += __shfl_xor(v, 1); v += __shfl_xor(v, 2); v += __shfl_xor(v, 4); v += __shfl_xor(v, 8); v += __shfl_xor(v, 16);
            if ((l & 31) == 0) lss[wn * 128 + wm * 64 + i * 32 + (rr & 3) + 8 * (rr >> 2) + 4 * hh] = v;
        }
    __syncthreads();
    if (tid < 128) gss[(size_t)(m0 + tid) * 8 + nt] = lss[tid] + lss[128 + tid];
    __syncthreads();
}

struct GroupScale {
    float s0[4], s1[4], s2[4];
    __device__ __forceinline__ float operator()(int i, int k0) const {
        float a = s0[i], b = s1[i], c = s2[i];
        float sel = (k0 < 256) ? 1.f : 0.f, sel2 = (k0 >= 256 && k0 < 512) ? 1.f : 0.f;
        return a * sel + b * sel2 + c * (1.f - sel - sel2);
    }
};

__device__ __forceinline__ void phase_wo(const Params& P, int L, int hsel, float* ss_out) {
    char* ws = opq(P.ws);
    bf16* hb_out = (bf16*)(ws + (hsel ? OFF_HB1 : OFF_HB0));
    const float* hin = (L == 0) ? opq(P.x) : (const float*)opq(P.out);
    float* hout = opq(P.out);
    const bf16* Y = (const bf16*)(ws + OFF_Y);
    const bf16* Bt = (const bf16*)(ws + OFF_WO) + (size_t)L * 1024 * 1024;
    const float* ssy = (const float*)(ws + OFF_SSY) + (size_t)L * TOK * 16;
    const int tid = opaque_tid(), w = tid >> 6, l = tid & 63, hh = l >> 5, wm = w >> 1, wn = w & 1;
    for (int it = 0;; ++it) {
        int mt, nt;
        if (!xcd_tile(it, 128, 8, mt, nt)) break;
        int m0 = mt * 128, n0 = nt * 128;
        GroupScale gs;
#pragma unroll
        for (int i = 0; i < 4; ++i) {
            int row = m0 + (tid >> 3) + 32 * i;
            float4 v0 = *(const float4*)(ssy + (size_t)row * 16), v1 = *(const float4*)(ssy + (size_t)row * 16 + 4), v2 = *(const float4*)(ssy + (size_t)row * 16 + 8);
            gs.s0[i] = rsqrtf(((v0.x + v0.y) + (v0.z + v0.w)) * (1.f / 256.f) + EPSF);
            gs.s1[i] = rsqrtf(((v1.x + v1.y) + (v1.z + v1.w)) * (1.f / 256.f) + EPSF);
            gs.s2[i] = rsqrtf(((v2.x + v2.y) + (v2.z + v2.w)) * (1.f / 512.f) + EPSF);
        }
        f32x16 acc[2][2];
        ZERO_ACC(acc);
        gemm_core<2>(acc, Y, 1024, Bt, 1024, 1024, m0, n0, gs);
        float part[2][16];
#pragma unroll
        for (int i = 0; i < 2; ++i) {
#pragma unroll
            for (int rr = 0; rr < 16; ++rr) part[i][rr] = 0.f;
#pragma unroll
            for (int j = 0; j < 2; ++j) {
                int col = n0 + wn * 64 + j * 32 + (l & 31);
                int rbase = m0 + wm * 64 + i * 32 + 4 * hh;
#pragma unroll
                for (int rr = 0; rr < 16; ++rr) {
                    int row = rbase + (rr & 3) + 8 * (rr >> 2);
                    size_t idx = (size_t)row * 1024 + col;
                    float v = hin[idx] + acc[i][j][rr];
                    hout[idx] = v;
                    hb_out[idx] = (bf16)v;
                    part[i][rr] += v * v;
                }
            }
        }
        rowss_flush(part, ss_out, m0, nt);
    }
}

__device__ __forceinline__ void phase_pq(const Params& P, int L, int hsel, const float* ssrow) {
    char* ws = opq(P.ws);
    const bf16* hb = (const bf16*)(ws + (hsel ? OFF_HB1 : OFF_HB0));
    const bf16* Bt = (const bf16*)(ws + OFF_WQ) + (size_t)L * 1024 * 1024;
    bf16* pq = (bf16*)(ws + OFF_PQ);
    const int tid = opaque_tid(), w = tid >> 6, l = tid & 63, hh = l >> 5, wm = w >> 1, wn = w & 1;
    for (int it = 0;; ++it) {
        int mt, nt;
        if (!xcd_tile(it, 128, 8, mt, nt)) break;
        int m0 = mt * 128, n0 = nt * 128;
        f32x16 acc[2][2];
        ZERO_ACC(acc);
        gemm_core<0>(acc, hb, 1024, Bt, 1024, 1024, m0, n0, NoScale());
#pragma unroll
        for (int i = 0; i < 2; ++i) {
            int rbase = m0 + wm * 64 + i * 32 + 4 * hh;
#pragma unroll
            for (int rr = 0; rr < 16; ++rr) {
                int row = rbase + (rr & 3) + 8 * (rr >> 2);
                float rs = row_rs8(ssrow, row);
#pragma unroll
                for (int j = 0; j < 2; ++j) {
                    int col = n0 + wn * 64 + j * 32 + (l & 31);
                    pq[(size_t)row * 1024 + col] = (bf16)(acc[i][j][rr] * rs);
                }
            }
        }
    }
}

__device__ __forceinline__ void cswap(int& a, int& b) { int mx = max(a, b), mn = min(a, b); a = mx; b = mn; }
__device__ __forceinline__ void bitonic_sort16(int (&v)[16]) {
#pragma unroll
    for (int k = 2; k <= 16; k <<= 1)
#pragma unroll
        for (int j = k >> 1; j > 0; j >>= 1)
#pragma unroll
            for (int i = 0; i < 16; ++i) {
                int q = i ^ j;
                if (q > i) {
                    if ((i & k) == 0) cswap(v[i], v[q]); else cswap(v[q], v[i]);
                }
            }
}
__device__ __forceinline__ void merge_top16(int (&Lv)[16], const int (&Rv)[16]) {
#pragma unroll
    for (int i = 0; i < 16; ++i) Lv[i] = max(Lv[i], Rv[15 - i]);
#pragma unroll
    for (int j = 8; j > 0; j >>= 1)
#pragma unroll
        for (int i = 0; i < 16; ++i) {
            int q = i ^ j;
            if (q > i) cswap(Lv[i], Lv[q]);
        }
}
__device__ __forceinline__ int f2key(float v, int low, int mask) {
    int b = __float_as_int(v);
    b ^= (b >> 31) & 0x7fffffff;
    return (b & ~mask) | low;
}
__device__ __forceinline__ float key2f(int k, int mask) {
    int b = k & ~mask;
    b ^= (b >> 31) & 0x7fffffff;
    return __int_as_float(b);
}

__device__ __forceinline__ void phase_topk(const Params& P, int L) {
    char* ws = opq(P.ws);
    const bf16* pq = (const bf16*)(ws + OFF_PQ);
    const bf16* skb = (const bf16*)(ws + OFF_SKB) + (size_t)L * 16 * 128 * 64;
    unsigned short* ids = (unsigned short*)(ws + OFF_IDS);
    float* gates = (float*)(ws + OFF_GATE);
    float* sc = (float*)smem;
    int* Lq = (int*)(smem + 64 * 129 * 4);
    int* Fin = Lq + 4 * 64 * 16;
    const int tid = opaque_tid(), w = tid >> 6, l = tid & 63, r = l & 31, hh = l >> 5;
    for (int item = blockIdx.x; item < TOK / 64; item += gridDim.x) {
        const int t0 = item * 64;
        for (int h = 0; h < 8; ++h) {
            for (int p = 0; p < 2; ++p) {
                const int hp = h * 2 + p;
                f32x16 acc[2];
#pragma unroll
                for (int j = 0; j < 2; ++j)
#pragma unroll
                    for (int rr = 0; rr < 16; ++rr) acc[j][rr] = 0.f;
#pragma unroll
                for (int s = 0; s < 4; ++s) {
                    bf16x8 af = *(const bf16x8*)(skb + ((size_t)hp * 128 + 32 * w + r) * 64 + 16 * s + 8 * hh);
#pragma unroll
                    for (int j = 0; j < 2; ++j) {
                        bf16x8 bfr = *(const bf16x8*)(pq + (size_t)(t0 + 32 * j + r) * 1024 + hp * 64 + 16 * s + 8 * hh);
                        acc[j] = __builtin_amdgcn_mfma_f32_32x32x16_bf16(af, bfr, acc[j], 0, 0, 0);
                    }
                }
#pragma unroll
                for (int j = 0; j < 2; ++j)
#pragma unroll
                    for (int rr = 0; rr < 16; ++rr) {
                        int key = 32 * w + (rr & 3) + 8 * (rr >> 2) + 4 * hh;
                        sc[(32 * j + r) * 129 + key] = acc[j][rr];
                    }
                __syncthreads();
                {
                    const int token = l, quarter = w;
                    int A[16], B[16];
#pragma unroll
                    for (int i = 0; i < 16; ++i) {
                        int n = quarter * 32 + i;
                        A[i] = f2key(sc[token * 129 + n], 127 - n, 127);
                        B[i] = f2key(sc[token * 129 + n + 16], 127 - (n + 16), 127);
                    }
                    bitonic_sort16(A);
                    bitonic_sort16(B);
                    merge_top16(A, B);
#pragma unroll
                    for (int i = 0; i < 16; ++i) Lq[(quarter * 64 + token) * 16 + i] = A[i];
                    __syncthreads();
                    if ((quarter & 1) == 0) {
#pragma unroll
                        for (int i = 0; i < 16; ++i) B[i] = Lq[((quarter + 1) * 64 + token) * 16 + i];
                        merge_top16(A, B);
                        if (quarter == 2) {
#pragma unroll
                            for (int i = 0; i < 16; ++i) Lq[(2 * 64 + token) * 16 + i] = A[i];
                        }
                    }
                    __syncthreads();
                    if (quarter == 0) {
#pragma unroll
                        for (int i = 0; i < 16; ++i) B[i] = Lq[(2 * 64 + token) * 16 + i];
                        merge_top16(A, B);
#pragma unroll
                        for (int i = 0; i < 16; ++i) Fin[(p * 64 + token) * 16 + i] = A[i];
                    }
                    __syncthreads();
                }
            }
            if (w == 0) {
                const int token = l;
                float s1[16], s2[16];
#pragma unroll
                for (int i = 0; i < 16; ++i) {
                    s1[i] = key2f(Fin[(0 * 64 + token) * 16 + i], 127);
                    s2[i] = key2f(Fin[(1 * 64 + token) * 16 + i], 127);
                }
                int Lc[16], X[16];
#pragma unroll
                for (int b2 = 0; b2 < 16; ++b2) Lc[b2] = f2key(s1[0] + s2[b2], 255 - b2, 255);
#pragma unroll
                for (int a = 1; a < 16; ++a) X[a - 1] = f2key(s1[a] + s2[0], 255 - a * 16, 255);
                X[15] = INT_MIN;
                merge_top16(Lc, X);
                {
                    int c = 0;
#pragma unroll
                    for (int b2 = 1; b2 <= 7; ++b2) X[c++] = f2key(s1[1] + s2[b2], 255 - (16 + b2), 255);
#pragma unroll
                    for (int b2 = 1; b2 <= 4; ++b2) X[c++] = f2key(s1[2] + s2[b2], 255 - (32 + b2), 255);
#pragma unroll
                    for (int b2 = 1; b2 <= 3; ++b2) X[c++] = f2key(s1[3] + s2[b2], 255 - (48 + b2), 255);
#pragma unroll
                    for (int b2 = 1; b2 <= 2; ++b2) X[c++] = f2key(s1[4] + s2[b2], 255 - (64 + b2), 255);
                }
                bitonic_sort16(X);
                merge_top16(Lc, X);
                X[0] = f2key(s1[5] + s2[1], 255 - (80 + 1), 255);
                X[1] = f2key(s1[6] + s2[1], 255 - (96 + 1), 255);
                X[2] = f2key(s1[7] + s2[1], 255 - (112 + 1), 255);
#pragma unroll
                for (int i = 3; i < 16; ++i) X[i] = INT_MIN;
                merge_top16(Lc, X);
                float mx = key2f(Lc[0], 255);
                float ev[16], sum = 0.f;
#pragma unroll
                for (int k = 0; k < 16; ++k) { ev[k] = __expf(key2f(Lc[k], 255) - mx); sum += ev[k]; }
                float inv = 1.f / sum;
                size_t ob = (size_t)(t0 + token) * 128 + h * 16;
#pragma unroll
                for (int k = 0; k < 16; ++k) {
                    int cidx = 255 - (Lc[k] & 255);
                    int a = cidx >> 4, b2 = cidx & 15;
                    int i1 = 127 - (Fin[(0 * 64 + token) * 16 + a] & 127);
                    int i2 = 127 - (Fin[(1 * 64 + token) * 16 + b2] & 127);
                    ids[ob + k] = (unsigned short)(i1 * 128 + i2);
                    gates[ob + k] = ev[k] * inv;
                }
            }
            __syncthreads();
        }
    }
}

__device__ __forceinline__ float gelu_exact(float x) { return 0.5f * x * (1.f + erff(x * 0.70710678118654752f)); }

__device__ __forceinline__ void dec16(const u32x4& v, float (&f)[16]) {
    f32x2 t;
    t = __builtin_amdgcn_cvt_pk_f32_fp8((int)v.x, false); f[0] = t.x; f[1] = t.y;
    t = __builtin_amdgcn_cvt_pk_f32_fp8((int)v.x, true);  f[2] = t.x; f[3] = t.y;
    t = __builtin_amdgcn_cvt_pk_f32_fp8((int)v.y, false); f[4] = t.x; f[5] = t.y;
    t = __builtin_amdgcn_cvt_pk_f32_fp8((int)v.y, true);  f[6] = t.x; f[7] = t.y;
    t = __builtin_amdgcn_cvt_pk_f32_fp8((int)v.z, false); f[8] = t.x; f[9] = t.y;
    t = __builtin_amdgcn_cvt_pk_f32_fp8((int)v.z, true);  f[10] = t.x; f[11] = t.y;
    t = __builtin_amdgcn_cvt_pk_f32_fp8((int)v.w, false); f[12] = t.x; f[13] = t.y;
    t = __builtin_amdgcn_cvt_pk_f32_fp8((int)v.w, true);  f[14] = t.x; f[15] = t.y;
}

__device__ __forceinline__ int idof16(const u32x4 (&q)[2], int i) {
    unsigned wv = (i >> 1) == 0 ? q[0].x : (i >> 1) == 1 ? q[0].y : (i >> 1) == 2 ? q[0].z : (i >> 1) == 3 ? q[0].w
                : (i >> 1) == 4 ? q[1].x : (i >> 1) == 5 ? q[1].y : (i >> 1) == 6 ? q[1].z : q[1].w;
    return (i & 1) ? (int)(wv >> 16) : (int)(wv & 0xffffu);
}
__device__ __forceinline__ void phase_gather_u(const Params& P, int L) {
    char* ws = opq(P.ws);
    const unsigned char* U8 = (const unsigned char*)(ws + OFF_UB) + (size_t)L * NEXP * DM;
    float* part = (float*)(ws + OFF_PART);
    const unsigned short* ids = (const unsigned short*)(ws + OFF_IDS);
    const float* hin = opq(P.out);
    const int tid = opaque_tid(), w = tid >> 6, l = tid & 63, c = l & 7, gq = l >> 3;
    const int j = blockIdx.x & 7, rk = blockIdx.x >> 3, nb = gridDim.x >> 3;
    if (rk >= nb) return;
    const unsigned char* ubase = U8 + (size_t)j * NEXP * 128 + c * 16;
    const int stride = nb * 4;
    int t = rk * 4 + w;
    if (t >= TOK) return;
    u32x4 idA[2], idB[2];
    u32x4 rv[16];
    f32x4 hA[4], hB[4];
    auto load_ids = [&](int tt, u32x4 (&idq)[2]) {
        const u32x4* i4 = (const u32x4*)(ids + (size_t)tt * 128 + 16 * gq);
        idq[0] = i4[0]; idq[1] = i4[1];
    };
    auto load_hx = [&](int tt, f32x4 (&hx)[4]) {
        const f32x4* h4 = (const f32x4*)(hin + (size_t)tt * 1024 + 128 * j + 16 * c);
#pragma unroll
        for (int q = 0; q < 4; ++q) hx[q] = h4[q];
    };
    auto step = [&](int tcur, int tnext, int tnext2, const u32x4 (&idn)[2], u32x4 (&idl)[2], const f32x4 (&hc)[4], f32x4 (&hn)[4]) {
        load_ids(tnext2, idl);
        load_hx(tnext, hn);
        __builtin_amdgcn_sched_barrier(0);
        float pr[16];
#pragma unroll
        for (int i = 0; i < 16; ++i) {
            float f[16];
            asm volatile("" : "+v"(rv[i].x), "+v"(rv[i].y), "+v"(rv[i].z), "+v"(rv[i].w));
            dec16(rv[i], f);
            rv[i] = *(const u32x4*)(ubase + (size_t)idof16(idn, i) * 128);
            __builtin_amdgcn_sched_barrier(0);
            float s0 = 0.f, s1 = 0.f;
#pragma unroll
            for (int q = 0; q < 4; ++q) {
                s0 += f[4 * q] * hc[q].x; s1 += f[4 * q + 1] * hc[q].y; s0 += f[4 * q + 2] * hc[q].z; s1 += f[4 * q + 3] * hc[q].w;
            }
            float sacc = s0 + s1;
            asm volatile("" : "+v"(sacc));
            pr[i] = sacc;
        }
#pragma unroll
        for (int i = 0; i < 16; ++i) pr[i] = sum8_dpp(pr[i]);
        if (c == 0) {
            f32x4* o4 = (f32x4*)(part + ((size_t)j * TOK + tcur) * 128 + 16 * gq);
#pragma unroll
            for (int q = 0; q < 4; ++q) { f32x4 o = {pr[4 * q], pr[4 * q + 1], pr[4 * q + 2], pr[4 * q + 3]}; o4[q] = o; }
        }
    };
    auto clampt = [&](int tt, int fb) { return tt < TOK ? tt : fb; };
    load_ids(t, idA);
#pragma unroll
    for (int i = 0; i < 16; ++i) rv[i] = *(const u32x4*)(ubase + (size_t)idof16(idA, i) * 128);
    load_hx(t, hA);
    load_ids(clampt(t + stride, t), idB);
    for (;;) {
        int tn = t + stride, tn2 = t + 2 * stride;
        step(t, clampt(tn, t), clampt(tn2, t), idB, idA, hA, hB);
        if (tn >= TOK) break;
        t = tn; tn = t + stride; tn2 = t + 2 * stride;
        step(t, clampt(tn, t), clampt(tn2, t), idA, idB, hB, hA);
        if (tn >= TOK) break;
        t = tn;
    }
}

__device__ __forceinline__ void phase_gather_act(const Params& P, int L, const float* ss_ffn) {
    char* ws = opq(P.ws);
    const float* part = (const float*)(ws + OFF_PART);
    const unsigned short* ids = (const unsigned short*)(ws + OFF_IDS);
    float* gates = (float*)(ws + OFF_GATE);
    const float* uinv = (const float*)(ws + OFF_TSC) + L * NEXP;
    const float* vinv = (const float*)(ws + OFF_TSC) + (2 + L) * NEXP;
    const int tid = opaque_tid(), w = tid >> 6, l = tid & 63;
    for (int t = blockIdx.x * 4 + w; t < TOK; t += gridDim.x * 4) {
        float rs = row_rs8(ss_ffn, t);
#pragma unroll
        for (int hsel = 0; hsel < 2; ++hsel) {
            int k = l + 64 * hsel;
            float sacc = 0.f;
#pragma unroll
            for (int j = 0; j < 8; ++j) sacc += part[((size_t)j * TOK + t) * 128 + k];
            int id = ids[(size_t)t * 128 + k];
            float pre = sacc * rs * uinv[id];
            gates[(size_t)t * 128 + k] = gates[(size_t)t * 128 + k] * gelu_exact(pre) * vinv[id];
        }
    }
}

__device__ __forceinline__ void phase_gather_v(const Params& P, int L, int hsel, float* ss_ple) {
    char* ws = opq(P.ws);
    bf16* hb_out = (bf16*)(ws + (hsel ? OFF_HB1 : OFF_HB0));
    const unsigned char* V8 = (const unsigned char*)(ws + OFF_VB) + (size_t)L * NEXP * DM;
    const unsigned short* ids = (const unsigned short*)(ws + OFF_IDS);
    const float* act = (const float*)(ws + OFF_GATE);
    float* hio = opq(P.out);
    const int tid = opaque_tid(), w = tid >> 6, l = tid & 63, c = l & 7, gq = l >> 3;
    const int j = blockIdx.x & 7, rk = blockIdx.x >> 3, nb = gridDim.x >> 3;
    if (rk >= nb) return;
    const unsigned char* vbase = V8 + (size_t)j * NEXP * 128 + c * 16;
    const int stride = nb * 4;
    int t = rk * 4 + w;
    if (t >= TOK) return;
    u32x4 idA[2], idB[2];
    u32x4 rv[16];
    f32x4 aA[4], aB[4];
    auto load_ids = [&](int tt, u32x4 (&idq)[2]) {
        const u32x4* i4 = (const u32x4*)(ids + (size_t)tt * 128 + 16 * gq);
        idq[0] = i4[0]; idq[1] = i4[1];
    };
    auto load_a = [&](int tt, f32x4 (&ax)[4]) {
        const f32x4* a4 = (const f32x4*)(act + (size_t)tt * 128 + 16 * gq);
#pragma unroll
        for (int q = 0; q < 4; ++q) ax[q] = a4[q];
    };
    auto step = [&](int tcur, int tnext, int tnext2, const u32x4 (&idn)[2], u32x4 (&idl)[2], const f32x4 (&ac)[4], f32x4 (&an)[4]) {
        load_ids(tnext2, idl);
        load_a(tnext, an);
        __builtin_amdgcn_sched_barrier(0);
        float acc[16];
#pragma unroll
        for (int e = 0; e < 16; ++e) acc[e] = 0.f;
#pragma unroll
        for (int i = 0; i < 16; ++i) {
            float f[16];
            asm volatile("" : "+v"(rv[i].x), "+v"(rv[i].y), "+v"(rv[i].z), "+v"(rv[i].w));
            dec16(rv[i], f);
            rv[i] = *(const u32x4*)(vbase + (size_t)idof16(idn, i) * 128);
            __builtin_amdgcn_sched_barrier(0);
            const float a = (i & 3) == 0 ? ac[i >> 2].x : (i & 3) == 1 ? ac[i >> 2].y : (i & 3) == 2 ? ac[i >> 2].z : ac[i >> 2].w;
#pragma unroll
            for (int e = 0; e < 16; ++e) acc[e] += a * f[e];
            asm volatile("" : "+v"(acc[0]), "+v"(acc[1]), "+v"(acc[2]), "+v"(acc[3]), "+v"(acc[4]), "+v"(acc[5]), "+v"(acc[6]), "+v"(acc[7]),
                              "+v"(acc[8]), "+v"(acc[9]), "+v"(acc[10]), "+v"(acc[11]), "+v"(acc[12]), "+v"(acc[13]), "+v"(acc[14]), "+v"(acc[15]));
        }
#pragma unroll
        for (int e = 0; e < 16; ++e) acc[e] = sumg_dpp(acc[e]);
        float ssq = 0.f;
        if (gq == 0) {
            f32x4* h4 = (f32x4*)(hio + (size_t)tcur * 1024 + 128 * j + 16 * c);
            float hv[16];
#pragma unroll
            for (int q = 0; q < 4; ++q) {
                f32x4 v = h4[q];
                hv[4 * q] = v.x + acc[4 * q]; hv[4 * q + 1] = v.y + acc[4 * q + 1]; hv[4 * q + 2] = v.z + acc[4 * q + 2]; hv[4 * q + 3] = v.w + acc[4 * q + 3];
                f32x4 o = {hv[4 * q], hv[4 * q + 1], hv[4 * q + 2], hv[4 * q + 3]};
                h4[q] = o;
            }
#pragma unroll
            for (int e = 0; e < 16; ++e) ssq += hv[e] * hv[e];
            u32x4 b0 = {pack2(hv[0], hv[1]), pack2(hv[2], hv[3]), pack2(hv[4], hv[5]), pack2(hv[6], hv[7])};
            u32x4 b1 = {pack2(hv[8], hv[9]), pack2(hv[10], hv[11]), pack2(hv[12], hv[13]), pack2(hv[14], hv[15])};
            u32x4* hb4 = (u32x4*)(hb_out + (size_t)tcur * 1024 + 128 * j + 16 * c);
            hb4[0] = b0; hb4[1] = b1;
        }
        ssq = sum8_dpp(ssq);
        if (l == 0) ss_ple[(size_t)tcur * 8 + j] = ssq;
    };
    auto clampt = [&](int tt, int fb) { return tt < TOK ? tt : fb; };
    load_ids(t, idA);
#pragma unroll
    for (int i = 0; i < 16; ++i) rv[i] = *(const u32x4*)(vbase + (size_t)idof16(idA, i) * 128);
    load_a(t, aA);
    load_ids(clampt(t + stride, t), idB);
    for (;;) {
        int tn = t + stride, tn2 = t + 2 * stride;
        step(t, clampt(tn, t), clampt(tn2, t), idB, idA, aA, aB);
        if (tn >= TOK) break;
        t = tn; tn = t + stride; tn2 = t + 2 * stride;
        step(t, clampt(tn, t), clampt(tn2, t), idA, idB, aB, aA);
        if (tn >= TOK) break;
        t = tn;
    }
}

__device__ __forceinline__ void phase_ple(const Params& P, int L, int hsel, const float* ss_ple, float* ss_out) {
    char* ws = opq(P.ws);
    const bf16* hb_in = (const bf16*)(ws + (hsel ? OFF_HB1 : OFF_HB0));
    bf16* hb_out = (bf16*)(ws + (hsel ? OFF_HB0 : OFF_HB1));
    float* hio = opq(P.out);
    const float* pin = opq(P.p) + (size_t)L * TOK * 256;
    const bf16* Wg = (const bf16*)(ws + OFF_WG) + (size_t)L * 1024 * 1024;
    const bf16* Wp = (const bf16*)(ws + OFF_WP) + (size_t)L * 1024 * 256;
    const int tid = opaque_tid(), w = tid >> 6, l = tid & 63, hh = l >> 5, wm = w >> 1, wn = w & 1;
    for (int it = 0;; ++it) {
        int mt, nt;
        if (!xcd_tile(it, 128, 8, mt, nt)) break;
        int m0 = mt * 128, n0 = nt * 128;
        f32x16 acc1[2][2], acc2[2][2];
        ZERO_ACC(acc1);
        ZERO_ACC(acc2);
        gemm_core<0>(acc1, hb_in, 1024, Wg, 1024, 1024, m0, n0, NoScale());
        gemm_core<1>(acc2, pin, 256, Wp, 256, 256, m0, n0, NoScale());
        float part[2][16];
#pragma unroll
        for (int i = 0; i < 2; ++i) {
            int rbase = m0 + wm * 64 + i * 32 + 4 * hh;
#pragma unroll
            for (int rr = 0; rr < 16; ++rr) {
                int row = rbase + (rr & 3) + 8 * (rr >> 2);
                float rs = row_rs8(ss_ple, row);
                float ps = 0.f;
#pragma unroll
                for (int j = 0; j < 2; ++j) {
                    int col = n0 + wn * 64 + j * 32 + (l & 31);
                    size_t idx = (size_t)row * 1024 + col;
                    float gte = 1.f / (1.f + __expf(-acc1[i][j][rr] * rs));
                    float v = hio[idx] + gte * acc2[i][j][rr];
                    hio[idx] = v;
                    hb_out[idx] = (bf16)v;
                    ps += v * v;
                }
                part[i][rr] = ps;
            }
        }
        rowss_flush(part, ss_out, m0, nt);
    }
}

__device__ __forceinline__ void phase_final(const Params& P, const float* ss) {
    float* hio = opq(P.out);
    const int tid = opaque_tid(), w = tid >> 6, l = tid & 63;
    const float4* g4 = (const float4*)P.final_norm_g;
    for (int t = blockIdx.x * 4 + w; t < TOK; t += gridDim.x * 4) {
        float rs = row_rs8(ss, t);
        float4* o4 = (float4*)(hio + (size_t)t * 1024);
#pragma unroll
        for (int i = 0; i < 4; ++i) {
            float4 v = o4[i * 64 + l], g = g4[i * 64 + l];
            v.x *= rs * g.x; v.y *= rs * g.y; v.z *= rs * g.z; v.w *= rs * g.w;
            o4[i * 64 + l] = v;
        }
    }
}

#define XB_TMO      128
#define XB_XCNT(j)  (256  + 64 * (j))
#define XB_XSUB(j)  (1280 + 64 * (j))
#define XB_XGEN(j)  (2304 + 64 * (j))
#define XB_TOP      3328
#define XB_TOPGEN   3392
#define XCD_BAR_WORDS 3456
#define XB_SPIN_CAP (1u << 22)
__device__ __forceinline__ unsigned xb_ld(unsigned* p) { return __hip_atomic_load(p, __ATOMIC_RELAXED, __HIP_MEMORY_SCOPE_AGENT); }
__device__ __forceinline__ unsigned xb_add(unsigned* p, unsigned v) { return __hip_atomic_fetch_add(p, v, __ATOMIC_RELAXED, __HIP_MEMORY_SCOPE_AGENT); }
__device__ __forceinline__ unsigned xb_xcc_id() { return (unsigned)__builtin_amdgcn_s_getreg((3 << 11) | 20) & 0xFu; }
#define XB_SPIN(cond, bar) do { unsigned _sp = 0; while (cond) { __builtin_amdgcn_s_sleep(1); \
    if ((++_sp & 255u) == 0u) { if (xb_ld(&(bar)[XB_TMO])) break; if (_sp > XB_SPIN_CAP) { atomicAdd(&(bar)[XB_TMO], 1u); break; } } } } while (0)
struct XcdBarrier { unsigned* bar; unsigned x, nloc, nx; };
__device__ __forceinline__ XcdBarrier xcd_barrier_post(unsigned* bar) {
    XcdBarrier b; b.bar = bar; b.x = xb_xcc_id(); b.nloc = 0u; b.nx = 0u;
    if (threadIdx.x == 0) (void)xb_add(&bar[XB_XCNT(b.x)], 1u);
    return b;
}
__device__ __forceinline__ void xcd_barrier_complete(unsigned* bar, unsigned x, unsigned& nloc, unsigned& nx) {
    const unsigned G = gridDim.x;
    unsigned sum, cnt, mine, sp = 0u;
    for (;;) {
        sum = 0u; cnt = 0u; mine = 0u;
#pragma unroll
        for (unsigned j = 0; j < 16; ++j) { const unsigned c = xb_ld(&bar[XB_XCNT(j)]); sum += c; cnt += (c > 0u) ? 1u : 0u; mine = (j == x) ? c : mine; }
        if (sum == G) break;
        __builtin_amdgcn_s_sleep(1);
        if ((++sp & 255u) == 0u) { if (xb_ld(&bar[XB_TMO])) break; if (sp > XB_SPIN_CAP) { atomicAdd(&bar[XB_TMO], 1u); break; } }
    }
    nloc = mine > 0u ? mine : 1u; nx = cnt > 0u ? cnt : 1u;
}
__device__ __forceinline__ void grid_barrier(XcdBarrier& b) {
    asm volatile("s_waitcnt vmcnt(0)" ::: "memory");
    __syncthreads();
    if (threadIdx.x == 0) {
        unsigned* bar = b.bar;
        __builtin_amdgcn_s_waitcnt(0);
        if (b.nloc == 0u) xcd_barrier_complete(bar, b.x, b.nloc, b.nx);
        const unsigned nloc = b.nloc, nx = b.nx;
        const unsigned old = xb_add(&bar[XB_XSUB(b.x)], 1u);
        const unsigned gen = old / nloc;
        if (old + 1u == (gen + 1u) * nloc) {
            __builtin_amdgcn_fence(__ATOMIC_RELEASE, "agent");
            asm volatile("s_waitcnt vmcnt(0)" ::: "memory");
            const unsigned og = xb_add(&bar[XB_TOP], 1u);
            const unsigned tg = og / nx;
            if (og + 1u == (tg + 1u) * nx) xb_add(&bar[XB_TOPGEN], 1u);
            else XB_SPIN(xb_ld(&bar[XB_TOPGEN]) == tg, bar);
            __builtin_amdgcn_fence(__ATOMIC_ACQUIRE, "agent");
            xb_add(&bar[XB_XGEN(b.x)], 1u);
            asm volatile("s_waitcnt vmcnt(0)" ::: "memory");
        } else {
            XB_SPIN(xb_ld(&bar[XB_XGEN(b.x)]) == gen, bar);
            __builtin_amdgcn_fence(__ATOMIC_ACQUIRE, "agent");
            asm volatile("s_waitcnt vmcnt(0)" ::: "memory");
        }
    }
    __syncthreads();
}

__global__ void __launch_bounds__(NTHR, 2) hymba_megakernel(Params P) {
    cg::grid_group grid = cg::this_grid();
    char* ws = opq(P.ws);
    float* ssa = (float*)(ws + OFF_SSA);
    XcdBarrier bar = xcd_barrier_post((unsigned*)(ws + OFF_BAR));
#define BAR() do { grid_barrier(bar); if (DUP == 20) grid_barrier(bar); } while (0)
    phase0(P);
    if (DUP == 0) { asm volatile("s_waitcnt vmcnt(0)" ::: "memory"); __syncthreads(); grid_barrier(bar); phase0(P); }
    asm volatile("s_waitcnt vmcnt(0)" ::: "memory");
    __syncthreads();
    grid.sync();
    BAR();
    int cur = 0;
    for (int L = 0; L < 2; ++L) {
        const float* ss_mix = (L == 0) ? ssa : (ssa + 3 * TOK * 8);
        float* ss_ffn = ssa + (size_t)(1 + L) * TOK * 8;
        float* ss_next = (L == 0) ? (ssa + 3 * TOK * 8) : (ssa + 4 * TOK * 8);
        float* ss_ple = ssa + (size_t)(5 + L) * TOK * 8;
        phase_proj(P, L, cur, ss_mix);
        BAR();
        if (DUP == 1) { phase_proj(P, L, cur, ss_mix); BAR(); }
        phase_mla_up(P, L);
        BAR();
        if (DUP == 2) { phase_mla_up(P, L); BAR(); }
        phase_attn(P, L, 0);
        BAR();
        if (DUP == 3) { phase_attn(P, L, 1); BAR(); }
        phase_wo(P, L, cur ^ 1, ss_ffn);
        BAR();
        if (DUP == 4 && L == 0) { phase_wo(P, L, cur ^ 1, ss_ffn); BAR(); }
        phase_pq(P, L, cur ^ 1, ss_ffn);
        BAR();
        if (DUP == 5) { phase_pq(P, L, cur ^ 1, ss_ffn); BAR(); }
        phase_topk(P, L);
        BAR();
        if (DUP == 6) { phase_topk(P, L); BAR(); }
        phase_gather_u(P, L);
        BAR();
        if (DUP == 7) { phase_gather_u(P, L); BAR(); }
        phase_gather_act(P, L, ss_ffn);
        BAR();
        phase_gather_v(P, L, cur, ss_ple);
        BAR();
        phase_ple(P, L, cur, ss_ple, ss_next);
        BAR();
        cur ^= 1;
    }
    phase_final(P, ssa + 4 * TOK * 8);
}

extern "C" void kernel_launch(void* const* d_in, const int* in_sizes, int n_in, void* d_out, int out_size, void* d_ws,
                              size_t ws_size, hipStream_t stream) {
    static int grid_blocks = 0;
    if (!grid_blocks) {
        int dev = 0, cus = 0, per_cu = 0;
        hipGetDevice(&dev);
        hipDeviceGetAttribute(&cus, hipDeviceAttributeMultiprocessorCount, dev);
        hipOccupancyMaxActiveBlocksPerMultiprocessor(&per_cu, hymba_megakernel, NTHR, 0);
        if (per_cu > 2) per_cu = 2;
        if (per_cu < 1) per_cu = 1;
        grid_blocks = cus * per_cu;
        if (ws_size < WS_END) fprintf(stderr, "workspace too small: %zu < %zu\n", ws_size, (size_t)WS_END);
    }
    Params P{};
    P.x = (const float*)d_in[0]; P.p = (const float*)d_in[1]; P.pos = (const int*)d_in[2];
    P.norm_mix_g = (const float*)d_in[3]; P.w_in = (const float*)d_in[4]; P.b_forget = (const float*)d_in[5];
    P.mla_q_norm_g = (const float*)d_in[6]; P.w_uq = (const float*)d_in[7]; P.mla_kv_norm_g = (const float*)d_in[8];
    P.w_ukv = (const float*)d_in[9]; P.mix_out_norm_g = (const float*)d_in[10]; P.w_o = (const float*)d_in[11];
    P.norm_ffn_g = (const float*)d_in[12]; P.w_query = (const float*)d_in[13]; P.sub_keys = (const float*)d_in[14];
    P.peer_u = (const float*)d_in[15]; P.peer_v = (const float*)d_in[16]; P.w_ple = (const float*)d_in[17];
    P.ple_norm_g = (const float*)d_in[18]; P.w_ple_gate = (const float*)d_in[19]; P.final_norm_g = (const float*)d_in[20];
    P.out = (float*)d_out; P.ws = (char*)d_ws;
    hipMemsetAsync((char*)d_ws + OFF_BAR, 0, 16384 + 4096, stream);
    void* args[] = {&P};
    hipError_t e = hipLaunchCooperativeKernel((void*)hymba_megakernel, dim3(grid_blocks), dim3(NTHR), args, 0, stream);
    if (e != hipSuccess) fprintf(stderr, "cooperative launch failed: %s (grid %d)\n", hipGetErrorString(e), grid_blocks);
}
```

```cpp
#include <hip/hip_runtime.h>
#include <hip/hip_cooperative_groups.h>
#include <cstdio>
#include <cstdint>
#include <math.h>
#include <climits>
namespace cg = cooperative_groups;

typedef __bf16 bf16;
typedef __bf16 bf16x8 __attribute__((ext_vector_type(8)));
typedef __bf16 bf16x4 __attribute__((ext_vector_type(4)));
typedef __bf16 bf16x2 __attribute__((ext_vector_type(2)));
typedef float f32x16 __attribute__((ext_vector_type(16)));
typedef float f32x4 __attribute__((ext_vector_type(4)));
typedef float f32x2 __attribute__((ext_vector_type(2)));
typedef unsigned u32x4 __attribute__((ext_vector_type(4)));
typedef unsigned u32x2 __attribute__((ext_vector_type(2)));

#define SEQ 2048
#define BATCH 8
#define TOK 16384
#define DM 1024
#define IN_W 1956
#define NEXP 16384
#define EPSF 1e-6f
#define LOG2E 1.4426950408889634f
#define NTHR 512
#define NW 8
#define LDS_BYTES 151808
#define STAGE_BYTES 49152
#define LDS_AUX 147456
#ifndef DUP
#define DUP -1
#endif

constexpr size_t MBy = 1ull << 20;
constexpr size_t OFF_UB = 0;
constexpr size_t OFF_VB = 32 * MBy;
constexpr size_t OFF_PART = 64 * MBy;
#define LDH 1088
#define LDP 320
#define LDC 192
constexpr size_t OFF_WIN = 128 * MBy;
constexpr size_t OFF_WO = 137 * MBy;
constexpr size_t OFF_WQ = 142 * MBy;
constexpr size_t OFF_WG = 147 * MBy;
constexpr size_t OFF_WP = 152 * MBy;
constexpr size_t OFF_WUQ = 154 * MBy;
constexpr size_t OFF_WUKV = 155 * MBy;
constexpr size_t OFF_SKB = 156 * MBy;
constexpr size_t OFF_CS = 157 * MBy;
constexpr size_t OFF_TSC = 159 * MBy;
constexpr size_t OFF_SSA = 160 * MBy;
constexpr size_t OFF_HB0 = 164 * MBy;
constexpr size_t OFF_HB1 = 200 * MBy;
constexpr size_t OFF_FQ = 236 * MBy;
constexpr size_t OFF_FK = 244 * MBy;
constexpr size_t OFF_FVT = 252 * MBy;
constexpr size_t OFF_SQ = 260 * MBy;
constexpr size_t OFF_SKK = 268 * MBy;
constexpr size_t OFF_SVT = 276 * MBy;
constexpr size_t OFF_CQ = 284 * MBy;
constexpr size_t OFF_CKV = 295 * MBy;
constexpr size_t OFF_FLOG = 302 * MBy;
constexpr size_t OFF_CUMF = 303 * MBy;
constexpr size_t OFF_MQ = 304 * MBy;
constexpr size_t OFF_MK = 316 * MBy;
constexpr size_t OFF_MVT = 328 * MBy;
constexpr size_t OFF_Y = 344 * MBy;
constexpr size_t OFF_PQ = 380 * MBy;
constexpr size_t OFF_IDS = 412 * MBy;
constexpr size_t OFF_GATE = 420 * MBy;
constexpr size_t OFF_BAR = 428 * MBy;
constexpr size_t OFF_CNT = OFF_BAR + 16384;
constexpr size_t OFF_SSY = 429 * MBy;
constexpr size_t OFF_PB = 431 * MBy;
constexpr size_t WS_END = 452 * MBy;

struct Params {
    const float* x; const float* p; const int* pos;
    const float* norm_mix_g; const float* w_in; const float* b_forget; const float* mla_q_norm_g; const float* w_uq;
    const float* mla_kv_norm_g; const float* w_ukv; const float* mix_out_norm_g; const float* w_o; const float* norm_ffn_g;
    const float* w_query; const float* sub_keys; const float* peer_u; const float* peer_v; const float* w_ple;
    const float* ple_norm_g; const float* w_ple_gate; const float* final_norm_g;
    float* out; char* ws;
};

__shared__ __attribute__((aligned(16))) char smem[LDS_BYTES];

__device__ __forceinline__ int opaque_tid() { int t = threadIdx.x; asm volatile("" : "+v"(t)); return t; }
template <typename T> __device__ __forceinline__ T* opq(T* p) { size_t z = 0; asm volatile("" : "+s"(z)); return (T*)((char*)p + z); }

__device__ __forceinline__ unsigned pack2(float a, float b) {
    f32x2 v = {a, b};
    bf16x2 r = __builtin_convertvector(v, bf16x2);
    return __builtin_bit_cast(unsigned, r);
}
__device__ __forceinline__ float bflo(unsigned u) { return __uint_as_float(u << 16); }
__device__ __forceinline__ float bfhi(unsigned u) { return __uint_as_float(u & 0xffff0000u); }
__device__ __forceinline__ float wave_sum(float v) {
#pragma unroll
    for (int o = 32; o > 0; o >>= 1) v += __shfl_xor(v, o);
    return v;
}
template <int CTRL> __device__ __forceinline__ float dpp_add(float v) {
    return v + __builtin_bit_cast(float, __builtin_amdgcn_update_dpp(0, __builtin_bit_cast(int, v), CTRL, 0xf, 0xf, true));
}
__device__ __forceinline__ float sum8_dpp(float v) { v = dpp_add<0xB1>(v); v = dpp_add<0x4E>(v); v = dpp_add<0x141>(v); return v; }
__device__ __forceinline__ float sumg_dpp(float v) {
    v = dpp_add<0x128>(v);
    float a = v, b = v;
    asm volatile("s_nop 1\n\tv_permlane16_swap_b32 %0, %1\n\ts_nop 1" : "+v"(a), "+v"(b));
    v = a + b;
    a = v; b = v;
    asm volatile("s_nop 1\n\tv_permlane32_swap_b32 %0, %1\n\ts_nop 1" : "+v"(a), "+v"(b));
    return a + b;
}
__device__ __forceinline__ float fexp2(float x) { return __builtin_amdgcn_exp2f(x); }
__device__ __forceinline__ float flog2(float x) { return __builtin_amdgcn_logf(x); }
__device__ __forceinline__ float log_sigmoid_f(float z) { return fminf(z, 0.f) - log1pf(expf(-fabsf(z))); }

struct WJob { const float* src; int lds; int K; int Np; bf16* dst; int ldd; const float* gain; int map; };

__device__ __forceinline__ int src_col_map(int map, int c) {
    if (map == 0) return c;
    if (map == 1) {
        if (c < 768) return c;
        if (c < 1952) return c + 4;
        if (c < 1956) return c - 1952 + 768;
        return -1;
    }
    if (c < 256) return 192 * (c >> 6) + (c & 63);
    int e = c - 256;
    return 192 * (e >> 7) + 64 + (e & 127);
}

__device__ __forceinline__ void wconv_tile(const WJob& j, int tile) {
    float* tl = (float*)smem;
    int ktiles = j.K >> 5;
    int nt = tile / ktiles, kt = tile % ktiles;
    int n0 = nt * 32, k0 = kt * 32;
    int tx = opaque_tid() & 31, ty = opaque_tid() >> 5;
    int sc = src_col_map(j.map, n0 + tx);
#pragma unroll
    for (int i = 0; i < 2; ++i) {
        int k = k0 + ty + 16 * i;
        float v = 0.f;
        if (sc >= 0) v = j.src[(size_t)k * j.lds + sc] * (j.gain ? j.gain[k] : 1.f);
        tl[(ty + 16 * i) * 33 + tx] = v;
    }
    __syncthreads();
#pragma unroll
    for (int i = 0; i < 2; ++i) {
        int n = n0 + ty + 16 * i;
        j.dst[(size_t)n * j.ldd + k0 + tx] = (bf16)tl[tx * 33 + ty + 16 * i];
    }
    __syncthreads();
}

__device__ __forceinline__ void phase0(const Params& P) {
    char* ws = opq(P.ws);
    const int G = gridDim.x, bid = blockIdx.x, tid = opaque_tid();
    {
        const int w = tid >> 6, l = tid & 63;
        float* tsc = (float*)(ws + OFF_TSC);
        for (int it = bid * NW + w; it < 4 * NEXP; it += G * NW) {
            int tb = it >> 14, e = it & (NEXP - 1);
            const float* src = (tb < 2 ? P.peer_u : P.peer_v) + ((size_t)(tb & 1) * NEXP + e) * DM + l * 16;
            unsigned char* dst = (unsigned char*)(ws + (tb < 2 ? OFF_UB : OFF_VB)) + (size_t)(tb & 1) * NEXP * DM;
            float4 a = ((const float4*)src)[0], b = ((const float4*)src)[1], c = ((const float4*)src)[2], d = ((const float4*)src)[3];
            if (tb < 2) {
                const float4* g4 = (const float4*)(P.norm_ffn_g + (tb & 1) * 1024 + l * 16);
                float4 g0 = g4[0], g1 = g4[1], g2 = g4[2], g3 = g4[3];
                a.x *= g0.x; a.y *= g0.y; a.z *= g0.z; a.w *= g0.w; b.x *= g1.x; b.y *= g1.y; b.z *= g1.z; b.w *= g1.w;
                c.x *= g2.x; c.y *= g2.y; c.z *= g2.z; c.w *= g2.w; d.x *= g3.x; d.y *= g3.y; d.z *= g3.z; d.w *= g3.w;
            }
            float am = fmaxf(fmaxf(fmaxf(fabsf(a.x), fabsf(a.y)), fmaxf(fabsf(a.z), fabsf(a.w))), fmaxf(fmaxf(fabsf(b.x), fabsf(b.y)), fmaxf(fabsf(b.z), fabsf(b.w))));
            am = fmaxf(am, fmaxf(fmaxf(fmaxf(fabsf(c.x), fabsf(c.y)), fmaxf(fabsf(c.z), fabsf(c.w))), fmaxf(fmaxf(fabsf(d.x), fabsf(d.y)), fmaxf(fabsf(d.z), fabsf(d.w)))));
#pragma unroll
            for (int o = 32; o > 0; o >>= 1) am = fmaxf(am, __shfl_xor(am, o));
            int eb = ((__float_as_int(am) >> 23) & 0xff) - 127;
            eb = max(-100, min(100, eb));
            if (am == 0.f) eb = 7;
            float sc = __int_as_float((127 + 7 - eb) << 23), isc = __int_as_float((127 + eb - 7) << 23);
            int w0 = 0, w1 = 0, w2 = 0, w3 = 0;
            w0 = __builtin_amdgcn_cvt_pk_fp8_f32(a.x * sc, a.y * sc, w0, false); w0 = __builtin_amdgcn_cvt_pk_fp8_f32(a.z * sc, a.w * sc, w0, true);
            w1 = __builtin_amdgcn_cvt_pk_fp8_f32(b.x * sc, b.y * sc, w1, false); w1 = __builtin_amdgcn_cvt_pk_fp8_f32(b.z * sc, b.w * sc, w1, true);
            w2 = __builtin_amdgcn_cvt_pk_fp8_f32(c.x * sc, c.y * sc, w2, false); w2 = __builtin_amdgcn_cvt_pk_fp8_f32(c.z * sc, c.w * sc, w2, true);
            w3 = __builtin_amdgcn_cvt_pk_fp8_f32(d.x * sc, d.y * sc, w3, false); w3 = __builtin_amdgcn_cvt_pk_fp8_f32(d.z * sc, d.w * sc, w3, true);
            u32x4 o4 = {(unsigned)w0, (unsigned)w1, (unsigned)w2, (unsigned)w3};
            *(u32x4*)(dst + ((size_t)(l >> 3) * NEXP + e) * 128 + (l & 7) * 16) = o4;
            if (l == 0) tsc[tb * NEXP + e] = isc;
        }
    }
    {
        for (int L = 0; L < 2; ++L) {
            WJob jobs[7];
            jobs[0] = {P.w_in + (size_t)L * 1024 * IN_W, IN_W, 1024, 2048, (bf16*)(ws + OFF_WIN) + (size_t)L * 2048 * LDH, LDH, P.norm_mix_g + L * 1024, 1};
            jobs[1] = {P.w_o + (size_t)L * 1024 * 1024, 1024, 1024, 1024, (bf16*)(ws + OFF_WO) + (size_t)L * 1024 * LDH, LDH, P.mix_out_norm_g + L * 1024, 0};
            jobs[2] = {P.w_query + (size_t)L * 1024 * 1024, 1024, 1024, 1024, (bf16*)(ws + OFF_WQ) + (size_t)L * 1024 * LDH, LDH, P.norm_ffn_g + L * 1024, 0};
            jobs[3] = {P.w_ple_gate + (size_t)L * 1024 * 1024, 1024, 1024, 1024, (bf16*)(ws + OFF_WG) + (size_t)L * 1024 * LDH, LDH, P.ple_norm_g + L * 1024, 0};
            jobs[4] = {P.w_ple + (size_t)L * 256 * 1024, 1024, 256, 1024, (bf16*)(ws + OFF_WP) + (size_t)L * 1024 * LDP, LDP, nullptr, 0};
            jobs[5] = {P.w_uq + (size_t)L * 256 * 384, 384, 256, 384, (bf16*)(ws + OFF_WUQ) + (size_t)L * 384 * LDP, LDP, P.mla_q_norm_g + L * 256, 0};
            jobs[6] = {P.w_ukv + (size_t)L * 128 * 768, 768, 128, 768, (bf16*)(ws + OFF_WUKV) + (size_t)L * 768 * LDC, LDC, P.mla_kv_norm_g + L * 128, 2};
#pragma unroll
            for (int q = 0; q < 7; ++q) {
                int nt = (jobs[q].Np >> 5) * (jobs[q].K >> 5);
                for (int it = bid; it < nt; it += G) wconv_tile(jobs[q], it);
            }
        }
    }
    {
        const float* src = P.sub_keys;
        bf16* dst = (bf16*)(ws + OFF_SKB);
        for (int i = bid * NTHR + tid; i < 262144 / 2; i += G * NTHR) {
            float2 v = ((const float2*)src)[i];
            ((unsigned*)dst)[i] = pack2(v.x, v.y);
        }
    }
    {
        const float4* src = (const float4*)P.p;
        bf16* dst = (bf16*)(ws + OFF_PB);
        for (int i = bid * NTHR + tid; i < 2 * TOK * 256 / 8; i += G * NTHR) {
            float4 a = src[2 * i], b = src[2 * i + 1];
            u32x4 o = {pack2(a.x, a.y), pack2(a.z, a.w), pack2(b.x, b.y), pack2(b.z, b.w)};
            *(u32x4*)(dst + (size_t)(i >> 5) * LDP + (i & 31) * 8) = o;
        }
    }
    {
        bf16* hb = (bf16*)(ws + OFF_HB0);
        float* ss0 = (float*)(ws + OFF_SSA);
        int w = tid >> 6, l = tid & 63;
        for (int row = bid * NW + w; row < TOK; row += G * NW) {
            const float4* xr = (const float4*)(P.x + (size_t)row * DM);
            float ss = 0.f;
#pragma unroll
            for (int i = 0; i < 2; ++i) {
                float4 a = xr[i * 128 + l * 2], b = xr[i * 128 + l * 2 + 1];
                ss += a.x * a.x + a.y * a.y + a.z * a.z + a.w * a.w + b.x * b.x + b.y * b.y + b.z * b.z + b.w * b.w;
                uint4 o;
                o.x = pack2(a.x, a.y); o.y = pack2(a.z, a.w); o.z = pack2(b.x, b.y); o.w = pack2(b.z, b.w);
                ((uint4*)(hb + (size_t)row * LDH))[i * 64 + l] = o;
            }
            ss = wave_sum(ss);
            if (l == 0) {
                *(float4*)(ss0 + (size_t)row * 8) = make_float4(ss, 0.f, 0.f, 0.f);
                *(float4*)(ss0 + (size_t)row * 8 + 4) = make_float4(0.f, 0.f, 0.f, 0.f);
            }
        }
    }
    {
        float* cs = (float*)(ws + OFF_CS);
        for (int i = bid * NTHR + tid; i < TOK * 16; i += G * NTHR) {
            int t = i >> 4, k = i & 15;
            float inv = powf(10000.0f, -(float)k / 16.0f);
            float ang = (float)P.pos[t] * inv;
            cs[2 * i] = cosf(ang);
            cs[2 * i + 1] = sinf(ang);
        }
    }
}

struct NoHook { static constexpr bool nodma = false; __device__ __forceinline__ void operator()(int, f32x16 (&)[2][2]) const {} };
struct NoDmaHook { static constexpr bool nodma = true; __device__ __forceinline__ void operator()(int, f32x16 (&)[2][2]) const {} };
template <typename HOOK>
__device__ __forceinline__ void gemm_core(f32x16 (&acc)[2][2], const bf16* A, int lda, const bf16* Bt, int ldb, int K,
                                          int m0, int n0, HOOK hook) {
    const int tid = opaque_tid(), w = tid >> 6, l = tid & 63, r = l & 31, hh = l >> 5;
    const int wm = w >> 1, wn = w & 1;
    const int dp = (tid & 15) ^ ((tid >> 4) & 15);
    const int drow = 2 * (tid >> 4) + (dp >> 3), dgc = (dp & 7) * 8;
    const bf16* asrc = A + (size_t)(m0 + drow) * lda + dgc;
    const bf16* bsrc = Bt + (size_t)(n0 + drow) * ldb + dgc;
    auto dma = [&](int buf, int k0) {
        if (HOOK::nodma) return;
        char* base = smem + buf * STAGE_BYTES + tid * 16;
#pragma unroll
        for (int i = 0; i < 4; ++i)
            __builtin_amdgcn_global_load_lds((const unsigned*)(asrc + (size_t)(64 * i) * lda + k0), (unsigned*)(base + i * 8192), 16, 0, 0);
#pragma unroll
        for (int i = 0; i < 2; ++i)
            __builtin_amdgcn_global_load_lds((const unsigned*)(bsrc + (size_t)(64 * i) * ldb + k0), (unsigned*)(base + 32768 + i * 8192), 16, 0, 0);
    };
    int offA[2], offB[2];
#pragma unroll
    for (int i = 0; i < 2; ++i) { offA[i] = ((wm * 64 + i * 32 + r) >> 1) * 256; offB[i] = 32768 + ((wn * 64 + i * 32 + r) >> 1) * 256; }
    const int pbase = ((r & 1) << 3), lx = (r >> 1) & 15;
    const int nk = K >> 6;
    const unsigned ldsbase = (unsigned)(size_t)(__attribute__((address_space(3))) char*)smem;
    auto ldfrag = [&](int stage, int s, bf16x8 (&af)[2], bf16x8 (&bfr)[2]) {
        unsigned ch = (unsigned)((((pbase | (2 * s + hh)) ^ lx) << 4)) + ldsbase + (unsigned)(stage * STAGE_BYTES);
        unsigned a0a = ch + offA[0], a1a = ch + offA[1], b0a = ch + offB[0], b1a = ch + offB[1];
        asm volatile("ds_read_b128 %0, %4\n\tds_read_b128 %1, %5\n\tds_read_b128 %2, %6\n\tds_read_b128 %3, %7"
                     : "=&v"(af[0]), "=&v"(af[1]), "=&v"(bfr[0]), "=&v"(bfr[1]) : "v"(a0a), "v"(a1a), "v"(b0a), "v"(b1a) : "memory");
    };
    auto mma = [&](bf16x8 (&af)[2], bf16x8 (&bfr)[2]) {
#pragma unroll
        for (int i = 0; i < 2; ++i)
#pragma unroll
            for (int j = 0; j < 2; ++j) acc[i][j] = __builtin_amdgcn_mfma_f32_32x32x16_bf16(af[i], bfr[j], acc[i][j], 0, 0, 0);
    };
#define LGKM_WAIT(n) do { asm volatile("s_waitcnt lgkmcnt(" #n ")" ::: "memory"); __builtin_amdgcn_sched_barrier(0); } while (0)
    asm volatile("s_waitcnt vmcnt(0)" ::: "memory");
    dma(0, 0);
    dma(1, 64);
    if (nk > 2) { dma(2, 128); asm volatile("s_waitcnt vmcnt(12)" ::: "memory"); }
    else asm volatile("s_waitcnt vmcnt(6)" ::: "memory");
    __builtin_amdgcn_s_barrier();
    bf16x8 a0[2], b0[2], a1[2], b1[2];
    ldfrag(0, 0, a0, b0);
    int cur = 0;
    for (int kt = 0; kt < nk; ++kt) {
        const int nxt = (cur == 2) ? 0 : cur + 1;
        if (kt == 4 || kt == 8) { LGKM_WAIT(0); hook(kt, acc); }
        ldfrag(cur, 1, a1, b1);
        LGKM_WAIT(4);
        mma(a0, b0);
        ldfrag(cur, 2, a0, b0);
        LGKM_WAIT(4);
        mma(a1, b1);
        ldfrag(cur, 3, a1, b1);
        LGKM_WAIT(4);
        mma(a0, b0);
        if (kt + 1 < nk) {
            if (kt + 2 < nk) asm volatile("s_waitcnt vmcnt(6) lgkmcnt(0)" ::: "memory");
            else asm volatile("s_waitcnt vmcnt(0) lgkmcnt(0)" ::: "memory");
            __builtin_amdgcn_s_barrier();
            __builtin_amdgcn_sched_barrier(0);
            if (kt + 3 < nk) dma(cur, (kt + 3) << 6);
            ldfrag(nxt, 0, a0, b0);
        } else {
            LGKM_WAIT(0);
        }
        mma(a1, b1);
        cur = nxt;
    }
    __syncthreads();
}
__device__ __forceinline__ float row_rs8(const float* part, int row) {
    float4 a = *(const float4*)(part + (size_t)row * 8), b = *(const float4*)(part + (size_t)row * 8 + 4);
    float ss = ((a.x + a.y) + (a.z + a.w)) + ((b.x + b.y) + (b.z + b.w));
    return rsqrtf(ss * (1.f / 1024.f) + EPSF);
}
__device__ __forceinline__ bool xcd_tile(int it, int MT, int NT, int& mt, int& nt) {
    const int G = gridDim.x, bid = blockIdx.x;
    if ((G & 7) == 0 && (MT & 7) == 0) {
        const int nbx = G >> 3, q = (bid >> 3) + it * nbx, per = (MT >> 3) * NT;
        if (q >= per) return false;
        mt = (bid & 7) * (MT >> 3) + q / NT; nt = q % NT;
        return true;
    }
    const int q = bid + it * G;
    if (q >= MT * NT) return false;
    mt = q / NT; nt = q % NT;
    return true;
}
struct NoScale { __device__ __forceinline__ float operator()(int, int) const { return 1.f; } };

#define ZERO_ACC(acc)                                  \
    _Pragma("unroll") for (int _i = 0; _i < 2; ++_i)   \
    _Pragma("unroll") for (int _j = 0; _j < 2; ++_j)   \
    _Pragma("unroll") for (int _r = 0; _r < 16; ++_r) acc[_i][_j][_r] = 0.f;


#define TB_LD 136
#define TF_LD 132
template <bool SCALE>
__device__ __forceinline__ void stage_bf16(const f32x16 (&acc)[2][2], const float* rsl) {
    bf16* T = (bf16*)smem;
    const int tid = opaque_tid(), w = tid >> 6, l = tid & 63, hh = l >> 5, wm = w >> 1, wn = w & 1;
#pragma unroll
    for (int i = 0; i < 2; ++i)
#pragma unroll
        for (int rr = 0; rr < 16; ++rr) {
            int row = wm * 64 + i * 32 + (rr & 3) + 8 * (rr >> 2) + 4 * hh;
            float sc = SCALE ? rsl[row] : 1.f;
#pragma unroll
            for (int j = 0; j < 2; ++j) T[row * TB_LD + wn * 64 + j * 32 + (l & 31)] = (bf16)(acc[i][j][rr] * sc);
        }
    __syncthreads();
}
template <bool SCALE>
__device__ __forceinline__ void stage_f32(const f32x16 (&acc)[2][2], const float* rsl) {
    float* T = (float*)smem;
    const int tid = opaque_tid(), w = tid >> 6, l = tid & 63, hh = l >> 5, wm = w >> 1, wn = w & 1;
#pragma unroll
    for (int i = 0; i < 2; ++i)
#pragma unroll
        for (int rr = 0; rr < 16; ++rr) {
            int row = wm * 64 + i * 32 + (rr & 3) + 8 * (rr >> 2) + 4 * hh;
            float sc = SCALE ? rsl[row] : 1.f;
#pragma unroll
            for (int j = 0; j < 2; ++j) T[row * TF_LD + wn * 64 + j * 32 + (l & 31)] = acc[i][j][rr] * sc;
        }
    __syncthreads();
}
template <typename CMAP>
__device__ __forceinline__ void store_rows_bf16(bf16* dst, int ld, int m0, CMAP cmap) {
    const bf16* T = (const bf16*)smem;
    const int tid = opaque_tid();
#pragma unroll
    for (int q = 0; q < 8; ++q) {
        int id = tid + 512 * q, row = id >> 4, ch = id & 15;
        u32x4 v = *(const u32x4*)(T + row * TB_LD + ch * 8);
        *(u32x4*)(dst + (size_t)(m0 + row) * ld + cmap(ch * 8)) = v;
    }
}
__device__ __forceinline__ void store_cols_bf16(bf16* vt, size_t crow0, int s0) {
    const unsigned short* T = (const unsigned short*)smem;
    const int tid = opaque_tid();
#pragma unroll
    for (int q = 0; q < 8; ++q) {
        int id = tid + 512 * q, c = id & 127, sg = id >> 7;
        unsigned e[8];
#pragma unroll
        for (int k = 0; k < 8; ++k) e[k] = T[(8 * sg + k) * TB_LD + c];
        u32x4 v = {e[0] | (e[1] << 16), e[2] | (e[3] << 16), e[4] | (e[5] << 16), e[6] | (e[7] << 16)};
        *(u32x4*)(vt + (crow0 + c) * SEQ + s0 + 8 * sg) = v;
    }
}
__device__ __forceinline__ void residual_store(const float* hin, float* hout, bf16* hb_out, float* gss, int m0, int n0, int nt) {
    const float* T = (const float*)smem;
    const int tid = opaque_tid(), l = tid & 63;
#pragma unroll 4
    for (int q = 0; q < 16; ++q) {
        int id = tid + 512 * q, row = id >> 5, ch = id & 31;
        f32x4 d = *(const f32x4*)(T + row * TF_LD + ch * 4);
        size_t gi = (size_t)(m0 + row) * 1024 + n0 + ch * 4;
        f32x4 h = *(const f32x4*)(hin + gi);
        f32x4 v = h + d;
        *(f32x4*)(hout + gi) = v;
        u32x2 b = {pack2(v.x, v.y), pack2(v.z, v.w)};
        *(u32x2*)(hb_out + (size_t)(m0 + row) * LDH + n0 + ch * 4) = b;
        float ss = v.x * v.x + v.y * v.y + v.z * v.z + v.w * v.w;
        ss = dpp_add<0xB1>(ss); ss = dpp_add<0x4E>(ss); ss = dpp_add<0x141>(ss); ss = dpp_add<0x140>(ss);
        ss += __shfl_xor(ss, 16);
        if ((l & 31) == 0) gss[(size_t)(m0 + row) * 8 + nt] = ss;
    }
}
struct ColAdd { int off; __device__ __forceinline__ int operator()(int c) const { return c + off; } };
struct ColHead96 { __device__ __forceinline__ int operator()(int c) const { return (c >> 6) * 96 + (c & 63); } };

__device__ __forceinline__ void phase_proj(const Params& P, int L, int hsel, const float* ssrow) {
    char* ws = opq(P.ws);
    const bf16* hb = (const bf16*)(ws + (hsel ? OFF_HB1 : OFF_HB0));
    const bf16* Bt = (const bf16*)(ws + OFF_WIN) + (size_t)L * 2048 * LDH;
    bf16* fq = (bf16*)(ws + OFF_FQ); bf16* fk = (bf16*)(ws + OFF_FK); bf16* fvt = (bf16*)(ws + OFF_FVT);
    bf16* sq = (bf16*)(ws + OFF_SQ); bf16* sk = (bf16*)(ws + OFF_SKK); bf16* svt = (bf16*)(ws + OFF_SVT);
    bf16* cq = (bf16*)(ws + OFF_CQ); bf16* ckv = (bf16*)(ws + OFF_CKV);
    float* flog = (float*)(ws + OFF_FLOG);
    bf16* mk = (bf16*)(ws + OFF_MK);
    const float* cs = (const float*)(ws + OFF_CS);
    const int tid = opaque_tid(), w = tid >> 6, l = tid & 63, hh = l >> 5, wm = w >> 1, wn = w & 1;
    for (int it = 0;; ++it) {
        int mt, nt;
        if (!xcd_tile(it, 64, 16, mt, nt)) break;
        int m0 = mt * 256, n0 = nt * 128;
        float* aux = (float*)(smem + LDS_AUX);
        if (tid < 256) aux[tid] = row_rs8(ssrow, m0 + tid);
        f32x16 acc[2][2];
        ZERO_ACC(acc);
        gemm_core(acc, hb, LDH, Bt, LDH, 1024, m0, n0, NoHook());
        if (nt < 15) {
            stage_bf16<true>(acc, aux);
            if (nt == 4 || nt == 5 || nt == 10 || nt == 11) {
                bf16* vt = (nt < 6) ? fvt : svt;
                int cbase = n0 - ((nt < 6) ? 512 : 1280);
                store_cols_bf16(vt, (size_t)(m0 >> 11) * 256 + cbase, m0 & 2047);
            } else if (nt < 2) store_rows_bf16(fq, 256, m0, ColAdd{n0});
            else if (nt < 4) store_rows_bf16(fk, 256, m0, ColAdd{n0 - 256});
            else if (nt < 8) store_rows_bf16(sq, 256, m0, ColAdd{n0 - 768});
            else if (nt < 10) store_rows_bf16(sk, 256, m0, ColAdd{n0 - 1024});
            else if (nt < 14) store_rows_bf16(cq, LDP, m0, ColAdd{n0 - 1536});
            else store_rows_bf16(ckv, LDC, m0, ColAdd{0});
        } else {
            if (wn == 0) {
#pragma unroll
                for (int i = 0; i < 2; ++i) {
                    int rloc = wm * 64 + i * 32 + 4 * hh;
                    int ci = l & 31, pi = ci & 15;
#pragma unroll
                    for (int rr = 0; rr < 16; ++rr) {
                        int rl = rloc + (rr & 3) + 8 * (rr >> 2), row = m0 + rl;
                        float rs = aux[rl];
                        float v = acc[i][0][rr] * rs;
                        float pv = __shfl_xor(v, 16);
                        float2 c_s = *(const float2*)(cs + ((size_t)row * 16 + pi) * 2);
                        float o = (ci < 16) ? (v * c_s.x - pv * c_s.y) : (pv * c_s.y + v * c_s.x);
                        bf16 ob = (bf16)o;
#pragma unroll
                        for (int h = 0; h < 4; ++h) mk[(size_t)row * 384 + h * 96 + 64 + ci] = ob;
                        if (ci < 4) flog[(size_t)row * 4 + ci] = acc[i][1][rr] * rs;
                    }
                }
            }
        }
        __syncthreads();
    }
}

template <int KW>
__device__ __forceinline__ void row_rms_to_lds(const bf16* A, int lda, int m0) {
    const int tid = opaque_tid(), row = tid >> 1, half = tid & 1;
    float ss = 0.f;
    const u32x4* p = (const u32x4*)(A + (size_t)(m0 + row) * lda + half * (KW / 2));
#pragma unroll
    for (int q = 0; q < KW / 16; ++q) {
        u32x4 v = p[q];
        float a;
        a = bflo(v.x); ss += a * a; a = bfhi(v.x); ss += a * a;
        a = bflo(v.y); ss += a * a; a = bfhi(v.y); ss += a * a;
        a = bflo(v.z); ss += a * a; a = bfhi(v.z); ss += a * a;
        a = bflo(v.w); ss += a * a; a = bfhi(v.w); ss += a * a;
    }
    ss += __shfl_xor(ss, 1);
    if (half == 0) ((float*)(smem + LDS_AUX))[row] = rsqrtf(ss * (1.f / (float)KW) + EPSF);
}

__device__ __forceinline__ void phase_mla_up(const Params& P, int L) {
    char* ws = opq(P.ws);
    const bf16* cq = (const bf16*)(ws + OFF_CQ); const bf16* ckv = (const bf16*)(ws + OFF_CKV);
    const bf16* wuq = (const bf16*)(ws + OFF_WUQ) + (size_t)L * 384 * LDP;
    const bf16* wukv = (const bf16*)(ws + OFF_WUKV) + (size_t)L * 768 * LDC;
    bf16* mq = (bf16*)(ws + OFF_MQ); bf16* mk = (bf16*)(ws + OFF_MK); bf16* mvt = (bf16*)(ws + OFF_MVT);
    const float* cs = (const float*)(ws + OFF_CS);
    const float* flog = (const float*)(ws + OFF_FLOG);
    float* cumF = (float*)(ws + OFF_CUMF);
    const int tid = opaque_tid(), w = tid >> 6, l = tid & 63, hh = l >> 5, wm = w >> 1, wn = w & 1;
    const int NQ = 64 * 3, NKV = 64 * 6, NCF = 4;
    const float* aux = (const float*)(smem + LDS_AUX);
    for (int item = blockIdx.x; item < NQ + NKV + NCF; item += gridDim.x) {
        if (item < NQ) {
            int mt = item / 3, nt = item % 3;
            int m0 = mt * 256, n0 = nt * 128;
            __syncthreads();
            row_rms_to_lds<256>(cq, LDP, m0);
            f32x16 acc[2][2];
            ZERO_ACC(acc);
            gemm_core(acc, cq, LDP, wuq, LDP, 256, m0, n0, NoHook());
#pragma unroll
            for (int i = 0; i < 2; ++i)
#pragma unroll
                for (int j = 0; j < 2; ++j) {
                    int c0 = n0 + wn * 64 + j * 32;
                    int rloc = wm * 64 + i * 32 + 4 * hh;
                    bool rot = (c0 % 96) == 64;
                    int ci = l & 31, pi = ci & 15;
#pragma unroll
                    for (int rr = 0; rr < 16; ++rr) {
                        int rl = rloc + (rr & 3) + 8 * (rr >> 2);
                        float v = acc[i][j][rr] * aux[rl];
                        if (rot) {
                            float pv = __shfl_xor(v, 16);
                            float2 c_s = *(const float2*)(cs + ((size_t)(m0 + rl) * 16 + pi) * 2);
                            v = (ci < 16) ? (v * c_s.x - pv * c_s.y) : (pv * c_s.y + v * c_s.x);
                        }
                        acc[i][j][rr] = v;
                    }
                }
            stage_bf16<false>(acc, nullptr);
            store_rows_bf16(mq, 384, m0, ColAdd{n0});
        } else if (item < NQ + NKV) {
            int it2 = item - NQ;
            int mt = it2 / 6, nt = it2 % 6;
            int m0 = mt * 256, n0 = nt * 128;
            __syncthreads();
            row_rms_to_lds<128>(ckv, LDC, m0);
            f32x16 acc[2][2];
            ZERO_ACC(acc);
            gemm_core(acc, ckv, LDC, wukv, LDC, 128, m0, n0, NoHook());
            stage_bf16<true>(acc, aux);
            if (nt < 2) {
                const int nb0 = n0;
                struct CM { int n0; __device__ __forceinline__ int operator()(int c) const { int col = n0 + c; return (col >> 6) * 96 + (col & 63); } };
                store_rows_bf16(mk, 384, m0, CM{nb0});
            } else {
                store_cols_bf16(mvt, (size_t)(m0 >> 11) * 512 + (n0 - 256), m0 & 2047);
            }
        } else {
            int seq = (item - NQ - NKV) * NW + w;
            int b = seq >> 2, h = seq & 3;
            float bfv = P.b_forget[L * 4 + h];
            float vals[32];
            float run = 0.f;
#pragma unroll
            for (int i = 0; i < 32; ++i) {
                int s = l * 32 + i;
                float z = flog[((size_t)b * SEQ + s) * 4 + h] + bfv;
                run += log_sigmoid_f(z);
                vals[i] = run;
            }
            float tot = run, incl = tot;
#pragma unroll
            for (int o = 1; o < 64; o <<= 1) {
                float t = __shfl_up(incl, o);
                if (l >= o) incl += t;
            }
            float excl = incl - tot;
#pragma unroll
            for (int i = 0; i < 32; ++i) cumF[(size_t)seq * SEQ + l * 32 + i] = vals[i] + excl;
        }
    }
}

template <int MODE, int DK, int DV>
__device__ __forceinline__ void attn_item(const bf16* __restrict__ Q, int ldq, const bf16* __restrict__ Kg, int ldk,
                          const bf16* __restrict__ Vt, const float* __restrict__ cumF, bf16* __restrict__ Y,
                          float* __restrict__ ssy, int b, int h, int qb, float c1, char* lds) {
    constexpr int KSTR = DK * 2 + 16;
    constexpr int VSTR = 144;
    constexpr int KBYTES = 64 * KSTR, VBYTES = DV * VSTR;
    constexpr int BUF = (KBYTES + VBYTES + 256 + 255) & ~255;
    static_assert(2 * BUF <= 65536, "lds");
    constexpr int KCH = DK / 8, KPT = (64 * KCH) / 256, VPT = (DV * 8) / 256;
    const int tid = opaque_tid() & 255, w = tid >> 6, l = tid & 63, r = l & 31, hh = l >> 5;
    const int q0 = qb * 128;
    const int qrow = q0 + 32 * w + r;
    const size_t tok = (size_t)b * SEQ + qrow;
    const int bh = b * 4 + h;
    bf16x8 qf[DK / 16];
#pragma unroll
    for (int s = 0; s < DK / 16; ++s) qf[s] = *(const bf16x8*)(Q + tok * ldq + h * DK + 16 * s + 8 * hh);
    f32x16 o[DV / 32];
    const f32x16 zero16 = {0.f, 0.f, 0.f, 0.f, 0.f, 0.f, 0.f, 0.f, 0.f, 0.f, 0.f, 0.f, 0.f, 0.f, 0.f, 0.f};
#pragma unroll
    for (int d = 0; d < DV / 32; ++d) o[d] = zero16;
    float m = -1e30f, lsum = 0.f, R = 0.f;
    float Fq = 0.f;
    if (MODE == 0) Fq = cumF[(size_t)bh * SEQ + qrow] * LOG2E;
    const int nkt = (q0 + 128) >> 6;
    u32x4 kreg[KPT], vreg[VPT];
    float4 freg = {0.f, 0.f, 0.f, 0.f};
    auto gload = [&](int kt) {
#pragma unroll
        for (int i = 0; i < KPT; ++i) {
            int e = tid + 256 * i;
            int row = e / KCH, ch = e % KCH;
            kreg[i] = *(const u32x4*)(Kg + ((size_t)b * SEQ + kt * 64 + row) * ldk + h * DK + ch * 8);
        }
#pragma unroll
        for (int i = 0; i < VPT; ++i) {
            int e = tid + 256 * i;
            int row = e >> 3, ch = e & 7;
            vreg[i] = *(const u32x4*)(Vt + ((size_t)bh * DV + row) * SEQ + kt * 64 + ch * 8);
        }
        if (MODE == 0 && tid < 16) freg = *(const float4*)(cumF + (size_t)bh * SEQ + kt * 64 + tid * 4);
    };
    auto lwrite = [&](int buf) {
        char* base = lds + buf * BUF;
#pragma unroll
        for (int i = 0; i < KPT; ++i) {
            int e = tid + 256 * i;
            int row = e / KCH, ch = e % KCH;
            *(u32x4*)(base + row * KSTR + ch * 16) = kreg[i];
        }
#pragma unroll
        for (int i = 0; i < VPT; ++i) {
            int e = tid + 256 * i;
            int row = e >> 3, ch = e & 7;
            *(u32x4*)(base + KBYTES + row * VSTR + ch * 16) = vreg[i];
        }
        if (MODE == 0 && tid < 16) *(float4*)(base + KBYTES + VBYTES + tid * 16) = freg;
    };
    const int prow = (r & 0x13) | ((r & 4) << 1) | ((r & 8) >> 1);
    gload(MODE == 1 ? nkt - 1 : 0);
    lwrite(0);
    __syncthreads();
    for (int it = 0; it < nkt; ++it) {
        const int kt = (MODE == 1) ? (nkt - 1 - it) : it;
        if (it + 1 < nkt) gload((MODE == 1) ? (kt - 1) : (kt + 1));
        const char* base = lds + (it & 1) * BUF;
        const bool active = (kt * 64) <= (q0 + 32 * w + 31);
        if (active) {
            const bool needmask = (kt * 64 + 63) >= (q0 + 32 * w);
            f32x16 s[2];
#pragma unroll
            for (int sub = 0; sub < 2; ++sub) {
                s[sub] = zero16;
#pragma unroll
                for (int ks = 0; ks < DK / 16; ++ks) {
                    bf16x8 kf = *(const bf16x8*)(base + (sub * 32 + prow) * KSTR + (2 * ks + hh) * 16);
                    s[sub] = __builtin_amdgcn_mfma_f32_32x32x16_bf16(kf, qf[ks], s[sub], 0, 0, 0);
                }
            }
            bf16x8 pf[2][2];
            if (MODE != 1) {
                const float* Ft = (const float*)(base + KBYTES + VBYTES);
                float mx = -INFINITY;
                float tv[2][16];
#pragma unroll
                for (int sub = 0; sub < 2; ++sub)
#pragma unroll
                    for (int a = 0; a < 2; ++a) {
                        int kofs = sub * 32 + 16 * a + 8 * hh;
                        float fk[8];
                        if (MODE == 0) {
                            float4 f0 = *(const float4*)(Ft + kofs), f1 = *(const float4*)(Ft + kofs + 4);
                            fk[0] = f0.x; fk[1] = f0.y; fk[2] = f0.z; fk[3] = f0.w; fk[4] = f1.x; fk[5] = f1.y; fk[6] = f1.z; fk[7] = f1.w;
                        }
#pragma unroll
                        for (int j = 0; j < 8; ++j) {
                            int rr = 8 * a + j;
                            float v = s[sub][rr] * c1;
                            if (MODE == 0) v += Fq - fk[j] * LOG2E;
                            if (needmask && (kt * 64 + kofs + j > qrow)) v = -INFINITY;
                            tv[sub][rr] = v;
                            mx = fmaxf(mx, v);
                        }
                    }
                mx = fmaxf(mx, __shfl_xor(mx, 32));
                float mnew = fmaxf(m, mx);
                float alpha = fexp2(m - mnew);
                float rsum = 0.f;
#pragma unroll
                for (int sub = 0; sub < 2; ++sub)
#pragma unroll
                    for (int a = 0; a < 2; ++a) {
                        float pv[8];
#pragma unroll
                        for (int j = 0; j < 8; ++j) { pv[j] = fexp2(tv[sub][8 * a + j] - mnew); rsum += pv[j]; }
                        uint4 u;
                        u.x = pack2(pv[0], pv[1]); u.y = pack2(pv[2], pv[3]); u.z = pack2(pv[4], pv[5]); u.w = pack2(pv[6], pv[7]);
                        pf[sub][a] = __builtin_bit_cast(bf16x8, u);
                    }
                rsum += __shfl_xor(rsum, 32);
                lsum = lsum * alpha + rsum;
                m = mnew;
#pragma unroll
                for (int d = 0; d < DV / 32; ++d) o[d] = o[d] * alpha;
            } else {
#pragma unroll
                for (int sb = 0; sb < 2; ++sb) {
                    const int sub = 1 - sb;
                    float lsig[16], lneg[16];
                    float A0 = 0.f, A1 = 0.f;
#pragma unroll
                    for (int rr = 0; rr < 16; ++rr) {
                        int key = kt * 64 + sub * 32 + 16 * (rr >> 3) + 8 * hh + (rr & 7);
                        bool valid = key < qrow;
                        float z = s[sub][rr] * c1;
                        float e = fexp2(-fabsf(z));
                        float l1p = flog2(1.f + e);
                        float ls = fminf(z, 0.f) - l1p;
                        float ln = valid ? (ls - z) : 0.f;
                        lsig[rr] = valid ? ls : -INFINITY;
                        lneg[rr] = ln;
                        if (rr < 8) A0 += ln; else A1 += ln;
                    }
                    float B0 = __shfl_xor(A0, 32), B1 = __shfl_xor(A1, 32);
                    float base1 = (hh == 0) ? (R + B1) : R;
                    float base0 = (hh == 0) ? (R + B1 + A1 + B0) : (R + A1 + B1);
                    float wv[16];
                    float run = base1;
#pragma unroll
                    for (int j = 7; j >= 0; --j) { wv[8 + j] = fexp2(lsig[8 + j] + run); run += lneg[8 + j]; }
                    run = base0;
#pragma unroll
                    for (int j = 7; j >= 0; --j) { wv[j] = fexp2(lsig[j] + run); run += lneg[j]; }
                    R += A0 + A1 + B0 + B1;
#pragma unroll
                    for (int a = 0; a < 2; ++a) {
                        uint4 u;
                        u.x = pack2(wv[8 * a], wv[8 * a + 1]); u.y = pack2(wv[8 * a + 2], wv[8 * a + 3]);
                        u.z = pack2(wv[8 * a + 4], wv[8 * a + 5]); u.w = pack2(wv[8 * a + 6], wv[8 * a + 7]);
                        pf[sub][a] = __builtin_bit_cast(bf16x8, u);
                    }
                }
            }
#pragma unroll
            for (int d = 0; d < DV / 32; ++d)
#pragma unroll
                for (int sub = 0; sub < 2; ++sub)
#pragma unroll
                    for (int a = 0; a < 2; ++a) {
                        bf16x8 vf = *(const bf16x8*)(base + KBYTES + (d * 32 + r) * VSTR + (sub * 32 + 16 * a + 8 * hh) * 2);
                        o[d] = __builtin_amdgcn_mfma_f32_32x32x16_bf16(vf, pf[sub][a], o[d], 0, 0, 0);
                    }
        }
        if (it + 1 < nkt) lwrite((it + 1) & 1);
        __syncthreads();
    }
    float inv = (MODE == 1) ? 1.f : (1.f / lsum);
    float ssq = 0.f;
#pragma unroll
    for (int d = 0; d < DV / 32; ++d)
#pragma unroll
        for (int g = 0; g < 4; ++g) {
            float v0 = o[d][4 * g] * inv, v1 = o[d][4 * g + 1] * inv, v2 = o[d][4 * g + 2] * inv, v3 = o[d][4 * g + 3] * inv;
            ssq += v0 * v0 + v1 * v1 + v2 * v2 + v3 * v3;
            uint2 u; u.x = pack2(v0, v1); u.y = pack2(v2, v3);
            *(uint2*)(Y + tok * LDH + h * DV + d * 32 + 8 * g + 4 * hh) = u;
        }
    ssq += __shfl_xor(ssq, 32);
    if (hh == 0) ssy[tok * 16 + h] = ssq;
}

__device__ __forceinline__ void phase_attn(const Params& P, int L, int rep = 0) {
    char* ws = opq(P.ws);
    int* cnt = (int*)(ws + OFF_CNT) + L * 64 + rep * 16;
    int* s_item = (int*)(smem + LDS_BYTES - 16);
    const float* cumF = (const float*)(ws + OFF_CUMF);
    bf16* Y = (bf16*)(ws + OFF_Y);
    float* ssy = (float*)(ws + OFF_SSY) + (size_t)L * TOK * 16;
    const int half = opaque_tid() >> 8;
    char* lds = smem + half * 65536;
    for (;;) {
        if (opaque_tid() == 0) *s_item = atomicAdd(cnt, 1);
        __syncthreads();
        int pair = *s_item;
        __syncthreads();
        if (pair >= 768) break;
        int item = pair * 2 + half;
        int qb = 15 - item / 96;
        int rem = item % 96;
        int type = rem >> 5, bh = rem & 31;
        int b = bh >> 2, h = bh & 3;
        if (type == 0) {
            attn_item<2, 96, 128>((const bf16*)(ws + OFF_MQ), 384, (const bf16*)(ws + OFF_MK), 384, (const bf16*)(ws + OFF_MVT), cumF,
                                  Y + 512, ssy + 8, b, h, qb, 0.10206207261596577f * LOG2E, lds);
        } else if (type == 1) {
            attn_item<1, 64, 64>((const bf16*)(ws + OFF_SQ), 256, (const bf16*)(ws + OFF_SKK), 256, (const bf16*)(ws + OFF_SVT), cumF,
                                 Y + 256, ssy + 4, b, h, qb, 0.125f * LOG2E, lds);
        } else {
            attn_item<0, 64, 64>((const bf16*)(ws + OFF_FQ), 256, (const bf16*)(ws + OFF_FK), 256, (const bf16*)(ws + OFF_FVT), cumF,
                                 Y + 0, ssy + 0, b, h, qb, 0.125f * LOG2E, lds);
        }
    }
}

__device__ __forceinline__ void rowss_flush(float (&part)[2][16], float* gss, int m0, int nt) {
    float* lss = (float*)smem;
    const int tid = opaque_tid(), w = tid >> 6, l = tid & 63, hh = l >> 5, wm = w >> 1, wn = w & 1;
#pragma unroll
    for (int i = 0; i < 2; ++i)
#pragma unroll
        for (int rr = 0; rr < 16; ++rr) {
            float v = part[i][rr];
            v = dpp_add<0xB1>(v); v = dpp_add<0x4E>(v); v = dpp_add<0x141>(v); v = dpp_add<0x140>(v);
            v += __shfl_xor(v, 16);
            if ((l & 31) == 0) lss[wn * 256 + wm * 64 + i * 32 + (rr & 3) + 8 * (rr >> 2) + 4 * hh] = v;
        }
    __syncthreads();
    if (tid < 256) gss[(size_t)(m0 + tid) * 8 + nt] = lss[tid] + lss[256 + tid];
    __syncthreads();
}

struct WoHook {
    static constexpr bool nodma = false;
    __device__ __forceinline__ void operator()(int kt, f32x16 (&acc)[2][2]) const {
        if (kt == 4 || kt == 8) {
            const float* fac = (const float*)(smem + LDS_AUX) + (kt == 4 ? 0 : 256);
            const int tid = opaque_tid(), w = tid >> 6, l = tid & 63, hh = l >> 5, wm = w >> 1;
#pragma unroll
            for (int i = 0; i < 2; ++i)
#pragma unroll
                for (int rr = 0; rr < 16; ++rr) {
                    float f = fac[wm * 64 + i * 32 + (rr & 3) + 8 * (rr >> 2) + 4 * hh];
                    acc[i][0][rr] *= f; acc[i][1][rr] *= f;
                }
        }
    }
};

__device__ __forceinline__ void phase_wo(const Params& P, int L, int hsel, float* ss_out) {
    char* ws = opq(P.ws);
    bf16* hb_out = (bf16*)(ws + (hsel ? OFF_HB1 : OFF_HB0));
    const float* hin = (L == 0) ? opq(P.x) : (const float*)opq(P.out);
    float* hout = opq(P.out);
    const bf16* Y = (const bf16*)(ws + OFF_Y);
    const bf16* Bt = (const bf16*)(ws + OFF_WO) + (size_t)L * 1024 * LDH;
    const float* ssy = (const float*)(ws + OFF_SSY) + (size_t)L * TOK * 16;
    float* aux = (float*)(smem + LDS_AUX);
    const int tid = opaque_tid(), w = tid >> 6, l = tid & 63, hh = l >> 5, wm = w >> 1, wn = w & 1;
    for (int it = 0;; ++it) {
        int mt, nt;
        if (!xcd_tile(it, 64, 8, mt, nt)) break;
        int m0 = mt * 256, n0 = nt * 128;
        __syncthreads();
        if (tid < 256) {
            int row = m0 + tid;
            float4 v0 = *(const float4*)(ssy + (size_t)row * 16), v1 = *(const float4*)(ssy + (size_t)row * 16 + 4), v2 = *(const float4*)(ssy + (size_t)row * 16 + 8);
            float r0 = rsqrtf(((v0.x + v0.y) + (v0.z + v0.w)) * (1.f / 256.f) + EPSF);
            float r1 = rsqrtf(((v1.x + v1.y) + (v1.z + v1.w)) * (1.f / 256.f) + EPSF);
            float r2 = rsqrtf(((v2.x + v2.y) + (v2.z + v2.w)) * (1.f / 512.f) + EPSF);
            aux[tid] = r0 / r1; aux[256 + tid] = r1 / r2; aux[512 + tid] = r2;
        }
        f32x16 acc[2][2];
        ZERO_ACC(acc);
        gemm_core(acc, Y, LDH, Bt, LDH, 1024, m0, n0, WoHook());
        stage_f32<true>(acc, aux + 512);
        residual_store(hin, hout, hb_out, ss_out, m0, n0, nt);
    }
}

__device__ __forceinline__ void phase_pq(const Params& P, int L, int hsel, const float* ssrow, int fake = 0) {
    char* ws = opq(P.ws);
    const bf16* hb = (const bf16*)(ws + (hsel ? OFF_HB1 : OFF_HB0));
    const bf16* Bt = (const bf16*)(ws + OFF_WQ) + (size_t)L * 1024 * LDH;
    bf16* pq = (bf16*)(ws + (fake ? OFF_PART : OFF_PQ));
    const int tid = opaque_tid(), w = tid >> 6, l = tid & 63, hh = l >> 5, wm = w >> 1, wn = w & 1;
    for (int it = 0;; ++it) {
        int mt, nt;
        if (!xcd_tile(it, 64, 8, mt, nt)) break;
        int m0 = mt * 256, n0 = nt * 128;
        f32x16 acc[2][2];
        ZERO_ACC(acc);
        float* aux = (float*)(smem + LDS_AUX);
        if (tid < 256) aux[tid] = row_rs8(ssrow, m0 + tid);
        if (fake & 4) gemm_core(acc, hb, LDH, Bt, LDH, 1024, 0, 0, NoDmaHook());
        else gemm_core(acc, hb, LDH, Bt, LDH, 1024, (fake & 1) ? 0 : m0, (fake & 2) ? 0 : n0, NoHook());
        if (fake & 8) {
#pragma unroll
            for (int i = 0; i < 2; ++i)
#pragma unroll
                for (int j = 0; j < 2; ++j) asm volatile("" :: "v"(acc[i][j]));
            continue;
        }
        stage_bf16<true>(acc, aux);
        store_rows_bf16(pq, 1024, m0, ColAdd{n0});
        __syncthreads();
    }
}

__device__ __forceinline__ void cswap(int& a, int& b) { int mx = max(a, b), mn = min(a, b); a = mx; b = mn; }
__device__ __forceinline__ void bitonic_sort16(int (&v)[16]) {
#pragma unroll
    for (int k = 2; k <= 16; k <<= 1)
#pragma unroll
        for (int j = k >> 1; j > 0; j >>= 1)
#pragma unroll
            for (int i = 0; i < 16; ++i) {
                int q = i ^ j;
                if (q > i) {
                    if ((i & k) == 0) cswap(v[i], v[q]); else cswap(v[q], v[i]);
                }
            }
}
__device__ __forceinline__ void merge_top16(int (&Lv)[16], const int (&Rv)[16]) {
#pragma unroll
    for (int i = 0; i < 16; ++i) Lv[i] = max(Lv[i], Rv[15 - i]);
#pragma unroll
    for (int j = 8; j > 0; j >>= 1)
#pragma unroll
        for (int i = 0; i < 16; ++i) {
            int q = i ^ j;
            if (q > i) cswap(Lv[i], Lv[q]);
        }
}
__device__ __forceinline__ int f2key(float v, int low, int mask) {
    int b = __float_as_int(v);
    b ^= (b >> 31) & 0x7fffffff;
    return (b & ~mask) | low;
}
__device__ __forceinline__ float key2f(int k, int mask) {
    int b = k & ~mask;
    b ^= (b >> 31) & 0x7fffffff;
    return __int_as_float(b);
}

__device__ __forceinline__ void phase_topk(const Params& P, int L) {
    char* ws = opq(P.ws);
    const bf16* pq = (const bf16*)(ws + OFF_PQ);
    const bf16* skb = (const bf16*)(ws + OFF_SKB) + (size_t)L * 16 * 128 * 64;
    unsigned short* ids = (unsigned short*)(ws + OFF_IDS);
    float* gates = (float*)(ws + OFF_GATE);
    const int half = opaque_tid() >> 8;
    char* lds = smem + half * 57600;
    float* sc = (float*)lds;
    int* Lq = (int*)(lds + 64 * 129 * 4);
    int* Fin = Lq + 4 * 64 * 16;
    const int tid = opaque_tid() & 255, w = tid >> 6, l = tid & 63, r = l & 31, hh = l >> 5;
    for (int item = blockIdx.x * 2 + half; item < TOK / 64; item += gridDim.x * 2) {
        const int t0 = item * 64;
        for (int h = 0; h < 8; ++h) {
            for (int p = 0; p < 2; ++p) {
                const int hp = h * 2 + p;
                f32x16 acc[2];
#pragma unroll
                for (int j = 0; j < 2; ++j)
#pragma unroll
                    for (int rr = 0; rr < 16; ++rr) acc[j][rr] = 0.f;
#pragma unroll
                for (int s = 0; s < 4; ++s) {
                    bf16x8 af = *(const bf16x8*)(skb + ((size_t)hp * 128 + 32 * w + r) * 64 + 16 * s + 8 * hh);
#pragma unroll
                    for (int j = 0; j < 2; ++j) {
                        bf16x8 bfr = *(const bf16x8*)(pq + (size_t)(t0 + 32 * j + r) * 1024 + hp * 64 + 16 * s + 8 * hh);
                        acc[j] = __builtin_amdgcn_mfma_f32_32x32x16_bf16(af, bfr, acc[j], 0, 0, 0);
                    }
                }
#pragma unroll
                for (int j = 0; j < 2; ++j)
#pragma unroll
                    for (int rr = 0; rr < 16; ++rr) {
                        int key = 32 * w + (rr & 3) + 8 * (rr >> 2) + 4 * hh;
                        sc[(32 * j + r) * 129 + key] = acc[j][rr];
                    }
                __syncthreads();
                {
                    const int token = l, quarter = w;
                    int A[16], B[16];
#pragma unroll
                    for (int i = 0; i < 16; ++i) {
                        int n = quarter * 32 + i;
                        A[i] = f2key(sc[token * 129 + n], 127 - n, 127);
                        B[i] = f2key(sc[token * 129 + n + 16], 127 - (n + 16), 127);
                    }
                    bitonic_sort16(A);
                    bitonic_sort16(B);
                    merge_top16(A, B);
#pragma unroll
                    for (int i = 0; i < 16; ++i) Lq[(quarter * 64 + token) * 16 + i] = A[i];
                    __syncthreads();
                    if ((quarter & 1) == 0) {
#pragma unroll
                        for (int i = 0; i < 16; ++i) B[i] = Lq[((quarter + 1) * 64 + token) * 16 + i];
                        merge_top16(A, B);
                        if (quarter == 2) {
#pragma unroll
                            for (int i = 0; i < 16; ++i) Lq[(2 * 64 + token) * 16 + i] = A[i];
                        }
                    }
                    __syncthreads();
                    if (quarter == 0) {
#pragma unroll
                        for (int i = 0; i < 16; ++i) B[i] = Lq[(2 * 64 + token) * 16 + i];
                        merge_top16(A, B);
#pragma unroll
                        for (int i = 0; i < 16; ++i) Fin[(p * 64 + token) * 16 + i] = A[i];
                    }
                    __syncthreads();
                }
            }
            if (w == 0) {
                const int token = l;
                float s1[16], s2[16];
#pragma unroll
                for (int i = 0; i < 16; ++i) {
                    s1[i] = key2f(Fin[(0 * 64 + token) * 16 + i], 127);
                    s2[i] = key2f(Fin[(1 * 64 + token) * 16 + i], 127);
                }
                int Lc[16], X[16];
#pragma unroll
                for (int b2 = 0; b2 < 16; ++b2) Lc[b2] = f2key(s1[0] + s2[b2], 255 - b2, 255);
#pragma unroll
                for (int a = 1; a < 16; ++a) X[a - 1] = f2key(s1[a] + s2[0], 255 - a * 16, 255);
                X[15] = INT_MIN;
                merge_top16(Lc, X);
                {
                    int c = 0;
#pragma unroll
                    for (int b2 = 1; b2 <= 7; ++b2) X[c++] = f2key(s1[1] + s2[b2], 255 - (16 + b2), 255);
#pragma unroll
                    for (int b2 = 1; b2 <= 4; ++b2) X[c++] = f2key(s1[2] + s2[b2], 255 - (32 + b2), 255);
#pragma unroll
                    for (int b2 = 1; b2 <= 3; ++b2) X[c++] = f2key(s1[3] + s2[b2], 255 - (48 + b2), 255);
#pragma unroll
                    for (int b2 = 1; b2 <= 2; ++b2) X[c++] = f2key(s1[4] + s2[b2], 255 - (64 + b2), 255);
                }
                bitonic_sort16(X);
                merge_top16(Lc, X);
                X[0] = f2key(s1[5] + s2[1], 255 - (80 + 1), 255);
                X[1] = f2key(s1[6] + s2[1], 255 - (96 + 1), 255);
                X[2] = f2key(s1[7] + s2[1], 255 - (112 + 1), 255);
#pragma unroll
                for (int i = 3; i < 16; ++i) X[i] = INT_MIN;
                merge_top16(Lc, X);
                float mx = key2f(Lc[0], 255);
                float ev[16], sum = 0.f;
#pragma unroll
                for (int k = 0; k < 16; ++k) { ev[k] = __expf(key2f(Lc[k], 255) - mx); sum += ev[k]; }
                float inv = 1.f / sum;
                size_t ob = (size_t)(t0 + token) * 128 + h * 16;
#pragma unroll
                for (int k = 0; k < 16; ++k) {
                    int cidx = 255 - (Lc[k] & 255);
                    int a = cidx >> 4, b2 = cidx & 15;
                    int i1 = 127 - (Fin[(0 * 64 + token) * 16 + a] & 127);
                    int i2 = 127 - (Fin[(1 * 64 + token) * 16 + b2] & 127);
                    ids[ob + k] = (unsigned short)(i1 * 128 + i2);
                    gates[ob + k] = ev[k] * inv;
                }
            }
            __syncthreads();
        }
    }
}

__device__ __forceinline__ float gelu_exact(float x) { return 0.5f * x * (1.f + erff(x * 0.70710678118654752f)); }

__device__ __forceinline__ void dec16(const u32x4& v, float (&f)[16]) {
    f32x2 t;
    t = __builtin_amdgcn_cvt_pk_f32_fp8((int)v.x, false); f[0] = t.x; f[1] = t.y;
    t = __builtin_amdgcn_cvt_pk_f32_fp8((int)v.x, true);  f[2] = t.x; f[3] = t.y;
    t = __builtin_amdgcn_cvt_pk_f32_fp8((int)v.y, false); f[4] = t.x; f[5] = t.y;
    t = __builtin_amdgcn_cvt_pk_f32_fp8((int)v.y, true);  f[6] = t.x; f[7] = t.y;
    t = __builtin_amdgcn_cvt_pk_f32_fp8((int)v.z, false); f[8] = t.x; f[9] = t.y;
    t = __builtin_amdgcn_cvt_pk_f32_fp8((int)v.z, true);  f[10] = t.x; f[11] = t.y;
    t = __builtin_amdgcn_cvt_pk_f32_fp8((int)v.w, false); f[12] = t.x; f[13] = t.y;
    t = __builtin_amdgcn_cvt_pk_f32_fp8((int)v.w, true);  f[14] = t.x; f[15] = t.y;
}

__device__ __forceinline__ int idof16(const u32x4 (&q)[2], int i) {
    unsigned wv = (i >> 1) == 0 ? q[0].x : (i >> 1) == 1 ? q[0].y : (i >> 1) == 2 ? q[0].z : (i >> 1) == 3 ? q[0].w
                : (i >> 1) == 4 ? q[1].x : (i >> 1) == 5 ? q[1].y : (i >> 1) == 6 ? q[1].z : q[1].w;
    return (i & 1) ? (int)(wv >> 16) : (int)(wv & 0xffffu);
}
__device__ __forceinline__ void phase_gather_u(const Params& P, int L) {
    char* ws = opq(P.ws);
    const unsigned char* U8 = (const unsigned char*)(ws + OFF_UB) + (size_t)L * NEXP * DM;
    float* part = (float*)(ws + OFF_PART);
    const unsigned short* ids = (const unsigned short*)(ws + OFF_IDS);
    const float* hin = opq(P.out);
    const int tid = opaque_tid(), w = tid >> 6, l = tid & 63, c = l & 7, gq = l >> 3;
    const int j = blockIdx.x & 7, rk = blockIdx.x >> 3, nb = gridDim.x >> 3;
    if (rk >= nb) return;
    const unsigned char* ubase = U8 + (size_t)j * NEXP * 128 + c * 16;
    const int stride = nb * NW;
    int t = rk * NW + w;
    if (t >= TOK) return;
    u32x4 idA[2], idB[2];
    u32x4 rv[16];
    f32x4 hA[4], hB[4];
    auto load_ids = [&](int tt, u32x4 (&idq)[2]) {
        const u32x4* i4 = (const u32x4*)(ids + (size_t)tt * 128 + 16 * gq);
        idq[0] = i4[0]; idq[1] = i4[1];
    };
    auto load_hx = [&](int tt, f32x4 (&hx)[4]) {
        const f32x4* h4 = (const f32x4*)(hin + (size_t)tt * 1024 + 128 * j + 16 * c);
#pragma unroll
        for (int q = 0; q < 4; ++q) hx[q] = h4[q];
    };
    auto step = [&](int tcur, int tnext, int tnext2, const u32x4 (&idn)[2], u32x4 (&idl)[2], const f32x4 (&hc)[4], f32x4 (&hn)[4]) {
        load_ids(tnext2, idl);
        load_hx(tnext, hn);
        __builtin_amdgcn_sched_barrier(0);
        float pr[16];
#pragma unroll
        for (int i = 0; i < 16; ++i) {
            float f[16];
            asm volatile("" : "+v"(rv[i].x), "+v"(rv[i].y), "+v"(rv[i].z), "+v"(rv[i].w));
            dec16(rv[i], f);
            rv[i] = *(const u32x4*)(ubase + (size_t)idof16(idn, i) * 128);
            __builtin_amdgcn_sched_barrier(0);
            float s0 = 0.f, s1 = 0.f;
#pragma unroll
            for (int q = 0; q < 4; ++q) {
                s0 += f[4 * q] * hc[q].x; s1 += f[4 * q + 1] * hc[q].y; s0 += f[4 * q + 2] * hc[q].z; s1 += f[4 * q + 3] * hc[q].w;
            }
            float sacc = s0 + s1;
            asm volatile("" : "+v"(sacc));
            pr[i] = sacc;
        }
#pragma unroll
        for (int i = 0; i < 16; ++i) pr[i] = sum8_dpp(pr[i]);
        if (c == 0) {
            f32x4* o4 = (f32x4*)(part + ((size_t)j * TOK + tcur) * 128 + 16 * gq);
#pragma unroll
            for (int q = 0; q < 4; ++q) { f32x4 o = {pr[4 * q], pr[4 * q + 1], pr[4 * q + 2], pr[4 * q + 3]}; o4[q] = o; }
        }
    };
    auto clampt = [&](int tt, int fb) { return tt < TOK ? tt : fb; };
    load_ids(t, idA);
#pragma unroll
    for (int i = 0; i < 16; ++i) rv[i] = *(const u32x4*)(ubase + (size_t)idof16(idA, i) * 128);
    load_hx(t, hA);
    load_ids(clampt(t + stride, t), idB);
    for (;;) {
        int tn = t + stride, tn2 = t + 2 * stride;
        step(t, clampt(tn, t), clampt(tn2, t), idB, idA, hA, hB);
        if (tn >= TOK) break;
        t = tn; tn = t + stride; tn2 = t + 2 * stride;
        step(t, clampt(tn, t), clampt(tn2, t), idA, idB, hB, hA);
        if (tn >= TOK) break;
        t = tn;
    }
}

__device__ __forceinline__ void phase_gather_act(const Params& P, int L, const float* ss_ffn) {
    char* ws = opq(P.ws);
    const float* part = (const float*)(ws + OFF_PART);
    const unsigned short* ids = (const unsigned short*)(ws + OFF_IDS);
    float* gates = (float*)(ws + OFF_GATE);
    const float* uinv = (const float*)(ws + OFF_TSC) + L * NEXP;
    const float* vinv = (const float*)(ws + OFF_TSC) + (2 + L) * NEXP;
    const int tid = opaque_tid(), w = tid >> 6, l = tid & 63;
    for (int t = blockIdx.x * NW + w; t < TOK; t += gridDim.x * NW) {
        float rs = row_rs8(ss_ffn, t);
#pragma unroll
        for (int hsel = 0; hsel < 2; ++hsel) {
            int k = l + 64 * hsel;
            float sacc = 0.f;
#pragma unroll
            for (int j = 0; j < 8; ++j) sacc += part[((size_t)j * TOK + t) * 128 + k];
            int id = ids[(size_t)t * 128 + k];
            float pre = sacc * rs * uinv[id];
            gates[(size_t)t * 128 + k] = gates[(size_t)t * 128 + k] * gelu_exact(pre) * vinv[id];
        }
    }
}

__device__ __forceinline__ void phase_gather_v(const Params& P, int L, int hsel, float* ss_ple) {
    char* ws = opq(P.ws);
    bf16* hb_out = (bf16*)(ws + (hsel ? OFF_HB1 : OFF_HB0));
    const unsigned char* V8 = (const unsigned char*)(ws + OFF_VB) + (size_t)L * NEXP * DM;
    const unsigned short* ids = (const unsigned short*)(ws + OFF_IDS);
    const float* act = (const float*)(ws + OFF_GATE);
    float* hio = opq(P.out);
    const int tid = opaque_tid(), w = tid >> 6, l = tid & 63, c = l & 7, gq = l >> 3;
    const int j = blockIdx.x & 7, rk = blockIdx.x >> 3, nb = gridDim.x >> 3;
    if (rk >= nb) return;
    const unsigned char* vbase = V8 + (size_t)j * NEXP * 128 + c * 16;
    const int stride = nb * NW;
    int t = rk * NW + w;
    if (t >= TOK) return;
    u32x4 idA[2], idB[2];
    u32x4 rv[16];
    f32x4 aA[4], aB[4];
    auto load_ids = [&](int tt, u32x4 (&idq)[2]) {
        const u32x4* i4 = (const u32x4*)(ids + (size_t)tt * 128 + 16 * gq);
        idq[0] = i4[0]; idq[1] = i4[1];
    };
    auto load_a = [&](int tt, f32x4 (&ax)[4]) {
        const f32x4* a4 = (const f32x4*)(act + (size_t)tt * 128 + 16 * gq);
#pragma unroll
        for (int q = 0; q < 4; ++q) ax[q] = a4[q];
    };
    auto step = [&](int tcur, int tnext, int tnext2, const u32x4 (&idn)[2], u32x4 (&idl)[2], const f32x4 (&ac)[4], f32x4 (&an)[4]) {
        load_ids(tnext2, idl);
        load_a(tnext, an);
        __builtin_amdgcn_sched_barrier(0);
        float acc[16];
#pragma unroll
        for (int e = 0; e < 16; ++e) acc[e] = 0.f;
#pragma unroll
        for (int i = 0; i < 16; ++i) {
            float f[16];
            asm volatile("" : "+v"(rv[i].x), "+v"(rv[i].y), "+v"(rv[i].z), "+v"(rv[i].w));
            dec16(rv[i], f);
            rv[i] = *(const u32x4*)(vbase + (size_t)idof16(idn, i) * 128);
            __builtin_amdgcn_sched_barrier(0);
            const float a = (i & 3) == 0 ? ac[i >> 2].x : (i & 3) == 1 ? ac[i >> 2].y : (i & 3) == 2 ? ac[i >> 2].z : ac[i >> 2].w;
#pragma unroll
            for (int e = 0; e < 16; ++e) acc[e] += a * f[e];
            asm volatile("" : "+v"(acc[0]), "+v"(acc[1]), "+v"(acc[2]), "+v"(acc[3]), "+v"(acc[4]), "+v"(acc[5]), "+v"(acc[6]), "+v"(acc[7]),
                              "+v"(acc[8]), "+v"(acc[9]), "+v"(acc[10]), "+v"(acc[11]), "+v"(acc[12]), "+v"(acc[13]), "+v"(acc[14]), "+v"(acc[15]));
        }
#pragma unroll
        for (int e = 0; e < 16; ++e) acc[e] = sumg_dpp(acc[e]);
        float ssq = 0.f;
        if (gq == 0) {
            f32x4* h4 = (f32x4*)(hio + (size_t)tcur * 1024 + 128 * j + 16 * c);
            float hv[16];
#pragma unroll
            for (int q = 0; q < 4; ++q) {
                f32x4 v = h4[q];
                hv[4 * q] = v.x + acc[4 * q]; hv[4 * q + 1] = v.y + acc[4 * q + 1]; hv[4 * q + 2] = v.z + acc[4 * q + 2]; hv[4 * q + 3] = v.w + acc[4 * q + 3];
                f32x4 o = {hv[4 * q], hv[4 * q + 1], hv[4 * q + 2], hv[4 * q + 3]};
                h4[q] = o;
            }
#pragma unroll
            for (int e = 0; e < 16; ++e) ssq += hv[e] * hv[e];
            u32x4 b0 = {pack2(hv[0], hv[1]), pack2(hv[2], hv[3]), pack2(hv[4], hv[5]), pack2(hv[6], hv[7])};
            u32x4 b1 = {pack2(hv[8], hv[9]), pack2(hv[10], hv[11]), pack2(hv[12], hv[13]), pack2(hv[14], hv[15])};
            u32x4* hb4 = (u32x4*)(hb_out + (size_t)tcur * LDH + 128 * j + 16 * c);
            hb4[0] = b0; hb4[1] = b1;
        }
        ssq = sum8_dpp(ssq);
        if (l == 0) ss_ple[(size_t)tcur * 8 + j] = ssq;
    };
    auto clampt = [&](int tt, int fb) { return tt < TOK ? tt : fb; };
    load_ids(t, idA);
#pragma unroll
    for (int i = 0; i < 16; ++i) rv[i] = *(const u32x4*)(vbase + (size_t)idof16(idA, i) * 128);
    load_a(t, aA);
    load_ids(clampt(t + stride, t), idB);
    for (;;) {
        int tn = t + stride, tn2 = t + 2 * stride;
        step(t, clampt(tn, t), clampt(tn2, t), idB, idA, aA, aB);
        if (tn >= TOK) break;
        t = tn; tn = t + stride; tn2 = t + 2 * stride;
        step(t, clampt(tn, t), clampt(tn2, t), idA, idB, aB, aA);
        if (tn >= TOK) break;
        t = tn;
    }
}

__device__ __forceinline__ void phase_ple(const Params& P, int L, int hsel, const float* ss_ple, float* ss_out) {
    char* ws = opq(P.ws);
    const bf16* hb_in = (const bf16*)(ws + (hsel ? OFF_HB1 : OFF_HB0));
    bf16* hb_out = (bf16*)(ws + (hsel ? OFF_HB0 : OFF_HB1));
    float* hio = opq(P.out);
    const bf16* pin = (const bf16*)(ws + OFF_PB) + (size_t)L * TOK * LDP;
    const bf16* Wg = (const bf16*)(ws + OFF_WG) + (size_t)L * 1024 * LDH;
    const bf16* Wp = (const bf16*)(ws + OFF_WP) + (size_t)L * 1024 * LDP;
    const int tid = opaque_tid(), w = tid >> 6, l = tid & 63, hh = l >> 5, wm = w >> 1, wn = w & 1;
    for (int it = 0;; ++it) {
        int mt, nt;
        if (!xcd_tile(it, 64, 8, mt, nt)) break;
        int m0 = mt * 256, n0 = nt * 128;
        float* aux = (float*)(smem + LDS_AUX);
        __syncthreads();
        if (tid < 256) aux[tid] = row_rs8(ss_ple, m0 + tid);
        f32x16 acc1[2][2], acc2[2][2];
        ZERO_ACC(acc1);
        ZERO_ACC(acc2);
        gemm_core(acc1, hb_in, LDH, Wg, LDH, 1024, m0, n0, NoHook());
        gemm_core(acc2, pin, LDP, Wp, LDP, 256, m0, n0, NoHook());
#pragma unroll
        for (int i = 0; i < 2; ++i)
#pragma unroll
            for (int rr = 0; rr < 16; ++rr) {
                float rs = aux[wm * 64 + i * 32 + (rr & 3) + 8 * (rr >> 2) + 4 * hh];
#pragma unroll
                for (int j = 0; j < 2; ++j) {
                    float gte = 1.f / (1.f + __expf(-acc1[i][j][rr] * rs));
                    acc2[i][j][rr] *= gte;
                }
            }
        stage_f32<false>(acc2, nullptr);
        residual_store(hio, hio, hb_out, ss_out, m0, n0, nt);
    }
}

__device__ __forceinline__ void phase_final(const Params& P, const float* ss) {
    float* hio = opq(P.out);
    const int tid = opaque_tid(), w = tid >> 6, l = tid & 63;
    const float4* g4 = (const float4*)P.final_norm_g;
    for (int t = blockIdx.x * NW + w; t < TOK; t += gridDim.x * NW) {
        float rs = row_rs8(ss, t);
        float4* o4 = (float4*)(hio + (size_t)t * 1024);
#pragma unroll
        for (int i = 0; i < 4; ++i) {
            float4 v = o4[i * 64 + l], g = g4[i * 64 + l];
            v.x *= rs * g.x; v.y *= rs * g.y; v.z *= rs * g.z; v.w *= rs * g.w;
            o4[i * 64 + l] = v;
        }
    }
}

#define XB_TMO      128
#define XB_XCNT(j)  (256  + 64 * (j))
#define XB_XSUB(j)  (1280 + 64 * (j))
#define XB_XGEN(j)  (2304 + 64 * (j))
#define XB_TOP      3328
#define XB_TOPGEN   3392
#define XCD_BAR_WORDS 3456
#define XB_SPIN_CAP (1u << 22)
__device__ __forceinline__ unsigned xb_ld(unsigned* p) { return __hip_atomic_load(p, __ATOMIC_RELAXED, __HIP_MEMORY_SCOPE_AGENT); }
__device__ __forceinline__ unsigned xb_add(unsigned* p, unsigned v) { return __hip_atomic_fetch_add(p, v, __ATOMIC_RELAXED, __HIP_MEMORY_SCOPE_AGENT); }
__device__ __forceinline__ unsigned xb_xcc_id() { return (unsigned)__builtin_amdgcn_s_getreg((3 << 11) | 20) & 0xFu; }
#define XB_SPIN(cond, bar) do { unsigned _sp = 0; while (cond) { __builtin_amdgcn_s_sleep(1); \
    if ((++_sp & 255u) == 0u) { if (xb_ld(&(bar)[XB_TMO])) break; if (_sp > XB_SPIN_CAP) { atomicAdd(&(bar)[XB_TMO], 1u); break; } } } } while (0)
struct XcdBarrier { unsigned* bar; unsigned x, nloc, nx; };
__device__ __forceinline__ XcdBarrier xcd_barrier_post(unsigned* bar) {
    XcdBarrier b; b.bar = bar; b.x = xb_xcc_id(); b.nloc = 0u; b.nx = 0u;
    if (threadIdx.x == 0) (void)xb_add(&bar[XB_XCNT(b.x)], 1u);
    return b;
}
__device__ __forceinline__ void xcd_barrier_complete(unsigned* bar, unsigned x, unsigned& nloc, unsigned& nx) {
    const unsigned G = gridDim.x;
    unsigned sum, cnt, mine, sp = 0u;
    for (;;) {
        sum = 0u; cnt = 0u; mine = 0u;
#pragma unroll
        for (unsigned j = 0; j < 16; ++j) { const unsigned c = xb_ld(&bar[XB_XCNT(j)]); sum += c; cnt += (c > 0u) ? 1u : 0u; mine = (j == x) ? c : mine; }
        if (sum == G) break;
        __builtin_amdgcn_s_sleep(1);
        if ((++sp & 255u) == 0u) { if (xb_ld(&bar[XB_TMO])) break; if (sp > XB_SPIN_CAP) { atomicAdd(&bar[XB_TMO], 1u); break; } }
    }
    nloc = mine > 0u ? mine : 1u; nx = cnt > 0u ? cnt : 1u;
}
__device__ __forceinline__ void grid_barrier(XcdBarrier& b) {
    asm volatile("s_waitcnt vmcnt(0)" ::: "memory");
    __syncthreads();
    if (threadIdx.x == 0) {
        unsigned* bar = b.bar;
        __builtin_amdgcn_s_waitcnt(0);
        if (b.nloc == 0u) xcd_barrier_complete(bar, b.x, b.nloc, b.nx);
        const unsigned nloc = b.nloc, nx = b.nx;
        const unsigned old = xb_add(&bar[XB_XSUB(b.x)], 1u);
        const unsigned gen = old / nloc;
        if (old + 1u == (gen + 1u) * nloc) {
            __builtin_amdgcn_fence(__ATOMIC_RELEASE, "agent");
            asm volatile("s_waitcnt vmcnt(0)" ::: "memory");
            const unsigned og = xb_add(&bar[XB_TOP], 1u);
            const unsigned tg = og / nx;
            if (og + 1u == (tg + 1u) * nx) xb_add(&bar[XB_TOPGEN], 1u);
            else XB_SPIN(xb_ld(&bar[XB_TOPGEN]) == tg, bar);
            __builtin_amdgcn_fence(__ATOMIC_ACQUIRE, "agent");
            xb_add(&bar[XB_XGEN(b.x)], 1u);
            asm volatile("s_waitcnt vmcnt(0)" ::: "memory");
        } else {
            XB_SPIN(xb_ld(&bar[XB_XGEN(b.x)]) == gen, bar);
            __builtin_amdgcn_fence(__ATOMIC_ACQUIRE, "agent");
            asm volatile("s_waitcnt vmcnt(0)" ::: "memory");
        }
    }
    __syncthreads();
}

__global__ void __launch_bounds__(NTHR, 2) hymba_megakernel(Params P) {
    cg::grid_group grid = cg::this_grid();
    char* ws = opq(P.ws);
    float* ssa = (float*)(ws + OFF_SSA);
    XcdBarrier bar = xcd_barrier_post((unsigned*)(ws + OFF_BAR));
#define BAR() do { grid_barrier(bar); if (DUP == 20) grid_barrier(bar); } while (0)
    phase0(P);
    if (DUP == 0) { asm volatile("s_waitcnt vmcnt(0)" ::: "memory"); __syncthreads(); grid_barrier(bar); phase0(P); }
    asm volatile("s_waitcnt vmcnt(0)" ::: "memory");
    __syncthreads();
    grid.sync();
    BAR();
    int cur = 0;
    for (int L = 0; L < 2; ++L) {
        const float* ss_mix = (L == 0) ? ssa : (ssa + 3 * TOK * 8);
        float* ss_ffn = ssa + (size_t)(1 + L) * TOK * 8;
        float* ss_next = (L == 0) ? (ssa + 3 * TOK * 8) : (ssa + 4 * TOK * 8);
        float* ss_ple = ssa + (size_t)(5 + L) * TOK * 8;
        phase_proj(P, L, cur, ss_mix);
        BAR();
        if (DUP == 1) { phase_proj(P, L, cur, ss_mix); BAR(); }
        phase_mla_up(P, L);
        BAR();
        if (DUP == 2) { phase_mla_up(P, L); BAR(); }
        phase_attn(P, L, 0);
        BAR();
        if (DUP == 3) { phase_attn(P, L, 1); BAR(); }
        phase_wo(P, L, cur ^ 1, ss_ffn);
        BAR();
        if (DUP == 4 && L == 0) { phase_wo(P, L, cur ^ 1, ss_ffn); BAR(); }
        phase_pq(P, L, cur ^ 1, ss_ffn);
        BAR();
        if (DUP == 5) { phase_pq(P, L, cur ^ 1, ss_ffn); BAR(); }
        if (DUP >= 50 && DUP < 66) { phase_pq(P, L, cur ^ 1, ss_ffn, DUP - 50); BAR(); }
        phase_topk(P, L);
        BAR();
        if (DUP == 6) { phase_topk(P, L); BAR(); }
        phase_gather_u(P, L);
        BAR();
        if (DUP == 7) { phase_gather_u(P, L); BAR(); }
        phase_gather_act(P, L, ss_ffn);
        BAR();
        phase_gather_v(P, L, cur, ss_ple);
        BAR();
        phase_ple(P, L, cur, ss_ple, ss_next);
        BAR();
        cur ^= 1;
    }
    phase_final(P, ssa + 4 * TOK * 8);
}

extern "C" void kernel_launch(void* const* d_in, const int* in_sizes, int n_in, void* d_out, int out_size, void* d_ws,
                              size_t ws_size, hipStream_t stream) {
    static int grid_blocks = 0;
    if (!grid_blocks) {
        int dev = 0, cus = 0, per_cu = 0;
        hipGetDevice(&dev);
        hipDeviceGetAttribute(&cus, hipDeviceAttributeMultiprocessorCount, dev);
        hipOccupancyMaxActiveBlocksPerMultiprocessor(&per_cu, hymba_megakernel, NTHR, 0);
        if (per_cu > 1) per_cu = 1;
        if (per_cu < 1) per_cu = 1;
        grid_blocks = cus * per_cu;
        if (ws_size < WS_END) fprintf(stderr, "workspace too small: %zu < %zu\n", ws_size, (size_t)WS_END);
    }
    Params P{};
    P.x = (const float*)d_in[0]; P.p = (const float*)d_in[1]; P.pos = (const int*)d_in[2];
    P.norm_mix_g = (const float*)d_in[3]; P.w_in = (const float*)d_in[4]; P.b_forget = (const float*)d_in[5];
    P.mla_q_norm_g = (const float*)d_in[6]; P.w_uq = (const float*)d_in[7]; P.mla_kv_norm_g = (const float*)d_in[8];
    P.w_ukv = (const float*)d_in[9]; P.mix_out_norm_g = (const float*)d_in[10]; P.w_o = (const float*)d_in[11];
    P.norm_ffn_g = (const float*)d_in[12]; P.w_query = (const float*)d_in[13]; P.sub_keys = (const float*)d_in[14];
    P.peer_u = (const float*)d_in[15]; P.peer_v = (const float*)d_in[16]; P.w_ple = (const float*)d_in[17];
    P.ple_norm_g = (const float*)d_in[18]; P.w_ple_gate = (const float*)d_in[19]; P.final_norm_g = (const float*)d_in[20];
    P.out = (float*)d_out; P.ws = (char*)d_ws;
    hipMemsetAsync((char*)d_ws + OFF_BAR, 0, 16384 + 4096, stream);
    void* args[] = {&P};
    hipError_t e = hipLaunchCooperativeKernel((void*)hymba_megakernel, dim3(grid_blocks), dim3(NTHR), args, 0, stream);
    if (e != hipSuccess) fprintf(stderr, "cooperative launch failed: %s (grid %d)\n", hipGetErrorString(e), grid_blocks);
}
```

```cpp
#include <hip/hip_runtime.h>
#include <hip/hip_cooperative_groups.h>
#include <cstdio>
#include <cstdint>
#include <math.h>
#include <climits>
namespace cg = cooperative_groups;

typedef __bf16 bf16;
typedef __bf16 bf16x8 __attribute__((ext_vector_type(8)));
typedef __bf16 bf16x4 __attribute__((ext_vector_type(4)));
typedef __bf16 bf16x2 __attribute__((ext_vector_type(2)));
typedef float f32x16 __attribute__((ext_vector_type(16)));
typedef float f32x4 __attribute__((ext_vector_type(4)));
typedef float f32x2 __attribute__((ext_vector_type(2)));
typedef unsigned u32x4 __attribute__((ext_vector_type(4)));
typedef unsigned u32x2 __attribute__((ext_vector_type(2)));

#define SEQ 2048
#define BATCH 8
#define TOK 16384
#define DM 1024
#define IN_W 1956
#define NEXP 16384
#define EPSF 1e-6f
#define LOG2E 1.4426950408889634f
#define NTHR 512
#define NW 8
#define LDS_BYTES 151808
#define STAGE_BYTES 49152
#define LDS_AUX 147456
#ifndef DUP
#define DUP -1
#endif

constexpr size_t MBy = 1ull << 20;
constexpr size_t OFF_UB = 0;
constexpr size_t OFF_VB = 32 * MBy;
constexpr size_t OFF_PART = 64 * MBy;
#define LDH 1088
#define LDP 320
#define LDC 192
constexpr size_t OFF_WIN = 128 * MBy;
constexpr size_t OFF_WO = 137 * MBy;
constexpr size_t OFF_WQ = 142 * MBy;
constexpr size_t OFF_WG = 147 * MBy;
constexpr size_t OFF_WP = 152 * MBy;
constexpr size_t OFF_WUQ = 154 * MBy;
constexpr size_t OFF_WUKV = 155 * MBy;
constexpr size_t OFF_SKB = 156 * MBy;
constexpr size_t OFF_CS = 157 * MBy;
constexpr size_t OFF_TSC = 159 * MBy;
constexpr size_t OFF_SSA = 160 * MBy;
constexpr size_t OFF_HB0 = 164 * MBy;
constexpr size_t OFF_HB1 = 200 * MBy;
constexpr size_t OFF_FQ = 236 * MBy;
constexpr size_t OFF_FK = 244 * MBy;
constexpr size_t OFF_FVT = 252 * MBy;
constexpr size_t OFF_SQ = 260 * MBy;
constexpr size_t OFF_SKK = 268 * MBy;
constexpr size_t OFF_SVT = 276 * MBy;
constexpr size_t OFF_CQ = 284 * MBy;
constexpr size_t OFF_CKV = 295 * MBy;
constexpr size_t OFF_FLOG = 302 * MBy;
constexpr size_t OFF_CUMF = 303 * MBy;
constexpr size_t OFF_MQ = 304 * MBy;
constexpr size_t OFF_MK = 316 * MBy;
constexpr size_t OFF_MVT = 328 * MBy;
constexpr size_t OFF_Y = 344 * MBy;
constexpr size_t OFF_PQ = 380 * MBy;
constexpr size_t OFF_IDS = 412 * MBy;
constexpr size_t OFF_GATE = 420 * MBy;
constexpr size_t OFF_BAR = 428 * MBy;
constexpr size_t OFF_CNT = OFF_BAR + 16384;
constexpr size_t OFF_SSY = 429 * MBy;
constexpr size_t OFF_PB = 431 * MBy;
constexpr size_t WS_END = 452 * MBy;

struct Params {
    const float* x; const float* p; const int* pos;
    const float* norm_mix_g; const float* w_in; const float* b_forget; const float* mla_q_norm_g; const float* w_uq;
    const float* mla_kv_norm_g; const float* w_ukv; const float* mix_out_norm_g; const float* w_o; const float* norm_ffn_g;
    const float* w_query; const float* sub_keys; const float* peer_u; const float* peer_v; const float* w_ple;
    const float* ple_norm_g; const float* w_ple_gate; const float* final_norm_g;
    float* out; char* ws;
};

__shared__ __attribute__((aligned(16))) char smem[LDS_BYTES];

__device__ __forceinline__ int opaque_tid() { int t = threadIdx.x; asm volatile("" : "+v"(t)); return t; }
template <typename T> __device__ __forceinline__ T* opq(T* p) { size_t z = 0; asm volatile("" : "+s"(z)); return (T*)((char*)p + z); }

__device__ __forceinline__ unsigned pack2(float a, float b) {
    f32x2 v = {a, b};
    bf16x2 r = __builtin_convertvector(v, bf16x2);
    return __builtin_bit_cast(unsigned, r);
}
__device__ __forceinline__ float bflo(unsigned u) { return __uint_as_float(u << 16); }
__device__ __forceinline__ float bfhi(unsigned u) { return __uint_as_float(u & 0xffff0000u); }
__device__ __forceinline__ float wave_sum(float v) {
#pragma unroll
    for (int o = 32; o > 0; o >>= 1) v += __shfl_xor(v, o);
    return v;
}
template <int CTRL> __device__ __forceinline__ float dpp_add(float v) {
    return v + __builtin_bit_cast(float, __builtin_amdgcn_update_dpp(0, __builtin_bit_cast(int, v), CTRL, 0xf, 0xf, true));
}
__device__ __forceinline__ float sum8_dpp(float v) { v = dpp_add<0xB1>(v); v = dpp_add<0x4E>(v); v = dpp_add<0x141>(v); return v; }
__device__ __forceinline__ float sumg_dpp(float v) {
    v = dpp_add<0x128>(v);
    float a = v, b = v;
    asm volatile("s_nop 1\n\tv_permlane16_swap_b32 %0, %1\n\ts_nop 1" : "+v"(a), "+v"(b));
    v = a + b;
    a = v; b = v;
    asm volatile("s_nop 1\n\tv_permlane32_swap_b32 %0, %1\n\ts_nop 1" : "+v"(a), "+v"(b));
    return a + b;
}
__device__ __forceinline__ float fexp2(float x) { return __builtin_amdgcn_exp2f(x); }
__device__ __forceinline__ float flog2(float x) { return __builtin_amdgcn_logf(x); }
__device__ __forceinline__ float log_sigmoid_f(float z) { return fminf(z, 0.f) - log1pf(expf(-fabsf(z))); }

struct WJob { const float* src; int lds; int K; int Np; bf16* dst; int ldd; const float* gain; int map; };

__device__ __forceinline__ int src_col_map(int map, int c) {
    if (map == 0) return c;
    if (map == 1) {
        if (c < 768) return c;
        if (c < 1952) return c + 4;
        if (c < 1956) return c - 1952 + 768;
        return -1;
    }
    if (c < 256) return 192 * (c >> 6) + (c & 63);
    int e = c - 256;
    return 192 * (e >> 7) + 64 + (e & 127);
}

__device__ __forceinline__ void wconv_tile(const WJob& j, int tile) {
    float* tl = (float*)smem;
    int ktiles = j.K >> 5;
    int nt = tile / ktiles, kt = tile % ktiles;
    int n0 = nt * 32, k0 = kt * 32;
    int tx = opaque_tid() & 31, ty = opaque_tid() >> 5;
    int sc = src_col_map(j.map, n0 + tx);
#pragma unroll
    for (int i = 0; i < 2; ++i) {
        int k = k0 + ty + 16 * i;
        float v = 0.f;
        if (sc >= 0) v = j.src[(size_t)k * j.lds + sc] * (j.gain ? j.gain[k] : 1.f);
        tl[(ty + 16 * i) * 33 + tx] = v;
    }
    __syncthreads();
#pragma unroll
    for (int i = 0; i < 2; ++i) {
        int n = n0 + ty + 16 * i;
        j.dst[(size_t)n * j.ldd + k0 + tx] = (bf16)tl[tx * 33 + ty + 16 * i];
    }
    __syncthreads();
}

__device__ __forceinline__ void phase0(const Params& P) {
    char* ws = opq(P.ws);
    const int G = gridDim.x, bid = blockIdx.x, tid = opaque_tid();
    {
        const int w = tid >> 6, l = tid & 63;
        float* tsc = (float*)(ws + OFF_TSC);
        for (int it = bid * NW + w; it < 4 * NEXP; it += G * NW) {
            int tb = it >> 14, e = it & (NEXP - 1);
            const float* src = (tb < 2 ? P.peer_u : P.peer_v) + ((size_t)(tb & 1) * NEXP + e) * DM + l * 16;
            unsigned char* dst = (unsigned char*)(ws + (tb < 2 ? OFF_UB : OFF_VB)) + (size_t)(tb & 1) * NEXP * 512;
            float4 a = ((const float4*)src)[0], b = ((const float4*)src)[1], c = ((const float4*)src)[2], d = ((const float4*)src)[3];
            if (tb < 2) {
                const float4* g4 = (const float4*)(P.norm_ffn_g + (tb & 1) * 1024 + l * 16);
                float4 g0 = g4[0], g1 = g4[1], g2 = g4[2], g3 = g4[3];
                a.x *= g0.x; a.y *= g0.y; a.z *= g0.z; a.w *= g0.w; b.x *= g1.x; b.y *= g1.y; b.z *= g1.z; b.w *= g1.w;
                c.x *= g2.x; c.y *= g2.y; c.z *= g2.z; c.w *= g2.w; d.x *= g3.x; d.y *= g3.y; d.z *= g3.z; d.w *= g3.w;
            }
            float am = fmaxf(fmaxf(fmaxf(fabsf(a.x), fabsf(a.y)), fmaxf(fabsf(a.z), fabsf(a.w))), fmaxf(fmaxf(fabsf(b.x), fabsf(b.y)), fmaxf(fabsf(b.z), fabsf(b.w))));
            am = fmaxf(am, fmaxf(fmaxf(fmaxf(fabsf(c.x), fabsf(c.y)), fmaxf(fabsf(c.z), fabsf(c.w))), fmaxf(fmaxf(fabsf(d.x), fabsf(d.y)), fmaxf(fabsf(d.z), fabsf(d.w)))));
#pragma unroll
            for (int o = 32; o > 0; o >>= 1) am = fmaxf(am, __shfl_xor(am, o));
            float sc = (am > 0.f) ? (6.0f / am) : 1.f, isc = (am > 0.f) ? (am * (1.f / 6.0f)) : 1.f;
            unsigned w0 = 0, w1 = 0;
            w0 = __builtin_amdgcn_cvt_scalef32_pk_fp4_f32(w0, a.x * sc, a.y * sc, 1.0f, 0);
            w0 = __builtin_amdgcn_cvt_scalef32_pk_fp4_f32(w0, a.z * sc, a.w * sc, 1.0f, 1);
            w0 = __builtin_amdgcn_cvt_scalef32_pk_fp4_f32(w0, b.x * sc, b.y * sc, 1.0f, 2);
            w0 = __builtin_amdgcn_cvt_scalef32_pk_fp4_f32(w0, b.z * sc, b.w * sc, 1.0f, 3);
            w1 = __builtin_amdgcn_cvt_scalef32_pk_fp4_f32(w1, c.x * sc, c.y * sc, 1.0f, 0);
            w1 = __builtin_amdgcn_cvt_scalef32_pk_fp4_f32(w1, c.z * sc, c.w * sc, 1.0f, 1);
            w1 = __builtin_amdgcn_cvt_scalef32_pk_fp4_f32(w1, d.x * sc, d.y * sc, 1.0f, 2);
            w1 = __builtin_amdgcn_cvt_scalef32_pk_fp4_f32(w1, d.z * sc, d.w * sc, 1.0f, 3);
            u32x2 o2 = {w0, w1};
            *(u32x2*)(dst + ((size_t)(l >> 4) * NEXP + e) * 128 + (l & 15) * 8) = o2;
            if (l == 0) tsc[tb * NEXP + e] = isc;
        }
    }
    {
        for (int L = 0; L < 2; ++L) {
            WJob jobs[7];
            jobs[0] = {P.w_in + (size_t)L * 1024 * IN_W, IN_W, 1024, 2048, (bf16*)(ws + OFF_WIN) + (size_t)L * 2048 * LDH, LDH, P.norm_mix_g + L * 1024, 1};
            jobs[1] = {P.w_o + (size_t)L * 1024 * 1024, 1024, 1024, 1024, (bf16*)(ws + OFF_WO) + (size_t)L * 1024 * LDH, LDH, P.mix_out_norm_g + L * 1024, 0};
            jobs[2] = {P.w_query + (size_t)L * 1024 * 1024, 1024, 1024, 1024, (bf16*)(ws + OFF_WQ) + (size_t)L * 1024 * LDH, LDH, P.norm_ffn_g + L * 1024, 0};
            jobs[3] = {P.w_ple_gate + (size_t)L * 1024 * 1024, 1024, 1024, 1024, (bf16*)(ws + OFF_WG) + (size_t)L * 1024 * LDH, LDH, P.ple_norm_g + L * 1024, 0};
            jobs[4] = {P.w_ple + (size_t)L * 256 * 1024, 1024, 256, 1024, (bf16*)(ws + OFF_WP) + (size_t)L * 1024 * LDP, LDP, nullptr, 0};
            jobs[5] = {P.w_uq + (size_t)L * 256 * 384, 384, 256, 384, (bf16*)(ws + OFF_WUQ) + (size_t)L * 384 * LDP, LDP, P.mla_q_norm_g + L * 256, 0};
            jobs[6] = {P.w_ukv + (size_t)L * 128 * 768, 768, 128, 768, (bf16*)(ws + OFF_WUKV) + (size_t)L * 768 * LDC, LDC, P.mla_kv_norm_g + L * 128, 2};
#pragma unroll
            for (int q = 0; q < 7; ++q) {
                int nt = (jobs[q].Np >> 5) * (jobs[q].K >> 5);
                for (int it = bid; it < nt; it += G) wconv_tile(jobs[q], it);
            }
        }
    }
    {
        const float* src = P.sub_keys;
        bf16* dst = (bf16*)(ws + OFF_SKB);
        for (int i = bid * NTHR + tid; i < 262144 / 2; i += G * NTHR) {
            float2 v = ((const float2*)src)[i];
            ((unsigned*)dst)[i] = pack2(v.x, v.y);
        }
    }
    {
        const float4* src = (const float4*)P.p;
        bf16* dst = (bf16*)(ws + OFF_PB);
        for (int i = bid * NTHR + tid; i < 2 * TOK * 256 / 8; i += G * NTHR) {
            float4 a = src[2 * i], b = src[2 * i + 1];
            u32x4 o = {pack2(a.x, a.y), pack2(a.z, a.w), pack2(b.x, b.y), pack2(b.z, b.w)};
            *(u32x4*)(dst + (size_t)(i >> 5) * LDP + (i & 31) * 8) = o;
        }
    }
    {
        bf16* hb = (bf16*)(ws + OFF_HB0);
        float* ss0 = (float*)(ws + OFF_SSA);
        int w = tid >> 6, l = tid & 63;
        for (int row = bid * NW + w; row < TOK; row += G * NW) {
            const float4* xr = (const float4*)(P.x + (size_t)row * DM);
            float ss = 0.f;
#pragma unroll
            for (int i = 0; i < 2; ++i) {
                float4 a = xr[i * 128 + l * 2], b = xr[i * 128 + l * 2 + 1];
                ss += a.x * a.x + a.y * a.y + a.z * a.z + a.w * a.w + b.x * b.x + b.y * b.y + b.z * b.z + b.w * b.w;
                uint4 o;
                o.x = pack2(a.x, a.y); o.y = pack2(a.z, a.w); o.z = pack2(b.x, b.y); o.w = pack2(b.z, b.w);
                ((uint4*)(hb + (size_t)row * LDH))[i * 64 + l] = o;
            }
            ss = wave_sum(ss);
            if (l == 0) {
                *(float4*)(ss0 + (size_t)row * 8) = make_float4(ss, 0.f, 0.f, 0.f);
                *(float4*)(ss0 + (size_t)row * 8 + 4) = make_float4(0.f, 0.f, 0.f, 0.f);
            }
        }
    }
    {
        float* cs = (float*)(ws + OFF_CS);
        for (int i = bid * NTHR + tid; i < TOK * 16; i += G * NTHR) {
            int t = i >> 4, k = i & 15;
            float inv = powf(10000.0f, -(float)k / 16.0f);
            float ang = (float)P.pos[t] * inv;
            cs[2 * i] = cosf(ang);
            cs[2 * i + 1] = sinf(ang);
        }
    }
}

struct NoHook { static constexpr bool nodma = false; __device__ __forceinline__ void operator()(int, f32x16 (&)[2][2]) const {} };
struct NoDmaHook { static constexpr bool nodma = true; __device__ __forceinline__ void operator()(int, f32x16 (&)[2][2]) const {} };
template <typename HOOK>
__device__ __forceinline__ void gemm_core(f32x16 (&acc)[2][2], const bf16* A, int lda, const bf16* Bt, int ldb, int K,
                                          int m0, int n0, HOOK hook) {
    const int tid = opaque_tid(), w = tid >> 6, l = tid & 63, r = l & 31, hh = l >> 5;
    const int wm = w >> 1, wn = w & 1;
    const int dp = (tid & 15) ^ ((tid >> 4) & 15);
    const int drow = 2 * (tid >> 4) + (dp >> 3), dgc = (dp & 7) * 8;
    const bf16* asrc = A + (size_t)(m0 + drow) * lda + dgc;
    const bf16* bsrc = Bt + (size_t)(n0 + drow) * ldb + dgc;
    auto dma = [&](int buf, int k0) {
        if (HOOK::nodma) return;
        char* base = smem + buf * STAGE_BYTES + tid * 16;
#pragma unroll
        for (int i = 0; i < 4; ++i)
            __builtin_amdgcn_global_load_lds((const unsigned*)(asrc + (size_t)(64 * i) * lda + k0), (unsigned*)(base + i * 8192), 16, 0, 0);
#pragma unroll
        for (int i = 0; i < 2; ++i)
            __builtin_amdgcn_global_load_lds((const unsigned*)(bsrc + (size_t)(64 * i) * ldb + k0), (unsigned*)(base + 32768 + i * 8192), 16, 0, 0);
    };
    int offA[2], offB[2];
#pragma unroll
    for (int i = 0; i < 2; ++i) { offA[i] = ((wm * 64 + i * 32 + r) >> 1) * 256; offB[i] = 32768 + ((wn * 64 + i * 32 + r) >> 1) * 256; }
    const int pbase = ((r & 1) << 3), lx = (r >> 1) & 15;
    const int nk = K >> 6;
    const unsigned ldsbase = (unsigned)(size_t)(__attribute__((address_space(3))) char*)smem;
    auto ldfrag = [&](int stage, int s, bf16x8 (&af)[2], bf16x8 (&bfr)[2]) {
        unsigned ch = (unsigned)((((pbase | (2 * s + hh)) ^ lx) << 4)) + ldsbase + (unsigned)(stage * STAGE_BYTES);
        unsigned a0a = ch + offA[0], a1a = ch + offA[1], b0a = ch + offB[0], b1a = ch + offB[1];
        asm volatile("ds_read_b128 %0, %4\n\tds_read_b128 %1, %5\n\tds_read_b128 %2, %6\n\tds_read_b128 %3, %7"
                     : "=&v"(af[0]), "=&v"(af[1]), "=&v"(bfr[0]), "=&v"(bfr[1]) : "v"(a0a), "v"(a1a), "v"(b0a), "v"(b1a) : "memory");
    };
    auto mma = [&](bf16x8 (&af)[2], bf16x8 (&bfr)[2]) {
#pragma unroll
        for (int i = 0; i < 2; ++i)
#pragma unroll
            for (int j = 0; j < 2; ++j) acc[i][j] = __builtin_amdgcn_mfma_f32_32x32x16_bf16(af[i], bfr[j], acc[i][j], 0, 0, 0);
    };
#define LGKM_WAIT(n) do { asm volatile("s_waitcnt lgkmcnt(" #n ")" ::: "memory"); __builtin_amdgcn_sched_barrier(0); } while (0)
    asm volatile("s_waitcnt vmcnt(0)" ::: "memory");
    dma(0, 0);
    dma(1, 64);
    if (nk > 2) { dma(2, 128); asm volatile("s_waitcnt vmcnt(12)" ::: "memory"); }
    else asm volatile("s_waitcnt vmcnt(6)" ::: "memory");
    __builtin_amdgcn_s_barrier();
    bf16x8 a0[2], b0[2], a1[2], b1[2];
    ldfrag(0, 0, a0, b0);
    int cur = 0;
    for (int kt = 0; kt < nk; ++kt) {
        const int nxt = (cur == 2) ? 0 : cur + 1;
        if (kt == 4 || kt == 8) { LGKM_WAIT(0); hook(kt, acc); }
        ldfrag(cur, 1, a1, b1);
        LGKM_WAIT(4);
        mma(a0, b0);
        ldfrag(cur, 2, a0, b0);
        LGKM_WAIT(4);
        mma(a1, b1);
        ldfrag(cur, 3, a1, b1);
        LGKM_WAIT(4);
        mma(a0, b0);
        if (kt + 1 < nk) {
            if (kt + 2 < nk) asm volatile("s_waitcnt vmcnt(6) lgkmcnt(0)" ::: "memory");
            else asm volatile("s_waitcnt vmcnt(0) lgkmcnt(0)" ::: "memory");
            __builtin_amdgcn_s_barrier();
            __builtin_amdgcn_sched_barrier(0);
            if (kt + 3 < nk) dma(cur, (kt + 3) << 6);
            ldfrag(nxt, 0, a0, b0);
        } else {
            LGKM_WAIT(0);
        }
        mma(a1, b1);
        cur = nxt;
    }
    __syncthreads();
}
__device__ __forceinline__ float row_rs8(const float* part, int row) {
    float4 a = *(const float4*)(part + (size_t)row * 8), b = *(const float4*)(part + (size_t)row * 8 + 4);
    float ss = ((a.x + a.y) + (a.z + a.w)) + ((b.x + b.y) + (b.z + b.w));
    return rsqrtf(ss * (1.f / 1024.f) + EPSF);
}
__device__ __forceinline__ bool xcd_tile(int it, int MT, int NT, int& mt, int& nt) {
    const int G = gridDim.x, bid = blockIdx.x;
    if ((G & 7) == 0 && (MT & 7) == 0) {
        const int nbx = G >> 3, q = (bid >> 3) + it * nbx, per = (MT >> 3) * NT;
        if (q >= per) return false;
        mt = (bid & 7) * (MT >> 3) + q / NT; nt = q % NT;
        return true;
    }
    const int q = bid + it * G;
    if (q >= MT * NT) return false;
    mt = q / NT; nt = q % NT;
    return true;
}
struct NoScale { __device__ __forceinline__ float operator()(int, int) const { return 1.f; } };

#define ZERO_ACC(acc)                                  \
    _Pragma("unroll") for (int _i = 0; _i < 2; ++_i)   \
    _Pragma("unroll") for (int _j = 0; _j < 2; ++_j)   \
    _Pragma("unroll") for (int _r = 0; _r < 16; ++_r) acc[_i][_j][_r] = 0.f;


#define TB_LD 136
#define TF_LD 132
template <bool SCALE>
__device__ __forceinline__ void stage_bf16(const f32x16 (&acc)[2][2], const float* rsl) {
    bf16* T = (bf16*)smem;
    const int tid = opaque_tid(), w = tid >> 6, l = tid & 63, hh = l >> 5, wm = w >> 1, wn = w & 1;
#pragma unroll
    for (int i = 0; i < 2; ++i)
#pragma unroll
        for (int rr = 0; rr < 16; ++rr) {
            int row = wm * 64 + i * 32 + (rr & 3) + 8 * (rr >> 2) + 4 * hh;
            float sc = SCALE ? rsl[row] : 1.f;
#pragma unroll
            for (int j = 0; j < 2; ++j) T[row * TB_LD + wn * 64 + j * 32 + (l & 31)] = (bf16)(acc[i][j][rr] * sc);
        }
    __syncthreads();
}
template <bool SCALE>
__device__ __forceinline__ void stage_f32(const f32x16 (&acc)[2][2], const float* rsl) {
    float* T = (float*)smem;
    const int tid = opaque_tid(), w = tid >> 6, l = tid & 63, hh = l >> 5, wm = w >> 1, wn = w & 1;
#pragma unroll
    for (int i = 0; i < 2; ++i)
#pragma unroll
        for (int rr = 0; rr < 16; ++rr) {
            int row = wm * 64 + i * 32 + (rr & 3) + 8 * (rr >> 2) + 4 * hh;
            float sc = SCALE ? rsl[row] : 1.f;
#pragma unroll
            for (int j = 0; j < 2; ++j) T[row * TF_LD + wn * 64 + j * 32 + (l & 31)] = acc[i][j][rr] * sc;
        }
    __syncthreads();
}
template <typename CMAP>
__device__ __forceinline__ void store_rows_bf16(bf16* dst, int ld, int m0, CMAP cmap) {
    const bf16* T = (const bf16*)smem;
    const int tid = opaque_tid();
#pragma unroll
    for (int q = 0; q < 8; ++q) {
        int id = tid + 512 * q, row = id >> 4, ch = id & 15;
        u32x4 v = *(const u32x4*)(T + row * TB_LD + ch * 8);
        *(u32x4*)(dst + (size_t)(m0 + row) * ld + cmap(ch * 8)) = v;
    }
}
__device__ __forceinline__ void store_cols_bf16(bf16* vt, size_t crow0, int s0) {
    const unsigned short* T = (const unsigned short*)smem;
    const int tid = opaque_tid();
#pragma unroll
    for (int q = 0; q < 8; ++q) {
        int id = tid + 512 * q, c = id & 127, sg = id >> 7;
        unsigned e[8];
#pragma unroll
        for (int k = 0; k < 8; ++k) e[k] = T[(8 * sg + k) * TB_LD + c];
        u32x4 v = {e[0] | (e[1] << 16), e[2] | (e[3] << 16), e[4] | (e[5] << 16), e[6] | (e[7] << 16)};
        *(u32x4*)(vt + (crow0 + c) * SEQ + s0 + 8 * sg) = v;
    }
}
__device__ __forceinline__ void residual_store(const float* hin, float* hout, bf16* hb_out, float* gss, int m0, int n0, int nt) {
    const float* T = (const float*)smem;
    const int tid = opaque_tid(), l = tid & 63;
#pragma unroll 4
    for (int q = 0; q < 16; ++q) {
        int id = tid + 512 * q, row = id >> 5, ch = id & 31;
        f32x4 d = *(const f32x4*)(T + row * TF_LD + ch * 4);
        size_t gi = (size_t)(m0 + row) * 1024 + n0 + ch * 4;
        f32x4 h = *(const f32x4*)(hin + gi);
        f32x4 v = h + d;
        *(f32x4*)(hout + gi) = v;
        u32x2 b = {pack2(v.x, v.y), pack2(v.z, v.w)};
        *(u32x2*)(hb_out + (size_t)(m0 + row) * LDH + n0 + ch * 4) = b;
        float ss = v.x * v.x + v.y * v.y + v.z * v.z + v.w * v.w;
        ss = dpp_add<0xB1>(ss); ss = dpp_add<0x4E>(ss); ss = dpp_add<0x141>(ss); ss = dpp_add<0x140>(ss);
        ss += __shfl_xor(ss, 16);
        if ((l & 31) == 0) gss[(size_t)(m0 + row) * 8 + nt] = ss;
    }
}
struct ColAdd { int off; __device__ __forceinline__ int operator()(int c) const { return c + off; } };
struct ColHead96 { __device__ __forceinline__ int operator()(int c) const { return (c >> 6) * 96 + (c & 63); } };

__device__ __forceinline__ void phase_proj(const Params& P, int L, int hsel, const float* ssrow) {
    char* ws = opq(P.ws);
    const bf16* hb = (const bf16*)(ws + (hsel ? OFF_HB1 : OFF_HB0));
    const bf16* Bt = (const bf16*)(ws + OFF_WIN) + (size_t)L * 2048 * LDH;
    bf16* fq = (bf16*)(ws + OFF_FQ); bf16* fk = (bf16*)(ws + OFF_FK); bf16* fvt = (bf16*)(ws + OFF_FVT);
    bf16* sq = (bf16*)(ws + OFF_SQ); bf16* sk = (bf16*)(ws + OFF_SKK); bf16* svt = (bf16*)(ws + OFF_SVT);
    bf16* cq = (bf16*)(ws + OFF_CQ); bf16* ckv = (bf16*)(ws + OFF_CKV);
    float* flog = (float*)(ws + OFF_FLOG);
    bf16* mk = (bf16*)(ws + OFF_MK);
    const float* cs = (const float*)(ws + OFF_CS);
    const int tid = opaque_tid(), w = tid >> 6, l = tid & 63, hh = l >> 5, wm = w >> 1, wn = w & 1;
    for (int it = 0;; ++it) {
        int mt, nt;
        if (!xcd_tile(it, 64, 16, mt, nt)) break;
        int m0 = mt * 256, n0 = nt * 128;
        float* aux = (float*)(smem + LDS_AUX);
        if (tid < 256) aux[tid] = row_rs8(ssrow, m0 + tid);
        f32x16 acc[2][2];
        ZERO_ACC(acc);
        gemm_core(acc, hb, LDH, Bt, LDH, 1024, m0, n0, NoHook());
        if (nt < 15) {
            stage_bf16<true>(acc, aux);
            if (nt == 4 || nt == 5 || nt == 10 || nt == 11) {
                bf16* vt = (nt < 6) ? fvt : svt;
                int cbase = n0 - ((nt < 6) ? 512 : 1280);
                store_cols_bf16(vt, (size_t)(m0 >> 11) * 256 + cbase, m0 & 2047);
            } else if (nt < 2) store_rows_bf16(fq, 256, m0, ColAdd{n0});
            else if (nt < 4) store_rows_bf16(fk, 256, m0, ColAdd{n0 - 256});
            else if (nt < 8) store_rows_bf16(sq, 256, m0, ColAdd{n0 - 768});
            else if (nt < 10) store_rows_bf16(sk, 256, m0, ColAdd{n0 - 1024});
            else if (nt < 14) store_rows_bf16(cq, LDP, m0, ColAdd{n0 - 1536});
            else store_rows_bf16(ckv, LDC, m0, ColAdd{0});
        } else {
            if (wn == 0) {
#pragma unroll
                for (int i = 0; i < 2; ++i) {
                    int rloc = wm * 64 + i * 32 + 4 * hh;
                    int ci = l & 31, pi = ci & 15;
#pragma unroll
                    for (int rr = 0; rr < 16; ++rr) {
                        int rl = rloc + (rr & 3) + 8 * (rr >> 2), row = m0 + rl;
                        float rs = aux[rl];
                        float v = acc[i][0][rr] * rs;
                        float pv = __shfl_xor(v, 16);
                        float2 c_s = *(const float2*)(cs + ((size_t)row * 16 + pi) * 2);
                        float o = (ci < 16) ? (v * c_s.x - pv * c_s.y) : (pv * c_s.y + v * c_s.x);
                        bf16 ob = (bf16)o;
#pragma unroll
                        for (int h = 0; h < 4; ++h) mk[(size_t)row * 384 + h * 96 + 64 + ci] = ob;
                        if (ci < 4) flog[(size_t)row * 4 + ci] = acc[i][1][rr] * rs;
                    }
                }
            }
        }
        __syncthreads();
    }
}

template <int KW>
__device__ __forceinline__ void row_rms_to_lds(const bf16* A, int lda, int m0) {
    const int tid = opaque_tid(), row = tid >> 1, half = tid & 1;
    float ss = 0.f;
    const u32x4* p = (const u32x4*)(A + (size_t)(m0 + row) * lda + half * (KW / 2));
#pragma unroll
    for (int q = 0; q < KW / 16; ++q) {
        u32x4 v = p[q];
        float a;
        a = bflo(v.x); ss += a * a; a = bfhi(v.x); ss += a * a;
        a = bflo(v.y); ss += a * a; a = bfhi(v.y); ss += a * a;
        a = bflo(v.z); ss += a * a; a = bfhi(v.z); ss += a * a;
        a = bflo(v.w); ss += a * a; a = bfhi(v.w); ss += a * a;
    }
    ss += __shfl_xor(ss, 1);
    if (half == 0) ((float*)(smem + LDS_AUX))[row] = rsqrtf(ss * (1.f / (float)KW) + EPSF);
}

__device__ __forceinline__ void phase_mla_up(const Params& P, int L) {
    char* ws = opq(P.ws);
    const bf16* cq = (const bf16*)(ws + OFF_CQ); const bf16* ckv = (const bf16*)(ws + OFF_CKV);
    const bf16* wuq = (const bf16*)(ws + OFF_WUQ) + (size_t)L * 384 * LDP;
    const bf16* wukv = (const bf16*)(ws + OFF_WUKV) + (size_t)L * 768 * LDC;
    bf16* mq = (bf16*)(ws + OFF_MQ); bf16* mk = (bf16*)(ws + OFF_MK); bf16* mvt = (bf16*)(ws + OFF_MVT);
    const float* cs = (const float*)(ws + OFF_CS);
    const float* flog = (const float*)(ws + OFF_FLOG);
    float* cumF = (float*)(ws + OFF_CUMF);
    const int tid = opaque_tid(), w = tid >> 6, l = tid & 63, hh = l >> 5, wm = w >> 1, wn = w & 1;
    const int NQ = 64 * 3, NKV = 64 * 6, NCF = 4;
    const float* aux = (const float*)(smem + LDS_AUX);
    for (int item = blockIdx.x; item < NQ + NKV + NCF; item += gridDim.x) {
        if (item < NQ) {
            int mt = item / 3, nt = item % 3;
            int m0 = mt * 256, n0 = nt * 128;
            __syncthreads();
            row_rms_to_lds<256>(cq, LDP, m0);
            f32x16 acc[2][2];
            ZERO_ACC(acc);
            gemm_core(acc, cq, LDP, wuq, LDP, 256, m0, n0, NoHook());
#pragma unroll
            for (int i = 0; i < 2; ++i)
#pragma unroll
                for (int j = 0; j < 2; ++j) {
                    int c0 = n0 + wn * 64 + j * 32;
                    int rloc = wm * 64 + i * 32 + 4 * hh;
                    bool rot = (c0 % 96) == 64;
                    int ci = l & 31, pi = ci & 15;
#pragma unroll
                    for (int rr = 0; rr < 16; ++rr) {
                        int rl = rloc + (rr & 3) + 8 * (rr >> 2);
                        float v = acc[i][j][rr] * aux[rl];
                        if (rot) {
                            float pv = __shfl_xor(v, 16);
                            float2 c_s = *(const float2*)(cs + ((size_t)(m0 + rl) * 16 + pi) * 2);
                            v = (ci < 16) ? (v * c_s.x - pv * c_s.y) : (pv * c_s.y + v * c_s.x);
                        }
                        acc[i][j][rr] = v;
                    }
                }
            stage_bf16<false>(acc, nullptr);
            store_rows_bf16(mq, 384, m0, ColAdd{n0});
        } else if (item < NQ + NKV) {
            int it2 = item - NQ;
            int mt = it2 / 6, nt = it2 % 6;
            int m0 = mt * 256, n0 = nt * 128;
            __syncthreads();
            row_rms_to_lds<128>(ckv, LDC, m0);
            f32x16 acc[2][2];
            ZERO_ACC(acc);
            gemm_core(acc, ckv, LDC, wukv, LDC, 128, m0, n0, NoHook());
            stage_bf16<true>(acc, aux);
            if (nt < 2) {
                const int nb0 = n0;
                struct CM { int n0; __device__ __forceinline__ int operator()(int c) const { int col = n0 + c; return (col >> 6) * 96 + (col & 63); } };
                store_rows_bf16(mk, 384, m0, CM{nb0});
            } else {
                store_cols_bf16(mvt, (size_t)(m0 >> 11) * 512 + (n0 - 256), m0 & 2047);
            }
        } else {
            int seq = (item - NQ - NKV) * NW + w;
            int b = seq >> 2, h = seq & 3;
            float bfv = P.b_forget[L * 4 + h];
            float vals[32];
            float run = 0.f;
#pragma unroll
            for (int i = 0; i < 32; ++i) {
                int s = l * 32 + i;
                float z = flog[((size_t)b * SEQ + s) * 4 + h] + bfv;
                run += log_sigmoid_f(z);
                vals[i] = run;
            }
            float tot = run, incl = tot;
#pragma unroll
            for (int o = 1; o < 64; o <<= 1) {
                float t = __shfl_up(incl, o);
                if (l >= o) incl += t;
            }
            float excl = incl - tot;
#pragma unroll
            for (int i = 0; i < 32; ++i) cumF[(size_t)seq * SEQ + l * 32 + i] = vals[i] + excl;
        }
    }
}

template <int MODE, int DK, int DV>
__device__ __forceinline__ void attn_item(const bf16* __restrict__ Q, int ldq, const bf16* __restrict__ Kg, int ldk,
                          const bf16* __restrict__ Vt, const float* __restrict__ cumF, bf16* __restrict__ Y,
                          float* __restrict__ ssy, int b, int h, int qb, float c1, char* lds) {
    constexpr int KSTR = DK * 2 + 16;
    constexpr int VSTR = 144;
    constexpr int KBYTES = 64 * KSTR, VBYTES = DV * VSTR;
    constexpr int BUF = (KBYTES + VBYTES + 256 + 255) & ~255;
    static_assert(2 * BUF <= 65536, "lds");
    constexpr int KCH = DK / 8, KPT = (64 * KCH) / 256, VPT = (DV * 8) / 256;
    const int tid = opaque_tid() & 255, w = tid >> 6, l = tid & 63, r = l & 31, hh = l >> 5;
    const int q0 = qb * 128;
    const int qrow = q0 + 32 * w + r;
    const size_t tok = (size_t)b * SEQ + qrow;
    const int bh = b * 4 + h;
    bf16x8 qf[DK / 16];
#pragma unroll
    for (int s = 0; s < DK / 16; ++s) qf[s] = *(const bf16x8*)(Q + tok * ldq + h * DK + 16 * s + 8 * hh);
    f32x16 o[DV / 32];
    const f32x16 zero16 = {0.f, 0.f, 0.f, 0.f, 0.f, 0.f, 0.f, 0.f, 0.f, 0.f, 0.f, 0.f, 0.f, 0.f, 0.f, 0.f};
#pragma unroll
    for (int d = 0; d < DV / 32; ++d) o[d] = zero16;
    float m = -1e30f, lsum = 0.f, R = 0.f;
    float Fq = 0.f;
    if (MODE == 0) Fq = cumF[(size_t)bh * SEQ + qrow] * LOG2E;
    const int nkt = (q0 + 128) >> 6;
    u32x4 kreg[KPT], vreg[VPT];
    float4 freg = {0.f, 0.f, 0.f, 0.f};
    auto gload = [&](int kt) {
#pragma unroll
        for (int i = 0; i < KPT; ++i) {
            int e = tid + 256 * i;
            int row = e / KCH, ch = e % KCH;
            kreg[i] = *(const u32x4*)(Kg + ((size_t)b * SEQ + kt * 64 + row) * ldk + h * DK + ch * 8);
        }
#pragma unroll
        for (int i = 0; i < VPT; ++i) {
            int e = tid + 256 * i;
            int row = e >> 3, ch = e & 7;
            vreg[i] = *(const u32x4*)(Vt + ((size_t)bh * DV + row) * SEQ + kt * 64 + ch * 8);
        }
        if (MODE == 0 && tid < 16) freg = *(const float4*)(cumF + (size_t)bh * SEQ + kt * 64 + tid * 4);
    };
    auto lwrite = [&](int buf) {
        char* base = lds + buf * BUF;
#pragma unroll
        for (int i = 0; i < KPT; ++i) {
            int e = tid + 256 * i;
            int row = e / KCH, ch = e % KCH;
            *(u32x4*)(base + row * KSTR + ch * 16) = kreg[i];
        }
#pragma unroll
        for (int i = 0; i < VPT; ++i) {
            int e = tid + 256 * i;
            int row = e >> 3, ch = e & 7;
            *(u32x4*)(base + KBYTES + row * VSTR + ch * 16) = vreg[i];
        }
        if (MODE == 0 && tid < 16) *(float4*)(base + KBYTES + VBYTES + tid * 16) = freg;
    };
    const int prow = (r & 0x13) | ((r & 4) << 1) | ((r & 8) >> 1);
    gload(MODE == 1 ? nkt - 1 : 0);
    lwrite(0);
    __syncthreads();
    for (int it = 0; it < nkt; ++it) {
        const int kt = (MODE == 1) ? (nkt - 1 - it) : it;
        if (it + 1 < nkt) gload((MODE == 1) ? (kt - 1) : (kt + 1));
        const char* base = lds + (it & 1) * BUF;
        const bool active = (kt * 64) <= (q0 + 32 * w + 31);
        if (active) {
            const bool needmask = (kt * 64 + 63) >= (q0 + 32 * w);
            f32x16 s[2];
#pragma unroll
            for (int sub = 0; sub < 2; ++sub) {
                s[sub] = zero16;
#pragma unroll
                for (int ks = 0; ks < DK / 16; ++ks) {
                    bf16x8 kf = *(const bf16x8*)(base + (sub * 32 + prow) * KSTR + (2 * ks + hh) * 16);
                    s[sub] = __builtin_amdgcn_mfma_f32_32x32x16_bf16(kf, qf[ks], s[sub], 0, 0, 0);
                }
            }
            bf16x8 pf[2][2];
            if (MODE != 1) {
                const float* Ft = (const float*)(base + KBYTES + VBYTES);
                float mx = -INFINITY;
                float tv[2][16];
#pragma unroll
                for (int sub = 0; sub < 2; ++sub)
#pragma unroll
                    for (int a = 0; a < 2; ++a) {
                        int kofs = sub * 32 + 16 * a + 8 * hh;
                        float fk[8];
                        if (MODE == 0) {
                            float4 f0 = *(const float4*)(Ft + kofs), f1 = *(const float4*)(Ft + kofs + 4);
                            fk[0] = f0.x; fk[1] = f0.y; fk[2] = f0.z; fk[3] = f0.w; fk[4] = f1.x; fk[5] = f1.y; fk[6] = f1.z; fk[7] = f1.w;
                        }
#pragma unroll
                        for (int j = 0; j < 8; ++j) {
                            int rr = 8 * a + j;
                            float v = s[sub][rr] * c1;
                            if (MODE == 0) v += Fq - fk[j] * LOG2E;
                            if (needmask && (kt * 64 + kofs + j > qrow)) v = -INFINITY;
                            tv[sub][rr] = v;
                            mx = fmaxf(mx, v);
                        }
                    }
                mx = fmaxf(mx, __shfl_xor(mx, 32));
                float mnew = fmaxf(m, mx);
                float alpha = fexp2(m - mnew);
                float rsum = 0.f;
#pragma unroll
                for (int sub = 0; sub < 2; ++sub)
#pragma unroll
                    for (int a = 0; a < 2; ++a) {
                        float pv[8];
#pragma unroll
                        for (int j = 0; j < 8; ++j) { pv[j] = fexp2(tv[sub][8 * a + j] - mnew); rsum += pv[j]; }
                        uint4 u;
                        u.x = pack2(pv[0], pv[1]); u.y = pack2(pv[2], pv[3]); u.z = pack2(pv[4], pv[5]); u.w = pack2(pv[6], pv[7]);
                        pf[sub][a] = __builtin_bit_cast(bf16x8, u);
                    }
                rsum += __shfl_xor(rsum, 32);
                lsum = lsum * alpha + rsum;
                m = mnew;
#pragma unroll
                for (int d = 0; d < DV / 32; ++d) o[d] = o[d] * alpha;
            } else {
#pragma unroll
                for (int sb = 0; sb < 2; ++sb) {
                    const int sub = 1 - sb;
                    float lsig[16], lneg[16];
                    float A0 = 0.f, A1 = 0.f;
#pragma unroll
                    for (int rr = 0; rr < 16; ++rr) {
                        int key = kt * 64 + sub * 32 + 16 * (rr >> 3) + 8 * hh + (rr & 7);
                        bool valid = key < qrow;
                        float z = s[sub][rr] * c1;
                        float e = fexp2(-fabsf(z));
                        float l1p = flog2(1.f + e);
                        float ls = fminf(z, 0.f) - l1p;
                        float ln = valid ? (ls - z) : 0.f;
                        lsig[rr] = valid ? ls : -INFINITY;
                        lneg[rr] = ln;
                        if (rr < 8) A0 += ln; else A1 += ln;
                    }
                    float B0 = __shfl_xor(A0, 32), B1 = __shfl_xor(A1, 32);
                    float base1 = (hh == 0) ? (R + B1) : R;
                    float base0 = (hh == 0) ? (R + B1 + A1 + B0) : (R + A1 + B1);
                    float wv[16];
                    float run = base1;
#pragma unroll
                    for (int j = 7; j >= 0; --j) { wv[8 + j] = fexp2(lsig[8 + j] + run); run += lneg[8 + j]; }
                    run = base0;
#pragma unroll
                    for (int j = 7; j >= 0; --j) { wv[j] = fexp2(lsig[j] + run); run += lneg[j]; }
                    R += A0 + A1 + B0 + B1;
#pragma unroll
                    for (int a = 0; a < 2; ++a) {
                        uint4 u;
                        u.x = pack2(wv[8 * a], wv[8 * a + 1]); u.y = pack2(wv[8 * a + 2], wv[8 * a + 3]);
                        u.z = pack2(wv[8 * a + 4], wv[8 * a + 5]); u.w = pack2(wv[8 * a + 6], wv[8 * a + 7]);
                        pf[sub][a] = __builtin_bit_cast(bf16x8, u);
                    }
                }
            }
#pragma unroll
            for (int d = 0; d < DV / 32; ++d)
#pragma unroll
                for (int sub = 0; sub < 2; ++sub)
#pragma unroll
                    for (int a = 0; a < 2; ++a) {
                        bf16x8 vf = *(const bf16x8*)(base + KBYTES + (d * 32 + r) * VSTR + (sub * 32 + 16 * a + 8 * hh) * 2);
                        o[d] = __builtin_amdgcn_mfma_f32_32x32x16_bf16(vf, pf[sub][a], o[d], 0, 0, 0);
                    }
        }
        if (it + 1 < nkt) lwrite((it + 1) & 1);
        __syncthreads();
    }
    float inv = (MODE == 1) ? 1.f : (1.f / lsum);
    float ssq = 0.f;
#pragma unroll
    for (int d = 0; d < DV / 32; ++d)
#pragma unroll
        for (int g = 0; g < 4; ++g) {
            float v0 = o[d][4 * g] * inv, v1 = o[d][4 * g + 1] * inv, v2 = o[d][4 * g + 2] * inv, v3 = o[d][4 * g + 3] * inv;
            ssq += v0 * v0 + v1 * v1 + v2 * v2 + v3 * v3;
            uint2 u; u.x = pack2(v0, v1); u.y = pack2(v2, v3);
            *(uint2*)(Y + tok * LDH + h * DV + d * 32 + 8 * g + 4 * hh) = u;
        }
    ssq += __shfl_xor(ssq, 32);
    if (hh == 0) ssy[tok * 16 + h] = ssq;
}

__device__ __forceinline__ void phase_attn(const Params& P, int L, int rep = 0) {
    char* ws = opq(P.ws);
    int* cnt = (int*)(ws + OFF_CNT) + L * 64 + rep * 16;
    int* s_item = (int*)(smem + LDS_BYTES - 16);
    const float* cumF = (const float*)(ws + OFF_CUMF);
    bf16* Y = (bf16*)(ws + OFF_Y);
    float* ssy = (float*)(ws + OFF_SSY) + (size_t)L * TOK * 16;
    const int half = opaque_tid() >> 8;
    char* lds = smem + half * 65536;
    for (;;) {
        if (opaque_tid() == 0) *s_item = atomicAdd(cnt, 1);
        __syncthreads();
        int pair = *s_item;
        __syncthreads();
        if (pair >= 768) break;
        int item = pair * 2 + half;
        int qb = 15 - item / 96;
        int rem = item % 96;
        int type = rem >> 5, bh = rem & 31;
        int b = bh >> 2, h = bh & 3;
        if (type == 0) {
            attn_item<2, 96, 128>((const bf16*)(ws + OFF_MQ), 384, (const bf16*)(ws + OFF_MK), 384, (const bf16*)(ws + OFF_MVT), cumF,
                                  Y + 512, ssy + 8, b, h, qb, 0.10206207261596577f * LOG2E, lds);
        } else if (type == 1) {
            attn_item<1, 64, 64>((const bf16*)(ws + OFF_SQ), 256, (const bf16*)(ws + OFF_SKK), 256, (const bf16*)(ws + OFF_SVT), cumF,
                                 Y + 256, ssy + 4, b, h, qb, 0.125f * LOG2E, lds);
        } else {
            attn_item<0, 64, 64>((const bf16*)(ws + OFF_FQ), 256, (const bf16*)(ws + OFF_FK), 256, (const bf16*)(ws + OFF_FVT), cumF,
                                 Y + 0, ssy + 0, b, h, qb, 0.125f * LOG2E, lds);
        }
    }
}

__device__ __forceinline__ void rowss_flush(float (&part)[2][16], float* gss, int m0, int nt) {
    float* lss = (float*)smem;
    const int tid = opaque_tid(), w = tid >> 6, l = tid & 63, hh = l >> 5, wm = w >> 1, wn = w & 1;
#pragma unroll
    for (int i = 0; i < 2; ++i)
#pragma unroll
        for (int rr = 0; rr < 16; ++rr) {
            float v = part[i][rr];
            v = dpp_add<0xB1>(v); v = dpp_add<0x4E>(v); v = dpp_add<0x141>(v); v = dpp_add<0x140>(v);
            v += __shfl_xor(v, 16);
            if ((l & 31) == 0) lss[wn * 256 + wm * 64 + i * 32 + (rr & 3) + 8 * (rr >> 2) + 4 * hh] = v;
        }
    __syncthreads();
    if (tid < 256) gss[(size_t)(m0 + tid) * 8 + nt] = lss[tid] + lss[256 + tid];
    __syncthreads();
}

struct WoHook {
    static constexpr bool nodma = false;
    __device__ __forceinline__ void operator()(int kt, f32x16 (&acc)[2][2]) const {
        if (kt == 4 || kt == 8) {
            const float* fac = (const float*)(smem + LDS_AUX) + (kt == 4 ? 0 : 256);
            const int tid = opaque_tid(), w = tid >> 6, l = tid & 63, hh = l >> 5, wm = w >> 1;
#pragma unroll
            for (int i = 0; i < 2; ++i)
#pragma unroll
                for (int rr = 0; rr < 16; ++rr) {
                    float f = fac[wm * 64 + i * 32 + (rr & 3) + 8 * (rr >> 2) + 4 * hh];
                    acc[i][0][rr] *= f; acc[i][1][rr] *= f;
                }
        }
    }
};

__device__ __forceinline__ void phase_wo(const Params& P, int L, int hsel, float* ss_out) {
    char* ws = opq(P.ws);
    bf16* hb_out = (bf16*)(ws + (hsel ? OFF_HB1 : OFF_HB0));
    const float* hin = (L == 0) ? opq(P.x) : (const float*)opq(P.out);
    float* hout = opq(P.out);
    const bf16* Y = (const bf16*)(ws + OFF_Y);
    const bf16* Bt = (const bf16*)(ws + OFF_WO) + (size_t)L * 1024 * LDH;
    const float* ssy = (const float*)(ws + OFF_SSY) + (size_t)L * TOK * 16;
    float* aux = (float*)(smem + LDS_AUX);
    const int tid = opaque_tid(), w = tid >> 6, l = tid & 63, hh = l >> 5, wm = w >> 1, wn = w & 1;
    for (int it = 0;; ++it) {
        int mt, nt;
        if (!xcd_tile(it, 64, 8, mt, nt)) break;
        int m0 = mt * 256, n0 = nt * 128;
        __syncthreads();
        if (tid < 256) {
            int row = m0 + tid;
            float4 v0 = *(const float4*)(ssy + (size_t)row * 16), v1 = *(const float4*)(ssy + (size_t)row * 16 + 4), v2 = *(const float4*)(ssy + (size_t)row * 16 + 8);
            float r0 = rsqrtf(((v0.x + v0.y) + (v0.z + v0.w)) * (1.f / 256.f) + EPSF);
            float r1 = rsqrtf(((v1.x + v1.y) + (v1.z + v1.w)) * (1.f / 256.f) + EPSF);
            float r2 = rsqrtf(((v2.x + v2.y) + (v2.z + v2.w)) * (1.f / 512.f) + EPSF);
            aux[tid] = r0 / r1; aux[256 + tid] = r1 / r2; aux[512 + tid] = r2;
        }
        f32x16 acc[2][2];
        ZERO_ACC(acc);
        gemm_core(acc, Y, LDH, Bt, LDH, 1024, m0, n0, WoHook());
        stage_f32<true>(acc, aux + 512);
        residual_store(hin, hout, hb_out, ss_out, m0, n0, nt);
    }
}

__device__ __forceinline__ void phase_pq(const Params& P, int L, int hsel, const float* ssrow, int fake = 0) {
    char* ws = opq(P.ws);
    const bf16* hb = (const bf16*)(ws + (hsel ? OFF_HB1 : OFF_HB0));
    const bf16* Bt = (const bf16*)(ws + OFF_WQ) + (size_t)L * 1024 * LDH;
    bf16* pq = (bf16*)(ws + (fake ? OFF_PART : OFF_PQ));
    const int tid = opaque_tid(), w = tid >> 6, l = tid & 63, hh = l >> 5, wm = w >> 1, wn = w & 1;
    for (int it = 0;; ++it) {
        int mt, nt;
        if (!xcd_tile(it, 64, 8, mt, nt)) break;
        int m0 = mt * 256, n0 = nt * 128;
        f32x16 acc[2][2];
        ZERO_ACC(acc);
        float* aux = (float*)(smem + LDS_AUX);
        if (tid < 256) aux[tid] = row_rs8(ssrow, m0 + tid);
        if (fake & 4) gemm_core(acc, hb, LDH, Bt, LDH, 1024, 0, 0, NoDmaHook());
        else gemm_core(acc, hb, LDH, Bt, LDH, 1024, (fake & 1) ? 0 : m0, (fake & 2) ? 0 : n0, NoHook());
        if (fake & 8) {
#pragma unroll
            for (int i = 0; i < 2; ++i)
#pragma unroll
                for (int j = 0; j < 2; ++j) asm volatile("" :: "v"(acc[i][j]));
            continue;
        }
        stage_bf16<true>(acc, aux);
        store_rows_bf16(pq, 1024, m0, ColAdd{n0});
        __syncthreads();
    }
}

__device__ __forceinline__ void cswap(int& a, int& b) { int mx = max(a, b), mn = min(a, b); a = mx; b = mn; }
__device__ __forceinline__ void bitonic_sort16(int (&v)[16]) {
#pragma unroll
    for (int k = 2; k <= 16; k <<= 1)
#pragma unroll
        for (int j = k >> 1; j > 0; j >>= 1)
#pragma unroll
            for (int i = 0; i < 16; ++i) {
                int q = i ^ j;
                if (q > i) {
                    if ((i & k) == 0) cswap(v[i], v[q]); else cswap(v[q], v[i]);
                }
            }
}
__device__ __forceinline__ void merge_top16(int (&Lv)[16], const int (&Rv)[16]) {
#pragma unroll
    for (int i = 0; i < 16; ++i) Lv[i] = max(Lv[i], Rv[15 - i]);
#pragma unroll
    for (int j = 8; j > 0; j >>= 1)
#pragma unroll
        for (int i = 0; i < 16; ++i) {
            int q = i ^ j;
            if (q > i) cswap(Lv[i], Lv[q]);
        }
}
__device__ __forceinline__ int f2key(float v, int low, int mask) {
    int b = __float_as_int(v);
    b ^= (b >> 31) & 0x7fffffff;
    return (b & ~mask) | low;
}
__device__ __forceinline__ float key2f(int k, int mask) {
    int b = k & ~mask;
    b ^= (b >> 31) & 0x7fffffff;
    return __int_as_float(b);
}

__device__ __forceinline__ void phase_topk(const Params& P, int L) {
    char* ws = opq(P.ws);
    const bf16* pq = (const bf16*)(ws + OFF_PQ);
    const bf16* skb = (const bf16*)(ws + OFF_SKB) + (size_t)L * 16 * 128 * 64;
    unsigned short* ids = (unsigned short*)(ws + OFF_IDS);
    float* gates = (float*)(ws + OFF_GATE);
    const int half = opaque_tid() >> 8;
    char* lds = smem + half * 57600;
    float* sc = (float*)lds;
    int* Lq = (int*)(lds + 64 * 129 * 4);
    int* Fin = Lq + 4 * 64 * 16;
    const int tid = opaque_tid() & 255, w = tid >> 6, l = tid & 63, r = l & 31, hh = l >> 5;
    for (int item = blockIdx.x * 2 + half; item < TOK / 64; item += gridDim.x * 2) {
        const int t0 = item * 64;
        for (int h = 0; h < 8; ++h) {
            for (int p = 0; p < 2; ++p) {
                const int hp = h * 2 + p;
                f32x16 acc[2];
#pragma unroll
                for (int j = 0; j < 2; ++j)
#pragma unroll
                    for (int rr = 0; rr < 16; ++rr) acc[j][rr] = 0.f;
#pragma unroll
                for (int s = 0; s < 4; ++s) {
                    bf16x8 af = *(const bf16x8*)(skb + ((size_t)hp * 128 + 32 * w + r) * 64 + 16 * s + 8 * hh);
#pragma unroll
                    for (int j = 0; j < 2; ++j) {
                        bf16x8 bfr = *(const bf16x8*)(pq + (size_t)(t0 + 32 * j + r) * 1024 + hp * 64 + 16 * s + 8 * hh);
                        acc[j] = __builtin_amdgcn_mfma_f32_32x32x16_bf16(af, bfr, acc[j], 0, 0, 0);
                    }
                }
#pragma unroll
                for (int j = 0; j < 2; ++j)
#pragma unroll
                    for (int rr = 0; rr < 16; ++rr) {
                        int key = 32 * w + (rr & 3) + 8 * (rr >> 2) + 4 * hh;
                        sc[(32 * j + r) * 129 + key] = acc[j][rr];
                    }
                __syncthreads();
                {
                    const int token = l, quarter = w;
                    int A[16], B[16];
#pragma unroll
                    for (int i = 0; i < 16; ++i) {
                        int n = quarter * 32 + i;
                        A[i] = f2key(sc[token * 129 + n], 127 - n, 127);
                        B[i] = f2key(sc[token * 129 + n + 16], 127 - (n + 16), 127);
                    }
                    bitonic_sort16(A);
                    bitonic_sort16(B);
                    merge_top16(A, B);
#pragma unroll
                    for (int i = 0; i < 16; ++i) Lq[(quarter * 64 + token) * 16 + i] = A[i];
                    __syncthreads();
                    if ((quarter & 1) == 0) {
#pragma unroll
                        for (int i = 0; i < 16; ++i) B[i] = Lq[((quarter + 1) * 64 + token) * 16 + i];
                        merge_top16(A, B);
                        if (quarter == 2) {
#pragma unroll
                            for (int i = 0; i < 16; ++i) Lq[(2 * 64 + token) * 16 + i] = A[i];
                        }
                    }
                    __syncthreads();
                    if (quarter == 0) {
#pragma unroll
                        for (int i = 0; i < 16; ++i) B[i] = Lq[(2 * 64 + token) * 16 + i];
                        merge_top16(A, B);
#pragma unroll
                        for (int i = 0; i < 16; ++i) Fin[(p * 64 + token) * 16 + i] = A[i];
                    }
                    __syncthreads();
                }
            }
            if (w == 0) {
                const int token = l;
                float s1[16], s2[16];
#pragma unroll
                for (int i = 0; i < 16; ++i) {
                    s1[i] = key2f(Fin[(0 * 64 + token) * 16 + i], 127);
                    s2[i] = key2f(Fin[(1 * 64 + token) * 16 + i], 127);
                }
                int Lc[16], X[16];
#pragma unroll
                for (int b2 = 0; b2 < 16; ++b2) Lc[b2] = f2key(s1[0] + s2[b2], 255 - b2, 255);
#pragma unroll
                for (int a = 1; a < 16; ++a) X[a - 1] = f2key(s1[a] + s2[0], 255 - a * 16, 255);
                X[15] = INT_MIN;
                merge_top16(Lc, X);
                {
                    int c = 0;
#pragma unroll
                    for (int b2 = 1; b2 <= 7; ++b2) X[c++] = f2key(s1[1] + s2[b2], 255 - (16 + b2), 255);
#pragma unroll
                    for (int b2 = 1; b2 <= 4; ++b2) X[c++] = f2key(s1[2] + s2[b2], 255 - (32 + b2), 255);
#pragma unroll
                    for (int b2 = 1; b2 <= 3; ++b2) X[c++] = f2key(s1[3] + s2[b2], 255 - (48 + b2), 255);
#pragma unroll
                    for (int b2 = 1; b2 <= 2; ++b2) X[c++] = f2key(s1[4] + s2[b2], 255 - (64 + b2), 255);
                }
                bitonic_sort16(X);
                merge_top16(Lc, X);
                X[0] = f2key(s1[5] + s2[1], 255 - (80 + 1), 255);
                X[1] = f2key(s1[6] + s2[1], 255 - (96 + 1), 255);
                X[2] = f2key(s1[7] + s2[1], 255 - (112 + 1), 255);
#pragma unroll
                for (int i = 3; i < 16; ++i) X[i] = INT_MIN;
                merge_top16(Lc, X);
                float mx = key2f(Lc[0], 255);
                float ev[16], sum = 0.f;
#pragma unroll
                for (int k = 0; k < 16; ++k) { ev[k] = __expf(key2f(Lc[k], 255) - mx); sum += ev[k]; }
                float inv = 1.f / sum;
                size_t ob = (size_t)(t0 + token) * 128 + h * 16;
#pragma unroll
                for (int k = 0; k < 16; ++k) {
                    int cidx = 255 - (Lc[k] & 255);
                    int a = cidx >> 4, b2 = cidx & 15;
                    int i1 = 127 - (Fin[(0 * 64 + token) * 16 + a] & 127);
                    int i2 = 127 - (Fin[(1 * 64 + token) * 16 + b2] & 127);
                    ids[ob + k] = (unsigned short)(i1 * 128 + i2);
                    gates[ob + k] = ev[k] * inv;
                }
            }
            __syncthreads();
        }
    }
}

__device__ __forceinline__ float gelu_exact(float x) { return 0.5f * x * (1.f + erff(x * 0.70710678118654752f)); }

__device__ __forceinline__ void dec16(const u32x4& v, float (&f)[16]) {
    f32x2 t;
    t = __builtin_amdgcn_cvt_pk_f32_fp8((int)v.x, false); f[0] = t.x; f[1] = t.y;
    t = __builtin_amdgcn_cvt_pk_f32_fp8((int)v.x, true);  f[2] = t.x; f[3] = t.y;
    t = __builtin_amdgcn_cvt_pk_f32_fp8((int)v.y, false); f[4] = t.x; f[5] = t.y;
    t = __builtin_amdgcn_cvt_pk_f32_fp8((int)v.y, true);  f[6] = t.x; f[7] = t.y;
    t = __builtin_amdgcn_cvt_pk_f32_fp8((int)v.z, false); f[8] = t.x; f[9] = t.y;
    t = __builtin_amdgcn_cvt_pk_f32_fp8((int)v.z, true);  f[10] = t.x; f[11] = t.y;
    t = __builtin_amdgcn_cvt_pk_f32_fp8((int)v.w, false); f[12] = t.x; f[13] = t.y;
    t = __builtin_amdgcn_cvt_pk_f32_fp8((int)v.w, true);  f[14] = t.x; f[15] = t.y;
}

__device__ __forceinline__ void dec32(const u32x4& v, f32x2 (&f)[16]) {
    f[0] = __builtin_amdgcn_cvt_scalef32_pk_f32_fp4(v.x, 1.0f, 0); f[1] = __builtin_amdgcn_cvt_scalef32_pk_f32_fp4(v.x, 1.0f, 1);
    f[2] = __builtin_amdgcn_cvt_scalef32_pk_f32_fp4(v.x, 1.0f, 2); f[3] = __builtin_amdgcn_cvt_scalef32_pk_f32_fp4(v.x, 1.0f, 3);
    f[4] = __builtin_amdgcn_cvt_scalef32_pk_f32_fp4(v.y, 1.0f, 0); f[5] = __builtin_amdgcn_cvt_scalef32_pk_f32_fp4(v.y, 1.0f, 1);
    f[6] = __builtin_amdgcn_cvt_scalef32_pk_f32_fp4(v.y, 1.0f, 2); f[7] = __builtin_amdgcn_cvt_scalef32_pk_f32_fp4(v.y, 1.0f, 3);
    f[8] = __builtin_amdgcn_cvt_scalef32_pk_f32_fp4(v.z, 1.0f, 0); f[9] = __builtin_amdgcn_cvt_scalef32_pk_f32_fp4(v.z, 1.0f, 1);
    f[10] = __builtin_amdgcn_cvt_scalef32_pk_f32_fp4(v.z, 1.0f, 2); f[11] = __builtin_amdgcn_cvt_scalef32_pk_f32_fp4(v.z, 1.0f, 3);
    f[12] = __builtin_amdgcn_cvt_scalef32_pk_f32_fp4(v.w, 1.0f, 0); f[13] = __builtin_amdgcn_cvt_scalef32_pk_f32_fp4(v.w, 1.0f, 1);
    f[14] = __builtin_amdgcn_cvt_scalef32_pk_f32_fp4(v.w, 1.0f, 2); f[15] = __builtin_amdgcn_cvt_scalef32_pk_f32_fp4(v.w, 1.0f, 3);
}

__device__ __forceinline__ int idof16(const u32x4 (&q)[2], int i) {
    unsigned wv = (i >> 1) == 0 ? q[0].x : (i >> 1) == 1 ? q[0].y : (i >> 1) == 2 ? q[0].z : (i >> 1) == 3 ? q[0].w
                : (i >> 1) == 4 ? q[1].x : (i >> 1) == 5 ? q[1].y : (i >> 1) == 6 ? q[1].z : q[1].w;
    return (i & 1) ? (int)(wv >> 16) : (int)(wv & 0xffffu);
}
__device__ __forceinline__ void phase_gather_u(const Params& P, int L) {
    char* ws = opq(P.ws);
    const unsigned char* U4 = (const unsigned char*)(ws + OFF_UB) + (size_t)L * NEXP * 512;
    float* part = (float*)(ws + OFF_PART);
    const unsigned short* ids = (const unsigned short*)(ws + OFF_IDS);
    const float* hin = opq(P.out);
    const int tid = opaque_tid(), w = tid >> 6, l = tid & 63, c = l & 7, gq = l >> 3;
    const int sl = blockIdx.x & 3, par = (blockIdx.x >> 2) & 1, rk = blockIdx.x >> 3, nb = gridDim.x >> 3;
    if (rk >= nb) return;
    const unsigned char* ubase = U4 + (size_t)sl * NEXP * 128 + c * 16;
    const int stride = nb * NW;
    int ti = rk * NW + w;
    if (ti >= TOK / 2) return;
    u32x4 idA[2], idB[2];
    u32x4 rv[16];
    f32x4 hA[8], hB[8];
    auto load_ids = [&](int tt, u32x4 (&idq)[2]) {
        const u32x4* i4 = (const u32x4*)(ids + (size_t)tt * 128 + 16 * gq);
        idq[0] = i4[0]; idq[1] = i4[1];
    };
    auto load_hx = [&](int tt, f32x4 (&hx)[8]) {
        const f32x4* h4 = (const f32x4*)(hin + (size_t)tt * 1024 + 256 * sl + 32 * c);
#pragma unroll
        for (int q = 0; q < 8; ++q) hx[q] = h4[q];
    };
    auto step = [&](int tcur, int tnext, int tnext2, const u32x4 (&idn)[2], u32x4 (&idl)[2], const f32x4 (&hc)[8], f32x4 (&hn)[8]) {
        load_ids(tnext2, idl);
        load_hx(tnext, hn);
        __builtin_amdgcn_sched_barrier(0);
        float pr[16];
#pragma unroll
        for (int i = 0; i < 16; ++i) {
            f32x2 f[16];
            asm volatile("" : "+v"(rv[i].x), "+v"(rv[i].y), "+v"(rv[i].z), "+v"(rv[i].w));
            dec32(rv[i], f);
            rv[i] = *(const u32x4*)(ubase + (size_t)idof16(idn, i) * 128);
            __builtin_amdgcn_sched_barrier(0);
            f32x2 s2 = {0.f, 0.f};
#pragma unroll
            for (int q = 0; q < 8; ++q) {
                f32x2 x0 = {hc[q].x, hc[q].y}, x1 = {hc[q].z, hc[q].w};
                s2 = __builtin_elementwise_fma(f[2 * q], x0, s2);
                s2 = __builtin_elementwise_fma(f[2 * q + 1], x1, s2);
            }
            float sacc = s2.x + s2.y;
            asm volatile("" : "+v"(sacc));
            pr[i] = sacc;
        }
#pragma unroll
        for (int i = 0; i < 16; ++i) pr[i] = sum8_dpp(pr[i]);
        if (c == 0) {
            f32x4* o4 = (f32x4*)(part + ((size_t)sl * TOK + tcur) * 128 + 16 * gq);
#pragma unroll
            for (int q = 0; q < 4; ++q) { f32x4 o = {pr[4 * q], pr[4 * q + 1], pr[4 * q + 2], pr[4 * q + 3]}; o4[q] = o; }
        }
    };
    auto tok = [&](int tidx, int fb) { return 2 * (tidx < TOK / 2 ? tidx : fb) + par; };
    load_ids(tok(ti, ti), idA);
#pragma unroll
    for (int i = 0; i < 16; ++i) rv[i] = *(const u32x4*)(ubase + (size_t)idof16(idA, i) * 128);
    load_hx(tok(ti, ti), hA);
    load_ids(tok(ti + stride, ti), idB);
    for (;;) {
        int tn = ti + stride, tn2 = ti + 2 * stride;
        step(tok(ti, ti), tok(tn, ti), tok(tn2, ti), idB, idA, hA, hB);
        if (tn >= TOK / 2) break;
        ti = tn; tn = ti + stride; tn2 = ti + 2 * stride;
        step(tok(ti, ti), tok(tn, ti), tok(tn2, ti), idA, idB, hB, hA);
        if (tn >= TOK / 2) break;
        ti = tn;
    }
}

__device__ __forceinline__ void phase_gather_act(const Params& P, int L, const float* ss_ffn) {
    char* ws = opq(P.ws);
    const float* part = (const float*)(ws + OFF_PART);
    const unsigned short* ids = (const unsigned short*)(ws + OFF_IDS);
    float* gates = (float*)(ws + OFF_GATE);
    const float* uinv = (const float*)(ws + OFF_TSC) + L * NEXP;
    const float* vinv = (const float*)(ws + OFF_TSC) + (2 + L) * NEXP;
    const int tid = opaque_tid(), w = tid >> 6, l = tid & 63;
    for (int t = blockIdx.x * NW + w; t < TOK; t += gridDim.x * NW) {
        float rs = row_rs8(ss_ffn, t);
#pragma unroll
        for (int hsel = 0; hsel < 2; ++hsel) {
            int k = l + 64 * hsel;
            float sacc = 0.f;
#pragma unroll
            for (int j = 0; j < 4; ++j) sacc += part[((size_t)j * TOK + t) * 128 + k];
            int id = ids[(size_t)t * 128 + k];
            float pre = sacc * rs * uinv[id];
            gates[(size_t)t * 128 + k] = gates[(size_t)t * 128 + k] * gelu_exact(pre) * vinv[id];
        }
    }
}

__device__ __forceinline__ void phase_gather_v(const Params& P, int L, int hsel, float* ss_ple) {
    char* ws = opq(P.ws);
    bf16* hb_out = (bf16*)(ws + (hsel ? OFF_HB1 : OFF_HB0));
    const unsigned char* V4 = (const unsigned char*)(ws + OFF_VB) + (size_t)L * NEXP * 512;
    const unsigned short* ids = (const unsigned short*)(ws + OFF_IDS);
    const float* act = (const float*)(ws + OFF_GATE);
    float* hio = opq(P.out);
    const int tid = opaque_tid(), w = tid >> 6, l = tid & 63, c = l & 7, gq = l >> 3;
    const int sl = blockIdx.x & 3, par = (blockIdx.x >> 2) & 1, rk = blockIdx.x >> 3, nb = gridDim.x >> 3;
    if (rk >= nb) return;
    const unsigned char* vbase = V4 + (size_t)sl * NEXP * 128 + c * 16;
    const int stride = nb * NW;
    int ti = rk * NW + w;
    if (ti >= TOK / 2) return;
    const bool b3 = (l >> 3) & 1;
    u32x4 idA[2], idB[2];
    u32x4 rv[16];
    f32x4 aA[4], aB[4];
    auto load_ids = [&](int tt, u32x4 (&idq)[2]) {
        const u32x4* i4 = (const u32x4*)(ids + (size_t)tt * 128 + 16 * gq);
        idq[0] = i4[0]; idq[1] = i4[1];
    };
    auto load_a = [&](int tt, f32x4 (&ax)[4]) {
        const f32x4* a4 = (const f32x4*)(act + (size_t)tt * 128 + 16 * gq);
#pragma unroll
        for (int q = 0; q < 4; ++q) ax[q] = a4[q];
    };
    auto step = [&](int tcur, int tnext, int tnext2, const u32x4 (&idn)[2], u32x4 (&idl)[2], const f32x4 (&ac)[4], f32x4 (&an)[4]) {
        load_ids(tnext2, idl);
        load_a(tnext, an);
        __builtin_amdgcn_sched_barrier(0);
        f32x2 acc[16];
#pragma unroll
        for (int e = 0; e < 16; ++e) { acc[e].x = 0.f; acc[e].y = 0.f; }
#pragma unroll
        for (int i = 0; i < 16; ++i) {
            f32x2 f[16];
            asm volatile("" : "+v"(rv[i].x), "+v"(rv[i].y), "+v"(rv[i].z), "+v"(rv[i].w));
            dec32(rv[i], f);
            rv[i] = *(const u32x4*)(vbase + (size_t)idof16(idn, i) * 128);
            __builtin_amdgcn_sched_barrier(0);
            const float a = (i & 3) == 0 ? ac[i >> 2].x : (i & 3) == 1 ? ac[i >> 2].y : (i & 3) == 2 ? ac[i >> 2].z : ac[i >> 2].w;
            const f32x2 a2 = {a, a};
#pragma unroll
            for (int e = 0; e < 16; ++e) acc[e] = __builtin_elementwise_fma(f[e], a2, acc[e]);
#pragma unroll
            for (int e = 0; e < 16; ++e) asm volatile("" : "+v"(acc[e]));
        }
        float v8[8][2];
#pragma unroll
        for (int e = 0; e < 8; ++e) {
            float k0 = b3 ? acc[8 + e].x : acc[e].x, k1 = b3 ? acc[8 + e].y : acc[e].y;
            float s0 = b3 ? acc[e].x : acc[8 + e].x, s1 = b3 ? acc[e].y : acc[8 + e].y;
            v8[e][0] = k0 + __builtin_bit_cast(float, __builtin_amdgcn_update_dpp(0, __builtin_bit_cast(int, s0), 0x128, 0xf, 0xf, true));
            v8[e][1] = k1 + __builtin_bit_cast(float, __builtin_amdgcn_update_dpp(0, __builtin_bit_cast(int, s1), 0x128, 0xf, 0xf, true));
        }
        float v4[8];
#pragma unroll
        for (int e = 0; e < 8; ++e) {
            float X = v8[e >> 1][e & 1], Y = v8[4 + (e >> 1)][e & 1];
            asm volatile("s_nop 1\n\tv_permlane16_swap_b32 %0, %1\n\ts_nop 1" : "+v"(X), "+v"(Y));
            v4[e] = X + Y;
        }
        float v2[4];
#pragma unroll
        for (int e = 0; e < 4; ++e) {
            float X = v4[e], Y = v4[4 + e];
            asm volatile("s_nop 1\n\tv_permlane32_swap_b32 %0, %1\n\ts_nop 1" : "+v"(X), "+v"(Y));
            v2[e] = X + Y;
        }
        const int col = 256 * sl + 32 * c + 16 * ((l >> 3) & 1) + 8 * ((l >> 4) & 1) + 4 * (l >> 5);
        f32x4* h4 = (f32x4*)(hio + (size_t)tcur * 1024 + col);
        f32x4 hv = *h4;
        hv.x += v2[0]; hv.y += v2[1]; hv.z += v2[2]; hv.w += v2[3];
        *h4 = hv;
        u32x2 bb = {pack2(hv.x, hv.y), pack2(hv.z, hv.w)};
        *(u32x2*)(hb_out + (size_t)tcur * LDH + col) = bb;
        float ssq = hv.x * hv.x + hv.y * hv.y + hv.z * hv.z + hv.w * hv.w;
        ssq = wave_sum(ssq);
        if (l == 0) { ss_ple[(size_t)tcur * 8 + sl] = ssq; ss_ple[(size_t)tcur * 8 + 4 + sl] = 0.f; }
    };
    auto tok = [&](int tidx, int fb) { return 2 * (tidx < TOK / 2 ? tidx : fb) + par; };
    load_ids(tok(ti, ti), idA);
#pragma unroll
    for (int i = 0; i < 16; ++i) rv[i] = *(const u32x4*)(vbase + (size_t)idof16(idA, i) * 128);
    load_a(tok(ti, ti), aA);
    load_ids(tok(ti + stride, ti), idB);
    for (;;) {
        int tn = ti + stride, tn2 = ti + 2 * stride;
        step(tok(ti, ti), tok(tn, ti), tok(tn2, ti), idB, idA, aA, aB);
        if (tn >= TOK / 2) break;
        ti = tn; tn = ti + stride; tn2 = ti + 2 * stride;
        step(tok(ti, ti), tok(tn, ti), tok(tn2, ti), idA, idB, aB, aA);
        if (tn >= TOK / 2) break;
        ti = tn;
    }
}

__device__ __forceinline__ void phase_ple(const Params& P, int L, int hsel, const float* ss_ple, float* ss_out) {
    char* ws = opq(P.ws);
    const bf16* hb_in = (const bf16*)(ws + (hsel ? OFF_HB1 : OFF_HB0));
    bf16* hb_out = (bf16*)(ws + (hsel ? OFF_HB0 : OFF_HB1));
    float* hio = opq(P.out);
    const bf16* pin = (const bf16*)(ws + OFF_PB) + (size_t)L * TOK * LDP;
    const bf16* Wg = (const bf16*)(ws + OFF_WG) + (size_t)L * 1024 * LDH;
    const bf16* Wp = (const bf16*)(ws + OFF_WP) + (size_t)L * 1024 * LDP;
    const int tid = opaque_tid(), w = tid >> 6, l = tid & 63, hh = l >> 5, wm = w >> 1, wn = w & 1;
    for (int it = 0;; ++it) {
        int mt, nt;
        if (!xcd_tile(it, 64, 8, mt, nt)) break;
        int m0 = mt * 256, n0 = nt * 128;
        float* aux = (float*)(smem + LDS_AUX);
        __syncthreads();
        if (tid < 256) aux[tid] = row_rs8(ss_ple, m0 + tid);
        f32x16 acc1[2][2], acc2[2][2];
        ZERO_ACC(acc1);
        ZERO_ACC(acc2);
        gemm_core(acc1, hb_in, LDH, Wg, LDH, 1024, m0, n0, NoHook());
        gemm_core(acc2, pin, LDP, Wp, LDP, 256, m0, n0, NoHook());
#pragma unroll
        for (int i = 0; i < 2; ++i)
#pragma unroll
            for (int rr = 0; rr < 16; ++rr) {
                float rs = aux[wm * 64 + i * 32 + (rr & 3) + 8 * (rr >> 2) + 4 * hh];
#pragma unroll
                for (int j = 0; j < 2; ++j) {
                    float gte = 1.f / (1.f + __expf(-acc1[i][j][rr] * rs));
                    acc2[i][j][rr] *= gte;
                }
            }
        stage_f32<false>(acc2, nullptr);
        residual_store(hio, hio, hb_out, ss_out, m0, n0, nt);
    }
}

__device__ __forceinline__ void phase_final(const Params& P, const float* ss) {
    float* hio = opq(P.out);
    const int tid = opaque_tid(), w = tid >> 6, l = tid & 63;
    const float4* g4 = (const float4*)P.final_norm_g;
    for (int t = blockIdx.x * NW + w; t < TOK; t += gridDim.x * NW) {
        float rs = row_rs8(ss, t);
        float4* o4 = (float4*)(hio + (size_t)t * 1024);
#pragma unroll
        for (int i = 0; i < 4; ++i) {
            float4 v = o4[i * 64 + l], g = g4[i * 64 + l];
            v.x *= rs * g.x; v.y *= rs * g.y; v.z *= rs * g.z; v.w *= rs * g.w;
            o4[i * 64 + l] = v;
        }
    }
}

#define XB_TMO      128
#define XB_XCNT(j)  (256  + 64 * (j))
#define XB_XSUB(j)  (1280 + 64 * (j))
#define XB_XGEN(j)  (2304 + 64 * (j))
#define XB_TOP      3328
#define XB_TOPGEN   3392
#define XCD_BAR_WORDS 3456
#define XB_SPIN_CAP (1u << 22)
__device__ __forceinline__ unsigned xb_ld(unsigned* p) { return __hip_atomic_load(p, __ATOMIC_RELAXED, __HIP_MEMORY_SCOPE_AGENT); }
__device__ __forceinline__ unsigned xb_add(unsigned* p, unsigned v) { return __hip_atomic_fetch_add(p, v, __ATOMIC_RELAXED, __HIP_MEMORY_SCOPE_AGENT); }
__device__ __forceinline__ unsigned xb_xcc_id() { return (unsigned)__builtin_amdgcn_s_getreg((3 << 11) | 20) & 0xFu; }
#define XB_SPIN(cond, bar) do { unsigned _sp = 0; while (cond) { __builtin_amdgcn_s_sleep(1); \
    if ((++_sp & 255u) == 0u) { if (xb_ld(&(bar)[XB_TMO])) break; if (_sp > XB_SPIN_CAP) { atomicAdd(&(bar)[XB_TMO], 1u); break; } } } } while (0)
struct XcdBarrier { unsigned* bar; unsigned x, nloc, nx; };
__device__ __forceinline__ XcdBarrier xcd_barrier_post(unsigned* bar) {
    XcdBarrier b; b.bar = bar; b.x = xb_xcc_id(); b.nloc = 0u; b.nx = 0u;
    if (threadIdx.x == 0) (void)xb_add(&bar[XB_XCNT(b.x)], 1u);
    return b;
}
__device__ __forceinline__ void xcd_barrier_complete(unsigned* bar, unsigned x, unsigned& nloc, unsigned& nx) {
    const unsigned G = gridDim.x;
    unsigned sum, cnt, mine, sp = 0u;
    for (;;) {
        sum = 0u; cnt = 0u; mine = 0u;
#pragma unroll
        for (unsigned j = 0; j < 16; ++j) { const unsigned c = xb_ld(&bar[XB_XCNT(j)]); sum += c; cnt += (c > 0u) ? 1u : 0u; mine = (j == x) ? c : mine; }
        if (sum == G) break;
        __builtin_amdgcn_s_sleep(1);
        if ((++sp & 255u) == 0u) { if (xb_ld(&bar[XB_TMO])) break; if (sp > XB_SPIN_CAP) { atomicAdd(&bar[XB_TMO], 1u); break; } }
    }
    nloc = mine > 0u ? mine : 1u; nx = cnt > 0u ? cnt : 1u;
}
__device__ __forceinline__ void grid_barrier(XcdBarrier& b) {
    asm volatile("s_waitcnt vmcnt(0)" ::: "memory");
    __syncthreads();
    if (threadIdx.x == 0) {
        unsigned* bar = b.bar;
        __builtin_amdgcn_s_waitcnt(0);
        if (b.nloc == 0u) xcd_barrier_complete(bar, b.x, b.nloc, b.nx);
        const unsigned nloc = b.nloc, nx = b.nx;
        const unsigned old = xb_add(&bar[XB_XSUB(b.x)], 1u);
        const unsigned gen = old / nloc;
        if (old + 1u == (gen + 1u) * nloc) {
            __builtin_amdgcn_fence(__ATOMIC_RELEASE, "agent");
            asm volatile("s_waitcnt vmcnt(0)" ::: "memory");
            const unsigned og = xb_add(&bar[XB_TOP], 1u);
            const unsigned tg = og / nx;
            if (og + 1u == (tg + 1u) * nx) xb_add(&bar[XB_TOPGEN], 1u);
            else XB_SPIN(xb_ld(&bar[XB_TOPGEN]) == tg, bar);
            __builtin_amdgcn_fence(__ATOMIC_ACQUIRE, "agent");
            xb_add(&bar[XB_XGEN(b.x)], 1u);
            asm volatile("s_waitcnt vmcnt(0)" ::: "memory");
        } else {
            XB_SPIN(xb_ld(&bar[XB_XGEN(b.x)]) == gen, bar);
            __builtin_amdgcn_fence(__ATOMIC_ACQUIRE, "agent");
            asm volatile("s_waitcnt vmcnt(0)" ::: "memory");
        }
    }
    __syncthreads();
}

__global__ void __launch_bounds__(NTHR, 2) hymba_megakernel(Params P) {
    cg::grid_group grid = cg::this_grid();
    char* ws = opq(P.ws);
    float* ssa = (float*)(ws + OFF_SSA);
    XcdBarrier bar = xcd_barrier_post((unsigned*)(ws + OFF_BAR));
#define BAR() do { grid_barrier(bar); if (DUP == 20) grid_barrier(bar); } while (0)
    phase0(P);
    if (DUP == 0) { asm volatile("s_waitcnt vmcnt(0)" ::: "memory"); __syncthreads(); grid_barrier(bar); phase0(P); }
    asm volatile("s_waitcnt vmcnt(0)" ::: "memory");
    __syncthreads();
    grid.sync();
    BAR();
    int cur = 0;
    for (int L = 0; L < 2; ++L) {
        const float* ss_mix = (L == 0) ? ssa : (ssa + 3 * TOK * 8);
        float* ss_ffn = ssa + (size_t)(1 + L) * TOK * 8;
        float* ss_next = (L == 0) ? (ssa + 3 * TOK * 8) : (ssa + 4 * TOK * 8);
        float* ss_ple = ssa + (size_t)(5 + L) * TOK * 8;
        phase_proj(P, L, cur, ss_mix);
        BAR();
        if (DUP == 1) { phase_proj(P, L, cur, ss_mix); BAR(); }
        phase_mla_up(P, L);
        BAR();
        if (DUP == 2) { phase_mla_up(P, L); BAR(); }
        phase_attn(P, L, 0);
        BAR();
        if (DUP == 3) { phase_attn(P, L, 1); BAR(); }
        phase_wo(P, L, cur ^ 1, ss_ffn);
        BAR();
        if (DUP == 4 && L == 0) { phase_wo(P, L, cur ^ 1, ss_ffn); BAR(); }
        phase_pq(P, L, cur ^ 1, ss_ffn);
        BAR();
        if (DUP == 5) { phase_pq(P, L, cur ^ 1, ss_ffn); BAR(); }
        if (DUP >= 50 && DUP < 66) { phase_pq(P, L, cur ^ 1, ss_ffn, DUP - 50); BAR(); }
        phase_topk(P, L);
        BAR();
        if (DUP == 6) { phase_topk(P, L); BAR(); }
        phase_gather_u(P, L);
        BAR();
        if (DUP == 7) { phase_gather_u(P, L); BAR(); }
        phase_gather_act(P, L, ss_ffn);
        BAR();
        phase_gather_v(P, L, cur, ss_ple);
        BAR();
        phase_ple(P, L, cur, ss_ple, ss_next);
        BAR();
        cur ^= 1;
    }
    phase_final(P, ssa + 4 * TOK * 8);
}

extern "C" void kernel_launch(void* const* d_in, const int* in_sizes, int n_in, void* d_out, int out_size, void* d_ws,
                              size_t ws_size, hipStream_t stream) {
    static int grid_blocks = 0;
    if (!grid_blocks) {
        int dev = 0, cus = 0, per_cu = 0;
        hipGetDevice(&dev);
        hipDeviceGetAttribute(&cus, hipDeviceAttributeMultiprocessorCount, dev);
        hipOccupancyMaxActiveBlocksPerMultiprocessor(&per_cu, hymba_megakernel, NTHR, 0);
        if (per_cu > 1) per_cu = 1;
        if (per_cu < 1) per_cu = 1;
        grid_blocks = cus * per_cu;
        if (ws_size < WS_END) fprintf(stderr, "workspace too small: %zu < %zu\n", ws_size, (size_t)WS_END);
    }
    Params P{};
    P.x = (const float*)d_in[0]; P.p = (const float*)d_in[1]; P.pos = (const int*)d_in[2];
    P.norm_mix_g = (const float*)d_in[3]; P.w_in = (const float*)d_in[4]; P.b_forget = (const float*)d_in[5];
    P.mla_q_norm_g = (const float*)d_in[6]; P.w_uq = (const float*)d_in[7]; P.mla_kv_norm_g = (const float*)d_in[8];
    P.w_ukv = (const float*)d_in[9]; P.mix_out_norm_g = (const float*)d_in[10]; P.w_o = (const float*)d_in[11];
    P.norm_ffn_g = (const float*)d_in[12]; P.w_query = (const float*)d_in[13]; P.sub_keys = (const float*)d_in[14];
    P.peer_u = (const float*)d_in[15]; P.peer_v = (const float*)d_in[16]; P.w_ple = (const float*)d_in[17];
    P.ple_norm_g = (const float*)d_in[18]; P.w_ple_gate = (const float*)d_in[19]; P.final_norm_g = (const float*)d_in[20];
    P.out = (float*)d_out; P.ws = (char*)d_ws;
    hipMemsetAsync((char*)d_ws + OFF_BAR, 0, 16384 + 4096, stream);
    void* args[] = {&P};
    hipError_t e = hipLaunchCooperativeKernel((void*)hymba_megakernel, dim3(grid_blocks), dim3(NTHR), args, 0, stream);
    if (e != hipSuccess) fprintf(stderr, "cooperative launch failed: %s (grid %d)\n", hipGetErrorString(e), grid_blocks);
}
```

```cpp
#include <hip/hip_runtime.h>
#include <hip/hip_cooperative_groups.h>
#include <cstdio>
#include <cstdint>
#include <math.h>
#include <climits>
namespace cg = cooperative_groups;

typedef __bf16 bf16;
typedef __bf16 bf16x8 __attribute__((ext_vector_type(8)));
typedef __bf16 bf16x4 __attribute__((ext_vector_type(4)));
typedef __bf16 bf16x2 __attribute__((ext_vector_type(2)));
typedef float f32x16 __attribute__((ext_vector_type(16)));
typedef float f32x4 __attribute__((ext_vector_type(4)));
typedef float f32x2 __attribute__((ext_vector_type(2)));
typedef unsigned u32x4 __attribute__((ext_vector_type(4)));
typedef unsigned u32x2 __attribute__((ext_vector_type(2)));

#define SEQ 2048
#define BATCH 8
#define TOK 16384
#define DM 1024
#define IN_W 1956
#define NEXP 16384
#define EPSF 1e-6f
#define LOG2E 1.4426950408889634f
#define NTHR 512
#define NW 8
#define LDS_BYTES 151808
#define STAGE_BYTES 49152
#define LDS_AUX 147456
#ifndef DUP
#define DUP -1
#endif

constexpr size_t MBy = 1ull << 20;
constexpr size_t OFF_UB = 0;
constexpr size_t OFF_VB = 32 * MBy;
constexpr size_t OFF_PART = 64 * MBy;
#define LDH 1088
#define LDP 320
#define LDC 192
constexpr size_t OFF_WIN = 128 * MBy;
constexpr size_t OFF_WO = 137 * MBy;
constexpr size_t OFF_WQ = 142 * MBy;
constexpr size_t OFF_WG = 147 * MBy;
constexpr size_t OFF_WP = 152 * MBy;
constexpr size_t OFF_WUQ = 154 * MBy;
constexpr size_t OFF_WUKV = 155 * MBy;
constexpr size_t OFF_SKB = 156 * MBy;
constexpr size_t OFF_CS = 157 * MBy;
constexpr size_t OFF_TSC = 159 * MBy;
constexpr size_t OFF_SSA = 160 * MBy;
constexpr size_t OFF_HB0 = 164 * MBy;
constexpr size_t OFF_HB1 = 200 * MBy;
constexpr size_t OFF_FQ = 236 * MBy;
constexpr size_t OFF_FK = 244 * MBy;
constexpr size_t OFF_FVT = 252 * MBy;
constexpr size_t OFF_SQ = 260 * MBy;
constexpr size_t OFF_SKK = 268 * MBy;
constexpr size_t OFF_SVT = 276 * MBy;
constexpr size_t OFF_CQ = 284 * MBy;
constexpr size_t OFF_CKV = 295 * MBy;
constexpr size_t OFF_FLOG = 302 * MBy;
constexpr size_t OFF_CUMF = 303 * MBy;
constexpr size_t OFF_MQ = 304 * MBy;
constexpr size_t OFF_MK = 316 * MBy;
constexpr size_t OFF_MVT = 328 * MBy;
constexpr size_t OFF_Y = 344 * MBy;
constexpr size_t OFF_PQ = 380 * MBy;
constexpr size_t OFF_IDS = 412 * MBy;
constexpr size_t OFF_GATE = 420 * MBy;
constexpr size_t OFF_BAR = 428 * MBy;
constexpr size_t OFF_CNT = OFF_BAR + 16384;
constexpr size_t OFF_SSY = 429 * MBy;
constexpr size_t OFF_PB = 431 * MBy;
constexpr size_t WS_END = 452 * MBy;

struct Params {
    const float* x; const float* p; const int* pos;
    const float* norm_mix_g; const float* w_in; const float* b_forget; const float* mla_q_norm_g; const float* w_uq;
    const float* mla_kv_norm_g; const float* w_ukv; const float* mix_out_norm_g; const float* w_o; const float* norm_ffn_g;
    const float* w_query; const float* sub_keys; const float* peer_u; const float* peer_v; const float* w_ple;
    const float* ple_norm_g; const float* w_ple_gate; const float* final_norm_g;
    float* out; char* ws;
};

__shared__ __attribute__((aligned(16))) char smem[LDS_BYTES];

__device__ __forceinline__ int opaque_tid() { int t = threadIdx.x; asm volatile("" : "+v"(t)); return t; }
template <typename T> __device__ __forceinline__ T* opq(T* p) { size_t z = 0; asm volatile("" : "+s"(z)); return (T*)((char*)p + z); }

__device__ __forceinline__ unsigned pack2(float a, float b) {
    f32x2 v = {a, b};
    bf16x2 r = __builtin_convertvector(v, bf16x2);
    return __builtin_bit_cast(unsigned, r);
}
__device__ __forceinline__ float bflo(unsigned u) { return __uint_as_float(u << 16); }
__device__ __forceinline__ float bfhi(unsigned u) { return __uint_as_float(u & 0xffff0000u); }
__device__ __forceinline__ float wave_sum(float v) {
#pragma unroll
    for (int o = 32; o > 0; o >>= 1) v += __shfl_xor(v, o);
    return v;
}
template <int CTRL> __device__ __forceinline__ float dpp_add(float v) {
    return v + __builtin_bit_cast(float, __builtin_amdgcn_update_dpp(0, __builtin_bit_cast(int, v), CTRL, 0xf, 0xf, true));
}
__device__ __forceinline__ float sum8_dpp(float v) { v = dpp_add<0xB1>(v); v = dpp_add<0x4E>(v); v = dpp_add<0x141>(v); return v; }
__device__ __forceinline__ float sumg_dpp(float v) {
    v = dpp_add<0x128>(v);
    float a = v, b = v;
    asm volatile("s_nop 1\n\tv_permlane16_swap_b32 %0, %1\n\ts_nop 1" : "+v"(a), "+v"(b));
    v = a + b;
    a = v; b = v;
    asm volatile("s_nop 1\n\tv_permlane32_swap_b32 %0, %1\n\ts_nop 1" : "+v"(a), "+v"(b));
    return a + b;
}
__device__ __forceinline__ float fexp2(float x) { return __builtin_amdgcn_exp2f(x); }
__device__ __forceinline__ float flog2(float x) { return __builtin_amdgcn_logf(x); }
__device__ __forceinline__ float log_sigmoid_f(float z) { return fminf(z, 0.f) - log1pf(expf(-fabsf(z))); }

struct WJob { const float* src; int lds; int K; int Np; bf16* dst; int ldd; const float* gain; int map; };

__device__ __forceinline__ int src_col_map(int map, int c) {
    if (map == 0) return c;
    if (map == 1) {
        if (c < 768) return c;
        if (c < 1952) return c + 4;
        if (c < 1956) return c - 1952 + 768;
        return -1;
    }
    if (c < 256) return 192 * (c >> 6) + (c & 63);
    int e = c - 256;
    return 192 * (e >> 7) + 64 + (e & 127);
}

__device__ __forceinline__ void wconv_tile(const WJob& j, int tile) {
    float* tl = (float*)smem;
    int ktiles = j.K >> 5;
    int nt = tile / ktiles, kt = tile % ktiles;
    int n0 = nt * 32, k0 = kt * 32;
    int tx = opaque_tid() & 31, ty = opaque_tid() >> 5;
    int sc = src_col_map(j.map, n0 + tx);
#pragma unroll
    for (int i = 0; i < 2; ++i) {
        int k = k0 + ty + 16 * i;
        float v = 0.f;
        if (sc >= 0) v = j.src[(size_t)k * j.lds + sc] * (j.gain ? j.gain[k] : 1.f);
        tl[(ty + 16 * i) * 33 + tx] = v;
    }
    __syncthreads();
#pragma unroll
    for (int i = 0; i < 2; ++i) {
        int n = n0 + ty + 16 * i;
        j.dst[(size_t)n * j.ldd + k0 + tx] = (bf16)tl[tx * 33 + ty + 16 * i];
    }
    __syncthreads();
}

__device__ __forceinline__ void phase0(const Params& P) {
    char* ws = opq(P.ws);
    const int G = gridDim.x, bid = blockIdx.x, tid = opaque_tid();
    {
        const int w = tid >> 6, l = tid & 63;
        float* tsc = (float*)(ws + OFF_TSC);
        for (int it = bid * NW + w; it < 4 * NEXP; it += G * NW) {
            int tb = it >> 14, e = it & (NEXP - 1);
            const float* src = (tb < 2 ? P.peer_u : P.peer_v) + ((size_t)(tb & 1) * NEXP + e) * DM + l * 16;
            unsigned char* dst = (unsigned char*)(ws + (tb < 2 ? OFF_UB : OFF_VB)) + (size_t)(tb & 1) * NEXP * 512;
            float4 a = ((const float4*)src)[0], b = ((const float4*)src)[1], c = ((const float4*)src)[2], d = ((const float4*)src)[3];
            if (tb < 2) {
                const float4* g4 = (const float4*)(P.norm_ffn_g + (tb & 1) * 1024 + l * 16);
                float4 g0 = g4[0], g1 = g4[1], g2 = g4[2], g3 = g4[3];
                a.x *= g0.x; a.y *= g0.y; a.z *= g0.z; a.w *= g0.w; b.x *= g1.x; b.y *= g1.y; b.z *= g1.z; b.w *= g1.w;
                c.x *= g2.x; c.y *= g2.y; c.z *= g2.z; c.w *= g2.w; d.x *= g3.x; d.y *= g3.y; d.z *= g3.z; d.w *= g3.w;
            }
            float am = fmaxf(fmaxf(fmaxf(fabsf(a.x), fabsf(a.y)), fmaxf(fabsf(a.z), fabsf(a.w))), fmaxf(fmaxf(fabsf(b.x), fabsf(b.y)), fmaxf(fabsf(b.z), fabsf(b.w))));
            am = fmaxf(am, fmaxf(fmaxf(fmaxf(fabsf(c.x), fabsf(c.y)), fmaxf(fabsf(c.z), fabsf(c.w))), fmaxf(fmaxf(fabsf(d.x), fabsf(d.y)), fmaxf(fabsf(d.z), fabsf(d.w)))));
#pragma unroll
            for (int o = 32; o > 0; o >>= 1) am = fmaxf(am, __shfl_xor(am, o));
            float sc = (am > 0.f) ? (6.0f / am) : 1.f, isc = (am > 0.f) ? (am * (1.f / 6.0f)) : 1.f;
            unsigned w0 = 0, w1 = 0;
            w0 = __builtin_amdgcn_cvt_scalef32_pk_fp4_f32(w0, a.x * sc, a.y * sc, 1.0f, 0);
            w0 = __builtin_amdgcn_cvt_scalef32_pk_fp4_f32(w0, a.z * sc, a.w * sc, 1.0f, 1);
            w0 = __builtin_amdgcn_cvt_scalef32_pk_fp4_f32(w0, b.x * sc, b.y * sc, 1.0f, 2);
            w0 = __builtin_amdgcn_cvt_scalef32_pk_fp4_f32(w0, b.z * sc, b.w * sc, 1.0f, 3);
            w1 = __builtin_amdgcn_cvt_scalef32_pk_fp4_f32(w1, c.x * sc, c.y * sc, 1.0f, 0);
            w1 = __builtin_amdgcn_cvt_scalef32_pk_fp4_f32(w1, c.z * sc, c.w * sc, 1.0f, 1);
            w1 = __builtin_amdgcn_cvt_scalef32_pk_fp4_f32(w1, d.x * sc, d.y * sc, 1.0f, 2);
            w1 = __builtin_amdgcn_cvt_scalef32_pk_fp4_f32(w1, d.z * sc, d.w * sc, 1.0f, 3);
            u32x2 o2 = {w0, w1};
            *(u32x2*)(dst + ((size_t)(l >> 4) * NEXP + e) * 128 + (l & 15) * 8) = o2;
            if (l == 0) tsc[tb * NEXP + e] = isc;
        }
    }
    {
        for (int L = 0; L < 2; ++L) {
            WJob jobs[7];
            jobs[0] = {P.w_in + (size_t)L * 1024 * IN_W, IN_W, 1024, 2048, (bf16*)(ws + OFF_WIN) + (size_t)L * 2048 * LDH, LDH, P.norm_mix_g + L * 1024, 1};
            jobs[1] = {P.w_o + (size_t)L * 1024 * 1024, 1024, 1024, 1024, (bf16*)(ws + OFF_WO) + (size_t)L * 1024 * LDH, LDH, P.mix_out_norm_g + L * 1024, 0};
            jobs[2] = {P.w_query + (size_t)L * 1024 * 1024, 1024, 1024, 1024, (bf16*)(ws + OFF_WQ) + (size_t)L * 1024 * LDH, LDH, P.norm_ffn_g + L * 1024, 0};
            jobs[3] = {P.w_ple_gate + (size_t)L * 1024 * 1024, 1024, 1024, 1024, (bf16*)(ws + OFF_WG) + (size_t)L * 1024 * LDH, LDH, P.ple_norm_g + L * 1024, 0};
            jobs[4] = {P.w_ple + (size_t)L * 256 * 1024, 1024, 256, 1024, (bf16*)(ws + OFF_WP) + (size_t)L * 1024 * LDP, LDP, nullptr, 0};
            jobs[5] = {P.w_uq + (size_t)L * 256 * 384, 384, 256, 384, (bf16*)(ws + OFF_WUQ) + (size_t)L * 384 * LDP, LDP, P.mla_q_norm_g + L * 256, 0};
            jobs[6] = {P.w_ukv + (size_t)L * 128 * 768, 768, 128, 768, (bf16*)(ws + OFF_WUKV) + (size_t)L * 768 * LDC, LDC, P.mla_kv_norm_g + L * 128, 2};
#pragma unroll
            for (int q = 0; q < 7; ++q) {
                int nt = (jobs[q].Np >> 5) * (jobs[q].K >> 5);
                for (int it = bid; it < nt; it += G) wconv_tile(jobs[q], it);
            }
        }
    }
    {
        const float* src = P.sub_keys;
        bf16* dst = (bf16*)(ws + OFF_SKB);
        for (int i = bid * NTHR + tid; i < 262144 / 2; i += G * NTHR) {
            float2 v = ((const float2*)src)[i];
            ((unsigned*)dst)[i] = pack2(v.x, v.y);
        }
    }
    {
        const float4* src = (const float4*)P.p;
        bf16* dst = (bf16*)(ws + OFF_PB);
        for (int i = bid * NTHR + tid; i < 2 * TOK * 256 / 8; i += G * NTHR) {
            float4 a = src[2 * i], b = src[2 * i + 1];
            u32x4 o = {pack2(a.x, a.y), pack2(a.z, a.w), pack2(b.x, b.y), pack2(b.z, b.w)};
            *(u32x4*)(dst + (size_t)(i >> 5) * LDP + (i & 31) * 8) = o;
        }
    }
    {
        bf16* hb = (bf16*)(ws + OFF_HB0);
        float* ss0 = (float*)(ws + OFF_SSA);
        int w = tid >> 6, l = tid & 63;
        for (int row = bid * NW + w; row < TOK; row += G * NW) {
            const float4* xr = (const float4*)(P.x + (size_t)row * DM);
            float ss = 0.f;
#pragma unroll
            for (int i = 0; i < 2; ++i) {
                float4 a = xr[i * 128 + l * 2], b = xr[i * 128 + l * 2 + 1];
                ss += a.x * a.x + a.y * a.y + a.z * a.z + a.w * a.w + b.x * b.x + b.y * b.y + b.z * b.z + b.w * b.w;
                uint4 o;
                o.x = pack2(a.x, a.y); o.y = pack2(a.z, a.w); o.z = pack2(b.x, b.y); o.w = pack2(b.z, b.w);
                ((uint4*)(hb + (size_t)row * LDH))[i * 64 + l] = o;
            }
            ss = wave_sum(ss);
            if (l == 0) {
                *(float4*)(ss0 + (size_t)row * 8) = make_float4(ss, 0.f, 0.f, 0.f);
                *(float4*)(ss0 + (size_t)row * 8 + 4) = make_float4(0.f, 0.f, 0.f, 0.f);
            }
        }
    }
    {
        float* cs = (float*)(ws + OFF_CS);
        for (int i = bid * NTHR + tid; i < TOK * 16; i += G * NTHR) {
            int t = i >> 4, k = i & 15;
            float inv = powf(10000.0f, -(float)k / 16.0f);
            float ang = (float)P.pos[t] * inv;
            cs[2 * i] = cosf(ang);
            cs[2 * i + 1] = sinf(ang);
        }
    }
}

struct NoHook { static constexpr bool nodma = false; __device__ __forceinline__ void operator()(int, f32x16 (&)[2][2]) const {} };
struct NoDmaHook { static constexpr bool nodma = true; __device__ __forceinline__ void operator()(int, f32x16 (&)[2][2]) const {} };
template <typename HOOK>
__device__ __forceinline__ void gemm_core(f32x16 (&acc)[2][2], const bf16* A, int lda, const bf16* Bt, int ldb, int K,
                                          int m0, int n0, HOOK hook) {
    const int tid = opaque_tid(), w = tid >> 6, l = tid & 63, r = l & 31, hh = l >> 5;
    const int wm = w >> 1, wn = w & 1;
    const int dp = (tid & 15) ^ ((tid >> 4) & 15);
    const int drow = 2 * (tid >> 4) + (dp >> 3), dgc = (dp & 7) * 8;
    const bf16* asrc = A + (size_t)(m0 + drow) * lda + dgc;
    const bf16* bsrc = Bt + (size_t)(n0 + drow) * ldb + dgc;
    auto dma = [&](int buf, int k0) {
        if (HOOK::nodma) return;
        char* base = smem + buf * STAGE_BYTES + tid * 16;
#pragma unroll
        for (int i = 0; i < 4; ++i)
            __builtin_amdgcn_global_load_lds((const unsigned*)(asrc + (size_t)(64 * i) * lda + k0), (unsigned*)(base + i * 8192), 16, 0, 0);
#pragma unroll
        for (int i = 0; i < 2; ++i)
            __builtin_amdgcn_global_load_lds((const unsigned*)(bsrc + (size_t)(64 * i) * ldb + k0), (unsigned*)(base + 32768 + i * 8192), 16, 0, 0);
    };
    int offA[2], offB[2];
#pragma unroll
    for (int i = 0; i < 2; ++i) { offA[i] = ((wm * 64 + i * 32 + r) >> 1) * 256; offB[i] = 32768 + ((wn * 64 + i * 32 + r) >> 1) * 256; }
    const int pbase = ((r & 1) << 3), lx = (r >> 1) & 15;
    const int nk = K >> 6;
    const unsigned ldsbase = (unsigned)(size_t)(__attribute__((address_space(3))) char*)smem;
    auto ldfrag = [&](int stage, int s, bf16x8 (&af)[2], bf16x8 (&bfr)[2]) {
        unsigned ch = (unsigned)((((pbase | (2 * s + hh)) ^ lx) << 4)) + ldsbase + (unsigned)(stage * STAGE_BYTES);
        unsigned a0a = ch + offA[0], a1a = ch + offA[1], b0a = ch + offB[0], b1a = ch + offB[1];
        asm volatile("ds_read_b128 %0, %4\n\tds_read_b128 %1, %5\n\tds_read_b128 %2, %6\n\tds_read_b128 %3, %7"
                     : "=&v"(af[0]), "=&v"(af[1]), "=&v"(bfr[0]), "=&v"(bfr[1]) : "v"(a0a), "v"(a1a), "v"(b0a), "v"(b1a) : "memory");
    };
    auto mma = [&](bf16x8 (&af)[2], bf16x8 (&bfr)[2]) {
#pragma unroll
        for (int i = 0; i < 2; ++i)
#pragma unroll
            for (int j = 0; j < 2; ++j) acc[i][j] = __builtin_amdgcn_mfma_f32_32x32x16_bf16(af[i], bfr[j], acc[i][j], 0, 0, 0);
    };
#define LGKM_WAIT(n) do { asm volatile("s_waitcnt lgkmcnt(" #n ")" ::: "memory"); __builtin_amdgcn_sched_barrier(0); } while (0)
    asm volatile("s_waitcnt vmcnt(0)" ::: "memory");
    dma(0, 0);
    dma(1, 64);
    if (nk > 2) { dma(2, 128); asm volatile("s_waitcnt vmcnt(12)" ::: "memory"); }
    else asm volatile("s_waitcnt vmcnt(6)" ::: "memory");
    __builtin_amdgcn_s_barrier();
    bf16x8 a0[2], b0[2], a1[2], b1[2];
    ldfrag(0, 0, a0, b0);
    int cur = 0;
    for (int kt = 0; kt < nk; ++kt) {
        const int nxt = (cur == 2) ? 0 : cur + 1;
        if (kt == 4 || kt == 8) { LGKM_WAIT(0); hook(kt, acc); }
        ldfrag(cur, 1, a1, b1);
        LGKM_WAIT(4);
        mma(a0, b0);
        ldfrag(cur, 2, a0, b0);
        LGKM_WAIT(4);
        mma(a1, b1);
        ldfrag(cur, 3, a1, b1);
        LGKM_WAIT(4);
        mma(a0, b0);
        if (kt + 1 < nk) {
            if (kt + 2 < nk) asm volatile("s_waitcnt vmcnt(6) lgkmcnt(0)" ::: "memory");
            else asm volatile("s_waitcnt vmcnt(0) lgkmcnt(0)" ::: "memory");
            __builtin_amdgcn_s_barrier();
            __builtin_amdgcn_sched_barrier(0);
            if (kt + 3 < nk) dma(cur, (kt + 3) << 6);
            ldfrag(nxt, 0, a0, b0);
        } else {
            LGKM_WAIT(0);
        }
        mma(a1, b1);
        cur = nxt;
    }
    __syncthreads();
}
__device__ __forceinline__ float row_rs8(const float* part, int row) {
    float4 a = *(const float4*)(part + (size_t)row * 8), b = *(const float4*)(part + (size_t)row * 8 + 4);
    float ss = ((a.x + a.y) + (a.z + a.w)) + ((b.x + b.y) + (b.z + b.w));
    return rsqrtf(ss * (1.f / 1024.f) + EPSF);
}
__device__ __forceinline__ bool xcd_tile(int it, int MT, int NT, int& mt, int& nt) {
    const int G = gridDim.x, bid = blockIdx.x;
    if ((G & 7) == 0 && (MT & 7) == 0) {
        const int nbx = G >> 3, q = (bid >> 3) + it * nbx, per = (MT >> 3) * NT;
        if (q >= per) return false;
        mt = (bid & 7) * (MT >> 3) + q / NT; nt = q % NT;
        return true;
    }
    const int q = bid + it * G;
    if (q >= MT * NT) return false;
    mt = q / NT; nt = q % NT;
    return true;
}
struct NoScale { __device__ __forceinline__ float operator()(int, int) const { return 1.f; } };

#define ZERO_ACC(acc)                                  \
    _Pragma("unroll") for (int _i = 0; _i < 2; ++_i)   \
    _Pragma("unroll") for (int _j = 0; _j < 2; ++_j)   \
    _Pragma("unroll") for (int _r = 0; _r < 16; ++_r) acc[_i][_j][_r] = 0.f;


#define TB_LD 136
#define TF_LD 132
template <bool SCALE>
__device__ __forceinline__ void stage_bf16(const f32x16 (&acc)[2][2], const float* rsl) {
    bf16* T = (bf16*)smem;
    const int tid = opaque_tid(), w = tid >> 6, l = tid & 63, hh = l >> 5, wm = w >> 1, wn = w & 1;
#pragma unroll
    for (int i = 0; i < 2; ++i)
#pragma unroll
        for (int rr = 0; rr < 16; ++rr) {
            int row = wm * 64 + i * 32 + (rr & 3) + 8 * (rr >> 2) + 4 * hh;
            float sc = SCALE ? rsl[row] : 1.f;
#pragma unroll
            for (int j = 0; j < 2; ++j) T[row * TB_LD + wn * 64 + j * 32 + (l & 31)] = (bf16)(acc[i][j][rr] * sc);
        }
    __syncthreads();
}
template <bool SCALE>
__device__ __forceinline__ void stage_f32(const f32x16 (&acc)[2][2], const float* rsl) {
    float* T = (float*)smem;
    const int tid = opaque_tid(), w = tid >> 6, l = tid & 63, hh = l >> 5, wm = w >> 1, wn = w & 1;
#pragma unroll
    for (int i = 0; i < 2; ++i)
#pragma unroll
        for (int rr = 0; rr < 16; ++rr) {
            int row = wm * 64 + i * 32 + (rr & 3) + 8 * (rr >> 2) + 4 * hh;
            float sc = SCALE ? rsl[row] : 1.f;
#pragma unroll
            for (int j = 0; j < 2; ++j) T[row * TF_LD + wn * 64 + j * 32 + (l & 31)] = acc[i][j][rr] * sc;
        }
    __syncthreads();
}
template <typename CMAP>
__device__ __forceinline__ void store_rows_bf16(bf16* dst, int ld, int m0, CMAP cmap) {
    const bf16* T = (const bf16*)smem;
    const int tid = opaque_tid();
#pragma unroll
    for (int q = 0; q < 8; ++q) {
        int id = tid + 512 * q, row = id >> 4, ch = id & 15;
        u32x4 v = *(const u32x4*)(T + row * TB_LD + ch * 8);
        *(u32x4*)(dst + (size_t)(m0 + row) * ld + cmap(ch * 8)) = v;
    }
}
__device__ __forceinline__ void store_cols_bf16(bf16* vt, size_t crow0, int s0) {
    const unsigned short* T = (const unsigned short*)smem;
    const int tid = opaque_tid();
#pragma unroll
    for (int q = 0; q < 8; ++q) {
        int id = tid + 512 * q, c = id & 127, sg = id >> 7;
        unsigned e[8];
#pragma unroll
        for (int k = 0; k < 8; ++k) e[k] = T[(8 * sg + k) * TB_LD + c];
        u32x4 v = {e[0] | (e[1] << 16), e[2] | (e[3] << 16), e[4] | (e[5] << 16), e[6] | (e[7] << 16)};
        *(u32x4*)(vt + (crow0 + c) * SEQ + s0 + 8 * sg) = v;
    }
}
__device__ __forceinline__ void residual_store(const float* hin, float* hout, bf16* hb_out, float* gss, int m0, int n0, int nt) {
    const float* T = (const float*)smem;
    const int tid = opaque_tid(), l = tid & 63;
#pragma unroll 4
    for (int q = 0; q < 16; ++q) {
        int id = tid + 512 * q, row = id >> 5, ch = id & 31;
        f32x4 d = *(const f32x4*)(T + row * TF_LD + ch * 4);
        size_t gi = (size_t)(m0 + row) * 1024 + n0 + ch * 4;
        f32x4 h = *(const f32x4*)(hin + gi);
        f32x4 v = h + d;
        *(f32x4*)(hout + gi) = v;
        u32x2 b = {pack2(v.x, v.y), pack2(v.z, v.w)};
        *(u32x2*)(hb_out + (size_t)(m0 + row) * LDH + n0 + ch * 4) = b;
        float ss = v.x * v.x + v.y * v.y + v.z * v.z + v.w * v.w;
        ss = dpp_add<0xB1>(ss); ss = dpp_add<0x4E>(ss); ss = dpp_add<0x141>(ss); ss = dpp_add<0x140>(ss);
        ss += __shfl_xor(ss, 16);
        if ((l & 31) == 0) gss[(size_t)(m0 + row) * 8 + nt] = ss;
    }
}
struct ColAdd { int off; __device__ __forceinline__ int operator()(int c) const { return c + off; } };
struct ColHead96 { __device__ __forceinline__ int operator()(int c) const { return (c >> 6) * 96 + (c & 63); } };

__device__ __forceinline__ void phase_proj(const Params& P, int L, int hsel, const float* ssrow) {
    char* ws = opq(P.ws);
    const bf16* hb = (const bf16*)(ws + (hsel ? OFF_HB1 : OFF_HB0));
    const bf16* Bt = (const bf16*)(ws + OFF_WIN) + (size_t)L * 2048 * LDH;
    bf16* fq = (bf16*)(ws + OFF_FQ); bf16* fk = (bf16*)(ws + OFF_FK); bf16* fvt = (bf16*)(ws + OFF_FVT);
    bf16* sq = (bf16*)(ws + OFF_SQ); bf16* sk = (bf16*)(ws + OFF_SKK); bf16* svt = (bf16*)(ws + OFF_SVT);
    bf16* cq = (bf16*)(ws + OFF_CQ); bf16* ckv = (bf16*)(ws + OFF_CKV);
    float* flog = (float*)(ws + OFF_FLOG);
    bf16* mk = (bf16*)(ws + OFF_MK);
    const float* cs = (const float*)(ws + OFF_CS);
    const int tid = opaque_tid(), w = tid >> 6, l = tid & 63, hh = l >> 5, wm = w >> 1, wn = w & 1;
    for (int it = 0;; ++it) {
        int mt, nt;
        if (!xcd_tile(it, 64, 16, mt, nt)) break;
        int m0 = mt * 256, n0 = nt * 128;
        float* aux = (float*)(smem + LDS_AUX);
        if (tid < 256) aux[tid] = row_rs8(ssrow, m0 + tid);
        f32x16 acc[2][2];
        ZERO_ACC(acc);
        gemm_core(acc, hb, LDH, Bt, LDH, 1024, m0, n0, NoHook());
        if (nt < 15) {
            stage_bf16<true>(acc, aux);
            if (nt == 4 || nt == 5 || nt == 10 || nt == 11) {
                bf16* vt = (nt < 6) ? fvt : svt;
                int cbase = n0 - ((nt < 6) ? 512 : 1280);
                store_cols_bf16(vt, (size_t)(m0 >> 11) * 256 + cbase, m0 & 2047);
            } else if (nt < 2) store_rows_bf16(fq, 256, m0, ColAdd{n0});
            else if (nt < 4) store_rows_bf16(fk, 256, m0, ColAdd{n0 - 256});
            else if (nt < 8) store_rows_bf16(sq, 256, m0, ColAdd{n0 - 768});
            else if (nt < 10) store_rows_bf16(sk, 256, m0, ColAdd{n0 - 1024});
            else if (nt < 14) store_rows_bf16(cq, LDP, m0, ColAdd{n0 - 1536});
            else store_rows_bf16(ckv, LDC, m0, ColAdd{0});
        } else {
            if (wn == 0) {
#pragma unroll
                for (int i = 0; i < 2; ++i) {
                    int rloc = wm * 64 + i * 32 + 4 * hh;
                    int ci = l & 31, pi = ci & 15;
#pragma unroll
                    for (int rr = 0; rr < 16; ++rr) {
                        int rl = rloc + (rr & 3) + 8 * (rr >> 2), row = m0 + rl;
                        float rs = aux[rl];
                        float v = acc[i][0][rr] * rs;
                        float pv = __shfl_xor(v, 16);
                        float2 c_s = *(const float2*)(cs + ((size_t)row * 16 + pi) * 2);
                        float o = (ci < 16) ? (v * c_s.x - pv * c_s.y) : (pv * c_s.y + v * c_s.x);
                        bf16 ob = (bf16)o;
#pragma unroll
                        for (int h = 0; h < 4; ++h) mk[(size_t)row * 384 + h * 96 + 64 + ci] = ob;
                        if (ci < 4) flog[(size_t)row * 4 + ci] = acc[i][1][rr] * rs;
                    }
                }
            }
        }
        __syncthreads();
    }
}

template <int KW>
__device__ __forceinline__ void row_rms_to_lds(const bf16* A, int lda, int m0) {
    const int tid = opaque_tid(), row = tid >> 1, half = tid & 1;
    float ss = 0.f;
    const u32x4* p = (const u32x4*)(A + (size_t)(m0 + row) * lda + half * (KW / 2));
#pragma unroll
    for (int q = 0; q < KW / 16; ++q) {
        u32x4 v = p[q];
        float a;
        a = bflo(v.x); ss += a * a; a = bfhi(v.x); ss += a * a;
        a = bflo(v.y); ss += a * a; a = bfhi(v.y); ss += a * a;
        a = bflo(v.z); ss += a * a; a = bfhi(v.z); ss += a * a;
        a = bflo(v.w); ss += a * a; a = bfhi(v.w); ss += a * a;
    }
    ss += __shfl_xor(ss, 1);
    if (half == 0) ((float*)(smem + LDS_AUX))[row] = rsqrtf(ss * (1.f / (float)KW) + EPSF);
}

__device__ __forceinline__ void phase_mla_up(const Params& P, int L) {
    char* ws = opq(P.ws);
    const bf16* cq = (const bf16*)(ws + OFF_CQ); const bf16* ckv = (const bf16*)(ws + OFF_CKV);
    const bf16* wuq = (const bf16*)(ws + OFF_WUQ) + (size_t)L * 384 * LDP;
    const bf16* wukv = (const bf16*)(ws + OFF_WUKV) + (size_t)L * 768 * LDC;
    bf16* mq = (bf16*)(ws + OFF_MQ); bf16* mk = (bf16*)(ws + OFF_MK); bf16* mvt = (bf16*)(ws + OFF_MVT);
    const float* cs = (const float*)(ws + OFF_CS);
    const float* flog = (const float*)(ws + OFF_FLOG);
    float* cumF = (float*)(ws + OFF_CUMF);
    const int tid = opaque_tid(), w = tid >> 6, l = tid & 63, hh = l >> 5, wm = w >> 1, wn = w & 1;
    const int NQ = 64 * 3, NKV = 64 * 6, NCF = 4;
    const float* aux = (const float*)(smem + LDS_AUX);
    for (int item = blockIdx.x; item < NQ + NKV + NCF; item += gridDim.x) {
        if (item < NQ) {
            int mt = item / 3, nt = item % 3;
            int m0 = mt * 256, n0 = nt * 128;
            __syncthreads();
            row_rms_to_lds<256>(cq, LDP, m0);
            f32x16 acc[2][2];
            ZERO_ACC(acc);
            gemm_core(acc, cq, LDP, wuq, LDP, 256, m0, n0, NoHook());
#pragma unroll
            for (int i = 0; i < 2; ++i)
#pragma unroll
                for (int j = 0; j < 2; ++j) {
                    int c0 = n0 + wn * 64 + j * 32;
                    int rloc = wm * 64 + i * 32 + 4 * hh;
                    bool rot = (c0 % 96) == 64;
                    int ci = l & 31, pi = ci & 15;
#pragma unroll
                    for (int rr = 0; rr < 16; ++rr) {
                        int rl = rloc + (rr & 3) + 8 * (rr >> 2);
                        float v = acc[i][j][rr] * aux[rl];
                        if (rot) {
                            float pv = __shfl_xor(v, 16);
                            float2 c_s = *(const float2*)(cs + ((size_t)(m0 + rl) * 16 + pi) * 2);
                            v = (ci < 16) ? (v * c_s.x - pv * c_s.y) : (pv * c_s.y + v * c_s.x);
                        }
                        acc[i][j][rr] = v;
                    }
                }
            stage_bf16<false>(acc, nullptr);
            store_rows_bf16(mq, 384, m0, ColAdd{n0});
        } else if (item < NQ + NKV) {
            int it2 = item - NQ;
            int mt = it2 / 6, nt = it2 % 6;
            int m0 = mt * 256, n0 = nt * 128;
            __syncthreads();
            row_rms_to_lds<128>(ckv, LDC, m0);
            f32x16 acc[2][2];
            ZERO_ACC(acc);
            gemm_core(acc, ckv, LDC, wukv, LDC, 128, m0, n0, NoHook());
            stage_bf16<true>(acc, aux);
            if (nt < 2) {
                const int nb0 = n0;
                struct CM { int n0; __device__ __forceinline__ int operator()(int c) const { int col = n0 + c; return (col >> 6) * 96 + (col & 63); } };
                store_rows_bf16(mk, 384, m0, CM{nb0});
            } else {
                store_cols_bf16(mvt, (size_t)(m0 >> 11) * 512 + (n0 - 256), m0 & 2047);
            }
        } else {
            int seq = (item - NQ - NKV) * NW + w;
            int b = seq >> 2, h = seq & 3;
            float bfv = P.b_forget[L * 4 + h];
            float vals[32];
            float run = 0.f;
#pragma unroll
            for (int i = 0; i < 32; ++i) {
                int s = l * 32 + i;
                float z = flog[((size_t)b * SEQ + s) * 4 + h] + bfv;
                run += log_sigmoid_f(z);
                vals[i] = run;
            }
            float tot = run, incl = tot;
#pragma unroll
            for (int o = 1; o < 64; o <<= 1) {
                float t = __shfl_up(incl, o);
                if (l >= o) incl += t;
            }
            float excl = incl - tot;
#pragma unroll
            for (int i = 0; i < 32; ++i) cumF[(size_t)seq * SEQ + l * 32 + i] = vals[i] + excl;
        }
    }
}

template <int MODE, int DK, int DV>
__device__ __forceinline__ void attn_item(const bf16* __restrict__ Q, int ldq, const bf16* __restrict__ Kg, int ldk,
                          const bf16* __restrict__ Vt, const float* __restrict__ cumF, bf16* __restrict__ Y,
                          float* __restrict__ ssy, int b, int h, int qb, float c1, char* lds) {
    constexpr int KSTR = DK * 2 + 16;
    constexpr int VSTR = 144;
    constexpr int KBYTES = 64 * KSTR, VBYTES = DV * VSTR;
    constexpr int BUF = (KBYTES + VBYTES + 256 + 255) & ~255;
    static_assert(2 * BUF <= 65536, "lds");
    constexpr int KCH = DK / 8, KPT = (64 * KCH) / 256, VPT = (DV * 8) / 256;
    const int tid = opaque_tid() & 255, w = tid >> 6, l = tid & 63, r = l & 31, hh = l >> 5;
    const int q0 = qb * 128;
    const int qrow = q0 + 32 * w + r;
    const size_t tok = (size_t)b * SEQ + qrow;
    const int bh = b * 4 + h;
    bf16x8 qf[DK / 16];
#pragma unroll
    for (int s = 0; s < DK / 16; ++s) qf[s] = *(const bf16x8*)(Q + tok * ldq + h * DK + 16 * s + 8 * hh);
    f32x16 o[DV / 32];
    const f32x16 zero16 = {0.f, 0.f, 0.f, 0.f, 0.f, 0.f, 0.f, 0.f, 0.f, 0.f, 0.f, 0.f, 0.f, 0.f, 0.f, 0.f};
#pragma unroll
    for (int d = 0; d < DV / 32; ++d) o[d] = zero16;
    float m = -1e30f, lsum = 0.f, R = 0.f;
    float Fq = 0.f;
    if (MODE == 0) Fq = cumF[(size_t)bh * SEQ + qrow] * LOG2E;
    const int nkt = (q0 + 128) >> 6;
    u32x4 kreg[KPT], vreg[VPT];
    float4 freg = {0.f, 0.f, 0.f, 0.f};
    auto gload = [&](int kt) {
#pragma unroll
        for (int i = 0; i < KPT; ++i) {
            int e = tid + 256 * i;
            int row = e / KCH, ch = e % KCH;
            kreg[i] = *(const u32x4*)(Kg + ((size_t)b * SEQ + kt * 64 + row) * ldk + h * DK + ch * 8);
        }
#pragma unroll
        for (int i = 0; i < VPT; ++i) {
            int e = tid + 256 * i;
            int row = e >> 3, ch = e & 7;
            vreg[i] = *(const u32x4*)(Vt + ((size_t)bh * DV + row) * SEQ + kt * 64 + ch * 8);
        }
        if (MODE == 0 && tid < 16) freg = *(const float4*)(cumF + (size_t)bh * SEQ + kt * 64 + tid * 4);
    };
    auto lwrite = [&](int buf) {
        char* base = lds + buf * BUF;
#pragma unroll
        for (int i = 0; i < KPT; ++i) {
            int e = tid + 256 * i;
            int row = e / KCH, ch = e % KCH;
            *(u32x4*)(base + row * KSTR + ch * 16) = kreg[i];
        }
#pragma unroll
        for (int i = 0; i < VPT; ++i) {
            int e = tid + 256 * i;
            int row = e >> 3, ch = e & 7;
            *(u32x4*)(base + KBYTES + row * VSTR + ch * 16) = vreg[i];
        }
        if (MODE == 0 && tid < 16) *(float4*)(base + KBYTES + VBYTES + tid * 16) = freg;
    };
    const int prow = (r & 0x13) | ((r & 4) << 1) | ((r & 8) >> 1);
    gload(MODE == 1 ? nkt - 1 : 0);
    lwrite(0);
    __syncthreads();
    for (int it = 0; it < nkt; ++it) {
        const int kt = (MODE == 1) ? (nkt - 1 - it) : it;
        if (it + 1 < nkt) gload((MODE == 1) ? (kt - 1) : (kt + 1));
        const char* base = lds + (it & 1) * BUF;
        const bool active = (kt * 64) <= (q0 + 32 * w + 31);
        if (active) {
            const bool needmask = (kt * 64 + 63) >= (q0 + 32 * w);
            f32x16 s[2];
#pragma unroll
            for (int sub = 0; sub < 2; ++sub) {
                s[sub] = zero16;
#pragma unroll
                for (int ks = 0; ks < DK / 16; ++ks) {
                    bf16x8 kf = *(const bf16x8*)(base + (sub * 32 + prow) * KSTR + (2 * ks + hh) * 16);
                    s[sub] = __builtin_amdgcn_mfma_f32_32x32x16_bf16(kf, qf[ks], s[sub], 0, 0, 0);
                }
            }
            bf16x8 pf[2][2];
            if (MODE != 1) {
                const float* Ft = (const float*)(base + KBYTES + VBYTES);
                float mx = -INFINITY;
                float tv[2][16];
#pragma unroll
                for (int sub = 0; sub < 2; ++sub)
#pragma unroll
                    for (int a = 0; a < 2; ++a) {
                        int kofs = sub * 32 + 16 * a + 8 * hh;
                        float fk[8];
                        if (MODE == 0) {
                            float4 f0 = *(const float4*)(Ft + kofs), f1 = *(const float4*)(Ft + kofs + 4);
                            fk[0] = f0.x; fk[1] = f0.y; fk[2] = f0.z; fk[3] = f0.w; fk[4] = f1.x; fk[5] = f1.y; fk[6] = f1.z; fk[7] = f1.w;
                        }
#pragma unroll
                        for (int j = 0; j < 8; ++j) {
                            int rr = 8 * a + j;
                            float v = s[sub][rr] * c1;
                            if (MODE == 0) v += Fq - fk[j] * LOG2E;
                            if (needmask && (kt * 64 + kofs + j > qrow)) v = -INFINITY;
                            tv[sub][rr] = v;
                            mx = fmaxf(mx, v);
                        }
                    }
                mx = fmaxf(mx, __shfl_xor(mx, 32));
                float mnew = fmaxf(m, mx);
                float alpha = fexp2(m - mnew);
                float rsum = 0.f;
#pragma unroll
                for (int sub = 0; sub < 2; ++sub)
#pragma unroll
                    for (int a = 0; a < 2; ++a) {
                        float pv[8];
#pragma unroll
                        for (int j = 0; j < 8; ++j) { pv[j] = fexp2(tv[sub][8 * a + j] - mnew); rsum += pv[j]; }
                        uint4 u;
                        u.x = pack2(pv[0], pv[1]); u.y = pack2(pv[2], pv[3]); u.z = pack2(pv[4], pv[5]); u.w = pack2(pv[6], pv[7]);
                        pf[sub][a] = __builtin_bit_cast(bf16x8, u);
                    }
                rsum += __shfl_xor(rsum, 32);
                lsum = lsum * alpha + rsum;
                m = mnew;
#pragma unroll
                for (int d = 0; d < DV / 32; ++d) o[d] = o[d] * alpha;
            } else {
#pragma unroll
                for (int sb = 0; sb < 2; ++sb) {
                    const int sub = 1 - sb;
                    float lsig[16], lneg[16];
                    float A0 = 0.f, A1 = 0.f;
#pragma unroll
                    for (int rr = 0; rr < 16; ++rr) {
                        int key = kt * 64 + sub * 32 + 16 * (rr >> 3) + 8 * hh + (rr & 7);
                        bool valid = key < qrow;
                        float z = s[sub][rr] * c1;
                        float e = fexp2(-fabsf(z));
                        float l1p = flog2(1.f + e);
                        float ls = fminf(z, 0.f) - l1p;
                        float ln = valid ? (ls - z) : 0.f;
                        lsig[rr] = valid ? ls : -INFINITY;
                        lneg[rr] = ln;
                        if (rr < 8) A0 += ln; else A1 += ln;
                    }
                    float B0 = __shfl_xor(A0, 32), B1 = __shfl_xor(A1, 32);
                    float base1 = (hh == 0) ? (R + B1) : R;
                    float base0 = (hh == 0) ? (R + B1 + A1 + B0) : (R + A1 + B1);
                    float wv[16];
                    float run = base1;
#pragma unroll
                    for (int j = 7; j >= 0; --j) { wv[8 + j] = fexp2(lsig[8 + j] + run); run += lneg[8 + j]; }
                    run = base0;
#pragma unroll
                    for (int j = 7; j >= 0; --j) { wv[j] = fexp2(lsig[j] + run); run += lneg[j]; }
                    R += A0 + A1 + B0 + B1;
#pragma unroll
                    for (int a = 0; a < 2; ++a) {
                        uint4 u;
                        u.x = pack2(wv[8 * a], wv[8 * a + 1]); u.y = pack2(wv[8 * a + 2], wv[8 * a + 3]);
                        u.z = pack2(wv[8 * a + 4], wv[8 * a + 5]); u.w = pack2(wv[8 * a + 6], wv[8 * a + 7]);
                        pf[sub][a] = __builtin_bit_cast(bf16x8, u);
                    }
                }
            }
#pragma unroll
            for (int d = 0; d < DV / 32; ++d)
#pragma unroll
                for (int sub = 0; sub < 2; ++sub)
#pragma unroll
                    for (int a = 0; a < 2; ++a) {
                        bf16x8 vf = *(const bf16x8*)(base + KBYTES + (d * 32 + r) * VSTR + (sub * 32 + 16 * a + 8 * hh) * 2);
                        o[d] = __builtin_amdgcn_mfma_f32_32x32x16_bf16(vf, pf[sub][a], o[d], 0, 0, 0);
                    }
        }
        if (it + 1 < nkt) lwrite((it + 1) & 1);
        __syncthreads();
    }
    float inv = (MODE == 1) ? 1.f : (1.f / lsum);
    float ssq = 0.f;
#pragma unroll
    for (int d = 0; d < DV / 32; ++d)
#pragma unroll
        for (int g = 0; g < 4; ++g) {
            float v0 = o[d][4 * g] * inv, v1 = o[d][4 * g + 1] * inv, v2 = o[d][4 * g + 2] * inv, v3 = o[d][4 * g + 3] * inv;
            ssq += v0 * v0 + v1 * v1 + v2 * v2 + v3 * v3;
            uint2 u; u.x = pack2(v0, v1); u.y = pack2(v2, v3);
            *(uint2*)(Y + tok * LDH + h * DV + d * 32 + 8 * g + 4 * hh) = u;
        }
    ssq += __shfl_xor(ssq, 32);
    if (hh == 0) ssy[tok * 16 + h] = ssq;
}

__device__ __forceinline__ void phase_attn(const Params& P, int L, int rep = 0) {
    char* ws = opq(P.ws);
    int* cnt = (int*)(ws + OFF_CNT) + L * 64 + rep * 16;
    int* s_item = (int*)(smem + LDS_BYTES - 16);
    const float* cumF = (const float*)(ws + OFF_CUMF);
    bf16* Y = (bf16*)(ws + OFF_Y);
    float* ssy = (float*)(ws + OFF_SSY) + (size_t)L * TOK * 16;
    const int half = opaque_tid() >> 8;
    char* lds = smem + half * 65536;
    for (;;) {
        if (opaque_tid() == 0) *s_item = atomicAdd(cnt, 1);
        __syncthreads();
        int pair = *s_item;
        __syncthreads();
        if (pair >= 768) break;
        int item = pair * 2 + half;
        int qb = 15 - item / 96;
        int rem = item % 96;
        int type = rem >> 5, bh = rem & 31;
        int b = bh >> 2, h = bh & 3;
        if (type == 0) {
            attn_item<2, 96, 128>((const bf16*)(ws + OFF_MQ), 384, (const bf16*)(ws + OFF_MK), 384, (const bf16*)(ws + OFF_MVT), cumF,
                                  Y + 512, ssy + 8, b, h, qb, 0.10206207261596577f * LOG2E, lds);
        } else if (type == 1) {
            attn_item<1, 64, 64>((const bf16*)(ws + OFF_SQ), 256, (const bf16*)(ws + OFF_SKK), 256, (const bf16*)(ws + OFF_SVT), cumF,
                                 Y + 256, ssy + 4, b, h, qb, 0.125f * LOG2E, lds);
        } else {
            attn_item<0, 64, 64>((const bf16*)(ws + OFF_FQ), 256, (const bf16*)(ws + OFF_FK), 256, (const bf16*)(ws + OFF_FVT), cumF,
                                 Y + 0, ssy + 0, b, h, qb, 0.125f * LOG2E, lds);
        }
    }
}

__device__ __forceinline__ void rowss_flush(float (&part)[2][16], float* gss, int m0, int nt) {
    float* lss = (float*)smem;
    const int tid = opaque_tid(), w = tid >> 6, l = tid & 63, hh = l >> 5, wm = w >> 1, wn = w & 1;
#pragma unroll
    for (int i = 0; i < 2; ++i)
#pragma unroll
        for (int rr = 0; rr < 16; ++rr) {
            float v = part[i][rr];
            v = dpp_add<0xB1>(v); v = dpp_add<0x4E>(v); v = dpp_add<0x141>(v); v = dpp_add<0x140>(v);
            v += __shfl_xor(v, 16);
            if ((l & 31) == 0) lss[wn * 256 + wm * 64 + i * 32 + (rr & 3) + 8 * (rr >> 2) + 4 * hh] = v;
        }
    __syncthreads();
    if (tid < 256) gss[(size_t)(m0 + tid) * 8 + nt] = lss[tid] + lss[256 + tid];
    __syncthreads();
}

struct WoHook {
    static constexpr bool nodma = false;
    __device__ __forceinline__ void operator()(int kt, f32x16 (&acc)[2][2]) const {
        if (kt == 4 || kt == 8) {
            const float* fac = (const float*)(smem + LDS_AUX) + (kt == 4 ? 0 : 256);
            const int tid = opaque_tid(), w = tid >> 6, l = tid & 63, hh = l >> 5, wm = w >> 1;
#pragma unroll
            for (int i = 0; i < 2; ++i)
#pragma unroll
                for (int rr = 0; rr < 16; ++rr) {
                    float f = fac[wm * 64 + i * 32 + (rr & 3) + 8 * (rr >> 2) + 4 * hh];
                    acc[i][0][rr] *= f; acc[i][1][rr] *= f;
                }
        }
    }
};

__device__ __forceinline__ void phase_wo(const Params& P, int L, int hsel, float* ss_out) {
    char* ws = opq(P.ws);
    bf16* hb_out = (bf16*)(ws + (hsel ? OFF_HB1 : OFF_HB0));
    const float* hin = (L == 0) ? opq(P.x) : (const float*)opq(P.out);
    float* hout = opq(P.out);
    const bf16* Y = (const bf16*)(ws + OFF_Y);
    const bf16* Bt = (const bf16*)(ws + OFF_WO) + (size_t)L * 1024 * LDH;
    const float* ssy = (const float*)(ws + OFF_SSY) + (size_t)L * TOK * 16;
    float* aux = (float*)(smem + LDS_AUX);
    const int tid = opaque_tid(), w = tid >> 6, l = tid & 63, hh = l >> 5, wm = w >> 1, wn = w & 1;
    for (int it = 0;; ++it) {
        int mt, nt;
        if (!xcd_tile(it, 64, 8, mt, nt)) break;
        int m0 = mt * 256, n0 = nt * 128;
        __syncthreads();
        if (tid < 256) {
            int row = m0 + tid;
            float4 v0 = *(const float4*)(ssy + (size_t)row * 16), v1 = *(const float4*)(ssy + (size_t)row * 16 + 4), v2 = *(const float4*)(ssy + (size_t)row * 16 + 8);
            float r0 = rsqrtf(((v0.x + v0.y) + (v0.z + v0.w)) * (1.f / 256.f) + EPSF);
            float r1 = rsqrtf(((v1.x + v1.y) + (v1.z + v1.w)) * (1.f / 256.f) + EPSF);
            float r2 = rsqrtf(((v2.x + v2.y) + (v2.z + v2.w)) * (1.f / 512.f) + EPSF);
            aux[tid] = r0 / r1; aux[256 + tid] = r1 / r2; aux[512 + tid] = r2;
        }
        f32x16 acc[2][2];
        ZERO_ACC(acc);
        gemm_core(acc, Y, LDH, Bt, LDH, 1024, m0, n0, WoHook());
        stage_f32<true>(acc, aux + 512);
        residual_store(hin, hout, hb_out, ss_out, m0, n0, nt);
    }
}

__device__ __forceinline__ void phase_pq(const Params& P, int L, int hsel, const float* ssrow, int fake = 0) {
    char* ws = opq(P.ws);
    const bf16* hb = (const bf16*)(ws + (hsel ? OFF_HB1 : OFF_HB0));
    const bf16* Bt = (const bf16*)(ws + OFF_WQ) + (size_t)L * 1024 * LDH;
    bf16* pq = (bf16*)(ws + (fake ? OFF_PART : OFF_PQ));
    const int tid = opaque_tid(), w = tid >> 6, l = tid & 63, hh = l >> 5, wm = w >> 1, wn = w & 1;
    for (int it = 0;; ++it) {
        int mt, nt;
        if (!xcd_tile(it, 64, 8, mt, nt)) break;
        int m0 = mt * 256, n0 = nt * 128;
        f32x16 acc[2][2];
        ZERO_ACC(acc);
        float* aux = (float*)(smem + LDS_AUX);
        if (tid < 256) aux[tid] = row_rs8(ssrow, m0 + tid);
        if (fake & 4) gemm_core(acc, hb, LDH, Bt, LDH, 1024, 0, 0, NoDmaHook());
        else gemm_core(acc, hb, LDH, Bt, LDH, 1024, (fake & 1) ? 0 : m0, (fake & 2) ? 0 : n0, NoHook());
        if (fake & 8) {
#pragma unroll
            for (int i = 0; i < 2; ++i)
#pragma unroll
                for (int j = 0; j < 2; ++j) asm volatile("" :: "v"(acc[i][j]));
            continue;
        }
        stage_bf16<true>(acc, aux);
        store_rows_bf16(pq, 1024, m0, ColAdd{n0});
        __syncthreads();
    }
}

__device__ __forceinline__ void cswap(int& a, int& b) { int mx = max(a, b), mn = min(a, b); a = mx; b = mn; }
__device__ __forceinline__ void bitonic_sort16(int (&v)[16]) {
#pragma unroll
    for (int k = 2; k <= 16; k <<= 1)
#pragma unroll
        for (int j = k >> 1; j > 0; j >>= 1)
#pragma unroll
            for (int i = 0; i < 16; ++i) {
                int q = i ^ j;
                if (q > i) {
                    if ((i & k) == 0) cswap(v[i], v[q]); else cswap(v[q], v[i]);
                }
            }
}
__device__ __forceinline__ void merge_top16(int (&Lv)[16], const int (&Rv)[16]) {
#pragma unroll
    for (int i = 0; i < 16; ++i) Lv[i] = max(Lv[i], Rv[15 - i]);
#pragma unroll
    for (int j = 8; j > 0; j >>= 1)
#pragma unroll
        for (int i = 0; i < 16; ++i) {
            int q = i ^ j;
            if (q > i) cswap(Lv[i], Lv[q]);
        }
}
__device__ __forceinline__ int f2key(float v, int low, int mask) {
    int b = __float_as_int(v);
    b ^= (b >> 31) & 0x7fffffff;
    return (b & ~mask) | low;
}
__device__ __forceinline__ float key2f(int k, int mask) {
    int b = k & ~mask;
    b ^= (b >> 31) & 0x7fffffff;
    return __int_as_float(b);
}

__device__ __forceinline__ int partner32(int v, int hh) {
    int a = v, b = v;
    asm volatile("s_nop 1\n\tv_permlane32_swap_b32 %0, %1\n\ts_nop 1" : "+v"(a), "+v"(b));
    return hh ? a : b;
}
__device__ __forceinline__ void phase_topk(const Params& P, int L) {
    char* ws = opq(P.ws);
    const bf16* pq = (const bf16*)(ws + OFF_PQ);
    const bf16* skb = (const bf16*)(ws + OFF_SKB) + (size_t)L * 16 * 128 * 64;
    unsigned short* ids = (unsigned short*)(ws + OFF_IDS);
    float* gates = (float*)(ws + OFF_GATE);
    const int tid = opaque_tid(), w = tid >> 6, l = tid & 63, r = l & 31, hh = l >> 5;
    unsigned char* lidx = (unsigned char*)(smem + w * 1024 + r * 32);
    for (int task = blockIdx.x * NW + w; task < (TOK / 32) * 8; task += gridDim.x * NW) {
        const int t0 = (task >> 3) * 32, h = task & 7;
        int F[2][16];
#pragma unroll
        for (int p = 0; p < 2; ++p) {
            const int hp = h * 2 + p;
            f32x16 acc[4];
            const f32x16 z16 = {0.f, 0.f, 0.f, 0.f, 0.f, 0.f, 0.f, 0.f, 0.f, 0.f, 0.f, 0.f, 0.f, 0.f, 0.f, 0.f};
#pragma unroll
            for (int kt = 0; kt < 4; ++kt) acc[kt] = z16;
#pragma unroll
            for (int s4 = 0; s4 < 4; ++s4) {
                bf16x8 bfr = *(const bf16x8*)(pq + (size_t)(t0 + r) * 1024 + hp * 64 + 16 * s4 + 8 * hh);
#pragma unroll
                for (int kt = 0; kt < 4; ++kt) {
                    bf16x8 af = *(const bf16x8*)(skb + ((size_t)hp * 128 + 32 * kt + r) * 64 + 16 * s4 + 8 * hh);
                    acc[kt] = __builtin_amdgcn_mfma_f32_32x32x16_bf16(af, bfr, acc[kt], 0, 0, 0);
                }
            }
            int K0[16], K1[16], K2[16], K3[16];
#pragma unroll
            for (int rr = 0; rr < 16; ++rr) {
                const int nb = (rr & 3) + 8 * (rr >> 2) + 4 * hh;
                K0[rr] = f2key(acc[0][rr], 127 - nb, 127);
                K1[rr] = f2key(acc[1][rr], 127 - (32 + nb), 127);
                K2[rr] = f2key(acc[2][rr], 127 - (64 + nb), 127);
                K3[rr] = f2key(acc[3][rr], 127 - (96 + nb), 127);
            }
            bitonic_sort16(K0); bitonic_sort16(K1); bitonic_sort16(K2); bitonic_sort16(K3);
            merge_top16(K0, K1);
            merge_top16(K2, K3);
            merge_top16(K0, K2);
#pragma unroll
            for (int i = 0; i < 16; ++i) K1[i] = partner32(K0[i], hh);
            merge_top16(K0, K1);
#pragma unroll
            for (int i = 0; i < 16; ++i) F[p][i] = K0[i];
        }
        if (hh == 0) {
#pragma unroll
            for (int q = 0; q < 4; ++q) {
                unsigned w1 = 0, w2 = 0;
#pragma unroll
                for (int e = 0; e < 4; ++e) {
                    w1 |= (unsigned)(127 - (F[0][4 * q + e] & 127)) << (8 * e);
                    w2 |= (unsigned)(127 - (F[1][4 * q + e] & 127)) << (8 * e);
                }
                ((unsigned*)lidx)[q] = w1;
                ((unsigned*)lidx)[4 + q] = w2;
            }
        }
        {
            float s1[16], s2[16];
#pragma unroll
            for (int i = 0; i < 16; ++i) { s1[i] = key2f(F[0][i], 127); s2[i] = key2f(F[1][i], 127); }
            int Lc[16], X[16];
#pragma unroll
            for (int b2 = 0; b2 < 16; ++b2) Lc[b2] = f2key(s1[0] + s2[b2], 255 - b2, 255);
#pragma unroll
            for (int a2 = 1; a2 < 16; ++a2) X[a2 - 1] = f2key(s1[a2] + s2[0], 255 - a2 * 16, 255);
            X[15] = INT_MIN;
            merge_top16(Lc, X);
            X[0] = f2key(s1[1] + s2[1], 255 - 17, 255); X[1] = f2key(s1[1] + s2[2], 255 - 18, 255); X[2] = f2key(s1[1] + s2[3], 255 - 19, 255);
            X[3] = f2key(s1[1] + s2[4], 255 - 20, 255); X[4] = f2key(s1[1] + s2[5], 255 - 21, 255); X[5] = f2key(s1[1] + s2[6], 255 - 22, 255);
            X[6] = f2key(s1[1] + s2[7], 255 - 23, 255);
            X[7] = f2key(s1[2] + s2[1], 255 - 33, 255); X[8] = f2key(s1[2] + s2[2], 255 - 34, 255); X[9] = f2key(s1[2] + s2[3], 255 - 35, 255);
            X[10] = f2key(s1[2] + s2[4], 255 - 36, 255);
            X[11] = f2key(s1[3] + s2[1], 255 - 49, 255); X[12] = f2key(s1[3] + s2[2], 255 - 50, 255); X[13] = f2key(s1[3] + s2[3], 255 - 51, 255);
            X[14] = f2key(s1[4] + s2[1], 255 - 65, 255); X[15] = f2key(s1[4] + s2[2], 255 - 66, 255);
            bitonic_sort16(X);
            merge_top16(Lc, X);
            X[0] = f2key(s1[5] + s2[1], 255 - 81, 255);
            X[1] = f2key(s1[6] + s2[1], 255 - 97, 255);
            X[2] = f2key(s1[7] + s2[1], 255 - 113, 255);
#pragma unroll
            for (int i = 3; i < 16; ++i) X[i] = INT_MIN;
            merge_top16(Lc, X);
            if (hh == 0) {
                float mx = key2f(Lc[0], 255);
                float ev[16], sum = 0.f;
#pragma unroll
                for (int k = 0; k < 16; ++k) { ev[k] = __expf(key2f(Lc[k], 255) - mx); sum += ev[k]; }
                float inv = 1.f / sum;
                size_t ob = (size_t)(t0 + r) * 128 + h * 16;
                unsigned idw[8];
#pragma unroll
                for (int k = 0; k < 16; ++k) {
                    int cidx = 255 - (Lc[k] & 255);
                    int i1 = lidx[cidx >> 4], i2 = lidx[16 + (cidx & 15)];
                    unsigned idv = (unsigned)(i1 * 128 + i2);
                    if (k & 1) idw[k >> 1] |= idv << 16; else idw[k >> 1] = idv;
                }
                u32x4 o0 = {idw[0], idw[1], idw[2], idw[3]}, o1 = {idw[4], idw[5], idw[6], idw[7]};
                *(u32x4*)(ids + ob) = o0;
                *(u32x4*)(ids + ob + 8) = o1;
#pragma unroll
                for (int q = 0; q < 4; ++q) {
                    f32x4 g4 = {ev[4 * q] * inv, ev[4 * q + 1] * inv, ev[4 * q + 2] * inv, ev[4 * q + 3] * inv};
                    *(f32x4*)(gates + ob + 4 * q) = g4;
                }
            }
        }
    }
}

__device__ __forceinline__ float gelu_exact(float x) { return 0.5f * x * (1.f + erff(x * 0.70710678118654752f)); }

__device__ __forceinline__ void dec16(const u32x4& v, float (&f)[16]) {
    f32x2 t;
    t = __builtin_amdgcn_cvt_pk_f32_fp8((int)v.x, false); f[0] = t.x; f[1] = t.y;
    t = __builtin_amdgcn_cvt_pk_f32_fp8((int)v.x, true);  f[2] = t.x; f[3] = t.y;
    t = __builtin_amdgcn_cvt_pk_f32_fp8((int)v.y, false); f[4] = t.x; f[5] = t.y;
    t = __builtin_amdgcn_cvt_pk_f32_fp8((int)v.y, true);  f[6] = t.x; f[7] = t.y;
    t = __builtin_amdgcn_cvt_pk_f32_fp8((int)v.z, false); f[8] = t.x; f[9] = t.y;
    t = __builtin_amdgcn_cvt_pk_f32_fp8((int)v.z, true);  f[10] = t.x; f[11] = t.y;
    t = __builtin_amdgcn_cvt_pk_f32_fp8((int)v.w, false); f[12] = t.x; f[13] = t.y;
    t = __builtin_amdgcn_cvt_pk_f32_fp8((int)v.w, true);  f[14] = t.x; f[15] = t.y;
}

__device__ __forceinline__ void dec32(const u32x4& v, f32x2 (&f)[16]) {
    f[0] = __builtin_amdgcn_cvt_scalef32_pk_f32_fp4(v.x, 1.0f, 0); f[1] = __builtin_amdgcn_cvt_scalef32_pk_f32_fp4(v.x, 1.0f, 1);
    f[2] = __builtin_amdgcn_cvt_scalef32_pk_f32_fp4(v.x, 1.0f, 2); f[3] = __builtin_amdgcn_cvt_scalef32_pk_f32_fp4(v.x, 1.0f, 3);
    f[4] = __builtin_amdgcn_cvt_scalef32_pk_f32_fp4(v.y, 1.0f, 0); f[5] = __builtin_amdgcn_cvt_scalef32_pk_f32_fp4(v.y, 1.0f, 1);
    f[6] = __builtin_amdgcn_cvt_scalef32_pk_f32_fp4(v.y, 1.0f, 2); f[7] = __builtin_amdgcn_cvt_scalef32_pk_f32_fp4(v.y, 1.0f, 3);
    f[8] = __builtin_amdgcn_cvt_scalef32_pk_f32_fp4(v.z, 1.0f, 0); f[9] = __builtin_amdgcn_cvt_scalef32_pk_f32_fp4(v.z, 1.0f, 1);
    f[10] = __builtin_amdgcn_cvt_scalef32_pk_f32_fp4(v.z, 1.0f, 2); f[11] = __builtin_amdgcn_cvt_scalef32_pk_f32_fp4(v.z, 1.0f, 3);
    f[12] = __builtin_amdgcn_cvt_scalef32_pk_f32_fp4(v.w, 1.0f, 0); f[13] = __builtin_amdgcn_cvt_scalef32_pk_f32_fp4(v.w, 1.0f, 1);
    f[14] = __builtin_amdgcn_cvt_scalef32_pk_f32_fp4(v.w, 1.0f, 2); f[15] = __builtin_amdgcn_cvt_scalef32_pk_f32_fp4(v.w, 1.0f, 3);
}

__device__ __forceinline__ int idof16(const u32x4 (&q)[2], int i) {
    unsigned wv = (i >> 1) == 0 ? q[0].x : (i >> 1) == 1 ? q[0].y : (i >> 1) == 2 ? q[0].z : (i >> 1) == 3 ? q[0].w
                : (i >> 1) == 4 ? q[1].x : (i >> 1) == 5 ? q[1].y : (i >> 1) == 6 ? q[1].z : q[1].w;
    return (i & 1) ? (int)(wv >> 16) : (int)(wv & 0xffffu);
}
__device__ __forceinline__ void phase_gather_u(const Params& P, int L) {
    char* ws = opq(P.ws);
    const unsigned char* U4 = (const unsigned char*)(ws + OFF_UB) + (size_t)L * NEXP * 512;
    float* part = (float*)(ws + OFF_PART);
    const unsigned short* ids = (const unsigned short*)(ws + OFF_IDS);
    const float* hin = opq(P.out);
    const int tid = opaque_tid(), w = tid >> 6, l = tid & 63, c = l & 7, gq = l >> 3;
    const int sl = blockIdx.x & 3, par = (blockIdx.x >> 2) & 1, rk = blockIdx.x >> 3, nb = gridDim.x >> 3;
    if (rk >= nb) return;
    const unsigned char* ubase = U4 + (size_t)sl * NEXP * 128 + c * 16;
    const int stride = nb * NW;
    int ti = rk * NW + w;
    if (ti >= TOK / 2) return;
    u32x4 idA[2], idB[2];
    u32x4 rv[16];
    f32x4 hA[8], hB[8];
    auto load_ids = [&](int tt, u32x4 (&idq)[2]) {
        const u32x4* i4 = (const u32x4*)(ids + (size_t)tt * 128 + 16 * gq);
        idq[0] = i4[0]; idq[1] = i4[1];
    };
    auto load_hx = [&](int tt, f32x4 (&hx)[8]) {
        const f32x4* h4 = (const f32x4*)(hin + (size_t)tt * 1024 + 256 * sl + 32 * c);
#pragma unroll
        for (int q = 0; q < 8; ++q) hx[q] = h4[q];
    };
    auto step = [&](int tcur, int tnext, int tnext2, const u32x4 (&idn)[2], u32x4 (&idl)[2], const f32x4 (&hc)[8], f32x4 (&hn)[8]) {
        load_ids(tnext2, idl);
        load_hx(tnext, hn);
        __builtin_amdgcn_sched_barrier(0);
        float pr[16];
#pragma unroll
        for (int i = 0; i < 16; ++i) {
            f32x2 f[16];
            asm volatile("" : "+v"(rv[i].x), "+v"(rv[i].y), "+v"(rv[i].z), "+v"(rv[i].w));
            dec32(rv[i], f);
            rv[i] = *(const u32x4*)(ubase + (size_t)idof16(idn, i) * 128);
            __builtin_amdgcn_sched_barrier(0);
            f32x2 s2 = {0.f, 0.f};
#pragma unroll
            for (int q = 0; q < 8; ++q) {
                f32x2 x0 = {hc[q].x, hc[q].y}, x1 = {hc[q].z, hc[q].w};
                s2 = __builtin_elementwise_fma(f[2 * q], x0, s2);
                s2 = __builtin_elementwise_fma(f[2 * q + 1], x1, s2);
            }
            float sacc = s2.x + s2.y;
            asm volatile("" : "+v"(sacc));
            pr[i] = sacc;
        }
#pragma unroll
        for (int i = 0; i < 16; ++i) pr[i] = sum8_dpp(pr[i]);
        if (c == 0) {
            f32x4* o4 = (f32x4*)(part + ((size_t)sl * TOK + tcur) * 128 + 16 * gq);
#pragma unroll
            for (int q = 0; q < 4; ++q) { f32x4 o = {pr[4 * q], pr[4 * q + 1], pr[4 * q + 2], pr[4 * q + 3]}; o4[q] = o; }
        }
    };
    auto tok = [&](int tidx, int fb) { return 2 * (tidx < TOK / 2 ? tidx : fb) + par; };
    load_ids(tok(ti, ti), idA);
#pragma unroll
    for (int i = 0; i < 16; ++i) rv[i] = *(const u32x4*)(ubase + (size_t)idof16(idA, i) * 128);
    load_hx(tok(ti, ti), hA);
    load_ids(tok(ti + stride, ti), idB);
    for (;;) {
        int tn = ti + stride, tn2 = ti + 2 * stride;
        step(tok(ti, ti), tok(tn, ti), tok(tn2, ti), idB, idA, hA, hB);
        if (tn >= TOK / 2) break;
        ti = tn; tn = ti + stride; tn2 = ti + 2 * stride;
        step(tok(ti, ti), tok(tn, ti), tok(tn2, ti), idA, idB, hB, hA);
        if (tn >= TOK / 2) break;
        ti = tn;
    }
}

__device__ __forceinline__ void phase_gather_act(const Params& P, int L, const float* ss_ffn) {
    char* ws = opq(P.ws);
    const float* part = (const float*)(ws + OFF_PART);
    const unsigned short* ids = (const unsigned short*)(ws + OFF_IDS);
    float* gates = (float*)(ws + OFF_GATE);
    const float* uinv = (const float*)(ws + OFF_TSC) + L * NEXP;
    const float* vinv = (const float*)(ws + OFF_TSC) + (2 + L) * NEXP;
    const int tid = opaque_tid(), w = tid >> 6, l = tid & 63;
    for (int t = blockIdx.x * NW + w; t < TOK; t += gridDim.x * NW) {
        float rs = row_rs8(ss_ffn, t);
#pragma unroll
        for (int hsel = 0; hsel < 2; ++hsel) {
            int k = l + 64 * hsel;
            float sacc = 0.f;
#pragma unroll
            for (int j = 0; j < 4; ++j) sacc += part[((size_t)j * TOK + t) * 128 + k];
            int id = ids[(size_t)t * 128 + k];
            float pre = sacc * rs * uinv[id];
            gates[(size_t)t * 128 + k] = gates[(size_t)t * 128 + k] * gelu_exact(pre) * vinv[id];
        }
    }
}

__device__ __forceinline__ void phase_gather_v(const Params& P, int L, int hsel, float* ss_ple) {
    char* ws = opq(P.ws);
    bf16* hb_out = (bf16*)(ws + (hsel ? OFF_HB1 : OFF_HB0));
    const unsigned char* V4 = (const unsigned char*)(ws + OFF_VB) + (size_t)L * NEXP * 512;
    const unsigned short* ids = (const unsigned short*)(ws + OFF_IDS);
    const float* act = (const float*)(ws + OFF_GATE);
    float* hio = opq(P.out);
    const int tid = opaque_tid(), w = tid >> 6, l = tid & 63, c = l & 7, gq = l >> 3;
    const int sl = blockIdx.x & 3, par = (blockIdx.x >> 2) & 1, rk = blockIdx.x >> 3, nb = gridDim.x >> 3;
    if (rk >= nb) return;
    const unsigned char* vbase = V4 + (size_t)sl * NEXP * 128 + c * 16;
    const int stride = nb * NW;
    int ti = rk * NW + w;
    if (ti >= TOK / 2) return;
    const bool b3 = (l >> 3) & 1;
    u32x4 idA[2], idB[2];
    u32x4 rv[16];
    f32x4 aA[4], aB[4];
    auto load_ids = [&](int tt, u32x4 (&idq)[2]) {
        const u32x4* i4 = (const u32x4*)(ids + (size_t)tt * 128 + 16 * gq);
        idq[0] = i4[0]; idq[1] = i4[1];
    };
    auto load_a = [&](int tt, f32x4 (&ax)[4]) {
        const f32x4* a4 = (const f32x4*)(act + (size_t)tt * 128 + 16 * gq);
#pragma unroll
        for (int q = 0; q < 4; ++q) ax[q] = a4[q];
    };
    auto step = [&](int tcur, int tnext, int tnext2, const u32x4 (&idn)[2], u32x4 (&idl)[2], const f32x4 (&ac)[4], f32x4 (&an)[4]) {
        load_ids(tnext2, idl);
        load_a(tnext, an);
        __builtin_amdgcn_sched_barrier(0);
        f32x2 acc[16];
#pragma unroll
        for (int e = 0; e < 16; ++e) { acc[e].x = 0.f; acc[e].y = 0.f; }
#pragma unroll
        for (int i = 0; i < 16; ++i) {
            f32x2 f[16];
            asm volatile("" : "+v"(rv[i].x), "+v"(rv[i].y), "+v"(rv[i].z), "+v"(rv[i].w));
            dec32(rv[i], f);
            rv[i] = *(const u32x4*)(vbase + (size_t)idof16(idn, i) * 128);
            __builtin_amdgcn_sched_barrier(0);
            const float a = (i & 3) == 0 ? ac[i >> 2].x : (i & 3) == 1 ? ac[i >> 2].y : (i & 3) == 2 ? ac[i >> 2].z : ac[i >> 2].w;
            const f32x2 a2 = {a, a};
#pragma unroll
            for (int e = 0; e < 16; ++e) acc[e] = __builtin_elementwise_fma(f[e], a2, acc[e]);
#pragma unroll
            for (int e = 0; e < 16; ++e) asm volatile("" : "+v"(acc[e]));
        }
        float v8[8][2];
#pragma unroll
        for (int e = 0; e < 8; ++e) {
            float k0 = b3 ? acc[8 + e].x : acc[e].x, k1 = b3 ? acc[8 + e].y : acc[e].y;
            float s0 = b3 ? acc[e].x : acc[8 + e].x, s1 = b3 ? acc[e].y : acc[8 + e].y;
            v8[e][0] = k0 + __builtin_bit_cast(float, __builtin_amdgcn_update_dpp(0, __builtin_bit_cast(int, s0), 0x128, 0xf, 0xf, true));
            v8[e][1] = k1 + __builtin_bit_cast(float, __builtin_amdgcn_update_dpp(0, __builtin_bit_cast(int, s1), 0x128, 0xf, 0xf, true));
        }
        float v4[8];
#pragma unroll
        for (int e = 0; e < 8; ++e) {
            float X = v8[e >> 1][e & 1], Y = v8[4 + (e >> 1)][e & 1];
            asm volatile("s_nop 1\n\tv_permlane16_swap_b32 %0, %1\n\ts_nop 1" : "+v"(X), "+v"(Y));
            v4[e] = X + Y;
        }
        float v2[4];
#pragma unroll
        for (int e = 0; e < 4; ++e) {
            float X = v4[e], Y = v4[4 + e];
            asm volatile("s_nop 1\n\tv_permlane32_swap_b32 %0, %1\n\ts_nop 1" : "+v"(X), "+v"(Y));
            v2[e] = X + Y;
        }
        const int col = 256 * sl + 32 * c + 16 * ((l >> 3) & 1) + 8 * ((l >> 4) & 1) + 4 * (l >> 5);
        f32x4* h4 = (f32x4*)(hio + (size_t)tcur * 1024 + col);
        f32x4 hv = *h4;
        hv.x += v2[0]; hv.y += v2[1]; hv.z += v2[2]; hv.w += v2[3];
        *h4 = hv;
        u32x2 bb = {pack2(hv.x, hv.y), pack2(hv.z, hv.w)};
        *(u32x2*)(hb_out + (size_t)tcur * LDH + col) = bb;
        float ssq = hv.x * hv.x + hv.y * hv.y + hv.z * hv.z + hv.w * hv.w;
        ssq = wave_sum(ssq);
        if (l == 0) { ss_ple[(size_t)tcur * 8 + sl] = ssq; ss_ple[(size_t)tcur * 8 + 4 + sl] = 0.f; }
    };
    auto tok = [&](int tidx, int fb) { return 2 * (tidx < TOK / 2 ? tidx : fb) + par; };
    load_ids(tok(ti, ti), idA);
#pragma unroll
    for (int i = 0; i < 16; ++i) rv[i] = *(const u32x4*)(vbase + (size_t)idof16(idA, i) * 128);
    load_a(tok(ti, ti), aA);
    load_ids(tok(ti + stride, ti), idB);
    for (;;) {
        int tn = ti + stride, tn2 = ti + 2 * stride;
        step(tok(ti, ti), tok(tn, ti), tok(tn2, ti), idB, idA, aA, aB);
        if (tn >= TOK / 2) break;
        ti = tn; tn = ti + stride; tn2 = ti + 2 * stride;
        step(tok(ti, ti), tok(tn, ti), tok(tn2, ti), idA, idB, aB, aA);
        if (tn >= TOK / 2) break;
        ti = tn;
    }
}

__device__ __forceinline__ void phase_ple(const Params& P, int L, int hsel, const float* ss_ple, float* ss_out) {
    char* ws = opq(P.ws);
    const bf16* hb_in = (const bf16*)(ws + (hsel ? OFF_HB1 : OFF_HB0));
    bf16* hb_out = (bf16*)(ws + (hsel ? OFF_HB0 : OFF_HB1));
    float* hio = opq(P.out);
    const bf16* pin = (const bf16*)(ws + OFF_PB) + (size_t)L * TOK * LDP;
    const bf16* Wg = (const bf16*)(ws + OFF_WG) + (size_t)L * 1024 * LDH;
    const bf16* Wp = (const bf16*)(ws + OFF_WP) + (size_t)L * 1024 * LDP;
    const int tid = opaque_tid(), w = tid >> 6, l = tid & 63, hh = l >> 5, wm = w >> 1, wn = w & 1;
    for (int it = 0;; ++it) {
        int mt, nt;
        if (!xcd_tile(it, 64, 8, mt, nt)) break;
        int m0 = mt * 256, n0 = nt * 128;
        float* aux = (float*)(smem + LDS_AUX);
        __syncthreads();
        if (tid < 256) aux[tid] = row_rs8(ss_ple, m0 + tid);
        f32x16 acc1[2][2], acc2[2][2];
        ZERO_ACC(acc1);
        ZERO_ACC(acc2);
        gemm_core(acc1, hb_in, LDH, Wg, LDH, 1024, m0, n0, NoHook());
        gemm_core(acc2, pin, LDP, Wp, LDP, 256, m0, n0, NoHook());
#pragma unroll
        for (int i = 0; i < 2; ++i)
#pragma unroll
            for (int rr = 0; rr < 16; ++rr) {
                float rs = aux[wm * 64 + i * 32 + (rr & 3) + 8 * (rr >> 2) + 4 * hh];
#pragma unroll
                for (int j = 0; j < 2; ++j) {
                    float gte = 1.f / (1.f + __expf(-acc1[i][j][rr] * rs));
                    acc2[i][j][rr] *= gte;
                }
            }
        stage_f32<false>(acc2, nullptr);
        residual_store(hio, hio, hb_out, ss_out, m0, n0, nt);
    }
}

__device__ __forceinline__ void phase_final(const Params& P, const float* ss) {
    float* hio = opq(P.out);
    const int tid = opaque_tid(), w = tid >> 6, l = tid & 63;
    const float4* g4 = (const float4*)P.final_norm_g;
    for (int t = blockIdx.x * NW + w; t < TOK; t += gridDim.x * NW) {
        float rs = row_rs8(ss, t);
        float4* o4 = (float4*)(hio + (size_t)t * 1024);
#pragma unroll
        for (int i = 0; i < 4; ++i) {
            float4 v = o4[i * 64 + l], g = g4[i * 64 + l];
            v.x *= rs * g.x; v.y *= rs * g.y; v.z *= rs * g.z; v.w *= rs * g.w;
            o4[i * 64 + l] = v;
        }
    }
}

#define XB_TMO      128
#define XB_XCNT(j)  (256  + 64 * (j))
#define XB_XSUB(j)  (1280 + 64 * (j))
#define XB_XGEN(j)  (2304 + 64 * (j))
#define XB_TOP      3328
#define XB_TOPGEN   3392
#define XCD_BAR_WORDS 3456
#define XB_SPIN_CAP (1u << 22)
__device__ __forceinline__ unsigned xb_ld(unsigned* p) { return __hip_atomic_load(p, __ATOMIC_RELAXED, __HIP_MEMORY_SCOPE_AGENT); }
__device__ __forceinline__ unsigned xb_add(unsigned* p, unsigned v) { return __hip_atomic_fetch_add(p, v, __ATOMIC_RELAXED, __HIP_MEMORY_SCOPE_AGENT); }
__device__ __forceinline__ unsigned xb_xcc_id() { return (unsigned)__builtin_amdgcn_s_getreg((3 << 11) | 20) & 0xFu; }
#define XB_SPIN(cond, bar) do { unsigned _sp = 0; while (cond) { __builtin_amdgcn_s_sleep(1); \
    if ((++_sp & 255u) == 0u) { if (xb_ld(&(bar)[XB_TMO])) break; if (_sp > XB_SPIN_CAP) { atomicAdd(&(bar)[XB_TMO], 1u); break; } } } } while (0)
struct XcdBarrier { unsigned* bar; unsigned x, nloc, nx; };
__device__ __forceinline__ XcdBarrier xcd_barrier_post(unsigned* bar) {
    XcdBarrier b; b.bar = bar; b.x = xb_xcc_id(); b.nloc = 0u; b.nx = 0u;
    if (threadIdx.x == 0) (void)xb_add(&bar[XB_XCNT(b.x)], 1u);
    return b;
}
__device__ __forceinline__ void xcd_barrier_complete(unsigned* bar, unsigned x, unsigned& nloc, unsigned& nx) {
    const unsigned G = gridDim.x;
    unsigned sum, cnt, mine, sp = 0u;
    for (;;) {
        sum = 0u; cnt = 0u; mine = 0u;
#pragma unroll
        for (unsigned j = 0; j < 16; ++j) { const unsigned c = xb_ld(&bar[XB_XCNT(j)]); sum += c; cnt += (c > 0u) ? 1u : 0u; mine = (j == x) ? c : mine; }
        if (sum == G) break;
        __builtin_amdgcn_s_sleep(1);
        if ((++sp & 255u) == 0u) { if (xb_ld(&bar[XB_TMO])) break; if (sp > XB_SPIN_CAP) { atomicAdd(&bar[XB_TMO], 1u); break; } }
    }
    nloc = mine > 0u ? mine : 1u; nx = cnt > 0u ? cnt : 1u;
}
__device__ __forceinline__ void grid_barrier(XcdBarrier& b) {
    asm volatile("s_waitcnt vmcnt(0)" ::: "memory");
    __syncthreads();
    if (threadIdx.x == 0) {
        unsigned* bar = b.bar;
        __builtin_amdgcn_s_waitcnt(0);
        if (b.nloc == 0u) xcd_barrier_complete(bar, b.x, b.nloc, b.nx);
        const unsigned nloc = b.nloc, nx = b.nx;
        const unsigned old = xb_add(&bar[XB_XSUB(b.x)], 1u);
        const unsigned gen = old / nloc;
        if (old + 1u == (gen + 1u) * nloc) {
            __builtin_amdgcn_fence(__ATOMIC_RELEASE, "agent");
            asm volatile("s_waitcnt vmcnt(0)" ::: "memory");
            const unsigned og = xb_add(&bar[XB_TOP], 1u);
            const unsigned tg = og / nx;
            if (og + 1u == (tg + 1u) * nx) xb_add(&bar[XB_TOPGEN], 1u);
            else XB_SPIN(xb_ld(&bar[XB_TOPGEN]) == tg, bar);
            __builtin_amdgcn_fence(__ATOMIC_ACQUIRE, "agent");
            xb_add(&bar[XB_XGEN(b.x)], 1u);
            asm volatile("s_waitcnt vmcnt(0)" ::: "memory");
        } else {
            XB_SPIN(xb_ld(&bar[XB_XGEN(b.x)]) == gen, bar);
            __builtin_amdgcn_fence(__ATOMIC_ACQUIRE, "agent");
            asm volatile("s_waitcnt vmcnt(0)" ::: "memory");
        }
    }
    __syncthreads();
}

__global__ void __launch_bounds__(NTHR, 2) hymba_megakernel(Params P) {
    cg::grid_group grid = cg::this_grid();
    char* ws = opq(P.ws);
    float* ssa = (float*)(ws + OFF_SSA);
    XcdBarrier bar = xcd_barrier_post((unsigned*)(ws + OFF_BAR));
#define BAR() do { grid_barrier(bar); if (DUP == 20) grid_barrier(bar); } while (0)
    phase0(P);
    if (DUP == 0) { asm volatile("s_waitcnt vmcnt(0)" ::: "memory"); __syncthreads(); grid_barrier(bar); phase0(P); }
    asm volatile("s_waitcnt vmcnt(0)" ::: "memory");
    __syncthreads();
    grid.sync();
    BAR();
    int cur = 0;
    for (int L = 0; L < 2; ++L) {
        const float* ss_mix = (L == 0) ? ssa : (ssa + 3 * TOK * 8);
        float* ss_ffn = ssa + (size_t)(1 + L) * TOK * 8;
        float* ss_next = (L == 0) ? (ssa + 3 * TOK * 8) : (ssa + 4 * TOK * 8);
        float* ss_ple = ssa + (size_t)(5 + L) * TOK * 8;
        phase_proj(P, L, cur, ss_mix);
        BAR();
        if (DUP == 1) { phase_proj(P, L, cur, ss_mix); BAR(); }
        phase_mla_up(P, L);
        BAR();
        if (DUP == 2) { phase_mla_up(P, L); BAR(); }
        phase_attn(P, L, 0);
        BAR();
        if (DUP == 3) { phase_attn(P, L, 1); BAR(); }
        phase_wo(P, L, cur ^ 1, ss_ffn);
        BAR();
        if (DUP == 4 && L == 0) { phase_wo(P, L, cur ^ 1, ss_ffn); BAR(); }
        phase_pq(P, L, cur ^ 1, ss_ffn);
        BAR();
        if (DUP == 5) { phase_pq(P, L, cur ^ 1, ss_ffn); BAR(); }
        if (DUP >= 50 && DUP < 66) { phase_pq(P, L, cur ^ 1, ss_ffn, DUP - 50); BAR(); }
        phase_topk(P, L);
        BAR();
        if (DUP == 6) { phase_topk(P, L); BAR(); }
        phase_gather_u(P, L);
        BAR();
        if (DUP == 7) { phase_gather_u(P, L); BAR(); }
        phase_gather_act(P, L, ss_ffn);
        BAR();
        phase_gather_v(P, L, cur, ss_ple);
        BAR();
        phase_ple(P, L, cur, ss_ple, ss_next);
        BAR();
        cur ^= 1;
    }
    phase_final(P, ssa + 4 * TOK * 8);
}

extern "C" void kernel_launch(void* const* d_in, const int* in_sizes, int n_in, void* d_out, int out_size, void* d_ws,
                              size_t ws_size, hipStream_t stream) {
    static int grid_blocks = 0;
    if (!grid_blocks) {
        int dev = 0, cus = 0, per_cu = 0;
        hipGetDevice(&dev);
        hipDeviceGetAttribute(&cus, hipDeviceAttributeMultiprocessorCount, dev);
        hipOccupancyMaxActiveBlocksPerMultiprocessor(&per_cu, hymba_megakernel, NTHR, 0);
        if (per_cu > 1) per_cu = 1;
        if (per_cu < 1) per_cu = 1;
        grid_blocks = cus * per_cu;
        if (ws_size < WS_END) fprintf(stderr, "workspace too small: %zu < %zu\n", ws_size, (size_t)WS_END);
    }
    Params P{};
    P.x = (const float*)d_in[0]; P.p = (const float*)d_in[1]; P.pos = (const int*)d_in[2];
    P.norm_mix_g = (const float*)d_in[3]; P.w_in = (const float*)d_in[4]; P.b_forget = (const float*)d_in[5];
    P.mla_q_norm_g = (const float*)d_in[6]; P.w_uq = (const float*)d_in[7]; P.mla_kv_norm_g = (const float*)d_in[8];
    P.w_ukv = (const float*)d_in[9]; P.mix_out_norm_g = (const float*)d_in[10]; P.w_o = (const float*)d_in[11];
    P.norm_ffn_g = (const float*)d_in[12]; P.w_query = (const float*)d_in[13]; P.sub_keys = (const float*)d_in[14];
    P.peer_u = (const float*)d_in[15]; P.peer_v = (const float*)d_in[16]; P.w_ple = (const float*)d_in[17];
    P.ple_norm_g = (const float*)d_in[18]; P.w_ple_gate = (const float*)d_in[19]; P.final_norm_g = (const float*)d_in[20];
    P.out = (float*)d_out; P.ws = (char*)d_ws;
    hipMemsetAsync((char*)d_ws + OFF_BAR, 0, 16384 + 4096, stream);
    void* args[] = {&P};
    hipError_t e = hipLaunchCooperativeKernel((void*)hymba_megakernel, dim3(grid_blocks), dim3(NTHR), args, 0, stream);
    if (e != hipSuccess) fprintf(stderr, "cooperative launch failed: %s (grid %d)\n", hipGetErrorString(e), grid_blocks);
}
```

```cpp
#include <hip/hip_runtime.h>
#include <hip/hip_cooperative_groups.h>
#include <cstdio>
#include <cstdint>
#include <math.h>
#include <climits>
namespace cg = cooperative_groups;

typedef __bf16 bf16;
typedef __bf16 bf16x8 __attribute__((ext_vector_type(8)));
typedef __bf16 bf16x4 __attribute__((ext_vector_type(4)));
typedef __bf16 bf16x2 __attribute__((ext_vector_type(2)));
typedef float f32x16 __attribute__((ext_vector_type(16)));
typedef float f32x4 __attribute__((ext_vector_type(4)));
typedef float f32x2 __attribute__((ext_vector_type(2)));
typedef unsigned u32x4 __attribute__((ext_vector_type(4)));
typedef unsigned u32x2 __attribute__((ext_vector_type(2)));

#define SEQ 2048
#define BATCH 8
#define TOK 16384
#define DM 1024
#define IN_W 1956
#define NEXP 16384
#define EPSF 1e-6f
#define LOG2E 1.4426950408889634f
#define NTHR 512
#define NW 8
#define LDS_BYTES 151808
#define STAGE_BYTES 49152
#define LDS_AUX 147456
#ifndef DUP
#define DUP -1
#endif

constexpr size_t MBy = 1ull << 20;
constexpr size_t OFF_UB = 0;
constexpr size_t OFF_VB = 32 * MBy;
constexpr size_t OFF_PART = 64 * MBy;
#define LDH 1088
#define LDP 320
#define LDC 192
constexpr size_t OFF_WIN = 128 * MBy;
constexpr size_t OFF_WO = 137 * MBy;
constexpr size_t OFF_WQ = 142 * MBy;
constexpr size_t OFF_WG = 147 * MBy;
constexpr size_t OFF_WP = 152 * MBy;
constexpr size_t OFF_WUQ = 154 * MBy;
constexpr size_t OFF_WUKV = 155 * MBy;
constexpr size_t OFF_SKB = 156 * MBy;
constexpr size_t OFF_CS = 157 * MBy;
constexpr size_t OFF_TSC = 159 * MBy;
constexpr size_t OFF_SSA = 160 * MBy;
constexpr size_t OFF_HB0 = 164 * MBy;
constexpr size_t OFF_HB1 = 200 * MBy;
constexpr size_t OFF_FQ = 236 * MBy;
constexpr size_t OFF_FK = 244 * MBy;
constexpr size_t OFF_FVT = 252 * MBy;
constexpr size_t OFF_SQ = 260 * MBy;
constexpr size_t OFF_SKK = 268 * MBy;
constexpr size_t OFF_SVT = 276 * MBy;
constexpr size_t OFF_CQ = 284 * MBy;
constexpr size_t OFF_CKV = 295 * MBy;
constexpr size_t OFF_FLOG = 302 * MBy;
constexpr size_t OFF_CUMF = 303 * MBy;
constexpr size_t OFF_MQ = 304 * MBy;
constexpr size_t OFF_MK = 316 * MBy;
constexpr size_t OFF_MVT = 328 * MBy;
constexpr size_t OFF_Y = 344 * MBy;
constexpr size_t OFF_PQ = 380 * MBy;
constexpr size_t OFF_IDS = 412 * MBy;
constexpr size_t OFF_GATE = 420 * MBy;
constexpr size_t OFF_BAR = 428 * MBy;
constexpr size_t OFF_CNT = OFF_BAR + 16384;
constexpr size_t OFF_SSY = 429 * MBy;
constexpr size_t OFF_PB = 431 * MBy;
constexpr size_t WS_END = 452 * MBy;

struct Params {
    const float* x; const float* p; const int* pos;
    const float* norm_mix_g; const float* w_in; const float* b_forget; const float* mla_q_norm_g; const float* w_uq;
    const float* mla_kv_norm_g; const float* w_ukv; const float* mix_out_norm_g; const float* w_o; const float* norm_ffn_g;
    const float* w_query; const float* sub_keys; const float* peer_u; const float* peer_v; const float* w_ple;
    const float* ple_norm_g; const float* w_ple_gate; const float* final_norm_g;
    float* out; char* ws;
};

__shared__ __attribute__((aligned(16))) char smem[LDS_BYTES];

__device__ __forceinline__ int opaque_tid() { int t = threadIdx.x; asm volatile("" : "+v"(t)); return t; }
template <typename T> __device__ __forceinline__ T* opq(T* p) { size_t z = 0; asm volatile("" : "+s"(z)); return (T*)((char*)p + z); }

__device__ __forceinline__ unsigned pack2(float a, float b) {
    f32x2 v = {a, b};
    bf16x2 r = __builtin_convertvector(v, bf16x2);
    return __builtin_bit_cast(unsigned, r);
}
__device__ __forceinline__ float bflo(unsigned u) { return __uint_as_float(u << 16); }
__device__ __forceinline__ float bfhi(unsigned u) { return __uint_as_float(u & 0xffff0000u); }
__device__ __forceinline__ float wave_sum(float v) {
#pragma unroll
    for (int o = 32; o > 0; o >>= 1) v += __shfl_xor(v, o);
    return v;
}
template <int CTRL> __device__ __forceinline__ float dpp_add(float v) {
    return v + __builtin_bit_cast(float, __builtin_amdgcn_update_dpp(0, __builtin_bit_cast(int, v), CTRL, 0xf, 0xf, true));
}
__device__ __forceinline__ float sum8_dpp(float v) { v = dpp_add<0xB1>(v); v = dpp_add<0x4E>(v); v = dpp_add<0x141>(v); return v; }
__device__ __forceinline__ float sumg_dpp(float v) {
    v = dpp_add<0x128>(v);
    float a = v, b = v;
    asm volatile("s_nop 1\n\tv_permlane16_swap_b32 %0, %1\n\ts_nop 1" : "+v"(a), "+v"(b));
    v = a + b;
    a = v; b = v;
    asm volatile("s_nop 1\n\tv_permlane32_swap_b32 %0, %1\n\ts_nop 1" : "+v"(a), "+v"(b));
    return a + b;
}
__device__ __forceinline__ int partner32(int v, int hh) {
    int a = v, b = v;
    asm volatile("s_nop 1\n\tv_permlane32_swap_b32 %0, %1\n\ts_nop 1" : "+v"(a), "+v"(b));
    return hh ? a : b;
}
__device__ __forceinline__ float fexp2(float x) { return __builtin_amdgcn_exp2f(x); }
__device__ __forceinline__ float flog2(float x) { return __builtin_amdgcn_logf(x); }
__device__ __forceinline__ float log_sigmoid_f(float z) { return fminf(z, 0.f) - log1pf(expf(-fabsf(z))); }

struct WJob { const float* src; int lds; int K; int Np; bf16* dst; int ldd; const float* gain; int map; };

__device__ __forceinline__ int src_col_map(int map, int c) {
    if (map == 0) return c;
    if (map == 1) {
        if (c < 768) return c;
        if (c < 1952) return c + 4;
        if (c < 1956) return c - 1952 + 768;
        return -1;
    }
    if (c < 256) return 192 * (c >> 6) + (c & 63);
    int e = c - 256;
    return 192 * (e >> 7) + 64 + (e & 127);
}

__device__ __forceinline__ void wconv_tile(const WJob& j, int tile) {
    float* tl = (float*)smem;
    int ktiles = j.K >> 5;
    int nt = tile / ktiles, kt = tile % ktiles;
    int n0 = nt * 32, k0 = kt * 32;
    int tx = opaque_tid() & 31, ty = opaque_tid() >> 5;
    int sc = src_col_map(j.map, n0 + tx);
#pragma unroll
    for (int i = 0; i < 2; ++i) {
        int k = k0 + ty + 16 * i;
        float v = 0.f;
        if (sc >= 0) v = j.src[(size_t)k * j.lds + sc] * (j.gain ? j.gain[k] : 1.f);
        tl[(ty + 16 * i) * 33 + tx] = v;
    }
    __syncthreads();
#pragma unroll
    for (int i = 0; i < 2; ++i) {
        int n = n0 + ty + 16 * i;
        j.dst[(size_t)n * j.ldd + k0 + tx] = (bf16)tl[tx * 33 + ty + 16 * i];
    }
    __syncthreads();
}

__device__ __forceinline__ void phase0(const Params& P) {
    char* ws = opq(P.ws);
    const int G = gridDim.x, bid = blockIdx.x, tid = opaque_tid();
    {
        const int w = tid >> 6, l = tid & 63;
        float* tsc = (float*)(ws + OFF_TSC);
        for (int it = bid * NW + w; it < 4 * NEXP; it += G * NW) {
            int tb = it >> 14, e = it & (NEXP - 1);
            const float* src = (tb < 2 ? P.peer_u : P.peer_v) + ((size_t)(tb & 1) * NEXP + e) * DM + l * 16;
            unsigned char* dst = (unsigned char*)(ws + (tb < 2 ? OFF_UB : OFF_VB)) + (size_t)(tb & 1) * NEXP * 512;
            float4 a = ((const float4*)src)[0], b = ((const float4*)src)[1], c = ((const float4*)src)[2], d = ((const float4*)src)[3];
            if (tb < 2) {
                const float4* g4 = (const float4*)(P.norm_ffn_g + (tb & 1) * 1024 + l * 16);
                float4 g0 = g4[0], g1 = g4[1], g2 = g4[2], g3 = g4[3];
                a.x *= g0.x; a.y *= g0.y; a.z *= g0.z; a.w *= g0.w; b.x *= g1.x; b.y *= g1.y; b.z *= g1.z; b.w *= g1.w;
                c.x *= g2.x; c.y *= g2.y; c.z *= g2.z; c.w *= g2.w; d.x *= g3.x; d.y *= g3.y; d.z *= g3.z; d.w *= g3.w;
            }
            float am = fmaxf(fmaxf(fmaxf(fabsf(a.x), fabsf(a.y)), fmaxf(fabsf(a.z), fabsf(a.w))), fmaxf(fmaxf(fabsf(b.x), fabsf(b.y)), fmaxf(fabsf(b.z), fabsf(b.w))));
            am = fmaxf(am, fmaxf(fmaxf(fmaxf(fabsf(c.x), fabsf(c.y)), fmaxf(fabsf(c.z), fabsf(c.w))), fmaxf(fmaxf(fabsf(d.x), fabsf(d.y)), fmaxf(fabsf(d.z), fabsf(d.w)))));
#pragma unroll
            for (int o = 32; o > 0; o >>= 1) am = fmaxf(am, __shfl_xor(am, o));
            float sc = (am > 0.f) ? (6.0f / am) : 1.f, isc = (am > 0.f) ? (am * (1.f / 6.0f)) : 1.f;
            unsigned w0 = 0, w1 = 0;
            w0 = __builtin_amdgcn_cvt_scalef32_pk_fp4_f32(w0, a.x * sc, a.y * sc, 1.0f, 0);
            w0 = __builtin_amdgcn_cvt_scalef32_pk_fp4_f32(w0, a.z * sc, a.w * sc, 1.0f, 1);
            w0 = __builtin_amdgcn_cvt_scalef32_pk_fp4_f32(w0, b.x * sc, b.y * sc, 1.0f, 2);
            w0 = __builtin_amdgcn_cvt_scalef32_pk_fp4_f32(w0, b.z * sc, b.w * sc, 1.0f, 3);
            w1 = __builtin_amdgcn_cvt_scalef32_pk_fp4_f32(w1, c.x * sc, c.y * sc, 1.0f, 0);
            w1 = __builtin_amdgcn_cvt_scalef32_pk_fp4_f32(w1, c.z * sc, c.w * sc, 1.0f, 1);
            w1 = __builtin_amdgcn_cvt_scalef32_pk_fp4_f32(w1, d.x * sc, d.y * sc, 1.0f, 2);
            w1 = __builtin_amdgcn_cvt_scalef32_pk_fp4_f32(w1, d.z * sc, d.w * sc, 1.0f, 3);
            u32x2 o2 = {w0, w1};
            *(u32x2*)(dst + ((size_t)(l >> 4) * NEXP + e) * 128 + (l & 15) * 8) = o2;
            if (l == 0) tsc[tb * NEXP + e] = isc;
        }
    }
    {
        for (int L = 0; L < 2; ++L) {
            WJob jobs[7];
            jobs[0] = {P.w_in + (size_t)L * 1024 * IN_W, IN_W, 1024, 2048, (bf16*)(ws + OFF_WIN) + (size_t)L * 2048 * LDH, LDH, P.norm_mix_g + L * 1024, 1};
            jobs[1] = {P.w_o + (size_t)L * 1024 * 1024, 1024, 1024, 1024, (bf16*)(ws + OFF_WO) + (size_t)L * 1024 * LDH, LDH, P.mix_out_norm_g + L * 1024, 0};
            jobs[2] = {P.w_query + (size_t)L * 1024 * 1024, 1024, 1024, 1024, (bf16*)(ws + OFF_WQ) + (size_t)L * 1024 * LDH, LDH, P.norm_ffn_g + L * 1024, 0};
            jobs[3] = {P.w_ple_gate + (size_t)L * 1024 * 1024, 1024, 1024, 1024, (bf16*)(ws + OFF_WG) + (size_t)L * 1024 * LDH, LDH, P.ple_norm_g + L * 1024, 0};
            jobs[4] = {P.w_ple + (size_t)L * 256 * 1024, 1024, 256, 1024, (bf16*)(ws + OFF_WP) + (size_t)L * 1024 * LDP, LDP, nullptr, 0};
            jobs[5] = {P.w_uq + (size_t)L * 256 * 384, 384, 256, 384, (bf16*)(ws + OFF_WUQ) + (size_t)L * 384 * LDP, LDP, P.mla_q_norm_g + L * 256, 0};
            jobs[6] = {P.w_ukv + (size_t)L * 128 * 768, 768, 128, 768, (bf16*)(ws + OFF_WUKV) + (size_t)L * 768 * LDC, LDC, P.mla_kv_norm_g + L * 128, 2};
#pragma unroll
            for (int q = 0; q < 7; ++q) {
                int nt = (jobs[q].Np >> 5) * (jobs[q].K >> 5);
                for (int it = bid; it < nt; it += G) wconv_tile(jobs[q], it);
            }
        }
    }
    {
        const float* src = P.sub_keys;
        bf16* dst = (bf16*)(ws + OFF_SKB);
        for (int i = bid * NTHR + tid; i < 262144 / 2; i += G * NTHR) {
            float2 v = ((const float2*)src)[i];
            ((unsigned*)dst)[i] = pack2(v.x, v.y);
        }
    }
    {
        const float4* src = (const float4*)P.p;
        bf16* dst = (bf16*)(ws + OFF_PB);
        for (int i = bid * NTHR + tid; i < 2 * TOK * 256 / 8; i += G * NTHR) {
            float4 a = src[2 * i], b = src[2 * i + 1];
            u32x4 o = {pack2(a.x, a.y), pack2(a.z, a.w), pack2(b.x, b.y), pack2(b.z, b.w)};
            *(u32x4*)(dst + (size_t)(i >> 5) * LDP + (i & 31) * 8) = o;
        }
    }
    {
        bf16* hb = (bf16*)(ws + OFF_HB0);
        float* ss0 = (float*)(ws + OFF_SSA);
        int w = tid >> 6, l = tid & 63;
        for (int row = bid * NW + w; row < TOK; row += G * NW) {
            const float4* xr = (const float4*)(P.x + (size_t)row * DM);
            float ss = 0.f;
#pragma unroll
            for (int i = 0; i < 2; ++i) {
                float4 a = xr[i * 128 + l * 2], b = xr[i * 128 + l * 2 + 1];
                ss += a.x * a.x + a.y * a.y + a.z * a.z + a.w * a.w + b.x * b.x + b.y * b.y + b.z * b.z + b.w * b.w;
                uint4 o;
                o.x = pack2(a.x, a.y); o.y = pack2(a.z, a.w); o.z = pack2(b.x, b.y); o.w = pack2(b.z, b.w);
                ((uint4*)(hb + (size_t)row * LDH))[i * 64 + l] = o;
            }
            ss = wave_sum(ss);
            if (l == 0) {
                *(float4*)(ss0 + (size_t)row * 8) = make_float4(ss, 0.f, 0.f, 0.f);
                *(float4*)(ss0 + (size_t)row * 8 + 4) = make_float4(0.f, 0.f, 0.f, 0.f);
            }
        }
    }
    {
        float* cs = (float*)(ws + OFF_CS);
        for (int i = bid * NTHR + tid; i < TOK * 16; i += G * NTHR) {
            int t = i >> 4, k = i & 15;
            float inv = powf(10000.0f, -(float)k / 16.0f);
            float ang = (float)P.pos[t] * inv;
            cs[2 * i] = cosf(ang);
            cs[2 * i + 1] = sinf(ang);
        }
    }
}

struct NoHook { static constexpr bool nodma = false; __device__ __forceinline__ void operator()(int, f32x16 (&)[2][2]) const {} };
struct NoDmaHook { static constexpr bool nodma = true; __device__ __forceinline__ void operator()(int, f32x16 (&)[2][2]) const {} };
template <typename HOOK>
__device__ __forceinline__ void gemm_core(f32x16 (&acc)[2][2], const bf16* A, int lda, const bf16* Bt, int ldb, int K,
                                          int m0, int n0, HOOK hook) {
    const int tid = opaque_tid(), w = tid >> 6, l = tid & 63, r = l & 31, hh = l >> 5;
    const int wm = w >> 1, wn = w & 1;
    const int dp = (tid & 15) ^ ((tid >> 4) & 15);
    const int drow = 2 * (tid >> 4) + (dp >> 3), dgc = (dp & 7) * 8;
    const bf16* asrc = A + (size_t)(m0 + drow) * lda + dgc;
    const bf16* bsrc = Bt + (size_t)(n0 + drow) * ldb + dgc;
    auto dma = [&](int buf, int k0) {
        if (HOOK::nodma) return;
        char* base = smem + buf * STAGE_BYTES + tid * 16;
#pragma unroll
        for (int i = 0; i < 4; ++i)
            __builtin_amdgcn_global_load_lds((const unsigned*)(asrc + (size_t)(64 * i) * lda + k0), (unsigned*)(base + i * 8192), 16, 0, 0);
#pragma unroll
        for (int i = 0; i < 2; ++i)
            __builtin_amdgcn_global_load_lds((const unsigned*)(bsrc + (size_t)(64 * i) * ldb + k0), (unsigned*)(base + 32768 + i * 8192), 16, 0, 0);
    };
    int offA[2], offB[2];
#pragma unroll
    for (int i = 0; i < 2; ++i) { offA[i] = ((wm * 64 + i * 32 + r) >> 1) * 256; offB[i] = 32768 + ((wn * 64 + i * 32 + r) >> 1) * 256; }
    const int pbase = ((r & 1) << 3), lx = (r >> 1) & 15;
    const int nk = K >> 6;
    const unsigned ldsbase = (unsigned)(size_t)(__attribute__((address_space(3))) char*)smem;
    auto ldfrag = [&](int stage, int s, bf16x8 (&af)[2], bf16x8 (&bfr)[2]) {
        unsigned ch = (unsigned)((((pbase | (2 * s + hh)) ^ lx) << 4)) + ldsbase + (unsigned)(stage * STAGE_BYTES);
        unsigned a0a = ch + offA[0], a1a = ch + offA[1], b0a = ch + offB[0], b1a = ch + offB[1];
        asm volatile("ds_read_b128 %0, %4\n\tds_read_b128 %1, %5\n\tds_read_b128 %2, %6\n\tds_read_b128 %3, %7"
                     : "=&v"(af[0]), "=&v"(af[1]), "=&v"(bfr[0]), "=&v"(bfr[1]) : "v"(a0a), "v"(a1a), "v"(b0a), "v"(b1a) : "memory");
    };
    auto mma = [&](bf16x8 (&af)[2], bf16x8 (&bfr)[2]) {
#pragma unroll
        for (int i = 0; i < 2; ++i)
#pragma unroll
            for (int j = 0; j < 2; ++j) acc[i][j] = __builtin_amdgcn_mfma_f32_32x32x16_bf16(af[i], bfr[j], acc[i][j], 0, 0, 0);
    };
#define LGKM_WAIT(n) do { asm volatile("s_waitcnt lgkmcnt(" #n ")" ::: "memory"); __builtin_amdgcn_sched_barrier(0); } while (0)
    asm volatile("s_waitcnt vmcnt(0)" ::: "memory");
    dma(0, 0);
    dma(1, 64);
    if (nk > 2) { dma(2, 128); asm volatile("s_waitcnt vmcnt(12)" ::: "memory"); }
    else asm volatile("s_waitcnt vmcnt(6)" ::: "memory");
    __builtin_amdgcn_s_barrier();
    bf16x8 a0[2], b0[2], a1[2], b1[2];
    ldfrag(0, 0, a0, b0);
    int cur = 0;
    for (int kt = 0; kt < nk; ++kt) {
        const int nxt = (cur == 2) ? 0 : cur + 1;
        if (kt == 4 || kt == 8) { LGKM_WAIT(0); hook(kt, acc); }
        ldfrag(cur, 1, a1, b1);
        LGKM_WAIT(4);
        mma(a0, b0);
        ldfrag(cur, 2, a0, b0);
        LGKM_WAIT(4);
        mma(a1, b1);
        ldfrag(cur, 3, a1, b1);
        LGKM_WAIT(4);
        mma(a0, b0);
        if (kt + 1 < nk) {
            if (kt + 2 < nk) asm volatile("s_waitcnt vmcnt(6) lgkmcnt(0)" ::: "memory");
            else asm volatile("s_waitcnt vmcnt(0) lgkmcnt(0)" ::: "memory");
            __builtin_amdgcn_s_barrier();
            __builtin_amdgcn_sched_barrier(0);
            if (kt + 3 < nk) dma(cur, (kt + 3) << 6);
            ldfrag(nxt, 0, a0, b0);
        } else {
            LGKM_WAIT(0);
        }
        mma(a1, b1);
        cur = nxt;
    }
    __syncthreads();
}
__device__ __forceinline__ float row_rs8(const float* part, int row) {
    float4 a = *(const float4*)(part + (size_t)row * 8), b = *(const float4*)(part + (size_t)row * 8 + 4);
    float ss = ((a.x + a.y) + (a.z + a.w)) + ((b.x + b.y) + (b.z + b.w));
    return rsqrtf(ss * (1.f / 1024.f) + EPSF);
}
__device__ __forceinline__ bool xcd_tile(int it, int MT, int NT, int& mt, int& nt) {
    const int G = gridDim.x, bid = blockIdx.x;
    if ((G & 7) == 0 && (MT & 7) == 0) {
        const int nbx = G >> 3, q = (bid >> 3) + it * nbx, per = (MT >> 3) * NT;
        if (q >= per) return false;
        mt = (bid & 7) * (MT >> 3) + q / NT; nt = q % NT;
        return true;
    }
    const int q = bid + it * G;
    if (q >= MT * NT) return false;
    mt = q / NT; nt = q % NT;
    return true;
}
struct NoScale { __device__ __forceinline__ float operator()(int, int) const { return 1.f; } };

#define ZERO_ACC(acc)                                  \
    _Pragma("unroll") for (int _i = 0; _i < 2; ++_i)   \
    _Pragma("unroll") for (int _j = 0; _j < 2; ++_j)   \
    _Pragma("unroll") for (int _r = 0; _r < 16; ++_r) acc[_i][_j][_r] = 0.f;


#define TB_LD 136
#define TF_LD 132
template <bool SCALE>
__device__ __forceinline__ void stage_bf16(const f32x16 (&acc)[2][2], const float* rsl) {
    bf16* T = (bf16*)smem;
    const int tid = opaque_tid(), w = tid >> 6, l = tid & 63, hh = l >> 5, wm = w >> 1, wn = w & 1;
#pragma unroll
    for (int i = 0; i < 2; ++i)
#pragma unroll
        for (int rr = 0; rr < 16; ++rr) {
            int row = wm * 64 + i * 32 + (rr & 3) + 8 * (rr >> 2) + 4 * hh;
            float sc = SCALE ? rsl[row] : 1.f;
#pragma unroll
            for (int j = 0; j < 2; ++j) T[row * TB_LD + wn * 64 + j * 32 + (l & 31)] = (bf16)(acc[i][j][rr] * sc);
        }
    __syncthreads();
}
template <bool SCALE>
__device__ __forceinline__ void stage_f32(const f32x16 (&acc)[2][2], const float* rsl) {
    float* T = (float*)smem;
    const int tid = opaque_tid(), w = tid >> 6, l = tid & 63, hh = l >> 5, wm = w >> 1, wn = w & 1;
#pragma unroll
    for (int i = 0; i < 2; ++i)
#pragma unroll
        for (int rr = 0; rr < 16; ++rr) {
            int row = wm * 64 + i * 32 + (rr & 3) + 8 * (rr >> 2) + 4 * hh;
            float sc = SCALE ? rsl[row] : 1.f;
#pragma unroll
            for (int j = 0; j < 2; ++j) T[row * TF_LD + wn * 64 + j * 32 + (l & 31)] = acc[i][j][rr] * sc;
        }
    __syncthreads();
}
template <typename CMAP>
__device__ __forceinline__ void store_rows_bf16(bf16* dst, int ld, int m0, CMAP cmap) {
    const bf16* T = (const bf16*)smem;
    const int tid = opaque_tid();
#pragma unroll
    for (int q = 0; q < 8; ++q) {
        int id = tid + 512 * q, row = id >> 4, ch = id & 15;
        u32x4 v = *(const u32x4*)(T + row * TB_LD + ch * 8);
        *(u32x4*)(dst + (size_t)(m0 + row) * ld + cmap(ch * 8)) = v;
    }
}
__device__ __forceinline__ void store_cols_bf16(bf16* vt, size_t crow0, int s0) {
    const unsigned short* T = (const unsigned short*)smem;
    const int tid = opaque_tid();
#pragma unroll
    for (int q = 0; q < 8; ++q) {
        int id = tid + 512 * q, c = id & 127, sg = id >> 7;
        unsigned e[8];
#pragma unroll
        for (int k = 0; k < 8; ++k) e[k] = T[(8 * sg + k) * TB_LD + c];
        u32x4 v = {e[0] | (e[1] << 16), e[2] | (e[3] << 16), e[4] | (e[5] << 16), e[6] | (e[7] << 16)};
        *(u32x4*)(vt + (crow0 + c) * SEQ + s0 + 8 * sg) = v;
    }
}
__device__ __forceinline__ void residual_store(const float* hin, float* hout, bf16* hb_out, float* gss, int m0, int n0, int nt) {
    const float* T = (const float*)smem;
    const int tid = opaque_tid(), l = tid & 63;
#pragma unroll 4
    for (int q = 0; q < 16; ++q) {
        int id = tid + 512 * q, row = id >> 5, ch = id & 31;
        f32x4 d = *(const f32x4*)(T + row * TF_LD + ch * 4);
        size_t gi = (size_t)(m0 + row) * 1024 + n0 + ch * 4;
        f32x4 h = *(const f32x4*)(hin + gi);
        f32x4 v = h + d;
        *(f32x4*)(hout + gi) = v;
        u32x2 b = {pack2(v.x, v.y), pack2(v.z, v.w)};
        *(u32x2*)(hb_out + (size_t)(m0 + row) * LDH + n0 + ch * 4) = b;
        float ss = v.x * v.x + v.y * v.y + v.z * v.z + v.w * v.w;
        ss = dpp_add<0xB1>(ss); ss = dpp_add<0x4E>(ss); ss = dpp_add<0x141>(ss); ss = dpp_add<0x140>(ss);
        ss += __shfl_xor(ss, 16);
        if ((l & 31) == 0) gss[(size_t)(m0 + row) * 8 + nt] = ss;
    }
}
struct ColAdd { int off; __device__ __forceinline__ int operator()(int c) const { return c + off; } };
struct ColHead96 { __device__ __forceinline__ int operator()(int c) const { return (c >> 6) * 96 + (c & 63); } };

__device__ __forceinline__ void phase_proj(const Params& P, int L, int hsel, const float* ssrow) {
    char* ws = opq(P.ws);
    const bf16* hb = (const bf16*)(ws + (hsel ? OFF_HB1 : OFF_HB0));
    const bf16* Bt = (const bf16*)(ws + OFF_WIN) + (size_t)L * 2048 * LDH;
    bf16* fq = (bf16*)(ws + OFF_FQ); bf16* fk = (bf16*)(ws + OFF_FK); bf16* fvt = (bf16*)(ws + OFF_FVT);
    bf16* sq = (bf16*)(ws + OFF_SQ); bf16* sk = (bf16*)(ws + OFF_SKK); bf16* svt = (bf16*)(ws + OFF_SVT);
    bf16* cq = (bf16*)(ws + OFF_CQ); bf16* ckv = (bf16*)(ws + OFF_CKV);
    float* flog = (float*)(ws + OFF_FLOG);
    bf16* mk = (bf16*)(ws + OFF_MK);
    const float* cs = (const float*)(ws + OFF_CS);
    const int tid = opaque_tid(), w = tid >> 6, l = tid & 63, hh = l >> 5, wm = w >> 1, wn = w & 1;
    for (int it = 0;; ++it) {
        int mt, nt;
        if (!xcd_tile(it, 64, 16, mt, nt)) break;
        int m0 = mt * 256, n0 = nt * 128;
        float* aux = (float*)(smem + LDS_AUX);
        if (tid < 256) aux[tid] = row_rs8(ssrow, m0 + tid);
        f32x16 acc[2][2];
        ZERO_ACC(acc);
        gemm_core(acc, hb, LDH, Bt, LDH, 1024, m0, n0, NoHook());
        if (nt < 15) {
            stage_bf16<true>(acc, aux);
            if (nt == 4 || nt == 5 || nt == 10 || nt == 11) {
                bf16* vt = (nt < 6) ? fvt : svt;
                int cbase = n0 - ((nt < 6) ? 512 : 1280);
                store_cols_bf16(vt, (size_t)(m0 >> 11) * 256 + cbase, m0 & 2047);
            } else if (nt < 2) store_rows_bf16(fq, 256, m0, ColAdd{n0});
            else if (nt < 4) store_rows_bf16(fk, 256, m0, ColAdd{n0 - 256});
            else if (nt < 8) store_rows_bf16(sq, 256, m0, ColAdd{n0 - 768});
            else if (nt < 10) store_rows_bf16(sk, 256, m0, ColAdd{n0 - 1024});
            else if (nt < 14) store_rows_bf16(cq, LDP, m0, ColAdd{n0 - 1536});
            else store_rows_bf16(ckv, LDC, m0, ColAdd{0});
        } else {
            if (wn == 0) {
#pragma unroll
                for (int i = 0; i < 2; ++i) {
                    int rloc = wm * 64 + i * 32 + 4 * hh;
                    int ci = l & 31, pi = ci & 15;
#pragma unroll
                    for (int rr = 0; rr < 16; ++rr) {
                        int rl = rloc + (rr & 3) + 8 * (rr >> 2), row = m0 + rl;
                        float rs = aux[rl];
                        float v = acc[i][0][rr] * rs;
                        float pv = __shfl_xor(v, 16);
                        float2 c_s = *(const float2*)(cs + ((size_t)row * 16 + pi) * 2);
                        float o = (ci < 16) ? (v * c_s.x - pv * c_s.y) : (pv * c_s.y + v * c_s.x);
                        bf16 ob = (bf16)o;
#pragma unroll
                        for (int h = 0; h < 4; ++h) mk[(size_t)row * 384 + h * 96 + 64 + ci] = ob;
                        if (ci < 4) flog[(size_t)row * 4 + ci] = acc[i][1][rr] * rs;
                    }
                }
            }
        }
        __syncthreads();
    }
}

template <int KW>
__device__ __forceinline__ void row_rms_to_lds(const bf16* A, int lda, int m0) {
    const int tid = opaque_tid(), row = tid >> 1, half = tid & 1;
    float ss = 0.f;
    const u32x4* p = (const u32x4*)(A + (size_t)(m0 + row) * lda + half * (KW / 2));
#pragma unroll
    for (int q = 0; q < KW / 16; ++q) {
        u32x4 v = p[q];
        float a;
        a = bflo(v.x); ss += a * a; a = bfhi(v.x); ss += a * a;
        a = bflo(v.y); ss += a * a; a = bfhi(v.y); ss += a * a;
        a = bflo(v.z); ss += a * a; a = bfhi(v.z); ss += a * a;
        a = bflo(v.w); ss += a * a; a = bfhi(v.w); ss += a * a;
    }
    ss += __shfl_xor(ss, 1);
    if (half == 0) ((float*)(smem + LDS_AUX))[row] = rsqrtf(ss * (1.f / (float)KW) + EPSF);
}

__device__ __forceinline__ void phase_mla_up(const Params& P, int L) {
    char* ws = opq(P.ws);
    const bf16* cq = (const bf16*)(ws + OFF_CQ); const bf16* ckv = (const bf16*)(ws + OFF_CKV);
    const bf16* wuq = (const bf16*)(ws + OFF_WUQ) + (size_t)L * 384 * LDP;
    const bf16* wukv = (const bf16*)(ws + OFF_WUKV) + (size_t)L * 768 * LDC;
    bf16* mq = (bf16*)(ws + OFF_MQ); bf16* mk = (bf16*)(ws + OFF_MK); bf16* mvt = (bf16*)(ws + OFF_MVT);
    const float* cs = (const float*)(ws + OFF_CS);
    const float* flog = (const float*)(ws + OFF_FLOG);
    float* cumF = (float*)(ws + OFF_CUMF);
    const int tid = opaque_tid(), w = tid >> 6, l = tid & 63, hh = l >> 5, wm = w >> 1, wn = w & 1;
    const int NQ = 64 * 3, NKV = 64 * 6, NCF = 4;
    const float* aux = (const float*)(smem + LDS_AUX);
    for (int item = blockIdx.x; item < NQ + NKV + NCF; item += gridDim.x) {
        if (item < NQ) {
            int mt = item / 3, nt = item % 3;
            int m0 = mt * 256, n0 = nt * 128;
            __syncthreads();
            row_rms_to_lds<256>(cq, LDP, m0);
            f32x16 acc[2][2];
            ZERO_ACC(acc);
            gemm_core(acc, cq, LDP, wuq, LDP, 256, m0, n0, NoHook());
#pragma unroll
            for (int i = 0; i < 2; ++i)
#pragma unroll
                for (int j = 0; j < 2; ++j) {
                    int c0 = n0 + wn * 64 + j * 32;
                    int rloc = wm * 64 + i * 32 + 4 * hh;
                    bool rot = (c0 % 96) == 64;
                    int ci = l & 31, pi = ci & 15;
#pragma unroll
                    for (int rr = 0; rr < 16; ++rr) {
                        int rl = rloc + (rr & 3) + 8 * (rr >> 2);
                        float v = acc[i][j][rr] * aux[rl];
                        if (rot) {
                            float pv = __shfl_xor(v, 16);
                            float2 c_s = *(const float2*)(cs + ((size_t)(m0 + rl) * 16 + pi) * 2);
                            v = (ci < 16) ? (v * c_s.x - pv * c_s.y) : (pv * c_s.y + v * c_s.x);
                        }
                        acc[i][j][rr] = v;
                    }
                }
            stage_bf16<false>(acc, nullptr);
            store_rows_bf16(mq, 384, m0, ColAdd{n0});
        } else if (item < NQ + NKV) {
            int it2 = item - NQ;
            int mt = it2 / 6, nt = it2 % 6;
            int m0 = mt * 256, n0 = nt * 128;
            __syncthreads();
            row_rms_to_lds<128>(ckv, LDC, m0);
            f32x16 acc[2][2];
            ZERO_ACC(acc);
            gemm_core(acc, ckv, LDC, wukv, LDC, 128, m0, n0, NoHook());
            stage_bf16<true>(acc, aux);
            if (nt < 2) {
                const int nb0 = n0;
                struct CM { int n0; __device__ __forceinline__ int operator()(int c) const { int col = n0 + c; return (col >> 6) * 96 + (col & 63); } };
                store_rows_bf16(mk, 384, m0, CM{nb0});
            } else {
                store_cols_bf16(mvt, (size_t)(m0 >> 11) * 512 + (n0 - 256), m0 & 2047);
            }
        } else {
            int seq = (item - NQ - NKV) * NW + w;
            int b = seq >> 2, h = seq & 3;
            float bfv = P.b_forget[L * 4 + h];
            float vals[32];
            float run = 0.f;
#pragma unroll
            for (int i = 0; i < 32; ++i) {
                int s = l * 32 + i;
                float z = flog[((size_t)b * SEQ + s) * 4 + h] + bfv;
                run += log_sigmoid_f(z);
                vals[i] = run;
            }
            float tot = run, incl = tot;
#pragma unroll
            for (int o = 1; o < 64; o <<= 1) {
                float t = __shfl_up(incl, o);
                if (l >= o) incl += t;
            }
            float excl = incl - tot;
#pragma unroll
            for (int i = 0; i < 32; ++i) cumF[(size_t)seq * SEQ + l * 32 + i] = vals[i] + excl;
        }
    }
}

template <int MODE, int DK, int DV>
__device__ __forceinline__ void attn_item(const bf16* __restrict__ Q, int ldq, const bf16* __restrict__ Kg, int ldk,
                          const bf16* __restrict__ Vt, const float* __restrict__ cumF, bf16* __restrict__ Y,
                          float* __restrict__ ssy, int b, int h, int qb, float c1, char* lds, int fake = 0) {
    constexpr int KSTR = DK * 2 + 16;
    constexpr int VSTR = 144;
    constexpr int KBYTES = 64 * KSTR, VBYTES = DV * VSTR;
    constexpr int BUF = (KBYTES + VBYTES + 256 + 255) & ~255;
    static_assert(2 * BUF <= 65536, "lds");
    constexpr int KCH = DK / 8, KPT = (64 * KCH) / 256, VPT = (DV * 8) / 256;
    const int tid = opaque_tid() & 255, w = tid >> 6, l = tid & 63, r = l & 31, hh = l >> 5;
    const int q0 = qb * 128;
    const int qrow = q0 + 32 * w + r;
    const size_t tok = (size_t)b * SEQ + qrow;
    const int bh = b * 4 + h;
    bf16x8 qf[DK / 16];
#pragma unroll
    for (int s = 0; s < DK / 16; ++s) qf[s] = *(const bf16x8*)(Q + tok * ldq + h * DK + 16 * s + 8 * hh);
    f32x16 o[DV / 32];
    const f32x16 zero16 = {0.f, 0.f, 0.f, 0.f, 0.f, 0.f, 0.f, 0.f, 0.f, 0.f, 0.f, 0.f, 0.f, 0.f, 0.f, 0.f};
#pragma unroll
    for (int d = 0; d < DV / 32; ++d) o[d] = zero16;
    float m = -1e30f, lsum = 0.f, R = 0.f;
    float Fq = 0.f;
    if (MODE == 0) Fq = cumF[(size_t)bh * SEQ + qrow] * LOG2E;
    const int nkt = (q0 + 128) >> 6;
    u32x4 kregA[KPT], vregA[VPT], kregB[KPT], vregB[VPT];
    float4 fregA = {0.f, 0.f, 0.f, 0.f}, fregB = {0.f, 0.f, 0.f, 0.f};
    auto gload = [&](int kt, u32x4 (&kreg)[KPT], u32x4 (&vreg)[VPT], float4& freg) {
#pragma unroll
        for (int i = 0; i < KPT; ++i) {
            int e = tid + 256 * i;
            int row = e / KCH, ch = e % KCH;
            kreg[i] = *(const u32x4*)(Kg + ((size_t)b * SEQ + kt * 64 + row) * ldk + h * DK + ch * 8);
        }
#pragma unroll
        for (int i = 0; i < VPT; ++i) {
            int e = tid + 256 * i;
            int row = e >> 3, ch = e & 7;
            vreg[i] = *(const u32x4*)(Vt + ((size_t)bh * DV + row) * SEQ + kt * 64 + ch * 8);
        }
        if (MODE == 0 && tid < 16) freg = *(const float4*)(cumF + (size_t)bh * SEQ + kt * 64 + tid * 4);
    };
    auto lwrite = [&](int buf, u32x4 (&kreg)[KPT], u32x4 (&vreg)[VPT], float4& freg) {
        char* base = lds + buf * BUF;
#pragma unroll
        for (int i = 0; i < KPT; ++i) {
            int e = tid + 256 * i;
            int row = e / KCH, ch = e % KCH;
            *(u32x4*)(base + row * KSTR + ch * 16) = kreg[i];
        }
#pragma unroll
        for (int i = 0; i < VPT; ++i) {
            int e = tid + 256 * i;
            int row = e >> 3, ch = e & 7;
            *(u32x4*)(base + KBYTES + row * VSTR + ch * 16) = vreg[i];
        }
        if (MODE == 0 && tid < 16) { float4 fn = {-freg.x * LOG2E, -freg.y * LOG2E, -freg.z * LOG2E, -freg.w * LOG2E}; *(float4*)(base + KBYTES + VBYTES + tid * 16) = fn; }
    };
    const int prow = (r & 0x13) | ((r & 4) << 1) | ((r & 8) >> 1);
    auto ktof = [&](int it) { return (MODE == 1) ? (nkt - 1 - it) : it; };
    gload(ktof(0), kregA, vregA, fregA);
    lwrite(0, kregA, vregA, fregA);
    constexpr bool D2 = (MODE != 2);
    if (D2 && nkt > 1) gload(ktof(1), kregB, vregB, fregB);
    __syncthreads();
    auto tile = [&](int it, u32x4 (&kn)[KPT], u32x4 (&vn)[VPT], float4& fn2, u32x4 (&kf)[KPT], u32x4 (&vf2)[VPT], float4& ff) {
        const int kt = ktof(it);
        if (!(fake & 1)) {
        if (D2) { if (it + 2 < nkt) gload(ktof(it + 2), kf, vf2, ff); }
        else { if (it + 1 < nkt) gload(ktof(it + 1), kf, vf2, ff); }
        }
        const char* base = lds + (it & 1) * BUF;
        const bool active = (kt * 64) <= (q0 + 32 * w + 31);
        if (active) {
            const bool needmask = (kt * 64 + 63) >= (q0 + 32 * w);
            f32x16 s[2];
#pragma unroll
            for (int sub = 0; sub < 2; ++sub) {
                s[sub] = zero16;
#pragma unroll
                for (int ks = 0; ks < DK / 16; ++ks) {
                    bf16x8 kf = *(const bf16x8*)(base + (sub * 32 + prow) * KSTR + (2 * ks + hh) * 16);
                    s[sub] = __builtin_amdgcn_mfma_f32_32x32x16_bf16(kf, qf[ks], s[sub], 0, 0, 0);
                }
            }
            bf16x8 pf[2][2];
            if (fake & 2) {
#pragma unroll
                for (int sub = 0; sub < 2; ++sub)
#pragma unroll
                    for (int a = 0; a < 2; ++a) {
                        uint4 u;
                        u.x = pack2(s[sub][8 * a], s[sub][8 * a + 1]); u.y = pack2(s[sub][8 * a + 2], s[sub][8 * a + 3]);
                        u.z = pack2(s[sub][8 * a + 4], s[sub][8 * a + 5]); u.w = pack2(s[sub][8 * a + 6], s[sub][8 * a + 7]);
                        pf[sub][a] = __builtin_bit_cast(bf16x8, u);
                    }
                lsum = 1.f;
            } else if (MODE != 1) {
                const float* Ft = (const float*)(base + KBYTES + VBYTES);
                float mx = -INFINITY;
                float tv[2][16];
#pragma unroll
                for (int sub = 0; sub < 2; ++sub)
#pragma unroll
                    for (int a = 0; a < 2; ++a) {
                        int kofs = sub * 32 + 16 * a + 8 * hh;
                        float fk[8];
                        if (MODE == 0) {
                            float4 f0 = *(const float4*)(Ft + kofs), f1 = *(const float4*)(Ft + kofs + 4);
                            fk[0] = f0.x; fk[1] = f0.y; fk[2] = f0.z; fk[3] = f0.w; fk[4] = f1.x; fk[5] = f1.y; fk[6] = f1.z; fk[7] = f1.w;
                        }
#pragma unroll
                        for (int j = 0; j < 8; ++j) {
                            int rr = 8 * a + j;
                            float v = (MODE == 0) ? fmaf(s[sub][rr], c1, fk[j]) : s[sub][rr] * c1;
                            tv[sub][rr] = v;
                        }
                    }
                if (needmask) {
#pragma unroll
                    for (int sub = 0; sub < 2; ++sub)
#pragma unroll
                        for (int rr = 0; rr < 16; ++rr) {
                            int key = kt * 64 + sub * 32 + 16 * (rr >> 3) + 8 * hh + (rr & 7);
                            if (key > qrow) tv[sub][rr] = -INFINITY;
                        }
                }
#pragma unroll
                for (int sub = 0; sub < 2; ++sub)
#pragma unroll
                    for (int rr = 0; rr < 16; ++rr) mx = fmaxf(mx, tv[sub][rr]);
                mx = fmaxf(mx, __builtin_bit_cast(float, partner32(__builtin_bit_cast(int, mx), hh)));
                float mnew = fmaxf(m, mx);
                float rsum = 0.f;
#pragma unroll
                for (int sub = 0; sub < 2; ++sub)
#pragma unroll
                    for (int a = 0; a < 2; ++a) {
                        float pv[8];
#pragma unroll
                        for (int j = 0; j < 8; ++j) { pv[j] = fexp2(tv[sub][8 * a + j] - mnew); rsum += pv[j]; }
                        uint4 u;
                        u.x = pack2(pv[0], pv[1]); u.y = pack2(pv[2], pv[3]); u.z = pack2(pv[4], pv[5]); u.w = pack2(pv[6], pv[7]);
                        pf[sub][a] = __builtin_bit_cast(bf16x8, u);
                    }
                rsum += __builtin_bit_cast(float, partner32(__builtin_bit_cast(int, rsum), hh));
                if (__builtin_amdgcn_ballot_w64(mnew != m) != 0ull) {
                    float alpha = fexp2(m - mnew);
                    lsum *= alpha;
#pragma unroll
                    for (int d = 0; d < DV / 32; ++d) o[d] = o[d] * alpha;
                    m = mnew;
                }
                lsum += rsum;
            } else {
#pragma unroll
                for (int sb = 0; sb < 2; ++sb) {
                    const int sub = 1 - sb;
                    float lsig[16], lneg[16];
                    float A0 = 0.f, A1 = 0.f;
#pragma unroll
                    for (int rr = 0; rr < 16; ++rr) {
                        int key = kt * 64 + sub * 32 + 16 * (rr >> 3) + 8 * hh + (rr & 7);
                        bool valid = key < qrow;
                        float z = s[sub][rr] * c1;
                        float e = fexp2(-fabsf(z));
                        float l1p = flog2(1.f + e);
                        float ls = fminf(z, 0.f) - l1p;
                        float ln = valid ? (ls - z) : 0.f;
                        lsig[rr] = valid ? ls : -INFINITY;
                        lneg[rr] = ln;
                        if (rr < 8) A0 += ln; else A1 += ln;
                    }
                    float B0 = __shfl_xor(A0, 32), B1 = __shfl_xor(A1, 32);
                    float base1 = (hh == 0) ? (R + B1) : R;
                    float base0 = (hh == 0) ? (R + B1 + A1 + B0) : (R + A1 + B1);
                    float wv[16];
                    float run = base1;
#pragma unroll
                    for (int j = 7; j >= 0; --j) { wv[8 + j] = fexp2(lsig[8 + j] + run); run += lneg[8 + j]; }
                    run = base0;
#pragma unroll
                    for (int j = 7; j >= 0; --j) { wv[j] = fexp2(lsig[j] + run); run += lneg[j]; }
                    R += A0 + A1 + B0 + B1;
#pragma unroll
                    for (int a = 0; a < 2; ++a) {
                        uint4 u;
                        u.x = pack2(wv[8 * a], wv[8 * a + 1]); u.y = pack2(wv[8 * a + 2], wv[8 * a + 3]);
                        u.z = pack2(wv[8 * a + 4], wv[8 * a + 5]); u.w = pack2(wv[8 * a + 6], wv[8 * a + 7]);
                        pf[sub][a] = __builtin_bit_cast(bf16x8, u);
                    }
                }
            }
#pragma unroll
            for (int d = 0; d < DV / 32; ++d)
#pragma unroll
                for (int sub = 0; sub < 2; ++sub)
#pragma unroll
                    for (int a = 0; a < 2; ++a) {
                        bf16x8 vf = *(const bf16x8*)(base + KBYTES + (d * 32 + r) * VSTR + (sub * 32 + 16 * a + 8 * hh) * 2);
                        o[d] = __builtin_amdgcn_mfma_f32_32x32x16_bf16(vf, pf[sub][a], o[d], 0, 0, 0);
                    }
        }
        if (!(fake & 1)) { if (it + 1 < nkt) lwrite((it + 1) & 1, kn, vn, fn2); }
        __syncthreads();
    };
    if (D2) {
        for (int it = 0; it < nkt; it += 2) {
            tile(it, kregB, vregB, fregB, kregA, vregA, fregA);
            if (it + 1 < nkt) tile(it + 1, kregA, vregA, fregA, kregB, vregB, fregB);
        }
    } else {
        for (int it = 0; it < nkt; ++it) tile(it, kregA, vregA, fregA, kregA, vregA, fregA);
    }
    float inv = (MODE == 1) ? 1.f : (1.f / lsum);
    float ssq = 0.f;
#pragma unroll
    for (int d = 0; d < DV / 32; ++d)
#pragma unroll
        for (int g = 0; g < 4; ++g) {
            float v0 = o[d][4 * g] * inv, v1 = o[d][4 * g + 1] * inv, v2 = o[d][4 * g + 2] * inv, v3 = o[d][4 * g + 3] * inv;
            ssq += v0 * v0 + v1 * v1 + v2 * v2 + v3 * v3;
            uint2 u; u.x = pack2(v0, v1); u.y = pack2(v2, v3);
            *(uint2*)(Y + tok * LDH + h * DV + d * 32 + 8 * g + 4 * hh) = u;
        }
    ssq += __shfl_xor(ssq, 32);
    if (hh == 0) ssy[tok * 16 + h] = ssq;
}

__device__ __forceinline__ void phase_attn(const Params& P, int L, int rep = 0, int fake = 0) {
    char* ws = opq(P.ws);
    int* cnt = (int*)(ws + OFF_CNT) + L * 64 + rep * 16;
    int* s_item = (int*)(smem + LDS_BYTES - 16);
    const float* cumF = (const float*)(ws + OFF_CUMF);
    bf16* Y = (bf16*)(ws + (fake ? OFF_PART : OFF_Y));
    float* ssy = fake ? (float*)(ws + OFF_PART + 40 * MBy) : (float*)(ws + OFF_SSY) + (size_t)L * TOK * 16;
    const int half = opaque_tid() >> 8;
    char* lds = smem + half * 65536;
    for (;;) {
        if (opaque_tid() == 0) *s_item = atomicAdd(cnt, 1);
        __syncthreads();
        int pair = *s_item;
        __syncthreads();
        if (pair >= 768) break;
        int item = pair * 2 + half;
        int qb = 15 - item / 96;
        int rem = item % 96;
        int type = rem >> 5, bh = rem & 31;
        int b = bh >> 2, h = bh & 3;
        if (type == 0) {
            attn_item<2, 96, 128>((const bf16*)(ws + OFF_MQ), 384, (const bf16*)(ws + OFF_MK), 384, (const bf16*)(ws + OFF_MVT), cumF,
                                  Y + 512, ssy + 8, b, h, qb, 0.10206207261596577f * LOG2E, lds, fake);
        } else if (type == 1) {
            attn_item<1, 64, 64>((const bf16*)(ws + OFF_SQ), 256, (const bf16*)(ws + OFF_SKK), 256, (const bf16*)(ws + OFF_SVT), cumF,
                                 Y + 256, ssy + 4, b, h, qb, 0.125f * LOG2E, lds, fake);
        } else {
            attn_item<0, 64, 64>((const bf16*)(ws + OFF_FQ), 256, (const bf16*)(ws + OFF_FK), 256, (const bf16*)(ws + OFF_FVT), cumF,
                                 Y + 0, ssy + 0, b, h, qb, 0.125f * LOG2E, lds, fake);
        }
    }
}

__device__ __forceinline__ void rowss_flush(float (&part)[2][16], float* gss, int m0, int nt) {
    float* lss = (float*)smem;
    const int tid = opaque_tid(), w = tid >> 6, l = tid & 63, hh = l >> 5, wm = w >> 1, wn = w & 1;
#pragma unroll
    for (int i = 0; i < 2; ++i)
#pragma unroll
        for (int rr = 0; rr < 16; ++rr) {
            float v = part[i][rr];
            v = dpp_add<0xB1>(v); v = dpp_add<0x4E>(v); v = dpp_add<0x141>(v); v = dpp_add<0x140>(v);
            v += __shfl_xor(v, 16);
            if ((l & 31) == 0) lss[wn * 256 + wm * 64 + i * 32 + (rr & 3) + 8 * (rr >> 2) + 4 * hh] = v;
        }
    __syncthreads();
    if (tid < 256) gss[(size_t)(m0 + tid) * 8 + nt] = lss[tid] + lss[256 + tid];
    __syncthreads();
}

struct WoHook {
    static constexpr bool nodma = false;
    __device__ __forceinline__ void operator()(int kt, f32x16 (&acc)[2][2]) const {
        if (kt == 4 || kt == 8) {
            const float* fac = (const float*)(smem + LDS_AUX) + (kt == 4 ? 0 : 256);
            const int tid = opaque_tid(), w = tid >> 6, l = tid & 63, hh = l >> 5, wm = w >> 1;
#pragma unroll
            for (int i = 0; i < 2; ++i)
#pragma unroll
                for (int rr = 0; rr < 16; ++rr) {
                    float f = fac[wm * 64 + i * 32 + (rr & 3) + 8 * (rr >> 2) + 4 * hh];
                    acc[i][0][rr] *= f; acc[i][1][rr] *= f;
                }
        }
    }
};

__device__ __forceinline__ void phase_wo(const Params& P, int L, int hsel, float* ss_out) {
    char* ws = opq(P.ws);
    bf16* hb_out = (bf16*)(ws + (hsel ? OFF_HB1 : OFF_HB0));
    const float* hin = (L == 0) ? opq(P.x) : (const float*)opq(P.out);
    float* hout = opq(P.out);
    const bf16* Y = (const bf16*)(ws + OFF_Y);
    const bf16* Bt = (const bf16*)(ws + OFF_WO) + (size_t)L * 1024 * LDH;
    const float* ssy = (const float*)(ws + OFF_SSY) + (size_t)L * TOK * 16;
    float* aux = (float*)(smem + LDS_AUX);
    const int tid = opaque_tid(), w = tid >> 6, l = tid & 63, hh = l >> 5, wm = w >> 1, wn = w & 1;
    for (int it = 0;; ++it) {
        int mt, nt;
        if (!xcd_tile(it, 64, 8, mt, nt)) break;
        int m0 = mt * 256, n0 = nt * 128;
        __syncthreads();
        if (tid < 256) {
            int row = m0 + tid;
            float4 v0 = *(const float4*)(ssy + (size_t)row * 16), v1 = *(const float4*)(ssy + (size_t)row * 16 + 4), v2 = *(const float4*)(ssy + (size_t)row * 16 + 8);
            float r0 = rsqrtf(((v0.x + v0.y) + (v0.z + v0.w)) * (1.f / 256.f) + EPSF);
            float r1 = rsqrtf(((v1.x + v1.y) + (v1.z + v1.w)) * (1.f / 256.f) + EPSF);
            float r2 = rsqrtf(((v2.x + v2.y) + (v2.z + v2.w)) * (1.f / 512.f) + EPSF);
            aux[tid] = r0 / r1; aux[256 + tid] = r1 / r2; aux[512 + tid] = r2;
        }
        f32x16 acc[2][2];
        ZERO_ACC(acc);
        gemm_core(acc, Y, LDH, Bt, LDH, 1024, m0, n0, WoHook());
        stage_f32<true>(acc, aux + 512);
        residual_store(hin, hout, hb_out, ss_out, m0, n0, nt);
    }
}

__device__ __forceinline__ void phase_pq(const Params& P, int L, int hsel, const float* ssrow, int fake = 0) {
    char* ws = opq(P.ws);
    const bf16* hb = (const bf16*)(ws + (hsel ? OFF_HB1 : OFF_HB0));
    const bf16* Bt = (const bf16*)(ws + OFF_WQ) + (size_t)L * 1024 * LDH;
    bf16* pq = (bf16*)(ws + (fake ? OFF_PART : OFF_PQ));
    const int tid = opaque_tid(), w = tid >> 6, l = tid & 63, hh = l >> 5, wm = w >> 1, wn = w & 1;
    for (int it = 0;; ++it) {
        int mt, nt;
        if (!xcd_tile(it, 64, 8, mt, nt)) break;
        int m0 = mt * 256, n0 = nt * 128;
        f32x16 acc[2][2];
        ZERO_ACC(acc);
        float* aux = (float*)(smem + LDS_AUX);
        if (tid < 256) aux[tid] = row_rs8(ssrow, m0 + tid);
        if (fake & 4) gemm_core(acc, hb, LDH, Bt, LDH, 1024, 0, 0, NoDmaHook());
        else gemm_core(acc, hb, LDH, Bt, LDH, 1024, (fake & 1) ? 0 : m0, (fake & 2) ? 0 : n0, NoHook());
        if (fake & 8) {
#pragma unroll
            for (int i = 0; i < 2; ++i)
#pragma unroll
                for (int j = 0; j < 2; ++j) asm volatile("" :: "v"(acc[i][j]));
            continue;
        }
        stage_bf16<true>(acc, aux);
        store_rows_bf16(pq, 1024, m0, ColAdd{n0});
        __syncthreads();
    }
}

__device__ __forceinline__ void cswap(int& a, int& b) { int mx = max(a, b), mn = min(a, b); a = mx; b = mn; }
__device__ __forceinline__ void bitonic_sort16(int (&v)[16]) {
#pragma unroll
    for (int k = 2; k <= 16; k <<= 1)
#pragma unroll
        for (int j = k >> 1; j > 0; j >>= 1)
#pragma unroll
            for (int i = 0; i < 16; ++i) {
                int q = i ^ j;
                if (q > i) {
                    if ((i & k) == 0) cswap(v[i], v[q]); else cswap(v[q], v[i]);
                }
            }
}
__device__ __forceinline__ void merge_top16(int (&Lv)[16], const int (&Rv)[16]) {
#pragma unroll
    for (int i = 0; i < 16; ++i) Lv[i] = max(Lv[i], Rv[15 - i]);
#pragma unroll
    for (int j = 8; j > 0; j >>= 1)
#pragma unroll
        for (int i = 0; i < 16; ++i) {
            int q = i ^ j;
            if (q > i) cswap(Lv[i], Lv[q]);
        }
}
__device__ __forceinline__ int f2key(float v, int low, int mask) {
    int b = __float_as_int(v);
    b ^= (b >> 31) & 0x7fffffff;
    return (b & ~mask) | low;
}
__device__ __forceinline__ float key2f(int k, int mask) {
    int b = k & ~mask;
    b ^= (b >> 31) & 0x7fffffff;
    return __int_as_float(b);
}

__device__ __forceinline__ void phase_topk(const Params& P, int L) {
    char* ws = opq(P.ws);
    const bf16* pq = (const bf16*)(ws + OFF_PQ);
    const bf16* skb = (const bf16*)(ws + OFF_SKB) + (size_t)L * 16 * 128 * 64;
    unsigned short* ids = (unsigned short*)(ws + OFF_IDS);
    float* gates = (float*)(ws + OFF_GATE);
    const int tid = opaque_tid(), w = tid >> 6, l = tid & 63, r = l & 31, hh = l >> 5;
    unsigned char* lidx = (unsigned char*)(smem + w * 1024 + r * 32);
    for (int task = blockIdx.x * NW + w; task < (TOK / 32) * 8; task += gridDim.x * NW) {
        const int t0 = (task >> 3) * 32, h = task & 7;
        int F[2][16];
#pragma unroll
        for (int p = 0; p < 2; ++p) {
            const int hp = h * 2 + p;
            f32x16 acc[4];
            const f32x16 z16 = {0.f, 0.f, 0.f, 0.f, 0.f, 0.f, 0.f, 0.f, 0.f, 0.f, 0.f, 0.f, 0.f, 0.f, 0.f, 0.f};
#pragma unroll
            for (int kt = 0; kt < 4; ++kt) acc[kt] = z16;
#pragma unroll
            for (int s4 = 0; s4 < 4; ++s4) {
                bf16x8 bfr = *(const bf16x8*)(pq + (size_t)(t0 + r) * 1024 + hp * 64 + 16 * s4 + 8 * hh);
#pragma unroll
                for (int kt = 0; kt < 4; ++kt) {
                    bf16x8 af = *(const bf16x8*)(skb + ((size_t)hp * 128 + 32 * kt + r) * 64 + 16 * s4 + 8 * hh);
                    acc[kt] = __builtin_amdgcn_mfma_f32_32x32x16_bf16(af, bfr, acc[kt], 0, 0, 0);
                }
            }
            int K0[16], K1[16], K2[16], K3[16];
#pragma unroll
            for (int rr = 0; rr < 16; ++rr) {
                const int nb = (rr & 3) + 8 * (rr >> 2) + 4 * hh;
                K0[rr] = f2key(acc[0][rr], 127 - nb, 127);
                K1[rr] = f2key(acc[1][rr], 127 - (32 + nb), 127);
                K2[rr] = f2key(acc[2][rr], 127 - (64 + nb), 127);
                K3[rr] = f2key(acc[3][rr], 127 - (96 + nb), 127);
            }
            bitonic_sort16(K0); bitonic_sort16(K1); bitonic_sort16(K2); bitonic_sort16(K3);
            merge_top16(K0, K1);
            merge_top16(K2, K3);
            merge_top16(K0, K2);
#pragma unroll
            for (int i = 0; i < 16; ++i) K1[i] = partner32(K0[i], hh);
            merge_top16(K0, K1);
#pragma unroll
            for (int i = 0; i < 16; ++i) F[p][i] = K0[i];
        }
        if (hh == 0) {
#pragma unroll
            for (int q = 0; q < 4; ++q) {
                unsigned w1 = 0, w2 = 0;
#pragma unroll
                for (int e = 0; e < 4; ++e) {
                    w1 |= (unsigned)(127 - (F[0][4 * q + e] & 127)) << (8 * e);
                    w2 |= (unsigned)(127 - (F[1][4 * q + e] & 127)) << (8 * e);
                }
                ((unsigned*)lidx)[q] = w1;
                ((unsigned*)lidx)[4 + q] = w2;
            }
        }
        {
            float s1[16], s2[16];
#pragma unroll
            for (int i = 0; i < 16; ++i) { s1[i] = key2f(F[0][i], 127); s2[i] = key2f(F[1][i], 127); }
            int Lc[16], X[16];
#pragma unroll
            for (int b2 = 0; b2 < 16; ++b2) Lc[b2] = f2key(s1[0] + s2[b2], 255 - b2, 255);
#pragma unroll
            for (int a2 = 1; a2 < 16; ++a2) X[a2 - 1] = f2key(s1[a2] + s2[0], 255 - a2 * 16, 255);
            X[15] = INT_MIN;
            merge_top16(Lc, X);
            X[0] = f2key(s1[1] + s2[1], 255 - 17, 255); X[1] = f2key(s1[1] + s2[2], 255 - 18, 255); X[2] = f2key(s1[1] + s2[3], 255 - 19, 255);
            X[3] = f2key(s1[1] + s2[4], 255 - 20, 255); X[4] = f2key(s1[1] + s2[5], 255 - 21, 255); X[5] = f2key(s1[1] + s2[6], 255 - 22, 255);
            X[6] = f2key(s1[1] + s2[7], 255 - 23, 255);
            X[7] = f2key(s1[2] + s2[1], 255 - 33, 255); X[8] = f2key(s1[2] + s2[2], 255 - 34, 255); X[9] = f2key(s1[2] + s2[3], 255 - 35, 255);
            X[10] = f2key(s1[2] + s2[4], 255 - 36, 255);
            X[11] = f2key(s1[3] + s2[1], 255 - 49, 255); X[12] = f2key(s1[3] + s2[2], 255 - 50, 255); X[13] = f2key(s1[3] + s2[3], 255 - 51, 255);
            X[14] = f2key(s1[4] + s2[1], 255 - 65, 255); X[15] = f2key(s1[4] + s2[2], 255 - 66, 255);
            bitonic_sort16(X);
            merge_top16(Lc, X);
            X[0] = f2key(s1[5] + s2[1], 255 - 81, 255);
            X[1] = f2key(s1[6] + s2[1], 255 - 97, 255);
            X[2] = f2key(s1[7] + s2[1], 255 - 113, 255);
#pragma unroll
            for (int i = 3; i < 16; ++i) X[i] = INT_MIN;
            merge_top16(Lc, X);
            if (hh == 0) {
                float mx = key2f(Lc[0], 255);
                float ev[16], sum = 0.f;
#pragma unroll
                for (int k = 0; k < 16; ++k) { ev[k] = __expf(key2f(Lc[k], 255) - mx); sum += ev[k]; }
                float inv = 1.f / sum;
                size_t ob = (size_t)(t0 + r) * 128 + h * 16;
                unsigned idw[8];
#pragma unroll
                for (int k = 0; k < 16; ++k) {
                    int cidx = 255 - (Lc[k] & 255);
                    int i1 = lidx[cidx >> 4], i2 = lidx[16 + (cidx & 15)];
                    unsigned idv = (unsigned)(i1 * 128 + i2);
                    if (k & 1) idw[k >> 1] |= idv << 16; else idw[k >> 1] = idv;
                }
                u32x4 o0 = {idw[0], idw[1], idw[2], idw[3]}, o1 = {idw[4], idw[5], idw[6], idw[7]};
                *(u32x4*)(ids + ob) = o0;
                *(u32x4*)(ids + ob + 8) = o1;
#pragma unroll
                for (int q = 0; q < 4; ++q) {
                    f32x4 g4 = {ev[4 * q] * inv, ev[4 * q + 1] * inv, ev[4 * q + 2] * inv, ev[4 * q + 3] * inv};
                    *(f32x4*)(gates + ob + 4 * q) = g4;
                }
            }
        }
    }
}

__device__ __forceinline__ float gelu_exact(float x) { return 0.5f * x * (1.f + erff(x * 0.70710678118654752f)); }

__device__ __forceinline__ void dec16(const u32x4& v, float (&f)[16]) {
    f32x2 t;
    t = __builtin_amdgcn_cvt_pk_f32_fp8((int)v.x, false); f[0] = t.x; f[1] = t.y;
    t = __builtin_amdgcn_cvt_pk_f32_fp8((int)v.x, true);  f[2] = t.x; f[3] = t.y;
    t = __builtin_amdgcn_cvt_pk_f32_fp8((int)v.y, false); f[4] = t.x; f[5] = t.y;
    t = __builtin_amdgcn_cvt_pk_f32_fp8((int)v.y, true);  f[6] = t.x; f[7] = t.y;
    t = __builtin_amdgcn_cvt_pk_f32_fp8((int)v.z, false); f[8] = t.x; f[9] = t.y;
    t = __builtin_amdgcn_cvt_pk_f32_fp8((int)v.z, true);  f[10] = t.x; f[11] = t.y;
    t = __builtin_amdgcn_cvt_pk_f32_fp8((int)v.w, false); f[12] = t.x; f[13] = t.y;
    t = __builtin_amdgcn_cvt_pk_f32_fp8((int)v.w, true);  f[14] = t.x; f[15] = t.y;
}

__device__ __forceinline__ void dec32(const u32x4& v, f32x2 (&f)[16]) {
    f[0] = __builtin_amdgcn_cvt_scalef32_pk_f32_fp4(v.x, 1.0f, 0); f[1] = __builtin_amdgcn_cvt_scalef32_pk_f32_fp4(v.x, 1.0f, 1);
    f[2] = __builtin_amdgcn_cvt_scalef32_pk_f32_fp4(v.x, 1.0f, 2); f[3] = __builtin_amdgcn_cvt_scalef32_pk_f32_fp4(v.x, 1.0f, 3);
    f[4] = __builtin_amdgcn_cvt_scalef32_pk_f32_fp4(v.y, 1.0f, 0); f[5] = __builtin_amdgcn_cvt_scalef32_pk_f32_fp4(v.y, 1.0f, 1);
    f[6] = __builtin_amdgcn_cvt_scalef32_pk_f32_fp4(v.y, 1.0f, 2); f[7] = __builtin_amdgcn_cvt_scalef32_pk_f32_fp4(v.y, 1.0f, 3);
    f[8] = __builtin_amdgcn_cvt_scalef32_pk_f32_fp4(v.z, 1.0f, 0); f[9] = __builtin_amdgcn_cvt_scalef32_pk_f32_fp4(v.z, 1.0f, 1);
    f[10] = __builtin_amdgcn_cvt_scalef32_pk_f32_fp4(v.z, 1.0f, 2); f[11] = __builtin_amdgcn_cvt_scalef32_pk_f32_fp4(v.z, 1.0f, 3);
    f[12] = __builtin_amdgcn_cvt_scalef32_pk_f32_fp4(v.w, 1.0f, 0); f[13] = __builtin_amdgcn_cvt_scalef32_pk_f32_fp4(v.w, 1.0f, 1);
    f[14] = __builtin_amdgcn_cvt_scalef32_pk_f32_fp4(v.w, 1.0f, 2); f[15] = __builtin_amdgcn_cvt_scalef32_pk_f32_fp4(v.w, 1.0f, 3);
}

typedef _Float16 f16x2 __attribute__((ext_vector_type(2)));
__device__ __forceinline__ void dec8_f16(unsigned x, f16x2 (&wv)[4]) {
    const unsigned lo = x & 0x07070707u, hi = (x >> 4) & 0x07070707u;
    const unsigned Lb = __builtin_amdgcn_perm(0x46444240u, 0x3E3C3800u, lo) | ((x & 0x08080808u) << 4);
    const unsigned Hb = __builtin_amdgcn_perm(0x46444240u, 0x3E3C3800u, hi) | (x & 0x80808080u);
    wv[0] = __builtin_bit_cast(f16x2, __builtin_amdgcn_perm(Hb, Lb, 0x040c000cu));
    wv[1] = __builtin_bit_cast(f16x2, __builtin_amdgcn_perm(Hb, Lb, 0x050c010cu));
    wv[2] = __builtin_bit_cast(f16x2, __builtin_amdgcn_perm(Hb, Lb, 0x060c020cu));
    wv[3] = __builtin_bit_cast(f16x2, __builtin_amdgcn_perm(Hb, Lb, 0x070c030cu));
}

__device__ __forceinline__ int idof16(const u32x4 (&q)[2], int i) {
    unsigned wv = (i >> 1) == 0 ? q[0].x : (i >> 1) == 1 ? q[0].y : (i >> 1) == 2 ? q[0].z : (i >> 1) == 3 ? q[0].w
                : (i >> 1) == 4 ? q[1].x : (i >> 1) == 5 ? q[1].y : (i >> 1) == 6 ? q[1].z : q[1].w;
    return (i & 1) ? (int)(wv >> 16) : (int)(wv & 0xffffu);
}
__device__ __forceinline__ void phase_gather_u(const Params& P, int L) {
    char* ws = opq(P.ws);
    const unsigned char* U4 = (const unsigned char*)(ws + OFF_UB) + (size_t)L * NEXP * 512;
    float* part = (float*)(ws + OFF_PART);
    const unsigned short* ids = (const unsigned short*)(ws + OFF_IDS);
    const float* hin = opq(P.out);
    const int tid = opaque_tid(), w = tid >> 6, l = tid & 63, c = l & 7, gq = l >> 3;
    const int sl = blockIdx.x & 3, par = (blockIdx.x >> 2) & 1, rk = blockIdx.x >> 3, nb = gridDim.x >> 3;
    if (rk >= nb) return;
    const unsigned char* ubase = U4 + (size_t)sl * NEXP * 128 + c * 16;
    const int stride = nb * NW;
    int ti = rk * NW + w;
    if (ti >= TOK / 2) return;
    u32x4 idA[2], idB[2];
    u32x4 rv[16];
    f32x4 hA[8], hB[8];
    auto load_ids = [&](int tt, u32x4 (&idq)[2]) {
        const u32x4* i4 = (const u32x4*)(ids + (size_t)tt * 128 + 16 * gq);
        idq[0] = i4[0]; idq[1] = i4[1];
    };
    auto load_hx = [&](int tt, f32x4 (&hx)[8]) {
        const f32x4* h4 = (const f32x4*)(hin + (size_t)tt * 1024 + 256 * sl + 32 * c);
#pragma unroll
        for (int q = 0; q < 8; ++q) hx[q] = h4[q];
    };
    auto step = [&](int tcur, int tnext, int tnext2, const u32x4 (&idn)[2], u32x4 (&idl)[2], const f32x4 (&hc)[8], f32x4 (&hn)[8]) {
        load_ids(tnext2, idl);
        load_hx(tnext, hn);
        __builtin_amdgcn_sched_barrier(0);
        float pr[16];
#pragma unroll
        for (int i = 0; i < 16; ++i) {
            f32x2 f[16];
            asm volatile("" : "+v"(rv[i].x), "+v"(rv[i].y), "+v"(rv[i].z), "+v"(rv[i].w));
            dec32(rv[i], f);
            rv[i] = *(const u32x4*)(ubase + (size_t)idof16(idn, i) * 128);
            __builtin_amdgcn_sched_barrier(0);
            f32x2 s2 = {0.f, 0.f};
#pragma unroll
            for (int q = 0; q < 8; ++q) {
                f32x2 x0 = {hc[q].x, hc[q].y}, x1 = {hc[q].z, hc[q].w};
                s2 = __builtin_elementwise_fma(f[2 * q], x0, s2);
                s2 = __builtin_elementwise_fma(f[2 * q + 1], x1, s2);
            }
            float sacc = s2.x + s2.y;
            asm volatile("" : "+v"(sacc));
            pr[i] = sacc;
        }
#pragma unroll
        for (int i = 0; i < 16; ++i) pr[i] = sum8_dpp(pr[i]);
        if (c == 0) {
            f32x4* o4 = (f32x4*)(part + ((size_t)sl * TOK + tcur) * 128 + 16 * gq);
#pragma unroll
            for (int q = 0; q < 4; ++q) { f32x4 o = {pr[4 * q], pr[4 * q + 1], pr[4 * q + 2], pr[4 * q + 3]}; o4[q] = o; }
        }
    };
    auto tok = [&](int tidx, int fb) { return 2 * (tidx < TOK / 2 ? tidx : fb) + par; };
    load_ids(tok(ti, ti), idA);
#pragma unroll
    for (int i = 0; i < 16; ++i) rv[i] = *(const u32x4*)(ubase + (size_t)idof16(idA, i) * 128);
    load_hx(tok(ti, ti), hA);
    load_ids(tok(ti + stride, ti), idB);
    for (;;) {
        int tn = ti + stride, tn2 = ti + 2 * stride;
        step(tok(ti, ti), tok(tn, ti), tok(tn2, ti), idB, idA, hA, hB);
        if (tn >= TOK / 2) break;
        ti = tn; tn = ti + stride; tn2 = ti + 2 * stride;
        step(tok(ti, ti), tok(tn, ti), tok(tn2, ti), idA, idB, hB, hA);
        if (tn >= TOK / 2) break;
        ti = tn;
    }
}

__device__ __forceinline__ void phase_gather_act(const Params& P, int L, const float* ss_ffn) {
    char* ws = opq(P.ws);
    const float* part = (const float*)(ws + OFF_PART);
    const unsigned short* ids = (const unsigned short*)(ws + OFF_IDS);
    float* gates = (float*)(ws + OFF_GATE);
    const float* uinv = (const float*)(ws + OFF_TSC) + L * NEXP;
    const float* vinv = (const float*)(ws + OFF_TSC) + (2 + L) * NEXP;
    const int tid = opaque_tid(), w = tid >> 6, l = tid & 63;
    for (int t = blockIdx.x * NW + w; t < TOK; t += gridDim.x * NW) {
        float rs = row_rs8(ss_ffn, t);
#pragma unroll
        for (int hsel = 0; hsel < 2; ++hsel) {
            int k = l + 64 * hsel;
            float sacc = 0.f;
#pragma unroll
            for (int j = 0; j < 4; ++j) sacc += part[((size_t)j * TOK + t) * 128 + k];
            int id = ids[(size_t)t * 128 + k];
            float pre = sacc * rs * uinv[id];
            gates[(size_t)t * 128 + k] = gates[(size_t)t * 128 + k] * gelu_exact(pre) * vinv[id];
        }
    }
}

__device__ __forceinline__ void phase_gather_v(const Params& P, int L, int hsel, float* ss_ple) {
    char* ws = opq(P.ws);
    bf16* hb_out = (bf16*)(ws + (hsel ? OFF_HB1 : OFF_HB0));
    const unsigned char* V4 = (const unsigned char*)(ws + OFF_VB) + (size_t)L * NEXP * 512;
    const unsigned short* ids = (const unsigned short*)(ws + OFF_IDS);
    const float* act = (const float*)(ws + OFF_GATE);
    float* hio = opq(P.out);
    const int tid = opaque_tid(), w = tid >> 6, l = tid & 63, c = l & 7, gq = l >> 3;
    const int sl = blockIdx.x & 3, par = (blockIdx.x >> 2) & 1, rk = blockIdx.x >> 3, nb = gridDim.x >> 3;
    if (rk >= nb) return;
    const unsigned char* vbase = V4 + (size_t)sl * NEXP * 128 + c * 16;
    const int stride = nb * NW;
    int ti = rk * NW + w;
    if (ti >= TOK / 2) return;
    const bool b3 = (l >> 3) & 1;
    u32x4 idA[2], idB[2];
    u32x4 rv[16];
    f32x4 aA[4], aB[4];
    auto load_ids = [&](int tt, u32x4 (&idq)[2]) {
        const u32x4* i4 = (const u32x4*)(ids + (size_t)tt * 128 + 16 * gq);
        idq[0] = i4[0]; idq[1] = i4[1];
    };
    auto load_a = [&](int tt, f32x4 (&ax)[4]) {
        const f32x4* a4 = (const f32x4*)(act + (size_t)tt * 128 + 16 * gq);
#pragma unroll
        for (int q = 0; q < 4; ++q) ax[q] = a4[q];
    };
    auto step = [&](int tcur, int tnext, int tnext2, const u32x4 (&idn)[2], u32x4 (&idl)[2], const f32x4 (&ac)[4], f32x4 (&an)[4]) {
        load_ids(tnext2, idl);
        load_a(tnext, an);
        __builtin_amdgcn_sched_barrier(0);
        f32x2 acc[16];
#pragma unroll
        for (int e = 0; e < 16; ++e) { acc[e].x = 0.f; acc[e].y = 0.f; }
#pragma unroll
        for (int i = 0; i < 16; ++i) {
            f32x2 f[16];
            asm volatile("" : "+v"(rv[i].x), "+v"(rv[i].y), "+v"(rv[i].z), "+v"(rv[i].w));
            dec32(rv[i], f);
            rv[i] = *(const u32x4*)(vbase + (size_t)idof16(idn, i) * 128);
            __builtin_amdgcn_sched_barrier(0);
            const float a = (i & 3) == 0 ? ac[i >> 2].x : (i & 3) == 1 ? ac[i >> 2].y : (i & 3) == 2 ? ac[i >> 2].z : ac[i >> 2].w;
            const f32x2 a2 = {a, a};
#pragma unroll
            for (int e = 0; e < 16; ++e) acc[e] = __builtin_elementwise_fma(f[e], a2, acc[e]);
#pragma unroll
            for (int e = 0; e < 16; ++e) asm volatile("" : "+v"(acc[e]));
        }
        float v8[8][2];
#pragma unroll
        for (int e = 0; e < 8; ++e) {
            float k0 = b3 ? acc[8 + e].x : acc[e].x, k1 = b3 ? acc[8 + e].y : acc[e].y;
            float s0 = b3 ? acc[e].x : acc[8 + e].x, s1 = b3 ? acc[e].y : acc[8 + e].y;
            v8[e][0] = k0 + __builtin_bit_cast(float, __builtin_amdgcn_update_dpp(0, __builtin_bit_cast(int, s0), 0x128, 0xf, 0xf, true));
            v8[e][1] = k1 + __builtin_bit_cast(float, __builtin_amdgcn_update_dpp(0, __builtin_bit_cast(int, s1), 0x128, 0xf, 0xf, true));
        }
        float v4[8];
#pragma unroll
        for (int e = 0; e < 8; ++e) {
            float X = v8[e >> 1][e & 1], Y = v8[4 + (e >> 1)][e & 1];
            asm volatile("s_nop 1\n\tv_permlane16_swap_b32 %0, %1\n\ts_nop 1" : "+v"(X), "+v"(Y));
            v4[e] = X + Y;
        }
        float v2[4];
#pragma unroll
        for (int e = 0; e < 4; ++e) {
            float X = v4[e], Y = v4[4 + e];
            asm volatile("s_nop 1\n\tv_permlane32_swap_b32 %0, %1\n\ts_nop 1" : "+v"(X), "+v"(Y));
            v2[e] = X + Y;
        }
        const int col = 256 * sl + 32 * c + 16 * ((l >> 3) & 1) + 8 * ((l >> 4) & 1) + 4 * (l >> 5);
        f32x4* h4 = (f32x4*)(hio + (size_t)tcur * 1024 + col);
        f32x4 hv = *h4;
        hv.x += v2[0]; hv.y += v2[1]; hv.z += v2[2]; hv.w += v2[3];
        *h4 = hv;
        u32x2 bb = {pack2(hv.x, hv.y), pack2(hv.z, hv.w)};
        *(u32x2*)(hb_out + (size_t)tcur * LDH + col) = bb;
        float ssq = hv.x * hv.x + hv.y * hv.y + hv.z * hv.z + hv.w * hv.w;
        ssq = wave_sum(ssq);
        if (l == 0) { ss_ple[(size_t)tcur * 8 + sl] = ssq; ss_ple[(size_t)tcur * 8 + 4 + sl] = 0.f; }
    };
    auto tok = [&](int tidx, int fb) { return 2 * (tidx < TOK / 2 ? tidx : fb) + par; };
    load_ids(tok(ti, ti), idA);
#pragma unroll
    for (int i = 0; i < 16; ++i) rv[i] = *(const u32x4*)(vbase + (size_t)idof16(idA, i) * 128);
    load_a(tok(ti, ti), aA);
    load_ids(tok(ti + stride, ti), idB);
    for (;;) {
        int tn = ti + stride, tn2 = ti + 2 * stride;
        step(tok(ti, ti), tok(tn, ti), tok(tn2, ti), idB, idA, aA, aB);
        if (tn >= TOK / 2) break;
        ti = tn; tn = ti + stride; tn2 = ti + 2 * stride;
        step(tok(ti, ti), tok(tn, ti), tok(tn2, ti), idA, idB, aB, aA);
        if (tn >= TOK / 2) break;
        ti = tn;
    }
}

__device__ __forceinline__ void phase_ple(const Params& P, int L, int hsel, const float* ss_ple, float* ss_out) {
    char* ws = opq(P.ws);
    const bf16* hb_in = (const bf16*)(ws + (hsel ? OFF_HB1 : OFF_HB0));
    bf16* hb_out = (bf16*)(ws + (hsel ? OFF_HB0 : OFF_HB1));
    float* hio = opq(P.out);
    const bf16* pin = (const bf16*)(ws + OFF_PB) + (size_t)L * TOK * LDP;
    const bf16* Wg = (const bf16*)(ws + OFF_WG) + (size_t)L * 1024 * LDH;
    const bf16* Wp = (const bf16*)(ws + OFF_WP) + (size_t)L * 1024 * LDP;
    const int tid = opaque_tid(), w = tid >> 6, l = tid & 63, hh = l >> 5, wm = w >> 1, wn = w & 1;
    for (int it = 0;; ++it) {
        int mt, nt;
        if (!xcd_tile(it, 64, 8, mt, nt)) break;
        int m0 = mt * 256, n0 = nt * 128;
        float* aux = (float*)(smem + LDS_AUX);
        __syncthreads();
        if (tid < 256) aux[tid] = row_rs8(ss_ple, m0 + tid);
        f32x16 acc1[2][2], acc2[2][2];
        ZERO_ACC(acc1);
        ZERO_ACC(acc2);
        gemm_core(acc1, hb_in, LDH, Wg, LDH, 1024, m0, n0, NoHook());
        gemm_core(acc2, pin, LDP, Wp, LDP, 256, m0, n0, NoHook());
#pragma unroll
        for (int i = 0; i < 2; ++i)
#pragma unroll
            for (int rr = 0; rr < 16; ++rr) {
                float rs = aux[wm * 64 + i * 32 + (rr & 3) + 8 * (rr >> 2) + 4 * hh];
#pragma unroll
                for (int j = 0; j < 2; ++j) {
                    float gte = 1.f / (1.f + __expf(-acc1[i][j][rr] * rs));
                    acc2[i][j][rr] *= gte;
                }
            }
        stage_f32<false>(acc2, nullptr);
        residual_store(hio, hio, hb_out, ss_out, m0, n0, nt);
    }
}

__device__ __forceinline__ void phase_final(const Params& P, const float* ss) {
    float* hio = opq(P.out);
    const int tid = opaque_tid(), w = tid >> 6, l = tid & 63;
    const float4* g4 = (const float4*)P.final_norm_g;
    for (int t = blockIdx.x * NW + w; t < TOK; t += gridDim.x * NW) {
        float rs = row_rs8(ss, t);
        float4* o4 = (float4*)(hio + (size_t)t * 1024);
#pragma unroll
        for (int i = 0; i < 4; ++i) {
            float4 v = o4[i * 64 + l], g = g4[i * 64 + l];
            v.x *= rs * g.x; v.y *= rs * g.y; v.z *= rs * g.z; v.w *= rs * g.w;
            o4[i * 64 + l] = v;
        }
    }
}

#define XB_TMO      128
#define XB_XCNT(j)  (256  + 64 * (j))
#define XB_XSUB(j)  (1280 + 64 * (j))
#define XB_XGEN(j)  (2304 + 64 * (j))
#define XB_TOP      3328
#define XB_TOPGEN   3392
#define XCD_BAR_WORDS 3456
#define XB_SPIN_CAP (1u << 22)
__device__ __forceinline__ unsigned xb_ld(unsigned* p) { return __hip_atomic_load(p, __ATOMIC_RELAXED, __HIP_MEMORY_SCOPE_AGENT); }
__device__ __forceinline__ unsigned xb_add(unsigned* p, unsigned v) { return __hip_atomic_fetch_add(p, v, __ATOMIC_RELAXED, __HIP_MEMORY_SCOPE_AGENT); }
__device__ __forceinline__ unsigned xb_xcc_id() { return (unsigned)__builtin_amdgcn_s_getreg((3 << 11) | 20) & 0xFu; }
#define XB_SPIN(cond, bar) do { unsigned _sp = 0; while (cond) { __builtin_amdgcn_s_sleep(1); \
    if ((++_sp & 255u) == 0u) { if (xb_ld(&(bar)[XB_TMO])) break; if (_sp > XB_SPIN_CAP) { atomicAdd(&(bar)[XB_TMO], 1u); break; } } } } while (0)
struct XcdBarrier { unsigned* bar; unsigned x, nloc, nx; };
__device__ __forceinline__ XcdBarrier xcd_barrier_post(unsigned* bar) {
    XcdBarrier b; b.bar = bar; b.x = xb_xcc_id(); b.nloc = 0u; b.nx = 0u;
    if (threadIdx.x == 0) (void)xb_add(&bar[XB_XCNT(b.x)], 1u);
    return b;
}
__device__ __forceinline__ void xcd_barrier_complete(unsigned* bar, unsigned x, unsigned& nloc, unsigned& nx) {
    const unsigned G = gridDim.x;
    unsigned sum, cnt, mine, sp = 0u;
    for (;;) {
        sum = 0u; cnt = 0u; mine = 0u;
#pragma unroll
        for (unsigned j = 0; j < 16; ++j) { const unsigned c = xb_ld(&bar[XB_XCNT(j)]); sum += c; cnt += (c > 0u) ? 1u : 0u; mine = (j == x) ? c : mine; }
        if (sum == G) break;
        __builtin_amdgcn_s_sleep(1);
        if ((++sp & 255u) == 0u) { if (xb_ld(&bar[XB_TMO])) break; if (sp > XB_SPIN_CAP) { atomicAdd(&bar[XB_TMO], 1u); break; } }
    }
    nloc = mine > 0u ? mine : 1u; nx = cnt > 0u ? cnt : 1u;
}
__device__ __forceinline__ void grid_barrier(XcdBarrier& b) {
    asm volatile("s_waitcnt vmcnt(0)" ::: "memory");
    __syncthreads();
    if (threadIdx.x == 0) {
        unsigned* bar = b.bar;
        __builtin_amdgcn_s_waitcnt(0);
        if (b.nloc == 0u) xcd_barrier_complete(bar, b.x, b.nloc, b.nx);
        const unsigned nloc = b.nloc, nx = b.nx;
        const unsigned old = xb_add(&bar[XB_XSUB(b.x)], 1u);
        const unsigned gen = old / nloc;
        if (old + 1u == (gen + 1u) * nloc) {
            __builtin_amdgcn_fence(__ATOMIC_RELEASE, "agent");
            asm volatile("s_waitcnt vmcnt(0)" ::: "memory");
            const unsigned og = xb_add(&bar[XB_TOP], 1u);
            const unsigned tg = og / nx;
            if (og + 1u == (tg + 1u) * nx) xb_add(&bar[XB_TOPGEN], 1u);
            else XB_SPIN(xb_ld(&bar[XB_TOPGEN]) == tg, bar);
            __builtin_amdgcn_fence(__ATOMIC_ACQUIRE, "agent");
            xb_add(&bar[XB_XGEN(b.x)], 1u);
            asm volatile("s_waitcnt vmcnt(0)" ::: "memory");
        } else {
            XB_SPIN(xb_ld(&bar[XB_XGEN(b.x)]) == gen, bar);
            __builtin_amdgcn_fence(__ATOMIC_ACQUIRE, "agent");
            asm volatile("s_waitcnt vmcnt(0)" ::: "memory");
        }
    }
    __syncthreads();
}

__global__ void __launch_bounds__(NTHR, 2) hymba_megakernel(Params P) {
    cg::grid_group grid = cg::this_grid();
    char* ws = opq(P.ws);
    float* ssa = (float*)(ws + OFF_SSA);
    XcdBarrier bar = xcd_barrier_post((unsigned*)(ws + OFF_BAR));
#define BAR() do { grid_barrier(bar); if (DUP == 20) grid_barrier(bar); } while (0)
    phase0(P);
    if (DUP == 0) { asm volatile("s_waitcnt vmcnt(0)" ::: "memory"); __syncthreads(); grid_barrier(bar); phase0(P); }
    asm volatile("s_waitcnt vmcnt(0)" ::: "memory");
    __syncthreads();
    grid.sync();
    BAR();
    int cur = 0;
    for (int L = 0; L < 2; ++L) {
        const float* ss_mix = (L == 0) ? ssa : (ssa + 3 * TOK * 8);
        float* ss_ffn = ssa + (size_t)(1 + L) * TOK * 8;
        float* ss_next = (L == 0) ? (ssa + 3 * TOK * 8) : (ssa + 4 * TOK * 8);
        float* ss_ple = ssa + (size_t)(5 + L) * TOK * 8;
        phase_proj(P, L, cur, ss_mix);
        BAR();
        if (DUP == 1) { phase_proj(P, L, cur, ss_mix); BAR(); }
        phase_mla_up(P, L);
        BAR();
        if (DUP == 2) { phase_mla_up(P, L); BAR(); }
        phase_attn(P, L, 0);
        BAR();
        if (DUP == 3) { phase_attn(P, L, 1); BAR(); }
        if (DUP >= 30 && DUP < 34) { phase_attn(P, L, 1, DUP - 30); BAR(); }
        phase_wo(P, L, cur ^ 1, ss_ffn);
        BAR();
        if (DUP == 4 && L == 0) { phase_wo(P, L, cur ^ 1, ss_ffn); BAR(); }
        phase_pq(P, L, cur ^ 1, ss_ffn);
        BAR();
        if (DUP == 5) { phase_pq(P, L, cur ^ 1, ss_ffn); BAR(); }
        if (DUP >= 50 && DUP < 66) { phase_pq(P, L, cur ^ 1, ss_ffn, DUP - 50); BAR(); }
        phase_topk(P, L);
        BAR();
        if (DUP == 6) { phase_topk(P, L); BAR(); }
        phase_gather_u(P, L);
        BAR();
        if (DUP == 7) { phase_gather_u(P, L); BAR(); }
        phase_gather_act(P, L, ss_ffn);
        BAR();
        phase_gather_v(P, L, cur, ss_ple);
        BAR();
        phase_ple(P, L, cur, ss_ple, ss_next);
        BAR();
        cur ^= 1;
    }
    phase_final(P, ssa + 4 * TOK * 8);
}

extern "C" void kernel_launch(void* const* d_in, const int* in_sizes, int n_in, void* d_out, int out_size, void* d_ws,
                              size_t ws_size, hipStream_t stream) {
    static int grid_blocks = 0;
    if (!grid_blocks) {
        int dev = 0, cus = 0, per_cu = 0;
        hipGetDevice(&dev);
        hipDeviceGetAttribute(&cus, hipDeviceAttributeMultiprocessorCount, dev);
        hipOccupancyMaxActiveBlocksPerMultiprocessor(&per_cu, hymba_megakernel, NTHR, 0);
        if (per_cu > 1) per_cu = 1;
        if (per_cu < 1) per_cu = 1;
        grid_blocks = cus * per_cu;
        if (ws_size < WS_END) fprintf(stderr, "workspace too small: %zu < %zu\n", ws_size, (size_t)WS_END);
    }
    Params P{};
    P.x = (const float*)d_in[0]; P.p = (const float*)d_in[1]; P.pos = (const int*)d_in[2];
    P.norm_mix_g = (const float*)d_in[3]; P.w_in = (const float*)d_in[4]; P.b_forget = (const float*)d_in[5];
    P.mla_q_norm_g = (const float*)d_in[6]; P.w_uq = (const float*)d_in[7]; P.mla_kv_norm_g = (const float*)d_in[8];
    P.w_ukv = (const float*)d_in[9]; P.mix_out_norm_g = (const float*)d_in[10]; P.w_o = (const float*)d_in[11];
    P.norm_ffn_g = (const float*)d_in[12]; P.w_query = (const float*)d_in[13]; P.sub_keys = (const float*)d_in[14];
    P.peer_u = (const float*)d_in[15]; P.peer_v = (const float*)d_in[16]; P.w_ple = (const float*)d_in[17];
    P.ple_norm_g = (const float*)d_in[18]; P.w_ple_gate = (const float*)d_in[19]; P.final_norm_g = (const float*)d_in[20];
    P.out = (float*)d_out; P.ws = (char*)d_ws;
    hipMemsetAsync((char*)d_ws + OFF_BAR, 0, 16384 + 4096, stream);
    void* args[] = {&P};
    hipError_t e = hipLaunchCooperativeKernel((void*)hymba_megakernel, dim3(grid_blocks), dim3(NTHR), args, 0, stream);
    if (e != hipSuccess) fprintf(stderr, "cooperative launch failed: %s (grid %d)\n", hipGetErrorString(e), grid_blocks);
}
```

```cpp
#include <hip/hip_runtime.h>
#include <hip/hip_cooperative_groups.h>
#include <cstdio>
#include <cstdint>
#include <math.h>
#include <climits>
namespace cg = cooperative_groups;

typedef __bf16 bf16;
typedef __bf16 bf16x8 __attribute__((ext_vector_type(8)));
typedef __bf16 bf16x4 __attribute__((ext_vector_type(4)));
typedef __bf16 bf16x2 __attribute__((ext_vector_type(2)));
typedef float f32x16 __attribute__((ext_vector_type(16)));
typedef float f32x4 __attribute__((ext_vector_type(4)));
typedef float f32x2 __attribute__((ext_vector_type(2)));
typedef unsigned u32x4 __attribute__((ext_vector_type(4)));
typedef unsigned u32x2 __attribute__((ext_vector_type(2)));

#define SEQ 2048
#define BATCH 8
#define TOK 16384
#define DM 1024
#define IN_W 1956
#define NEXP 16384
#define EPSF 1e-6f
#define LOG2E 1.4426950408889634f
#define NTHR 512
#define NW 8
#define LDS_BYTES 151808
#define STAGE_BYTES 49152
#define LDS_AUX 147456
#ifndef DUP
#define DUP -1
#endif

constexpr size_t MBy = 1ull << 20;
constexpr size_t OFF_UB = 0;
constexpr size_t OFF_VB = 32 * MBy;
constexpr size_t OFF_PART = 64 * MBy;
#define LDH 1088
#define LDP 320
#define LDC 192
constexpr size_t OFF_WIN = 128 * MBy;
constexpr size_t OFF_WO = 137 * MBy;
constexpr size_t OFF_WQ = 142 * MBy;
constexpr size_t OFF_WG = 147 * MBy;
constexpr size_t OFF_WP = 152 * MBy;
constexpr size_t OFF_WUQ = 154 * MBy;
constexpr size_t OFF_WUKV = 155 * MBy;
constexpr size_t OFF_SKB = 156 * MBy;
constexpr size_t OFF_CS = 157 * MBy;
constexpr size_t OFF_TSC = 159 * MBy;
constexpr size_t OFF_SSA = 160 * MBy;
constexpr size_t OFF_HB0 = 164 * MBy;
constexpr size_t OFF_HB1 = 200 * MBy;
constexpr size_t OFF_FQ = 236 * MBy;
constexpr size_t OFF_FK = 244 * MBy;
constexpr size_t OFF_FVT = 252 * MBy;
constexpr size_t OFF_SQ = 260 * MBy;
constexpr size_t OFF_SKK = 268 * MBy;
constexpr size_t OFF_SVT = 276 * MBy;
constexpr size_t OFF_CQ = 284 * MBy;
constexpr size_t OFF_CKV = 295 * MBy;
constexpr size_t OFF_FLOG = 302 * MBy;
constexpr size_t OFF_CUMF = 303 * MBy;
constexpr size_t OFF_MQ = 304 * MBy;
constexpr size_t OFF_MK = 316 * MBy;
constexpr size_t OFF_MVT = 328 * MBy;
constexpr size_t OFF_Y = 344 * MBy;
constexpr size_t OFF_PQ = 380 * MBy;
constexpr size_t OFF_IDS = 412 * MBy;
constexpr size_t OFF_GATE = 420 * MBy;
constexpr size_t OFF_BAR = 428 * MBy;
constexpr size_t OFF_CNT = OFF_BAR + 16384;
constexpr size_t OFF_SSY = 429 * MBy;
constexpr size_t OFF_PB = 431 * MBy;
constexpr size_t WS_END = 452 * MBy;

struct Params {
    const float* x; const float* p; const int* pos;
    const float* norm_mix_g; const float* w_in; const float* b_forget; const float* mla_q_norm_g; const float* w_uq;
    const float* mla_kv_norm_g; const float* w_ukv; const float* mix_out_norm_g; const float* w_o; const float* norm_ffn_g;
    const float* w_query; const float* sub_keys; const float* peer_u; const float* peer_v; const float* w_ple;
    const float* ple_norm_g; const float* w_ple_gate; const float* final_norm_g;
    float* out; char* ws;
};

__shared__ __attribute__((aligned(16))) char smem[LDS_BYTES];

__device__ __forceinline__ int opaque_tid() { int t = threadIdx.x; asm volatile("" : "+v"(t)); return t; }
template <typename T> __device__ __forceinline__ T* opq(T* p) { size_t z = 0; asm volatile("" : "+s"(z)); return (T*)((char*)p + z); }

__device__ __forceinline__ unsigned pack2(float a, float b) {
    f32x2 v = {a, b};
    bf16x2 r = __builtin_convertvector(v, bf16x2);
    return __builtin_bit_cast(unsigned, r);
}
__device__ __forceinline__ float bflo(unsigned u) { return __uint_as_float(u << 16); }
__device__ __forceinline__ float bfhi(unsigned u) { return __uint_as_float(u & 0xffff0000u); }
__device__ __forceinline__ float wave_sum(float v) {
#pragma unroll
    for (int o = 32; o > 0; o >>= 1) v += __shfl_xor(v, o);
    return v;
}
template <int CTRL> __device__ __forceinline__ float dpp_add(float v) {
    return v + __builtin_bit_cast(float, __builtin_amdgcn_update_dpp(0, __builtin_bit_cast(int, v), CTRL, 0xf, 0xf, true));
}
__device__ __forceinline__ float sum8_dpp(float v) { v = dpp_add<0xB1>(v); v = dpp_add<0x4E>(v); v = dpp_add<0x141>(v); return v; }
__device__ __forceinline__ float sumg_dpp(float v) {
    v = dpp_add<0x128>(v);
    float a = v, b = v;
    asm volatile("s_nop 1\n\tv_permlane16_swap_b32 %0, %1\n\ts_nop 1" : "+v"(a), "+v"(b));
    v = a + b;
    a = v; b = v;
    asm volatile("s_nop 1\n\tv_permlane32_swap_b32 %0, %1\n\ts_nop 1" : "+v"(a), "+v"(b));
    return a + b;
}
__device__ __forceinline__ int partner32(int v, int hh) {
    int a = v, b = v;
    asm volatile("s_nop 1\n\tv_permlane32_swap_b32 %0, %1\n\ts_nop 1" : "+v"(a), "+v"(b));
    return hh ? a : b;
}
__device__ __forceinline__ float fexp2(float x) { return __builtin_amdgcn_exp2f(x); }
__device__ __forceinline__ float flog2(float x) { return __builtin_amdgcn_logf(x); }
__device__ __forceinline__ float log_sigmoid_f(float z) { return fminf(z, 0.f) - log1pf(expf(-fabsf(z))); }

struct WJob { const float* src; int lds; int K; int Np; bf16* dst; int ldd; const float* gain; int map; };

__device__ __forceinline__ int src_col_map(int map, int c) {
    if (map == 0) return c;
    if (map == 1) {
        if (c < 768) return c;
        if (c < 1952) return c + 4;
        if (c < 1956) return c - 1952 + 768;
        return -1;
    }
    if (c < 256) return 192 * (c >> 6) + (c & 63);
    int e = c - 256;
    return 192 * (e >> 7) + 64 + (e & 127);
}

__device__ __forceinline__ void wconv_tile(const WJob& j, int tile) {
    float* tl = (float*)smem;
    int ktiles = j.K >> 5;
    int nt = tile / ktiles, kt = tile % ktiles;
    int n0 = nt * 32, k0 = kt * 32;
    int tx = opaque_tid() & 31, ty = opaque_tid() >> 5;
    int sc = src_col_map(j.map, n0 + tx);
#pragma unroll
    for (int i = 0; i < 2; ++i) {
        int k = k0 + ty + 16 * i;
        float v = 0.f;
        if (sc >= 0) v = j.src[(size_t)k * j.lds + sc] * (j.gain ? j.gain[k] : 1.f);
        tl[(ty + 16 * i) * 33 + tx] = v;
    }
    __syncthreads();
#pragma unroll
    for (int i = 0; i < 2; ++i) {
        int n = n0 + ty + 16 * i;
        j.dst[(size_t)n * j.ldd + k0 + tx] = (bf16)tl[tx * 33 + ty + 16 * i];
    }
    __syncthreads();
}

__device__ __forceinline__ void phase0(const Params& P) {
    char* ws = opq(P.ws);
    const int G = gridDim.x, bid = blockIdx.x, tid = opaque_tid();
    {
        const int w = tid >> 6, l = tid & 63;
        float* tsc = (float*)(ws + OFF_TSC);
        for (int it = bid * NW + w; it < 4 * NEXP; it += G * NW) {
            int tb = it >> 14, e = it & (NEXP - 1);
            const float* src = (tb < 2 ? P.peer_u : P.peer_v) + ((size_t)(tb & 1) * NEXP + e) * DM + l * 16;
            unsigned char* dst = (unsigned char*)(ws + (tb < 2 ? OFF_UB : OFF_VB)) + (size_t)(tb & 1) * NEXP * 512;
            float4 a = ((const float4*)src)[0], b = ((const float4*)src)[1], c = ((const float4*)src)[2], d = ((const float4*)src)[3];
            if (tb < 2) {
                const float4* g4 = (const float4*)(P.norm_ffn_g + (tb & 1) * 1024 + l * 16);
                float4 g0 = g4[0], g1 = g4[1], g2 = g4[2], g3 = g4[3];
                a.x *= g0.x; a.y *= g0.y; a.z *= g0.z; a.w *= g0.w; b.x *= g1.x; b.y *= g1.y; b.z *= g1.z; b.w *= g1.w;
                c.x *= g2.x; c.y *= g2.y; c.z *= g2.z; c.w *= g2.w; d.x *= g3.x; d.y *= g3.y; d.z *= g3.z; d.w *= g3.w;
            }
            float am = fmaxf(fmaxf(fmaxf(fabsf(a.x), fabsf(a.y)), fmaxf(fabsf(a.z), fabsf(a.w))), fmaxf(fmaxf(fabsf(b.x), fabsf(b.y)), fmaxf(fabsf(b.z), fabsf(b.w))));
            am = fmaxf(am, fmaxf(fmaxf(fmaxf(fabsf(c.x), fabsf(c.y)), fmaxf(fabsf(c.z), fabsf(c.w))), fmaxf(fmaxf(fabsf(d.x), fabsf(d.y)), fmaxf(fabsf(d.z), fabsf(d.w)))));
#pragma unroll
            for (int o = 32; o > 0; o >>= 1) am = fmaxf(am, __shfl_xor(am, o));
            float sc = (am > 0.f) ? (6.0f / am) : 1.f, isc = (am > 0.f) ? (am * (1.f / 6.0f)) : 1.f;
            unsigned w0 = 0, w1 = 0;
            w0 = __builtin_amdgcn_cvt_scalef32_pk_fp4_f32(w0, a.x * sc, a.y * sc, 1.0f, 0);
            w0 = __builtin_amdgcn_cvt_scalef32_pk_fp4_f32(w0, a.z * sc, a.w * sc, 1.0f, 1);
            w0 = __builtin_amdgcn_cvt_scalef32_pk_fp4_f32(w0, b.x * sc, b.y * sc, 1.0f, 2);
            w0 = __builtin_amdgcn_cvt_scalef32_pk_fp4_f32(w0, b.z * sc, b.w * sc, 1.0f, 3);
            w1 = __builtin_amdgcn_cvt_scalef32_pk_fp4_f32(w1, c.x * sc, c.y * sc, 1.0f, 0);
            w1 = __builtin_amdgcn_cvt_scalef32_pk_fp4_f32(w1, c.z * sc, c.w * sc, 1.0f, 1);
            w1 = __builtin_amdgcn_cvt_scalef32_pk_fp4_f32(w1, d.x * sc, d.y * sc, 1.0f, 2);
            w1 = __builtin_amdgcn_cvt_scalef32_pk_fp4_f32(w1, d.z * sc, d.w * sc, 1.0f, 3);
            u32x2 o2 = {w0, w1};
            *(u32x2*)(dst + ((size_t)(l >> 4) * NEXP + e) * 128 + (l & 15) * 8) = o2;
            if (l == 0) tsc[tb * NEXP + e] = isc;
        }
    }
    {
        for (int L = 0; L < 2; ++L) {
            WJob jobs[7];
            jobs[0] = {P.w_in + (size_t)L * 1024 * IN_W, IN_W, 1024, 2048, (bf16*)(ws + OFF_WIN) + (size_t)L * 2048 * LDH, LDH, P.norm_mix_g + L * 1024, 1};
            jobs[1] = {P.w_o + (size_t)L * 1024 * 1024, 1024, 1024, 1024, (bf16*)(ws + OFF_WO) + (size_t)L * 1024 * LDH, LDH, P.mix_out_norm_g + L * 1024, 0};
            jobs[2] = {P.w_query + (size_t)L * 1024 * 1024, 1024, 1024, 1024, (bf16*)(ws + OFF_WQ) + (size_t)L * 1024 * LDH, LDH, P.norm_ffn_g + L * 1024, 0};
            jobs[3] = {P.w_ple_gate + (size_t)L * 1024 * 1024, 1024, 1024, 1024, (bf16*)(ws + OFF_WG) + (size_t)L * 1024 * LDH, LDH, P.ple_norm_g + L * 1024, 0};
            jobs[4] = {P.w_ple + (size_t)L * 256 * 1024, 1024, 256, 1024, (bf16*)(ws + OFF_WP) + (size_t)L * 1024 * LDP, LDP, nullptr, 0};
            jobs[5] = {P.w_uq + (size_t)L * 256 * 384, 384, 256, 384, (bf16*)(ws + OFF_WUQ) + (size_t)L * 384 * LDP, LDP, P.mla_q_norm_g + L * 256, 0};
            jobs[6] = {P.w_ukv + (size_t)L * 128 * 768, 768, 128, 768, (bf16*)(ws + OFF_WUKV) + (size_t)L * 768 * LDC, LDC, P.mla_kv_norm_g + L * 128, 2};
#pragma unroll
            for (int q = 0; q < 7; ++q) {
                int nt = (jobs[q].Np >> 5) * (jobs[q].K >> 5);
                for (int it = bid; it < nt; it += G) wconv_tile(jobs[q], it);
            }
        }
    }
    {
        const float* src = P.sub_keys;
        bf16* dst = (bf16*)(ws + OFF_SKB);
        for (int i = bid * NTHR + tid; i < 262144 / 2; i += G * NTHR) {
            float2 v = ((const float2*)src)[i];
            ((unsigned*)dst)[i] = pack2(v.x, v.y);
        }
    }
    {
        const float4* src = (const float4*)P.p;
        bf16* dst = (bf16*)(ws + OFF_PB);
        for (int i = bid * NTHR + tid; i < 2 * TOK * 256 / 8; i += G * NTHR) {
            float4 a = src[2 * i], b = src[2 * i + 1];
            u32x4 o = {pack2(a.x, a.y), pack2(a.z, a.w), pack2(b.x, b.y), pack2(b.z, b.w)};
            *(u32x4*)(dst + (size_t)(i >> 5) * LDP + (i & 31) * 8) = o;
        }
    }
    {
        bf16* hb = (bf16*)(ws + OFF_HB0);
        float* ss0 = (float*)(ws + OFF_SSA);
        int w = tid >> 6, l = tid & 63;
        for (int row = bid * NW + w; row < TOK; row += G * NW) {
            const float4* xr = (const float4*)(P.x + (size_t)row * DM);
            float ss = 0.f;
#pragma unroll
            for (int i = 0; i < 2; ++i) {
                float4 a = xr[i * 128 + l * 2], b = xr[i * 128 + l * 2 + 1];
                ss += a.x * a.x + a.y * a.y + a.z * a.z + a.w * a.w + b.x * b.x + b.y * b.y + b.z * b.z + b.w * b.w;
                uint4 o;
                o.x = pack2(a.x, a.y); o.y = pack2(a.z, a.w); o.z = pack2(b.x, b.y); o.w = pack2(b.z, b.w);
                ((uint4*)(hb + (size_t)row * LDH))[i * 64 + l] = o;
            }
            ss = wave_sum(ss);
            if (l == 0) {
                *(float4*)(ss0 + (size_t)row * 8) = make_float4(ss, 0.f, 0.f, 0.f);
                *(float4*)(ss0 + (size_t)row * 8 + 4) = make_float4(0.f, 0.f, 0.f, 0.f);
            }
        }
    }
    {
        float* cs = (float*)(ws + OFF_CS);
        for (int i = bid * NTHR + tid; i < TOK * 16; i += G * NTHR) {
            int t = i >> 4, k = i & 15;
            float inv = powf(10000.0f, -(float)k / 16.0f);
            float ang = (float)P.pos[t] * inv;
            cs[2 * i] = cosf(ang);
            cs[2 * i + 1] = sinf(ang);
        }
    }
}

struct NoHook { static constexpr bool nodma = false; __device__ __forceinline__ void operator()(int, f32x16 (&)[2][2]) const {} };
struct NoDmaHook { static constexpr bool nodma = true; __device__ __forceinline__ void operator()(int, f32x16 (&)[2][2]) const {} };
template <typename HOOK>
__device__ __forceinline__ void gemm_core(f32x16 (&acc)[2][2], const bf16* A, int lda, const bf16* Bt, int ldb, int K,
                                          int m0, int n0, HOOK hook) {
    const int tid = opaque_tid(), w = tid >> 6, l = tid & 63, r = l & 31, hh = l >> 5;
    const int wm = w >> 1, wn = w & 1;
    const int dp = (tid & 15) ^ ((tid >> 4) & 15);
    const int drow = 2 * (tid >> 4) + (dp >> 3), dgc = (dp & 7) * 8;
    const bf16* asrc = A + (size_t)(m0 + drow) * lda + dgc;
    const bf16* bsrc = Bt + (size_t)(n0 + drow) * ldb + dgc;
    auto dma = [&](int buf, int k0) {
        if (HOOK::nodma) return;
        char* base = smem + buf * STAGE_BYTES + tid * 16;
#pragma unroll
        for (int i = 0; i < 4; ++i)
            __builtin_amdgcn_global_load_lds((const unsigned*)(asrc + (size_t)(64 * i) * lda + k0), (unsigned*)(base + i * 8192), 16, 0, 0);
#pragma unroll
        for (int i = 0; i < 2; ++i)
            __builtin_amdgcn_global_load_lds((const unsigned*)(bsrc + (size_t)(64 * i) * ldb + k0), (unsigned*)(base + 32768 + i * 8192), 16, 0, 0);
    };
    int offA[2], offB[2];
#pragma unroll
    for (int i = 0; i < 2; ++i) { offA[i] = ((wm * 64 + i * 32 + r) >> 1) * 256; offB[i] = 32768 + ((wn * 64 + i * 32 + r) >> 1) * 256; }
    const int pbase = ((r & 1) << 3), lx = (r >> 1) & 15;
    const int nk = K >> 6;
    const unsigned ldsbase = (unsigned)(size_t)(__attribute__((address_space(3))) char*)smem;
    auto ldfrag = [&](int stage, int s, bf16x8 (&af)[2], bf16x8 (&bfr)[2]) {
        unsigned ch = (unsigned)((((pbase | (2 * s + hh)) ^ lx) << 4)) + ldsbase + (unsigned)(stage * STAGE_BYTES);
        unsigned a0a = ch + offA[0], a1a = ch + offA[1], b0a = ch + offB[0], b1a = ch + offB[1];
        asm volatile("ds_read_b128 %0, %4\n\tds_read_b128 %1, %5\n\tds_read_b128 %2, %6\n\tds_read_b128 %3, %7"
                     : "=&v"(af[0]), "=&v"(af[1]), "=&v"(bfr[0]), "=&v"(bfr[1]) : "v"(a0a), "v"(a1a), "v"(b0a), "v"(b1a) : "memory");
    };
    auto mma = [&](bf16x8 (&af)[2], bf16x8 (&bfr)[2]) {
#pragma unroll
        for (int i = 0; i < 2; ++i)
#pragma unroll
            for (int j = 0; j < 2; ++j) acc[i][j] = __builtin_amdgcn_mfma_f32_32x32x16_bf16(af[i], bfr[j], acc[i][j], 0, 0, 0);
    };
#define LGKM_WAIT(n) do { asm volatile("s_waitcnt lgkmcnt(" #n ")" ::: "memory"); __builtin_amdgcn_sched_barrier(0); } while (0)
    asm volatile("s_waitcnt vmcnt(0)" ::: "memory");
    dma(0, 0);
    dma(1, 64);
    if (nk > 2) { dma(2, 128); asm volatile("s_waitcnt vmcnt(12)" ::: "memory"); }
    else asm volatile("s_waitcnt vmcnt(6)" ::: "memory");
    __builtin_amdgcn_s_barrier();
    bf16x8 a0[2], b0[2], a1[2], b1[2];
    ldfrag(0, 0, a0, b0);
    int cur = 0;
    for (int kt = 0; kt < nk; ++kt) {
        const int nxt = (cur == 2) ? 0 : cur + 1;
        if (kt == 4 || kt == 8) { LGKM_WAIT(0); hook(kt, acc); }
        ldfrag(cur, 1, a1, b1);
        LGKM_WAIT(4);
        mma(a0, b0);
        ldfrag(cur, 2, a0, b0);
        LGKM_WAIT(4);
        mma(a1, b1);
        ldfrag(cur, 3, a1, b1);
        LGKM_WAIT(4);
        mma(a0, b0);
        if (kt + 1 < nk) {
            if (kt + 2 < nk) asm volatile("s_waitcnt vmcnt(6) lgkmcnt(0)" ::: "memory");
            else asm volatile("s_waitcnt vmcnt(0) lgkmcnt(0)" ::: "memory");
            __builtin_amdgcn_s_barrier();
            __builtin_amdgcn_sched_barrier(0);
            if (kt + 3 < nk) dma(cur, (kt + 3) << 6);
            ldfrag(nxt, 0, a0, b0);
        } else {
            LGKM_WAIT(0);
        }
        mma(a1, b1);
        cur = nxt;
    }
    __syncthreads();
}
__device__ __forceinline__ float row_rs8(const float* part, int row) {
    float4 a = *(const float4*)(part + (size_t)row * 8), b = *(const float4*)(part + (size_t)row * 8 + 4);
    float ss = ((a.x + a.y) + (a.z + a.w)) + ((b.x + b.y) + (b.z + b.w));
    return rsqrtf(ss * (1.f / 1024.f) + EPSF);
}
__device__ __forceinline__ bool xcd_tile(int it, int MT, int NT, int& mt, int& nt) {
    const int G = gridDim.x, bid = blockIdx.x;
    if ((G & 7) == 0 && (MT & 7) == 0) {
        const int nbx = G >> 3, q = (bid >> 3) + it * nbx, per = (MT >> 3) * NT;
        if (q >= per) return false;
        mt = (bid & 7) * (MT >> 3) + q / NT; nt = q % NT;
        return true;
    }
    const int q = bid + it * G;
    if (q >= MT * NT) return false;
    mt = q / NT; nt = q % NT;
    return true;
}
struct NoScale { __device__ __forceinline__ float operator()(int, int) const { return 1.f; } };

#define ZERO_ACC(acc)                                  \
    _Pragma("unroll") for (int _i = 0; _i < 2; ++_i)   \
    _Pragma("unroll") for (int _j = 0; _j < 2; ++_j)   \
    _Pragma("unroll") for (int _r = 0; _r < 16; ++_r) acc[_i][_j][_r] = 0.f;


namespace pg8 {
#define PG8_LAS __attribute__((address_space(3)))
typedef unsigned short bf16_t;
constexpr int BM = 256, BK = 64, HALF = 128, HTB = HALF * BK * 2  , NXCD = 8, WGM = 8;

__host__ __device__ __forceinline__ int lds_byte(int r, int c) { const int st = (r >> 4) * 2 + (c >> 5), rr = r & 15, cc = c & 31, ob = rr * 64 + cc * 2; return st * 1024 + (ob ^ (((ob >> 9) & 1) << 5)); }
__host__ __device__ __forceinline__ void stage_rc(int b, int& R, int& C) { const int st = b / 1024, sb = b % 1024, swz = sb ^ (((sb >> 9) & 1) << 5); R = (st >> 1) * 16 + swz / 64; C = (st & 1) * 32 + (swz % 64) / 2; }
__host__ __device__ __forceinline__ int perm32(int rho) { const int n = rho >> 4, i = rho & 15; return 8 * (i >> 2) + 4 * n + (i & 3); }
struct Unit { int pm, pn; };
struct Gemm { const bf16* A; const bf16* Bt; int lda, ldb, M, N, K; };
struct StaticOrder {
    int nM, nN, nwg, G, c;
    __device__ void init(int M, int N, int G_, int c_) { nM = M / BM; nN = N / BM; nwg = nM * nN; G = G_; c = c_; }
    __device__ bool next(int i, Unit& u) const {
        const long L = (long)i * G + c; if (L >= nwg) return false;
        int wgid = (int)L; { const int q = nwg / NXCD, r = nwg % NXCD, xcd = wgid % NXCD, off = wgid / NXCD; wgid = (xcd < r ? xcd * (q + 1) : r * (q + 1) + (xcd - r) * q) + off; }
        const int nig = WGM * nN, gid = wgid / nig, fm = gid * WGM, gsz = (nM - fm) < WGM ? (nM - fm) : WGM;
        u.pm = fm + ((wgid % nig) % gsz); u.pn = (wgid % nig) / gsz; return true;
    }
    __device__ __forceinline__ void a_ready(const Unit&) const {}
    __device__ __forceinline__ void done(const Unit&) const {}
};
template <class Epi, class Sched, bool STAMP = false>
__device__ __forceinline__ void gemm_phase(PG8_LAS unsigned char* lds, const Gemm g, const Sched& S, const Epi& E, unsigned long long* stamps) {
    const int tid = opaque_tid(), wid = __builtin_amdgcn_readfirstlane(tid >> 6), lane = tid & 63, wr = wid >> 2, wc = wid & 3, fr = lane & 15, fq = lane >> 4;
    const int K = g.K, nt = K / BK;
    int ts_lo = 0, ts_hi = 0, nts = 0; const unsigned long long rt_entry = STAMP ? (unsigned long long)wall_clock64() : 0ull;
#define PG8_STAMP() do { if (STAMP && wid == 0 && nts < 64) { const unsigned long long _c = (unsigned long long)clock64(); \
        ts_lo = (lane == nts) ? (int)(unsigned)_c : ts_lo; ts_hi = (lane == nts) ? (int)(unsigned)(_c >> 32) : ts_hi; ++nts; } } while (0)
    PG8_STAMP();
    unsigned voffA[2], voffB[2];
#pragma unroll
    for (int i = 0; i < 2; ++i) { int R, C; stage_rc(tid * 16 + i * 8192, R, C); const int Rb = Epi::PERM ? ((R & ~31) + perm32(R & 31)) : R;
        voffA[i] = (unsigned)(R * g.lda + C) * 2u; voffB[i] = (unsigned)(Rb * g.ldb + C) * 2u; }
    const size_t kstep = (size_t)(BK * 2);
    const size_t hstepA = (size_t)HALF * g.lda * 2, hstepB = (size_t)HALF * g.ldb * 2;
    const size_t tstepA = 2 * hstepA, tstepB = 2 * hstepB;
    const unsigned ldsw = (unsigned)wid * 1024u;
    const int aoff = lds_byte(wr * 64 + fr, fq * 8), boff = lds_byte(wc * 32 + fr, fq * 8);
#define PG8_SA(b, h) (((b) * 2 + (h)) * HTB)
#define PG8_SB(b, h) ((4 + (b) * 2 + (h)) * HTB)
#define PG8_STAGE(bufoff, gbase, voff) do { _Pragma("unroll") for (int _i = 0; _i < 2; ++_i) \
        __builtin_amdgcn_global_load_lds((const unsigned*)((const char*)(gbase) + (voff)[_i]), (PG8_LAS unsigned*)(lds + (bufoff) + ldsw + _i * 8192), 16, 0, 0); } while (0)
#define PG8_LDA(dst, b, h) do { _Pragma("unroll") for (int m = 0; m < 4; ++m) _Pragma("unroll") for (int k = 0; k < 2; ++k) dst[m][k] = *(const PG8_LAS bf16x8*)(lds + PG8_SA(b, h) + aoff + m * 2048 + k * 1024); } while (0)
#define PG8_LDB(dst, b, h) do { _Pragma("unroll") for (int n = 0; n < 2; ++n) _Pragma("unroll") for (int k = 0; k < 2; ++k) dst[n][k] = *(const PG8_LAS bf16x8*)(lds + PG8_SB(b, h) + boff + n * 2048 + k * 1024); } while (0)
#define PG8_MMA(ai, bj, At, Bt) do { __builtin_amdgcn_s_setprio(1); _Pragma("unroll") for (int m = 0; m < 4; ++m) _Pragma("unroll") for (int n = 0; n < 2; ++n) _Pragma("unroll") for (int k = 0; k < 2; ++k) \
        acc[ai][bj][m][n] = __builtin_amdgcn_mfma_f32_16x16x32_bf16(Bt[n][k], At[m][k], acc[ai][bj][m][n], 0, 0, 0); __builtin_amdgcn_s_setprio(0); } while (0)
#define PG8_WAIT_V(n) asm volatile("s_waitcnt vmcnt(" #n ")" ::: "memory")
#define PG8_WAIT_L(n) asm volatile("s_waitcnt lgkmcnt(" #n ")" ::: "memory")
#define PG8_BAR __builtin_amdgcn_s_barrier()
#define PG8_SCHED __builtin_amdgcn_sched_barrier(0)
    Unit cur, nxt; int ui = 0;
    if (!S.next(0, cur)) return;
    f32x4 acc[2][2][4][2];
#pragma unroll
    for (int a = 0; a < 2; ++a)
#pragma unroll
        for (int b = 0; b < 2; ++b)
#pragma unroll
            for (int m = 0; m < 4; ++m)
#pragma unroll
                for (int n = 0; n < 2; ++n) acc[a][b][m][n] = (f32x4){0.f, 0.f, 0.f, 0.f};
    bf16x8 At[4][2], B0[2][2], B1[2][2];
    const char* cA = (const char*)g.A + (size_t)cur.pm * tstepA; const char* cB = (const char*)g.Bt + (size_t)cur.pn * tstepB;
    S.a_ready(cur);
    PG8_STAGE(PG8_SB(0, 0), cB, voffB); PG8_STAGE(PG8_SA(0, 0), cA, voffA); PG8_STAGE(PG8_SB(0, 1), cB + hstepB, voffB); PG8_STAGE(PG8_SA(0, 1), cA + hstepA, voffA);
    if (wr == 1) PG8_BAR;
    PG8_WAIT_V(4); PG8_BAR;
    PG8_STAGE(PG8_SB(1, 0), cB + kstep, voffB); PG8_STAGE(PG8_SA(1, 0), cA + kstep, voffA); PG8_STAGE(PG8_SB(1, 1), cB + hstepB + kstep, voffB);
    PG8_WAIT_V(6); PG8_BAR;
    PG8_STAMP();
    for (;;) {
        const bool has_next = S.next(ui + 1, nxt);
        const char* nA = has_next ? (const char*)g.A + (size_t)nxt.pm * tstepA : cA; const char* nB = has_next ? (const char*)g.Bt + (size_t)nxt.pn * tstepB : cB;
        for (int t = 0; t < nt; t += 2) {
            const bool last = (t == nt - 2);
            const char* a1 = cA + (size_t)(t + 1) * kstep;
            const char* a2 = last ? nA : cA + (size_t)(t + 2) * kstep; const char* b2 = last ? nB : cB + (size_t)(t + 2) * kstep;
            const char* a3 = a2 + kstep; const char* b3 = b2 + kstep;
            if (last && has_next) S.a_ready(nxt);
            E.khook(t, acc, wr, fr);
            PG8_LDB(B0, 0, 0); PG8_SCHED; PG8_LDA(At, 0, 0); PG8_STAGE(PG8_SA(1, 1), a1 + hstepA, voffA);
            PG8_WAIT_L(8); PG8_BAR; PG8_WAIT_L(0); PG8_MMA(0, 0, At, B0); PG8_BAR; PG8_SCHED;
            PG8_LDB(B1, 0, 1); PG8_STAGE(PG8_SB(0, 0), b2, voffB);
            PG8_BAR; PG8_WAIT_L(0); PG8_MMA(0, 1, At, B1); PG8_BAR;
            PG8_LDA(At, 0, 1); PG8_STAGE(PG8_SA(0, 0), a2, voffA);
            PG8_BAR; PG8_WAIT_L(0); PG8_MMA(1, 0, At, B0); PG8_BAR; PG8_SCHED;
            PG8_STAGE(PG8_SB(0, 1), b2 + hstepB, voffB);
            PG8_WAIT_V(6); PG8_BAR; PG8_MMA(1, 1, At, B1); PG8_BAR;
            PG8_LDB(B0, 1, 0); PG8_SCHED; PG8_LDA(At, 1, 0); PG8_STAGE(PG8_SA(0, 1), a2 + hstepA, voffA);
            PG8_WAIT_L(8); PG8_BAR; PG8_WAIT_L(0); PG8_MMA(0, 0, At, B0); PG8_BAR; PG8_SCHED;
            PG8_LDB(B1, 1, 1); PG8_STAGE(PG8_SB(1, 0), b3, voffB);
            PG8_BAR; PG8_WAIT_L(0); PG8_MMA(0, 1, At, B1); PG8_BAR;
            PG8_LDA(At, 1, 1); PG8_STAGE(PG8_SA(1, 0), a3, voffA);
            PG8_BAR; PG8_WAIT_L(0); PG8_MMA(1, 0, At, B0); PG8_BAR; PG8_SCHED;
            PG8_STAGE(PG8_SB(1, 1), b3 + hstepB, voffB);
            PG8_WAIT_V(6); PG8_BAR; PG8_MMA(1, 1, At, B1); PG8_BAR;
        }
        PG8_STAMP();
        if constexpr (!Epi::AFTER_DRAIN) { E(acc, cur, wr, wc, fr, fq); S.done(cur); }
        PG8_STAMP();
        if (!has_next) break;
#pragma unroll
        for (int a = 0; a < 2; ++a)
#pragma unroll
            for (int b = 0; b < 2; ++b)
#pragma unroll
                for (int m = 0; m < 4; ++m)
#pragma unroll
                    for (int n = 0; n < 2; ++n) acc[a][b][m][n] = (f32x4){0.f, 0.f, 0.f, 0.f};
        cur = nxt; cA = nA; cB = nB; ++ui;
    }
    PG8_WAIT_V(0);
    if (wr == 0) PG8_BAR;
    PG8_BAR;
    if constexpr (Epi::AFTER_DRAIN) { E.fused(acc, cur, wr, wc, fr, fq, lds, wid, lane); S.done(cur); }
    PG8_STAMP();
    if (STAMP && wid == 0) { stamps[lane] = lane < nts ? (((unsigned long long)(unsigned)ts_hi << 32) | (unsigned)ts_lo) : 0ull;
        if (lane == 62) stamps[62] = rt_entry; if (lane == 63) stamps[63] = (unsigned long long)wall_clock64(); }
#undef PG8_STAMP
#undef PG8_SA
#undef PG8_SB
#undef PG8_STAGE
#undef PG8_LDA
#undef PG8_LDB
#undef PG8_MMA
#undef PG8_WAIT_V
#undef PG8_WAIT_L
#undef PG8_BAR
#undef PG8_SCHED
}
}

#define TB_LD 136
#define TF_LD 132
template <bool SCALE>
__device__ __forceinline__ void stage_bf16(const f32x16 (&acc)[2][2], const float* rsl) {
    bf16* T = (bf16*)smem;
    const int tid = opaque_tid(), w = tid >> 6, l = tid & 63, hh = l >> 5, wm = w >> 1, wn = w & 1;
#pragma unroll
    for (int i = 0; i < 2; ++i)
#pragma unroll
        for (int rr = 0; rr < 16; ++rr) {
            int row = wm * 64 + i * 32 + (rr & 3) + 8 * (rr >> 2) + 4 * hh;
            float sc = SCALE ? rsl[row] : 1.f;
#pragma unroll
            for (int j = 0; j < 2; ++j) T[row * TB_LD + wn * 64 + j * 32 + (l & 31)] = (bf16)(acc[i][j][rr] * sc);
        }
    __syncthreads();
}
template <bool SCALE>
__device__ __forceinline__ void stage_f32(const f32x16 (&acc)[2][2], const float* rsl) {
    float* T = (float*)smem;
    const int tid = opaque_tid(), w = tid >> 6, l = tid & 63, hh = l >> 5, wm = w >> 1, wn = w & 1;
#pragma unroll
    for (int i = 0; i < 2; ++i)
#pragma unroll
        for (int rr = 0; rr < 16; ++rr) {
            int row = wm * 64 + i * 32 + (rr & 3) + 8 * (rr >> 2) + 4 * hh;
            float sc = SCALE ? rsl[row] : 1.f;
#pragma unroll
            for (int j = 0; j < 2; ++j) T[row * TF_LD + wn * 64 + j * 32 + (l & 31)] = acc[i][j][rr] * sc;
        }
    __syncthreads();
}
template <typename CMAP>
__device__ __forceinline__ void store_rows_bf16(bf16* dst, int ld, int m0, CMAP cmap) {
    const bf16* T = (const bf16*)smem;
    const int tid = opaque_tid();
#pragma unroll
    for (int q = 0; q < 8; ++q) {
        int id = tid + 512 * q, row = id >> 4, ch = id & 15;
        u32x4 v = *(const u32x4*)(T + row * TB_LD + ch * 8);
        *(u32x4*)(dst + (size_t)(m0 + row) * ld + cmap(ch * 8)) = v;
    }
}
__device__ __forceinline__ void store_cols_bf16(bf16* vt, size_t crow0, int s0) {
    const unsigned short* T = (const unsigned short*)smem;
    const int tid = opaque_tid();
#pragma unroll
    for (int q = 0; q < 8; ++q) {
        int id = tid + 512 * q, c = id & 127, sg = id >> 7;
        unsigned e[8];
#pragma unroll
        for (int k = 0; k < 8; ++k) e[k] = T[(8 * sg + k) * TB_LD + c];
        u32x4 v = {e[0] | (e[1] << 16), e[2] | (e[3] << 16), e[4] | (e[5] << 16), e[6] | (e[7] << 16)};
        *(u32x4*)(vt + (crow0 + c) * SEQ + s0 + 8 * sg) = v;
    }
}
__device__ __forceinline__ void residual_store(const float* hin, float* hout, bf16* hb_out, float* gss, int m0, int n0, int nt) {
    const float* T = (const float*)smem;
    const int tid = opaque_tid(), l = tid & 63;
#pragma unroll 4
    for (int q = 0; q < 16; ++q) {
        int id = tid + 512 * q, row = id >> 5, ch = id & 31;
        f32x4 d = *(const f32x4*)(T + row * TF_LD + ch * 4);
        size_t gi = (size_t)(m0 + row) * 1024 + n0 + ch * 4;
        f32x4 h = *(const f32x4*)(hin + gi);
        f32x4 v = h + d;
        *(f32x4*)(hout + gi) = v;
        u32x2 b = {pack2(v.x, v.y), pack2(v.z, v.w)};
        *(u32x2*)(hb_out + (size_t)(m0 + row) * LDH + n0 + ch * 4) = b;
        float ss = v.x * v.x + v.y * v.y + v.z * v.z + v.w * v.w;
        ss = dpp_add<0xB1>(ss); ss = dpp_add<0x4E>(ss); ss = dpp_add<0x141>(ss); ss = dpp_add<0x140>(ss);
        ss += __shfl_xor(ss, 16);
        if ((l & 31) == 0) gss[(size_t)(m0 + row) * 8 + nt] = ss;
    }
}
struct ColAdd { int off; __device__ __forceinline__ int operator()(int c) const { return c + off; } };
struct ColHead96 { __device__ __forceinline__ int operator()(int c) const { return (c >> 6) * 96 + (c & 63); } };

__device__ __forceinline__ void phase_proj(const Params& P, int L, int hsel, const float* ssrow) {
    char* ws = opq(P.ws);
    const bf16* hb = (const bf16*)(ws + (hsel ? OFF_HB1 : OFF_HB0));
    const bf16* Bt = (const bf16*)(ws + OFF_WIN) + (size_t)L * 2048 * LDH;
    bf16* fq = (bf16*)(ws + OFF_FQ); bf16* fk = (bf16*)(ws + OFF_FK); bf16* fvt = (bf16*)(ws + OFF_FVT);
    bf16* sq = (bf16*)(ws + OFF_SQ); bf16* sk = (bf16*)(ws + OFF_SKK); bf16* svt = (bf16*)(ws + OFF_SVT);
    bf16* cq = (bf16*)(ws + OFF_CQ); bf16* ckv = (bf16*)(ws + OFF_CKV);
    float* flog = (float*)(ws + OFF_FLOG);
    bf16* mk = (bf16*)(ws + OFF_MK);
    const float* cs = (const float*)(ws + OFF_CS);
    const int tid = opaque_tid(), w = tid >> 6, l = tid & 63, hh = l >> 5, wm = w >> 1, wn = w & 1;
    for (int it = 0;; ++it) {
        int mt, nt;
        if (!xcd_tile(it, 64, 16, mt, nt)) break;
        int m0 = mt * 256, n0 = nt * 128;
        float* aux = (float*)(smem + LDS_AUX);
        if (tid < 256) aux[tid] = row_rs8(ssrow, m0 + tid);
        f32x16 acc[2][2];
        ZERO_ACC(acc);
        gemm_core(acc, hb, LDH, Bt, LDH, 1024, m0, n0, NoHook());
        if (nt < 15) {
            stage_bf16<true>(acc, aux);
            if (nt == 4 || nt == 5 || nt == 10 || nt == 11) {
                bf16* vt = (nt < 6) ? fvt : svt;
                int cbase = n0 - ((nt < 6) ? 512 : 1280);
                store_cols_bf16(vt, (size_t)(m0 >> 11) * 256 + cbase, m0 & 2047);
            } else if (nt < 2) store_rows_bf16(fq, 256, m0, ColAdd{n0});
            else if (nt < 4) store_rows_bf16(fk, 256, m0, ColAdd{n0 - 256});
            else if (nt < 8) store_rows_bf16(sq, 256, m0, ColAdd{n0 - 768});
            else if (nt < 10) store_rows_bf16(sk, 256, m0, ColAdd{n0 - 1024});
            else if (nt < 14) store_rows_bf16(cq, LDP, m0, ColAdd{n0 - 1536});
            else store_rows_bf16(ckv, LDC, m0, ColAdd{0});
        } else {
            if (wn == 0) {
#pragma unroll
                for (int i = 0; i < 2; ++i) {
                    int rloc = wm * 64 + i * 32 + 4 * hh;
                    int ci = l & 31, pi = ci & 15;
#pragma unroll
                    for (int rr = 0; rr < 16; ++rr) {
                        int rl = rloc + (rr & 3) + 8 * (rr >> 2), row = m0 + rl;
                        float rs = aux[rl];
                        float v = acc[i][0][rr] * rs;
                        float pv = __shfl_xor(v, 16);
                        float2 c_s = *(const float2*)(cs + ((size_t)row * 16 + pi) * 2);
                        float o = (ci < 16) ? (v * c_s.x - pv * c_s.y) : (pv * c_s.y + v * c_s.x);
                        bf16 ob = (bf16)o;
#pragma unroll
                        for (int h = 0; h < 4; ++h) mk[(size_t)row * 384 + h * 96 + 64 + ci] = ob;
                        if (ci < 4) flog[(size_t)row * 4 + ci] = acc[i][1][rr] * rs;
                    }
                }
            }
        }
        __syncthreads();
    }
}

template <int KW>
__device__ __forceinline__ void row_rms_to_lds(const bf16* A, int lda, int m0) {
    const int tid = opaque_tid(), row = tid >> 1, half = tid & 1;
    float ss = 0.f;
    const u32x4* p = (const u32x4*)(A + (size_t)(m0 + row) * lda + half * (KW / 2));
#pragma unroll
    for (int q = 0; q < KW / 16; ++q) {
        u32x4 v = p[q];
        float a;
        a = bflo(v.x); ss += a * a; a = bfhi(v.x); ss += a * a;
        a = bflo(v.y); ss += a * a; a = bfhi(v.y); ss += a * a;
        a = bflo(v.z); ss += a * a; a = bfhi(v.z); ss += a * a;
        a = bflo(v.w); ss += a * a; a = bfhi(v.w); ss += a * a;
    }
    ss += __shfl_xor(ss, 1);
    if (half == 0) ((float*)(smem + LDS_AUX))[row] = rsqrtf(ss * (1.f / (float)KW) + EPSF);
}

__device__ __forceinline__ void phase_mla_up(const Params& P, int L) {
    char* ws = opq(P.ws);
    const bf16* cq = (const bf16*)(ws + OFF_CQ); const bf16* ckv = (const bf16*)(ws + OFF_CKV);
    const bf16* wuq = (const bf16*)(ws + OFF_WUQ) + (size_t)L * 384 * LDP;
    const bf16* wukv = (const bf16*)(ws + OFF_WUKV) + (size_t)L * 768 * LDC;
    bf16* mq = (bf16*)(ws + OFF_MQ); bf16* mk = (bf16*)(ws + OFF_MK); bf16* mvt = (bf16*)(ws + OFF_MVT);
    const float* cs = (const float*)(ws + OFF_CS);
    const float* flog = (const float*)(ws + OFF_FLOG);
    float* cumF = (float*)(ws + OFF_CUMF);
    const int tid = opaque_tid(), w = tid >> 6, l = tid & 63, hh = l >> 5, wm = w >> 1, wn = w & 1;
    const int NQ = 64 * 3, NKV = 64 * 6, NCF = 4;
    const float* aux = (const float*)(smem + LDS_AUX);
    for (int item = blockIdx.x; item < NQ + NKV + NCF; item += gridDim.x) {
        if (item < NQ) {
            int mt = item / 3, nt = item % 3;
            int m0 = mt * 256, n0 = nt * 128;
            __syncthreads();
            row_rms_to_lds<256>(cq, LDP, m0);
            f32x16 acc[2][2];
            ZERO_ACC(acc);
            gemm_core(acc, cq, LDP, wuq, LDP, 256, m0, n0, NoHook());
#pragma unroll
            for (int i = 0; i < 2; ++i)
#pragma unroll
                for (int j = 0; j < 2; ++j) {
                    int c0 = n0 + wn * 64 + j * 32;
                    int rloc = wm * 64 + i * 32 + 4 * hh;
                    bool rot = (c0 % 96) == 64;
                    int ci = l & 31, pi = ci & 15;
#pragma unroll
                    for (int rr = 0; rr < 16; ++rr) {
                        int rl = rloc + (rr & 3) + 8 * (rr >> 2);
                        float v = acc[i][j][rr] * aux[rl];
                        if (rot) {
                            float pv = __shfl_xor(v, 16);
                            float2 c_s = *(const float2*)(cs + ((size_t)(m0 + rl) * 16 + pi) * 2);
                            v = (ci < 16) ? (v * c_s.x - pv * c_s.y) : (pv * c_s.y + v * c_s.x);
                        }
                        acc[i][j][rr] = v;
                    }
                }
            stage_bf16<false>(acc, nullptr);
            store_rows_bf16(mq, 384, m0, ColAdd{n0});
        } else if (item < NQ + NKV) {
            int it2 = item - NQ;
            int mt = it2 / 6, nt = it2 % 6;
            int m0 = mt * 256, n0 = nt * 128;
            __syncthreads();
            row_rms_to_lds<128>(ckv, LDC, m0);
            f32x16 acc[2][2];
            ZERO_ACC(acc);
            gemm_core(acc, ckv, LDC, wukv, LDC, 128, m0, n0, NoHook());
            stage_bf16<true>(acc, aux);
            if (nt < 2) {
                const int nb0 = n0;
                struct CM { int n0; __device__ __forceinline__ int operator()(int c) const { int col = n0 + c; return (col >> 6) * 96 + (col & 63); } };
                store_rows_bf16(mk, 384, m0, CM{nb0});
            } else {
                store_cols_bf16(mvt, (size_t)(m0 >> 11) * 512 + (n0 - 256), m0 & 2047);
            }
        } else {
            int seq = (item - NQ - NKV) * NW + w;
            int b = seq >> 2, h = seq & 3;
            float bfv = P.b_forget[L * 4 + h];
            float vals[32];
            float run = 0.f;
#pragma unroll
            for (int i = 0; i < 32; ++i) {
                int s = l * 32 + i;
                float z = flog[((size_t)b * SEQ + s) * 4 + h] + bfv;
                run += log_sigmoid_f(z);
                vals[i] = run;
            }
            float tot = run, incl = tot;
#pragma unroll
            for (int o = 1; o < 64; o <<= 1) {
                float t = __shfl_up(incl, o);
                if (l >= o) incl += t;
            }
            float excl = incl - tot;
#pragma unroll
            for (int i = 0; i < 32; ++i) cumF[(size_t)seq * SEQ + l * 32 + i] = vals[i] + excl;
        }
    }
}

template <int MODE, int DK, int DV>
__device__ __forceinline__ void attn_item(const bf16* __restrict__ Q, int ldq, const bf16* __restrict__ Kg, int ldk,
                          const bf16* __restrict__ Vt, const float* __restrict__ cumF, bf16* __restrict__ Y,
                          float* __restrict__ ssy, int b, int h, int qb, float c1, char* lds, int fake = 0) {
    constexpr int KSTR = DK * 2 + 16;
    constexpr int VSTR = 144;
    constexpr int KBYTES = 64 * KSTR, VBYTES = DV * VSTR;
    constexpr int BUF = (KBYTES + VBYTES + 256 + 255) & ~255;
    static_assert(2 * BUF <= 65536, "lds");
    constexpr int KCH = DK / 8, KPT = (64 * KCH) / 256, VPT = (DV * 8) / 256;
    const int tid = opaque_tid() & 255, w = tid >> 6, l = tid & 63, r = l & 31, hh = l >> 5;
    const int q0 = qb * 128;
    const int qrow = q0 + 32 * w + r;
    const size_t tok = (size_t)b * SEQ + qrow;
    const int bh = b * 4 + h;
    bf16x8 qf[DK / 16];
#pragma unroll
    for (int s = 0; s < DK / 16; ++s) qf[s] = *(const bf16x8*)(Q + tok * ldq + h * DK + 16 * s + 8 * hh);
    f32x16 o[DV / 32];
    const f32x16 zero16 = {0.f, 0.f, 0.f, 0.f, 0.f, 0.f, 0.f, 0.f, 0.f, 0.f, 0.f, 0.f, 0.f, 0.f, 0.f, 0.f};
#pragma unroll
    for (int d = 0; d < DV / 32; ++d) o[d] = zero16;
    float m = -1e30f, lsum = 0.f, R = 0.f;
    float Fq = 0.f;
    if (MODE == 0) Fq = cumF[(size_t)bh * SEQ + qrow] * LOG2E;
    const int nkt = (q0 + 128) >> 6;
    u32x4 kregA[KPT], vregA[VPT], kregB[KPT], vregB[VPT];
    float4 fregA = {0.f, 0.f, 0.f, 0.f}, fregB = {0.f, 0.f, 0.f, 0.f};
    auto gload = [&](int kt, u32x4 (&kreg)[KPT], u32x4 (&vreg)[VPT], float4& freg) {
#pragma unroll
        for (int i = 0; i < KPT; ++i) {
            int e = tid + 256 * i;
            int row = e / KCH, ch = e % KCH;
            kreg[i] = *(const u32x4*)(Kg + ((size_t)b * SEQ + kt * 64 + row) * ldk + h * DK + ch * 8);
        }
#pragma unroll
        for (int i = 0; i < VPT; ++i) {
            int e = tid + 256 * i;
            int row = e >> 3, ch = e & 7;
            vreg[i] = *(const u32x4*)(Vt + ((size_t)bh * DV + row) * SEQ + kt * 64 + ch * 8);
        }
        if (MODE == 0 && tid < 16) freg = *(const float4*)(cumF + (size_t)bh * SEQ + kt * 64 + tid * 4);
    };
    auto lwrite = [&](int buf, u32x4 (&kreg)[KPT], u32x4 (&vreg)[VPT], float4& freg) {
        char* base = lds + buf * BUF;
#pragma unroll
        for (int i = 0; i < KPT; ++i) {
            int e = tid + 256 * i;
            int row = e / KCH, ch = e % KCH;
            *(u32x4*)(base + row * KSTR + ch * 16) = kreg[i];
        }
#pragma unroll
        for (int i = 0; i < VPT; ++i) {
            int e = tid + 256 * i;
            int row = e >> 3, ch = e & 7;
            *(u32x4*)(base + KBYTES + row * VSTR + ch * 16) = vreg[i];
        }
        if (MODE == 0 && tid < 16) { float4 fn = {-freg.x * LOG2E, -freg.y * LOG2E, -freg.z * LOG2E, -freg.w * LOG2E}; *(float4*)(base + KBYTES + VBYTES + tid * 16) = fn; }
    };
    const int prow = (r & 0x13) | ((r & 4) << 1) | ((r & 8) >> 1);
    auto ktof = [&](int it) { return (MODE == 1) ? (nkt - 1 - it) : it; };
    gload(ktof(0), kregA, vregA, fregA);
    lwrite(0, kregA, vregA, fregA);
    constexpr bool D2 = (MODE != 2);
    if (D2 && nkt > 1) gload(ktof(1), kregB, vregB, fregB);
    __syncthreads();
    auto tile = [&](int it, u32x4 (&kn)[KPT], u32x4 (&vn)[VPT], float4& fn2, u32x4 (&kf)[KPT], u32x4 (&vf2)[VPT], float4& ff) {
        const int kt = ktof(it);
        if (!(fake & 1)) {
        if (D2) { if (it + 2 < nkt) gload(ktof(it + 2), kf, vf2, ff); }
        else { if (it + 1 < nkt) gload(ktof(it + 1), kf, vf2, ff); }
        }
        const char* base = lds + (it & 1) * BUF;
        const bool active = (kt * 64) <= (q0 + 32 * w + 31);
        if (active) {
            const bool needmask = (kt * 64 + 63) >= (q0 + 32 * w);
            f32x16 s[2];
#pragma unroll
            for (int sub = 0; sub < 2; ++sub) {
                s[sub] = zero16;
#pragma unroll
                for (int ks = 0; ks < DK / 16; ++ks) {
                    bf16x8 kf = *(const bf16x8*)(base + (sub * 32 + prow) * KSTR + (2 * ks + hh) * 16);
                    s[sub] = __builtin_amdgcn_mfma_f32_32x32x16_bf16(kf, qf[ks], s[sub], 0, 0, 0);
                }
            }
            bf16x8 pf[2][2];
            if (fake & 2) {
#pragma unroll
                for (int sub = 0; sub < 2; ++sub)
#pragma unroll
                    for (int a = 0; a < 2; ++a) {
                        uint4 u;
                        u.x = pack2(s[sub][8 * a], s[sub][8 * a + 1]); u.y = pack2(s[sub][8 * a + 2], s[sub][8 * a + 3]);
                        u.z = pack2(s[sub][8 * a + 4], s[sub][8 * a + 5]); u.w = pack2(s[sub][8 * a + 6], s[sub][8 * a + 7]);
                        pf[sub][a] = __builtin_bit_cast(bf16x8, u);
                    }
                lsum = 1.f;
            } else if (MODE != 1) {
                const float* Ft = (const float*)(base + KBYTES + VBYTES);
                float mx = -INFINITY;
                float tv[2][16];
#pragma unroll
                for (int sub = 0; sub < 2; ++sub)
#pragma unroll
                    for (int a = 0; a < 2; ++a) {
                        int kofs = sub * 32 + 16 * a + 8 * hh;
                        float fk[8];
                        if (MODE == 0) {
                            float4 f0 = *(const float4*)(Ft + kofs), f1 = *(const float4*)(Ft + kofs + 4);
                            fk[0] = f0.x; fk[1] = f0.y; fk[2] = f0.z; fk[3] = f0.w; fk[4] = f1.x; fk[5] = f1.y; fk[6] = f1.z; fk[7] = f1.w;
                        }
#pragma unroll
                        for (int j = 0; j < 8; ++j) {
                            int rr = 8 * a + j;
                            float v = (MODE == 0) ? fmaf(s[sub][rr], c1, fk[j]) : s[sub][rr] * c1;
                            tv[sub][rr] = v;
                        }
                    }
                if (needmask) {
#pragma unroll
                    for (int sub = 0; sub < 2; ++sub)
#pragma unroll
                        for (int rr = 0; rr < 16; ++rr) {
                            int key = kt * 64 + sub * 32 + 16 * (rr >> 3) + 8 * hh + (rr & 7);
                            if (key > qrow) tv[sub][rr] = -INFINITY;
                        }
                }
#pragma unroll
                for (int sub = 0; sub < 2; ++sub)
#pragma unroll
                    for (int rr = 0; rr < 16; ++rr) mx = fmaxf(mx, tv[sub][rr]);
                mx = fmaxf(mx, __builtin_bit_cast(float, partner32(__builtin_bit_cast(int, mx), hh)));
                float mnew = fmaxf(m, mx);
                float rsum = 0.f;
#pragma unroll
                for (int sub = 0; sub < 2; ++sub)
#pragma unroll
                    for (int a = 0; a < 2; ++a) {
                        float pv[8];
#pragma unroll
                        for (int j = 0; j < 8; ++j) { pv[j] = fexp2(tv[sub][8 * a + j] - mnew); rsum += pv[j]; }
                        uint4 u;
                        u.x = pack2(pv[0], pv[1]); u.y = pack2(pv[2], pv[3]); u.z = pack2(pv[4], pv[5]); u.w = pack2(pv[6], pv[7]);
                        pf[sub][a] = __builtin_bit_cast(bf16x8, u);
                    }
                rsum += __builtin_bit_cast(float, partner32(__builtin_bit_cast(int, rsum), hh));
                if (__builtin_amdgcn_ballot_w64(mnew != m) != 0ull) {
                    float alpha = fexp2(m - mnew);
                    lsum *= alpha;
#pragma unroll
                    for (int d = 0; d < DV / 32; ++d) o[d] = o[d] * alpha;
                    m = mnew;
                }
                lsum += rsum;
            } else {
#pragma unroll
                for (int sb = 0; sb < 2; ++sb) {
                    const int sub = 1 - sb;
                    float lsig[16], lneg[16];
                    float A0 = 0.f, A1 = 0.f;
#pragma unroll
                    for (int rr = 0; rr < 16; ++rr) {
                        int key = kt * 64 + sub * 32 + 16 * (rr >> 3) + 8 * hh + (rr & 7);
                        bool valid = key < qrow;
                        float z = s[sub][rr] * c1;
                        float e = fexp2(-fabsf(z));
                        float l1p = flog2(1.f + e);
                        float ls = fminf(z, 0.f) - l1p;
                        float ln = valid ? (ls - z) : 0.f;
                        lsig[rr] = valid ? ls : -INFINITY;
                        lneg[rr] = ln;
                        if (rr < 8) A0 += ln; else A1 += ln;
                    }
                    float B0 = __shfl_xor(A0, 32), B1 = __shfl_xor(A1, 32);
                    float base1 = (hh == 0) ? (R + B1) : R;
                    float base0 = (hh == 0) ? (R + B1 + A1 + B0) : (R + A1 + B1);
                    float wv[16];
                    float run = base1;
#pragma unroll
                    for (int j = 7; j >= 0; --j) { wv[8 + j] = fexp2(lsig[8 + j] + run); run += lneg[8 + j]; }
                    run = base0;
#pragma unroll
                    for (int j = 7; j >= 0; --j) { wv[j] = fexp2(lsig[j] + run); run += lneg[j]; }
                    R += A0 + A1 + B0 + B1;
#pragma unroll
                    for (int a = 0; a < 2; ++a) {
                        uint4 u;
                        u.x = pack2(wv[8 * a], wv[8 * a + 1]); u.y = pack2(wv[8 * a + 2], wv[8 * a + 3]);
                        u.z = pack2(wv[8 * a + 4], wv[8 * a + 5]); u.w = pack2(wv[8 * a + 6], wv[8 * a + 7]);
                        pf[sub][a] = __builtin_bit_cast(bf16x8, u);
                    }
                }
            }
#pragma unroll
            for (int d = 0; d < DV / 32; ++d)
#pragma unroll
                for (int sub = 0; sub < 2; ++sub)
#pragma unroll
                    for (int a = 0; a < 2; ++a) {
                        bf16x8 vf = *(const bf16x8*)(base + KBYTES + (d * 32 + r) * VSTR + (sub * 32 + 16 * a + 8 * hh) * 2);
                        o[d] = __builtin_amdgcn_mfma_f32_32x32x16_bf16(vf, pf[sub][a], o[d], 0, 0, 0);
                    }
        }
        if (!(fake & 1)) { if (it + 1 < nkt) lwrite((it + 1) & 1, kn, vn, fn2); }
        __syncthreads();
    };
    if (D2) {
        for (int it = 0; it < nkt; it += 2) {
            tile(it, kregB, vregB, fregB, kregA, vregA, fregA);
            if (it + 1 < nkt) tile(it + 1, kregA, vregA, fregA, kregB, vregB, fregB);
        }
    } else {
        for (int it = 0; it < nkt; ++it) tile(it, kregA, vregA, fregA, kregA, vregA, fregA);
    }
    float inv = (MODE == 1) ? 1.f : (1.f / lsum);
    float ssq = 0.f;
#pragma unroll
    for (int d = 0; d < DV / 32; ++d)
#pragma unroll
        for (int g = 0; g < 4; ++g) {
            float v0 = o[d][4 * g] * inv, v1 = o[d][4 * g + 1] * inv, v2 = o[d][4 * g + 2] * inv, v3 = o[d][4 * g + 3] * inv;
            ssq += v0 * v0 + v1 * v1 + v2 * v2 + v3 * v3;
            uint2 u; u.x = pack2(v0, v1); u.y = pack2(v2, v3);
            *(uint2*)(Y + tok * LDH + h * DV + d * 32 + 8 * g + 4 * hh) = u;
        }
    ssq += __shfl_xor(ssq, 32);
    if (hh == 0) ssy[tok * 16 + h] = ssq;
}

__device__ __forceinline__ void phase_attn(const Params& P, int L, int rep = 0, int fake = 0) {
    char* ws = opq(P.ws);
    int* cnt = (int*)(ws + OFF_CNT) + L * 64 + rep * 16;
    int* s_item = (int*)(smem + LDS_BYTES - 16);
    const float* cumF = (const float*)(ws + OFF_CUMF);
    bf16* Y = (bf16*)(ws + (fake ? OFF_PART : OFF_Y));
    float* ssy = fake ? (float*)(ws + OFF_PART + 40 * MBy) : (float*)(ws + OFF_SSY) + (size_t)L * TOK * 16;
    const int half = opaque_tid() >> 8;
    char* lds = smem + half * 65536;
    for (;;) {
        if (opaque_tid() == 0) *s_item = atomicAdd(cnt, 1);
        __syncthreads();
        int pair = *s_item;
        __syncthreads();
        if (pair >= 768) break;
        int item = pair * 2 + half;
        int qb = 15 - item / 96;
        int rem = item % 96;
        int type = rem >> 5, bh = rem & 31;
        int b = bh >> 2, h = bh & 3;
        if (type == 0) {
            attn_item<2, 96, 128>((const bf16*)(ws + OFF_MQ), 384, (const bf16*)(ws + OFF_MK), 384, (const bf16*)(ws + OFF_MVT), cumF,
                                  Y + 512, ssy + 8, b, h, qb, 0.10206207261596577f * LOG2E, lds, fake);
        } else if (type == 1) {
            attn_item<1, 64, 64>((const bf16*)(ws + OFF_SQ), 256, (const bf16*)(ws + OFF_SKK), 256, (const bf16*)(ws + OFF_SVT), cumF,
                                 Y + 256, ssy + 4, b, h, qb, 0.125f * LOG2E, lds, fake);
        } else {
            attn_item<0, 64, 64>((const bf16*)(ws + OFF_FQ), 256, (const bf16*)(ws + OFF_FK), 256, (const bf16*)(ws + OFF_FVT), cumF,
                                 Y + 0, ssy + 0, b, h, qb, 0.125f * LOG2E, lds, fake);
        }
    }
}

__device__ __forceinline__ void rowss_flush(float (&part)[2][16], float* gss, int m0, int nt) {
    float* lss = (float*)smem;
    const int tid = opaque_tid(), w = tid >> 6, l = tid & 63, hh = l >> 5, wm = w >> 1, wn = w & 1;
#pragma unroll
    for (int i = 0; i < 2; ++i)
#pragma unroll
        for (int rr = 0; rr < 16; ++rr) {
            float v = part[i][rr];
            v = dpp_add<0xB1>(v); v = dpp_add<0x4E>(v); v = dpp_add<0x141>(v); v = dpp_add<0x140>(v);
            v += __shfl_xor(v, 16);
            if ((l & 31) == 0) lss[wn * 256 + wm * 64 + i * 32 + (rr & 3) + 8 * (rr >> 2) + 4 * hh] = v;
        }
    __syncthreads();
    if (tid < 256) gss[(size_t)(m0 + tid) * 8 + nt] = lss[tid] + lss[256 + tid];
    __syncthreads();
}

struct WoHook {
    static constexpr bool nodma = false;
    __device__ __forceinline__ void operator()(int kt, f32x16 (&acc)[2][2]) const {
        if (kt == 4 || kt == 8) {
            const float* fac = (const float*)(smem + LDS_AUX) + (kt == 4 ? 0 : 256);
            const int tid = opaque_tid(), w = tid >> 6, l = tid & 63, hh = l >> 5, wm = w >> 1;
#pragma unroll
            for (int i = 0; i < 2; ++i)
#pragma unroll
                for (int rr = 0; rr < 16; ++rr) {
                    float f = fac[wm * 64 + i * 32 + (rr & 3) + 8 * (rr >> 2) + 4 * hh];
                    acc[i][0][rr] *= f; acc[i][1][rr] *= f;
                }
        }
    }
};

__device__ __forceinline__ void phase_wo(const Params& P, int L, int hsel, float* ss_out) {
    char* ws = opq(P.ws);
    bf16* hb_out = (bf16*)(ws + (hsel ? OFF_HB1 : OFF_HB0));
    const float* hin = (L == 0) ? opq(P.x) : (const float*)opq(P.out);
    float* hout = opq(P.out);
    const bf16* Y = (const bf16*)(ws + OFF_Y);
    const bf16* Bt = (const bf16*)(ws + OFF_WO) + (size_t)L * 1024 * LDH;
    const float* ssy = (const float*)(ws + OFF_SSY) + (size_t)L * TOK * 16;
    float* aux = (float*)(smem + LDS_AUX);
    const int tid = opaque_tid(), w = tid >> 6, l = tid & 63, hh = l >> 5, wm = w >> 1, wn = w & 1;
    for (int it = 0;; ++it) {
        int mt, nt;
        if (!xcd_tile(it, 64, 8, mt, nt)) break;
        int m0 = mt * 256, n0 = nt * 128;
        __syncthreads();
        if (tid < 256) {
            int row = m0 + tid;
            float4 v0 = *(const float4*)(ssy + (size_t)row * 16), v1 = *(const float4*)(ssy + (size_t)row * 16 + 4), v2 = *(const float4*)(ssy + (size_t)row * 16 + 8);
            float r0 = rsqrtf(((v0.x + v0.y) + (v0.z + v0.w)) * (1.f / 256.f) + EPSF);
            float r1 = rsqrtf(((v1.x + v1.y) + (v1.z + v1.w)) * (1.f / 256.f) + EPSF);
            float r2 = rsqrtf(((v2.x + v2.y) + (v2.z + v2.w)) * (1.f / 512.f) + EPSF);
            aux[tid] = r0 / r1; aux[256 + tid] = r1 / r2; aux[512 + tid] = r2;
        }
        f32x16 acc[2][2];
        ZERO_ACC(acc);
        gemm_core(acc, Y, LDH, Bt, LDH, 1024, m0, n0, WoHook());
        stage_f32<true>(acc, aux + 512);
        residual_store(hin, hout, hb_out, ss_out, m0, n0, nt);
    }
}

struct EpiPq {
    static constexpr bool PERM = true, AFTER_DRAIN = false;
    bf16* O; const float* ssrow;
    __device__ __forceinline__ void khook(int, f32x4 (&)[2][2][4][2], int, int) const {}
    __device__ __forceinline__ void operator()(const f32x4 (&acc)[2][2][4][2], const pg8::Unit& u, int wr, int wc, int fr, int fq) const {
        const int row0 = u.pm * 256 + wr * 64 + fr, col0 = u.pn * 256 + wc * 32 + 8 * fq;
#pragma unroll
        for (int ai = 0; ai < 2; ++ai)
#pragma unroll
            for (int m = 0; m < 4; ++m) {
                const int row = row0 + ai * 128 + m * 16;
                const float rs = row_rs8(ssrow, row);
                bf16* rowp = O + (size_t)row * 1024 + col0;
#pragma unroll
                for (int bj = 0; bj < 2; ++bj) {
                    f32x4 v0 = acc[ai][bj][m][0] * rs, v1 = acc[ai][bj][m][1] * rs;
                    u32x4 wv = {pack2(v0[0], v0[1]), pack2(v0[2], v0[3]), pack2(v1[0], v1[1]), pack2(v1[2], v1[3])};
                    *(u32x4*)(rowp + bj * 128) = wv;
                }
            }
    }
};
__device__ __forceinline__ void phase_pq(const Params& P, int L, int hsel, const float* ssrow) {
    char* ws = opq(P.ws);
    const bf16* hb = (const bf16*)(ws + (hsel ? OFF_HB1 : OFF_HB0));
    const bf16* Bt = (const bf16*)(ws + OFF_WQ) + (size_t)L * 1024 * LDH;
    pg8::Gemm g{hb, Bt, LDH, LDH, TOK, 1024, 1024};
    pg8::StaticOrder S; S.init(TOK, 1024, gridDim.x, blockIdx.x);
    EpiPq E{(bf16*)(ws + OFF_PQ), ssrow};
    pg8::gemm_phase((PG8_LAS unsigned char*)smem, g, S, E, nullptr);
    __syncthreads();
}

__device__ __forceinline__ void cswap(int& a, int& b) { int mx = max(a, b), mn = min(a, b); a = mx; b = mn; }
__device__ __forceinline__ void bitonic_sort16(int (&v)[16]) {
#pragma unroll
    for (int k = 2; k <= 16; k <<= 1)
#pragma unroll
        for (int j = k >> 1; j > 0; j >>= 1)
#pragma unroll
            for (int i = 0; i < 16; ++i) {
                int q = i ^ j;
                if (q > i) {
                    if ((i & k) == 0) cswap(v[i], v[q]); else cswap(v[q], v[i]);
                }
            }
}
__device__ __forceinline__ void merge_top16(int (&Lv)[16], const int (&Rv)[16]) {
#pragma unroll
    for (int i = 0; i < 16; ++i) Lv[i] = max(Lv[i], Rv[15 - i]);
#pragma unroll
    for (int j = 8; j > 0; j >>= 1)
#pragma unroll
        for (int i = 0; i < 16; ++i) {
            int q = i ^ j;
            if (q > i) cswap(Lv[i], Lv[q]);
        }
}
__device__ __forceinline__ int f2key(float v, int low, int mask) {
    int b = __float_as_int(v);
    b ^= (b >> 31) & 0x7fffffff;
    return (b & ~mask) | low;
}
__device__ __forceinline__ float key2f(int k, int mask) {
    int b = k & ~mask;
    b ^= (b >> 31) & 0x7fffffff;
    return __int_as_float(b);
}

__device__ __forceinline__ void phase_topk(const Params& P, int L) {
    char* ws = opq(P.ws);
    const bf16* pq = (const bf16*)(ws + OFF_PQ);
    const bf16* skb = (const bf16*)(ws + OFF_SKB) + (size_t)L * 16 * 128 * 64;
    unsigned short* ids = (unsigned short*)(ws + OFF_IDS);
    float* gates = (float*)(ws + OFF_GATE);
    const int tid = opaque_tid(), w = tid >> 6, l = tid & 63, r = l & 31, hh = l >> 5;
    unsigned char* lidx = (unsigned char*)(smem + w * 1024 + r * 32);
    for (int task = blockIdx.x * NW + w; task < (TOK / 32) * 8; task += gridDim.x * NW) {
        const int t0 = (task >> 3) * 32, h = task & 7;
        int F[2][16];
#pragma unroll
        for (int p = 0; p < 2; ++p) {
            const int hp = h * 2 + p;
            f32x16 acc[4];
            const f32x16 z16 = {0.f, 0.f, 0.f, 0.f, 0.f, 0.f, 0.f, 0.f, 0.f, 0.f, 0.f, 0.f, 0.f, 0.f, 0.f, 0.f};
#pragma unroll
            for (int kt = 0; kt < 4; ++kt) acc[kt] = z16;
#pragma unroll
            for (int s4 = 0; s4 < 4; ++s4) {
                bf16x8 bfr = *(const bf16x8*)(pq + (size_t)(t0 + r) * 1024 + hp * 64 + 16 * s4 + 8 * hh);
#pragma unroll
                for (int kt = 0; kt < 4; ++kt) {
                    bf16x8 af = *(const bf16x8*)(skb + ((size_t)hp * 128 + 32 * kt + r) * 64 + 16 * s4 + 8 * hh);
                    acc[kt] = __builtin_amdgcn_mfma_f32_32x32x16_bf16(af, bfr, acc[kt], 0, 0, 0);
                }
            }
            int K0[16], K1[16], K2[16], K3[16];
#pragma unroll
            for (int rr = 0; rr < 16; ++rr) {
                const int nb = (rr & 3) + 8 * (rr >> 2) + 4 * hh;
                K0[rr] = f2key(acc[0][rr], 127 - nb, 127);
                K1[rr] = f2key(acc[1][rr], 127 - (32 + nb), 127);
                K2[rr] = f2key(acc[2][rr], 127 - (64 + nb), 127);
                K3[rr] = f2key(acc[3][rr], 127 - (96 + nb), 127);
            }
            bitonic_sort16(K0); bitonic_sort16(K1); bitonic_sort16(K2); bitonic_sort16(K3);
            merge_top16(K0, K1);
            merge_top16(K2, K3);
            merge_top16(K0, K2);
#pragma unroll
            for (int i = 0; i < 16; ++i) K1[i] = partner32(K0[i], hh);
            merge_top16(K0, K1);
#pragma unroll
            for (int i = 0; i < 16; ++i) F[p][i] = K0[i];
        }
        if (hh == 0) {
#pragma unroll
            for (int q = 0; q < 4; ++q) {
                unsigned w1 = 0, w2 = 0;
#pragma unroll
                for (int e = 0; e < 4; ++e) {
                    w1 |= (unsigned)(127 - (F[0][4 * q + e] & 127)) << (8 * e);
                    w2 |= (unsigned)(127 - (F[1][4 * q + e] & 127)) << (8 * e);
                }
                ((unsigned*)lidx)[q] = w1;
                ((unsigned*)lidx)[4 + q] = w2;
            }
        }
        {
            float s1[16], s2[16];
#pragma unroll
            for (int i = 0; i < 16; ++i) { s1[i] = key2f(F[0][i], 127); s2[i] = key2f(F[1][i], 127); }
            int Lc[16], X[16];
#pragma unroll
            for (int b2 = 0; b2 < 16; ++b2) Lc[b2] = f2key(s1[0] + s2[b2], 255 - b2, 255);
#pragma unroll
            for (int a2 = 1; a2 < 16; ++a2) X[a2 - 1] = f2key(s1[a2] + s2[0], 255 - a2 * 16, 255);
            X[15] = INT_MIN;
            merge_top16(Lc, X);
            X[0] = f2key(s1[1] + s2[1], 255 - 17, 255); X[1] = f2key(s1[1] + s2[2], 255 - 18, 255); X[2] = f2key(s1[1] + s2[3], 255 - 19, 255);
            X[3] = f2key(s1[1] + s2[4], 255 - 20, 255); X[4] = f2key(s1[1] + s2[5], 255 - 21, 255); X[5] = f2key(s1[1] + s2[6], 255 - 22, 255);
            X[6] = f2key(s1[1] + s2[7], 255 - 23, 255);
            X[7] = f2key(s1[2] + s2[1], 255 - 33, 255); X[8] = f2key(s1[2] + s2[2], 255 - 34, 255); X[9] = f2key(s1[2] + s2[3], 255 - 35, 255);
            X[10] = f2key(s1[2] + s2[4], 255 - 36, 255);
            X[11] = f2key(s1[3] + s2[1], 255 - 49, 255); X[12] = f2key(s1[3] + s2[2], 255 - 50, 255); X[13] = f2key(s1[3] + s2[3], 255 - 51, 255);
            X[14] = f2key(s1[4] + s2[1], 255 - 65, 255); X[15] = f2key(s1[4] + s2[2], 255 - 66, 255);
            bitonic_sort16(X);
            merge_top16(Lc, X);
            X[0] = f2key(s1[5] + s2[1], 255 - 81, 255);
            X[1] = f2key(s1[6] + s2[1], 255 - 97, 255);
            X[2] = f2key(s1[7] + s2[1], 255 - 113, 255);
#pragma unroll
            for (int i = 3; i < 16; ++i) X[i] = INT_MIN;
            merge_top16(Lc, X);
            if (hh == 0) {
                float mx = key2f(Lc[0], 255);
                float ev[16], sum = 0.f;
#pragma unroll
                for (int k = 0; k < 16; ++k) { ev[k] = __expf(key2f(Lc[k], 255) - mx); sum += ev[k]; }
                float inv = 1.f / sum;
                size_t ob = (size_t)(t0 + r) * 128 + h * 16;
                unsigned idw[8];
#pragma unroll
                for (int k = 0; k < 16; ++k) {
                    int cidx = 255 - (Lc[k] & 255);
                    int i1 = lidx[cidx >> 4], i2 = lidx[16 + (cidx & 15)];
                    unsigned idv = (unsigned)(i1 * 128 + i2);
                    if (k & 1) idw[k >> 1] |= idv << 16; else idw[k >> 1] = idv;
                }
                u32x4 o0 = {idw[0], idw[1], idw[2], idw[3]}, o1 = {idw[4], idw[5], idw[6], idw[7]};
                *(u32x4*)(ids + ob) = o0;
                *(u32x4*)(ids + ob + 8) = o1;
#pragma unroll
                for (int q = 0; q < 4; ++q) {
                    f32x4 g4 = {ev[4 * q] * inv, ev[4 * q + 1] * inv, ev[4 * q + 2] * inv, ev[4 * q + 3] * inv};
                    *(f32x4*)(gates + ob + 4 * q) = g4;
                }
            }
        }
    }
}

__device__ __forceinline__ float gelu_exact(float x) { return 0.5f * x * (1.f + erff(x * 0.70710678118654752f)); }

__device__ __forceinline__ void dec16(const u32x4& v, float (&f)[16]) {
    f32x2 t;
    t = __builtin_amdgcn_cvt_pk_f32_fp8((int)v.x, false); f[0] = t.x; f[1] = t.y;
    t = __builtin_amdgcn_cvt_pk_f32_fp8((int)v.x, true);  f[2] = t.x; f[3] = t.y;
    t = __builtin_amdgcn_cvt_pk_f32_fp8((int)v.y, false); f[4] = t.x; f[5] = t.y;
    t = __builtin_amdgcn_cvt_pk_f32_fp8((int)v.y, true);  f[6] = t.x; f[7] = t.y;
    t = __builtin_amdgcn_cvt_pk_f32_fp8((int)v.z, false); f[8] = t.x; f[9] = t.y;
    t = __builtin_amdgcn_cvt_pk_f32_fp8((int)v.z, true);  f[10] = t.x; f[11] = t.y;
    t = __builtin_amdgcn_cvt_pk_f32_fp8((int)v.w, false); f[12] = t.x; f[13] = t.y;
    t = __builtin_amdgcn_cvt_pk_f32_fp8((int)v.w, true);  f[14] = t.x; f[15] = t.y;
}

__device__ __forceinline__ void dec32(const u32x4& v, f32x2 (&f)[16]) {
    f[0] = __builtin_amdgcn_cvt_scalef32_pk_f32_fp4(v.x, 1.0f, 0); f[1] = __builtin_amdgcn_cvt_scalef32_pk_f32_fp4(v.x, 1.0f, 1);
    f[2] = __builtin_amdgcn_cvt_scalef32_pk_f32_fp4(v.x, 1.0f, 2); f[3] = __builtin_amdgcn_cvt_scalef32_pk_f32_fp4(v.x, 1.0f, 3);
    f[4] = __builtin_amdgcn_cvt_scalef32_pk_f32_fp4(v.y, 1.0f, 0); f[5] = __builtin_amdgcn_cvt_scalef32_pk_f32_fp4(v.y, 1.0f, 1);
    f[6] = __builtin_amdgcn_cvt_scalef32_pk_f32_fp4(v.y, 1.0f, 2); f[7] = __builtin_amdgcn_cvt_scalef32_pk_f32_fp4(v.y, 1.0f, 3);
    f[8] = __builtin_amdgcn_cvt_scalef32_pk_f32_fp4(v.z, 1.0f, 0); f[9] = __builtin_amdgcn_cvt_scalef32_pk_f32_fp4(v.z, 1.0f, 1);
    f[10] = __builtin_amdgcn_cvt_scalef32_pk_f32_fp4(v.z, 1.0f, 2); f[11] = __builtin_amdgcn_cvt_scalef32_pk_f32_fp4(v.z, 1.0f, 3);
    f[12] = __builtin_amdgcn_cvt_scalef32_pk_f32_fp4(v.w, 1.0f, 0); f[13] = __builtin_amdgcn_cvt_scalef32_pk_f32_fp4(v.w, 1.0f, 1);
    f[14] = __builtin_amdgcn_cvt_scalef32_pk_f32_fp4(v.w, 1.0f, 2); f[15] = __builtin_amdgcn_cvt_scalef32_pk_f32_fp4(v.w, 1.0f, 3);
}

typedef _Float16 f16x2 __attribute__((ext_vector_type(2)));
__device__ __forceinline__ void dec8_f16(unsigned x, f16x2 (&wv)[4]) {
    const unsigned lo = x & 0x07070707u, hi = (x >> 4) & 0x07070707u;
    const unsigned Lb = __builtin_amdgcn_perm(0x46444240u, 0x3E3C3800u, lo) | ((x & 0x08080808u) << 4);
    const unsigned Hb = __builtin_amdgcn_perm(0x46444240u, 0x3E3C3800u, hi) | (x & 0x80808080u);
    wv[0] = __builtin_bit_cast(f16x2, __builtin_amdgcn_perm(Hb, Lb, 0x040c000cu));
    wv[1] = __builtin_bit_cast(f16x2, __builtin_amdgcn_perm(Hb, Lb, 0x050c010cu));
    wv[2] = __builtin_bit_cast(f16x2, __builtin_amdgcn_perm(Hb, Lb, 0x060c020cu));
    wv[3] = __builtin_bit_cast(f16x2, __builtin_amdgcn_perm(Hb, Lb, 0x070c030cu));
}

__device__ __forceinline__ int idof16(const u32x4 (&q)[2], int i) {
    unsigned wv = (i >> 1) == 0 ? q[0].x : (i >> 1) == 1 ? q[0].y : (i >> 1) == 2 ? q[0].z : (i >> 1) == 3 ? q[0].w
                : (i >> 1) == 4 ? q[1].x : (i >> 1) == 5 ? q[1].y : (i >> 1) == 6 ? q[1].z : q[1].w;
    return (i & 1) ? (int)(wv >> 16) : (int)(wv & 0xffffu);
}
__device__ __forceinline__ void phase_gather_u(const Params& P, int L) {
    char* ws = opq(P.ws);
    const unsigned char* U4 = (const unsigned char*)(ws + OFF_UB) + (size_t)L * NEXP * 512;
    float* part = (float*)(ws + OFF_PART);
    const unsigned short* ids = (const unsigned short*)(ws + OFF_IDS);
    const float* hin = opq(P.out);
    const int tid = opaque_tid(), w = tid >> 6, l = tid & 63, c = l & 7, gq = l >> 3;
    const int sl = blockIdx.x & 3, par = (blockIdx.x >> 2) & 1, rk = blockIdx.x >> 3, nb = gridDim.x >> 3;
    if (rk >= nb) return;
    const unsigned char* ubase = U4 + (size_t)sl * NEXP * 128 + c * 16;
    const int stride = nb * NW;
    int ti = rk * NW + w;
    if (ti >= TOK / 2) return;
    u32x4 idA[2], idB[2];
    u32x4 rv[16];
    f32x4 hA[8], hB[8];
    auto load_ids = [&](int tt, u32x4 (&idq)[2]) {
        const u32x4* i4 = (const u32x4*)(ids + (size_t)tt * 128 + 16 * gq);
        idq[0] = i4[0]; idq[1] = i4[1];
    };
    auto load_hx = [&](int tt, f32x4 (&hx)[8]) {
        const f32x4* h4 = (const f32x4*)(hin + (size_t)tt * 1024 + 256 * sl + 32 * c);
#pragma unroll
        for (int q = 0; q < 8; ++q) hx[q] = h4[q];
    };
    auto step = [&](int tcur, int tnext, int tnext2, const u32x4 (&idn)[2], u32x4 (&idl)[2], const f32x4 (&hc)[8], f32x4 (&hn)[8]) {
        load_ids(tnext2, idl);
        load_hx(tnext, hn);
        __builtin_amdgcn_sched_barrier(0);
        float pr[16];
#pragma unroll
        for (int i = 0; i < 16; ++i) {
            f32x2 f[16];
            asm volatile("" : "+v"(rv[i].x), "+v"(rv[i].y), "+v"(rv[i].z), "+v"(rv[i].w));
            dec32(rv[i], f);
            rv[i] = *(const u32x4*)(ubase + (size_t)idof16(idn, i) * 128);
            __builtin_amdgcn_sched_barrier(0);
            f32x2 s2 = {0.f, 0.f};
#pragma unroll
            for (int q = 0; q < 8; ++q) {
                f32x2 x0 = {hc[q].x, hc[q].y}, x1 = {hc[q].z, hc[q].w};
                s2 = __builtin_elementwise_fma(f[2 * q], x0, s2);
                s2 = __builtin_elementwise_fma(f[2 * q + 1], x1, s2);
            }
            float sacc = s2.x + s2.y;
            asm volatile("" : "+v"(sacc));
            pr[i] = sacc;
        }
#pragma unroll
        for (int i = 0; i < 16; ++i) pr[i] = sum8_dpp(pr[i]);
        if (c == 0) {
            f32x4* o4 = (f32x4*)(part + ((size_t)sl * TOK + tcur) * 128 + 16 * gq);
#pragma unroll
            for (int q = 0; q < 4; ++q) { f32x4 o = {pr[4 * q], pr[4 * q + 1], pr[4 * q + 2], pr[4 * q + 3]}; o4[q] = o; }
        }
    };
    auto tok = [&](int tidx, int fb) { return 2 * (tidx < TOK / 2 ? tidx : fb) + par; };
    load_ids(tok(ti, ti), idA);
#pragma unroll
    for (int i = 0; i < 16; ++i) rv[i] = *(const u32x4*)(ubase + (size_t)idof16(idA, i) * 128);
    load_hx(tok(ti, ti), hA);
    load_ids(tok(ti + stride, ti), idB);
    for (;;) {
        int tn = ti + stride, tn2 = ti + 2 * stride;
        step(tok(ti, ti), tok(tn, ti), tok(tn2, ti), idB, idA, hA, hB);
        if (tn >= TOK / 2) break;
        ti = tn; tn = ti + stride; tn2 = ti + 2 * stride;
        step(tok(ti, ti), tok(tn, ti), tok(tn2, ti), idA, idB, hB, hA);
        if (tn >= TOK / 2) break;
        ti = tn;
    }
}

__device__ __forceinline__ void phase_gather_act(const Params& P, int L, const float* ss_ffn) {
    char* ws = opq(P.ws);
    const float* part = (const float*)(ws + OFF_PART);
    const unsigned short* ids = (const unsigned short*)(ws + OFF_IDS);
    float* gates = (float*)(ws + OFF_GATE);
    const float* uinv = (const float*)(ws + OFF_TSC) + L * NEXP;
    const float* vinv = (const float*)(ws + OFF_TSC) + (2 + L) * NEXP;
    const int tid = opaque_tid(), w = tid >> 6, l = tid & 63;
    for (int t = blockIdx.x * NW + w; t < TOK; t += gridDim.x * NW) {
        float rs = row_rs8(ss_ffn, t);
#pragma unroll
        for (int hsel = 0; hsel < 2; ++hsel) {
            int k = l + 64 * hsel;
            float sacc = 0.f;
#pragma unroll
            for (int j = 0; j < 4; ++j) sacc += part[((size_t)j * TOK + t) * 128 + k];
            int id = ids[(size_t)t * 128 + k];
            float pre = sacc * rs * uinv[id];
            gates[(size_t)t * 128 + k] = gates[(size_t)t * 128 + k] * gelu_exact(pre) * vinv[id];
        }
    }
}

__device__ __forceinline__ void phase_gather_v(const Params& P, int L, int hsel, float* ss_ple) {
    char* ws = opq(P.ws);
    bf16* hb_out = (bf16*)(ws + (hsel ? OFF_HB1 : OFF_HB0));
    const unsigned char* V4 = (const unsigned char*)(ws + OFF_VB) + (size_t)L * NEXP * 512;
    const unsigned short* ids = (const unsigned short*)(ws + OFF_IDS);
    const float* act = (const float*)(ws + OFF_GATE);
    float* hio = opq(P.out);
    const int tid = opaque_tid(), w = tid >> 6, l = tid & 63, c = l & 7, gq = l >> 3;
    const int sl = blockIdx.x & 3, par = (blockIdx.x >> 2) & 1, rk = blockIdx.x >> 3, nb = gridDim.x >> 3;
    if (rk >= nb) return;
    const unsigned char* vbase = V4 + (size_t)sl * NEXP * 128 + c * 16;
    const int stride = nb * NW;
    int ti = rk * NW + w;
    if (ti >= TOK / 2) return;
    const bool b3 = (l >> 3) & 1;
    u32x4 idA[2], idB[2];
    u32x4 rv[16];
    f32x4 aA[4], aB[4];
    auto load_ids = [&](int tt, u32x4 (&idq)[2]) {
        const u32x4* i4 = (const u32x4*)(ids + (size_t)tt * 128 + 16 * gq);
        idq[0] = i4[0]; idq[1] = i4[1];
    };
    auto load_a = [&](int tt, f32x4 (&ax)[4]) {
        const f32x4* a4 = (const f32x4*)(act + (size_t)tt * 128 + 16 * gq);
#pragma unroll
        for (int q = 0; q < 4; ++q) ax[q] = a4[q];
    };
    auto step = [&](int tcur, int tnext, int tnext2, const u32x4 (&idn)[2], u32x4 (&idl)[2], const f32x4 (&ac)[4], f32x4 (&an)[4]) {
        load_ids(tnext2, idl);
        load_a(tnext, an);
        __builtin_amdgcn_sched_barrier(0);
        f32x2 acc[16];
#pragma unroll
        for (int e = 0; e < 16; ++e) { acc[e].x = 0.f; acc[e].y = 0.f; }
#pragma unroll
        for (int i = 0; i < 16; ++i) {
            f32x2 f[16];
            asm volatile("" : "+v"(rv[i].x), "+v"(rv[i].y), "+v"(rv[i].z), "+v"(rv[i].w));
            dec32(rv[i], f);
            rv[i] = *(const u32x4*)(vbase + (size_t)idof16(idn, i) * 128);
            __builtin_amdgcn_sched_barrier(0);
            const float a = (i & 3) == 0 ? ac[i >> 2].x : (i & 3) == 1 ? ac[i >> 2].y : (i & 3) == 2 ? ac[i >> 2].z : ac[i >> 2].w;
            const f32x2 a2 = {a, a};
#pragma unroll
            for (int e = 0; e < 16; ++e) acc[e] = __builtin_elementwise_fma(f[e], a2, acc[e]);
#pragma unroll
            for (int e = 0; e < 16; ++e) asm volatile("" : "+v"(acc[e]));
        }
        float v8[8][2];
#pragma unroll
        for (int e = 0; e < 8; ++e) {
            float k0 = b3 ? acc[8 + e].x : acc[e].x, k1 = b3 ? acc[8 + e].y : acc[e].y;
            float s0 = b3 ? acc[e].x : acc[8 + e].x, s1 = b3 ? acc[e].y : acc[8 + e].y;
            v8[e][0] = k0 + __builtin_bit_cast(float, __builtin_amdgcn_update_dpp(0, __builtin_bit_cast(int, s0), 0x128, 0xf, 0xf, true));
            v8[e][1] = k1 + __builtin_bit_cast(float, __builtin_amdgcn_update_dpp(0, __builtin_bit_cast(int, s1), 0x128, 0xf, 0xf, true));
        }
        float v4[8];
#pragma unroll
        for (int e = 0; e < 8; ++e) {
            float X = v8[e >> 1][e & 1], Y = v8[4 + (e >> 1)][e & 1];
            asm volatile("s_nop 1\n\tv_permlane16_swap_b32 %0, %1\n\ts_nop 1" : "+v"(X), "+v"(Y));
            v4[e] = X + Y;
        }
        float v2[4];
#pragma unroll
        for (int e = 0; e < 4; ++e) {
            float X = v4[e], Y = v4[4 + e];
            asm volatile("s_nop 1\n\tv_permlane32_swap_b32 %0, %1\n\ts_nop 1" : "+v"(X), "+v"(Y));
            v2[e] = X + Y;
        }
        const int col = 256 * sl + 32 * c + 16 * ((l >> 3) & 1) + 8 * ((l >> 4) & 1) + 4 * (l >> 5);
        f32x4* h4 = (f32x4*)(hio + (size_t)tcur * 1024 + col);
        f32x4 hv = *h4;
        hv.x += v2[0]; hv.y += v2[1]; hv.z += v2[2]; hv.w += v2[3];
        *h4 = hv;
        u32x2 bb = {pack2(hv.x, hv.y), pack2(hv.z, hv.w)};
        *(u32x2*)(hb_out + (size_t)tcur * LDH + col) = bb;
        float ssq = hv.x * hv.x + hv.y * hv.y + hv.z * hv.z + hv.w * hv.w;
        ssq = wave_sum(ssq);
        if (l == 0) { ss_ple[(size_t)tcur * 8 + sl] = ssq; ss_ple[(size_t)tcur * 8 + 4 + sl] = 0.f; }
    };
    auto tok = [&](int tidx, int fb) { return 2 * (tidx < TOK / 2 ? tidx : fb) + par; };
    load_ids(tok(ti, ti), idA);
#pragma unroll
    for (int i = 0; i < 16; ++i) rv[i] = *(const u32x4*)(vbase + (size_t)idof16(idA, i) * 128);
    load_a(tok(ti, ti), aA);
    load_ids(tok(ti + stride, ti), idB);
    for (;;) {
        int tn = ti + stride, tn2 = ti + 2 * stride;
        step(tok(ti, ti), tok(tn, ti), tok(tn2, ti), idB, idA, aA, aB);
        if (tn >= TOK / 2) break;
        ti = tn; tn = ti + stride; tn2 = ti + 2 * stride;
        step(tok(ti, ti), tok(tn, ti), tok(tn2, ti), idA, idB, aB, aA);
        if (tn >= TOK / 2) break;
        ti = tn;
    }
}

__device__ __forceinline__ void phase_ple(const Params& P, int L, int hsel, const float* ss_ple, float* ss_out) {
    char* ws = opq(P.ws);
    const bf16* hb_in = (const bf16*)(ws + (hsel ? OFF_HB1 : OFF_HB0));
    bf16* hb_out = (bf16*)(ws + (hsel ? OFF_HB0 : OFF_HB1));
    float* hio = opq(P.out);
    const bf16* pin = (const bf16*)(ws + OFF_PB) + (size_t)L * TOK * LDP;
    const bf16* Wg = (const bf16*)(ws + OFF_WG) + (size_t)L * 1024 * LDH;
    const bf16* Wp = (const bf16*)(ws + OFF_WP) + (size_t)L * 1024 * LDP;
    const int tid = opaque_tid(), w = tid >> 6, l = tid & 63, hh = l >> 5, wm = w >> 1, wn = w & 1;
    for (int it = 0;; ++it) {
        int mt, nt;
        if (!xcd_tile(it, 64, 8, mt, nt)) break;
        int m0 = mt * 256, n0 = nt * 128;
        float* aux = (float*)(smem + LDS_AUX);
        __syncthreads();
        if (tid < 256) aux[tid] = row_rs8(ss_ple, m0 + tid);
        f32x16 acc1[2][2], acc2[2][2];
        ZERO_ACC(acc1);
        ZERO_ACC(acc2);
        gemm_core(acc1, hb_in, LDH, Wg, LDH, 1024, m0, n0, NoHook());
        gemm_core(acc2, pin, LDP, Wp, LDP, 256, m0, n0, NoHook());
#pragma unroll
        for (int i = 0; i < 2; ++i)
#pragma unroll
            for (int rr = 0; rr < 16; ++rr) {
                float rs = aux[wm * 64 + i * 32 + (rr & 3) + 8 * (rr >> 2) + 4 * hh];
#pragma unroll
                for (int j = 0; j < 2; ++j) {
                    float gte = 1.f / (1.f + __expf(-acc1[i][j][rr] * rs));
                    acc2[i][j][rr] *= gte;
                }
            }
        stage_f32<false>(acc2, nullptr);
        residual_store(hio, hio, hb_out, ss_out, m0, n0, nt);
    }
}

__device__ __forceinline__ void phase_final(const Params& P, const float* ss) {
    float* hio = opq(P.out);
    const int tid = opaque_tid(), w = tid >> 6, l = tid & 63;
    const float4* g4 = (const float4*)P.final_norm_g;
    for (int t = blockIdx.x * NW + w; t < TOK; t += gridDim.x * NW) {
        float rs = row_rs8(ss, t);
        float4* o4 = (float4*)(hio + (size_t)t * 1024);
#pragma unroll
        for (int i = 0; i < 4; ++i) {
            float4 v = o4[i * 64 + l], g = g4[i * 64 + l];
            v.x *= rs * g.x; v.y *= rs * g.y; v.z *= rs * g.z; v.w *= rs * g.w;
            o4[i * 64 + l] = v;
        }
    }
}

#define XB_TMO      128
#define XB_XCNT(j)  (256  + 64 * (j))
#define XB_XSUB(j)  (1280 + 64 * (j))
#define XB_XGEN(j)  (2304 + 64 * (j))
#define XB_TOP      3328
#define XB_TOPGEN   3392
#define XCD_BAR_WORDS 3456
#define XB_SPIN_CAP (1u << 22)
__device__ __forceinline__ unsigned xb_ld(unsigned* p) { return __hip_atomic_load(p, __ATOMIC_RELAXED, __HIP_MEMORY_SCOPE_AGENT); }
__device__ __forceinline__ unsigned xb_add(unsigned* p, unsigned v) { return __hip_atomic_fetch_add(p, v, __ATOMIC_RELAXED, __HIP_MEMORY_SCOPE_AGENT); }
__device__ __forceinline__ unsigned xb_xcc_id() { return (unsigned)__builtin_amdgcn_s_getreg((3 << 11) | 20) & 0xFu; }
#define XB_SPIN(cond, bar) do { unsigned _sp = 0; while (cond) { __builtin_amdgcn_s_sleep(1); \
    if ((++_sp & 255u) == 0u) { if (xb_ld(&(bar)[XB_TMO])) break; if (_sp > XB_SPIN_CAP) { atomicAdd(&(bar)[XB_TMO], 1u); break; } } } } while (0)
#define XB_LDS_OFF (LDS_BYTES - 64)
__device__ __forceinline__ void xcd_barrier_post(const Params& P) {
    if (threadIdx.x == 0) {
        unsigned* bar = (unsigned*)(P.ws + OFF_BAR);
        volatile unsigned* st = (volatile unsigned*)(smem + XB_LDS_OFF);
        st[0] = 0u; st[1] = 0u;
        (void)xb_add(&bar[XB_XCNT(xb_xcc_id())], 1u);
    }
}
__device__ __forceinline__ void xcd_barrier_complete(unsigned* bar, unsigned x, unsigned& nloc, unsigned& nx) {
    const unsigned G = gridDim.x;
    unsigned sum, cnt, mine, sp = 0u;
    for (;;) {
        sum = 0u; cnt = 0u; mine = 0u;
#pragma unroll
        for (unsigned j = 0; j < 16; ++j) { const unsigned c = xb_ld(&bar[XB_XCNT(j)]); sum += c; cnt += (c > 0u) ? 1u : 0u; mine = (j == x) ? c : mine; }
        if (sum == G) break;
        __builtin_amdgcn_s_sleep(1);
        if ((++sp & 255u) == 0u) { if (xb_ld(&bar[XB_TMO])) break; if (sp > XB_SPIN_CAP) { atomicAdd(&bar[XB_TMO], 1u); break; } }
    }
    nloc = mine > 0u ? mine : 1u; nx = cnt > 0u ? cnt : 1u;
}
__device__ __forceinline__ void grid_barrier(const Params& P) {
    asm volatile("s_waitcnt vmcnt(0)" ::: "memory");
    __syncthreads();
    if (threadIdx.x == 0) {
        unsigned* bar = (unsigned*)(opq(P.ws) + OFF_BAR);
        volatile unsigned* st = (volatile unsigned*)(smem + XB_LDS_OFF);
        const unsigned x = xb_xcc_id();
        __builtin_amdgcn_s_waitcnt(0);
        unsigned nloc = st[0], nx = st[1];
        if (nloc == 0u) { xcd_barrier_complete(bar, x, nloc, nx); st[0] = nloc; st[1] = nx; }
        const unsigned old = xb_add(&bar[XB_XSUB(x)], 1u);
        const unsigned gen = old / nloc;
        if (old + 1u == (gen + 1u) * nloc) {
            __builtin_amdgcn_fence(__ATOMIC_RELEASE, "agent");
            asm volatile("s_waitcnt vmcnt(0)" ::: "memory");
            const unsigned og = xb_add(&bar[XB_TOP], 1u);
            const unsigned tg = og / nx;
            if (og + 1u == (tg + 1u) * nx) xb_add(&bar[XB_TOPGEN], 1u);
            else XB_SPIN(xb_ld(&bar[XB_TOPGEN]) == tg, bar);
            __builtin_amdgcn_fence(__ATOMIC_ACQUIRE, "agent");
            xb_add(&bar[XB_XGEN(x)], 1u);
            asm volatile("s_waitcnt vmcnt(0)" ::: "memory");
        } else {
            XB_SPIN(xb_ld(&bar[XB_XGEN(x)]) == gen, bar);
            __builtin_amdgcn_fence(__ATOMIC_ACQUIRE, "agent");
            asm volatile("s_waitcnt vmcnt(0)" ::: "memory");
        }
    }
    __syncthreads();
}

__global__ void __launch_bounds__(NTHR, 2) hymba_megakernel(Params P) {
    cg::grid_group grid = cg::this_grid();
    char* ws = opq(P.ws);
    float* ssa = (float*)(ws + OFF_SSA);
    xcd_barrier_post(P);
#define BAR() do { grid_barrier(P); if (DUP == 20) grid_barrier(P); } while (0)
    phase0(P);
    if (DUP == 0) { asm volatile("s_waitcnt vmcnt(0)" ::: "memory"); __syncthreads(); grid_barrier(P); phase0(P); }
    asm volatile("s_waitcnt vmcnt(0)" ::: "memory");
    __syncthreads();
    grid.sync();
    BAR();
    int cur = 0;
    for (int L = 0; L < 2; ++L) {
        const float* ss_mix = (L == 0) ? ssa : (ssa + 3 * TOK * 8);
        float* ss_ffn = ssa + (size_t)(1 + L) * TOK * 8;
        float* ss_next = (L == 0) ? (ssa + 3 * TOK * 8) : (ssa + 4 * TOK * 8);
        float* ss_ple = ssa + (size_t)(5 + L) * TOK * 8;
        phase_proj(P, L, cur, ss_mix);
        BAR();
        if (DUP == 1) { phase_proj(P, L, cur, ss_mix); BAR(); }
        phase_mla_up(P, L);
        BAR();
        if (DUP == 2) { phase_mla_up(P, L); BAR(); }
        phase_attn(P, L, 0);
        BAR();
        if (DUP == 3) { phase_attn(P, L, 1); BAR(); }
        if (DUP >= 30 && DUP < 34) { phase_attn(P, L, 1, DUP - 30); BAR(); }
        phase_wo(P, L, cur ^ 1, ss_ffn);
        BAR();
        if (DUP == 4 && L == 0) { phase_wo(P, L, cur ^ 1, ss_ffn); BAR(); }
        phase_pq(P, L, cur ^ 1, ss_ffn);
        BAR();
        if (DUP == 5) { phase_pq(P, L, cur ^ 1, ss_ffn); BAR(); }
        phase_topk(P, L);
        BAR();
        if (DUP == 6) { phase_topk(P, L); BAR(); }
        phase_gather_u(P, L);
        BAR();
        if (DUP == 7) { phase_gather_u(P, L); BAR(); }
        phase_gather_act(P, L, ss_ffn);
        BAR();
        phase_gather_v(P, L, cur, ss_ple);
        BAR();
        phase_ple(P, L, cur, ss_ple, ss_next);
        BAR();
        cur ^= 1;
    }
    phase_final(P, ssa + 4 * TOK * 8);
}

extern "C" void kernel_launch(void* const* d_in, const int* in_sizes, int n_in, void* d_out, int out_size, void* d_ws,
                              size_t ws_size, hipStream_t stream) {
    static int grid_blocks = 0;
    if (!grid_blocks) {
        int dev = 0, cus = 0, per_cu = 0;
        hipGetDevice(&dev);
        hipDeviceGetAttribute(&cus, hipDeviceAttributeMultiprocessorCount, dev);
        hipOccupancyMaxActiveBlocksPerMultiprocessor(&per_cu, hymba_megakernel, NTHR, 0);
        if (per_cu > 1) per_cu = 1;
        if (per_cu < 1) per_cu = 1;
        grid_blocks = cus * per_cu;
        if (ws_size < WS_END) fprintf(stderr, "workspace too small: %zu < %zu\n", ws_size, (size_t)WS_END);
    }
    Params P{};
    P.x = (const float*)d_in[0]; P.p = (const float*)d_in[1]; P.pos = (const int*)d_in[2];
    P.norm_mix_g = (const float*)d_in[3]; P.w_in = (const float*)d_in[4]; P.b_forget = (const float*)d_in[5];
    P.mla_q_norm_g = (const float*)d_in[6]; P.w_uq = (const float*)d_in[7]; P.mla_kv_norm_g = (const float*)d_in[8];
    P.w_ukv = (const float*)d_in[9]; P.mix_out_norm_g = (const float*)d_in[10]; P.w_o = (const float*)d_in[11];
    P.norm_ffn_g = (const float*)d_in[12]; P.w_query = (const float*)d_in[13]; P.sub_keys = (const float*)d_in[14];
    P.peer_u = (const float*)d_in[15]; P.peer_v = (const float*)d_in[16]; P.w_ple = (const float*)d_in[17];
    P.ple_norm_g = (const float*)d_in[18]; P.w_ple_gate = (const float*)d_in[19]; P.final_norm_g = (const float*)d_in[20];
    P.out = (float*)d_out; P.ws = (char*)d_ws;
    hipMemsetAsync((char*)d_ws + OFF_BAR, 0, 16384 + 4096, stream);
    void* args[] = {&P};
    hipError_t e = hipLaunchCooperativeKernel((void*)hymba_megakernel, dim3(grid_blocks), dim3(NTHR), args, 0, stream);
    if (e != hipSuccess) fprintf(stderr, "cooperative launch failed: %s (grid %d)\n", hipGetErrorString(e), grid_blocks);
}
```

```cpp
#include <hip/hip_runtime.h>
#include <hip/hip_cooperative_groups.h>
#include <cstdio>
#include <cstdint>
#include <math.h>
#include <climits>
namespace cg = cooperative_groups;

typedef __bf16 bf16;
typedef __bf16 bf16x8 __attribute__((ext_vector_type(8)));
typedef __bf16 bf16x4 __attribute__((ext_vector_type(4)));
typedef __bf16 bf16x2 __attribute__((ext_vector_type(2)));
typedef float f32x16 __attribute__((ext_vector_type(16)));
typedef float f32x4 __attribute__((ext_vector_type(4)));
typedef float f32x2 __attribute__((ext_vector_type(2)));
typedef unsigned u32x4 __attribute__((ext_vector_type(4)));
typedef unsigned u32x2 __attribute__((ext_vector_type(2)));

#define SEQ 2048
#define BATCH 8
#define TOK 16384
#define DM 1024
#define IN_W 1956
#define NEXP 16384
#define EPSF 1e-6f
#define LOG2E 1.4426950408889634f
#define NTHR 512
#define NW 8
#define LDS_BYTES 151808
#define STAGE_BYTES 49152
#define LDS_AUX 147456
#ifndef DUP
#define DUP -1
#endif

constexpr size_t MBy = 1ull << 20;
constexpr size_t OFF_UB = 0;
constexpr size_t OFF_VB = 32 * MBy;
constexpr size_t OFF_PART = 64 * MBy;
#define LDH 1088
#define LDP 320
#define LDC 192
constexpr size_t OFF_WIN = 128 * MBy;
constexpr size_t OFF_WO = 137 * MBy;
constexpr size_t OFF_WQ = 142 * MBy;
constexpr size_t OFF_WG = 147 * MBy;
constexpr size_t OFF_WP = 152 * MBy;
constexpr size_t OFF_WUQ = 154 * MBy;
constexpr size_t OFF_WUKV = 155 * MBy;
constexpr size_t OFF_SKB = 156 * MBy;
constexpr size_t OFF_CS = 157 * MBy;
constexpr size_t OFF_TSC = 159 * MBy;
constexpr size_t OFF_SSA = 160 * MBy;
constexpr size_t OFF_HB0 = 164 * MBy;
constexpr size_t OFF_HB1 = 200 * MBy;
constexpr size_t OFF_FQ = 236 * MBy;
constexpr size_t OFF_FK = 244 * MBy;
constexpr size_t OFF_FVT = 252 * MBy;
constexpr size_t OFF_SQ = 260 * MBy;
constexpr size_t OFF_SKK = 268 * MBy;
constexpr size_t OFF_SVT = 276 * MBy;
constexpr size_t OFF_CQ = 284 * MBy;
constexpr size_t OFF_CKV = 295 * MBy;
constexpr size_t OFF_FLOG = 302 * MBy;
constexpr size_t OFF_CUMF = 303 * MBy;
constexpr size_t OFF_MQ = 304 * MBy;
constexpr size_t OFF_MK = 316 * MBy;
constexpr size_t OFF_MVT = 328 * MBy;
constexpr size_t OFF_Y = 344 * MBy;
constexpr size_t OFF_PQ = 380 * MBy;
constexpr size_t OFF_IDS = 412 * MBy;
constexpr size_t OFF_GATE = 420 * MBy;
constexpr size_t OFF_BAR = 428 * MBy;
constexpr size_t OFF_CNT = OFF_BAR + 16384;
constexpr size_t OFF_SSY = 429 * MBy;
constexpr size_t OFF_PB = 431 * MBy;
constexpr size_t WS_END = 452 * MBy;

struct Params {
    const float* x; const float* p; const int* pos;
    const float* norm_mix_g; const float* w_in; const float* b_forget; const float* mla_q_norm_g; const float* w_uq;
    const float* mla_kv_norm_g; const float* w_ukv; const float* mix_out_norm_g; const float* w_o; const float* norm_ffn_g;
    const float* w_query; const float* sub_keys; const float* peer_u; const float* peer_v; const float* w_ple;
    const float* ple_norm_g; const float* w_ple_gate; const float* final_norm_g;
    float* out; char* ws;
};

__shared__ __attribute__((aligned(16))) char smem[LDS_BYTES];

__device__ __forceinline__ int opaque_tid() { int t = threadIdx.x; asm volatile("" : "+v"(t)); return t; }
template <typename T> __device__ __forceinline__ T* opq(T* p) { size_t z = 0; asm volatile("" : "+s"(z)); return (T*)((char*)p + z); }

__device__ __forceinline__ unsigned pack2(float a, float b) {
    f32x2 v = {a, b};
    bf16x2 r = __builtin_convertvector(v, bf16x2);
    return __builtin_bit_cast(unsigned, r);
}
__device__ __forceinline__ float bflo(unsigned u) { return __uint_as_float(u << 16); }
__device__ __forceinline__ float bfhi(unsigned u) { return __uint_as_float(u & 0xffff0000u); }
__device__ __forceinline__ float wave_sum(float v) {
#pragma unroll
    for (int o = 32; o > 0; o >>= 1) v += __shfl_xor(v, o);
    return v;
}
template <int CTRL> __device__ __forceinline__ float dpp_add(float v) {
    return v + __builtin_bit_cast(float, __builtin_amdgcn_update_dpp(0, __builtin_bit_cast(int, v), CTRL, 0xf, 0xf, true));
}
__device__ __forceinline__ float sum8_dpp(float v) { v = dpp_add<0xB1>(v); v = dpp_add<0x4E>(v); v = dpp_add<0x141>(v); return v; }
__device__ __forceinline__ float sumg_dpp(float v) {
    v = dpp_add<0x128>(v);
    float a = v, b = v;
    asm volatile("s_nop 1\n\tv_permlane16_swap_b32 %0, %1\n\ts_nop 1" : "+v"(a), "+v"(b));
    v = a + b;
    a = v; b = v;
    asm volatile("s_nop 1\n\tv_permlane32_swap_b32 %0, %1\n\ts_nop 1" : "+v"(a), "+v"(b));
    return a + b;
}
__device__ __forceinline__ int partner32(int v, int hh) {
    int a = v, b = v;
    asm volatile("s_nop 1\n\tv_permlane32_swap_b32 %0, %1\n\ts_nop 1" : "+v"(a), "+v"(b));
    return hh ? a : b;
}
__device__ __forceinline__ float fexp2(float x) { return __builtin_amdgcn_exp2f(x); }
__device__ __forceinline__ float flog2(float x) { return __builtin_amdgcn_logf(x); }
__device__ __forceinline__ float log_sigmoid_f(float z) { return fminf(z, 0.f) - log1pf(expf(-fabsf(z))); }

struct WJob { const float* src; int lds; int K; int Np; bf16* dst; int ldd; const float* gain; int map; };

__device__ __forceinline__ int src_col_map(int map, int c) {
    if (map == 0) return c;
    if (map == 1) {
        if (c < 768) return c;
        if (c < 1952) return c + 4;
        if (c < 1956) return c - 1952 + 768;
        return -1;
    }
    if (c < 256) return 192 * (c >> 6) + (c & 63);
    int e = c - 256;
    return 192 * (e >> 7) + 64 + (e & 127);
}

__device__ __forceinline__ void wconv_tile(const WJob& j, int tile) {
    float* tl = (float*)smem;
    int ktiles = j.K >> 5;
    int nt = tile / ktiles, kt = tile % ktiles;
    int n0 = nt * 32, k0 = kt * 32;
    int tx = opaque_tid() & 31, ty = opaque_tid() >> 5;
    int sc = src_col_map(j.map, n0 + tx);
#pragma unroll
    for (int i = 0; i < 2; ++i) {
        int k = k0 + ty + 16 * i;
        float v = 0.f;
        if (sc >= 0) v = j.src[(size_t)k * j.lds + sc] * (j.gain ? j.gain[k] : 1.f);
        tl[(ty + 16 * i) * 33 + tx] = v;
    }
    __syncthreads();
#pragma unroll
    for (int i = 0; i < 2; ++i) {
        int n = n0 + ty + 16 * i;
        j.dst[(size_t)n * j.ldd + k0 + tx] = (bf16)tl[tx * 33 + ty + 16 * i];
    }
    __syncthreads();
}

__device__ __forceinline__ void phase0(const Params& P) {
    char* ws = opq(P.ws);
    const int G = gridDim.x, bid = blockIdx.x, tid = opaque_tid();
    {
        const int w = tid >> 6, l = tid & 63;
        float* tsc = (float*)(ws + OFF_TSC);
        for (int it = bid * NW + w; it < 4 * NEXP; it += G * NW) {
            int tb = it >> 14, e = it & (NEXP - 1);
            const float* src = (tb < 2 ? P.peer_u : P.peer_v) + ((size_t)(tb & 1) * NEXP + e) * DM + l * 16;
            unsigned char* dst = (unsigned char*)(ws + (tb < 2 ? OFF_UB : OFF_VB)) + (size_t)(tb & 1) * NEXP * 512;
            float4 a = ((const float4*)src)[0], b = ((const float4*)src)[1], c = ((const float4*)src)[2], d = ((const float4*)src)[3];
            if (tb < 2) {
                const float4* g4 = (const float4*)(P.norm_ffn_g + (tb & 1) * 1024 + l * 16);
                float4 g0 = g4[0], g1 = g4[1], g2 = g4[2], g3 = g4[3];
                a.x *= g0.x; a.y *= g0.y; a.z *= g0.z; a.w *= g0.w; b.x *= g1.x; b.y *= g1.y; b.z *= g1.z; b.w *= g1.w;
                c.x *= g2.x; c.y *= g2.y; c.z *= g2.z; c.w *= g2.w; d.x *= g3.x; d.y *= g3.y; d.z *= g3.z; d.w *= g3.w;
            }
            float am = fmaxf(fmaxf(fmaxf(fabsf(a.x), fabsf(a.y)), fmaxf(fabsf(a.z), fabsf(a.w))), fmaxf(fmaxf(fabsf(b.x), fabsf(b.y)), fmaxf(fabsf(b.z), fabsf(b.w))));
            am = fmaxf(am, fmaxf(fmaxf(fmaxf(fabsf(c.x), fabsf(c.y)), fmaxf(fabsf(c.z), fabsf(c.w))), fmaxf(fmaxf(fabsf(d.x), fabsf(d.y)), fmaxf(fabsf(d.z), fabsf(d.w)))));
#pragma unroll
            for (int o = 32; o > 0; o >>= 1) am = fmaxf(am, __shfl_xor(am, o));
            float sc = (am > 0.f) ? (6.0f / am) : 1.f, isc = (am > 0.f) ? (am * (1.f / 6.0f)) : 1.f;
            unsigned w0 = 0, w1 = 0;
            w0 = __builtin_amdgcn_cvt_scalef32_pk_fp4_f32(w0, a.x * sc, a.y * sc, 1.0f, 0);
            w0 = __builtin_amdgcn_cvt_scalef32_pk_fp4_f32(w0, a.z * sc, a.w * sc, 1.0f, 1);
            w0 = __builtin_amdgcn_cvt_scalef32_pk_fp4_f32(w0, b.x * sc, b.y * sc, 1.0f, 2);
            w0 = __builtin_amdgcn_cvt_scalef32_pk_fp4_f32(w0, b.z * sc, b.w * sc, 1.0f, 3);
            w1 = __builtin_amdgcn_cvt_scalef32_pk_fp4_f32(w1, c.x * sc, c.y * sc, 1.0f, 0);
            w1 = __builtin_amdgcn_cvt_scalef32_pk_fp4_f32(w1, c.z * sc, c.w * sc, 1.0f, 1);
            w1 = __builtin_amdgcn_cvt_scalef32_pk_fp4_f32(w1, d.x * sc, d.y * sc, 1.0f, 2);
            w1 = __builtin_amdgcn_cvt_scalef32_pk_fp4_f32(w1, d.z * sc, d.w * sc, 1.0f, 3);
            u32x2 o2 = {w0, w1};
            *(u32x2*)(dst + ((size_t)(l >> 4) * NEXP + e) * 128 + (l & 15) * 8) = o2;
            if (l == 0) tsc[tb * NEXP + e] = isc;
        }
    }
    {
        for (int L = 0; L < 2; ++L) {
            WJob jobs[7];
            jobs[0] = {P.w_in + (size_t)L * 1024 * IN_W, IN_W, 1024, 2048, (bf16*)(ws + OFF_WIN) + (size_t)L * 2048 * LDH, LDH, P.norm_mix_g + L * 1024, 1};
            jobs[1] = {P.w_o + (size_t)L * 1024 * 1024, 1024, 1024, 1024, (bf16*)(ws + OFF_WO) + (size_t)L * 1024 * LDH, LDH, P.mix_out_norm_g + L * 1024, 0};
            jobs[2] = {P.w_query + (size_t)L * 1024 * 1024, 1024, 1024, 1024, (bf16*)(ws + OFF_WQ) + (size_t)L * 1024 * LDH, LDH, P.norm_ffn_g + L * 1024, 0};
            jobs[3] = {P.w_ple_gate + (size_t)L * 1024 * 1024, 1024, 1024, 1024, (bf16*)(ws + OFF_WG) + (size_t)L * 1024 * LDH, LDH, P.ple_norm_g + L * 1024, 0};
            jobs[4] = {P.w_ple + (size_t)L * 256 * 1024, 1024, 256, 1024, (bf16*)(ws + OFF_WP) + (size_t)L * 1024 * LDP, LDP, nullptr, 0};
            jobs[5] = {P.w_uq + (size_t)L * 256 * 384, 384, 256, 384, (bf16*)(ws + OFF_WUQ) + (size_t)L * 384 * LDP, LDP, P.mla_q_norm_g + L * 256, 0};
            jobs[6] = {P.w_ukv + (size_t)L * 128 * 768, 768, 128, 768, (bf16*)(ws + OFF_WUKV) + (size_t)L * 768 * LDC, LDC, P.mla_kv_norm_g + L * 128, 2};
#pragma unroll
            for (int q = 0; q < 7; ++q) {
                int nt = (jobs[q].Np >> 5) * (jobs[q].K >> 5);
                for (int it = bid; it < nt; it += G) wconv_tile(jobs[q], it);
            }
        }
    }
    {
        const float* src = P.sub_keys;
        bf16* dst = (bf16*)(ws + OFF_SKB);
        for (int i = bid * NTHR + tid; i < 262144 / 2; i += G * NTHR) {
            float2 v = ((const float2*)src)[i];
            ((unsigned*)dst)[i] = pack2(v.x, v.y);
        }
    }
    {
        const float4* src = (const float4*)P.p;
        bf16* dst = (bf16*)(ws + OFF_PB);
        for (int i = bid * NTHR + tid; i < 2 * TOK * 256 / 8; i += G * NTHR) {
            float4 a = src[2 * i], b = src[2 * i + 1];
            u32x4 o = {pack2(a.x, a.y), pack2(a.z, a.w), pack2(b.x, b.y), pack2(b.z, b.w)};
            *(u32x4*)(dst + (size_t)(i >> 5) * LDP + (i & 31) * 8) = o;
        }
    }
    {
        bf16* hb = (bf16*)(ws + OFF_HB0);
        float* ss0 = (float*)(ws + OFF_SSA);
        int w = tid >> 6, l = tid & 63;
        for (int row = bid * NW + w; row < TOK; row += G * NW) {
            const float4* xr = (const float4*)(P.x + (size_t)row * DM);
            float ss = 0.f;
#pragma unroll
            for (int i = 0; i < 2; ++i) {
                float4 a = xr[i * 128 + l * 2], b = xr[i * 128 + l * 2 + 1];
                ss += a.x * a.x + a.y * a.y + a.z * a.z + a.w * a.w + b.x * b.x + b.y * b.y + b.z * b.z + b.w * b.w;
                uint4 o;
                o.x = pack2(a.x, a.y); o.y = pack2(a.z, a.w); o.z = pack2(b.x, b.y); o.w = pack2(b.z, b.w);
                ((uint4*)(hb + (size_t)row * LDH))[i * 64 + l] = o;
            }
            ss = wave_sum(ss);
            if (l == 0) {
                *(float4*)(ss0 + (size_t)row * 8) = make_float4(ss, 0.f, 0.f, 0.f);
                *(float4*)(ss0 + (size_t)row * 8 + 4) = make_float4(0.f, 0.f, 0.f, 0.f);
            }
        }
    }
    {
        float* cs = (float*)(ws + OFF_CS);
        for (int i = bid * NTHR + tid; i < TOK * 16; i += G * NTHR) {
            int t = i >> 4, k = i & 15;
            float inv = powf(10000.0f, -(float)k / 16.0f);
            float ang = (float)P.pos[t] * inv;
            cs[2 * i] = cosf(ang);
            cs[2 * i + 1] = sinf(ang);
        }
    }
}

struct NoHook { static constexpr bool nodma = false; __device__ __forceinline__ void operator()(int, f32x16 (&)[2][2]) const {} };
struct NoDmaHook { static constexpr bool nodma = true; __device__ __forceinline__ void operator()(int, f32x16 (&)[2][2]) const {} };
template <typename HOOK>
__device__ __forceinline__ void gemm_core(f32x16 (&acc)[2][2], const bf16* A, int lda, const bf16* Bt, int ldb, int K,
                                          int m0, int n0, HOOK hook) {
    const int tid = opaque_tid(), w = tid >> 6, l = tid & 63, r = l & 31, hh = l >> 5;
    const int wm = w >> 1, wn = w & 1;
    const int dp = (tid & 15) ^ ((tid >> 4) & 15);
    const int drow = 2 * (tid >> 4) + (dp >> 3), dgc = (dp & 7) * 8;
    const bf16* asrc = A + (size_t)(m0 + drow) * lda + dgc;
    const bf16* bsrc = Bt + (size_t)(n0 + drow) * ldb + dgc;
    auto dma = [&](int buf, int k0) {
        if (HOOK::nodma) return;
        char* base = smem + buf * STAGE_BYTES + tid * 16;
#pragma unroll
        for (int i = 0; i < 4; ++i)
            __builtin_amdgcn_global_load_lds((const unsigned*)(asrc + (size_t)(64 * i) * lda + k0), (unsigned*)(base + i * 8192), 16, 0, 0);
#pragma unroll
        for (int i = 0; i < 2; ++i)
            __builtin_amdgcn_global_load_lds((const unsigned*)(bsrc + (size_t)(64 * i) * ldb + k0), (unsigned*)(base + 32768 + i * 8192), 16, 0, 0);
    };
    int offA[2], offB[2];
#pragma unroll
    for (int i = 0; i < 2; ++i) { offA[i] = ((wm * 64 + i * 32 + r) >> 1) * 256; offB[i] = 32768 + ((wn * 64 + i * 32 + r) >> 1) * 256; }
    const int pbase = ((r & 1) << 3), lx = (r >> 1) & 15;
    const int nk = K >> 6;
    const unsigned ldsbase = (unsigned)(size_t)(__attribute__((address_space(3))) char*)smem;
    auto ldfrag = [&](int stage, int s, bf16x8 (&af)[2], bf16x8 (&bfr)[2]) {
        unsigned ch = (unsigned)((((pbase | (2 * s + hh)) ^ lx) << 4)) + ldsbase + (unsigned)(stage * STAGE_BYTES);
        unsigned a0a = ch + offA[0], a1a = ch + offA[1], b0a = ch + offB[0], b1a = ch + offB[1];
        asm volatile("ds_read_b128 %0, %4\n\tds_read_b128 %1, %5\n\tds_read_b128 %2, %6\n\tds_read_b128 %3, %7"
                     : "=&v"(af[0]), "=&v"(af[1]), "=&v"(bfr[0]), "=&v"(bfr[1]) : "v"(a0a), "v"(a1a), "v"(b0a), "v"(b1a) : "memory");
    };
    auto mma = [&](bf16x8 (&af)[2], bf16x8 (&bfr)[2]) {
#pragma unroll
        for (int i = 0; i < 2; ++i)
#pragma unroll
            for (int j = 0; j < 2; ++j) acc[i][j] = __builtin_amdgcn_mfma_f32_32x32x16_bf16(af[i], bfr[j], acc[i][j], 0, 0, 0);
    };
#define LGKM_WAIT(n) do { asm volatile("s_waitcnt lgkmcnt(" #n ")" ::: "memory"); __builtin_amdgcn_sched_barrier(0); } while (0)
    asm volatile("s_waitcnt vmcnt(0)" ::: "memory");
    dma(0, 0);
    dma(1, 64);
    if (nk > 2) { dma(2, 128); asm volatile("s_waitcnt vmcnt(12)" ::: "memory"); }
    else asm volatile("s_waitcnt vmcnt(6)" ::: "memory");
    __builtin_amdgcn_s_barrier();
    bf16x8 a0[2], b0[2], a1[2], b1[2];
    ldfrag(0, 0, a0, b0);
    int cur = 0;
    for (int kt = 0; kt < nk; ++kt) {
        const int nxt = (cur == 2) ? 0 : cur + 1;
        if (kt == 4 || kt == 8) { LGKM_WAIT(0); hook(kt, acc); }
        ldfrag(cur, 1, a1, b1);
        LGKM_WAIT(4);
        mma(a0, b0);
        ldfrag(cur, 2, a0, b0);
        LGKM_WAIT(4);
        mma(a1, b1);
        ldfrag(cur, 3, a1, b1);
        LGKM_WAIT(4);
        mma(a0, b0);
        if (kt + 1 < nk) {
            if (kt + 2 < nk) asm volatile("s_waitcnt vmcnt(6) lgkmcnt(0)" ::: "memory");
            else asm volatile("s_waitcnt vmcnt(0) lgkmcnt(0)" ::: "memory");
            __builtin_amdgcn_s_barrier();
            __builtin_amdgcn_sched_barrier(0);
            if (kt + 3 < nk) dma(cur, (kt + 3) << 6);
            ldfrag(nxt, 0, a0, b0);
        } else {
            LGKM_WAIT(0);
        }
        mma(a1, b1);
        cur = nxt;
    }
    __syncthreads();
}
__device__ __forceinline__ float row_rs8(const float* part, int row) {
    float4 a = *(const float4*)(part + (size_t)row * 8), b = *(const float4*)(part + (size_t)row * 8 + 4);
    float ss = ((a.x + a.y) + (a.z + a.w)) + ((b.x + b.y) + (b.z + b.w));
    return rsqrtf(ss * (1.f / 1024.f) + EPSF);
}
__device__ __forceinline__ bool xcd_tile(int it, int MT, int NT, int& mt, int& nt) {
    const int G = gridDim.x, bid = blockIdx.x;
    if ((G & 7) == 0 && (MT & 7) == 0) {
        const int nbx = G >> 3, q = (bid >> 3) + it * nbx, per = (MT >> 3) * NT;
        if (q >= per) return false;
        mt = (bid & 7) * (MT >> 3) + q / NT; nt = q % NT;
        return true;
    }
    const int q = bid + it * G;
    if (q >= MT * NT) return false;
    mt = q / NT; nt = q % NT;
    return true;
}
struct NoScale { __device__ __forceinline__ float operator()(int, int) const { return 1.f; } };

#define ZERO_ACC(acc)                                  \
    _Pragma("unroll") for (int _i = 0; _i < 2; ++_i)   \
    _Pragma("unroll") for (int _j = 0; _j < 2; ++_j)   \
    _Pragma("unroll") for (int _r = 0; _r < 16; ++_r) acc[_i][_j][_r] = 0.f;


namespace pg8 {
#define PG8_LAS __attribute__((address_space(3)))
typedef unsigned short bf16_t;
constexpr int BM = 256, BK = 64, HALF = 128, HTB = HALF * BK * 2  , NXCD = 8, WGM = 8;

__host__ __device__ __forceinline__ int lds_byte(int r, int c) { const int st = (r >> 4) * 2 + (c >> 5), rr = r & 15, cc = c & 31, ob = rr * 64 + cc * 2; return st * 1024 + (ob ^ (((ob >> 9) & 1) << 5)); }
__host__ __device__ __forceinline__ void stage_rc(int b, int& R, int& C) { const int st = b / 1024, sb = b % 1024, swz = sb ^ (((sb >> 9) & 1) << 5); R = (st >> 1) * 16 + swz / 64; C = (st & 1) * 32 + (swz % 64) / 2; }
__host__ __device__ __forceinline__ int perm32(int rho) { const int n = rho >> 4, i = rho & 15; return 8 * (i >> 2) + 4 * n + (i & 3); }
struct Unit { int pm, pn; };
struct Gemm { const bf16* A; const bf16* Bt; int lda, ldb, M, N, K; };
struct StaticOrder {
    int nM, nN, nwg, G, c;
    __device__ void init(int M, int N, int G_, int c_) { nM = M / BM; nN = N / BM; nwg = nM * nN; G = G_; c = c_; }
    __device__ bool next(int i, Unit& u) const {
        const long L = (long)i * G + c; if (L >= nwg) return false;
        int wgid = (int)L; { const int q = nwg / NXCD, r = nwg % NXCD, xcd = wgid % NXCD, off = wgid / NXCD; wgid = (xcd < r ? xcd * (q + 1) : r * (q + 1) + (xcd - r) * q) + off; }
        const int nig = WGM * nN, gid = wgid / nig, fm = gid * WGM, gsz = (nM - fm) < WGM ? (nM - fm) : WGM;
        u.pm = fm + ((wgid % nig) % gsz); u.pn = (wgid % nig) / gsz; return true;
    }
    __device__ __forceinline__ void a_ready(const Unit&) const {}
    __device__ __forceinline__ void done(const Unit&) const {}
};
template <class Epi, class Sched, bool STAMP = false>
__device__ __forceinline__ void gemm_phase(PG8_LAS unsigned char* lds, const Gemm g, const Sched& S, const Epi& E, unsigned long long* stamps) {
    const int tid = opaque_tid(), wid = __builtin_amdgcn_readfirstlane(tid >> 6), lane = tid & 63, wr = wid >> 2, wc = wid & 3, fr = lane & 15, fq = lane >> 4;
    const int K = g.K, nt = K / BK;
    int ts_lo = 0, ts_hi = 0, nts = 0; const unsigned long long rt_entry = STAMP ? (unsigned long long)wall_clock64() : 0ull;
#define PG8_STAMP() do { if (STAMP && wid == 0 && nts < 64) { const unsigned long long _c = (unsigned long long)clock64(); \
        ts_lo = (lane == nts) ? (int)(unsigned)_c : ts_lo; ts_hi = (lane == nts) ? (int)(unsigned)(_c >> 32) : ts_hi; ++nts; } } while (0)
    PG8_STAMP();
    unsigned voffA[2], voffB[2];
#pragma unroll
    for (int i = 0; i < 2; ++i) { int R, C; stage_rc(tid * 16 + i * 8192, R, C); const int Rb = Epi::PERM ? ((R & ~31) + perm32(R & 31)) : R;
        voffA[i] = (unsigned)(R * g.lda + C) * 2u; voffB[i] = (unsigned)(Rb * g.ldb + C) * 2u; }
    const size_t kstep = (size_t)(BK * 2);
    const size_t hstepA = (size_t)HALF * g.lda * 2, hstepB = (size_t)HALF * g.ldb * 2;
    const size_t tstepA = 2 * hstepA, tstepB = 2 * hstepB;
    const unsigned ldsw = (unsigned)wid * 1024u;
    const int aoff = lds_byte(wr * 64 + fr, fq * 8), boff = lds_byte(wc * 32 + fr, fq * 8);
#define PG8_SA(b, h) (((b) * 2 + (h)) * HTB)
#define PG8_SB(b, h) ((4 + (b) * 2 + (h)) * HTB)
#define PG8_STAGE(bufoff, gbase, voff) do { _Pragma("unroll") for (int _i = 0; _i < 2; ++_i) \
        __builtin_amdgcn_global_load_lds((const unsigned*)((const char*)(gbase) + (voff)[_i]), (PG8_LAS unsigned*)(lds + (bufoff) + ldsw + _i * 8192), 16, 0, 0); } while (0)
#define PG8_LDA(dst, b, h) do { _Pragma("unroll") for (int m = 0; m < 4; ++m) _Pragma("unroll") for (int k = 0; k < 2; ++k) dst[m][k] = *(const PG8_LAS bf16x8*)(lds + PG8_SA(b, h) + aoff + m * 2048 + k * 1024); } while (0)
#define PG8_LDB(dst, b, h) do { _Pragma("unroll") for (int n = 0; n < 2; ++n) _Pragma("unroll") for (int k = 0; k < 2; ++k) dst[n][k] = *(const PG8_LAS bf16x8*)(lds + PG8_SB(b, h) + boff + n * 2048 + k * 1024); } while (0)
#define PG8_MMA(ai, bj, At, Bt) do { __builtin_amdgcn_s_setprio(1); _Pragma("unroll") for (int m = 0; m < 4; ++m) _Pragma("unroll") for (int n = 0; n < 2; ++n) _Pragma("unroll") for (int k = 0; k < 2; ++k) \
        acc[ai][bj][m][n] = __builtin_amdgcn_mfma_f32_16x16x32_bf16(Bt[n][k], At[m][k], acc[ai][bj][m][n], 0, 0, 0); __builtin_amdgcn_s_setprio(0); } while (0)
#define PG8_WAIT_V(n) asm volatile("s_waitcnt vmcnt(" #n ")" ::: "memory")
#define PG8_WAIT_L(n) asm volatile("s_waitcnt lgkmcnt(" #n ")" ::: "memory")
#define PG8_BAR __builtin_amdgcn_s_barrier()
#define PG8_SCHED __builtin_amdgcn_sched_barrier(0)
    Unit cur, nxt; int ui = 0;
    if (!S.next(0, cur)) return;
    f32x4 acc[2][2][4][2];
#pragma unroll
    for (int a = 0; a < 2; ++a)
#pragma unroll
        for (int b = 0; b < 2; ++b)
#pragma unroll
            for (int m = 0; m < 4; ++m)
#pragma unroll
                for (int n = 0; n < 2; ++n) acc[a][b][m][n] = (f32x4){0.f, 0.f, 0.f, 0.f};
    bf16x8 At[4][2], B0[2][2], B1[2][2];
    const char* cA = (const char*)g.A + (size_t)cur.pm * tstepA; const char* cB = (const char*)g.Bt + (size_t)cur.pn * tstepB;
    S.a_ready(cur);
    PG8_STAGE(PG8_SB(0, 0), cB, voffB); PG8_STAGE(PG8_SA(0, 0), cA, voffA); PG8_STAGE(PG8_SB(0, 1), cB + hstepB, voffB); PG8_STAGE(PG8_SA(0, 1), cA + hstepA, voffA);
    if (wr == 1) PG8_BAR;
    PG8_WAIT_V(4); PG8_BAR;
    PG8_STAGE(PG8_SB(1, 0), cB + kstep, voffB); PG8_STAGE(PG8_SA(1, 0), cA + kstep, voffA); PG8_STAGE(PG8_SB(1, 1), cB + hstepB + kstep, voffB);
    PG8_WAIT_V(6); PG8_BAR;
    PG8_STAMP();
    for (;;) {
        const bool has_next = S.next(ui + 1, nxt);
        const char* nA = has_next ? (const char*)g.A + (size_t)nxt.pm * tstepA : cA; const char* nB = has_next ? (const char*)g.Bt + (size_t)nxt.pn * tstepB : cB;
        for (int t = 0; t < nt; t += 2) {
            const bool last = (t == nt - 2);
            const char* a1 = cA + (size_t)(t + 1) * kstep;
            const char* a2 = last ? nA : cA + (size_t)(t + 2) * kstep; const char* b2 = last ? nB : cB + (size_t)(t + 2) * kstep;
            const char* a3 = a2 + kstep; const char* b3 = b2 + kstep;
            if (last && has_next) S.a_ready(nxt);
            E.khook(t, acc, wr, fr);
            PG8_LDB(B0, 0, 0); PG8_SCHED; PG8_LDA(At, 0, 0); PG8_STAGE(PG8_SA(1, 1), a1 + hstepA, voffA);
            PG8_WAIT_L(8); PG8_BAR; PG8_WAIT_L(0); PG8_MMA(0, 0, At, B0); PG8_BAR; PG8_SCHED;
            PG8_LDB(B1, 0, 1); PG8_STAGE(PG8_SB(0, 0), b2, voffB);
            PG8_BAR; PG8_WAIT_L(0); PG8_MMA(0, 1, At, B1); PG8_BAR;
            PG8_LDA(At, 0, 1); PG8_STAGE(PG8_SA(0, 0), a2, voffA);
            PG8_BAR; PG8_WAIT_L(0); PG8_MMA(1, 0, At, B0); PG8_BAR; PG8_SCHED;
            PG8_STAGE(PG8_SB(0, 1), b2 + hstepB, voffB);
            PG8_WAIT_V(6); PG8_BAR; PG8_MMA(1, 1, At, B1); PG8_BAR;
            PG8_LDB(B0, 1, 0); PG8_SCHED; PG8_LDA(At, 1, 0); PG8_STAGE(PG8_SA(0, 1), a2 + hstepA, voffA);
            PG8_WAIT_L(8); PG8_BAR; PG8_WAIT_L(0); PG8_MMA(0, 0, At, B0); PG8_BAR; PG8_SCHED;
            PG8_LDB(B1, 1, 1); PG8_STAGE(PG8_SB(1, 0), b3, voffB);
            PG8_BAR; PG8_WAIT_L(0); PG8_MMA(0, 1, At, B1); PG8_BAR;
            PG8_LDA(At, 1, 1); PG8_STAGE(PG8_SA(1, 0), a3, voffA);
            PG8_BAR; PG8_WAIT_L(0); PG8_MMA(1, 0, At, B0); PG8_BAR; PG8_SCHED;
            PG8_STAGE(PG8_SB(1, 1), b3 + hstepB, voffB);
            PG8_WAIT_V(6); PG8_BAR; PG8_MMA(1, 1, At, B1); PG8_BAR;
        }
        PG8_STAMP();
        if constexpr (!Epi::AFTER_DRAIN) { E(acc, cur, wr, wc, fr, fq); S.done(cur); }
        PG8_STAMP();
        if (!has_next) break;
#pragma unroll
        for (int a = 0; a < 2; ++a)
#pragma unroll
            for (int b = 0; b < 2; ++b)
#pragma unroll
                for (int m = 0; m < 4; ++m)
#pragma unroll
                    for (int n = 0; n < 2; ++n) acc[a][b][m][n] = (f32x4){0.f, 0.f, 0.f, 0.f};
        cur = nxt; cA = nA; cB = nB; ++ui;
    }
    PG8_WAIT_V(0);
    if (wr == 0) PG8_BAR;
    PG8_BAR;
    if constexpr (Epi::AFTER_DRAIN) { E.fused(acc, cur, wr, wc, fr, fq, lds, wid, lane); S.done(cur); }
    PG8_STAMP();
    if (STAMP && wid == 0) { stamps[lane] = lane < nts ? (((unsigned long long)(unsigned)ts_hi << 32) | (unsigned)ts_lo) : 0ull;
        if (lane == 62) stamps[62] = rt_entry; if (lane == 63) stamps[63] = (unsigned long long)wall_clock64(); }
#undef PG8_STAMP
#undef PG8_SA
#undef PG8_SB
#undef PG8_STAGE
#undef PG8_LDA
#undef PG8_LDB
#undef PG8_MMA
#undef PG8_WAIT_V
#undef PG8_WAIT_L
#undef PG8_BAR
#undef PG8_SCHED
}
}

#define TB_LD 136
#define TF_LD 132
template <bool SCALE>
__device__ __forceinline__ void stage_bf16(const f32x16 (&acc)[2][2], const float* rsl) {
    bf16* T = (bf16*)smem;
    const int tid = opaque_tid(), w = tid >> 6, l = tid & 63, hh = l >> 5, wm = w >> 1, wn = w & 1;
#pragma unroll
    for (int i = 0; i < 2; ++i)
#pragma unroll
        for (int rr = 0; rr < 16; ++rr) {
            int row = wm * 64 + i * 32 + (rr & 3) + 8 * (rr >> 2) + 4 * hh;
            float sc = SCALE ? rsl[row] : 1.f;
#pragma unroll
            for (int j = 0; j < 2; ++j) T[row * TB_LD + wn * 64 + j * 32 + (l & 31)] = (bf16)(acc[i][j][rr] * sc);
        }
    __syncthreads();
}
template <bool SCALE>
__device__ __forceinline__ void stage_f32(const f32x16 (&acc)[2][2], const float* rsl) {
    float* T = (float*)smem;
    const int tid = opaque_tid(), w = tid >> 6, l = tid & 63, hh = l >> 5, wm = w >> 1, wn = w & 1;
#pragma unroll
    for (int i = 0; i < 2; ++i)
#pragma unroll
        for (int rr = 0; rr < 16; ++rr) {
            int row = wm * 64 + i * 32 + (rr & 3) + 8 * (rr >> 2) + 4 * hh;
            float sc = SCALE ? rsl[row] : 1.f;
#pragma unroll
            for (int j = 0; j < 2; ++j) T[row * TF_LD + wn * 64 + j * 32 + (l & 31)] = acc[i][j][rr] * sc;
        }
    __syncthreads();
}
template <typename CMAP>
__device__ __forceinline__ void store_rows_bf16(bf16* dst, int ld, int m0, CMAP cmap) {
    const bf16* T = (const bf16*)smem;
    const int tid = opaque_tid();
#pragma unroll
    for (int q = 0; q < 8; ++q) {
        int id = tid + 512 * q, row = id >> 4, ch = id & 15;
        u32x4 v = *(const u32x4*)(T + row * TB_LD + ch * 8);
        *(u32x4*)(dst + (size_t)(m0 + row) * ld + cmap(ch * 8)) = v;
    }
}
__device__ __forceinline__ void store_cols_bf16(bf16* vt, size_t crow0, int s0) {
    const unsigned short* T = (const unsigned short*)smem;
    const int tid = opaque_tid();
#pragma unroll
    for (int q = 0; q < 8; ++q) {
        int id = tid + 512 * q, c = id & 127, sg = id >> 7;
        unsigned e[8];
#pragma unroll
        for (int k = 0; k < 8; ++k) e[k] = T[(8 * sg + k) * TB_LD + c];
        u32x4 v = {e[0] | (e[1] << 16), e[2] | (e[3] << 16), e[4] | (e[5] << 16), e[6] | (e[7] << 16)};
        *(u32x4*)(vt + (crow0 + c) * SEQ + s0 + 8 * sg) = v;
    }
}
__device__ __forceinline__ void residual_store(const float* hin, float* hout, bf16* hb_out, float* gss, int m0, int n0, int nt) {
    const float* T = (const float*)smem;
    const int tid = opaque_tid(), l = tid & 63;
#pragma unroll 4
    for (int q = 0; q < 16; ++q) {
        int id = tid + 512 * q, row = id >> 5, ch = id & 31;
        f32x4 d = *(const f32x4*)(T + row * TF_LD + ch * 4);
        size_t gi = (size_t)(m0 + row) * 1024 + n0 + ch * 4;
        f32x4 h = *(const f32x4*)(hin + gi);
        f32x4 v = h + d;
        *(f32x4*)(hout + gi) = v;
        u32x2 b = {pack2(v.x, v.y), pack2(v.z, v.w)};
        *(u32x2*)(hb_out + (size_t)(m0 + row) * LDH + n0 + ch * 4) = b;
        float ss = v.x * v.x + v.y * v.y + v.z * v.z + v.w * v.w;
        ss = dpp_add<0xB1>(ss); ss = dpp_add<0x4E>(ss); ss = dpp_add<0x141>(ss); ss = dpp_add<0x140>(ss);
        ss += __shfl_xor(ss, 16);
        if ((l & 31) == 0) gss[(size_t)(m0 + row) * 8 + nt] = ss;
    }
}
struct ColAdd { int off; __device__ __forceinline__ int operator()(int c) const { return c + off; } };
struct ColHead96 { __device__ __forceinline__ int operator()(int c) const { return (c >> 6) * 96 + (c & 63); } };

struct EpiProj {
    static constexpr bool PERM = true, AFTER_DRAIN = false;
    const float* ssrow; bf16 *fq, *fk, *fvr, *sq, *sk, *svr, *cq, *ckv, *mk; float* flog; const float* cs;
    __device__ __forceinline__ void khook(int, f32x4 (&)[2][2][4][2], int, int) const {}
    __device__ __forceinline__ void operator()(const f32x4 (&acc)[2][2][4][2], const pg8::Unit& u, int wr, int wc, int fr, int fqd) const {
        const int row0 = u.pm * 256 + wr * 64 + fr, lc0 = wc * 32 + 8 * fqd, pn = u.pn;
        bf16* dst; int ld;
        if (pn == 0) { dst = fq; ld = 256; } else if (pn == 1) { dst = fk; ld = 256; } else if (pn == 2) { dst = fvr; ld = 256; }
        else if (pn == 3) { dst = sq; ld = 256; } else if (pn == 4) { dst = sk; ld = 256; } else if (pn == 5) { dst = svr; ld = 256; }
        else if (pn == 6) { dst = cq; ld = LDP; } else { dst = ckv; ld = LDC; }
#pragma unroll
        for (int ai = 0; ai < 2; ++ai)
#pragma unroll
            for (int m = 0; m < 4; ++m) {
                const int row = row0 + ai * 128 + m * 16;
                const float rs = row_rs8(ssrow, row);
#pragma unroll
                for (int bj = 0; bj < 2; ++bj) {
                    f32x4 v0 = acc[ai][bj][m][0] * rs, v1 = acc[ai][bj][m][1] * rs;
                    if (pn < 7 || bj == 0) {
                        u32x4 wv = {pack2(v0[0], v0[1]), pack2(v0[2], v0[3]), pack2(v1[0], v1[1]), pack2(v1[2], v1[3])};
                        *(u32x4*)(dst + (size_t)row * ld + bj * 128 + lc0) = wv;
                    } else if (wc == 0) {
                        const int hh = fqd >> 1, pi = 8 * (fqd & 1);
                        float vv[8] = {v0[0], v0[1], v0[2], v0[3], v1[0], v1[1], v1[2], v1[3]}, ov[8];
                        const f32x4* c4 = (const f32x4*)(cs + ((size_t)row * 16 + pi) * 2);
                        f32x4 t0 = c4[0], t1 = c4[1], t2 = c4[2], t3 = c4[3];
                        float cc[8] = {t0.x, t0.z, t1.x, t1.z, t2.x, t2.z, t3.x, t3.z}, sn[8] = {t0.y, t0.w, t1.y, t1.w, t2.y, t2.w, t3.y, t3.w};
#pragma unroll
                        for (int e = 0; e < 8; ++e) {
                            float pv = __builtin_bit_cast(float, partner32(__builtin_bit_cast(int, vv[e]), hh));
                            ov[e] = hh ? (pv * sn[e] + vv[e] * cc[e]) : (vv[e] * cc[e] - pv * sn[e]);
                        }
                        u32x4 wv = {pack2(ov[0], ov[1]), pack2(ov[2], ov[3]), pack2(ov[4], ov[5]), pack2(ov[6], ov[7])};
#pragma unroll
                        for (int h = 0; h < 4; ++h) *(u32x4*)(mk + (size_t)row * 384 + h * 96 + 64 + 8 * fqd) = wv;
                    } else if (wc == 1 && fqd == 0) {
                        *(f32x4*)(flog + (size_t)row * 4) = v0;
                    }
                }
            }
    }
};
__device__ __forceinline__ void phase_proj(const Params& P, int L, int hsel, const float* ssrow) {
    char* ws = opq(P.ws);
    const bf16* hb = (const bf16*)(ws + (hsel ? OFF_HB1 : OFF_HB0));
    const bf16* Bt = (const bf16*)(ws + OFF_WIN) + (size_t)L * 2048 * LDH;
    pg8::Gemm g{hb, Bt, LDH, LDH, TOK, 2048, 1024};
    pg8::StaticOrder S; S.init(TOK, 2048, gridDim.x, blockIdx.x);
    EpiProj E{ssrow, (bf16*)(ws + OFF_FQ), (bf16*)(ws + OFF_FK), (bf16*)(ws + OFF_PART), (bf16*)(ws + OFF_SQ), (bf16*)(ws + OFF_SKK),
              (bf16*)(ws + OFF_PART + 8 * MBy), (bf16*)(ws + OFF_CQ), (bf16*)(ws + OFF_CKV), (bf16*)(ws + OFF_MK), (float*)(ws + OFF_FLOG),
              (const float*)(ws + OFF_CS)};
    pg8::gemm_phase((PG8_LAS unsigned char*)smem, g, S, E, nullptr);
    __syncthreads();
}

template <int KW>
__device__ __forceinline__ void row_rms_to_lds(const bf16* A, int lda, int m0) {
    const int tid = opaque_tid(), row = tid >> 1, half = tid & 1;
    float ss = 0.f;
    const u32x4* p = (const u32x4*)(A + (size_t)(m0 + row) * lda + half * (KW / 2));
#pragma unroll
    for (int q = 0; q < KW / 16; ++q) {
        u32x4 v = p[q];
        float a;
        a = bflo(v.x); ss += a * a; a = bfhi(v.x); ss += a * a;
        a = bflo(v.y); ss += a * a; a = bfhi(v.y); ss += a * a;
        a = bflo(v.z); ss += a * a; a = bfhi(v.z); ss += a * a;
        a = bflo(v.w); ss += a * a; a = bfhi(v.w); ss += a * a;
    }
    ss += __shfl_xor(ss, 1);
    if (half == 0) ((float*)(smem + LDS_AUX))[row] = rsqrtf(ss * (1.f / (float)KW) + EPSF);
}

__device__ __forceinline__ void phase_mla_up(const Params& P, int L) {
    char* ws = opq(P.ws);
    const bf16* cq = (const bf16*)(ws + OFF_CQ); const bf16* ckv = (const bf16*)(ws + OFF_CKV);
    const bf16* wuq = (const bf16*)(ws + OFF_WUQ) + (size_t)L * 384 * LDP;
    const bf16* wukv = (const bf16*)(ws + OFF_WUKV) + (size_t)L * 768 * LDC;
    bf16* mq = (bf16*)(ws + OFF_MQ); bf16* mk = (bf16*)(ws + OFF_MK); bf16* mvt = (bf16*)(ws + OFF_MVT);
    const float* cs = (const float*)(ws + OFF_CS);
    const float* flog = (const float*)(ws + OFF_FLOG);
    float* cumF = (float*)(ws + OFF_CUMF);
    const int tid = opaque_tid(), w = tid >> 6, l = tid & 63, hh = l >> 5, wm = w >> 1, wn = w & 1;
    const int NQ = 64 * 3, NKV = 64 * 6, NCF = 4;
    const float* aux = (const float*)(smem + LDS_AUX);
    for (int gw = blockIdx.x * NW + w; gw < 2048; gw += gridDim.x * NW) {
        const int type = gw >> 10, bh = (gw >> 5) & 31, tb = gw & 31, b = bh >> 2, h = bh & 3;
        const bf16* src = (const bf16*)(ws + OFF_PART + (type ? 8 * MBy : 0)) + ((size_t)(b * SEQ + tb * 64 + l) * 256 + h * 64);
        unsigned short* dst = (unsigned short*)(ws + (type ? OFF_SVT : OFF_FVT)) + (size_t)bh * 64 * SEQ + tb * 64 + l;
        u32x4 rv8[8];
#pragma unroll
        for (int q = 0; q < 8; ++q) rv8[q] = ((const u32x4*)src)[q];
#pragma unroll
        for (int q = 0; q < 8; ++q) {
            dst[(size_t)(8 * q + 0) * SEQ] = (unsigned short)(rv8[q].x & 0xffffu); dst[(size_t)(8 * q + 1) * SEQ] = (unsigned short)(rv8[q].x >> 16);
            dst[(size_t)(8 * q + 2) * SEQ] = (unsigned short)(rv8[q].y & 0xffffu); dst[(size_t)(8 * q + 3) * SEQ] = (unsigned short)(rv8[q].y >> 16);
            dst[(size_t)(8 * q + 4) * SEQ] = (unsigned short)(rv8[q].z & 0xffffu); dst[(size_t)(8 * q + 5) * SEQ] = (unsigned short)(rv8[q].z >> 16);
            dst[(size_t)(8 * q + 6) * SEQ] = (unsigned short)(rv8[q].w & 0xffffu); dst[(size_t)(8 * q + 7) * SEQ] = (unsigned short)(rv8[q].w >> 16);
        }
    }
    for (int item = blockIdx.x; item < NQ + NKV + NCF; item += gridDim.x) {
        if (item < NQ) {
            int mt = item / 3, nt = item % 3;
            int m0 = mt * 256, n0 = nt * 128;
            __syncthreads();
            row_rms_to_lds<256>(cq, LDP, m0);
            f32x16 acc[2][2];
            ZERO_ACC(acc);
            gemm_core(acc, cq, LDP, wuq, LDP, 256, m0, n0, NoHook());
#pragma unroll
            for (int i = 0; i < 2; ++i)
#pragma unroll
                for (int j = 0; j < 2; ++j) {
                    int c0 = n0 + wn * 64 + j * 32;
                    int rloc = wm * 64 + i * 32 + 4 * hh;
                    bool rot = (c0 % 96) == 64;
                    int ci = l & 31, pi = ci & 15;
#pragma unroll
                    for (int rr = 0; rr < 16; ++rr) {
                        int rl = rloc + (rr & 3) + 8 * (rr >> 2);
                        float v = acc[i][j][rr] * aux[rl];
                        if (rot) {
                            float pv = __shfl_xor(v, 16);
                            float2 c_s = *(const float2*)(cs + ((size_t)(m0 + rl) * 16 + pi) * 2);
                            v = (ci < 16) ? (v * c_s.x - pv * c_s.y) : (pv * c_s.y + v * c_s.x);
                        }
                        acc[i][j][rr] = v;
                    }
                }
            stage_bf16<false>(acc, nullptr);
            store_rows_bf16(mq, 384, m0, ColAdd{n0});
        } else if (item < NQ + NKV) {
            int it2 = item - NQ;
            int mt = it2 / 6, nt = it2 % 6;
            int m0 = mt * 256, n0 = nt * 128;
            __syncthreads();
            row_rms_to_lds<128>(ckv, LDC, m0);
            f32x16 acc[2][2];
            ZERO_ACC(acc);
            gemm_core(acc, ckv, LDC, wukv, LDC, 128, m0, n0, NoHook());
            stage_bf16<true>(acc, aux);
            if (nt < 2) {
                const int nb0 = n0;
                struct CM { int n0; __device__ __forceinline__ int operator()(int c) const { int col = n0 + c; return (col >> 6) * 96 + (col & 63); } };
                store_rows_bf16(mk, 384, m0, CM{nb0});
            } else {
                store_cols_bf16(mvt, (size_t)(m0 >> 11) * 512 + (n0 - 256), m0 & 2047);
            }
        } else {
            int seq = (item - NQ - NKV) * NW + w;
            int b = seq >> 2, h = seq & 3;
            float bfv = P.b_forget[L * 4 + h];
            float vals[32];
            float run = 0.f;
#pragma unroll
            for (int i = 0; i < 32; ++i) {
                int s = l * 32 + i;
                float z = flog[((size_t)b * SEQ + s) * 4 + h] + bfv;
                run += log_sigmoid_f(z);
                vals[i] = run;
            }
            float tot = run, incl = tot;
#pragma unroll
            for (int o = 1; o < 64; o <<= 1) {
                float t = __shfl_up(incl, o);
                if (l >= o) incl += t;
            }
            float excl = incl - tot;
#pragma unroll
            for (int i = 0; i < 32; ++i) cumF[(size_t)seq * SEQ + l * 32 + i] = vals[i] + excl;
        }
    }
}

template <int MODE, int DK, int DV>
__device__ __forceinline__ void attn_item(const bf16* __restrict__ Q, int ldq, const bf16* __restrict__ Kg, int ldk,
                          const bf16* __restrict__ Vt, const float* __restrict__ cumF, bf16* __restrict__ Y,
                          float* __restrict__ ssy, int b, int h, int qb, float c1, char* lds, int fake = 0) {
    constexpr int KSTR = DK * 2 + 16;
    constexpr int VSTR = 144;
    constexpr int KBYTES = 64 * KSTR, VBYTES = DV * VSTR;
    constexpr int BUF = (KBYTES + VBYTES + 256 + 255) & ~255;
    static_assert(2 * BUF <= 65536, "lds");
    constexpr int KCH = DK / 8, KPT = (64 * KCH) / 256, VPT = (DV * 8) / 256;
    const int tid = opaque_tid() & 255, w = tid >> 6, l = tid & 63, r = l & 31, hh = l >> 5;
    const int q0 = qb * 128;
    const int qrow = q0 + 32 * w + r;
    const size_t tok = (size_t)b * SEQ + qrow;
    const int bh = b * 4 + h;
    bf16x8 qf[DK / 16];
#pragma unroll
    for (int s = 0; s < DK / 16; ++s) qf[s] = *(const bf16x8*)(Q + tok * ldq + h * DK + 16 * s + 8 * hh);
    f32x16 o[DV / 32];
    const f32x16 zero16 = {0.f, 0.f, 0.f, 0.f, 0.f, 0.f, 0.f, 0.f, 0.f, 0.f, 0.f, 0.f, 0.f, 0.f, 0.f, 0.f};
#pragma unroll
    for (int d = 0; d < DV / 32; ++d) o[d] = zero16;
    float m = -1e30f, lsum = 0.f, R = 0.f;
    float Fq = 0.f;
    if (MODE == 0) Fq = cumF[(size_t)bh * SEQ + qrow] * LOG2E;
    const int nkt = (q0 + 128) >> 6;
    u32x4 kregA[KPT], vregA[VPT], kregB[KPT], vregB[VPT];
    float4 fregA = {0.f, 0.f, 0.f, 0.f}, fregB = {0.f, 0.f, 0.f, 0.f};
    auto gload = [&](int kt, u32x4 (&kreg)[KPT], u32x4 (&vreg)[VPT], float4& freg) {
#pragma unroll
        for (int i = 0; i < KPT; ++i) {
            int e = tid + 256 * i;
            int row = e / KCH, ch = e % KCH;
            kreg[i] = *(const u32x4*)(Kg + ((size_t)b * SEQ + kt * 64 + row) * ldk + h * DK + ch * 8);
        }
#pragma unroll
        for (int i = 0; i < VPT; ++i) {
            int e = tid + 256 * i;
            int row = e >> 3, ch = e & 7;
            vreg[i] = *(const u32x4*)(Vt + ((size_t)bh * DV + row) * SEQ + kt * 64 + ch * 8);
        }
        if (MODE == 0 && tid < 16) freg = *(const float4*)(cumF + (size_t)bh * SEQ + kt * 64 + tid * 4);
    };
    auto lwrite = [&](int buf, u32x4 (&kreg)[KPT], u32x4 (&vreg)[VPT], float4& freg) {
        char* base = lds + buf * BUF;
#pragma unroll
        for (int i = 0; i < KPT; ++i) {
            int e = tid + 256 * i;
            int row = e / KCH, ch = e % KCH;
            *(u32x4*)(base + row * KSTR + ch * 16) = kreg[i];
        }
#pragma unroll
        for (int i = 0; i < VPT; ++i) {
            int e = tid + 256 * i;
            int row = e >> 3, ch = e & 7;
            *(u32x4*)(base + KBYTES + row * VSTR + ch * 16) = vreg[i];
        }
        if (MODE == 0 && tid < 16) { float4 fn = {-freg.x * LOG2E, -freg.y * LOG2E, -freg.z * LOG2E, -freg.w * LOG2E}; *(float4*)(base + KBYTES + VBYTES + tid * 16) = fn; }
    };
    const int prow = (r & 0x13) | ((r & 4) << 1) | ((r & 8) >> 1);
    auto ktof = [&](int it) { return (MODE == 1) ? (nkt - 1 - it) : it; };
    gload(ktof(0), kregA, vregA, fregA);
    lwrite(0, kregA, vregA, fregA);
    constexpr bool D2 = (MODE != 2);
    if (D2 && nkt > 1) gload(ktof(1), kregB, vregB, fregB);
    __syncthreads();
    auto tile = [&](int it, u32x4 (&kn)[KPT], u32x4 (&vn)[VPT], float4& fn2, u32x4 (&kf)[KPT], u32x4 (&vf2)[VPT], float4& ff) {
        const int kt = ktof(it);
        if (!(fake & 1)) {
        if (D2) { if (it + 2 < nkt) gload(ktof(it + 2), kf, vf2, ff); }
        else { if (it + 1 < nkt) gload(ktof(it + 1), kf, vf2, ff); }
        }
        const char* base = lds + (it & 1) * BUF;
        const bool active = (kt * 64) <= (q0 + 32 * w + 31);
        if (active) {
            const bool needmask = (kt * 64 + 63) >= (q0 + 32 * w);
            f32x16 s[2];
#pragma unroll
            for (int sub = 0; sub < 2; ++sub) {
                s[sub] = zero16;
#pragma unroll
                for (int ks = 0; ks < DK / 16; ++ks) {
                    bf16x8 kf = *(const bf16x8*)(base + (sub * 32 + prow) * KSTR + (2 * ks + hh) * 16);
                    s[sub] = __builtin_amdgcn_mfma_f32_32x32x16_bf16(kf, qf[ks], s[sub], 0, 0, 0);
                }
            }
            bf16x8 pf[2][2];
            if (fake & 2) {
#pragma unroll
                for (int sub = 0; sub < 2; ++sub)
#pragma unroll
                    for (int a = 0; a < 2; ++a) {
                        uint4 u;
                        u.x = pack2(s[sub][8 * a], s[sub][8 * a + 1]); u.y = pack2(s[sub][8 * a + 2], s[sub][8 * a + 3]);
                        u.z = pack2(s[sub][8 * a + 4], s[sub][8 * a + 5]); u.w = pack2(s[sub][8 * a + 6], s[sub][8 * a + 7]);
                        pf[sub][a] = __builtin_bit_cast(bf16x8, u);
                    }
                lsum = 1.f;
            } else if (MODE != 1) {
                const float* Ft = (const float*)(base + KBYTES + VBYTES);
                float mx = -INFINITY;
                float tv[2][16];
#pragma unroll
                for (int sub = 0; sub < 2; ++sub)
#pragma unroll
                    for (int a = 0; a < 2; ++a) {
                        int kofs = sub * 32 + 16 * a + 8 * hh;
                        float fk[8];
                        if (MODE == 0) {
                            float4 f0 = *(const float4*)(Ft + kofs), f1 = *(const float4*)(Ft + kofs + 4);
                            fk[0] = f0.x; fk[1] = f0.y; fk[2] = f0.z; fk[3] = f0.w; fk[4] = f1.x; fk[5] = f1.y; fk[6] = f1.z; fk[7] = f1.w;
                        }
#pragma unroll
                        for (int j = 0; j < 8; ++j) {
                            int rr = 8 * a + j;
                            float v = (MODE == 0) ? fmaf(s[sub][rr], c1, fk[j]) : s[sub][rr] * c1;
                            tv[sub][rr] = v;
                        }
                    }
                if (needmask) {
#pragma unroll
                    for (int sub = 0; sub < 2; ++sub)
#pragma unroll
                        for (int rr = 0; rr < 16; ++rr) {
                            int key = kt * 64 + sub * 32 + 16 * (rr >> 3) + 8 * hh + (rr & 7);
                            if (key > qrow) tv[sub][rr] = -INFINITY;
                        }
                }
#pragma unroll
                for (int sub = 0; sub < 2; ++sub)
#pragma unroll
                    for (int rr = 0; rr < 16; ++rr) mx = fmaxf(mx, tv[sub][rr]);
                mx = fmaxf(mx, __builtin_bit_cast(float, partner32(__builtin_bit_cast(int, mx), hh)));
                float mnew = fmaxf(m, mx);
                float rsum = 0.f;
#pragma unroll
                for (int sub = 0; sub < 2; ++sub)
#pragma unroll
                    for (int a = 0; a < 2; ++a) {
                        float pv[8];
#pragma unroll
                        for (int j = 0; j < 8; ++j) { pv[j] = fexp2(tv[sub][8 * a + j] - mnew); rsum += pv[j]; }
                        uint4 u;
                        u.x = pack2(pv[0], pv[1]); u.y = pack2(pv[2], pv[3]); u.z = pack2(pv[4], pv[5]); u.w = pack2(pv[6], pv[7]);
                        pf[sub][a] = __builtin_bit_cast(bf16x8, u);
                    }
                rsum += __builtin_bit_cast(float, partner32(__builtin_bit_cast(int, rsum), hh));
                if (__builtin_amdgcn_ballot_w64(mnew != m) != 0ull) {
                    float alpha = fexp2(m - mnew);
                    lsum *= alpha;
#pragma unroll
                    for (int d = 0; d < DV / 32; ++d) o[d] = o[d] * alpha;
                    m = mnew;
                }
                lsum += rsum;
            } else {
#pragma unroll
                for (int sb = 0; sb < 2; ++sb) {
                    const int sub = 1 - sb;
                    float lsig[16], lneg[16];
                    float A0 = 0.f, A1 = 0.f;
#pragma unroll
                    for (int rr = 0; rr < 16; ++rr) {
                        int key = kt * 64 + sub * 32 + 16 * (rr >> 3) + 8 * hh + (rr & 7);
                        bool valid = key < qrow;
                        float z = s[sub][rr] * c1;
                        float e = fexp2(-fabsf(z));
                        float l1p = flog2(1.f + e);
                        float ls = fminf(z, 0.f) - l1p;
                        float ln = valid ? (ls - z) : 0.f;
                        lsig[rr] = valid ? ls : -INFINITY;
                        lneg[rr] = ln;
                        if (rr < 8) A0 += ln; else A1 += ln;
                    }
                    float B0 = __shfl_xor(A0, 32), B1 = __shfl_xor(A1, 32);
                    float base1 = (hh == 0) ? (R + B1) : R;
                    float base0 = (hh == 0) ? (R + B1 + A1 + B0) : (R + A1 + B1);
                    float wv[16];
                    float run = base1;
#pragma unroll
                    for (int j = 7; j >= 0; --j) { wv[8 + j] = fexp2(lsig[8 + j] + run); run += lneg[8 + j]; }
                    run = base0;
#pragma unroll
                    for (int j = 7; j >= 0; --j) { wv[j] = fexp2(lsig[j] + run); run += lneg[j]; }
                    R += A0 + A1 + B0 + B1;
#pragma unroll
                    for (int a = 0; a < 2; ++a) {
                        uint4 u;
                        u.x = pack2(wv[8 * a], wv[8 * a + 1]); u.y = pack2(wv[8 * a + 2], wv[8 * a + 3]);
                        u.z = pack2(wv[8 * a + 4], wv[8 * a + 5]); u.w = pack2(wv[8 * a + 6], wv[8 * a + 7]);
                        pf[sub][a] = __builtin_bit_cast(bf16x8, u);
                    }
                }
            }
#pragma unroll
            for (int d = 0; d < DV / 32; ++d)
#pragma unroll
                for (int sub = 0; sub < 2; ++sub)
#pragma unroll
                    for (int a = 0; a < 2; ++a) {
                        bf16x8 vf = *(const bf16x8*)(base + KBYTES + (d * 32 + r) * VSTR + (sub * 32 + 16 * a + 8 * hh) * 2);
                        o[d] = __builtin_amdgcn_mfma_f32_32x32x16_bf16(vf, pf[sub][a], o[d], 0, 0, 0);
                    }
        }
        if (!(fake & 1)) { if (it + 1 < nkt) lwrite((it + 1) & 1, kn, vn, fn2); }
        __syncthreads();
    };
    if (D2) {
        for (int it = 0; it < nkt; it += 2) {
            tile(it, kregB, vregB, fregB, kregA, vregA, fregA);
            if (it + 1 < nkt) tile(it + 1, kregA, vregA, fregA, kregB, vregB, fregB);
        }
    } else {
        for (int it = 0; it < nkt; ++it) tile(it, kregA, vregA, fregA, kregA, vregA, fregA);
    }
    float inv = (MODE == 1) ? 1.f : (1.f / lsum);
    float ssq = 0.f;
#pragma unroll
    for (int d = 0; d < DV / 32; ++d)
#pragma unroll
        for (int g = 0; g < 4; ++g) {
            float v0 = o[d][4 * g] * inv, v1 = o[d][4 * g + 1] * inv, v2 = o[d][4 * g + 2] * inv, v3 = o[d][4 * g + 3] * inv;
            ssq += v0 * v0 + v1 * v1 + v2 * v2 + v3 * v3;
            uint2 u; u.x = pack2(v0, v1); u.y = pack2(v2, v3);
            *(uint2*)(Y + tok * LDH + h * DV + d * 32 + 8 * g + 4 * hh) = u;
        }
    ssq += __shfl_xor(ssq, 32);
    if (hh == 0) ssy[tok * 16 + h] = ssq;
}

__device__ __forceinline__ void phase_attn(const Params& P, int L, int rep = 0, int fake = 0) {
    char* ws = opq(P.ws);
    int* cnt = (int*)(ws + OFF_CNT) + L * 64 + rep * 16;
    int* s_item = (int*)(smem + LDS_BYTES - 16);
    const float* cumF = (const float*)(ws + OFF_CUMF);
    bf16* Y = (bf16*)(ws + (fake ? OFF_PART : OFF_Y));
    float* ssy = fake ? (float*)(ws + OFF_PART + 40 * MBy) : (float*)(ws + OFF_SSY) + (size_t)L * TOK * 16;
    const int half = opaque_tid() >> 8;
    char* lds = smem + half * 65536;
    for (;;) {
        if (opaque_tid() == 0) *s_item = atomicAdd(cnt, 1);
        __syncthreads();
        int pair = *s_item;
        __syncthreads();
        if (pair >= 768) break;
        int item = pair * 2 + half;
        int qb = 15 - item / 96;
        int rem = item % 96;
        int type = rem >> 5, bh = rem & 31;
        int b = bh >> 2, h = bh & 3;
        if (type == 0) {
            attn_item<2, 96, 128>((const bf16*)(ws + OFF_MQ), 384, (const bf16*)(ws + OFF_MK), 384, (const bf16*)(ws + OFF_MVT), cumF,
                                  Y + 512, ssy + 8, b, h, qb, 0.10206207261596577f * LOG2E, lds, fake);
        } else if (type == 1) {
            attn_item<1, 64, 64>((const bf16*)(ws + OFF_SQ), 256, (const bf16*)(ws + OFF_SKK), 256, (const bf16*)(ws + OFF_SVT), cumF,
                                 Y + 256, ssy + 4, b, h, qb, 0.125f * LOG2E, lds, fake);
        } else {
            attn_item<0, 64, 64>((const bf16*)(ws + OFF_FQ), 256, (const bf16*)(ws + OFF_FK), 256, (const bf16*)(ws + OFF_FVT), cumF,
                                 Y + 0, ssy + 0, b, h, qb, 0.125f * LOG2E, lds, fake);
        }
    }
}

__device__ __forceinline__ void rowss_flush(float (&part)[2][16], float* gss, int m0, int nt) {
    float* lss = (float*)smem;
    const int tid = opaque_tid(), w = tid >> 6, l = tid & 63, hh = l >> 5, wm = w >> 1, wn = w & 1;
#pragma unroll
    for (int i = 0; i < 2; ++i)
#pragma unroll
        for (int rr = 0; rr < 16; ++rr) {
            float v = part[i][rr];
            v = dpp_add<0xB1>(v); v = dpp_add<0x4E>(v); v = dpp_add<0x141>(v); v = dpp_add<0x140>(v);
            v += __shfl_xor(v, 16);
            if ((l & 31) == 0) lss[wn * 256 + wm * 64 + i * 32 + (rr & 3) + 8 * (rr >> 2) + 4 * hh] = v;
        }
    __syncthreads();
    if (tid < 256) gss[(size_t)(m0 + tid) * 8 + nt] = lss[tid] + lss[256 + tid];
    __syncthreads();
}

struct WoHook {
    static constexpr bool nodma = false;
    __device__ __forceinline__ void operator()(int kt, f32x16 (&acc)[2][2]) const {
        if (kt == 4 || kt == 8) {
            const float* fac = (const float*)(smem + LDS_AUX) + (kt == 4 ? 0 : 256);
            const int tid = opaque_tid(), w = tid >> 6, l = tid & 63, hh = l >> 5, wm = w >> 1;
#pragma unroll
            for (int i = 0; i < 2; ++i)
#pragma unroll
                for (int rr = 0; rr < 16; ++rr) {
                    float f = fac[wm * 64 + i * 32 + (rr & 3) + 8 * (rr >> 2) + 4 * hh];
                    acc[i][0][rr] *= f; acc[i][1][rr] *= f;
                }
        }
    }
};

__device__ __forceinline__ void phase_wo(const Params& P, int L, int hsel, float* ss_out) {
    char* ws = opq(P.ws);
    bf16* hb_out = (bf16*)(ws + (hsel ? OFF_HB1 : OFF_HB0));
    const float* hin = (L == 0) ? opq(P.x) : (const float*)opq(P.out);
    float* hout = opq(P.out);
    const bf16* Y = (const bf16*)(ws + OFF_Y);
    const bf16* Bt = (const bf16*)(ws + OFF_WO) + (size_t)L * 1024 * LDH;
    const float* ssy = (const float*)(ws + OFF_SSY) + (size_t)L * TOK * 16;
    float* aux = (float*)(smem + LDS_AUX);
    const int tid = opaque_tid(), w = tid >> 6, l = tid & 63, hh = l >> 5, wm = w >> 1, wn = w & 1;
    for (int it = 0;; ++it) {
        int mt, nt;
        if (!xcd_tile(it, 64, 8, mt, nt)) break;
        int m0 = mt * 256, n0 = nt * 128;
        __syncthreads();
        if (tid < 256) {
            int row = m0 + tid;
            float4 v0 = *(const float4*)(ssy + (size_t)row * 16), v1 = *(const float4*)(ssy + (size_t)row * 16 + 4), v2 = *(const float4*)(ssy + (size_t)row * 16 + 8);
            float r0 = rsqrtf(((v0.x + v0.y) + (v0.z + v0.w)) * (1.f / 256.f) + EPSF);
            float r1 = rsqrtf(((v1.x + v1.y) + (v1.z + v1.w)) * (1.f / 256.f) + EPSF);
            float r2 = rsqrtf(((v2.x + v2.y) + (v2.z + v2.w)) * (1.f / 512.f) + EPSF);
            aux[tid] = r0 / r1; aux[256 + tid] = r1 / r2; aux[512 + tid] = r2;
        }
        f32x16 acc[2][2];
        ZERO_ACC(acc);
        gemm_core(acc, Y, LDH, Bt, LDH, 1024, m0, n0, WoHook());
        stage_f32<true>(acc, aux + 512);
        residual_store(hin, hout, hb_out, ss_out, m0, n0, nt);
    }
}

struct EpiPq {
    static constexpr bool PERM = true, AFTER_DRAIN = false;
    bf16* O; const float* ssrow;
    __device__ __forceinline__ void khook(int, f32x4 (&)[2][2][4][2], int, int) const {}
    __device__ __forceinline__ void operator()(const f32x4 (&acc)[2][2][4][2], const pg8::Unit& u, int wr, int wc, int fr, int fq) const {
        const int row0 = u.pm * 256 + wr * 64 + fr, col0 = u.pn * 256 + wc * 32 + 8 * fq;
#pragma unroll
        for (int ai = 0; ai < 2; ++ai)
#pragma unroll
            for (int m = 0; m < 4; ++m) {
                const int row = row0 + ai * 128 + m * 16;
                const float rs = row_rs8(ssrow, row);
                bf16* rowp = O + (size_t)row * 1024 + col0;
#pragma unroll
                for (int bj = 0; bj < 2; ++bj) {
                    f32x4 v0 = acc[ai][bj][m][0] * rs, v1 = acc[ai][bj][m][1] * rs;
                    u32x4 wv = {pack2(v0[0], v0[1]), pack2(v0[2], v0[3]), pack2(v1[0], v1[1]), pack2(v1[2], v1[3])};
                    *(u32x4*)(rowp + bj * 128) = wv;
                }
            }
    }
};
__device__ __forceinline__ void phase_pq(const Params& P, int L, int hsel, const float* ssrow) {
    char* ws = opq(P.ws);
    const bf16* hb = (const bf16*)(ws + (hsel ? OFF_HB1 : OFF_HB0));
    const bf16* Bt = (const bf16*)(ws + OFF_WQ) + (size_t)L * 1024 * LDH;
    pg8::Gemm g{hb, Bt, LDH, LDH, TOK, 1024, 1024};
    pg8::StaticOrder S; S.init(TOK, 1024, gridDim.x, blockIdx.x);
    EpiPq E{(bf16*)(ws + OFF_PQ), ssrow};
    pg8::gemm_phase((PG8_LAS unsigned char*)smem, g, S, E, nullptr);
    __syncthreads();
}

__device__ __forceinline__ void cswap(int& a, int& b) { int mx = max(a, b), mn = min(a, b); a = mx; b = mn; }
__device__ __forceinline__ void bitonic_sort16(int (&v)[16]) {
#pragma unroll
    for (int k = 2; k <= 16; k <<= 1)
#pragma unroll
        for (int j = k >> 1; j > 0; j >>= 1)
#pragma unroll
            for (int i = 0; i < 16; ++i) {
                int q = i ^ j;
                if (q > i) {
                    if ((i & k) == 0) cswap(v[i], v[q]); else cswap(v[q], v[i]);
                }
            }
}
__device__ __forceinline__ void merge_top16(int (&Lv)[16], const int (&Rv)[16]) {
#pragma unroll
    for (int i = 0; i < 16; ++i) Lv[i] = max(Lv[i], Rv[15 - i]);
#pragma unroll
    for (int j = 8; j > 0; j >>= 1)
#pragma unroll
        for (int i = 0; i < 16; ++i) {
            int q = i ^ j;
            if (q > i) cswap(Lv[i], Lv[q]);
        }
}
__device__ __forceinline__ int f2key(float v, int low, int mask) {
    int b = __float_as_int(v);
    b ^= (b >> 31) & 0x7fffffff;
    return (b & ~mask) | low;
}
__device__ __forceinline__ float key2f(int k, int mask) {
    int b = k & ~mask;
    b ^= (b >> 31) & 0x7fffffff;
    return __int_as_float(b);
}

__device__ __forceinline__ void phase_topk(const Params& P, int L) {
    char* ws = opq(P.ws);
    const bf16* pq = (const bf16*)(ws + OFF_PQ);
    const bf16* skb = (const bf16*)(ws + OFF_SKB) + (size_t)L * 16 * 128 * 64;
    unsigned short* ids = (unsigned short*)(ws + OFF_IDS);
    float* gates = (float*)(ws + OFF_GATE);
    const int tid = opaque_tid(), w = tid >> 6, l = tid & 63, r = l & 31, hh = l >> 5;
    unsigned char* lidx = (unsigned char*)(smem + w * 1024 + r * 32);
    for (int task = blockIdx.x * NW + w; task < (TOK / 32) * 8; task += gridDim.x * NW) {
        const int t0 = (task >> 3) * 32, h = task & 7;
        int F[2][16];
#pragma unroll
        for (int p = 0; p < 2; ++p) {
            const int hp = h * 2 + p;
            f32x16 acc[4];
            const f32x16 z16 = {0.f, 0.f, 0.f, 0.f, 0.f, 0.f, 0.f, 0.f, 0.f, 0.f, 0.f, 0.f, 0.f, 0.f, 0.f, 0.f};
#pragma unroll
            for (int kt = 0; kt < 4; ++kt) acc[kt] = z16;
#pragma unroll
            for (int s4 = 0; s4 < 4; ++s4) {
                bf16x8 bfr = *(const bf16x8*)(pq + (size_t)(t0 + r) * 1024 + hp * 64 + 16 * s4 + 8 * hh);
#pragma unroll
                for (int kt = 0; kt < 4; ++kt) {
                    bf16x8 af = *(const bf16x8*)(skb + ((size_t)hp * 128 + 32 * kt + r) * 64 + 16 * s4 + 8 * hh);
                    acc[kt] = __builtin_amdgcn_mfma_f32_32x32x16_bf16(af, bfr, acc[kt], 0, 0, 0);
                }
            }
            int K0[16], K1[16], K2[16], K3[16];
#pragma unroll
            for (int rr = 0; rr < 16; ++rr) {
                const int nb = (rr & 3) + 8 * (rr >> 2) + 4 * hh;
                K0[rr] = f2key(acc[0][rr], 127 - nb, 127);
                K1[rr] = f2key(acc[1][rr], 127 - (32 + nb), 127);
                K2[rr] = f2key(acc[2][rr], 127 - (64 + nb), 127);
                K3[rr] = f2key(acc[3][rr], 127 - (96 + nb), 127);
            }
            bitonic_sort16(K0); bitonic_sort16(K1); bitonic_sort16(K2); bitonic_sort16(K3);
            merge_top16(K0, K1);
            merge_top16(K2, K3);
            merge_top16(K0, K2);
#pragma unroll
            for (int i = 0; i < 16; ++i) K1[i] = partner32(K0[i], hh);
            merge_top16(K0, K1);
#pragma unroll
            for (int i = 0; i < 16; ++i) F[p][i] = K0[i];
        }
        if (hh == 0) {
#pragma unroll
            for (int q = 0; q < 4; ++q) {
                unsigned w1 = 0, w2 = 0;
#pragma unroll
                for (int e = 0; e < 4; ++e) {
                    w1 |= (unsigned)(127 - (F[0][4 * q + e] & 127)) << (8 * e);
                    w2 |= (unsigned)(127 - (F[1][4 * q + e] & 127)) << (8 * e);
                }
                ((unsigned*)lidx)[q] = w1;
                ((unsigned*)lidx)[4 + q] = w2;
            }
        }
        {
            float s1[16], s2[16];
#pragma unroll
            for (int i = 0; i < 16; ++i) { s1[i] = key2f(F[0][i], 127); s2[i] = key2f(F[1][i], 127); }
            int Lc[16], X[16];
#pragma unroll
            for (int b2 = 0; b2 < 16; ++b2) Lc[b2] = f2key(s1[0] + s2[b2], 255 - b2, 255);
#pragma unroll
            for (int a2 = 1; a2 < 16; ++a2) X[a2 - 1] = f2key(s1[a2] + s2[0], 255 - a2 * 16, 255);
            X[15] = INT_MIN;
            merge_top16(Lc, X);
            X[0] = f2key(s1[1] + s2[1], 255 - 17, 255); X[1] = f2key(s1[1] + s2[2], 255 - 18, 255); X[2] = f2key(s1[1] + s2[3], 255 - 19, 255);
            X[3] = f2key(s1[1] + s2[4], 255 - 20, 255); X[4] = f2key(s1[1] + s2[5], 255 - 21, 255); X[5] = f2key(s1[1] + s2[6], 255 - 22, 255);
            X[6] = f2key(s1[1] + s2[7], 255 - 23, 255);
            X[7] = f2key(s1[2] + s2[1], 255 - 33, 255); X[8] = f2key(s1[2] + s2[2], 255 - 34, 255); X[9] = f2key(s1[2] + s2[3], 255 - 35, 255);
            X[10] = f2key(s1[2] + s2[4], 255 - 36, 255);
            X[11] = f2key(s1[3] + s2[1], 255 - 49, 255); X[12] = f2key(s1[3] + s2[2], 255 - 50, 255); X[13] = f2key(s1[3] + s2[3], 255 - 51, 255);
            X[14] = f2key(s1[4] + s2[1], 255 - 65, 255); X[15] = f2key(s1[4] + s2[2], 255 - 66, 255);
            bitonic_sort16(X);
            merge_top16(Lc, X);
            X[0] = f2key(s1[5] + s2[1], 255 - 81, 255);
            X[1] = f2key(s1[6] + s2[1], 255 - 97, 255);
            X[2] = f2key(s1[7] + s2[1], 255 - 113, 255);
#pragma unroll
            for (int i = 3; i < 16; ++i) X[i] = INT_MIN;
            merge_top16(Lc, X);
            if (hh == 0) {
                float mx = key2f(Lc[0], 255);
                float ev[16], sum = 0.f;
#pragma unroll
                for (int k = 0; k < 16; ++k) { ev[k] = __expf(key2f(Lc[k], 255) - mx); sum += ev[k]; }
                float inv = 1.f / sum;
                size_t ob = (size_t)(t0 + r) * 128 + h * 16;
                unsigned idw[8];
#pragma unroll
                for (int k = 0; k < 16; ++k) {
                    int cidx = 255 - (Lc[k] & 255);
                    int i1 = lidx[cidx >> 4], i2 = lidx[16 + (cidx & 15)];
                    unsigned idv = (unsigned)(i1 * 128 + i2);
                    if (k & 1) idw[k >> 1] |= idv << 16; else idw[k >> 1] = idv;
                }
                u32x4 o0 = {idw[0], idw[1], idw[2], idw[3]}, o1 = {idw[4], idw[5], idw[6], idw[7]};
                *(u32x4*)(ids + ob) = o0;
                *(u32x4*)(ids + ob + 8) = o1;
#pragma unroll
                for (int q = 0; q < 4; ++q) {
                    f32x4 g4 = {ev[4 * q] * inv, ev[4 * q + 1] * inv, ev[4 * q + 2] * inv, ev[4 * q + 3] * inv};
                    *(f32x4*)(gates + ob + 4 * q) = g4;
                }
            }
        }
    }
}

__device__ __forceinline__ float gelu_exact(float x) { return 0.5f * x * (1.f + erff(x * 0.70710678118654752f)); }

__device__ __forceinline__ void dec16(const u32x4& v, float (&f)[16]) {
    f32x2 t;
    t = __builtin_amdgcn_cvt_pk_f32_fp8((int)v.x, false); f[0] = t.x; f[1] = t.y;
    t = __builtin_amdgcn_cvt_pk_f32_fp8((int)v.x, true);  f[2] = t.x; f[3] = t.y;
    t = __builtin_amdgcn_cvt_pk_f32_fp8((int)v.y, false); f[4] = t.x; f[5] = t.y;
    t = __builtin_amdgcn_cvt_pk_f32_fp8((int)v.y, true);  f[6] = t.x; f[7] = t.y;
    t = __builtin_amdgcn_cvt_pk_f32_fp8((int)v.z, false); f[8] = t.x; f[9] = t.y;
    t = __builtin_amdgcn_cvt_pk_f32_fp8((int)v.z, true);  f[10] = t.x; f[11] = t.y;
    t = __builtin_amdgcn_cvt_pk_f32_fp8((int)v.w, false); f[12] = t.x; f[13] = t.y;
    t = __builtin_amdgcn_cvt_pk_f32_fp8((int)v.w, true);  f[14] = t.x; f[15] = t.y;
}

__device__ __forceinline__ void dec32(const u32x4& v, f32x2 (&f)[16]) {
    f[0] = __builtin_amdgcn_cvt_scalef32_pk_f32_fp4(v.x, 1.0f, 0); f[1] = __builtin_amdgcn_cvt_scalef32_pk_f32_fp4(v.x, 1.0f, 1);
    f[2] = __builtin_amdgcn_cvt_scalef32_pk_f32_fp4(v.x, 1.0f, 2); f[3] = __builtin_amdgcn_cvt_scalef32_pk_f32_fp4(v.x, 1.0f, 3);
    f[4] = __builtin_amdgcn_cvt_scalef32_pk_f32_fp4(v.y, 1.0f, 0); f[5] = __builtin_amdgcn_cvt_scalef32_pk_f32_fp4(v.y, 1.0f, 1);
    f[6] = __builtin_amdgcn_cvt_scalef32_pk_f32_fp4(v.y, 1.0f, 2); f[7] = __builtin_amdgcn_cvt_scalef32_pk_f32_fp4(v.y, 1.0f, 3);
    f[8] = __builtin_amdgcn_cvt_scalef32_pk_f32_fp4(v.z, 1.0f, 0); f[9] = __builtin_amdgcn_cvt_scalef32_pk_f32_fp4(v.z, 1.0f, 1);
    f[10] = __builtin_amdgcn_cvt_scalef32_pk_f32_fp4(v.z, 1.0f, 2); f[11] = __builtin_amdgcn_cvt_scalef32_pk_f32_fp4(v.z, 1.0f, 3);
    f[12] = __builtin_amdgcn_cvt_scalef32_pk_f32_fp4(v.w, 1.0f, 0); f[13] = __builtin_amdgcn_cvt_scalef32_pk_f32_fp4(v.w, 1.0f, 1);
    f[14] = __builtin_amdgcn_cvt_scalef32_pk_f32_fp4(v.w, 1.0f, 2); f[15] = __builtin_amdgcn_cvt_scalef32_pk_f32_fp4(v.w, 1.0f, 3);
}

typedef _Float16 f16x2 __attribute__((ext_vector_type(2)));
__device__ __forceinline__ void dec8_f16(unsigned x, f16x2 (&wv)[4]) {
    const unsigned lo = x & 0x07070707u, hi = (x >> 4) & 0x07070707u;
    const unsigned Lb = __builtin_amdgcn_perm(0x46444240u, 0x3E3C3800u, lo) | ((x & 0x08080808u) << 4);
    const unsigned Hb = __builtin_amdgcn_perm(0x46444240u, 0x3E3C3800u, hi) | (x & 0x80808080u);
    wv[0] = __builtin_bit_cast(f16x2, __builtin_amdgcn_perm(Hb, Lb, 0x040c000cu));
    wv[1] = __builtin_bit_cast(f16x2, __builtin_amdgcn_perm(Hb, Lb, 0x050c010cu));
    wv[2] = __builtin_bit_cast(f16x2, __builtin_amdgcn_perm(Hb, Lb, 0x060c020cu));
    wv[3] = __builtin_bit_cast(f16x2, __builtin_amdgcn_perm(Hb, Lb, 0x070c030cu));
}

__device__ __forceinline__ int idof16(const u32x4 (&q)[2], int i) {
    unsigned wv = (i >> 1) == 0 ? q[0].x : (i >> 1) == 1 ? q[0].y : (i >> 1) == 2 ? q[0].z : (i >> 1) == 3 ? q[0].w
                : (i >> 1) == 4 ? q[1].x : (i >> 1) == 5 ? q[1].y : (i >> 1) == 6 ? q[1].z : q[1].w;
    return (i & 1) ? (int)(wv >> 16) : (int)(wv & 0xffffu);
}
__device__ __forceinline__ void phase_gather_u(const Params& P, int L) {
    char* ws = opq(P.ws);
    const unsigned char* U4 = (const unsigned char*)(ws + OFF_UB) + (size_t)L * NEXP * 512;
    float* part = (float*)(ws + OFF_PART);
    const unsigned short* ids = (const unsigned short*)(ws + OFF_IDS);
    const float* hin = opq(P.out);
    const int tid = opaque_tid(), w = tid >> 6, l = tid & 63, c = l & 7, gq = l >> 3;
    const int sl = blockIdx.x & 3, par = (blockIdx.x >> 2) & 1, rk = blockIdx.x >> 3, nb = gridDim.x >> 3;
    if (rk >= nb) return;
    const unsigned char* ubase = U4 + (size_t)sl * NEXP * 128 + c * 16;
    const int stride = nb * NW;
    int ti = rk * NW + w;
    if (ti >= TOK / 2) return;
    u32x4 idA[2], idB[2];
    u32x4 rv[16];
    f32x4 hA[8], hB[8];
    auto load_ids = [&](int tt, u32x4 (&idq)[2]) {
        const u32x4* i4 = (const u32x4*)(ids + (size_t)tt * 128 + 16 * gq);
        idq[0] = i4[0]; idq[1] = i4[1];
    };
    auto load_hx = [&](int tt, f32x4 (&hx)[8]) {
        const f32x4* h4 = (const f32x4*)(hin + (size_t)tt * 1024 + 256 * sl + 32 * c);
#pragma unroll
        for (int q = 0; q < 8; ++q) hx[q] = h4[q];
    };
    auto step = [&](int tcur, int tnext, int tnext2, const u32x4 (&idn)[2], u32x4 (&idl)[2], const f32x4 (&hc)[8], f32x4 (&hn)[8]) {
        load_ids(tnext2, idl);
        load_hx(tnext, hn);
        __builtin_amdgcn_sched_barrier(0);
        float pr[16];
#pragma unroll
        for (int i = 0; i < 16; ++i) {
            f32x2 f[16];
            asm volatile("" : "+v"(rv[i].x), "+v"(rv[i].y), "+v"(rv[i].z), "+v"(rv[i].w));
            dec32(rv[i], f);
            rv[i] = *(const u32x4*)(ubase + (size_t)idof16(idn, i) * 128);
            __builtin_amdgcn_sched_barrier(0);
            f32x2 s2 = {0.f, 0.f};
#pragma unroll
            for (int q = 0; q < 8; ++q) {
                f32x2 x0 = {hc[q].x, hc[q].y}, x1 = {hc[q].z, hc[q].w};
                s2 = __builtin_elementwise_fma(f[2 * q], x0, s2);
                s2 = __builtin_elementwise_fma(f[2 * q + 1], x1, s2);
            }
            float sacc = s2.x + s2.y;
            asm volatile("" : "+v"(sacc));
            pr[i] = sacc;
        }
#pragma unroll
        for (int i = 0; i < 16; ++i) pr[i] = sum8_dpp(pr[i]);
        if (c == 0) {
            f32x4* o4 = (f32x4*)(part + ((size_t)sl * TOK + tcur) * 128 + 16 * gq);
#pragma unroll
            for (int q = 0; q < 4; ++q) { f32x4 o = {pr[4 * q], pr[4 * q + 1], pr[4 * q + 2], pr[4 * q + 3]}; o4[q] = o; }
        }
    };
    auto tok = [&](int tidx, int fb) { return 2 * (tidx < TOK / 2 ? tidx : fb) + par; };
    load_ids(tok(ti, ti), idA);
#pragma unroll
    for (int i = 0; i < 16; ++i) rv[i] = *(const u32x4*)(ubase + (size_t)idof16(idA, i) * 128);
    load_hx(tok(ti, ti), hA);
    load_ids(tok(ti + stride, ti), idB);
    for (;;) {
        int tn = ti + stride, tn2 = ti + 2 * stride;
        step(tok(ti, ti), tok(tn, ti), tok(tn2, ti), idB, idA, hA, hB);
        if (tn >= TOK / 2) break;
        ti = tn; tn = ti + stride; tn2 = ti + 2 * stride;
        step(tok(ti, ti), tok(tn, ti), tok(tn2, ti), idA, idB, hB, hA);
        if (tn >= TOK / 2) break;
        ti = tn;
    }
}

__device__ __forceinline__ void phase_gather_act(const Params& P, int L, const float* ss_ffn) {
    char* ws = opq(P.ws);
    const float* part = (const float*)(ws + OFF_PART);
    const unsigned short* ids = (const unsigned short*)(ws + OFF_IDS);
    float* gates = (float*)(ws + OFF_GATE);
    const float* uinv = (const float*)(ws + OFF_TSC) + L * NEXP;
    const float* vinv = (const float*)(ws + OFF_TSC) + (2 + L) * NEXP;
    const int tid = opaque_tid(), w = tid >> 6, l = tid & 63;
    for (int t = blockIdx.x * NW + w; t < TOK; t += gridDim.x * NW) {
        float rs = row_rs8(ss_ffn, t);
#pragma unroll
        for (int hsel = 0; hsel < 2; ++hsel) {
            int k = l + 64 * hsel;
            float sacc = 0.f;
#pragma unroll
            for (int j = 0; j < 4; ++j) sacc += part[((size_t)j * TOK + t) * 128 + k];
            int id = ids[(size_t)t * 128 + k];
            float pre = sacc * rs * uinv[id];
            gates[(size_t)t * 128 + k] = gates[(size_t)t * 128 + k] * gelu_exact(pre) * vinv[id];
        }
    }
}

__device__ __forceinline__ void phase_gather_v(const Params& P, int L, int hsel, float* ss_ple) {
    char* ws = opq(P.ws);
    bf16* hb_out = (bf16*)(ws + (hsel ? OFF_HB1 : OFF_HB0));
    const unsigned char* V4 = (const unsigned char*)(ws + OFF_VB) + (size_t)L * NEXP * 512;
    const unsigned short* ids = (const unsigned short*)(ws + OFF_IDS);
    const float* act = (const float*)(ws + OFF_GATE);
    float* hio = opq(P.out);
    const int tid = opaque_tid(), w = tid >> 6, l = tid & 63, c = l & 7, gq = l >> 3;
    const int sl = blockIdx.x & 3, par = (blockIdx.x >> 2) & 1, rk = blockIdx.x >> 3, nb = gridDim.x >> 3;
    if (rk >= nb) return;
    const unsigned char* vbase = V4 + (size_t)sl * NEXP * 128 + c * 16;
    const int stride = nb * NW;
    int ti = rk * NW + w;
    if (ti >= TOK / 2) return;
    const bool b3 = (l >> 3) & 1;
    u32x4 idA[2], idB[2];
    u32x4 rv[16];
    f32x4 aA[4], aB[4];
    auto load_ids = [&](int tt, u32x4 (&idq)[2]) {
        const u32x4* i4 = (const u32x4*)(ids + (size_t)tt * 128 + 16 * gq);
        idq[0] = i4[0]; idq[1] = i4[1];
    };
    auto load_a = [&](int tt, f32x4 (&ax)[4]) {
        const f32x4* a4 = (const f32x4*)(act + (size_t)tt * 128 + 16 * gq);
#pragma unroll
        for (int q = 0; q < 4; ++q) ax[q] = a4[q];
    };
    auto step = [&](int tcur, int tnext, int tnext2, const u32x4 (&idn)[2], u32x4 (&idl)[2], const f32x4 (&ac)[4], f32x4 (&an)[4]) {
        load_ids(tnext2, idl);
        load_a(tnext, an);
        __builtin_amdgcn_sched_barrier(0);
        f32x2 acc[16];
#pragma unroll
        for (int e = 0; e < 16; ++e) { acc[e].x = 0.f; acc[e].y = 0.f; }
#pragma unroll
        for (int i = 0; i < 16; ++i) {
            f32x2 f[16];
            asm volatile("" : "+v"(rv[i].x), "+v"(rv[i].y), "+v"(rv[i].z), "+v"(rv[i].w));
            dec32(rv[i], f);
            rv[i] = *(const u32x4*)(vbase + (size_t)idof16(idn, i) * 128);
            __builtin_amdgcn_sched_barrier(0);
            const float a = (i & 3) == 0 ? ac[i >> 2].x : (i & 3) == 1 ? ac[i >> 2].y : (i & 3) == 2 ? ac[i >> 2].z : ac[i >> 2].w;
            const f32x2 a2 = {a, a};
#pragma unroll
            for (int e = 0; e < 16; ++e) acc[e] = __builtin_elementwise_fma(f[e], a2, acc[e]);
#pragma unroll
            for (int e = 0; e < 16; ++e) asm volatile("" : "+v"(acc[e]));
        }
        float v8[8][2];
#pragma unroll
        for (int e = 0; e < 8; ++e) {
            float k0 = b3 ? acc[8 + e].x : acc[e].x, k1 = b3 ? acc[8 + e].y : acc[e].y;
            float s0 = b3 ? acc[e].x : acc[8 + e].x, s1 = b3 ? acc[e].y : acc[8 + e].y;
            v8[e][0] = k0 + __builtin_bit_cast(float, __builtin_amdgcn_update_dpp(0, __builtin_bit_cast(int, s0), 0x128, 0xf, 0xf, true));
            v8[e][1] = k1 + __builtin_bit_cast(float, __builtin_amdgcn_update_dpp(0, __builtin_bit_cast(int, s1), 0x128, 0xf, 0xf, true));
        }
        float v4[8];
#pragma unroll
        for (int e = 0; e < 8; ++e) {
            float X = v8[e >> 1][e & 1], Y = v8[4 + (e >> 1)][e & 1];
            asm volatile("s_nop 1\n\tv_permlane16_swap_b32 %0, %1\n\ts_nop 1" : "+v"(X), "+v"(Y));
            v4[e] = X + Y;
        }
        float v2[4];
#pragma unroll
        for (int e = 0; e < 4; ++e) {
            float X = v4[e], Y = v4[4 + e];
            asm volatile("s_nop 1\n\tv_permlane32_swap_b32 %0, %1\n\ts_nop 1" : "+v"(X), "+v"(Y));
            v2[e] = X + Y;
        }
        const int col = 256 * sl + 32 * c + 16 * ((l >> 3) & 1) + 8 * ((l >> 4) & 1) + 4 * (l >> 5);
        f32x4* h4 = (f32x4*)(hio + (size_t)tcur * 1024 + col);
        f32x4 hv = *h4;
        hv.x += v2[0]; hv.y += v2[1]; hv.z += v2[2]; hv.w += v2[3];
        *h4 = hv;
        u32x2 bb = {pack2(hv.x, hv.y), pack2(hv.z, hv.w)};
        *(u32x2*)(hb_out + (size_t)tcur * LDH + col) = bb;
        float ssq = hv.x * hv.x + hv.y * hv.y + hv.z * hv.z + hv.w * hv.w;
        ssq = wave_sum(ssq);
        if (l == 0) { ss_ple[(size_t)tcur * 8 + sl] = ssq; ss_ple[(size_t)tcur * 8 + 4 + sl] = 0.f; }
    };
    auto tok = [&](int tidx, int fb) { return 2 * (tidx < TOK / 2 ? tidx : fb) + par; };
    load_ids(tok(ti, ti), idA);
#pragma unroll
    for (int i = 0; i < 16; ++i) rv[i] = *(const u32x4*)(vbase + (size_t)idof16(idA, i) * 128);
    load_a(tok(ti, ti), aA);
    load_ids(tok(ti + stride, ti), idB);
    for (;;) {
        int tn = ti + stride, tn2 = ti + 2 * stride;
        step(tok(ti, ti), tok(tn, ti), tok(tn2, ti), idB, idA, aA, aB);
        if (tn >= TOK / 2) break;
        ti = tn; tn = ti + stride; tn2 = ti + 2 * stride;
        step(tok(ti, ti), tok(tn, ti), tok(tn2, ti), idA, idB, aB, aA);
        if (tn >= TOK / 2) break;
        ti = tn;
    }
}

__device__ __forceinline__ void phase_ple(const Params& P, int L, int hsel, const float* ss_ple, float* ss_out) {
    char* ws = opq(P.ws);
    const bf16* hb_in = (const bf16*)(ws + (hsel ? OFF_HB1 : OFF_HB0));
    bf16* hb_out = (bf16*)(ws + (hsel ? OFF_HB0 : OFF_HB1));
    float* hio = opq(P.out);
    const bf16* pin = (const bf16*)(ws + OFF_PB) + (size_t)L * TOK * LDP;
    const bf16* Wg = (const bf16*)(ws + OFF_WG) + (size_t)L * 1024 * LDH;
    const bf16* Wp = (const bf16*)(ws + OFF_WP) + (size_t)L * 1024 * LDP;
    const int tid = opaque_tid(), w = tid >> 6, l = tid & 63, hh = l >> 5, wm = w >> 1, wn = w & 1;
    for (int it = 0;; ++it) {
        int mt, nt;
        if (!xcd_tile(it, 64, 8, mt, nt)) break;
        int m0 = mt * 256, n0 = nt * 128;
        float* aux = (float*)(smem + LDS_AUX);
        __syncthreads();
        if (tid < 256) aux[tid] = row_rs8(ss_ple, m0 + tid);
        f32x16 acc1[2][2], acc2[2][2];
        ZERO_ACC(acc1);
        ZERO_ACC(acc2);
        gemm_core(acc1, hb_in, LDH, Wg, LDH, 1024, m0, n0, NoHook());
        gemm_core(acc2, pin, LDP, Wp, LDP, 256, m0, n0, NoHook());
#pragma unroll
        for (int i = 0; i < 2; ++i)
#pragma unroll
            for (int rr = 0; rr < 16; ++rr) {
                float rs = aux[wm * 64 + i * 32 + (rr & 3) + 8 * (rr >> 2) + 4 * hh];
#pragma unroll
                for (int j = 0; j < 2; ++j) {
                    float gte = 1.f / (1.f + __expf(-acc1[i][j][rr] * rs));
                    acc2[i][j][rr] *= gte;
                }
            }
        stage_f32<false>(acc2, nullptr);
        residual_store(hio, hio, hb_out, ss_out, m0, n0, nt);
    }
}

__device__ __forceinline__ void phase_final(const Params& P, const float* ss) {
    float* hio = opq(P.out);
    const int tid = opaque_tid(), w = tid >> 6, l = tid & 63;
    const float4* g4 = (const float4*)P.final_norm_g;
    for (int t = blockIdx.x * NW + w; t < TOK; t += gridDim.x * NW) {
        float rs = row_rs8(ss, t);
        float4* o4 = (float4*)(hio + (size_t)t * 1024);
#pragma unroll
        for (int i = 0; i < 4; ++i) {
            float4 v = o4[i * 64 + l], g = g4[i * 64 + l];
            v.x *= rs * g.x; v.y *= rs * g.y; v.z *= rs * g.z; v.w *= rs * g.w;
            o4[i * 64 + l] = v;
        }
    }
}

#define XB_TMO      128
#define XB_XCNT(j)  (256  + 64 * (j))
#define XB_XSUB(j)  (1280 + 64 * (j))
#define XB_XGEN(j)  (2304 + 64 * (j))
#define XB_TOP      3328
#define XB_TOPGEN   3392
#define XCD_BAR_WORDS 3456
#define XB_SPIN_CAP (1u << 22)
__device__ __forceinline__ unsigned xb_ld(unsigned* p) { return __hip_atomic_load(p, __ATOMIC_RELAXED, __HIP_MEMORY_SCOPE_AGENT); }
__device__ __forceinline__ unsigned xb_add(unsigned* p, unsigned v) { return __hip_atomic_fetch_add(p, v, __ATOMIC_RELAXED, __HIP_MEMORY_SCOPE_AGENT); }
__device__ __forceinline__ unsigned xb_xcc_id() { return (unsigned)__builtin_amdgcn_s_getreg((3 << 11) | 20) & 0xFu; }
#define XB_SPIN(cond, bar) do { unsigned _sp = 0; while (cond) { __builtin_amdgcn_s_sleep(1); \
    if ((++_sp & 255u) == 0u) { if (xb_ld(&(bar)[XB_TMO])) break; if (_sp > XB_SPIN_CAP) { atomicAdd(&(bar)[XB_TMO], 1u); break; } } } } while (0)
#define XB_LDS_OFF (LDS_BYTES - 64)
__device__ __forceinline__ void xcd_barrier_post(const Params& P) {
    if (threadIdx.x == 0) {
        unsigned* bar = (unsigned*)(P.ws + OFF_BAR);
        volatile unsigned* st = (volatile unsigned*)(smem + XB_LDS_OFF);
        st[0] = 0u; st[1] = 0u;
        (void)xb_add(&bar[XB_XCNT(xb_xcc_id())], 1u);
    }
}
__device__ __forceinline__ void xcd_barrier_complete(unsigned* bar, unsigned x, unsigned& nloc, unsigned& nx) {
    const unsigned G = gridDim.x;
    unsigned sum, cnt, mine, sp = 0u;
    for (;;) {
        sum = 0u; cnt = 0u; mine = 0u;
#pragma unroll
        for (unsigned j = 0; j < 16; ++j) { const unsigned c = xb_ld(&bar[XB_XCNT(j)]); sum += c; cnt += (c > 0u) ? 1u : 0u; mine = (j == x) ? c : mine; }
        if (sum == G) break;
        __builtin_amdgcn_s_sleep(1);
        if ((++sp & 255u) == 0u) { if (xb_ld(&bar[XB_TMO])) break; if (sp > XB_SPIN_CAP) { atomicAdd(&bar[XB_TMO], 1u); break; } }
    }
    nloc = mine > 0u ? mine : 1u; nx = cnt > 0u ? cnt : 1u;
}
__device__ __forceinline__ void grid_barrier(const Params& P) {
    asm volatile("s_waitcnt vmcnt(0)" ::: "memory");
    __syncthreads();
    if (threadIdx.x == 0) {
        unsigned* bar = (unsigned*)(opq(P.ws) + OFF_BAR);
        volatile unsigned* st = (volatile unsigned*)(smem + XB_LDS_OFF);
        const unsigned x = xb_xcc_id();
        __builtin_amdgcn_s_waitcnt(0);
        unsigned nloc = st[0], nx = st[1];
        if (nloc == 0u) { xcd_barrier_complete(bar, x, nloc, nx); st[0] = nloc; st[1] = nx; }
        const unsigned old = xb_add(&bar[XB_XSUB(x)], 1u);
        const unsigned gen = old / nloc;
        if (old + 1u == (gen + 1u) * nloc) {
            __builtin_amdgcn_fence(__ATOMIC_RELEASE, "agent");
            asm volatile("s_waitcnt vmcnt(0)" ::: "memory");
            const unsigned og = xb_add(&bar[XB_TOP], 1u);
            const unsigned tg = og / nx;
            if (og + 1u == (tg + 1u) * nx) xb_add(&bar[XB_TOPGEN], 1u);
            else XB_SPIN(xb_ld(&bar[XB_TOPGEN]) == tg, bar);
            __builtin_amdgcn_fence(__ATOMIC_ACQUIRE, "agent");
            xb_add(&bar[XB_XGEN(x)], 1u);
            asm volatile("s_waitcnt vmcnt(0)" ::: "memory");
        } else {
            XB_SPIN(xb_ld(&bar[XB_XGEN(x)]) == gen, bar);
            __builtin_amdgcn_fence(__ATOMIC_ACQUIRE, "agent");
            asm volatile("s_waitcnt vmcnt(0)" ::: "memory");
        }
    }
    __syncthreads();
}

__global__ void __launch_bounds__(NTHR, 2) hymba_megakernel(Params P) {
    cg::grid_group grid = cg::this_grid();
    char* ws = opq(P.ws);
    float* ssa = (float*)(ws + OFF_SSA);
    xcd_barrier_post(P);
#define BAR() do { grid_barrier(P); if (DUP == 20) grid_barrier(P); } while (0)
    phase0(P);
    if (DUP == 0) { asm volatile("s_waitcnt vmcnt(0)" ::: "memory"); __syncthreads(); grid_barrier(P); phase0(P); }
    asm volatile("s_waitcnt vmcnt(0)" ::: "memory");
    __syncthreads();
    grid.sync();
    BAR();
    int cur = 0;
    for (int L = 0; L < 2; ++L) {
        const float* ss_mix = (L == 0) ? ssa : (ssa + 3 * TOK * 8);
        float* ss_ffn = ssa + (size_t)(1 + L) * TOK * 8;
        float* ss_next = (L == 0) ? (ssa + 3 * TOK * 8) : (ssa + 4 * TOK * 8);
        float* ss_ple = ssa + (size_t)(5 + L) * TOK * 8;
        phase_proj(P, L, cur, ss_mix);
        BAR();
        if (DUP == 1) { phase_proj(P, L, cur, ss_mix); BAR(); }
        phase_mla_up(P, L);
        BAR();
        if (DUP == 2) { phase_mla_up(P, L); BAR(); }
        phase_attn(P, L, 0);
        BAR();
        if (DUP == 3) { phase_attn(P, L, 1); BAR(); }
        if (DUP >= 30 && DUP < 34) { phase_attn(P, L, 1, DUP - 30); BAR(); }
        phase_wo(P, L, cur ^ 1, ss_ffn);
        BAR();
        if (DUP == 4 && L == 0) { phase_wo(P, L, cur ^ 1, ss_ffn); BAR(); }
        phase_pq(P, L, cur ^ 1, ss_ffn);
        BAR();
        if (DUP == 5) { phase_pq(P, L, cur ^ 1, ss_ffn); BAR(); }
        phase_topk(P, L);
        BAR();
        if (DUP == 6) { phase_topk(P, L); BAR(); }
        phase_gather_u(P, L);
        BAR();
        if (DUP == 7) { phase_gather_u(P, L); BAR(); }
        phase_gather_act(P, L, ss_ffn);
        BAR();
        phase_gather_v(P, L, cur, ss_ple);
        BAR();
        phase_ple(P, L, cur, ss_ple, ss_next);
        BAR();
        cur ^= 1;
    }
    phase_final(P, ssa + 4 * TOK * 8);
}

extern "C" void kernel_launch(void* const* d_in, const int* in_sizes, int n_in, void* d_out, int out_size, void* d_ws,
                              size_t ws_size, hipStream_t stream) {
    static int grid_blocks = 0;
    if (!grid_blocks) {
        int dev = 0, cus = 0, per_cu = 0;
        hipGetDevice(&dev);
        hipDeviceGetAttribute(&cus, hipDeviceAttributeMultiprocessorCount, dev);
        hipOccupancyMaxActiveBlocksPerMultiprocessor(&per_cu, hymba_megakernel, NTHR, 0);
        if (per_cu > 1) per_cu = 1;
        if (per_cu < 1) per_cu = 1;
        grid_blocks = cus * per_cu;
        if (ws_size < WS_END) fprintf(stderr, "workspace too small: %zu < %zu\n", ws_size, (size_t)WS_END);
    }
    Params P{};
    P.x = (const float*)d_in[0]; P.p = (const float*)d_in[1]; P.pos = (const int*)d_in[2];
    P.norm_mix_g = (const float*)d_in[3]; P.w_in = (const float*)d_in[4]; P.b_forget = (const float*)d_in[5];
    P.mla_q_norm_g = (const float*)d_in[6]; P.w_uq = (const float*)d_in[7]; P.mla_kv_norm_g = (const float*)d_in[8];
    P.w_ukv = (const float*)d_in[9]; P.mix_out_norm_g = (const float*)d_in[10]; P.w_o = (const float*)d_in[11];
    P.norm_ffn_g = (const float*)d_in[12]; P.w_query = (const float*)d_in[13]; P.sub_keys = (const float*)d_in[14];
    P.peer_u = (const float*)d_in[15]; P.peer_v = (const float*)d_in[16]; P.w_ple = (const float*)d_in[17];
    P.ple_norm_g = (const float*)d_in[18]; P.w_ple_gate = (const float*)d_in[19]; P.final_norm_g = (const float*)d_in[20];
    P.out = (float*)d_out; P.ws = (char*)d_ws;
    hipMemsetAsync((char*)d_ws + OFF_BAR, 0, 16384 + 4096, stream);
    void* args[] = {&P};
    hipError_t e = hipLaunchCooperativeKernel((void*)hymba_megakernel, dim3(grid_blocks), dim3(NTHR), args, 0, stream);
    if (e != hipSuccess) fprintf(stderr, "cooperative launch failed: %s (grid %d)\n", hipGetErrorString(e), grid_blocks);
}
```

```cpp
#include <hip/hip_runtime.h>
#include <hip/hip_cooperative_groups.h>
#include <cstdio>
#include <cstdint>
#include <math.h>
#include <climits>
namespace cg = cooperative_groups;

typedef __bf16 bf16;
typedef __bf16 bf16x8 __attribute__((ext_vector_type(8)));
typedef __bf16 bf16x4 __attribute__((ext_vector_type(4)));
typedef __bf16 bf16x2 __attribute__((ext_vector_type(2)));
typedef float f32x16 __attribute__((ext_vector_type(16)));
typedef float f32x4 __attribute__((ext_vector_type(4)));
typedef float f32x2 __attribute__((ext_vector_type(2)));
typedef unsigned u32x4 __attribute__((ext_vector_type(4)));
typedef unsigned u32x2 __attribute__((ext_vector_type(2)));

#define SEQ 2048
#define BATCH 8
#define TOK 16384
#define DM 1024
#define IN_W 1956
#define NEXP 16384
#define EPSF 1e-6f
#define LOG2E 1.4426950408889634f
#define NTHR 512
#define NW 8
#define LDS_BYTES 151808
#define STAGE_BYTES 49152
#define LDS_AUX 147456
#ifndef DUP
#define DUP -1
#endif

constexpr size_t MBy = 1ull << 20;
constexpr size_t OFF_UB = 0;
constexpr size_t OFF_VB = 32 * MBy;
constexpr size_t OFF_PART = 64 * MBy;
#define LDH 1088
#define LDP 320
#define LDC 192
constexpr size_t OFF_WIN = 128 * MBy;
constexpr size_t OFF_WO = 137 * MBy;
constexpr size_t OFF_WQ = 142 * MBy;
constexpr size_t OFF_WG = 147 * MBy;
constexpr size_t OFF_WP = 152 * MBy;
constexpr size_t OFF_WUQ = 154 * MBy;
constexpr size_t OFF_WUKV = 155 * MBy;
constexpr size_t OFF_SKB = 156 * MBy;
constexpr size_t OFF_CS = 157 * MBy;
constexpr size_t OFF_TSC = 159 * MBy;
constexpr size_t OFF_SSA = 160 * MBy;
constexpr size_t OFF_HB0 = 164 * MBy;
constexpr size_t OFF_HB1 = 200 * MBy;
constexpr size_t OFF_FQ = 236 * MBy;
constexpr size_t OFF_FK = 244 * MBy;
constexpr size_t OFF_FVT = 252 * MBy;
constexpr size_t OFF_SQ = 260 * MBy;
constexpr size_t OFF_SKK = 268 * MBy;
constexpr size_t OFF_SVT = 276 * MBy;
constexpr size_t OFF_CQ = 284 * MBy;
constexpr size_t OFF_CKV = 295 * MBy;
constexpr size_t OFF_FLOG = 302 * MBy;
constexpr size_t OFF_CUMF = 303 * MBy;
constexpr size_t OFF_MQ = 304 * MBy;
constexpr size_t OFF_MK = 316 * MBy;
constexpr size_t OFF_MVT = 328 * MBy;
constexpr size_t OFF_Y = 344 * MBy;
constexpr size_t OFF_PQ = 380 * MBy;
constexpr size_t OFF_IDS = 412 * MBy;
constexpr size_t OFF_GATE = 420 * MBy;
constexpr size_t OFF_BAR = 428 * MBy;
constexpr size_t OFF_CNT = OFF_BAR + 16384;
constexpr size_t OFF_SSY = 429 * MBy;
constexpr size_t OFF_PB = 431 * MBy;
constexpr size_t WS_END = 452 * MBy;

struct Params {
    const float* x; const float* p; const int* pos;
    const float* norm_mix_g; const float* w_in; const float* b_forget; const float* mla_q_norm_g; const float* w_uq;
    const float* mla_kv_norm_g; const float* w_ukv; const float* mix_out_norm_g; const float* w_o; const float* norm_ffn_g;
    const float* w_query; const float* sub_keys; const float* peer_u; const float* peer_v; const float* w_ple;
    const float* ple_norm_g; const float* w_ple_gate; const float* final_norm_g;
    float* out; char* ws;
};

__shared__ __attribute__((aligned(16))) char smem[LDS_BYTES];

__device__ __forceinline__ int opaque_tid() { int t = threadIdx.x; asm volatile("" : "+v"(t)); return t; }
template <typename T> __device__ __forceinline__ T* opq(T* p) { size_t z = 0; asm volatile("" : "+s"(z)); return (T*)((char*)p + z); }

__device__ __forceinline__ unsigned pack2(float a, float b) {
    f32x2 v = {a, b};
    bf16x2 r = __builtin_convertvector(v, bf16x2);
    return __builtin_bit_cast(unsigned, r);
}
__device__ __forceinline__ float bflo(unsigned u) { return __uint_as_float(u << 16); }
__device__ __forceinline__ float bfhi(unsigned u) { return __uint_as_float(u & 0xffff0000u); }
__device__ __forceinline__ float wave_sum(float v) {
#pragma unroll
    for (int o = 32; o > 0; o >>= 1) v += __shfl_xor(v, o);
    return v;
}
template <int CTRL> __device__ __forceinline__ float dpp_add(float v) {
    return v + __builtin_bit_cast(float, __builtin_amdgcn_update_dpp(0, __builtin_bit_cast(int, v), CTRL, 0xf, 0xf, true));
}
__device__ __forceinline__ float sum8_dpp(float v) { v = dpp_add<0xB1>(v); v = dpp_add<0x4E>(v); v = dpp_add<0x141>(v); return v; }
__device__ __forceinline__ float sumg_dpp(float v) {
    v = dpp_add<0x128>(v);
    float a = v, b = v;
    asm volatile("s_nop 1\n\tv_permlane16_swap_b32 %0, %1\n\ts_nop 1" : "+v"(a), "+v"(b));
    v = a + b;
    a = v; b = v;
    asm volatile("s_nop 1\n\tv_permlane32_swap_b32 %0, %1\n\ts_nop 1" : "+v"(a), "+v"(b));
    return a + b;
}
__device__ __forceinline__ int partner32(int v, int hh) {
    int a = v, b = v;
    asm volatile("s_nop 1\n\tv_permlane32_swap_b32 %0, %1\n\ts_nop 1" : "+v"(a), "+v"(b));
    return hh ? a : b;
}
__device__ __forceinline__ float fexp2(float x) { return __builtin_amdgcn_exp2f(x); }
__device__ __forceinline__ float flog2(float x) { return __builtin_amdgcn_logf(x); }
__device__ __forceinline__ float log_sigmoid_f(float z) { return fminf(z, 0.f) - 0.6931471805599453f * flog2(1.f + fexp2(-1.4426950408889634f * fabsf(z))); }

struct WJob { const float* src; int lds; int K; int Np; bf16* dst; int ldd; const float* gain; int map; };

__device__ __forceinline__ int src_col_map(int map, int c) {
    if (map == 0) return c;
    if (map == 1) {
        if (c < 768) return c;
        if (c < 1952) return c + 4;
        if (c < 1956) return c - 1952 + 768;
        return -1;
    }
    if (c < 256) return 192 * (c >> 6) + (c & 63);
    int e = c - 256;
    return 192 * (e >> 7) + 64 + (e & 127);
}

__device__ __forceinline__ void wconv_tile(const WJob& j, int tile) {
    float* tl = (float*)smem;
    int ktiles = j.K >> 5;
    int nt = tile / ktiles, kt = tile % ktiles;
    int n0 = nt * 32, k0 = kt * 32;
    int tx = opaque_tid() & 31, ty = opaque_tid() >> 5;
    int sc = src_col_map(j.map, n0 + tx);
#pragma unroll
    for (int i = 0; i < 2; ++i) {
        int k = k0 + ty + 16 * i;
        float v = 0.f;
        if (sc >= 0) v = j.src[(size_t)k * j.lds + sc] * (j.gain ? j.gain[k] : 1.f);
        tl[(ty + 16 * i) * 33 + tx] = v;
    }
    __syncthreads();
#pragma unroll
    for (int i = 0; i < 2; ++i) {
        int n = n0 + ty + 16 * i;
        j.dst[(size_t)n * j.ldd + k0 + tx] = (bf16)tl[tx * 33 + ty + 16 * i];
    }
    __syncthreads();
}

__device__ __forceinline__ void phase0(const Params& P) {
    char* ws = opq(P.ws);
    const int G = gridDim.x, bid = blockIdx.x, tid = opaque_tid();
    {
        const int w = tid >> 6, l = tid & 63;
        float* tsc = (float*)(ws + OFF_TSC);
        for (int it = bid * NW + w; it < 4 * NEXP; it += G * NW) {
            int tb = it >> 14, e = it & (NEXP - 1);
            const float* src = (tb < 2 ? P.peer_u : P.peer_v) + ((size_t)(tb & 1) * NEXP + e) * DM + l * 16;
            unsigned char* dst = (unsigned char*)(ws + (tb < 2 ? OFF_UB : OFF_VB)) + (size_t)(tb & 1) * NEXP * 512;
            float4 a = ((const float4*)src)[0], b = ((const float4*)src)[1], c = ((const float4*)src)[2], d = ((const float4*)src)[3];
            if (tb < 2) {
                const float4* g4 = (const float4*)(P.norm_ffn_g + (tb & 1) * 1024 + l * 16);
                float4 g0 = g4[0], g1 = g4[1], g2 = g4[2], g3 = g4[3];
                a.x *= g0.x; a.y *= g0.y; a.z *= g0.z; a.w *= g0.w; b.x *= g1.x; b.y *= g1.y; b.z *= g1.z; b.w *= g1.w;
                c.x *= g2.x; c.y *= g2.y; c.z *= g2.z; c.w *= g2.w; d.x *= g3.x; d.y *= g3.y; d.z *= g3.z; d.w *= g3.w;
            }
            float am = fmaxf(fmaxf(fmaxf(fabsf(a.x), fabsf(a.y)), fmaxf(fabsf(a.z), fabsf(a.w))), fmaxf(fmaxf(fabsf(b.x), fabsf(b.y)), fmaxf(fabsf(b.z), fabsf(b.w))));
            am = fmaxf(am, fmaxf(fmaxf(fmaxf(fabsf(c.x), fabsf(c.y)), fmaxf(fabsf(c.z), fabsf(c.w))), fmaxf(fmaxf(fabsf(d.x), fabsf(d.y)), fmaxf(fabsf(d.z), fabsf(d.w)))));
#pragma unroll
            for (int o = 32; o > 0; o >>= 1) am = fmaxf(am, __shfl_xor(am, o));
            float sc = (am > 0.f) ? (6.0f / am) : 1.f, isc = (am > 0.f) ? (am * (1.f / 6.0f)) : 1.f;
            unsigned w0 = 0, w1 = 0;
            w0 = __builtin_amdgcn_cvt_scalef32_pk_fp4_f32(w0, a.x * sc, a.y * sc, 1.0f, 0);
            w0 = __builtin_amdgcn_cvt_scalef32_pk_fp4_f32(w0, a.z * sc, a.w * sc, 1.0f, 1);
            w0 = __builtin_amdgcn_cvt_scalef32_pk_fp4_f32(w0, b.x * sc, b.y * sc, 1.0f, 2);
            w0 = __builtin_amdgcn_cvt_scalef32_pk_fp4_f32(w0, b.z * sc, b.w * sc, 1.0f, 3);
            w1 = __builtin_amdgcn_cvt_scalef32_pk_fp4_f32(w1, c.x * sc, c.y * sc, 1.0f, 0);
            w1 = __builtin_amdgcn_cvt_scalef32_pk_fp4_f32(w1, c.z * sc, c.w * sc, 1.0f, 1);
            w1 = __builtin_amdgcn_cvt_scalef32_pk_fp4_f32(w1, d.x * sc, d.y * sc, 1.0f, 2);
            w1 = __builtin_amdgcn_cvt_scalef32_pk_fp4_f32(w1, d.z * sc, d.w * sc, 1.0f, 3);
            u32x2 o2 = {w0, w1};
            *(u32x2*)(dst + ((size_t)(l >> 4) * NEXP + e) * 128 + (l & 15) * 8) = o2;
            if (l == 0) tsc[tb * NEXP + e] = isc;
        }
    }
    {
        for (int L = 0; L < 2; ++L) {
            WJob jobs[7];
            jobs[0] = {P.w_in + (size_t)L * 1024 * IN_W, IN_W, 1024, 2048, (bf16*)(ws + OFF_WIN) + (size_t)L * 2048 * LDH, LDH, P.norm_mix_g + L * 1024, 1};
            jobs[1] = {P.w_o + (size_t)L * 1024 * 1024, 1024, 1024, 1024, (bf16*)(ws + OFF_WO) + (size_t)L * 1024 * LDH, LDH, P.mix_out_norm_g + L * 1024, 0};
            jobs[2] = {P.w_query + (size_t)L * 1024 * 1024, 1024, 1024, 1024, (bf16*)(ws + OFF_WQ) + (size_t)L * 1024 * LDH, LDH, P.norm_ffn_g + L * 1024, 0};
            jobs[3] = {P.w_ple_gate + (size_t)L * 1024 * 1024, 1024, 1024, 1024, (bf16*)(ws + OFF_WG) + (size_t)L * 1024 * LDH, LDH, P.ple_norm_g + L * 1024, 0};
            jobs[4] = {P.w_ple + (size_t)L * 256 * 1024, 1024, 256, 1024, (bf16*)(ws + OFF_WP) + (size_t)L * 1024 * LDP, LDP, nullptr, 0};
            jobs[5] = {P.w_uq + (size_t)L * 256 * 384, 384, 256, 384, (bf16*)(ws + OFF_WUQ) + (size_t)L * 384 * LDP, LDP, P.mla_q_norm_g + L * 256, 0};
            jobs[6] = {P.w_ukv + (size_t)L * 128 * 768, 768, 128, 768, (bf16*)(ws + OFF_WUKV) + (size_t)L * 768 * LDC, LDC, P.mla_kv_norm_g + L * 128, 2};
#pragma unroll
            for (int q = 0; q < 7; ++q) {
                int nt = (jobs[q].Np >> 5) * (jobs[q].K >> 5);
                for (int it = bid; it < nt; it += G) wconv_tile(jobs[q], it);
            }
        }
    }
    {
        const float* src = P.sub_keys;
        bf16* dst = (bf16*)(ws + OFF_SKB);
        for (int i = bid * NTHR + tid; i < 262144 / 2; i += G * NTHR) {
            float2 v = ((const float2*)src)[i];
            ((unsigned*)dst)[i] = pack2(v.x, v.y);
        }
    }
    {
        const float4* src = (const float4*)P.p;
        bf16* dst = (bf16*)(ws + OFF_PB);
        for (int i = bid * NTHR + tid; i < 2 * TOK * 256 / 8; i += G * NTHR) {
            float4 a = src[2 * i], b = src[2 * i + 1];
            u32x4 o = {pack2(a.x, a.y), pack2(a.z, a.w), pack2(b.x, b.y), pack2(b.z, b.w)};
            *(u32x4*)(dst + (size_t)(i >> 5) * LDP + (i & 31) * 8) = o;
        }
    }
    {
        bf16* hb = (bf16*)(ws + OFF_HB0);
        float* ss0 = (float*)(ws + OFF_SSA);
        int w = tid >> 6, l = tid & 63;
        for (int row = bid * NW + w; row < TOK; row += G * NW) {
            const float4* xr = (const float4*)(P.x + (size_t)row * DM);
            float ss = 0.f;
#pragma unroll
            for (int i = 0; i < 2; ++i) {
                float4 a = xr[i * 128 + l * 2], b = xr[i * 128 + l * 2 + 1];
                ss += a.x * a.x + a.y * a.y + a.z * a.z + a.w * a.w + b.x * b.x + b.y * b.y + b.z * b.z + b.w * b.w;
                uint4 o;
                o.x = pack2(a.x, a.y); o.y = pack2(a.z, a.w); o.z = pack2(b.x, b.y); o.w = pack2(b.z, b.w);
                ((uint4*)(hb + (size_t)row * LDH))[i * 64 + l] = o;
            }
            ss = wave_sum(ss);
            if (l == 0) {
                *(float4*)(ss0 + (size_t)row * 8) = make_float4(ss, 0.f, 0.f, 0.f);
                *(float4*)(ss0 + (size_t)row * 8 + 4) = make_float4(0.f, 0.f, 0.f, 0.f);
            }
        }
    }
    {
        float* cs = (float*)(ws + OFF_CS);
        for (int i = bid * NTHR + tid; i < TOK * 16; i += G * NTHR) {
            int t = i >> 4, k = i & 15;
            float inv = powf(10000.0f, -(float)k / 16.0f);
            float ang = (float)P.pos[t] * inv;
            cs[2 * i] = cosf(ang);
            cs[2 * i + 1] = sinf(ang);
        }
    }
}

struct NoHook { static constexpr bool nodma = false; __device__ __forceinline__ void operator()(int, f32x16 (&)[2][2]) const {} };
struct NoDmaHook { static constexpr bool nodma = true; __device__ __forceinline__ void operator()(int, f32x16 (&)[2][2]) const {} };
template <typename HOOK>
__device__ __forceinline__ void gemm_core(f32x16 (&acc)[2][2], const bf16* A, int lda, const bf16* Bt, int ldb, int K,
                                          int m0, int n0, HOOK hook) {
    const int tid = opaque_tid(), w = tid >> 6, l = tid & 63, r = l & 31, hh = l >> 5;
    const int wm = w >> 1, wn = w & 1;
    const int dp = (tid & 15) ^ ((tid >> 4) & 15);
    const int drow = 2 * (tid >> 4) + (dp >> 3), dgc = (dp & 7) * 8;
    const bf16* asrc = A + (size_t)(m0 + drow) * lda + dgc;
    const bf16* bsrc = Bt + (size_t)(n0 + drow) * ldb + dgc;
    auto dma = [&](int buf, int k0) {
        if (HOOK::nodma) return;
        char* base = smem + buf * STAGE_BYTES + tid * 16;
#pragma unroll
        for (int i = 0; i < 4; ++i)
            __builtin_amdgcn_global_load_lds((const unsigned*)(asrc + (size_t)(64 * i) * lda + k0), (unsigned*)(base + i * 8192), 16, 0, 0);
#pragma unroll
        for (int i = 0; i < 2; ++i)
            __builtin_amdgcn_global_load_lds((const unsigned*)(bsrc + (size_t)(64 * i) * ldb + k0), (unsigned*)(base + 32768 + i * 8192), 16, 0, 0);
    };
    int offA[2], offB[2];
#pragma unroll
    for (int i = 0; i < 2; ++i) { offA[i] = ((wm * 64 + i * 32 + r) >> 1) * 256; offB[i] = 32768 + ((wn * 64 + i * 32 + r) >> 1) * 256; }
    const int pbase = ((r & 1) << 3), lx = (r >> 1) & 15;
    const int nk = K >> 6;
    const unsigned ldsbase = (unsigned)(size_t)(__attribute__((address_space(3))) char*)smem;
    auto ldfrag = [&](int stage, int s, bf16x8 (&af)[2], bf16x8 (&bfr)[2]) {
        unsigned ch = (unsigned)((((pbase | (2 * s + hh)) ^ lx) << 4)) + ldsbase + (unsigned)(stage * STAGE_BYTES);
        unsigned a0a = ch + offA[0], a1a = ch + offA[1], b0a = ch + offB[0], b1a = ch + offB[1];
        asm volatile("ds_read_b128 %0, %4\n\tds_read_b128 %1, %5\n\tds_read_b128 %2, %6\n\tds_read_b128 %3, %7"
                     : "=&v"(af[0]), "=&v"(af[1]), "=&v"(bfr[0]), "=&v"(bfr[1]) : "v"(a0a), "v"(a1a), "v"(b0a), "v"(b1a) : "memory");
    };
    auto mma = [&](bf16x8 (&af)[2], bf16x8 (&bfr)[2]) {
#pragma unroll
        for (int i = 0; i < 2; ++i)
#pragma unroll
            for (int j = 0; j < 2; ++j) acc[i][j] = __builtin_amdgcn_mfma_f32_32x32x16_bf16(af[i], bfr[j], acc[i][j], 0, 0, 0);
    };
#define LGKM_WAIT(n) do { asm volatile("s_waitcnt lgkmcnt(" #n ")" ::: "memory"); __builtin_amdgcn_sched_barrier(0); } while (0)
    asm volatile("s_waitcnt vmcnt(0)" ::: "memory");
    dma(0, 0);
    dma(1, 64);
    if (nk > 2) { dma(2, 128); asm volatile("s_waitcnt vmcnt(12)" ::: "memory"); }
    else asm volatile("s_waitcnt vmcnt(6)" ::: "memory");
    __builtin_amdgcn_s_barrier();
    bf16x8 a0[2], b0[2], a1[2], b1[2];
    ldfrag(0, 0, a0, b0);
    int cur = 0;
    for (int kt = 0; kt < nk; ++kt) {
        const int nxt = (cur == 2) ? 0 : cur + 1;
        if (kt == 4 || kt == 8) { LGKM_WAIT(0); hook(kt, acc); }
        ldfrag(cur, 1, a1, b1);
        LGKM_WAIT(4);
        mma(a0, b0);
        ldfrag(cur, 2, a0, b0);
        LGKM_WAIT(4);
        mma(a1, b1);
        ldfrag(cur, 3, a1, b1);
        LGKM_WAIT(4);
        mma(a0, b0);
        if (kt + 1 < nk) {
            if (kt + 2 < nk) asm volatile("s_waitcnt vmcnt(6) lgkmcnt(0)" ::: "memory");
            else asm volatile("s_waitcnt vmcnt(0) lgkmcnt(0)" ::: "memory");
            __builtin_amdgcn_s_barrier();
            __builtin_amdgcn_sched_barrier(0);
            if (kt + 3 < nk) dma(cur, (kt + 3) << 6);
            ldfrag(nxt, 0, a0, b0);
        } else {
            LGKM_WAIT(0);
        }
        mma(a1, b1);
        cur = nxt;
    }
    __syncthreads();
}
__device__ __forceinline__ float row_rs8(const float* part, int row) {
    float4 a = *(const float4*)(part + (size_t)row * 8), b = *(const float4*)(part + (size_t)row * 8 + 4);
    float ss = ((a.x + a.y) + (a.z + a.w)) + ((b.x + b.y) + (b.z + b.w));
    return rsqrtf(ss * (1.f / 1024.f) + EPSF);
}
__device__ __forceinline__ bool xcd_tile(int it, int MT, int NT, int& mt, int& nt) {
    const int G = gridDim.x, bid = blockIdx.x;
    if ((G & 7) == 0 && (MT & 7) == 0) {
        const int nbx = G >> 3, q = (bid >> 3) + it * nbx, per = (MT >> 3) * NT;
        if (q >= per) return false;
        mt = (bid & 7) * (MT >> 3) + q / NT; nt = q % NT;
        return true;
    }
    const int q = bid + it * G;
    if (q >= MT * NT) return false;
    mt = q / NT; nt = q % NT;
    return true;
}
struct NoScale { __device__ __forceinline__ float operator()(int, int) const { return 1.f; } };

#define ZERO_ACC(acc)                                  \
    _Pragma("unroll") for (int _i = 0; _i < 2; ++_i)   \
    _Pragma("unroll") for (int _j = 0; _j < 2; ++_j)   \
    _Pragma("unroll") for (int _r = 0; _r < 16; ++_r) acc[_i][_j][_r] = 0.f;


namespace pg8 {
#define PG8_LAS __attribute__((address_space(3)))
typedef unsigned short bf16_t;
constexpr int BM = 256, BK = 64, HALF = 128, HTB = HALF * BK * 2  , NXCD = 8, WGM = 8;

__host__ __device__ __forceinline__ int lds_byte(int r, int c) { const int st = (r >> 4) * 2 + (c >> 5), rr = r & 15, cc = c & 31, ob = rr * 64 + cc * 2; return st * 1024 + (ob ^ (((ob >> 9) & 1) << 5)); }
__host__ __device__ __forceinline__ void stage_rc(int b, int& R, int& C) { const int st = b / 1024, sb = b % 1024, swz = sb ^ (((sb >> 9) & 1) << 5); R = (st >> 1) * 16 + swz / 64; C = (st & 1) * 32 + (swz % 64) / 2; }
__host__ __device__ __forceinline__ int perm32(int rho) { const int n = rho >> 4, i = rho & 15; return 8 * (i >> 2) + 4 * n + (i & 3); }
struct Unit { int pm, pn; };
struct Gemm { const bf16* A; const bf16* Bt; int lda, ldb, M, N, K; };
struct StaticOrder {
    int nM, nN, nwg, G, c;
    __device__ void init(int M, int N, int G_, int c_) { nM = M / BM; nN = N / BM; nwg = nM * nN; G = G_; c = c_; }
    __device__ bool next(int i, Unit& u) const {
        const long L = (long)i * G + c; if (L >= nwg) return false;
        int wgid = (int)L; { const int q = nwg / NXCD, r = nwg % NXCD, xcd = wgid % NXCD, off = wgid / NXCD; wgid = (xcd < r ? xcd * (q + 1) : r * (q + 1) + (xcd - r) * q) + off; }
        const int nig = WGM * nN, gid = wgid / nig, fm = gid * WGM, gsz = (nM - fm) < WGM ? (nM - fm) : WGM;
        u.pm = fm + ((wgid % nig) % gsz); u.pn = (wgid % nig) / gsz; return true;
    }
    __device__ __forceinline__ void a_ready(const Unit&) const {}
    __device__ __forceinline__ void done(const Unit&) const {}
};
template <class Epi, class Sched, bool STAMP = false>
__device__ __forceinline__ void gemm_phase(PG8_LAS unsigned char* lds, const Gemm g, const Sched& S, const Epi& E, unsigned long long* stamps) {
    const int tid = opaque_tid(), wid = __builtin_amdgcn_readfirstlane(tid >> 6), lane = tid & 63, wr = wid >> 2, wc = wid & 3, fr = lane & 15, fq = lane >> 4;
    const int K = g.K, nt = K / BK;
    int ts_lo = 0, ts_hi = 0, nts = 0; const unsigned long long rt_entry = STAMP ? (unsigned long long)wall_clock64() : 0ull;
#define PG8_STAMP() do { if (STAMP && wid == 0 && nts < 64) { const unsigned long long _c = (unsigned long long)clock64(); \
        ts_lo = (lane == nts) ? (int)(unsigned)_c : ts_lo; ts_hi = (lane == nts) ? (int)(unsigned)(_c >> 32) : ts_hi; ++nts; } } while (0)
    PG8_STAMP();
    unsigned voffA[2], voffB[2];
#pragma unroll
    for (int i = 0; i < 2; ++i) { int R, C; stage_rc(tid * 16 + i * 8192, R, C); const int Rb = Epi::PERM ? ((R & ~31) + perm32(R & 31)) : R;
        voffA[i] = (unsigned)(R * g.lda + C) * 2u; voffB[i] = (unsigned)(Rb * g.ldb + C) * 2u; }
    const size_t kstep = (size_t)(BK * 2);
    const size_t hstepA = (size_t)HALF * g.lda * 2, hstepB = (size_t)HALF * g.ldb * 2;
    const size_t tstepA = 2 * hstepA, tstepB = 2 * hstepB;
    const unsigned ldsw = (unsigned)wid * 1024u;
    const int aoff = lds_byte(wr * 64 + fr, fq * 8), boff = lds_byte(wc * 32 + fr, fq * 8);
#define PG8_SA(b, h) (((b) * 2 + (h)) * HTB)
#define PG8_SB(b, h) ((4 + (b) * 2 + (h)) * HTB)
#define PG8_STAGE(bufoff, gbase, voff) do { _Pragma("unroll") for (int _i = 0; _i < 2; ++_i) \
        __builtin_amdgcn_global_load_lds((const unsigned*)((const char*)(gbase) + (voff)[_i]), (PG8_LAS unsigned*)(lds + (bufoff) + ldsw + _i * 8192), 16, 0, 0); } while (0)
#define PG8_LDA(dst, b, h) do { _Pragma("unroll") for (int m = 0; m < 4; ++m) _Pragma("unroll") for (int k = 0; k < 2; ++k) dst[m][k] = *(const PG8_LAS bf16x8*)(lds + PG8_SA(b, h) + aoff + m * 2048 + k * 1024); } while (0)
#define PG8_LDB(dst, b, h) do { _Pragma("unroll") for (int n = 0; n < 2; ++n) _Pragma("unroll") for (int k = 0; k < 2; ++k) dst[n][k] = *(const PG8_LAS bf16x8*)(lds + PG8_SB(b, h) + boff + n * 2048 + k * 1024); } while (0)
#define PG8_MMA(ai, bj, At, Bt) do { __builtin_amdgcn_s_setprio(1); _Pragma("unroll") for (int m = 0; m < 4; ++m) _Pragma("unroll") for (int n = 0; n < 2; ++n) _Pragma("unroll") for (int k = 0; k < 2; ++k) \
        acc[ai][bj][m][n] = __builtin_amdgcn_mfma_f32_16x16x32_bf16(Bt[n][k], At[m][k], acc[ai][bj][m][n], 0, 0, 0); __builtin_amdgcn_s_setprio(0); } while (0)
#define PG8_WAIT_V(n) asm volatile("s_waitcnt vmcnt(" #n ")" ::: "memory")
#define PG8_WAIT_L(n) asm volatile("s_waitcnt lgkmcnt(" #n ")" ::: "memory")
#define PG8_BAR __builtin_amdgcn_s_barrier()
#define PG8_SCHED __builtin_amdgcn_sched_barrier(0)
    Unit cur, nxt; int ui = 0;
    if (!S.next(0, cur)) return;
    f32x4 acc[2][2][4][2];
#pragma unroll
    for (int a = 0; a < 2; ++a)
#pragma unroll
        for (int b = 0; b < 2; ++b)
#pragma unroll
            for (int m = 0; m < 4; ++m)
#pragma unroll
                for (int n = 0; n < 2; ++n) acc[a][b][m][n] = (f32x4){0.f, 0.f, 0.f, 0.f};
    bf16x8 At[4][2], B0[2][2], B1[2][2];
    const char* cA = (const char*)g.A + (size_t)cur.pm * tstepA; const char* cB = (const char*)g.Bt + (size_t)cur.pn * tstepB;
    S.a_ready(cur);
    PG8_STAGE(PG8_SB(0, 0), cB, voffB); PG8_STAGE(PG8_SA(0, 0), cA, voffA); PG8_STAGE(PG8_SB(0, 1), cB + hstepB, voffB); PG8_STAGE(PG8_SA(0, 1), cA + hstepA, voffA);
    if (wr == 1) PG8_BAR;
    PG8_WAIT_V(4); PG8_BAR;
    PG8_STAGE(PG8_SB(1, 0), cB + kstep, voffB); PG8_STAGE(PG8_SA(1, 0), cA + kstep, voffA); PG8_STAGE(PG8_SB(1, 1), cB + hstepB + kstep, voffB);
    PG8_WAIT_V(6); PG8_BAR;
    PG8_STAMP();
    for (;;) {
        const bool has_next = S.next(ui + 1, nxt);
        const char* nA = has_next ? (const char*)g.A + (size_t)nxt.pm * tstepA : cA; const char* nB = has_next ? (const char*)g.Bt + (size_t)nxt.pn * tstepB : cB;
        for (int t = 0; t < nt; t += 2) {
            const bool last = (t == nt - 2);
            const char* a1 = cA + (size_t)(t + 1) * kstep;
            const char* a2 = last ? nA : cA + (size_t)(t + 2) * kstep; const char* b2 = last ? nB : cB + (size_t)(t + 2) * kstep;
            const char* a3 = a2 + kstep; const char* b3 = b2 + kstep;
            if (last && has_next) S.a_ready(nxt);
            E.khook(t, acc, wr, fr);
            PG8_LDB(B0, 0, 0); PG8_SCHED; PG8_LDA(At, 0, 0); PG8_STAGE(PG8_SA(1, 1), a1 + hstepA, voffA);
            PG8_WAIT_L(8); PG8_BAR; PG8_WAIT_L(0); PG8_MMA(0, 0, At, B0); PG8_BAR; PG8_SCHED;
            PG8_LDB(B1, 0, 1); PG8_STAGE(PG8_SB(0, 0), b2, voffB);
            PG8_BAR; PG8_WAIT_L(0); PG8_MMA(0, 1, At, B1); PG8_BAR;
            PG8_LDA(At, 0, 1); PG8_STAGE(PG8_SA(0, 0), a2, voffA);
            PG8_BAR; PG8_WAIT_L(0); PG8_MMA(1, 0, At, B0); PG8_BAR; PG8_SCHED;
            PG8_STAGE(PG8_SB(0, 1), b2 + hstepB, voffB);
            PG8_WAIT_V(6); PG8_BAR; PG8_MMA(1, 1, At, B1); PG8_BAR;
            PG8_LDB(B0, 1, 0); PG8_SCHED; PG8_LDA(At, 1, 0); PG8_STAGE(PG8_SA(0, 1), a2 + hstepA, voffA);
            PG8_WAIT_L(8); PG8_BAR; PG8_WAIT_L(0); PG8_MMA(0, 0, At, B0); PG8_BAR; PG8_SCHED;
            PG8_LDB(B1, 1, 1); PG8_STAGE(PG8_SB(1, 0), b3, voffB);
            PG8_BAR; PG8_WAIT_L(0); PG8_MMA(0, 1, At, B1); PG8_BAR;
            PG8_LDA(At, 1, 1); PG8_STAGE(PG8_SA(1, 0), a3, voffA);
            PG8_BAR; PG8_WAIT_L(0); PG8_MMA(1, 0, At, B0); PG8_BAR; PG8_SCHED;
            PG8_STAGE(PG8_SB(1, 1), b3 + hstepB, voffB);
            PG8_WAIT_V(6); PG8_BAR; PG8_MMA(1, 1, At, B1); PG8_BAR;
        }
        PG8_STAMP();
        if constexpr (!Epi::AFTER_DRAIN) { E(acc, cur, wr, wc, fr, fq); S.done(cur); }
        PG8_STAMP();
        if (!has_next) break;
#pragma unroll
        for (int a = 0; a < 2; ++a)
#pragma unroll
            for (int b = 0; b < 2; ++b)
#pragma unroll
                for (int m = 0; m < 4; ++m)
#pragma unroll
                    for (int n = 0; n < 2; ++n) acc[a][b][m][n] = (f32x4){0.f, 0.f, 0.f, 0.f};
        cur = nxt; cA = nA; cB = nB; ++ui;
    }
    PG8_WAIT_V(0);
    if (wr == 0) PG8_BAR;
    PG8_BAR;
    if constexpr (Epi::AFTER_DRAIN) { E.fused(acc, cur, wr, wc, fr, fq, lds, wid, lane); S.done(cur); }
    PG8_STAMP();
    if (STAMP && wid == 0) { stamps[lane] = lane < nts ? (((unsigned long long)(unsigned)ts_hi << 32) | (unsigned)ts_lo) : 0ull;
        if (lane == 62) stamps[62] = rt_entry; if (lane == 63) stamps[63] = (unsigned long long)wall_clock64(); }
#undef PG8_STAMP
#undef PG8_SA
#undef PG8_SB
#undef PG8_STAGE
#undef PG8_LDA
#undef PG8_LDB
#undef PG8_MMA
#undef PG8_WAIT_V
#undef PG8_WAIT_L
#undef PG8_BAR
#undef PG8_SCHED
}
}

#define TB_LD 136
#define TF_LD 132
template <bool SCALE>
__device__ __forceinline__ void stage_bf16(const f32x16 (&acc)[2][2], const float* rsl) {
    bf16* T = (bf16*)smem;
    const int tid = opaque_tid(), w = tid >> 6, l = tid & 63, hh = l >> 5, wm = w >> 1, wn = w & 1;
#pragma unroll
    for (int i = 0; i < 2; ++i)
#pragma unroll
        for (int rr = 0; rr < 16; ++rr) {
            int row = wm * 64 + i * 32 + (rr & 3) + 8 * (rr >> 2) + 4 * hh;
            float sc = SCALE ? rsl[row] : 1.f;
#pragma unroll
            for (int j = 0; j < 2; ++j) T[row * TB_LD + wn * 64 + j * 32 + (l & 31)] = (bf16)(acc[i][j][rr] * sc);
        }
    __syncthreads();
}
template <bool SCALE>
__device__ __forceinline__ void stage_f32(const f32x16 (&acc)[2][2], const float* rsl) {
    float* T = (float*)smem;
    const int tid = opaque_tid(), w = tid >> 6, l = tid & 63, hh = l >> 5, wm = w >> 1, wn = w & 1;
#pragma unroll
    for (int i = 0; i < 2; ++i)
#pragma unroll
        for (int rr = 0; rr < 16; ++rr) {
            int row = wm * 64 + i * 32 + (rr & 3) + 8 * (rr >> 2) + 4 * hh;
            float sc = SCALE ? rsl[row] : 1.f;
#pragma unroll
            for (int j = 0; j < 2; ++j) T[row * TF_LD + wn * 64 + j * 32 + (l & 31)] = acc[i][j][rr] * sc;
        }
    __syncthreads();
}
template <typename CMAP>
__device__ __forceinline__ void store_rows_bf16(bf16* dst, int ld, int m0, CMAP cmap) {
    const bf16* T = (const bf16*)smem;
    const int tid = opaque_tid();
#pragma unroll
    for (int q = 0; q < 8; ++q) {
        int id = tid + 512 * q, row = id >> 4, ch = id & 15;
        u32x4 v = *(const u32x4*)(T + row * TB_LD + ch * 8);
        *(u32x4*)(dst + (size_t)(m0 + row) * ld + cmap(ch * 8)) = v;
    }
}
__device__ __forceinline__ void store_cols_bf16(bf16* vt, size_t crow0, int s0) {
    const unsigned short* T = (const unsigned short*)smem;
    const int tid = opaque_tid();
#pragma unroll
    for (int q = 0; q < 8; ++q) {
        int id = tid + 512 * q, c = id & 127, sg = id >> 7;
        unsigned e[8];
#pragma unroll
        for (int k = 0; k < 8; ++k) e[k] = T[(8 * sg + k) * TB_LD + c];
        u32x4 v = {e[0] | (e[1] << 16), e[2] | (e[3] << 16), e[4] | (e[5] << 16), e[6] | (e[7] << 16)};
        *(u32x4*)(vt + (crow0 + c) * SEQ + s0 + 8 * sg) = v;
    }
}
__device__ __forceinline__ void residual_store(const float* hin, float* hout, bf16* hb_out, float* gss, int m0, int n0, int nt) {
    const float* T = (const float*)smem;
    const int tid = opaque_tid(), l = tid & 63;
#pragma unroll 4
    for (int q = 0; q < 16; ++q) {
        int id = tid + 512 * q, row = id >> 5, ch = id & 31;
        f32x4 d = *(const f32x4*)(T + row * TF_LD + ch * 4);
        size_t gi = (size_t)(m0 + row) * 1024 + n0 + ch * 4;
        f32x4 h = *(const f32x4*)(hin + gi);
        f32x4 v = h + d;
        *(f32x4*)(hout + gi) = v;
        u32x2 b = {pack2(v.x, v.y), pack2(v.z, v.w)};
        *(u32x2*)(hb_out + (size_t)(m0 + row) * LDH + n0 + ch * 4) = b;
        float ss = v.x * v.x + v.y * v.y + v.z * v.z + v.w * v.w;
        ss = dpp_add<0xB1>(ss); ss = dpp_add<0x4E>(ss); ss = dpp_add<0x141>(ss); ss = dpp_add<0x140>(ss);
        ss += __shfl_xor(ss, 16);
        if ((l & 31) == 0) gss[(size_t)(m0 + row) * 8 + nt] = ss;
    }
}
struct ColAdd { int off; __device__ __forceinline__ int operator()(int c) const { return c + off; } };
struct ColHead96 { __device__ __forceinline__ int operator()(int c) const { return (c >> 6) * 96 + (c & 63); } };

struct EpiProj {
    static constexpr bool PERM = true, AFTER_DRAIN = false;
    const float* ssrow; char* ws;
    __device__ __forceinline__ void khook(int, f32x4 (&)[2][2][4][2], int, int) const {}
    __device__ __forceinline__ void operator()(const f32x4 (&acc)[2][2][4][2], const pg8::Unit& u, int wr, int wc, int fr, int fqd) const {
        const int row0 = u.pm * 256 + wr * 64 + fr, lc0 = wc * 32 + 8 * fqd, pn = u.pn;
        size_t doff; int ld = 256;
        if (pn == 0) doff = OFF_FQ; else if (pn == 1) doff = OFF_FK; else if (pn == 2) doff = OFF_PART;
        else if (pn == 3) doff = OFF_SQ; else if (pn == 4) doff = OFF_SKK; else if (pn == 5) doff = OFF_PART + 8 * MBy;
        else if (pn == 6) { doff = OFF_CQ; ld = LDP; } else { doff = OFF_CKV; ld = LDC; }
        bf16* dst = (bf16*)(ws + doff);
        bf16* mk = (bf16*)(ws + OFF_MK); float* flog = (float*)(ws + OFF_FLOG); const float* cs = (const float*)(ws + OFF_CS);
#pragma unroll
        for (int ai = 0; ai < 2; ++ai)
#pragma unroll
            for (int m = 0; m < 4; ++m) {
                const int row = row0 + ai * 128 + m * 16;
                const float rs = row_rs8(ssrow, row);
#pragma unroll
                for (int bj = 0; bj < 2; ++bj) {
                    f32x4 v0 = acc[ai][bj][m][0] * rs, v1 = acc[ai][bj][m][1] * rs;
                    if (pn < 7 || bj == 0) {
                        u32x4 wv = {pack2(v0[0], v0[1]), pack2(v0[2], v0[3]), pack2(v1[0], v1[1]), pack2(v1[2], v1[3])};
                        *(u32x4*)(dst + (size_t)row * ld + bj * 128 + lc0) = wv;
                    } else if (wc == 0) {
                        const int hh = fqd >> 1, pi = 8 * (fqd & 1);
                        float vv[8] = {v0[0], v0[1], v0[2], v0[3], v1[0], v1[1], v1[2], v1[3]}, ov[8];
                        const f32x4* c4 = (const f32x4*)(cs + ((size_t)row * 16 + pi) * 2);
                        f32x4 t0 = c4[0], t1 = c4[1], t2 = c4[2], t3 = c4[3];
                        float cc[8] = {t0.x, t0.z, t1.x, t1.z, t2.x, t2.z, t3.x, t3.z}, sn[8] = {t0.y, t0.w, t1.y, t1.w, t2.y, t2.w, t3.y, t3.w};
#pragma unroll
                        for (int e = 0; e < 8; ++e) {
                            float pv = __builtin_bit_cast(float, partner32(__builtin_bit_cast(int, vv[e]), hh));
                            ov[e] = hh ? (pv * sn[e] + vv[e] * cc[e]) : (vv[e] * cc[e] - pv * sn[e]);
                        }
                        u32x4 wv = {pack2(ov[0], ov[1]), pack2(ov[2], ov[3]), pack2(ov[4], ov[5]), pack2(ov[6], ov[7])};
#pragma unroll
                        for (int h = 0; h < 4; ++h) *(u32x4*)(mk + (size_t)row * 384 + h * 96 + 64 + 8 * fqd) = wv;
                    } else if (wc == 1 && fqd == 0) {
                        *(f32x4*)(flog + (size_t)row * 4) = v0;
                    }
                }
            }
    }
};
__device__ __forceinline__ void phase_proj(const Params& P, int L, int hsel, int ss_slot) {
    char* ws = opq(P.ws);
    const float* ssrow = (const float*)(ws + OFF_SSA) + (size_t)ss_slot * TOK * 8;
    const bf16* hb = (const bf16*)(ws + (hsel ? OFF_HB1 : OFF_HB0));
    const bf16* Bt = (const bf16*)(ws + OFF_WIN) + (size_t)L * 2048 * LDH;
    pg8::Gemm g{hb, Bt, LDH, LDH, TOK, 2048, 1024};
    pg8::StaticOrder S; S.init(TOK, 2048, gridDim.x, blockIdx.x);
    EpiProj E{ssrow, ws};
    pg8::gemm_phase((PG8_LAS unsigned char*)smem, g, S, E, nullptr);
    __syncthreads();
}

template <int KW>
__device__ __forceinline__ void row_rms_to_lds(const bf16* A, int lda, int m0) {
    const int tid = opaque_tid(), row = tid >> 1, half = tid & 1;
    float ss = 0.f;
    const u32x4* p = (const u32x4*)(A + (size_t)(m0 + row) * lda + half * (KW / 2));
#pragma unroll
    for (int q = 0; q < KW / 16; ++q) {
        u32x4 v = p[q];
        float a;
        a = bflo(v.x); ss += a * a; a = bfhi(v.x); ss += a * a;
        a = bflo(v.y); ss += a * a; a = bfhi(v.y); ss += a * a;
        a = bflo(v.z); ss += a * a; a = bfhi(v.z); ss += a * a;
        a = bflo(v.w); ss += a * a; a = bfhi(v.w); ss += a * a;
    }
    ss += __shfl_xor(ss, 1);
    if (half == 0) ((float*)(smem + LDS_AUX))[row] = rsqrtf(ss * (1.f / (float)KW) + EPSF);
}

__device__ __forceinline__ void phase_mla_up(const Params& P, int L) {
    char* ws = opq(P.ws);
    const bf16* cq = (const bf16*)(ws + OFF_CQ); const bf16* ckv = (const bf16*)(ws + OFF_CKV);
    const bf16* wuq = (const bf16*)(ws + OFF_WUQ) + (size_t)L * 384 * LDP;
    const bf16* wukv = (const bf16*)(ws + OFF_WUKV) + (size_t)L * 768 * LDC;
    bf16* mq = (bf16*)(ws + OFF_MQ); bf16* mk = (bf16*)(ws + OFF_MK); bf16* mvt = (bf16*)(ws + OFF_MVT);
    const float* cs = (const float*)(ws + OFF_CS);
    const float* flog = (const float*)(ws + OFF_FLOG);
    float* cumF = (float*)(ws + OFF_CUMF);
    const int tid = opaque_tid(), w = tid >> 6, l = tid & 63, hh = l >> 5, wm = w >> 1, wn = w & 1;
    const int NQ = 64 * 3, NKV = 64 * 6, NCF = 4;
    const float* aux = (const float*)(smem + LDS_AUX);
    for (int gw = blockIdx.x * NW + w; gw < 2048; gw += gridDim.x * NW) {
        const int type = gw >> 10, bh = (gw >> 5) & 31, tb = gw & 31, b = bh >> 2, h = bh & 3;
        const bf16* src = (const bf16*)(ws + OFF_PART + (type ? 8 * MBy : 0)) + ((size_t)(b * SEQ + tb * 64 + l) * 256 + h * 64);
        unsigned short* dst = (unsigned short*)(ws + (type ? OFF_SVT : OFF_FVT)) + (size_t)bh * 64 * SEQ + tb * 64 + l;
        u32x4 rv8[8];
#pragma unroll
        for (int q = 0; q < 8; ++q) rv8[q] = ((const u32x4*)src)[q];
#pragma unroll
        for (int q = 0; q < 8; ++q) {
            dst[(size_t)(8 * q + 0) * SEQ] = (unsigned short)(rv8[q].x & 0xffffu); dst[(size_t)(8 * q + 1) * SEQ] = (unsigned short)(rv8[q].x >> 16);
            dst[(size_t)(8 * q + 2) * SEQ] = (unsigned short)(rv8[q].y & 0xffffu); dst[(size_t)(8 * q + 3) * SEQ] = (unsigned short)(rv8[q].y >> 16);
            dst[(size_t)(8 * q + 4) * SEQ] = (unsigned short)(rv8[q].z & 0xffffu); dst[(size_t)(8 * q + 5) * SEQ] = (unsigned short)(rv8[q].z >> 16);
            dst[(size_t)(8 * q + 6) * SEQ] = (unsigned short)(rv8[q].w & 0xffffu); dst[(size_t)(8 * q + 7) * SEQ] = (unsigned short)(rv8[q].w >> 16);
        }
    }
    for (int item = blockIdx.x; item < NQ + NKV + NCF; item += gridDim.x) {
        if (item < NQ) {
            int mt = item / 3, nt = item % 3;
            int m0 = mt * 256, n0 = nt * 128;
            __syncthreads();
            row_rms_to_lds<256>(cq, LDP, m0);
            f32x16 acc[2][2];
            ZERO_ACC(acc);
            gemm_core(acc, cq, LDP, wuq, LDP, 256, m0, n0, NoHook());
#pragma unroll
            for (int i = 0; i < 2; ++i)
#pragma unroll
                for (int j = 0; j < 2; ++j) {
                    int c0 = n0 + wn * 64 + j * 32;
                    int rloc = wm * 64 + i * 32 + 4 * hh;
                    bool rot = (c0 % 96) == 64;
                    int ci = l & 31, pi = ci & 15;
#pragma unroll
                    for (int rr = 0; rr < 16; ++rr) {
                        int rl = rloc + (rr & 3) + 8 * (rr >> 2);
                        float v = acc[i][j][rr] * aux[rl];
                        if (rot) {
                            float pv = __shfl_xor(v, 16);
                            float2 c_s = *(const float2*)(cs + ((size_t)(m0 + rl) * 16 + pi) * 2);
                            v = (ci < 16) ? (v * c_s.x - pv * c_s.y) : (pv * c_s.y + v * c_s.x);
                        }
                        acc[i][j][rr] = v;
                    }
                }
            stage_bf16<false>(acc, nullptr);
            store_rows_bf16(mq, 384, m0, ColAdd{n0});
        } else if (item < NQ + NKV) {
            int it2 = item - NQ;
            int mt = it2 / 6, nt = it2 % 6;
            int m0 = mt * 256, n0 = nt * 128;
            __syncthreads();
            row_rms_to_lds<128>(ckv, LDC, m0);
            f32x16 acc[2][2];
            ZERO_ACC(acc);
            gemm_core(acc, ckv, LDC, wukv, LDC, 128, m0, n0, NoHook());
            stage_bf16<true>(acc, aux);
            if (nt < 2) {
                const int nb0 = n0;
                struct CM { int n0; __device__ __forceinline__ int operator()(int c) const { int col = n0 + c; return (col >> 6) * 96 + (col & 63); } };
                store_rows_bf16(mk, 384, m0, CM{nb0});
            } else {
                store_cols_bf16(mvt, (size_t)(m0 >> 11) * 512 + (n0 - 256), m0 & 2047);
            }
        } else {
            int seq = (item - NQ - NKV) * NW + w;
            int b = seq >> 2, h = seq & 3;
            float bfv = P.b_forget[L * 4 + h];
            float vals[32];
            float run = 0.f;
#pragma unroll
            for (int i = 0; i < 32; ++i) {
                int s = l * 32 + i;
                float z = flog[((size_t)b * SEQ + s) * 4 + h] + bfv;
                run += log_sigmoid_f(z);
                vals[i] = run;
            }
            float tot = run, incl = tot;
#pragma unroll
            for (int o = 1; o < 64; o <<= 1) {
                float t = __shfl_up(incl, o);
                if (l >= o) incl += t;
            }
            float excl = incl - tot;
#pragma unroll
            for (int i = 0; i < 32; ++i) cumF[(size_t)seq * SEQ + l * 32 + i] = vals[i] + excl;
        }
    }
}

template <int MODE, int DK, int DV>
__device__ __forceinline__ void attn_item(const bf16* __restrict__ Q, int ldq, const bf16* __restrict__ Kg, int ldk,
                          const bf16* __restrict__ Vt, const float* __restrict__ cumF, bf16* __restrict__ Y,
                          float* __restrict__ ssy, int b, int h, int qb, float c1, char* lds, int fake = 0) {
    constexpr int KSTR = DK * 2 + 16;
    constexpr int VSTR = 144;
    constexpr int KBYTES = 64 * KSTR, VBYTES = DV * VSTR;
    constexpr int BUF = (KBYTES + VBYTES + 256 + 255) & ~255;
    static_assert(2 * BUF <= 65536, "lds");
    constexpr int KCH = DK / 8, KPT = (64 * KCH) / 256, VPT = (DV * 8) / 256;
    const int tid = opaque_tid() & 255, w = tid >> 6, l = tid & 63, r = l & 31, hh = l >> 5;
    const int q0 = qb * 128;
    const int qrow = q0 + 32 * w + r;
    const size_t tok = (size_t)b * SEQ + qrow;
    const int bh = b * 4 + h;
    bf16x8 qf[DK / 16];
#pragma unroll
    for (int s = 0; s < DK / 16; ++s) qf[s] = *(const bf16x8*)(Q + tok * ldq + h * DK + 16 * s + 8 * hh);
    f32x16 o[DV / 32];
    const f32x16 zero16 = {0.f, 0.f, 0.f, 0.f, 0.f, 0.f, 0.f, 0.f, 0.f, 0.f, 0.f, 0.f, 0.f, 0.f, 0.f, 0.f};
#pragma unroll
    for (int d = 0; d < DV / 32; ++d) o[d] = zero16;
    float m = -1e30f, lsum = 0.f, R = 0.f;
    float Fq = 0.f;
    if (MODE == 0) Fq = cumF[(size_t)bh * SEQ + qrow] * LOG2E;
    const int nkt = (q0 + 128) >> 6;
    u32x4 kregA[KPT], vregA[VPT], kregB[KPT], vregB[VPT];
    float4 fregA = {0.f, 0.f, 0.f, 0.f}, fregB = {0.f, 0.f, 0.f, 0.f};
    auto gload = [&](int kt, u32x4 (&kreg)[KPT], u32x4 (&vreg)[VPT], float4& freg) {
#pragma unroll
        for (int i = 0; i < KPT; ++i) {
            int e = tid + 256 * i;
            int row = e / KCH, ch = e % KCH;
            kreg[i] = *(const u32x4*)(Kg + ((size_t)b * SEQ + kt * 64 + row) * ldk + h * DK + ch * 8);
        }
#pragma unroll
        for (int i = 0; i < VPT; ++i) {
            int e = tid + 256 * i;
            int row = e >> 3, ch = e & 7;
            vreg[i] = *(const u32x4*)(Vt + ((size_t)bh * DV + row) * SEQ + kt * 64 + ch * 8);
        }
        if (MODE == 0 && tid < 16) freg = *(const float4*)(cumF + (size_t)bh * SEQ + kt * 64 + tid * 4);
    };
    auto lwrite = [&](int buf, u32x4 (&kreg)[KPT], u32x4 (&vreg)[VPT], float4& freg) {
        char* base = lds + buf * BUF;
#pragma unroll
        for (int i = 0; i < KPT; ++i) {
            int e = tid + 256 * i;
            int row = e / KCH, ch = e % KCH;
            *(u32x4*)(base + row * KSTR + ch * 16) = kreg[i];
        }
#pragma unroll
        for (int i = 0; i < VPT; ++i) {
            int e = tid + 256 * i;
            int row = e >> 3, ch = e & 7;
            *(u32x4*)(base + KBYTES + row * VSTR + ch * 16) = vreg[i];
        }
        if (MODE == 0 && tid < 16) { float4 fn = {-freg.x * LOG2E, -freg.y * LOG2E, -freg.z * LOG2E, -freg.w * LOG2E}; *(float4*)(base + KBYTES + VBYTES + tid * 16) = fn; }
    };
    const int prow = (r & 0x13) | ((r & 4) << 1) | ((r & 8) >> 1);
    auto ktof = [&](int it) { return (MODE == 1) ? (nkt - 1 - it) : it; };
    gload(ktof(0), kregA, vregA, fregA);
    lwrite(0, kregA, vregA, fregA);
    constexpr bool D2 = (MODE != 2);
    if (D2 && nkt > 1) gload(ktof(1), kregB, vregB, fregB);
    __syncthreads();
    auto tile = [&](int it, u32x4 (&kn)[KPT], u32x4 (&vn)[VPT], float4& fn2, u32x4 (&kf)[KPT], u32x4 (&vf2)[VPT], float4& ff) {
        const int kt = ktof(it);
        if (!(fake & 1)) {
        if (D2) { if (it + 2 < nkt) gload(ktof(it + 2), kf, vf2, ff); }
        else { if (it + 1 < nkt) gload(ktof(it + 1), kf, vf2, ff); }
        }
        const char* base = lds + (it & 1) * BUF;
        const bool active = (kt * 64) <= (q0 + 32 * w + 31);
        if (active) {
            const bool needmask = (kt * 64 + 63) >= (q0 + 32 * w);
            f32x16 s[2];
#pragma unroll
            for (int sub = 0; sub < 2; ++sub) {
                s[sub] = zero16;
#pragma unroll
                for (int ks = 0; ks < DK / 16; ++ks) {
                    bf16x8 kf = *(const bf16x8*)(base + (sub * 32 + prow) * KSTR + (2 * ks + hh) * 16);
                    s[sub] = __builtin_amdgcn_mfma_f32_32x32x16_bf16(kf, qf[ks], s[sub], 0, 0, 0);
                }
            }
            bf16x8 pf[2][2];
            if (fake & 2) {
#pragma unroll
                for (int sub = 0; sub < 2; ++sub)
#pragma unroll
                    for (int a = 0; a < 2; ++a) {
                        uint4 u;
                        u.x = pack2(s[sub][8 * a], s[sub][8 * a + 1]); u.y = pack2(s[sub][8 * a + 2], s[sub][8 * a + 3]);
                        u.z = pack2(s[sub][8 * a + 4], s[sub][8 * a + 5]); u.w = pack2(s[sub][8 * a + 6], s[sub][8 * a + 7]);
                        pf[sub][a] = __builtin_bit_cast(bf16x8, u);
                    }
                lsum = 1.f;
            } else if (MODE != 1) {
                const float* Ft = (const float*)(base + KBYTES + VBYTES);
                float mx = -INFINITY;
                float tv[2][16];
#pragma unroll
                for (int sub = 0; sub < 2; ++sub)
#pragma unroll
                    for (int a = 0; a < 2; ++a) {
                        int kofs = sub * 32 + 16 * a + 8 * hh;
                        float fk[8];
                        if (MODE == 0) {
                            float4 f0 = *(const float4*)(Ft + kofs), f1 = *(const float4*)(Ft + kofs + 4);
                            fk[0] = f0.x; fk[1] = f0.y; fk[2] = f0.z; fk[3] = f0.w; fk[4] = f1.x; fk[5] = f1.y; fk[6] = f1.z; fk[7] = f1.w;
                        }
#pragma unroll
                        for (int j = 0; j < 8; ++j) {
                            int rr = 8 * a + j;
                            float v = (MODE == 0) ? fmaf(s[sub][rr], c1, fk[j]) : s[sub][rr] * c1;
                            tv[sub][rr] = v;
                        }
                    }
                if (needmask) {
#pragma unroll
                    for (int sub = 0; sub < 2; ++sub)
#pragma unroll
                        for (int rr = 0; rr < 16; ++rr) {
                            int key = kt * 64 + sub * 32 + 16 * (rr >> 3) + 8 * hh + (rr & 7);
                            if (key > qrow) tv[sub][rr] = -INFINITY;
                        }
                }
#pragma unroll
                for (int sub = 0; sub < 2; ++sub)
#pragma unroll
                    for (int rr = 0; rr < 16; ++rr) mx = fmaxf(mx, tv[sub][rr]);
                mx = fmaxf(mx, __builtin_bit_cast(float, partner32(__builtin_bit_cast(int, mx), hh)));
                float mnew = fmaxf(m, mx);
                float rsum = 0.f;
#pragma unroll
                for (int sub = 0; sub < 2; ++sub)
#pragma unroll
                    for (int a = 0; a < 2; ++a) {
                        float pv[8];
#pragma unroll
                        for (int j = 0; j < 8; ++j) { pv[j] = fexp2(tv[sub][8 * a + j] - mnew); rsum += pv[j]; }
                        uint4 u;
                        u.x = pack2(pv[0], pv[1]); u.y = pack2(pv[2], pv[3]); u.z = pack2(pv[4], pv[5]); u.w = pack2(pv[6], pv[7]);
                        pf[sub][a] = __builtin_bit_cast(bf16x8, u);
                    }
                rsum += __builtin_bit_cast(float, partner32(__builtin_bit_cast(int, rsum), hh));
                if (__builtin_amdgcn_ballot_w64(mnew != m) != 0ull) {
                    float alpha = fexp2(m - mnew);
                    lsum *= alpha;
#pragma unroll
                    for (int d = 0; d < DV / 32; ++d) o[d] = o[d] * alpha;
                    m = mnew;
                }
                lsum += rsum;
            } else {
#pragma unroll
                for (int sb = 0; sb < 2; ++sb) {
                    const int sub = 1 - sb;
                    float lsig[16], lneg[16];
                    float A0 = 0.f, A1 = 0.f;
#pragma unroll
                    for (int rr = 0; rr < 16; ++rr) {
                        int key = kt * 64 + sub * 32 + 16 * (rr >> 3) + 8 * hh + (rr & 7);
                        bool valid = key < qrow;
                        float z = s[sub][rr] * c1;
                        float e = fexp2(-fabsf(z));
                        float l1p = flog2(1.f + e);
                        float ls = fminf(z, 0.f) - l1p;
                        float ln = valid ? (ls - z) : 0.f;
                        lsig[rr] = valid ? ls : -INFINITY;
                        lneg[rr] = ln;
                        if (rr < 8) A0 += ln; else A1 += ln;
                    }
                    float B0 = __shfl_xor(A0, 32), B1 = __shfl_xor(A1, 32);
                    float base1 = (hh == 0) ? (R + B1) : R;
                    float base0 = (hh == 0) ? (R + B1 + A1 + B0) : (R + A1 + B1);
                    float wv[16];
                    float run = base1;
#pragma unroll
                    for (int j = 7; j >= 0; --j) { wv[8 + j] = fexp2(lsig[8 + j] + run); run += lneg[8 + j]; }
                    run = base0;
#pragma unroll
                    for (int j = 7; j >= 0; --j) { wv[j] = fexp2(lsig[j] + run); run += lneg[j]; }
                    R += A0 + A1 + B0 + B1;
#pragma unroll
                    for (int a = 0; a < 2; ++a) {
                        uint4 u;
                        u.x = pack2(wv[8 * a], wv[8 * a + 1]); u.y = pack2(wv[8 * a + 2], wv[8 * a + 3]);
                        u.z = pack2(wv[8 * a + 4], wv[8 * a + 5]); u.w = pack2(wv[8 * a + 6], wv[8 * a + 7]);
                        pf[sub][a] = __builtin_bit_cast(bf16x8, u);
                    }
                }
            }
#pragma unroll
            for (int d = 0; d < DV / 32; ++d)
#pragma unroll
                for (int sub = 0; sub < 2; ++sub)
#pragma unroll
                    for (int a = 0; a < 2; ++a) {
                        bf16x8 vf = *(const bf16x8*)(base + KBYTES + (d * 32 + r) * VSTR + (sub * 32 + 16 * a + 8 * hh) * 2);
                        o[d] = __builtin_amdgcn_mfma_f32_32x32x16_bf16(vf, pf[sub][a], o[d], 0, 0, 0);
                    }
        }
        if (!(fake & 1)) { if (it + 1 < nkt) lwrite((it + 1) & 1, kn, vn, fn2); }
        __syncthreads();
    };
    if (D2) {
        for (int it = 0; it < nkt; it += 2) {
            tile(it, kregB, vregB, fregB, kregA, vregA, fregA);
            if (it + 1 < nkt) tile(it + 1, kregA, vregA, fregA, kregB, vregB, fregB);
        }
    } else {
        for (int it = 0; it < nkt; ++it) tile(it, kregA, vregA, fregA, kregA, vregA, fregA);
    }
    float inv = (MODE == 1) ? 1.f : (1.f / lsum);
    float ssq = 0.f;
#pragma unroll
    for (int d = 0; d < DV / 32; ++d)
#pragma unroll
        for (int g = 0; g < 4; ++g) {
            float v0 = o[d][4 * g] * inv, v1 = o[d][4 * g + 1] * inv, v2 = o[d][4 * g + 2] * inv, v3 = o[d][4 * g + 3] * inv;
            ssq += v0 * v0 + v1 * v1 + v2 * v2 + v3 * v3;
            uint2 u; u.x = pack2(v0, v1); u.y = pack2(v2, v3);
            *(uint2*)(Y + tok * LDH + h * DV + d * 32 + 8 * g + 4 * hh) = u;
        }
    ssq += __shfl_xor(ssq, 32);
    if (hh == 0) ssy[tok * 16 + h] = ssq;
}

__device__ __forceinline__ void phase_attn(const Params& P, int L, int rep = 0, int fake = 0) {
    char* ws = opq(P.ws);
    int* cnt = (int*)(ws + OFF_CNT) + L * 64 + rep * 16;
    int* s_item = (int*)(smem + LDS_BYTES - 16);
    const float* cumF = (const float*)(ws + OFF_CUMF);
    bf16* Y = (bf16*)(ws + (fake ? OFF_PART : OFF_Y));
    float* ssy = fake ? (float*)(ws + OFF_PART + 40 * MBy) : (float*)(ws + OFF_SSY) + (size_t)L * TOK * 16;
    const int half = opaque_tid() >> 8;
    char* lds = smem + half * 65536;
    for (;;) {
        if (opaque_tid() == 0) *s_item = atomicAdd(cnt, 1);
        __syncthreads();
        int pair = *s_item;
        __syncthreads();
        if (pair >= 768) break;
        int item = pair * 2 + half;
        int qb = 15 - item / 96;
        int rem = item % 96;
        int type = rem >> 5, bh = rem & 31;
        int b = bh >> 2, h = bh & 3;
        if (type == 0) {
            attn_item<2, 96, 128>((const bf16*)(ws + OFF_MQ), 384, (const bf16*)(ws + OFF_MK), 384, (const bf16*)(ws + OFF_MVT), cumF,
                                  Y + 512, ssy + 8, b, h, qb, 0.10206207261596577f * LOG2E, lds, fake);
        } else if (type == 1) {
            attn_item<1, 64, 64>((const bf16*)(ws + OFF_SQ), 256, (const bf16*)(ws + OFF_SKK), 256, (const bf16*)(ws + OFF_SVT), cumF,
                                 Y + 256, ssy + 4, b, h, qb, 0.125f * LOG2E, lds, fake);
        } else {
            attn_item<0, 64, 64>((const bf16*)(ws + OFF_FQ), 256, (const bf16*)(ws + OFF_FK), 256, (const bf16*)(ws + OFF_FVT), cumF,
                                 Y + 0, ssy + 0, b, h, qb, 0.125f * LOG2E, lds, fake);
        }
    }
}

__device__ __forceinline__ void rowss_flush(float (&part)[2][16], float* gss, int m0, int nt) {
    float* lss = (float*)smem;
    const int tid = opaque_tid(), w = tid >> 6, l = tid & 63, hh = l >> 5, wm = w >> 1, wn = w & 1;
#pragma unroll
    for (int i = 0; i < 2; ++i)
#pragma unroll
        for (int rr = 0; rr < 16; ++rr) {
            float v = part[i][rr];
            v = dpp_add<0xB1>(v); v = dpp_add<0x4E>(v); v = dpp_add<0x141>(v); v = dpp_add<0x140>(v);
            v += __shfl_xor(v, 16);
            if ((l & 31) == 0) lss[wn * 256 + wm * 64 + i * 32 + (rr & 3) + 8 * (rr >> 2) + 4 * hh] = v;
        }
    __syncthreads();
    if (tid < 256) gss[(size_t)(m0 + tid) * 8 + nt] = lss[tid] + lss[256 + tid];
    __syncthreads();
}

__device__ __forceinline__ float sum_fq(float v) {
    float a = v, b = v;
    asm volatile("s_nop 1\n\tv_permlane16_swap_b32 %0, %1\n\ts_nop 1" : "+v"(a), "+v"(b));
    v = a + b; a = v; b = v;
    asm volatile("s_nop 1\n\tv_permlane32_swap_b32 %0, %1\n\ts_nop 1" : "+v"(a), "+v"(b));
    return a + b;
}
__device__ __forceinline__ void residual_fused(const f32x4 (&acc)[2][2][4][2], const pg8::Unit& u, int wr, int wc, int fr, int fqd,
                                               const float* rowscale  , const float* hin, float* hout, bf16* hb_out, float* gss) {
    float* lss = (float*)smem;
#pragma unroll
    for (int ai = 0; ai < 2; ++ai)
#pragma unroll
        for (int m = 0; m < 4; ++m) {
            const int rl = 128 * ai + 64 * wr + 16 * m + fr, row = u.pm * 256 + rl;
            const float sc = rowscale ? rowscale[rl] : 1.f;
#pragma unroll
            for (int bj = 0; bj < 2; ++bj) {
                const int col = u.pn * 256 + 128 * bj + 32 * wc + 8 * fqd;
                const f32x4* hp = (const f32x4*)(hin + (size_t)row * 1024 + col);
                f32x4 v0 = hp[0] + acc[ai][bj][m][0] * sc, v1 = hp[1] + acc[ai][bj][m][1] * sc;
                f32x4* op = (f32x4*)(hout + (size_t)row * 1024 + col);
                op[0] = v0; op[1] = v1;
                u32x4 wv = {pack2(v0[0], v0[1]), pack2(v0[2], v0[3]), pack2(v1[0], v1[1]), pack2(v1[2], v1[3])};
                *(u32x4*)(hb_out + (size_t)row * LDH + col) = wv;
                float ss = (v0[0] * v0[0] + v0[1] * v0[1]) + (v0[2] * v0[2] + v0[3] * v0[3]) + (v1[0] * v1[0] + v1[1] * v1[1]) + (v1[2] * v1[2] + v1[3] * v1[3]);
                ss = sum_fq(ss);
                if (fqd == 0) lss[(wc * 256 + rl) * 2 + bj] = ss;
            }
        }
    __syncthreads();
    const int tid = opaque_tid();
    if (tid < 256) {
        const int row = u.pm * 256 + tid;
#pragma unroll
        for (int bj = 0; bj < 2; ++bj)
            gss[(size_t)row * 8 + u.pn * 2 + bj] = (lss[(0 * 256 + tid) * 2 + bj] + lss[(1 * 256 + tid) * 2 + bj]) + (lss[(2 * 256 + tid) * 2 + bj] + lss[(3 * 256 + tid) * 2 + bj]);
    }
    __syncthreads();
}
struct EpiWo {
    static constexpr bool PERM = true, AFTER_DRAIN = true;
    const float* hin; float* hout; bf16* hb_out; float* gss;
    __device__ __forceinline__ void khook(int t, f32x4 (&acc)[2][2][4][2], int wr, int fr) const {
        if (t == 4 || t == 8) {
            const float* fac = (const float*)(smem + LDS_AUX) + (t == 4 ? 0 : 256);
#pragma unroll
            for (int ai = 0; ai < 2; ++ai)
#pragma unroll
                for (int m = 0; m < 4; ++m) {
                    const float f = fac[128 * ai + 64 * wr + 16 * m + fr];
#pragma unroll
                    for (int bj = 0; bj < 2; ++bj) { acc[ai][bj][m][0] *= f; acc[ai][bj][m][1] *= f; }
                }
        }
    }
    __device__ __forceinline__ void operator()(const f32x4 (&)[2][2][4][2], const pg8::Unit&, int, int, int, int) const {}
    __device__ __forceinline__ void fused(const f32x4 (&acc)[2][2][4][2], const pg8::Unit& u, int wr, int wc, int fr, int fqd, PG8_LAS unsigned char*, int, int) const {
        residual_fused(acc, u, wr, wc, fr, fqd, (const float*)(smem + LDS_AUX) + 512, hin, hout, hb_out, gss);
    }
};
__device__ __forceinline__ void phase_wo(const Params& P, int L, int hsel, int ss_slot) {
    char* ws = opq(P.ws);
    float* ss_out = (float*)(ws + OFF_SSA) + (size_t)ss_slot * TOK * 8;
    bf16* hb_out = (bf16*)(ws + (hsel ? OFF_HB1 : OFF_HB0));
    const float* hin = (L == 0) ? opq(P.x) : (const float*)opq(P.out);
    float* hout = opq(P.out);
    const bf16* Y = (const bf16*)(ws + OFF_Y);
    const bf16* Bt = (const bf16*)(ws + OFF_WO) + (size_t)L * 1024 * LDH;
    const float* ssy = (const float*)(ws + OFF_SSY) + (size_t)L * TOK * 16;
    float* aux = (float*)(smem + LDS_AUX);
    const int tid = opaque_tid();
    pg8::Gemm g{Y, Bt, LDH, LDH, TOK, 1024, 1024};
    pg8::StaticOrder S; S.init(TOK, 1024, gridDim.x, blockIdx.x);
    pg8::Unit u0;
    if (S.next(0, u0) && tid < 256) {
        int row = u0.pm * 256 + tid;
        float4 v0 = *(const float4*)(ssy + (size_t)row * 16), v1 = *(const float4*)(ssy + (size_t)row * 16 + 4), v2 = *(const float4*)(ssy + (size_t)row * 16 + 8);
        float r0 = rsqrtf(((v0.x + v0.y) + (v0.z + v0.w)) * (1.f / 256.f) + EPSF);
        float r1 = rsqrtf(((v1.x + v1.y) + (v1.z + v1.w)) * (1.f / 256.f) + EPSF);
        float r2 = rsqrtf(((v2.x + v2.y) + (v2.z + v2.w)) * (1.f / 512.f) + EPSF);
        aux[tid] = r0 / r1; aux[256 + tid] = r1 / r2; aux[512 + tid] = r2;
    }
    __syncthreads();
    EpiWo E{hin, hout, hb_out, ss_out};
    pg8::gemm_phase((PG8_LAS unsigned char*)smem, g, S, E, nullptr);
    __syncthreads();
}

struct EpiPq {
    static constexpr bool PERM = true, AFTER_DRAIN = false;
    bf16* O; const float* ssrow;
    __device__ __forceinline__ void khook(int, f32x4 (&)[2][2][4][2], int, int) const {}
    __device__ __forceinline__ void operator()(const f32x4 (&acc)[2][2][4][2], const pg8::Unit& u, int wr, int wc, int fr, int fq) const {
        const int row0 = u.pm * 256 + wr * 64 + fr, col0 = u.pn * 256 + wc * 32 + 8 * fq;
#pragma unroll
        for (int ai = 0; ai < 2; ++ai)
#pragma unroll
            for (int m = 0; m < 4; ++m) {
                const int row = row0 + ai * 128 + m * 16;
                const float rs = row_rs8(ssrow, row);
                bf16* rowp = O + (size_t)row * 1024 + col0;
#pragma unroll
                for (int bj = 0; bj < 2; ++bj) {
                    f32x4 v0 = acc[ai][bj][m][0] * rs, v1 = acc[ai][bj][m][1] * rs;
                    u32x4 wv = {pack2(v0[0], v0[1]), pack2(v0[2], v0[3]), pack2(v1[0], v1[1]), pack2(v1[2], v1[3])};
                    *(u32x4*)(rowp + bj * 128) = wv;
                }
            }
    }
};
__device__ __forceinline__ void phase_pq(const Params& P, int L, int hsel, int ss_slot) {
    char* ws = opq(P.ws);
    const float* ssrow = (const float*)(ws + OFF_SSA) + (size_t)ss_slot * TOK * 8;
    const bf16* hb = (const bf16*)(ws + (hsel ? OFF_HB1 : OFF_HB0));
    const bf16* Bt = (const bf16*)(ws + OFF_WQ) + (size_t)L * 1024 * LDH;
    pg8::Gemm g{hb, Bt, LDH, LDH, TOK, 1024, 1024};
    pg8::StaticOrder S; S.init(TOK, 1024, gridDim.x, blockIdx.x);
    EpiPq E{(bf16*)(ws + OFF_PQ), ssrow};
    pg8::gemm_phase((PG8_LAS unsigned char*)smem, g, S, E, nullptr);
    __syncthreads();
}

__device__ __forceinline__ void cswap(int& a, int& b) { int mx = max(a, b), mn = min(a, b); a = mx; b = mn; }
__device__ __forceinline__ void bitonic_sort16(int (&v)[16]) {
#pragma unroll
    for (int k = 2; k <= 16; k <<= 1)
#pragma unroll
        for (int j = k >> 1; j > 0; j >>= 1)
#pragma unroll
            for (int i = 0; i < 16; ++i) {
                int q = i ^ j;
                if (q > i) {
                    if ((i & k) == 0) cswap(v[i], v[q]); else cswap(v[q], v[i]);
                }
            }
}
__device__ __forceinline__ void merge_top16(int (&Lv)[16], const int (&Rv)[16]) {
#pragma unroll
    for (int i = 0; i < 16; ++i) Lv[i] = max(Lv[i], Rv[15 - i]);
#pragma unroll
    for (int j = 8; j > 0; j >>= 1)
#pragma unroll
        for (int i = 0; i < 16; ++i) {
            int q = i ^ j;
            if (q > i) cswap(Lv[i], Lv[q]);
        }
}
__device__ __forceinline__ int f2key(float v, int low, int mask) {
    int b = __float_as_int(v);
    b ^= (b >> 31) & 0x7fffffff;
    return (b & ~mask) | low;
}
__device__ __forceinline__ float key2f(int k, int mask) {
    int b = k & ~mask;
    b ^= (b >> 31) & 0x7fffffff;
    return __int_as_float(b);
}

__device__ __forceinline__ void phase_topk(const Params& P, int L) {
    char* ws = opq(P.ws);
    const bf16* pq = (const bf16*)(ws + OFF_PQ);
    const bf16* skb = (const bf16*)(ws + OFF_SKB) + (size_t)L * 16 * 128 * 64;
    unsigned short* ids = (unsigned short*)(ws + OFF_IDS);
    float* gates = (float*)(ws + OFF_GATE);
    const int tid = opaque_tid(), w = tid >> 6, l = tid & 63, r = l & 31, hh = l >> 5;
    unsigned char* lidx = (unsigned char*)(smem + w * 1024 + r * 32);
    for (int task = blockIdx.x * NW + w; task < (TOK / 32) * 8; task += gridDim.x * NW) {
        const int t0 = (task >> 3) * 32, h = task & 7;
        int F[2][16];
#pragma unroll
        for (int p = 0; p < 2; ++p) {
            const int hp = h * 2 + p;
            f32x16 acc[4];
            const f32x16 z16 = {0.f, 0.f, 0.f, 0.f, 0.f, 0.f, 0.f, 0.f, 0.f, 0.f, 0.f, 0.f, 0.f, 0.f, 0.f, 0.f};
#pragma unroll
            for (int kt = 0; kt < 4; ++kt) acc[kt] = z16;
#pragma unroll
            for (int s4 = 0; s4 < 4; ++s4) {
                bf16x8 bfr = *(const bf16x8*)(pq + (size_t)(t0 + r) * 1024 + hp * 64 + 16 * s4 + 8 * hh);
#pragma unroll
                for (int kt = 0; kt < 4; ++kt) {
                    bf16x8 af = *(const bf16x8*)(skb + ((size_t)hp * 128 + 32 * kt + r) * 64 + 16 * s4 + 8 * hh);
                    acc[kt] = __builtin_amdgcn_mfma_f32_32x32x16_bf16(af, bfr, acc[kt], 0, 0, 0);
                }
            }
            int K0[16], K1[16], K2[16], K3[16];
#pragma unroll
            for (int rr = 0; rr < 16; ++rr) {
                const int nb = (rr & 3) + 8 * (rr >> 2) + 4 * hh;
                K0[rr] = f2key(acc[0][rr], 127 - nb, 127);
                K1[rr] = f2key(acc[1][rr], 127 - (32 + nb), 127);
                K2[rr] = f2key(acc[2][rr], 127 - (64 + nb), 127);
                K3[rr] = f2key(acc[3][rr], 127 - (96 + nb), 127);
            }
            bitonic_sort16(K0); bitonic_sort16(K1); bitonic_sort16(K2); bitonic_sort16(K3);
            merge_top16(K0, K1);
            merge_top16(K2, K3);
            merge_top16(K0, K2);
#pragma unroll
            for (int i = 0; i < 16; ++i) K1[i] = partner32(K0[i], hh);
            merge_top16(K0, K1);
#pragma unroll
            for (int i = 0; i < 16; ++i) F[p][i] = K0[i];
        }
        if (hh == 0) {
#pragma unroll
            for (int q = 0; q < 4; ++q) {
                unsigned w1 = 0, w2 = 0;
#pragma unroll
                for (int e = 0; e < 4; ++e) {
                    w1 |= (unsigned)(127 - (F[0][4 * q + e] & 127)) << (8 * e);
                    w2 |= (unsigned)(127 - (F[1][4 * q + e] & 127)) << (8 * e);
                }
                ((unsigned*)lidx)[q] = w1;
                ((unsigned*)lidx)[4 + q] = w2;
            }
        }
        {
            float s1[16], s2[16];
#pragma unroll
            for (int i = 0; i < 16; ++i) { s1[i] = key2f(F[0][i], 127); s2[i] = key2f(F[1][i], 127); }
            int Lc[16], X[16];
#pragma unroll
            for (int b2 = 0; b2 < 16; ++b2) Lc[b2] = f2key(s1[0] + s2[b2], 255 - b2, 255);
#pragma unroll
            for (int a2 = 1; a2 < 16; ++a2) X[a2 - 1] = f2key(s1[a2] + s2[0], 255 - a2 * 16, 255);
            X[15] = INT_MIN;
            merge_top16(Lc, X);
            X[0] = f2key(s1[1] + s2[1], 255 - 17, 255); X[1] = f2key(s1[1] + s2[2], 255 - 18, 255); X[2] = f2key(s1[1] + s2[3], 255 - 19, 255);
            X[3] = f2key(s1[1] + s2[4], 255 - 20, 255); X[4] = f2key(s1[1] + s2[5], 255 - 21, 255); X[5] = f2key(s1[1] + s2[6], 255 - 22, 255);
            X[6] = f2key(s1[1] + s2[7], 255 - 23, 255);
            X[7] = f2key(s1[2] + s2[1], 255 - 33, 255); X[8] = f2key(s1[2] + s2[2], 255 - 34, 255); X[9] = f2key(s1[2] + s2[3], 255 - 35, 255);
            X[10] = f2key(s1[2] + s2[4], 255 - 36, 255);
            X[11] = f2key(s1[3] + s2[1], 255 - 49, 255); X[12] = f2key(s1[3] + s2[2], 255 - 50, 255); X[13] = f2key(s1[3] + s2[3], 255 - 51, 255);
            X[14] = f2key(s1[4] + s2[1], 255 - 65, 255); X[15] = f2key(s1[4] + s2[2], 255 - 66, 255);
            bitonic_sort16(X);
            merge_top16(Lc, X);
            X[0] = f2key(s1[5] + s2[1], 255 - 81, 255);
            X[1] = f2key(s1[6] + s2[1], 255 - 97, 255);
            X[2] = f2key(s1[7] + s2[1], 255 - 113, 255);
#pragma unroll
            for (int i = 3; i < 16; ++i) X[i] = INT_MIN;
            merge_top16(Lc, X);
            if (hh == 0) {
                float mx = key2f(Lc[0], 255);
                float ev[16], sum = 0.f;
#pragma unroll
                for (int k = 0; k < 16; ++k) { ev[k] = __expf(key2f(Lc[k], 255) - mx); sum += ev[k]; }
                float inv = 1.f / sum;
                size_t ob = (size_t)(t0 + r) * 128 + h * 16;
                unsigned idw[8];
#pragma unroll
                for (int k = 0; k < 16; ++k) {
                    int cidx = 255 - (Lc[k] & 255);
                    int i1 = lidx[cidx >> 4], i2 = lidx[16 + (cidx & 15)];
                    unsigned idv = (unsigned)(i1 * 128 + i2);
                    if (k & 1) idw[k >> 1] |= idv << 16; else idw[k >> 1] = idv;
                }
                u32x4 o0 = {idw[0], idw[1], idw[2], idw[3]}, o1 = {idw[4], idw[5], idw[6], idw[7]};
                *(u32x4*)(ids + ob) = o0;
                *(u32x4*)(ids + ob + 8) = o1;
#pragma unroll
                for (int q = 0; q < 4; ++q) {
                    f32x4 g4 = {ev[4 * q] * inv, ev[4 * q + 1] * inv, ev[4 * q + 2] * inv, ev[4 * q + 3] * inv};
                    *(f32x4*)(gates + ob + 4 * q) = g4;
                }
            }
        }
    }
}

__device__ __forceinline__ float gelu_exact(float x) { return 0.5f * x * (1.f + erff(x * 0.70710678118654752f)); }

__device__ __forceinline__ void dec16(const u32x4& v, float (&f)[16]) {
    f32x2 t;
    t = __builtin_amdgcn_cvt_pk_f32_fp8((int)v.x, false); f[0] = t.x; f[1] = t.y;
    t = __builtin_amdgcn_cvt_pk_f32_fp8((int)v.x, true);  f[2] = t.x; f[3] = t.y;
    t = __builtin_amdgcn_cvt_pk_f32_fp8((int)v.y, false); f[4] = t.x; f[5] = t.y;
    t = __builtin_amdgcn_cvt_pk_f32_fp8((int)v.y, true);  f[6] = t.x; f[7] = t.y;
    t = __builtin_amdgcn_cvt_pk_f32_fp8((int)v.z, false); f[8] = t.x; f[9] = t.y;
    t = __builtin_amdgcn_cvt_pk_f32_fp8((int)v.z, true);  f[10] = t.x; f[11] = t.y;
    t = __builtin_amdgcn_cvt_pk_f32_fp8((int)v.w, false); f[12] = t.x; f[13] = t.y;
    t = __builtin_amdgcn_cvt_pk_f32_fp8((int)v.w, true);  f[14] = t.x; f[15] = t.y;
}

__device__ __forceinline__ void dec32(const u32x4& v, f32x2 (&f)[16]) {
    f[0] = __builtin_amdgcn_cvt_scalef32_pk_f32_fp4(v.x, 1.0f, 0); f[1] = __builtin_amdgcn_cvt_scalef32_pk_f32_fp4(v.x, 1.0f, 1);
    f[2] = __builtin_amdgcn_cvt_scalef32_pk_f32_fp4(v.x, 1.0f, 2); f[3] = __builtin_amdgcn_cvt_scalef32_pk_f32_fp4(v.x, 1.0f, 3);
    f[4] = __builtin_amdgcn_cvt_scalef32_pk_f32_fp4(v.y, 1.0f, 0); f[5] = __builtin_amdgcn_cvt_scalef32_pk_f32_fp4(v.y, 1.0f, 1);
    f[6] = __builtin_amdgcn_cvt_scalef32_pk_f32_fp4(v.y, 1.0f, 2); f[7] = __builtin_amdgcn_cvt_scalef32_pk_f32_fp4(v.y, 1.0f, 3);
    f[8] = __builtin_amdgcn_cvt_scalef32_pk_f32_fp4(v.z, 1.0f, 0); f[9] = __builtin_amdgcn_cvt_scalef32_pk_f32_fp4(v.z, 1.0f, 1);
    f[10] = __builtin_amdgcn_cvt_scalef32_pk_f32_fp4(v.z, 1.0f, 2); f[11] = __builtin_amdgcn_cvt_scalef32_pk_f32_fp4(v.z, 1.0f, 3);
    f[12] = __builtin_amdgcn_cvt_scalef32_pk_f32_fp4(v.w, 1.0f, 0); f[13] = __builtin_amdgcn_cvt_scalef32_pk_f32_fp4(v.w, 1.0f, 1);
    f[14] = __builtin_amdgcn_cvt_scalef32_pk_f32_fp4(v.w, 1.0f, 2); f[15] = __builtin_amdgcn_cvt_scalef32_pk_f32_fp4(v.w, 1.0f, 3);
}

typedef _Float16 f16x2 __attribute__((ext_vector_type(2)));
__device__ __forceinline__ void dec8_f16(unsigned x, f16x2 (&wv)[4]) {
    const unsigned lo = x & 0x07070707u, hi = (x >> 4) & 0x07070707u;
    const unsigned Lb = __builtin_amdgcn_perm(0x46444240u, 0x3E3C3800u, lo) | ((x & 0x08080808u) << 4);
    const unsigned Hb = __builtin_amdgcn_perm(0x46444240u, 0x3E3C3800u, hi) | (x & 0x80808080u);
    wv[0] = __builtin_bit_cast(f16x2, __builtin_amdgcn_perm(Hb, Lb, 0x040c000cu));
    wv[1] = __builtin_bit_cast(f16x2, __builtin_amdgcn_perm(Hb, Lb, 0x050c010cu));
    wv[2] = __builtin_bit_cast(f16x2, __builtin_amdgcn_perm(Hb, Lb, 0x060c020cu));
    wv[3] = __builtin_bit_cast(f16x2, __builtin_amdgcn_perm(Hb, Lb, 0x070c030cu));
}

__device__ __forceinline__ int idof16(const u32x4 (&q)[2], int i) {
    unsigned wv = (i >> 1) == 0 ? q[0].x : (i >> 1) == 1 ? q[0].y : (i >> 1) == 2 ? q[0].z : (i >> 1) == 3 ? q[0].w
                : (i >> 1) == 4 ? q[1].x : (i >> 1) == 5 ? q[1].y : (i >> 1) == 6 ? q[1].z : q[1].w;
    return (i & 1) ? (int)(wv >> 16) : (int)(wv & 0xffffu);
}
__device__ __forceinline__ void phase_gather_u(const Params& P, int L) {
    char* ws = opq(P.ws);
    const unsigned char* U4 = (const unsigned char*)(ws + OFF_UB) + (size_t)L * NEXP * 512;
    float* part = (float*)(ws + OFF_PART);
    const unsigned short* ids = (const unsigned short*)(ws + OFF_IDS);
    const float* hin = opq(P.out);
    const int tid = opaque_tid(), w = tid >> 6, l = tid & 63, c = l & 7, gq = l >> 3;
    const int sl = blockIdx.x & 3, par = (blockIdx.x >> 2) & 1, rk = blockIdx.x >> 3, nb = gridDim.x >> 3;
    if (rk >= nb) return;
    const unsigned char* ubase = U4 + (size_t)sl * NEXP * 128 + c * 16;
    const int stride = nb * NW;
    int ti = rk * NW + w;
    if (ti >= TOK / 2) return;
    u32x4 idA[2], idB[2];
    u32x4 rv[16];
    f32x4 hA[8], hB[8];
    auto load_ids = [&](int tt, u32x4 (&idq)[2]) {
        const u32x4* i4 = (const u32x4*)(ids + (size_t)tt * 128 + 16 * gq);
        idq[0] = i4[0]; idq[1] = i4[1];
    };
    auto load_hx = [&](int tt, f32x4 (&hx)[8]) {
        const f32x4* h4 = (const f32x4*)(hin + (size_t)tt * 1024 + 256 * sl + 32 * c);
#pragma unroll
        for (int q = 0; q < 8; ++q) hx[q] = h4[q];
    };
    auto step = [&](int tcur, int tnext, int tnext2, const u32x4 (&idn)[2], u32x4 (&idl)[2], const f32x4 (&hc)[8], f32x4 (&hn)[8]) {
        load_ids(tnext2, idl);
        load_hx(tnext, hn);
        __builtin_amdgcn_sched_barrier(0);
        float pr[16];
#pragma unroll
        for (int i = 0; i < 16; ++i) {
            f32x2 f[16];
            asm volatile("" : "+v"(rv[i].x), "+v"(rv[i].y), "+v"(rv[i].z), "+v"(rv[i].w));
            dec32(rv[i], f);
            rv[i] = *(const u32x4*)(ubase + (size_t)idof16(idn, i) * 128);
            __builtin_amdgcn_sched_barrier(0);
            f32x2 s2 = {0.f, 0.f};
#pragma unroll
            for (int q = 0; q < 8; ++q) {
                f32x2 x0 = {hc[q].x, hc[q].y}, x1 = {hc[q].z, hc[q].w};
                s2 = __builtin_elementwise_fma(f[2 * q], x0, s2);
                s2 = __builtin_elementwise_fma(f[2 * q + 1], x1, s2);
            }
            float sacc = s2.x + s2.y;
            asm volatile("" : "+v"(sacc));
            pr[i] = sacc;
        }
#pragma unroll
        for (int i = 0; i < 16; ++i) pr[i] = sum8_dpp(pr[i]);
        if (c == 0) {
            f32x4* o4 = (f32x4*)(part + ((size_t)sl * TOK + tcur) * 128 + 16 * gq);
#pragma unroll
            for (int q = 0; q < 4; ++q) { f32x4 o = {pr[4 * q], pr[4 * q + 1], pr[4 * q + 2], pr[4 * q + 3]}; o4[q] = o; }
        }
    };
    auto tok = [&](int tidx, int fb) { return 2 * (tidx < TOK / 2 ? tidx : fb) + par; };
    load_ids(tok(ti, ti), idA);
#pragma unroll
    for (int i = 0; i < 16; ++i) rv[i] = *(const u32x4*)(ubase + (size_t)idof16(idA, i) * 128);
    load_hx(tok(ti, ti), hA);
    load_ids(tok(ti + stride, ti), idB);
    for (;;) {
        int tn = ti + stride, tn2 = ti + 2 * stride;
        step(tok(ti, ti), tok(tn, ti), tok(tn2, ti), idB, idA, hA, hB);
        if (tn >= TOK / 2) break;
        ti = tn; tn = ti + stride; tn2 = ti + 2 * stride;
        step(tok(ti, ti), tok(tn, ti), tok(tn2, ti), idA, idB, hB, hA);
        if (tn >= TOK / 2) break;
        ti = tn;
    }
}

__device__ __forceinline__ void phase_gather_act(const Params& P, int L, int ss_slot) {
    char* ws = opq(P.ws);
    const float* ss_ffn = (const float*)(ws + OFF_SSA) + (size_t)ss_slot * TOK * 8;
    const float* part = (const float*)(ws + OFF_PART);
    const unsigned short* ids = (const unsigned short*)(ws + OFF_IDS);
    float* gates = (float*)(ws + OFF_GATE);
    const float* uinv = (const float*)(ws + OFF_TSC) + L * NEXP;
    const float* vinv = (const float*)(ws + OFF_TSC) + (2 + L) * NEXP;
    const int tid = opaque_tid(), w = tid >> 6, l = tid & 63;
    for (int t = blockIdx.x * NW + w; t < TOK; t += gridDim.x * NW) {
        float rs = row_rs8(ss_ffn, t);
#pragma unroll
        for (int hsel = 0; hsel < 2; ++hsel) {
            int k = l + 64 * hsel;
            float sacc = 0.f;
#pragma unroll
            for (int j = 0; j < 4; ++j) sacc += part[((size_t)j * TOK + t) * 128 + k];
            int id = ids[(size_t)t * 128 + k];
            float pre = sacc * rs * uinv[id];
            gates[(size_t)t * 128 + k] = gates[(size_t)t * 128 + k] * gelu_exact(pre) * vinv[id];
        }
    }
}

__device__ __forceinline__ void phase_gather_v(const Params& P, int L, int hsel, int ss_slot) {
    char* ws = opq(P.ws);
    float* ss_ple = (float*)(ws + OFF_SSA) + (size_t)ss_slot * TOK * 8;
    bf16* hb_out = (bf16*)(ws + (hsel ? OFF_HB1 : OFF_HB0));
    const unsigned char* V4 = (const unsigned char*)(ws + OFF_VB) + (size_t)L * NEXP * 512;
    const unsigned short* ids = (const unsigned short*)(ws + OFF_IDS);
    const float* act = (const float*)(ws + OFF_GATE);
    float* hio = opq(P.out);
    const int tid = opaque_tid(), w = tid >> 6, l = tid & 63, c = l & 7, gq = l >> 3;
    const int sl = blockIdx.x & 3, par = (blockIdx.x >> 2) & 1, rk = blockIdx.x >> 3, nb = gridDim.x >> 3;
    if (rk >= nb) return;
    const unsigned char* vbase = V4 + (size_t)sl * NEXP * 128 + c * 16;
    const int stride = nb * NW;
    int ti = rk * NW + w;
    if (ti >= TOK / 2) return;
    const bool b3 = (l >> 3) & 1;
    u32x4 idA[2], idB[2];
    u32x4 rv[16];
    f32x4 aA[4], aB[4];
    auto load_ids = [&](int tt, u32x4 (&idq)[2]) {
        const u32x4* i4 = (const u32x4*)(ids + (size_t)tt * 128 + 16 * gq);
        idq[0] = i4[0]; idq[1] = i4[1];
    };
    auto load_a = [&](int tt, f32x4 (&ax)[4]) {
        const f32x4* a4 = (const f32x4*)(act + (size_t)tt * 128 + 16 * gq);
#pragma unroll
        for (int q = 0; q < 4; ++q) ax[q] = a4[q];
    };
    auto step = [&](int tcur, int tnext, int tnext2, const u32x4 (&idn)[2], u32x4 (&idl)[2], const f32x4 (&ac)[4], f32x4 (&an)[4]) {
        load_ids(tnext2, idl);
        load_a(tnext, an);
        __builtin_amdgcn_sched_barrier(0);
        f32x2 acc[16];
#pragma unroll
        for (int e = 0; e < 16; ++e) { acc[e].x = 0.f; acc[e].y = 0.f; }
#pragma unroll
        for (int i = 0; i < 16; ++i) {
            f32x2 f[16];
            asm volatile("" : "+v"(rv[i].x), "+v"(rv[i].y), "+v"(rv[i].z), "+v"(rv[i].w));
            dec32(rv[i], f);
            rv[i] = *(const u32x4*)(vbase + (size_t)idof16(idn, i) * 128);
            __builtin_amdgcn_sched_barrier(0);
            const float a = (i & 3) == 0 ? ac[i >> 2].x : (i & 3) == 1 ? ac[i >> 2].y : (i & 3) == 2 ? ac[i >> 2].z : ac[i >> 2].w;
            const f32x2 a2 = {a, a};
#pragma unroll
            for (int e = 0; e < 16; ++e) acc[e] = __builtin_elementwise_fma(f[e], a2, acc[e]);
#pragma unroll
            for (int e = 0; e < 16; ++e) asm volatile("" : "+v"(acc[e]));
        }
        float v8[8][2];
#pragma unroll
        for (int e = 0; e < 8; ++e) {
            float k0 = b3 ? acc[8 + e].x : acc[e].x, k1 = b3 ? acc[8 + e].y : acc[e].y;
            float s0 = b3 ? acc[e].x : acc[8 + e].x, s1 = b3 ? acc[e].y : acc[8 + e].y;
            v8[e][0] = k0 + __builtin_bit_cast(float, __builtin_amdgcn_update_dpp(0, __builtin_bit_cast(int, s0), 0x128, 0xf, 0xf, true));
            v8[e][1] = k1 + __builtin_bit_cast(float, __builtin_amdgcn_update_dpp(0, __builtin_bit_cast(int, s1), 0x128, 0xf, 0xf, true));
        }
        float v4[8];
#pragma unroll
        for (int e = 0; e < 8; ++e) {
            float X = v8[e >> 1][e & 1], Y = v8[4 + (e >> 1)][e & 1];
            asm volatile("s_nop 1\n\tv_permlane16_swap_b32 %0, %1\n\ts_nop 1" : "+v"(X), "+v"(Y));
            v4[e] = X + Y;
        }
        float v2[4];
#pragma unroll
        for (int e = 0; e < 4; ++e) {
            float X = v4[e], Y = v4[4 + e];
            asm volatile("s_nop 1\n\tv_permlane32_swap_b32 %0, %1\n\ts_nop 1" : "+v"(X), "+v"(Y));
            v2[e] = X + Y;
        }
        const int col = 256 * sl + 32 * c + 16 * ((l >> 3) & 1) + 8 * ((l >> 4) & 1) + 4 * (l >> 5);
        f32x4* h4 = (f32x4*)(hio + (size_t)tcur * 1024 + col);
        f32x4 hv = *h4;
        hv.x += v2[0]; hv.y += v2[1]; hv.z += v2[2]; hv.w += v2[3];
        *h4 = hv;
        u32x2 bb = {pack2(hv.x, hv.y), pack2(hv.z, hv.w)};
        *(u32x2*)(hb_out + (size_t)tcur * LDH + col) = bb;
        float ssq = hv.x * hv.x + hv.y * hv.y + hv.z * hv.z + hv.w * hv.w;
        ssq = wave_sum(ssq);
        if (l == 0) { ss_ple[(size_t)tcur * 8 + sl] = ssq; ss_ple[(size_t)tcur * 8 + 4 + sl] = 0.f; }
    };
    auto tok = [&](int tidx, int fb) { return 2 * (tidx < TOK / 2 ? tidx : fb) + par; };
    load_ids(tok(ti, ti), idA);
#pragma unroll
    for (int i = 0; i < 16; ++i) rv[i] = *(const u32x4*)(vbase + (size_t)idof16(idA, i) * 128);
    load_a(tok(ti, ti), aA);
    load_ids(tok(ti + stride, ti), idB);
    for (;;) {
        int tn = ti + stride, tn2 = ti + 2 * stride;
        step(tok(ti, ti), tok(tn, ti), tok(tn2, ti), idB, idA, aA, aB);
        if (tn >= TOK / 2) break;
        ti = tn; tn = ti + stride; tn2 = ti + 2 * stride;
        step(tok(ti, ti), tok(tn, ti), tok(tn2, ti), idA, idB, aB, aA);
        if (tn >= TOK / 2) break;
        ti = tn;
    }
}

__device__ __forceinline__ void phase_ple(const Params& P, int L, int hsel, int ss_slot_in, int ss_slot_out) {
    char* ws = opq(P.ws);
    const float* ss_ple = (const float*)(ws + OFF_SSA) + (size_t)ss_slot_in * TOK * 8;
    float* ss_out = (float*)(ws + OFF_SSA) + (size_t)ss_slot_out * TOK * 8;
    const bf16* hb_in = (const bf16*)(ws + (hsel ? OFF_HB1 : OFF_HB0));
    bf16* hb_out = (bf16*)(ws + (hsel ? OFF_HB0 : OFF_HB1));
    float* hio = opq(P.out);
    const bf16* pin = (const bf16*)(ws + OFF_PB) + (size_t)L * TOK * LDP;
    const bf16* Wg = (const bf16*)(ws + OFF_WG) + (size_t)L * 1024 * LDH;
    const bf16* Wp = (const bf16*)(ws + OFF_WP) + (size_t)L * 1024 * LDP;
    const int tid = opaque_tid(), w = tid >> 6, l = tid & 63, hh = l >> 5, wm = w >> 1, wn = w & 1;
    for (int it = 0;; ++it) {
        int mt, nt;
        if (!xcd_tile(it, 64, 8, mt, nt)) break;
        int m0 = mt * 256, n0 = nt * 128;
        float* aux = (float*)(smem + LDS_AUX);
        __syncthreads();
        if (tid < 256) aux[tid] = row_rs8(ss_ple, m0 + tid);
        f32x16 acc1[2][2], acc2[2][2];
        ZERO_ACC(acc1);
        ZERO_ACC(acc2);
        gemm_core(acc1, hb_in, LDH, Wg, LDH, 1024, m0, n0, NoHook());
        gemm_core(acc2, pin, LDP, Wp, LDP, 256, m0, n0, NoHook());
#pragma unroll
        for (int i = 0; i < 2; ++i)
#pragma unroll
            for (int rr = 0; rr < 16; ++rr) {
                float rs = aux[wm * 64 + i * 32 + (rr & 3) + 8 * (rr >> 2) + 4 * hh];
#pragma unroll
                for (int j = 0; j < 2; ++j) {
                    float gte = 1.f / (1.f + __expf(-acc1[i][j][rr] * rs));
                    acc2[i][j][rr] *= gte;
                }
            }
        stage_f32<false>(acc2, nullptr);
        residual_store(hio, hio, hb_out, ss_out, m0, n0, nt);
    }
}

__device__ __forceinline__ void phase_final(const Params& P, int ss_slot) {
    float* hio = opq(P.out);
    const float* ss = (const float*)(opq(P.ws) + OFF_SSA) + (size_t)ss_slot * TOK * 8;
    const int tid = opaque_tid(), w = tid >> 6, l = tid & 63;
    const float4* g4 = (const float4*)P.final_norm_g;
    for (int t = blockIdx.x * NW + w; t < TOK; t += gridDim.x * NW) {
        float rs = row_rs8(ss, t);
        float4* o4 = (float4*)(hio + (size_t)t * 1024);
#pragma unroll
        for (int i = 0; i < 4; ++i) {
            float4 v = o4[i * 64 + l], g = g4[i * 64 + l];
            v.x *= rs * g.x; v.y *= rs * g.y; v.z *= rs * g.z; v.w *= rs * g.w;
            o4[i * 64 + l] = v;
        }
    }
}

#define XB_TMO      128
#define XB_XCNT(j)  (256  + 64 * (j))
#define XB_XSUB(j)  (1280 + 64 * (j))
#define XB_XGEN(j)  (2304 + 64 * (j))
#define XB_TOP      3328
#define XB_TOPGEN   3392
#define XCD_BAR_WORDS 3456
#define XB_SPIN_CAP (1u << 22)
__device__ __forceinline__ unsigned xb_ld(unsigned* p) { return __hip_atomic_load(p, __ATOMIC_RELAXED, __HIP_MEMORY_SCOPE_AGENT); }
__device__ __forceinline__ unsigned xb_add(unsigned* p, unsigned v) { return __hip_atomic_fetch_add(p, v, __ATOMIC_RELAXED, __HIP_MEMORY_SCOPE_AGENT); }
__device__ __forceinline__ unsigned xb_xcc_id() { return (unsigned)__builtin_amdgcn_s_getreg((3 << 11) | 20) & 0xFu; }
#define XB_SPIN(cond, bar) do { unsigned _sp = 0; while (cond) { __builtin_amdgcn_s_sleep(1); \
    if ((++_sp & 255u) == 0u) { if (xb_ld(&(bar)[XB_TMO])) break; if (_sp > XB_SPIN_CAP) { atomicAdd(&(bar)[XB_TMO], 1u); break; } } } } while (0)
#define XB_LDS_OFF (LDS_BYTES - 64)
__device__ __forceinline__ void xcd_barrier_post(const Params& P) {
    if (threadIdx.x == 0) {
        unsigned* bar = (unsigned*)(P.ws + OFF_BAR);
        volatile __attribute__((address_space(3))) unsigned* st = (volatile __attribute__((address_space(3))) unsigned*)(smem + XB_LDS_OFF);
        st[0] = 0u; st[1] = 0u;
        (void)xb_add(&bar[XB_XCNT(xb_xcc_id())], 1u);
    }
}
__device__ __forceinline__ void xcd_barrier_complete(unsigned* bar, unsigned x, unsigned& nloc, unsigned& nx) {
    const unsigned G = gridDim.x;
    unsigned sum, cnt, mine, sp = 0u;
    for (;;) {
        sum = 0u; cnt = 0u; mine = 0u;
#pragma unroll
        for (unsigned j = 0; j < 16; ++j) { const unsigned c = xb_ld(&bar[XB_XCNT(j)]); sum += c; cnt += (c > 0u) ? 1u : 0u; mine = (j == x) ? c : mine; }
        if (sum == G) break;
        __builtin_amdgcn_s_sleep(1);
        if ((++sp & 255u) == 0u) { if (xb_ld(&bar[XB_TMO])) break; if (sp > XB_SPIN_CAP) { atomicAdd(&bar[XB_TMO], 1u); break; } }
    }
    nloc = mine > 0u ? mine : 1u; nx = cnt > 0u ? cnt : 1u;
}
__device__ __forceinline__ void grid_barrier(const Params& P) {
    asm volatile("s_waitcnt vmcnt(0)" ::: "memory");
    __syncthreads();
    if (threadIdx.x == 0) {
        unsigned* bar = (unsigned*)(P.ws + OFF_BAR);
        volatile __attribute__((address_space(3))) unsigned* st = (volatile __attribute__((address_space(3))) unsigned*)(smem + XB_LDS_OFF);
        const unsigned x = xb_xcc_id();
        __builtin_amdgcn_s_waitcnt(0);
        unsigned nloc = st[0], nx = st[1];
        if (nloc == 0u) { xcd_barrier_complete(bar, x, nloc, nx); st[0] = nloc; st[1] = nx; }
        const unsigned old = xb_add(&bar[XB_XSUB(x)], 1u);
        const unsigned gen = old / nloc;
        if (old + 1u == (gen + 1u) * nloc) {
            __builtin_amdgcn_fence(__ATOMIC_RELEASE, "agent");
            asm volatile("s_waitcnt vmcnt(0)" ::: "memory");
            const unsigned og = xb_add(&bar[XB_TOP], 1u);
            const unsigned tg = og / nx;
            if (og + 1u == (tg + 1u) * nx) xb_add(&bar[XB_TOPGEN], 1u);
            else XB_SPIN(xb_ld(&bar[XB_TOPGEN]) == tg, bar);
            __builtin_amdgcn_fence(__ATOMIC_ACQUIRE, "agent");
            xb_add(&bar[XB_XGEN(x)], 1u);
            asm volatile("s_waitcnt vmcnt(0)" ::: "memory");
        } else {
            XB_SPIN(xb_ld(&bar[XB_XGEN(x)]) == gen, bar);
            __builtin_amdgcn_fence(__ATOMIC_ACQUIRE, "agent");
            asm volatile("s_waitcnt vmcnt(0)" ::: "memory");
        }
    }
    __syncthreads();
}

__global__ void __launch_bounds__(NTHR, 2) hymba_megakernel(Params P) {
    cg::grid_group grid = cg::this_grid();
    char* ws = opq(P.ws);
    xcd_barrier_post(P);
#define BAR() do { grid_barrier(P); if (DUP == 20) grid_barrier(P); } while (0)
    phase0(P);
    if (DUP == 0) { asm volatile("s_waitcnt vmcnt(0)" ::: "memory"); __syncthreads(); grid_barrier(P); phase0(P); }
    asm volatile("s_waitcnt vmcnt(0)" ::: "memory");
    __syncthreads();
    grid.sync();
    BAR();
    int cur = 0;
    for (int L = 0; L < 2; ++L) {
        const int ss_mix = (L == 0) ? 0 : 3, ss_ffn = 1 + L, ss_next = (L == 0) ? 3 : 4, ss_ple = 5 + L;
        phase_proj(P, L, cur, ss_mix);
        BAR();
        if (DUP == 1) { phase_proj(P, L, cur, ss_mix); BAR(); }
        phase_mla_up(P, L);
        BAR();
        if (DUP == 2) { phase_mla_up(P, L); BAR(); }
        phase_attn(P, L, 0);
        BAR();
        if (DUP == 3) { phase_attn(P, L, 1); BAR(); }
        if (DUP >= 30 && DUP < 34) { phase_attn(P, L, 1, DUP - 30); BAR(); }
        phase_wo(P, L, cur ^ 1, ss_ffn);
        BAR();
        if (DUP == 4 && L == 0) { phase_wo(P, L, cur ^ 1, ss_ffn); BAR(); }
        phase_pq(P, L, cur ^ 1, ss_ffn);
        BAR();
        if (DUP == 5) { phase_pq(P, L, cur ^ 1, ss_ffn); BAR(); }
        phase_topk(P, L);
        BAR();
        if (DUP == 6) { phase_topk(P, L); BAR(); }
        phase_gather_u(P, L);
        BAR();
        if (DUP == 7) { phase_gather_u(P, L); BAR(); }
        phase_gather_act(P, L, ss_ffn);
        BAR();
        phase_gather_v(P, L, cur, ss_ple);
        BAR();
        phase_ple(P, L, cur, ss_ple, ss_next);
        BAR();
        cur ^= 1;
    }
    phase_final(P, 4);
}

extern "C" void kernel_launch(void* const* d_in, const int* in_sizes, int n_in, void* d_out, int out_size, void* d_ws,
                              size_t ws_size, hipStream_t stream) {
    static int grid_blocks = 0;
    if (!grid_blocks) {
        int dev = 0, cus = 0, per_cu = 0;
        hipGetDevice(&dev);
        hipDeviceGetAttribute(&cus, hipDeviceAttributeMultiprocessorCount, dev);
        hipOccupancyMaxActiveBlocksPerMultiprocessor(&per_cu, hymba_megakernel, NTHR, 0);
        if (per_cu > 1) per_cu = 1;
        if (per_cu < 1) per_cu = 1;
        grid_blocks = cus * per_cu;
        if (ws_size < WS_END) fprintf(stderr, "workspace too small: %zu < %zu\n", ws_size, (size_t)WS_END);
    }
    Params P{};
    P.x = (const float*)d_in[0]; P.p = (const float*)d_in[1]; P.pos = (const int*)d_in[2];
    P.norm_mix_g = (const float*)d_in[3]; P.w_in = (const float*)d_in[4]; P.b_forget = (const float*)d_in[5];
    P.mla_q_norm_g = (const float*)d_in[6]; P.w_uq = (const float*)d_in[7]; P.mla_kv_norm_g = (const float*)d_in[8];
    P.w_ukv = (const float*)d_in[9]; P.mix_out_norm_g = (const float*)d_in[10]; P.w_o = (const float*)d_in[11];
    P.norm_ffn_g = (const float*)d_in[12]; P.w_query = (const float*)d_in[13]; P.sub_keys = (const float*)d_in[14];
    P.peer_u = (const float*)d_in[15]; P.peer_v = (const float*)d_in[16]; P.w_ple = (const float*)d_in[17];
    P.ple_norm_g = (const float*)d_in[18]; P.w_ple_gate = (const float*)d_in[19]; P.final_norm_g = (const float*)d_in[20];
    P.out = (float*)d_out; P.ws = (char*)d_ws;
    hipMemsetAsync((char*)d_ws + OFF_BAR, 0, 16384 + 4096, stream);
    void* args[] = {&P};
    hipError_t e = hipLaunchCooperativeKernel((void*)hymba_megakernel, dim3(grid_blocks), dim3(NTHR), args, 0, stream);
    if (e != hipSuccess) fprintf(stderr, "cooperative launch failed: %s (grid %d)\n", hipGetErrorString(e), grid_blocks);
}
```

```cpp
#include <hip/hip_runtime.h>
#include <hip/hip_cooperative_groups.h>
#include <cstdio>
#include <cstdint>
#include <math.h>
#include <climits>
namespace cg = cooperative_groups;

typedef __bf16 bf16;
typedef __bf16 bf16x8 __attribute__((ext_vector_type(8)));
typedef __bf16 bf16x4 __attribute__((ext_vector_type(4)));
typedef __bf16 bf16x2 __attribute__((ext_vector_type(2)));
typedef float f32x16 __attribute__((ext_vector_type(16)));
typedef float f32x4 __attribute__((ext_vector_type(4)));
typedef float f32x2 __attribute__((ext_vector_type(2)));
typedef unsigned u32x4 __attribute__((ext_vector_type(4)));
typedef unsigned u32x2 __attribute__((ext_vector_type(2)));

#define SEQ 2048
#define BATCH 8
#define TOK 16384
#define DM 1024
#define IN_W 1956
#define NEXP 16384
#define EPSF 1e-6f
#define LOG2E 1.4426950408889634f
#define NTHR 512
#define NW 8
#define LDS_BYTES 151808
#define STAGE_BYTES 49152
#define LDS_AUX 147456
#ifndef DUP
#define DUP -1
#endif

constexpr size_t MBy = 1ull << 20;
constexpr size_t OFF_UB = 0;
constexpr size_t OFF_VB = 32 * MBy;
constexpr size_t OFF_PART = 64 * MBy;
#define LDH 1088
#define LDP 320
#define LDC 192
constexpr size_t OFF_WIN = 128 * MBy;
constexpr size_t OFF_WO = 137 * MBy;
constexpr size_t OFF_WQ = 142 * MBy;
constexpr size_t OFF_WG = 147 * MBy;
constexpr size_t OFF_WP = 152 * MBy;
constexpr size_t OFF_WUQ = 154 * MBy;
constexpr size_t OFF_WUKV = 155 * MBy;
constexpr size_t OFF_SKB = 156 * MBy;
constexpr size_t OFF_CS = 157 * MBy;
constexpr size_t OFF_TSC = 159 * MBy;
constexpr size_t OFF_SSA = 160 * MBy;
constexpr size_t OFF_HB0 = 164 * MBy;
constexpr size_t OFF_HB1 = 200 * MBy;
constexpr size_t OFF_FQ = 236 * MBy;
constexpr size_t OFF_FK = 244 * MBy;
constexpr size_t OFF_FVT = 252 * MBy;
constexpr size_t OFF_SQ = 260 * MBy;
constexpr size_t OFF_SKK = 268 * MBy;
constexpr size_t OFF_SVT = 276 * MBy;
constexpr size_t OFF_CQ = 284 * MBy;
constexpr size_t OFF_CKV = 295 * MBy;
constexpr size_t OFF_FLOG = 302 * MBy;
constexpr size_t OFF_CUMF = 303 * MBy;
constexpr size_t OFF_MQ = 304 * MBy;
constexpr size_t OFF_MK = 316 * MBy;
constexpr size_t OFF_MVT = 328 * MBy;
constexpr size_t OFF_Y = 344 * MBy;
constexpr size_t OFF_PQ = 380 * MBy;
constexpr size_t OFF_IDS = 412 * MBy;
constexpr size_t OFF_GATE = 420 * MBy;
constexpr size_t OFF_BAR = 428 * MBy;
constexpr size_t OFF_CNT = OFF_BAR + 16384;
constexpr size_t OFF_SSY = 429 * MBy;
constexpr size_t OFF_PB = 431 * MBy;
constexpr size_t WS_END = 452 * MBy;

struct Params {
    const float* x; const float* p; const int* pos;
    const float* norm_mix_g; const float* w_in; const float* b_forget; const float* mla_q_norm_g; const float* w_uq;
    const float* mla_kv_norm_g; const float* w_ukv; const float* mix_out_norm_g; const float* w_o; const float* norm_ffn_g;
    const float* w_query; const float* sub_keys; const float* peer_u; const float* peer_v; const float* w_ple;
    const float* ple_norm_g; const float* w_ple_gate; const float* final_norm_g;
    float* out; char* ws;
};

__shared__ __attribute__((aligned(16))) char smem[LDS_BYTES];

__device__ __forceinline__ int opaque_tid() { int t = threadIdx.x; asm volatile("" : "+v"(t)); return t; }
template <typename T> __device__ __forceinline__ T* opq(T* p) { size_t z = 0; asm volatile("" : "+s"(z)); return (T*)((char*)p + z); }

__device__ __forceinline__ unsigned pack2(float a, float b) {
    f32x2 v = {a, b};
    bf16x2 r = __builtin_convertvector(v, bf16x2);
    return __builtin_bit_cast(unsigned, r);
}
__device__ __forceinline__ float bflo(unsigned u) { return __uint_as_float(u << 16); }
__device__ __forceinline__ float bfhi(unsigned u) { return __uint_as_float(u & 0xffff0000u); }
__device__ __forceinline__ float wave_sum(float v) {
#pragma unroll
    for (int o = 32; o > 0; o >>= 1) v += __shfl_xor(v, o);
    return v;
}
template <int CTRL> __device__ __forceinline__ float dpp_add(float v) {
    return v + __builtin_bit_cast(float, __builtin_amdgcn_update_dpp(0, __builtin_bit_cast(int, v), CTRL, 0xf, 0xf, true));
}
__device__ __forceinline__ float sum8_dpp(float v) { v = dpp_add<0xB1>(v); v = dpp_add<0x4E>(v); v = dpp_add<0x141>(v); return v; }
__device__ __forceinline__ float sumg_dpp(float v) {
    v = dpp_add<0x128>(v);
    float a = v, b = v;
    asm volatile("s_nop 1\n\tv_permlane16_swap_b32 %0, %1\n\ts_nop 1" : "+v"(a), "+v"(b));
    v = a + b;
    a = v; b = v;
    asm volatile("s_nop 1\n\tv_permlane32_swap_b32 %0, %1\n\ts_nop 1" : "+v"(a), "+v"(b));
    return a + b;
}
__device__ __forceinline__ int partner32(int v, int hh) {
    int a = v, b = v;
    asm volatile("s_nop 1\n\tv_permlane32_swap_b32 %0, %1\n\ts_nop 1" : "+v"(a), "+v"(b));
    return hh ? a : b;
}
__device__ __forceinline__ float fexp2(float x) { return __builtin_amdgcn_exp2f(x); }
__device__ __forceinline__ float flog2(float x) { return __builtin_amdgcn_logf(x); }
__device__ __forceinline__ float log_sigmoid_f(float z) { return fminf(z, 0.f) - 0.6931471805599453f * flog2(1.f + fexp2(-1.4426950408889634f * fabsf(z))); }

struct WJob { const float* src; int lds; int K; int Np; bf16* dst; int ldd; const float* gain; int map; };

__device__ __forceinline__ int src_col_map(int map, int c) {
    if (map == 0) return c;
    if (map == 1) {
        if (c < 768) return c;
        if (c < 1952) return c + 4;
        if (c < 1956) return c - 1952 + 768;
        return -1;
    }
    if (c < 256) return 192 * (c >> 6) + (c & 63);
    int e = c - 256;
    return 192 * (e >> 7) + 64 + (e & 127);
}

__device__ __forceinline__ void wconv_tile(const WJob& j, int tile) {
    float* tl = (float*)smem;
    int ktiles = j.K >> 5;
    int nt = tile / ktiles, kt = tile % ktiles;
    int n0 = nt * 32, k0 = kt * 32;
    int tx = opaque_tid() & 31, ty = opaque_tid() >> 5;
    int sc = src_col_map(j.map, n0 + tx);
#pragma unroll
    for (int i = 0; i < 2; ++i) {
        int k = k0 + ty + 16 * i;
        float v = 0.f;
        if (sc >= 0) v = j.src[(size_t)k * j.lds + sc] * (j.gain ? j.gain[k] : 1.f);
        tl[(ty + 16 * i) * 33 + tx] = v;
    }
    __syncthreads();
#pragma unroll
    for (int i = 0; i < 2; ++i) {
        int n = n0 + ty + 16 * i;
        j.dst[(size_t)n * j.ldd + k0 + tx] = (bf16)tl[tx * 33 + ty + 16 * i];
    }
    __syncthreads();
}

__device__ __forceinline__ void phase0(const Params& P) {
    char* ws = opq(P.ws);
    const int G = gridDim.x, bid = blockIdx.x, tid = opaque_tid();
    {
        const int w = tid >> 6, l = tid & 63;
        float* tsc = (float*)(ws + OFF_TSC);
        for (int it = bid * NW + w; it < 4 * NEXP; it += G * NW) {
            int tb = it >> 14, e = it & (NEXP - 1);
            const float* src = (tb < 2 ? P.peer_u : P.peer_v) + ((size_t)(tb & 1) * NEXP + e) * DM + l * 16;
            unsigned char* dst = (unsigned char*)(ws + (tb < 2 ? OFF_UB : OFF_VB)) + (size_t)(tb & 1) * NEXP * 512;
            float4 a = ((const float4*)src)[0], b = ((const float4*)src)[1], c = ((const float4*)src)[2], d = ((const float4*)src)[3];
            if (tb < 2) {
                const float4* g4 = (const float4*)(P.norm_ffn_g + (tb & 1) * 1024 + l * 16);
                float4 g0 = g4[0], g1 = g4[1], g2 = g4[2], g3 = g4[3];
                a.x *= g0.x; a.y *= g0.y; a.z *= g0.z; a.w *= g0.w; b.x *= g1.x; b.y *= g1.y; b.z *= g1.z; b.w *= g1.w;
                c.x *= g2.x; c.y *= g2.y; c.z *= g2.z; c.w *= g2.w; d.x *= g3.x; d.y *= g3.y; d.z *= g3.z; d.w *= g3.w;
            }
            float am = fmaxf(fmaxf(fmaxf(fabsf(a.x), fabsf(a.y)), fmaxf(fabsf(a.z), fabsf(a.w))), fmaxf(fmaxf(fabsf(b.x), fabsf(b.y)), fmaxf(fabsf(b.z), fabsf(b.w))));
            am = fmaxf(am, fmaxf(fmaxf(fmaxf(fabsf(c.x), fabsf(c.y)), fmaxf(fabsf(c.z), fabsf(c.w))), fmaxf(fmaxf(fabsf(d.x), fabsf(d.y)), fmaxf(fabsf(d.z), fabsf(d.w)))));
#pragma unroll
            for (int o = 32; o > 0; o >>= 1) am = fmaxf(am, __shfl_xor(am, o));
            float sc = (am > 0.f) ? (6.0f / am) : 1.f, isc = (am > 0.f) ? (am * (1.f / 6.0f)) : 1.f;
            unsigned w0 = 0, w1 = 0;
            w0 = __builtin_amdgcn_cvt_scalef32_pk_fp4_f32(w0, a.x * sc, a.y * sc, 1.0f, 0);
            w0 = __builtin_amdgcn_cvt_scalef32_pk_fp4_f32(w0, a.z * sc, a.w * sc, 1.0f, 1);
            w0 = __builtin_amdgcn_cvt_scalef32_pk_fp4_f32(w0, b.x * sc, b.y * sc, 1.0f, 2);
            w0 = __builtin_amdgcn_cvt_scalef32_pk_fp4_f32(w0, b.z * sc, b.w * sc, 1.0f, 3);
            w1 = __builtin_amdgcn_cvt_scalef32_pk_fp4_f32(w1, c.x * sc, c.y * sc, 1.0f, 0);
            w1 = __builtin_amdgcn_cvt_scalef32_pk_fp4_f32(w1, c.z * sc, c.w * sc, 1.0f, 1);
            w1 = __builtin_amdgcn_cvt_scalef32_pk_fp4_f32(w1, d.x * sc, d.y * sc, 1.0f, 2);
            w1 = __builtin_amdgcn_cvt_scalef32_pk_fp4_f32(w1, d.z * sc, d.w * sc, 1.0f, 3);
            u32x2 o2 = {w0, w1};
            *(u32x2*)(dst + ((size_t)(l >> 4) * NEXP + e) * 128 + (l & 15) * 8) = o2;
            if (l == 0) tsc[tb * NEXP + e] = isc;
        }
    }
    {
        for (int L = 0; L < 2; ++L) {
            WJob jobs[7];
            jobs[0] = {P.w_in + (size_t)L * 1024 * IN_W, IN_W, 1024, 2048, (bf16*)(ws + OFF_WIN) + (size_t)L * 2048 * LDH, LDH, P.norm_mix_g + L * 1024, 1};
            jobs[1] = {P.w_o + (size_t)L * 1024 * 1024, 1024, 1024, 1024, (bf16*)(ws + OFF_WO) + (size_t)L * 1024 * LDH, LDH, P.mix_out_norm_g + L * 1024, 0};
            jobs[2] = {P.w_query + (size_t)L * 1024 * 1024, 1024, 1024, 1024, (bf16*)(ws + OFF_WQ) + (size_t)L * 1024 * LDH, LDH, P.norm_ffn_g + L * 1024, 0};
            jobs[3] = {P.w_ple_gate + (size_t)L * 1024 * 1024, 1024, 1024, 1024, (bf16*)(ws + OFF_WG) + (size_t)L * 1024 * LDH, LDH, P.ple_norm_g + L * 1024, 0};
            jobs[4] = {P.w_ple + (size_t)L * 256 * 1024, 1024, 256, 1024, (bf16*)(ws + OFF_WP) + (size_t)L * 1024 * LDP, LDP, nullptr, 0};
            jobs[5] = {P.w_uq + (size_t)L * 256 * 384, 384, 256, 384, (bf16*)(ws + OFF_WUQ) + (size_t)L * 384 * LDP, LDP, P.mla_q_norm_g + L * 256, 0};
            jobs[6] = {P.w_ukv + (size_t)L * 128 * 768, 768, 128, 768, (bf16*)(ws + OFF_WUKV) + (size_t)L * 768 * LDC, LDC, P.mla_kv_norm_g + L * 128, 2};
#pragma unroll
            for (int q = 0; q < 7; ++q) {
                int nt = (jobs[q].Np >> 5) * (jobs[q].K >> 5);
                for (int it = bid; it < nt; it += G) wconv_tile(jobs[q], it);
            }
        }
    }
    {
        const float* src = P.sub_keys;
        bf16* dst = (bf16*)(ws + OFF_SKB);
        for (int i = bid * NTHR + tid; i < 262144 / 2; i += G * NTHR) {
            float2 v = ((const float2*)src)[i];
            ((unsigned*)dst)[i] = pack2(v.x, v.y);
        }
    }
    {
        const float4* src = (const float4*)P.p;
        bf16* dst = (bf16*)(ws + OFF_PB);
        for (int i = bid * NTHR + tid; i < 2 * TOK * 256 / 8; i += G * NTHR) {
            float4 a = src[2 * i], b = src[2 * i + 1];
            u32x4 o = {pack2(a.x, a.y), pack2(a.z, a.w), pack2(b.x, b.y), pack2(b.z, b.w)};
            *(u32x4*)(dst + (size_t)(i >> 5) * LDP + (i & 31) * 8) = o;
        }
    }
    {
        bf16* hb = (bf16*)(ws + OFF_HB0);
        float* ss0 = (float*)(ws + OFF_SSA);
        int w = tid >> 6, l = tid & 63;
        for (int row = bid * NW + w; row < TOK; row += G * NW) {
            const float4* xr = (const float4*)(P.x + (size_t)row * DM);
            float ss = 0.f;
#pragma unroll
            for (int i = 0; i < 2; ++i) {
                float4 a = xr[i * 128 + l * 2], b = xr[i * 128 + l * 2 + 1];
                ss += a.x * a.x + a.y * a.y + a.z * a.z + a.w * a.w + b.x * b.x + b.y * b.y + b.z * b.z + b.w * b.w;
                uint4 o;
                o.x = pack2(a.x, a.y); o.y = pack2(a.z, a.w); o.z = pack2(b.x, b.y); o.w = pack2(b.z, b.w);
                ((uint4*)(hb + (size_t)row * LDH))[i * 64 + l] = o;
            }
            ss = wave_sum(ss);
            if (l == 0) {
                *(float4*)(ss0 + (size_t)row * 8) = make_float4(ss, 0.f, 0.f, 0.f);
                *(float4*)(ss0 + (size_t)row * 8 + 4) = make_float4(0.f, 0.f, 0.f, 0.f);
            }
        }
    }
    {
        float* cs = (float*)(ws + OFF_CS);
        for (int i = bid * NTHR + tid; i < TOK * 16; i += G * NTHR) {
            int t = i >> 4, k = i & 15;
            float inv = powf(10000.0f, -(float)k / 16.0f);
            float ang = (float)P.pos[t] * inv;
            cs[2 * i] = cosf(ang);
            cs[2 * i + 1] = sinf(ang);
        }
    }
}

struct NoHook { static constexpr bool nodma = false; __device__ __forceinline__ void operator()(int, f32x16 (&)[2][2]) const {} };
struct NoDmaHook { static constexpr bool nodma = true; __device__ __forceinline__ void operator()(int, f32x16 (&)[2][2]) const {} };
template <typename HOOK>
__device__ __forceinline__ void gemm_core(f32x16 (&acc)[2][2], const bf16* A, int lda, const bf16* Bt, int ldb, int K,
                                          int m0, int n0, HOOK hook) {
    const int tid = opaque_tid(), w = tid >> 6, l = tid & 63, r = l & 31, hh = l >> 5;
    const int wm = w >> 1, wn = w & 1;
    const int dp = (tid & 15) ^ ((tid >> 4) & 15);
    const int drow = 2 * (tid >> 4) + (dp >> 3), dgc = (dp & 7) * 8;
    const bf16* asrc = A + (size_t)(m0 + drow) * lda + dgc;
    const bf16* bsrc = Bt + (size_t)(n0 + drow) * ldb + dgc;
    auto dma = [&](int buf, int k0) {
        if (HOOK::nodma) return;
        char* base = smem + buf * STAGE_BYTES + tid * 16;
#pragma unroll
        for (int i = 0; i < 4; ++i)
            __builtin_amdgcn_global_load_lds((const unsigned*)(asrc + (size_t)(64 * i) * lda + k0), (unsigned*)(base + i * 8192), 16, 0, 0);
#pragma unroll
        for (int i = 0; i < 2; ++i)
            __builtin_amdgcn_global_load_lds((const unsigned*)(bsrc + (size_t)(64 * i) * ldb + k0), (unsigned*)(base + 32768 + i * 8192), 16, 0, 0);
    };
    int offA[2], offB[2];
#pragma unroll
    for (int i = 0; i < 2; ++i) { offA[i] = ((wm * 64 + i * 32 + r) >> 1) * 256; offB[i] = 32768 + ((wn * 64 + i * 32 + r) >> 1) * 256; }
    const int pbase = ((r & 1) << 3), lx = (r >> 1) & 15;
    const int nk = K >> 6;
    const unsigned ldsbase = (unsigned)(size_t)(__attribute__((address_space(3))) char*)smem;
    auto ldfrag = [&](int stage, int s, bf16x8 (&af)[2], bf16x8 (&bfr)[2]) {
        unsigned ch = (unsigned)((((pbase | (2 * s + hh)) ^ lx) << 4)) + ldsbase + (unsigned)(stage * STAGE_BYTES);
        unsigned a0a = ch + offA[0], a1a = ch + offA[1], b0a = ch + offB[0], b1a = ch + offB[1];
        asm volatile("ds_read_b128 %0, %4\n\tds_read_b128 %1, %5\n\tds_read_b128 %2, %6\n\tds_read_b128 %3, %7"
                     : "=&v"(af[0]), "=&v"(af[1]), "=&v"(bfr[0]), "=&v"(bfr[1]) : "v"(a0a), "v"(a1a), "v"(b0a), "v"(b1a) : "memory");
    };
    auto mma = [&](bf16x8 (&af)[2], bf16x8 (&bfr)[2]) {
#pragma unroll
        for (int i = 0; i < 2; ++i)
#pragma unroll
            for (int j = 0; j < 2; ++j) acc[i][j] = __builtin_amdgcn_mfma_f32_32x32x16_bf16(af[i], bfr[j], acc[i][j], 0, 0, 0);
    };
#define LGKM_WAIT(n) do { asm volatile("s_waitcnt lgkmcnt(" #n ")" ::: "memory"); __builtin_amdgcn_sched_barrier(0); } while (0)
    asm volatile("s_waitcnt vmcnt(0)" ::: "memory");
    dma(0, 0);
    dma(1, 64);
    if (nk > 2) { dma(2, 128); asm volatile("s_waitcnt vmcnt(12)" ::: "memory"); }
    else asm volatile("s_waitcnt vmcnt(6)" ::: "memory");
    __builtin_amdgcn_s_barrier();
    bf16x8 a0[2], b0[2], a1[2], b1[2];
    ldfrag(0, 0, a0, b0);
    int cur = 0;
    for (int kt = 0; kt < nk; ++kt) {
        const int nxt = (cur == 2) ? 0 : cur + 1;
        if (kt == 4 || kt == 8) { LGKM_WAIT(0); hook(kt, acc); }
        ldfrag(cur, 1, a1, b1);
        LGKM_WAIT(4);
        mma(a0, b0);
        ldfrag(cur, 2, a0, b0);
        LGKM_WAIT(4);
        mma(a1, b1);
        ldfrag(cur, 3, a1, b1);
        LGKM_WAIT(4);
        mma(a0, b0);
        if (kt + 1 < nk) {
            if (kt + 2 < nk) asm volatile("s_waitcnt vmcnt(6) lgkmcnt(0)" ::: "memory");
            else asm volatile("s_waitcnt vmcnt(0) lgkmcnt(0)" ::: "memory");
            __builtin_amdgcn_s_barrier();
            __builtin_amdgcn_sched_barrier(0);
            if (kt + 3 < nk) dma(cur, (kt + 3) << 6);
            ldfrag(nxt, 0, a0, b0);
        } else {
            LGKM_WAIT(0);
        }
        mma(a1, b1);
        cur = nxt;
    }
    __syncthreads();
}
__device__ __forceinline__ float row_rs8(const float* part, int row) {
    float4 a = *(const float4*)(part + (size_t)row * 8), b = *(const float4*)(part + (size_t)row * 8 + 4);
    float ss = ((a.x + a.y) + (a.z + a.w)) + ((b.x + b.y) + (b.z + b.w));
    return rsqrtf(ss * (1.f / 1024.f) + EPSF);
}
__device__ __forceinline__ bool xcd_tile(int it, int MT, int NT, int& mt, int& nt) {
    const int G = gridDim.x, bid = blockIdx.x;
    if ((G & 7) == 0 && (MT & 7) == 0) {
        const int nbx = G >> 3, q = (bid >> 3) + it * nbx, per = (MT >> 3) * NT;
        if (q >= per) return false;
        mt = (bid & 7) * (MT >> 3) + q / NT; nt = q % NT;
        return true;
    }
    const int q = bid + it * G;
    if (q >= MT * NT) return false;
    mt = q / NT; nt = q % NT;
    return true;
}
struct NoScale { __device__ __forceinline__ float operator()(int, int) const { return 1.f; } };

#define ZERO_ACC(acc)                                  \
    _Pragma("unroll") for (int _i = 0; _i < 2; ++_i)   \
    _Pragma("unroll") for (int _j = 0; _j < 2; ++_j)   \
    _Pragma("unroll") for (int _r = 0; _r < 16; ++_r) acc[_i][_j][_r] = 0.f;


namespace pg8 {
#define PG8_LAS __attribute__((address_space(3)))
typedef unsigned short bf16_t;
constexpr int BM = 256, BK = 64, HALF = 128, HTB = HALF * BK * 2  , NXCD = 8, WGM = 8;

__host__ __device__ __forceinline__ int lds_byte(int r, int c) { const int st = (r >> 4) * 2 + (c >> 5), rr = r & 15, cc = c & 31, ob = rr * 64 + cc * 2; return st * 1024 + (ob ^ (((ob >> 9) & 1) << 5)); }
__host__ __device__ __forceinline__ void stage_rc(int b, int& R, int& C) { const int st = b / 1024, sb = b % 1024, swz = sb ^ (((sb >> 9) & 1) << 5); R = (st >> 1) * 16 + swz / 64; C = (st & 1) * 32 + (swz % 64) / 2; }
__host__ __device__ __forceinline__ int perm32(int rho) { const int n = rho >> 4, i = rho & 15; return 8 * (i >> 2) + 4 * n + (i & 3); }
struct Unit { int pm, pn; };
struct Gemm { const bf16* A; const bf16* Bt; int lda, ldb, M, N, K; };
struct StaticOrder {
    int nM, nN, nwg, G, c;
    __device__ void init(int M, int N, int G_, int c_) { nM = M / BM; nN = N / BM; nwg = nM * nN; G = G_; c = c_; }
    __device__ bool next(int i, Unit& u) const {
        const long L = (long)i * G + c; if (L >= nwg) return false;
        int wgid = (int)L; { const int q = nwg / NXCD, r = nwg % NXCD, xcd = wgid % NXCD, off = wgid / NXCD; wgid = (xcd < r ? xcd * (q + 1) : r * (q + 1) + (xcd - r) * q) + off; }
        const int nig = WGM * nN, gid = wgid / nig, fm = gid * WGM, gsz = (nM - fm) < WGM ? (nM - fm) : WGM;
        u.pm = fm + ((wgid % nig) % gsz); u.pn = (wgid % nig) / gsz; return true;
    }
    __device__ __forceinline__ void a_ready(const Unit&) const {}
    __device__ __forceinline__ void done(const Unit&) const {}
};
template <class Epi, class Sched, bool STAMP = false>
__device__ __forceinline__ void gemm_phase(PG8_LAS unsigned char* lds, const Gemm g, const Sched& S, const Epi& E, unsigned long long* stamps) {
    const int tid = opaque_tid(), wid = __builtin_amdgcn_readfirstlane(tid >> 6), lane = tid & 63, wr = wid >> 2, wc = wid & 3, fr = lane & 15, fq = lane >> 4;
    const int K = g.K, nt = K / BK;
    int ts_lo = 0, ts_hi = 0, nts = 0; const unsigned long long rt_entry = STAMP ? (unsigned long long)wall_clock64() : 0ull;
#define PG8_STAMP() do { if (STAMP && wid == 0 && nts < 64) { const unsigned long long _c = (unsigned long long)clock64(); \
        ts_lo = (lane == nts) ? (int)(unsigned)_c : ts_lo; ts_hi = (lane == nts) ? (int)(unsigned)(_c >> 32) : ts_hi; ++nts; } } while (0)
    PG8_STAMP();
    unsigned voffA[2], voffB[2];
#pragma unroll
    for (int i = 0; i < 2; ++i) { int R, C; stage_rc(tid * 16 + i * 8192, R, C); const int Rb = Epi::PERM ? ((R & ~31) + perm32(R & 31)) : R;
        voffA[i] = (unsigned)(R * g.lda + C) * 2u; voffB[i] = (unsigned)(Rb * g.ldb + C) * 2u; }
    const size_t kstep = (size_t)(BK * 2);
    const size_t hstepA = (size_t)HALF * g.lda * 2, hstepB = (size_t)HALF * g.ldb * 2;
    const size_t tstepA = 2 * hstepA, tstepB = 2 * hstepB;
    const unsigned ldsw = (unsigned)wid * 1024u;
    const int aoff = lds_byte(wr * 64 + fr, fq * 8), boff = lds_byte(wc * 32 + fr, fq * 8);
#define PG8_SA(b, h) (((b) * 2 + (h)) * HTB)
#define PG8_SB(b, h) ((4 + (b) * 2 + (h)) * HTB)
#define PG8_STAGE(bufoff, gbase, voff) do { _Pragma("unroll") for (int _i = 0; _i < 2; ++_i) \
        __builtin_amdgcn_global_load_lds((const unsigned*)((const char*)(gbase) + (voff)[_i]), (PG8_LAS unsigned*)(lds + (bufoff) + ldsw + _i * 8192), 16, 0, 0); } while (0)
#define PG8_LDA(dst, b, h) do { _Pragma("unroll") for (int m = 0; m < 4; ++m) _Pragma("unroll") for (int k = 0; k < 2; ++k) dst[m][k] = *(const PG8_LAS bf16x8*)(lds + PG8_SA(b, h) + aoff + m * 2048 + k * 1024); } while (0)
#define PG8_LDB(dst, b, h) do { _Pragma("unroll") for (int n = 0; n < 2; ++n) _Pragma("unroll") for (int k = 0; k < 2; ++k) dst[n][k] = *(const PG8_LAS bf16x8*)(lds + PG8_SB(b, h) + boff + n * 2048 + k * 1024); } while (0)
#define PG8_MMA(ai, bj, At, Bt) do { __builtin_amdgcn_s_setprio(1); _Pragma("unroll") for (int m = 0; m < 4; ++m) _Pragma("unroll") for (int n = 0; n < 2; ++n) _Pragma("unroll") for (int k = 0; k < 2; ++k) \
        acc[ai][bj][m][n] = __builtin_amdgcn_mfma_f32_16x16x32_bf16(Bt[n][k], At[m][k], acc[ai][bj][m][n], 0, 0, 0); __builtin_amdgcn_s_setprio(0); } while (0)
#define PG8_WAIT_V(n) asm volatile("s_waitcnt vmcnt(" #n ")" ::: "memory")
#define PG8_WAIT_L(n) asm volatile("s_waitcnt lgkmcnt(" #n ")" ::: "memory")
#define PG8_BAR __builtin_amdgcn_s_barrier()
#define PG8_SCHED __builtin_amdgcn_sched_barrier(0)
    Unit cur, nxt; int ui = 0;
    if (!S.next(0, cur)) return;
    f32x4 acc[2][2][4][2];
#pragma unroll
    for (int a = 0; a < 2; ++a)
#pragma unroll
        for (int b = 0; b < 2; ++b)
#pragma unroll
            for (int m = 0; m < 4; ++m)
#pragma unroll
                for (int n = 0; n < 2; ++n) acc[a][b][m][n] = (f32x4){0.f, 0.f, 0.f, 0.f};
    bf16x8 At[4][2], B0[2][2], B1[2][2];
    const char* cA = (const char*)g.A + (size_t)cur.pm * tstepA; const char* cB = (const char*)g.Bt + (size_t)cur.pn * tstepB;
    S.a_ready(cur);
    PG8_STAGE(PG8_SB(0, 0), cB, voffB); PG8_STAGE(PG8_SA(0, 0), cA, voffA); PG8_STAGE(PG8_SB(0, 1), cB + hstepB, voffB); PG8_STAGE(PG8_SA(0, 1), cA + hstepA, voffA);
    if (wr == 1) PG8_BAR;
    PG8_WAIT_V(4); PG8_BAR;
    PG8_STAGE(PG8_SB(1, 0), cB + kstep, voffB); PG8_STAGE(PG8_SA(1, 0), cA + kstep, voffA); PG8_STAGE(PG8_SB(1, 1), cB + hstepB + kstep, voffB);
    PG8_WAIT_V(6); PG8_BAR;
    PG8_STAMP();
    for (;;) {
        const bool has_next = S.next(ui + 1, nxt);
        const char* nA = has_next ? (const char*)g.A + (size_t)nxt.pm * tstepA : cA; const char* nB = has_next ? (const char*)g.Bt + (size_t)nxt.pn * tstepB : cB;
        for (int t = 0; t < nt; t += 2) {
            const bool last = (t == nt - 2);
            const char* a1 = cA + (size_t)(t + 1) * kstep;
            const char* a2 = last ? nA : cA + (size_t)(t + 2) * kstep; const char* b2 = last ? nB : cB + (size_t)(t + 2) * kstep;
            const char* a3 = a2 + kstep; const char* b3 = b2 + kstep;
            if (last && has_next) S.a_ready(nxt);
            E.khook(t, acc, wr, fr);
            PG8_LDB(B0, 0, 0); PG8_SCHED; PG8_LDA(At, 0, 0); PG8_STAGE(PG8_SA(1, 1), a1 + hstepA, voffA);
            PG8_WAIT_L(8); PG8_BAR; PG8_WAIT_L(0); PG8_MMA(0, 0, At, B0); PG8_BAR; PG8_SCHED;
            PG8_LDB(B1, 0, 1); PG8_STAGE(PG8_SB(0, 0), b2, voffB);
            PG8_BAR; PG8_WAIT_L(0); PG8_MMA(0, 1, At, B1); PG8_BAR;
            PG8_LDA(At, 0, 1); PG8_STAGE(PG8_SA(0, 0), a2, voffA);
            PG8_BAR; PG8_WAIT_L(0); PG8_MMA(1, 0, At, B0); PG8_BAR; PG8_SCHED;
            PG8_STAGE(PG8_SB(0, 1), b2 + hstepB, voffB);
            PG8_WAIT_V(6); PG8_BAR; PG8_MMA(1, 1, At, B1); PG8_BAR;
            PG8_LDB(B0, 1, 0); PG8_SCHED; PG8_LDA(At, 1, 0); PG8_STAGE(PG8_SA(0, 1), a2 + hstepA, voffA);
            PG8_WAIT_L(8); PG8_BAR; PG8_WAIT_L(0); PG8_MMA(0, 0, At, B0); PG8_BAR; PG8_SCHED;
            PG8_LDB(B1, 1, 1); PG8_STAGE(PG8_SB(1, 0), b3, voffB);
            PG8_BAR; PG8_WAIT_L(0); PG8_MMA(0, 1, At, B1); PG8_BAR;
            PG8_LDA(At, 1, 1); PG8_STAGE(PG8_SA(1, 0), a3, voffA);
            PG8_BAR; PG8_WAIT_L(0); PG8_MMA(1, 0, At, B0); PG8_BAR; PG8_SCHED;
            PG8_STAGE(PG8_SB(1, 1), b3 + hstepB, voffB);
            PG8_WAIT_V(6); PG8_BAR; PG8_MMA(1, 1, At, B1); PG8_BAR;
        }
        PG8_STAMP();
        if constexpr (!Epi::AFTER_DRAIN) { E(acc, cur, wr, wc, fr, fq); S.done(cur); }
        PG8_STAMP();
        if (!has_next) break;
#pragma unroll
        for (int a = 0; a < 2; ++a)
#pragma unroll
            for (int b = 0; b < 2; ++b)
#pragma unroll
                for (int m = 0; m < 4; ++m)
#pragma unroll
                    for (int n = 0; n < 2; ++n) acc[a][b][m][n] = (f32x4){0.f, 0.f, 0.f, 0.f};
        cur = nxt; cA = nA; cB = nB; ++ui;
    }
    PG8_WAIT_V(0);
    if (wr == 0) PG8_BAR;
    PG8_BAR;
    if constexpr (Epi::AFTER_DRAIN) { E.fused(acc, cur, wr, wc, fr, fq, lds, wid, lane); S.done(cur); }
    PG8_STAMP();
    if (STAMP && wid == 0) { stamps[lane] = lane < nts ? (((unsigned long long)(unsigned)ts_hi << 32) | (unsigned)ts_lo) : 0ull;
        if (lane == 62) stamps[62] = rt_entry; if (lane == 63) stamps[63] = (unsigned long long)wall_clock64(); }
#undef PG8_STAMP
#undef PG8_SA
#undef PG8_SB
#undef PG8_STAGE
#undef PG8_LDA
#undef PG8_LDB
#undef PG8_MMA
#undef PG8_WAIT_V
#undef PG8_WAIT_L
#undef PG8_BAR
#undef PG8_SCHED
}
}

#define TB_LD 136
#define TF_LD 132
template <bool SCALE>
__device__ __forceinline__ void stage_bf16(const f32x16 (&acc)[2][2], const float* rsl) {
    bf16* T = (bf16*)smem;
    const int tid = opaque_tid(), w = tid >> 6, l = tid & 63, hh = l >> 5, wm = w >> 1, wn = w & 1;
#pragma unroll
    for (int i = 0; i < 2; ++i)
#pragma unroll
        for (int rr = 0; rr < 16; ++rr) {
            int row = wm * 64 + i * 32 + (rr & 3) + 8 * (rr >> 2) + 4 * hh;
            float sc = SCALE ? rsl[row] : 1.f;
#pragma unroll
            for (int j = 0; j < 2; ++j) T[row * TB_LD + wn * 64 + j * 32 + (l & 31)] = (bf16)(acc[i][j][rr] * sc);
        }
    __syncthreads();
}
template <bool SCALE>
__device__ __forceinline__ void stage_f32(const f32x16 (&acc)[2][2], const float* rsl) {
    float* T = (float*)smem;
    const int tid = opaque_tid(), w = tid >> 6, l = tid & 63, hh = l >> 5, wm = w >> 1, wn = w & 1;
#pragma unroll
    for (int i = 0; i < 2; ++i)
#pragma unroll
        for (int rr = 0; rr < 16; ++rr) {
            int row = wm * 64 + i * 32 + (rr & 3) + 8 * (rr >> 2) + 4 * hh;
            float sc = SCALE ? rsl[row] : 1.f;
#pragma unroll
            for (int j = 0; j < 2; ++j) T[row * TF_LD + wn * 64 + j * 32 + (l & 31)] = acc[i][j][rr] * sc;
        }
    __syncthreads();
}
template <typename CMAP>
__device__ __forceinline__ void store_rows_bf16(bf16* dst, int ld, int m0, CMAP cmap) {
    const bf16* T = (const bf16*)smem;
    const int tid = opaque_tid();
#pragma unroll
    for (int q = 0; q < 8; ++q) {
        int id = tid + 512 * q, row = id >> 4, ch = id & 15;
        u32x4 v = *(const u32x4*)(T + row * TB_LD + ch * 8);
        *(u32x4*)(dst + (size_t)(m0 + row) * ld + cmap(ch * 8)) = v;
    }
}
__device__ __forceinline__ void store_cols_bf16(bf16* vt, size_t crow0, int s0) {
    const unsigned short* T = (const unsigned short*)smem;
    const int tid = opaque_tid();
#pragma unroll
    for (int q = 0; q < 8; ++q) {
        int id = tid + 512 * q, c = id & 127, sg = id >> 7;
        unsigned e[8];
#pragma unroll
        for (int k = 0; k < 8; ++k) e[k] = T[(8 * sg + k) * TB_LD + c];
        u32x4 v = {e[0] | (e[1] << 16), e[2] | (e[3] << 16), e[4] | (e[5] << 16), e[6] | (e[7] << 16)};
        *(u32x4*)(vt + (crow0 + c) * SEQ + s0 + 8 * sg) = v;
    }
}
__device__ __forceinline__ void residual_store(const float* hin, float* hout, bf16* hb_out, float* gss, int m0, int n0, int nt) {
    const float* T = (const float*)smem;
    const int tid = opaque_tid(), l = tid & 63;
#pragma unroll 4
    for (int q = 0; q < 16; ++q) {
        int id = tid + 512 * q, row = id >> 5, ch = id & 31;
        f32x4 d = *(const f32x4*)(T + row * TF_LD + ch * 4);
        size_t gi = (size_t)(m0 + row) * 1024 + n0 + ch * 4;
        f32x4 h = *(const f32x4*)(hin + gi);
        f32x4 v = h + d;
        *(f32x4*)(hout + gi) = v;
        u32x2 b = {pack2(v.x, v.y), pack2(v.z, v.w)};
        *(u32x2*)(hb_out + (size_t)(m0 + row) * LDH + n0 + ch * 4) = b;
        float ss = v.x * v.x + v.y * v.y + v.z * v.z + v.w * v.w;
        ss = dpp_add<0xB1>(ss); ss = dpp_add<0x4E>(ss); ss = dpp_add<0x141>(ss); ss = dpp_add<0x140>(ss);
        ss += __shfl_xor(ss, 16);
        if ((l & 31) == 0) gss[(size_t)(m0 + row) * 8 + nt] = ss;
    }
}
struct ColAdd { int off; __device__ __forceinline__ int operator()(int c) const { return c + off; } };
struct ColHead96 { __device__ __forceinline__ int operator()(int c) const { return (c >> 6) * 96 + (c & 63); } };

struct EpiProj {
    static constexpr bool PERM = true, AFTER_DRAIN = false;
    const float* ssrow; char* ws;
    __device__ __forceinline__ void khook(int, f32x4 (&)[2][2][4][2], int, int) const {}
    __device__ __forceinline__ void operator()(const f32x4 (&acc)[2][2][4][2], const pg8::Unit& u, int wr, int wc, int fr, int fqd) const {
        const int row0 = u.pm * 256 + wr * 64 + fr, lc0 = wc * 32 + 8 * fqd, pn = u.pn;
        size_t doff; int ld = 256;
        if (pn == 0) doff = OFF_FQ; else if (pn == 1) doff = OFF_FK; else if (pn == 2) doff = OFF_PART;
        else if (pn == 3) doff = OFF_SQ; else if (pn == 4) doff = OFF_SKK; else if (pn == 5) doff = OFF_PART + 8 * MBy;
        else if (pn == 6) { doff = OFF_CQ; ld = LDP; } else { doff = OFF_CKV; ld = LDC; }
        bf16* dst = (bf16*)(ws + doff);
        bf16* mk = (bf16*)(ws + OFF_MK); float* flog = (float*)(ws + OFF_FLOG); const float* cs = (const float*)(ws + OFF_CS);
#pragma unroll
        for (int ai = 0; ai < 2; ++ai)
#pragma unroll
            for (int m = 0; m < 4; ++m) {
                const int row = row0 + ai * 128 + m * 16;
                const float rs = row_rs8(ssrow, row);
#pragma unroll
                for (int bj = 0; bj < 2; ++bj) {
                    f32x4 v0 = acc[ai][bj][m][0] * rs, v1 = acc[ai][bj][m][1] * rs;
                    if (pn < 7 || bj == 0) {
                        u32x4 wv = {pack2(v0[0], v0[1]), pack2(v0[2], v0[3]), pack2(v1[0], v1[1]), pack2(v1[2], v1[3])};
                        *(u32x4*)(dst + (size_t)row * ld + bj * 128 + lc0) = wv;
                    } else if (wc == 0) {
                        const int hh = fqd >> 1, pi = 8 * (fqd & 1);
                        float vv[8] = {v0[0], v0[1], v0[2], v0[3], v1[0], v1[1], v1[2], v1[3]}, ov[8];
                        const f32x4* c4 = (const f32x4*)(cs + ((size_t)row * 16 + pi) * 2);
                        f32x4 t0 = c4[0], t1 = c4[1], t2 = c4[2], t3 = c4[3];
                        float cc[8] = {t0.x, t0.z, t1.x, t1.z, t2.x, t2.z, t3.x, t3.z}, sn[8] = {t0.y, t0.w, t1.y, t1.w, t2.y, t2.w, t3.y, t3.w};
#pragma unroll
                        for (int e = 0; e < 8; ++e) {
                            float pv = __builtin_bit_cast(float, partner32(__builtin_bit_cast(int, vv[e]), hh));
                            ov[e] = hh ? (pv * sn[e] + vv[e] * cc[e]) : (vv[e] * cc[e] - pv * sn[e]);
                        }
                        u32x4 wv = {pack2(ov[0], ov[1]), pack2(ov[2], ov[3]), pack2(ov[4], ov[5]), pack2(ov[6], ov[7])};
#pragma unroll
                        for (int h = 0; h < 4; ++h) *(u32x4*)(mk + (size_t)row * 384 + h * 96 + 64 + 8 * fqd) = wv;
                    } else if (wc == 1 && fqd == 0) {
                        *(f32x4*)(flog + (size_t)row * 4) = v0;
                    }
                }
            }
    }
};
__device__ __forceinline__ void phase_proj(const Params& P, int L, int hsel, int ss_slot) {
    char* ws = opq(P.ws);
    const float* ssrow = (const float*)(ws + OFF_SSA) + (size_t)ss_slot * TOK * 8;
    const bf16* hb = (const bf16*)(ws + (hsel ? OFF_HB1 : OFF_HB0));
    const bf16* Bt = (const bf16*)(ws + OFF_WIN) + (size_t)L * 2048 * LDH;
    pg8::Gemm g{hb, Bt, LDH, LDH, TOK, 2048, 1024};
    pg8::StaticOrder S; S.init(TOK, 2048, gridDim.x, blockIdx.x);
    EpiProj E{ssrow, ws};
    pg8::gemm_phase((PG8_LAS unsigned char*)smem, g, S, E, nullptr);
    __syncthreads();
}

template <int KW>
__device__ __forceinline__ void row_rms_to_lds(const bf16* A, int lda, int m0) {
    const int tid = opaque_tid(), row = tid >> 1, half = tid & 1;
    float ss = 0.f;
    const u32x4* p = (const u32x4*)(A + (size_t)(m0 + row) * lda + half * (KW / 2));
#pragma unroll
    for (int q = 0; q < KW / 16; ++q) {
        u32x4 v = p[q];
        float a;
        a = bflo(v.x); ss += a * a; a = bfhi(v.x); ss += a * a;
        a = bflo(v.y); ss += a * a; a = bfhi(v.y); ss += a * a;
        a = bflo(v.z); ss += a * a; a = bfhi(v.z); ss += a * a;
        a = bflo(v.w); ss += a * a; a = bfhi(v.w); ss += a * a;
    }
    ss += __shfl_xor(ss, 1);
    if (half == 0) ((float*)(smem + LDS_AUX))[row] = rsqrtf(ss * (1.f / (float)KW) + EPSF);
}

__device__ __forceinline__ void phase_mla_up(const Params& P, int L) {
    char* ws = opq(P.ws);
    const bf16* cq = (const bf16*)(ws + OFF_CQ); const bf16* ckv = (const bf16*)(ws + OFF_CKV);
    const bf16* wuq = (const bf16*)(ws + OFF_WUQ) + (size_t)L * 384 * LDP;
    const bf16* wukv = (const bf16*)(ws + OFF_WUKV) + (size_t)L * 768 * LDC;
    bf16* mq = (bf16*)(ws + OFF_MQ); bf16* mk = (bf16*)(ws + OFF_MK); bf16* mvt = (bf16*)(ws + OFF_MVT);
    const float* cs = (const float*)(ws + OFF_CS);
    const float* flog = (const float*)(ws + OFF_FLOG);
    float* cumF = (float*)(ws + OFF_CUMF);
    const int tid = opaque_tid(), w = tid >> 6, l = tid & 63, hh = l >> 5, wm = w >> 1, wn = w & 1;
    const int NQ = 64 * 3, NKV = 64 * 6, NCF = 4;
    const float* aux = (const float*)(smem + LDS_AUX);
    for (int gw = blockIdx.x * NW + w; gw < 2048; gw += gridDim.x * NW) {
        const int type = gw >> 10, bh = (gw >> 5) & 31, tb = gw & 31, b = bh >> 2, h = bh & 3;
        const bf16* src = (const bf16*)(ws + OFF_PART + (type ? 8 * MBy : 0)) + ((size_t)(b * SEQ + tb * 64 + l) * 256 + h * 64);
        unsigned short* dst = (unsigned short*)(ws + (type ? OFF_SVT : OFF_FVT)) + (size_t)bh * 64 * SEQ + tb * 64 + l;
        u32x4 rv8[8];
#pragma unroll
        for (int q = 0; q < 8; ++q) rv8[q] = ((const u32x4*)src)[q];
#pragma unroll
        for (int q = 0; q < 8; ++q) {
            dst[(size_t)(8 * q + 0) * SEQ] = (unsigned short)(rv8[q].x & 0xffffu); dst[(size_t)(8 * q + 1) * SEQ] = (unsigned short)(rv8[q].x >> 16);
            dst[(size_t)(8 * q + 2) * SEQ] = (unsigned short)(rv8[q].y & 0xffffu); dst[(size_t)(8 * q + 3) * SEQ] = (unsigned short)(rv8[q].y >> 16);
            dst[(size_t)(8 * q + 4) * SEQ] = (unsigned short)(rv8[q].z & 0xffffu); dst[(size_t)(8 * q + 5) * SEQ] = (unsigned short)(rv8[q].z >> 16);
            dst[(size_t)(8 * q + 6) * SEQ] = (unsigned short)(rv8[q].w & 0xffffu); dst[(size_t)(8 * q + 7) * SEQ] = (unsigned short)(rv8[q].w >> 16);
        }
    }
    for (int item = blockIdx.x; item < NQ + NKV + NCF; item += gridDim.x) {
        if (item < NQ) {
            int mt = item / 3, nt = item % 3;
            int m0 = mt * 256, n0 = nt * 128;
            __syncthreads();
            row_rms_to_lds<256>(cq, LDP, m0);
            f32x16 acc[2][2];
            ZERO_ACC(acc);
            gemm_core(acc, cq, LDP, wuq, LDP, 256, m0, n0, NoHook());
#pragma unroll
            for (int i = 0; i < 2; ++i)
#pragma unroll
                for (int j = 0; j < 2; ++j) {
                    int c0 = n0 + wn * 64 + j * 32;
                    int rloc = wm * 64 + i * 32 + 4 * hh;
                    bool rot = (c0 % 96) == 64;
                    int ci = l & 31, pi = ci & 15;
#pragma unroll
                    for (int rr = 0; rr < 16; ++rr) {
                        int rl = rloc + (rr & 3) + 8 * (rr >> 2);
                        float v = acc[i][j][rr] * aux[rl];
                        if (rot) {
                            float pv = __shfl_xor(v, 16);
                            float2 c_s = *(const float2*)(cs + ((size_t)(m0 + rl) * 16 + pi) * 2);
                            v = (ci < 16) ? (v * c_s.x - pv * c_s.y) : (pv * c_s.y + v * c_s.x);
                        }
                        acc[i][j][rr] = v;
                    }
                }
            stage_bf16<false>(acc, nullptr);
            store_rows_bf16(mq, 384, m0, ColAdd{n0});
        } else if (item < NQ + NKV) {
            int it2 = item - NQ;
            int mt = it2 / 6, nt = it2 % 6;
            int m0 = mt * 256, n0 = nt * 128;
            __syncthreads();
            row_rms_to_lds<128>(ckv, LDC, m0);
            f32x16 acc[2][2];
            ZERO_ACC(acc);
            gemm_core(acc, ckv, LDC, wukv, LDC, 128, m0, n0, NoHook());
            stage_bf16<true>(acc, aux);
            if (nt < 2) {
                const int nb0 = n0;
                struct CM { int n0; __device__ __forceinline__ int operator()(int c) const { int col = n0 + c; return (col >> 6) * 96 + (col & 63); } };
                store_rows_bf16(mk, 384, m0, CM{nb0});
            } else {
                store_cols_bf16(mvt, (size_t)(m0 >> 11) * 512 + (n0 - 256), m0 & 2047);
            }
        } else {
            int seq = (item - NQ - NKV) * NW + w;
            int b = seq >> 2, h = seq & 3;
            float bfv = P.b_forget[L * 4 + h];
            float vals[32];
            float run = 0.f;
#pragma unroll
            for (int i = 0; i < 32; ++i) {
                int s = l * 32 + i;
                float z = flog[((size_t)b * SEQ + s) * 4 + h] + bfv;
                run += log_sigmoid_f(z);
                vals[i] = run;
            }
            float tot = run, incl = tot;
#pragma unroll
            for (int o = 1; o < 64; o <<= 1) {
                float t = __shfl_up(incl, o);
                if (l >= o) incl += t;
            }
            float excl = incl - tot;
#pragma unroll
            for (int i = 0; i < 32; ++i) cumF[(size_t)seq * SEQ + l * 32 + i] = vals[i] + excl;
        }
    }
}

template <int MODE, int DK, int DV>
__device__ __forceinline__ void attn_item(const bf16* __restrict__ Q, int ldq, const bf16* __restrict__ Kg, int ldk,
                          const bf16* __restrict__ Vt, const float* __restrict__ cumF, bf16* __restrict__ Y,
                          float* __restrict__ ssy, int b, int h, int qb, float c1, char* lds, int fake = 0) {
    constexpr int KSTR = DK * 2 + 16;
    constexpr int VSTR = 144;
    constexpr int KBYTES = 64 * KSTR, VBYTES = DV * VSTR;
    constexpr int BUF = (KBYTES + VBYTES + 256 + 255) & ~255;
    static_assert(2 * BUF <= 65536, "lds");
    constexpr int KCH = DK / 8, KPT = (64 * KCH) / 256, VPT = (DV * 8) / 256;
    const int tid = opaque_tid() & 255, w = tid >> 6, l = tid & 63, r = l & 31, hh = l >> 5;
    const int q0 = qb * 128;
    const int qrow = q0 + 32 * w + r;
    const size_t tok = (size_t)b * SEQ + qrow;
    const int bh = b * 4 + h;
    bf16x8 qf[DK / 16];
#pragma unroll
    for (int s = 0; s < DK / 16; ++s) qf[s] = *(const bf16x8*)(Q + tok * ldq + h * DK + 16 * s + 8 * hh);
    f32x16 o[DV / 32];
    const f32x16 zero16 = {0.f, 0.f, 0.f, 0.f, 0.f, 0.f, 0.f, 0.f, 0.f, 0.f, 0.f, 0.f, 0.f, 0.f, 0.f, 0.f};
#pragma unroll
    for (int d = 0; d < DV / 32; ++d) o[d] = zero16;
    float m = -1e30f, lsum = 0.f, R = 0.f;
    bool sbdead = false;
    int* dmask = (int*)(smem + LDS_BYTES - 32);
    float Fq = 0.f;
    if (MODE == 0) Fq = cumF[(size_t)bh * SEQ + qrow] * LOG2E;
    const int nkt = (q0 + 128) >> 6;
    u32x4 kregA[KPT], vregA[VPT], kregB[KPT], vregB[VPT];
    float4 fregA = {0.f, 0.f, 0.f, 0.f}, fregB = {0.f, 0.f, 0.f, 0.f};
    auto gload = [&](int kt, u32x4 (&kreg)[KPT], u32x4 (&vreg)[VPT], float4& freg) {
#pragma unroll
        for (int i = 0; i < KPT; ++i) {
            int e = tid + 256 * i;
            int row = e / KCH, ch = e % KCH;
            kreg[i] = *(const u32x4*)(Kg + ((size_t)b * SEQ + kt * 64 + row) * ldk + h * DK + ch * 8);
        }
#pragma unroll
        for (int i = 0; i < VPT; ++i) {
            int e = tid + 256 * i;
            int row = e >> 3, ch = e & 7;
            vreg[i] = *(const u32x4*)(Vt + ((size_t)bh * DV + row) * SEQ + kt * 64 + ch * 8);
        }
        if (MODE == 0 && tid < 16) freg = *(const float4*)(cumF + (size_t)bh * SEQ + kt * 64 + tid * 4);
    };
    auto lwrite = [&](int buf, u32x4 (&kreg)[KPT], u32x4 (&vreg)[VPT], float4& freg) {
        char* base = lds + buf * BUF;
#pragma unroll
        for (int i = 0; i < KPT; ++i) {
            int e = tid + 256 * i;
            int row = e / KCH, ch = e % KCH;
            *(u32x4*)(base + row * KSTR + ch * 16) = kreg[i];
        }
#pragma unroll
        for (int i = 0; i < VPT; ++i) {
            int e = tid + 256 * i;
            int row = e >> 3, ch = e & 7;
            *(u32x4*)(base + KBYTES + row * VSTR + ch * 16) = vreg[i];
        }
        if (MODE == 0 && tid < 16) { float4 fn = {-freg.x * LOG2E, -freg.y * LOG2E, -freg.z * LOG2E, -freg.w * LOG2E}; *(float4*)(base + KBYTES + VBYTES + tid * 16) = fn; }
    };
    const int prow = (r & 0x13) | ((r & 4) << 1) | ((r & 8) >> 1);
    auto ktof = [&](int it) { return (MODE == 1) ? (nkt - 1 - it) : it; };
    gload(ktof(0), kregA, vregA, fregA);
    lwrite(0, kregA, vregA, fregA);
    constexpr bool D2 = (MODE != 2);
    if (D2 && nkt > 1) gload(ktof(1), kregB, vregB, fregB);
    __syncthreads();
    auto tile = [&](int it, u32x4 (&kn)[KPT], u32x4 (&vn)[VPT], float4& fn2, u32x4 (&kf)[KPT], u32x4 (&vf2)[VPT], float4& ff) {
        const int kt = ktof(it);
        if (!(fake & 1)) {
        if (D2) { if (it + 2 < nkt) gload(ktof(it + 2), kf, vf2, ff); }
        else { if (it + 1 < nkt) gload(ktof(it + 1), kf, vf2, ff); }
        }
        const char* base = lds + (it & 1) * BUF;
        bool active = (kt * 64) <= (q0 + 32 * w + 31);
        if (MODE == 1) {
            if (sbdead) { active = false; atomicOr(&dmask[it & 1], 1 << (opaque_tid() >> 6)); }
        }
        if (active) {
            const bool needmask = (kt * 64 + 63) >= (q0 + 32 * w);
            f32x16 s[2];
#pragma unroll
            for (int sub = 0; sub < 2; ++sub) {
                s[sub] = zero16;
#pragma unroll
                for (int ks = 0; ks < DK / 16; ++ks) {
                    bf16x8 kf = *(const bf16x8*)(base + (sub * 32 + prow) * KSTR + (2 * ks + hh) * 16);
                    s[sub] = __builtin_amdgcn_mfma_f32_32x32x16_bf16(kf, qf[ks], s[sub], 0, 0, 0);
                }
            }
            bf16x8 pf[2][2];
            if (fake & 2) {
#pragma unroll
                for (int sub = 0; sub < 2; ++sub)
#pragma unroll
                    for (int a = 0; a < 2; ++a) {
                        uint4 u;
                        u.x = pack2(s[sub][8 * a], s[sub][8 * a + 1]); u.y = pack2(s[sub][8 * a + 2], s[sub][8 * a + 3]);
                        u.z = pack2(s[sub][8 * a + 4], s[sub][8 * a + 5]); u.w = pack2(s[sub][8 * a + 6], s[sub][8 * a + 7]);
                        pf[sub][a] = __builtin_bit_cast(bf16x8, u);
                    }
                lsum = 1.f;
            } else if (MODE != 1) {
                const float* Ft = (const float*)(base + KBYTES + VBYTES);
                float mx = -INFINITY;
                float tv[2][16];
#pragma unroll
                for (int sub = 0; sub < 2; ++sub)
#pragma unroll
                    for (int a = 0; a < 2; ++a) {
                        int kofs = sub * 32 + 16 * a + 8 * hh;
                        float fk[8];
                        if (MODE == 0) {
                            float4 f0 = *(const float4*)(Ft + kofs), f1 = *(const float4*)(Ft + kofs + 4);
                            fk[0] = f0.x; fk[1] = f0.y; fk[2] = f0.z; fk[3] = f0.w; fk[4] = f1.x; fk[5] = f1.y; fk[6] = f1.z; fk[7] = f1.w;
                        }
#pragma unroll
                        for (int j = 0; j < 8; ++j) {
                            int rr = 8 * a + j;
                            float v = (MODE == 0) ? fmaf(s[sub][rr], c1, fk[j]) : s[sub][rr] * c1;
                            tv[sub][rr] = v;
                        }
                    }
                if (needmask) {
#pragma unroll
                    for (int sub = 0; sub < 2; ++sub)
#pragma unroll
                        for (int rr = 0; rr < 16; ++rr) {
                            int key = kt * 64 + sub * 32 + 16 * (rr >> 3) + 8 * hh + (rr & 7);
                            if (key > qrow) tv[sub][rr] = -INFINITY;
                        }
                }
#pragma unroll
                for (int sub = 0; sub < 2; ++sub)
#pragma unroll
                    for (int rr = 0; rr < 16; ++rr) mx = fmaxf(mx, tv[sub][rr]);
                mx = fmaxf(mx, __builtin_bit_cast(float, partner32(__builtin_bit_cast(int, mx), hh)));
                float mnew = fmaxf(m, mx);
                float rsum = 0.f;
#pragma unroll
                for (int sub = 0; sub < 2; ++sub)
#pragma unroll
                    for (int a = 0; a < 2; ++a) {
                        float pv[8];
#pragma unroll
                        for (int j = 0; j < 8; ++j) { pv[j] = fexp2(tv[sub][8 * a + j] - mnew); rsum += pv[j]; }
                        uint4 u;
                        u.x = pack2(pv[0], pv[1]); u.y = pack2(pv[2], pv[3]); u.z = pack2(pv[4], pv[5]); u.w = pack2(pv[6], pv[7]);
                        pf[sub][a] = __builtin_bit_cast(bf16x8, u);
                    }
                rsum += __builtin_bit_cast(float, partner32(__builtin_bit_cast(int, rsum), hh));
                if (__builtin_amdgcn_ballot_w64(mnew != m) != 0ull) {
                    float alpha = fexp2(m - mnew);
                    lsum *= alpha;
#pragma unroll
                    for (int d = 0; d < DV / 32; ++d) o[d] = o[d] * alpha;
                    m = mnew;
                }
                lsum += rsum;
            } else {
#pragma unroll
                for (int sb = 0; sb < 2; ++sb) {
                    const int sub = 1 - sb;
                    float lsig[16], lneg[16];
                    float A0 = 0.f, A1 = 0.f;
#pragma unroll
                    for (int rr = 0; rr < 16; ++rr) {
                        int key = kt * 64 + sub * 32 + 16 * (rr >> 3) + 8 * hh + (rr & 7);
                        bool valid = key < qrow;
                        float z = s[sub][rr] * c1;
                        float e = fexp2(-fabsf(z));
                        float l1p = flog2(1.f + e);
                        float ls = fminf(z, 0.f) - l1p;
                        float ln = valid ? (ls - z) : 0.f;
                        lsig[rr] = valid ? ls : -INFINITY;
                        lneg[rr] = ln;
                        if (rr < 8) A0 += ln; else A1 += ln;
                    }
                    float B0 = __shfl_xor(A0, 32), B1 = __shfl_xor(A1, 32);
                    float base1 = (hh == 0) ? (R + B1) : R;
                    float base0 = (hh == 0) ? (R + B1 + A1 + B0) : (R + A1 + B1);
                    float wv[16];
                    float run = base1;
#pragma unroll
                    for (int j = 7; j >= 0; --j) { wv[8 + j] = fexp2(lsig[8 + j] + run); run += lneg[8 + j]; }
                    run = base0;
#pragma unroll
                    for (int j = 7; j >= 0; --j) { wv[j] = fexp2(lsig[j] + run); run += lneg[j]; }
                    R += A0 + A1 + B0 + B1;
#pragma unroll
                    for (int a = 0; a < 2; ++a) {
                        uint4 u;
                        u.x = pack2(wv[8 * a], wv[8 * a + 1]); u.y = pack2(wv[8 * a + 2], wv[8 * a + 3]);
                        u.z = pack2(wv[8 * a + 4], wv[8 * a + 5]); u.w = pack2(wv[8 * a + 6], wv[8 * a + 7]);
                        pf[sub][a] = __builtin_bit_cast(bf16x8, u);
                    }
                }
            }
            if (MODE == 1) {
                if (__builtin_amdgcn_ballot_w64(R > -150.f) == 0ull) { sbdead = true; atomicOr(&dmask[it & 1], 1 << (opaque_tid() >> 6)); }
            }
#pragma unroll
            for (int d = 0; d < DV / 32; ++d)
#pragma unroll
                for (int sub = 0; sub < 2; ++sub)
#pragma unroll
                    for (int a = 0; a < 2; ++a) {
                        bf16x8 vf = *(const bf16x8*)(base + KBYTES + (d * 32 + r) * VSTR + (sub * 32 + 16 * a + 8 * hh) * 2);
                        o[d] = __builtin_amdgcn_mfma_f32_32x32x16_bf16(vf, pf[sub][a], o[d], 0, 0, 0);
                    }
        }
        if (!(fake & 1)) { if (it + 1 < nkt) lwrite((it + 1) & 1, kn, vn, fn2); }
        __syncthreads();
    };
    if (D2) {
        for (int it = 0; it < nkt; it += 2) {
            if (MODE == 1 && it > 0 && ((volatile int*)dmask)[(it - 1) & 1] == 0xFF) break;
            tile(it, kregB, vregB, fregB, kregA, vregA, fregA);
            if (it + 1 < nkt) {
                if (MODE == 1 && ((volatile int*)dmask)[it & 1] == 0xFF) break;
                tile(it + 1, kregA, vregA, fregA, kregB, vregB, fregB);
            }
        }
    } else {
        for (int it = 0; it < nkt; ++it) tile(it, kregA, vregA, fregA, kregA, vregA, fregA);
    }
    float inv = (MODE == 1) ? 1.f : (1.f / lsum);
    float ssq = 0.f;
#pragma unroll
    for (int d = 0; d < DV / 32; ++d)
#pragma unroll
        for (int g = 0; g < 4; ++g) {
            float v0 = o[d][4 * g] * inv, v1 = o[d][4 * g + 1] * inv, v2 = o[d][4 * g + 2] * inv, v3 = o[d][4 * g + 3] * inv;
            ssq += v0 * v0 + v1 * v1 + v2 * v2 + v3 * v3;
            uint2 u; u.x = pack2(v0, v1); u.y = pack2(v2, v3);
            *(uint2*)(Y + tok * LDH + h * DV + d * 32 + 8 * g + 4 * hh) = u;
        }
    ssq += __shfl_xor(ssq, 32);
    if (hh == 0) ssy[tok * 16 + h] = ssq;
}

__device__ __forceinline__ void phase_attn(const Params& P, int L, int rep = 0, int fake = 0) {
    char* ws = opq(P.ws);
    int* cnt = (int*)(ws + OFF_CNT) + L * 64 + rep * 16;
    int* s_item = (int*)(smem + LDS_BYTES - 16);
    const float* cumF = (const float*)(ws + OFF_CUMF);
    bf16* Y = (bf16*)(ws + (fake ? OFF_PART : OFF_Y));
    float* ssy = fake ? (float*)(ws + OFF_PART + 40 * MBy) : (float*)(ws + OFF_SSY) + (size_t)L * TOK * 16;
    const int half = opaque_tid() >> 8;
    char* lds = smem + half * 65536;
    for (;;) {
        if (opaque_tid() == 0) { int z0 = 0; asm volatile("" : "+v"(z0)); *s_item = atomicAdd(cnt, 1); s_item[-4] = z0; s_item[-3] = z0; }
        __syncthreads();
        int pair = *s_item;
        __syncthreads();
        if (pair >= 768) break;
        int item = pair * 2 + half;
        int qb = 15 - item / 96;
        int rem = item % 96;
        int type = rem >> 5, bh = rem & 31;
        int b = bh >> 2, h = bh & 3;
        if (type == 0) {
            attn_item<2, 96, 128>((const bf16*)(ws + OFF_MQ), 384, (const bf16*)(ws + OFF_MK), 384, (const bf16*)(ws + OFF_MVT), cumF,
                                  Y + 512, ssy + 8, b, h, qb, 0.10206207261596577f * LOG2E, lds, fake);
        } else if (type == 1) {
            attn_item<1, 64, 64>((const bf16*)(ws + OFF_SQ), 256, (const bf16*)(ws + OFF_SKK), 256, (const bf16*)(ws + OFF_SVT), cumF,
                                 Y + 256, ssy + 4, b, h, qb, 0.125f * LOG2E, lds, fake);
        } else {
            attn_item<0, 64, 64>((const bf16*)(ws + OFF_FQ), 256, (const bf16*)(ws + OFF_FK), 256, (const bf16*)(ws + OFF_FVT), cumF,
                                 Y + 0, ssy + 0, b, h, qb, 0.125f * LOG2E, lds, fake);
        }
    }
}

__device__ __forceinline__ void rowss_flush(float (&part)[2][16], float* gss, int m0, int nt) {
    float* lss = (float*)smem;
    const int tid = opaque_tid(), w = tid >> 6, l = tid & 63, hh = l >> 5, wm = w >> 1, wn = w & 1;
#pragma unroll
    for (int i = 0; i < 2; ++i)
#pragma unroll
        for (int rr = 0; rr < 16; ++rr) {
            float v = part[i][rr];
            v = dpp_add<0xB1>(v); v = dpp_add<0x4E>(v); v = dpp_add<0x141>(v); v = dpp_add<0x140>(v);
            v += __shfl_xor(v, 16);
            if ((l & 31) == 0) lss[wn * 256 + wm * 64 + i * 32 + (rr & 3) + 8 * (rr >> 2) + 4 * hh] = v;
        }
    __syncthreads();
    if (tid < 256) gss[(size_t)(m0 + tid) * 8 + nt] = lss[tid] + lss[256 + tid];
    __syncthreads();
}

__device__ __forceinline__ float sum_fq(float v) {
    float a = v, b = v;
    asm volatile("s_nop 1\n\tv_permlane16_swap_b32 %0, %1\n\ts_nop 1" : "+v"(a), "+v"(b));
    v = a + b; a = v; b = v;
    asm volatile("s_nop 1\n\tv_permlane32_swap_b32 %0, %1\n\ts_nop 1" : "+v"(a), "+v"(b));
    return a + b;
}
__device__ __forceinline__ void residual_fused(const f32x4 (&acc)[2][2][4][2], const pg8::Unit& u, int wr, int wc, int fr, int fqd,
                                               const float* rowscale  , const float* hin, float* hout, bf16* hb_out, float* gss) {
    float* lss = (float*)smem;
#pragma unroll
    for (int ai = 0; ai < 2; ++ai)
#pragma unroll
        for (int m = 0; m < 4; ++m) {
            const int rl = 128 * ai + 64 * wr + 16 * m + fr, row = u.pm * 256 + rl;
            const float sc = rowscale ? rowscale[rl] : 1.f;
#pragma unroll
            for (int bj = 0; bj < 2; ++bj) {
                const int col = u.pn * 256 + 128 * bj + 32 * wc + 8 * fqd;
                const f32x4* hp = (const f32x4*)(hin + (size_t)row * 1024 + col);
                f32x4 v0 = hp[0] + acc[ai][bj][m][0] * sc, v1 = hp[1] + acc[ai][bj][m][1] * sc;
                f32x4* op = (f32x4*)(hout + (size_t)row * 1024 + col);
                op[0] = v0; op[1] = v1;
                u32x4 wv = {pack2(v0[0], v0[1]), pack2(v0[2], v0[3]), pack2(v1[0], v1[1]), pack2(v1[2], v1[3])};
                *(u32x4*)(hb_out + (size_t)row * LDH + col) = wv;
                float ss = (v0[0] * v0[0] + v0[1] * v0[1]) + (v0[2] * v0[2] + v0[3] * v0[3]) + (v1[0] * v1[0] + v1[1] * v1[1]) + (v1[2] * v1[2] + v1[3] * v1[3]);
                ss = sum_fq(ss);
                if (fqd == 0) lss[(wc * 256 + rl) * 2 + bj] = ss;
            }
        }
    __syncthreads();
    const int tid = opaque_tid();
    if (tid < 256) {
        const int row = u.pm * 256 + tid;
#pragma unroll
        for (int bj = 0; bj < 2; ++bj)
            gss[(size_t)row * 8 + u.pn * 2 + bj] = (lss[(0 * 256 + tid) * 2 + bj] + lss[(1 * 256 + tid) * 2 + bj]) + (lss[(2 * 256 + tid) * 2 + bj] + lss[(3 * 256 + tid) * 2 + bj]);
    }
    __syncthreads();
}
struct EpiWo {
    static constexpr bool PERM = true, AFTER_DRAIN = true;
    const float* hin; float* hout; bf16* hb_out; float* gss;
    __device__ __forceinline__ void khook(int t, f32x4 (&acc)[2][2][4][2], int wr, int fr) const {
        if (t == 4 || t == 8) {
            const float* fac = (const float*)(smem + LDS_AUX) + (t == 4 ? 0 : 256);
#pragma unroll
            for (int ai = 0; ai < 2; ++ai)
#pragma unroll
                for (int m = 0; m < 4; ++m) {
                    const float f = fac[128 * ai + 64 * wr + 16 * m + fr];
#pragma unroll
                    for (int bj = 0; bj < 2; ++bj) { acc[ai][bj][m][0] *= f; acc[ai][bj][m][1] *= f; }
                }
        }
    }
    __device__ __forceinline__ void operator()(const f32x4 (&)[2][2][4][2], const pg8::Unit&, int, int, int, int) const {}
    __device__ __forceinline__ void fused(const f32x4 (&acc)[2][2][4][2], const pg8::Unit& u, int wr, int wc, int fr, int fqd, PG8_LAS unsigned char*, int, int) const {
        residual_fused(acc, u, wr, wc, fr, fqd, (const float*)(smem + LDS_AUX) + 512, hin, hout, hb_out, gss);
    }
};
__device__ __forceinline__ void phase_wo(const Params& P, int L, int hsel, int ss_slot) {
    char* ws = opq(P.ws);
    float* ss_out = (float*)(ws + OFF_SSA) + (size_t)ss_slot * TOK * 8;
    bf16* hb_out = (bf16*)(ws + (hsel ? OFF_HB1 : OFF_HB0));
    const float* hin = (L == 0) ? opq(P.x) : (const float*)opq(P.out);
    float* hout = opq(P.out);
    const bf16* Y = (const bf16*)(ws + OFF_Y);
    const bf16* Bt = (const bf16*)(ws + OFF_WO) + (size_t)L * 1024 * LDH;
    const float* ssy = (const float*)(ws + OFF_SSY) + (size_t)L * TOK * 16;
    float* aux = (float*)(smem + LDS_AUX);
    const int tid = opaque_tid();
    pg8::Gemm g{Y, Bt, LDH, LDH, TOK, 1024, 1024};
    pg8::StaticOrder S; S.init(TOK, 1024, gridDim.x, blockIdx.x);
    pg8::Unit u0;
    if (S.next(0, u0) && tid < 256) {
        int row = u0.pm * 256 + tid;
        float4 v0 = *(const float4*)(ssy + (size_t)row * 16), v1 = *(const float4*)(ssy + (size_t)row * 16 + 4), v2 = *(const float4*)(ssy + (size_t)row * 16 + 8);
        float r0 = rsqrtf(((v0.x + v0.y) + (v0.z + v0.w)) * (1.f / 256.f) + EPSF);
        float r1 = rsqrtf(((v1.x + v1.y) + (v1.z + v1.w)) * (1.f / 256.f) + EPSF);
        float r2 = rsqrtf(((v2.x + v2.y) + (v2.z + v2.w)) * (1.f / 512.f) + EPSF);
        aux[tid] = r0 / r1; aux[256 + tid] = r1 / r2; aux[512 + tid] = r2;
    }
    __syncthreads();
    EpiWo E{hin, hout, hb_out, ss_out};
    pg8::gemm_phase((PG8_LAS unsigned char*)smem, g, S, E, nullptr);
    __syncthreads();
}

struct EpiPq {
    static constexpr bool PERM = true, AFTER_DRAIN = false;
    bf16* O; const float* ssrow;
    __device__ __forceinline__ void khook(int, f32x4 (&)[2][2][4][2], int, int) const {}
    __device__ __forceinline__ void operator()(const f32x4 (&acc)[2][2][4][2], const pg8::Unit& u, int wr, int wc, int fr, int fq) const {
        const int row0 = u.pm * 256 + wr * 64 + fr, col0 = u.pn * 256 + wc * 32 + 8 * fq;
#pragma unroll
        for (int ai = 0; ai < 2; ++ai)
#pragma unroll
            for (int m = 0; m < 4; ++m) {
                const int row = row0 + ai * 128 + m * 16;
                const float rs = row_rs8(ssrow, row);
                bf16* rowp = O + (size_t)row * 1024 + col0;
#pragma unroll
                for (int bj = 0; bj < 2; ++bj) {
                    f32x4 v0 = acc[ai][bj][m][0] * rs, v1 = acc[ai][bj][m][1] * rs;
                    u32x4 wv = {pack2(v0[0], v0[1]), pack2(v0[2], v0[3]), pack2(v1[0], v1[1]), pack2(v1[2], v1[3])};
                    *(u32x4*)(rowp + bj * 128) = wv;
                }
            }
    }
};
__device__ __forceinline__ void phase_pq(const Params& P, int L, int hsel, int ss_slot) {
    char* ws = opq(P.ws);
    const float* ssrow = (const float*)(ws + OFF_SSA) + (size_t)ss_slot * TOK * 8;
    const bf16* hb = (const bf16*)(ws + (hsel ? OFF_HB1 : OFF_HB0));
    const bf16* Bt = (const bf16*)(ws + OFF_WQ) + (size_t)L * 1024 * LDH;
    pg8::Gemm g{hb, Bt, LDH, LDH, TOK, 1024, 1024};
    pg8::StaticOrder S; S.init(TOK, 1024, gridDim.x, blockIdx.x);
    EpiPq E{(bf16*)(ws + OFF_PQ), ssrow};
    pg8::gemm_phase((PG8_LAS unsigned char*)smem, g, S, E, nullptr);
    __syncthreads();
}

__device__ __forceinline__ void cswap(int& a, int& b) { int mx = max(a, b), mn = min(a, b); a = mx; b = mn; }
__device__ __forceinline__ void bitonic_sort16(int (&v)[16]) {
#pragma unroll
    for (int k = 2; k <= 16; k <<= 1)
#pragma unroll
        for (int j = k >> 1; j > 0; j >>= 1)
#pragma unroll
            for (int i = 0; i < 16; ++i) {
                int q = i ^ j;
                if (q > i) {
                    if ((i & k) == 0) cswap(v[i], v[q]); else cswap(v[q], v[i]);
                }
            }
}
__device__ __forceinline__ void merge_top16(int (&Lv)[16], const int (&Rv)[16]) {
#pragma unroll
    for (int i = 0; i < 16; ++i) Lv[i] = max(Lv[i], Rv[15 - i]);
#pragma unroll
    for (int j = 8; j > 0; j >>= 1)
#pragma unroll
        for (int i = 0; i < 16; ++i) {
            int q = i ^ j;
            if (q > i) cswap(Lv[i], Lv[q]);
        }
}
__device__ __forceinline__ int f2key(float v, int low, int mask) {
    int b = __float_as_int(v);
    b ^= (b >> 31) & 0x7fffffff;
    return (b & ~mask) | low;
}
__device__ __forceinline__ float key2f(int k, int mask) {
    int b = k & ~mask;
    b ^= (b >> 31) & 0x7fffffff;
    return __int_as_float(b);
}

__device__ __forceinline__ void phase_topk(const Params& P, int L) {
    char* ws = opq(P.ws);
    const bf16* pq = (const bf16*)(ws + OFF_PQ);
    const bf16* skb = (const bf16*)(ws + OFF_SKB) + (size_t)L * 16 * 128 * 64;
    unsigned short* ids = (unsigned short*)(ws + OFF_IDS);
    float* gates = (float*)(ws + OFF_GATE);
    const int tid = opaque_tid(), w = tid >> 6, l = tid & 63, r = l & 31, hh = l >> 5;
    unsigned char* lidx = (unsigned char*)(smem + w * 1024 + r * 32);
    for (int task = blockIdx.x * NW + w; task < (TOK / 32) * 8; task += gridDim.x * NW) {
        const int t0 = (task >> 3) * 32, h = task & 7;
        int F[2][16];
#pragma unroll
        for (int p = 0; p < 2; ++p) {
            const int hp = h * 2 + p;
            f32x16 acc[4];
            const f32x16 z16 = {0.f, 0.f, 0.f, 0.f, 0.f, 0.f, 0.f, 0.f, 0.f, 0.f, 0.f, 0.f, 0.f, 0.f, 0.f, 0.f};
#pragma unroll
            for (int kt = 0; kt < 4; ++kt) acc[kt] = z16;
#pragma unroll
            for (int s4 = 0; s4 < 4; ++s4) {
                bf16x8 bfr = *(const bf16x8*)(pq + (size_t)(t0 + r) * 1024 + hp * 64 + 16 * s4 + 8 * hh);
#pragma unroll
                for (int kt = 0; kt < 4; ++kt) {
                    bf16x8 af = *(const bf16x8*)(skb + ((size_t)hp * 128 + 32 * kt + r) * 64 + 16 * s4 + 8 * hh);
                    acc[kt] = __builtin_amdgcn_mfma_f32_32x32x16_bf16(af, bfr, acc[kt], 0, 0, 0);
                }
            }
            int K0[16], K1[16], K2[16], K3[16];
#pragma unroll
            for (int rr = 0; rr < 16; ++rr) {
                const int nb = (rr & 3) + 8 * (rr >> 2) + 4 * hh;
                K0[rr] = f2key(acc[0][rr], 127 - nb, 127);
                K1[rr] = f2key(acc[1][rr], 127 - (32 + nb), 127);
                K2[rr] = f2key(acc[2][rr], 127 - (64 + nb), 127);
                K3[rr] = f2key(acc[3][rr], 127 - (96 + nb), 127);
            }
            bitonic_sort16(K0); bitonic_sort16(K1); bitonic_sort16(K2); bitonic_sort16(K3);
            merge_top16(K0, K1);
            merge_top16(K2, K3);
            merge_top16(K0, K2);
#pragma unroll
            for (int i = 0; i < 16; ++i) K1[i] = partner32(K0[i], hh);
            merge_top16(K0, K1);
#pragma unroll
            for (int i = 0; i < 16; ++i) F[p][i] = K0[i];
        }
        if (hh == 0) {
#pragma unroll
            for (int q = 0; q < 4; ++q) {
                unsigned w1 = 0, w2 = 0;
#pragma unroll
                for (int e = 0; e < 4; ++e) {
                    w1 |= (unsigned)(127 - (F[0][4 * q + e] & 127)) << (8 * e);
                    w2 |= (unsigned)(127 - (F[1][4 * q + e] & 127)) << (8 * e);
                }
                ((unsigned*)lidx)[q] = w1;
                ((unsigned*)lidx)[4 + q] = w2;
            }
        }
        {
            float s1[16], s2[16];
#pragma unroll
            for (int i = 0; i < 16; ++i) { s1[i] = key2f(F[0][i], 127); s2[i] = key2f(F[1][i], 127); }
            int Lc[16], X[16];
#pragma unroll
            for (int b2 = 0; b2 < 16; ++b2) Lc[b2] = f2key(s1[0] + s2[b2], 255 - b2, 255);
#pragma unroll
            for (int a2 = 1; a2 < 16; ++a2) X[a2 - 1] = f2key(s1[a2] + s2[0], 255 - a2 * 16, 255);
            X[15] = INT_MIN;
            merge_top16(Lc, X);
            X[0] = f2key(s1[1] + s2[1], 255 - 17, 255); X[1] = f2key(s1[1] + s2[2], 255 - 18, 255); X[2] = f2key(s1[1] + s2[3], 255 - 19, 255);
            X[3] = f2key(s1[1] + s2[4], 255 - 20, 255); X[4] = f2key(s1[1] + s2[5], 255 - 21, 255); X[5] = f2key(s1[1] + s2[6], 255 - 22, 255);
            X[6] = f2key(s1[1] + s2[7], 255 - 23, 255);
            X[7] = f2key(s1[2] + s2[1], 255 - 33, 255); X[8] = f2key(s1[2] + s2[2], 255 - 34, 255); X[9] = f2key(s1[2] + s2[3], 255 - 35, 255);
            X[10] = f2key(s1[2] + s2[4], 255 - 36, 255);
            X[11] = f2key(s1[3] + s2[1], 255 - 49, 255); X[12] = f2key(s1[3] + s2[2], 255 - 50, 255); X[13] = f2key(s1[3] + s2[3], 255 - 51, 255);
            X[14] = f2key(s1[4] + s2[1], 255 - 65, 255); X[15] = f2key(s1[4] + s2[2], 255 - 66, 255);
            bitonic_sort16(X);
            merge_top16(Lc, X);
            X[0] = f2key(s1[5] + s2[1], 255 - 81, 255);
            X[1] = f2key(s1[6] + s2[1], 255 - 97, 255);
            X[2] = f2key(s1[7] + s2[1], 255 - 113, 255);
#pragma unroll
            for (int i = 3; i < 16; ++i) X[i] = INT_MIN;
            merge_top16(Lc, X);
            if (hh == 0) {
                float mx = key2f(Lc[0], 255);
                float ev[16], sum = 0.f;
#pragma unroll
                for (int k = 0; k < 16; ++k) { ev[k] = __expf(key2f(Lc[k], 255) - mx); sum += ev[k]; }
                float inv = 1.f / sum;
                size_t ob = (size_t)(t0 + r) * 128 + h * 16;
                unsigned idw[8];
#pragma unroll
                for (int k = 0; k < 16; ++k) {
                    int cidx = 255 - (Lc[k] & 255);
                    int i1 = lidx[cidx >> 4], i2 = lidx[16 + (cidx & 15)];
                    unsigned idv = (unsigned)(i1 * 128 + i2);
                    if (k & 1) idw[k >> 1] |= idv << 16; else idw[k >> 1] = idv;
                }
                u32x4 o0 = {idw[0], idw[1], idw[2], idw[3]}, o1 = {idw[4], idw[5], idw[6], idw[7]};
                *(u32x4*)(ids + ob) = o0;
                *(u32x4*)(ids + ob + 8) = o1;
#pragma unroll
                for (int q = 0; q < 4; ++q) {
                    f32x4 g4 = {ev[4 * q] * inv, ev[4 * q + 1] * inv, ev[4 * q + 2] * inv, ev[4 * q + 3] * inv};
                    *(f32x4*)(gates + ob + 4 * q) = g4;
                }
            }
        }
    }
}

__device__ __forceinline__ float gelu_exact(float x) { return 0.5f * x * (1.f + erff(x * 0.70710678118654752f)); }

__device__ __forceinline__ void dec16(const u32x4& v, float (&f)[16]) {
    f32x2 t;
    t = __builtin_amdgcn_cvt_pk_f32_fp8((int)v.x, false); f[0] = t.x; f[1] = t.y;
    t = __builtin_amdgcn_cvt_pk_f32_fp8((int)v.x, true);  f[2] = t.x; f[3] = t.y;
    t = __builtin_amdgcn_cvt_pk_f32_fp8((int)v.y, false); f[4] = t.x; f[5] = t.y;
    t = __builtin_amdgcn_cvt_pk_f32_fp8((int)v.y, true);  f[6] = t.x; f[7] = t.y;
    t = __builtin_amdgcn_cvt_pk_f32_fp8((int)v.z, false); f[8] = t.x; f[9] = t.y;
    t = __builtin_amdgcn_cvt_pk_f32_fp8((int)v.z, true);  f[10] = t.x; f[11] = t.y;
    t = __builtin_amdgcn_cvt_pk_f32_fp8((int)v.w, false); f[12] = t.x; f[13] = t.y;
    t = __builtin_amdgcn_cvt_pk_f32_fp8((int)v.w, true);  f[14] = t.x; f[15] = t.y;
}

__device__ __forceinline__ void dec32(const u32x4& v, f32x2 (&f)[16]) {
    f[0] = __builtin_amdgcn_cvt_scalef32_pk_f32_fp4(v.x, 1.0f, 0); f[1] = __builtin_amdgcn_cvt_scalef32_pk_f32_fp4(v.x, 1.0f, 1);
    f[2] = __builtin_amdgcn_cvt_scalef32_pk_f32_fp4(v.x, 1.0f, 2); f[3] = __builtin_amdgcn_cvt_scalef32_pk_f32_fp4(v.x, 1.0f, 3);
    f[4] = __builtin_amdgcn_cvt_scalef32_pk_f32_fp4(v.y, 1.0f, 0); f[5] = __builtin_amdgcn_cvt_scalef32_pk_f32_fp4(v.y, 1.0f, 1);
    f[6] = __builtin_amdgcn_cvt_scalef32_pk_f32_fp4(v.y, 1.0f, 2); f[7] = __builtin_amdgcn_cvt_scalef32_pk_f32_fp4(v.y, 1.0f, 3);
    f[8] = __builtin_amdgcn_cvt_scalef32_pk_f32_fp4(v.z, 1.0f, 0); f[9] = __builtin_amdgcn_cvt_scalef32_pk_f32_fp4(v.z, 1.0f, 1);
    f[10] = __builtin_amdgcn_cvt_scalef32_pk_f32_fp4(v.z, 1.0f, 2); f[11] = __builtin_amdgcn_cvt_scalef32_pk_f32_fp4(v.z, 1.0f, 3);
    f[12] = __builtin_amdgcn_cvt_scalef32_pk_f32_fp4(v.w, 1.0f, 0); f[13] = __builtin_amdgcn_cvt_scalef32_pk_f32_fp4(v.w, 1.0f, 1);
    f[14] = __builtin_amdgcn_cvt_scalef32_pk_f32_fp4(v.w, 1.0f, 2); f[15] = __builtin_amdgcn_cvt_scalef32_pk_f32_fp4(v.w, 1.0f, 3);
}

typedef _Float16 f16x2 __attribute__((ext_vector_type(2)));
__device__ __forceinline__ void dec8_f16(unsigned x, f16x2 (&wv)[4]) {
    const unsigned lo = x & 0x07070707u, hi = (x >> 4) & 0x07070707u;
    const unsigned Lb = __builtin_amdgcn_perm(0x46444240u, 0x3E3C3800u, lo) | ((x & 0x08080808u) << 4);
    const unsigned Hb = __builtin_amdgcn_perm(0x46444240u, 0x3E3C3800u, hi) | (x & 0x80808080u);
    wv[0] = __builtin_bit_cast(f16x2, __builtin_amdgcn_perm(Hb, Lb, 0x040c000cu));
    wv[1] = __builtin_bit_cast(f16x2, __builtin_amdgcn_perm(Hb, Lb, 0x050c010cu));
    wv[2] = __builtin_bit_cast(f16x2, __builtin_amdgcn_perm(Hb, Lb, 0x060c020cu));
    wv[3] = __builtin_bit_cast(f16x2, __builtin_amdgcn_perm(Hb, Lb, 0x070c030cu));
}

__device__ __forceinline__ int idof16(const u32x4 (&q)[2], int i) {
    unsigned wv = (i >> 1) == 0 ? q[0].x : (i >> 1) == 1 ? q[0].y : (i >> 1) == 2 ? q[0].z : (i >> 1) == 3 ? q[0].w
                : (i >> 1) == 4 ? q[1].x : (i >> 1) == 5 ? q[1].y : (i >> 1) == 6 ? q[1].z : q[1].w;
    return (i & 1) ? (int)(wv >> 16) : (int)(wv & 0xffffu);
}
__device__ __forceinline__ void phase_gather_u(const Params& P, int L) {
    char* ws = opq(P.ws);
    const unsigned char* U4 = (const unsigned char*)(ws + OFF_UB) + (size_t)L * NEXP * 512;
    float* part = (float*)(ws + OFF_PART);
    const unsigned short* ids = (const unsigned short*)(ws + OFF_IDS);
    const float* hin = opq(P.out);
    const int tid = opaque_tid(), w = tid >> 6, l = tid & 63, c = l & 7, gq = l >> 3;
    const int sl = blockIdx.x & 3, par = (blockIdx.x >> 2) & 1, rk = blockIdx.x >> 3, nb = gridDim.x >> 3;
    if (rk >= nb) return;
    const unsigned char* ubase = U4 + (size_t)sl * NEXP * 128 + c * 16;
    const int stride = nb * NW;
    int ti = rk * NW + w;
    if (ti >= TOK / 2) return;
    u32x4 idA[2], idB[2];
    u32x4 rv[16];
    f32x4 hA[8], hB[8];
    auto load_ids = [&](int tt, u32x4 (&idq)[2]) {
        const u32x4* i4 = (const u32x4*)(ids + (size_t)tt * 128 + 16 * gq);
        idq[0] = i4[0]; idq[1] = i4[1];
    };
    auto load_hx = [&](int tt, f32x4 (&hx)[8]) {
        const f32x4* h4 = (const f32x4*)(hin + (size_t)tt * 1024 + 256 * sl + 32 * c);
#pragma unroll
        for (int q = 0; q < 8; ++q) hx[q] = h4[q];
    };
    auto step = [&](int tcur, int tnext, int tnext2, const u32x4 (&idn)[2], u32x4 (&idl)[2], const f32x4 (&hc)[8], f32x4 (&hn)[8]) {
        load_ids(tnext2, idl);
        load_hx(tnext, hn);
        __builtin_amdgcn_sched_barrier(0);
        float pr[16];
#pragma unroll
        for (int i = 0; i < 16; ++i) {
            f32x2 f[16];
            asm volatile("" : "+v"(rv[i].x), "+v"(rv[i].y), "+v"(rv[i].z), "+v"(rv[i].w));
            dec32(rv[i], f);
            rv[i] = *(const u32x4*)(ubase + (size_t)idof16(idn, i) * 128);
            __builtin_amdgcn_sched_barrier(0);
            f32x2 s2 = {0.f, 0.f};
#pragma unroll
            for (int q = 0; q < 8; ++q) {
                f32x2 x0 = {hc[q].x, hc[q].y}, x1 = {hc[q].z, hc[q].w};
                s2 = __builtin_elementwise_fma(f[2 * q], x0, s2);
                s2 = __builtin_elementwise_fma(f[2 * q + 1], x1, s2);
            }
            float sacc = s2.x + s2.y;
            asm volatile("" : "+v"(sacc));
            pr[i] = sacc;
        }
#pragma unroll
        for (int i = 0; i < 16; ++i) pr[i] = sum8_dpp(pr[i]);
        if (c == 0) {
            f32x4* o4 = (f32x4*)(part + ((size_t)sl * TOK + tcur) * 128 + 16 * gq);
#pragma unroll
            for (int q = 0; q < 4; ++q) { f32x4 o = {pr[4 * q], pr[4 * q + 1], pr[4 * q + 2], pr[4 * q + 3]}; o4[q] = o; }
        }
    };
    auto tok = [&](int tidx, int fb) { return 2 * (tidx < TOK / 2 ? tidx : fb) + par; };
    load_ids(tok(ti, ti), idA);
#pragma unroll
    for (int i = 0; i < 16; ++i) rv[i] = *(const u32x4*)(ubase + (size_t)idof16(idA, i) * 128);
    load_hx(tok(ti, ti), hA);
    load_ids(tok(ti + stride, ti), idB);
    for (;;) {
        int tn = ti + stride, tn2 = ti + 2 * stride;
        step(tok(ti, ti), tok(tn, ti), tok(tn2, ti), idB, idA, hA, hB);
        if (tn >= TOK / 2) break;
        ti = tn; tn = ti + stride; tn2 = ti + 2 * stride;
        step(tok(ti, ti), tok(tn, ti), tok(tn2, ti), idA, idB, hB, hA);
        if (tn >= TOK / 2) break;
        ti = tn;
    }
}

__device__ __forceinline__ void phase_gather_act(const Params& P, int L, int ss_slot) {
    char* ws = opq(P.ws);
    const float* ss_ffn = (const float*)(ws + OFF_SSA) + (size_t)ss_slot * TOK * 8;
    const float* part = (const float*)(ws + OFF_PART);
    const unsigned short* ids = (const unsigned short*)(ws + OFF_IDS);
    float* gates = (float*)(ws + OFF_GATE);
    const float* uinv = (const float*)(ws + OFF_TSC) + L * NEXP;
    const float* vinv = (const float*)(ws + OFF_TSC) + (2 + L) * NEXP;
    const int tid = opaque_tid(), w = tid >> 6, l = tid & 63;
    for (int t = blockIdx.x * NW + w; t < TOK; t += gridDim.x * NW) {
        float rs = row_rs8(ss_ffn, t);
#pragma unroll
        for (int hsel = 0; hsel < 2; ++hsel) {
            int k = l + 64 * hsel;
            float sacc = 0.f;
#pragma unroll
            for (int j = 0; j < 4; ++j) sacc += part[((size_t)j * TOK + t) * 128 + k];
            int id = ids[(size_t)t * 128 + k];
            float pre = sacc * rs * uinv[id];
            gates[(size_t)t * 128 + k] = gates[(size_t)t * 128 + k] * gelu_exact(pre) * vinv[id];
        }
    }
}

__device__ __forceinline__ void phase_gather_v(const Params& P, int L, int hsel, int ss_slot) {
    char* ws = opq(P.ws);
    float* ss_ple = (float*)(ws + OFF_SSA) + (size_t)ss_slot * TOK * 8;
    bf16* hb_out = (bf16*)(ws + (hsel ? OFF_HB1 : OFF_HB0));
    const unsigned char* V4 = (const unsigned char*)(ws + OFF_VB) + (size_t)L * NEXP * 512;
    const unsigned short* ids = (const unsigned short*)(ws + OFF_IDS);
    const float* act = (const float*)(ws + OFF_GATE);
    float* hio = opq(P.out);
    const int tid = opaque_tid(), w = tid >> 6, l = tid & 63, c = l & 7, gq = l >> 3;
    const int sl = blockIdx.x & 3, par = (blockIdx.x >> 2) & 1, rk = blockIdx.x >> 3, nb = gridDim.x >> 3;
    if (rk >= nb) return;
    const unsigned char* vbase = V4 + (size_t)sl * NEXP * 128 + c * 16;
    const int stride = nb * NW;
    int ti = rk * NW + w;
    if (ti >= TOK / 2) return;
    const bool b3 = (l >> 3) & 1;
    u32x4 idA[2], idB[2];
    u32x4 rv[16];
    f32x4 aA[4], aB[4];
    auto load_ids = [&](int tt, u32x4 (&idq)[2]) {
        const u32x4* i4 = (const u32x4*)(ids + (size_t)tt * 128 + 16 * gq);
        idq[0] = i4[0]; idq[1] = i4[1];
    };
    auto load_a = [&](int tt, f32x4 (&ax)[4]) {
        const f32x4* a4 = (const f32x4*)(act + (size_t)tt * 128 + 16 * gq);
#pragma unroll
        for (int q = 0; q < 4; ++q) ax[q] = a4[q];
    };
    auto step = [&](int tcur, int tnext, int tnext2, const u32x4 (&idn)[2], u32x4 (&idl)[2], const f32x4 (&ac)[4], f32x4 (&an)[4]) {
        load_ids(tnext2, idl);
        load_a(tnext, an);
        __builtin_amdgcn_sched_barrier(0);
        f32x2 acc[16];
#pragma unroll
        for (int e = 0; e < 16; ++e) { acc[e].x = 0.f; acc[e].y = 0.f; }
#pragma unroll
        for (int i = 0; i < 16; ++i) {
            f32x2 f[16];
            asm volatile("" : "+v"(rv[i].x), "+v"(rv[i].y), "+v"(rv[i].z), "+v"(rv[i].w));
            dec32(rv[i], f);
            rv[i] = *(const u32x4*)(vbase + (size_t)idof16(idn, i) * 128);
            __builtin_amdgcn_sched_barrier(0);
            const float a = (i & 3) == 0 ? ac[i >> 2].x : (i & 3) == 1 ? ac[i >> 2].y : (i & 3) == 2 ? ac[i >> 2].z : ac[i >> 2].w;
            const f32x2 a2 = {a, a};
#pragma unroll
            for (int e = 0; e < 16; ++e) acc[e] = __builtin_elementwise_fma(f[e], a2, acc[e]);
#pragma unroll
            for (int e = 0; e < 16; ++e) asm volatile("" : "+v"(acc[e]));
        }
        float v8[8][2];
#pragma unroll
        for (int e = 0; e < 8; ++e) {
            float k0 = b3 ? acc[8 + e].x : acc[e].x, k1 = b3 ? acc[8 + e].y : acc[e].y;
            float s0 = b3 ? acc[e].x : acc[8 + e].x, s1 = b3 ? acc[e].y : acc[8 + e].y;
            v8[e][0] = k0 + __builtin_bit_cast(float, __builtin_amdgcn_update_dpp(0, __builtin_bit_cast(int, s0), 0x128, 0xf, 0xf, true));
            v8[e][1] = k1 + __builtin_bit_cast(float, __builtin_amdgcn_update_dpp(0, __builtin_bit_cast(int, s1), 0x128, 0xf, 0xf, true));
        }
        float v4[8];
#pragma unroll
        for (int e = 0; e < 8; ++e) {
            float X = v8[e >> 1][e & 1], Y = v8[4 + (e >> 1)][e & 1];
            asm volatile("s_nop 1\n\tv_permlane16_swap_b32 %0, %1\n\ts_nop 1" : "+v"(X), "+v"(Y));
            v4[e] = X + Y;
        }
        float v2[4];
#pragma unroll
        for (int e = 0; e < 4; ++e) {
            float X = v4[e], Y = v4[4 + e];
            asm volatile("s_nop 1\n\tv_permlane32_swap_b32 %0, %1\n\ts_nop 1" : "+v"(X), "+v"(Y));
            v2[e] = X + Y;
        }
        const int col = 256 * sl + 32 * c + 16 * ((l >> 3) & 1) + 8 * ((l >> 4) & 1) + 4 * (l >> 5);
        f32x4* h4 = (f32x4*)(hio + (size_t)tcur * 1024 + col);
        f32x4 hv = *h4;
        hv.x += v2[0]; hv.y += v2[1]; hv.z += v2[2]; hv.w += v2[3];
        *h4 = hv;
        u32x2 bb = {pack2(hv.x, hv.y), pack2(hv.z, hv.w)};
        *(u32x2*)(hb_out + (size_t)tcur * LDH + col) = bb;
        float ssq = hv.x * hv.x + hv.y * hv.y + hv.z * hv.z + hv.w * hv.w;
        ssq = wave_sum(ssq);
        if (l == 0) { ss_ple[(size_t)tcur * 8 + sl] = ssq; ss_ple[(size_t)tcur * 8 + 4 + sl] = 0.f; }
    };
    auto tok = [&](int tidx, int fb) { return 2 * (tidx < TOK / 2 ? tidx : fb) + par; };
    load_ids(tok(ti, ti), idA);
#pragma unroll
    for (int i = 0; i < 16; ++i) rv[i] = *(const u32x4*)(vbase + (size_t)idof16(idA, i) * 128);
    load_a(tok(ti, ti), aA);
    load_ids(tok(ti + stride, ti), idB);
    for (;;) {
        int tn = ti + stride, tn2 = ti + 2 * stride;
        step(tok(ti, ti), tok(tn, ti), tok(tn2, ti), idB, idA, aA, aB);
        if (tn >= TOK / 2) break;
        ti = tn; tn = ti + stride; tn2 = ti + 2 * stride;
        step(tok(ti, ti), tok(tn, ti), tok(tn2, ti), idA, idB, aB, aA);
        if (tn >= TOK / 2) break;
        ti = tn;
    }
}

__device__ __forceinline__ void phase_ple(const Params& P, int L, int hsel, int ss_slot_in, int ss_slot_out) {
    char* ws = opq(P.ws);
    const float* ss_ple = (const float*)(ws + OFF_SSA) + (size_t)ss_slot_in * TOK * 8;
    float* ss_out = (float*)(ws + OFF_SSA) + (size_t)ss_slot_out * TOK * 8;
    const bf16* hb_in = (const bf16*)(ws + (hsel ? OFF_HB1 : OFF_HB0));
    bf16* hb_out = (bf16*)(ws + (hsel ? OFF_HB0 : OFF_HB1));
    float* hio = opq(P.out);
    const bf16* pin = (const bf16*)(ws + OFF_PB) + (size_t)L * TOK * LDP;
    const bf16* Wg = (const bf16*)(ws + OFF_WG) + (size_t)L * 1024 * LDH;
    const bf16* Wp = (const bf16*)(ws + OFF_WP) + (size_t)L * 1024 * LDP;
    const int tid = opaque_tid(), w = tid >> 6, l = tid & 63, hh = l >> 5, wm = w >> 1, wn = w & 1;
    for (int it = 0;; ++it) {
        int mt, nt;
        if (!xcd_tile(it, 64, 8, mt, nt)) break;
        int m0 = mt * 256, n0 = nt * 128;
        float* aux = (float*)(smem + LDS_AUX);
        __syncthreads();
        if (tid < 256) aux[tid] = row_rs8(ss_ple, m0 + tid);
        f32x16 acc1[2][2], acc2[2][2];
        ZERO_ACC(acc1);
        ZERO_ACC(acc2);
        gemm_core(acc1, hb_in, LDH, Wg, LDH, 1024, m0, n0, NoHook());
        gemm_core(acc2, pin, LDP, Wp, LDP, 256, m0, n0, NoHook());
#pragma unroll
        for (int i = 0; i < 2; ++i)
#pragma unroll
            for (int rr = 0; rr < 16; ++rr) {
                float rs = aux[wm * 64 + i * 32 + (rr & 3) + 8 * (rr >> 2) + 4 * hh];
#pragma unroll
                for (int j = 0; j < 2; ++j) {
                    float gte = 1.f / (1.f + __expf(-acc1[i][j][rr] * rs));
                    acc2[i][j][rr] *= gte;
                }
            }
        stage_f32<false>(acc2, nullptr);
        residual_store(hio, hio, hb_out, ss_out, m0, n0, nt);
    }
}

__device__ __forceinline__ void phase_final(const Params& P, int ss_slot) {
    float* hio = opq(P.out);
    const float* ss = (const float*)(opq(P.ws) + OFF_SSA) + (size_t)ss_slot * TOK * 8;
    const int tid = opaque_tid(), w = tid >> 6, l = tid & 63;
    const float4* g4 = (const float4*)P.final_norm_g;
    for (int t = blockIdx.x * NW + w; t < TOK; t += gridDim.x * NW) {
        float rs = row_rs8(ss, t);
        float4* o4 = (float4*)(hio + (size_t)t * 1024);
#pragma unroll
        for (int i = 0; i < 4; ++i) {
            float4 v = o4[i * 64 + l], g = g4[i * 64 + l];
            v.x *= rs * g.x; v.y *= rs * g.y; v.z *= rs * g.z; v.w *= rs * g.w;
            o4[i * 64 + l] = v;
        }
    }
}

#define XB_TMO      128
#define XB_XCNT(j)  (256  + 64 * (j))
#define XB_XSUB(j)  (1280 + 64 * (j))
#define XB_XGEN(j)  (2304 + 64 * (j))
#define XB_TOP      3328
#define XB_TOPGEN   3392
#define XCD_BAR_WORDS 3456
#define XB_SPIN_CAP (1u << 22)
__device__ __forceinline__ unsigned xb_ld(unsigned* p) { return __hip_atomic_load(p, __ATOMIC_RELAXED, __HIP_MEMORY_SCOPE_AGENT); }
__device__ __forceinline__ unsigned xb_add(unsigned* p, unsigned v) { return __hip_atomic_fetch_add(p, v, __ATOMIC_RELAXED, __HIP_MEMORY_SCOPE_AGENT); }
__device__ __forceinline__ unsigned xb_xcc_id() { return (unsigned)__builtin_amdgcn_s_getreg((3 << 11) | 20) & 0xFu; }
#define XB_SPIN(cond, bar) do { unsigned _sp = 0; while (cond) { __builtin_amdgcn_s_sleep(1); \
    if ((++_sp & 255u) == 0u) { if (xb_ld(&(bar)[XB_TMO])) break; if (_sp > XB_SPIN_CAP) { atomicAdd(&(bar)[XB_TMO], 1u); break; } } } } while (0)
#define XB_LDS_OFF (LDS_BYTES - 64)
__device__ __forceinline__ void xcd_barrier_post(const Params& P) {
    if (threadIdx.x == 0) {
        unsigned* bar = (unsigned*)(P.ws + OFF_BAR);
        volatile __attribute__((address_space(3))) unsigned* st = (volatile __attribute__((address_space(3))) unsigned*)(smem + XB_LDS_OFF);
        st[0] = 0u; st[1] = 0u;
        (void)xb_add(&bar[XB_XCNT(xb_xcc_id())], 1u);
    }
}
__device__ __forceinline__ void xcd_barrier_complete(unsigned* bar, unsigned x, unsigned& nloc, unsigned& nx) {
    const unsigned G = gridDim.x;
    unsigned sum, cnt, mine, sp = 0u;
    for (;;) {
        sum = 0u; cnt = 0u; mine = 0u;
#pragma unroll
        for (unsigned j = 0; j < 16; ++j) { const unsigned c = xb_ld(&bar[XB_XCNT(j)]); sum += c; cnt += (c > 0u) ? 1u : 0u; mine = (j == x) ? c : mine; }
        if (sum == G) break;
        __builtin_amdgcn_s_sleep(1);
        if ((++sp & 255u) == 0u) { if (xb_ld(&bar[XB_TMO])) break; if (sp > XB_SPIN_CAP) { atomicAdd(&bar[XB_TMO], 1u); break; } }
    }
    nloc = mine > 0u ? mine : 1u; nx = cnt > 0u ? cnt : 1u;
}
__device__ __forceinline__ void grid_barrier(const Params& P) {
    asm volatile("s_waitcnt vmcnt(0)" ::: "memory");
    __syncthreads();
    if (threadIdx.x == 0) {
        unsigned* bar = (unsigned*)(P.ws + OFF_BAR);
        volatile __attribute__((address_space(3))) unsigned* st = (volatile __attribute__((address_space(3))) unsigned*)(smem + XB_LDS_OFF);
        const unsigned x = xb_xcc_id();
        __builtin_amdgcn_s_waitcnt(0);
        unsigned nloc = st[0], nx = st[1];
        if (nloc == 0u) { xcd_barrier_complete(bar, x, nloc, nx); st[0] = nloc; st[1] = nx; }
        const unsigned old = xb_add(&bar[XB_XSUB(x)], 1u);
        const unsigned gen = old / nloc;
        if (old + 1u == (gen + 1u) * nloc) {
            __builtin_amdgcn_fence(__ATOMIC_RELEASE, "agent");
            asm volatile("s_waitcnt vmcnt(0)" ::: "memory");
            const unsigned og = xb_add(&bar[XB_TOP], 1u);
            const unsigned tg = og / nx;
            if (og + 1u == (tg + 1u) * nx) xb_add(&bar[XB_TOPGEN], 1u);
            else XB_SPIN(xb_ld(&bar[XB_TOPGEN]) == tg, bar);
            __builtin_amdgcn_fence(__ATOMIC_ACQUIRE, "agent");
            xb_add(&bar[XB_XGEN(x)], 1u);
            asm volatile("s_waitcnt vmcnt(0)" ::: "memory");
        } else {
            XB_SPIN(xb_ld(&bar[XB_XGEN(x)]) == gen, bar);
            __builtin_amdgcn_fence(__ATOMIC_ACQUIRE, "agent");
            asm volatile("s_waitcnt vmcnt(0)" ::: "memory");
        }
    }
    __syncthreads();
}

__global__ void __launch_bounds__(NTHR, 2) hymba_megakernel(Params P) {
    cg::grid_group grid = cg::this_grid();
    char* ws = opq(P.ws);
    xcd_barrier_post(P);
#define BAR() do { grid_barrier(P); if (DUP == 20) grid_barrier(P); } while (0)
    phase0(P);
    if (DUP == 0) { asm volatile("s_waitcnt vmcnt(0)" ::: "memory"); __syncthreads(); grid_barrier(P); phase0(P); }
    asm volatile("s_waitcnt vmcnt(0)" ::: "memory");
    __syncthreads();
    grid.sync();
    BAR();
    int cur = 0;
    for (int L = 0; L < 2; ++L) {
        const int ss_mix = (L == 0) ? 0 : 3, ss_ffn = 1 + L, ss_next = (L == 0) ? 3 : 4, ss_ple = 5 + L;
        phase_proj(P, L, cur, ss_mix);
        BAR();
        if (DUP == 1) { phase_proj(P, L, cur, ss_mix); BAR(); }
        phase_mla_up(P, L);
        BAR();
        if (DUP == 2) { phase_mla_up(P, L); BAR(); }
        phase_attn(P, L, 0);
        BAR();
        if (DUP == 3) { phase_attn(P, L, 1); BAR(); }
        if (DUP >= 30 && DUP < 34) { phase_attn(P, L, 1, DUP - 30); BAR(); }
        phase_wo(P, L, cur ^ 1, ss_ffn);
        BAR();
        if (DUP == 4 && L == 0) { phase_wo(P, L, cur ^ 1, ss_ffn); BAR(); }
        phase_pq(P, L, cur ^ 1, ss_ffn);
        BAR();
        if (DUP == 5) { phase_pq(P, L, cur ^ 1, ss_ffn); BAR(); }
        phase_topk(P, L);
        BAR();
        if (DUP == 6) { phase_topk(P, L); BAR(); }
        phase_gather_u(P, L);
        BAR();
        if (DUP == 7) { phase_gather_u(P, L); BAR(); }
        phase_gather_act(P, L, ss_ffn);
        BAR();
        phase_gather_v(P, L, cur, ss_ple);
        BAR();
        phase_ple(P, L, cur, ss_ple, ss_next);
        BAR();
        cur ^= 1;
    }
    phase_final(P, 4);
}

extern "C" void kernel_launch(void* const* d_in, const int* in_sizes, int n_in, void* d_out, int out_size, void* d_ws,
                              size_t ws_size, hipStream_t stream) {
    static int grid_blocks = 0;
    if (!grid_blocks) {
        int dev = 0, cus = 0, per_cu = 0;
        hipGetDevice(&dev);
        hipDeviceGetAttribute(&cus, hipDeviceAttributeMultiprocessorCount, dev);
        hipOccupancyMaxActiveBlocksPerMultiprocessor(&per_cu, hymba_megakernel, NTHR, 0);
        if (per_cu > 1) per_cu = 1;
        if (per_cu < 1) per_cu = 1;
        grid_blocks = cus * per_cu;
        if (ws_size < WS_END) fprintf(stderr, "workspace too small: %zu < %zu\n", ws_size, (size_t)WS_END);
    }
    Params P{};
    P.x = (const float*)d_in[0]; P.p = (const float*)d_in[1]; P.pos = (const int*)d_in[2];
    P.norm_mix_g = (const float*)d_in[3]; P.w_in = (const float*)d_in[4]; P.b_forget = (const float*)d_in[5];
    P.mla_q_norm_g = (const float*)d_in[6]; P.w_uq = (const float*)d_in[7]; P.mla_kv_norm_g = (const float*)d_in[8];
    P.w_ukv = (const float*)d_in[9]; P.mix_out_norm_g = (const float*)d_in[10]; P.w_o = (const float*)d_in[11];
    P.norm_ffn_g = (const float*)d_in[12]; P.w_query = (const float*)d_in[13]; P.sub_keys = (const float*)d_in[14];
    P.peer_u = (const float*)d_in[15]; P.peer_v = (const float*)d_in[16]; P.w_ple = (const float*)d_in[17];
    P.ple_norm_g = (const float*)d_in[18]; P.w_ple_gate = (const float*)d_in[19]; P.final_norm_g = (const float*)d_in[20];
    P.out = (float*)d_out; P.ws = (char*)d_ws;
    hipMemsetAsync((char*)d_ws + OFF_BAR, 0, 16384 + 4096, stream);
    void* args[] = {&P};
    hipError_t e = hipLaunchCooperativeKernel((void*)hymba_megakernel, dim3(grid_blocks), dim3(NTHR), args, 0, stream);
    if (e != hipSuccess) fprintf(stderr, "cooperative launch failed: %s (grid %d)\n", hipGetErrorString(e), grid_blocks);
}
```

```cpp
#include <hip/hip_runtime.h>
#include <hip/hip_cooperative_groups.h>
#include <cstdio>
#include <cstdint>
#include <math.h>
#include <climits>
namespace cg = cooperative_groups;

typedef __bf16 bf16;
typedef __bf16 bf16x8 __attribute__((ext_vector_type(8)));
typedef __bf16 bf16x4 __attribute__((ext_vector_type(4)));
typedef __bf16 bf16x2 __attribute__((ext_vector_type(2)));
typedef float f32x16 __attribute__((ext_vector_type(16)));
typedef float f32x4 __attribute__((ext_vector_type(4)));
typedef float f32x2 __attribute__((ext_vector_type(2)));
typedef unsigned u32x4 __attribute__((ext_vector_type(4)));
typedef unsigned u32x2 __attribute__((ext_vector_type(2)));

#define SEQ 2048
#define BATCH 8
#define TOK 16384
#define DM 1024
#define IN_W 1956
#define NEXP 16384
#define EPSF 1e-6f
#define LOG2E 1.4426950408889634f
#define NTHR 512
#define NW 8
#define LDS_BYTES 151808
#define STAGE_BYTES 49152
#define LDS_AUX 147456
#ifndef DUP
#define DUP -1
#endif

constexpr size_t MBy = 1ull << 20;
constexpr size_t OFF_UB = 0;
constexpr size_t OFF_VB = 32 * MBy;
constexpr size_t OFF_PART = 64 * MBy;
#define LDH 1088
#define LDP 320
#define LDC 192
constexpr size_t OFF_WIN = 128 * MBy;
constexpr size_t OFF_WO = 137 * MBy;
constexpr size_t OFF_WQ = 142 * MBy;
constexpr size_t OFF_WG = 147 * MBy;
constexpr size_t OFF_WP = 152 * MBy;
constexpr size_t OFF_WUQ = 154 * MBy;
constexpr size_t OFF_WUKV = 155 * MBy;
constexpr size_t OFF_SKB = 156 * MBy;
constexpr size_t OFF_CS = 157 * MBy;
constexpr size_t OFF_TSC = 159 * MBy;
constexpr size_t OFF_SSA = 160 * MBy;
constexpr size_t OFF_HB0 = 164 * MBy;
constexpr size_t OFF_HB1 = 200 * MBy;
constexpr size_t OFF_FQ = 236 * MBy;
constexpr size_t OFF_FK = 244 * MBy;
constexpr size_t OFF_FVT = 252 * MBy;
constexpr size_t OFF_SQ = 260 * MBy;
constexpr size_t OFF_SKK = 268 * MBy;
constexpr size_t OFF_SVT = 276 * MBy;
constexpr size_t OFF_CQ = 284 * MBy;
constexpr size_t OFF_CKV = 295 * MBy;
constexpr size_t OFF_FLOG = 302 * MBy;
constexpr size_t OFF_CUMF = 303 * MBy;
constexpr size_t OFF_MQ = 304 * MBy;
constexpr size_t OFF_MK = 316 * MBy;
constexpr size_t OFF_MVT = 328 * MBy;
constexpr size_t OFF_Y = 344 * MBy;
constexpr size_t OFF_PQ = 380 * MBy;
constexpr size_t OFF_IDS = 412 * MBy;
constexpr size_t OFF_GATE = 420 * MBy;
constexpr size_t OFF_BAR = 428 * MBy;
constexpr size_t OFF_CNT = OFF_BAR + 16384;
constexpr size_t OFF_SSY = 429 * MBy;
constexpr size_t OFF_PB = 431 * MBy;
constexpr size_t WS_END = 452 * MBy;

struct Params {
    const float* x; const float* p; const int* pos;
    const float* norm_mix_g; const float* w_in; const float* b_forget; const float* mla_q_norm_g; const float* w_uq;
    const float* mla_kv_norm_g; const float* w_ukv; const float* mix_out_norm_g; const float* w_o; const float* norm_ffn_g;
    const float* w_query; const float* sub_keys; const float* peer_u; const float* peer_v; const float* w_ple;
    const float* ple_norm_g; const float* w_ple_gate; const float* final_norm_g;
    float* out; char* ws;
};

__shared__ __attribute__((aligned(16))) char smem[LDS_BYTES];

__device__ __forceinline__ int opaque_tid() { int t = threadIdx.x; asm volatile("" : "+v"(t)); return t; }
template <typename T> __device__ __forceinline__ T* opq(T* p) { size_t z = 0; asm volatile("" : "+s"(z)); return (T*)((char*)p + z); }

__device__ __forceinline__ unsigned pack2(float a, float b) {
    f32x2 v = {a, b};
    bf16x2 r = __builtin_convertvector(v, bf16x2);
    return __builtin_bit_cast(unsigned, r);
}
__device__ __forceinline__ float bflo(unsigned u) { return __uint_as_float(u << 16); }
__device__ __forceinline__ float bfhi(unsigned u) { return __uint_as_float(u & 0xffff0000u); }
__device__ __forceinline__ float wave_sum(float v) {
#pragma unroll
    for (int o = 32; o > 0; o >>= 1) v += __shfl_xor(v, o);
    return v;
}
template <int CTRL> __device__ __forceinline__ float dpp_add(float v) {
    return v + __builtin_bit_cast(float, __builtin_amdgcn_update_dpp(0, __builtin_bit_cast(int, v), CTRL, 0xf, 0xf, true));
}
__device__ __forceinline__ float sum8_dpp(float v) { v = dpp_add<0xB1>(v); v = dpp_add<0x4E>(v); v = dpp_add<0x141>(v); return v; }
__device__ __forceinline__ float sumg_dpp(float v) {
    v = dpp_add<0x128>(v);
    float a = v, b = v;
    asm volatile("s_nop 1\n\tv_permlane16_swap_b32 %0, %1\n\ts_nop 1" : "+v"(a), "+v"(b));
    v = a + b;
    a = v; b = v;
    asm volatile("s_nop 1\n\tv_permlane32_swap_b32 %0, %1\n\ts_nop 1" : "+v"(a), "+v"(b));
    return a + b;
}
__device__ __forceinline__ int partner32(int v, int hh) {
    int a = v, b = v;
    asm volatile("s_nop 1\n\tv_permlane32_swap_b32 %0, %1\n\ts_nop 1" : "+v"(a), "+v"(b));
    return hh ? a : b;
}
__device__ __forceinline__ float fexp2(float x) { return __builtin_amdgcn_exp2f(x); }
__device__ __forceinline__ float flog2(float x) { return __builtin_amdgcn_logf(x); }
__device__ __forceinline__ float log_sigmoid_f(float z) { return fminf(z, 0.f) - 0.6931471805599453f * flog2(1.f + fexp2(-1.4426950408889634f * fabsf(z))); }

struct WJob { const float* src; int lds; int K; int Np; bf16* dst; int ldd; const float* gain; int map; };

__device__ __forceinline__ int src_col_map(int map, int c) {
    if (map == 0) return c;
    if (map == 1) {
        if (c < 768) return c;
        if (c < 1952) return c + 4;
        if (c < 1956) return c - 1952 + 768;
        return -1;
    }
    if (c < 256) return 192 * (c >> 6) + (c & 63);
    int e = c - 256;
    return 192 * (e >> 7) + 64 + (e & 127);
}

__device__ __forceinline__ void wconv_tile(const WJob& j, int tile) {
    float* tl = (float*)smem;
    int ktiles = j.K >> 5;
    int nt = tile / ktiles, kt = tile % ktiles;
    int n0 = nt * 32, k0 = kt * 32;
    int tx = opaque_tid() & 31, ty = opaque_tid() >> 5;
    int sc = src_col_map(j.map, n0 + tx);
#pragma unroll
    for (int i = 0; i < 2; ++i) {
        int k = k0 + ty + 16 * i;
        float v = 0.f;
        if (sc >= 0) v = j.src[(size_t)k * j.lds + sc] * (j.gain ? j.gain[k] : 1.f);
        tl[(ty + 16 * i) * 33 + tx] = v;
    }
    __syncthreads();
#pragma unroll
    for (int i = 0; i < 2; ++i) {
        int n = n0 + ty + 16 * i;
        j.dst[(size_t)n * j.ldd + k0 + tx] = (bf16)tl[tx * 33 + ty + 16 * i];
    }
    __syncthreads();
}

__device__ __forceinline__ void phase0(const Params& P) {
    char* ws = opq(P.ws);
    const int G = gridDim.x, bid = blockIdx.x, tid = opaque_tid();
    {
        const int w = tid >> 6, l = tid & 63;
        float* tsc = (float*)(ws + OFF_TSC);
        for (int it = bid * NW + w; it < 4 * NEXP; it += G * NW) {
            int tb = it >> 14, e = it & (NEXP - 1);
            const float* src = (tb < 2 ? P.peer_u : P.peer_v) + ((size_t)(tb & 1) * NEXP + e) * DM + l * 16;
            unsigned char* dst = (unsigned char*)(ws + (tb < 2 ? OFF_UB : OFF_VB)) + (size_t)(tb & 1) * NEXP * 512;
            float4 a = ((const float4*)src)[0], b = ((const float4*)src)[1], c = ((const float4*)src)[2], d = ((const float4*)src)[3];
            if (tb < 2) {
                const float4* g4 = (const float4*)(P.norm_ffn_g + (tb & 1) * 1024 + l * 16);
                float4 g0 = g4[0], g1 = g4[1], g2 = g4[2], g3 = g4[3];
                a.x *= g0.x; a.y *= g0.y; a.z *= g0.z; a.w *= g0.w; b.x *= g1.x; b.y *= g1.y; b.z *= g1.z; b.w *= g1.w;
                c.x *= g2.x; c.y *= g2.y; c.z *= g2.z; c.w *= g2.w; d.x *= g3.x; d.y *= g3.y; d.z *= g3.z; d.w *= g3.w;
            }
            float am = fmaxf(fmaxf(fmaxf(fabsf(a.x), fabsf(a.y)), fmaxf(fabsf(a.z), fabsf(a.w))), fmaxf(fmaxf(fabsf(b.x), fabsf(b.y)), fmaxf(fabsf(b.z), fabsf(b.w))));
            am = fmaxf(am, fmaxf(fmaxf(fmaxf(fabsf(c.x), fabsf(c.y)), fmaxf(fabsf(c.z), fabsf(c.w))), fmaxf(fmaxf(fabsf(d.x), fabsf(d.y)), fmaxf(fabsf(d.z), fabsf(d.w)))));
#pragma unroll
            for (int o = 32; o > 0; o >>= 1) am = fmaxf(am, __shfl_xor(am, o));
            float sc = (am > 0.f) ? (6.0f / am) : 1.f, isc = (am > 0.f) ? (am * (1.f / 6.0f)) : 1.f;
            unsigned w0 = 0, w1 = 0;
            w0 = __builtin_amdgcn_cvt_scalef32_pk_fp4_f32(w0, a.x * sc, a.y * sc, 1.0f, 0);
            w0 = __builtin_amdgcn_cvt_scalef32_pk_fp4_f32(w0, a.z * sc, a.w * sc, 1.0f, 1);
            w0 = __builtin_amdgcn_cvt_scalef32_pk_fp4_f32(w0, b.x * sc, b.y * sc, 1.0f, 2);
            w0 = __builtin_amdgcn_cvt_scalef32_pk_fp4_f32(w0, b.z * sc, b.w * sc, 1.0f, 3);
            w1 = __builtin_amdgcn_cvt_scalef32_pk_fp4_f32(w1, c.x * sc, c.y * sc, 1.0f, 0);
            w1 = __builtin_amdgcn_cvt_scalef32_pk_fp4_f32(w1, c.z * sc, c.w * sc, 1.0f, 1);
            w1 = __builtin_amdgcn_cvt_scalef32_pk_fp4_f32(w1, d.x * sc, d.y * sc, 1.0f, 2);
            w1 = __builtin_amdgcn_cvt_scalef32_pk_fp4_f32(w1, d.z * sc, d.w * sc, 1.0f, 3);
            u32x2 o2 = {w0, w1};
            *(u32x2*)(dst + ((size_t)(l >> 4) * NEXP + e) * 128 + (l & 15) * 8) = o2;
            if (l == 0) tsc[tb * NEXP + e] = isc;
        }
    }
    {
        for (int L = 0; L < 2; ++L) {
            WJob jobs[7];
            jobs[0] = {P.w_in + (size_t)L * 1024 * IN_W, IN_W, 1024, 2048, (bf16*)(ws + OFF_WIN) + (size_t)L * 2048 * LDH, LDH, P.norm_mix_g + L * 1024, 1};
            jobs[1] = {P.w_o + (size_t)L * 1024 * 1024, 1024, 1024, 1024, (bf16*)(ws + OFF_WO) + (size_t)L * 1024 * LDH, LDH, P.mix_out_norm_g + L * 1024, 0};
            jobs[2] = {P.w_query + (size_t)L * 1024 * 1024, 1024, 1024, 1024, (bf16*)(ws + OFF_WQ) + (size_t)L * 1024 * LDH, LDH, P.norm_ffn_g + L * 1024, 0};
            jobs[3] = {P.w_ple_gate + (size_t)L * 1024 * 1024, 1024, 1024, 1024, (bf16*)(ws + OFF_WG) + (size_t)L * 1024 * LDH, LDH, P.ple_norm_g + L * 1024, 0};
            jobs[4] = {P.w_ple + (size_t)L * 256 * 1024, 1024, 256, 1024, (bf16*)(ws + OFF_WP) + (size_t)L * 1024 * LDP, LDP, nullptr, 0};
            jobs[5] = {P.w_uq + (size_t)L * 256 * 384, 384, 256, 384, (bf16*)(ws + OFF_WUQ) + (size_t)L * 384 * LDP, LDP, P.mla_q_norm_g + L * 256, 0};
            jobs[6] = {P.w_ukv + (size_t)L * 128 * 768, 768, 128, 768, (bf16*)(ws + OFF_WUKV) + (size_t)L * 768 * LDC, LDC, P.mla_kv_norm_g + L * 128, 2};
#pragma unroll
            for (int q = 0; q < 7; ++q) {
                int nt = (jobs[q].Np >> 5) * (jobs[q].K >> 5);
                for (int it = bid; it < nt; it += G) wconv_tile(jobs[q], it);
            }
        }
    }
    {
        const float* src = P.sub_keys;
        bf16* dst = (bf16*)(ws + OFF_SKB);
        for (int i = bid * NTHR + tid; i < 262144 / 2; i += G * NTHR) {
            float2 v = ((const float2*)src)[i];
            ((unsigned*)dst)[i] = pack2(v.x, v.y);
        }
    }
    {
        const float4* src = (const float4*)P.p;
        bf16* dst = (bf16*)(ws + OFF_PB);
        for (int i = bid * NTHR + tid; i < 2 * TOK * 256 / 8; i += G * NTHR) {
            float4 a = src[2 * i], b = src[2 * i + 1];
            u32x4 o = {pack2(a.x, a.y), pack2(a.z, a.w), pack2(b.x, b.y), pack2(b.z, b.w)};
            *(u32x4*)(dst + (size_t)(i >> 5) * LDP + (i & 31) * 8) = o;
        }
    }
    {
        bf16* hb = (bf16*)(ws + OFF_HB0);
        float* ss0 = (float*)(ws + OFF_SSA);
        int w = tid >> 6, l = tid & 63;
        for (int row = bid * NW + w; row < TOK; row += G * NW) {
            const float4* xr = (const float4*)(P.x + (size_t)row * DM);
            float ss = 0.f;
#pragma unroll
            for (int i = 0; i < 2; ++i) {
                float4 a = xr[i * 128 + l * 2], b = xr[i * 128 + l * 2 + 1];
                ss += a.x * a.x + a.y * a.y + a.z * a.z + a.w * a.w + b.x * b.x + b.y * b.y + b.z * b.z + b.w * b.w;
                uint4 o;
                o.x = pack2(a.x, a.y); o.y = pack2(a.z, a.w); o.z = pack2(b.x, b.y); o.w = pack2(b.z, b.w);
                ((uint4*)(hb + (size_t)row * LDH))[i * 64 + l] = o;
            }
            ss = wave_sum(ss);
            if (l == 0) {
                *(float4*)(ss0 + (size_t)row * 8) = make_float4(ss, 0.f, 0.f, 0.f);
                *(float4*)(ss0 + (size_t)row * 8 + 4) = make_float4(0.f, 0.f, 0.f, 0.f);
            }
        }
    }
    {
        float* cs = (float*)(ws + OFF_CS);
        for (int i = bid * NTHR + tid; i < TOK * 16; i += G * NTHR) {
            int t = i >> 4, k = i & 15;
            float inv = powf(10000.0f, -(float)k / 16.0f);
            float ang = (float)P.pos[t] * inv;
            cs[2 * i] = cosf(ang);
            cs[2 * i + 1] = sinf(ang);
        }
    }
}

struct NoHook { static constexpr bool nodma = false; __device__ __forceinline__ void operator()(int, f32x16 (&)[2][2]) const {} };
struct NoDmaHook { static constexpr bool nodma = true; __device__ __forceinline__ void operator()(int, f32x16 (&)[2][2]) const {} };
template <typename HOOK>
__device__ __forceinline__ void gemm_core(f32x16 (&acc)[2][2], const bf16* A, int lda, const bf16* Bt, int ldb, int K,
                                          int m0, int n0, HOOK hook) {
    const int tid = opaque_tid(), w = tid >> 6, l = tid & 63, r = l & 31, hh = l >> 5;
    const int wm = w >> 1, wn = w & 1;
    const int dp = (tid & 15) ^ ((tid >> 4) & 15);
    const int drow = 2 * (tid >> 4) + (dp >> 3), dgc = (dp & 7) * 8;
    const bf16* asrc = A + (size_t)(m0 + drow) * lda + dgc;
    const bf16* bsrc = Bt + (size_t)(n0 + drow) * ldb + dgc;
    auto dma = [&](int buf, int k0) {
        if (HOOK::nodma) return;
        char* base = smem + buf * STAGE_BYTES + tid * 16;
#pragma unroll
        for (int i = 0; i < 4; ++i)
            __builtin_amdgcn_global_load_lds((const unsigned*)(asrc + (size_t)(64 * i) * lda + k0), (unsigned*)(base + i * 8192), 16, 0, 0);
#pragma unroll
        for (int i = 0; i < 2; ++i)
            __builtin_amdgcn_global_load_lds((const unsigned*)(bsrc + (size_t)(64 * i) * ldb + k0), (unsigned*)(base + 32768 + i * 8192), 16, 0, 0);
    };
    int offA[2], offB[2];
#pragma unroll
    for (int i = 0; i < 2; ++i) { offA[i] = ((wm * 64 + i * 32 + r) >> 1) * 256; offB[i] = 32768 + ((wn * 64 + i * 32 + r) >> 1) * 256; }
    const int pbase = ((r & 1) << 3), lx = (r >> 1) & 15;
    const int nk = K >> 6;
    const unsigned ldsbase = (unsigned)(size_t)(__attribute__((address_space(3))) char*)smem;
    auto ldfrag = [&](int stage, int s, bf16x8 (&af)[2], bf16x8 (&bfr)[2]) {
        unsigned ch = (unsigned)((((pbase | (2 * s + hh)) ^ lx) << 4)) + ldsbase + (unsigned)(stage * STAGE_BYTES);
        unsigned a0a = ch + offA[0], a1a = ch + offA[1], b0a = ch + offB[0], b1a = ch + offB[1];
        asm volatile("ds_read_b128 %0, %4\n\tds_read_b128 %1, %5\n\tds_read_b128 %2, %6\n\tds_read_b128 %3, %7"
                     : "=&v"(af[0]), "=&v"(af[1]), "=&v"(bfr[0]), "=&v"(bfr[1]) : "v"(a0a), "v"(a1a), "v"(b0a), "v"(b1a) : "memory");
    };
    auto mma = [&](bf16x8 (&af)[2], bf16x8 (&bfr)[2]) {
#pragma unroll
        for (int i = 0; i < 2; ++i)
#pragma unroll
            for (int j = 0; j < 2; ++j) acc[i][j] = __builtin_amdgcn_mfma_f32_32x32x16_bf16(af[i], bfr[j], acc[i][j], 0, 0, 0);
    };
#define LGKM_WAIT(n) do { asm volatile("s_waitcnt lgkmcnt(" #n ")" ::: "memory"); __builtin_amdgcn_sched_barrier(0); } while (0)
    asm volatile("s_waitcnt vmcnt(0)" ::: "memory");
    dma(0, 0);
    dma(1, 64);
    if (nk > 2) { dma(2, 128); asm volatile("s_waitcnt vmcnt(12)" ::: "memory"); }
    else asm volatile("s_waitcnt vmcnt(6)" ::: "memory");
    __builtin_amdgcn_s_barrier();
    bf16x8 a0[2], b0[2], a1[2], b1[2];
    ldfrag(0, 0, a0, b0);
    int cur = 0;
    for (int kt = 0; kt < nk; ++kt) {
        const int nxt = (cur == 2) ? 0 : cur + 1;
        if (kt == 4 || kt == 8) { LGKM_WAIT(0); hook(kt, acc); }
        ldfrag(cur, 1, a1, b1);
        LGKM_WAIT(4);
        mma(a0, b0);
        ldfrag(cur, 2, a0, b0);
        LGKM_WAIT(4);
        mma(a1, b1);
        ldfrag(cur, 3, a1, b1);
        LGKM_WAIT(4);
        mma(a0, b0);
        if (kt + 1 < nk) {
            if (kt + 2 < nk) asm volatile("s_waitcnt vmcnt(6) lgkmcnt(0)" ::: "memory");
            else asm volatile("s_waitcnt vmcnt(0) lgkmcnt(0)" ::: "memory");
            __builtin_amdgcn_s_barrier();
            __builtin_amdgcn_sched_barrier(0);
            if (kt + 3 < nk) dma(cur, (kt + 3) << 6);
            ldfrag(nxt, 0, a0, b0);
        } else {
            LGKM_WAIT(0);
        }
        mma(a1, b1);
        cur = nxt;
    }
    __syncthreads();
}
__device__ __forceinline__ float row_rs8(const float* part, int row) {
    float4 a = *(const float4*)(part + (size_t)row * 8), b = *(const float4*)(part + (size_t)row * 8 + 4);
    float ss = ((a.x + a.y) + (a.z + a.w)) + ((b.x + b.y) + (b.z + b.w));
    return rsqrtf(ss * (1.f / 1024.f) + EPSF);
}
__device__ __forceinline__ bool xcd_tile(int it, int MT, int NT, int& mt, int& nt) {
    const int G = gridDim.x, bid = blockIdx.x;
    if ((G & 7) == 0 && (MT & 7) == 0) {
        const int nbx = G >> 3, q = (bid >> 3) + it * nbx, per = (MT >> 3) * NT;
        if (q >= per) return false;
        mt = (bid & 7) * (MT >> 3) + q / NT; nt = q % NT;
        return true;
    }
    const int q = bid + it * G;
    if (q >= MT * NT) return false;
    mt = q / NT; nt = q % NT;
    return true;
}
struct NoScale { __device__ __forceinline__ float operator()(int, int) const { return 1.f; } };

#define ZERO_ACC(acc)                                  \
    _Pragma("unroll") for (int _i = 0; _i < 2; ++_i)   \
    _Pragma("unroll") for (int _j = 0; _j < 2; ++_j)   \
    _Pragma("unroll") for (int _r = 0; _r < 16; ++_r) acc[_i][_j][_r] = 0.f;


namespace pg8 {
#define PG8_LAS __attribute__((address_space(3)))
typedef unsigned short bf16_t;
constexpr int BM = 256, BK = 64, HALF = 128, HTB = HALF * BK * 2  , NXCD = 8, WGM = 8;

__host__ __device__ __forceinline__ int lds_byte(int r, int c) { const int st = (r >> 4) * 2 + (c >> 5), rr = r & 15, cc = c & 31, ob = rr * 64 + cc * 2; return st * 1024 + (ob ^ (((ob >> 9) & 1) << 5)); }
__host__ __device__ __forceinline__ void stage_rc(int b, int& R, int& C) { const int st = b / 1024, sb = b % 1024, swz = sb ^ (((sb >> 9) & 1) << 5); R = (st >> 1) * 16 + swz / 64; C = (st & 1) * 32 + (swz % 64) / 2; }
__host__ __device__ __forceinline__ int perm32(int rho) { const int n = rho >> 4, i = rho & 15; return 8 * (i >> 2) + 4 * n + (i & 3); }
struct Unit { int pm, pn; };
struct Gemm { const bf16* A; const bf16* Bt; int lda, ldb, M, N, K; };
struct StaticOrder {
    int nM, nN, nwg, G, c;
    __device__ void init(int M, int N, int G_, int c_) { nM = M / BM; nN = N / BM; nwg = nM * nN; G = G_; c = c_; }
    __device__ bool next(int i, Unit& u) const {
        const long L = (long)i * G + c; if (L >= nwg) return false;
        int wgid = (int)L; { const int q = nwg / NXCD, r = nwg % NXCD, xcd = wgid % NXCD, off = wgid / NXCD; wgid = (xcd < r ? xcd * (q + 1) : r * (q + 1) + (xcd - r) * q) + off; }
        const int nig = WGM * nN, gid = wgid / nig, fm = gid * WGM, gsz = (nM - fm) < WGM ? (nM - fm) : WGM;
        u.pm = fm + ((wgid % nig) % gsz); u.pn = (wgid % nig) / gsz; return true;
    }
    __device__ __forceinline__ void a_ready(const Unit&) const {}
    __device__ __forceinline__ void done(const Unit&) const {}
};
template <class Epi, class Sched, bool STAMP = false>
__device__ __forceinline__ void gemm_phase(PG8_LAS unsigned char* lds, const Gemm g, const Sched& S, const Epi& E, unsigned long long* stamps) {
    const int tid = opaque_tid(), wid = __builtin_amdgcn_readfirstlane(tid >> 6), lane = tid & 63, wr = wid >> 2, wc = wid & 3, fr = lane & 15, fq = lane >> 4;
    const int K = g.K, nt = K / BK;
    int ts_lo = 0, ts_hi = 0, nts = 0; const unsigned long long rt_entry = STAMP ? (unsigned long long)wall_clock64() : 0ull;
#define PG8_STAMP() do { if (STAMP && wid == 0 && nts < 64) { const unsigned long long _c = (unsigned long long)clock64(); \
        ts_lo = (lane == nts) ? (int)(unsigned)_c : ts_lo; ts_hi = (lane == nts) ? (int)(unsigned)(_c >> 32) : ts_hi; ++nts; } } while (0)
    PG8_STAMP();
    unsigned voffA[2], voffB[2];
#pragma unroll
    for (int i = 0; i < 2; ++i) { int R, C; stage_rc(tid * 16 + i * 8192, R, C); const int Rb = Epi::PERM ? ((R & ~31) + perm32(R & 31)) : R;
        voffA[i] = (unsigned)(R * g.lda + C) * 2u; voffB[i] = (unsigned)(Rb * g.ldb + C) * 2u; }
    const size_t kstep = (size_t)(BK * 2);
    const size_t hstepA = (size_t)HALF * g.lda * 2, hstepB = (size_t)HALF * g.ldb * 2;
    const size_t tstepA = 2 * hstepA, tstepB = 2 * hstepB;
    const unsigned ldsw = (unsigned)wid * 1024u;
    const int aoff = lds_byte(wr * 64 + fr, fq * 8), boff = lds_byte(wc * 32 + fr, fq * 8);
#define PG8_SA(b, h) (((b) * 2 + (h)) * HTB)
#define PG8_SB(b, h) ((4 + (b) * 2 + (h)) * HTB)
#define PG8_STAGE(bufoff, gbase, voff) do { _Pragma("unroll") for (int _i = 0; _i < 2; ++_i) \
        __builtin_amdgcn_global_load_lds((const unsigned*)((const char*)(gbase) + (voff)[_i]), (PG8_LAS unsigned*)(lds + (bufoff) + ldsw + _i * 8192), 16, 0, 0); } while (0)
#define PG8_LDA(dst, b, h) do { _Pragma("unroll") for (int m = 0; m < 4; ++m) _Pragma("unroll") for (int k = 0; k < 2; ++k) dst[m][k] = *(const PG8_LAS bf16x8*)(lds + PG8_SA(b, h) + aoff + m * 2048 + k * 1024); } while (0)
#define PG8_LDB(dst, b, h) do { _Pragma("unroll") for (int n = 0; n < 2; ++n) _Pragma("unroll") for (int k = 0; k < 2; ++k) dst[n][k] = *(const PG8_LAS bf16x8*)(lds + PG8_SB(b, h) + boff + n * 2048 + k * 1024); } while (0)
#define PG8_MMA(ai, bj, At, Bt) do { __builtin_amdgcn_s_setprio(1); _Pragma("unroll") for (int m = 0; m < 4; ++m) _Pragma("unroll") for (int n = 0; n < 2; ++n) _Pragma("unroll") for (int k = 0; k < 2; ++k) \
        acc[ai][bj][m][n] = __builtin_amdgcn_mfma_f32_16x16x32_bf16(Bt[n][k], At[m][k], acc[ai][bj][m][n], 0, 0, 0); __builtin_amdgcn_s_setprio(0); } while (0)
#define PG8_WAIT_V(n) asm volatile("s_waitcnt vmcnt(" #n ")" ::: "memory")
#define PG8_WAIT_L(n) asm volatile("s_waitcnt lgkmcnt(" #n ")" ::: "memory")
#define PG8_BAR __builtin_amdgcn_s_barrier()
#define PG8_SCHED __builtin_amdgcn_sched_barrier(0)
    Unit cur, nxt; int ui = 0;
    if (!S.next(0, cur)) return;
    f32x4 acc[2][2][4][2];
#pragma unroll
    for (int a = 0; a < 2; ++a)
#pragma unroll
        for (int b = 0; b < 2; ++b)
#pragma unroll
            for (int m = 0; m < 4; ++m)
#pragma unroll
                for (int n = 0; n < 2; ++n) acc[a][b][m][n] = (f32x4){0.f, 0.f, 0.f, 0.f};
    bf16x8 At[4][2], B0[2][2], B1[2][2];
    const char* cA = (const char*)g.A + (size_t)cur.pm * tstepA; const char* cB = (const char*)g.Bt + (size_t)cur.pn * tstepB;
    S.a_ready(cur);
    PG8_STAGE(PG8_SB(0, 0), cB, voffB); PG8_STAGE(PG8_SA(0, 0), cA, voffA); PG8_STAGE(PG8_SB(0, 1), cB + hstepB, voffB); PG8_STAGE(PG8_SA(0, 1), cA + hstepA, voffA);
    if (wr == 1) PG8_BAR;
    PG8_WAIT_V(4); PG8_BAR;
    PG8_STAGE(PG8_SB(1, 0), cB + kstep, voffB); PG8_STAGE(PG8_SA(1, 0), cA + kstep, voffA); PG8_STAGE(PG8_SB(1, 1), cB + hstepB + kstep, voffB);
    PG8_WAIT_V(6); PG8_BAR;
    PG8_STAMP();
    for (;;) {
        const bool has_next = S.next(ui + 1, nxt);
        const char* nA = has_next ? (const char*)g.A + (size_t)nxt.pm * tstepA : cA; const char* nB = has_next ? (const char*)g.Bt + (size_t)nxt.pn * tstepB : cB;
        for (int t = 0; t < nt; t += 2) {
            const bool last = (t == nt - 2);
            const char* a1 = cA + (size_t)(t + 1) * kstep;
            const char* a2 = last ? nA : cA + (size_t)(t + 2) * kstep; const char* b2 = last ? nB : cB + (size_t)(t + 2) * kstep;
            const char* a3 = a2 + kstep; const char* b3 = b2 + kstep;
            if (last && has_next) S.a_ready(nxt);
            E.khook(t, acc, wr, fr);
            PG8_LDB(B0, 0, 0); PG8_SCHED; PG8_LDA(At, 0, 0); PG8_STAGE(PG8_SA(1, 1), a1 + hstepA, voffA);
            PG8_WAIT_L(8); PG8_BAR; PG8_WAIT_L(0); PG8_MMA(0, 0, At, B0); PG8_BAR; PG8_SCHED;
            PG8_LDB(B1, 0, 1); PG8_STAGE(PG8_SB(0, 0), b2, voffB);
            PG8_BAR; PG8_WAIT_L(0); PG8_MMA(0, 1, At, B1); PG8_BAR;
            PG8_LDA(At, 0, 1); PG8_STAGE(PG8_SA(0, 0), a2, voffA);
            PG8_BAR; PG8_WAIT_L(0); PG8_MMA(1, 0, At, B0); PG8_BAR; PG8_SCHED;
            PG8_STAGE(PG8_SB(0, 1), b2 + hstepB, voffB);
            PG8_WAIT_V(6); PG8_BAR; PG8_MMA(1, 1, At, B1); PG8_BAR;
            PG8_LDB(B0, 1, 0); PG8_SCHED; PG8_LDA(At, 1, 0); PG8_STAGE(PG8_SA(0, 1), a2 + hstepA, voffA);
            PG8_WAIT_L(8); PG8_BAR; PG8_WAIT_L(0); PG8_MMA(0, 0, At, B0); PG8_BAR; PG8_SCHED;
            PG8_LDB(B1, 1, 1); PG8_STAGE(PG8_SB(1, 0), b3, voffB);
            PG8_BAR; PG8_WAIT_L(0); PG8_MMA(0, 1, At, B1); PG8_BAR;
            PG8_LDA(At, 1, 1); PG8_STAGE(PG8_SA(1, 0), a3, voffA);
            PG8_BAR; PG8_WAIT_L(0); PG8_MMA(1, 0, At, B0); PG8_BAR; PG8_SCHED;
            PG8_STAGE(PG8_SB(1, 1), b3 + hstepB, voffB);
            PG8_WAIT_V(6); PG8_BAR; PG8_MMA(1, 1, At, B1); PG8_BAR;
        }
        PG8_STAMP();
        if constexpr (!Epi::AFTER_DRAIN) { E(acc, cur, wr, wc, fr, fq); S.done(cur); }
        PG8_STAMP();
        if (!has_next) break;
#pragma unroll
        for (int a = 0; a < 2; ++a)
#pragma unroll
            for (int b = 0; b < 2; ++b)
#pragma unroll
                for (int m = 0; m < 4; ++m)
#pragma unroll
                    for (int n = 0; n < 2; ++n) acc[a][b][m][n] = (f32x4){0.f, 0.f, 0.f, 0.f};
        cur = nxt; cA = nA; cB = nB; ++ui;
    }
    PG8_WAIT_V(0);
    if (wr == 0) PG8_BAR;
    PG8_BAR;
    if constexpr (Epi::AFTER_DRAIN) { E.fused(acc, cur, wr, wc, fr, fq, lds, wid, lane); S.done(cur); }
    PG8_STAMP();
    if (STAMP && wid == 0) { stamps[lane] = lane < nts ? (((unsigned long long)(unsigned)ts_hi << 32) | (unsigned)ts_lo) : 0ull;
        if (lane == 62) stamps[62] = rt_entry; if (lane == 63) stamps[63] = (unsigned long long)wall_clock64(); }
#undef PG8_STAMP
#undef PG8_SA
#undef PG8_SB
#undef PG8_STAGE
#undef PG8_LDA
#undef PG8_LDB
#undef PG8_MMA
#undef PG8_WAIT_V
#undef PG8_WAIT_L
#undef PG8_BAR
#undef PG8_SCHED
}
}

#define TB_LD 136
#define TF_LD 132
template <bool SCALE>
__device__ __forceinline__ void stage_bf16(const f32x16 (&acc)[2][2], const float* rsl) {
    bf16* T = (bf16*)smem;
    const int tid = opaque_tid(), w = tid >> 6, l = tid & 63, hh = l >> 5, wm = w >> 1, wn = w & 1;
#pragma unroll
    for (int i = 0; i < 2; ++i)
#pragma unroll
        for (int rr = 0; rr < 16; ++rr) {
            int row = wm * 64 + i * 32 + (rr & 3) + 8 * (rr >> 2) + 4 * hh;
            float sc = SCALE ? rsl[row] : 1.f;
#pragma unroll
            for (int j = 0; j < 2; ++j) T[row * TB_LD + wn * 64 + j * 32 + (l & 31)] = (bf16)(acc[i][j][rr] * sc);
        }
    __syncthreads();
}
template <bool SCALE>
__device__ __forceinline__ void stage_f32(const f32x16 (&acc)[2][2], const float* rsl) {
    float* T = (float*)smem;
    const int tid = opaque_tid(), w = tid >> 6, l = tid & 63, hh = l >> 5, wm = w >> 1, wn = w & 1;
#pragma unroll
    for (int i = 0; i < 2; ++i)
#pragma unroll
        for (int rr = 0; rr < 16; ++rr) {
            int row = wm * 64 + i * 32 + (rr & 3) + 8 * (rr >> 2) + 4 * hh;
            float sc = SCALE ? rsl[row] : 1.f;
#pragma unroll
            for (int j = 0; j < 2; ++j) T[row * TF_LD + wn * 64 + j * 32 + (l & 31)] = acc[i][j][rr] * sc;
        }
    __syncthreads();
}
template <typename CMAP>
__device__ __forceinline__ void store_rows_bf16(bf16* dst, int ld, int m0, CMAP cmap) {
    const bf16* T = (const bf16*)smem;
    const int tid = opaque_tid();
#pragma unroll
    for (int q = 0; q < 8; ++q) {
        int id = tid + 512 * q, row = id >> 4, ch = id & 15;
        u32x4 v = *(const u32x4*)(T + row * TB_LD + ch * 8);
        *(u32x4*)(dst + (size_t)(m0 + row) * ld + cmap(ch * 8)) = v;
    }
}
__device__ __forceinline__ void store_cols_bf16(bf16* vt, size_t crow0, int s0) {
    const unsigned short* T = (const unsigned short*)smem;
    const int tid = opaque_tid();
#pragma unroll
    for (int q = 0; q < 8; ++q) {
        int id = tid + 512 * q, c = id & 127, sg = id >> 7;
        unsigned e[8];
#pragma unroll
        for (int k = 0; k < 8; ++k) e[k] = T[(8 * sg + k) * TB_LD + c];
        u32x4 v = {e[0] | (e[1] << 16), e[2] | (e[3] << 16), e[4] | (e[5] << 16), e[6] | (e[7] << 16)};
        *(u32x4*)(vt + (crow0 + c) * SEQ + s0 + 8 * sg) = v;
    }
}
__device__ __forceinline__ void residual_store(const float* hin, float* hout, bf16* hb_out, float* gss, int m0, int n0, int nt) {
    const float* T = (const float*)smem;
    const int tid = opaque_tid(), l = tid & 63;
#pragma unroll 4
    for (int q = 0; q < 16; ++q) {
        int id = tid + 512 * q, row = id >> 5, ch = id & 31;
        f32x4 d = *(const f32x4*)(T + row * TF_LD + ch * 4);
        size_t gi = (size_t)(m0 + row) * 1024 + n0 + ch * 4;
        f32x4 h = *(const f32x4*)(hin + gi);
        f32x4 v = h + d;
        *(f32x4*)(hout + gi) = v;
        u32x2 b = {pack2(v.x, v.y), pack2(v.z, v.w)};
        *(u32x2*)(hb_out + (size_t)(m0 + row) * LDH + n0 + ch * 4) = b;
        float ss = v.x * v.x + v.y * v.y + v.z * v.z + v.w * v.w;
        ss = dpp_add<0xB1>(ss); ss = dpp_add<0x4E>(ss); ss = dpp_add<0x141>(ss); ss = dpp_add<0x140>(ss);
        ss += __shfl_xor(ss, 16);
        if ((l & 31) == 0) gss[(size_t)(m0 + row) * 8 + nt] = ss;
    }
}
struct ColAdd { int off; __device__ __forceinline__ int operator()(int c) const { return c + off; } };
struct ColHead96 { __device__ __forceinline__ int operator()(int c) const { return (c >> 6) * 96 + (c & 63); } };

struct EpiProj {
    static constexpr bool PERM = true, AFTER_DRAIN = false;
    const float* ssrow; char* ws;
    __device__ __forceinline__ void khook(int, f32x4 (&)[2][2][4][2], int, int) const {}
    __device__ __forceinline__ void operator()(const f32x4 (&acc)[2][2][4][2], const pg8::Unit& u, int wr, int wc, int fr, int fqd) const {
        const int row0 = u.pm * 256 + wr * 64 + fr, lc0 = wc * 32 + 8 * fqd, pn = u.pn;
        size_t doff; int ld = 256;
        if (pn == 0) doff = OFF_FQ; else if (pn == 1) doff = OFF_FK; else if (pn == 2) doff = OFF_PART;
        else if (pn == 3) doff = OFF_SQ; else if (pn == 4) doff = OFF_SKK; else if (pn == 5) doff = OFF_PART + 8 * MBy;
        else if (pn == 6) { doff = OFF_CQ; ld = LDP; } else { doff = OFF_CKV; ld = LDC; }
        bf16* dst = (bf16*)(ws + doff);
        bf16* mk = (bf16*)(ws + OFF_MK); float* flog = (float*)(ws + OFF_FLOG); const float* cs = (const float*)(ws + OFF_CS);
#pragma unroll
        for (int ai = 0; ai < 2; ++ai)
#pragma unroll
            for (int m = 0; m < 4; ++m) {
                const int row = row0 + ai * 128 + m * 16;
                const float rs = row_rs8(ssrow, row);
#pragma unroll
                for (int bj = 0; bj < 2; ++bj) {
                    f32x4 v0 = acc[ai][bj][m][0] * rs, v1 = acc[ai][bj][m][1] * rs;
                    if (pn < 7 || bj == 0) {
                        u32x4 wv = {pack2(v0[0], v0[1]), pack2(v0[2], v0[3]), pack2(v1[0], v1[1]), pack2(v1[2], v1[3])};
                        *(u32x4*)(dst + (size_t)row * ld + bj * 128 + lc0) = wv;
                    } else if (wc == 0) {
                        const int hh = fqd >> 1, pi = 8 * (fqd & 1);
                        float vv[8] = {v0[0], v0[1], v0[2], v0[3], v1[0], v1[1], v1[2], v1[3]}, ov[8];
                        const f32x4* c4 = (const f32x4*)(cs + ((size_t)row * 16 + pi) * 2);
                        f32x4 t0 = c4[0], t1 = c4[1], t2 = c4[2], t3 = c4[3];
                        float cc[8] = {t0.x, t0.z, t1.x, t1.z, t2.x, t2.z, t3.x, t3.z}, sn[8] = {t0.y, t0.w, t1.y, t1.w, t2.y, t2.w, t3.y, t3.w};
#pragma unroll
                        for (int e = 0; e < 8; ++e) {
                            float pv = __builtin_bit_cast(float, partner32(__builtin_bit_cast(int, vv[e]), hh));
                            ov[e] = hh ? (pv * sn[e] + vv[e] * cc[e]) : (vv[e] * cc[e] - pv * sn[e]);
                        }
                        u32x4 wv = {pack2(ov[0], ov[1]), pack2(ov[2], ov[3]), pack2(ov[4], ov[5]), pack2(ov[6], ov[7])};
#pragma unroll
                        for (int h = 0; h < 4; ++h) *(u32x4*)(mk + (size_t)row * 384 + h * 96 + 64 + 8 * fqd) = wv;
                    } else if (wc == 1 && fqd == 0) {
                        *(f32x4*)(flog + (size_t)row * 4) = v0;
                    }
                }
            }
    }
};
__device__ __forceinline__ void phase_proj(const Params& P, int L, int hsel, int ss_slot) {
    char* ws = opq(P.ws);
    const float* ssrow = (const float*)(ws + OFF_SSA) + (size_t)ss_slot * TOK * 8;
    const bf16* hb = (const bf16*)(ws + (hsel ? OFF_HB1 : OFF_HB0));
    const bf16* Bt = (const bf16*)(ws + OFF_WIN) + (size_t)L * 2048 * LDH;
    pg8::Gemm g{hb, Bt, LDH, LDH, TOK, 2048, 1024};
    pg8::StaticOrder S; S.init(TOK, 2048, gridDim.x, blockIdx.x);
    EpiProj E{ssrow, ws};
    pg8::gemm_phase((PG8_LAS unsigned char*)smem, g, S, E, nullptr);
    __syncthreads();
}

template <int KW>
__device__ __forceinline__ void row_rms_to_lds(const bf16* A, int lda, int m0) {
    const int tid = opaque_tid(), row = tid >> 1, half = tid & 1;
    float ss = 0.f;
    const u32x4* p = (const u32x4*)(A + (size_t)(m0 + row) * lda + half * (KW / 2));
#pragma unroll
    for (int q = 0; q < KW / 16; ++q) {
        u32x4 v = p[q];
        float a;
        a = bflo(v.x); ss += a * a; a = bfhi(v.x); ss += a * a;
        a = bflo(v.y); ss += a * a; a = bfhi(v.y); ss += a * a;
        a = bflo(v.z); ss += a * a; a = bfhi(v.z); ss += a * a;
        a = bflo(v.w); ss += a * a; a = bfhi(v.w); ss += a * a;
    }
    ss += __shfl_xor(ss, 1);
    if (half == 0) ((float*)(smem + LDS_AUX))[row] = rsqrtf(ss * (1.f / (float)KW) + EPSF);
}

__device__ __forceinline__ void phase_mla_up(const Params& P, int L) {
    char* ws = opq(P.ws);
    const bf16* cq = (const bf16*)(ws + OFF_CQ); const bf16* ckv = (const bf16*)(ws + OFF_CKV);
    const bf16* wuq = (const bf16*)(ws + OFF_WUQ) + (size_t)L * 384 * LDP;
    const bf16* wukv = (const bf16*)(ws + OFF_WUKV) + (size_t)L * 768 * LDC;
    bf16* mq = (bf16*)(ws + OFF_MQ); bf16* mk = (bf16*)(ws + OFF_MK); bf16* mvt = (bf16*)(ws + OFF_MVT);
    const float* cs = (const float*)(ws + OFF_CS);
    const float* flog = (const float*)(ws + OFF_FLOG);
    float* cumF = (float*)(ws + OFF_CUMF);
    const int tid = opaque_tid(), w = tid >> 6, l = tid & 63, hh = l >> 5, wm = w >> 1, wn = w & 1;
    const int NQ = 64 * 3, NKV = 64 * 6, NCF = 4;
    const float* aux = (const float*)(smem + LDS_AUX);
    for (int gw = blockIdx.x * NW + w; gw < 2048; gw += gridDim.x * NW) {
        const int type = gw >> 10, bh = (gw >> 5) & 31, tb = gw & 31, b = bh >> 2, h = bh & 3;
        const bf16* src = (const bf16*)(ws + OFF_PART + (type ? 8 * MBy : 0)) + ((size_t)(b * SEQ + tb * 64 + l) * 256 + h * 64);
        unsigned short* dst = (unsigned short*)(ws + (type ? OFF_SVT : OFF_FVT)) + (size_t)bh * 64 * SEQ + tb * 64 + l;
        u32x4 rv8[8];
#pragma unroll
        for (int q = 0; q < 8; ++q) rv8[q] = ((const u32x4*)src)[q];
#pragma unroll
        for (int q = 0; q < 8; ++q) {
            dst[(size_t)(8 * q + 0) * SEQ] = (unsigned short)(rv8[q].x & 0xffffu); dst[(size_t)(8 * q + 1) * SEQ] = (unsigned short)(rv8[q].x >> 16);
            dst[(size_t)(8 * q + 2) * SEQ] = (unsigned short)(rv8[q].y & 0xffffu); dst[(size_t)(8 * q + 3) * SEQ] = (unsigned short)(rv8[q].y >> 16);
            dst[(size_t)(8 * q + 4) * SEQ] = (unsigned short)(rv8[q].z & 0xffffu); dst[(size_t)(8 * q + 5) * SEQ] = (unsigned short)(rv8[q].z >> 16);
            dst[(size_t)(8 * q + 6) * SEQ] = (unsigned short)(rv8[q].w & 0xffffu); dst[(size_t)(8 * q + 7) * SEQ] = (unsigned short)(rv8[q].w >> 16);
        }
    }
    for (int item = blockIdx.x; item < NQ + NKV + NCF; item += gridDim.x) {
        if (item < NQ) {
            int mt = item / 3, nt = item % 3;
            int m0 = mt * 256, n0 = nt * 128;
            __syncthreads();
            row_rms_to_lds<256>(cq, LDP, m0);
            f32x16 acc[2][2];
            ZERO_ACC(acc);
            gemm_core(acc, cq, LDP, wuq, LDP, 256, m0, n0, NoHook());
#pragma unroll
            for (int i = 0; i < 2; ++i)
#pragma unroll
                for (int j = 0; j < 2; ++j) {
                    int c0 = n0 + wn * 64 + j * 32;
                    int rloc = wm * 64 + i * 32 + 4 * hh;
                    bool rot = (c0 % 96) == 64;
                    int ci = l & 31, pi = ci & 15;
#pragma unroll
                    for (int rr = 0; rr < 16; ++rr) {
                        int rl = rloc + (rr & 3) + 8 * (rr >> 2);
                        float v = acc[i][j][rr] * aux[rl];
                        if (rot) {
                            float pv = __shfl_xor(v, 16);
                            float2 c_s = *(const float2*)(cs + ((size_t)(m0 + rl) * 16 + pi) * 2);
                            v = (ci < 16) ? (v * c_s.x - pv * c_s.y) : (pv * c_s.y + v * c_s.x);
                        }
                        acc[i][j][rr] = v;
                    }
                }
            stage_bf16<false>(acc, nullptr);
            store_rows_bf16(mq, 384, m0, ColAdd{n0});
        } else if (item < NQ + NKV) {
            int it2 = item - NQ;
            int mt = it2 / 6, nt = it2 % 6;
            int m0 = mt * 256, n0 = nt * 128;
            __syncthreads();
            row_rms_to_lds<128>(ckv, LDC, m0);
            f32x16 acc[2][2];
            ZERO_ACC(acc);
            gemm_core(acc, ckv, LDC, wukv, LDC, 128, m0, n0, NoHook());
            stage_bf16<true>(acc, aux);
            if (nt < 2) {
                const int nb0 = n0;
                struct CM { int n0; __device__ __forceinline__ int operator()(int c) const { int col = n0 + c; return (col >> 6) * 96 + (col & 63); } };
                store_rows_bf16(mk, 384, m0, CM{nb0});
            } else {
                store_cols_bf16(mvt, (size_t)(m0 >> 11) * 512 + (n0 - 256), m0 & 2047);
            }
        } else {
            int seq = (item - NQ - NKV) * NW + w;
            int b = seq >> 2, h = seq & 3;
            float bfv = P.b_forget[L * 4 + h];
            float vals[32];
            float run = 0.f;
#pragma unroll
            for (int i = 0; i < 32; ++i) {
                int s = l * 32 + i;
                float z = flog[((size_t)b * SEQ + s) * 4 + h] + bfv;
                run += log_sigmoid_f(z);
                vals[i] = run;
            }
            float tot = run, incl = tot;
#pragma unroll
            for (int o = 1; o < 64; o <<= 1) {
                float t = __shfl_up(incl, o);
                if (l >= o) incl += t;
            }
            float excl = incl - tot;
#pragma unroll
            for (int i = 0; i < 32; ++i) cumF[(size_t)seq * SEQ + l * 32 + i] = vals[i] + excl;
        }
    }
}

template <int MODE, int DK, int DV>
__device__ __forceinline__ void attn_item(const bf16* __restrict__ Q, int ldq, const bf16* __restrict__ Kg, int ldk,
                          const bf16* __restrict__ Vt, const float* __restrict__ cumF, bf16* __restrict__ Y,
                          float* __restrict__ ssy, int b, int h, int qb, float c1, char* lds, int fake = 0) {
    constexpr int KSTR = DK * 2 + 16;
    constexpr int VSTR = 144;
    constexpr int KBYTES = 64 * KSTR, VBYTES = DV * VSTR;
    constexpr int BUF = (KBYTES + VBYTES + 256 + 255) & ~255;
    static_assert(2 * BUF <= 65536, "lds");
    constexpr int KCH = DK / 8, KPT = (64 * KCH) / 256, VPT = (DV * 8) / 256;
    const int tid = opaque_tid() & 255, w = tid >> 6, l = tid & 63, r = l & 31, hh = l >> 5;
    const int q0 = qb * 128;
    const int qrow = q0 + 32 * w + r;
    const size_t tok = (size_t)b * SEQ + qrow;
    const int bh = b * 4 + h;
    bf16x8 qf[DK / 16];
#pragma unroll
    for (int s = 0; s < DK / 16; ++s) qf[s] = *(const bf16x8*)(Q + tok * ldq + h * DK + 16 * s + 8 * hh);
    f32x16 o[DV / 32];
    const f32x16 zero16 = {0.f, 0.f, 0.f, 0.f, 0.f, 0.f, 0.f, 0.f, 0.f, 0.f, 0.f, 0.f, 0.f, 0.f, 0.f, 0.f};
#pragma unroll
    for (int d = 0; d < DV / 32; ++d) o[d] = zero16;
    float m = -1e30f, lsum = 0.f, R = 0.f;
    bool sbdead = false;
    int* dmask = (int*)(smem + LDS_BYTES - 32);
    float Fq = 0.f;
    if (MODE == 0) Fq = cumF[(size_t)bh * SEQ + qrow] * LOG2E;
    const int nkt = (q0 + 128) >> 6;
    u32x4 kregA[KPT], vregA[VPT], kregB[KPT], vregB[VPT];
    float4 fregA = {0.f, 0.f, 0.f, 0.f}, fregB = {0.f, 0.f, 0.f, 0.f};
    auto gload = [&](int kt, u32x4 (&kreg)[KPT], u32x4 (&vreg)[VPT], float4& freg) {
#pragma unroll
        for (int i = 0; i < KPT; ++i) {
            int e = tid + 256 * i;
            int row = e / KCH, ch = e % KCH;
            kreg[i] = *(const u32x4*)(Kg + ((size_t)b * SEQ + kt * 64 + row) * ldk + h * DK + ch * 8);
        }
#pragma unroll
        for (int i = 0; i < VPT; ++i) {
            int e = tid + 256 * i;
            int row = e >> 3, ch = e & 7;
            vreg[i] = *(const u32x4*)(Vt + ((size_t)bh * DV + row) * SEQ + kt * 64 + ch * 8);
        }
        if (MODE == 0 && tid < 16) freg = *(const float4*)(cumF + (size_t)bh * SEQ + kt * 64 + tid * 4);
    };
    auto lwrite = [&](int buf, u32x4 (&kreg)[KPT], u32x4 (&vreg)[VPT], float4& freg) {
        char* base = lds + buf * BUF;
#pragma unroll
        for (int i = 0; i < KPT; ++i) {
            int e = tid + 256 * i;
            int row = e / KCH, ch = e % KCH;
            *(u32x4*)(base + row * KSTR + ch * 16) = kreg[i];
        }
#pragma unroll
        for (int i = 0; i < VPT; ++i) {
            int e = tid + 256 * i;
            int row = e >> 3, ch = e & 7;
            *(u32x4*)(base + KBYTES + row * VSTR + ch * 16) = vreg[i];
        }
        if (MODE == 0 && tid < 16) { float4 fn = {-freg.x * LOG2E, -freg.y * LOG2E, -freg.z * LOG2E, -freg.w * LOG2E}; *(float4*)(base + KBYTES + VBYTES + tid * 16) = fn; }
    };
    const int prow = (r & 0x13) | ((r & 4) << 1) | ((r & 8) >> 1);
    auto ktof = [&](int it) { return (MODE == 1) ? (nkt - 1 - it) : it; };
    gload(ktof(0), kregA, vregA, fregA);
    lwrite(0, kregA, vregA, fregA);
    constexpr bool D2 = (MODE != 2);
    if (D2 && nkt > 1) gload(ktof(1), kregB, vregB, fregB);
    __syncthreads();
    auto tile = [&](int it, u32x4 (&kn)[KPT], u32x4 (&vn)[VPT], float4& fn2, u32x4 (&kf)[KPT], u32x4 (&vf2)[VPT], float4& ff) {
        const int kt = ktof(it);
        if (!(fake & 1)) {
        if (D2) { if (it + 2 < nkt) gload(ktof(it + 2), kf, vf2, ff); }
        else { if (it + 1 < nkt) gload(ktof(it + 1), kf, vf2, ff); }
        }
        const char* base = lds + (it & 1) * BUF;
        bool active = (kt * 64) <= (q0 + 32 * w + 31);
        if (MODE == 1) {
            if (sbdead) { active = false; atomicOr(&dmask[it & 1], 1 << (opaque_tid() >> 6)); }
        }
        if (active) {
            const bool needmask = (kt * 64 + 63) >= (q0 + 32 * w);
            f32x16 s[2];
#pragma unroll
            for (int sub = 0; sub < 2; ++sub) {
                s[sub] = zero16;
#pragma unroll
                for (int ks = 0; ks < DK / 16; ++ks) {
                    bf16x8 kf = *(const bf16x8*)(base + (sub * 32 + prow) * KSTR + (2 * ks + hh) * 16);
                    s[sub] = __builtin_amdgcn_mfma_f32_32x32x16_bf16(kf, qf[ks], s[sub], 0, 0, 0);
                }
            }
            bf16x8 pf[2][2];
            if (fake & 2) {
#pragma unroll
                for (int sub = 0; sub < 2; ++sub)
#pragma unroll
                    for (int a = 0; a < 2; ++a) {
                        uint4 u;
                        u.x = pack2(s[sub][8 * a], s[sub][8 * a + 1]); u.y = pack2(s[sub][8 * a + 2], s[sub][8 * a + 3]);
                        u.z = pack2(s[sub][8 * a + 4], s[sub][8 * a + 5]); u.w = pack2(s[sub][8 * a + 6], s[sub][8 * a + 7]);
                        pf[sub][a] = __builtin_bit_cast(bf16x8, u);
                    }
                lsum = 1.f;
            } else if (MODE != 1) {
                const float* Ft = (const float*)(base + KBYTES + VBYTES);
                float mx = -INFINITY;
                float tv[2][16];
#pragma unroll
                for (int sub = 0; sub < 2; ++sub)
#pragma unroll
                    for (int a = 0; a < 2; ++a) {
                        int kofs = sub * 32 + 16 * a + 8 * hh;
                        float fk[8];
                        if (MODE == 0) {
                            float4 f0 = *(const float4*)(Ft + kofs), f1 = *(const float4*)(Ft + kofs + 4);
                            fk[0] = f0.x; fk[1] = f0.y; fk[2] = f0.z; fk[3] = f0.w; fk[4] = f1.x; fk[5] = f1.y; fk[6] = f1.z; fk[7] = f1.w;
                        }
#pragma unroll
                        for (int j = 0; j < 8; ++j) {
                            int rr = 8 * a + j;
                            float v = (MODE == 0) ? fmaf(s[sub][rr], c1, fk[j]) : s[sub][rr] * c1;
                            tv[sub][rr] = v;
                        }
                    }
                if (needmask) {
#pragma unroll
                    for (int sub = 0; sub < 2; ++sub)
#pragma unroll
                        for (int rr = 0; rr < 16; ++rr) {
                            int key = kt * 64 + sub * 32 + 16 * (rr >> 3) + 8 * hh + (rr & 7);
                            if (key > qrow) tv[sub][rr] = -INFINITY;
                        }
                }
#pragma unroll
                for (int sub = 0; sub < 2; ++sub)
#pragma unroll
                    for (int rr = 0; rr < 16; ++rr) mx = fmaxf(mx, tv[sub][rr]);
                mx = fmaxf(mx, __builtin_bit_cast(float, partner32(__builtin_bit_cast(int, mx), hh)));
                float mnew = fmaxf(m, mx);
                float rsum = 0.f;
#pragma unroll
                for (int sub = 0; sub < 2; ++sub)
#pragma unroll
                    for (int a = 0; a < 2; ++a) {
                        float pv[8];
#pragma unroll
                        for (int j = 0; j < 8; ++j) { pv[j] = fexp2(tv[sub][8 * a + j] - mnew); rsum += pv[j]; }
                        uint4 u;
                        u.x = pack2(pv[0], pv[1]); u.y = pack2(pv[2], pv[3]); u.z = pack2(pv[4], pv[5]); u.w = pack2(pv[6], pv[7]);
                        pf[sub][a] = __builtin_bit_cast(bf16x8, u);
                    }
                rsum += __builtin_bit_cast(float, partner32(__builtin_bit_cast(int, rsum), hh));
                if (__builtin_amdgcn_ballot_w64(mnew != m) != 0ull) {
                    float alpha = fexp2(m - mnew);
                    lsum *= alpha;
#pragma unroll
                    for (int d = 0; d < DV / 32; ++d) o[d] = o[d] * alpha;
                    m = mnew;
                }
                lsum += rsum;
            } else {
#pragma unroll
                for (int sb = 0; sb < 2; ++sb) {
                    const int sub = 1 - sb;
                    float lsig[16], lneg[16];
                    float A0 = 0.f, A1 = 0.f;
#pragma unroll
                    for (int rr = 0; rr < 16; ++rr) {
                        int key = kt * 64 + sub * 32 + 16 * (rr >> 3) + 8 * hh + (rr & 7);
                        bool valid = key < qrow;
                        float z = s[sub][rr] * c1;
                        float e = fexp2(-fabsf(z));
                        float l1p = flog2(1.f + e);
                        float ls = fminf(z, 0.f) - l1p;
                        float ln = valid ? (ls - z) : 0.f;
                        lsig[rr] = valid ? ls : -INFINITY;
                        lneg[rr] = ln;
                        if (rr < 8) A0 += ln; else A1 += ln;
                    }
                    float B0 = __shfl_xor(A0, 32), B1 = __shfl_xor(A1, 32);
                    float base1 = (hh == 0) ? (R + B1) : R;
                    float base0 = (hh == 0) ? (R + B1 + A1 + B0) : (R + A1 + B1);
                    float wv[16];
                    float run = base1;
#pragma unroll
                    for (int j = 7; j >= 0; --j) { wv[8 + j] = fexp2(lsig[8 + j] + run); run += lneg[8 + j]; }
                    run = base0;
#pragma unroll
                    for (int j = 7; j >= 0; --j) { wv[j] = fexp2(lsig[j] + run); run += lneg[j]; }
                    R += A0 + A1 + B0 + B1;
#pragma unroll
                    for (int a = 0; a < 2; ++a) {
                        uint4 u;
                        u.x = pack2(wv[8 * a], wv[8 * a + 1]); u.y = pack2(wv[8 * a + 2], wv[8 * a + 3]);
                        u.z = pack2(wv[8 * a + 4], wv[8 * a + 5]); u.w = pack2(wv[8 * a + 6], wv[8 * a + 7]);
                        pf[sub][a] = __builtin_bit_cast(bf16x8, u);
                    }
                }
            }
            if (MODE == 1) {
                if (__builtin_amdgcn_ballot_w64(R > -150.f) == 0ull) { sbdead = true; atomicOr(&dmask[it & 1], 1 << (opaque_tid() >> 6)); }
            }
#pragma unroll
            for (int d = 0; d < DV / 32; ++d)
#pragma unroll
                for (int sub = 0; sub < 2; ++sub)
#pragma unroll
                    for (int a = 0; a < 2; ++a) {
                        bf16x8 vf = *(const bf16x8*)(base + KBYTES + (d * 32 + r) * VSTR + (sub * 32 + 16 * a + 8 * hh) * 2);
                        o[d] = __builtin_amdgcn_mfma_f32_32x32x16_bf16(vf, pf[sub][a], o[d], 0, 0, 0);
                    }
        }
        if (!(fake & 1)) { if (it + 1 < nkt) lwrite((it + 1) & 1, kn, vn, fn2); }
        __syncthreads();
    };
    if (D2) {
        for (int it = 0; it < nkt; it += 2) {
            if (MODE == 1 && it > 0 && ((volatile int*)dmask)[(it - 1) & 1] == 0xFF) break;
            tile(it, kregB, vregB, fregB, kregA, vregA, fregA);
            if (it + 1 < nkt) {
                if (MODE == 1 && ((volatile int*)dmask)[it & 1] == 0xFF) break;
                tile(it + 1, kregA, vregA, fregA, kregB, vregB, fregB);
            }
        }
    } else {
        for (int it = 0; it < nkt; ++it) tile(it, kregA, vregA, fregA, kregA, vregA, fregA);
    }
    float inv = (MODE == 1) ? 1.f : (1.f / lsum);
    float ssq = 0.f;
#pragma unroll
    for (int d = 0; d < DV / 32; ++d)
#pragma unroll
        for (int g = 0; g < 4; ++g) {
            float v0 = o[d][4 * g] * inv, v1 = o[d][4 * g + 1] * inv, v2 = o[d][4 * g + 2] * inv, v3 = o[d][4 * g + 3] * inv;
            ssq += v0 * v0 + v1 * v1 + v2 * v2 + v3 * v3;
            uint2 u; u.x = pack2(v0, v1); u.y = pack2(v2, v3);
            *(uint2*)(Y + tok * LDH + h * DV + d * 32 + 8 * g + 4 * hh) = u;
        }
    ssq += __shfl_xor(ssq, 32);
    if (hh == 0) ssy[tok * 16 + h] = ssq;
}

__device__ __forceinline__ void phase_attn(const Params& P, int L, int rep = 0, int fake = 0) {
    char* ws = opq(P.ws);
    int* cnt = (int*)(ws + OFF_CNT) + L * 64 + rep * 16;
    int* s_item = (int*)(smem + LDS_BYTES - 16);
    const float* cumF = (const float*)(ws + OFF_CUMF);
    bf16* Y = (bf16*)(ws + (fake ? OFF_PART : OFF_Y));
    float* ssy = fake ? (float*)(ws + OFF_PART + 40 * MBy) : (float*)(ws + OFF_SSY) + (size_t)L * TOK * 16;
    const int half = opaque_tid() >> 8;
    char* lds = smem + half * 65536;
    for (;;) {
        if (opaque_tid() == 0) { int z0 = 0; asm volatile("" : "+v"(z0)); *s_item = atomicAdd(cnt, 1); s_item[-4] = z0; s_item[-3] = z0; }
        __syncthreads();
        int pair = *s_item;
        __syncthreads();
        if (pair >= 768) break;
        int item = pair * 2 + half;
        int qb, type, bh;
        if (item < 1024) { qb = 15 - (item >> 6); type = (item & 32) ? 2 : 0; bh = item & 31; }
        else { const int j2 = item - 1024; qb = 15 - (j2 >> 5); type = 1; bh = j2 & 31; }
        int b = bh >> 2, h = bh & 3;
        if (type == 0) {
            attn_item<2, 96, 128>((const bf16*)(ws + OFF_MQ), 384, (const bf16*)(ws + OFF_MK), 384, (const bf16*)(ws + OFF_MVT), cumF,
                                  Y + 512, ssy + 8, b, h, qb, 0.10206207261596577f * LOG2E, lds, fake);
        } else if (type == 1) {
            attn_item<1, 64, 64>((const bf16*)(ws + OFF_SQ), 256, (const bf16*)(ws + OFF_SKK), 256, (const bf16*)(ws + OFF_SVT), cumF,
                                 Y + 256, ssy + 4, b, h, qb, 0.125f * LOG2E, lds, fake);
        } else {
            attn_item<0, 64, 64>((const bf16*)(ws + OFF_FQ), 256, (const bf16*)(ws + OFF_FK), 256, (const bf16*)(ws + OFF_FVT), cumF,
                                 Y + 0, ssy + 0, b, h, qb, 0.125f * LOG2E, lds, fake);
        }
    }
}

__device__ __forceinline__ void rowss_flush(float (&part)[2][16], float* gss, int m0, int nt) {
    float* lss = (float*)smem;
    const int tid = opaque_tid(), w = tid >> 6, l = tid & 63, hh = l >> 5, wm = w >> 1, wn = w & 1;
#pragma unroll
    for (int i = 0; i < 2; ++i)
#pragma unroll
        for (int rr = 0; rr < 16; ++rr) {
            float v = part[i][rr];
            v = dpp_add<0xB1>(v); v = dpp_add<0x4E>(v); v = dpp_add<0x141>(v); v = dpp_add<0x140>(v);
            v += __shfl_xor(v, 16);
            if ((l & 31) == 0) lss[wn * 256 + wm * 64 + i * 32 + (rr & 3) + 8 * (rr >> 2) + 4 * hh] = v;
        }
    __syncthreads();
    if (tid < 256) gss[(size_t)(m0 + tid) * 8 + nt] = lss[tid] + lss[256 + tid];
    __syncthreads();
}

__device__ __forceinline__ float sum_fq(float v) {
    float a = v, b = v;
    asm volatile("s_nop 1\n\tv_permlane16_swap_b32 %0, %1\n\ts_nop 1" : "+v"(a), "+v"(b));
    v = a + b; a = v; b = v;
    asm volatile("s_nop 1\n\tv_permlane32_swap_b32 %0, %1\n\ts_nop 1" : "+v"(a), "+v"(b));
    return a + b;
}
__device__ __forceinline__ void residual_fused(const f32x4 (&acc)[2][2][4][2], const pg8::Unit& u, int wr, int wc, int fr, int fqd,
                                               const float* rowscale  , const float* hin, float* hout, bf16* hb_out, float* gss) {
    float* lss = (float*)smem;
#pragma unroll
    for (int ai = 0; ai < 2; ++ai)
#pragma unroll
        for (int m = 0; m < 4; ++m) {
            const int rl = 128 * ai + 64 * wr + 16 * m + fr, row = u.pm * 256 + rl;
            const float sc = rowscale ? rowscale[rl] : 1.f;
#pragma unroll
            for (int bj = 0; bj < 2; ++bj) {
                const int col = u.pn * 256 + 128 * bj + 32 * wc + 8 * fqd;
                const f32x4* hp = (const f32x4*)(hin + (size_t)row * 1024 + col);
                f32x4 v0 = hp[0] + acc[ai][bj][m][0] * sc, v1 = hp[1] + acc[ai][bj][m][1] * sc;
                f32x4* op = (f32x4*)(hout + (size_t)row * 1024 + col);
                op[0] = v0; op[1] = v1;
                u32x4 wv = {pack2(v0[0], v0[1]), pack2(v0[2], v0[3]), pack2(v1[0], v1[1]), pack2(v1[2], v1[3])};
                *(u32x4*)(hb_out + (size_t)row * LDH + col) = wv;
                float ss = (v0[0] * v0[0] + v0[1] * v0[1]) + (v0[2] * v0[2] + v0[3] * v0[3]) + (v1[0] * v1[0] + v1[1] * v1[1]) + (v1[2] * v1[2] + v1[3] * v1[3]);
                ss = sum_fq(ss);
                if (fqd == 0) lss[(wc * 256 + rl) * 2 + bj] = ss;
            }
        }
    __syncthreads();
    const int tid = opaque_tid();
    if (tid < 256) {
        const int row = u.pm * 256 + tid;
#pragma unroll
        for (int bj = 0; bj < 2; ++bj)
            gss[(size_t)row * 8 + u.pn * 2 + bj] = (lss[(0 * 256 + tid) * 2 + bj] + lss[(1 * 256 + tid) * 2 + bj]) + (lss[(2 * 256 + tid) * 2 + bj] + lss[(3 * 256 + tid) * 2 + bj]);
    }
    __syncthreads();
}
struct EpiWo {
    static constexpr bool PERM = true, AFTER_DRAIN = true;
    const float* hin; float* hout; bf16* hb_out; float* gss;
    __device__ __forceinline__ void khook(int t, f32x4 (&acc)[2][2][4][2], int wr, int fr) const {
        if (t == 4 || t == 8) {
            const float* fac = (const float*)(smem + LDS_AUX) + (t == 4 ? 0 : 256);
#pragma unroll
            for (int ai = 0; ai < 2; ++ai)
#pragma unroll
                for (int m = 0; m < 4; ++m) {
                    const float f = fac[128 * ai + 64 * wr + 16 * m + fr];
#pragma unroll
                    for (int bj = 0; bj < 2; ++bj) { acc[ai][bj][m][0] *= f; acc[ai][bj][m][1] *= f; }
                }
        }
    }
    __device__ __forceinline__ void operator()(const f32x4 (&)[2][2][4][2], const pg8::Unit&, int, int, int, int) const {}
    __device__ __forceinline__ void fused(const f32x4 (&acc)[2][2][4][2], const pg8::Unit& u, int wr, int wc, int fr, int fqd, PG8_LAS unsigned char*, int, int) const {
        residual_fused(acc, u, wr, wc, fr, fqd, (const float*)(smem + LDS_AUX) + 512, hin, hout, hb_out, gss);
    }
};
__device__ __forceinline__ void phase_wo(const Params& P, int L, int hsel, int ss_slot) {
    char* ws = opq(P.ws);
    float* ss_out = (float*)(ws + OFF_SSA) + (size_t)ss_slot * TOK * 8;
    bf16* hb_out = (bf16*)(ws + (hsel ? OFF_HB1 : OFF_HB0));
    const float* hin = (L == 0) ? opq(P.x) : (const float*)opq(P.out);
    float* hout = opq(P.out);
    const bf16* Y = (const bf16*)(ws + OFF_Y);
    const bf16* Bt = (const bf16*)(ws + OFF_WO) + (size_t)L * 1024 * LDH;
    const float* ssy = (const float*)(ws + OFF_SSY) + (size_t)L * TOK * 16;
    float* aux = (float*)(smem + LDS_AUX);
    const int tid = opaque_tid();
    pg8::Gemm g{Y, Bt, LDH, LDH, TOK, 1024, 1024};
    pg8::StaticOrder S; S.init(TOK, 1024, gridDim.x, blockIdx.x);
    pg8::Unit u0;
    if (S.next(0, u0) && tid < 256) {
        int row = u0.pm * 256 + tid;
        float4 v0 = *(const float4*)(ssy + (size_t)row * 16), v1 = *(const float4*)(ssy + (size_t)row * 16 + 4), v2 = *(const float4*)(ssy + (size_t)row * 16 + 8);
        float r0 = rsqrtf(((v0.x + v0.y) + (v0.z + v0.w)) * (1.f / 256.f) + EPSF);
        float r1 = rsqrtf(((v1.x + v1.y) + (v1.z + v1.w)) * (1.f / 256.f) + EPSF);
        float r2 = rsqrtf(((v2.x + v2.y) + (v2.z + v2.w)) * (1.f / 512.f) + EPSF);
        aux[tid] = r0 / r1; aux[256 + tid] = r1 / r2; aux[512 + tid] = r2;
    }
    __syncthreads();
    EpiWo E{hin, hout, hb_out, ss_out};
    pg8::gemm_phase((PG8_LAS unsigned char*)smem, g, S, E, nullptr);
    __syncthreads();
}

struct EpiPq {
    static constexpr bool PERM = true, AFTER_DRAIN = false;
    bf16* O; const float* ssrow;
    __device__ __forceinline__ void khook(int, f32x4 (&)[2][2][4][2], int, int) const {}
    __device__ __forceinline__ void operator()(const f32x4 (&acc)[2][2][4][2], const pg8::Unit& u, int wr, int wc, int fr, int fq) const {
        const int row0 = u.pm * 256 + wr * 64 + fr, col0 = u.pn * 256 + wc * 32 + 8 * fq;
#pragma unroll
        for (int ai = 0; ai < 2; ++ai)
#pragma unroll
            for (int m = 0; m < 4; ++m) {
                const int row = row0 + ai * 128 + m * 16;
                const float rs = row_rs8(ssrow, row);
                bf16* rowp = O + (size_t)row * 1024 + col0;
#pragma unroll
                for (int bj = 0; bj < 2; ++bj) {
                    f32x4 v0 = acc[ai][bj][m][0] * rs, v1 = acc[ai][bj][m][1] * rs;
                    u32x4 wv = {pack2(v0[0], v0[1]), pack2(v0[2], v0[3]), pack2(v1[0], v1[1]), pack2(v1[2], v1[3])};
                    *(u32x4*)(rowp + bj * 128) = wv;
                }
            }
    }
};
__device__ __forceinline__ void phase_pq(const Params& P, int L, int hsel, int ss_slot) {
    char* ws = opq(P.ws);
    const float* ssrow = (const float*)(ws + OFF_SSA) + (size_t)ss_slot * TOK * 8;
    const bf16* hb = (const bf16*)(ws + (hsel ? OFF_HB1 : OFF_HB0));
    const bf16* Bt = (const bf16*)(ws + OFF_WQ) + (size_t)L * 1024 * LDH;
    pg8::Gemm g{hb, Bt, LDH, LDH, TOK, 1024, 1024};
    pg8::StaticOrder S; S.init(TOK, 1024, gridDim.x, blockIdx.x);
    EpiPq E{(bf16*)(ws + OFF_PQ), ssrow};
    pg8::gemm_phase((PG8_LAS unsigned char*)smem, g, S, E, nullptr);
    __syncthreads();
}

__device__ __forceinline__ void cswap(int& a, int& b) { int mx = max(a, b), mn = min(a, b); a = mx; b = mn; }
__device__ __forceinline__ void bitonic_sort16(int (&v)[16]) {
#pragma unroll
    for (int k = 2; k <= 16; k <<= 1)
#pragma unroll
        for (int j = k >> 1; j > 0; j >>= 1)
#pragma unroll
            for (int i = 0; i < 16; ++i) {
                int q = i ^ j;
                if (q > i) {
                    if ((i & k) == 0) cswap(v[i], v[q]); else cswap(v[q], v[i]);
                }
            }
}
__device__ __forceinline__ void merge_top16(int (&Lv)[16], const int (&Rv)[16]) {
#pragma unroll
    for (int i = 0; i < 16; ++i) Lv[i] = max(Lv[i], Rv[15 - i]);
#pragma unroll
    for (int j = 8; j > 0; j >>= 1)
#pragma unroll
        for (int i = 0; i < 16; ++i) {
            int q = i ^ j;
            if (q > i) cswap(Lv[i], Lv[q]);
        }
}
__device__ __forceinline__ int f2key(float v, int low, int mask) {
    int b = __float_as_int(v);
    b ^= (b >> 31) & 0x7fffffff;
    return (b & ~mask) | low;
}
__device__ __forceinline__ float key2f(int k, int mask) {
    int b = k & ~mask;
    b ^= (b >> 31) & 0x7fffffff;
    return __int_as_float(b);
}

__device__ __forceinline__ void phase_topk(const Params& P, int L) {
    char* ws = opq(P.ws);
    const bf16* pq = (const bf16*)(ws + OFF_PQ);
    const bf16* skb = (const bf16*)(ws + OFF_SKB) + (size_t)L * 16 * 128 * 64;
    unsigned short* ids = (unsigned short*)(ws + OFF_IDS);
    float* gates = (float*)(ws + OFF_GATE);
    const int tid = opaque_tid(), w = tid >> 6, l = tid & 63, r = l & 31, hh = l >> 5;
    unsigned char* lidx = (unsigned char*)(smem + w * 1024 + r * 32);
    for (int task = blockIdx.x * NW + w; task < (TOK / 32) * 8; task += gridDim.x * NW) {
        const int t0 = (task >> 3) * 32, h = task & 7;
        int F[2][16];
#pragma unroll
        for (int p = 0; p < 2; ++p) {
            const int hp = h * 2 + p;
            f32x16 acc[4];
            const f32x16 z16 = {0.f, 0.f, 0.f, 0.f, 0.f, 0.f, 0.f, 0.f, 0.f, 0.f, 0.f, 0.f, 0.f, 0.f, 0.f, 0.f};
#pragma unroll
            for (int kt = 0; kt < 4; ++kt) acc[kt] = z16;
#pragma unroll
            for (int s4 = 0; s4 < 4; ++s4) {
                bf16x8 bfr = *(const bf16x8*)(pq + (size_t)(t0 + r) * 1024 + hp * 64 + 16 * s4 + 8 * hh);
#pragma unroll
                for (int kt = 0; kt < 4; ++kt) {
                    bf16x8 af = *(const bf16x8*)(skb + ((size_t)hp * 128 + 32 * kt + r) * 64 + 16 * s4 + 8 * hh);
                    acc[kt] = __builtin_amdgcn_mfma_f32_32x32x16_bf16(af, bfr, acc[kt], 0, 0, 0);
                }
            }
            int K0[16], K1[16], K2[16], K3[16];
#pragma unroll
            for (int rr = 0; rr < 16; ++rr) {
                const int nb = (rr & 3) + 8 * (rr >> 2) + 4 * hh;
                K0[rr] = f2key(acc[0][rr], 127 - nb, 127);
                K1[rr] = f2key(acc[1][rr], 127 - (32 + nb), 127);
                K2[rr] = f2key(acc[2][rr], 127 - (64 + nb), 127);
                K3[rr] = f2key(acc[3][rr], 127 - (96 + nb), 127);
            }
            bitonic_sort16(K0); bitonic_sort16(K1); bitonic_sort16(K2); bitonic_sort16(K3);
            merge_top16(K0, K1);
            merge_top16(K2, K3);
            merge_top16(K0, K2);
#pragma unroll
            for (int i = 0; i < 16; ++i) K1[i] = partner32(K0[i], hh);
            merge_top16(K0, K1);
#pragma unroll
            for (int i = 0; i < 16; ++i) F[p][i] = K0[i];
        }
        if (hh == 0) {
#pragma unroll
            for (int q = 0; q < 4; ++q) {
                unsigned w1 = 0, w2 = 0;
#pragma unroll
                for (int e = 0; e < 4; ++e) {
                    w1 |= (unsigned)(127 - (F[0][4 * q + e] & 127)) << (8 * e);
                    w2 |= (unsigned)(127 - (F[1][4 * q + e] & 127)) << (8 * e);
                }
                ((unsigned*)lidx)[q] = w1;
                ((unsigned*)lidx)[4 + q] = w2;
            }
        }
        {
            float s1[16], s2[16];
#pragma unroll
            for (int i = 0; i < 16; ++i) { s1[i] = key2f(F[0][i], 127); s2[i] = key2f(F[1][i], 127); }
            int Lc[16], X[16];
#pragma unroll
            for (int b2 = 0; b2 < 16; ++b2) Lc[b2] = f2key(s1[0] + s2[b2], 255 - b2, 255);
#pragma unroll
            for (int a2 = 1; a2 < 16; ++a2) X[a2 - 1] = f2key(s1[a2] + s2[0], 255 - a2 * 16, 255);
            X[15] = INT_MIN;
            merge_top16(Lc, X);
            X[0] = f2key(s1[1] + s2[1], 255 - 17, 255); X[1] = f2key(s1[1] + s2[2], 255 - 18, 255); X[2] = f2key(s1[1] + s2[3], 255 - 19, 255);
            X[3] = f2key(s1[1] + s2[4], 255 - 20, 255); X[4] = f2key(s1[1] + s2[5], 255 - 21, 255); X[5] = f2key(s1[1] + s2[6], 255 - 22, 255);
            X[6] = f2key(s1[1] + s2[7], 255 - 23, 255);
            X[7] = f2key(s1[2] + s2[1], 255 - 33, 255); X[8] = f2key(s1[2] + s2[2], 255 - 34, 255); X[9] = f2key(s1[2] + s2[3], 255 - 35, 255);
            X[10] = f2key(s1[2] + s2[4], 255 - 36, 255);
            X[11] = f2key(s1[3] + s2[1], 255 - 49, 255); X[12] = f2key(s1[3] + s2[2], 255 - 50, 255); X[13] = f2key(s1[3] + s2[3], 255 - 51, 255);
            X[14] = f2key(s1[4] + s2[1], 255 - 65, 255); X[15] = f2key(s1[4] + s2[2], 255 - 66, 255);
            bitonic_sort16(X);
            merge_top16(Lc, X);
            X[0] = f2key(s1[5] + s2[1], 255 - 81, 255);
            X[1] = f2key(s1[6] + s2[1], 255 - 97, 255);
            X[2] = f2key(s1[7] + s2[1], 255 - 113, 255);
#pragma unroll
            for (int i = 3; i < 16; ++i) X[i] = INT_MIN;
            merge_top16(Lc, X);
            if (hh == 0) {
                float mx = key2f(Lc[0], 255);
                float ev[16], sum = 0.f;
#pragma unroll
                for (int k = 0; k < 16; ++k) { ev[k] = __expf(key2f(Lc[k], 255) - mx); sum += ev[k]; }
                float inv = 1.f / sum;
                size_t ob = (size_t)(t0 + r) * 128 + h * 16;
                unsigned idw[8];
#pragma unroll
                for (int k = 0; k < 16; ++k) {
                    int cidx = 255 - (Lc[k] & 255);
                    int i1 = lidx[cidx >> 4], i2 = lidx[16 + (cidx & 15)];
                    unsigned idv = (unsigned)(i1 * 128 + i2);
                    if (k & 1) idw[k >> 1] |= idv << 16; else idw[k >> 1] = idv;
                }
                u32x4 o0 = {idw[0], idw[1], idw[2], idw[3]}, o1 = {idw[4], idw[5], idw[6], idw[7]};
                *(u32x4*)(ids + ob) = o0;
                *(u32x4*)(ids + ob + 8) = o1;
#pragma unroll
                for (int q = 0; q < 4; ++q) {
                    f32x4 g4 = {ev[4 * q] * inv, ev[4 * q + 1] * inv, ev[4 * q + 2] * inv, ev[4 * q + 3] * inv};
                    *(f32x4*)(gates + ob + 4 * q) = g4;
                }
            }
        }
    }
}

__device__ __forceinline__ float gelu_exact(float x) { return 0.5f * x * (1.f + erff(x * 0.70710678118654752f)); }

__device__ __forceinline__ void dec16(const u32x4& v, float (&f)[16]) {
    f32x2 t;
    t = __builtin_amdgcn_cvt_pk_f32_fp8((int)v.x, false); f[0] = t.x; f[1] = t.y;
    t = __builtin_amdgcn_cvt_pk_f32_fp8((int)v.x, true);  f[2] = t.x; f[3] = t.y;
    t = __builtin_amdgcn_cvt_pk_f32_fp8((int)v.y, false); f[4] = t.x; f[5] = t.y;
    t = __builtin_amdgcn_cvt_pk_f32_fp8((int)v.y, true);  f[6] = t.x; f[7] = t.y;
    t = __builtin_amdgcn_cvt_pk_f32_fp8((int)v.z, false); f[8] = t.x; f[9] = t.y;
    t = __builtin_amdgcn_cvt_pk_f32_fp8((int)v.z, true);  f[10] = t.x; f[11] = t.y;
    t = __builtin_amdgcn_cvt_pk_f32_fp8((int)v.w, false); f[12] = t.x; f[13] = t.y;
    t = __builtin_amdgcn_cvt_pk_f32_fp8((int)v.w, true);  f[14] = t.x; f[15] = t.y;
}

__device__ __forceinline__ void dec32(const u32x4& v, f32x2 (&f)[16]) {
    f[0] = __builtin_amdgcn_cvt_scalef32_pk_f32_fp4(v.x, 1.0f, 0); f[1] = __builtin_amdgcn_cvt_scalef32_pk_f32_fp4(v.x, 1.0f, 1);
    f[2] = __builtin_amdgcn_cvt_scalef32_pk_f32_fp4(v.x, 1.0f, 2); f[3] = __builtin_amdgcn_cvt_scalef32_pk_f32_fp4(v.x, 1.0f, 3);
    f[4] = __builtin_amdgcn_cvt_scalef32_pk_f32_fp4(v.y, 1.0f, 0); f[5] = __builtin_amdgcn_cvt_scalef32_pk_f32_fp4(v.y, 1.0f, 1);
    f[6] = __builtin_amdgcn_cvt_scalef32_pk_f32_fp4(v.y, 1.0f, 2); f[7] = __builtin_amdgcn_cvt_scalef32_pk_f32_fp4(v.y, 1.0f, 3);
    f[8] = __builtin_amdgcn_cvt_scalef32_pk_f32_fp4(v.z, 1.0f, 0); f[9] = __builtin_amdgcn_cvt_scalef32_pk_f32_fp4(v.z, 1.0f, 1);
    f[10] = __builtin_amdgcn_cvt_scalef32_pk_f32_fp4(v.z, 1.0f, 2); f[11] = __builtin_amdgcn_cvt_scalef32_pk_f32_fp4(v.z, 1.0f, 3);
    f[12] = __builtin_amdgcn_cvt_scalef32_pk_f32_fp4(v.w, 1.0f, 0); f[13] = __builtin_amdgcn_cvt_scalef32_pk_f32_fp4(v.w, 1.0f, 1);
    f[14] = __builtin_amdgcn_cvt_scalef32_pk_f32_fp4(v.w, 1.0f, 2); f[15] = __builtin_amdgcn_cvt_scalef32_pk_f32_fp4(v.w, 1.0f, 3);
}

typedef _Float16 f16x2 __attribute__((ext_vector_type(2)));
__device__ __forceinline__ void dec8_f16(unsigned x, f16x2 (&wv)[4]) {
    const unsigned lo = x & 0x07070707u, hi = (x >> 4) & 0x07070707u;
    const unsigned Lb = __builtin_amdgcn_perm(0x46444240u, 0x3E3C3800u, lo) | ((x & 0x08080808u) << 4);
    const unsigned Hb = __builtin_amdgcn_perm(0x46444240u, 0x3E3C3800u, hi) | (x & 0x80808080u);
    wv[0] = __builtin_bit_cast(f16x2, __builtin_amdgcn_perm(Hb, Lb, 0x040c000cu));
    wv[1] = __builtin_bit_cast(f16x2, __builtin_amdgcn_perm(Hb, Lb, 0x050c010cu));
    wv[2] = __builtin_bit_cast(f16x2, __builtin_amdgcn_perm(Hb, Lb, 0x060c020cu));
    wv[3] = __builtin_bit_cast(f16x2, __builtin_amdgcn_perm(Hb, Lb, 0x070c030cu));
}

__device__ __forceinline__ int idof16(const u32x4 (&q)[2], int i) {
    unsigned wv = (i >> 1) == 0 ? q[0].x : (i >> 1) == 1 ? q[0].y : (i >> 1) == 2 ? q[0].z : (i >> 1) == 3 ? q[0].w
                : (i >> 1) == 4 ? q[1].x : (i >> 1) == 5 ? q[1].y : (i >> 1) == 6 ? q[1].z : q[1].w;
    return (i & 1) ? (int)(wv >> 16) : (int)(wv & 0xffffu);
}
__device__ __forceinline__ void phase_gather_u(const Params& P, int L) {
    char* ws = opq(P.ws);
    const unsigned char* U4 = (const unsigned char*)(ws + OFF_UB) + (size_t)L * NEXP * 512;
    float* part = (float*)(ws + OFF_PART);
    const unsigned short* ids = (const unsigned short*)(ws + OFF_IDS);
    const float* hin = opq(P.out);
    const int tid = opaque_tid(), w = tid >> 6, l = tid & 63, c = l & 7, gq = l >> 3;
    const int sl = blockIdx.x & 3, par = (blockIdx.x >> 2) & 1, rk = blockIdx.x >> 3, nb = gridDim.x >> 3;
    if (rk >= nb) return;
    const unsigned char* ubase = U4 + (size_t)sl * NEXP * 128 + c * 16;
    const int stride = nb * NW;
    int ti = rk * NW + w;
    if (ti >= TOK / 2) return;
    u32x4 idA[2], idB[2];
    u32x4 rv[16];
    f32x4 hA[8], hB[8];
    auto load_ids = [&](int tt, u32x4 (&idq)[2]) {
        const u32x4* i4 = (const u32x4*)(ids + (size_t)tt * 128 + 16 * gq);
        idq[0] = i4[0]; idq[1] = i4[1];
    };
    auto load_hx = [&](int tt, f32x4 (&hx)[8]) {
        const f32x4* h4 = (const f32x4*)(hin + (size_t)tt * 1024 + 256 * sl + 32 * c);
#pragma unroll
        for (int q = 0; q < 8; ++q) hx[q] = h4[q];
    };
    auto step = [&](int tcur, int tnext, int tnext2, const u32x4 (&idn)[2], u32x4 (&idl)[2], const f32x4 (&hc)[8], f32x4 (&hn)[8]) {
        load_ids(tnext2, idl);
        load_hx(tnext, hn);
        __builtin_amdgcn_sched_barrier(0);
        float pr[16];
#pragma unroll
        for (int i = 0; i < 16; ++i) {
            f32x2 f[16];
            asm volatile("" : "+v"(rv[i].x), "+v"(rv[i].y), "+v"(rv[i].z), "+v"(rv[i].w));
            dec32(rv[i], f);
            rv[i] = *(const u32x4*)(ubase + (size_t)idof16(idn, i) * 128);
            __builtin_amdgcn_sched_barrier(0);
            f32x2 s2 = {0.f, 0.f};
#pragma unroll
            for (int q = 0; q < 8; ++q) {
                f32x2 x0 = {hc[q].x, hc[q].y}, x1 = {hc[q].z, hc[q].w};
                s2 = __builtin_elementwise_fma(f[2 * q], x0, s2);
                s2 = __builtin_elementwise_fma(f[2 * q + 1], x1, s2);
            }
            float sacc = s2.x + s2.y;
            asm volatile("" : "+v"(sacc));
            pr[i] = sacc;
        }
#pragma unroll
        for (int i = 0; i < 16; ++i) pr[i] = sum8_dpp(pr[i]);
        if (c == 0) {
            f32x4* o4 = (f32x4*)(part + ((size_t)sl * TOK + tcur) * 128 + 16 * gq);
#pragma unroll
            for (int q = 0; q < 4; ++q) { f32x4 o = {pr[4 * q], pr[4 * q + 1], pr[4 * q + 2], pr[4 * q + 3]}; o4[q] = o; }
        }
    };
    auto tok = [&](int tidx, int fb) { return 2 * (tidx < TOK / 2 ? tidx : fb) + par; };
    load_ids(tok(ti, ti), idA);
#pragma unroll
    for (int i = 0; i < 16; ++i) rv[i] = *(const u32x4*)(ubase + (size_t)idof16(idA, i) * 128);
    load_hx(tok(ti, ti), hA);
    load_ids(tok(ti + stride, ti), idB);
    for (;;) {
        int tn = ti + stride, tn2 = ti + 2 * stride;
        step(tok(ti, ti), tok(tn, ti), tok(tn2, ti), idB, idA, hA, hB);
        if (tn >= TOK / 2) break;
        ti = tn; tn = ti + stride; tn2 = ti + 2 * stride;
        step(tok(ti, ti), tok(tn, ti), tok(tn2, ti), idA, idB, hB, hA);
        if (tn >= TOK / 2) break;
        ti = tn;
    }
}

__device__ __forceinline__ void phase_gather_act(const Params& P, int L, int ss_slot) {
    char* ws = opq(P.ws);
    const float* ss_ffn = (const float*)(ws + OFF_SSA) + (size_t)ss_slot * TOK * 8;
    const float* part = (const float*)(ws + OFF_PART);
    const unsigned short* ids = (const unsigned short*)(ws + OFF_IDS);
    float* gates = (float*)(ws + OFF_GATE);
    const float* uinv = (const float*)(ws + OFF_TSC) + L * NEXP;
    const float* vinv = (const float*)(ws + OFF_TSC) + (2 + L) * NEXP;
    const int tid = opaque_tid(), w = tid >> 6, l = tid & 63;
    for (int t = blockIdx.x * NW + w; t < TOK; t += gridDim.x * NW) {
        float rs = row_rs8(ss_ffn, t);
#pragma unroll
        for (int hsel = 0; hsel < 2; ++hsel) {
            int k = l + 64 * hsel;
            float sacc = 0.f;
#pragma unroll
            for (int j = 0; j < 4; ++j) sacc += part[((size_t)j * TOK + t) * 128 + k];
            int id = ids[(size_t)t * 128 + k];
            float pre = sacc * rs * uinv[id];
            gates[(size_t)t * 128 + k] = gates[(size_t)t * 128 + k] * gelu_exact(pre) * vinv[id];
        }
    }
}

__device__ __forceinline__ void phase_gather_v(const Params& P, int L, int hsel, int ss_slot) {
    char* ws = opq(P.ws);
    float* ss_ple = (float*)(ws + OFF_SSA) + (size_t)ss_slot * TOK * 8;
    bf16* hb_out = (bf16*)(ws + (hsel ? OFF_HB1 : OFF_HB0));
    const unsigned char* V4 = (const unsigned char*)(ws + OFF_VB) + (size_t)L * NEXP * 512;
    const unsigned short* ids = (const unsigned short*)(ws + OFF_IDS);
    const float* act = (const float*)(ws + OFF_GATE);
    float* hio = opq(P.out);
    const int tid = opaque_tid(), w = tid >> 6, l = tid & 63, c = l & 7, gq = l >> 3;
    const int sl = blockIdx.x & 3, par = (blockIdx.x >> 2) & 1, rk = blockIdx.x >> 3, nb = gridDim.x >> 3;
    if (rk >= nb) return;
    const unsigned char* vbase = V4 + (size_t)sl * NEXP * 128 + c * 16;
    const int stride = nb * NW;
    int ti = rk * NW + w;
    if (ti >= TOK / 2) return;
    const bool b3 = (l >> 3) & 1;
    u32x4 idA[2], idB[2];
    u32x4 rv[16];
    f32x4 aA[4], aB[4];
    auto load_ids = [&](int tt, u32x4 (&idq)[2]) {
        const u32x4* i4 = (const u32x4*)(ids + (size_t)tt * 128 + 16 * gq);
        idq[0] = i4[0]; idq[1] = i4[1];
    };
    auto load_a = [&](int tt, f32x4 (&ax)[4]) {
        const f32x4* a4 = (const f32x4*)(act + (size_t)tt * 128 + 16 * gq);
#pragma unroll
        for (int q = 0; q < 4; ++q) ax[q] = a4[q];
    };
    auto step = [&](int tcur, int tnext, int tnext2, const u32x4 (&idn)[2], u32x4 (&idl)[2], const f32x4 (&ac)[4], f32x4 (&an)[4]) {
        load_ids(tnext2, idl);
        load_a(tnext, an);
        __builtin_amdgcn_sched_barrier(0);
        f32x2 acc[16];
#pragma unroll
        for (int e = 0; e < 16; ++e) { acc[e].x = 0.f; acc[e].y = 0.f; }
#pragma unroll
        for (int i = 0; i < 16; ++i) {
            f32x2 f[16];
            asm volatile("" : "+v"(rv[i].x), "+v"(rv[i].y), "+v"(rv[i].z), "+v"(rv[i].w));
            dec32(rv[i], f);
            rv[i] = *(const u32x4*)(vbase + (size_t)idof16(idn, i) * 128);
            __builtin_amdgcn_sched_barrier(0);
            const float a = (i & 3) == 0 ? ac[i >> 2].x : (i & 3) == 1 ? ac[i >> 2].y : (i & 3) == 2 ? ac[i >> 2].z : ac[i >> 2].w;
            const f32x2 a2 = {a, a};
#pragma unroll
            for (int e = 0; e < 16; ++e) acc[e] = __builtin_elementwise_fma(f[e], a2, acc[e]);
#pragma unroll
            for (int e = 0; e < 16; ++e) asm volatile("" : "+v"(acc[e]));
        }
        float v8[8][2];
#pragma unroll
        for (int e = 0; e < 8; ++e) {
            float k0 = b3 ? acc[8 + e].x : acc[e].x, k1 = b3 ? acc[8 + e].y : acc[e].y;
            float s0 = b3 ? acc[e].x : acc[8 + e].x, s1 = b3 ? acc[e].y : acc[8 + e].y;
            v8[e][0] = k0 + __builtin_bit_cast(float, __builtin_amdgcn_update_dpp(0, __builtin_bit_cast(int, s0), 0x128, 0xf, 0xf, true));
            v8[e][1] = k1 + __builtin_bit_cast(float, __builtin_amdgcn_update_dpp(0, __builtin_bit_cast(int, s1), 0x128, 0xf, 0xf, true));
        }
        float v4[8];
#pragma unroll
        for (int e = 0; e < 8; ++e) {
            float X = v8[e >> 1][e & 1], Y = v8[4 + (e >> 1)][e & 1];
            asm volatile("s_nop 1\n\tv_permlane16_swap_b32 %0, %1\n\ts_nop 1" : "+v"(X), "+v"(Y));
            v4[e] = X + Y;
        }
        float v2[4];
#pragma unroll
        for (int e = 0; e < 4; ++e) {
            float X = v4[e], Y = v4[4 + e];
            asm volatile("s_nop 1\n\tv_permlane32_swap_b32 %0, %1\n\ts_nop 1" : "+v"(X), "+v"(Y));
            v2[e] = X + Y;
        }
        const int col = 256 * sl + 32 * c + 16 * ((l >> 3) & 1) + 8 * ((l >> 4) & 1) + 4 * (l >> 5);
        f32x4* h4 = (f32x4*)(hio + (size_t)tcur * 1024 + col);
        f32x4 hv = *h4;
        hv.x += v2[0]; hv.y += v2[1]; hv.z += v2[2]; hv.w += v2[3];
        *h4 = hv;
        u32x2 bb = {pack2(hv.x, hv.y), pack2(hv.z, hv.w)};
        *(u32x2*)(hb_out + (size_t)tcur * LDH + col) = bb;
        float ssq = hv.x * hv.x + hv.y * hv.y + hv.z * hv.z + hv.w * hv.w;
        ssq = wave_sum(ssq);
        if (l == 0) { ss_ple[(size_t)tcur * 8 + sl] = ssq; ss_ple[(size_t)tcur * 8 + 4 + sl] = 0.f; }
    };
    auto tok = [&](int tidx, int fb) { return 2 * (tidx < TOK / 2 ? tidx : fb) + par; };
    load_ids(tok(ti, ti), idA);
#pragma unroll
    for (int i = 0; i < 16; ++i) rv[i] = *(const u32x4*)(vbase + (size_t)idof16(idA, i) * 128);
    load_a(tok(ti, ti), aA);
    load_ids(tok(ti + stride, ti), idB);
    for (;;) {
        int tn = ti + stride, tn2 = ti + 2 * stride;
        step(tok(ti, ti), tok(tn, ti), tok(tn2, ti), idB, idA, aA, aB);
        if (tn >= TOK / 2) break;
        ti = tn; tn = ti + stride; tn2 = ti + 2 * stride;
        step(tok(ti, ti), tok(tn, ti), tok(tn2, ti), idA, idB, aB, aA);
        if (tn >= TOK / 2) break;
        ti = tn;
    }
}

__device__ __forceinline__ void phase_ple(const Params& P, int L, int hsel, int ss_slot_in, int ss_slot_out) {
    char* ws = opq(P.ws);
    const float* ss_ple = (const float*)(ws + OFF_SSA) + (size_t)ss_slot_in * TOK * 8;
    float* ss_out = (float*)(ws + OFF_SSA) + (size_t)ss_slot_out * TOK * 8;
    const bf16* hb_in = (const bf16*)(ws + (hsel ? OFF_HB1 : OFF_HB0));
    bf16* hb_out = (bf16*)(ws + (hsel ? OFF_HB0 : OFF_HB1));
    float* hio = opq(P.out);
    const bf16* pin = (const bf16*)(ws + OFF_PB) + (size_t)L * TOK * LDP;
    const bf16* Wg = (const bf16*)(ws + OFF_WG) + (size_t)L * 1024 * LDH;
    const bf16* Wp = (const bf16*)(ws + OFF_WP) + (size_t)L * 1024 * LDP;
    const int tid = opaque_tid(), w = tid >> 6, l = tid & 63, hh = l >> 5, wm = w >> 1, wn = w & 1;
    for (int it = 0;; ++it) {
        int mt, nt;
        if (!xcd_tile(it, 64, 8, mt, nt)) break;
        int m0 = mt * 256, n0 = nt * 128;
        float* aux = (float*)(smem + LDS_AUX);
        __syncthreads();
        if (tid < 256) aux[tid] = row_rs8(ss_ple, m0 + tid);
        f32x16 acc1[2][2], acc2[2][2];
        ZERO_ACC(acc1);
        ZERO_ACC(acc2);
        gemm_core(acc1, hb_in, LDH, Wg, LDH, 1024, m0, n0, NoHook());
        gemm_core(acc2, pin, LDP, Wp, LDP, 256, m0, n0, NoHook());
#pragma unroll
        for (int i = 0; i < 2; ++i)
#pragma unroll
            for (int rr = 0; rr < 16; ++rr) {
                float rs = aux[wm * 64 + i * 32 + (rr & 3) + 8 * (rr >> 2) + 4 * hh];
#pragma unroll
                for (int j = 0; j < 2; ++j) {
                    float gte = 1.f / (1.f + __expf(-acc1[i][j][rr] * rs));
                    acc2[i][j][rr] *= gte;
                }
            }
        stage_f32<false>(acc2, nullptr);
        residual_store(hio, hio, hb_out, ss_out, m0, n0, nt);
    }
}

__device__ __forceinline__ void phase_final(const Params& P, int ss_slot) {
    float* hio = opq(P.out);
    const float* ss = (const float*)(opq(P.ws) + OFF_SSA) + (size_t)ss_slot * TOK * 8;
    const int tid = opaque_tid(), w = tid >> 6, l = tid & 63;
    const float4* g4 = (const float4*)P.final_norm_g;
    for (int t = blockIdx.x * NW + w; t < TOK; t += gridDim.x * NW) {
        float rs = row_rs8(ss, t);
        float4* o4 = (float4*)(hio + (size_t)t * 1024);
#pragma unroll
        for (int i = 0; i < 4; ++i) {
            float4 v = o4[i * 64 + l], g = g4[i * 64 + l];
            v.x *= rs * g.x; v.y *= rs * g.y; v.z *= rs * g.z; v.w *= rs * g.w;
            o4[i * 64 + l] = v;
        }
    }
}

#define XB_TMO      128
#define XB_XCNT(j)  (256  + 64 * (j))
#define XB_XSUB(j)  (1280 + 64 * (j))
#define XB_XGEN(j)  (2304 + 64 * (j))
#define XB_TOP      3328
#define XB_TOPGEN   3392
#define XCD_BAR_WORDS 3456
#define XB_SPIN_CAP (1u << 22)
__device__ __forceinline__ unsigned xb_ld(unsigned* p) { return __hip_atomic_load(p, __ATOMIC_RELAXED, __HIP_MEMORY_SCOPE_AGENT); }
__device__ __forceinline__ unsigned xb_add(unsigned* p, unsigned v) { return __hip_atomic_fetch_add(p, v, __ATOMIC_RELAXED, __HIP_MEMORY_SCOPE_AGENT); }
__device__ __forceinline__ unsigned xb_xcc_id() { return (unsigned)__builtin_amdgcn_s_getreg((3 << 11) | 20) & 0xFu; }
#define XB_SPIN(cond, bar) do { unsigned _sp = 0; while (cond) { __builtin_amdgcn_s_sleep(1); \
    if ((++_sp & 255u) == 0u) { if (xb_ld(&(bar)[XB_TMO])) break; if (_sp > XB_SPIN_CAP) { atomicAdd(&(bar)[XB_TMO], 1u); break; } } } } while (0)
#define XB_LDS_OFF (LDS_BYTES - 64)
__device__ __forceinline__ void xcd_barrier_post(const Params& P) {
    if (threadIdx.x == 0) {
        unsigned* bar = (unsigned*)(P.ws + OFF_BAR);
        volatile __attribute__((address_space(3))) unsigned* st = (volatile __attribute__((address_space(3))) unsigned*)(smem + XB_LDS_OFF);
        st[0] = 0u; st[1] = 0u;
        (void)xb_add(&bar[XB_XCNT(xb_xcc_id())], 1u);
    }
}
__device__ __forceinline__ void xcd_barrier_complete(unsigned* bar, unsigned x, unsigned& nloc, unsigned& nx) {
    const unsigned G = gridDim.x;
    unsigned sum, cnt, mine, sp = 0u;
    for (;;) {
        sum = 0u; cnt = 0u; mine = 0u;
#pragma unroll
        for (unsigned j = 0; j < 16; ++j) { const unsigned c = xb_ld(&bar[XB_XCNT(j)]); sum += c; cnt += (c > 0u) ? 1u : 0u; mine = (j == x) ? c : mine; }
        if (sum == G) break;
        __builtin_amdgcn_s_sleep(1);
        if ((++sp & 255u) == 0u) { if (xb_ld(&bar[XB_TMO])) break; if (sp > XB_SPIN_CAP) { atomicAdd(&bar[XB_TMO], 1u); break; } }
    }
    nloc = mine > 0u ? mine : 1u; nx = cnt > 0u ? cnt : 1u;
}
__device__ __forceinline__ void grid_barrier(const Params& P) {
    asm volatile("s_waitcnt vmcnt(0)" ::: "memory");
    __syncthreads();
    if (threadIdx.x == 0) {
        unsigned* bar = (unsigned*)(P.ws + OFF_BAR);
        volatile __attribute__((address_space(3))) unsigned* st = (volatile __attribute__((address_space(3))) unsigned*)(smem + XB_LDS_OFF);
        const unsigned x = xb_xcc_id();
        __builtin_amdgcn_s_waitcnt(0);
        unsigned nloc = st[0], nx = st[1];
        if (nloc == 0u) { xcd_barrier_complete(bar, x, nloc, nx); st[0] = nloc; st[1] = nx; }
        const unsigned old = xb_add(&bar[XB_XSUB(x)], 1u);
        const unsigned gen = old / nloc;
        if (old + 1u == (gen + 1u) * nloc) {
            __builtin_amdgcn_fence(__ATOMIC_RELEASE, "agent");
            asm volatile("s_waitcnt vmcnt(0)" ::: "memory");
            const unsigned og = xb_add(&bar[XB_TOP], 1u);
            const unsigned tg = og / nx;
            if (og + 1u == (tg + 1u) * nx) xb_add(&bar[XB_TOPGEN], 1u);
            else XB_SPIN(xb_ld(&bar[XB_TOPGEN]) == tg, bar);
            __builtin_amdgcn_fence(__ATOMIC_ACQUIRE, "agent");
            xb_add(&bar[XB_XGEN(x)], 1u);
            asm volatile("s_waitcnt vmcnt(0)" ::: "memory");
        } else {
            XB_SPIN(xb_ld(&bar[XB_XGEN(x)]) == gen, bar);
            __builtin_amdgcn_fence(__ATOMIC_ACQUIRE, "agent");
            asm volatile("s_waitcnt vmcnt(0)" ::: "memory");
        }
    }
    __syncthreads();
}

__global__ void __launch_bounds__(NTHR, 2) hymba_megakernel(Params P) {
    cg::grid_group grid = cg::this_grid();
    char* ws = opq(P.ws);
    xcd_barrier_post(P);
#define BAR() do { grid_barrier(P); if (DUP == 20) grid_barrier(P); } while (0)
    phase0(P);
    if (DUP == 0) { asm volatile("s_waitcnt vmcnt(0)" ::: "memory"); __syncthreads(); grid_barrier(P); phase0(P); }
    asm volatile("s_waitcnt vmcnt(0)" ::: "memory");
    __syncthreads();
    grid.sync();
    BAR();
    int cur = 0;
    for (int L = 0; L < 2; ++L) {
        const int ss_mix = (L == 0) ? 0 : 3, ss_ffn = 1 + L, ss_next = (L == 0) ? 3 : 4, ss_ple = 5 + L;
        phase_proj(P, L, cur, ss_mix);
        BAR();
        if (DUP == 1) { phase_proj(P, L, cur, ss_mix); BAR(); }
        phase_mla_up(P, L);
        BAR();
        if (DUP == 2) { phase_mla_up(P, L); BAR(); }
        phase_attn(P, L, 0);
        BAR();
        if (DUP == 3) { phase_attn(P, L, 1); BAR(); }
        if (DUP >= 30 && DUP < 34) { phase_attn(P, L, 1, DUP - 30); BAR(); }
        phase_wo(P, L, cur ^ 1, ss_ffn);
        BAR();
        if (DUP == 4 && L == 0) { phase_wo(P, L, cur ^ 1, ss_ffn); BAR(); }
        phase_pq(P, L, cur ^ 1, ss_ffn);
        BAR();
        if (DUP == 5) { phase_pq(P, L, cur ^ 1, ss_ffn); BAR(); }
        phase_topk(P, L);
        BAR();
        if (DUP == 6) { phase_topk(P, L); BAR(); }
        phase_gather_u(P, L);
        BAR();
        if (DUP == 7) { phase_gather_u(P, L); BAR(); }
        phase_gather_act(P, L, ss_ffn);
        BAR();
        phase_gather_v(P, L, cur, ss_ple);
        BAR();
        phase_ple(P, L, cur, ss_ple, ss_next);
        BAR();
        cur ^= 1;
    }
    phase_final(P, 4);
}

extern "C" void kernel_launch(void* const* d_in, const int* in_sizes, int n_in, void* d_out, int out_size, void* d_ws,
                              size_t ws_size, hipStream_t stream) {
    static int grid_blocks = 0;
    if (!grid_blocks) {
        int dev = 0, cus = 0, per_cu = 0;
        hipGetDevice(&dev);
        hipDeviceGetAttribute(&cus, hipDeviceAttributeMultiprocessorCount, dev);
        hipOccupancyMaxActiveBlocksPerMultiprocessor(&per_cu, hymba_megakernel, NTHR, 0);
        if (per_cu > 1) per_cu = 1;
        if (per_cu < 1) per_cu = 1;
        grid_blocks = cus * per_cu;
        if (ws_size < WS_END) fprintf(stderr, "workspace too small: %zu < %zu\n", ws_size, (size_t)WS_END);
    }
    Params P{};
    P.x = (const float*)d_in[0]; P.p = (const float*)d_in[1]; P.pos = (const int*)d_in[2];
    P.norm_mix_g = (const float*)d_in[3]; P.w_in = (const float*)d_in[4]; P.b_forget = (const float*)d_in[5];
    P.mla_q_norm_g = (const float*)d_in[6]; P.w_uq = (const float*)d_in[7]; P.mla_kv_norm_g = (const float*)d_in[8];
    P.w_ukv = (const float*)d_in[9]; P.mix_out_norm_g = (const float*)d_in[10]; P.w_o = (const float*)d_in[11];
    P.norm_ffn_g = (const float*)d_in[12]; P.w_query = (const float*)d_in[13]; P.sub_keys = (const float*)d_in[14];
    P.peer_u = (const float*)d_in[15]; P.peer_v = (const float*)d_in[16]; P.w_ple = (const float*)d_in[17];
    P.ple_norm_g = (const float*)d_in[18]; P.w_ple_gate = (const float*)d_in[19]; P.final_norm_g = (const float*)d_in[20];
    P.out = (float*)d_out; P.ws = (char*)d_ws;
    hipMemsetAsync((char*)d_ws + OFF_BAR, 0, 16384 + 4096, stream);
    void* args[] = {&P};
    hipError_t e = hipLaunchCooperativeKernel((void*)hymba_megakernel, dim3(grid_blocks), dim3(NTHR), args, 0, stream);
    if (e != hipSuccess) fprintf(stderr, "cooperative launch failed: %s (grid %d)\n", hipGetErrorString(e), grid_blocks);
}
```

```cpp
#include <hip/hip_runtime.h>
#include <hip/hip_cooperative_groups.h>
#include <cstdio>
#include <cstdint>
#include <math.h>
#include <climits>
namespace cg = cooperative_groups;

typedef __bf16 bf16;
typedef __bf16 bf16x8 __attribute__((ext_vector_type(8)));
typedef __bf16 bf16x4 __attribute__((ext_vector_type(4)));
typedef __bf16 bf16x2 __attribute__((ext_vector_type(2)));
typedef float f32x16 __attribute__((ext_vector_type(16)));
typedef float f32x4 __attribute__((ext_vector_type(4)));
typedef float f32x2 __attribute__((ext_vector_type(2)));
typedef unsigned u32x4 __attribute__((ext_vector_type(4)));
typedef unsigned u32x2 __attribute__((ext_vector_type(2)));

#define SEQ 2048
#define BATCH 8
#define TOK 16384
#define DM 1024
#define IN_W 1956
#define NEXP 16384
#define EPSF 1e-6f
#define LOG2E 1.4426950408889634f
#define NTHR 512
#define NW 8
#define LDS_BYTES 151808
#define STAGE_BYTES 49152
#define LDS_AUX 147456
#ifndef DUP
#define DUP -1
#endif

constexpr size_t MBy = 1ull << 20;
constexpr size_t OFF_UB = 0;
constexpr size_t OFF_VB = 16 * MBy;
constexpr size_t OFF_PART = 32 * MBy;
constexpr size_t OFF_PW1 = 96 * MBy;
#define LDH 1088
#define LDP 320
#define LDC 192
constexpr size_t OFF_WIN = 128 * MBy;
constexpr size_t OFF_WO = 137 * MBy;
constexpr size_t OFF_WQ = 142 * MBy;
constexpr size_t OFF_WG = 147 * MBy;
constexpr size_t OFF_WP = 152 * MBy;
constexpr size_t OFF_WUQ = 154 * MBy;
constexpr size_t OFF_WUKV = 155 * MBy;
constexpr size_t OFF_SKB = 156 * MBy;
constexpr size_t OFF_CS = 157 * MBy;
constexpr size_t OFF_TSC = 159 * MBy;
constexpr size_t OFF_SSA = 160 * MBy;
constexpr size_t OFF_HB0 = 164 * MBy;
constexpr size_t OFF_HB1 = 200 * MBy;
constexpr size_t OFF_FQ = 236 * MBy;
constexpr size_t OFF_FK = 244 * MBy;
constexpr size_t OFF_FVT = 252 * MBy;
constexpr size_t OFF_SQ = 260 * MBy;
constexpr size_t OFF_SKK = 268 * MBy;
constexpr size_t OFF_SVT = 276 * MBy;
constexpr size_t OFF_CQ = 284 * MBy;
constexpr size_t OFF_CKV = 295 * MBy;
constexpr size_t OFF_FLOG = 302 * MBy;
constexpr size_t OFF_CUMF = 303 * MBy;
constexpr size_t OFF_MQ = 304 * MBy;
constexpr size_t OFF_MK = 316 * MBy;
constexpr size_t OFF_MVT = 328 * MBy;
constexpr size_t OFF_Y = 344 * MBy;
constexpr size_t OFF_PQ = 380 * MBy;
constexpr size_t OFF_IDS = 412 * MBy;
constexpr size_t OFF_GATE = 420 * MBy;
constexpr size_t OFF_BAR = 428 * MBy;
constexpr size_t OFF_CNT = OFF_BAR + 16384;
constexpr size_t OFF_SSY = 429 * MBy;
constexpr size_t OFF_PB = 431 * MBy;
constexpr size_t OFF_PW0 = 452 * MBy;
constexpr size_t WS_END = 484 * MBy;

struct Params {
    const float* x; const float* p; const int* pos;
    const float* norm_mix_g; const float* w_in; const float* b_forget; const float* mla_q_norm_g; const float* w_uq;
    const float* mla_kv_norm_g; const float* w_ukv; const float* mix_out_norm_g; const float* w_o; const float* norm_ffn_g;
    const float* w_query; const float* sub_keys; const float* peer_u; const float* peer_v; const float* w_ple;
    const float* ple_norm_g; const float* w_ple_gate; const float* final_norm_g;
    float* out; char* ws;
};

__shared__ __attribute__((aligned(16))) char smem[LDS_BYTES];

__device__ __forceinline__ int opaque_tid() { int t = threadIdx.x; asm volatile("" : "+v"(t)); return t; }
template <typename T> __device__ __forceinline__ T* opq(T* p) { size_t z = 0; asm volatile("" : "+s"(z)); return (T*)((char*)p + z); }

__device__ __forceinline__ unsigned pack2(float a, float b) {
    f32x2 v = {a, b};
    bf16x2 r = __builtin_convertvector(v, bf16x2);
    return __builtin_bit_cast(unsigned, r);
}
__device__ __forceinline__ float bflo(unsigned u) { return __uint_as_float(u << 16); }
__device__ __forceinline__ float bfhi(unsigned u) { return __uint_as_float(u & 0xffff0000u); }
__device__ __forceinline__ float wave_sum(float v) {
#pragma unroll
    for (int o = 32; o > 0; o >>= 1) v += __shfl_xor(v, o);
    return v;
}
template <int CTRL> __device__ __forceinline__ float dpp_add(float v) {
    return v + __builtin_bit_cast(float, __builtin_amdgcn_update_dpp(0, __builtin_bit_cast(int, v), CTRL, 0xf, 0xf, true));
}
__device__ __forceinline__ float sum8_dpp(float v) { v = dpp_add<0xB1>(v); v = dpp_add<0x4E>(v); v = dpp_add<0x141>(v); return v; }
__device__ __forceinline__ float sumg_dpp(float v) {
    v = dpp_add<0x128>(v);
    float a = v, b = v;
    asm volatile("s_nop 1\n\tv_permlane16_swap_b32 %0, %1\n\ts_nop 1" : "+v"(a), "+v"(b));
    v = a + b;
    a = v; b = v;
    asm volatile("s_nop 1\n\tv_permlane32_swap_b32 %0, %1\n\ts_nop 1" : "+v"(a), "+v"(b));
    return a + b;
}
__device__ __forceinline__ int partner32(int v, int hh) {
    int a = v, b = v;
    asm volatile("s_nop 1\n\tv_permlane32_swap_b32 %0, %1\n\ts_nop 1" : "+v"(a), "+v"(b));
    return hh ? a : b;
}
__device__ __forceinline__ float fexp2(float x) { return __builtin_amdgcn_exp2f(x); }
__device__ __forceinline__ float flog2(float x) { return __builtin_amdgcn_logf(x); }
__device__ __forceinline__ float log_sigmoid_f(float z) { return fminf(z, 0.f) - 0.6931471805599453f * flog2(1.f + fexp2(-1.4426950408889634f * fabsf(z))); }

struct WJob { const float* src; int lds; int K; int Np; bf16* dst; int ldd; const float* gain; int map; };

__device__ __forceinline__ int src_col_map(int map, int c) {
    if (map == 0) return c;
    if (map == 1) {
        if (c < 768) return c;
        if (c < 1952) return c + 4;
        if (c < 1956) return c - 1952 + 768;
        return -1;
    }
    if (c < 256) return 192 * (c >> 6) + (c & 63);
    int e = c - 256;
    return 192 * (e >> 7) + 64 + (e & 127);
}

__device__ __forceinline__ void wconv_tile(const WJob& j, int tile) {
    float* tl = (float*)smem;
    int ktiles = j.K >> 5;
    int nt = tile / ktiles, kt = tile % ktiles;
    int n0 = nt * 32, k0 = kt * 32;
    int tx = opaque_tid() & 31, ty = opaque_tid() >> 5;
    int sc = src_col_map(j.map, n0 + tx);
#pragma unroll
    for (int i = 0; i < 2; ++i) {
        int k = k0 + ty + 16 * i;
        float v = 0.f;
        if (sc >= 0) v = j.src[(size_t)k * j.lds + sc] * (j.gain ? j.gain[k] : 1.f);
        tl[(ty + 16 * i) * 33 + tx] = v;
    }
    __syncthreads();
#pragma unroll
    for (int i = 0; i < 2; ++i) {
        int n = n0 + ty + 16 * i;
        j.dst[(size_t)n * j.ldd + k0 + tx] = (bf16)tl[tx * 33 + ty + 16 * i];
    }
    __syncthreads();
}

__device__ __forceinline__ void phase0(const Params& P) {
    char* ws = opq(P.ws);
    const int G = gridDim.x, bid = blockIdx.x, tid = opaque_tid();
    {
        const int w = tid >> 6, l = tid & 63;
        float* tsc = (float*)(ws + OFF_TSC);
        for (int it = bid * NW + w; it < 4 * NEXP; it += G * NW) {
            int tb = it >> 14, e = it & (NEXP - 1);
            const float* src = (tb < 2 ? P.peer_u : P.peer_v) + ((size_t)(tb & 1) * NEXP + e) * DM + l * 16;
            unsigned char* dst = (unsigned char*)(ws + (tb < 2 ? OFF_UB : OFF_VB)) + (size_t)(tb & 1) * NEXP * 512;
            float4 a = ((const float4*)src)[0], b = ((const float4*)src)[1], c = ((const float4*)src)[2], d = ((const float4*)src)[3];
            if (tb < 2) {
                const float4* g4 = (const float4*)(P.norm_ffn_g + (tb & 1) * 1024 + l * 16);
                float4 g0 = g4[0], g1 = g4[1], g2 = g4[2], g3 = g4[3];
                a.x *= g0.x; a.y *= g0.y; a.z *= g0.z; a.w *= g0.w; b.x *= g1.x; b.y *= g1.y; b.z *= g1.z; b.w *= g1.w;
                c.x *= g2.x; c.y *= g2.y; c.z *= g2.z; c.w *= g2.w; d.x *= g3.x; d.y *= g3.y; d.z *= g3.z; d.w *= g3.w;
            }
            float am = fmaxf(fmaxf(fmaxf(fabsf(a.x), fabsf(a.y)), fmaxf(fabsf(a.z), fabsf(a.w))), fmaxf(fmaxf(fabsf(b.x), fabsf(b.y)), fmaxf(fabsf(b.z), fabsf(b.w))));
            am = fmaxf(am, fmaxf(fmaxf(fmaxf(fabsf(c.x), fabsf(c.y)), fmaxf(fabsf(c.z), fabsf(c.w))), fmaxf(fmaxf(fabsf(d.x), fabsf(d.y)), fmaxf(fabsf(d.z), fabsf(d.w)))));
#pragma unroll
            for (int o = 32; o > 0; o >>= 1) am = fmaxf(am, __shfl_xor(am, o));
            float sc = (am > 0.f) ? (6.0f / am) : 1.f, isc = (am > 0.f) ? (am * (1.f / 6.0f)) : 1.f;
            unsigned w0 = 0, w1 = 0;
            w0 = __builtin_amdgcn_cvt_scalef32_pk_fp4_f32(w0, a.x * sc, a.y * sc, 1.0f, 0);
            w0 = __builtin_amdgcn_cvt_scalef32_pk_fp4_f32(w0, a.z * sc, a.w * sc, 1.0f, 1);
            w0 = __builtin_amdgcn_cvt_scalef32_pk_fp4_f32(w0, b.x * sc, b.y * sc, 1.0f, 2);
            w0 = __builtin_amdgcn_cvt_scalef32_pk_fp4_f32(w0, b.z * sc, b.w * sc, 1.0f, 3);
            w1 = __builtin_amdgcn_cvt_scalef32_pk_fp4_f32(w1, c.x * sc, c.y * sc, 1.0f, 0);
            w1 = __builtin_amdgcn_cvt_scalef32_pk_fp4_f32(w1, c.z * sc, c.w * sc, 1.0f, 1);
            w1 = __builtin_amdgcn_cvt_scalef32_pk_fp4_f32(w1, d.x * sc, d.y * sc, 1.0f, 2);
            w1 = __builtin_amdgcn_cvt_scalef32_pk_fp4_f32(w1, d.z * sc, d.w * sc, 1.0f, 3);
            u32x2 o2 = {w0, w1};
            *(u32x2*)(dst + ((size_t)(l >> 4) * NEXP + e) * 128 + (l & 15) * 8) = o2;
            if (l == 0) tsc[tb * NEXP + e] = isc;
        }
    }
    {
        for (int L = 0; L < 2; ++L) {
            WJob jobs[7];
            jobs[0] = {P.w_in + (size_t)L * 1024 * IN_W, IN_W, 1024, 2048, (bf16*)(ws + OFF_WIN) + (size_t)L * 2048 * LDH, LDH, P.norm_mix_g + L * 1024, 1};
            jobs[1] = {P.w_o + (size_t)L * 1024 * 1024, 1024, 1024, 1024, (bf16*)(ws + OFF_WO) + (size_t)L * 1024 * LDH, LDH, P.mix_out_norm_g + L * 1024, 0};
            jobs[2] = {P.w_query + (size_t)L * 1024 * 1024, 1024, 1024, 1024, (bf16*)(ws + OFF_WQ) + (size_t)L * 1024 * LDH, LDH, P.norm_ffn_g + L * 1024, 0};
            jobs[3] = {P.w_ple_gate + (size_t)L * 1024 * 1024, 1024, 1024, 1024, (bf16*)(ws + OFF_WG) + (size_t)L * 1024 * LDH, LDH, P.ple_norm_g + L * 1024, 0};
            jobs[4] = {P.w_ple + (size_t)L * 256 * 1024, 1024, 256, 1024, (bf16*)(ws + OFF_WP) + (size_t)L * 1024 * LDP, LDP, nullptr, 0};
            jobs[5] = {P.w_uq + (size_t)L * 256 * 384, 384, 256, 384, (bf16*)(ws + OFF_WUQ) + (size_t)L * 384 * LDP, LDP, P.mla_q_norm_g + L * 256, 0};
            jobs[6] = {P.w_ukv + (size_t)L * 128 * 768, 768, 128, 768, (bf16*)(ws + OFF_WUKV) + (size_t)L * 768 * LDC, LDC, P.mla_kv_norm_g + L * 128, 2};
#pragma unroll
            for (int q = 0; q < 7; ++q) {
                int nt = (jobs[q].Np >> 5) * (jobs[q].K >> 5);
                for (int it = bid; it < nt; it += G) wconv_tile(jobs[q], it);
            }
        }
    }
    {
        const float* src = P.sub_keys;
        bf16* dst = (bf16*)(ws + OFF_SKB);
        for (int i = bid * NTHR + tid; i < 262144 / 2; i += G * NTHR) {
            float2 v = ((const float2*)src)[i];
            ((unsigned*)dst)[i] = pack2(v.x, v.y);
        }
    }
    {
        const float4* src = (const float4*)P.p;
        bf16* dst = (bf16*)(ws + OFF_PB);
        for (int i = bid * NTHR + tid; i < 2 * TOK * 256 / 8; i += G * NTHR) {
            float4 a = src[2 * i], b = src[2 * i + 1];
            u32x4 o = {pack2(a.x, a.y), pack2(a.z, a.w), pack2(b.x, b.y), pack2(b.z, b.w)};
            *(u32x4*)(dst + (size_t)(i >> 5) * LDP + (i & 31) * 8) = o;
        }
    }
    {
        bf16* hb = (bf16*)(ws + OFF_HB0);
        float* ss0 = (float*)(ws + OFF_SSA);
        int w = tid >> 6, l = tid & 63;
        for (int row = bid * NW + w; row < TOK; row += G * NW) {
            const float4* xr = (const float4*)(P.x + (size_t)row * DM);
            float ss = 0.f;
#pragma unroll
            for (int i = 0; i < 2; ++i) {
                float4 a = xr[i * 128 + l * 2], b = xr[i * 128 + l * 2 + 1];
                ss += a.x * a.x + a.y * a.y + a.z * a.z + a.w * a.w + b.x * b.x + b.y * b.y + b.z * b.z + b.w * b.w;
                uint4 o;
                o.x = pack2(a.x, a.y); o.y = pack2(a.z, a.w); o.z = pack2(b.x, b.y); o.w = pack2(b.z, b.w);
                ((uint4*)(hb + (size_t)row * LDH))[i * 64 + l] = o;
            }
            ss = wave_sum(ss);
            if (l == 0) {
                *(float4*)(ss0 + (size_t)row * 8) = make_float4(ss, 0.f, 0.f, 0.f);
                *(float4*)(ss0 + (size_t)row * 8 + 4) = make_float4(0.f, 0.f, 0.f, 0.f);
            }
        }
    }
    {
        float* cs = (float*)(ws + OFF_CS);
        for (int i = bid * NTHR + tid; i < TOK * 16; i += G * NTHR) {
            int t = i >> 4, k = i & 15;
            float inv = powf(10000.0f, -(float)k / 16.0f);
            float ang = (float)P.pos[t] * inv;
            cs[2 * i] = cosf(ang);
            cs[2 * i + 1] = sinf(ang);
        }
    }
}

struct NoHook { static constexpr bool nodma = false; __device__ __forceinline__ void operator()(int, f32x16 (&)[2][2]) const {} };
struct NoDmaHook { static constexpr bool nodma = true; __device__ __forceinline__ void operator()(int, f32x16 (&)[2][2]) const {} };
template <typename HOOK>
__device__ __forceinline__ void gemm_core(f32x16 (&acc)[2][2], const bf16* A, int lda, const bf16* Bt, int ldb, int K,
                                          int m0, int n0, HOOK hook) {
    const int tid = opaque_tid(), w = tid >> 6, l = tid & 63, r = l & 31, hh = l >> 5;
    const int wm = w >> 1, wn = w & 1;
    const int dp = (tid & 15) ^ ((tid >> 4) & 15);
    const int drow = 2 * (tid >> 4) + (dp >> 3), dgc = (dp & 7) * 8;
    const bf16* asrc = A + (size_t)(m0 + drow) * lda + dgc;
    const bf16* bsrc = Bt + (size_t)(n0 + drow) * ldb + dgc;
    auto dma = [&](int buf, int k0) {
        if (HOOK::nodma) return;
        char* base = smem + buf * STAGE_BYTES + tid * 16;
#pragma unroll
        for (int i = 0; i < 4; ++i)
            __builtin_amdgcn_global_load_lds((const unsigned*)(asrc + (size_t)(64 * i) * lda + k0), (unsigned*)(base + i * 8192), 16, 0, 0);
#pragma unroll
        for (int i = 0; i < 2; ++i)
            __builtin_amdgcn_global_load_lds((const unsigned*)(bsrc + (size_t)(64 * i) * ldb + k0), (unsigned*)(base + 32768 + i * 8192), 16, 0, 0);
    };
    int offA[2], offB[2];
#pragma unroll
    for (int i = 0; i < 2; ++i) { offA[i] = ((wm * 64 + i * 32 + r) >> 1) * 256; offB[i] = 32768 + ((wn * 64 + i * 32 + r) >> 1) * 256; }
    const int pbase = ((r & 1) << 3), lx = (r >> 1) & 15;
    const int nk = K >> 6;
    const unsigned ldsbase = (unsigned)(size_t)(__attribute__((address_space(3))) char*)smem;
    auto ldfrag = [&](int stage, int s, bf16x8 (&af)[2], bf16x8 (&bfr)[2]) {
        unsigned ch = (unsigned)((((pbase | (2 * s + hh)) ^ lx) << 4)) + ldsbase + (unsigned)(stage * STAGE_BYTES);
        unsigned a0a = ch + offA[0], a1a = ch + offA[1], b0a = ch + offB[0], b1a = ch + offB[1];
        asm volatile("ds_read_b128 %0, %4\n\tds_read_b128 %1, %5\n\tds_read_b128 %2, %6\n\tds_read_b128 %3, %7"
                     : "=&v"(af[0]), "=&v"(af[1]), "=&v"(bfr[0]), "=&v"(bfr[1]) : "v"(a0a), "v"(a1a), "v"(b0a), "v"(b1a) : "memory");
    };
    auto mma = [&](bf16x8 (&af)[2], bf16x8 (&bfr)[2]) {
#pragma unroll
        for (int i = 0; i < 2; ++i)
#pragma unroll
            for (int j = 0; j < 2; ++j) acc[i][j] = __builtin_amdgcn_mfma_f32_32x32x16_bf16(af[i], bfr[j], acc[i][j], 0, 0, 0);
    };
#define LGKM_WAIT(n) do { asm volatile("s_waitcnt lgkmcnt(" #n ")" ::: "memory"); __builtin_amdgcn_sched_barrier(0); } while (0)
    asm volatile("s_waitcnt vmcnt(0)" ::: "memory");
    dma(0, 0);
    dma(1, 64);
    if (nk > 2) { dma(2, 128); asm volatile("s_waitcnt vmcnt(12)" ::: "memory"); }
    else asm volatile("s_waitcnt vmcnt(6)" ::: "memory");
    __builtin_amdgcn_s_barrier();
    bf16x8 a0[2], b0[2], a1[2], b1[2];
    ldfrag(0, 0, a0, b0);
    int cur = 0;
    for (int kt = 0; kt < nk; ++kt) {
        const int nxt = (cur == 2) ? 0 : cur + 1;
        if (kt == 4 || kt == 8) { LGKM_WAIT(0); hook(kt, acc); }
        ldfrag(cur, 1, a1, b1);
        LGKM_WAIT(4);
        mma(a0, b0);
        ldfrag(cur, 2, a0, b0);
        LGKM_WAIT(4);
        mma(a1, b1);
        ldfrag(cur, 3, a1, b1);
        LGKM_WAIT(4);
        mma(a0, b0);
        if (kt + 1 < nk) {
            if (kt + 2 < nk) asm volatile("s_waitcnt vmcnt(6) lgkmcnt(0)" ::: "memory");
            else asm volatile("s_waitcnt vmcnt(0) lgkmcnt(0)" ::: "memory");
            __builtin_amdgcn_s_barrier();
            __builtin_amdgcn_sched_barrier(0);
            if (kt + 3 < nk) dma(cur, (kt + 3) << 6);
            ldfrag(nxt, 0, a0, b0);
        } else {
            LGKM_WAIT(0);
        }
        mma(a1, b1);
        cur = nxt;
    }
    __syncthreads();
}
__device__ __forceinline__ float row_rs8(const float* part, int row) {
    float4 a = *(const float4*)(part + (size_t)row * 8), b = *(const float4*)(part + (size_t)row * 8 + 4);
    float ss = ((a.x + a.y) + (a.z + a.w)) + ((b.x + b.y) + (b.z + b.w));
    return rsqrtf(ss * (1.f / 1024.f) + EPSF);
}
__device__ __forceinline__ bool xcd_tile(int it, int MT, int NT, int& mt, int& nt) {
    const int G = gridDim.x, bid = blockIdx.x;
    if ((G & 7) == 0 && (MT & 7) == 0) {
        const int nbx = G >> 3, q = (bid >> 3) + it * nbx, per = (MT >> 3) * NT;
        if (q >= per) return false;
        mt = (bid & 7) * (MT >> 3) + q / NT; nt = q % NT;
        return true;
    }
    const int q = bid + it * G;
    if (q >= MT * NT) return false;
    mt = q / NT; nt = q % NT;
    return true;
}
struct NoScale { __device__ __forceinline__ float operator()(int, int) const { return 1.f; } };

#define ZERO_ACC(acc)                                  \
    _Pragma("unroll") for (int _i = 0; _i < 2; ++_i)   \
    _Pragma("unroll") for (int _j = 0; _j < 2; ++_j)   \
    _Pragma("unroll") for (int _r = 0; _r < 16; ++_r) acc[_i][_j][_r] = 0.f;


namespace pg8 {
#define PG8_LAS __attribute__((address_space(3)))
typedef unsigned short bf16_t;
constexpr int BM = 256, BK = 64, HALF = 128, HTB = HALF * BK * 2  , NXCD = 8, WGM = 8;

__host__ __device__ __forceinline__ int lds_byte(int r, int c) { const int st = (r >> 4) * 2 + (c >> 5), rr = r & 15, cc = c & 31, ob = rr * 64 + cc * 2; return st * 1024 + (ob ^ (((ob >> 9) & 1) << 5)); }
__host__ __device__ __forceinline__ void stage_rc(int b, int& R, int& C) { const int st = b / 1024, sb = b % 1024, swz = sb ^ (((sb >> 9) & 1) << 5); R = (st >> 1) * 16 + swz / 64; C = (st & 1) * 32 + (swz % 64) / 2; }
__host__ __device__ __forceinline__ int perm32(int rho) { const int n = rho >> 4, i = rho & 15; return 8 * (i >> 2) + 4 * n + (i & 3); }
struct Unit { int pm, pn; };
struct Gemm { const bf16* A; const bf16* Bt; int lda, ldb, M, N, K; };
struct StaticOrder {
    int nM, nN, nwg, G, c;
    __device__ void init(int M, int N, int G_, int c_) { nM = M / BM; nN = N / BM; nwg = nM * nN; G = G_; c = c_; }
    __device__ bool next(int i, Unit& u) const {
        const long L = (long)i * G + c; if (L >= nwg) return false;
        int wgid = (int)L; { const int q = nwg / NXCD, r = nwg % NXCD, xcd = wgid % NXCD, off = wgid / NXCD; wgid = (xcd < r ? xcd * (q + 1) : r * (q + 1) + (xcd - r) * q) + off; }
        const int nig = WGM * nN, gid = wgid / nig, fm = gid * WGM, gsz = (nM - fm) < WGM ? (nM - fm) : WGM;
        u.pm = fm + ((wgid % nig) % gsz); u.pn = (wgid % nig) / gsz; return true;
    }
    __device__ __forceinline__ void a_ready(const Unit&) const {}
    __device__ __forceinline__ void done(const Unit&) const {}
};
template <class Epi, class Sched, bool STAMP = false>
__device__ __forceinline__ void gemm_phase(PG8_LAS unsigned char* lds, const Gemm g, const Sched& S, const Epi& E, unsigned long long* stamps) {
    const int tid = opaque_tid(), wid = __builtin_amdgcn_readfirstlane(tid >> 6), lane = tid & 63, wr = wid >> 2, wc = wid & 3, fr = lane & 15, fq = lane >> 4;
    const int K = g.K, nt = K / BK;
    int ts_lo = 0, ts_hi = 0, nts = 0; const unsigned long long rt_entry = STAMP ? (unsigned long long)wall_clock64() : 0ull;
#define PG8_STAMP() do { if (STAMP && wid == 0 && nts < 64) { const unsigned long long _c = (unsigned long long)clock64(); \
        ts_lo = (lane == nts) ? (int)(unsigned)_c : ts_lo; ts_hi = (lane == nts) ? (int)(unsigned)(_c >> 32) : ts_hi; ++nts; } } while (0)
    PG8_STAMP();
    unsigned voffA[2], voffB[2];
#pragma unroll
    for (int i = 0; i < 2; ++i) { int R, C; stage_rc(tid * 16 + i * 8192, R, C); const int Rb = Epi::PERM ? ((R & ~31) + perm32(R & 31)) : R;
        voffA[i] = (unsigned)(R * g.lda + C) * 2u; voffB[i] = (unsigned)(Rb * g.ldb + C) * 2u; }
    const size_t kstep = (size_t)(BK * 2);
    const size_t hstepA = (size_t)HALF * g.lda * 2, hstepB = (size_t)HALF * g.ldb * 2;
    const size_t tstepA = 2 * hstepA, tstepB = 2 * hstepB;
    const unsigned ldsw = (unsigned)wid * 1024u;
    const int aoff = lds_byte(wr * 64 + fr, fq * 8), boff = lds_byte(wc * 32 + fr, fq * 8);
#define PG8_SA(b, h) (((b) * 2 + (h)) * HTB)
#define PG8_SB(b, h) ((4 + (b) * 2 + (h)) * HTB)
#define PG8_STAGE(bufoff, gbase, voff) do { _Pragma("unroll") for (int _i = 0; _i < 2; ++_i) \
        __builtin_amdgcn_global_load_lds((const unsigned*)((const char*)(gbase) + (voff)[_i]), (PG8_LAS unsigned*)(lds + (bufoff) + ldsw + _i * 8192), 16, 0, 0); } while (0)
#define PG8_LDA(dst, b, h) do { _Pragma("unroll") for (int m = 0; m < 4; ++m) _Pragma("unroll") for (int k = 0; k < 2; ++k) dst[m][k] = *(const PG8_LAS bf16x8*)(lds + PG8_SA(b, h) + aoff + m * 2048 + k * 1024); } while (0)
#define PG8_LDB(dst, b, h) do { _Pragma("unroll") for (int n = 0; n < 2; ++n) _Pragma("unroll") for (int k = 0; k < 2; ++k) dst[n][k] = *(const PG8_LAS bf16x8*)(lds + PG8_SB(b, h) + boff + n * 2048 + k * 1024); } while (0)
#define PG8_MMA(ai, bj, At, Bt) do { __builtin_amdgcn_s_setprio(1); _Pragma("unroll") for (int m = 0; m < 4; ++m) _Pragma("unroll") for (int n = 0; n < 2; ++n) _Pragma("unroll") for (int k = 0; k < 2; ++k) \
        acc[ai][bj][m][n] = __builtin_amdgcn_mfma_f32_16x16x32_bf16(Bt[n][k], At[m][k], acc[ai][bj][m][n], 0, 0, 0); __builtin_amdgcn_s_setprio(0); } while (0)
#define PG8_WAIT_V(n) asm volatile("s_waitcnt vmcnt(" #n ")" ::: "memory")
#define PG8_WAIT_L(n) asm volatile("s_waitcnt lgkmcnt(" #n ")" ::: "memory")
#define PG8_BAR __builtin_amdgcn_s_barrier()
#define PG8_SCHED __builtin_amdgcn_sched_barrier(0)
    Unit cur, nxt; int ui = 0;
    if (!S.next(0, cur)) return;
    f32x4 acc[2][2][4][2];
#pragma unroll
    for (int a = 0; a < 2; ++a)
#pragma unroll
        for (int b = 0; b < 2; ++b)
#pragma unroll
            for (int m = 0; m < 4; ++m)
#pragma unroll
                for (int n = 0; n < 2; ++n) acc[a][b][m][n] = (f32x4){0.f, 0.f, 0.f, 0.f};
    bf16x8 At[4][2], B0[2][2], B1[2][2];
    const char* cA = (const char*)g.A + (size_t)cur.pm * tstepA; const char* cB = (const char*)g.Bt + (size_t)cur.pn * tstepB;
    S.a_ready(cur);
    PG8_STAGE(PG8_SB(0, 0), cB, voffB); PG8_STAGE(PG8_SA(0, 0), cA, voffA); PG8_STAGE(PG8_SB(0, 1), cB + hstepB, voffB); PG8_STAGE(PG8_SA(0, 1), cA + hstepA, voffA);
    if (wr == 1) PG8_BAR;
    PG8_WAIT_V(4); PG8_BAR;
    PG8_STAGE(PG8_SB(1, 0), cB + kstep, voffB); PG8_STAGE(PG8_SA(1, 0), cA + kstep, voffA); PG8_STAGE(PG8_SB(1, 1), cB + hstepB + kstep, voffB);
    PG8_WAIT_V(6); PG8_BAR;
    PG8_STAMP();
    for (;;) {
        const bool has_next = S.next(ui + 1, nxt);
        const char* nA = has_next ? (const char*)g.A + (size_t)nxt.pm * tstepA : cA; const char* nB = has_next ? (const char*)g.Bt + (size_t)nxt.pn * tstepB : cB;
        for (int t = 0; t < nt; t += 2) {
            const bool last = (t == nt - 2);
            const char* a1 = cA + (size_t)(t + 1) * kstep;
            const char* a2 = last ? nA : cA + (size_t)(t + 2) * kstep; const char* b2 = last ? nB : cB + (size_t)(t + 2) * kstep;
            const char* a3 = a2 + kstep; const char* b3 = b2 + kstep;
            if (last && has_next) S.a_ready(nxt);
            E.khook(t, acc, wr, fr);
            PG8_LDB(B0, 0, 0); PG8_SCHED; PG8_LDA(At, 0, 0); PG8_STAGE(PG8_SA(1, 1), a1 + hstepA, voffA);
            PG8_WAIT_L(8); PG8_BAR; PG8_WAIT_L(0); PG8_MMA(0, 0, At, B0); PG8_BAR; PG8_SCHED;
            PG8_LDB(B1, 0, 1); PG8_STAGE(PG8_SB(0, 0), b2, voffB);
            PG8_BAR; PG8_WAIT_L(0); PG8_MMA(0, 1, At, B1); PG8_BAR;
            PG8_LDA(At, 0, 1); PG8_STAGE(PG8_SA(0, 0), a2, voffA);
            PG8_BAR; PG8_WAIT_L(0); PG8_MMA(1, 0, At, B0); PG8_BAR; PG8_SCHED;
            PG8_STAGE(PG8_SB(0, 1), b2 + hstepB, voffB);
            PG8_WAIT_V(6); PG8_BAR; PG8_MMA(1, 1, At, B1); PG8_BAR;
            PG8_LDB(B0, 1, 0); PG8_SCHED; PG8_LDA(At, 1, 0); PG8_STAGE(PG8_SA(0, 1), a2 + hstepA, voffA);
            PG8_WAIT_L(8); PG8_BAR; PG8_WAIT_L(0); PG8_MMA(0, 0, At, B0); PG8_BAR; PG8_SCHED;
            PG8_LDB(B1, 1, 1); PG8_STAGE(PG8_SB(1, 0), b3, voffB);
            PG8_BAR; PG8_WAIT_L(0); PG8_MMA(0, 1, At, B1); PG8_BAR;
            PG8_LDA(At, 1, 1); PG8_STAGE(PG8_SA(1, 0), a3, voffA);
            PG8_BAR; PG8_WAIT_L(0); PG8_MMA(1, 0, At, B0); PG8_BAR; PG8_SCHED;
            PG8_STAGE(PG8_SB(1, 1), b3 + hstepB, voffB);
            PG8_WAIT_V(6); PG8_BAR; PG8_MMA(1, 1, At, B1); PG8_BAR;
        }
        PG8_STAMP();
        if constexpr (!Epi::AFTER_DRAIN) { E(acc, cur, wr, wc, fr, fq); S.done(cur); }
        PG8_STAMP();
        if (!has_next) break;
#pragma unroll
        for (int a = 0; a < 2; ++a)
#pragma unroll
            for (int b = 0; b < 2; ++b)
#pragma unroll
                for (int m = 0; m < 4; ++m)
#pragma unroll
                    for (int n = 0; n < 2; ++n) acc[a][b][m][n] = (f32x4){0.f, 0.f, 0.f, 0.f};
        cur = nxt; cA = nA; cB = nB; ++ui;
    }
    PG8_WAIT_V(0);
    if (wr == 0) PG8_BAR;
    PG8_BAR;
    if constexpr (Epi::AFTER_DRAIN) { E.fused(acc, cur, wr, wc, fr, fq, lds, wid, lane); S.done(cur); }
    PG8_STAMP();
    if (STAMP && wid == 0) { stamps[lane] = lane < nts ? (((unsigned long long)(unsigned)ts_hi << 32) | (unsigned)ts_lo) : 0ull;
        if (lane == 62) stamps[62] = rt_entry; if (lane == 63) stamps[63] = (unsigned long long)wall_clock64(); }
#undef PG8_STAMP
#undef PG8_SA
#undef PG8_SB
#undef PG8_STAGE
#undef PG8_LDA
#undef PG8_LDB
#undef PG8_MMA
#undef PG8_WAIT_V
#undef PG8_WAIT_L
#undef PG8_BAR
#undef PG8_SCHED
}
}

#define TB_LD 136
#define TF_LD 132
template <bool SCALE>
__device__ __forceinline__ void stage_bf16(const f32x16 (&acc)[2][2], const float* rsl) {
    bf16* T = (bf16*)smem;
    const int tid = opaque_tid(), w = tid >> 6, l = tid & 63, hh = l >> 5, wm = w >> 1, wn = w & 1;
#pragma unroll
    for (int i = 0; i < 2; ++i)
#pragma unroll
        for (int rr = 0; rr < 16; ++rr) {
            int row = wm * 64 + i * 32 + (rr & 3) + 8 * (rr >> 2) + 4 * hh;
            float sc = SCALE ? rsl[row] : 1.f;
#pragma unroll
            for (int j = 0; j < 2; ++j) T[row * TB_LD + wn * 64 + j * 32 + (l & 31)] = (bf16)(acc[i][j][rr] * sc);
        }
    __syncthreads();
}
template <bool SCALE>
__device__ __forceinline__ void stage_f32(const f32x16 (&acc)[2][2], const float* rsl) {
    float* T = (float*)smem;
    const int tid = opaque_tid(), w = tid >> 6, l = tid & 63, hh = l >> 5, wm = w >> 1, wn = w & 1;
#pragma unroll
    for (int i = 0; i < 2; ++i)
#pragma unroll
        for (int rr = 0; rr < 16; ++rr) {
            int row = wm * 64 + i * 32 + (rr & 3) + 8 * (rr >> 2) + 4 * hh;
            float sc = SCALE ? rsl[row] : 1.f;
#pragma unroll
            for (int j = 0; j < 2; ++j) T[row * TF_LD + wn * 64 + j * 32 + (l & 31)] = acc[i][j][rr] * sc;
        }
    __syncthreads();
}
template <typename CMAP>
__device__ __forceinline__ void store_rows_bf16(bf16* dst, int ld, int m0, CMAP cmap) {
    const bf16* T = (const bf16*)smem;
    const int tid = opaque_tid();
#pragma unroll
    for (int q = 0; q < 8; ++q) {
        int id = tid + 512 * q, row = id >> 4, ch = id & 15;
        u32x4 v = *(const u32x4*)(T + row * TB_LD + ch * 8);
        *(u32x4*)(dst + (size_t)(m0 + row) * ld + cmap(ch * 8)) = v;
    }
}
__device__ __forceinline__ void store_cols_bf16(bf16* vt, size_t crow0, int s0) {
    const unsigned short* T = (const unsigned short*)smem;
    const int tid = opaque_tid();
#pragma unroll
    for (int q = 0; q < 8; ++q) {
        int id = tid + 512 * q, c = id & 127, sg = id >> 7;
        unsigned e[8];
#pragma unroll
        for (int k = 0; k < 8; ++k) e[k] = T[(8 * sg + k) * TB_LD + c];
        u32x4 v = {e[0] | (e[1] << 16), e[2] | (e[3] << 16), e[4] | (e[5] << 16), e[6] | (e[7] << 16)};
        *(u32x4*)(vt + (crow0 + c) * SEQ + s0 + 8 * sg) = v;
    }
}
__device__ __forceinline__ void residual_store(const float* hin, float* hout, bf16* hb_out, float* gss, int m0, int n0, int nt) {
    const float* T = (const float*)smem;
    const int tid = opaque_tid(), l = tid & 63;
#pragma unroll 4
    for (int q = 0; q < 16; ++q) {
        int id = tid + 512 * q, row = id >> 5, ch = id & 31;
        f32x4 d = *(const f32x4*)(T + row * TF_LD + ch * 4);
        size_t gi = (size_t)(m0 + row) * 1024 + n0 + ch * 4;
        f32x4 h = *(const f32x4*)(hin + gi);
        f32x4 v = h + d;
        *(f32x4*)(hout + gi) = v;
        u32x2 b = {pack2(v.x, v.y), pack2(v.z, v.w)};
        *(u32x2*)(hb_out + (size_t)(m0 + row) * LDH + n0 + ch * 4) = b;
        float ss = v.x * v.x + v.y * v.y + v.z * v.z + v.w * v.w;
        ss = dpp_add<0xB1>(ss); ss = dpp_add<0x4E>(ss); ss = dpp_add<0x141>(ss); ss = dpp_add<0x140>(ss);
        ss += __shfl_xor(ss, 16);
        if ((l & 31) == 0) gss[(size_t)(m0 + row) * 8 + nt] = ss;
    }
}
struct ColAdd { int off; __device__ __forceinline__ int operator()(int c) const { return c + off; } };
struct ColHead96 { __device__ __forceinline__ int operator()(int c) const { return (c >> 6) * 96 + (c & 63); } };

struct EpiProj {
    static constexpr bool PERM = true, AFTER_DRAIN = false;
    const float* ssrow; char* ws;
    __device__ __forceinline__ void khook(int, f32x4 (&)[2][2][4][2], int, int) const {}
    __device__ __forceinline__ void operator()(const f32x4 (&acc)[2][2][4][2], const pg8::Unit& u, int wr, int wc, int fr, int fqd) const {
        const int row0 = u.pm * 256 + wr * 64 + fr, lc0 = wc * 32 + 8 * fqd, pn = u.pn;
        size_t doff; int ld = 256;
        if (pn == 0) doff = OFF_FQ; else if (pn == 1) doff = OFF_FK; else if (pn == 2) doff = OFF_PART;
        else if (pn == 3) doff = OFF_SQ; else if (pn == 4) doff = OFF_SKK; else if (pn == 5) doff = OFF_PART + 8 * MBy;
        else if (pn == 6) { doff = OFF_CQ; ld = LDP; } else { doff = OFF_CKV; ld = LDC; }
        bf16* dst = (bf16*)(ws + doff);
        bf16* mk = (bf16*)(ws + OFF_MK); float* flog = (float*)(ws + OFF_FLOG); const float* cs = (const float*)(ws + OFF_CS);
#pragma unroll
        for (int ai = 0; ai < 2; ++ai)
#pragma unroll
            for (int m = 0; m < 4; ++m) {
                const int row = row0 + ai * 128 + m * 16;
                const float rs = row_rs8(ssrow, row);
#pragma unroll
                for (int bj = 0; bj < 2; ++bj) {
                    f32x4 v0 = acc[ai][bj][m][0] * rs, v1 = acc[ai][bj][m][1] * rs;
                    if (pn < 7 || bj == 0) {
                        u32x4 wv = {pack2(v0[0], v0[1]), pack2(v0[2], v0[3]), pack2(v1[0], v1[1]), pack2(v1[2], v1[3])};
                        *(u32x4*)(dst + (size_t)row * ld + bj * 128 + lc0) = wv;
                    } else if (wc == 0) {
                        const int hh = fqd >> 1, pi = 8 * (fqd & 1);
                        float vv[8] = {v0[0], v0[1], v0[2], v0[3], v1[0], v1[1], v1[2], v1[3]}, ov[8];
                        const f32x4* c4 = (const f32x4*)(cs + ((size_t)row * 16 + pi) * 2);
                        f32x4 t0 = c4[0], t1 = c4[1], t2 = c4[2], t3 = c4[3];
                        float cc[8] = {t0.x, t0.z, t1.x, t1.z, t2.x, t2.z, t3.x, t3.z}, sn[8] = {t0.y, t0.w, t1.y, t1.w, t2.y, t2.w, t3.y, t3.w};
#pragma unroll
                        for (int e = 0; e < 8; ++e) {
                            float pv = __builtin_bit_cast(float, partner32(__builtin_bit_cast(int, vv[e]), hh));
                            ov[e] = hh ? (pv * sn[e] + vv[e] * cc[e]) : (vv[e] * cc[e] - pv * sn[e]);
                        }
                        u32x4 wv = {pack2(ov[0], ov[1]), pack2(ov[2], ov[3]), pack2(ov[4], ov[5]), pack2(ov[6], ov[7])};
#pragma unroll
                        for (int h = 0; h < 4; ++h) *(u32x4*)(mk + (size_t)row * 384 + h * 96 + 64 + 8 * fqd) = wv;
                    } else if (wc == 1 && fqd == 0) {
                        *(f32x4*)(flog + (size_t)row * 4) = v0;
                    }
                }
            }
    }
};
__device__ __forceinline__ void phase_proj(const Params& P, int L, int hsel, int ss_slot) {
    char* ws = opq(P.ws);
    const float* ssrow = (const float*)(ws + OFF_SSA) + (size_t)ss_slot * TOK * 8;
    const bf16* hb = (const bf16*)(ws + (hsel ? OFF_HB1 : OFF_HB0));
    const bf16* Bt = (const bf16*)(ws + OFF_WIN) + (size_t)L * 2048 * LDH;
    pg8::Gemm g{hb, Bt, LDH, LDH, TOK, 2048, 1024};
    pg8::StaticOrder S; S.init(TOK, 2048, gridDim.x, blockIdx.x);
    EpiProj E{ssrow, ws};
    pg8::gemm_phase((PG8_LAS unsigned char*)smem, g, S, E, nullptr);
    __syncthreads();
}

template <int KW>
__device__ __forceinline__ void row_rms_to_lds(const bf16* A, int lda, int m0) {
    const int tid = opaque_tid(), row = tid >> 1, half = tid & 1;
    float ss = 0.f;
    const u32x4* p = (const u32x4*)(A + (size_t)(m0 + row) * lda + half * (KW / 2));
#pragma unroll
    for (int q = 0; q < KW / 16; ++q) {
        u32x4 v = p[q];
        float a;
        a = bflo(v.x); ss += a * a; a = bfhi(v.x); ss += a * a;
        a = bflo(v.y); ss += a * a; a = bfhi(v.y); ss += a * a;
        a = bflo(v.z); ss += a * a; a = bfhi(v.z); ss += a * a;
        a = bflo(v.w); ss += a * a; a = bfhi(v.w); ss += a * a;
    }
    ss += __shfl_xor(ss, 1);
    if (half == 0) ((float*)(smem + LDS_AUX))[row] = rsqrtf(ss * (1.f / (float)KW) + EPSF);
}

__device__ __forceinline__ void phase_mla_up(const Params& P, int L) {
    char* ws = opq(P.ws);
    const bf16* cq = (const bf16*)(ws + OFF_CQ); const bf16* ckv = (const bf16*)(ws + OFF_CKV);
    const bf16* wuq = (const bf16*)(ws + OFF_WUQ) + (size_t)L * 384 * LDP;
    const bf16* wukv = (const bf16*)(ws + OFF_WUKV) + (size_t)L * 768 * LDC;
    bf16* mq = (bf16*)(ws + OFF_MQ); bf16* mk = (bf16*)(ws + OFF_MK); bf16* mvt = (bf16*)(ws + OFF_MVT);
    const float* cs = (const float*)(ws + OFF_CS);
    const float* flog = (const float*)(ws + OFF_FLOG);
    float* cumF = (float*)(ws + OFF_CUMF);
    const int tid = opaque_tid(), w = tid >> 6, l = tid & 63, hh = l >> 5, wm = w >> 1, wn = w & 1;
    const int NQ = 64 * 3, NKV = 64 * 6, NCF = 4;
    const float* aux = (const float*)(smem + LDS_AUX);
    for (int gw = blockIdx.x * NW + w; gw < 2048; gw += gridDim.x * NW) {
        const int type = gw >> 10, bh = (gw >> 5) & 31, tb = gw & 31, b = bh >> 2, h = bh & 3;
        const bf16* src = (const bf16*)(ws + OFF_PART + (type ? 8 * MBy : 0)) + ((size_t)(b * SEQ + tb * 64 + l) * 256 + h * 64);
        unsigned short* dst = (unsigned short*)(ws + (type ? OFF_SVT : OFF_FVT)) + (size_t)bh * 64 * SEQ + tb * 64 + l;
        u32x4 rv8[8];
#pragma unroll
        for (int q = 0; q < 8; ++q) rv8[q] = ((const u32x4*)src)[q];
#pragma unroll
        for (int q = 0; q < 8; ++q) {
            dst[(size_t)(8 * q + 0) * SEQ] = (unsigned short)(rv8[q].x & 0xffffu); dst[(size_t)(8 * q + 1) * SEQ] = (unsigned short)(rv8[q].x >> 16);
            dst[(size_t)(8 * q + 2) * SEQ] = (unsigned short)(rv8[q].y & 0xffffu); dst[(size_t)(8 * q + 3) * SEQ] = (unsigned short)(rv8[q].y >> 16);
            dst[(size_t)(8 * q + 4) * SEQ] = (unsigned short)(rv8[q].z & 0xffffu); dst[(size_t)(8 * q + 5) * SEQ] = (unsigned short)(rv8[q].z >> 16);
            dst[(size_t)(8 * q + 6) * SEQ] = (unsigned short)(rv8[q].w & 0xffffu); dst[(size_t)(8 * q + 7) * SEQ] = (unsigned short)(rv8[q].w >> 16);
        }
    }
    for (int item = blockIdx.x; item < NQ + NKV + NCF; item += gridDim.x) {
        if (item < NQ) {
            int mt = item / 3, nt = item % 3;
            int m0 = mt * 256, n0 = nt * 128;
            __syncthreads();
            row_rms_to_lds<256>(cq, LDP, m0);
            f32x16 acc[2][2];
            ZERO_ACC(acc);
            gemm_core(acc, cq, LDP, wuq, LDP, 256, m0, n0, NoHook());
#pragma unroll
            for (int i = 0; i < 2; ++i)
#pragma unroll
                for (int j = 0; j < 2; ++j) {
                    int c0 = n0 + wn * 64 + j * 32;
                    int rloc = wm * 64 + i * 32 + 4 * hh;
                    bool rot = (c0 % 96) == 64;
                    int ci = l & 31, pi = ci & 15;
#pragma unroll
                    for (int rr = 0; rr < 16; ++rr) {
                        int rl = rloc + (rr & 3) + 8 * (rr >> 2);
                        float v = acc[i][j][rr] * aux[rl];
                        if (rot) {
                            float pv = __shfl_xor(v, 16);
                            float2 c_s = *(const float2*)(cs + ((size_t)(m0 + rl) * 16 + pi) * 2);
                            v = (ci < 16) ? (v * c_s.x - pv * c_s.y) : (pv * c_s.y + v * c_s.x);
                        }
                        acc[i][j][rr] = v;
                    }
                }
            stage_bf16<false>(acc, nullptr);
            store_rows_bf16(mq, 384, m0, ColAdd{n0});
        } else if (item < NQ + NKV) {
            int it2 = item - NQ;
            int mt = it2 / 6, nt = it2 % 6;
            int m0 = mt * 256, n0 = nt * 128;
            __syncthreads();
            row_rms_to_lds<128>(ckv, LDC, m0);
            f32x16 acc[2][2];
            ZERO_ACC(acc);
            gemm_core(acc, ckv, LDC, wukv, LDC, 128, m0, n0, NoHook());
            stage_bf16<true>(acc, aux);
            if (nt < 2) {
                const int nb0 = n0;
                struct CM { int n0; __device__ __forceinline__ int operator()(int c) const { int col = n0 + c; return (col >> 6) * 96 + (col & 63); } };
                store_rows_bf16(mk, 384, m0, CM{nb0});
            } else {
                store_cols_bf16(mvt, (size_t)(m0 >> 11) * 512 + (n0 - 256), m0 & 2047);
            }
        } else {
            int seq = (item - NQ - NKV) * NW + w;
            int b = seq >> 2, h = seq & 3;
            float bfv = P.b_forget[L * 4 + h];
            float vals[32];
            float run = 0.f;
#pragma unroll
            for (int i = 0; i < 32; ++i) {
                int s = l * 32 + i;
                float z = flog[((size_t)b * SEQ + s) * 4 + h] + bfv;
                run += log_sigmoid_f(z);
                vals[i] = run;
            }
            float tot = run, incl = tot;
#pragma unroll
            for (int o = 1; o < 64; o <<= 1) {
                float t = __shfl_up(incl, o);
                if (l >= o) incl += t;
            }
            float excl = incl - tot;
#pragma unroll
            for (int i = 0; i < 32; ++i) cumF[(size_t)seq * SEQ + l * 32 + i] = vals[i] + excl;
        }
    }
}

template <int MODE, int DK, int DV>
__device__ __forceinline__ void attn_item(const bf16* __restrict__ Q, int ldq, const bf16* __restrict__ Kg, int ldk,
                          const bf16* __restrict__ Vt, const float* __restrict__ cumF, bf16* __restrict__ Y,
                          float* __restrict__ ssy, int b, int h, int qb, float c1, char* lds, int fake = 0) {
    constexpr int KSTR = DK * 2 + 16;
    constexpr int VSTR = 144;
    constexpr int KBYTES = 64 * KSTR, VBYTES = DV * VSTR;
    constexpr int BUF = (KBYTES + VBYTES + 256 + 255) & ~255;
    static_assert(2 * BUF <= 65536, "lds");
    constexpr int KCH = DK / 8, KPT = (64 * KCH) / 256, VPT = (DV * 8) / 256;
    const int tid = opaque_tid() & 255, w = tid >> 6, l = tid & 63, r = l & 31, hh = l >> 5;
    const int q0 = qb * 128;
    const int qrow = q0 + 32 * w + r;
    const size_t tok = (size_t)b * SEQ + qrow;
    const int bh = b * 4 + h;
    bf16x8 qf[DK / 16];
#pragma unroll
    for (int s = 0; s < DK / 16; ++s) qf[s] = *(const bf16x8*)(Q + tok * ldq + h * DK + 16 * s + 8 * hh);
    f32x16 o[DV / 32];
    const f32x16 zero16 = {0.f, 0.f, 0.f, 0.f, 0.f, 0.f, 0.f, 0.f, 0.f, 0.f, 0.f, 0.f, 0.f, 0.f, 0.f, 0.f};
#pragma unroll
    for (int d = 0; d < DV / 32; ++d) o[d] = zero16;
    float m = -1e30f, lsum = 0.f, R = 0.f;
    bool sbdead = false;
    int* dmask = (int*)(smem + LDS_BYTES - 32);
    float Fq = 0.f;
    if (MODE == 0) Fq = cumF[(size_t)bh * SEQ + qrow] * LOG2E;
    const int nkt = (q0 + 128) >> 6;
    u32x4 kregA[KPT], vregA[VPT], kregB[KPT], vregB[VPT];
    float4 fregA = {0.f, 0.f, 0.f, 0.f}, fregB = {0.f, 0.f, 0.f, 0.f};
    auto gload = [&](int kt, u32x4 (&kreg)[KPT], u32x4 (&vreg)[VPT], float4& freg) {
#pragma unroll
        for (int i = 0; i < KPT; ++i) {
            int e = tid + 256 * i;
            int row = e / KCH, ch = e % KCH;
            kreg[i] = *(const u32x4*)(Kg + ((size_t)b * SEQ + kt * 64 + row) * ldk + h * DK + ch * 8);
        }
#pragma unroll
        for (int i = 0; i < VPT; ++i) {
            int e = tid + 256 * i;
            int row = e >> 3, ch = e & 7;
            vreg[i] = *(const u32x4*)(Vt + ((size_t)bh * DV + row) * SEQ + kt * 64 + ch * 8);
        }
        if (MODE == 0 && tid < 16) freg = *(const float4*)(cumF + (size_t)bh * SEQ + kt * 64 + tid * 4);
    };
    auto lwrite = [&](int buf, u32x4 (&kreg)[KPT], u32x4 (&vreg)[VPT], float4& freg) {
        char* base = lds + buf * BUF;
#pragma unroll
        for (int i = 0; i < KPT; ++i) {
            int e = tid + 256 * i;
            int row = e / KCH, ch = e % KCH;
            *(u32x4*)(base + row * KSTR + ch * 16) = kreg[i];
        }
#pragma unroll
        for (int i = 0; i < VPT; ++i) {
            int e = tid + 256 * i;
            int row = e >> 3, ch = e & 7;
            *(u32x4*)(base + KBYTES + row * VSTR + ch * 16) = vreg[i];
        }
        if (MODE == 0 && tid < 16) { float4 fn = {-freg.x * LOG2E, -freg.y * LOG2E, -freg.z * LOG2E, -freg.w * LOG2E}; *(float4*)(base + KBYTES + VBYTES + tid * 16) = fn; }
    };
    const int prow = (r & 0x13) | ((r & 4) << 1) | ((r & 8) >> 1);
    auto ktof = [&](int it) { return (MODE == 1) ? (nkt - 1 - it) : it; };
    gload(ktof(0), kregA, vregA, fregA);
    lwrite(0, kregA, vregA, fregA);
    constexpr bool D2 = (MODE != 2);
    if (D2 && nkt > 1) gload(ktof(1), kregB, vregB, fregB);
    __syncthreads();
    auto tile = [&](int it, u32x4 (&kn)[KPT], u32x4 (&vn)[VPT], float4& fn2, u32x4 (&kf)[KPT], u32x4 (&vf2)[VPT], float4& ff) {
        const int kt = ktof(it);
        if (!(fake & 1)) {
        if (D2) { if (it + 2 < nkt) gload(ktof(it + 2), kf, vf2, ff); }
        else { if (it + 1 < nkt) gload(ktof(it + 1), kf, vf2, ff); }
        }
        const char* base = lds + (it & 1) * BUF;
        bool active = (kt * 64) <= (q0 + 32 * w + 31);
        if (MODE == 1) {
            if (sbdead) { active = false; atomicOr(&dmask[it & 1], 1 << (opaque_tid() >> 6)); }
        }
        if (active) {
            const bool needmask = (kt * 64 + 63) >= (q0 + 32 * w);
            f32x16 s[2];
#pragma unroll
            for (int sub = 0; sub < 2; ++sub) {
                s[sub] = zero16;
#pragma unroll
                for (int ks = 0; ks < DK / 16; ++ks) {
                    bf16x8 kf = *(const bf16x8*)(base + (sub * 32 + prow) * KSTR + (2 * ks + hh) * 16);
                    s[sub] = __builtin_amdgcn_mfma_f32_32x32x16_bf16(kf, qf[ks], s[sub], 0, 0, 0);
                }
            }
            bf16x8 pf[2][2];
            if (fake & 2) {
#pragma unroll
                for (int sub = 0; sub < 2; ++sub)
#pragma unroll
                    for (int a = 0; a < 2; ++a) {
                        uint4 u;
                        u.x = pack2(s[sub][8 * a], s[sub][8 * a + 1]); u.y = pack2(s[sub][8 * a + 2], s[sub][8 * a + 3]);
                        u.z = pack2(s[sub][8 * a + 4], s[sub][8 * a + 5]); u.w = pack2(s[sub][8 * a + 6], s[sub][8 * a + 7]);
                        pf[sub][a] = __builtin_bit_cast(bf16x8, u);
                    }
                lsum = 1.f;
            } else if (MODE != 1) {
                const float* Ft = (const float*)(base + KBYTES + VBYTES);
                float mx = -INFINITY;
                float tv[2][16];
#pragma unroll
                for (int sub = 0; sub < 2; ++sub)
#pragma unroll
                    for (int a = 0; a < 2; ++a) {
                        int kofs = sub * 32 + 16 * a + 8 * hh;
                        float fk[8];
                        if (MODE == 0) {
                            float4 f0 = *(const float4*)(Ft + kofs), f1 = *(const float4*)(Ft + kofs + 4);
                            fk[0] = f0.x; fk[1] = f0.y; fk[2] = f0.z; fk[3] = f0.w; fk[4] = f1.x; fk[5] = f1.y; fk[6] = f1.z; fk[7] = f1.w;
                        }
#pragma unroll
                        for (int j = 0; j < 8; ++j) {
                            int rr = 8 * a + j;
                            float v = (MODE == 0) ? fmaf(s[sub][rr], c1, fk[j]) : s[sub][rr] * c1;
                            tv[sub][rr] = v;
                        }
                    }
                if (needmask) {
#pragma unroll
                    for (int sub = 0; sub < 2; ++sub)
#pragma unroll
                        for (int rr = 0; rr < 16; ++rr) {
                            int key = kt * 64 + sub * 32 + 16 * (rr >> 3) + 8 * hh + (rr & 7);
                            if (key > qrow) tv[sub][rr] = -INFINITY;
                        }
                }
#pragma unroll
                for (int sub = 0; sub < 2; ++sub)
#pragma unroll
                    for (int rr = 0; rr < 16; ++rr) mx = fmaxf(mx, tv[sub][rr]);
                mx = fmaxf(mx, __builtin_bit_cast(float, partner32(__builtin_bit_cast(int, mx), hh)));
                float mnew = fmaxf(m, mx);
                float rsum = 0.f;
#pragma unroll
                for (int sub = 0; sub < 2; ++sub)
#pragma unroll
                    for (int a = 0; a < 2; ++a) {
                        float pv[8];
#pragma unroll
                        for (int j = 0; j < 8; ++j) { pv[j] = fexp2(tv[sub][8 * a + j] - mnew); rsum += pv[j]; }
                        uint4 u;
                        u.x = pack2(pv[0], pv[1]); u.y = pack2(pv[2], pv[3]); u.z = pack2(pv[4], pv[5]); u.w = pack2(pv[6], pv[7]);
                        pf[sub][a] = __builtin_bit_cast(bf16x8, u);
                    }
                rsum += __builtin_bit_cast(float, partner32(__builtin_bit_cast(int, rsum), hh));
                if (__builtin_amdgcn_ballot_w64(mnew != m) != 0ull) {
                    float alpha = fexp2(m - mnew);
                    lsum *= alpha;
#pragma unroll
                    for (int d = 0; d < DV / 32; ++d) o[d] = o[d] * alpha;
                    m = mnew;
                }
                lsum += rsum;
            } else {
#pragma unroll
                for (int sb = 0; sb < 2; ++sb) {
                    const int sub = 1 - sb;
                    float lsig[16], lneg[16];
                    float A0 = 0.f, A1 = 0.f;
#pragma unroll
                    for (int rr = 0; rr < 16; ++rr) {
                        int key = kt * 64 + sub * 32 + 16 * (rr >> 3) + 8 * hh + (rr & 7);
                        bool valid = key < qrow;
                        float z = s[sub][rr] * c1;
                        float e = fexp2(-fabsf(z));
                        float l1p = flog2(1.f + e);
                        float ls = fminf(z, 0.f) - l1p;
                        float ln = valid ? (ls - z) : 0.f;
                        lsig[rr] = valid ? ls : -INFINITY;
                        lneg[rr] = ln;
                        if (rr < 8) A0 += ln; else A1 += ln;
                    }
                    float B0 = __shfl_xor(A0, 32), B1 = __shfl_xor(A1, 32);
                    float base1 = (hh == 0) ? (R + B1) : R;
                    float base0 = (hh == 0) ? (R + B1 + A1 + B0) : (R + A1 + B1);
                    float wv[16];
                    float run = base1;
#pragma unroll
                    for (int j = 7; j >= 0; --j) { wv[8 + j] = fexp2(lsig[8 + j] + run); run += lneg[8 + j]; }
                    run = base0;
#pragma unroll
                    for (int j = 7; j >= 0; --j) { wv[j] = fexp2(lsig[j] + run); run += lneg[j]; }
                    R += A0 + A1 + B0 + B1;
#pragma unroll
                    for (int a = 0; a < 2; ++a) {
                        uint4 u;
                        u.x = pack2(wv[8 * a], wv[8 * a + 1]); u.y = pack2(wv[8 * a + 2], wv[8 * a + 3]);
                        u.z = pack2(wv[8 * a + 4], wv[8 * a + 5]); u.w = pack2(wv[8 * a + 6], wv[8 * a + 7]);
                        pf[sub][a] = __builtin_bit_cast(bf16x8, u);
                    }
                }
            }
            if (MODE == 1) {
                if (__builtin_amdgcn_ballot_w64(R > -150.f) == 0ull) { sbdead = true; atomicOr(&dmask[it & 1], 1 << (opaque_tid() >> 6)); }
            }
#pragma unroll
            for (int d = 0; d < DV / 32; ++d)
#pragma unroll
                for (int sub = 0; sub < 2; ++sub)
#pragma unroll
                    for (int a = 0; a < 2; ++a) {
                        bf16x8 vf = *(const bf16x8*)(base + KBYTES + (d * 32 + r) * VSTR + (sub * 32 + 16 * a + 8 * hh) * 2);
                        o[d] = __builtin_amdgcn_mfma_f32_32x32x16_bf16(vf, pf[sub][a], o[d], 0, 0, 0);
                    }
        }
        if (!(fake & 1)) { if (it + 1 < nkt) lwrite((it + 1) & 1, kn, vn, fn2); }
        __syncthreads();
    };
    if (D2) {
        for (int it = 0; it < nkt; it += 2) {
            if (MODE == 1 && it > 0 && ((volatile int*)dmask)[(it - 1) & 1] == 0xFF) break;
            tile(it, kregB, vregB, fregB, kregA, vregA, fregA);
            if (it + 1 < nkt) {
                if (MODE == 1 && ((volatile int*)dmask)[it & 1] == 0xFF) break;
                tile(it + 1, kregA, vregA, fregA, kregB, vregB, fregB);
            }
        }
    } else {
        for (int it = 0; it < nkt; ++it) tile(it, kregA, vregA, fregA, kregA, vregA, fregA);
    }
    float inv = (MODE == 1) ? 1.f : (1.f / lsum);
    float ssq = 0.f;
#pragma unroll
    for (int d = 0; d < DV / 32; ++d)
#pragma unroll
        for (int g = 0; g < 4; ++g) {
            float v0 = o[d][4 * g] * inv, v1 = o[d][4 * g + 1] * inv, v2 = o[d][4 * g + 2] * inv, v3 = o[d][4 * g + 3] * inv;
            ssq += v0 * v0 + v1 * v1 + v2 * v2 + v3 * v3;
            uint2 u; u.x = pack2(v0, v1); u.y = pack2(v2, v3);
            *(uint2*)(Y + tok * LDH + h * DV + d * 32 + 8 * g + 4 * hh) = u;
        }
    ssq += __shfl_xor(ssq, 32);
    if (hh == 0) ssy[tok * 16 + h] = ssq;
}

__device__ __forceinline__ void phase_attn(const Params& P, int L, int rep = 0, int fake = 0) {
    char* ws = opq(P.ws);
    int* cnt = (int*)(ws + OFF_CNT) + L * 64 + rep * 16;
    int* s_item = (int*)(smem + LDS_BYTES - 16);
    const float* cumF = (const float*)(ws + OFF_CUMF);
    bf16* Y = (bf16*)(ws + (fake ? OFF_PART : OFF_Y));
    float* ssy = fake ? (float*)(ws + OFF_PART + 40 * MBy) : (float*)(ws + OFF_SSY) + (size_t)L * TOK * 16;
    const int half = opaque_tid() >> 8;
    char* lds = smem + half * 65536;
    for (;;) {
        if (opaque_tid() == 0) { int z0 = 0; asm volatile("" : "+v"(z0)); *s_item = atomicAdd(cnt, 1); s_item[-4] = z0; s_item[-3] = z0; }
        __syncthreads();
        int pair = *s_item;
        __syncthreads();
        if (pair >= 768) break;
        int item = pair * 2 + half;
        int qb, type, bh;
        if (item < 1024) { qb = 15 - (item >> 6); type = (item & 32) ? 2 : 0; bh = item & 31; }
        else { const int j2 = item - 1024; qb = 15 - (j2 >> 5); type = 1; bh = j2 & 31; }
        int b = bh >> 2, h = bh & 3;
        if (type == 0) {
            attn_item<2, 96, 128>((const bf16*)(ws + OFF_MQ), 384, (const bf16*)(ws + OFF_MK), 384, (const bf16*)(ws + OFF_MVT), cumF,
                                  Y + 512, ssy + 8, b, h, qb, 0.10206207261596577f * LOG2E, lds, fake);
        } else if (type == 1) {
            attn_item<1, 64, 64>((const bf16*)(ws + OFF_SQ), 256, (const bf16*)(ws + OFF_SKK), 256, (const bf16*)(ws + OFF_SVT), cumF,
                                 Y + 256, ssy + 4, b, h, qb, 0.125f * LOG2E, lds, fake);
        } else {
            attn_item<0, 64, 64>((const bf16*)(ws + OFF_FQ), 256, (const bf16*)(ws + OFF_FK), 256, (const bf16*)(ws + OFF_FVT), cumF,
                                 Y + 0, ssy + 0, b, h, qb, 0.125f * LOG2E, lds, fake);
        }
    }
}

__device__ __forceinline__ void rowss_flush(float (&part)[2][16], float* gss, int m0, int nt) {
    float* lss = (float*)smem;
    const int tid = opaque_tid(), w = tid >> 6, l = tid & 63, hh = l >> 5, wm = w >> 1, wn = w & 1;
#pragma unroll
    for (int i = 0; i < 2; ++i)
#pragma unroll
        for (int rr = 0; rr < 16; ++rr) {
            float v = part[i][rr];
            v = dpp_add<0xB1>(v); v = dpp_add<0x4E>(v); v = dpp_add<0x141>(v); v = dpp_add<0x140>(v);
            v += __shfl_xor(v, 16);
            if ((l & 31) == 0) lss[wn * 256 + wm * 64 + i * 32 + (rr & 3) + 8 * (rr >> 2) + 4 * hh] = v;
        }
    __syncthreads();
    if (tid < 256) gss[(size_t)(m0 + tid) * 8 + nt] = lss[tid] + lss[256 + tid];
    __syncthreads();
}

__device__ __forceinline__ float sum_fq(float v) {
    float a = v, b = v;
    asm volatile("s_nop 1\n\tv_permlane16_swap_b32 %0, %1\n\ts_nop 1" : "+v"(a), "+v"(b));
    v = a + b; a = v; b = v;
    asm volatile("s_nop 1\n\tv_permlane32_swap_b32 %0, %1\n\ts_nop 1" : "+v"(a), "+v"(b));
    return a + b;
}
template <bool SIG>
__device__ __forceinline__ void residual_fused(const f32x4 (&acc)[2][2][4][2], const pg8::Unit& u, int wr, int wc, int fr, int fqd,
                                               const float* rowscale  , const bf16* gate  ,
                                               const bf16* hb_in, bf16* hb_out, float* gss) {
    float* lss = (float*)smem;
#pragma unroll
    for (int ai = 0; ai < 2; ++ai)
#pragma unroll
        for (int m = 0; m < 4; ++m) {
            const int rl = 128 * ai + 64 * wr + 16 * m + fr, row = u.pm * 256 + rl;
            const float sc = rowscale ? rowscale[rl] : 1.f;
#pragma unroll
            for (int bj = 0; bj < 2; ++bj) {
                const int col = u.pn * 256 + 128 * bj + 32 * wc + 8 * fqd;
                const u32x4 hq = *(const u32x4*)(hb_in + (size_t)row * LDH + col);
                const f32x4 hp0 = {bflo(hq.x), bfhi(hq.x), bflo(hq.y), bfhi(hq.y)}, hp1 = {bflo(hq.z), bfhi(hq.z), bflo(hq.w), bfhi(hq.w)};
                f32x4 d0 = acc[ai][bj][m][0] * sc, d1 = acc[ai][bj][m][1] * sc;
                if (SIG) {
#pragma unroll
                    for (int e = 0; e < 4; ++e) {
                        d0[e] = __builtin_amdgcn_rcpf(1.f + fexp2(-LOG2E * d0[e]));
                        d1[e] = __builtin_amdgcn_rcpf(1.f + fexp2(-LOG2E * d1[e]));
                    }
                }
                if (gate) {
                    u32x4 gq = *(const u32x4*)(gate + (size_t)row * 1024 + col);
                    f32x4 g0 = {bflo(gq.x), bfhi(gq.x), bflo(gq.y), bfhi(gq.y)}, g1 = {bflo(gq.z), bfhi(gq.z), bflo(gq.w), bfhi(gq.w)};
                    d0 = d0 * g0; d1 = d1 * g1;
                }
                f32x4 v0 = hp0 + d0, v1 = hp1 + d1;
                u32x4 wv = {pack2(v0[0], v0[1]), pack2(v0[2], v0[3]), pack2(v1[0], v1[1]), pack2(v1[2], v1[3])};
                *(u32x4*)(hb_out + (size_t)row * LDH + col) = wv;
                float ss = (v0[0] * v0[0] + v0[1] * v0[1]) + (v0[2] * v0[2] + v0[3] * v0[3]) + (v1[0] * v1[0] + v1[1] * v1[1]) + (v1[2] * v1[2] + v1[3] * v1[3]);
                ss = sum_fq(ss);
                if (fqd == 0) lss[(wc * 256 + rl) * 2 + bj] = ss;
            }
        }
    __syncthreads();
    const int tid = opaque_tid();
    if (tid < 256) {
        const int row = u.pm * 256 + tid;
#pragma unroll
        for (int bj = 0; bj < 2; ++bj)
            gss[(size_t)row * 8 + u.pn * 2 + bj] = (lss[(0 * 256 + tid) * 2 + bj] + lss[(1 * 256 + tid) * 2 + bj]) + (lss[(2 * 256 + tid) * 2 + bj] + lss[(3 * 256 + tid) * 2 + bj]);
    }
    __syncthreads();
}
struct EpiWo {
    static constexpr bool PERM = true, AFTER_DRAIN = true;
    const bf16* hb_in; bf16* hb_out; float* gss;
    __device__ __forceinline__ void khook(int t, f32x4 (&acc)[2][2][4][2], int wr, int fr) const {
        if (t == 4 || t == 8) {
            const float* fac = (const float*)(smem + LDS_AUX) + (t == 4 ? 0 : 256);
#pragma unroll
            for (int ai = 0; ai < 2; ++ai)
#pragma unroll
                for (int m = 0; m < 4; ++m) {
                    const float f = fac[128 * ai + 64 * wr + 16 * m + fr];
#pragma unroll
                    for (int bj = 0; bj < 2; ++bj) { acc[ai][bj][m][0] *= f; acc[ai][bj][m][1] *= f; }
                }
        }
    }
    __device__ __forceinline__ void operator()(const f32x4 (&)[2][2][4][2], const pg8::Unit&, int, int, int, int) const {}
    __device__ __forceinline__ void fused(const f32x4 (&acc)[2][2][4][2], const pg8::Unit& u, int wr, int wc, int fr, int fqd, PG8_LAS unsigned char*, int, int) const {
        residual_fused<false>(acc, u, wr, wc, fr, fqd, (const float*)(smem + LDS_AUX) + 512, nullptr, hb_in, hb_out, gss);
    }
};
__device__ __forceinline__ void phase_wo(const Params& P, int L, int hsel, int ss_slot) {
    char* ws = opq(P.ws);
    float* ss_out = (float*)(ws + OFF_SSA) + (size_t)ss_slot * TOK * 8;
    bf16* hb_out = (bf16*)(ws + (hsel ? OFF_HB1 : OFF_HB0));
    const bf16* hb_in = (const bf16*)(ws + (hsel ? OFF_HB0 : OFF_HB1));
    const bf16* Y = (const bf16*)(ws + OFF_Y);
    const bf16* Bt = (const bf16*)(ws + OFF_WO) + (size_t)L * 1024 * LDH;
    const float* ssy = (const float*)(ws + OFF_SSY) + (size_t)L * TOK * 16;
    float* aux = (float*)(smem + LDS_AUX);
    const int tid = opaque_tid();
    pg8::Gemm g{Y, Bt, LDH, LDH, TOK, 1024, 1024};
    pg8::StaticOrder S; S.init(TOK, 1024, gridDim.x, blockIdx.x);
    pg8::Unit u0;
    if (S.next(0, u0) && tid < 256) {
        int row = u0.pm * 256 + tid;
        float4 v0 = *(const float4*)(ssy + (size_t)row * 16), v1 = *(const float4*)(ssy + (size_t)row * 16 + 4), v2 = *(const float4*)(ssy + (size_t)row * 16 + 8);
        float r0 = rsqrtf(((v0.x + v0.y) + (v0.z + v0.w)) * (1.f / 256.f) + EPSF);
        float r1 = rsqrtf(((v1.x + v1.y) + (v1.z + v1.w)) * (1.f / 256.f) + EPSF);
        float r2 = rsqrtf(((v2.x + v2.y) + (v2.z + v2.w)) * (1.f / 512.f) + EPSF);
        aux[tid] = r0 / r1; aux[256 + tid] = r1 / r2; aux[512 + tid] = r2;
    }
    __syncthreads();
    EpiWo E{hb_in, hb_out, ss_out};
    pg8::gemm_phase((PG8_LAS unsigned char*)smem, g, S, E, nullptr);
    __syncthreads();
}

struct EpiPq {
    static constexpr bool PERM = true, AFTER_DRAIN = false;
    bf16* O; const float* ssrow;
    __device__ __forceinline__ void khook(int, f32x4 (&)[2][2][4][2], int, int) const {}
    __device__ __forceinline__ void operator()(const f32x4 (&acc)[2][2][4][2], const pg8::Unit& u, int wr, int wc, int fr, int fq) const {
        const int row0 = u.pm * 256 + wr * 64 + fr, col0 = u.pn * 256 + wc * 32 + 8 * fq;
#pragma unroll
        for (int ai = 0; ai < 2; ++ai)
#pragma unroll
            for (int m = 0; m < 4; ++m) {
                const int row = row0 + ai * 128 + m * 16;
                const float rs = row_rs8(ssrow, row);
                bf16* rowp = O + (size_t)row * 1024 + col0;
#pragma unroll
                for (int bj = 0; bj < 2; ++bj) {
                    f32x4 v0 = acc[ai][bj][m][0] * rs, v1 = acc[ai][bj][m][1] * rs;
                    u32x4 wv = {pack2(v0[0], v0[1]), pack2(v0[2], v0[3]), pack2(v1[0], v1[1]), pack2(v1[2], v1[3])};
                    *(u32x4*)(rowp + bj * 128) = wv;
                }
            }
    }
};
__device__ __forceinline__ void phase_pq(const Params& P, int L, int hsel, int ss_slot) {
    char* ws = opq(P.ws);
    const float* ssrow = (const float*)(ws + OFF_SSA) + (size_t)ss_slot * TOK * 8;
    const bf16* hb = (const bf16*)(ws + (hsel ? OFF_HB1 : OFF_HB0));
    const bf16* Bt = (const bf16*)(ws + OFF_WQ) + (size_t)L * 1024 * LDH;
    pg8::Gemm g{hb, Bt, LDH, LDH, TOK, 1024, 1024};
    pg8::StaticOrder S; S.init(TOK, 1024, gridDim.x, blockIdx.x);
    EpiPq E{(bf16*)(ws + OFF_PQ), ssrow};
    pg8::gemm_phase((PG8_LAS unsigned char*)smem, g, S, E, nullptr);
    __syncthreads();
}

__device__ __forceinline__ void cswap(int& a, int& b) { int mx = max(a, b), mn = min(a, b); a = mx; b = mn; }
__device__ __forceinline__ void bitonic_sort16(int (&v)[16]) {
#pragma unroll
    for (int k = 2; k <= 16; k <<= 1)
#pragma unroll
        for (int j = k >> 1; j > 0; j >>= 1)
#pragma unroll
            for (int i = 0; i < 16; ++i) {
                int q = i ^ j;
                if (q > i) {
                    if ((i & k) == 0) cswap(v[i], v[q]); else cswap(v[q], v[i]);
                }
            }
}
__device__ __forceinline__ void merge_top16(int (&Lv)[16], const int (&Rv)[16]) {
#pragma unroll
    for (int i = 0; i < 16; ++i) Lv[i] = max(Lv[i], Rv[15 - i]);
#pragma unroll
    for (int j = 8; j > 0; j >>= 1)
#pragma unroll
        for (int i = 0; i < 16; ++i) {
            int q = i ^ j;
            if (q > i) cswap(Lv[i], Lv[q]);
        }
}
__device__ __forceinline__ int f2key(float v, int low, int mask) {
    int b = __float_as_int(v);
    b ^= (b >> 31) & 0x7fffffff;
    return (b & ~mask) | low;
}
__device__ __forceinline__ float key2f(int k, int mask) {
    int b = k & ~mask;
    b ^= (b >> 31) & 0x7fffffff;
    return __int_as_float(b);
}

__device__ __forceinline__ void phase_topk(const Params& P, int L) {
    char* ws = opq(P.ws);
    const bf16* pq = (const bf16*)(ws + OFF_PQ);
    const bf16* skb = (const bf16*)(ws + OFF_SKB) + (size_t)L * 16 * 128 * 64;
    unsigned short* ids = (unsigned short*)(ws + OFF_IDS);
    float* gates = (float*)(ws + OFF_GATE);
    const int tid = opaque_tid(), w = tid >> 6, l = tid & 63, r = l & 31, hh = l >> 5;
    unsigned char* lidx = (unsigned char*)(smem + w * 1024 + r * 32);
    for (int task = blockIdx.x * NW + w; task < (TOK / 32) * 8; task += gridDim.x * NW) {
        const int t0 = (task >> 3) * 32, h = task & 7;
        int F[2][16];
#pragma unroll
        for (int p = 0; p < 2; ++p) {
            const int hp = h * 2 + p;
            f32x16 acc[4];
            const f32x16 z16 = {0.f, 0.f, 0.f, 0.f, 0.f, 0.f, 0.f, 0.f, 0.f, 0.f, 0.f, 0.f, 0.f, 0.f, 0.f, 0.f};
#pragma unroll
            for (int kt = 0; kt < 4; ++kt) acc[kt] = z16;
#pragma unroll
            for (int s4 = 0; s4 < 4; ++s4) {
                bf16x8 bfr = *(const bf16x8*)(pq + (size_t)(t0 + r) * 1024 + hp * 64 + 16 * s4 + 8 * hh);
#pragma unroll
                for (int kt = 0; kt < 4; ++kt) {
                    bf16x8 af = *(const bf16x8*)(skb + ((size_t)hp * 128 + 32 * kt + r) * 64 + 16 * s4 + 8 * hh);
                    acc[kt] = __builtin_amdgcn_mfma_f32_32x32x16_bf16(af, bfr, acc[kt], 0, 0, 0);
                }
            }
            int K0[16], K1[16], K2[16], K3[16];
#pragma unroll
            for (int rr = 0; rr < 16; ++rr) {
                const int nb = (rr & 3) + 8 * (rr >> 2) + 4 * hh;
                K0[rr] = f2key(acc[0][rr], 127 - nb, 127);
                K1[rr] = f2key(acc[1][rr], 127 - (32 + nb), 127);
                K2[rr] = f2key(acc[2][rr], 127 - (64 + nb), 127);
                K3[rr] = f2key(acc[3][rr], 127 - (96 + nb), 127);
            }
            bitonic_sort16(K0); bitonic_sort16(K1); bitonic_sort16(K2); bitonic_sort16(K3);
            merge_top16(K0, K1);
            merge_top16(K2, K3);
            merge_top16(K0, K2);
#pragma unroll
            for (int i = 0; i < 16; ++i) K1[i] = partner32(K0[i], hh);
            merge_top16(K0, K1);
#pragma unroll
            for (int i = 0; i < 16; ++i) F[p][i] = K0[i];
        }
        if (hh == 0) {
#pragma unroll
            for (int q = 0; q < 4; ++q) {
                unsigned w1 = 0, w2 = 0;
#pragma unroll
                for (int e = 0; e < 4; ++e) {
                    w1 |= (unsigned)(127 - (F[0][4 * q + e] & 127)) << (8 * e);
                    w2 |= (unsigned)(127 - (F[1][4 * q + e] & 127)) << (8 * e);
                }
                ((unsigned*)lidx)[q] = w1;
                ((unsigned*)lidx)[4 + q] = w2;
            }
        }
        {
            float s1[16], s2[16];
#pragma unroll
            for (int i = 0; i < 16; ++i) { s1[i] = key2f(F[0][i], 127); s2[i] = key2f(F[1][i], 127); }
            int Lc[16], X[16];
#pragma unroll
            for (int b2 = 0; b2 < 16; ++b2) Lc[b2] = f2key(s1[0] + s2[b2], 255 - b2, 255);
#pragma unroll
            for (int a2 = 1; a2 < 16; ++a2) X[a2 - 1] = f2key(s1[a2] + s2[0], 255 - a2 * 16, 255);
            X[15] = INT_MIN;
            merge_top16(Lc, X);
            X[0] = f2key(s1[1] + s2[1], 255 - 17, 255); X[1] = f2key(s1[1] + s2[2], 255 - 18, 255); X[2] = f2key(s1[1] + s2[3], 255 - 19, 255);
            X[3] = f2key(s1[1] + s2[4], 255 - 20, 255); X[4] = f2key(s1[1] + s2[5], 255 - 21, 255); X[5] = f2key(s1[1] + s2[6], 255 - 22, 255);
            X[6] = f2key(s1[1] + s2[7], 255 - 23, 255);
            X[7] = f2key(s1[2] + s2[1], 255 - 33, 255); X[8] = f2key(s1[2] + s2[2], 255 - 34, 255); X[9] = f2key(s1[2] + s2[3], 255 - 35, 255);
            X[10] = f2key(s1[2] + s2[4], 255 - 36, 255);
            X[11] = f2key(s1[3] + s2[1], 255 - 49, 255); X[12] = f2key(s1[3] + s2[2], 255 - 50, 255); X[13] = f2key(s1[3] + s2[3], 255 - 51, 255);
            X[14] = f2key(s1[4] + s2[1], 255 - 65, 255); X[15] = f2key(s1[4] + s2[2], 255 - 66, 255);
            bitonic_sort16(X);
            merge_top16(Lc, X);
            X[0] = f2key(s1[5] + s2[1], 255 - 81, 255);
            X[1] = f2key(s1[6] + s2[1], 255 - 97, 255);
            X[2] = f2key(s1[7] + s2[1], 255 - 113, 255);
#pragma unroll
            for (int i = 3; i < 16; ++i) X[i] = INT_MIN;
            merge_top16(Lc, X);
            if (hh == 0) {
                float mx = key2f(Lc[0], 255);
                float ev[16], sum = 0.f;
#pragma unroll
                for (int k = 0; k < 16; ++k) { ev[k] = __expf(key2f(Lc[k], 255) - mx); sum += ev[k]; }
                float inv = 1.f / sum;
                size_t ob = (size_t)(t0 + r) * 128 + h * 16;
                unsigned idw[8];
#pragma unroll
                for (int k = 0; k < 16; ++k) {
                    int cidx = 255 - (Lc[k] & 255);
                    int i1 = lidx[cidx >> 4], i2 = lidx[16 + (cidx & 15)];
                    unsigned idv = (unsigned)(i1 * 128 + i2);
                    if (k & 1) idw[k >> 1] |= idv << 16; else idw[k >> 1] = idv;
                }
                u32x4 o0 = {idw[0], idw[1], idw[2], idw[3]}, o1 = {idw[4], idw[5], idw[6], idw[7]};
                *(u32x4*)(ids + ob) = o0;
                *(u32x4*)(ids + ob + 8) = o1;
#pragma unroll
                for (int q = 0; q < 4; ++q) {
                    f32x4 g4 = {ev[4 * q] * inv, ev[4 * q + 1] * inv, ev[4 * q + 2] * inv, ev[4 * q + 3] * inv};
                    *(f32x4*)(gates + ob + 4 * q) = g4;
                }
            }
        }
    }
}

__device__ __forceinline__ float gelu_exact(float x) { return 0.5f * x * (1.f + erff(x * 0.70710678118654752f)); }

__device__ __forceinline__ void dec16(const u32x4& v, float (&f)[16]) {
    f32x2 t;
    t = __builtin_amdgcn_cvt_pk_f32_fp8((int)v.x, false); f[0] = t.x; f[1] = t.y;
    t = __builtin_amdgcn_cvt_pk_f32_fp8((int)v.x, true);  f[2] = t.x; f[3] = t.y;
    t = __builtin_amdgcn_cvt_pk_f32_fp8((int)v.y, false); f[4] = t.x; f[5] = t.y;
    t = __builtin_amdgcn_cvt_pk_f32_fp8((int)v.y, true);  f[6] = t.x; f[7] = t.y;
    t = __builtin_amdgcn_cvt_pk_f32_fp8((int)v.z, false); f[8] = t.x; f[9] = t.y;
    t = __builtin_amdgcn_cvt_pk_f32_fp8((int)v.z, true);  f[10] = t.x; f[11] = t.y;
    t = __builtin_amdgcn_cvt_pk_f32_fp8((int)v.w, false); f[12] = t.x; f[13] = t.y;
    t = __builtin_amdgcn_cvt_pk_f32_fp8((int)v.w, true);  f[14] = t.x; f[15] = t.y;
}

__device__ __forceinline__ void dec32(const u32x4& v, f32x2 (&f)[16]) {
    f[0] = __builtin_amdgcn_cvt_scalef32_pk_f32_fp4(v.x, 1.0f, 0); f[1] = __builtin_amdgcn_cvt_scalef32_pk_f32_fp4(v.x, 1.0f, 1);
    f[2] = __builtin_amdgcn_cvt_scalef32_pk_f32_fp4(v.x, 1.0f, 2); f[3] = __builtin_amdgcn_cvt_scalef32_pk_f32_fp4(v.x, 1.0f, 3);
    f[4] = __builtin_amdgcn_cvt_scalef32_pk_f32_fp4(v.y, 1.0f, 0); f[5] = __builtin_amdgcn_cvt_scalef32_pk_f32_fp4(v.y, 1.0f, 1);
    f[6] = __builtin_amdgcn_cvt_scalef32_pk_f32_fp4(v.y, 1.0f, 2); f[7] = __builtin_amdgcn_cvt_scalef32_pk_f32_fp4(v.y, 1.0f, 3);
    f[8] = __builtin_amdgcn_cvt_scalef32_pk_f32_fp4(v.z, 1.0f, 0); f[9] = __builtin_amdgcn_cvt_scalef32_pk_f32_fp4(v.z, 1.0f, 1);
    f[10] = __builtin_amdgcn_cvt_scalef32_pk_f32_fp4(v.z, 1.0f, 2); f[11] = __builtin_amdgcn_cvt_scalef32_pk_f32_fp4(v.z, 1.0f, 3);
    f[12] = __builtin_amdgcn_cvt_scalef32_pk_f32_fp4(v.w, 1.0f, 0); f[13] = __builtin_amdgcn_cvt_scalef32_pk_f32_fp4(v.w, 1.0f, 1);
    f[14] = __builtin_amdgcn_cvt_scalef32_pk_f32_fp4(v.w, 1.0f, 2); f[15] = __builtin_amdgcn_cvt_scalef32_pk_f32_fp4(v.w, 1.0f, 3);
}

typedef _Float16 f16x2 __attribute__((ext_vector_type(2)));
__device__ __forceinline__ void dec8_f16(unsigned x, f16x2 (&wv)[4]) {
    const unsigned lo = x & 0x07070707u, hi = (x >> 4) & 0x07070707u;
    const unsigned Lb = __builtin_amdgcn_perm(0x46444240u, 0x3E3C3800u, lo) | ((x & 0x08080808u) << 4);
    const unsigned Hb = __builtin_amdgcn_perm(0x46444240u, 0x3E3C3800u, hi) | (x & 0x80808080u);
    wv[0] = __builtin_bit_cast(f16x2, __builtin_amdgcn_perm(Hb, Lb, 0x040c000cu));
    wv[1] = __builtin_bit_cast(f16x2, __builtin_amdgcn_perm(Hb, Lb, 0x050c010cu));
    wv[2] = __builtin_bit_cast(f16x2, __builtin_amdgcn_perm(Hb, Lb, 0x060c020cu));
    wv[3] = __builtin_bit_cast(f16x2, __builtin_amdgcn_perm(Hb, Lb, 0x070c030cu));
}

__device__ __forceinline__ int idof16(const u32x4 (&q)[2], int i) {
    unsigned wv = (i >> 1) == 0 ? q[0].x : (i >> 1) == 1 ? q[0].y : (i >> 1) == 2 ? q[0].z : (i >> 1) == 3 ? q[0].w
                : (i >> 1) == 4 ? q[1].x : (i >> 1) == 5 ? q[1].y : (i >> 1) == 6 ? q[1].z : q[1].w;
    return (i & 1) ? (int)(wv >> 16) : (int)(wv & 0xffffu);
}
__device__ __forceinline__ void phase_gather_u(const Params& P, int L, int hsel) {
    char* ws = opq(P.ws);
    const unsigned char* U4 = (const unsigned char*)(ws + OFF_UB) + (size_t)L * NEXP * 512;
    float* part = (float*)(ws + OFF_PART);
    const unsigned short* ids = (const unsigned short*)(ws + OFF_IDS);
    const bf16* hbin = (const bf16*)(ws + (hsel ? OFF_HB1 : OFF_HB0));
    const int tid = opaque_tid(), w = tid >> 6, l = tid & 63, c = l & 7, gq = l >> 3;
    const int sl = blockIdx.x & 3, par = (blockIdx.x >> 2) & 1, rk = blockIdx.x >> 3, nb = gridDim.x >> 3;
    if (rk >= nb) return;
    const unsigned char* ubase = U4 + (size_t)sl * NEXP * 128 + c * 16;
    const int stride = nb * NW;
    int ti = rk * NW + w;
    if (ti >= TOK / 2) return;
    u32x4 idA[2], idB[2];
    u32x4 rv[16];
    u32x4 hA[4], hB[4];
    auto load_ids = [&](int tt, u32x4 (&idq)[2]) {
        const u32x4* i4 = (const u32x4*)(ids + (size_t)tt * 128 + 16 * gq);
        idq[0] = i4[0]; idq[1] = i4[1];
    };
    auto load_hx = [&](int tt, u32x4 (&hx)[4]) {
        const u32x4* h4 = (const u32x4*)(hbin + (size_t)tt * LDH + 256 * sl + 32 * c);
#pragma unroll
        for (int q = 0; q < 4; ++q) hx[q] = h4[q];
    };
    auto step = [&](int tcur, int tnext, int tnext2, const u32x4 (&idn)[2], u32x4 (&idl)[2], const u32x4 (&hcb)[4], u32x4 (&hn)[4]) {
        f32x4 hc[8];
#pragma unroll
        for (int q = 0; q < 4; ++q) {
            f32x4 t0 = {bflo(hcb[q].x), bfhi(hcb[q].x), bflo(hcb[q].y), bfhi(hcb[q].y)}, t1 = {bflo(hcb[q].z), bfhi(hcb[q].z), bflo(hcb[q].w), bfhi(hcb[q].w)};
            hc[2 * q] = t0; hc[2 * q + 1] = t1;
        }
        __builtin_amdgcn_sched_barrier(0);
        load_ids(tnext2, idl);
        load_hx(tnext, hn);
        __builtin_amdgcn_sched_barrier(0);
        float pr[16];
#pragma unroll
        for (int i = 0; i < 16; ++i) {
            f32x2 f[16];
            asm volatile("" : "+v"(rv[i].x), "+v"(rv[i].y), "+v"(rv[i].z), "+v"(rv[i].w));
            dec32(rv[i], f);
            rv[i] = *(const u32x4*)(ubase + (size_t)idof16(idn, i) * 128);
            __builtin_amdgcn_sched_barrier(0);
            f32x2 s2 = {0.f, 0.f};
#pragma unroll
            for (int q = 0; q < 8; ++q) {
                f32x2 x0 = {hc[q].x, hc[q].y}, x1 = {hc[q].z, hc[q].w};
                s2 = __builtin_elementwise_fma(f[2 * q], x0, s2);
                s2 = __builtin_elementwise_fma(f[2 * q + 1], x1, s2);
            }
            float sacc = s2.x + s2.y;
            asm volatile("" : "+v"(sacc));
            pr[i] = sacc;
        }
#pragma unroll
        for (int i = 0; i < 16; ++i) pr[i] = sum8_dpp(pr[i]);
        if (c == 0) {
            f32x4* o4 = (f32x4*)(part + ((size_t)sl * TOK + tcur) * 128 + 16 * gq);
#pragma unroll
            for (int q = 0; q < 4; ++q) { f32x4 o = {pr[4 * q], pr[4 * q + 1], pr[4 * q + 2], pr[4 * q + 3]}; o4[q] = o; }
        }
    };
    auto tok = [&](int tidx, int fb) { return 2 * (tidx < TOK / 2 ? tidx : fb) + par; };
    load_ids(tok(ti, ti), idA);
#pragma unroll
    for (int i = 0; i < 16; ++i) rv[i] = *(const u32x4*)(ubase + (size_t)idof16(idA, i) * 128);
    load_hx(tok(ti, ti), hA);
    load_ids(tok(ti + stride, ti), idB);
    for (;;) {
        int tn = ti + stride, tn2 = ti + 2 * stride;
        step(tok(ti, ti), tok(tn, ti), tok(tn2, ti), idB, idA, hA, hB);
        if (tn >= TOK / 2) break;
        ti = tn; tn = ti + stride; tn2 = ti + 2 * stride;
        step(tok(ti, ti), tok(tn, ti), tok(tn2, ti), idA, idB, hB, hA);
        if (tn >= TOK / 2) break;
        ti = tn;
    }
}

__device__ __forceinline__ void phase_gather_act(const Params& P, int L, int ss_slot, int fake = 0) {
    char* ws = opq(P.ws);
    const float* ss_ffn = (const float*)(ws + OFF_SSA) + (size_t)ss_slot * TOK * 8;
    const float* part = (const float*)(ws + OFF_PART);
    const unsigned short* ids = (const unsigned short*)(ws + OFF_IDS);
    float* gates = (float*)(ws + OFF_GATE);
    const float* uinv = (const float*)(ws + OFF_TSC) + L * NEXP;
    const float* vinv = (const float*)(ws + OFF_TSC) + (2 + L) * NEXP;
    const int tid = opaque_tid(), w = tid >> 6, l = tid & 63;
    float* gdst = fake ? (float*)(ws + OFF_FQ) : gates;
    const int stride = gridDim.x * NW;
    for (int t0 = blockIdx.x * NW + w; t0 < TOK; t0 += 4 * stride) {
        f32x2 pa[4][4], gt[4];
        unsigned idw[4];
        f32x4 s0[4], s1[4];
#pragma unroll
        for (int q = 0; q < 4; ++q) {
            const int t = (t0 + q * stride < TOK) ? (t0 + q * stride) : t0;
#pragma unroll
            for (int j = 0; j < 4; ++j) pa[q][j] = *(const f32x2*)(part + ((size_t)j * TOK + t) * 128 + 2 * l);
            idw[q] = *(const unsigned*)(ids + (size_t)t * 128 + 2 * l);
            gt[q] = *(const f32x2*)(gates + (size_t)t * 128 + 2 * l);
            s0[q] = *(const f32x4*)(ss_ffn + (size_t)t * 8); s1[q] = *(const f32x4*)(ss_ffn + (size_t)t * 8 + 4);
        }
        float ui[4][2], vi[4][2];
#pragma unroll
        for (int q = 0; q < 4; ++q) {
            const int i0 = (int)(idw[q] & 0xffffu), i1 = (int)(idw[q] >> 16);
            ui[q][0] = uinv[i0]; ui[q][1] = uinv[i1]; vi[q][0] = vinv[i0]; vi[q][1] = vinv[i1];
        }
#pragma unroll
        for (int q = 0; q < 4; ++q) {
            const int t = t0 + q * stride;
            if (t < TOK) {
                const float ssum = ((s0[q].x + s0[q].y) + (s0[q].z + s0[q].w)) + ((s1[q].x + s1[q].y) + (s1[q].z + s1[q].w));
                const float rs = rsqrtf(ssum * (1.f / 1024.f) + EPSF);
                f32x2 sa = (pa[q][0] + pa[q][1]) + (pa[q][2] + pa[q][3]);
                f32x2 o;
                o.x = gt[q].x * gelu_exact(sa.x * rs * ui[q][0]) * vi[q][0];
                o.y = gt[q].y * gelu_exact(sa.y * rs * ui[q][1]) * vi[q][1];
                *(f32x2*)(gdst + (size_t)t * 128 + 2 * l) = o;
            }
        }
    }
}

__device__ __forceinline__ void phase_gather_v(const Params& P, int L, int hsel, int ss_slot, int fake = 0) {
    char* ws = opq(P.ws);
    float* ss_ple = fake ? (float*)(ws + OFF_FQ) : (float*)(ws + OFF_SSA) + (size_t)ss_slot * TOK * 8;
    bf16* hb_out = fake ? (bf16*)(ws + OFF_PART) : (bf16*)(ws + (hsel ? OFF_HB1 : OFF_HB0));
    const bf16* hbin = (const bf16*)(ws + (hsel ? OFF_HB0 : OFF_HB1));
    const unsigned char* V4 = (const unsigned char*)(ws + OFF_VB) + (size_t)L * NEXP * 512;
    const unsigned short* ids = (const unsigned short*)(ws + OFF_IDS);
    const float* act = (const float*)(ws + OFF_GATE);
    const int tid = opaque_tid(), w = tid >> 6, l = tid & 63, c = l & 7, gq = l >> 3;
    const int sl = blockIdx.x & 3, par = (blockIdx.x >> 2) & 1, rk = blockIdx.x >> 3, nb = gridDim.x >> 3;
    if (rk >= nb) return;
    const unsigned char* vbase = V4 + (size_t)sl * NEXP * 128 + c * 16;
    const int stride = nb * NW;
    int ti = rk * NW + w;
    if (ti >= TOK / 2) return;
    const bool b3 = (l >> 3) & 1;
    u32x4 idA[2], idB[2];
    u32x4 rv[16];
    f32x4 aA[4], aB[4];
    auto load_ids = [&](int tt, u32x4 (&idq)[2]) {
        const u32x4* i4 = (const u32x4*)(ids + (size_t)tt * 128 + 16 * gq);
        idq[0] = i4[0]; idq[1] = i4[1];
    };
    auto load_a = [&](int tt, f32x4 (&ax)[4]) {
        const f32x4* a4 = (const f32x4*)(act + (size_t)tt * 128 + 16 * gq);
#pragma unroll
        for (int q = 0; q < 4; ++q) ax[q] = a4[q];
    };
    auto step = [&](int tcur, int tnext, int tnext2, const u32x4 (&idn)[2], u32x4 (&idl)[2], const f32x4 (&ac)[4], f32x4 (&an)[4]) {
        load_ids(tnext2, idl);
        load_a(tnext, an);
        __builtin_amdgcn_sched_barrier(0);
        f32x2 acc[16];
#pragma unroll
        for (int e = 0; e < 16; ++e) { acc[e].x = 0.f; acc[e].y = 0.f; }
#pragma unroll
        for (int i = 0; i < 16; ++i) {
            f32x2 f[16];
            asm volatile("" : "+v"(rv[i].x), "+v"(rv[i].y), "+v"(rv[i].z), "+v"(rv[i].w));
            dec32(rv[i], f);
            rv[i] = *(const u32x4*)(vbase + (size_t)idof16(idn, i) * 128);
            __builtin_amdgcn_sched_barrier(0);
            const float a = (i & 3) == 0 ? ac[i >> 2].x : (i & 3) == 1 ? ac[i >> 2].y : (i & 3) == 2 ? ac[i >> 2].z : ac[i >> 2].w;
            const f32x2 a2 = {a, a};
#pragma unroll
            for (int e = 0; e < 16; ++e) acc[e] = __builtin_elementwise_fma(f[e], a2, acc[e]);
#pragma unroll
            for (int e = 0; e < 16; ++e) asm volatile("" : "+v"(acc[e]));
        }
        float v8[8][2];
#pragma unroll
        for (int e = 0; e < 8; ++e) {
            float k0 = b3 ? acc[8 + e].x : acc[e].x, k1 = b3 ? acc[8 + e].y : acc[e].y;
            float s0 = b3 ? acc[e].x : acc[8 + e].x, s1 = b3 ? acc[e].y : acc[8 + e].y;
            v8[e][0] = k0 + __builtin_bit_cast(float, __builtin_amdgcn_update_dpp(0, __builtin_bit_cast(int, s0), 0x128, 0xf, 0xf, true));
            v8[e][1] = k1 + __builtin_bit_cast(float, __builtin_amdgcn_update_dpp(0, __builtin_bit_cast(int, s1), 0x128, 0xf, 0xf, true));
        }
        float v4[8];
#pragma unroll
        for (int e = 0; e < 8; ++e) {
            float X = v8[e >> 1][e & 1], Y = v8[4 + (e >> 1)][e & 1];
            asm volatile("s_nop 1\n\tv_permlane16_swap_b32 %0, %1\n\ts_nop 1" : "+v"(X), "+v"(Y));
            v4[e] = X + Y;
        }
        float v2[4];
#pragma unroll
        for (int e = 0; e < 4; ++e) {
            float X = v4[e], Y = v4[4 + e];
            asm volatile("s_nop 1\n\tv_permlane32_swap_b32 %0, %1\n\ts_nop 1" : "+v"(X), "+v"(Y));
            v2[e] = X + Y;
        }
        const int col = 256 * sl + 32 * c + 16 * ((l >> 3) & 1) + 8 * ((l >> 4) & 1) + 4 * (l >> 5);
        const u32x2 hq = *(const u32x2*)(hbin + (size_t)tcur * LDH + col);
        f32x4 hv = {bflo(hq.x) + v2[0], bfhi(hq.x) + v2[1], bflo(hq.y) + v2[2], bfhi(hq.y) + v2[3]};
        u32x2 bb = {pack2(hv.x, hv.y), pack2(hv.z, hv.w)};
        *(u32x2*)(hb_out + (size_t)tcur * LDH + col) = bb;
        float ssq = hv.x * hv.x + hv.y * hv.y + hv.z * hv.z + hv.w * hv.w;
        ssq = wave_sum(ssq);
        if (l == 0) { ss_ple[(size_t)tcur * 8 + sl] = ssq; ss_ple[(size_t)tcur * 8 + 4 + sl] = 0.f; }
    };
    auto tok = [&](int tidx, int fb) { return 2 * (tidx < TOK / 2 ? tidx : fb) + par; };
    load_ids(tok(ti, ti), idA);
#pragma unroll
    for (int i = 0; i < 16; ++i) rv[i] = *(const u32x4*)(vbase + (size_t)idof16(idA, i) * 128);
    load_a(tok(ti, ti), aA);
    load_ids(tok(ti + stride, ti), idB);
    for (;;) {
        int tn = ti + stride, tn2 = ti + 2 * stride;
        step(tok(ti, ti), tok(tn, ti), tok(tn2, ti), idB, idA, aA, aB);
        if (tn >= TOK / 2) break;
        ti = tn; tn = ti + stride; tn2 = ti + 2 * stride;
        step(tok(ti, ti), tok(tn, ti), tok(tn2, ti), idA, idB, aB, aA);
        if (tn >= TOK / 2) break;
        ti = tn;
    }
}

struct EpiStoreBf16 {
    static constexpr bool PERM = true, AFTER_DRAIN = false;
    bf16* O;
    __device__ __forceinline__ void khook(int, f32x4 (&)[2][2][4][2], int, int) const {}
    __device__ __forceinline__ void operator()(const f32x4 (&acc)[2][2][4][2], const pg8::Unit& u, int wr, int wc, int fr, int fqd) const {
        const int row0 = u.pm * 256 + wr * 64 + fr, col0 = u.pn * 256 + wc * 32 + 8 * fqd;
#pragma unroll
        for (int ai = 0; ai < 2; ++ai)
#pragma unroll
            for (int m = 0; m < 4; ++m) {
                bf16* rowp = O + (size_t)(row0 + ai * 128 + m * 16) * 1024 + col0;
#pragma unroll
                for (int bj = 0; bj < 2; ++bj) {
                    const f32x4 v0 = acc[ai][bj][m][0], v1 = acc[ai][bj][m][1];
                    u32x4 wv = {pack2(v0[0], v0[1]), pack2(v0[2], v0[3]), pack2(v1[0], v1[1]), pack2(v1[2], v1[3])};
                    *(u32x4*)(rowp + bj * 128) = wv;
                }
            }
    }
};
__device__ __forceinline__ void phase_pw(const Params& P) {
    char* ws = opq(P.ws);
    pg8::StaticOrder S; S.init(TOK, 1024, gridDim.x, blockIdx.x);
    for (int L = 0; L < 2; ++L) {
        pg8::Gemm g{(const bf16*)(ws + OFF_PB) + (size_t)L * TOK * LDP, (const bf16*)(ws + OFF_WP) + (size_t)L * 1024 * LDP, LDP, LDP, TOK, 1024, 256};
        EpiStoreBf16 E{(bf16*)(ws + (L ? OFF_PW1 : OFF_PW0))};
        pg8::gemm_phase((PG8_LAS unsigned char*)smem, g, S, E, nullptr);
        __syncthreads();
    }
}
struct EpiPle {
    static constexpr bool PERM = true, AFTER_DRAIN = true;
    const bf16* PW; const bf16* hb_in; bf16* hb_out; float* gss;
    __device__ __forceinline__ void khook(int, f32x4 (&)[2][2][4][2], int, int) const {}
    __device__ __forceinline__ void operator()(const f32x4 (&)[2][2][4][2], const pg8::Unit&, int, int, int, int) const {}
    __device__ __forceinline__ void fused(const f32x4 (&acc)[2][2][4][2], const pg8::Unit& u, int wr, int wc, int fr, int fqd, PG8_LAS unsigned char*, int, int) const {
        residual_fused<true>(acc, u, wr, wc, fr, fqd, (const float*)(smem + LDS_AUX), PW, hb_in, hb_out, gss);
    }
};
__device__ __forceinline__ void phase_ple(const Params& P, int L, int hsel, int ss_slot_in, int ss_slot_out, int fake = 0) {
    char* ws = opq(P.ws);
    const float* ss_ple = (const float*)(ws + OFF_SSA) + (size_t)ss_slot_in * TOK * 8;
    float* ss_out = (float*)(ws + OFF_SSA) + (size_t)ss_slot_out * TOK * 8;
    const bf16* hb_in = (const bf16*)(ws + (hsel ? OFF_HB1 : OFF_HB0));
    bf16* hb_out = (bf16*)(ws + (hsel ? OFF_HB0 : OFF_HB1));
    const bf16* Wg = (const bf16*)(ws + OFF_WG) + (size_t)L * 1024 * LDH;
    float* aux = (float*)(smem + LDS_AUX);
    const int tid = opaque_tid();
    pg8::Gemm g{hb_in, Wg, LDH, LDH, TOK, 1024, 1024};
    pg8::StaticOrder S; S.init(TOK, 1024, gridDim.x, blockIdx.x);
    pg8::Unit u0;
    if (S.next(0, u0) && tid < 256) aux[tid] = row_rs8(ss_ple, u0.pm * 256 + tid);
    __syncthreads();
    EpiPle E{(const bf16*)(ws + (L ? OFF_PW1 : OFF_PW0)), hb_in, fake ? (bf16*)(ws + OFF_PART) : hb_out, fake ? (float*)(ws + OFF_FQ) : ss_out};
    pg8::gemm_phase((PG8_LAS unsigned char*)smem, g, S, E, nullptr);
    __syncthreads();
}

__device__ __forceinline__ void phase_final(const Params& P, int ss_slot, int hsel) {
    char* ws = opq(P.ws);
    float* out = opq(P.out);
    const bf16* hbin = (const bf16*)(ws + (hsel ? OFF_HB1 : OFF_HB0));
    const float* ss = (const float*)(ws + OFF_SSA) + (size_t)ss_slot * TOK * 8;
    const int tid = opaque_tid(), w = tid >> 6, l = tid & 63;
    const float4* g4 = (const float4*)P.final_norm_g;
    for (int t = blockIdx.x * NW + w; t < TOK; t += gridDim.x * NW) {
        float rs = row_rs8(ss, t);
        float4* o4 = (float4*)(out + (size_t)t * 1024);
#pragma unroll
        for (int i = 0; i < 2; ++i) {
            u32x4 hq = *(const u32x4*)(hbin + (size_t)t * LDH + (i * 64 + l) * 8);
            float4 ga = g4[(i * 64 + l) * 2], gb = g4[(i * 64 + l) * 2 + 1];
            float4 va = {bflo(hq.x) * rs * ga.x, bfhi(hq.x) * rs * ga.y, bflo(hq.y) * rs * ga.z, bfhi(hq.y) * rs * ga.w};
            float4 vb = {bflo(hq.z) * rs * gb.x, bfhi(hq.z) * rs * gb.y, bflo(hq.w) * rs * gb.z, bfhi(hq.w) * rs * gb.w};
            o4[(i * 64 + l) * 2] = va; o4[(i * 64 + l) * 2 + 1] = vb;
        }
    }
}

#define XB_TMO      128
#define XB_XCNT(j)  (256  + 64 * (j))
#define XB_XSUB(j)  (1280 + 64 * (j))
#define XB_XGEN(j)  (2304 + 64 * (j))
#define XB_TOP      3328
#define XB_TOPGEN   3392
#define XCD_BAR_WORDS 3456
#define XB_SPIN_CAP (1u << 22)
__device__ __forceinline__ unsigned xb_ld(unsigned* p) { return __hip_atomic_load(p, __ATOMIC_RELAXED, __HIP_MEMORY_SCOPE_AGENT); }
__device__ __forceinline__ unsigned xb_add(unsigned* p, unsigned v) { return __hip_atomic_fetch_add(p, v, __ATOMIC_RELAXED, __HIP_MEMORY_SCOPE_AGENT); }
__device__ __forceinline__ unsigned xb_xcc_id() { return (unsigned)__builtin_amdgcn_s_getreg((3 << 11) | 20) & 0xFu; }
#define XB_SPIN(cond, bar) do { unsigned _sp = 0; while (cond) { __builtin_amdgcn_s_sleep(1); \
    if ((++_sp & 255u) == 0u) { if (xb_ld(&(bar)[XB_TMO])) break; if (_sp > XB_SPIN_CAP) { atomicAdd(&(bar)[XB_TMO], 1u); break; } } } } while (0)
#define XB_LDS_OFF (LDS_BYTES - 64)
__device__ __forceinline__ void xcd_barrier_post(const Params& P) {
    if (threadIdx.x == 0) {
        unsigned* bar = (unsigned*)(P.ws + OFF_BAR);
        volatile __attribute__((address_space(3))) unsigned* st = (volatile __attribute__((address_space(3))) unsigned*)(smem + XB_LDS_OFF);
        st[0] = 0u; st[1] = 0u;
        (void)xb_add(&bar[XB_XCNT(xb_xcc_id())], 1u);
    }
}
__device__ __forceinline__ void xcd_barrier_complete(unsigned* bar, unsigned x, unsigned& nloc, unsigned& nx) {
    const unsigned G = gridDim.x;
    unsigned sum, cnt, mine, sp = 0u;
    for (;;) {
        sum = 0u; cnt = 0u; mine = 0u;
#pragma unroll
        for (unsigned j = 0; j < 16; ++j) { const unsigned c = xb_ld(&bar[XB_XCNT(j)]); sum += c; cnt += (c > 0u) ? 1u : 0u; mine = (j == x) ? c : mine; }
        if (sum == G) break;
        __builtin_amdgcn_s_sleep(1);
        if ((++sp & 255u) == 0u) { if (xb_ld(&bar[XB_TMO])) break; if (sp > XB_SPIN_CAP) { atomicAdd(&bar[XB_TMO], 1u); break; } }
    }
    nloc = mine > 0u ? mine : 1u; nx = cnt > 0u ? cnt : 1u;
}
__device__ __forceinline__ void grid_barrier(const Params& P) {
    asm volatile("s_waitcnt vmcnt(0)" ::: "memory");
    __syncthreads();
    if (threadIdx.x == 0) {
        unsigned* bar = (unsigned*)(P.ws + OFF_BAR);
        volatile __attribute__((address_space(3))) unsigned* st = (volatile __attribute__((address_space(3))) unsigned*)(smem + XB_LDS_OFF);
        const unsigned x = xb_xcc_id();
        __builtin_amdgcn_s_waitcnt(0);
        unsigned nloc = st[0], nx = st[1];
        if (nloc == 0u) { xcd_barrier_complete(bar, x, nloc, nx); st[0] = nloc; st[1] = nx; }
        const unsigned old = xb_add(&bar[XB_XSUB(x)], 1u);
        const unsigned gen = old / nloc;
        if (old + 1u == (gen + 1u) * nloc) {
            __builtin_amdgcn_fence(__ATOMIC_RELEASE, "agent");
            asm volatile("s_waitcnt vmcnt(0)" ::: "memory");
            const unsigned og = xb_add(&bar[XB_TOP], 1u);
            const unsigned tg = og / nx;
            if (og + 1u == (tg + 1u) * nx) xb_add(&bar[XB_TOPGEN], 1u);
            else XB_SPIN(xb_ld(&bar[XB_TOPGEN]) == tg, bar);
            __builtin_amdgcn_fence(__ATOMIC_ACQUIRE, "agent");
            xb_add(&bar[XB_XGEN(x)], 1u);
            asm volatile("s_waitcnt vmcnt(0)" ::: "memory");
        } else {
            XB_SPIN(xb_ld(&bar[XB_XGEN(x)]) == gen, bar);
            __builtin_amdgcn_fence(__ATOMIC_ACQUIRE, "agent");
            asm volatile("s_waitcnt vmcnt(0)" ::: "memory");
        }
    }
    __syncthreads();
}

__global__ void __launch_bounds__(NTHR, 2) hymba_megakernel(Params P) {
    cg::grid_group grid = cg::this_grid();
    char* ws = opq(P.ws);
    xcd_barrier_post(P);
#define BAR() do { grid_barrier(P); if (DUP == 20) grid_barrier(P); } while (0)
    phase0(P);
    if (DUP == 0) { asm volatile("s_waitcnt vmcnt(0)" ::: "memory"); __syncthreads(); grid_barrier(P); phase0(P); }
    asm volatile("s_waitcnt vmcnt(0)" ::: "memory");
    __syncthreads();
    grid.sync();
    BAR();
    phase_pw(P);
    BAR();
    if (DUP == 11) { phase_pw(P); BAR(); }
    int cur = 0;
    for (int L = 0; L < 2; ++L) {
        const int ss_mix = (L == 0) ? 0 : 3, ss_ffn = 1 + L, ss_next = (L == 0) ? 3 : 4, ss_ple = 5 + L;
        phase_proj(P, L, cur, ss_mix);
        BAR();
        if (DUP == 1) { phase_proj(P, L, cur, ss_mix); BAR(); }
        phase_mla_up(P, L);
        BAR();
        if (DUP == 2) { phase_mla_up(P, L); BAR(); }
        phase_attn(P, L, 0);
        BAR();
        if (DUP == 3) { phase_attn(P, L, 1); BAR(); }
        if (DUP >= 30 && DUP < 34) { phase_attn(P, L, 1, DUP - 30); BAR(); }
        phase_wo(P, L, cur ^ 1, ss_ffn);
        BAR();
        if (DUP == 4 && L == 0) { phase_wo(P, L, cur ^ 1, ss_ffn); BAR(); }
        phase_pq(P, L, cur ^ 1, ss_ffn);
        BAR();
        if (DUP == 5) { phase_pq(P, L, cur ^ 1, ss_ffn); BAR(); }
        phase_topk(P, L);
        BAR();
        if (DUP == 6) { phase_topk(P, L); BAR(); }
        phase_gather_u(P, L, cur ^ 1);
        BAR();
        if (DUP == 7) { phase_gather_u(P, L, cur ^ 1); BAR(); }
        if (DUP == 10) { phase_gather_act(P, L, ss_ffn, 1); BAR(); }
        phase_gather_act(P, L, ss_ffn);
        BAR();
        if (DUP == 8) { phase_gather_v(P, L, cur, ss_ple, 1); BAR(); }
        phase_gather_v(P, L, cur, ss_ple);
        BAR();
        if (DUP == 9) { phase_ple(P, L, cur, ss_ple, ss_next, 1); BAR(); }
        phase_ple(P, L, cur, ss_ple, ss_next);
        BAR();
        cur ^= 1;
    }
    phase_final(P, 4, cur);
}

extern "C" void kernel_launch(void* const* d_in, const int* in_sizes, int n_in, void* d_out, int out_size, void* d_ws,
                              size_t ws_size, hipStream_t stream) {
    static int grid_blocks = 0;
    if (!grid_blocks) {
        int dev = 0, cus = 0, per_cu = 0;
        hipGetDevice(&dev);
        hipDeviceGetAttribute(&cus, hipDeviceAttributeMultiprocessorCount, dev);
        hipOccupancyMaxActiveBlocksPerMultiprocessor(&per_cu, hymba_megakernel, NTHR, 0);
        if (per_cu > 1) per_cu = 1;
        if (per_cu < 1) per_cu = 1;
        grid_blocks = cus * per_cu;
        if (ws_size < WS_END) fprintf(stderr, "workspace too small: %zu < %zu\n", ws_size, (size_t)WS_END);
    }
    Params P{};
    P.x = (const float*)d_in[0]; P.p = (const float*)d_in[1]; P.pos = (const int*)d_in[2];
    P.norm_mix_g = (const float*)d_in[3]; P.w_in = (const float*)d_in[4]; P.b_forget = (const float*)d_in[5];
    P.mla_q_norm_g = (const float*)d_in[6]; P.w_uq = (const float*)d_in[7]; P.mla_kv_norm_g = (const float*)d_in[8];
    P.w_ukv = (const float*)d_in[9]; P.mix_out_norm_g = (const float*)d_in[10]; P.w_o = (const float*)d_in[11];
    P.norm_ffn_g = (const float*)d_in[12]; P.w_query = (const float*)d_in[13]; P.sub_keys = (const float*)d_in[14];
    P.peer_u = (const float*)d_in[15]; P.peer_v = (const float*)d_in[16]; P.w_ple = (const float*)d_in[17];
    P.ple_norm_g = (const float*)d_in[18]; P.w_ple_gate = (const float*)d_in[19]; P.final_norm_g = (const float*)d_in[20];
    P.out = (float*)d_out; P.ws = (char*)d_ws;
    hipMemsetAsync((char*)d_ws + OFF_BAR, 0, 16384 + 4096, stream);
    void* args[] = {&P};
    hipError_t e = hipLaunchCooperativeKernel((void*)hymba_megakernel, dim3(grid_blocks), dim3(NTHR), args, 0, stream);
    if (e != hipSuccess) fprintf(stderr, "cooperative launch failed: %s (grid %d)\n", hipGetErrorString(e), grid_blocks);
}
```

```cpp
#include <hip/hip_runtime.h>
#include <hip/hip_cooperative_groups.h>
#include <cstdio>
#include <cstdint>
#include <math.h>
#include <climits>
namespace cg = cooperative_groups;

typedef __bf16 bf16;
typedef __bf16 bf16x8 __attribute__((ext_vector_type(8)));
typedef __bf16 bf16x4 __attribute__((ext_vector_type(4)));
typedef __bf16 bf16x2 __attribute__((ext_vector_type(2)));
typedef float f32x16 __attribute__((ext_vector_type(16)));
typedef float f32x4 __attribute__((ext_vector_type(4)));
typedef float f32x2 __attribute__((ext_vector_type(2)));
typedef unsigned u32x4 __attribute__((ext_vector_type(4)));
typedef unsigned u32x2 __attribute__((ext_vector_type(2)));

#define SEQ 2048
#define BATCH 8
#define TOK 16384
#define DM 1024
#define IN_W 1956
#define NEXP 16384
#define EPSF 1e-6f
#define LOG2E 1.4426950408889634f
#define NTHR 512
#define NW 8
#define LDS_BYTES 151808
#define STAGE_BYTES 49152
#define LDS_AUX 147456
#ifndef DUP
#define DUP -1
#endif

constexpr size_t MBy = 1ull << 20;
constexpr size_t OFF_UB = 0;
constexpr size_t OFF_VB = 16 * MBy;
constexpr size_t OFF_PART = 32 * MBy;
constexpr size_t OFF_PW1 = 96 * MBy;
#define LDH 1088
#define LDP 320
#define LDC 192
constexpr size_t OFF_WIN = 128 * MBy;
constexpr size_t OFF_WO = 137 * MBy;
constexpr size_t OFF_WQ = 142 * MBy;
constexpr size_t OFF_WG = 147 * MBy;
constexpr size_t OFF_WP = 152 * MBy;
constexpr size_t OFF_WUQ = 154 * MBy;
constexpr size_t OFF_WUKV = 155 * MBy;
constexpr size_t OFF_SKB = 156 * MBy;
constexpr size_t OFF_CS = 157 * MBy;
constexpr size_t OFF_TSC = 159 * MBy;
constexpr size_t OFF_SSA = 160 * MBy;
constexpr size_t OFF_HB0 = 164 * MBy;
constexpr size_t OFF_HB1 = 200 * MBy;
constexpr size_t OFF_FQ = 236 * MBy;
constexpr size_t OFF_FK = 244 * MBy;
constexpr size_t OFF_FVT = 252 * MBy;
constexpr size_t OFF_SQ = 260 * MBy;
constexpr size_t OFF_SKK = 268 * MBy;
constexpr size_t OFF_SVT = 276 * MBy;
constexpr size_t OFF_CQ = 284 * MBy;
constexpr size_t OFF_CKV = 295 * MBy;
constexpr size_t OFF_FLOG = 302 * MBy;
constexpr size_t OFF_CUMF = 303 * MBy;
constexpr size_t OFF_MQ = 304 * MBy;
constexpr size_t OFF_MK = 316 * MBy;
constexpr size_t OFF_MVT = 328 * MBy;
constexpr size_t OFF_Y = 344 * MBy;
constexpr size_t OFF_PQ = 380 * MBy;
constexpr size_t OFF_IDS = 412 * MBy;
constexpr size_t OFF_GATE = 420 * MBy;
constexpr size_t OFF_BAR = 428 * MBy;
constexpr size_t OFF_CNT = OFF_BAR + 16384;
constexpr size_t OFF_SSY = 429 * MBy;
constexpr size_t OFF_PB = 431 * MBy;
constexpr size_t OFF_PW0 = 452 * MBy;
constexpr size_t OFF_XH = OFF_FQ;
constexpr size_t OFF_XL = OFF_FQ + 16 * MBy;
constexpr size_t WS_END = 484 * MBy;

struct Params {
    const float* x; const float* p; const int* pos;
    const float* norm_mix_g; const float* w_in; const float* b_forget; const float* mla_q_norm_g; const float* w_uq;
    const float* mla_kv_norm_g; const float* w_ukv; const float* mix_out_norm_g; const float* w_o; const float* norm_ffn_g;
    const float* w_query; const float* sub_keys; const float* peer_u; const float* peer_v; const float* w_ple;
    const float* ple_norm_g; const float* w_ple_gate; const float* final_norm_g;
    float* out; char* ws;
};

__shared__ __attribute__((aligned(16))) char smem[LDS_BYTES];

__device__ __forceinline__ int opaque_tid() { int t = threadIdx.x; asm volatile("" : "+v"(t)); return t; }
template <typename T> __device__ __forceinline__ T* opq(T* p) { size_t z = 0; asm volatile("" : "+s"(z)); return (T*)((char*)p + z); }

__device__ __forceinline__ unsigned pack2(float a, float b) {
    f32x2 v = {a, b};
    bf16x2 r = __builtin_convertvector(v, bf16x2);
    return __builtin_bit_cast(unsigned, r);
}
__device__ __forceinline__ float bflo(unsigned u) { return __uint_as_float(u << 16); }
__device__ __forceinline__ float bfhi(unsigned u) { return __uint_as_float(u & 0xffff0000u); }
__device__ __forceinline__ float wave_sum(float v) {
#pragma unroll
    for (int o = 32; o > 0; o >>= 1) v += __shfl_xor(v, o);
    return v;
}
template <int CTRL> __device__ __forceinline__ float dpp_add(float v) {
    return v + __builtin_bit_cast(float, __builtin_amdgcn_update_dpp(0, __builtin_bit_cast(int, v), CTRL, 0xf, 0xf, true));
}
__device__ __forceinline__ float sum8_dpp(float v) { v = dpp_add<0xB1>(v); v = dpp_add<0x4E>(v); v = dpp_add<0x141>(v); return v; }
__device__ __forceinline__ float sumg_dpp(float v) {
    v = dpp_add<0x128>(v);
    float a = v, b = v;
    asm volatile("s_nop 1\n\tv_permlane16_swap_b32 %0, %1\n\ts_nop 1" : "+v"(a), "+v"(b));
    v = a + b;
    a = v; b = v;
    asm volatile("s_nop 1\n\tv_permlane32_swap_b32 %0, %1\n\ts_nop 1" : "+v"(a), "+v"(b));
    return a + b;
}
__device__ __forceinline__ int partner32(int v, int hh) {
    int a = v, b = v;
    asm volatile("s_nop 1\n\tv_permlane32_swap_b32 %0, %1\n\ts_nop 1" : "+v"(a), "+v"(b));
    return hh ? a : b;
}
__device__ __forceinline__ float fexp2(float x) { return __builtin_amdgcn_exp2f(x); }
__device__ __forceinline__ float flog2(float x) { return __builtin_amdgcn_logf(x); }
__device__ __forceinline__ float log_sigmoid_f(float z) { return fminf(z, 0.f) - 0.6931471805599453f * flog2(1.f + fexp2(-1.4426950408889634f * fabsf(z))); }

struct WJob { const float* src; int lds; int K; int Np; bf16* dst; int ldd; const float* gain; int map; };

__device__ __forceinline__ int src_col_map(int map, int c) {
    if (map == 0) return c;
    if (map == 1) {
        if (c < 768) return c;
        if (c < 1952) return c + 4;
        if (c < 1956) return c - 1952 + 768;
        return -1;
    }
    if (c < 256) return 192 * (c >> 6) + (c & 63);
    int e = c - 256;
    return 192 * (e >> 7) + 64 + (e & 127);
}

__device__ __forceinline__ void wconv_tile(const WJob& j, int tile) {
    float* tl = (float*)smem;
    int ktiles = j.K >> 5;
    int nt = tile / ktiles, kt = tile % ktiles;
    int n0 = nt * 32, k0 = kt * 32;
    int tx = opaque_tid() & 31, ty = opaque_tid() >> 5;
    int sc = src_col_map(j.map, n0 + tx);
#pragma unroll
    for (int i = 0; i < 2; ++i) {
        int k = k0 + ty + 16 * i;
        float v = 0.f;
        if (sc >= 0) v = j.src[(size_t)k * j.lds + sc] * (j.gain ? j.gain[k] : 1.f);
        tl[(ty + 16 * i) * 33 + tx] = v;
    }
    __syncthreads();
#pragma unroll
    for (int i = 0; i < 2; ++i) {
        int n = n0 + ty + 16 * i;
        j.dst[(size_t)n * j.ldd + k0 + tx] = (bf16)tl[tx * 33 + ty + 16 * i];
    }
    __syncthreads();
}

__device__ __forceinline__ void phase0(const Params& P) {
    char* ws = opq(P.ws);
    const int G = gridDim.x, bid = blockIdx.x, tid = opaque_tid();
    {
        const int w = tid >> 6, l = tid & 63;
        float* tsc = (float*)(ws + OFF_TSC);
        for (int it = bid * NW + w; it < 4 * NEXP; it += G * NW) {
            int tb = it >> 14, e = it & (NEXP - 1);
            const float* src = (tb < 2 ? P.peer_u : P.peer_v) + ((size_t)(tb & 1) * NEXP + e) * DM + l * 16;
            unsigned char* dst = (unsigned char*)(ws + (tb < 2 ? OFF_UB : OFF_VB)) + (size_t)(tb & 1) * NEXP * 512;
            float4 a = ((const float4*)src)[0], b = ((const float4*)src)[1], c = ((const float4*)src)[2], d = ((const float4*)src)[3];
            if (tb < 2) {
                const float4* g4 = (const float4*)(P.norm_ffn_g + (tb & 1) * 1024 + l * 16);
                float4 g0 = g4[0], g1 = g4[1], g2 = g4[2], g3 = g4[3];
                a.x *= g0.x; a.y *= g0.y; a.z *= g0.z; a.w *= g0.w; b.x *= g1.x; b.y *= g1.y; b.z *= g1.z; b.w *= g1.w;
                c.x *= g2.x; c.y *= g2.y; c.z *= g2.z; c.w *= g2.w; d.x *= g3.x; d.y *= g3.y; d.z *= g3.z; d.w *= g3.w;
            }
            float am = fmaxf(fmaxf(fmaxf(fabsf(a.x), fabsf(a.y)), fmaxf(fabsf(a.z), fabsf(a.w))), fmaxf(fmaxf(fabsf(b.x), fabsf(b.y)), fmaxf(fabsf(b.z), fabsf(b.w))));
            am = fmaxf(am, fmaxf(fmaxf(fmaxf(fabsf(c.x), fabsf(c.y)), fmaxf(fabsf(c.z), fabsf(c.w))), fmaxf(fmaxf(fabsf(d.x), fabsf(d.y)), fmaxf(fabsf(d.z), fabsf(d.w)))));
#pragma unroll
            for (int o = 32; o > 0; o >>= 1) am = fmaxf(am, __shfl_xor(am, o));
            float sc = (am > 0.f) ? (6.0f / am) : 1.f, isc = (am > 0.f) ? (am * (1.f / 6.0f)) : 1.f;
            unsigned w0 = 0, w1 = 0;
            w0 = __builtin_amdgcn_cvt_scalef32_pk_fp4_f32(w0, a.x * sc, a.y * sc, 1.0f, 0);
            w0 = __builtin_amdgcn_cvt_scalef32_pk_fp4_f32(w0, a.z * sc, a.w * sc, 1.0f, 1);
            w0 = __builtin_amdgcn_cvt_scalef32_pk_fp4_f32(w0, b.x * sc, b.y * sc, 1.0f, 2);
            w0 = __builtin_amdgcn_cvt_scalef32_pk_fp4_f32(w0, b.z * sc, b.w * sc, 1.0f, 3);
            w1 = __builtin_amdgcn_cvt_scalef32_pk_fp4_f32(w1, c.x * sc, c.y * sc, 1.0f, 0);
            w1 = __builtin_amdgcn_cvt_scalef32_pk_fp4_f32(w1, c.z * sc, c.w * sc, 1.0f, 1);
            w1 = __builtin_amdgcn_cvt_scalef32_pk_fp4_f32(w1, d.x * sc, d.y * sc, 1.0f, 2);
            w1 = __builtin_amdgcn_cvt_scalef32_pk_fp4_f32(w1, d.z * sc, d.w * sc, 1.0f, 3);
            u32x2 o2 = {w0, w1};
            *(u32x2*)(dst + ((size_t)(l >> 4) * NEXP + e) * 128 + (l & 15) * 8) = o2;
            if (l == 0) tsc[tb * NEXP + e] = isc;
        }
    }
    {
        for (int L = 0; L < 2; ++L) {
            WJob jobs[7];
            jobs[0] = {P.w_in + (size_t)L * 1024 * IN_W, IN_W, 1024, 2048, (bf16*)(ws + OFF_WIN) + (size_t)L * 2048 * LDH, LDH, P.norm_mix_g + L * 1024, 1};
            jobs[1] = {P.w_o + (size_t)L * 1024 * 1024, 1024, 1024, 1024, (bf16*)(ws + OFF_WO) + (size_t)L * 1024 * LDH, LDH, P.mix_out_norm_g + L * 1024, 0};
            jobs[2] = {P.w_query + (size_t)L * 1024 * 1024, 1024, 1024, 1024, (bf16*)(ws + OFF_WQ) + (size_t)L * 1024 * LDH, LDH, P.norm_ffn_g + L * 1024, 0};
            jobs[3] = {P.w_ple_gate + (size_t)L * 1024 * 1024, 1024, 1024, 1024, (bf16*)(ws + OFF_WG) + (size_t)L * 1024 * LDH, LDH, P.ple_norm_g + L * 1024, 0};
            jobs[4] = {P.w_ple + (size_t)L * 256 * 1024, 1024, 256, 1024, (bf16*)(ws + OFF_WP) + (size_t)L * 1024 * LDP, LDP, nullptr, 0};
            jobs[5] = {P.w_uq + (size_t)L * 256 * 384, 384, 256, 384, (bf16*)(ws + OFF_WUQ) + (size_t)L * 384 * LDP, LDP, P.mla_q_norm_g + L * 256, 0};
            jobs[6] = {P.w_ukv + (size_t)L * 128 * 768, 768, 128, 768, (bf16*)(ws + OFF_WUKV) + (size_t)L * 768 * LDC, LDC, P.mla_kv_norm_g + L * 128, 2};
#pragma unroll
            for (int q = 0; q < 7; ++q) {
                int nt = (jobs[q].Np >> 5) * (jobs[q].K >> 5);
                for (int it = bid; it < nt; it += G) wconv_tile(jobs[q], it);
            }
        }
    }
    {
        const float* src = P.sub_keys;
        bf16* dst = (bf16*)(ws + OFF_SKB);
        for (int i = bid * NTHR + tid; i < 262144 / 2; i += G * NTHR) {
            float2 v = ((const float2*)src)[i];
            ((unsigned*)dst)[i] = pack2(v.x, v.y);
        }
    }
    {
        const float4* src = (const float4*)P.p;
        bf16* dst = (bf16*)(ws + OFF_PB);
        for (int i = bid * NTHR + tid; i < 2 * TOK * 256 / 8; i += G * NTHR) {
            float4 a = src[2 * i], b = src[2 * i + 1];
            u32x4 o = {pack2(a.x, a.y), pack2(a.z, a.w), pack2(b.x, b.y), pack2(b.z, b.w)};
            *(u32x4*)(dst + (size_t)(i >> 5) * LDP + (i & 31) * 8) = o;
        }
    }
    {
        bf16* hb = (bf16*)(ws + OFF_HB0);
        float* ss0 = (float*)(ws + OFF_SSA);
        int w = tid >> 6, l = tid & 63;
        for (int row = bid * NW + w; row < TOK; row += G * NW) {
            const float4* xr = (const float4*)(P.x + (size_t)row * DM);
            float ss = 0.f;
#pragma unroll
            for (int i = 0; i < 2; ++i) {
                float4 a = xr[i * 128 + l * 2], b = xr[i * 128 + l * 2 + 1];
                ss += a.x * a.x + a.y * a.y + a.z * a.z + a.w * a.w + b.x * b.x + b.y * b.y + b.z * b.z + b.w * b.w;
                uint4 o;
                o.x = pack2(a.x, a.y); o.y = pack2(a.z, a.w); o.z = pack2(b.x, b.y); o.w = pack2(b.z, b.w);
                ((uint4*)(hb + (size_t)row * LDH))[i * 64 + l] = o;
            }
            ss = wave_sum(ss);
            if (l == 0) {
                *(float4*)(ss0 + (size_t)row * 8) = make_float4(ss, 0.f, 0.f, 0.f);
                *(float4*)(ss0 + (size_t)row * 8 + 4) = make_float4(0.f, 0.f, 0.f, 0.f);
            }
        }
    }
    {
        float* cs = (float*)(ws + OFF_CS);
        for (int i = bid * NTHR + tid; i < TOK * 16; i += G * NTHR) {
            int t = i >> 4, k = i & 15;
            float inv = powf(10000.0f, -(float)k / 16.0f);
            float ang = (float)P.pos[t] * inv;
            cs[2 * i] = cosf(ang);
            cs[2 * i + 1] = sinf(ang);
        }
    }
}

struct NoHook { static constexpr bool nodma = false; __device__ __forceinline__ void operator()(int, f32x16 (&)[2][2]) const {} };
struct NoDmaHook { static constexpr bool nodma = true; __device__ __forceinline__ void operator()(int, f32x16 (&)[2][2]) const {} };
template <typename HOOK>
__device__ __forceinline__ void gemm_core(f32x16 (&acc)[2][2], const bf16* A, int lda, const bf16* Bt, int ldb, int K,
                                          int m0, int n0, HOOK hook) {
    const int tid = opaque_tid(), w = tid >> 6, l = tid & 63, r = l & 31, hh = l >> 5;
    const int wm = w >> 1, wn = w & 1;
    const int dp = (tid & 15) ^ ((tid >> 4) & 15);
    const int drow = 2 * (tid >> 4) + (dp >> 3), dgc = (dp & 7) * 8;
    const bf16* asrc = A + (size_t)(m0 + drow) * lda + dgc;
    const bf16* bsrc = Bt + (size_t)(n0 + drow) * ldb + dgc;
    auto dma = [&](int buf, int k0) {
        if (HOOK::nodma) return;
        char* base = smem + buf * STAGE_BYTES + tid * 16;
#pragma unroll
        for (int i = 0; i < 4; ++i)
            __builtin_amdgcn_global_load_lds((const unsigned*)(asrc + (size_t)(64 * i) * lda + k0), (unsigned*)(base + i * 8192), 16, 0, 0);
#pragma unroll
        for (int i = 0; i < 2; ++i)
            __builtin_amdgcn_global_load_lds((const unsigned*)(bsrc + (size_t)(64 * i) * ldb + k0), (unsigned*)(base + 32768 + i * 8192), 16, 0, 0);
    };
    int offA[2], offB[2];
#pragma unroll
    for (int i = 0; i < 2; ++i) { offA[i] = ((wm * 64 + i * 32 + r) >> 1) * 256; offB[i] = 32768 + ((wn * 64 + i * 32 + r) >> 1) * 256; }
    const int pbase = ((r & 1) << 3), lx = (r >> 1) & 15;
    const int nk = K >> 6;
    const unsigned ldsbase = (unsigned)(size_t)(__attribute__((address_space(3))) char*)smem;
    auto ldfrag = [&](int stage, int s, bf16x8 (&af)[2], bf16x8 (&bfr)[2]) {
        unsigned ch = (unsigned)((((pbase | (2 * s + hh)) ^ lx) << 4)) + ldsbase + (unsigned)(stage * STAGE_BYTES);
        unsigned a0a = ch + offA[0], a1a = ch + offA[1], b0a = ch + offB[0], b1a = ch + offB[1];
        asm volatile("ds_read_b128 %0, %4\n\tds_read_b128 %1, %5\n\tds_read_b128 %2, %6\n\tds_read_b128 %3, %7"
                     : "=&v"(af[0]), "=&v"(af[1]), "=&v"(bfr[0]), "=&v"(bfr[1]) : "v"(a0a), "v"(a1a), "v"(b0a), "v"(b1a) : "memory");
    };
    auto mma = [&](bf16x8 (&af)[2], bf16x8 (&bfr)[2]) {
#pragma unroll
        for (int i = 0; i < 2; ++i)
#pragma unroll
            for (int j = 0; j < 2; ++j) acc[i][j] = __builtin_amdgcn_mfma_f32_32x32x16_bf16(af[i], bfr[j], acc[i][j], 0, 0, 0);
    };
#define LGKM_WAIT(n) do { asm volatile("s_waitcnt lgkmcnt(" #n ")" ::: "memory"); __builtin_amdgcn_sched_barrier(0); } while (0)
    asm volatile("s_waitcnt vmcnt(0)" ::: "memory");
    dma(0, 0);
    dma(1, 64);
    if (nk > 2) { dma(2, 128); asm volatile("s_waitcnt vmcnt(12)" ::: "memory"); }
    else asm volatile("s_waitcnt vmcnt(6)" ::: "memory");
    __builtin_amdgcn_s_barrier();
    bf16x8 a0[2], b0[2], a1[2], b1[2];
    ldfrag(0, 0, a0, b0);
    int cur = 0;
    for (int kt = 0; kt < nk; ++kt) {
        const int nxt = (cur == 2) ? 0 : cur + 1;
        if (kt == 4 || kt == 8) { LGKM_WAIT(0); hook(kt, acc); }
        ldfrag(cur, 1, a1, b1);
        LGKM_WAIT(4);
        mma(a0, b0);
        ldfrag(cur, 2, a0, b0);
        LGKM_WAIT(4);
        mma(a1, b1);
        ldfrag(cur, 3, a1, b1);
        LGKM_WAIT(4);
        mma(a0, b0);
        if (kt + 1 < nk) {
            if (kt + 2 < nk) asm volatile("s_waitcnt vmcnt(6) lgkmcnt(0)" ::: "memory");
            else asm volatile("s_waitcnt vmcnt(0) lgkmcnt(0)" ::: "memory");
            __builtin_amdgcn_s_barrier();
            __builtin_amdgcn_sched_barrier(0);
            if (kt + 3 < nk) dma(cur, (kt + 3) << 6);
            ldfrag(nxt, 0, a0, b0);
        } else {
            LGKM_WAIT(0);
        }
        mma(a1, b1);
        cur = nxt;
    }
    __syncthreads();
}
__device__ __forceinline__ float row_rs8(const float* part, int row) {
    float4 a = *(const float4*)(part + (size_t)row * 8), b = *(const float4*)(part + (size_t)row * 8 + 4);
    float ss = ((a.x + a.y) + (a.z + a.w)) + ((b.x + b.y) + (b.z + b.w));
    return rsqrtf(ss * (1.f / 1024.f) + EPSF);
}
__device__ __forceinline__ bool xcd_tile(int it, int MT, int NT, int& mt, int& nt) {
    const int G = gridDim.x, bid = blockIdx.x;
    if ((G & 7) == 0 && (MT & 7) == 0) {
        const int nbx = G >> 3, q = (bid >> 3) + it * nbx, per = (MT >> 3) * NT;
        if (q >= per) return false;
        mt = (bid & 7) * (MT >> 3) + q / NT; nt = q % NT;
        return true;
    }
    const int q = bid + it * G;
    if (q >= MT * NT) return false;
    mt = q / NT; nt = q % NT;
    return true;
}
struct NoScale { __device__ __forceinline__ float operator()(int, int) const { return 1.f; } };

#define ZERO_ACC(acc)                                  \
    _Pragma("unroll") for (int _i = 0; _i < 2; ++_i)   \
    _Pragma("unroll") for (int _j = 0; _j < 2; ++_j)   \
    _Pragma("unroll") for (int _r = 0; _r < 16; ++_r) acc[_i][_j][_r] = 0.f;


namespace pg8 {
#define PG8_LAS __attribute__((address_space(3)))
typedef unsigned short bf16_t;
constexpr int BM = 256, BK = 64, HALF = 128, HTB = HALF * BK * 2  , NXCD = 8, WGM = 8;

__host__ __device__ __forceinline__ int lds_byte(int r, int c) { const int st = (r >> 4) * 2 + (c >> 5), rr = r & 15, cc = c & 31, ob = rr * 64 + cc * 2; return st * 1024 + (ob ^ (((ob >> 9) & 1) << 5)); }
__host__ __device__ __forceinline__ void stage_rc(int b, int& R, int& C) { const int st = b / 1024, sb = b % 1024, swz = sb ^ (((sb >> 9) & 1) << 5); R = (st >> 1) * 16 + swz / 64; C = (st & 1) * 32 + (swz % 64) / 2; }
__host__ __device__ __forceinline__ int perm32(int rho) { const int n = rho >> 4, i = rho & 15; return 8 * (i >> 2) + 4 * n + (i & 3); }
struct Unit { int pm, pn; };
struct Gemm { const bf16* A; const bf16* Bt; int lda, ldb, M, N, K; };
struct StaticOrder {
    int nM, nN, nwg, G, c;
    __device__ void init(int M, int N, int G_, int c_) { nM = M / BM; nN = N / BM; nwg = nM * nN; G = G_; c = c_; }
    __device__ bool next(int i, Unit& u) const {
        const long L = (long)i * G + c; if (L >= nwg) return false;
        int wgid = (int)L; { const int q = nwg / NXCD, r = nwg % NXCD, xcd = wgid % NXCD, off = wgid / NXCD; wgid = (xcd < r ? xcd * (q + 1) : r * (q + 1) + (xcd - r) * q) + off; }
        const int nig = WGM * nN, gid = wgid / nig, fm = gid * WGM, gsz = (nM - fm) < WGM ? (nM - fm) : WGM;
        u.pm = fm + ((wgid % nig) % gsz); u.pn = (wgid % nig) / gsz; return true;
    }
    __device__ __forceinline__ void a_ready(const Unit&) const {}
    __device__ __forceinline__ void done(const Unit&) const {}
};
template <class Epi, class Sched, bool STAMP = false>
__device__ __forceinline__ void gemm_phase(PG8_LAS unsigned char* lds, const Gemm g, const Sched& S, const Epi& E, unsigned long long* stamps) {
    const int tid = opaque_tid(), wid = __builtin_amdgcn_readfirstlane(tid >> 6), lane = tid & 63, wr = wid >> 2, wc = wid & 3, fr = lane & 15, fq = lane >> 4;
    const int K = g.K, nt = K / BK;
    int ts_lo = 0, ts_hi = 0, nts = 0; const unsigned long long rt_entry = STAMP ? (unsigned long long)wall_clock64() : 0ull;
#define PG8_STAMP() do { if (STAMP && wid == 0 && nts < 64) { const unsigned long long _c = (unsigned long long)clock64(); \
        ts_lo = (lane == nts) ? (int)(unsigned)_c : ts_lo; ts_hi = (lane == nts) ? (int)(unsigned)(_c >> 32) : ts_hi; ++nts; } } while (0)
    PG8_STAMP();
    unsigned voffA[2], voffB[2];
#pragma unroll
    for (int i = 0; i < 2; ++i) { int R, C; stage_rc(tid * 16 + i * 8192, R, C); const int Rb = Epi::PERM ? ((R & ~31) + perm32(R & 31)) : R;
        voffA[i] = (unsigned)(R * g.lda + C) * 2u; voffB[i] = (unsigned)(Rb * g.ldb + C) * 2u; }
    const size_t kstep = (size_t)(BK * 2);
    const size_t hstepA = (size_t)HALF * g.lda * 2, hstepB = (size_t)HALF * g.ldb * 2;
    const size_t tstepA = 2 * hstepA, tstepB = 2 * hstepB;
    const unsigned ldsw = (unsigned)wid * 1024u;
    const int aoff = lds_byte(wr * 64 + fr, fq * 8), boff = lds_byte(wc * 32 + fr, fq * 8);
#define PG8_SA(b, h) (((b) * 2 + (h)) * HTB)
#define PG8_SB(b, h) ((4 + (b) * 2 + (h)) * HTB)
#define PG8_STAGE(bufoff, gbase, voff) do { _Pragma("unroll") for (int _i = 0; _i < 2; ++_i) \
        __builtin_amdgcn_global_load_lds((const unsigned*)((const char*)(gbase) + (voff)[_i]), (PG8_LAS unsigned*)(lds + (bufoff) + ldsw + _i * 8192), 16, 0, 0); } while (0)
#define PG8_LDA(dst, b, h) do { _Pragma("unroll") for (int m = 0; m < 4; ++m) _Pragma("unroll") for (int k = 0; k < 2; ++k) dst[m][k] = *(const PG8_LAS bf16x8*)(lds + PG8_SA(b, h) + aoff + m * 2048 + k * 1024); } while (0)
#define PG8_LDB(dst, b, h) do { _Pragma("unroll") for (int n = 0; n < 2; ++n) _Pragma("unroll") for (int k = 0; k < 2; ++k) dst[n][k] = *(const PG8_LAS bf16x8*)(lds + PG8_SB(b, h) + boff + n * 2048 + k * 1024); } while (0)
#define PG8_MMA(ai, bj, At, Bt) do { __builtin_amdgcn_s_setprio(1); _Pragma("unroll") for (int m = 0; m < 4; ++m) _Pragma("unroll") for (int n = 0; n < 2; ++n) _Pragma("unroll") for (int k = 0; k < 2; ++k) \
        acc[ai][bj][m][n] = __builtin_amdgcn_mfma_f32_16x16x32_bf16(Bt[n][k], At[m][k], acc[ai][bj][m][n], 0, 0, 0); __builtin_amdgcn_s_setprio(0); } while (0)
#define PG8_WAIT_V(n) asm volatile("s_waitcnt vmcnt(" #n ")" ::: "memory")
#define PG8_WAIT_L(n) asm volatile("s_waitcnt lgkmcnt(" #n ")" ::: "memory")
#define PG8_BAR __builtin_amdgcn_s_barrier()
#define PG8_SCHED __builtin_amdgcn_sched_barrier(0)
    Unit cur, nxt; int ui = 0;
    if (!S.next(0, cur)) return;
    f32x4 acc[2][2][4][2];
#pragma unroll
    for (int a = 0; a < 2; ++a)
#pragma unroll
        for (int b = 0; b < 2; ++b)
#pragma unroll
            for (int m = 0; m < 4; ++m)
#pragma unroll
                for (int n = 0; n < 2; ++n) acc[a][b][m][n] = (f32x4){0.f, 0.f, 0.f, 0.f};
    bf16x8 At[4][2], B0[2][2], B1[2][2];
    const char* cA = (const char*)g.A + (size_t)cur.pm * tstepA; const char* cB = (const char*)g.Bt + (size_t)cur.pn * tstepB;
    S.a_ready(cur);
    PG8_STAGE(PG8_SB(0, 0), cB, voffB); PG8_STAGE(PG8_SA(0, 0), cA, voffA); PG8_STAGE(PG8_SB(0, 1), cB + hstepB, voffB); PG8_STAGE(PG8_SA(0, 1), cA + hstepA, voffA);
    if (wr == 1) PG8_BAR;
    PG8_WAIT_V(4); PG8_BAR;
    PG8_STAGE(PG8_SB(1, 0), cB + kstep, voffB); PG8_STAGE(PG8_SA(1, 0), cA + kstep, voffA); PG8_STAGE(PG8_SB(1, 1), cB + hstepB + kstep, voffB);
    PG8_WAIT_V(6); PG8_BAR;
    PG8_STAMP();
    for (;;) {
        const bool has_next = S.next(ui + 1, nxt);
        const char* nA = has_next ? (const char*)g.A + (size_t)nxt.pm * tstepA : cA; const char* nB = has_next ? (const char*)g.Bt + (size_t)nxt.pn * tstepB : cB;
        for (int t = 0; t < nt; t += 2) {
            const bool last = (t == nt - 2);
            const char* a1 = cA + (size_t)(t + 1) * kstep;
            const char* a2 = last ? nA : cA + (size_t)(t + 2) * kstep; const char* b2 = last ? nB : cB + (size_t)(t + 2) * kstep;
            const char* a3 = a2 + kstep; const char* b3 = b2 + kstep;
            if (last && has_next) S.a_ready(nxt);
            E.khook(t, acc, wr, fr);
            PG8_LDB(B0, 0, 0); PG8_SCHED; PG8_LDA(At, 0, 0); PG8_STAGE(PG8_SA(1, 1), a1 + hstepA, voffA);
            PG8_WAIT_L(8); PG8_BAR; PG8_WAIT_L(0); PG8_MMA(0, 0, At, B0); PG8_BAR; PG8_SCHED;
            PG8_LDB(B1, 0, 1); PG8_STAGE(PG8_SB(0, 0), b2, voffB);
            PG8_BAR; PG8_WAIT_L(0); PG8_MMA(0, 1, At, B1); PG8_BAR;
            PG8_LDA(At, 0, 1); PG8_STAGE(PG8_SA(0, 0), a2, voffA);
            PG8_BAR; PG8_WAIT_L(0); PG8_MMA(1, 0, At, B0); PG8_BAR; PG8_SCHED;
            PG8_STAGE(PG8_SB(0, 1), b2 + hstepB, voffB);
            PG8_WAIT_V(6); PG8_BAR; PG8_MMA(1, 1, At, B1); PG8_BAR;
            PG8_LDB(B0, 1, 0); PG8_SCHED; PG8_LDA(At, 1, 0); PG8_STAGE(PG8_SA(0, 1), a2 + hstepA, voffA);
            PG8_WAIT_L(8); PG8_BAR; PG8_WAIT_L(0); PG8_MMA(0, 0, At, B0); PG8_BAR; PG8_SCHED;
            PG8_LDB(B1, 1, 1); PG8_STAGE(PG8_SB(1, 0), b3, voffB);
            PG8_BAR; PG8_WAIT_L(0); PG8_MMA(0, 1, At, B1); PG8_BAR;
            PG8_LDA(At, 1, 1); PG8_STAGE(PG8_SA(1, 0), a3, voffA);
            PG8_BAR; PG8_WAIT_L(0); PG8_MMA(1, 0, At, B0); PG8_BAR; PG8_SCHED;
            PG8_STAGE(PG8_SB(1, 1), b3 + hstepB, voffB);
            PG8_WAIT_V(6); PG8_BAR; PG8_MMA(1, 1, At, B1); PG8_BAR;
        }
        PG8_STAMP();
        if constexpr (!Epi::AFTER_DRAIN) { E(acc, cur, wr, wc, fr, fq); S.done(cur); }
        PG8_STAMP();
        if (!has_next) break;
#pragma unroll
        for (int a = 0; a < 2; ++a)
#pragma unroll
            for (int b = 0; b < 2; ++b)
#pragma unroll
                for (int m = 0; m < 4; ++m)
#pragma unroll
                    for (int n = 0; n < 2; ++n) acc[a][b][m][n] = (f32x4){0.f, 0.f, 0.f, 0.f};
        cur = nxt; cA = nA; cB = nB; ++ui;
    }
    PG8_WAIT_V(0);
    if (wr == 0) PG8_BAR;
    PG8_BAR;
    if constexpr (Epi::AFTER_DRAIN) { E.fused(acc, cur, wr, wc, fr, fq, lds, wid, lane); S.done(cur); }
    PG8_STAMP();
    if (STAMP && wid == 0) { stamps[lane] = lane < nts ? (((unsigned long long)(unsigned)ts_hi << 32) | (unsigned)ts_lo) : 0ull;
        if (lane == 62) stamps[62] = rt_entry; if (lane == 63) stamps[63] = (unsigned long long)wall_clock64(); }
#undef PG8_STAMP
#undef PG8_SA
#undef PG8_SB
#undef PG8_STAGE
#undef PG8_LDA
#undef PG8_LDB
#undef PG8_MMA
#undef PG8_WAIT_V
#undef PG8_WAIT_L
#undef PG8_BAR
#undef PG8_SCHED
}
}

#define TB_LD 136
#define TF_LD 132
template <bool SCALE>
__device__ __forceinline__ void stage_bf16(const f32x16 (&acc)[2][2], const float* rsl) {
    bf16* T = (bf16*)smem;
    const int tid = opaque_tid(), w = tid >> 6, l = tid & 63, hh = l >> 5, wm = w >> 1, wn = w & 1;
#pragma unroll
    for (int i = 0; i < 2; ++i)
#pragma unroll
        for (int rr = 0; rr < 16; ++rr) {
            int row = wm * 64 + i * 32 + (rr & 3) + 8 * (rr >> 2) + 4 * hh;
            float sc = SCALE ? rsl[row] : 1.f;
#pragma unroll
            for (int j = 0; j < 2; ++j) T[row * TB_LD + wn * 64 + j * 32 + (l & 31)] = (bf16)(acc[i][j][rr] * sc);
        }
    __syncthreads();
}
template <bool SCALE>
__device__ __forceinline__ void stage_f32(const f32x16 (&acc)[2][2], const float* rsl) {
    float* T = (float*)smem;
    const int tid = opaque_tid(), w = tid >> 6, l = tid & 63, hh = l >> 5, wm = w >> 1, wn = w & 1;
#pragma unroll
    for (int i = 0; i < 2; ++i)
#pragma unroll
        for (int rr = 0; rr < 16; ++rr) {
            int row = wm * 64 + i * 32 + (rr & 3) + 8 * (rr >> 2) + 4 * hh;
            float sc = SCALE ? rsl[row] : 1.f;
#pragma unroll
            for (int j = 0; j < 2; ++j) T[row * TF_LD + wn * 64 + j * 32 + (l & 31)] = acc[i][j][rr] * sc;
        }
    __syncthreads();
}
template <typename CMAP>
__device__ __forceinline__ void store_rows_bf16(bf16* dst, int ld, int m0, CMAP cmap) {
    const bf16* T = (const bf16*)smem;
    const int tid = opaque_tid();
#pragma unroll
    for (int q = 0; q < 8; ++q) {
        int id = tid + 512 * q, row = id >> 4, ch = id & 15;
        u32x4 v = *(const u32x4*)(T + row * TB_LD + ch * 8);
        *(u32x4*)(dst + (size_t)(m0 + row) * ld + cmap(ch * 8)) = v;
    }
}
__device__ __forceinline__ void store_cols_bf16(bf16* vt, size_t crow0, int s0) {
    const unsigned short* T = (const unsigned short*)smem;
    const int tid = opaque_tid();
#pragma unroll
    for (int q = 0; q < 8; ++q) {
        int id = tid + 512 * q, c = id & 127, sg = id >> 7;
        unsigned e[8];
#pragma unroll
        for (int k = 0; k < 8; ++k) e[k] = T[(8 * sg + k) * TB_LD + c];
        u32x4 v = {e[0] | (e[1] << 16), e[2] | (e[3] << 16), e[4] | (e[5] << 16), e[6] | (e[7] << 16)};
        *(u32x4*)(vt + (crow0 + c) * SEQ + s0 + 8 * sg) = v;
    }
}
__device__ __forceinline__ void residual_store(const float* hin, float* hout, bf16* hb_out, float* gss, int m0, int n0, int nt) {
    const float* T = (const float*)smem;
    const int tid = opaque_tid(), l = tid & 63;
#pragma unroll 4
    for (int q = 0; q < 16; ++q) {
        int id = tid + 512 * q, row = id >> 5, ch = id & 31;
        f32x4 d = *(const f32x4*)(T + row * TF_LD + ch * 4);
        size_t gi = (size_t)(m0 + row) * 1024 + n0 + ch * 4;
        f32x4 h = *(const f32x4*)(hin + gi);
        f32x4 v = h + d;
        *(f32x4*)(hout + gi) = v;
        u32x2 b = {pack2(v.x, v.y), pack2(v.z, v.w)};
        *(u32x2*)(hb_out + (size_t)(m0 + row) * LDH + n0 + ch * 4) = b;
        float ss = v.x * v.x + v.y * v.y + v.z * v.z + v.w * v.w;
        ss = dpp_add<0xB1>(ss); ss = dpp_add<0x4E>(ss); ss = dpp_add<0x141>(ss); ss = dpp_add<0x140>(ss);
        ss += __shfl_xor(ss, 16);
        if ((l & 31) == 0) gss[(size_t)(m0 + row) * 8 + nt] = ss;
    }
}
struct ColAdd { int off; __device__ __forceinline__ int operator()(int c) const { return c + off; } };
struct ColHead96 { __device__ __forceinline__ int operator()(int c) const { return (c >> 6) * 96 + (c & 63); } };

struct EpiProj {
    static constexpr bool PERM = true, AFTER_DRAIN = false;
    const float* ssrow; char* ws;
    __device__ __forceinline__ void khook(int, f32x4 (&)[2][2][4][2], int, int) const {}
    __device__ __forceinline__ void operator()(const f32x4 (&acc)[2][2][4][2], const pg8::Unit& u, int wr, int wc, int fr, int fqd) const {
        const int row0 = u.pm * 256 + wr * 64 + fr, lc0 = wc * 32 + 8 * fqd, pn = u.pn;
        size_t doff; int ld = 256;
        if (pn == 0) doff = OFF_FQ; else if (pn == 1) doff = OFF_FK; else if (pn == 2) doff = OFF_PART;
        else if (pn == 3) doff = OFF_SQ; else if (pn == 4) doff = OFF_SKK; else if (pn == 5) doff = OFF_PART + 8 * MBy;
        else if (pn == 6) { doff = OFF_CQ; ld = LDP; } else { doff = OFF_CKV; ld = LDC; }
        bf16* dst = (bf16*)(ws + doff);
        bf16* mk = (bf16*)(ws + OFF_MK); float* flog = (float*)(ws + OFF_FLOG); const float* cs = (const float*)(ws + OFF_CS);
#pragma unroll
        for (int ai = 0; ai < 2; ++ai)
#pragma unroll
            for (int m = 0; m < 4; ++m) {
                const int row = row0 + ai * 128 + m * 16;
                const float rs = row_rs8(ssrow, row);
#pragma unroll
                for (int bj = 0; bj < 2; ++bj) {
                    f32x4 v0 = acc[ai][bj][m][0] * rs, v1 = acc[ai][bj][m][1] * rs;
                    if (pn < 7 || bj == 0) {
                        u32x4 wv = {pack2(v0[0], v0[1]), pack2(v0[2], v0[3]), pack2(v1[0], v1[1]), pack2(v1[2], v1[3])};
                        *(u32x4*)(dst + (size_t)row * ld + bj * 128 + lc0) = wv;
                    } else if (wc == 0) {
                        const int hh = fqd >> 1, pi = 8 * (fqd & 1);
                        float vv[8] = {v0[0], v0[1], v0[2], v0[3], v1[0], v1[1], v1[2], v1[3]}, ov[8];
                        const f32x4* c4 = (const f32x4*)(cs + ((size_t)row * 16 + pi) * 2);
                        f32x4 t0 = c4[0], t1 = c4[1], t2 = c4[2], t3 = c4[3];
                        float cc[8] = {t0.x, t0.z, t1.x, t1.z, t2.x, t2.z, t3.x, t3.z}, sn[8] = {t0.y, t0.w, t1.y, t1.w, t2.y, t2.w, t3.y, t3.w};
#pragma unroll
                        for (int e = 0; e < 8; ++e) {
                            float pv = __builtin_bit_cast(float, partner32(__builtin_bit_cast(int, vv[e]), hh));
                            ov[e] = hh ? (pv * sn[e] + vv[e] * cc[e]) : (vv[e] * cc[e] - pv * sn[e]);
                        }
                        u32x4 wv = {pack2(ov[0], ov[1]), pack2(ov[2], ov[3]), pack2(ov[4], ov[5]), pack2(ov[6], ov[7])};
#pragma unroll
                        for (int h = 0; h < 4; ++h) *(u32x4*)(mk + (size_t)row * 384 + h * 96 + 64 + 8 * fqd) = wv;
                    } else if (wc == 1 && fqd == 0) {
                        *(f32x4*)(flog + (size_t)row * 4) = v0;
                    }
                }
            }
    }
};
__device__ __forceinline__ void phase_proj(const Params& P, int L, int hsel, int ss_slot) {
    char* ws = opq(P.ws);
    const float* ssrow = (const float*)(ws + OFF_SSA) + (size_t)ss_slot * TOK * 8;
    const bf16* hb = (const bf16*)(ws + (hsel ? OFF_HB1 : OFF_HB0));
    const bf16* Bt = (const bf16*)(ws + OFF_WIN) + (size_t)L * 2048 * LDH;
    pg8::Gemm g{hb, Bt, LDH, LDH, TOK, 2048, 1024};
    pg8::StaticOrder S; S.init(TOK, 2048, gridDim.x, blockIdx.x);
    EpiProj E{ssrow, ws};
    pg8::gemm_phase((PG8_LAS unsigned char*)smem, g, S, E, nullptr);
    __syncthreads();
}

template <int KW>
__device__ __forceinline__ void row_rms_to_lds(const bf16* A, int lda, int m0) {
    const int tid = opaque_tid(), row = tid >> 1, half = tid & 1;
    float ss = 0.f;
    const u32x4* p = (const u32x4*)(A + (size_t)(m0 + row) * lda + half * (KW / 2));
#pragma unroll
    for (int q = 0; q < KW / 16; ++q) {
        u32x4 v = p[q];
        float a;
        a = bflo(v.x); ss += a * a; a = bfhi(v.x); ss += a * a;
        a = bflo(v.y); ss += a * a; a = bfhi(v.y); ss += a * a;
        a = bflo(v.z); ss += a * a; a = bfhi(v.z); ss += a * a;
        a = bflo(v.w); ss += a * a; a = bfhi(v.w); ss += a * a;
    }
    ss += __shfl_xor(ss, 1);
    if (half == 0) ((float*)(smem + LDS_AUX))[row] = rsqrtf(ss * (1.f / (float)KW) + EPSF);
}

__device__ __forceinline__ void phase_mla_up(const Params& P, int L) {
    char* ws = opq(P.ws);
    const bf16* cq = (const bf16*)(ws + OFF_CQ); const bf16* ckv = (const bf16*)(ws + OFF_CKV);
    const bf16* wuq = (const bf16*)(ws + OFF_WUQ) + (size_t)L * 384 * LDP;
    const bf16* wukv = (const bf16*)(ws + OFF_WUKV) + (size_t)L * 768 * LDC;
    bf16* mq = (bf16*)(ws + OFF_MQ); bf16* mk = (bf16*)(ws + OFF_MK); bf16* mvt = (bf16*)(ws + OFF_MVT);
    const float* cs = (const float*)(ws + OFF_CS);
    const float* flog = (const float*)(ws + OFF_FLOG);
    float* cumF = (float*)(ws + OFF_CUMF);
    const int tid = opaque_tid(), w = tid >> 6, l = tid & 63, hh = l >> 5, wm = w >> 1, wn = w & 1;
    const int NQ = 64 * 3, NKV = 64 * 6, NCF = 4;
    const float* aux = (const float*)(smem + LDS_AUX);
    for (int gw = blockIdx.x * NW + w; gw < 2048; gw += gridDim.x * NW) {
        const int type = gw >> 10, bh = (gw >> 5) & 31, tb = gw & 31, b = bh >> 2, h = bh & 3;
        const bf16* src = (const bf16*)(ws + OFF_PART + (type ? 8 * MBy : 0)) + ((size_t)(b * SEQ + tb * 64 + l) * 256 + h * 64);
        unsigned short* dst = (unsigned short*)(ws + (type ? OFF_SVT : OFF_FVT)) + (size_t)bh * 64 * SEQ + tb * 64 + l;
        u32x4 rv8[8];
#pragma unroll
        for (int q = 0; q < 8; ++q) rv8[q] = ((const u32x4*)src)[q];
#pragma unroll
        for (int q = 0; q < 8; ++q) {
            dst[(size_t)(8 * q + 0) * SEQ] = (unsigned short)(rv8[q].x & 0xffffu); dst[(size_t)(8 * q + 1) * SEQ] = (unsigned short)(rv8[q].x >> 16);
            dst[(size_t)(8 * q + 2) * SEQ] = (unsigned short)(rv8[q].y & 0xffffu); dst[(size_t)(8 * q + 3) * SEQ] = (unsigned short)(rv8[q].y >> 16);
            dst[(size_t)(8 * q + 4) * SEQ] = (unsigned short)(rv8[q].z & 0xffffu); dst[(size_t)(8 * q + 5) * SEQ] = (unsigned short)(rv8[q].z >> 16);
            dst[(size_t)(8 * q + 6) * SEQ] = (unsigned short)(rv8[q].w & 0xffffu); dst[(size_t)(8 * q + 7) * SEQ] = (unsigned short)(rv8[q].w >> 16);
        }
    }
    for (int item = blockIdx.x; item < NQ + NKV + NCF; item += gridDim.x) {
        if (item < NQ) {
            int mt = item / 3, nt = item % 3;
            int m0 = mt * 256, n0 = nt * 128;
            __syncthreads();
            row_rms_to_lds<256>(cq, LDP, m0);
            f32x16 acc[2][2];
            ZERO_ACC(acc);
            gemm_core(acc, cq, LDP, wuq, LDP, 256, m0, n0, NoHook());
#pragma unroll
            for (int i = 0; i < 2; ++i)
#pragma unroll
                for (int j = 0; j < 2; ++j) {
                    int c0 = n0 + wn * 64 + j * 32;
                    int rloc = wm * 64 + i * 32 + 4 * hh;
                    bool rot = (c0 % 96) == 64;
                    int ci = l & 31, pi = ci & 15;
#pragma unroll
                    for (int rr = 0; rr < 16; ++rr) {
                        int rl = rloc + (rr & 3) + 8 * (rr >> 2);
                        float v = acc[i][j][rr] * aux[rl];
                        if (rot) {
                            float pv = __shfl_xor(v, 16);
                            float2 c_s = *(const float2*)(cs + ((size_t)(m0 + rl) * 16 + pi) * 2);
                            v = (ci < 16) ? (v * c_s.x - pv * c_s.y) : (pv * c_s.y + v * c_s.x);
                        }
                        acc[i][j][rr] = v;
                    }
                }
            stage_bf16<false>(acc, nullptr);
            store_rows_bf16(mq, 384, m0, ColAdd{n0});
        } else if (item < NQ + NKV) {
            int it2 = item - NQ;
            int mt = it2 / 6, nt = it2 % 6;
            int m0 = mt * 256, n0 = nt * 128;
            __syncthreads();
            row_rms_to_lds<128>(ckv, LDC, m0);
            f32x16 acc[2][2];
            ZERO_ACC(acc);
            gemm_core(acc, ckv, LDC, wukv, LDC, 128, m0, n0, NoHook());
            stage_bf16<true>(acc, aux);
            if (nt < 2) {
                const int nb0 = n0;
                struct CM { int n0; __device__ __forceinline__ int operator()(int c) const { int col = n0 + c; return (col >> 6) * 96 + (col & 63); } };
                store_rows_bf16(mk, 384, m0, CM{nb0});
            } else {
                store_cols_bf16(mvt, (size_t)(m0 >> 11) * 512 + (n0 - 256), m0 & 2047);
            }
        } else {
            int seq = (item - NQ - NKV) * NW + w;
            int b = seq >> 2, h = seq & 3;
            float bfv = P.b_forget[L * 4 + h];
            float vals[32];
            float run = 0.f;
#pragma unroll
            for (int i = 0; i < 32; ++i) {
                int s = l * 32 + i;
                float z = flog[((size_t)b * SEQ + s) * 4 + h] + bfv;
                run += log_sigmoid_f(z);
                vals[i] = run;
            }
            float tot = run, incl = tot;
#pragma unroll
            for (int o = 1; o < 64; o <<= 1) {
                float t = __shfl_up(incl, o);
                if (l >= o) incl += t;
            }
            float excl = incl - tot;
#pragma unroll
            for (int i = 0; i < 32; ++i) cumF[(size_t)seq * SEQ + l * 32 + i] = vals[i] + excl;
        }
    }
}

template <int MODE, int DK, int DV>
__device__ __forceinline__ void attn_item(const bf16* __restrict__ Q, int ldq, const bf16* __restrict__ Kg, int ldk,
                          const bf16* __restrict__ Vt, const float* __restrict__ cumF, bf16* __restrict__ Y,
                          float* __restrict__ ssy, int b, int h, int qb, float c1, char* lds, int fake = 0) {
    constexpr int KSTR = DK * 2 + 16;
    constexpr int VSTR = 144;
    constexpr int KBYTES = 64 * KSTR, VBYTES = DV * VSTR;
    constexpr int BUF = (KBYTES + VBYTES + 256 + 255) & ~255;
    static_assert(2 * BUF <= 65536, "lds");
    constexpr int KCH = DK / 8, KPT = (64 * KCH) / 256, VPT = (DV * 8) / 256;
    const int tid = opaque_tid() & 255, w = tid >> 6, l = tid & 63, r = l & 31, hh = l >> 5;
    const int q0 = qb * 128;
    const int qrow = q0 + 32 * w + r;
    const size_t tok = (size_t)b * SEQ + qrow;
    const int bh = b * 4 + h;
    bf16x8 qf[DK / 16];
#pragma unroll
    for (int s = 0; s < DK / 16; ++s) qf[s] = *(const bf16x8*)(Q + tok * ldq + h * DK + 16 * s + 8 * hh);
    f32x16 o[DV / 32];
    const f32x16 zero16 = {0.f, 0.f, 0.f, 0.f, 0.f, 0.f, 0.f, 0.f, 0.f, 0.f, 0.f, 0.f, 0.f, 0.f, 0.f, 0.f};
#pragma unroll
    for (int d = 0; d < DV / 32; ++d) o[d] = zero16;
    float m = -1e30f, lsum = 0.f, R = 0.f;
    bool sbdead = false;
    int* dmask = (int*)(smem + LDS_BYTES - 32);
    float Fq = 0.f;
    if (MODE == 0) Fq = cumF[(size_t)bh * SEQ + qrow] * LOG2E;
    const int nkt = (q0 + 128) >> 6;
    u32x4 kregA[KPT], vregA[VPT], kregB[KPT], vregB[VPT];
    float4 fregA = {0.f, 0.f, 0.f, 0.f}, fregB = {0.f, 0.f, 0.f, 0.f};
    auto gload = [&](int kt, u32x4 (&kreg)[KPT], u32x4 (&vreg)[VPT], float4& freg) {
#pragma unroll
        for (int i = 0; i < KPT; ++i) {
            int e = tid + 256 * i;
            int row = e / KCH, ch = e % KCH;
            kreg[i] = *(const u32x4*)(Kg + ((size_t)b * SEQ + kt * 64 + row) * ldk + h * DK + ch * 8);
        }
#pragma unroll
        for (int i = 0; i < VPT; ++i) {
            int e = tid + 256 * i;
            int row = e >> 3, ch = e & 7;
            vreg[i] = *(const u32x4*)(Vt + ((size_t)bh * DV + row) * SEQ + kt * 64 + ch * 8);
        }
        if (MODE == 0 && tid < 16) freg = *(const float4*)(cumF + (size_t)bh * SEQ + kt * 64 + tid * 4);
    };
    auto lwrite = [&](int buf, u32x4 (&kreg)[KPT], u32x4 (&vreg)[VPT], float4& freg) {
        char* base = lds + buf * BUF;
#pragma unroll
        for (int i = 0; i < KPT; ++i) {
            int e = tid + 256 * i;
            int row = e / KCH, ch = e % KCH;
            *(u32x4*)(base + row * KSTR + ch * 16) = kreg[i];
        }
#pragma unroll
        for (int i = 0; i < VPT; ++i) {
            int e = tid + 256 * i;
            int row = e >> 3, ch = e & 7;
            *(u32x4*)(base + KBYTES + row * VSTR + ch * 16) = vreg[i];
        }
        if (MODE == 0 && tid < 16) { float4 fn = {-freg.x * LOG2E, -freg.y * LOG2E, -freg.z * LOG2E, -freg.w * LOG2E}; *(float4*)(base + KBYTES + VBYTES + tid * 16) = fn; }
    };
    const int prow = (r & 0x13) | ((r & 4) << 1) | ((r & 8) >> 1);
    auto ktof = [&](int it) { return (MODE == 1) ? (nkt - 1 - it) : it; };
    gload(ktof(0), kregA, vregA, fregA);
    lwrite(0, kregA, vregA, fregA);
    constexpr bool D2 = (MODE != 2);
    if (D2 && nkt > 1) gload(ktof(1), kregB, vregB, fregB);
    __syncthreads();
    auto tile = [&](int it, u32x4 (&kn)[KPT], u32x4 (&vn)[VPT], float4& fn2, u32x4 (&kf)[KPT], u32x4 (&vf2)[VPT], float4& ff) {
        const int kt = ktof(it);
        if (!(fake & 1)) {
        if (D2) { if (it + 2 < nkt) gload(ktof(it + 2), kf, vf2, ff); }
        else { if (it + 1 < nkt) gload(ktof(it + 1), kf, vf2, ff); }
        }
        const char* base = lds + (it & 1) * BUF;
        bool active = (kt * 64) <= (q0 + 32 * w + 31);
        if (MODE == 1) {
            if (sbdead) { active = false; atomicOr(&dmask[it & 1], 1 << (opaque_tid() >> 6)); }
        }
        if (active) {
            const bool needmask = (kt * 64 + 63) >= (q0 + 32 * w);
            f32x16 s[2];
#pragma unroll
            for (int sub = 0; sub < 2; ++sub) {
                s[sub] = zero16;
#pragma unroll
                for (int ks = 0; ks < DK / 16; ++ks) {
                    bf16x8 kf = *(const bf16x8*)(base + (sub * 32 + prow) * KSTR + (2 * ks + hh) * 16);
                    s[sub] = __builtin_amdgcn_mfma_f32_32x32x16_bf16(kf, qf[ks], s[sub], 0, 0, 0);
                }
            }
            bf16x8 pf[2][2];
            if (fake & 2) {
#pragma unroll
                for (int sub = 0; sub < 2; ++sub)
#pragma unroll
                    for (int a = 0; a < 2; ++a) {
                        uint4 u;
                        u.x = pack2(s[sub][8 * a], s[sub][8 * a + 1]); u.y = pack2(s[sub][8 * a + 2], s[sub][8 * a + 3]);
                        u.z = pack2(s[sub][8 * a + 4], s[sub][8 * a + 5]); u.w = pack2(s[sub][8 * a + 6], s[sub][8 * a + 7]);
                        pf[sub][a] = __builtin_bit_cast(bf16x8, u);
                    }
                lsum = 1.f;
            } else if (MODE != 1) {
                const float* Ft = (const float*)(base + KBYTES + VBYTES);
                float mx = -INFINITY;
                float tv[2][16];
#pragma unroll
                for (int sub = 0; sub < 2; ++sub)
#pragma unroll
                    for (int a = 0; a < 2; ++a) {
                        int kofs = sub * 32 + 16 * a + 8 * hh;
                        float fk[8];
                        if (MODE == 0) {
                            float4 f0 = *(const float4*)(Ft + kofs), f1 = *(const float4*)(Ft + kofs + 4);
                            fk[0] = f0.x; fk[1] = f0.y; fk[2] = f0.z; fk[3] = f0.w; fk[4] = f1.x; fk[5] = f1.y; fk[6] = f1.z; fk[7] = f1.w;
                        }
#pragma unroll
                        for (int j = 0; j < 8; ++j) {
                            int rr = 8 * a + j;
                            float v = (MODE == 0) ? fmaf(s[sub][rr], c1, fk[j]) : s[sub][rr] * c1;
                            tv[sub][rr] = v;
                        }
                    }
                if (needmask) {
#pragma unroll
                    for (int sub = 0; sub < 2; ++sub)
#pragma unroll
                        for (int rr = 0; rr < 16; ++rr) {
                            int key = kt * 64 + sub * 32 + 16 * (rr >> 3) + 8 * hh + (rr & 7);
                            if (key > qrow) tv[sub][rr] = -INFINITY;
                        }
                }
#pragma unroll
                for (int sub = 0; sub < 2; ++sub)
#pragma unroll
                    for (int rr = 0; rr < 16; ++rr) mx = fmaxf(mx, tv[sub][rr]);
                mx = fmaxf(mx, __builtin_bit_cast(float, partner32(__builtin_bit_cast(int, mx), hh)));
                float mnew = fmaxf(m, mx);
                float rsum = 0.f;
#pragma unroll
                for (int sub = 0; sub < 2; ++sub)
#pragma unroll
                    for (int a = 0; a < 2; ++a) {
                        float pv[8];
#pragma unroll
                        for (int j = 0; j < 8; ++j) { pv[j] = fexp2(tv[sub][8 * a + j] - mnew); rsum += pv[j]; }
                        uint4 u;
                        u.x = pack2(pv[0], pv[1]); u.y = pack2(pv[2], pv[3]); u.z = pack2(pv[4], pv[5]); u.w = pack2(pv[6], pv[7]);
                        pf[sub][a] = __builtin_bit_cast(bf16x8, u);
                    }
                rsum += __builtin_bit_cast(float, partner32(__builtin_bit_cast(int, rsum), hh));
                if (__builtin_amdgcn_ballot_w64(mnew != m) != 0ull) {
                    float alpha = fexp2(m - mnew);
                    lsum *= alpha;
#pragma unroll
                    for (int d = 0; d < DV / 32; ++d) o[d] = o[d] * alpha;
                    m = mnew;
                }
                lsum += rsum;
            } else {
#pragma unroll
                for (int sb = 0; sb < 2; ++sb) {
                    const int sub = 1 - sb;
                    float lsig[16], lneg[16];
                    float A0 = 0.f, A1 = 0.f;
#pragma unroll
                    for (int rr = 0; rr < 16; ++rr) {
                        int key = kt * 64 + sub * 32 + 16 * (rr >> 3) + 8 * hh + (rr & 7);
                        bool valid = key < qrow;
                        float z = s[sub][rr] * c1;
                        float e = fexp2(-fabsf(z));
                        float l1p = flog2(1.f + e);
                        float ls = fminf(z, 0.f) - l1p;
                        float ln = valid ? (ls - z) : 0.f;
                        lsig[rr] = valid ? ls : -INFINITY;
                        lneg[rr] = ln;
                        if (rr < 8) A0 += ln; else A1 += ln;
                    }
                    float B0 = __shfl_xor(A0, 32), B1 = __shfl_xor(A1, 32);
                    float base1 = (hh == 0) ? (R + B1) : R;
                    float base0 = (hh == 0) ? (R + B1 + A1 + B0) : (R + A1 + B1);
                    float wv[16];
                    float run = base1;
#pragma unroll
                    for (int j = 7; j >= 0; --j) { wv[8 + j] = fexp2(lsig[8 + j] + run); run += lneg[8 + j]; }
                    run = base0;
#pragma unroll
                    for (int j = 7; j >= 0; --j) { wv[j] = fexp2(lsig[j] + run); run += lneg[j]; }
                    R += A0 + A1 + B0 + B1;
#pragma unroll
                    for (int a = 0; a < 2; ++a) {
                        uint4 u;
                        u.x = pack2(wv[8 * a], wv[8 * a + 1]); u.y = pack2(wv[8 * a + 2], wv[8 * a + 3]);
                        u.z = pack2(wv[8 * a + 4], wv[8 * a + 5]); u.w = pack2(wv[8 * a + 6], wv[8 * a + 7]);
                        pf[sub][a] = __builtin_bit_cast(bf16x8, u);
                    }
                }
            }
            if (MODE == 1) {
                if (__builtin_amdgcn_ballot_w64(R > -150.f) == 0ull) { sbdead = true; atomicOr(&dmask[it & 1], 1 << (opaque_tid() >> 6)); }
            }
#pragma unroll
            for (int d = 0; d < DV / 32; ++d)
#pragma unroll
                for (int sub = 0; sub < 2; ++sub)
#pragma unroll
                    for (int a = 0; a < 2; ++a) {
                        bf16x8 vf = *(const bf16x8*)(base + KBYTES + (d * 32 + r) * VSTR + (sub * 32 + 16 * a + 8 * hh) * 2);
                        o[d] = __builtin_amdgcn_mfma_f32_32x32x16_bf16(vf, pf[sub][a], o[d], 0, 0, 0);
                    }
        }
        if (!(fake & 1)) { if (it + 1 < nkt) lwrite((it + 1) & 1, kn, vn, fn2); }
        __syncthreads();
    };
    if (D2) {
        for (int it = 0; it < nkt; it += 2) {
            if (MODE == 1 && it > 0 && ((volatile int*)dmask)[(it - 1) & 1] == 0xFF) break;
            tile(it, kregB, vregB, fregB, kregA, vregA, fregA);
            if (it + 1 < nkt) {
                if (MODE == 1 && ((volatile int*)dmask)[it & 1] == 0xFF) break;
                tile(it + 1, kregA, vregA, fregA, kregB, vregB, fregB);
            }
        }
    } else {
        for (int it = 0; it < nkt; ++it) tile(it, kregA, vregA, fregA, kregA, vregA, fregA);
    }
    float inv = (MODE == 1) ? 1.f : (1.f / lsum);
    float ssq = 0.f;
#pragma unroll
    for (int d = 0; d < DV / 32; ++d)
#pragma unroll
        for (int g = 0; g < 4; ++g) {
            float v0 = o[d][4 * g] * inv, v1 = o[d][4 * g + 1] * inv, v2 = o[d][4 * g + 2] * inv, v3 = o[d][4 * g + 3] * inv;
            ssq += v0 * v0 + v1 * v1 + v2 * v2 + v3 * v3;
            uint2 u; u.x = pack2(v0, v1); u.y = pack2(v2, v3);
            *(uint2*)(Y + tok * LDH + h * DV + d * 32 + 8 * g + 4 * hh) = u;
        }
    ssq += __shfl_xor(ssq, 32);
    if (hh == 0) ssy[tok * 16 + h] = ssq;
}

__device__ __forceinline__ void phase_attn(const Params& P, int L, int rep = 0, int fake = 0) {
    char* ws = opq(P.ws);
    int* cnt = (int*)(ws + OFF_CNT) + L * 64 + rep * 16;
    int* s_item = (int*)(smem + LDS_BYTES - 16);
    const float* cumF = (const float*)(ws + OFF_CUMF);
    bf16* Y = (bf16*)(ws + (fake ? OFF_PART : OFF_Y));
    float* ssy = fake ? (float*)(ws + OFF_PART + 40 * MBy) : (float*)(ws + OFF_SSY) + (size_t)L * TOK * 16;
    const int half = opaque_tid() >> 8;
    char* lds = smem + half * 65536;
    for (;;) {
        if (opaque_tid() == 0) { int z0 = 0; asm volatile("" : "+v"(z0)); *s_item = atomicAdd(cnt, 1); s_item[-4] = z0; s_item[-3] = z0; }
        __syncthreads();
        int pair = *s_item;
        __syncthreads();
        if (pair >= 768) break;
        int item = pair * 2 + half;
        int qb, type, bh;
        if (item < 1024) { qb = 15 - (item >> 6); type = (item & 32) ? 2 : 0; bh = item & 31; }
        else { const int j2 = item - 1024; qb = 15 - (j2 >> 5); type = 1; bh = j2 & 31; }
        int b = bh >> 2, h = bh & 3;
        if (type == 0) {
            attn_item<2, 96, 128>((const bf16*)(ws + OFF_MQ), 384, (const bf16*)(ws + OFF_MK), 384, (const bf16*)(ws + OFF_MVT), cumF,
                                  Y + 512, ssy + 8, b, h, qb, 0.10206207261596577f * LOG2E, lds, fake);
        } else if (type == 1) {
            attn_item<1, 64, 64>((const bf16*)(ws + OFF_SQ), 256, (const bf16*)(ws + OFF_SKK), 256, (const bf16*)(ws + OFF_SVT), cumF,
                                 Y + 256, ssy + 4, b, h, qb, 0.125f * LOG2E, lds, fake);
        } else {
            attn_item<0, 64, 64>((const bf16*)(ws + OFF_FQ), 256, (const bf16*)(ws + OFF_FK), 256, (const bf16*)(ws + OFF_FVT), cumF,
                                 Y + 0, ssy + 0, b, h, qb, 0.125f * LOG2E, lds, fake);
        }
    }
}

__device__ __forceinline__ void rowss_flush(float (&part)[2][16], float* gss, int m0, int nt) {
    float* lss = (float*)smem;
    const int tid = opaque_tid(), w = tid >> 6, l = tid & 63, hh = l >> 5, wm = w >> 1, wn = w & 1;
#pragma unroll
    for (int i = 0; i < 2; ++i)
#pragma unroll
        for (int rr = 0; rr < 16; ++rr) {
            float v = part[i][rr];
            v = dpp_add<0xB1>(v); v = dpp_add<0x4E>(v); v = dpp_add<0x141>(v); v = dpp_add<0x140>(v);
            v += __shfl_xor(v, 16);
            if ((l & 31) == 0) lss[wn * 256 + wm * 64 + i * 32 + (rr & 3) + 8 * (rr >> 2) + 4 * hh] = v;
        }
    __syncthreads();
    if (tid < 256) gss[(size_t)(m0 + tid) * 8 + nt] = lss[tid] + lss[256 + tid];
    __syncthreads();
}

__device__ __forceinline__ float sum_fq(float v) {
    float a = v, b = v;
    asm volatile("s_nop 1\n\tv_permlane16_swap_b32 %0, %1\n\ts_nop 1" : "+v"(a), "+v"(b));
    v = a + b; a = v; b = v;
    asm volatile("s_nop 1\n\tv_permlane32_swap_b32 %0, %1\n\ts_nop 1" : "+v"(a), "+v"(b));
    return a + b;
}
template <bool SIG, bool XQ>
__device__ __forceinline__ void residual_fused(const f32x4 (&acc)[2][2][4][2], const pg8::Unit& u, int wr, int wc, int fr, int fqd,
                                               const float* rowscale  , const bf16* gate  ,
                                               const bf16* hb_in, bf16* hb_out, float* gss, unsigned char* xq = nullptr) {
    float* lss = (float*)smem;
#pragma unroll
    for (int ai = 0; ai < 2; ++ai)
#pragma unroll
        for (int m = 0; m < 4; ++m) {
            const int rl = 128 * ai + 64 * wr + 16 * m + fr, row = u.pm * 256 + rl;
            const float sc = rowscale ? rowscale[rl] : 1.f;
#pragma unroll
            for (int bj = 0; bj < 2; ++bj) {
                const int col = u.pn * 256 + 128 * bj + 32 * wc + 8 * fqd;
                const u32x4 hq = *(const u32x4*)(hb_in + (size_t)row * LDH + col);
                const f32x4 hp0 = {bflo(hq.x), bfhi(hq.x), bflo(hq.y), bfhi(hq.y)}, hp1 = {bflo(hq.z), bfhi(hq.z), bflo(hq.w), bfhi(hq.w)};
                f32x4 d0 = acc[ai][bj][m][0] * sc, d1 = acc[ai][bj][m][1] * sc;
                if (SIG) {
#pragma unroll
                    for (int e = 0; e < 4; ++e) {
                        d0[e] = __builtin_amdgcn_rcpf(1.f + fexp2(-LOG2E * d0[e]));
                        d1[e] = __builtin_amdgcn_rcpf(1.f + fexp2(-LOG2E * d1[e]));
                    }
                }
                if (gate) {
                    u32x4 gq = *(const u32x4*)(gate + (size_t)row * 1024 + col);
                    f32x4 g0 = {bflo(gq.x), bfhi(gq.x), bflo(gq.y), bfhi(gq.y)}, g1 = {bflo(gq.z), bfhi(gq.z), bflo(gq.w), bfhi(gq.w)};
                    d0 = d0 * g0; d1 = d1 * g1;
                }
                f32x4 v0 = hp0 + d0, v1 = hp1 + d1;
                u32x4 wv = {pack2(v0[0], v0[1]), pack2(v0[2], v0[3]), pack2(v1[0], v1[1]), pack2(v1[2], v1[3])};
                *(u32x4*)(hb_out + (size_t)row * LDH + col) = wv;
                if (XQ) {
                    f32x4 c0, c1;
#pragma unroll
                    for (int e = 0; e < 4; ++e) { c0[e] = __builtin_amdgcn_fmed3f(v0[e], -448.f, 448.f); c1[e] = __builtin_amdgcn_fmed3f(v1[e], -448.f, 448.f); }
                    int h0 = __builtin_amdgcn_cvt_pk_fp8_f32(c0[0], c0[1], 0, false); h0 = __builtin_amdgcn_cvt_pk_fp8_f32(c0[2], c0[3], h0, true);
                    int h1 = __builtin_amdgcn_cvt_pk_fp8_f32(c1[0], c1[1], 0, false); h1 = __builtin_amdgcn_cvt_pk_fp8_f32(c1[2], c1[3], h1, true);
                    const f32x2 b0 = __builtin_amdgcn_cvt_pk_f32_fp8(h0, false), b1 = __builtin_amdgcn_cvt_pk_f32_fp8(h0, true);
                    const f32x2 b2 = __builtin_amdgcn_cvt_pk_f32_fp8(h1, false), b3 = __builtin_amdgcn_cvt_pk_f32_fp8(h1, true);
                    int l0 = __builtin_amdgcn_cvt_pk_fp8_f32((c0[0] - b0.x) * 16.f, (c0[1] - b0.y) * 16.f, 0, false);
                    l0 = __builtin_amdgcn_cvt_pk_fp8_f32((c0[2] - b1.x) * 16.f, (c0[3] - b1.y) * 16.f, l0, true);
                    int l1 = __builtin_amdgcn_cvt_pk_fp8_f32((c1[0] - b2.x) * 16.f, (c1[1] - b2.y) * 16.f, 0, false);
                    l1 = __builtin_amdgcn_cvt_pk_fp8_f32((c1[2] - b3.x) * 16.f, (c1[3] - b3.y) * 16.f, l1, true);
                    u32x2 hh = {(unsigned)h0, (unsigned)h1}, ll = {(unsigned)l0, (unsigned)l1};
                    *(u32x2*)(xq + (size_t)row * 1024 + col) = hh;
                    *(u32x2*)(xq + 16 * MBy + (size_t)row * 1024 + col) = ll;
                }
                float ss = (v0[0] * v0[0] + v0[1] * v0[1]) + (v0[2] * v0[2] + v0[3] * v0[3]) + (v1[0] * v1[0] + v1[1] * v1[1]) + (v1[2] * v1[2] + v1[3] * v1[3]);
                ss = sum_fq(ss);
                if (fqd == 0) lss[(wc * 256 + rl) * 2 + bj] = ss;
            }
        }
    __syncthreads();
    const int tid = opaque_tid();
    if (tid < 256) {
        const int row = u.pm * 256 + tid;
#pragma unroll
        for (int bj = 0; bj < 2; ++bj)
            gss[(size_t)row * 8 + u.pn * 2 + bj] = (lss[(0 * 256 + tid) * 2 + bj] + lss[(1 * 256 + tid) * 2 + bj]) + (lss[(2 * 256 + tid) * 2 + bj] + lss[(3 * 256 + tid) * 2 + bj]);
    }
    __syncthreads();
}
struct EpiWo {
    static constexpr bool PERM = true, AFTER_DRAIN = true;
    const bf16* hb_in; bf16* hb_out; float* gss; unsigned char* xq;
    __device__ __forceinline__ void khook(int t, f32x4 (&acc)[2][2][4][2], int wr, int fr) const {
        if (t == 4 || t == 8) {
            const float* fac = (const float*)(smem + LDS_AUX) + (t == 4 ? 0 : 256);
#pragma unroll
            for (int ai = 0; ai < 2; ++ai)
#pragma unroll
                for (int m = 0; m < 4; ++m) {
                    const float f = fac[128 * ai + 64 * wr + 16 * m + fr];
#pragma unroll
                    for (int bj = 0; bj < 2; ++bj) { acc[ai][bj][m][0] *= f; acc[ai][bj][m][1] *= f; }
                }
        }
    }
    __device__ __forceinline__ void operator()(const f32x4 (&)[2][2][4][2], const pg8::Unit&, int, int, int, int) const {}
    __device__ __forceinline__ void fused(const f32x4 (&acc)[2][2][4][2], const pg8::Unit& u, int wr, int wc, int fr, int fqd, PG8_LAS unsigned char*, int, int) const {
        residual_fused<false, true>(acc, u, wr, wc, fr, fqd, (const float*)(smem + LDS_AUX) + 512, nullptr, hb_in, hb_out, gss, xq);
    }
};
__device__ __forceinline__ void phase_wo(const Params& P, int L, int hsel, int ss_slot) {
    char* ws = opq(P.ws);
    float* ss_out = (float*)(ws + OFF_SSA) + (size_t)ss_slot * TOK * 8;
    bf16* hb_out = (bf16*)(ws + (hsel ? OFF_HB1 : OFF_HB0));
    const bf16* hb_in = (const bf16*)(ws + (hsel ? OFF_HB0 : OFF_HB1));
    const bf16* Y = (const bf16*)(ws + OFF_Y);
    const bf16* Bt = (const bf16*)(ws + OFF_WO) + (size_t)L * 1024 * LDH;
    const float* ssy = (const float*)(ws + OFF_SSY) + (size_t)L * TOK * 16;
    float* aux = (float*)(smem + LDS_AUX);
    const int tid = opaque_tid();
    pg8::Gemm g{Y, Bt, LDH, LDH, TOK, 1024, 1024};
    pg8::StaticOrder S; S.init(TOK, 1024, gridDim.x, blockIdx.x);
    pg8::Unit u0;
    if (S.next(0, u0) && tid < 256) {
        int row = u0.pm * 256 + tid;
        float4 v0 = *(const float4*)(ssy + (size_t)row * 16), v1 = *(const float4*)(ssy + (size_t)row * 16 + 4), v2 = *(const float4*)(ssy + (size_t)row * 16 + 8);
        float r0 = rsqrtf(((v0.x + v0.y) + (v0.z + v0.w)) * (1.f / 256.f) + EPSF);
        float r1 = rsqrtf(((v1.x + v1.y) + (v1.z + v1.w)) * (1.f / 256.f) + EPSF);
        float r2 = rsqrtf(((v2.x + v2.y) + (v2.z + v2.w)) * (1.f / 512.f) + EPSF);
        aux[tid] = r0 / r1; aux[256 + tid] = r1 / r2; aux[512 + tid] = r2;
    }
    __syncthreads();
    EpiWo E{hb_in, hb_out, ss_out, (unsigned char*)(ws + OFF_XH)};
    pg8::gemm_phase((PG8_LAS unsigned char*)smem, g, S, E, nullptr);
    __syncthreads();
}

struct EpiPq {
    static constexpr bool PERM = true, AFTER_DRAIN = false;
    bf16* O; const float* ssrow;
    __device__ __forceinline__ void khook(int, f32x4 (&)[2][2][4][2], int, int) const {}
    __device__ __forceinline__ void operator()(const f32x4 (&acc)[2][2][4][2], const pg8::Unit& u, int wr, int wc, int fr, int fq) const {
        const int row0 = u.pm * 256 + wr * 64 + fr, col0 = u.pn * 256 + wc * 32 + 8 * fq;
#pragma unroll
        for (int ai = 0; ai < 2; ++ai)
#pragma unroll
            for (int m = 0; m < 4; ++m) {
                const int row = row0 + ai * 128 + m * 16;
                const float rs = row_rs8(ssrow, row);
                bf16* rowp = O + (size_t)row * 1024 + col0;
#pragma unroll
                for (int bj = 0; bj < 2; ++bj) {
                    f32x4 v0 = acc[ai][bj][m][0] * rs, v1 = acc[ai][bj][m][1] * rs;
                    u32x4 wv = {pack2(v0[0], v0[1]), pack2(v0[2], v0[3]), pack2(v1[0], v1[1]), pack2(v1[2], v1[3])};
                    *(u32x4*)(rowp + bj * 128) = wv;
                }
            }
    }
};
__device__ __forceinline__ void phase_pq(const Params& P, int L, int hsel, int ss_slot) {
    char* ws = opq(P.ws);
    const float* ssrow = (const float*)(ws + OFF_SSA) + (size_t)ss_slot * TOK * 8;
    const bf16* hb = (const bf16*)(ws + (hsel ? OFF_HB1 : OFF_HB0));
    const bf16* Bt = (const bf16*)(ws + OFF_WQ) + (size_t)L * 1024 * LDH;
    pg8::Gemm g{hb, Bt, LDH, LDH, TOK, 1024, 1024};
    pg8::StaticOrder S; S.init(TOK, 1024, gridDim.x, blockIdx.x);
    EpiPq E{(bf16*)(ws + OFF_PQ), ssrow};
    pg8::gemm_phase((PG8_LAS unsigned char*)smem, g, S, E, nullptr);
    __syncthreads();
}

__device__ __forceinline__ void cswap(int& a, int& b) { int mx = max(a, b), mn = min(a, b); a = mx; b = mn; }
__device__ __forceinline__ void bitonic_sort16(int (&v)[16]) {
#pragma unroll
    for (int k = 2; k <= 16; k <<= 1)
#pragma unroll
        for (int j = k >> 1; j > 0; j >>= 1)
#pragma unroll
            for (int i = 0; i < 16; ++i) {
                int q = i ^ j;
                if (q > i) {
                    if ((i & k) == 0) cswap(v[i], v[q]); else cswap(v[q], v[i]);
                }
            }
}
__device__ __forceinline__ void merge_top16(int (&Lv)[16], const int (&Rv)[16]) {
#pragma unroll
    for (int i = 0; i < 16; ++i) Lv[i] = max(Lv[i], Rv[15 - i]);
#pragma unroll
    for (int j = 8; j > 0; j >>= 1)
#pragma unroll
        for (int i = 0; i < 16; ++i) {
            int q = i ^ j;
            if (q > i) cswap(Lv[i], Lv[q]);
        }
}
__device__ __forceinline__ int f2key(float v, int low, int mask) {
    int b = __float_as_int(v);
    b ^= (b >> 31) & 0x7fffffff;
    return (b & ~mask) | low;
}
__device__ __forceinline__ float key2f(int k, int mask) {
    int b = k & ~mask;
    b ^= (b >> 31) & 0x7fffffff;
    return __int_as_float(b);
}

__device__ __forceinline__ void phase_topk(const Params& P, int L) {
    char* ws = opq(P.ws);
    const bf16* pq = (const bf16*)(ws + OFF_PQ);
    const bf16* skb = (const bf16*)(ws + OFF_SKB) + (size_t)L * 16 * 128 * 64;
    unsigned short* ids = (unsigned short*)(ws + OFF_IDS);
    float* gates = (float*)(ws + OFF_GATE);
    const int tid = opaque_tid(), w = tid >> 6, l = tid & 63, r = l & 31, hh = l >> 5;
    unsigned char* lidx = (unsigned char*)(smem + w * 1024 + r * 32);
    for (int task = blockIdx.x * NW + w; task < (TOK / 32) * 8; task += gridDim.x * NW) {
        const int t0 = (task >> 3) * 32, h = task & 7;
        int F[2][16];
#pragma unroll
        for (int p = 0; p < 2; ++p) {
            const int hp = h * 2 + p;
            f32x16 acc[4];
            const f32x16 z16 = {0.f, 0.f, 0.f, 0.f, 0.f, 0.f, 0.f, 0.f, 0.f, 0.f, 0.f, 0.f, 0.f, 0.f, 0.f, 0.f};
#pragma unroll
            for (int kt = 0; kt < 4; ++kt) acc[kt] = z16;
#pragma unroll
            for (int s4 = 0; s4 < 4; ++s4) {
                bf16x8 bfr = *(const bf16x8*)(pq + (size_t)(t0 + r) * 1024 + hp * 64 + 16 * s4 + 8 * hh);
#pragma unroll
                for (int kt = 0; kt < 4; ++kt) {
                    bf16x8 af = *(const bf16x8*)(skb + ((size_t)hp * 128 + 32 * kt + r) * 64 + 16 * s4 + 8 * hh);
                    acc[kt] = __builtin_amdgcn_mfma_f32_32x32x16_bf16(af, bfr, acc[kt], 0, 0, 0);
                }
            }
            int K0[16], K1[16], K2[16], K3[16];
#pragma unroll
            for (int rr = 0; rr < 16; ++rr) {
                const int nb = (rr & 3) + 8 * (rr >> 2) + 4 * hh;
                K0[rr] = f2key(acc[0][rr], 127 - nb, 127);
                K1[rr] = f2key(acc[1][rr], 127 - (32 + nb), 127);
                K2[rr] = f2key(acc[2][rr], 127 - (64 + nb), 127);
                K3[rr] = f2key(acc[3][rr], 127 - (96 + nb), 127);
            }
            bitonic_sort16(K0); bitonic_sort16(K1); bitonic_sort16(K2); bitonic_sort16(K3);
            merge_top16(K0, K1);
            merge_top16(K2, K3);
            merge_top16(K0, K2);
#pragma unroll
            for (int i = 0; i < 16; ++i) K1[i] = partner32(K0[i], hh);
            merge_top16(K0, K1);
#pragma unroll
            for (int i = 0; i < 16; ++i) F[p][i] = K0[i];
        }
        if (hh == 0) {
#pragma unroll
            for (int q = 0; q < 4; ++q) {
                unsigned w1 = 0, w2 = 0;
#pragma unroll
                for (int e = 0; e < 4; ++e) {
                    w1 |= (unsigned)(127 - (F[0][4 * q + e] & 127)) << (8 * e);
                    w2 |= (unsigned)(127 - (F[1][4 * q + e] & 127)) << (8 * e);
                }
                ((unsigned*)lidx)[q] = w1;
                ((unsigned*)lidx)[4 + q] = w2;
            }
        }
        {
            float s1[16], s2[16];
#pragma unroll
            for (int i = 0; i < 16; ++i) { s1[i] = key2f(F[0][i], 127); s2[i] = key2f(F[1][i], 127); }
            int Lc[16], X[16];
#pragma unroll
            for (int b2 = 0; b2 < 16; ++b2) Lc[b2] = f2key(s1[0] + s2[b2], 255 - b2, 255);
#pragma unroll
            for (int a2 = 1; a2 < 16; ++a2) X[a2 - 1] = f2key(s1[a2] + s2[0], 255 - a2 * 16, 255);
            X[15] = INT_MIN;
            merge_top16(Lc, X);
            X[0] = f2key(s1[1] + s2[1], 255 - 17, 255); X[1] = f2key(s1[1] + s2[2], 255 - 18, 255); X[2] = f2key(s1[1] + s2[3], 255 - 19, 255);
            X[3] = f2key(s1[1] + s2[4], 255 - 20, 255); X[4] = f2key(s1[1] + s2[5], 255 - 21, 255); X[5] = f2key(s1[1] + s2[6], 255 - 22, 255);
            X[6] = f2key(s1[1] + s2[7], 255 - 23, 255);
            X[7] = f2key(s1[2] + s2[1], 255 - 33, 255); X[8] = f2key(s1[2] + s2[2], 255 - 34, 255); X[9] = f2key(s1[2] + s2[3], 255 - 35, 255);
            X[10] = f2key(s1[2] + s2[4], 255 - 36, 255);
            X[11] = f2key(s1[3] + s2[1], 255 - 49, 255); X[12] = f2key(s1[3] + s2[2], 255 - 50, 255); X[13] = f2key(s1[3] + s2[3], 255 - 51, 255);
            X[14] = f2key(s1[4] + s2[1], 255 - 65, 255); X[15] = f2key(s1[4] + s2[2], 255 - 66, 255);
            bitonic_sort16(X);
            merge_top16(Lc, X);
            X[0] = f2key(s1[5] + s2[1], 255 - 81, 255);
            X[1] = f2key(s1[6] + s2[1], 255 - 97, 255);
            X[2] = f2key(s1[7] + s2[1], 255 - 113, 255);
#pragma unroll
            for (int i = 3; i < 16; ++i) X[i] = INT_MIN;
            merge_top16(Lc, X);
            if (hh == 0) {
                float mx = key2f(Lc[0], 255);
                float ev[16], sum = 0.f;
#pragma unroll
                for (int k = 0; k < 16; ++k) { ev[k] = __expf(key2f(Lc[k], 255) - mx); sum += ev[k]; }
                float inv = 1.f / sum;
                size_t ob = (size_t)(t0 + r) * 128 + h * 16;
                unsigned idw[8];
#pragma unroll
                for (int k = 0; k < 16; ++k) {
                    int cidx = 255 - (Lc[k] & 255);
                    int i1 = lidx[cidx >> 4], i2 = lidx[16 + (cidx & 15)];
                    unsigned idv = (unsigned)(i1 * 128 + i2);
                    if (k & 1) idw[k >> 1] |= idv << 16; else idw[k >> 1] = idv;
                }
                u32x4 o0 = {idw[0], idw[1], idw[2], idw[3]}, o1 = {idw[4], idw[5], idw[6], idw[7]};
                *(u32x4*)(ids + ob) = o0;
                *(u32x4*)(ids + ob + 8) = o1;
#pragma unroll
                for (int q = 0; q < 4; ++q) {
                    f32x4 g4 = {ev[4 * q] * inv, ev[4 * q + 1] * inv, ev[4 * q + 2] * inv, ev[4 * q + 3] * inv};
                    *(f32x4*)(gates + ob + 4 * q) = g4;
                }
            }
        }
    }
}

__device__ __forceinline__ float gelu_exact(float x) { return 0.5f * x * (1.f + erff(x * 0.70710678118654752f)); }

__device__ __forceinline__ void dec16(const u32x4& v, float (&f)[16]) {
    f32x2 t;
    t = __builtin_amdgcn_cvt_pk_f32_fp8((int)v.x, false); f[0] = t.x; f[1] = t.y;
    t = __builtin_amdgcn_cvt_pk_f32_fp8((int)v.x, true);  f[2] = t.x; f[3] = t.y;
    t = __builtin_amdgcn_cvt_pk_f32_fp8((int)v.y, false); f[4] = t.x; f[5] = t.y;
    t = __builtin_amdgcn_cvt_pk_f32_fp8((int)v.y, true);  f[6] = t.x; f[7] = t.y;
    t = __builtin_amdgcn_cvt_pk_f32_fp8((int)v.z, false); f[8] = t.x; f[9] = t.y;
    t = __builtin_amdgcn_cvt_pk_f32_fp8((int)v.z, true);  f[10] = t.x; f[11] = t.y;
    t = __builtin_amdgcn_cvt_pk_f32_fp8((int)v.w, false); f[12] = t.x; f[13] = t.y;
    t = __builtin_amdgcn_cvt_pk_f32_fp8((int)v.w, true);  f[14] = t.x; f[15] = t.y;
}

__device__ __forceinline__ void dec32(const u32x4& v, f32x2 (&f)[16]) {
    f[0] = __builtin_amdgcn_cvt_scalef32_pk_f32_fp4(v.x, 1.0f, 0); f[1] = __builtin_amdgcn_cvt_scalef32_pk_f32_fp4(v.x, 1.0f, 1);
    f[2] = __builtin_amdgcn_cvt_scalef32_pk_f32_fp4(v.x, 1.0f, 2); f[3] = __builtin_amdgcn_cvt_scalef32_pk_f32_fp4(v.x, 1.0f, 3);
    f[4] = __builtin_amdgcn_cvt_scalef32_pk_f32_fp4(v.y, 1.0f, 0); f[5] = __builtin_amdgcn_cvt_scalef32_pk_f32_fp4(v.y, 1.0f, 1);
    f[6] = __builtin_amdgcn_cvt_scalef32_pk_f32_fp4(v.y, 1.0f, 2); f[7] = __builtin_amdgcn_cvt_scalef32_pk_f32_fp4(v.y, 1.0f, 3);
    f[8] = __builtin_amdgcn_cvt_scalef32_pk_f32_fp4(v.z, 1.0f, 0); f[9] = __builtin_amdgcn_cvt_scalef32_pk_f32_fp4(v.z, 1.0f, 1);
    f[10] = __builtin_amdgcn_cvt_scalef32_pk_f32_fp4(v.z, 1.0f, 2); f[11] = __builtin_amdgcn_cvt_scalef32_pk_f32_fp4(v.z, 1.0f, 3);
    f[12] = __builtin_amdgcn_cvt_scalef32_pk_f32_fp4(v.w, 1.0f, 0); f[13] = __builtin_amdgcn_cvt_scalef32_pk_f32_fp4(v.w, 1.0f, 1);
    f[14] = __builtin_amdgcn_cvt_scalef32_pk_f32_fp4(v.w, 1.0f, 2); f[15] = __builtin_amdgcn_cvt_scalef32_pk_f32_fp4(v.w, 1.0f, 3);
}

typedef _Float16 f16x2 __attribute__((ext_vector_type(2)));
__device__ __forceinline__ void dec8_f16(unsigned x, f16x2 (&wv)[4]) {
    const unsigned lo = x & 0x07070707u, hi = (x >> 4) & 0x07070707u;
    const unsigned Lb = __builtin_amdgcn_perm(0x46444240u, 0x3E3C3800u, lo) | ((x & 0x08080808u) << 4);
    const unsigned Hb = __builtin_amdgcn_perm(0x46444240u, 0x3E3C3800u, hi) | (x & 0x80808080u);
    wv[0] = __builtin_bit_cast(f16x2, __builtin_amdgcn_perm(Hb, Lb, 0x040c000cu));
    wv[1] = __builtin_bit_cast(f16x2, __builtin_amdgcn_perm(Hb, Lb, 0x050c010cu));
    wv[2] = __builtin_bit_cast(f16x2, __builtin_amdgcn_perm(Hb, Lb, 0x060c020cu));
    wv[3] = __builtin_bit_cast(f16x2, __builtin_amdgcn_perm(Hb, Lb, 0x070c030cu));
}

typedef _Float16 f16x2 __attribute__((ext_vector_type(2)));
__device__ __forceinline__ void dec32h(const u32x4& v, f16x2 (&f)[16]) {
    f[0] = __builtin_amdgcn_cvt_scalef32_pk_f16_fp4(v.x, 1.0f, 0); f[1] = __builtin_amdgcn_cvt_scalef32_pk_f16_fp4(v.x, 1.0f, 1);
    f[2] = __builtin_amdgcn_cvt_scalef32_pk_f16_fp4(v.x, 1.0f, 2); f[3] = __builtin_amdgcn_cvt_scalef32_pk_f16_fp4(v.x, 1.0f, 3);
    f[4] = __builtin_amdgcn_cvt_scalef32_pk_f16_fp4(v.y, 1.0f, 0); f[5] = __builtin_amdgcn_cvt_scalef32_pk_f16_fp4(v.y, 1.0f, 1);
    f[6] = __builtin_amdgcn_cvt_scalef32_pk_f16_fp4(v.y, 1.0f, 2); f[7] = __builtin_amdgcn_cvt_scalef32_pk_f16_fp4(v.y, 1.0f, 3);
    f[8] = __builtin_amdgcn_cvt_scalef32_pk_f16_fp4(v.z, 1.0f, 0); f[9] = __builtin_amdgcn_cvt_scalef32_pk_f16_fp4(v.z, 1.0f, 1);
    f[10] = __builtin_amdgcn_cvt_scalef32_pk_f16_fp4(v.z, 1.0f, 2); f[11] = __builtin_amdgcn_cvt_scalef32_pk_f16_fp4(v.z, 1.0f, 3);
    f[12] = __builtin_amdgcn_cvt_scalef32_pk_f16_fp4(v.w, 1.0f, 0); f[13] = __builtin_amdgcn_cvt_scalef32_pk_f16_fp4(v.w, 1.0f, 1);
    f[14] = __builtin_amdgcn_cvt_scalef32_pk_f16_fp4(v.w, 1.0f, 2); f[15] = __builtin_amdgcn_cvt_scalef32_pk_f16_fp4(v.w, 1.0f, 3);
}

__device__ __forceinline__ int idof16(const u32x4 (&q)[2], int i) {
    unsigned wv = (i >> 1) == 0 ? q[0].x : (i >> 1) == 1 ? q[0].y : (i >> 1) == 2 ? q[0].z : (i >> 1) == 3 ? q[0].w
                : (i >> 1) == 4 ? q[1].x : (i >> 1) == 5 ? q[1].y : (i >> 1) == 6 ? q[1].z : q[1].w;
    return (i & 1) ? (int)(wv >> 16) : (int)(wv & 0xffffu);
}
typedef int i32x8 __attribute__((ext_vector_type(8)));
#define GU_WAIT_V(n) asm volatile("s_waitcnt vmcnt(" #n ")" ::: "memory")
#define GU_WAIT_L0() asm volatile("s_waitcnt lgkmcnt(0)" ::: "memory")
__device__ __forceinline__ void phase_gather_u(const Params& P, int L) {
    char* ws = opq(P.ws);
    const unsigned char* U4 = (const unsigned char*)(ws + OFF_UB) + (size_t)L * NEXP * 512;
    float* part = (float*)(ws + OFF_PART);
    const unsigned short* ids = (const unsigned short*)(ws + OFF_IDS);
    const int tid = opaque_tid(), w = tid >> 6, l = tid & 63, i = l & 15, g4 = l >> 4, rr = l >> 3, dc = (l & 7) ^ rr;
    const int sl = blockIdx.x & 3, par = (blockIdx.x >> 2) & 1, rk = blockIdx.x >> 3, nb = gridDim.x >> 3;
    if (rk >= nb) return;
    PG8_LAS unsigned char* wl = (PG8_LAS unsigned char*)smem + w * 16384;
    const unsigned char* ubase = U4 + (size_t)sl * NEXP * 128 + dc * 16;
    const unsigned char* xbase = (const unsigned char*)(ws + OFF_XH) + (i == 1 ? 16 * MBy : 0) + 256 * sl + 16 * g4;
    const int scb = (i == 1) ? 123 : 127;
    const unsigned a0 = 1024u * (i >> 3) + 128u * (i & 7) + 16u * (g4 ^ (i & 7)), a1 = a0 ^ 64u;
    const int stride = nb * NW;
    int ti = rk * NW + w;
    if (ti >= TOK / 2) return;
    u32x4 idA[2], idB[2];
    u32x4 xA[4], xB[4];
    auto load_ids = [&](int tt, u32x4 (&idq)[2]) {
        const unsigned short* ip = ids + (size_t)tt * 128 + 16 * rr;
        asm volatile("global_load_dwordx4 %0, %2, off\n\tglobal_load_dwordx4 %1, %2, off offset:16" : "=&v"(idq[0]), "=&v"(idq[1]) : "v"(ip));
    };
    auto load_x = [&](int tt, u32x4 (&xx)[4]) {
        const unsigned char* p = xbase + (size_t)tt * 1024;
        asm volatile("global_load_dwordx4 %0, %4, off\n\tglobal_load_dwordx4 %1, %4, off offset:64\n\t"
                     "global_load_dwordx4 %2, %4, off offset:128\n\tglobal_load_dwordx4 %3, %4, off offset:192"
                     : "=&v"(xx[0]), "=&v"(xx[1]), "=&v"(xx[2]), "=&v"(xx[3]) : "v"(p));
    };
    auto pin = [&](u32x4 (&idq)[2], u32x4 (&xx)[4]) {
        asm volatile("" : "+v"(idq[0]), "+v"(idq[1]), "+v"(xx[0]), "+v"(xx[1]), "+v"(xx[2]), "+v"(xx[3]));
    };
    auto dma_half = [&](const u32x4 (&idq)[2], int h) {
#pragma unroll
        for (int jj = 0; jj < 8; ++jj) {
            const int j = 8 * h + jj;
            __builtin_amdgcn_global_load_lds((const unsigned*)(ubase + (size_t)idof16(idq, j) * 128), (PG8_LAS unsigned*)(wl + 1024 * j), 16, 0, 0);
        }
    };
    const unsigned la0 = (unsigned)(size_t)wl + a0, la1 = (unsigned)(size_t)wl + a1;
    auto mma_half = [&](f32x4 (&acc)[8], const u32x4 (&xc)[4], int h) {
        u32x4 av[8];
        if (h == 0)
            asm volatile("ds_read_b128 %0, %8\n\tds_read_b128 %1, %9\n\tds_read_b128 %2, %8 offset:2048\n\tds_read_b128 %3, %9 offset:2048\n\t"
                         "ds_read_b128 %4, %8 offset:4096\n\tds_read_b128 %5, %9 offset:4096\n\tds_read_b128 %6, %8 offset:6144\n\tds_read_b128 %7, %9 offset:6144\n\t"
                         "s_waitcnt lgkmcnt(0)"
                         : "=&v"(av[0]), "=&v"(av[1]), "=&v"(av[2]), "=&v"(av[3]), "=&v"(av[4]), "=&v"(av[5]), "=&v"(av[6]), "=&v"(av[7]) : "v"(la0), "v"(la1));
        else
            asm volatile("ds_read_b128 %0, %8 offset:8192\n\tds_read_b128 %1, %9 offset:8192\n\tds_read_b128 %2, %8 offset:10240\n\tds_read_b128 %3, %9 offset:10240\n\t"
                         "ds_read_b128 %4, %8 offset:12288\n\tds_read_b128 %5, %9 offset:12288\n\tds_read_b128 %6, %8 offset:14336\n\tds_read_b128 %7, %9 offset:14336\n\t"
                         "s_waitcnt lgkmcnt(0)"
                         : "=&v"(av[0]), "=&v"(av[1]), "=&v"(av[2]), "=&v"(av[3]), "=&v"(av[4]), "=&v"(av[5]), "=&v"(av[6]), "=&v"(av[7]) : "v"(la0), "v"(la1));
#pragma unroll
        for (int qq = 0; qq < 4; ++qq) {
#pragma unroll
            for (int hf = 0; hf < 2; ++hf) {
                const u32x4 a = av[2 * qq + hf];
                const i32x8 A = {(int)a.x, (int)a.y, (int)a.z, (int)a.w, 0, 0, 0, 0};
                const u32x4 b0 = xc[2 * hf], b1 = xc[2 * hf + 1];
                const i32x8 B = {(int)b0.x, (int)b0.y, (int)b0.z, (int)b0.w, (int)b1.x, (int)b1.y, (int)b1.z, (int)b1.w};
                f32x4 c = {0.f, 0.f, 0.f, 0.f};
                if (hf) c = acc[4 * h + qq];
                acc[4 * h + qq] = __builtin_amdgcn_mfma_scale_f32_16x16x128_f8f6f4(A, B, c, 4, 0, 0, 127, 0, scb);
            }
        }
    };
    auto step = [&](int tcur, int tnext, int tnext2, u32x4 (&idn)[2], u32x4 (&idl)[2], u32x4 (&xc)[4], u32x4 (&xn)[4]) {
        f32x4 acc[8];
        __builtin_amdgcn_sched_barrier(0);
        GU_WAIT_V(8);
        pin(idn, xc);
        __builtin_amdgcn_sched_barrier(0);
        mma_half(acc, xc, 0);
        __builtin_amdgcn_sched_barrier(0);
        dma_half(idn, 0);
        __builtin_amdgcn_sched_barrier(0);
        load_ids(tnext2, idl);
        load_x(tnext, xn);
        __builtin_amdgcn_sched_barrier(0);
        GU_WAIT_V(14);
        __builtin_amdgcn_sched_barrier(0);
        mma_half(acc, xc, 1);
        __builtin_amdgcn_sched_barrier(0);
#pragma unroll
        for (int q = 0; q < 8; ++q)
#pragma unroll
            for (int r = 0; r < 4; ++r) acc[q][r] = dpp_add<0xB1>(acc[q][r]);
        if (i == 0) {
            float* o = part + ((size_t)sl * TOK + tcur) * 128 + 32 * g4;
#pragma unroll
            for (int r = 0; r < 4; ++r)
#pragma unroll
                for (int gh = 0; gh < 2; ++gh) {
                    f32x4 ov = {acc[4 * gh][r], acc[4 * gh + 1][r], acc[4 * gh + 2][r], acc[4 * gh + 3][r]};
                    asm volatile("global_store_dwordx4 %0, %1, off offset:%2" :: "v"(o), "v"(ov), "n"(32 * r + 16 * gh) : "memory");
                }
        }
        __builtin_amdgcn_sched_barrier(0);
        dma_half(idn, 1);
        __builtin_amdgcn_sched_barrier(0);
    };
    auto tok = [&](int tidx, int fb) { return 2 * (tidx < TOK / 2 ? tidx : fb) + par; };
    load_ids(tok(ti, ti), idA);
    __builtin_amdgcn_sched_barrier(0);
    GU_WAIT_V(0);
    asm volatile("" : "+v"(idA[0]), "+v"(idA[1]));
    __builtin_amdgcn_sched_barrier(0);
    dma_half(idA, 0);
    __builtin_amdgcn_sched_barrier(0);
    load_ids(tok(ti + stride, ti), idB);
    load_x(tok(ti, ti), xA);
    __builtin_amdgcn_sched_barrier(0);
    dma_half(idA, 1);
    __builtin_amdgcn_sched_barrier(0);
    for (;;) {
        int tn = ti + stride, tn2 = ti + 2 * stride;
        step(tok(ti, ti), tok(tn, ti), tok(tn2, ti), idB, idA, xA, xB);
        if (tn >= TOK / 2) break;
        ti = tn; tn = ti + stride; tn2 = ti + 2 * stride;
        step(tok(ti, ti), tok(tn, ti), tok(tn2, ti), idA, idB, xB, xA);
        if (tn >= TOK / 2) break;
        ti = tn;
    }
    GU_WAIT_V(0);
}

__device__ __forceinline__ void phase_gather_act(const Params& P, int L, int ss_slot, int fake = 0) {
    char* ws = opq(P.ws);
    const float* ss_ffn = (const float*)(ws + OFF_SSA) + (size_t)ss_slot * TOK * 8;
    const float* part = (const float*)(ws + OFF_PART);
    const unsigned short* ids = (const unsigned short*)(ws + OFF_IDS);
    float* gates = (float*)(ws + OFF_GATE);
    const float* uinv = (const float*)(ws + OFF_TSC) + L * NEXP;
    const float* vinv = (const float*)(ws + OFF_TSC) + (2 + L) * NEXP;
    const int tid = opaque_tid(), w = tid >> 6, l = tid & 63;
    float* gdst = fake ? (float*)(ws + OFF_FQ) : gates;
    const int stride = gridDim.x * NW;
    for (int t0 = blockIdx.x * NW + w; t0 < TOK; t0 += 4 * stride) {
        f32x2 pa[4][4], gt[4];
        unsigned idw[4];
        f32x4 s0[4], s1[4];
#pragma unroll
        for (int q = 0; q < 4; ++q) {
            const int t = (t0 + q * stride < TOK) ? (t0 + q * stride) : t0;
#pragma unroll
            for (int j = 0; j < 4; ++j) { pa[q][j].x = part[((size_t)j * TOK + t) * 128 + l]; pa[q][j].y = part[((size_t)j * TOK + t) * 128 + 64 + l]; }
            idw[q] = *(const unsigned*)(ids + (size_t)t * 128 + 2 * l);
            gt[q] = *(const f32x2*)(gates + (size_t)t * 128 + 2 * l);
            s0[q] = *(const f32x4*)(ss_ffn + (size_t)t * 8); s1[q] = *(const f32x4*)(ss_ffn + (size_t)t * 8 + 4);
        }
        float ui[4][2], vi[4][2];
#pragma unroll
        for (int q = 0; q < 4; ++q) {
            const int i0 = (int)(idw[q] & 0xffffu), i1 = (int)(idw[q] >> 16);
            ui[q][0] = uinv[i0]; ui[q][1] = uinv[i1]; vi[q][0] = vinv[i0]; vi[q][1] = vinv[i1];
        }
#pragma unroll
        for (int q = 0; q < 4; ++q) {
            const int t = t0 + q * stride;
            if (t < TOK) {
                const float ssum = ((s0[q].x + s0[q].y) + (s0[q].z + s0[q].w)) + ((s1[q].x + s1[q].y) + (s1[q].z + s1[q].w));
                const float rs = rsqrtf(ssum * (1.f / 1024.f) + EPSF);
                f32x2 sa = (pa[q][0] + pa[q][1]) + (pa[q][2] + pa[q][3]);
                f32x2 o;
                o.x = gt[q].x * gelu_exact(sa.x * rs * ui[q][0]) * vi[q][0];
                o.y = gt[q].y * gelu_exact(sa.y * rs * ui[q][1]) * vi[q][1];
                *(f32x2*)(gdst + (size_t)t * 128 + 2 * l) = o;
            }
        }
    }
}

__device__ __forceinline__ void phase_gather_v(const Params& P, int L, int hsel, int ss_slot, int fake = 0) {
    char* ws = opq(P.ws);
    float* ss_ple = fake ? (float*)(ws + OFF_FQ) : (float*)(ws + OFF_SSA) + (size_t)ss_slot * TOK * 8;
    bf16* hb_out = fake ? (bf16*)(ws + OFF_PART) : (bf16*)(ws + (hsel ? OFF_HB1 : OFF_HB0));
    const bf16* hbin = (const bf16*)(ws + (hsel ? OFF_HB0 : OFF_HB1));
    const unsigned char* V4 = (const unsigned char*)(ws + OFF_VB) + (size_t)L * NEXP * 512;
    const unsigned short* ids = (const unsigned short*)(ws + OFF_IDS);
    const float* act = (const float*)(ws + OFF_GATE);
    const int tid = opaque_tid(), w = tid >> 6, l = tid & 63, c = l & 7, gq = l >> 3;
    const int sl = blockIdx.x & 3, par = (blockIdx.x >> 2) & 1, rk = blockIdx.x >> 3, nb = gridDim.x >> 3;
    if (rk >= nb) return;
    const unsigned char* vbase = V4 + (size_t)sl * NEXP * 128 + c * 16;
    const int stride = nb * NW;
    int ti = rk * NW + w;
    if (ti >= TOK / 2) return;
    const bool b3 = (l >> 3) & 1;
    u32x4 idA[2], idB[2];
    u32x4 rv[16];
    f32x4 aA[4], aB[4];
    auto load_ids = [&](int tt, u32x4 (&idq)[2]) {
        const u32x4* i4 = (const u32x4*)(ids + (size_t)tt * 128 + 16 * gq);
        idq[0] = i4[0]; idq[1] = i4[1];
    };
    auto load_a = [&](int tt, f32x4 (&ax)[4]) {
        const f32x4* a4 = (const f32x4*)(act + (size_t)tt * 128 + 16 * gq);
#pragma unroll
        for (int q = 0; q < 4; ++q) ax[q] = a4[q];
    };
    auto step = [&](int tcur, int tnext, int tnext2, const u32x4 (&idn)[2], u32x4 (&idl)[2], const f32x4 (&ac)[4], f32x4 (&an)[4]) {
        load_ids(tnext2, idl);
        load_a(tnext, an);
        __builtin_amdgcn_sched_barrier(0);
        f16x2 acc[16];
#pragma unroll
        for (int e = 0; e < 16; ++e) { acc[e].x = (_Float16)0.f; acc[e].y = (_Float16)0.f; }
#pragma unroll
        for (int i = 0; i < 16; ++i) {
            f16x2 f[16];
            asm volatile("" : "+v"(rv[i].x), "+v"(rv[i].y), "+v"(rv[i].z), "+v"(rv[i].w));
            dec32h(rv[i], f);
            rv[i] = *(const u32x4*)(vbase + (size_t)idof16(idn, i) * 128);
            __builtin_amdgcn_sched_barrier(0);
            const float a = (i & 3) == 0 ? ac[i >> 2].x : (i & 3) == 1 ? ac[i >> 2].y : (i & 3) == 2 ? ac[i >> 2].z : ac[i >> 2].w;
            const f16x2 a2 = {(_Float16)a, (_Float16)a};
#pragma unroll
            for (int e = 0; e < 16; ++e) acc[e] = f[e] * a2 + acc[e];
#pragma unroll
            for (int e = 0; e < 16; ++e) asm volatile("" : "+v"(acc[e]));
        }
        f16x2 r8[8];
#pragma unroll
        for (int e = 0; e < 8; ++e) {
            const unsigned keep = __builtin_bit_cast(unsigned, b3 ? acc[8 + e] : acc[e]);
            const unsigned send = __builtin_bit_cast(unsigned, b3 ? acc[e] : acc[8 + e]);
            const unsigned got = (unsigned)__builtin_amdgcn_update_dpp(0, (int)send, 0x128, 0xf, 0xf, true);
            r8[e] = __builtin_bit_cast(f16x2, keep) + __builtin_bit_cast(f16x2, got);
        }
        f16x2 r4[4];
#pragma unroll
        for (int e = 0; e < 4; ++e) {
            unsigned X = __builtin_bit_cast(unsigned, r8[e]), Y = __builtin_bit_cast(unsigned, r8[4 + e]);
            asm volatile("s_nop 1\n\tv_permlane16_swap_b32 %0, %1\n\ts_nop 1" : "+v"(X), "+v"(Y));
            r4[e] = __builtin_bit_cast(f16x2, X) + __builtin_bit_cast(f16x2, Y);
        }
        float v2[4];
        {
            unsigned X0 = __builtin_bit_cast(unsigned, r4[0]), Y0 = __builtin_bit_cast(unsigned, r4[2]);
            asm volatile("s_nop 1\n\tv_permlane32_swap_b32 %0, %1\n\ts_nop 1" : "+v"(X0), "+v"(Y0));
            unsigned X1 = __builtin_bit_cast(unsigned, r4[1]), Y1 = __builtin_bit_cast(unsigned, r4[3]);
            asm volatile("s_nop 1\n\tv_permlane32_swap_b32 %0, %1\n\ts_nop 1" : "+v"(X1), "+v"(Y1));
            const f16x2 q0 = __builtin_bit_cast(f16x2, X0), p0 = __builtin_bit_cast(f16x2, Y0), q1 = __builtin_bit_cast(f16x2, X1), p1 = __builtin_bit_cast(f16x2, Y1);
            v2[0] = (float)q0.x + (float)p0.x; v2[1] = (float)q0.y + (float)p0.y; v2[2] = (float)q1.x + (float)p1.x; v2[3] = (float)q1.y + (float)p1.y;
        }
        const int col = 256 * sl + 32 * c + 16 * ((l >> 3) & 1) + 8 * ((l >> 4) & 1) + 4 * (l >> 5);
        const u32x2 hq = *(const u32x2*)(hbin + (size_t)tcur * LDH + col);
        f32x4 hv = {bflo(hq.x) + v2[0], bfhi(hq.x) + v2[1], bflo(hq.y) + v2[2], bfhi(hq.y) + v2[3]};
        u32x2 bb = {pack2(hv.x, hv.y), pack2(hv.z, hv.w)};
        *(u32x2*)(hb_out + (size_t)tcur * LDH + col) = bb;
        float ssq = hv.x * hv.x + hv.y * hv.y + hv.z * hv.z + hv.w * hv.w;
        ssq = wave_sum(ssq);
        if (l == 0) { ss_ple[(size_t)tcur * 8 + sl] = ssq; ss_ple[(size_t)tcur * 8 + 4 + sl] = 0.f; }
    };
    auto tok = [&](int tidx, int fb) { return 2 * (tidx < TOK / 2 ? tidx : fb) + par; };
    load_ids(tok(ti, ti), idA);
#pragma unroll
    for (int i = 0; i < 16; ++i) rv[i] = *(const u32x4*)(vbase + (size_t)idof16(idA, i) * 128);
    load_a(tok(ti, ti), aA);
    load_ids(tok(ti + stride, ti), idB);
    for (;;) {
        int tn = ti + stride, tn2 = ti + 2 * stride;
        step(tok(ti, ti), tok(tn, ti), tok(tn2, ti), idB, idA, aA, aB);
        if (tn >= TOK / 2) break;
        ti = tn; tn = ti + stride; tn2 = ti + 2 * stride;
        step(tok(ti, ti), tok(tn, ti), tok(tn2, ti), idA, idB, aB, aA);
        if (tn >= TOK / 2) break;
        ti = tn;
    }
}

struct EpiStoreBf16 {
    static constexpr bool PERM = true, AFTER_DRAIN = false;
    bf16* O;
    __device__ __forceinline__ void khook(int, f32x4 (&)[2][2][4][2], int, int) const {}
    __device__ __forceinline__ void operator()(const f32x4 (&acc)[2][2][4][2], const pg8::Unit& u, int wr, int wc, int fr, int fqd) const {
        const int row0 = u.pm * 256 + wr * 64 + fr, col0 = u.pn * 256 + wc * 32 + 8 * fqd;
#pragma unroll
        for (int ai = 0; ai < 2; ++ai)
#pragma unroll
            for (int m = 0; m < 4; ++m) {
                bf16* rowp = O + (size_t)(row0 + ai * 128 + m * 16) * 1024 + col0;
#pragma unroll
                for (int bj = 0; bj < 2; ++bj) {
                    const f32x4 v0 = acc[ai][bj][m][0], v1 = acc[ai][bj][m][1];
                    u32x4 wv = {pack2(v0[0], v0[1]), pack2(v0[2], v0[3]), pack2(v1[0], v1[1]), pack2(v1[2], v1[3])};
                    *(u32x4*)(rowp + bj * 128) = wv;
                }
            }
    }
};
__device__ __forceinline__ void phase_pw(const Params& P) {
    char* ws = opq(P.ws);
    pg8::StaticOrder S; S.init(TOK, 1024, gridDim.x, blockIdx.x);
    for (int L = 0; L < 2; ++L) {
        pg8::Gemm g{(const bf16*)(ws + OFF_PB) + (size_t)L * TOK * LDP, (const bf16*)(ws + OFF_WP) + (size_t)L * 1024 * LDP, LDP, LDP, TOK, 1024, 256};
        EpiStoreBf16 E{(bf16*)(ws + (L ? OFF_PW1 : OFF_PW0))};
        pg8::gemm_phase((PG8_LAS unsigned char*)smem, g, S, E, nullptr);
        __syncthreads();
    }
}
struct EpiPle {
    static constexpr bool PERM = true, AFTER_DRAIN = true;
    const bf16* PW; const bf16* hb_in; bf16* hb_out; float* gss;
    __device__ __forceinline__ void khook(int, f32x4 (&)[2][2][4][2], int, int) const {}
    __device__ __forceinline__ void operator()(const f32x4 (&)[2][2][4][2], const pg8::Unit&, int, int, int, int) const {}
    __device__ __forceinline__ void fused(const f32x4 (&acc)[2][2][4][2], const pg8::Unit& u, int wr, int wc, int fr, int fqd, PG8_LAS unsigned char*, int, int) const {
        residual_fused<true, false>(acc, u, wr, wc, fr, fqd, (const float*)(smem + LDS_AUX), PW, hb_in, hb_out, gss);
    }
};
__device__ __forceinline__ void phase_ple(const Params& P, int L, int hsel, int ss_slot_in, int ss_slot_out, int fake = 0) {
    char* ws = opq(P.ws);
    const float* ss_ple = (const float*)(ws + OFF_SSA) + (size_t)ss_slot_in * TOK * 8;
    float* ss_out = (float*)(ws + OFF_SSA) + (size_t)ss_slot_out * TOK * 8;
    const bf16* hb_in = (const bf16*)(ws + (hsel ? OFF_HB1 : OFF_HB0));
    bf16* hb_out = (bf16*)(ws + (hsel ? OFF_HB0 : OFF_HB1));
    const bf16* Wg = (const bf16*)(ws + OFF_WG) + (size_t)L * 1024 * LDH;
    float* aux = (float*)(smem + LDS_AUX);
    const int tid = opaque_tid();
    pg8::Gemm g{hb_in, Wg, LDH, LDH, TOK, 1024, 1024};
    pg8::StaticOrder S; S.init(TOK, 1024, gridDim.x, blockIdx.x);
    pg8::Unit u0;
    if (S.next(0, u0) && tid < 256) aux[tid] = row_rs8(ss_ple, u0.pm * 256 + tid);
    __syncthreads();
    EpiPle E{(const bf16*)(ws + (L ? OFF_PW1 : OFF_PW0)), hb_in, fake ? (bf16*)(ws + OFF_PART) : hb_out, fake ? (float*)(ws + OFF_FQ) : ss_out};
    pg8::gemm_phase((PG8_LAS unsigned char*)smem, g, S, E, nullptr);
    __syncthreads();
}

__device__ __forceinline__ void phase_final(const Params& P, int ss_slot, int hsel) {
    char* ws = opq(P.ws);
    float* out = opq(P.out);
    const bf16* hbin = (const bf16*)(ws + (hsel ? OFF_HB1 : OFF_HB0));
    const float* ss = (const float*)(ws + OFF_SSA) + (size_t)ss_slot * TOK * 8;
    const int tid = opaque_tid(), w = tid >> 6, l = tid & 63;
    const float4* g4 = (const float4*)P.final_norm_g;
    for (int t = blockIdx.x * NW + w; t < TOK; t += gridDim.x * NW) {
        float rs = row_rs8(ss, t);
        float4* o4 = (float4*)(out + (size_t)t * 1024);
#pragma unroll
        for (int i = 0; i < 2; ++i) {
            u32x4 hq = *(const u32x4*)(hbin + (size_t)t * LDH + (i * 64 + l) * 8);
            float4 ga = g4[(i * 64 + l) * 2], gb = g4[(i * 64 + l) * 2 + 1];
            float4 va = {bflo(hq.x) * rs * ga.x, bfhi(hq.x) * rs * ga.y, bflo(hq.y) * rs * ga.z, bfhi(hq.y) * rs * ga.w};
            float4 vb = {bflo(hq.z) * rs * gb.x, bfhi(hq.z) * rs * gb.y, bflo(hq.w) * rs * gb.z, bfhi(hq.w) * rs * gb.w};
            o4[(i * 64 + l) * 2] = va; o4[(i * 64 + l) * 2 + 1] = vb;
        }
    }
}

#define XB_TMO      128
#define XB_XCNT(j)  (256  + 64 * (j))
#define XB_XSUB(j)  (1280 + 64 * (j))
#define XB_XGEN(j)  (2304 + 64 * (j))
#define XB_TOP      3328
#define XB_TOPGEN   3392
#define XCD_BAR_WORDS 3456
#define XB_SPIN_CAP (1u << 22)
__device__ __forceinline__ unsigned xb_ld(unsigned* p) { return __hip_atomic_load(p, __ATOMIC_RELAXED, __HIP_MEMORY_SCOPE_AGENT); }
__device__ __forceinline__ unsigned xb_add(unsigned* p, unsigned v) { return __hip_atomic_fetch_add(p, v, __ATOMIC_RELAXED, __HIP_MEMORY_SCOPE_AGENT); }
__device__ __forceinline__ unsigned xb_xcc_id() { return (unsigned)__builtin_amdgcn_s_getreg((3 << 11) | 20) & 0xFu; }
#define XB_SPIN(cond, bar) do { unsigned _sp = 0; while (cond) { __builtin_amdgcn_s_sleep(1); \
    if ((++_sp & 255u) == 0u) { if (xb_ld(&(bar)[XB_TMO])) break; if (_sp > XB_SPIN_CAP) { atomicAdd(&(bar)[XB_TMO], 1u); break; } } } } while (0)
#define XB_LDS_OFF (LDS_BYTES - 64)
__device__ __forceinline__ void xcd_barrier_post(const Params& P) {
    if (threadIdx.x == 0) {
        unsigned* bar = (unsigned*)(P.ws + OFF_BAR);
        volatile __attribute__((address_space(3))) unsigned* st = (volatile __attribute__((address_space(3))) unsigned*)(smem + XB_LDS_OFF);
        st[0] = 0u; st[1] = 0u;
        (void)xb_add(&bar[XB_XCNT(xb_xcc_id())], 1u);
    }
}
__device__ __forceinline__ void xcd_barrier_complete(unsigned* bar, unsigned x, unsigned& nloc, unsigned& nx) {
    const unsigned G = gridDim.x;
    unsigned sum, cnt, mine, sp = 0u;
    for (;;) {
        sum = 0u; cnt = 0u; mine = 0u;
#pragma unroll
        for (unsigned j = 0; j < 16; ++j) { const unsigned c = xb_ld(&bar[XB_XCNT(j)]); sum += c; cnt += (c > 0u) ? 1u : 0u; mine = (j == x) ? c : mine; }
        if (sum == G) break;
        __builtin_amdgcn_s_sleep(1);
        if ((++sp & 255u) == 0u) { if (xb_ld(&bar[XB_TMO])) break; if (sp > XB_SPIN_CAP) { atomicAdd(&bar[XB_TMO], 1u); break; } }
    }
    nloc = mine > 0u ? mine : 1u; nx = cnt > 0u ? cnt : 1u;
}
__device__ __forceinline__ void grid_barrier(const Params& P) {
    asm volatile("s_waitcnt vmcnt(0)" ::: "memory");
    __syncthreads();
    if (threadIdx.x == 0) {
        unsigned* bar = (unsigned*)(P.ws + OFF_BAR);
        volatile __attribute__((address_space(3))) unsigned* st = (volatile __attribute__((address_space(3))) unsigned*)(smem + XB_LDS_OFF);
        const unsigned x = xb_xcc_id();
        __builtin_amdgcn_s_waitcnt(0);
        unsigned nloc = st[0], nx = st[1];
        if (nloc == 0u) { xcd_barrier_complete(bar, x, nloc, nx); st[0] = nloc; st[1] = nx; }
        const unsigned old = xb_add(&bar[XB_XSUB(x)], 1u);
        const unsigned gen = old / nloc;
        if (old + 1u == (gen + 1u) * nloc) {
            __builtin_amdgcn_fence(__ATOMIC_RELEASE, "agent");
            asm volatile("s_waitcnt vmcnt(0)" ::: "memory");
            const unsigned og = xb_add(&bar[XB_TOP], 1u);
            const unsigned tg = og / nx;
            if (og + 1u == (tg + 1u) * nx) xb_add(&bar[XB_TOPGEN], 1u);
            else XB_SPIN(xb_ld(&bar[XB_TOPGEN]) == tg, bar);
            __builtin_amdgcn_fence(__ATOMIC_ACQUIRE, "agent");
            xb_add(&bar[XB_XGEN(x)], 1u);
            asm volatile("s_waitcnt vmcnt(0)" ::: "memory");
        } else {
            XB_SPIN(xb_ld(&bar[XB_XGEN(x)]) == gen, bar);
            __builtin_amdgcn_fence(__ATOMIC_ACQUIRE, "agent");
            asm volatile("s_waitcnt vmcnt(0)" ::: "memory");
        }
    }
    __syncthreads();
}

__global__ void __launch_bounds__(NTHR, 2) hymba_megakernel(Params P) {
    cg::grid_group grid = cg::this_grid();
    char* ws = opq(P.ws);
    xcd_barrier_post(P);
#define BAR() do { grid_barrier(P); if (DUP == 20) grid_barrier(P); } while (0)
    phase0(P);
    if (DUP == 0) { asm volatile("s_waitcnt vmcnt(0)" ::: "memory"); __syncthreads(); grid_barrier(P); phase0(P); }
    asm volatile("s_waitcnt vmcnt(0)" ::: "memory");
    __syncthreads();
    grid.sync();
    BAR();
    phase_pw(P);
    BAR();
    if (DUP == 11) { phase_pw(P); BAR(); }
    int cur = 0;
    for (int L = 0; L < 2; ++L) {
        const int ss_mix = (L == 0) ? 0 : 3, ss_ffn = 1 + L, ss_next = (L == 0) ? 3 : 4, ss_ple = 5 + L;
        phase_proj(P, L, cur, ss_mix);
        BAR();
        if (DUP == 1) { phase_proj(P, L, cur, ss_mix); BAR(); }
        phase_mla_up(P, L);
        BAR();
        if (DUP == 2) { phase_mla_up(P, L); BAR(); }
        phase_attn(P, L, 0);
        BAR();
        if (DUP == 3) { phase_attn(P, L, 1); BAR(); }
        if (DUP >= 30 && DUP < 34) { phase_attn(P, L, 1, DUP - 30); BAR(); }
        phase_wo(P, L, cur ^ 1, ss_ffn);
        BAR();
        if (DUP == 4 && L == 0) { phase_wo(P, L, cur ^ 1, ss_ffn); BAR(); }
        phase_pq(P, L, cur ^ 1, ss_ffn);
        BAR();
        if (DUP == 5) { phase_pq(P, L, cur ^ 1, ss_ffn); BAR(); }
        phase_topk(P, L);
        BAR();
        if (DUP == 6) { phase_topk(P, L); BAR(); }
        phase_gather_u(P, L);
        BAR();
        if (DUP == 7) { phase_gather_u(P, L); BAR(); }
        if (DUP == 10) { phase_gather_act(P, L, ss_ffn, 1); BAR(); }
        phase_gather_act(P, L, ss_ffn);
        BAR();
        if (DUP == 8) { phase_gather_v(P, L, cur, ss_ple, 1); BAR(); }
        phase_gather_v(P, L, cur, ss_ple);
        BAR();
        if (DUP == 9) { phase_ple(P, L, cur, ss_ple, ss_next, 1); BAR(); }
        phase_ple(P, L, cur, ss_ple, ss_next);
        BAR();
        cur ^= 1;
    }
    phase_final(P, 4, cur);
}

extern "C" void kernel_launch(void* const* d_in, const int* in_sizes, int n_in, void* d_out, int out_size, void* d_ws,
                              size_t ws_size, hipStream_t stream) {
    static int grid_blocks = 0;
    if (!grid_blocks) {
        int dev = 0, cus = 0, per_cu = 0;
        hipGetDevice(&dev);
        hipDeviceGetAttribute(&cus, hipDeviceAttributeMultiprocessorCount, dev);
        hipOccupancyMaxActiveBlocksPerMultiprocessor(&per_cu, hymba_megakernel, NTHR, 0);
        if (per_cu > 1) per_cu = 1;
        if (per_cu < 1) per_cu = 1;
        grid_blocks = cus * per_cu;
        if (ws_size < WS_END) fprintf(stderr, "workspace too small: %zu < %zu\n", ws_size, (size_t)WS_END);
    }
    Params P{};
    P.x = (const float*)d_in[0]; P.p = (const float*)d_in[1]; P.pos = (const int*)d_in[2];
    P.norm_mix_g = (const float*)d_in[3]; P.w_in = (const float*)d_in[4]; P.b_forget = (const float*)d_in[5];
    P.mla_q_norm_g = (const float*)d_in[6]; P.w_uq = (const float*)d_in[7]; P.mla_kv_norm_g = (const float*)d_in[8];
    P.w_ukv = (const float*)d_in[9]; P.mix_out_norm_g = (const float*)d_in[10]; P.w_o = (const float*)d_in[11];
    P.norm_ffn_g = (const float*)d_in[12]; P.w_query = (const float*)d_in[13]; P.sub_keys = (const float*)d_in[14];
    P.peer_u = (const float*)d_in[15]; P.peer_v = (const float*)d_in[16]; P.w_ple = (const float*)d_in[17];
    P.ple_norm_g = (const float*)d_in[18]; P.w_ple_gate = (const float*)d_in[19]; P.final_norm_g = (const float*)d_in[20];
    P.out = (float*)d_out; P.ws = (char*)d_ws;
    hipMemsetAsync((char*)d_ws + OFF_BAR, 0, 16384 + 4096, stream);
    void* args[] = {&P};
    hipError_t e = hipLaunchCooperativeKernel((void*)hymba_megakernel, dim3(grid_blocks), dim3(NTHR), args, 0, stream);
    if (e != hipSuccess) fprintf(stderr, "cooperative launch failed: %s (grid %d)\n", hipGetErrorString(e), grid_blocks);
}
```

```cpp
#include <hip/hip_runtime.h>
#include <hip/hip_cooperative_groups.h>
#include <cstdio>
#include <cstdint>
#include <math.h>
#include <climits>
namespace cg = cooperative_groups;

typedef __bf16 bf16;
typedef __bf16 bf16x8 __attribute__((ext_vector_type(8)));
typedef __bf16 bf16x4 __attribute__((ext_vector_type(4)));
typedef __bf16 bf16x2 __attribute__((ext_vector_type(2)));
typedef float f32x16 __attribute__((ext_vector_type(16)));
typedef float f32x4 __attribute__((ext_vector_type(4)));
typedef float f32x2 __attribute__((ext_vector_type(2)));
typedef unsigned u32x4 __attribute__((ext_vector_type(4)));
typedef unsigned u32x2 __attribute__((ext_vector_type(2)));

#define SEQ 2048
#define BATCH 8
#define TOK 16384
#define DM 1024
#define IN_W 1956
#define NEXP 16384
#define EPSF 1e-6f
#define LOG2E 1.4426950408889634f
#define NTHR 512
#define NW 8
#define LDS_BYTES 151808
#define STAGE_BYTES 49152
#define LDS_AUX 147456
#ifndef DUP
#define DUP -1
#endif

constexpr size_t MBy = 1ull << 20;
constexpr size_t OFF_UB = 0;
constexpr size_t OFF_VB = 16 * MBy;
constexpr size_t OFF_PART = 32 * MBy;
constexpr size_t OFF_PW1 = 96 * MBy;
#define LDH 1088
#define LDP 320
#define LDC 192
constexpr size_t OFF_WIN = 128 * MBy;
constexpr size_t OFF_WO = 137 * MBy;
constexpr size_t OFF_WQ = 142 * MBy;
constexpr size_t OFF_WG = 147 * MBy;
constexpr size_t OFF_WP = 152 * MBy;
constexpr size_t OFF_WUQ = 154 * MBy;
constexpr size_t OFF_WUKV = 155 * MBy;
constexpr size_t OFF_SKB = 156 * MBy;
constexpr size_t OFF_CS = 157 * MBy;
constexpr size_t OFF_TSC = 159 * MBy;
constexpr size_t OFF_SSA = 160 * MBy;
constexpr size_t OFF_HB0 = 164 * MBy;
constexpr size_t OFF_HB1 = 200 * MBy;
constexpr size_t OFF_FQ = 236 * MBy;
constexpr size_t OFF_FK = 244 * MBy;
constexpr size_t OFF_FVT = 252 * MBy;
constexpr size_t OFF_SQ = 260 * MBy;
constexpr size_t OFF_SKK = 268 * MBy;
constexpr size_t OFF_SVT = 276 * MBy;
constexpr size_t OFF_CQ = 284 * MBy;
constexpr size_t OFF_CKV = 295 * MBy;
constexpr size_t OFF_FLOG = 302 * MBy;
constexpr size_t OFF_CUMF = 303 * MBy;
constexpr size_t OFF_MQ = 304 * MBy;
constexpr size_t OFF_MK = 316 * MBy;
constexpr size_t OFF_MVT = 328 * MBy;
constexpr size_t OFF_Y = 344 * MBy;
constexpr size_t OFF_PQ = 380 * MBy;
constexpr size_t OFF_IDS = 412 * MBy;
constexpr size_t OFF_GATE = 420 * MBy;
constexpr size_t OFF_BAR = 428 * MBy;
constexpr size_t OFF_CNT = OFF_BAR + 16384;
constexpr size_t OFF_SSY = 429 * MBy;
constexpr size_t OFF_PB = 431 * MBy;
constexpr size_t OFF_PW0 = 452 * MBy;
constexpr size_t OFF_A8 = OFF_PQ;
constexpr size_t OFF_XH = OFF_FQ;
constexpr size_t OFF_XL = OFF_FQ + 16 * MBy;
constexpr size_t WS_END = 484 * MBy;

struct Params {
    const float* x; const float* p; const int* pos;
    const float* norm_mix_g; const float* w_in; const float* b_forget; const float* mla_q_norm_g; const float* w_uq;
    const float* mla_kv_norm_g; const float* w_ukv; const float* mix_out_norm_g; const float* w_o; const float* norm_ffn_g;
    const float* w_query; const float* sub_keys; const float* peer_u; const float* peer_v; const float* w_ple;
    const float* ple_norm_g; const float* w_ple_gate; const float* final_norm_g;
    float* out; char* ws;
};

__shared__ __attribute__((aligned(16))) char smem[LDS_BYTES];

__device__ __forceinline__ int opaque_tid() { int t = threadIdx.x; asm volatile("" : "+v"(t)); return t; }
template <typename T> __device__ __forceinline__ T* opq(T* p) { size_t z = 0; asm volatile("" : "+s"(z)); return (T*)((char*)p + z); }

__device__ __forceinline__ unsigned pack2(float a, float b) {
    f32x2 v = {a, b};
    bf16x2 r = __builtin_convertvector(v, bf16x2);
    return __builtin_bit_cast(unsigned, r);
}
__device__ __forceinline__ float bflo(unsigned u) { return __uint_as_float(u << 16); }
__device__ __forceinline__ float bfhi(unsigned u) { return __uint_as_float(u & 0xffff0000u); }
__device__ __forceinline__ float wave_sum(float v) {
#pragma unroll
    for (int o = 32; o > 0; o >>= 1) v += __shfl_xor(v, o);
    return v;
}
template <int CTRL> __device__ __forceinline__ float dpp_add(float v) {
    return v + __builtin_bit_cast(float, __builtin_amdgcn_update_dpp(0, __builtin_bit_cast(int, v), CTRL, 0xf, 0xf, true));
}
__device__ __forceinline__ float sum8_dpp(float v) { v = dpp_add<0xB1>(v); v = dpp_add<0x4E>(v); v = dpp_add<0x141>(v); return v; }
__device__ __forceinline__ float sumg_dpp(float v) {
    v = dpp_add<0x128>(v);
    float a = v, b = v;
    asm volatile("s_nop 1\n\tv_permlane16_swap_b32 %0, %1\n\ts_nop 1" : "+v"(a), "+v"(b));
    v = a + b;
    a = v; b = v;
    asm volatile("s_nop 1\n\tv_permlane32_swap_b32 %0, %1\n\ts_nop 1" : "+v"(a), "+v"(b));
    return a + b;
}
__device__ __forceinline__ int partner32(int v, int hh) {
    int a = v, b = v;
    asm volatile("s_nop 1\n\tv_permlane32_swap_b32 %0, %1\n\ts_nop 1" : "+v"(a), "+v"(b));
    return hh ? a : b;
}
__device__ __forceinline__ float fexp2(float x) { return __builtin_amdgcn_exp2f(x); }
__device__ __forceinline__ float flog2(float x) { return __builtin_amdgcn_logf(x); }
__device__ __forceinline__ float log_sigmoid_f(float z) { return fminf(z, 0.f) - 0.6931471805599453f * flog2(1.f + fexp2(-1.4426950408889634f * fabsf(z))); }

struct WJob { const float* src; int lds; int K; int Np; bf16* dst; int ldd; const float* gain; int map; };

__device__ __forceinline__ int src_col_map(int map, int c) {
    if (map == 0) return c;
    if (map == 1) {
        if (c < 768) return c;
        if (c < 1952) return c + 4;
        if (c < 1956) return c - 1952 + 768;
        return -1;
    }
    if (c < 256) return 192 * (c >> 6) + (c & 63);
    int e = c - 256;
    return 192 * (e >> 7) + 64 + (e & 127);
}

__device__ __forceinline__ void wconv_tile(const WJob& j, int tile) {
    float* tl = (float*)smem;
    int ktiles = j.K >> 5;
    int nt = tile / ktiles, kt = tile % ktiles;
    int n0 = nt * 32, k0 = kt * 32;
    int tx = opaque_tid() & 31, ty = opaque_tid() >> 5;
    int sc = src_col_map(j.map, n0 + tx);
#pragma unroll
    for (int i = 0; i < 2; ++i) {
        int k = k0 + ty + 16 * i;
        float v = 0.f;
        if (sc >= 0) v = j.src[(size_t)k * j.lds + sc] * (j.gain ? j.gain[k] : 1.f);
        tl[(ty + 16 * i) * 33 + tx] = v;
    }
    __syncthreads();
#pragma unroll
    for (int i = 0; i < 2; ++i) {
        int n = n0 + ty + 16 * i;
        j.dst[(size_t)n * j.ldd + k0 + tx] = (bf16)tl[tx * 33 + ty + 16 * i];
    }
    __syncthreads();
}

__device__ __forceinline__ void phase0(const Params& P) {
    char* ws = opq(P.ws);
    const int G = gridDim.x, bid = blockIdx.x, tid = opaque_tid();
    {
        const int w = tid >> 6, l = tid & 63;
        float* tsc = (float*)(ws + OFF_TSC);
        for (int it = bid * NW + w; it < 4 * NEXP; it += G * NW) {
            int tb = it >> 14, e = it & (NEXP - 1);
            const float* src = (tb < 2 ? P.peer_u : P.peer_v) + ((size_t)(tb & 1) * NEXP + e) * DM + l * 16;
            unsigned char* dst = (unsigned char*)(ws + (tb < 2 ? OFF_UB : OFF_VB)) + (size_t)(tb & 1) * NEXP * 512;
            float4 a = ((const float4*)src)[0], b = ((const float4*)src)[1], c = ((const float4*)src)[2], d = ((const float4*)src)[3];
            if (tb < 2) {
                const float4* g4 = (const float4*)(P.norm_ffn_g + (tb & 1) * 1024 + l * 16);
                float4 g0 = g4[0], g1 = g4[1], g2 = g4[2], g3 = g4[3];
                a.x *= g0.x; a.y *= g0.y; a.z *= g0.z; a.w *= g0.w; b.x *= g1.x; b.y *= g1.y; b.z *= g1.z; b.w *= g1.w;
                c.x *= g2.x; c.y *= g2.y; c.z *= g2.z; c.w *= g2.w; d.x *= g3.x; d.y *= g3.y; d.z *= g3.z; d.w *= g3.w;
            }
            float am = fmaxf(fmaxf(fmaxf(fabsf(a.x), fabsf(a.y)), fmaxf(fabsf(a.z), fabsf(a.w))), fmaxf(fmaxf(fabsf(b.x), fabsf(b.y)), fmaxf(fabsf(b.z), fabsf(b.w))));
            am = fmaxf(am, fmaxf(fmaxf(fmaxf(fabsf(c.x), fabsf(c.y)), fmaxf(fabsf(c.z), fabsf(c.w))), fmaxf(fmaxf(fabsf(d.x), fabsf(d.y)), fmaxf(fabsf(d.z), fabsf(d.w)))));
#pragma unroll
            for (int o = 32; o > 0; o >>= 1) am = fmaxf(am, __shfl_xor(am, o));
            float sc = (am > 0.f) ? (6.0f / am) : 1.f, isc = (am > 0.f) ? (am * (1.f / 6.0f)) : 1.f;
            unsigned w0 = 0, w1 = 0;
            w0 = __builtin_amdgcn_cvt_scalef32_pk_fp4_f32(w0, a.x * sc, a.y * sc, 1.0f, 0);
            w0 = __builtin_amdgcn_cvt_scalef32_pk_fp4_f32(w0, a.z * sc, a.w * sc, 1.0f, 1);
            w0 = __builtin_amdgcn_cvt_scalef32_pk_fp4_f32(w0, b.x * sc, b.y * sc, 1.0f, 2);
            w0 = __builtin_amdgcn_cvt_scalef32_pk_fp4_f32(w0, b.z * sc, b.w * sc, 1.0f, 3);
            w1 = __builtin_amdgcn_cvt_scalef32_pk_fp4_f32(w1, c.x * sc, c.y * sc, 1.0f, 0);
            w1 = __builtin_amdgcn_cvt_scalef32_pk_fp4_f32(w1, c.z * sc, c.w * sc, 1.0f, 1);
            w1 = __builtin_amdgcn_cvt_scalef32_pk_fp4_f32(w1, d.x * sc, d.y * sc, 1.0f, 2);
            w1 = __builtin_amdgcn_cvt_scalef32_pk_fp4_f32(w1, d.z * sc, d.w * sc, 1.0f, 3);
            u32x2 o2 = {w0, w1};
            *(u32x2*)(dst + ((size_t)(l >> 4) * NEXP + e) * 128 + (l & 15) * 8) = o2;
            if (l == 0) tsc[tb * NEXP + e] = isc;
        }
    }
    {
        for (int L = 0; L < 2; ++L) {
            WJob jobs[7];
            jobs[0] = {P.w_in + (size_t)L * 1024 * IN_W, IN_W, 1024, 2048, (bf16*)(ws + OFF_WIN) + (size_t)L * 2048 * LDH, LDH, P.norm_mix_g + L * 1024, 1};
            jobs[1] = {P.w_o + (size_t)L * 1024 * 1024, 1024, 1024, 1024, (bf16*)(ws + OFF_WO) + (size_t)L * 1024 * LDH, LDH, P.mix_out_norm_g + L * 1024, 0};
            jobs[2] = {P.w_query + (size_t)L * 1024 * 1024, 1024, 1024, 1024, (bf16*)(ws + OFF_WQ) + (size_t)L * 1024 * LDH, LDH, P.norm_ffn_g + L * 1024, 0};
            jobs[3] = {P.w_ple_gate + (size_t)L * 1024 * 1024, 1024, 1024, 1024, (bf16*)(ws + OFF_WG) + (size_t)L * 1024 * LDH, LDH, P.ple_norm_g + L * 1024, 0};
            jobs[4] = {P.w_ple + (size_t)L * 256 * 1024, 1024, 256, 1024, (bf16*)(ws + OFF_WP) + (size_t)L * 1024 * LDP, LDP, nullptr, 0};
            jobs[5] = {P.w_uq + (size_t)L * 256 * 384, 384, 256, 384, (bf16*)(ws + OFF_WUQ) + (size_t)L * 384 * LDP, LDP, P.mla_q_norm_g + L * 256, 0};
            jobs[6] = {P.w_ukv + (size_t)L * 128 * 768, 768, 128, 768, (bf16*)(ws + OFF_WUKV) + (size_t)L * 768 * LDC, LDC, P.mla_kv_norm_g + L * 128, 2};
#pragma unroll
            for (int q = 0; q < 7; ++q) {
                int nt = (jobs[q].Np >> 5) * (jobs[q].K >> 5);
                for (int it = bid; it < nt; it += G) wconv_tile(jobs[q], it);
            }
        }
    }
    {
        const float* src = P.sub_keys;
        bf16* dst = (bf16*)(ws + OFF_SKB);
        for (int i = bid * NTHR + tid; i < 262144 / 2; i += G * NTHR) {
            float2 v = ((const float2*)src)[i];
            ((unsigned*)dst)[i] = pack2(v.x, v.y);
        }
    }
    {
        const float4* src = (const float4*)P.p;
        bf16* dst = (bf16*)(ws + OFF_PB);
        for (int i = bid * NTHR + tid; i < 2 * TOK * 256 / 8; i += G * NTHR) {
            float4 a = src[2 * i], b = src[2 * i + 1];
            u32x4 o = {pack2(a.x, a.y), pack2(a.z, a.w), pack2(b.x, b.y), pack2(b.z, b.w)};
            *(u32x4*)(dst + (size_t)(i >> 5) * LDP + (i & 31) * 8) = o;
        }
    }
    {
        bf16* hb = (bf16*)(ws + OFF_HB0);
        float* ss0 = (float*)(ws + OFF_SSA);
        int w = tid >> 6, l = tid & 63;
        for (int row = bid * NW + w; row < TOK; row += G * NW) {
            const float4* xr = (const float4*)(P.x + (size_t)row * DM);
            float ss = 0.f;
#pragma unroll
            for (int i = 0; i < 2; ++i) {
                float4 a = xr[i * 128 + l * 2], b = xr[i * 128 + l * 2 + 1];
                ss += a.x * a.x + a.y * a.y + a.z * a.z + a.w * a.w + b.x * b.x + b.y * b.y + b.z * b.z + b.w * b.w;
                uint4 o;
                o.x = pack2(a.x, a.y); o.y = pack2(a.z, a.w); o.z = pack2(b.x, b.y); o.w = pack2(b.z, b.w);
                ((uint4*)(hb + (size_t)row * LDH))[i * 64 + l] = o;
            }
            ss = wave_sum(ss);
            if (l == 0) {
                *(float4*)(ss0 + (size_t)row * 8) = make_float4(ss, 0.f, 0.f, 0.f);
                *(float4*)(ss0 + (size_t)row * 8 + 4) = make_float4(0.f, 0.f, 0.f, 0.f);
            }
        }
    }
    {
        float* cs = (float*)(ws + OFF_CS);
        for (int i = bid * NTHR + tid; i < TOK * 16; i += G * NTHR) {
            int t = i >> 4, k = i & 15;
            float inv = powf(10000.0f, -(float)k / 16.0f);
            float ang = (float)P.pos[t] * inv;
            cs[2 * i] = cosf(ang);
            cs[2 * i + 1] = sinf(ang);
        }
    }
}

struct NoHook { static constexpr bool nodma = false; __device__ __forceinline__ void operator()(int, f32x16 (&)[2][2]) const {} };
struct NoDmaHook { static constexpr bool nodma = true; __device__ __forceinline__ void operator()(int, f32x16 (&)[2][2]) const {} };
template <typename HOOK>
__device__ __forceinline__ void gemm_core(f32x16 (&acc)[2][2], const bf16* A, int lda, const bf16* Bt, int ldb, int K,
                                          int m0, int n0, HOOK hook) {
    const int tid = opaque_tid(), w = tid >> 6, l = tid & 63, r = l & 31, hh = l >> 5;
    const int wm = w >> 1, wn = w & 1;
    const int dp = (tid & 15) ^ ((tid >> 4) & 15);
    const int drow = 2 * (tid >> 4) + (dp >> 3), dgc = (dp & 7) * 8;
    const bf16* asrc = A + (size_t)(m0 + drow) * lda + dgc;
    const bf16* bsrc = Bt + (size_t)(n0 + drow) * ldb + dgc;
    auto dma = [&](int buf, int k0) {
        if (HOOK::nodma) return;
        char* base = smem + buf * STAGE_BYTES + tid * 16;
#pragma unroll
        for (int i = 0; i < 4; ++i)
            __builtin_amdgcn_global_load_lds((const unsigned*)(asrc + (size_t)(64 * i) * lda + k0), (unsigned*)(base + i * 8192), 16, 0, 0);
#pragma unroll
        for (int i = 0; i < 2; ++i)
            __builtin_amdgcn_global_load_lds((const unsigned*)(bsrc + (size_t)(64 * i) * ldb + k0), (unsigned*)(base + 32768 + i * 8192), 16, 0, 0);
    };
    int offA[2], offB[2];
#pragma unroll
    for (int i = 0; i < 2; ++i) { offA[i] = ((wm * 64 + i * 32 + r) >> 1) * 256; offB[i] = 32768 + ((wn * 64 + i * 32 + r) >> 1) * 256; }
    const int pbase = ((r & 1) << 3), lx = (r >> 1) & 15;
    const int nk = K >> 6;
    const unsigned ldsbase = (unsigned)(size_t)(__attribute__((address_space(3))) char*)smem;
    auto ldfrag = [&](int stage, int s, bf16x8 (&af)[2], bf16x8 (&bfr)[2]) {
        unsigned ch = (unsigned)((((pbase | (2 * s + hh)) ^ lx) << 4)) + ldsbase + (unsigned)(stage * STAGE_BYTES);
        unsigned a0a = ch + offA[0], a1a = ch + offA[1], b0a = ch + offB[0], b1a = ch + offB[1];
        asm volatile("ds_read_b128 %0, %4\n\tds_read_b128 %1, %5\n\tds_read_b128 %2, %6\n\tds_read_b128 %3, %7"
                     : "=&v"(af[0]), "=&v"(af[1]), "=&v"(bfr[0]), "=&v"(bfr[1]) : "v"(a0a), "v"(a1a), "v"(b0a), "v"(b1a) : "memory");
    };
    auto mma = [&](bf16x8 (&af)[2], bf16x8 (&bfr)[2]) {
#pragma unroll
        for (int i = 0; i < 2; ++i)
#pragma unroll
            for (int j = 0; j < 2; ++j) acc[i][j] = __builtin_amdgcn_mfma_f32_32x32x16_bf16(af[i], bfr[j], acc[i][j], 0, 0, 0);
    };
#define LGKM_WAIT(n) do { asm volatile("s_waitcnt lgkmcnt(" #n ")" ::: "memory"); __builtin_amdgcn_sched_barrier(0); } while (0)
    asm volatile("s_waitcnt vmcnt(0)" ::: "memory");
    dma(0, 0);
    dma(1, 64);
    if (nk > 2) { dma(2, 128); asm volatile("s_waitcnt vmcnt(12)" ::: "memory"); }
    else asm volatile("s_waitcnt vmcnt(6)" ::: "memory");
    __builtin_amdgcn_s_barrier();
    bf16x8 a0[2], b0[2], a1[2], b1[2];
    ldfrag(0, 0, a0, b0);
    int cur = 0;
    for (int kt = 0; kt < nk; ++kt) {
        const int nxt = (cur == 2) ? 0 : cur + 1;
        if (kt == 4 || kt == 8) { LGKM_WAIT(0); hook(kt, acc); }
        ldfrag(cur, 1, a1, b1);
        LGKM_WAIT(4);
        mma(a0, b0);
        ldfrag(cur, 2, a0, b0);
        LGKM_WAIT(4);
        mma(a1, b1);
        ldfrag(cur, 3, a1, b1);
        LGKM_WAIT(4);
        mma(a0, b0);
        if (kt + 1 < nk) {
            if (kt + 2 < nk) asm volatile("s_waitcnt vmcnt(6) lgkmcnt(0)" ::: "memory");
            else asm volatile("s_waitcnt vmcnt(0) lgkmcnt(0)" ::: "memory");
            __builtin_amdgcn_s_barrier();
            __builtin_amdgcn_sched_barrier(0);
            if (kt + 3 < nk) dma(cur, (kt + 3) << 6);
            ldfrag(nxt, 0, a0, b0);
        } else {
            LGKM_WAIT(0);
        }
        mma(a1, b1);
        cur = nxt;
    }
    __syncthreads();
}
__device__ __forceinline__ float row_rs8(const float* part, int row) {
    float4 a = *(const float4*)(part + (size_t)row * 8), b = *(const float4*)(part + (size_t)row * 8 + 4);
    float ss = ((a.x + a.y) + (a.z + a.w)) + ((b.x + b.y) + (b.z + b.w));
    return rsqrtf(ss * (1.f / 1024.f) + EPSF);
}
__device__ __forceinline__ bool xcd_tile(int it, int MT, int NT, int& mt, int& nt) {
    const int G = gridDim.x, bid = blockIdx.x;
    if ((G & 7) == 0 && (MT & 7) == 0) {
        const int nbx = G >> 3, q = (bid >> 3) + it * nbx, per = (MT >> 3) * NT;
        if (q >= per) return false;
        mt = (bid & 7) * (MT >> 3) + q / NT; nt = q % NT;
        return true;
    }
    const int q = bid + it * G;
    if (q >= MT * NT) return false;
    mt = q / NT; nt = q % NT;
    return true;
}
struct NoScale { __device__ __forceinline__ float operator()(int, int) const { return 1.f; } };

#define ZERO_ACC(acc)                                  \
    _Pragma("unroll") for (int _i = 0; _i < 2; ++_i)   \
    _Pragma("unroll") for (int _j = 0; _j < 2; ++_j)   \
    _Pragma("unroll") for (int _r = 0; _r < 16; ++_r) acc[_i][_j][_r] = 0.f;


namespace pg8 {
#define PG8_LAS __attribute__((address_space(3)))
typedef unsigned short bf16_t;
constexpr int BM = 256, BK = 64, HALF = 128, HTB = HALF * BK * 2  , NXCD = 8, WGM = 8;

__host__ __device__ __forceinline__ int lds_byte(int r, int c) { const int st = (r >> 4) * 2 + (c >> 5), rr = r & 15, cc = c & 31, ob = rr * 64 + cc * 2; return st * 1024 + (ob ^ (((ob >> 9) & 1) << 5)); }
__host__ __device__ __forceinline__ void stage_rc(int b, int& R, int& C) { const int st = b / 1024, sb = b % 1024, swz = sb ^ (((sb >> 9) & 1) << 5); R = (st >> 1) * 16 + swz / 64; C = (st & 1) * 32 + (swz % 64) / 2; }
__host__ __device__ __forceinline__ int perm32(int rho) { const int n = rho >> 4, i = rho & 15; return 8 * (i >> 2) + 4 * n + (i & 3); }
struct Unit { int pm, pn; };
struct Gemm { const bf16* A; const bf16* Bt; int lda, ldb, M, N, K; };
struct StaticOrder {
    int nM, nN, nwg, G, c;
    __device__ void init(int M, int N, int G_, int c_) { nM = M / BM; nN = N / BM; nwg = nM * nN; G = G_; c = c_; }
    __device__ bool next(int i, Unit& u) const {
        const long L = (long)i * G + c; if (L >= nwg) return false;
        int wgid = (int)L; { const int q = nwg / NXCD, r = nwg % NXCD, xcd = wgid % NXCD, off = wgid / NXCD; wgid = (xcd < r ? xcd * (q + 1) : r * (q + 1) + (xcd - r) * q) + off; }
        const int nig = WGM * nN, gid = wgid / nig, fm = gid * WGM, gsz = (nM - fm) < WGM ? (nM - fm) : WGM;
        u.pm = fm + ((wgid % nig) % gsz); u.pn = (wgid % nig) / gsz; return true;
    }
    __device__ __forceinline__ void a_ready(const Unit&) const {}
    __device__ __forceinline__ void done(const Unit&) const {}
};
template <class Epi, class Sched, bool STAMP = false>
__device__ __forceinline__ void gemm_phase(PG8_LAS unsigned char* lds, const Gemm g, const Sched& S, const Epi& E, unsigned long long* stamps) {
    const int tid = opaque_tid(), wid = __builtin_amdgcn_readfirstlane(tid >> 6), lane = tid & 63, wr = wid >> 2, wc = wid & 3, fr = lane & 15, fq = lane >> 4;
    const int K = g.K, nt = K / BK;
    int ts_lo = 0, ts_hi = 0, nts = 0; const unsigned long long rt_entry = STAMP ? (unsigned long long)wall_clock64() : 0ull;
#define PG8_STAMP() do { if (STAMP && wid == 0 && nts < 64) { const unsigned long long _c = (unsigned long long)clock64(); \
        ts_lo = (lane == nts) ? (int)(unsigned)_c : ts_lo; ts_hi = (lane == nts) ? (int)(unsigned)(_c >> 32) : ts_hi; ++nts; } } while (0)
    PG8_STAMP();
    unsigned voffA[2], voffB[2];
#pragma unroll
    for (int i = 0; i < 2; ++i) { int R, C; stage_rc(tid * 16 + i * 8192, R, C); const int Rb = Epi::PERM ? ((R & ~31) + perm32(R & 31)) : R;
        voffA[i] = (unsigned)(R * g.lda + C) * 2u; voffB[i] = (unsigned)(Rb * g.ldb + C) * 2u; }
    const size_t kstep = (size_t)(BK * 2);
    const size_t hstepA = (size_t)HALF * g.lda * 2, hstepB = (size_t)HALF * g.ldb * 2;
    const size_t tstepA = 2 * hstepA, tstepB = 2 * hstepB;
    const unsigned ldsw = (unsigned)wid * 1024u;
    const int aoff = lds_byte(wr * 64 + fr, fq * 8), boff = lds_byte(wc * 32 + fr, fq * 8);
#define PG8_SA(b, h) (((b) * 2 + (h)) * HTB)
#define PG8_SB(b, h) ((4 + (b) * 2 + (h)) * HTB)
#define PG8_STAGE(bufoff, gbase, voff) do { _Pragma("unroll") for (int _i = 0; _i < 2; ++_i) \
        __builtin_amdgcn_global_load_lds((const unsigned*)((const char*)(gbase) + (voff)[_i]), (PG8_LAS unsigned*)(lds + (bufoff) + ldsw + _i * 8192), 16, 0, 0); } while (0)
#define PG8_LDA(dst, b, h) do { _Pragma("unroll") for (int m = 0; m < 4; ++m) _Pragma("unroll") for (int k = 0; k < 2; ++k) dst[m][k] = *(const PG8_LAS bf16x8*)(lds + PG8_SA(b, h) + aoff + m * 2048 + k * 1024); } while (0)
#define PG8_LDB(dst, b, h) do { _Pragma("unroll") for (int n = 0; n < 2; ++n) _Pragma("unroll") for (int k = 0; k < 2; ++k) dst[n][k] = *(const PG8_LAS bf16x8*)(lds + PG8_SB(b, h) + boff + n * 2048 + k * 1024); } while (0)
#define PG8_MMA(ai, bj, At, Bt) do { __builtin_amdgcn_s_setprio(1); _Pragma("unroll") for (int m = 0; m < 4; ++m) _Pragma("unroll") for (int n = 0; n < 2; ++n) _Pragma("unroll") for (int k = 0; k < 2; ++k) \
        acc[ai][bj][m][n] = __builtin_amdgcn_mfma_f32_16x16x32_bf16(Bt[n][k], At[m][k], acc[ai][bj][m][n], 0, 0, 0); __builtin_amdgcn_s_setprio(0); } while (0)
#define PG8_WAIT_V(n) asm volatile("s_waitcnt vmcnt(" #n ")" ::: "memory")
#define PG8_WAIT_L(n) asm volatile("s_waitcnt lgkmcnt(" #n ")" ::: "memory")
#define PG8_BAR __builtin_amdgcn_s_barrier()
#define PG8_SCHED __builtin_amdgcn_sched_barrier(0)
    Unit cur, nxt; int ui = 0;
    if (!S.next(0, cur)) return;
    f32x4 acc[2][2][4][2];
#pragma unroll
    for (int a = 0; a < 2; ++a)
#pragma unroll
        for (int b = 0; b < 2; ++b)
#pragma unroll
            for (int m = 0; m < 4; ++m)
#pragma unroll
                for (int n = 0; n < 2; ++n) acc[a][b][m][n] = (f32x4){0.f, 0.f, 0.f, 0.f};
    bf16x8 At[4][2], B0[2][2], B1[2][2];
    const char* cA = (const char*)g.A + (size_t)cur.pm * tstepA; const char* cB = (const char*)g.Bt + (size_t)cur.pn * tstepB;
    S.a_ready(cur);
    PG8_STAGE(PG8_SB(0, 0), cB, voffB); PG8_STAGE(PG8_SA(0, 0), cA, voffA); PG8_STAGE(PG8_SB(0, 1), cB + hstepB, voffB); PG8_STAGE(PG8_SA(0, 1), cA + hstepA, voffA);
    if (wr == 1) PG8_BAR;
    PG8_WAIT_V(4); PG8_BAR;
    PG8_STAGE(PG8_SB(1, 0), cB + kstep, voffB); PG8_STAGE(PG8_SA(1, 0), cA + kstep, voffA); PG8_STAGE(PG8_SB(1, 1), cB + hstepB + kstep, voffB);
    PG8_WAIT_V(6); PG8_BAR;
    PG8_STAMP();
    for (;;) {
        const bool has_next = S.next(ui + 1, nxt);
        const char* nA = has_next ? (const char*)g.A + (size_t)nxt.pm * tstepA : cA; const char* nB = has_next ? (const char*)g.Bt + (size_t)nxt.pn * tstepB : cB;
        for (int t = 0; t < nt; t += 2) {
            const bool last = (t == nt - 2);
            const char* a1 = cA + (size_t)(t + 1) * kstep;
            const char* a2 = last ? nA : cA + (size_t)(t + 2) * kstep; const char* b2 = last ? nB : cB + (size_t)(t + 2) * kstep;
            const char* a3 = a2 + kstep; const char* b3 = b2 + kstep;
            if (last && has_next) S.a_ready(nxt);
            E.khook(t, acc, wr, fr);
            PG8_LDB(B0, 0, 0); PG8_SCHED; PG8_LDA(At, 0, 0); PG8_STAGE(PG8_SA(1, 1), a1 + hstepA, voffA);
            PG8_WAIT_L(8); PG8_BAR; PG8_WAIT_L(0); PG8_MMA(0, 0, At, B0); PG8_BAR; PG8_SCHED;
            PG8_LDB(B1, 0, 1); PG8_STAGE(PG8_SB(0, 0), b2, voffB);
            PG8_BAR; PG8_WAIT_L(0); PG8_MMA(0, 1, At, B1); PG8_BAR;
            PG8_LDA(At, 0, 1); PG8_STAGE(PG8_SA(0, 0), a2, voffA);
            PG8_BAR; PG8_WAIT_L(0); PG8_MMA(1, 0, At, B0); PG8_BAR; PG8_SCHED;
            PG8_STAGE(PG8_SB(0, 1), b2 + hstepB, voffB);
            PG8_WAIT_V(6); PG8_BAR; PG8_MMA(1, 1, At, B1); PG8_BAR;
            PG8_LDB(B0, 1, 0); PG8_SCHED; PG8_LDA(At, 1, 0); PG8_STAGE(PG8_SA(0, 1), a2 + hstepA, voffA);
            PG8_WAIT_L(8); PG8_BAR; PG8_WAIT_L(0); PG8_MMA(0, 0, At, B0); PG8_BAR; PG8_SCHED;
            PG8_LDB(B1, 1, 1); PG8_STAGE(PG8_SB(1, 0), b3, voffB);
            PG8_BAR; PG8_WAIT_L(0); PG8_MMA(0, 1, At, B1); PG8_BAR;
            PG8_LDA(At, 1, 1); PG8_STAGE(PG8_SA(1, 0), a3, voffA);
            PG8_BAR; PG8_WAIT_L(0); PG8_MMA(1, 0, At, B0); PG8_BAR; PG8_SCHED;
            PG8_STAGE(PG8_SB(1, 1), b3 + hstepB, voffB);
            PG8_WAIT_V(6); PG8_BAR; PG8_MMA(1, 1, At, B1); PG8_BAR;
        }
        PG8_STAMP();
        if constexpr (!Epi::AFTER_DRAIN) { E(acc, cur, wr, wc, fr, fq); S.done(cur); }
        PG8_STAMP();
        if (!has_next) break;
#pragma unroll
        for (int a = 0; a < 2; ++a)
#pragma unroll
            for (int b = 0; b < 2; ++b)
#pragma unroll
                for (int m = 0; m < 4; ++m)
#pragma unroll
                    for (int n = 0; n < 2; ++n) acc[a][b][m][n] = (f32x4){0.f, 0.f, 0.f, 0.f};
        cur = nxt; cA = nA; cB = nB; ++ui;
    }
    PG8_WAIT_V(0);
    if (wr == 0) PG8_BAR;
    PG8_BAR;
    if constexpr (Epi::AFTER_DRAIN) { E.fused(acc, cur, wr, wc, fr, fq, lds, wid, lane); S.done(cur); }
    PG8_STAMP();
    if (STAMP && wid == 0) { stamps[lane] = lane < nts ? (((unsigned long long)(unsigned)ts_hi << 32) | (unsigned)ts_lo) : 0ull;
        if (lane == 62) stamps[62] = rt_entry; if (lane == 63) stamps[63] = (unsigned long long)wall_clock64(); }
#undef PG8_STAMP
#undef PG8_SA
#undef PG8_SB
#undef PG8_STAGE
#undef PG8_LDA
#undef PG8_LDB
#undef PG8_MMA
#undef PG8_WAIT_V
#undef PG8_WAIT_L
#undef PG8_BAR
#undef PG8_SCHED
}
}

#define TB_LD 136
#define TF_LD 132
template <bool SCALE>
__device__ __forceinline__ void stage_bf16(const f32x16 (&acc)[2][2], const float* rsl) {
    bf16* T = (bf16*)smem;
    const int tid = opaque_tid(), w = tid >> 6, l = tid & 63, hh = l >> 5, wm = w >> 1, wn = w & 1;
#pragma unroll
    for (int i = 0; i < 2; ++i)
#pragma unroll
        for (int rr = 0; rr < 16; ++rr) {
            int row = wm * 64 + i * 32 + (rr & 3) + 8 * (rr >> 2) + 4 * hh;
            float sc = SCALE ? rsl[row] : 1.f;
#pragma unroll
            for (int j = 0; j < 2; ++j) T[row * TB_LD + wn * 64 + j * 32 + (l & 31)] = (bf16)(acc[i][j][rr] * sc);
        }
    __syncthreads();
}
template <bool SCALE>
__device__ __forceinline__ void stage_f32(const f32x16 (&acc)[2][2], const float* rsl) {
    float* T = (float*)smem;
    const int tid = opaque_tid(), w = tid >> 6, l = tid & 63, hh = l >> 5, wm = w >> 1, wn = w & 1;
#pragma unroll
    for (int i = 0; i < 2; ++i)
#pragma unroll
        for (int rr = 0; rr < 16; ++rr) {
            int row = wm * 64 + i * 32 + (rr & 3) + 8 * (rr >> 2) + 4 * hh;
            float sc = SCALE ? rsl[row] : 1.f;
#pragma unroll
            for (int j = 0; j < 2; ++j) T[row * TF_LD + wn * 64 + j * 32 + (l & 31)] = acc[i][j][rr] * sc;
        }
    __syncthreads();
}
template <typename CMAP>
__device__ __forceinline__ void store_rows_bf16(bf16* dst, int ld, int m0, CMAP cmap) {
    const bf16* T = (const bf16*)smem;
    const int tid = opaque_tid();
#pragma unroll
    for (int q = 0; q < 8; ++q) {
        int id = tid + 512 * q, row = id >> 4, ch = id & 15;
        u32x4 v = *(const u32x4*)(T + row * TB_LD + ch * 8);
        *(u32x4*)(dst + (size_t)(m0 + row) * ld + cmap(ch * 8)) = v;
    }
}
__device__ __forceinline__ void store_cols_bf16(bf16* vt, size_t crow0, int s0) {
    const unsigned short* T = (const unsigned short*)smem;
    const int tid = opaque_tid();
#pragma unroll
    for (int q = 0; q < 8; ++q) {
        int id = tid + 512 * q, c = id & 127, sg = id >> 7;
        unsigned e[8];
#pragma unroll
        for (int k = 0; k < 8; ++k) e[k] = T[(8 * sg + k) * TB_LD + c];
        u32x4 v = {e[0] | (e[1] << 16), e[2] | (e[3] << 16), e[4] | (e[5] << 16), e[6] | (e[7] << 16)};
        *(u32x4*)(vt + (crow0 + c) * SEQ + s0 + 8 * sg) = v;
    }
}
__device__ __forceinline__ void residual_store(const float* hin, float* hout, bf16* hb_out, float* gss, int m0, int n0, int nt) {
    const float* T = (const float*)smem;
    const int tid = opaque_tid(), l = tid & 63;
#pragma unroll 4
    for (int q = 0; q < 16; ++q) {
        int id = tid + 512 * q, row = id >> 5, ch = id & 31;
        f32x4 d = *(const f32x4*)(T + row * TF_LD + ch * 4);
        size_t gi = (size_t)(m0 + row) * 1024 + n0 + ch * 4;
        f32x4 h = *(const f32x4*)(hin + gi);
        f32x4 v = h + d;
        *(f32x4*)(hout + gi) = v;
        u32x2 b = {pack2(v.x, v.y), pack2(v.z, v.w)};
        *(u32x2*)(hb_out + (size_t)(m0 + row) * LDH + n0 + ch * 4) = b;
        float ss = v.x * v.x + v.y * v.y + v.z * v.z + v.w * v.w;
        ss = dpp_add<0xB1>(ss); ss = dpp_add<0x4E>(ss); ss = dpp_add<0x141>(ss); ss = dpp_add<0x140>(ss);
        ss += __shfl_xor(ss, 16);
        if ((l & 31) == 0) gss[(size_t)(m0 + row) * 8 + nt] = ss;
    }
}
struct ColAdd { int off; __device__ __forceinline__ int operator()(int c) const { return c + off; } };
struct ColHead96 { __device__ __forceinline__ int operator()(int c) const { return (c >> 6) * 96 + (c & 63); } };

struct EpiProj {
    static constexpr bool PERM = true, AFTER_DRAIN = false;
    const float* ssrow; char* ws;
    __device__ __forceinline__ void khook(int, f32x4 (&)[2][2][4][2], int, int) const {}
    __device__ __forceinline__ void operator()(const f32x4 (&acc)[2][2][4][2], const pg8::Unit& u, int wr, int wc, int fr, int fqd) const {
        asm volatile("" : "+v"(fr), "+v"(fqd));
        const int row0 = u.pm * 256 + wr * 64 + fr, lc0 = wc * 32 + 8 * fqd, pn = u.pn;
        size_t doff; int ld = 256;
        if (pn == 0) doff = OFF_FQ; else if (pn == 1) doff = OFF_FK; else if (pn == 2) doff = OFF_PART;
        else if (pn == 3) doff = OFF_SQ; else if (pn == 4) doff = OFF_SKK; else if (pn == 5) doff = OFF_PART + 8 * MBy;
        else if (pn == 6) { doff = OFF_CQ; ld = LDP; } else { doff = OFF_CKV; ld = LDC; }
        bf16* dst = (bf16*)(ws + doff);
        bf16* mk = (bf16*)(ws + OFF_MK); float* flog = (float*)(ws + OFF_FLOG); const float* cs = (const float*)(ws + OFF_CS);
#pragma unroll
        for (int ai = 0; ai < 2; ++ai)
#pragma unroll
            for (int m = 0; m < 4; ++m) {
                const int row = row0 + ai * 128 + m * 16;
                const float rs = row_rs8(ssrow, row);
#pragma unroll
                for (int bj = 0; bj < 2; ++bj) {
                    f32x4 v0 = acc[ai][bj][m][0] * rs, v1 = acc[ai][bj][m][1] * rs;
                    if (pn < 7 || bj == 0) {
                        u32x4 wv = {pack2(v0[0], v0[1]), pack2(v0[2], v0[3]), pack2(v1[0], v1[1]), pack2(v1[2], v1[3])};
                        *(u32x4*)(dst + (size_t)row * ld + bj * 128 + lc0) = wv;
                    } else if (wc == 0) {
                        const int hh = fqd >> 1, pi = 8 * (fqd & 1);
                        float vv[8] = {v0[0], v0[1], v0[2], v0[3], v1[0], v1[1], v1[2], v1[3]}, ov[8];
                        const f32x4* c4 = (const f32x4*)(cs + ((size_t)row * 16 + pi) * 2);
                        f32x4 t0 = c4[0], t1 = c4[1], t2 = c4[2], t3 = c4[3];
                        float cc[8] = {t0.x, t0.z, t1.x, t1.z, t2.x, t2.z, t3.x, t3.z}, sn[8] = {t0.y, t0.w, t1.y, t1.w, t2.y, t2.w, t3.y, t3.w};
#pragma unroll
                        for (int e = 0; e < 8; ++e) {
                            float pv = __builtin_bit_cast(float, partner32(__builtin_bit_cast(int, vv[e]), hh));
                            ov[e] = hh ? (pv * sn[e] + vv[e] * cc[e]) : (vv[e] * cc[e] - pv * sn[e]);
                        }
                        u32x4 wv = {pack2(ov[0], ov[1]), pack2(ov[2], ov[3]), pack2(ov[4], ov[5]), pack2(ov[6], ov[7])};
#pragma unroll
                        for (int h = 0; h < 4; ++h) *(u32x4*)(mk + (size_t)row * 384 + h * 96 + 64 + 8 * fqd) = wv;
                    } else if (wc == 1 && fqd == 0) {
                        *(f32x4*)(flog + (size_t)row * 4) = v0;
                    }
                }
            }
    }
};
__device__ __forceinline__ void phase_proj(const Params& P, int L, int hsel, int ss_slot) {
    char* ws = opq(P.ws);
    const float* ssrow = (const float*)(ws + OFF_SSA) + (size_t)ss_slot * TOK * 8;
    const bf16* hb = (const bf16*)(ws + (hsel ? OFF_HB1 : OFF_HB0));
    const bf16* Bt = (const bf16*)(ws + OFF_WIN) + (size_t)L * 2048 * LDH;
    pg8::Gemm g{hb, Bt, LDH, LDH, TOK, 2048, 1024};
    pg8::StaticOrder S; S.init(TOK, 2048, gridDim.x, blockIdx.x);
    EpiProj E{ssrow, ws};
    pg8::gemm_phase((PG8_LAS unsigned char*)smem, g, S, E, nullptr);
    __syncthreads();
}

template <int KW>
__device__ __forceinline__ void row_rms_to_lds(const bf16* A, int lda, int m0) {
    const int tid = opaque_tid(), row = tid >> 1, half = tid & 1;
    float ss = 0.f;
    const u32x4* p = (const u32x4*)(A + (size_t)(m0 + row) * lda + half * (KW / 2));
#pragma unroll
    for (int q = 0; q < KW / 16; ++q) {
        u32x4 v = p[q];
        float a;
        a = bflo(v.x); ss += a * a; a = bfhi(v.x); ss += a * a;
        a = bflo(v.y); ss += a * a; a = bfhi(v.y); ss += a * a;
        a = bflo(v.z); ss += a * a; a = bfhi(v.z); ss += a * a;
        a = bflo(v.w); ss += a * a; a = bfhi(v.w); ss += a * a;
    }
    ss += __shfl_xor(ss, 1);
    if (half == 0) ((float*)(smem + LDS_AUX))[row] = rsqrtf(ss * (1.f / (float)KW) + EPSF);
}

__device__ __forceinline__ void phase_mla_up(const Params& P, int L) {
    char* ws = opq(P.ws);
    const bf16* cq = (const bf16*)(ws + OFF_CQ); const bf16* ckv = (const bf16*)(ws + OFF_CKV);
    const bf16* wuq = (const bf16*)(ws + OFF_WUQ) + (size_t)L * 384 * LDP;
    const bf16* wukv = (const bf16*)(ws + OFF_WUKV) + (size_t)L * 768 * LDC;
    bf16* mq = (bf16*)(ws + OFF_MQ); bf16* mk = (bf16*)(ws + OFF_MK); bf16* mvt = (bf16*)(ws + OFF_MVT);
    const float* cs = (const float*)(ws + OFF_CS);
    const float* flog = (const float*)(ws + OFF_FLOG);
    float* cumF = (float*)(ws + OFF_CUMF);
    const int tid = opaque_tid(), w = tid >> 6, l = tid & 63, hh = l >> 5, wm = w >> 1, wn = w & 1;
    const int NQ = 64 * 3, NKV = 64 * 6, NCF = 4;
    const float* aux = (const float*)(smem + LDS_AUX);
    for (int gw = blockIdx.x * NW + w; gw < 2048; gw += gridDim.x * NW) {
        const int type = gw >> 10, bh = (gw >> 5) & 31, tb = gw & 31, b = bh >> 2, h = bh & 3;
        const bf16* src = (const bf16*)(ws + OFF_PART + (type ? 8 * MBy : 0)) + ((size_t)(b * SEQ + tb * 64 + l) * 256 + h * 64);
        unsigned short* dst = (unsigned short*)(ws + (type ? OFF_SVT : OFF_FVT)) + (size_t)bh * 64 * SEQ + tb * 64 + l;
        u32x4 rv8[8];
#pragma unroll
        for (int q = 0; q < 8; ++q) rv8[q] = ((const u32x4*)src)[q];
#pragma unroll
        for (int q = 0; q < 8; ++q) {
            dst[(size_t)(8 * q + 0) * SEQ] = (unsigned short)(rv8[q].x & 0xffffu); dst[(size_t)(8 * q + 1) * SEQ] = (unsigned short)(rv8[q].x >> 16);
            dst[(size_t)(8 * q + 2) * SEQ] = (unsigned short)(rv8[q].y & 0xffffu); dst[(size_t)(8 * q + 3) * SEQ] = (unsigned short)(rv8[q].y >> 16);
            dst[(size_t)(8 * q + 4) * SEQ] = (unsigned short)(rv8[q].z & 0xffffu); dst[(size_t)(8 * q + 5) * SEQ] = (unsigned short)(rv8[q].z >> 16);
            dst[(size_t)(8 * q + 6) * SEQ] = (unsigned short)(rv8[q].w & 0xffffu); dst[(size_t)(8 * q + 7) * SEQ] = (unsigned short)(rv8[q].w >> 16);
        }
    }
    for (int item = blockIdx.x; item < NQ + NKV + NCF; item += gridDim.x) {
        if (item < NQ) {
            int mt = item / 3, nt = item % 3;
            int m0 = mt * 256, n0 = nt * 128;
            __syncthreads();
            row_rms_to_lds<256>(cq, LDP, m0);
            f32x16 acc[2][2];
            ZERO_ACC(acc);
            gemm_core(acc, cq, LDP, wuq, LDP, 256, m0, n0, NoHook());
#pragma unroll
            for (int i = 0; i < 2; ++i)
#pragma unroll
                for (int j = 0; j < 2; ++j) {
                    int c0 = n0 + wn * 64 + j * 32;
                    int rloc = wm * 64 + i * 32 + 4 * hh;
                    bool rot = (c0 % 96) == 64;
                    int ci = l & 31, pi = ci & 15;
#pragma unroll
                    for (int rr = 0; rr < 16; ++rr) {
                        int rl = rloc + (rr & 3) + 8 * (rr >> 2);
                        float v = acc[i][j][rr] * aux[rl];
                        if (rot) {
                            float pv = __shfl_xor(v, 16);
                            float2 c_s = *(const float2*)(cs + ((size_t)(m0 + rl) * 16 + pi) * 2);
                            v = (ci < 16) ? (v * c_s.x - pv * c_s.y) : (pv * c_s.y + v * c_s.x);
                        }
                        acc[i][j][rr] = v;
                    }
                }
            stage_bf16<false>(acc, nullptr);
            store_rows_bf16(mq, 384, m0, ColAdd{n0});
        } else if (item < NQ + NKV) {
            int it2 = item - NQ;
            int mt = it2 / 6, nt = it2 % 6;
            int m0 = mt * 256, n0 = nt * 128;
            __syncthreads();
            row_rms_to_lds<128>(ckv, LDC, m0);
            f32x16 acc[2][2];
            ZERO_ACC(acc);
            gemm_core(acc, ckv, LDC, wukv, LDC, 128, m0, n0, NoHook());
            stage_bf16<true>(acc, aux);
            if (nt < 2) {
                const int nb0 = n0;
                struct CM { int n0; __device__ __forceinline__ int operator()(int c) const { int col = n0 + c; return (col >> 6) * 96 + (col & 63); } };
                store_rows_bf16(mk, 384, m0, CM{nb0});
            } else {
                store_cols_bf16(mvt, (size_t)(m0 >> 11) * 512 + (n0 - 256), m0 & 2047);
            }
        } else {
            int seq = (item - NQ - NKV) * NW + w;
            int b = seq >> 2, h = seq & 3;
            float bfv = P.b_forget[L * 4 + h];
            float vals[32];
            float run = 0.f;
#pragma unroll
            for (int i = 0; i < 32; ++i) {
                int s = l * 32 + i;
                float z = flog[((size_t)b * SEQ + s) * 4 + h] + bfv;
                run += log_sigmoid_f(z);
                vals[i] = run;
            }
            float tot = run, incl = tot;
#pragma unroll
            for (int o = 1; o < 64; o <<= 1) {
                float t = __shfl_up(incl, o);
                if (l >= o) incl += t;
            }
            float excl = incl - tot;
#pragma unroll
            for (int i = 0; i < 32; ++i) cumF[(size_t)seq * SEQ + l * 32 + i] = vals[i] + excl;
        }
    }
}

template <int MODE, int DK, int DV>
__device__ __forceinline__ void attn_item(const bf16* __restrict__ Q, int ldq, const bf16* __restrict__ Kg, int ldk,
                          const bf16* __restrict__ Vt, const float* __restrict__ cumF, bf16* __restrict__ Y,
                          float* __restrict__ ssy, int b, int h, int qb, float c1, char* lds, int fake = 0) {
    constexpr int KSTR = DK * 2 + 16;
    constexpr int VSTR = 144;
    constexpr int KBYTES = 64 * KSTR, VBYTES = DV * VSTR;
    constexpr int BUF = (KBYTES + VBYTES + 256 + 255) & ~255;
    static_assert(2 * BUF <= 65536, "lds");
    constexpr int KCH = DK / 8, KPT = (64 * KCH) / 256, VPT = (DV * 8) / 256;
    const int tid = opaque_tid() & 255, w = tid >> 6, l = tid & 63, r = l & 31, hh = l >> 5;
    const int q0 = qb * 128;
    const int qrow = q0 + 32 * w + r;
    const size_t tok = (size_t)b * SEQ + qrow;
    const int bh = b * 4 + h;
    bf16x8 qf[DK / 16];
#pragma unroll
    for (int s = 0; s < DK / 16; ++s) qf[s] = *(const bf16x8*)(Q + tok * ldq + h * DK + 16 * s + 8 * hh);
    f32x16 o[DV / 32];
    const f32x16 zero16 = {0.f, 0.f, 0.f, 0.f, 0.f, 0.f, 0.f, 0.f, 0.f, 0.f, 0.f, 0.f, 0.f, 0.f, 0.f, 0.f};
#pragma unroll
    for (int d = 0; d < DV / 32; ++d) o[d] = zero16;
    float m = -1e30f, lsum = 0.f, R = 0.f;
    bool sbdead = false;
    int* dmask = (int*)(smem + LDS_BYTES - 32);
    float Fq = 0.f;
    if (MODE == 0) Fq = cumF[(size_t)bh * SEQ + qrow] * LOG2E;
    const int nkt = (q0 + 128) >> 6;
    u32x4 kregA[KPT], vregA[VPT], kregB[KPT], vregB[VPT];
    float4 fregA = {0.f, 0.f, 0.f, 0.f}, fregB = {0.f, 0.f, 0.f, 0.f};
    auto gload = [&](int kt, u32x4 (&kreg)[KPT], u32x4 (&vreg)[VPT], float4& freg) {
#pragma unroll
        for (int i = 0; i < KPT; ++i) {
            int e = tid + 256 * i;
            int row = e / KCH, ch = e % KCH;
            kreg[i] = *(const u32x4*)(Kg + ((size_t)b * SEQ + kt * 64 + row) * ldk + h * DK + ch * 8);
        }
#pragma unroll
        for (int i = 0; i < VPT; ++i) {
            int e = tid + 256 * i;
            int row = e >> 3, ch = e & 7;
            vreg[i] = *(const u32x4*)(Vt + ((size_t)bh * DV + row) * SEQ + kt * 64 + ch * 8);
        }
        if (MODE == 0 && tid < 16) freg = *(const float4*)(cumF + (size_t)bh * SEQ + kt * 64 + tid * 4);
    };
    auto lwrite = [&](int buf, u32x4 (&kreg)[KPT], u32x4 (&vreg)[VPT], float4& freg) {
        char* base = lds + buf * BUF;
#pragma unroll
        for (int i = 0; i < KPT; ++i) {
            int e = tid + 256 * i;
            int row = e / KCH, ch = e % KCH;
            *(u32x4*)(base + row * KSTR + ch * 16) = kreg[i];
        }
#pragma unroll
        for (int i = 0; i < VPT; ++i) {
            int e = tid + 256 * i;
            int row = e >> 3, ch = e & 7;
            *(u32x4*)(base + KBYTES + row * VSTR + ch * 16) = vreg[i];
        }
        if (MODE == 0 && tid < 16) { float4 fn = {-freg.x * LOG2E, -freg.y * LOG2E, -freg.z * LOG2E, -freg.w * LOG2E}; *(float4*)(base + KBYTES + VBYTES + tid * 16) = fn; }
    };
    const int prow = (r & 0x13) | ((r & 4) << 1) | ((r & 8) >> 1);
    auto ktof = [&](int it) { return (MODE == 1) ? (nkt - 1 - it) : it; };
    gload(ktof(0), kregA, vregA, fregA);
    lwrite(0, kregA, vregA, fregA);
    constexpr bool D2 = (MODE != 2);
    if (D2 && nkt > 1) gload(ktof(1), kregB, vregB, fregB);
    __syncthreads();
    auto tile = [&](int it, u32x4 (&kn)[KPT], u32x4 (&vn)[VPT], float4& fn2, u32x4 (&kf)[KPT], u32x4 (&vf2)[VPT], float4& ff) {
        const int kt = ktof(it);
        if (!(fake & 1)) {
        if (D2) { if (it + 2 < nkt) gload(ktof(it + 2), kf, vf2, ff); }
        else { if (it + 1 < nkt) gload(ktof(it + 1), kf, vf2, ff); }
        }
        const char* base = lds + (it & 1) * BUF;
        bool active = (kt * 64) <= (q0 + 32 * w + 31);
        if (MODE == 1) {
            if (sbdead) { active = false; atomicOr(&dmask[it & 1], 1 << (opaque_tid() >> 6)); }
        }
        if (active) {
            const bool needmask = (kt * 64 + 63) >= (q0 + 32 * w);
            f32x16 s[2];
#pragma unroll
            for (int sub = 0; sub < 2; ++sub) {
                s[sub] = zero16;
#pragma unroll
                for (int ks = 0; ks < DK / 16; ++ks) {
                    bf16x8 kf = *(const bf16x8*)(base + (sub * 32 + prow) * KSTR + (2 * ks + hh) * 16);
                    s[sub] = __builtin_amdgcn_mfma_f32_32x32x16_bf16(kf, qf[ks], s[sub], 0, 0, 0);
                }
            }
            bf16x8 pf[2][2];
            if (fake & 2) {
#pragma unroll
                for (int sub = 0; sub < 2; ++sub)
#pragma unroll
                    for (int a = 0; a < 2; ++a) {
                        uint4 u;
                        u.x = pack2(s[sub][8 * a], s[sub][8 * a + 1]); u.y = pack2(s[sub][8 * a + 2], s[sub][8 * a + 3]);
                        u.z = pack2(s[sub][8 * a + 4], s[sub][8 * a + 5]); u.w = pack2(s[sub][8 * a + 6], s[sub][8 * a + 7]);
                        pf[sub][a] = __builtin_bit_cast(bf16x8, u);
                    }
                lsum = 1.f;
            } else if (MODE != 1) {
                const float* Ft = (const float*)(base + KBYTES + VBYTES);
                float mx = -INFINITY;
                float tv[2][16];
#pragma unroll
                for (int sub = 0; sub < 2; ++sub)
#pragma unroll
                    for (int a = 0; a < 2; ++a) {
                        int kofs = sub * 32 + 16 * a + 8 * hh;
                        float fk[8];
                        if (MODE == 0) {
                            float4 f0 = *(const float4*)(Ft + kofs), f1 = *(const float4*)(Ft + kofs + 4);
                            fk[0] = f0.x; fk[1] = f0.y; fk[2] = f0.z; fk[3] = f0.w; fk[4] = f1.x; fk[5] = f1.y; fk[6] = f1.z; fk[7] = f1.w;
                        }
#pragma unroll
                        for (int j = 0; j < 8; ++j) {
                            int rr = 8 * a + j;
                            float v = (MODE == 0) ? fmaf(s[sub][rr], c1, fk[j]) : s[sub][rr] * c1;
                            tv[sub][rr] = v;
                        }
                    }
                if (needmask) {
#pragma unroll
                    for (int sub = 0; sub < 2; ++sub)
#pragma unroll
                        for (int rr = 0; rr < 16; ++rr) {
                            int key = kt * 64 + sub * 32 + 16 * (rr >> 3) + 8 * hh + (rr & 7);
                            if (key > qrow) tv[sub][rr] = -INFINITY;
                        }
                }
#pragma unroll
                for (int sub = 0; sub < 2; ++sub)
#pragma unroll
                    for (int rr = 0; rr < 16; ++rr) mx = fmaxf(mx, tv[sub][rr]);
                mx = fmaxf(mx, __builtin_bit_cast(float, partner32(__builtin_bit_cast(int, mx), hh)));
                float mnew = fmaxf(m, mx);
                float rsum = 0.f;
#pragma unroll
                for (int sub = 0; sub < 2; ++sub)
#pragma unroll
                    for (int a = 0; a < 2; ++a) {
                        float pv[8];
#pragma unroll
                        for (int j = 0; j < 8; ++j) { pv[j] = fexp2(tv[sub][8 * a + j] - mnew); rsum += pv[j]; }
                        uint4 u;
                        u.x = pack2(pv[0], pv[1]); u.y = pack2(pv[2], pv[3]); u.z = pack2(pv[4], pv[5]); u.w = pack2(pv[6], pv[7]);
                        pf[sub][a] = __builtin_bit_cast(bf16x8, u);
                    }
                rsum += __builtin_bit_cast(float, partner32(__builtin_bit_cast(int, rsum), hh));
                if (__builtin_amdgcn_ballot_w64(mnew != m) != 0ull) {
                    float alpha = fexp2(m - mnew);
                    lsum *= alpha;
#pragma unroll
                    for (int d = 0; d < DV / 32; ++d) o[d] = o[d] * alpha;
                    m = mnew;
                }
                lsum += rsum;
            } else {
#pragma unroll
                for (int sb = 0; sb < 2; ++sb) {
                    const int sub = 1 - sb;
                    float lsig[16], lneg[16];
                    float A0 = 0.f, A1 = 0.f;
#pragma unroll
                    for (int rr = 0; rr < 16; ++rr) {
                        int key = kt * 64 + sub * 32 + 16 * (rr >> 3) + 8 * hh + (rr & 7);
                        bool valid = key < qrow;
                        float z = s[sub][rr] * c1;
                        float e = fexp2(-fabsf(z));
                        float l1p = flog2(1.f + e);
                        float ls = fminf(z, 0.f) - l1p;
                        float ln = valid ? (ls - z) : 0.f;
                        lsig[rr] = valid ? ls : -INFINITY;
                        lneg[rr] = ln;
                        if (rr < 8) A0 += ln; else A1 += ln;
                    }
                    float B0 = __shfl_xor(A0, 32), B1 = __shfl_xor(A1, 32);
                    float base1 = (hh == 0) ? (R + B1) : R;
                    float base0 = (hh == 0) ? (R + B1 + A1 + B0) : (R + A1 + B1);
                    float wv[16];
                    float run = base1;
#pragma unroll
                    for (int j = 7; j >= 0; --j) { wv[8 + j] = fexp2(lsig[8 + j] + run); run += lneg[8 + j]; }
                    run = base0;
#pragma unroll
                    for (int j = 7; j >= 0; --j) { wv[j] = fexp2(lsig[j] + run); run += lneg[j]; }
                    R += A0 + A1 + B0 + B1;
#pragma unroll
                    for (int a = 0; a < 2; ++a) {
                        uint4 u;
                        u.x = pack2(wv[8 * a], wv[8 * a + 1]); u.y = pack2(wv[8 * a + 2], wv[8 * a + 3]);
                        u.z = pack2(wv[8 * a + 4], wv[8 * a + 5]); u.w = pack2(wv[8 * a + 6], wv[8 * a + 7]);
                        pf[sub][a] = __builtin_bit_cast(bf16x8, u);
                    }
                }
            }
            if (MODE == 1) {
                if (__builtin_amdgcn_ballot_w64(R > -150.f) == 0ull) { sbdead = true; atomicOr(&dmask[it & 1], 1 << (opaque_tid() >> 6)); }
            }
#pragma unroll
            for (int d = 0; d < DV / 32; ++d)
#pragma unroll
                for (int sub = 0; sub < 2; ++sub)
#pragma unroll
                    for (int a = 0; a < 2; ++a) {
                        bf16x8 vf = *(const bf16x8*)(base + KBYTES + (d * 32 + r) * VSTR + (sub * 32 + 16 * a + 8 * hh) * 2);
                        o[d] = __builtin_amdgcn_mfma_f32_32x32x16_bf16(vf, pf[sub][a], o[d], 0, 0, 0);
                    }
        }
        if (!(fake & 1)) { if (it + 1 < nkt) lwrite((it + 1) & 1, kn, vn, fn2); }
        __syncthreads();
    };
    if (D2) {
        for (int it = 0; it < nkt; it += 2) {
            if (MODE == 1 && it > 0 && ((volatile int*)dmask)[(it - 1) & 1] == 0xFF) break;
            tile(it, kregB, vregB, fregB, kregA, vregA, fregA);
            if (it + 1 < nkt) {
                if (MODE == 1 && ((volatile int*)dmask)[it & 1] == 0xFF) break;
                tile(it + 1, kregA, vregA, fregA, kregB, vregB, fregB);
            }
        }
    } else {
        for (int it = 0; it < nkt; ++it) tile(it, kregA, vregA, fregA, kregA, vregA, fregA);
    }
    float inv = (MODE == 1) ? 1.f : (1.f / lsum);
    float ssq = 0.f;
#pragma unroll
    for (int d = 0; d < DV / 32; ++d)
#pragma unroll
        for (int g = 0; g < 4; ++g) {
            float v0 = o[d][4 * g] * inv, v1 = o[d][4 * g + 1] * inv, v2 = o[d][4 * g + 2] * inv, v3 = o[d][4 * g + 3] * inv;
            ssq += v0 * v0 + v1 * v1 + v2 * v2 + v3 * v3;
            uint2 u; u.x = pack2(v0, v1); u.y = pack2(v2, v3);
            *(uint2*)(Y + tok * LDH + h * DV + d * 32 + 8 * g + 4 * hh) = u;
        }
    ssq += __shfl_xor(ssq, 32);
    if (hh == 0) ssy[tok * 16 + h] = ssq;
}

__device__ __forceinline__ void phase_attn(const Params& P, int L, int rep = 0, int fake = 0) {
    char* ws = opq(P.ws);
    int* cnt = (int*)(ws + OFF_CNT) + L * 64 + rep * 16;
    int* s_item = (int*)(smem + LDS_BYTES - 16);
    const float* cumF = (const float*)(ws + OFF_CUMF);
    bf16* Y = (bf16*)(ws + (fake ? OFF_PART : OFF_Y));
    float* ssy = fake ? (float*)(ws + OFF_PART + 40 * MBy) : (float*)(ws + OFF_SSY) + (size_t)L * TOK * 16;
    const int half = opaque_tid() >> 8;
    char* lds = smem + half * 65536;
    for (;;) {
        if (opaque_tid() == 0) { int z0 = 0; asm volatile("" : "+v"(z0)); *s_item = atomicAdd(cnt, 1); s_item[-4] = z0; s_item[-3] = z0; }
        __syncthreads();
        int pair = *s_item;
        __syncthreads();
        if (pair >= 768) break;
        int item = pair * 2 + half;
        int qb, type, bh;
        if (item < 1024) { qb = 15 - (item >> 6); type = (item & 32) ? 2 : 0; bh = item & 31; }
        else { const int j2 = item - 1024; qb = 15 - (j2 >> 5); type = 1; bh = j2 & 31; }
        int b = bh >> 2, h = bh & 3;
        if (type == 0) {
            attn_item<2, 96, 128>((const bf16*)(ws + OFF_MQ), 384, (const bf16*)(ws + OFF_MK), 384, (const bf16*)(ws + OFF_MVT), cumF,
                                  Y + 512, ssy + 8, b, h, qb, 0.10206207261596577f * LOG2E, lds, fake);
        } else if (type == 1) {
            attn_item<1, 64, 64>((const bf16*)(ws + OFF_SQ), 256, (const bf16*)(ws + OFF_SKK), 256, (const bf16*)(ws + OFF_SVT), cumF,
                                 Y + 256, ssy + 4, b, h, qb, 0.125f * LOG2E, lds, fake);
        } else {
            attn_item<0, 64, 64>((const bf16*)(ws + OFF_FQ), 256, (const bf16*)(ws + OFF_FK), 256, (const bf16*)(ws + OFF_FVT), cumF,
                                 Y + 0, ssy + 0, b, h, qb, 0.125f * LOG2E, lds, fake);
        }
    }
}

__device__ __forceinline__ void rowss_flush(float (&part)[2][16], float* gss, int m0, int nt) {
    float* lss = (float*)smem;
    const int tid = opaque_tid(), w = tid >> 6, l = tid & 63, hh = l >> 5, wm = w >> 1, wn = w & 1;
#pragma unroll
    for (int i = 0; i < 2; ++i)
#pragma unroll
        for (int rr = 0; rr < 16; ++rr) {
            float v = part[i][rr];
            v = dpp_add<0xB1>(v); v = dpp_add<0x4E>(v); v = dpp_add<0x141>(v); v = dpp_add<0x140>(v);
            v += __shfl_xor(v, 16);
            if ((l & 31) == 0) lss[wn * 256 + wm * 64 + i * 32 + (rr & 3) + 8 * (rr >> 2) + 4 * hh] = v;
        }
    __syncthreads();
    if (tid < 256) gss[(size_t)(m0 + tid) * 8 + nt] = lss[tid] + lss[256 + tid];
    __syncthreads();
}

__device__ __forceinline__ float sum_fq(float v) {
    float a = v, b = v;
    asm volatile("s_nop 1\n\tv_permlane16_swap_b32 %0, %1\n\ts_nop 1" : "+v"(a), "+v"(b));
    v = a + b; a = v; b = v;
    asm volatile("s_nop 1\n\tv_permlane32_swap_b32 %0, %1\n\ts_nop 1" : "+v"(a), "+v"(b));
    return a + b;
}
template <bool SIG, bool XQ>
__device__ __forceinline__ void residual_fused(const f32x4 (&acc)[2][2][4][2], const pg8::Unit& u, int wr, int wc, int fr, int fqd,
                                               const float* rowscale  , const bf16* gate  ,
                                               const bf16* hb_in, bf16* hb_out, float* gss, unsigned char* xq = nullptr) {
    float* lss = (float*)smem;
#pragma unroll
    for (int ai = 0; ai < 2; ++ai)
#pragma unroll
        for (int m = 0; m < 4; ++m) {
            const int rl = 128 * ai + 64 * wr + 16 * m + fr, row = u.pm * 256 + rl;
            const float sc = rowscale ? rowscale[rl] : 1.f;
#pragma unroll
            for (int bj = 0; bj < 2; ++bj) {
                const int col = u.pn * 256 + 128 * bj + 32 * wc + 8 * fqd;
                const u32x4 hq = *(const u32x4*)(hb_in + (size_t)row * LDH + col);
                const f32x4 hp0 = {bflo(hq.x), bfhi(hq.x), bflo(hq.y), bfhi(hq.y)}, hp1 = {bflo(hq.z), bfhi(hq.z), bflo(hq.w), bfhi(hq.w)};
                f32x4 d0 = acc[ai][bj][m][0] * sc, d1 = acc[ai][bj][m][1] * sc;
                if (SIG) {
#pragma unroll
                    for (int e = 0; e < 4; ++e) {
                        d0[e] = __builtin_amdgcn_rcpf(1.f + fexp2(-LOG2E * d0[e]));
                        d1[e] = __builtin_amdgcn_rcpf(1.f + fexp2(-LOG2E * d1[e]));
                    }
                }
                if (gate) {
                    u32x4 gq = *(const u32x4*)(gate + (size_t)row * 1024 + col);
                    f32x4 g0 = {bflo(gq.x), bfhi(gq.x), bflo(gq.y), bfhi(gq.y)}, g1 = {bflo(gq.z), bfhi(gq.z), bflo(gq.w), bfhi(gq.w)};
                    d0 = d0 * g0; d1 = d1 * g1;
                }
                f32x4 v0 = hp0 + d0, v1 = hp1 + d1;
                u32x4 wv = {pack2(v0[0], v0[1]), pack2(v0[2], v0[3]), pack2(v1[0], v1[1]), pack2(v1[2], v1[3])};
                *(u32x4*)(hb_out + (size_t)row * LDH + col) = wv;
                if (XQ) {
                    f32x4 c0, c1;
#pragma unroll
                    for (int e = 0; e < 4; ++e) { c0[e] = __builtin_amdgcn_fmed3f(v0[e], -448.f, 448.f); c1[e] = __builtin_amdgcn_fmed3f(v1[e], -448.f, 448.f); }
                    int h0 = __builtin_amdgcn_cvt_pk_fp8_f32(c0[0], c0[1], 0, false); h0 = __builtin_amdgcn_cvt_pk_fp8_f32(c0[2], c0[3], h0, true);
                    int h1 = __builtin_amdgcn_cvt_pk_fp8_f32(c1[0], c1[1], 0, false); h1 = __builtin_amdgcn_cvt_pk_fp8_f32(c1[2], c1[3], h1, true);
                    const f32x2 b0 = __builtin_amdgcn_cvt_pk_f32_fp8(h0, false), b1 = __builtin_amdgcn_cvt_pk_f32_fp8(h0, true);
                    const f32x2 b2 = __builtin_amdgcn_cvt_pk_f32_fp8(h1, false), b3 = __builtin_amdgcn_cvt_pk_f32_fp8(h1, true);
                    int l0 = __builtin_amdgcn_cvt_pk_fp8_f32((c0[0] - b0.x) * 16.f, (c0[1] - b0.y) * 16.f, 0, false);
                    l0 = __builtin_amdgcn_cvt_pk_fp8_f32((c0[2] - b1.x) * 16.f, (c0[3] - b1.y) * 16.f, l0, true);
                    int l1 = __builtin_amdgcn_cvt_pk_fp8_f32((c1[0] - b2.x) * 16.f, (c1[1] - b2.y) * 16.f, 0, false);
                    l1 = __builtin_amdgcn_cvt_pk_fp8_f32((c1[2] - b3.x) * 16.f, (c1[3] - b3.y) * 16.f, l1, true);
                    u32x2 hh = {(unsigned)h0, (unsigned)h1}, ll = {(unsigned)l0, (unsigned)l1};
                    *(u32x2*)(xq + (size_t)row * 1024 + col) = hh;
                    *(u32x2*)(xq + 16 * MBy + (size_t)row * 1024 + col) = ll;
                }
                float ss = (v0[0] * v0[0] + v0[1] * v0[1]) + (v0[2] * v0[2] + v0[3] * v0[3]) + (v1[0] * v1[0] + v1[1] * v1[1]) + (v1[2] * v1[2] + v1[3] * v1[3]);
                ss = sum_fq(ss);
                if (fqd == 0) lss[(wc * 256 + rl) * 2 + bj] = ss;
            }
        }
    __syncthreads();
    const int tid = opaque_tid();
    if (tid < 256) {
        const int row = u.pm * 256 + tid;
#pragma unroll
        for (int bj = 0; bj < 2; ++bj)
            gss[(size_t)row * 8 + u.pn * 2 + bj] = (lss[(0 * 256 + tid) * 2 + bj] + lss[(1 * 256 + tid) * 2 + bj]) + (lss[(2 * 256 + tid) * 2 + bj] + lss[(3 * 256 + tid) * 2 + bj]);
    }
    __syncthreads();
}
struct EpiWo {
    static constexpr bool PERM = true, AFTER_DRAIN = true;
    const bf16* hb_in; bf16* hb_out; float* gss; unsigned char* xq;
    __device__ __forceinline__ void khook(int t, f32x4 (&acc)[2][2][4][2], int wr, int fr) const {
        if (t == 4 || t == 8) {
            const float* fac = (const float*)(smem + LDS_AUX) + (t == 4 ? 0 : 256);
#pragma unroll
            for (int ai = 0; ai < 2; ++ai)
#pragma unroll
                for (int m = 0; m < 4; ++m) {
                    const float f = fac[128 * ai + 64 * wr + 16 * m + fr];
#pragma unroll
                    for (int bj = 0; bj < 2; ++bj) { acc[ai][bj][m][0] *= f; acc[ai][bj][m][1] *= f; }
                }
        }
    }
    __device__ __forceinline__ void operator()(const f32x4 (&)[2][2][4][2], const pg8::Unit&, int, int, int, int) const {}
    __device__ __forceinline__ void fused(const f32x4 (&acc)[2][2][4][2], const pg8::Unit& u, int wr, int wc, int fr, int fqd, PG8_LAS unsigned char*, int, int) const {
        residual_fused<false, true>(acc, u, wr, wc, fr, fqd, (const float*)(smem + LDS_AUX) + 512, nullptr, hb_in, hb_out, gss, xq);
    }
};
__device__ __forceinline__ void phase_wo(const Params& P, int L, int hsel, int ss_slot) {
    char* ws = opq(P.ws);
    float* ss_out = (float*)(ws + OFF_SSA) + (size_t)ss_slot * TOK * 8;
    bf16* hb_out = (bf16*)(ws + (hsel ? OFF_HB1 : OFF_HB0));
    const bf16* hb_in = (const bf16*)(ws + (hsel ? OFF_HB0 : OFF_HB1));
    const bf16* Y = (const bf16*)(ws + OFF_Y);
    const bf16* Bt = (const bf16*)(ws + OFF_WO) + (size_t)L * 1024 * LDH;
    const float* ssy = (const float*)(ws + OFF_SSY) + (size_t)L * TOK * 16;
    float* aux = (float*)(smem + LDS_AUX);
    const int tid = opaque_tid();
    pg8::Gemm g{Y, Bt, LDH, LDH, TOK, 1024, 1024};
    pg8::StaticOrder S; S.init(TOK, 1024, gridDim.x, blockIdx.x);
    pg8::Unit u0;
    if (S.next(0, u0) && tid < 256) {
        int row = u0.pm * 256 + tid;
        float4 v0 = *(const float4*)(ssy + (size_t)row * 16), v1 = *(const float4*)(ssy + (size_t)row * 16 + 4), v2 = *(const float4*)(ssy + (size_t)row * 16 + 8);
        float r0 = rsqrtf(((v0.x + v0.y) + (v0.z + v0.w)) * (1.f / 256.f) + EPSF);
        float r1 = rsqrtf(((v1.x + v1.y) + (v1.z + v1.w)) * (1.f / 256.f) + EPSF);
        float r2 = rsqrtf(((v2.x + v2.y) + (v2.z + v2.w)) * (1.f / 512.f) + EPSF);
        aux[tid] = r0 / r1; aux[256 + tid] = r1 / r2; aux[512 + tid] = r2;
    }
    __syncthreads();
    EpiWo E{hb_in, hb_out, ss_out, (unsigned char*)(ws + OFF_XH)};
    pg8::gemm_phase((PG8_LAS unsigned char*)smem, g, S, E, nullptr);
    __syncthreads();
}

struct EpiPq {
    static constexpr bool PERM = true, AFTER_DRAIN = false;
    bf16* O; const float* ssrow;
    __device__ __forceinline__ void khook(int, f32x4 (&)[2][2][4][2], int, int) const {}
    __device__ __forceinline__ void operator()(const f32x4 (&acc)[2][2][4][2], const pg8::Unit& u, int wr, int wc, int fr, int fq) const {
        const int row0 = u.pm * 256 + wr * 64 + fr, col0 = u.pn * 256 + wc * 32 + 8 * fq;
#pragma unroll
        for (int ai = 0; ai < 2; ++ai)
#pragma unroll
            for (int m = 0; m < 4; ++m) {
                const int row = row0 + ai * 128 + m * 16;
                const float rs = row_rs8(ssrow, row);
                bf16* rowp = O + (size_t)row * 1024 + col0;
#pragma unroll
                for (int bj = 0; bj < 2; ++bj) {
                    f32x4 v0 = acc[ai][bj][m][0] * rs, v1 = acc[ai][bj][m][1] * rs;
                    u32x4 wv = {pack2(v0[0], v0[1]), pack2(v0[2], v0[3]), pack2(v1[0], v1[1]), pack2(v1[2], v1[3])};
                    *(u32x4*)(rowp + bj * 128) = wv;
                }
            }
    }
};
__device__ __forceinline__ void phase_pq(const Params& P, int L, int hsel, int ss_slot) {
    char* ws = opq(P.ws);
    const float* ssrow = (const float*)(ws + OFF_SSA) + (size_t)ss_slot * TOK * 8;
    const bf16* hb = (const bf16*)(ws + (hsel ? OFF_HB1 : OFF_HB0));
    const bf16* Bt = (const bf16*)(ws + OFF_WQ) + (size_t)L * 1024 * LDH;
    pg8::Gemm g{hb, Bt, LDH, LDH, TOK, 1024, 1024};
    pg8::StaticOrder S; S.init(TOK, 1024, gridDim.x, blockIdx.x);
    EpiPq E{(bf16*)(ws + OFF_PQ), ssrow};
    pg8::gemm_phase((PG8_LAS unsigned char*)smem, g, S, E, nullptr);
    __syncthreads();
}

__device__ __forceinline__ void cswap(int& a, int& b) { int mx = max(a, b), mn = min(a, b); a = mx; b = mn; }
__device__ __forceinline__ void bitonic_sort16(int (&v)[16]) {
#pragma unroll
    for (int k = 2; k <= 16; k <<= 1)
#pragma unroll
        for (int j = k >> 1; j > 0; j >>= 1)
#pragma unroll
            for (int i = 0; i < 16; ++i) {
                int q = i ^ j;
                if (q > i) {
                    if ((i & k) == 0) cswap(v[i], v[q]); else cswap(v[q], v[i]);
                }
            }
}
__device__ __forceinline__ void merge_top16(int (&Lv)[16], const int (&Rv)[16]) {
#pragma unroll
    for (int i = 0; i < 16; ++i) Lv[i] = max(Lv[i], Rv[15 - i]);
#pragma unroll
    for (int j = 8; j > 0; j >>= 1)
#pragma unroll
        for (int i = 0; i < 16; ++i) {
            int q = i ^ j;
            if (q > i) cswap(Lv[i], Lv[q]);
        }
}
__device__ __forceinline__ int f2key(float v, int low, int mask) {
    int b = __float_as_int(v);
    b ^= (b >> 31) & 0x7fffffff;
    return (b & ~mask) | low;
}
__device__ __forceinline__ float key2f(int k, int mask) {
    int b = k & ~mask;
    b ^= (b >> 31) & 0x7fffffff;
    return __int_as_float(b);
}

__device__ __forceinline__ void phase_topk(const Params& P, int L) {
    char* ws = opq(P.ws);
    const bf16* pq = (const bf16*)(ws + OFF_PQ);
    const bf16* skb = (const bf16*)(ws + OFF_SKB) + (size_t)L * 16 * 128 * 64;
    unsigned short* ids = (unsigned short*)(ws + OFF_IDS);
    float* gates = (float*)(ws + OFF_GATE);
    const int tid = opaque_tid(), w = tid >> 6, l = tid & 63, r = l & 31, hh = l >> 5;
    unsigned char* lidx = (unsigned char*)(smem + w * 1024 + r * 32);
    for (int task = blockIdx.x * NW + w; task < (TOK / 32) * 8; task += gridDim.x * NW) {
        const int t0 = (task >> 3) * 32, h = task & 7;
        int F[2][16];
#pragma unroll
        for (int p = 0; p < 2; ++p) {
            const int hp = h * 2 + p;
            f32x16 acc[4];
            const f32x16 z16 = {0.f, 0.f, 0.f, 0.f, 0.f, 0.f, 0.f, 0.f, 0.f, 0.f, 0.f, 0.f, 0.f, 0.f, 0.f, 0.f};
#pragma unroll
            for (int kt = 0; kt < 4; ++kt) acc[kt] = z16;
#pragma unroll
            for (int s4 = 0; s4 < 4; ++s4) {
                bf16x8 bfr = *(const bf16x8*)(pq + (size_t)(t0 + r) * 1024 + hp * 64 + 16 * s4 + 8 * hh);
#pragma unroll
                for (int kt = 0; kt < 4; ++kt) {
                    bf16x8 af = *(const bf16x8*)(skb + ((size_t)hp * 128 + 32 * kt + r) * 64 + 16 * s4 + 8 * hh);
                    acc[kt] = __builtin_amdgcn_mfma_f32_32x32x16_bf16(af, bfr, acc[kt], 0, 0, 0);
                }
            }
            int K0[16], K1[16], K2[16], K3[16];
#pragma unroll
            for (int rr = 0; rr < 16; ++rr) {
                const int nb = (rr & 3) + 8 * (rr >> 2) + 4 * hh;
                K0[rr] = f2key(acc[0][rr], 127 - nb, 127);
                K1[rr] = f2key(acc[1][rr], 127 - (32 + nb), 127);
                K2[rr] = f2key(acc[2][rr], 127 - (64 + nb), 127);
                K3[rr] = f2key(acc[3][rr], 127 - (96 + nb), 127);
            }
            bitonic_sort16(K0); bitonic_sort16(K1); bitonic_sort16(K2); bitonic_sort16(K3);
            merge_top16(K0, K1);
            merge_top16(K2, K3);
            merge_top16(K0, K2);
#pragma unroll
            for (int i = 0; i < 16; ++i) K1[i] = partner32(K0[i], hh);
            merge_top16(K0, K1);
#pragma unroll
            for (int i = 0; i < 16; ++i) F[p][i] = K0[i];
        }
        if (hh == 0) {
#pragma unroll
            for (int q = 0; q < 4; ++q) {
                unsigned w1 = 0, w2 = 0;
#pragma unroll
                for (int e = 0; e < 4; ++e) {
                    w1 |= (unsigned)(127 - (F[0][4 * q + e] & 127)) << (8 * e);
                    w2 |= (unsigned)(127 - (F[1][4 * q + e] & 127)) << (8 * e);
                }
                ((unsigned*)lidx)[q] = w1;
                ((unsigned*)lidx)[4 + q] = w2;
            }
        }
        {
            float s1[16], s2[16];
#pragma unroll
            for (int i = 0; i < 16; ++i) { s1[i] = key2f(F[0][i], 127); s2[i] = key2f(F[1][i], 127); }
            int Lc[16], X[16];
#pragma unroll
            for (int b2 = 0; b2 < 16; ++b2) Lc[b2] = f2key(s1[0] + s2[b2], 255 - b2, 255);
#pragma unroll
            for (int a2 = 1; a2 < 16; ++a2) X[a2 - 1] = f2key(s1[a2] + s2[0], 255 - a2 * 16, 255);
            X[15] = INT_MIN;
            merge_top16(Lc, X);
            X[0] = f2key(s1[1] + s2[1], 255 - 17, 255); X[1] = f2key(s1[1] + s2[2], 255 - 18, 255); X[2] = f2key(s1[1] + s2[3], 255 - 19, 255);
            X[3] = f2key(s1[1] + s2[4], 255 - 20, 255); X[4] = f2key(s1[1] + s2[5], 255 - 21, 255); X[5] = f2key(s1[1] + s2[6], 255 - 22, 255);
            X[6] = f2key(s1[1] + s2[7], 255 - 23, 255);
            X[7] = f2key(s1[2] + s2[1], 255 - 33, 255); X[8] = f2key(s1[2] + s2[2], 255 - 34, 255); X[9] = f2key(s1[2] + s2[3], 255 - 35, 255);
            X[10] = f2key(s1[2] + s2[4], 255 - 36, 255);
            X[11] = f2key(s1[3] + s2[1], 255 - 49, 255); X[12] = f2key(s1[3] + s2[2], 255 - 50, 255); X[13] = f2key(s1[3] + s2[3], 255 - 51, 255);
            X[14] = f2key(s1[4] + s2[1], 255 - 65, 255); X[15] = f2key(s1[4] + s2[2], 255 - 66, 255);
            bitonic_sort16(X);
            merge_top16(Lc, X);
            X[0] = f2key(s1[5] + s2[1], 255 - 81, 255);
            X[1] = f2key(s1[6] + s2[1], 255 - 97, 255);
            X[2] = f2key(s1[7] + s2[1], 255 - 113, 255);
#pragma unroll
            for (int i = 3; i < 16; ++i) X[i] = INT_MIN;
            merge_top16(Lc, X);
            if (hh == 0) {
                float mx = key2f(Lc[0], 255);
                float ev[16], sum = 0.f;
#pragma unroll
                for (int k = 0; k < 16; ++k) { ev[k] = __expf(key2f(Lc[k], 255) - mx); sum += ev[k]; }
                float inv = 1.f / sum;
                size_t ob = (size_t)(t0 + r) * 128 + h * 16;
                unsigned idw[8];
#pragma unroll
                for (int k = 0; k < 16; ++k) {
                    int cidx = 255 - (Lc[k] & 255);
                    int i1 = lidx[cidx >> 4], i2 = lidx[16 + (cidx & 15)];
                    unsigned idv = (unsigned)(i1 * 128 + i2);
                    if (k & 1) idw[k >> 1] |= idv << 16; else idw[k >> 1] = idv;
                }
                u32x4 o0 = {idw[0], idw[1], idw[2], idw[3]}, o1 = {idw[4], idw[5], idw[6], idw[7]};
                *(u32x4*)(ids + ob) = o0;
                *(u32x4*)(ids + ob + 8) = o1;
#pragma unroll
                for (int q = 0; q < 4; ++q) {
                    f32x4 g4 = {ev[4 * q] * inv, ev[4 * q + 1] * inv, ev[4 * q + 2] * inv, ev[4 * q + 3] * inv};
                    *(f32x4*)(gates + ob + 4 * q) = g4;
                }
            }
        }
    }
}

__device__ __forceinline__ float gelu_exact(float x) { return 0.5f * x * (1.f + erff(x * 0.70710678118654752f)); }

__device__ __forceinline__ void dec16(const u32x4& v, float (&f)[16]) {
    f32x2 t;
    t = __builtin_amdgcn_cvt_pk_f32_fp8((int)v.x, false); f[0] = t.x; f[1] = t.y;
    t = __builtin_amdgcn_cvt_pk_f32_fp8((int)v.x, true);  f[2] = t.x; f[3] = t.y;
    t = __builtin_amdgcn_cvt_pk_f32_fp8((int)v.y, false); f[4] = t.x; f[5] = t.y;
    t = __builtin_amdgcn_cvt_pk_f32_fp8((int)v.y, true);  f[6] = t.x; f[7] = t.y;
    t = __builtin_amdgcn_cvt_pk_f32_fp8((int)v.z, false); f[8] = t.x; f[9] = t.y;
    t = __builtin_amdgcn_cvt_pk_f32_fp8((int)v.z, true);  f[10] = t.x; f[11] = t.y;
    t = __builtin_amdgcn_cvt_pk_f32_fp8((int)v.w, false); f[12] = t.x; f[13] = t.y;
    t = __builtin_amdgcn_cvt_pk_f32_fp8((int)v.w, true);  f[14] = t.x; f[15] = t.y;
}

__device__ __forceinline__ void dec32(const u32x4& v, f32x2 (&f)[16]) {
    f[0] = __builtin_amdgcn_cvt_scalef32_pk_f32_fp4(v.x, 1.0f, 0); f[1] = __builtin_amdgcn_cvt_scalef32_pk_f32_fp4(v.x, 1.0f, 1);
    f[2] = __builtin_amdgcn_cvt_scalef32_pk_f32_fp4(v.x, 1.0f, 2); f[3] = __builtin_amdgcn_cvt_scalef32_pk_f32_fp4(v.x, 1.0f, 3);
    f[4] = __builtin_amdgcn_cvt_scalef32_pk_f32_fp4(v.y, 1.0f, 0); f[5] = __builtin_amdgcn_cvt_scalef32_pk_f32_fp4(v.y, 1.0f, 1);
    f[6] = __builtin_amdgcn_cvt_scalef32_pk_f32_fp4(v.y, 1.0f, 2); f[7] = __builtin_amdgcn_cvt_scalef32_pk_f32_fp4(v.y, 1.0f, 3);
    f[8] = __builtin_amdgcn_cvt_scalef32_pk_f32_fp4(v.z, 1.0f, 0); f[9] = __builtin_amdgcn_cvt_scalef32_pk_f32_fp4(v.z, 1.0f, 1);
    f[10] = __builtin_amdgcn_cvt_scalef32_pk_f32_fp4(v.z, 1.0f, 2); f[11] = __builtin_amdgcn_cvt_scalef32_pk_f32_fp4(v.z, 1.0f, 3);
    f[12] = __builtin_amdgcn_cvt_scalef32_pk_f32_fp4(v.w, 1.0f, 0); f[13] = __builtin_amdgcn_cvt_scalef32_pk_f32_fp4(v.w, 1.0f, 1);
    f[14] = __builtin_amdgcn_cvt_scalef32_pk_f32_fp4(v.w, 1.0f, 2); f[15] = __builtin_amdgcn_cvt_scalef32_pk_f32_fp4(v.w, 1.0f, 3);
}

typedef _Float16 f16x2 __attribute__((ext_vector_type(2)));
__device__ __forceinline__ void dec8_f16(unsigned x, f16x2 (&wv)[4]) {
    const unsigned lo = x & 0x07070707u, hi = (x >> 4) & 0x07070707u;
    const unsigned Lb = __builtin_amdgcn_perm(0x46444240u, 0x3E3C3800u, lo) | ((x & 0x08080808u) << 4);
    const unsigned Hb = __builtin_amdgcn_perm(0x46444240u, 0x3E3C3800u, hi) | (x & 0x80808080u);
    wv[0] = __builtin_bit_cast(f16x2, __builtin_amdgcn_perm(Hb, Lb, 0x040c000cu));
    wv[1] = __builtin_bit_cast(f16x2, __builtin_amdgcn_perm(Hb, Lb, 0x050c010cu));
    wv[2] = __builtin_bit_cast(f16x2, __builtin_amdgcn_perm(Hb, Lb, 0x060c020cu));
    wv[3] = __builtin_bit_cast(f16x2, __builtin_amdgcn_perm(Hb, Lb, 0x070c030cu));
}

typedef _Float16 f16x2 __attribute__((ext_vector_type(2)));
__device__ __forceinline__ void dec32h(const u32x4& v, f16x2 (&f)[16]) {
    f[0] = __builtin_amdgcn_cvt_scalef32_pk_f16_fp4(v.x, 1.0f, 0); f[1] = __builtin_amdgcn_cvt_scalef32_pk_f16_fp4(v.x, 1.0f, 1);
    f[2] = __builtin_amdgcn_cvt_scalef32_pk_f16_fp4(v.x, 1.0f, 2); f[3] = __builtin_amdgcn_cvt_scalef32_pk_f16_fp4(v.x, 1.0f, 3);
    f[4] = __builtin_amdgcn_cvt_scalef32_pk_f16_fp4(v.y, 1.0f, 0); f[5] = __builtin_amdgcn_cvt_scalef32_pk_f16_fp4(v.y, 1.0f, 1);
    f[6] = __builtin_amdgcn_cvt_scalef32_pk_f16_fp4(v.y, 1.0f, 2); f[7] = __builtin_amdgcn_cvt_scalef32_pk_f16_fp4(v.y, 1.0f, 3);
    f[8] = __builtin_amdgcn_cvt_scalef32_pk_f16_fp4(v.z, 1.0f, 0); f[9] = __builtin_amdgcn_cvt_scalef32_pk_f16_fp4(v.z, 1.0f, 1);
    f[10] = __builtin_amdgcn_cvt_scalef32_pk_f16_fp4(v.z, 1.0f, 2); f[11] = __builtin_amdgcn_cvt_scalef32_pk_f16_fp4(v.z, 1.0f, 3);
    f[12] = __builtin_amdgcn_cvt_scalef32_pk_f16_fp4(v.w, 1.0f, 0); f[13] = __builtin_amdgcn_cvt_scalef32_pk_f16_fp4(v.w, 1.0f, 1);
    f[14] = __builtin_amdgcn_cvt_scalef32_pk_f16_fp4(v.w, 1.0f, 2); f[15] = __builtin_amdgcn_cvt_scalef32_pk_f16_fp4(v.w, 1.0f, 3);
}

__device__ __forceinline__ int idof16(const u32x4 (&q)[2], int i) {
    unsigned wv = (i >> 1) == 0 ? q[0].x : (i >> 1) == 1 ? q[0].y : (i >> 1) == 2 ? q[0].z : (i >> 1) == 3 ? q[0].w
                : (i >> 1) == 4 ? q[1].x : (i >> 1) == 5 ? q[1].y : (i >> 1) == 6 ? q[1].z : q[1].w;
    return (i & 1) ? (int)(wv >> 16) : (int)(wv & 0xffffu);
}
typedef int i32x8 __attribute__((ext_vector_type(8)));
#define GU_WAIT_V(n) asm volatile("s_waitcnt vmcnt(" #n ")" ::: "memory")
#define GU_WAIT_L0() asm volatile("s_waitcnt lgkmcnt(0)" ::: "memory")
__device__ __forceinline__ void phase_gather_u(const Params& P, int L) {
    char* ws = opq(P.ws);
    const unsigned char* U4 = (const unsigned char*)(ws + OFF_UB) + (size_t)L * NEXP * 512;
    float* part = (float*)(ws + OFF_PART);
    const unsigned short* ids = (const unsigned short*)(ws + OFF_IDS);
    const int tid = opaque_tid(), w = tid >> 6, l = tid & 63, i = l & 15, g4 = l >> 4, rr = l >> 3, dc = (l & 7) ^ rr;
    const int sl = blockIdx.x & 3, par = (blockIdx.x >> 2) & 1, rk = blockIdx.x >> 3, nb = gridDim.x >> 3;
    if (rk >= nb) return;
    PG8_LAS unsigned char* wl = (PG8_LAS unsigned char*)smem + w * 16384;
    const unsigned char* ubase = U4 + (size_t)sl * NEXP * 128 + dc * 16;
    const unsigned char* xbase = (const unsigned char*)(ws + OFF_XH) + (i == 1 ? 16 * MBy : 0) + 256 * sl + 16 * g4;
    const int scb = (i == 1) ? 123 : 127;
    const unsigned a0 = 1024u * (i >> 3) + 128u * (i & 7) + 16u * (g4 ^ (i & 7)), a1 = a0 ^ 64u;
    const int stride = nb * NW;
    int ti = rk * NW + w;
    if (ti >= TOK / 2) return;
    u32x4 idA[2], idB[2];
    u32x4 xA[4], xB[4];
    auto load_ids = [&](int tt, u32x4 (&idq)[2]) {
        const unsigned short* ip = ids + (size_t)tt * 128 + 16 * rr;
        asm volatile("global_load_dwordx4 %0, %2, off\n\tglobal_load_dwordx4 %1, %2, off offset:16" : "=&v"(idq[0]), "=&v"(idq[1]) : "v"(ip));
    };
    auto load_x = [&](int tt, u32x4 (&xx)[4]) {
        const unsigned char* p = xbase + (size_t)tt * 1024;
        asm volatile("global_load_dwordx4 %0, %4, off\n\tglobal_load_dwordx4 %1, %4, off offset:64\n\t"
                     "global_load_dwordx4 %2, %4, off offset:128\n\tglobal_load_dwordx4 %3, %4, off offset:192"
                     : "=&v"(xx[0]), "=&v"(xx[1]), "=&v"(xx[2]), "=&v"(xx[3]) : "v"(p));
    };
    auto pin = [&](u32x4 (&idq)[2], u32x4 (&xx)[4]) {
        asm volatile("" : "+v"(idq[0]), "+v"(idq[1]), "+v"(xx[0]), "+v"(xx[1]), "+v"(xx[2]), "+v"(xx[3]));
    };
    auto dma_half = [&](const u32x4 (&idq)[2], int h) {
#pragma unroll
        for (int jj = 0; jj < 8; ++jj) {
            const int j = 8 * h + jj;
            __builtin_amdgcn_global_load_lds((const unsigned*)(ubase + (size_t)idof16(idq, j) * 128), (PG8_LAS unsigned*)(wl + 1024 * j), 16, 0, 0);
        }
    };
    const unsigned la0 = (unsigned)(size_t)wl + a0, la1 = (unsigned)(size_t)wl + a1;
    auto mma_half = [&](f32x4 (&acc)[8], const u32x4 (&xc)[4], int h) {
        u32x4 av[8];
        if (h == 0)
            asm volatile("ds_read_b128 %0, %8\n\tds_read_b128 %1, %9\n\tds_read_b128 %2, %8 offset:2048\n\tds_read_b128 %3, %9 offset:2048\n\t"
                         "ds_read_b128 %4, %8 offset:4096\n\tds_read_b128 %5, %9 offset:4096\n\tds_read_b128 %6, %8 offset:6144\n\tds_read_b128 %7, %9 offset:6144\n\t"
                         "s_waitcnt lgkmcnt(0)"
                         : "=&v"(av[0]), "=&v"(av[1]), "=&v"(av[2]), "=&v"(av[3]), "=&v"(av[4]), "=&v"(av[5]), "=&v"(av[6]), "=&v"(av[7]) : "v"(la0), "v"(la1));
        else
            asm volatile("ds_read_b128 %0, %8 offset:8192\n\tds_read_b128 %1, %9 offset:8192\n\tds_read_b128 %2, %8 offset:10240\n\tds_read_b128 %3, %9 offset:10240\n\t"
                         "ds_read_b128 %4, %8 offset:12288\n\tds_read_b128 %5, %9 offset:12288\n\tds_read_b128 %6, %8 offset:14336\n\tds_read_b128 %7, %9 offset:14336\n\t"
                         "s_waitcnt lgkmcnt(0)"
                         : "=&v"(av[0]), "=&v"(av[1]), "=&v"(av[2]), "=&v"(av[3]), "=&v"(av[4]), "=&v"(av[5]), "=&v"(av[6]), "=&v"(av[7]) : "v"(la0), "v"(la1));
#pragma unroll
        for (int qq = 0; qq < 4; ++qq) {
#pragma unroll
            for (int hf = 0; hf < 2; ++hf) {
                const u32x4 a = av[2 * qq + hf];
                const i32x8 A = {(int)a.x, (int)a.y, (int)a.z, (int)a.w, 0, 0, 0, 0};
                const u32x4 b0 = xc[2 * hf], b1 = xc[2 * hf + 1];
                const i32x8 B = {(int)b0.x, (int)b0.y, (int)b0.z, (int)b0.w, (int)b1.x, (int)b1.y, (int)b1.z, (int)b1.w};
                f32x4 c = {0.f, 0.f, 0.f, 0.f};
                if (hf) c = acc[4 * h + qq];
                acc[4 * h + qq] = __builtin_amdgcn_mfma_scale_f32_16x16x128_f8f6f4(A, B, c, 4, 0, 0, 127, 0, scb);
            }
        }
    };
    auto step = [&](int tcur, int tnext, int tnext2, u32x4 (&idn)[2], u32x4 (&idl)[2], u32x4 (&xc)[4], u32x4 (&xn)[4]) {
        f32x4 acc[8];
        __builtin_amdgcn_sched_barrier(0);
        GU_WAIT_V(8);
        pin(idn, xc);
        __builtin_amdgcn_sched_barrier(0);
        mma_half(acc, xc, 0);
        __builtin_amdgcn_sched_barrier(0);
        dma_half(idn, 0);
        __builtin_amdgcn_sched_barrier(0);
        load_ids(tnext2, idl);
        load_x(tnext, xn);
        __builtin_amdgcn_sched_barrier(0);
        GU_WAIT_V(14);
        __builtin_amdgcn_sched_barrier(0);
        mma_half(acc, xc, 1);
        __builtin_amdgcn_sched_barrier(0);
#pragma unroll
        for (int q = 0; q < 8; ++q)
#pragma unroll
            for (int r = 0; r < 4; ++r) acc[q][r] = dpp_add<0xB1>(acc[q][r]);
        if (i == 0) {
            float* o = part + ((size_t)sl * TOK + tcur) * 128 + 32 * g4;
#pragma unroll
            for (int r = 0; r < 4; ++r)
#pragma unroll
                for (int gh = 0; gh < 2; ++gh) {
                    f32x4 ov = {acc[4 * gh][r], acc[4 * gh + 1][r], acc[4 * gh + 2][r], acc[4 * gh + 3][r]};
                    asm volatile("global_store_dwordx4 %0, %1, off offset:%2" :: "v"(o), "v"(ov), "n"(32 * r + 16 * gh) : "memory");
                }
        }
        __builtin_amdgcn_sched_barrier(0);
        dma_half(idn, 1);
        __builtin_amdgcn_sched_barrier(0);
    };
    auto tok = [&](int tidx, int fb) { return 2 * (tidx < TOK / 2 ? tidx : fb) + par; };
    load_ids(tok(ti, ti), idA);
    __builtin_amdgcn_sched_barrier(0);
    GU_WAIT_V(0);
    asm volatile("" : "+v"(idA[0]), "+v"(idA[1]));
    __builtin_amdgcn_sched_barrier(0);
    dma_half(idA, 0);
    __builtin_amdgcn_sched_barrier(0);
    load_ids(tok(ti + stride, ti), idB);
    load_x(tok(ti, ti), xA);
    __builtin_amdgcn_sched_barrier(0);
    dma_half(idA, 1);
    __builtin_amdgcn_sched_barrier(0);
    for (;;) {
        int tn = ti + stride, tn2 = ti + 2 * stride;
        step(tok(ti, ti), tok(tn, ti), tok(tn2, ti), idB, idA, xA, xB);
        if (tn >= TOK / 2) break;
        ti = tn; tn = ti + stride; tn2 = ti + 2 * stride;
        step(tok(ti, ti), tok(tn, ti), tok(tn2, ti), idA, idB, xB, xA);
        if (tn >= TOK / 2) break;
        ti = tn;
    }
    GU_WAIT_V(0);
    asm volatile("" :: "v"(idA[0]), "v"(idA[1]), "v"(idB[0]), "v"(idB[1]), "v"(xA[0]), "v"(xA[1]), "v"(xA[2]), "v"(xA[3]), "v"(xB[0]), "v"(xB[1]), "v"(xB[2]), "v"(xB[3]));
}

__device__ __forceinline__ void phase_gather_act(const Params& P, int L, int ss_slot, int fake = 0) {
    char* ws = opq(P.ws);
    const float* ss_ffn = (const float*)(ws + OFF_SSA) + (size_t)ss_slot * TOK * 8;
    const float* part = (const float*)(ws + OFF_PART);
    const unsigned short* ids = (const unsigned short*)(ws + OFF_IDS);
    const float* gates = (const float*)(ws + OFF_GATE);
    const float* uinv = (const float*)(ws + OFF_TSC) + L * NEXP;
    const float* vinv = (const float*)(ws + OFF_TSC) + (2 + L) * NEXP;
    const int tid = opaque_tid(), w = tid >> 6, l = tid & 63;
    const int stride = gridDim.x * NW;
    for (int t0 = blockIdx.x * NW + w; t0 < TOK; t0 += 4 * stride) {
        f32x2 pa[4][4], gt[4];
        unsigned idw[4];
        f32x4 s0[4], s1[4];
#pragma unroll
        for (int q = 0; q < 4; ++q) {
            const int t = (t0 + q * stride < TOK) ? (t0 + q * stride) : t0;
#pragma unroll
            for (int j = 0; j < 4; ++j) { pa[q][j].x = part[((size_t)j * TOK + t) * 128 + l]; pa[q][j].y = part[((size_t)j * TOK + t) * 128 + 64 + l]; }
            idw[q] = *(const unsigned*)(ids + (size_t)t * 128 + 2 * l);
            gt[q] = *(const f32x2*)(gates + (size_t)t * 128 + 2 * l);
            s0[q] = *(const f32x4*)(ss_ffn + (size_t)t * 8); s1[q] = *(const f32x4*)(ss_ffn + (size_t)t * 8 + 4);
        }
        float ui[4][2], vi[4][2];
#pragma unroll
        for (int q = 0; q < 4; ++q) {
            const int i0 = (int)(idw[q] & 0xffffu), i1 = (int)(idw[q] >> 16);
            ui[q][0] = uinv[i0]; ui[q][1] = uinv[i1]; vi[q][0] = vinv[i0]; vi[q][1] = vinv[i1];
        }
#pragma unroll
        for (int q = 0; q < 4; ++q) {
            const int t = t0 + q * stride;
            if (t < TOK) {
                const float ssum = ((s0[q].x + s0[q].y) + (s0[q].z + s0[q].w)) + ((s1[q].x + s1[q].y) + (s1[q].z + s1[q].w));
                const float rs = rsqrtf(ssum * (1.f / 1024.f) + EPSF);
                f32x2 sa = (pa[q][0] + pa[q][1]) + (pa[q][2] + pa[q][3]);
                f32x2 o;
                o.x = gt[q].x * gelu_exact(sa.x * rs * ui[q][0]) * vi[q][0];
                o.y = gt[q].y * gelu_exact(sa.y * rs * ui[q][1]) * vi[q][1];
                float am = fmaxf(fabsf(o.x), fabsf(o.y));
#pragma unroll
                for (int sh = 32; sh > 0; sh >>= 1) am = fmaxf(am, __shfl_xor(am, sh));
                int ex = (int)((__builtin_bit_cast(unsigned, am) >> 23) & 0xffu) - 127;
                int e = 7 - ex; e = e > 100 ? 100 : (e < -100 ? -100 : e);
                if (!(am > 0.f)) e = 0;
                const float sc2 = __builtin_bit_cast(float, (unsigned)(127 + e) << 23);
                const float s0 = __builtin_amdgcn_fmed3f(o.x * sc2, -448.f, 448.f), s1 = __builtin_amdgcn_fmed3f(o.y * sc2, -448.f, 448.f);
                const int h8 = __builtin_amdgcn_cvt_pk_fp8_f32(s0, s1, 0, false);
                const f32x2 hb2 = __builtin_amdgcn_cvt_pk_f32_fp8(h8, false);
                const int l8 = __builtin_amdgcn_cvt_pk_fp8_f32((s0 - hb2.x) * 16.f, (s1 - hb2.y) * 16.f, 0, false);
                unsigned char* a8 = (unsigned char*)(ws + (fake ? OFF_PART : OFF_A8)) + (size_t)t * 128 + 16 * (l & 7) + (l >> 3);
                a8[0] = (unsigned char)(h8 & 0xff); a8[8] = (unsigned char)((h8 >> 8) & 0xff);
                a8[2 * MBy] = (unsigned char)(l8 & 0xff); a8[2 * MBy + 8] = (unsigned char)((l8 >> 8) & 0xff);
                if (l == 0) ((int*)(ws + (fake ? OFF_PART : OFF_A8) + 4 * MBy))[t] = e;
            }
        }
    }
}

__device__ __forceinline__ void phase_gather_v(const Params& P, int L, int hsel, int ss_slot, int fake = 0) {
    char* ws = opq(P.ws);
    float* ss_ple = fake ? (float*)(ws + OFF_FQ) : (float*)(ws + OFF_SSA) + (size_t)ss_slot * TOK * 8;
    bf16* hb_out = fake ? (bf16*)(ws + OFF_PART) : (bf16*)(ws + (hsel ? OFF_HB1 : OFF_HB0));
    const bf16* hbin = (const bf16*)(ws + (hsel ? OFF_HB0 : OFF_HB1));
    const unsigned char* V4 = (const unsigned char*)(ws + OFF_VB) + (size_t)L * NEXP * 512;
    const unsigned short* ids = (const unsigned short*)(ws + OFF_IDS);
    const int tid = opaque_tid(), w = tid >> 6, l = tid & 63, i = l & 15, g4 = l >> 4, rr = l >> 3;
    const int sl = blockIdx.x & 3, par = (blockIdx.x >> 2) & 1, rk = blockIdx.x >> 3, nb = gridDim.x >> 3;
    if (rk >= nb) return;
    PG8_LAS unsigned char* wl = (PG8_LAS unsigned char*)smem + w * 16384;
    PG8_LAS unsigned char* wo = (PG8_LAS unsigned char*)smem + 8 * 16384 + w * 1024;
    const int dc0 = (l & 7) ^ (rr >> 1);
    const unsigned char* vbase0 = V4 + (size_t)sl * NEXP * 128 + dc0 * 16;
    const unsigned char* vbase1 = V4 + (size_t)sl * NEXP * 128 + (dc0 ^ 4) * 16;
    const unsigned char* abase = (const unsigned char*)(ws + OFF_A8) + ((i & 3) == 1 ? 2 * MBy : 0) + 16 * g4;
    const int* ebase = (const int*)(ws + OFF_A8 + 4 * MBy);
    const unsigned kb = 16u * (unsigned)((i >> 1) ^ (4 * (g4 & 1)));
    const unsigned rbase = (unsigned)(size_t)wl + 128u * (unsigned)(32 * g4 + i);
    const unsigned wob = (unsigned)(size_t)wo;
    const int stride = nb * NW;
    int ti = rk * NW + w;
    if (ti >= TOK / 2) return;
    u32x4 idA[2], idB[2];
    u32x4 aA[2], aB[2];
    int eA, eB;
    u32x2 hA, hB;
    auto load_ids = [&](int tt, u32x4 (&idq)[2]) {
        const unsigned short* ip = ids + (size_t)tt * 128 + 16 * rr;
        asm volatile("global_load_dwordx4 %0, %2, off\n\tglobal_load_dwordx4 %1, %2, off offset:16" : "=&v"(idq[0]), "=&v"(idq[1]) : "v"(ip));
    };
    auto load_tok = [&](int tt, u32x4 (&ax)[2], int& ex, u32x2& hx) {
        const unsigned char* ap = abase + (size_t)tt * 128;
        const int* ep = ebase + tt;
        const bf16* hp = hbin + (size_t)tt * LDH + 256 * sl + 4 * l;
        asm volatile("global_load_dwordx4 %0, %4, off\n\tglobal_load_dwordx4 %1, %4, off offset:64\n\tglobal_load_dword %2, %5, off\n\tglobal_load_dwordx2 %3, %6, off"
                     : "=&v"(ax[0]), "=&v"(ax[1]), "=&v"(ex), "=&v"(hx) : "v"(ap), "v"(ep), "v"(hp));
    };
    auto dma_all = [&](const u32x4 (&idq)[2]) {
#pragma unroll
        for (int j = 0; j < 16; ++j) {
            const unsigned char* vb = (((j ^ (j >> 2)) & 1) ? vbase1 : vbase0);
            __builtin_amdgcn_global_load_lds((const unsigned*)(vb + (size_t)idof16(idq, j) * 128), (PG8_LAS unsigned*)(wl + 1024 * j), 16, 0, 0);
        }
    };
    u32x2 pend_h = {0u, 0u}; float pend_ss = 0.f; int pend_t = -1;
    auto step = [&](int tcur, int tnext, int tnext2, u32x4 (&idn)[2], u32x4 (&idl)[2], u32x4 (&ac)[2], int& ec, u32x2& hc, u32x4 (&an)[2], int& en, u32x2& hn) {
        __builtin_amdgcn_sched_barrier(0);
        GU_WAIT_V(0);
        asm volatile("" : "+v"(idn[0]), "+v"(idn[1]), "+v"(ac[0]), "+v"(ac[1]), "+v"(ec), "+v"(hc));
        __builtin_amdgcn_sched_barrier(0);
        u32x2 bq[16][2];
#pragma unroll
        for (int c = 0; c < 8; ++c) {
            const unsigned ad = rbase + ((16u * c) ^ kb);
            asm volatile("ds_read_b64_tr_b4 %0, %4\n\tds_read_b64_tr_b4 %1, %4 offset:2048\n\tds_read_b64_tr_b4 %2, %4 offset:8\n\tds_read_b64_tr_b4 %3, %4 offset:2056"
                         : "=&v"(bq[2 * c][0]), "=&v"(bq[2 * c][1]), "=&v"(bq[2 * c + 1][0]), "=&v"(bq[2 * c + 1][1]) : "v"(ad));
        }
        asm volatile("s_waitcnt lgkmcnt(0)" ::: "memory");
#pragma unroll
        for (int c = 0; c < 16; ++c) asm volatile("" : "+v"(bq[c][0]), "+v"(bq[c][1]));
        __builtin_amdgcn_sched_barrier(0);
        if (pend_t >= 0) {
            bf16* op = hb_out + (size_t)pend_t * LDH + 256 * sl + 4 * l;
            asm volatile("global_store_dwordx2 %0, %1, off" :: "v"(op), "v"(pend_h) : "memory");
            if (l == 0) {
                float* sp = ss_ple + (size_t)pend_t * 8 + sl;
                const float zf = 0.f;
                asm volatile("global_store_dword %0, %1, off\n\tglobal_store_dword %0, %2, off offset:16" :: "v"(sp), "v"(pend_ss), "v"(zf) : "memory");
            }
        }
        __builtin_amdgcn_sched_barrier(0);
        dma_all(idn);
        __builtin_amdgcn_sched_barrier(0);
        load_ids(tnext2, idl);
        load_tok(tnext, an, en, hn);
        __builtin_amdgcn_sched_barrier(0);
        const int sca = 127 - ec - (((i & 3) == 1) ? 4 : 0);
        const i32x8 A = {(int)ac[0].x, (int)ac[0].y, (int)ac[0].z, (int)ac[0].w, (int)ac[1].x, (int)ac[1].y, (int)ac[1].z, (int)ac[1].w};
        f32x4 acc[16];
#pragma unroll
        for (int cb = 0; cb < 16; ++cb) {
            const i32x8 B = {(int)bq[cb][0].x, (int)bq[cb][0].y, (int)bq[cb][1].x, (int)bq[cb][1].y, 0, 0, 0, 0};
            const f32x4 z = {0.f, 0.f, 0.f, 0.f};
            acc[cb] = __builtin_amdgcn_mfma_scale_f32_16x16x128_f8f6f4(A, B, z, 0, 4, 0, sca, 0, 127);
        }
#pragma unroll
        for (int q = 0; q < 4; ++q) {
            float v = 0.f;
#pragma unroll
            for (int g = 0; g < 4; ++g) { const float t2 = acc[4 * g + q][0] + acc[4 * g + q][1]; v = (g4 == g) ? t2 : v; }
            const unsigned wa = wob + 4u * (unsigned)(64 * g4 + 16 * q + i);
            asm volatile("ds_write_b32 %0, %1" :: "v"(wa), "v"(v) : "memory");
        }
        f32x4 ov;
        {
            const unsigned ra = wob + 16u * (unsigned)l;
            asm volatile("s_waitcnt lgkmcnt(0)\n\tds_read_b128 %0, %1\n\ts_waitcnt lgkmcnt(0)" : "=&v"(ov) : "v"(ra) : "memory");
        }
        f32x4 hv = {bflo(hc.x) + ov[0], bfhi(hc.x) + ov[1], bflo(hc.y) + ov[2], bfhi(hc.y) + ov[3]};
        pend_h.x = pack2(hv.x, hv.y); pend_h.y = pack2(hv.z, hv.w);
        float ssq = hv.x * hv.x + hv.y * hv.y + hv.z * hv.z + hv.w * hv.w;
        pend_ss = wave_sum(ssq);
        pend_t = tcur;
        __builtin_amdgcn_sched_barrier(0);
    };
    auto tok = [&](int tidx, int fb) { return 2 * (tidx < TOK / 2 ? tidx : fb) + par; };
    load_ids(tok(ti, ti), idA);
    __builtin_amdgcn_sched_barrier(0);
    GU_WAIT_V(0);
    asm volatile("" : "+v"(idA[0]), "+v"(idA[1]));
    __builtin_amdgcn_sched_barrier(0);
    dma_all(idA);
    __builtin_amdgcn_sched_barrier(0);
    load_ids(tok(ti + stride, ti), idB);
    load_tok(tok(ti, ti), aA, eA, hA);
    __builtin_amdgcn_sched_barrier(0);
    for (;;) {
        int tn = ti + stride, tn2 = ti + 2 * stride;
        step(tok(ti, ti), tok(tn, ti), tok(tn2, ti), idB, idA, aA, eA, hA, aB, eB, hB);
        if (tn >= TOK / 2) break;
        ti = tn; tn = ti + stride; tn2 = ti + 2 * stride;
        step(tok(ti, ti), tok(tn, ti), tok(tn2, ti), idA, idB, aB, eB, hB, aA, eA, hA);
        if (tn >= TOK / 2) break;
        ti = tn;
    }
    asm volatile("s_waitcnt vmcnt(0)" : "+v"(pend_t), "+v"(pend_h), "+v"(pend_ss) :: "memory");
    asm volatile("" :: "v"(idA[0]), "v"(idA[1]), "v"(idB[0]), "v"(idB[1]), "v"(aA[0]), "v"(aA[1]), "v"(aB[0]), "v"(aB[1]), "v"(eA), "v"(eB), "v"(hA), "v"(hB));
    {
        bf16* op = hb_out + (size_t)pend_t * LDH + 256 * sl + 4 * l;
        *(u32x2*)op = pend_h;
        if (l == 0) { ss_ple[(size_t)pend_t * 8 + sl] = pend_ss; ss_ple[(size_t)pend_t * 8 + 4 + sl] = 0.f; }
    }
}

struct EpiStoreBf16 {
    static constexpr bool PERM = true, AFTER_DRAIN = false;
    bf16* O;
    __device__ __forceinline__ void khook(int, f32x4 (&)[2][2][4][2], int, int) const {}
    __device__ __forceinline__ void operator()(const f32x4 (&acc)[2][2][4][2], const pg8::Unit& u, int wr, int wc, int fr, int fqd) const {
        const int row0 = u.pm * 256 + wr * 64 + fr, col0 = u.pn * 256 + wc * 32 + 8 * fqd;
#pragma unroll
        for (int ai = 0; ai < 2; ++ai)
#pragma unroll
            for (int m = 0; m < 4; ++m) {
                bf16* rowp = O + (size_t)(row0 + ai * 128 + m * 16) * 1024 + col0;
#pragma unroll
                for (int bj = 0; bj < 2; ++bj) {
                    const f32x4 v0 = acc[ai][bj][m][0], v1 = acc[ai][bj][m][1];
                    u32x4 wv = {pack2(v0[0], v0[1]), pack2(v0[2], v0[3]), pack2(v1[0], v1[1]), pack2(v1[2], v1[3])};
                    *(u32x4*)(rowp + bj * 128) = wv;
                }
            }
    }
};
__device__ __forceinline__ void phase_pw(const Params& P) {
    char* ws = opq(P.ws);
    pg8::StaticOrder S; S.init(TOK, 1024, gridDim.x, blockIdx.x);
    for (int L = 0; L < 2; ++L) {
        pg8::Gemm g{(const bf16*)(ws + OFF_PB) + (size_t)L * TOK * LDP, (const bf16*)(ws + OFF_WP) + (size_t)L * 1024 * LDP, LDP, LDP, TOK, 1024, 256};
        EpiStoreBf16 E{(bf16*)(ws + (L ? OFF_PW1 : OFF_PW0))};
        pg8::gemm_phase((PG8_LAS unsigned char*)smem, g, S, E, nullptr);
        __syncthreads();
    }
}
struct EpiPle {
    static constexpr bool PERM = true, AFTER_DRAIN = true;
    const bf16* PW; const bf16* hb_in; bf16* hb_out; float* gss;
    __device__ __forceinline__ void khook(int, f32x4 (&)[2][2][4][2], int, int) const {}
    __device__ __forceinline__ void operator()(const f32x4 (&)[2][2][4][2], const pg8::Unit&, int, int, int, int) const {}
    __device__ __forceinline__ void fused(const f32x4 (&acc)[2][2][4][2], const pg8::Unit& u, int wr, int wc, int fr, int fqd, PG8_LAS unsigned char*, int, int) const {
        residual_fused<true, false>(acc, u, wr, wc, fr, fqd, (const float*)(smem + LDS_AUX), PW, hb_in, hb_out, gss);
    }
};
__device__ __forceinline__ void phase_ple(const Params& P, int L, int hsel, int ss_slot_in, int ss_slot_out, int fake = 0) {
    char* ws = opq(P.ws);
    const float* ss_ple = (const float*)(ws + OFF_SSA) + (size_t)ss_slot_in * TOK * 8;
    float* ss_out = (float*)(ws + OFF_SSA) + (size_t)ss_slot_out * TOK * 8;
    const bf16* hb_in = (const bf16*)(ws + (hsel ? OFF_HB1 : OFF_HB0));
    bf16* hb_out = (bf16*)(ws + (hsel ? OFF_HB0 : OFF_HB1));
    const bf16* Wg = (const bf16*)(ws + OFF_WG) + (size_t)L * 1024 * LDH;
    float* aux = (float*)(smem + LDS_AUX);
    const int tid = opaque_tid();
    pg8::Gemm g{hb_in, Wg, LDH, LDH, TOK, 1024, 1024};
    pg8::StaticOrder S; S.init(TOK, 1024, gridDim.x, blockIdx.x);
    pg8::Unit u0;
    if (S.next(0, u0) && tid < 256) aux[tid] = row_rs8(ss_ple, u0.pm * 256 + tid);
    __syncthreads();
    EpiPle E{(const bf16*)(ws + (L ? OFF_PW1 : OFF_PW0)), hb_in, fake ? (bf16*)(ws + OFF_PART) : hb_out, fake ? (float*)(ws + OFF_FQ) : ss_out};
    pg8::gemm_phase((PG8_LAS unsigned char*)smem, g, S, E, nullptr);
    __syncthreads();
}

__device__ __forceinline__ void phase_final(const Params& P, int ss_slot, int hsel) {
    char* ws = opq(P.ws);
    float* out = opq(P.out);
    const bf16* hbin = (const bf16*)(ws + (hsel ? OFF_HB1 : OFF_HB0));
    const float* ss = (const float*)(ws + OFF_SSA) + (size_t)ss_slot * TOK * 8;
    const int tid = opaque_tid(), w = tid >> 6, l = tid & 63;
    const float4* g4 = (const float4*)P.final_norm_g;
    for (int t = blockIdx.x * NW + w; t < TOK; t += gridDim.x * NW) {
        float rs = row_rs8(ss, t);
        float4* o4 = (float4*)(out + (size_t)t * 1024);
#pragma unroll
        for (int i = 0; i < 2; ++i) {
            u32x4 hq = *(const u32x4*)(hbin + (size_t)t * LDH + (i * 64 + l) * 8);
            float4 ga = g4[(i * 64 + l) * 2], gb = g4[(i * 64 + l) * 2 + 1];
            float4 va = {bflo(hq.x) * rs * ga.x, bfhi(hq.x) * rs * ga.y, bflo(hq.y) * rs * ga.z, bfhi(hq.y) * rs * ga.w};
            float4 vb = {bflo(hq.z) * rs * gb.x, bfhi(hq.z) * rs * gb.y, bflo(hq.w) * rs * gb.z, bfhi(hq.w) * rs * gb.w};
            o4[(i * 64 + l) * 2] = va; o4[(i * 64 + l) * 2 + 1] = vb;
        }
    }
}

#define XB_TMO      128
#define XB_XCNT(j)  (256  + 64 * (j))
#define XB_XSUB(j)  (1280 + 64 * (j))
#define XB_XGEN(j)  (2304 + 64 * (j))
#define XB_TOP      3328
#define XB_TOPGEN   3392
#define XCD_BAR_WORDS 3456
#define XB_SPIN_CAP (1u << 22)
__device__ __forceinline__ unsigned xb_ld(unsigned* p) { return __hip_atomic_load(p, __ATOMIC_RELAXED, __HIP_MEMORY_SCOPE_AGENT); }
__device__ __forceinline__ unsigned xb_add(unsigned* p, unsigned v) { return __hip_atomic_fetch_add(p, v, __ATOMIC_RELAXED, __HIP_MEMORY_SCOPE_AGENT); }
__device__ __forceinline__ unsigned xb_xcc_id() { return (unsigned)__builtin_amdgcn_s_getreg((3 << 11) | 20) & 0xFu; }
#define XB_SPIN(cond, bar) do { unsigned _sp = 0; while (cond) { __builtin_amdgcn_s_sleep(1); \
    if ((++_sp & 255u) == 0u) { if (xb_ld(&(bar)[XB_TMO])) break; if (_sp > XB_SPIN_CAP) { atomicAdd(&(bar)[XB_TMO], 1u); break; } } } } while (0)
#define XB_LDS_OFF (LDS_BYTES - 64)
__device__ __forceinline__ void xcd_barrier_post(const Params& P) {
    if (threadIdx.x == 0) {
        unsigned* bar = (unsigned*)(P.ws + OFF_BAR);
        volatile __attribute__((address_space(3))) unsigned* st = (volatile __attribute__((address_space(3))) unsigned*)(smem + XB_LDS_OFF);
        st[0] = 0u; st[1] = 0u;
        (void)xb_add(&bar[XB_XCNT(xb_xcc_id())], 1u);
    }
}
__device__ __forceinline__ void xcd_barrier_complete(unsigned* bar, unsigned x, unsigned& nloc, unsigned& nx) {
    const unsigned G = gridDim.x;
    unsigned sum, cnt, mine, sp = 0u;
    for (;;) {
        sum = 0u; cnt = 0u; mine = 0u;
#pragma unroll
        for (unsigned j = 0; j < 16; ++j) { const unsigned c = xb_ld(&bar[XB_XCNT(j)]); sum += c; cnt += (c > 0u) ? 1u : 0u; mine = (j == x) ? c : mine; }
        if (sum == G) break;
        __builtin_amdgcn_s_sleep(1);
        if ((++sp & 255u) == 0u) { if (xb_ld(&bar[XB_TMO])) break; if (sp > XB_SPIN_CAP) { atomicAdd(&bar[XB_TMO], 1u); break; } }
    }
    nloc = mine > 0u ? mine : 1u; nx = cnt > 0u ? cnt : 1u;
}
__device__ __forceinline__ void grid_barrier(const Params& P) {
    asm volatile("s_waitcnt vmcnt(0)" ::: "memory");
    __syncthreads();
    if (threadIdx.x == 0) {
        unsigned* bar = (unsigned*)(P.ws + OFF_BAR);
        volatile __attribute__((address_space(3))) unsigned* st = (volatile __attribute__((address_space(3))) unsigned*)(smem + XB_LDS_OFF);
        const unsigned x = xb_xcc_id();
        __builtin_amdgcn_s_waitcnt(0);
        unsigned nloc = st[0], nx = st[1];
        if (nloc == 0u) { xcd_barrier_complete(bar, x, nloc, nx); st[0] = nloc; st[1] = nx; }
        const unsigned old = xb_add(&bar[XB_XSUB(x)], 1u);
        const unsigned gen = old / nloc;
        if (old + 1u == (gen + 1u) * nloc) {
            __builtin_amdgcn_fence(__ATOMIC_RELEASE, "agent");
            asm volatile("s_waitcnt vmcnt(0)" ::: "memory");
            const unsigned og = xb_add(&bar[XB_TOP], 1u);
            const unsigned tg = og / nx;
            if (og + 1u == (tg + 1u) * nx) xb_add(&bar[XB_TOPGEN], 1u);
            else XB_SPIN(xb_ld(&bar[XB_TOPGEN]) == tg, bar);
            __builtin_amdgcn_fence(__ATOMIC_ACQUIRE, "agent");
            xb_add(&bar[XB_XGEN(x)], 1u);
            asm volatile("s_waitcnt vmcnt(0)" ::: "memory");
        } else {
            XB_SPIN(xb_ld(&bar[XB_XGEN(x)]) == gen, bar);
            __builtin_amdgcn_fence(__ATOMIC_ACQUIRE, "agent");
            asm volatile("s_waitcnt vmcnt(0)" ::: "memory");
        }
    }
    __syncthreads();
}

__global__ void __launch_bounds__(NTHR, 2) hymba_megakernel(Params P) {
    cg::grid_group grid = cg::this_grid();
    char* ws = opq(P.ws);
    xcd_barrier_post(P);
#define BAR() do { grid_barrier(P); if (DUP == 20) grid_barrier(P); } while (0)
    phase0(P);
    if (DUP == 0) { asm volatile("s_waitcnt vmcnt(0)" ::: "memory"); __syncthreads(); grid_barrier(P); phase0(P); }
    asm volatile("s_waitcnt vmcnt(0)" ::: "memory");
    __syncthreads();
    grid.sync();
    BAR();
    phase_pw(P);
    BAR();
    if (DUP == 11) { phase_pw(P); BAR(); }
    int cur = 0;
    for (int L = 0; L < 2; ++L) {
        const int ss_mix = (L == 0) ? 0 : 3, ss_ffn = 1 + L, ss_next = (L == 0) ? 3 : 4, ss_ple = 5 + L;
        phase_proj(P, L, cur, ss_mix);
        BAR();
        if (DUP == 1) { phase_proj(P, L, cur, ss_mix); BAR(); }
        phase_mla_up(P, L);
        BAR();
        if (DUP == 2) { phase_mla_up(P, L); BAR(); }
        phase_attn(P, L, 0);
        BAR();
        if (DUP == 3) { phase_attn(P, L, 1); BAR(); }
        if (DUP >= 30 && DUP < 34) { phase_attn(P, L, 1, DUP - 30); BAR(); }
        phase_wo(P, L, cur ^ 1, ss_ffn);
        BAR();
        if (DUP == 4 && L == 0) { phase_wo(P, L, cur ^ 1, ss_ffn); BAR(); }
        phase_pq(P, L, cur ^ 1, ss_ffn);
        BAR();
        if (DUP == 5) { phase_pq(P, L, cur ^ 1, ss_ffn); BAR(); }
        phase_topk(P, L);
        BAR();
        if (DUP == 6) { phase_topk(P, L); BAR(); }
        phase_gather_u(P, L);
        BAR();
        if (DUP == 7) { phase_gather_u(P, L); BAR(); }
        if (DUP == 10) { phase_gather_act(P, L, ss_ffn, 1); BAR(); }
        phase_gather_act(P, L, ss_ffn);
        BAR();
        if (DUP == 8) { phase_gather_v(P, L, cur, ss_ple, 1); BAR(); }
        phase_gather_v(P, L, cur, ss_ple);
        BAR();
        if (DUP == 9) { phase_ple(P, L, cur, ss_ple, ss_next, 1); BAR(); }
        phase_ple(P, L, cur, ss_ple, ss_next);
        BAR();
        cur ^= 1;
    }
    phase_final(P, 4, cur);
}

extern "C" void kernel_launch(void* const* d_in, const int* in_sizes, int n_in, void* d_out, int out_size, void* d_ws,
                              size_t ws_size, hipStream_t stream) {
    static int grid_blocks = 0;
    if (!grid_blocks) {
        int dev = 0, cus = 0, per_cu = 0;
        hipGetDevice(&dev);
        hipDeviceGetAttribute(&cus, hipDeviceAttributeMultiprocessorCount, dev);
        hipOccupancyMaxActiveBlocksPerMultiprocessor(&per_cu, hymba_megakernel, NTHR, 0);
        if (per_cu > 1) per_cu = 1;
        if (per_cu < 1) per_cu = 1;
        grid_blocks = cus * per_cu;
        if (ws_size < WS_END) fprintf(stderr, "workspace too small: %zu < %zu\n", ws_size, (size_t)WS_END);
    }
    Params P{};
    P.x = (const float*)d_in[0]; P.p = (const float*)d_in[1]; P.pos = (const int*)d_in[2];
    P.norm_mix_g = (const float*)d_in[3]; P.w_in = (const float*)d_in[4]; P.b_forget = (const float*)d_in[5];
    P.mla_q_norm_g = (const float*)d_in[6]; P.w_uq = (const float*)d_in[7]; P.mla_kv_norm_g = (const float*)d_in[8];
    P.w_ukv = (const float*)d_in[9]; P.mix_out_norm_g = (const float*)d_in[10]; P.w_o = (const float*)d_in[11];
    P.norm_ffn_g = (const float*)d_in[12]; P.w_query = (const float*)d_in[13]; P.sub_keys = (const float*)d_in[14];
    P.peer_u = (const float*)d_in[15]; P.peer_v = (const float*)d_in[16]; P.w_ple = (const float*)d_in[17];
    P.ple_norm_g = (const float*)d_in[18]; P.w_ple_gate = (const float*)d_in[19]; P.final_norm_g = (const float*)d_in[20];
    P.out = (float*)d_out; P.ws = (char*)d_ws;
    hipMemsetAsync((char*)d_ws + OFF_BAR, 0, 16384 + 4096, stream);
    void* args[] = {&P};
    hipError_t e = hipLaunchCooperativeKernel((void*)hymba_megakernel, dim3(grid_blocks), dim3(NTHR), args, 0, stream);
    if (e != hipSuccess) fprintf(stderr, "cooperative launch failed: %s (grid %d)\n", hipGetErrorString(e), grid_blocks);
}
```

```cpp
#include <hip/hip_runtime.h>
#include <hip/hip_cooperative_groups.h>
#include <cstdio>
#include <cstdint>
#include <math.h>
#include <climits>
namespace cg = cooperative_groups;

typedef __bf16 bf16;
typedef __bf16 bf16x8 __attribute__((ext_vector_type(8)));
typedef __bf16 bf16x4 __attribute__((ext_vector_type(4)));
typedef __bf16 bf16x2 __attribute__((ext_vector_type(2)));
typedef float f32x16 __attribute__((ext_vector_type(16)));
typedef float f32x4 __attribute__((ext_vector_type(4)));
typedef float f32x2 __attribute__((ext_vector_type(2)));
typedef unsigned u32x4 __attribute__((ext_vector_type(4)));
typedef unsigned u32x2 __attribute__((ext_vector_type(2)));

#define SEQ 2048
#define BATCH 8
#define TOK 16384
#define DM 1024
#define IN_W 1956
#define NEXP 16384
#define EPSF 1e-6f
#define LOG2E 1.4426950408889634f
#define NTHR 512
#define NW 8
#define LDS_BYTES 151808
#define STAGE_BYTES 49152
#define LDS_AUX 147456
#ifndef DUP
#define DUP -1
#endif

constexpr size_t MBy = 1ull << 20;
constexpr size_t OFF_UB = 0;
constexpr size_t OFF_VB = 16 * MBy;
constexpr size_t OFF_PART = 32 * MBy;
constexpr size_t OFF_PW1 = 96 * MBy;
#define LDH 1088
#define LDP 320
#define LDC 192
constexpr size_t OFF_WIN = 128 * MBy;
constexpr size_t OFF_WO = 137 * MBy;
constexpr size_t OFF_WQ = 142 * MBy;
constexpr size_t OFF_WG = 147 * MBy;
constexpr size_t OFF_WP = 152 * MBy;
constexpr size_t OFF_WUQ = 154 * MBy;
constexpr size_t OFF_WUKV = 155 * MBy;
constexpr size_t OFF_SKB = 156 * MBy;
constexpr size_t OFF_CS = 157 * MBy;
constexpr size_t OFF_TSC = 159 * MBy;
constexpr size_t OFF_SSA = 160 * MBy;
constexpr size_t OFF_HB0 = 164 * MBy;
constexpr size_t OFF_HB1 = 200 * MBy;
constexpr size_t OFF_FQ = 236 * MBy;
constexpr size_t OFF_FK = 244 * MBy;
constexpr size_t OFF_FVT = 252 * MBy;
constexpr size_t OFF_SQ = 260 * MBy;
constexpr size_t OFF_SKK = 268 * MBy;
constexpr size_t OFF_SVT = 276 * MBy;
constexpr size_t OFF_CQ = 284 * MBy;
constexpr size_t OFF_CKV = 295 * MBy;
constexpr size_t OFF_FLOG = 302 * MBy;
constexpr size_t OFF_CUMF = 303 * MBy;
constexpr size_t OFF_MQ = 304 * MBy;
constexpr size_t OFF_MK = 316 * MBy;
constexpr size_t OFF_MVT = 328 * MBy;
constexpr size_t OFF_Y = 344 * MBy;
constexpr size_t OFF_PQ = 380 * MBy;
constexpr size_t OFF_IDS = 412 * MBy;
constexpr size_t OFF_GATE = 420 * MBy;
constexpr size_t OFF_BAR = 428 * MBy;
constexpr size_t OFF_CNT = OFF_BAR + 16384;
constexpr size_t OFF_SSY = 429 * MBy;
constexpr size_t OFF_PB = 431 * MBy;
constexpr size_t OFF_PW0 = 452 * MBy;
constexpr size_t OFF_A8 = OFF_PQ;
constexpr size_t OFF_XH = OFF_FQ;
constexpr size_t OFF_XL = OFF_FQ + 16 * MBy;
constexpr size_t WS_END = 484 * MBy;

struct Params {
    const float* x; const float* p; const int* pos;
    const float* norm_mix_g; const float* w_in; const float* b_forget; const float* mla_q_norm_g; const float* w_uq;
    const float* mla_kv_norm_g; const float* w_ukv; const float* mix_out_norm_g; const float* w_o; const float* norm_ffn_g;
    const float* w_query; const float* sub_keys; const float* peer_u; const float* peer_v; const float* w_ple;
    const float* ple_norm_g; const float* w_ple_gate; const float* final_norm_g;
    float* out; char* ws;
};

__shared__ __attribute__((aligned(16))) char smem[LDS_BYTES];

__device__ __forceinline__ int opaque_tid() { int t = threadIdx.x; asm volatile("" : "+v"(t)); return t; }
template <typename T> __device__ __forceinline__ T* opq(T* p) { size_t z = 0; asm volatile("" : "+s"(z)); return (T*)((char*)p + z); }

__device__ __forceinline__ unsigned pack2(float a, float b) {
    f32x2 v = {a, b};
    bf16x2 r = __builtin_convertvector(v, bf16x2);
    return __builtin_bit_cast(unsigned, r);
}
__device__ __forceinline__ float bflo(unsigned u) { return __uint_as_float(u << 16); }
__device__ __forceinline__ float bfhi(unsigned u) { return __uint_as_float(u & 0xffff0000u); }
__device__ __forceinline__ float4 ntload4(const float4* p) {
    const f32x4 t = __builtin_nontemporal_load((const f32x4*)p);
    return make_float4(t.x, t.y, t.z, t.w);
}
__device__ __forceinline__ float wave_sum(float v) {
#pragma unroll
    for (int o = 32; o > 0; o >>= 1) v += __shfl_xor(v, o);
    return v;
}
template <int CTRL> __device__ __forceinline__ float dpp_add(float v) {
    return v + __builtin_bit_cast(float, __builtin_amdgcn_update_dpp(0, __builtin_bit_cast(int, v), CTRL, 0xf, 0xf, true));
}
__device__ __forceinline__ float sum8_dpp(float v) { v = dpp_add<0xB1>(v); v = dpp_add<0x4E>(v); v = dpp_add<0x141>(v); return v; }
__device__ __forceinline__ float sumg_dpp(float v) {
    v = dpp_add<0x128>(v);
    float a = v, b = v;
    asm volatile("s_nop 1\n\tv_permlane16_swap_b32 %0, %1\n\ts_nop 1" : "+v"(a), "+v"(b));
    v = a + b;
    a = v; b = v;
    asm volatile("s_nop 1\n\tv_permlane32_swap_b32 %0, %1\n\ts_nop 1" : "+v"(a), "+v"(b));
    return a + b;
}
template <int CTRL> __device__ __forceinline__ float dpp_max0(float v) {
    return fmaxf(v, __builtin_bit_cast(float, __builtin_amdgcn_update_dpp(0, __builtin_bit_cast(int, v), CTRL, 0xf, 0xf, true)));
}
__device__ __forceinline__ float wave_max0(float v) {
    v = dpp_max0<0xB1>(v); v = dpp_max0<0x4E>(v); v = dpp_max0<0x141>(v); v = dpp_max0<0x140>(v);
    float a = v, b = v;
    asm volatile("s_nop 1\n\tv_permlane16_swap_b32 %0, %1\n\ts_nop 1" : "+v"(a), "+v"(b));
    v = fmaxf(a, b); a = v; b = v;
    asm volatile("s_nop 1\n\tv_permlane32_swap_b32 %0, %1\n\ts_nop 1" : "+v"(a), "+v"(b));
    return fmaxf(a, b);
}
__device__ __forceinline__ int partner32(int v, int hh) {
    int a = v, b = v;
    asm volatile("s_nop 1\n\tv_permlane32_swap_b32 %0, %1\n\ts_nop 1" : "+v"(a), "+v"(b));
    return hh ? a : b;
}
__device__ __forceinline__ float fexp2(float x) { return __builtin_amdgcn_exp2f(x); }
__device__ __forceinline__ float flog2(float x) { return __builtin_amdgcn_logf(x); }
__device__ __forceinline__ float log_sigmoid_f(float z) { return fminf(z, 0.f) - 0.6931471805599453f * flog2(1.f + fexp2(-1.4426950408889634f * fabsf(z))); }

struct WJob { const float* src; int lds; int K; int Np; bf16* dst; int ldd; const float* gain; int map; };

__device__ __forceinline__ int src_col_map(int map, int c) {
    if (map == 0) return c;
    if (map == 1) {
        if (c < 768) return c;
        if (c < 1952) return c + 4;
        if (c < 1956) return c - 1952 + 768;
        return -1;
    }
    if (c < 256) return 192 * (c >> 6) + (c & 63);
    int e = c - 256;
    return 192 * (e >> 7) + 64 + (e & 127);
}

__device__ __forceinline__ void wconv_group(const WJob& j, int t0, int tstride, int ntiles) {
    float* tl = (float*)smem;
    const int ktiles = j.K >> 5;
    const int tx = opaque_tid() & 31, ty = opaque_tid() >> 5;
    float v[8][2];
#pragma unroll
    for (int u = 0; u < 8; ++u) {
        const int tile = t0 + u * tstride;
        v[u][0] = 0.f; v[u][1] = 0.f;
        if (tile < ntiles) {
            const int nt = tile / ktiles, kt = tile % ktiles;
            const int sc = src_col_map(j.map, nt * 32 + tx);
            if (sc >= 0) {
#pragma unroll
                for (int i = 0; i < 2; ++i) {
                    const int k = kt * 32 + ty + 16 * i;
                    v[u][i] = j.src[(size_t)k * j.lds + sc] * (j.gain ? j.gain[k] : 1.f);
                }
            }
        }
    }
#pragma unroll
    for (int u = 0; u < 8; ++u)
#pragma unroll
        for (int i = 0; i < 2; ++i) tl[u * 1056 + (ty + 16 * i) * 33 + tx] = v[u][i];
    __syncthreads();
#pragma unroll
    for (int u = 0; u < 8; ++u) {
        const int tile = t0 + u * tstride;
        if (tile < ntiles) {
            const int nt = tile / ktiles, kt = tile % ktiles;
#pragma unroll
            for (int i = 0; i < 2; ++i) {
                const int n = nt * 32 + ty + 16 * i;
                j.dst[(size_t)n * j.ldd + kt * 32 + tx] = (bf16)tl[u * 1056 + tx * 33 + ty + 16 * i];
            }
        }
    }
    __syncthreads();
}

__device__ __forceinline__ void phase0(const Params& P) {
    char* ws = opq(P.ws);
    const int G = gridDim.x, bid = blockIdx.x, tid = opaque_tid();
    for (int rep = 0; rep < (DUP == 20 ? 2 : 1); ++rep) {
        const int w = tid >> 6, l = tid & 63;
        float* tsc = (float*)(ws + OFF_TSC);
        for (int it = (bid * NW + w) * 4; it < 4 * NEXP; it += G * NW * 4) {
            const int tb = it >> 14, e0 = it & (NEXP - 1);
            const float4* src = (const float4*)((tb < 2 ? P.peer_u : P.peer_v) + ((size_t)(tb & 1) * NEXP + e0) * DM) + l;
            unsigned char* dst = (unsigned char*)(ws + (tb < 2 ? OFF_UB : OFF_VB)) + (size_t)(tb & 1) * NEXP * 512 + (size_t)e0 * 128 + 2 * l;
            float4 v[4][4];
#pragma unroll
            for (int r = 0; r < 4; ++r)
#pragma unroll
                for (int q = 0; q < 4; ++q) v[r][q] = ntload4(src + 256 * r + 64 * q);
            if (tb < 2) {
                const float4* g4 = (const float4*)(P.norm_ffn_g + (tb & 1) * 1024) + l;
#pragma unroll
                for (int q = 0; q < 4; ++q) {
                    const float4 g = g4[64 * q];
#pragma unroll
                    for (int r = 0; r < 4; ++r) { v[r][q].x *= g.x; v[r][q].y *= g.y; v[r][q].z *= g.z; v[r][q].w *= g.w; }
                }
            }
            float am[4];
#pragma unroll
            for (int r = 0; r < 4; ++r) {
                float m = 0.f;
#pragma unroll
                for (int q = 0; q < 4; ++q) m = fmaxf(m, fmaxf(fmaxf(fabsf(v[r][q].x), fabsf(v[r][q].y)), fmaxf(fabsf(v[r][q].z), fabsf(v[r][q].w))));
                am[r] = wave_max0(m);
            }
#pragma unroll
            for (int r = 0; r < 4; ++r) {
                const float sc = (am[r] > 0.f) ? (6.0f / am[r]) : 1.f, isc = (am[r] > 0.f) ? (am[r] * (1.f / 6.0f)) : 1.f;
#pragma unroll
                for (int q = 0; q < 4; ++q) {
                    unsigned wq = 0;
                    wq = __builtin_amdgcn_cvt_scalef32_pk_fp4_f32(wq, v[r][q].x * sc, v[r][q].y * sc, 1.0f, 0);
                    wq = __builtin_amdgcn_cvt_scalef32_pk_fp4_f32(wq, v[r][q].z * sc, v[r][q].w * sc, 1.0f, 1);
                    *(unsigned short*)(dst + (size_t)q * NEXP * 128 + r * 128) = (unsigned short)(wq & 0xffffu);
                }
                if (l == 0) tsc[tb * NEXP + e0 + r] = isc;
            }
        }
    }
    if (DUP == 22) {
        const int w = tid >> 6, l = tid & 63;
        float4 accp = {0.f, 0.f, 0.f, 0.f};
        for (int it = (bid * NW + w) * 4; it < 4 * NEXP; it += G * NW * 4) {
            float4 v[16];
#pragma unroll
            for (int r = 0; r < 4; ++r) {
                const int tb = (it + r) >> 14, e = (it + r) & (NEXP - 1);
                const float4* src = (const float4*)((tb < 2 ? P.peer_u : P.peer_v) + ((size_t)(tb & 1) * NEXP + e) * DM) + l;
#pragma unroll
                for (int q = 0; q < 4; ++q) v[4 * r + q] = src[64 * q];
            }
#pragma unroll
            for (int q = 0; q < 16; ++q) { accp.x += v[q].x; accp.y += v[q].y; accp.z += v[q].z; accp.w += v[q].w; }
        }
        ((float4*)(ws + OFF_PART))[bid * NTHR + tid] = accp;
    }
    for (int rep = 0; rep < (DUP == 21 ? 2 : 1); ++rep) {
        for (int L = 0; L < 2; ++L) {
            WJob jobs[7];
            jobs[0] = {P.w_in + (size_t)L * 1024 * IN_W, IN_W, 1024, 2048, (bf16*)(ws + OFF_WIN) + (size_t)L * 2048 * LDH, LDH, P.norm_mix_g + L * 1024, 1};
            jobs[1] = {P.w_o + (size_t)L * 1024 * 1024, 1024, 1024, 1024, (bf16*)(ws + OFF_WO) + (size_t)L * 1024 * LDH, LDH, P.mix_out_norm_g + L * 1024, 0};
            jobs[2] = {P.w_query + (size_t)L * 1024 * 1024, 1024, 1024, 1024, (bf16*)(ws + OFF_WQ) + (size_t)L * 1024 * LDH, LDH, P.norm_ffn_g + L * 1024, 0};
            jobs[3] = {P.w_ple_gate + (size_t)L * 1024 * 1024, 1024, 1024, 1024, (bf16*)(ws + OFF_WG) + (size_t)L * 1024 * LDH, LDH, P.ple_norm_g + L * 1024, 0};
            jobs[4] = {P.w_ple + (size_t)L * 256 * 1024, 1024, 256, 1024, (bf16*)(ws + OFF_WP) + (size_t)L * 1024 * LDP, LDP, nullptr, 0};
            jobs[5] = {P.w_uq + (size_t)L * 256 * 384, 384, 256, 384, (bf16*)(ws + OFF_WUQ) + (size_t)L * 384 * LDP, LDP, P.mla_q_norm_g + L * 256, 0};
            jobs[6] = {P.w_ukv + (size_t)L * 128 * 768, 768, 128, 768, (bf16*)(ws + OFF_WUKV) + (size_t)L * 768 * LDC, LDC, P.mla_kv_norm_g + L * 128, 2};
#pragma unroll
            for (int q = 0; q < 7; ++q) {
                int nt = (jobs[q].Np >> 5) * (jobs[q].K >> 5);
                for (int it = bid; it < nt; it += 8 * G) wconv_group(jobs[q], it, G, nt);
            }
        }
    }
    {
        const float* src = P.sub_keys;
        bf16* dst = (bf16*)(ws + OFF_SKB);
        for (int i = bid * NTHR + tid; i < 262144 / 2; i += G * NTHR) {
            float2 v = ((const float2*)src)[i];
            ((unsigned*)dst)[i] = pack2(v.x, v.y);
        }
    }
    {
        const float4* src = (const float4*)P.p;
        bf16* dst = (bf16*)(ws + OFF_PB);
        for (int i0 = bid * NTHR + tid; i0 < 2 * TOK * 256 / 4; i0 += 4 * G * NTHR) {
            float4 a[4];
#pragma unroll
            for (int u = 0; u < 4; ++u) a[u] = ntload4(src + ((i0 + u * G * NTHR < 2 * TOK * 64) ? (i0 + u * G * NTHR) : i0));
#pragma unroll
            for (int u = 0; u < 4; ++u) {
                const int i = i0 + u * G * NTHR;
                if (i >= 2 * TOK * 64) break;
                u32x2 o = {pack2(a[u].x, a[u].y), pack2(a[u].z, a[u].w)};
                *(u32x2*)(dst + (size_t)(i >> 6) * LDP + (i & 63) * 4) = o;
            }
        }
    }
    {
        bf16* hb = (bf16*)(ws + OFF_HB0);
        float* ss0 = (float*)(ws + OFF_SSA);
        int w = tid >> 6, l = tid & 63;
        for (int row0 = (bid * NW + w) * 4; row0 < TOK; row0 += G * NW * 4) {
            const float4* xr = (const float4*)(P.x + (size_t)row0 * DM) + l;
            float4 a[4][4];
#pragma unroll
            for (int r = 0; r < 4; ++r)
#pragma unroll
                for (int i = 0; i < 4; ++i) a[r][i] = ntload4(xr + 256 * r + 64 * i);
#pragma unroll
            for (int r = 0; r < 4; ++r) {
                const int row = row0 + r;
                float ss = 0.f;
#pragma unroll
                for (int i = 0; i < 4; ++i) {
                    ss += a[r][i].x * a[r][i].x + a[r][i].y * a[r][i].y + a[r][i].z * a[r][i].z + a[r][i].w * a[r][i].w;
                    u32x2 o = {pack2(a[r][i].x, a[r][i].y), pack2(a[r][i].z, a[r][i].w)};
                    ((u32x2*)(hb + (size_t)row * LDH))[i * 64 + l] = o;
                }
                ss = wave_sum(ss);
                if (l == 0) {
                    *(float4*)(ss0 + (size_t)row * 8) = make_float4(ss, 0.f, 0.f, 0.f);
                    *(float4*)(ss0 + (size_t)row * 8 + 4) = make_float4(0.f, 0.f, 0.f, 0.f);
                }
            }
        }
    }
    {
        float* cs = (float*)(ws + OFF_CS);
        for (int i = bid * NTHR + tid; i < TOK * 16; i += G * NTHR) {
            int t = i >> 4, k = i & 15;
            float inv = powf(10000.0f, -(float)k / 16.0f);
            float ang = (float)P.pos[t] * inv;
            cs[2 * i] = cosf(ang);
            cs[2 * i + 1] = sinf(ang);
        }
    }
}

struct NoHook { static constexpr bool nodma = false; __device__ __forceinline__ void operator()(int, f32x16 (&)[2][2]) const {} };
struct NoDmaHook { static constexpr bool nodma = true; __device__ __forceinline__ void operator()(int, f32x16 (&)[2][2]) const {} };
template <typename HOOK>
__device__ __forceinline__ void gemm_core(f32x16 (&acc)[2][2], const bf16* A, int lda, const bf16* Bt, int ldb, int K,
                                          int m0, int n0, HOOK hook) {
    const int tid = opaque_tid(), w = tid >> 6, l = tid & 63, r = l & 31, hh = l >> 5;
    const int wm = w >> 1, wn = w & 1;
    const int dp = (tid & 15) ^ ((tid >> 4) & 15);
    const int drow = 2 * (tid >> 4) + (dp >> 3), dgc = (dp & 7) * 8;
    const bf16* asrc = A + (size_t)(m0 + drow) * lda + dgc;
    const bf16* bsrc = Bt + (size_t)(n0 + drow) * ldb + dgc;
    auto dma = [&](int buf, int k0) {
        if (HOOK::nodma) return;
        char* base = smem + buf * STAGE_BYTES + tid * 16;
#pragma unroll
        for (int i = 0; i < 4; ++i)
            __builtin_amdgcn_global_load_lds((const unsigned*)(asrc + (size_t)(64 * i) * lda + k0), (unsigned*)(base + i * 8192), 16, 0, 0);
#pragma unroll
        for (int i = 0; i < 2; ++i)
            __builtin_amdgcn_global_load_lds((const unsigned*)(bsrc + (size_t)(64 * i) * ldb + k0), (unsigned*)(base + 32768 + i * 8192), 16, 0, 0);
    };
    int offA[2], offB[2];
#pragma unroll
    for (int i = 0; i < 2; ++i) { offA[i] = ((wm * 64 + i * 32 + r) >> 1) * 256; offB[i] = 32768 + ((wn * 64 + i * 32 + r) >> 1) * 256; }
    const int pbase = ((r & 1) << 3), lx = (r >> 1) & 15;
    const int nk = K >> 6;
    const unsigned ldsbase = (unsigned)(size_t)(__attribute__((address_space(3))) char*)smem;
    auto ldfrag = [&](int stage, int s, bf16x8 (&af)[2], bf16x8 (&bfr)[2]) {
        unsigned ch = (unsigned)((((pbase | (2 * s + hh)) ^ lx) << 4)) + ldsbase + (unsigned)(stage * STAGE_BYTES);
        unsigned a0a = ch + offA[0], a1a = ch + offA[1], b0a = ch + offB[0], b1a = ch + offB[1];
        asm volatile("ds_read_b128 %0, %4\n\tds_read_b128 %1, %5\n\tds_read_b128 %2, %6\n\tds_read_b128 %3, %7"
                     : "=&v"(af[0]), "=&v"(af[1]), "=&v"(bfr[0]), "=&v"(bfr[1]) : "v"(a0a), "v"(a1a), "v"(b0a), "v"(b1a) : "memory");
    };
    auto mma = [&](bf16x8 (&af)[2], bf16x8 (&bfr)[2]) {
#pragma unroll
        for (int i = 0; i < 2; ++i)
#pragma unroll
            for (int j = 0; j < 2; ++j) acc[i][j] = __builtin_amdgcn_mfma_f32_32x32x16_bf16(af[i], bfr[j], acc[i][j], 0, 0, 0);
    };
#define LGKM_WAIT(n) do { asm volatile("s_waitcnt lgkmcnt(" #n ")" ::: "memory"); __builtin_amdgcn_sched_barrier(0); } while (0)
    asm volatile("s_waitcnt vmcnt(0)" ::: "memory");
    dma(0, 0);
    dma(1, 64);
    if (nk > 2) { dma(2, 128); asm volatile("s_waitcnt vmcnt(12)" ::: "memory"); }
    else asm volatile("s_waitcnt vmcnt(6)" ::: "memory");
    __builtin_amdgcn_s_barrier();
    bf16x8 a0[2], b0[2], a1[2], b1[2];
    ldfrag(0, 0, a0, b0);
    int cur = 0;
    for (int kt = 0; kt < nk; ++kt) {
        const int nxt = (cur == 2) ? 0 : cur + 1;
        if (kt == 4 || kt == 8) { LGKM_WAIT(0); hook(kt, acc); }
        ldfrag(cur, 1, a1, b1);
        LGKM_WAIT(4);
        mma(a0, b0);
        ldfrag(cur, 2, a0, b0);
        LGKM_WAIT(4);
        mma(a1, b1);
        ldfrag(cur, 3, a1, b1);
        LGKM_WAIT(4);
        mma(a0, b0);
        if (kt + 1 < nk) {
            if (kt + 2 < nk) asm volatile("s_waitcnt vmcnt(6) lgkmcnt(0)" ::: "memory");
            else asm volatile("s_waitcnt vmcnt(0) lgkmcnt(0)" ::: "memory");
            __builtin_amdgcn_s_barrier();
            __builtin_amdgcn_sched_barrier(0);
            if (kt + 3 < nk) dma(cur, (kt + 3) << 6);
            ldfrag(nxt, 0, a0, b0);
        } else {
            LGKM_WAIT(0);
        }
        mma(a1, b1);
        cur = nxt;
    }
    __syncthreads();
}
__device__ __forceinline__ float row_rs8(const float* part, int row) {
    float4 a = *(const float4*)(part + (size_t)row * 8), b = *(const float4*)(part + (size_t)row * 8 + 4);
    float ss = ((a.x + a.y) + (a.z + a.w)) + ((b.x + b.y) + (b.z + b.w));
    return rsqrtf(ss * (1.f / 1024.f) + EPSF);
}
__device__ __forceinline__ bool xcd_tile(int it, int MT, int NT, int& mt, int& nt) {
    const int G = gridDim.x, bid = blockIdx.x;
    if ((G & 7) == 0 && (MT & 7) == 0) {
        const int nbx = G >> 3, q = (bid >> 3) + it * nbx, per = (MT >> 3) * NT;
        if (q >= per) return false;
        mt = (bid & 7) * (MT >> 3) + q / NT; nt = q % NT;
        return true;
    }
    const int q = bid + it * G;
    if (q >= MT * NT) return false;
    mt = q / NT; nt = q % NT;
    return true;
}
struct NoScale { __device__ __forceinline__ float operator()(int, int) const { return 1.f; } };

#define ZERO_ACC(acc)                                  \
    _Pragma("unroll") for (int _i = 0; _i < 2; ++_i)   \
    _Pragma("unroll") for (int _j = 0; _j < 2; ++_j)   \
    _Pragma("unroll") for (int _r = 0; _r < 16; ++_r) acc[_i][_j][_r] = 0.f;


namespace pg8 {
#define PG8_LAS __attribute__((address_space(3)))
typedef unsigned short bf16_t;
constexpr int BM = 256, BK = 64, HALF = 128, HTB = HALF * BK * 2  , NXCD = 8, WGM = 8;

__host__ __device__ __forceinline__ int lds_byte(int r, int c) { const int st = (r >> 4) * 2 + (c >> 5), rr = r & 15, cc = c & 31, ob = rr * 64 + cc * 2; return st * 1024 + (ob ^ (((ob >> 9) & 1) << 5)); }
__host__ __device__ __forceinline__ void stage_rc(int b, int& R, int& C) { const int st = b / 1024, sb = b % 1024, swz = sb ^ (((sb >> 9) & 1) << 5); R = (st >> 1) * 16 + swz / 64; C = (st & 1) * 32 + (swz % 64) / 2; }
__host__ __device__ __forceinline__ int perm32(int rho) { const int n = rho >> 4, i = rho & 15; return 8 * (i >> 2) + 4 * n + (i & 3); }
struct Unit { int pm, pn; };
struct Gemm { const bf16* A; const bf16* Bt; int lda, ldb, M, N, K; };
struct StaticOrder {
    int nM, nN, nwg, G, c;
    __device__ void init(int M, int N, int G_, int c_) { nM = M / BM; nN = N / BM; nwg = nM * nN; G = G_; c = c_; }
    __device__ bool next(int i, Unit& u) const {
        const long L = (long)i * G + c; if (L >= nwg) return false;
        int wgid = (int)L; { const int q = nwg / NXCD, r = nwg % NXCD, xcd = wgid % NXCD, off = wgid / NXCD; wgid = (xcd < r ? xcd * (q + 1) : r * (q + 1) + (xcd - r) * q) + off; }
        const int nig = WGM * nN, gid = wgid / nig, fm = gid * WGM, gsz = (nM - fm) < WGM ? (nM - fm) : WGM;
        u.pm = fm + ((wgid % nig) % gsz); u.pn = (wgid % nig) / gsz; return true;
    }
    __device__ __forceinline__ void a_ready(const Unit&) const {}
    __device__ __forceinline__ void done(const Unit&) const {}
};
template <class Epi, class Sched, bool STAMP = false>
__device__ __forceinline__ void gemm_phase(PG8_LAS unsigned char* lds, const Gemm g, const Sched& S, const Epi& E, unsigned long long* stamps) {
    const int tid = opaque_tid(), wid = __builtin_amdgcn_readfirstlane(tid >> 6), lane = tid & 63, wr = wid >> 2, wc = wid & 3, fr = lane & 15, fq = lane >> 4;
    const int K = g.K, nt = K / BK;
    int ts_lo = 0, ts_hi = 0, nts = 0; const unsigned long long rt_entry = STAMP ? (unsigned long long)wall_clock64() : 0ull;
#define PG8_STAMP() do { if (STAMP && wid == 0 && nts < 64) { const unsigned long long _c = (unsigned long long)clock64(); \
        ts_lo = (lane == nts) ? (int)(unsigned)_c : ts_lo; ts_hi = (lane == nts) ? (int)(unsigned)(_c >> 32) : ts_hi; ++nts; } } while (0)
    PG8_STAMP();
    unsigned voffA[2], voffB[2];
#pragma unroll
    for (int i = 0; i < 2; ++i) { int R, C; stage_rc(tid * 16 + i * 8192, R, C); const int Rb = Epi::PERM ? ((R & ~31) + perm32(R & 31)) : R;
        voffA[i] = (unsigned)(R * g.lda + C) * 2u; voffB[i] = (unsigned)(Rb * g.ldb + C) * 2u; }
    const size_t kstep = (size_t)(BK * 2);
    const size_t hstepA = (size_t)HALF * g.lda * 2, hstepB = (size_t)HALF * g.ldb * 2;
    const size_t tstepA = 2 * hstepA, tstepB = 2 * hstepB;
    const unsigned ldsw = (unsigned)wid * 1024u;
    const int aoff = lds_byte(wr * 64 + fr, fq * 8), boff = lds_byte(wc * 32 + fr, fq * 8);
#define PG8_SA(b, h) (((b) * 2 + (h)) * HTB)
#define PG8_SB(b, h) ((4 + (b) * 2 + (h)) * HTB)
#define PG8_STAGE(bufoff, gbase, voff) do { _Pragma("unroll") for (int _i = 0; _i < 2; ++_i) \
        __builtin_amdgcn_global_load_lds((const unsigned*)((const char*)(gbase) + (voff)[_i]), (PG8_LAS unsigned*)(lds + (bufoff) + ldsw + _i * 8192), 16, 0, 0); } while (0)
#define PG8_LDA(dst, b, h) do { _Pragma("unroll") for (int m = 0; m < 4; ++m) _Pragma("unroll") for (int k = 0; k < 2; ++k) dst[m][k] = *(const PG8_LAS bf16x8*)(lds + PG8_SA(b, h) + aoff + m * 2048 + k * 1024); } while (0)
#define PG8_LDB(dst, b, h) do { _Pragma("unroll") for (int n = 0; n < 2; ++n) _Pragma("unroll") for (int k = 0; k < 2; ++k) dst[n][k] = *(const PG8_LAS bf16x8*)(lds + PG8_SB(b, h) + boff + n * 2048 + k * 1024); } while (0)
#define PG8_MMA(ai, bj, At, Bt) do { __builtin_amdgcn_s_setprio(1); _Pragma("unroll") for (int m = 0; m < 4; ++m) _Pragma("unroll") for (int n = 0; n < 2; ++n) _Pragma("unroll") for (int k = 0; k < 2; ++k) \
        acc[ai][bj][m][n] = __builtin_amdgcn_mfma_f32_16x16x32_bf16(Bt[n][k], At[m][k], acc[ai][bj][m][n], 0, 0, 0); __builtin_amdgcn_s_setprio(0); } while (0)
#define PG8_WAIT_V(n) asm volatile("s_waitcnt vmcnt(" #n ")" ::: "memory")
#define PG8_WAIT_L(n) asm volatile("s_waitcnt lgkmcnt(" #n ")" ::: "memory")
#define PG8_BAR __builtin_amdgcn_s_barrier()
#define PG8_SCHED __builtin_amdgcn_sched_barrier(0)
    Unit cur, nxt; int ui = 0;
    if (!S.next(0, cur)) return;
    f32x4 acc[2][2][4][2];
#pragma unroll
    for (int a = 0; a < 2; ++a)
#pragma unroll
        for (int b = 0; b < 2; ++b)
#pragma unroll
            for (int m = 0; m < 4; ++m)
#pragma unroll
                for (int n = 0; n < 2; ++n) acc[a][b][m][n] = (f32x4){0.f, 0.f, 0.f, 0.f};
    bf16x8 At[4][2], B0[2][2], B1[2][2];
    const char* cA = (const char*)g.A + (size_t)cur.pm * tstepA; const char* cB = (const char*)g.Bt + (size_t)cur.pn * tstepB;
    S.a_ready(cur);
    PG8_STAGE(PG8_SB(0, 0), cB, voffB); PG8_STAGE(PG8_SA(0, 0), cA, voffA); PG8_STAGE(PG8_SB(0, 1), cB + hstepB, voffB); PG8_STAGE(PG8_SA(0, 1), cA + hstepA, voffA);
    if (wr == 1) PG8_BAR;
    PG8_WAIT_V(4); PG8_BAR;
    PG8_STAGE(PG8_SB(1, 0), cB + kstep, voffB); PG8_STAGE(PG8_SA(1, 0), cA + kstep, voffA); PG8_STAGE(PG8_SB(1, 1), cB + hstepB + kstep, voffB);
    PG8_WAIT_V(6); PG8_BAR;
    PG8_STAMP();
    for (;;) {
        const bool has_next = S.next(ui + 1, nxt);
        const char* nA = has_next ? (const char*)g.A + (size_t)nxt.pm * tstepA : cA; const char* nB = has_next ? (const char*)g.Bt + (size_t)nxt.pn * tstepB : cB;
        for (int t = 0; t < nt; t += 2) {
            const bool last = (t == nt - 2);
            const char* a1 = cA + (size_t)(t + 1) * kstep;
            const char* a2 = last ? nA : cA + (size_t)(t + 2) * kstep; const char* b2 = last ? nB : cB + (size_t)(t + 2) * kstep;
            const char* a3 = a2 + kstep; const char* b3 = b2 + kstep;
            if (last && has_next) S.a_ready(nxt);
            E.khook(t, acc, wr, fr);
            PG8_LDB(B0, 0, 0); PG8_SCHED; PG8_LDA(At, 0, 0); PG8_STAGE(PG8_SA(1, 1), a1 + hstepA, voffA);
            PG8_WAIT_L(8); PG8_BAR; PG8_WAIT_L(0); PG8_MMA(0, 0, At, B0); PG8_BAR; PG8_SCHED;
            PG8_LDB(B1, 0, 1); PG8_STAGE(PG8_SB(0, 0), b2, voffB);
            PG8_BAR; PG8_WAIT_L(0); PG8_MMA(0, 1, At, B1); PG8_BAR;
            PG8_LDA(At, 0, 1); PG8_STAGE(PG8_SA(0, 0), a2, voffA);
            PG8_BAR; PG8_WAIT_L(0); PG8_MMA(1, 0, At, B0); PG8_BAR; PG8_SCHED;
            PG8_STAGE(PG8_SB(0, 1), b2 + hstepB, voffB);
            PG8_WAIT_V(6); PG8_BAR; PG8_MMA(1, 1, At, B1); PG8_BAR;
            PG8_LDB(B0, 1, 0); PG8_SCHED; PG8_LDA(At, 1, 0); PG8_STAGE(PG8_SA(0, 1), a2 + hstepA, voffA);
            PG8_WAIT_L(8); PG8_BAR; PG8_WAIT_L(0); PG8_MMA(0, 0, At, B0); PG8_BAR; PG8_SCHED;
            PG8_LDB(B1, 1, 1); PG8_STAGE(PG8_SB(1, 0), b3, voffB);
            PG8_BAR; PG8_WAIT_L(0); PG8_MMA(0, 1, At, B1); PG8_BAR;
            PG8_LDA(At, 1, 1); PG8_STAGE(PG8_SA(1, 0), a3, voffA);
            PG8_BAR; PG8_WAIT_L(0); PG8_MMA(1, 0, At, B0); PG8_BAR; PG8_SCHED;
            PG8_STAGE(PG8_SB(1, 1), b3 + hstepB, voffB);
            PG8_WAIT_V(6); PG8_BAR; PG8_MMA(1, 1, At, B1); PG8_BAR;
        }
        PG8_STAMP();
        if constexpr (!Epi::AFTER_DRAIN) { E(acc, cur, wr, wc, fr, fq); S.done(cur); }
        PG8_STAMP();
        if (!has_next) break;
#pragma unroll
        for (int a = 0; a < 2; ++a)
#pragma unroll
            for (int b = 0; b < 2; ++b)
#pragma unroll
                for (int m = 0; m < 4; ++m)
#pragma unroll
                    for (int n = 0; n < 2; ++n) acc[a][b][m][n] = (f32x4){0.f, 0.f, 0.f, 0.f};
        cur = nxt; cA = nA; cB = nB; ++ui;
    }
    PG8_WAIT_V(0);
    if (wr == 0) PG8_BAR;
    PG8_BAR;
    if constexpr (Epi::AFTER_DRAIN) { E.fused(acc, cur, wr, wc, fr, fq, lds, wid, lane); S.done(cur); }
    PG8_STAMP();
    if (STAMP && wid == 0) { stamps[lane] = lane < nts ? (((unsigned long long)(unsigned)ts_hi << 32) | (unsigned)ts_lo) : 0ull;
        if (lane == 62) stamps[62] = rt_entry; if (lane == 63) stamps[63] = (unsigned long long)wall_clock64(); }
#undef PG8_STAMP
#undef PG8_SA
#undef PG8_SB
#undef PG8_STAGE
#undef PG8_LDA
#undef PG8_LDB
#undef PG8_MMA
#undef PG8_WAIT_V
#undef PG8_WAIT_L
#undef PG8_BAR
#undef PG8_SCHED
}
}

#define TB_LD 136
#define TF_LD 132
template <bool SCALE>
__device__ __forceinline__ void stage_bf16(const f32x16 (&acc)[2][2], const float* rsl) {
    bf16* T = (bf16*)smem;
    const int tid = opaque_tid(), w = tid >> 6, l = tid & 63, hh = l >> 5, wm = w >> 1, wn = w & 1;
#pragma unroll
    for (int i = 0; i < 2; ++i)
#pragma unroll
        for (int rr = 0; rr < 16; ++rr) {
            int row = wm * 64 + i * 32 + (rr & 3) + 8 * (rr >> 2) + 4 * hh;
            float sc = SCALE ? rsl[row] : 1.f;
#pragma unroll
            for (int j = 0; j < 2; ++j) T[row * TB_LD + wn * 64 + j * 32 + (l & 31)] = (bf16)(acc[i][j][rr] * sc);
        }
    __syncthreads();
}
template <bool SCALE>
__device__ __forceinline__ void stage_f32(const f32x16 (&acc)[2][2], const float* rsl) {
    float* T = (float*)smem;
    const int tid = opaque_tid(), w = tid >> 6, l = tid & 63, hh = l >> 5, wm = w >> 1, wn = w & 1;
#pragma unroll
    for (int i = 0; i < 2; ++i)
#pragma unroll
        for (int rr = 0; rr < 16; ++rr) {
            int row = wm * 64 + i * 32 + (rr & 3) + 8 * (rr >> 2) + 4 * hh;
            float sc = SCALE ? rsl[row] : 1.f;
#pragma unroll
            for (int j = 0; j < 2; ++j) T[row * TF_LD + wn * 64 + j * 32 + (l & 31)] = acc[i][j][rr] * sc;
        }
    __syncthreads();
}
template <typename CMAP>
__device__ __forceinline__ void store_rows_bf16(bf16* dst, int ld, int m0, CMAP cmap) {
    const bf16* T = (const bf16*)smem;
    const int tid = opaque_tid();
#pragma unroll
    for (int q = 0; q < 8; ++q) {
        int id = tid + 512 * q, row = id >> 4, ch = id & 15;
        u32x4 v = *(const u32x4*)(T + row * TB_LD + ch * 8);
        *(u32x4*)(dst + (size_t)(m0 + row) * ld + cmap(ch * 8)) = v;
    }
}
__device__ __forceinline__ void store_cols_bf16(bf16* vt, size_t crow0, int s0) {
    const unsigned short* T = (const unsigned short*)smem;
    const int tid = opaque_tid();
#pragma unroll
    for (int q = 0; q < 8; ++q) {
        int id = tid + 512 * q, c = id & 127, sg = id >> 7;
        unsigned e[8];
#pragma unroll
        for (int k = 0; k < 8; ++k) e[k] = T[(8 * sg + k) * TB_LD + c];
        u32x4 v = {e[0] | (e[1] << 16), e[2] | (e[3] << 16), e[4] | (e[5] << 16), e[6] | (e[7] << 16)};
        *(u32x4*)(vt + (crow0 + c) * SEQ + s0 + 8 * sg) = v;
    }
}
__device__ __forceinline__ void residual_store(const float* hin, float* hout, bf16* hb_out, float* gss, int m0, int n0, int nt) {
    const float* T = (const float*)smem;
    const int tid = opaque_tid(), l = tid & 63;
#pragma unroll 4
    for (int q = 0; q < 16; ++q) {
        int id = tid + 512 * q, row = id >> 5, ch = id & 31;
        f32x4 d = *(const f32x4*)(T + row * TF_LD + ch * 4);
        size_t gi = (size_t)(m0 + row) * 1024 + n0 + ch * 4;
        f32x4 h = *(const f32x4*)(hin + gi);
        f32x4 v = h + d;
        *(f32x4*)(hout + gi) = v;
        u32x2 b = {pack2(v.x, v.y), pack2(v.z, v.w)};
        *(u32x2*)(hb_out + (size_t)(m0 + row) * LDH + n0 + ch * 4) = b;
        float ss = v.x * v.x + v.y * v.y + v.z * v.z + v.w * v.w;
        ss = dpp_add<0xB1>(ss); ss = dpp_add<0x4E>(ss); ss = dpp_add<0x141>(ss); ss = dpp_add<0x140>(ss);
        ss += __shfl_xor(ss, 16);
        if ((l & 31) == 0) gss[(size_t)(m0 + row) * 8 + nt] = ss;
    }
}
struct ColAdd { int off; __device__ __forceinline__ int operator()(int c) const { return c + off; } };
struct ColHead96 { __device__ __forceinline__ int operator()(int c) const { return (c >> 6) * 96 + (c & 63); } };

struct EpiProj {
    static constexpr bool PERM = true, AFTER_DRAIN = false;
    const float* ssrow; char* ws;
    __device__ __forceinline__ void khook(int, f32x4 (&)[2][2][4][2], int, int) const {}
    __device__ __forceinline__ void operator()(const f32x4 (&acc)[2][2][4][2], const pg8::Unit& u, int wr, int wc, int fr, int fqd) const {
        asm volatile("" : "+v"(fr), "+v"(fqd));
        const int row0 = u.pm * 256 + wr * 64 + fr, lc0 = wc * 32 + 8 * fqd, pn = u.pn;
        size_t doff; int ld = 256;
        if (pn == 0) doff = OFF_FQ; else if (pn == 1) doff = OFF_FK; else if (pn == 2) doff = OFF_PART;
        else if (pn == 3) doff = OFF_SQ; else if (pn == 4) doff = OFF_SKK; else if (pn == 5) doff = OFF_PART + 8 * MBy;
        else if (pn == 6) { doff = OFF_CQ; ld = LDP; } else { doff = OFF_CKV; ld = LDC; }
        bf16* dst = (bf16*)(ws + doff);
        bf16* mk = (bf16*)(ws + OFF_MK); float* flog = (float*)(ws + OFF_FLOG); const float* cs = (const float*)(ws + OFF_CS);
#pragma unroll
        for (int ai = 0; ai < 2; ++ai)
#pragma unroll
            for (int m = 0; m < 4; ++m) {
                const int row = row0 + ai * 128 + m * 16;
                const float rs = row_rs8(ssrow, row);
#pragma unroll
                for (int bj = 0; bj < 2; ++bj) {
                    f32x4 v0 = acc[ai][bj][m][0] * rs, v1 = acc[ai][bj][m][1] * rs;
                    if (pn < 7 || bj == 0) {
                        u32x4 wv = {pack2(v0[0], v0[1]), pack2(v0[2], v0[3]), pack2(v1[0], v1[1]), pack2(v1[2], v1[3])};
                        *(u32x4*)(dst + (size_t)row * ld + bj * 128 + lc0) = wv;
                    } else if (wc == 0) {
                        const int hh = fqd >> 1, pi = 8 * (fqd & 1);
                        float vv[8] = {v0[0], v0[1], v0[2], v0[3], v1[0], v1[1], v1[2], v1[3]}, ov[8];
                        const f32x4* c4 = (const f32x4*)(cs + ((size_t)row * 16 + pi) * 2);
                        f32x4 t0 = c4[0], t1 = c4[1], t2 = c4[2], t3 = c4[3];
                        float cc[8] = {t0.x, t0.z, t1.x, t1.z, t2.x, t2.z, t3.x, t3.z}, sn[8] = {t0.y, t0.w, t1.y, t1.w, t2.y, t2.w, t3.y, t3.w};
#pragma unroll
                        for (int e = 0; e < 8; ++e) {
                            float pv = __builtin_bit_cast(float, partner32(__builtin_bit_cast(int, vv[e]), hh));
                            ov[e] = hh ? (pv * sn[e] + vv[e] * cc[e]) : (vv[e] * cc[e] - pv * sn[e]);
                        }
                        u32x4 wv = {pack2(ov[0], ov[1]), pack2(ov[2], ov[3]), pack2(ov[4], ov[5]), pack2(ov[6], ov[7])};
#pragma unroll
                        for (int h = 0; h < 4; ++h) *(u32x4*)(mk + (size_t)row * 384 + h * 96 + 64 + 8 * fqd) = wv;
                    } else if (wc == 1 && fqd == 0) {
                        *(f32x4*)(flog + (size_t)row * 4) = v0;
                    }
                }
            }
    }
};
__device__ __forceinline__ void phase_proj(const Params& P, int L, int hsel, int ss_slot) {
    char* ws = opq(P.ws);
    const float* ssrow = (const float*)(ws + OFF_SSA) + (size_t)ss_slot * TOK * 8;
    const bf16* hb = (const bf16*)(ws + (hsel ? OFF_HB1 : OFF_HB0));
    const bf16* Bt = (const bf16*)(ws + OFF_WIN) + (size_t)L * 2048 * LDH;
    pg8::Gemm g{hb, Bt, LDH, LDH, TOK, 2048, 1024};
    pg8::StaticOrder S; S.init(TOK, 2048, gridDim.x, blockIdx.x);
    EpiProj E{ssrow, ws};
    pg8::gemm_phase((PG8_LAS unsigned char*)smem, g, S, E, nullptr);
    __syncthreads();
}

template <int KW>
__device__ __forceinline__ void row_rms_to_lds(const bf16* A, int lda, int m0) {
    const int tid = opaque_tid(), row = tid >> 1, half = tid & 1;
    float ss = 0.f;
    const u32x4* p = (const u32x4*)(A + (size_t)(m0 + row) * lda + half * (KW / 2));
#pragma unroll
    for (int q = 0; q < KW / 16; ++q) {
        u32x4 v = p[q];
        float a;
        a = bflo(v.x); ss += a * a; a = bfhi(v.x); ss += a * a;
        a = bflo(v.y); ss += a * a; a = bfhi(v.y); ss += a * a;
        a = bflo(v.z); ss += a * a; a = bfhi(v.z); ss += a * a;
        a = bflo(v.w); ss += a * a; a = bfhi(v.w); ss += a * a;
    }
    ss += __shfl_xor(ss, 1);
    if (half == 0) ((float*)(smem + LDS_AUX))[row] = rsqrtf(ss * (1.f / (float)KW) + EPSF);
}

__device__ __forceinline__ void phase_mla_up(const Params& P, int L) {
    char* ws = opq(P.ws);
    const bf16* cq = (const bf16*)(ws + OFF_CQ); const bf16* ckv = (const bf16*)(ws + OFF_CKV);
    const bf16* wuq = (const bf16*)(ws + OFF_WUQ) + (size_t)L * 384 * LDP;
    const bf16* wukv = (const bf16*)(ws + OFF_WUKV) + (size_t)L * 768 * LDC;
    bf16* mq = (bf16*)(ws + OFF_MQ); bf16* mk = (bf16*)(ws + OFF_MK); bf16* mvt = (bf16*)(ws + OFF_MVT);
    const float* cs = (const float*)(ws + OFF_CS);
    const float* flog = (const float*)(ws + OFF_FLOG);
    float* cumF = (float*)(ws + OFF_CUMF);
    const int tid = opaque_tid(), w = tid >> 6, l = tid & 63, hh = l >> 5, wm = w >> 1, wn = w & 1;
    const int NQ = 64 * 3, NKV = 64 * 6, NCF = 4;
    const float* aux = (const float*)(smem + LDS_AUX);
    for (int gw = blockIdx.x * NW + w; gw < 2048; gw += gridDim.x * NW) {
        const int type = gw >> 10, bh = (gw >> 5) & 31, tb = gw & 31, b = bh >> 2, h = bh & 3;
        const bf16* src = (const bf16*)(ws + OFF_PART + (type ? 8 * MBy : 0)) + ((size_t)(b * SEQ + tb * 64 + l) * 256 + h * 64);
        unsigned short* dst = (unsigned short*)(ws + (type ? OFF_SVT : OFF_FVT)) + (size_t)bh * 64 * SEQ + tb * 64 + l;
        u32x4 rv8[8];
#pragma unroll
        for (int q = 0; q < 8; ++q) rv8[q] = ((const u32x4*)src)[q];
#pragma unroll
        for (int q = 0; q < 8; ++q) {
            dst[(size_t)(8 * q + 0) * SEQ] = (unsigned short)(rv8[q].x & 0xffffu); dst[(size_t)(8 * q + 1) * SEQ] = (unsigned short)(rv8[q].x >> 16);
            dst[(size_t)(8 * q + 2) * SEQ] = (unsigned short)(rv8[q].y & 0xffffu); dst[(size_t)(8 * q + 3) * SEQ] = (unsigned short)(rv8[q].y >> 16);
            dst[(size_t)(8 * q + 4) * SEQ] = (unsigned short)(rv8[q].z & 0xffffu); dst[(size_t)(8 * q + 5) * SEQ] = (unsigned short)(rv8[q].z >> 16);
            dst[(size_t)(8 * q + 6) * SEQ] = (unsigned short)(rv8[q].w & 0xffffu); dst[(size_t)(8 * q + 7) * SEQ] = (unsigned short)(rv8[q].w >> 16);
        }
    }
    for (int item = blockIdx.x; item < NQ + NKV + NCF; item += gridDim.x) {
        if (item < NQ) {
            int mt = item / 3, nt = item % 3;
            int m0 = mt * 256, n0 = nt * 128;
            __syncthreads();
            row_rms_to_lds<256>(cq, LDP, m0);
            f32x16 acc[2][2];
            ZERO_ACC(acc);
            gemm_core(acc, cq, LDP, wuq, LDP, 256, m0, n0, NoHook());
#pragma unroll
            for (int i = 0; i < 2; ++i)
#pragma unroll
                for (int j = 0; j < 2; ++j) {
                    int c0 = n0 + wn * 64 + j * 32;
                    int rloc = wm * 64 + i * 32 + 4 * hh;
                    bool rot = (c0 % 96) == 64;
                    int ci = l & 31, pi = ci & 15;
#pragma unroll
                    for (int rr = 0; rr < 16; ++rr) {
                        int rl = rloc + (rr & 3) + 8 * (rr >> 2);
                        float v = acc[i][j][rr] * aux[rl];
                        if (rot) {
                            float pv = __shfl_xor(v, 16);
                            float2 c_s = *(const float2*)(cs + ((size_t)(m0 + rl) * 16 + pi) * 2);
                            v = (ci < 16) ? (v * c_s.x - pv * c_s.y) : (pv * c_s.y + v * c_s.x);
                        }
                        acc[i][j][rr] = v;
                    }
                }
            stage_bf16<false>(acc, nullptr);
            store_rows_bf16(mq, 384, m0, ColAdd{n0});
        } else if (item < NQ + NKV) {
            int it2 = item - NQ;
            int mt = it2 / 6, nt = it2 % 6;
            int m0 = mt * 256, n0 = nt * 128;
            __syncthreads();
            row_rms_to_lds<128>(ckv, LDC, m0);
            f32x16 acc[2][2];
            ZERO_ACC(acc);
            gemm_core(acc, ckv, LDC, wukv, LDC, 128, m0, n0, NoHook());
            stage_bf16<true>(acc, aux);
            if (nt < 2) {
                const int nb0 = n0;
                struct CM { int n0; __device__ __forceinline__ int operator()(int c) const { int col = n0 + c; return (col >> 6) * 96 + (col & 63); } };
                store_rows_bf16(mk, 384, m0, CM{nb0});
            } else {
                store_cols_bf16(mvt, (size_t)(m0 >> 11) * 512 + (n0 - 256), m0 & 2047);
            }
        } else {
            int seq = (item - NQ - NKV) * NW + w;
            int b = seq >> 2, h = seq & 3;
            float bfv = P.b_forget[L * 4 + h];
            float vals[32];
            float run = 0.f;
#pragma unroll
            for (int i = 0; i < 32; ++i) {
                int s = l * 32 + i;
                float z = flog[((size_t)b * SEQ + s) * 4 + h] + bfv;
                run += log_sigmoid_f(z);
                vals[i] = run;
            }
            float tot = run, incl = tot;
#pragma unroll
            for (int o = 1; o < 64; o <<= 1) {
                float t = __shfl_up(incl, o);
                if (l >= o) incl += t;
            }
            float excl = incl - tot;
#pragma unroll
            for (int i = 0; i < 32; ++i) cumF[(size_t)seq * SEQ + l * 32 + i] = vals[i] + excl;
        }
    }
}

template <int MODE, int DK, int DV>
__device__ __forceinline__ void attn_item(const bf16* __restrict__ Q, int ldq, const bf16* __restrict__ Kg, int ldk,
                          const bf16* __restrict__ Vt, const float* __restrict__ cumF, bf16* __restrict__ Y,
                          float* __restrict__ ssy, int b, int h, int qb, float c1, char* lds, int fake = 0) {
    constexpr int KSTR = DK * 2 + 16;
    constexpr int VSTR = 144;
    constexpr int KBYTES = 64 * KSTR, VBYTES = DV * VSTR;
    constexpr int BUF = (KBYTES + VBYTES + 256 + 255) & ~255;
    static_assert(2 * BUF <= 65536, "lds");
    constexpr int KCH = DK / 8, KPT = (64 * KCH) / 256, VPT = (DV * 8) / 256;
    const int tid = opaque_tid() & 255, w = tid >> 6, l = tid & 63, r = l & 31, hh = l >> 5;
    const int q0 = qb * 128;
    const int qrow = q0 + 32 * w + r;
    const size_t tok = (size_t)b * SEQ + qrow;
    const int bh = b * 4 + h;
    bf16x8 qf[DK / 16];
#pragma unroll
    for (int s = 0; s < DK / 16; ++s) qf[s] = *(const bf16x8*)(Q + tok * ldq + h * DK + 16 * s + 8 * hh);
    f32x16 o[DV / 32];
    const f32x16 zero16 = {0.f, 0.f, 0.f, 0.f, 0.f, 0.f, 0.f, 0.f, 0.f, 0.f, 0.f, 0.f, 0.f, 0.f, 0.f, 0.f};
#pragma unroll
    for (int d = 0; d < DV / 32; ++d) o[d] = zero16;
    float m = -1e30f, lsum = 0.f, R = 0.f;
    bool sbdead = false;
    int* dmask = (int*)(smem + LDS_BYTES - 32);
    float Fq = 0.f;
    if (MODE == 0) Fq = cumF[(size_t)bh * SEQ + qrow] * LOG2E;
    const int nkt = (q0 + 128) >> 6;
    u32x4 kregA[KPT], vregA[VPT], kregB[KPT], vregB[VPT];
    float4 fregA = {0.f, 0.f, 0.f, 0.f}, fregB = {0.f, 0.f, 0.f, 0.f};
    auto gload = [&](int kt, u32x4 (&kreg)[KPT], u32x4 (&vreg)[VPT], float4& freg) {
#pragma unroll
        for (int i = 0; i < KPT; ++i) {
            int e = tid + 256 * i;
            int row = e / KCH, ch = e % KCH;
            kreg[i] = *(const u32x4*)(Kg + ((size_t)b * SEQ + kt * 64 + row) * ldk + h * DK + ch * 8);
        }
#pragma unroll
        for (int i = 0; i < VPT; ++i) {
            int e = tid + 256 * i;
            int row = e >> 3, ch = e & 7;
            vreg[i] = *(const u32x4*)(Vt + ((size_t)bh * DV + row) * SEQ + kt * 64 + ch * 8);
        }
        if (MODE == 0 && tid < 16) freg = *(const float4*)(cumF + (size_t)bh * SEQ + kt * 64 + tid * 4);
    };
    auto lwrite = [&](int buf, u32x4 (&kreg)[KPT], u32x4 (&vreg)[VPT], float4& freg) {
        char* base = lds + buf * BUF;
#pragma unroll
        for (int i = 0; i < KPT; ++i) {
            int e = tid + 256 * i;
            int row = e / KCH, ch = e % KCH;
            *(u32x4*)(base + row * KSTR + ch * 16) = kreg[i];
        }
#pragma unroll
        for (int i = 0; i < VPT; ++i) {
            int e = tid + 256 * i;
            int row = e >> 3, ch = e & 7;
            *(u32x4*)(base + KBYTES + row * VSTR + ch * 16) = vreg[i];
        }
        if (MODE == 0 && tid < 16) { float4 fn = {-freg.x * LOG2E, -freg.y * LOG2E, -freg.z * LOG2E, -freg.w * LOG2E}; *(float4*)(base + KBYTES + VBYTES + tid * 16) = fn; }
    };
    const int prow = (r & 0x13) | ((r & 4) << 1) | ((r & 8) >> 1);
    auto ktof = [&](int it) { return (MODE == 1) ? (nkt - 1 - it) : it; };
    gload(ktof(0), kregA, vregA, fregA);
    lwrite(0, kregA, vregA, fregA);
    constexpr bool D2 = (MODE != 2);
    if (D2 && nkt > 1) gload(ktof(1), kregB, vregB, fregB);
    __syncthreads();
    auto tile = [&](int it, u32x4 (&kn)[KPT], u32x4 (&vn)[VPT], float4& fn2, u32x4 (&kf)[KPT], u32x4 (&vf2)[VPT], float4& ff) {
        const int kt = ktof(it);
        if (!(fake & 1)) {
        if (D2) { if (it + 2 < nkt) gload(ktof(it + 2), kf, vf2, ff); }
        else { if (it + 1 < nkt) gload(ktof(it + 1), kf, vf2, ff); }
        }
        const char* base = lds + (it & 1) * BUF;
        bool active = (kt * 64) <= (q0 + 32 * w + 31);
        if (MODE == 1) {
            if (sbdead) { active = false; atomicOr(&dmask[it & 1], 1 << (opaque_tid() >> 6)); }
        }
        if (active) {
            const bool needmask = (kt * 64 + 63) >= (q0 + 32 * w);
            f32x16 s[2];
#pragma unroll
            for (int sub = 0; sub < 2; ++sub) {
                s[sub] = zero16;
#pragma unroll
                for (int ks = 0; ks < DK / 16; ++ks) {
                    bf16x8 kf = *(const bf16x8*)(base + (sub * 32 + prow) * KSTR + (2 * ks + hh) * 16);
                    s[sub] = __builtin_amdgcn_mfma_f32_32x32x16_bf16(kf, qf[ks], s[sub], 0, 0, 0);
                }
            }
            bf16x8 pf[2][2];
            if (fake & 2) {
#pragma unroll
                for (int sub = 0; sub < 2; ++sub)
#pragma unroll
                    for (int a = 0; a < 2; ++a) {
                        uint4 u;
                        u.x = pack2(s[sub][8 * a], s[sub][8 * a + 1]); u.y = pack2(s[sub][8 * a + 2], s[sub][8 * a + 3]);
                        u.z = pack2(s[sub][8 * a + 4], s[sub][8 * a + 5]); u.w = pack2(s[sub][8 * a + 6], s[sub][8 * a + 7]);
                        pf[sub][a] = __builtin_bit_cast(bf16x8, u);
                    }
                lsum = 1.f;
            } else if (MODE != 1) {
                const float* Ft = (const float*)(base + KBYTES + VBYTES);
                float mx = -INFINITY;
                float tv[2][16];
#pragma unroll
                for (int sub = 0; sub < 2; ++sub)
#pragma unroll
                    for (int a = 0; a < 2; ++a) {
                        int kofs = sub * 32 + 16 * a + 8 * hh;
                        float fk[8];
                        if (MODE == 0) {
                            float4 f0 = *(const float4*)(Ft + kofs), f1 = *(const float4*)(Ft + kofs + 4);
                            fk[0] = f0.x; fk[1] = f0.y; fk[2] = f0.z; fk[3] = f0.w; fk[4] = f1.x; fk[5] = f1.y; fk[6] = f1.z; fk[7] = f1.w;
                        }
#pragma unroll
                        for (int j = 0; j < 8; ++j) {
                            int rr = 8 * a + j;
                            float v = (MODE == 0) ? fmaf(s[sub][rr], c1, fk[j]) : s[sub][rr] * c1;
                            tv[sub][rr] = v;
                        }
                    }
                if (needmask) {
#pragma unroll
                    for (int sub = 0; sub < 2; ++sub)
#pragma unroll
                        for (int rr = 0; rr < 16; ++rr) {
                            int key = kt * 64 + sub * 32 + 16 * (rr >> 3) + 8 * hh + (rr & 7);
                            if (key > qrow) tv[sub][rr] = -INFINITY;
                        }
                }
#pragma unroll
                for (int sub = 0; sub < 2; ++sub)
#pragma unroll
                    for (int rr = 0; rr < 16; ++rr) mx = fmaxf(mx, tv[sub][rr]);
                mx = fmaxf(mx, __builtin_bit_cast(float, partner32(__builtin_bit_cast(int, mx), hh)));
                float mnew = fmaxf(m, mx);
                float rsum = 0.f;
#pragma unroll
                for (int sub = 0; sub < 2; ++sub)
#pragma unroll
                    for (int a = 0; a < 2; ++a) {
                        float pv[8];
#pragma unroll
                        for (int j = 0; j < 8; ++j) { pv[j] = fexp2(tv[sub][8 * a + j] - mnew); rsum += pv[j]; }
                        uint4 u;
                        u.x = pack2(pv[0], pv[1]); u.y = pack2(pv[2], pv[3]); u.z = pack2(pv[4], pv[5]); u.w = pack2(pv[6], pv[7]);
                        pf[sub][a] = __builtin_bit_cast(bf16x8, u);
                    }
                rsum += __builtin_bit_cast(float, partner32(__builtin_bit_cast(int, rsum), hh));
                if (__builtin_amdgcn_ballot_w64(mnew != m) != 0ull) {
                    float alpha = fexp2(m - mnew);
                    lsum *= alpha;
#pragma unroll
                    for (int d = 0; d < DV / 32; ++d) o[d] = o[d] * alpha;
                    m = mnew;
                }
                lsum += rsum;
            } else {
#pragma unroll
                for (int sb = 0; sb < 2; ++sb) {
                    const int sub = 1 - sb;
                    float lsig[16], lneg[16];
                    float A0 = 0.f, A1 = 0.f;
#pragma unroll
                    for (int rr = 0; rr < 16; ++rr) {
                        int key = kt * 64 + sub * 32 + 16 * (rr >> 3) + 8 * hh + (rr & 7);
                        bool valid = key < qrow;
                        float z = s[sub][rr] * c1;
                        float e = fexp2(-fabsf(z));
                        float l1p = flog2(1.f + e);
                        float ls = fminf(z, 0.f) - l1p;
                        float ln = valid ? (ls - z) : 0.f;
                        lsig[rr] = valid ? ls : -INFINITY;
                        lneg[rr] = ln;
                        if (rr < 8) A0 += ln; else A1 += ln;
                    }
                    float B0 = __shfl_xor(A0, 32), B1 = __shfl_xor(A1, 32);
                    float base1 = (hh == 0) ? (R + B1) : R;
                    float base0 = (hh == 0) ? (R + B1 + A1 + B0) : (R + A1 + B1);
                    float wv[16];
                    float run = base1;
#pragma unroll
                    for (int j = 7; j >= 0; --j) { wv[8 + j] = fexp2(lsig[8 + j] + run); run += lneg[8 + j]; }
                    run = base0;
#pragma unroll
                    for (int j = 7; j >= 0; --j) { wv[j] = fexp2(lsig[j] + run); run += lneg[j]; }
                    R += A0 + A1 + B0 + B1;
#pragma unroll
                    for (int a = 0; a < 2; ++a) {
                        uint4 u;
                        u.x = pack2(wv[8 * a], wv[8 * a + 1]); u.y = pack2(wv[8 * a + 2], wv[8 * a + 3]);
                        u.z = pack2(wv[8 * a + 4], wv[8 * a + 5]); u.w = pack2(wv[8 * a + 6], wv[8 * a + 7]);
                        pf[sub][a] = __builtin_bit_cast(bf16x8, u);
                    }
                }
            }
            if (MODE == 1) {
                if (__builtin_amdgcn_ballot_w64(R > -150.f) == 0ull) { sbdead = true; atomicOr(&dmask[it & 1], 1 << (opaque_tid() >> 6)); }
            }
#pragma unroll
            for (int d = 0; d < DV / 32; ++d)
#pragma unroll
                for (int sub = 0; sub < 2; ++sub)
#pragma unroll
                    for (int a = 0; a < 2; ++a) {
                        bf16x8 vf = *(const bf16x8*)(base + KBYTES + (d * 32 + r) * VSTR + (sub * 32 + 16 * a + 8 * hh) * 2);
                        o[d] = __builtin_amdgcn_mfma_f32_32x32x16_bf16(vf, pf[sub][a], o[d], 0, 0, 0);
                    }
        }
        if (!(fake & 1)) { if (it + 1 < nkt) lwrite((it + 1) & 1, kn, vn, fn2); }
        __syncthreads();
    };
    if (D2) {
        for (int it = 0; it < nkt; it += 2) {
            if (MODE == 1 && it > 0 && ((volatile int*)dmask)[(it - 1) & 1] == 0xFF) break;
            tile(it, kregB, vregB, fregB, kregA, vregA, fregA);
            if (it + 1 < nkt) {
                if (MODE == 1 && ((volatile int*)dmask)[it & 1] == 0xFF) break;
                tile(it + 1, kregA, vregA, fregA, kregB, vregB, fregB);
            }
        }
    } else {
        for (int it = 0; it < nkt; ++it) tile(it, kregA, vregA, fregA, kregA, vregA, fregA);
    }
    float inv = (MODE == 1) ? 1.f : (1.f / lsum);
    float ssq = 0.f;
#pragma unroll
    for (int d = 0; d < DV / 32; ++d)
#pragma unroll
        for (int g = 0; g < 4; ++g) {
            float v0 = o[d][4 * g] * inv, v1 = o[d][4 * g + 1] * inv, v2 = o[d][4 * g + 2] * inv, v3 = o[d][4 * g + 3] * inv;
            ssq += v0 * v0 + v1 * v1 + v2 * v2 + v3 * v3;
            uint2 u; u.x = pack2(v0, v1); u.y = pack2(v2, v3);
            *(uint2*)(Y + tok * LDH + h * DV + d * 32 + 8 * g + 4 * hh) = u;
        }
    ssq += __shfl_xor(ssq, 32);
    if (hh == 0) ssy[tok * 16 + h] = ssq;
}

__device__ __forceinline__ void phase_attn(const Params& P, int L, int rep = 0, int fake = 0) {
    char* ws = opq(P.ws);
    int* cnt = (int*)(ws + OFF_CNT) + L * 64 + rep * 16;
    int* s_item = (int*)(smem + LDS_BYTES - 16);
    const float* cumF = (const float*)(ws + OFF_CUMF);
    bf16* Y = (bf16*)(ws + (fake ? OFF_PART : OFF_Y));
    float* ssy = fake ? (float*)(ws + OFF_PART + 40 * MBy) : (float*)(ws + OFF_SSY) + (size_t)L * TOK * 16;
    const int half = opaque_tid() >> 8;
    char* lds = smem + half * 65536;
    for (;;) {
        if (opaque_tid() == 0) { int z0 = 0; asm volatile("" : "+v"(z0)); *s_item = atomicAdd(cnt, 1); s_item[-4] = z0; s_item[-3] = z0; }
        __syncthreads();
        int pair = *s_item;
        __syncthreads();
        if (pair >= 768) break;
        int item = pair * 2 + half;
        int qb, type, bh;
        if (item < 1024) { qb = 15 - (item >> 6); type = (item & 32) ? 2 : 0; bh = item & 31; }
        else { const int j2 = item - 1024; qb = 15 - (j2 >> 5); type = 1; bh = j2 & 31; }
        int b = bh >> 2, h = bh & 3;
        if (type == 0) {
            attn_item<2, 96, 128>((const bf16*)(ws + OFF_MQ), 384, (const bf16*)(ws + OFF_MK), 384, (const bf16*)(ws + OFF_MVT), cumF,
                                  Y + 512, ssy + 8, b, h, qb, 0.10206207261596577f * LOG2E, lds, fake);
        } else if (type == 1) {
            attn_item<1, 64, 64>((const bf16*)(ws + OFF_SQ), 256, (const bf16*)(ws + OFF_SKK), 256, (const bf16*)(ws + OFF_SVT), cumF,
                                 Y + 256, ssy + 4, b, h, qb, 0.125f * LOG2E, lds, fake);
        } else {
            attn_item<0, 64, 64>((const bf16*)(ws + OFF_FQ), 256, (const bf16*)(ws + OFF_FK), 256, (const bf16*)(ws + OFF_FVT), cumF,
                                 Y + 0, ssy + 0, b, h, qb, 0.125f * LOG2E, lds, fake);
        }
    }
}

__device__ __forceinline__ void rowss_flush(float (&part)[2][16], float* gss, int m0, int nt) {
    float* lss = (float*)smem;
    const int tid = opaque_tid(), w = tid >> 6, l = tid & 63, hh = l >> 5, wm = w >> 1, wn = w & 1;
#pragma unroll
    for (int i = 0; i < 2; ++i)
#pragma unroll
        for (int rr = 0; rr < 16; ++rr) {
            float v = part[i][rr];
            v = dpp_add<0xB1>(v); v = dpp_add<0x4E>(v); v = dpp_add<0x141>(v); v = dpp_add<0x140>(v);
            v += __shfl_xor(v, 16);
            if ((l & 31) == 0) lss[wn * 256 + wm * 64 + i * 32 + (rr & 3) + 8 * (rr >> 2) + 4 * hh] = v;
        }
    __syncthreads();
    if (tid < 256) gss[(size_t)(m0 + tid) * 8 + nt] = lss[tid] + lss[256 + tid];
    __syncthreads();
}

__device__ __forceinline__ float sum_fq(float v) {
    float a = v, b = v;
    asm volatile("s_nop 1\n\tv_permlane16_swap_b32 %0, %1\n\ts_nop 1" : "+v"(a), "+v"(b));
    v = a + b; a = v; b = v;
    asm volatile("s_nop 1\n\tv_permlane32_swap_b32 %0, %1\n\ts_nop 1" : "+v"(a), "+v"(b));
    return a + b;
}
template <bool SIG, bool XQ>
__device__ __forceinline__ void residual_fused(const f32x4 (&acc)[2][2][4][2], const pg8::Unit& u, int wr, int wc, int fr, int fqd,
                                               const float* rowscale  , const bf16* gate  ,
                                               const bf16* hb_in, bf16* hb_out, float* gss, unsigned char* xq = nullptr) {
    float* lss = (float*)smem;
#pragma unroll
    for (int ai = 0; ai < 2; ++ai)
#pragma unroll
        for (int m = 0; m < 4; ++m) {
            const int rl = 128 * ai + 64 * wr + 16 * m + fr, row = u.pm * 256 + rl;
            const float sc = rowscale ? rowscale[rl] : 1.f;
#pragma unroll
            for (int bj = 0; bj < 2; ++bj) {
                const int col = u.pn * 256 + 128 * bj + 32 * wc + 8 * fqd;
                const u32x4 hq = *(const u32x4*)(hb_in + (size_t)row * LDH + col);
                const f32x4 hp0 = {bflo(hq.x), bfhi(hq.x), bflo(hq.y), bfhi(hq.y)}, hp1 = {bflo(hq.z), bfhi(hq.z), bflo(hq.w), bfhi(hq.w)};
                f32x4 d0 = acc[ai][bj][m][0] * sc, d1 = acc[ai][bj][m][1] * sc;
                if (SIG) {
#pragma unroll
                    for (int e = 0; e < 4; ++e) {
                        d0[e] = __builtin_amdgcn_rcpf(1.f + fexp2(-LOG2E * d0[e]));
                        d1[e] = __builtin_amdgcn_rcpf(1.f + fexp2(-LOG2E * d1[e]));
                    }
                }
                if (gate) {
                    u32x4 gq = *(const u32x4*)(gate + (size_t)row * 1024 + col);
                    f32x4 g0 = {bflo(gq.x), bfhi(gq.x), bflo(gq.y), bfhi(gq.y)}, g1 = {bflo(gq.z), bfhi(gq.z), bflo(gq.w), bfhi(gq.w)};
                    d0 = d0 * g0; d1 = d1 * g1;
                }
                f32x4 v0 = hp0 + d0, v1 = hp1 + d1;
                u32x4 wv = {pack2(v0[0], v0[1]), pack2(v0[2], v0[3]), pack2(v1[0], v1[1]), pack2(v1[2], v1[3])};
                *(u32x4*)(hb_out + (size_t)row * LDH + col) = wv;
                if (XQ) {
                    f32x4 c0, c1;
#pragma unroll
                    for (int e = 0; e < 4; ++e) { c0[e] = __builtin_amdgcn_fmed3f(v0[e], -448.f, 448.f); c1[e] = __builtin_amdgcn_fmed3f(v1[e], -448.f, 448.f); }
                    int h0 = __builtin_amdgcn_cvt_pk_fp8_f32(c0[0], c0[1], 0, false); h0 = __builtin_amdgcn_cvt_pk_fp8_f32(c0[2], c0[3], h0, true);
                    int h1 = __builtin_amdgcn_cvt_pk_fp8_f32(c1[0], c1[1], 0, false); h1 = __builtin_amdgcn_cvt_pk_fp8_f32(c1[2], c1[3], h1, true);
                    const f32x2 b0 = __builtin_amdgcn_cvt_pk_f32_fp8(h0, false), b1 = __builtin_amdgcn_cvt_pk_f32_fp8(h0, true);
                    const f32x2 b2 = __builtin_amdgcn_cvt_pk_f32_fp8(h1, false), b3 = __builtin_amdgcn_cvt_pk_f32_fp8(h1, true);
                    int l0 = __builtin_amdgcn_cvt_pk_fp8_f32((c0[0] - b0.x) * 16.f, (c0[1] - b0.y) * 16.f, 0, false);
                    l0 = __builtin_amdgcn_cvt_pk_fp8_f32((c0[2] - b1.x) * 16.f, (c0[3] - b1.y) * 16.f, l0, true);
                    int l1 = __builtin_amdgcn_cvt_pk_fp8_f32((c1[0] - b2.x) * 16.f, (c1[1] - b2.y) * 16.f, 0, false);
                    l1 = __builtin_amdgcn_cvt_pk_fp8_f32((c1[2] - b3.x) * 16.f, (c1[3] - b3.y) * 16.f, l1, true);
                    u32x2 hh = {(unsigned)h0, (unsigned)h1}, ll = {(unsigned)l0, (unsigned)l1};
                    *(u32x2*)(xq + (size_t)row * 1024 + col) = hh;
                    *(u32x2*)(xq + 16 * MBy + (size_t)row * 1024 + col) = ll;
                }
                float ss = (v0[0] * v0[0] + v0[1] * v0[1]) + (v0[2] * v0[2] + v0[3] * v0[3]) + (v1[0] * v1[0] + v1[1] * v1[1]) + (v1[2] * v1[2] + v1[3] * v1[3]);
                ss = sum_fq(ss);
                if (fqd == 0) lss[(wc * 256 + rl) * 2 + bj] = ss;
            }
        }
    __syncthreads();
    const int tid = opaque_tid();
    if (tid < 256) {
        const int row = u.pm * 256 + tid;
#pragma unroll
        for (int bj = 0; bj < 2; ++bj)
            gss[(size_t)row * 8 + u.pn * 2 + bj] = (lss[(0 * 256 + tid) * 2 + bj] + lss[(1 * 256 + tid) * 2 + bj]) + (lss[(2 * 256 + tid) * 2 + bj] + lss[(3 * 256 + tid) * 2 + bj]);
    }
    __syncthreads();
}
struct EpiWo {
    static constexpr bool PERM = true, AFTER_DRAIN = true;
    const bf16* hb_in; bf16* hb_out; float* gss; unsigned char* xq;
    __device__ __forceinline__ void khook(int t, f32x4 (&acc)[2][2][4][2], int wr, int fr) const {
        if (t == 4 || t == 8) {
            const float* fac = (const float*)(smem + LDS_AUX) + (t == 4 ? 0 : 256);
#pragma unroll
            for (int ai = 0; ai < 2; ++ai)
#pragma unroll
                for (int m = 0; m < 4; ++m) {
                    const float f = fac[128 * ai + 64 * wr + 16 * m + fr];
#pragma unroll
                    for (int bj = 0; bj < 2; ++bj) { acc[ai][bj][m][0] *= f; acc[ai][bj][m][1] *= f; }
                }
        }
    }
    __device__ __forceinline__ void operator()(const f32x4 (&)[2][2][4][2], const pg8::Unit&, int, int, int, int) const {}
    __device__ __forceinline__ void fused(const f32x4 (&acc)[2][2][4][2], const pg8::Unit& u, int wr, int wc, int fr, int fqd, PG8_LAS unsigned char*, int, int) const {
        residual_fused<false, true>(acc, u, wr, wc, fr, fqd, (const float*)(smem + LDS_AUX) + 512, nullptr, hb_in, hb_out, gss, xq);
    }
};
__device__ __forceinline__ void phase_wo(const Params& P, int L, int hsel, int ss_slot) {
    char* ws = opq(P.ws);
    float* ss_out = (float*)(ws + OFF_SSA) + (size_t)ss_slot * TOK * 8;
    bf16* hb_out = (bf16*)(ws + (hsel ? OFF_HB1 : OFF_HB0));
    const bf16* hb_in = (const bf16*)(ws + (hsel ? OFF_HB0 : OFF_HB1));
    const bf16* Y = (const bf16*)(ws + OFF_Y);
    const bf16* Bt = (const bf16*)(ws + OFF_WO) + (size_t)L * 1024 * LDH;
    const float* ssy = (const float*)(ws + OFF_SSY) + (size_t)L * TOK * 16;
    float* aux = (float*)(smem + LDS_AUX);
    const int tid = opaque_tid();
    pg8::Gemm g{Y, Bt, LDH, LDH, TOK, 1024, 1024};
    pg8::StaticOrder S; S.init(TOK, 1024, gridDim.x, blockIdx.x);
    pg8::Unit u0;
    if (S.next(0, u0) && tid < 256) {
        int row = u0.pm * 256 + tid;
        float4 v0 = *(const float4*)(ssy + (size_t)row * 16), v1 = *(const float4*)(ssy + (size_t)row * 16 + 4), v2 = *(const float4*)(ssy + (size_t)row * 16 + 8);
        float r0 = rsqrtf(((v0.x + v0.y) + (v0.z + v0.w)) * (1.f / 256.f) + EPSF);
        float r1 = rsqrtf(((v1.x + v1.y) + (v1.z + v1.w)) * (1.f / 256.f) + EPSF);
        float r2 = rsqrtf(((v2.x + v2.y) + (v2.z + v2.w)) * (1.f / 512.f) + EPSF);
        aux[tid] = r0 / r1; aux[256 + tid] = r1 / r2; aux[512 + tid] = r2;
    }
    __syncthreads();
    EpiWo E{hb_in, hb_out, ss_out, (unsigned char*)(ws + OFF_XH)};
    pg8::gemm_phase((PG8_LAS unsigned char*)smem, g, S, E, nullptr);
    __syncthreads();
}

struct EpiPq {
    static constexpr bool PERM = true, AFTER_DRAIN = false;
    bf16* O; const float* ssrow;
    __device__ __forceinline__ void khook(int, f32x4 (&)[2][2][4][2], int, int) const {}
    __device__ __forceinline__ void operator()(const f32x4 (&acc)[2][2][4][2], const pg8::Unit& u, int wr, int wc, int fr, int fq) const {
        const int row0 = u.pm * 256 + wr * 64 + fr, col0 = u.pn * 256 + wc * 32 + 8 * fq;
#pragma unroll
        for (int ai = 0; ai < 2; ++ai)
#pragma unroll
            for (int m = 0; m < 4; ++m) {
                const int row = row0 + ai * 128 + m * 16;
                const float rs = row_rs8(ssrow, row);
                bf16* rowp = O + (size_t)row * 1024 + col0;
#pragma unroll
                for (int bj = 0; bj < 2; ++bj) {
                    f32x4 v0 = acc[ai][bj][m][0] * rs, v1 = acc[ai][bj][m][1] * rs;
                    u32x4 wv = {pack2(v0[0], v0[1]), pack2(v0[2], v0[3]), pack2(v1[0], v1[1]), pack2(v1[2], v1[3])};
                    *(u32x4*)(rowp + bj * 128) = wv;
                }
            }
    }
};
__device__ __forceinline__ void phase_pq(const Params& P, int L, int hsel, int ss_slot) {
    char* ws = opq(P.ws);
    const float* ssrow = (const float*)(ws + OFF_SSA) + (size_t)ss_slot * TOK * 8;
    const bf16* hb = (const bf16*)(ws + (hsel ? OFF_HB1 : OFF_HB0));
    const bf16* Bt = (const bf16*)(ws + OFF_WQ) + (size_t)L * 1024 * LDH;
    pg8::Gemm g{hb, Bt, LDH, LDH, TOK, 1024, 1024};
    pg8::StaticOrder S; S.init(TOK, 1024, gridDim.x, blockIdx.x);
    EpiPq E{(bf16*)(ws + OFF_PQ), ssrow};
    pg8::gemm_phase((PG8_LAS unsigned char*)smem, g, S, E, nullptr);
    __syncthreads();
}

__device__ __forceinline__ void cswap(int& a, int& b) { int mx = max(a, b), mn = min(a, b); a = mx; b = mn; }
__device__ __forceinline__ void bitonic_sort16(int (&v)[16]) {
#pragma unroll
    for (int k = 2; k <= 16; k <<= 1)
#pragma unroll
        for (int j = k >> 1; j > 0; j >>= 1)
#pragma unroll
            for (int i = 0; i < 16; ++i) {
                int q = i ^ j;
                if (q > i) {
                    if ((i & k) == 0) cswap(v[i], v[q]); else cswap(v[q], v[i]);
                }
            }
}
__device__ __forceinline__ void merge_top16(int (&Lv)[16], const int (&Rv)[16]) {
#pragma unroll
    for (int i = 0; i < 16; ++i) Lv[i] = max(Lv[i], Rv[15 - i]);
#pragma unroll
    for (int j = 8; j > 0; j >>= 1)
#pragma unroll
        for (int i = 0; i < 16; ++i) {
            int q = i ^ j;
            if (q > i) cswap(Lv[i], Lv[q]);
        }
}
__device__ __forceinline__ int f2key(float v, int low, int mask) {
    int b = __float_as_int(v);
    b ^= (b >> 31) & 0x7fffffff;
    return (b & ~mask) | low;
}
__device__ __forceinline__ float key2f(int k, int mask) {
    int b = k & ~mask;
    b ^= (b >> 31) & 0x7fffffff;
    return __int_as_float(b);
}

__device__ __forceinline__ void phase_topk(const Params& P, int L) {
    char* ws = opq(P.ws);
    const bf16* pq = (const bf16*)(ws + OFF_PQ);
    const bf16* skb = (const bf16*)(ws + OFF_SKB) + (size_t)L * 16 * 128 * 64;
    unsigned short* ids = (unsigned short*)(ws + OFF_IDS);
    float* gates = (float*)(ws + OFF_GATE);
    const int tid = opaque_tid(), w = tid >> 6, l = tid & 63, r = l & 31, hh = l >> 5;
    unsigned char* lidx = (unsigned char*)(smem + w * 1024 + r * 32);
    for (int task = blockIdx.x * NW + w; task < (TOK / 32) * 8; task += gridDim.x * NW) {
        const int t0 = (task >> 3) * 32, h = task & 7;
        int F[2][16];
#pragma unroll
        for (int p = 0; p < 2; ++p) {
            const int hp = h * 2 + p;
            f32x16 acc[4];
            const f32x16 z16 = {0.f, 0.f, 0.f, 0.f, 0.f, 0.f, 0.f, 0.f, 0.f, 0.f, 0.f, 0.f, 0.f, 0.f, 0.f, 0.f};
#pragma unroll
            for (int kt = 0; kt < 4; ++kt) acc[kt] = z16;
#pragma unroll
            for (int s4 = 0; s4 < 4; ++s4) {
                bf16x8 bfr = *(const bf16x8*)(pq + (size_t)(t0 + r) * 1024 + hp * 64 + 16 * s4 + 8 * hh);
#pragma unroll
                for (int kt = 0; kt < 4; ++kt) {
                    bf16x8 af = *(const bf16x8*)(skb + ((size_t)hp * 128 + 32 * kt + r) * 64 + 16 * s4 + 8 * hh);
                    acc[kt] = __builtin_amdgcn_mfma_f32_32x32x16_bf16(af, bfr, acc[kt], 0, 0, 0);
                }
            }
            int K0[16], K1[16], K2[16], K3[16];
#pragma unroll
            for (int rr = 0; rr < 16; ++rr) {
                const int nb = (rr & 3) + 8 * (rr >> 2) + 4 * hh;
                K0[rr] = f2key(acc[0][rr], 127 - nb, 127);
                K1[rr] = f2key(acc[1][rr], 127 - (32 + nb), 127);
                K2[rr] = f2key(acc[2][rr], 127 - (64 + nb), 127);
                K3[rr] = f2key(acc[3][rr], 127 - (96 + nb), 127);
            }
            bitonic_sort16(K0); bitonic_sort16(K1); bitonic_sort16(K2); bitonic_sort16(K3);
            merge_top16(K0, K1);
            merge_top16(K2, K3);
            merge_top16(K0, K2);
#pragma unroll
            for (int i = 0; i < 16; ++i) K1[i] = partner32(K0[i], hh);
            merge_top16(K0, K1);
#pragma unroll
            for (int i = 0; i < 16; ++i) F[p][i] = K0[i];
        }
        if (hh == 0) {
#pragma unroll
            for (int q = 0; q < 4; ++q) {
                unsigned w1 = 0, w2 = 0;
#pragma unroll
                for (int e = 0; e < 4; ++e) {
                    w1 |= (unsigned)(127 - (F[0][4 * q + e] & 127)) << (8 * e);
                    w2 |= (unsigned)(127 - (F[1][4 * q + e] & 127)) << (8 * e);
                }
                ((unsigned*)lidx)[q] = w1;
                ((unsigned*)lidx)[4 + q] = w2;
            }
        }
        {
            float s1[16], s2[16];
#pragma unroll
            for (int i = 0; i < 16; ++i) { s1[i] = key2f(F[0][i], 127); s2[i] = key2f(F[1][i], 127); }
            int Lc[16], X[16];
#pragma unroll
            for (int b2 = 0; b2 < 16; ++b2) Lc[b2] = f2key(s1[0] + s2[b2], 255 - b2, 255);
#pragma unroll
            for (int a2 = 1; a2 < 16; ++a2) X[a2 - 1] = f2key(s1[a2] + s2[0], 255 - a2 * 16, 255);
            X[15] = INT_MIN;
            merge_top16(Lc, X);
            X[0] = f2key(s1[1] + s2[1], 255 - 17, 255); X[1] = f2key(s1[1] + s2[2], 255 - 18, 255); X[2] = f2key(s1[1] + s2[3], 255 - 19, 255);
            X[3] = f2key(s1[1] + s2[4], 255 - 20, 255); X[4] = f2key(s1[1] + s2[5], 255 - 21, 255); X[5] = f2key(s1[1] + s2[6], 255 - 22, 255);
            X[6] = f2key(s1[1] + s2[7], 255 - 23, 255);
            X[7] = f2key(s1[2] + s2[1], 255 - 33, 255); X[8] = f2key(s1[2] + s2[2], 255 - 34, 255); X[9] = f2key(s1[2] + s2[3], 255 - 35, 255);
            X[10] = f2key(s1[2] + s2[4], 255 - 36, 255);
            X[11] = f2key(s1[3] + s2[1], 255 - 49, 255); X[12] = f2key(s1[3] + s2[2], 255 - 50, 255); X[13] = f2key(s1[3] + s2[3], 255 - 51, 255);
            X[14] = f2key(s1[4] + s2[1], 255 - 65, 255); X[15] = f2key(s1[4] + s2[2], 255 - 66, 255);
            bitonic_sort16(X);
            merge_top16(Lc, X);
            X[0] = f2key(s1[5] + s2[1], 255 - 81, 255);
            X[1] = f2key(s1[6] + s2[1], 255 - 97, 255);
            X[2] = f2key(s1[7] + s2[1], 255 - 113, 255);
#pragma unroll
            for (int i = 3; i < 16; ++i) X[i] = INT_MIN;
            merge_top16(Lc, X);
            if (hh == 0) {
                float mx = key2f(Lc[0], 255);
                float ev[16], sum = 0.f;
#pragma unroll
                for (int k = 0; k < 16; ++k) { ev[k] = __expf(key2f(Lc[k], 255) - mx); sum += ev[k]; }
                float inv = 1.f / sum;
                size_t ob = (size_t)(t0 + r) * 128 + h * 16;
                unsigned idw[8];
#pragma unroll
                for (int k = 0; k < 16; ++k) {
                    int cidx = 255 - (Lc[k] & 255);
                    int i1 = lidx[cidx >> 4], i2 = lidx[16 + (cidx & 15)];
                    unsigned idv = (unsigned)(i1 * 128 + i2);
                    if (k & 1) idw[k >> 1] |= idv << 16; else idw[k >> 1] = idv;
                }
                u32x4 o0 = {idw[0], idw[1], idw[2], idw[3]}, o1 = {idw[4], idw[5], idw[6], idw[7]};
                *(u32x4*)(ids + ob) = o0;
                *(u32x4*)(ids + ob + 8) = o1;
#pragma unroll
                for (int q = 0; q < 4; ++q) {
                    f32x4 g4 = {ev[4 * q] * inv, ev[4 * q + 1] * inv, ev[4 * q + 2] * inv, ev[4 * q + 3] * inv};
                    *(f32x4*)(gates + ob + 4 * q) = g4;
                }
            }
        }
    }
}

__device__ __forceinline__ float gelu_exact(float x) { return 0.5f * x * (1.f + erff(x * 0.70710678118654752f)); }

__device__ __forceinline__ void dec16(const u32x4& v, float (&f)[16]) {
    f32x2 t;
    t = __builtin_amdgcn_cvt_pk_f32_fp8((int)v.x, false); f[0] = t.x; f[1] = t.y;
    t = __builtin_amdgcn_cvt_pk_f32_fp8((int)v.x, true);  f[2] = t.x; f[3] = t.y;
    t = __builtin_amdgcn_cvt_pk_f32_fp8((int)v.y, false); f[4] = t.x; f[5] = t.y;
    t = __builtin_amdgcn_cvt_pk_f32_fp8((int)v.y, true);  f[6] = t.x; f[7] = t.y;
    t = __builtin_amdgcn_cvt_pk_f32_fp8((int)v.z, false); f[8] = t.x; f[9] = t.y;
    t = __builtin_amdgcn_cvt_pk_f32_fp8((int)v.z, true);  f[10] = t.x; f[11] = t.y;
    t = __builtin_amdgcn_cvt_pk_f32_fp8((int)v.w, false); f[12] = t.x; f[13] = t.y;
    t = __builtin_amdgcn_cvt_pk_f32_fp8((int)v.w, true);  f[14] = t.x; f[15] = t.y;
}

__device__ __forceinline__ void dec32(const u32x4& v, f32x2 (&f)[16]) {
    f[0] = __builtin_amdgcn_cvt_scalef32_pk_f32_fp4(v.x, 1.0f, 0); f[1] = __builtin_amdgcn_cvt_scalef32_pk_f32_fp4(v.x, 1.0f, 1);
    f[2] = __builtin_amdgcn_cvt_scalef32_pk_f32_fp4(v.x, 1.0f, 2); f[3] = __builtin_amdgcn_cvt_scalef32_pk_f32_fp4(v.x, 1.0f, 3);
    f[4] = __builtin_amdgcn_cvt_scalef32_pk_f32_fp4(v.y, 1.0f, 0); f[5] = __builtin_amdgcn_cvt_scalef32_pk_f32_fp4(v.y, 1.0f, 1);
    f[6] = __builtin_amdgcn_cvt_scalef32_pk_f32_fp4(v.y, 1.0f, 2); f[7] = __builtin_amdgcn_cvt_scalef32_pk_f32_fp4(v.y, 1.0f, 3);
    f[8] = __builtin_amdgcn_cvt_scalef32_pk_f32_fp4(v.z, 1.0f, 0); f[9] = __builtin_amdgcn_cvt_scalef32_pk_f32_fp4(v.z, 1.0f, 1);
    f[10] = __builtin_amdgcn_cvt_scalef32_pk_f32_fp4(v.z, 1.0f, 2); f[11] = __builtin_amdgcn_cvt_scalef32_pk_f32_fp4(v.z, 1.0f, 3);
    f[12] = __builtin_amdgcn_cvt_scalef32_pk_f32_fp4(v.w, 1.0f, 0); f[13] = __builtin_amdgcn_cvt_scalef32_pk_f32_fp4(v.w, 1.0f, 1);
    f[14] = __builtin_amdgcn_cvt_scalef32_pk_f32_fp4(v.w, 1.0f, 2); f[15] = __builtin_amdgcn_cvt_scalef32_pk_f32_fp4(v.w, 1.0f, 3);
}

typedef _Float16 f16x2 __attribute__((ext_vector_type(2)));
__device__ __forceinline__ void dec8_f16(unsigned x, f16x2 (&wv)[4]) {
    const unsigned lo = x & 0x07070707u, hi = (x >> 4) & 0x07070707u;
    const unsigned Lb = __builtin_amdgcn_perm(0x46444240u, 0x3E3C3800u, lo) | ((x & 0x08080808u) << 4);
    const unsigned Hb = __builtin_amdgcn_perm(0x46444240u, 0x3E3C3800u, hi) | (x & 0x80808080u);
    wv[0] = __builtin_bit_cast(f16x2, __builtin_amdgcn_perm(Hb, Lb, 0x040c000cu));
    wv[1] = __builtin_bit_cast(f16x2, __builtin_amdgcn_perm(Hb, Lb, 0x050c010cu));
    wv[2] = __builtin_bit_cast(f16x2, __builtin_amdgcn_perm(Hb, Lb, 0x060c020cu));
    wv[3] = __builtin_bit_cast(f16x2, __builtin_amdgcn_perm(Hb, Lb, 0x070c030cu));
}

typedef _Float16 f16x2 __attribute__((ext_vector_type(2)));
__device__ __forceinline__ void dec32h(const u32x4& v, f16x2 (&f)[16]) {
    f[0] = __builtin_amdgcn_cvt_scalef32_pk_f16_fp4(v.x, 1.0f, 0); f[1] = __builtin_amdgcn_cvt_scalef32_pk_f16_fp4(v.x, 1.0f, 1);
    f[2] = __builtin_amdgcn_cvt_scalef32_pk_f16_fp4(v.x, 1.0f, 2); f[3] = __builtin_amdgcn_cvt_scalef32_pk_f16_fp4(v.x, 1.0f, 3);
    f[4] = __builtin_amdgcn_cvt_scalef32_pk_f16_fp4(v.y, 1.0f, 0); f[5] = __builtin_amdgcn_cvt_scalef32_pk_f16_fp4(v.y, 1.0f, 1);
    f[6] = __builtin_amdgcn_cvt_scalef32_pk_f16_fp4(v.y, 1.0f, 2); f[7] = __builtin_amdgcn_cvt_scalef32_pk_f16_fp4(v.y, 1.0f, 3);
    f[8] = __builtin_amdgcn_cvt_scalef32_pk_f16_fp4(v.z, 1.0f, 0); f[9] = __builtin_amdgcn_cvt_scalef32_pk_f16_fp4(v.z, 1.0f, 1);
    f[10] = __builtin_amdgcn_cvt_scalef32_pk_f16_fp4(v.z, 1.0f, 2); f[11] = __builtin_amdgcn_cvt_scalef32_pk_f16_fp4(v.z, 1.0f, 3);
    f[12] = __builtin_amdgcn_cvt_scalef32_pk_f16_fp4(v.w, 1.0f, 0); f[13] = __builtin_amdgcn_cvt_scalef32_pk_f16_fp4(v.w, 1.0f, 1);
    f[14] = __builtin_amdgcn_cvt_scalef32_pk_f16_fp4(v.w, 1.0f, 2); f[15] = __builtin_amdgcn_cvt_scalef32_pk_f16_fp4(v.w, 1.0f, 3);
}

__device__ __forceinline__ int idof16(const u32x4 (&q)[2], int i) {
    unsigned wv = (i >> 1) == 0 ? q[0].x : (i >> 1) == 1 ? q[0].y : (i >> 1) == 2 ? q[0].z : (i >> 1) == 3 ? q[0].w
                : (i >> 1) == 4 ? q[1].x : (i >> 1) == 5 ? q[1].y : (i >> 1) == 6 ? q[1].z : q[1].w;
    return (i & 1) ? (int)(wv >> 16) : (int)(wv & 0xffffu);
}
typedef int i32x8 __attribute__((ext_vector_type(8)));
#define GU_WAIT_V(n) asm volatile("s_waitcnt vmcnt(" #n ")" ::: "memory")
#define GU_WAIT_L0() asm volatile("s_waitcnt lgkmcnt(0)" ::: "memory")
__device__ __forceinline__ void phase_gather_u(const Params& P, int L) {
    char* ws = opq(P.ws);
    const unsigned char* U4 = (const unsigned char*)(ws + OFF_UB) + (size_t)L * NEXP * 512;
    float* part = (float*)(ws + OFF_PART);
    const unsigned short* ids = (const unsigned short*)(ws + OFF_IDS);
    const int tid = opaque_tid(), w = tid >> 6, l = tid & 63, i = l & 15, g4 = l >> 4, rr = l >> 3, dc = (l & 7) ^ rr;
    const int sl = blockIdx.x & 3, par = (blockIdx.x >> 2) & 1, rk = blockIdx.x >> 3, nb = gridDim.x >> 3;
    if (rk >= nb) return;
    PG8_LAS unsigned char* wl = (PG8_LAS unsigned char*)smem + w * 16384;
    const unsigned char* ubase = U4 + (size_t)sl * NEXP * 128 + dc * 16;
    const unsigned char* xbase = (const unsigned char*)(ws + OFF_XH) + (i == 1 ? 16 * MBy : 0) + 256 * sl + 16 * g4;
    const int scb = (i == 1) ? 123 : 127;
    const unsigned a0 = 1024u * (i >> 3) + 128u * (i & 7) + 16u * (g4 ^ (i & 7)), a1 = a0 ^ 64u;
    const int stride = nb * NW;
    int ti = rk * NW + w;
    if (ti >= TOK / 2) return;
    u32x4 idA[2], idB[2];
    u32x4 xA[4], xB[4];
    auto load_ids = [&](int tt, u32x4 (&idq)[2]) {
        const unsigned short* ip = ids + (size_t)tt * 128 + 16 * rr;
        asm volatile("global_load_dwordx4 %0, %2, off\n\tglobal_load_dwordx4 %1, %2, off offset:16" : "=&v"(idq[0]), "=&v"(idq[1]) : "v"(ip));
    };
    auto load_x = [&](int tt, u32x4 (&xx)[4]) {
        const unsigned char* p = xbase + (size_t)tt * 1024;
        asm volatile("global_load_dwordx4 %0, %4, off\n\tglobal_load_dwordx4 %1, %4, off offset:64\n\t"
                     "global_load_dwordx4 %2, %4, off offset:128\n\tglobal_load_dwordx4 %3, %4, off offset:192"
                     : "=&v"(xx[0]), "=&v"(xx[1]), "=&v"(xx[2]), "=&v"(xx[3]) : "v"(p));
    };
    auto pin = [&](u32x4 (&idq)[2], u32x4 (&xx)[4]) {
        asm volatile("" : "+v"(idq[0]), "+v"(idq[1]), "+v"(xx[0]), "+v"(xx[1]), "+v"(xx[2]), "+v"(xx[3]));
    };
    auto dma_half = [&](const u32x4 (&idq)[2], int h) {
#pragma unroll
        for (int jj = 0; jj < 8; ++jj) {
            const int j = 8 * h + jj;
            __builtin_amdgcn_global_load_lds((const unsigned*)(ubase + (size_t)idof16(idq, j) * 128), (PG8_LAS unsigned*)(wl + 1024 * j), 16, 0, 0);
        }
    };
    const unsigned la0 = (unsigned)(size_t)wl + a0, la1 = (unsigned)(size_t)wl + a1;
    auto mma_half = [&](f32x4 (&acc)[8], const u32x4 (&xc)[4], int h) {
        u32x4 av[8];
        if (h == 0)
            asm volatile("ds_read_b128 %0, %8\n\tds_read_b128 %1, %9\n\tds_read_b128 %2, %8 offset:2048\n\tds_read_b128 %3, %9 offset:2048\n\t"
                         "ds_read_b128 %4, %8 offset:4096\n\tds_read_b128 %5, %9 offset:4096\n\tds_read_b128 %6, %8 offset:6144\n\tds_read_b128 %7, %9 offset:6144\n\t"
                         "s_waitcnt lgkmcnt(0)"
                         : "=&v"(av[0]), "=&v"(av[1]), "=&v"(av[2]), "=&v"(av[3]), "=&v"(av[4]), "=&v"(av[5]), "=&v"(av[6]), "=&v"(av[7]) : "v"(la0), "v"(la1));
        else
            asm volatile("ds_read_b128 %0, %8 offset:8192\n\tds_read_b128 %1, %9 offset:8192\n\tds_read_b128 %2, %8 offset:10240\n\tds_read_b128 %3, %9 offset:10240\n\t"
                         "ds_read_b128 %4, %8 offset:12288\n\tds_read_b128 %5, %9 offset:12288\n\tds_read_b128 %6, %8 offset:14336\n\tds_read_b128 %7, %9 offset:14336\n\t"
                         "s_waitcnt lgkmcnt(0)"
                         : "=&v"(av[0]), "=&v"(av[1]), "=&v"(av[2]), "=&v"(av[3]), "=&v"(av[4]), "=&v"(av[5]), "=&v"(av[6]), "=&v"(av[7]) : "v"(la0), "v"(la1));
#pragma unroll
        for (int qq = 0; qq < 4; ++qq) {
#pragma unroll
            for (int hf = 0; hf < 2; ++hf) {
                const u32x4 a = av[2 * qq + hf];
                const i32x8 A = {(int)a.x, (int)a.y, (int)a.z, (int)a.w, 0, 0, 0, 0};
                const u32x4 b0 = xc[2 * hf], b1 = xc[2 * hf + 1];
                const i32x8 B = {(int)b0.x, (int)b0.y, (int)b0.z, (int)b0.w, (int)b1.x, (int)b1.y, (int)b1.z, (int)b1.w};
                f32x4 c = {0.f, 0.f, 0.f, 0.f};
                if (hf) c = acc[4 * h + qq];
                acc[4 * h + qq] = __builtin_amdgcn_mfma_scale_f32_16x16x128_f8f6f4(A, B, c, 4, 0, 0, 127, 0, scb);
            }
        }
    };
    auto step = [&](int tcur, int tnext, int tnext2, u32x4 (&idn)[2], u32x4 (&idl)[2], u32x4 (&xc)[4], u32x4 (&xn)[4]) {
        f32x4 acc[8];
        __builtin_amdgcn_sched_barrier(0);
        GU_WAIT_V(8);
        pin(idn, xc);
        __builtin_amdgcn_sched_barrier(0);
        mma_half(acc, xc, 0);
        __builtin_amdgcn_sched_barrier(0);
        dma_half(idn, 0);
        __builtin_amdgcn_sched_barrier(0);
        load_ids(tnext2, idl);
        load_x(tnext, xn);
        __builtin_amdgcn_sched_barrier(0);
        GU_WAIT_V(14);
        __builtin_amdgcn_sched_barrier(0);
        mma_half(acc, xc, 1);
        __builtin_amdgcn_sched_barrier(0);
#pragma unroll
        for (int q = 0; q < 8; ++q)
#pragma unroll
            for (int r = 0; r < 4; ++r) acc[q][r] = dpp_add<0xB1>(acc[q][r]);
        if (i == 0) {
            float* o = part + ((size_t)sl * TOK + tcur) * 128 + 32 * g4;
#pragma unroll
            for (int r = 0; r < 4; ++r)
#pragma unroll
                for (int gh = 0; gh < 2; ++gh) {
                    f32x4 ov = {acc[4 * gh][r], acc[4 * gh + 1][r], acc[4 * gh + 2][r], acc[4 * gh + 3][r]};
                    asm volatile("global_store_dwordx4 %0, %1, off offset:%2" :: "v"(o), "v"(ov), "n"(32 * r + 16 * gh) : "memory");
                }
        }
        __builtin_amdgcn_sched_barrier(0);
        dma_half(idn, 1);
        __builtin_amdgcn_sched_barrier(0);
    };
    auto tok = [&](int tidx, int fb) { return 2 * (tidx < TOK / 2 ? tidx : fb) + par; };
    load_ids(tok(ti, ti), idA);
    __builtin_amdgcn_sched_barrier(0);
    GU_WAIT_V(0);
    asm volatile("" : "+v"(idA[0]), "+v"(idA[1]));
    __builtin_amdgcn_sched_barrier(0);
    dma_half(idA, 0);
    __builtin_amdgcn_sched_barrier(0);
    load_ids(tok(ti + stride, ti), idB);
    load_x(tok(ti, ti), xA);
    __builtin_amdgcn_sched_barrier(0);
    dma_half(idA, 1);
    __builtin_amdgcn_sched_barrier(0);
    for (;;) {
        int tn = ti + stride, tn2 = ti + 2 * stride;
        step(tok(ti, ti), tok(tn, ti), tok(tn2, ti), idB, idA, xA, xB);
        if (tn >= TOK / 2) break;
        ti = tn; tn = ti + stride; tn2 = ti + 2 * stride;
        step(tok(ti, ti), tok(tn, ti), tok(tn2, ti), idA, idB, xB, xA);
        if (tn >= TOK / 2) break;
        ti = tn;
    }
    GU_WAIT_V(0);
    asm volatile("" :: "v"(idA[0]), "v"(idA[1]), "v"(idB[0]), "v"(idB[1]), "v"(xA[0]), "v"(xA[1]), "v"(xA[2]), "v"(xA[3]), "v"(xB[0]), "v"(xB[1]), "v"(xB[2]), "v"(xB[3]));
}

__device__ __forceinline__ void phase_gather_act(const Params& P, int L, int ss_slot, int fake = 0) {
    char* ws = opq(P.ws);
    const float* ss_ffn = (const float*)(ws + OFF_SSA) + (size_t)ss_slot * TOK * 8;
    const float* part = (const float*)(ws + OFF_PART);
    const unsigned short* ids = (const unsigned short*)(ws + OFF_IDS);
    const float* gates = (const float*)(ws + OFF_GATE);
    const float* uinv = (const float*)(ws + OFF_TSC) + L * NEXP;
    const float* vinv = (const float*)(ws + OFF_TSC) + (2 + L) * NEXP;
    const int tid = opaque_tid(), w = tid >> 6, l = tid & 63;
    const int stride = gridDim.x * NW;
    for (int t0 = blockIdx.x * NW + w; t0 < TOK; t0 += 4 * stride) {
        f32x2 pa[4][4], gt[4];
        unsigned idw[4];
        f32x4 s0[4], s1[4];
#pragma unroll
        for (int q = 0; q < 4; ++q) {
            const int t = (t0 + q * stride < TOK) ? (t0 + q * stride) : t0;
#pragma unroll
            for (int j = 0; j < 4; ++j) { pa[q][j].x = part[((size_t)j * TOK + t) * 128 + l]; pa[q][j].y = part[((size_t)j * TOK + t) * 128 + 64 + l]; }
            idw[q] = *(const unsigned*)(ids + (size_t)t * 128 + 2 * l);
            gt[q] = *(const f32x2*)(gates + (size_t)t * 128 + 2 * l);
            s0[q] = *(const f32x4*)(ss_ffn + (size_t)t * 8); s1[q] = *(const f32x4*)(ss_ffn + (size_t)t * 8 + 4);
        }
        float ui[4][2], vi[4][2];
#pragma unroll
        for (int q = 0; q < 4; ++q) {
            const int i0 = (int)(idw[q] & 0xffffu), i1 = (int)(idw[q] >> 16);
            ui[q][0] = uinv[i0]; ui[q][1] = uinv[i1]; vi[q][0] = vinv[i0]; vi[q][1] = vinv[i1];
        }
#pragma unroll
        for (int q = 0; q < 4; ++q) {
            const int t = t0 + q * stride;
            if (t < TOK) {
                const float ssum = ((s0[q].x + s0[q].y) + (s0[q].z + s0[q].w)) + ((s1[q].x + s1[q].y) + (s1[q].z + s1[q].w));
                const float rs = rsqrtf(ssum * (1.f / 1024.f) + EPSF);
                f32x2 sa = (pa[q][0] + pa[q][1]) + (pa[q][2] + pa[q][3]);
                f32x2 o;
                o.x = gt[q].x * gelu_exact(sa.x * rs * ui[q][0]) * vi[q][0];
                o.y = gt[q].y * gelu_exact(sa.y * rs * ui[q][1]) * vi[q][1];
                float am = fmaxf(fabsf(o.x), fabsf(o.y));
#pragma unroll
                for (int sh = 32; sh > 0; sh >>= 1) am = fmaxf(am, __shfl_xor(am, sh));
                int ex = (int)((__builtin_bit_cast(unsigned, am) >> 23) & 0xffu) - 127;
                int e = 7 - ex; e = e > 100 ? 100 : (e < -100 ? -100 : e);
                if (!(am > 0.f)) e = 0;
                const float sc2 = __builtin_bit_cast(float, (unsigned)(127 + e) << 23);
                const float s0 = __builtin_amdgcn_fmed3f(o.x * sc2, -448.f, 448.f), s1 = __builtin_amdgcn_fmed3f(o.y * sc2, -448.f, 448.f);
                const int h8 = __builtin_amdgcn_cvt_pk_fp8_f32(s0, s1, 0, false);
                const f32x2 hb2 = __builtin_amdgcn_cvt_pk_f32_fp8(h8, false);
                const int l8 = __builtin_amdgcn_cvt_pk_fp8_f32((s0 - hb2.x) * 16.f, (s1 - hb2.y) * 16.f, 0, false);
                unsigned char* a8 = (unsigned char*)(ws + (fake ? OFF_PART : OFF_A8)) + (size_t)t * 128 + 16 * (l & 7) + (l >> 3);
                a8[0] = (unsigned char)(h8 & 0xff); a8[8] = (unsigned char)((h8 >> 8) & 0xff);
                a8[2 * MBy] = (unsigned char)(l8 & 0xff); a8[2 * MBy + 8] = (unsigned char)((l8 >> 8) & 0xff);
                if (l == 0) ((int*)(ws + (fake ? OFF_PART : OFF_A8) + 4 * MBy))[t] = e;
            }
        }
    }
}

__device__ __forceinline__ void phase_gather_v(const Params& P, int L, int hsel, int ss_slot, int fake = 0) {
    char* ws = opq(P.ws);
    float* ss_ple = fake ? (float*)(ws + OFF_FQ) : (float*)(ws + OFF_SSA) + (size_t)ss_slot * TOK * 8;
    bf16* hb_out = fake ? (bf16*)(ws + OFF_PART) : (bf16*)(ws + (hsel ? OFF_HB1 : OFF_HB0));
    const bf16* hbin = (const bf16*)(ws + (hsel ? OFF_HB0 : OFF_HB1));
    const unsigned char* V4 = (const unsigned char*)(ws + OFF_VB) + (size_t)L * NEXP * 512;
    const unsigned short* ids = (const unsigned short*)(ws + OFF_IDS);
    const int tid = opaque_tid(), w = tid >> 6, l = tid & 63, i = l & 15, g4 = l >> 4, rr = l >> 3;
    const int sl = blockIdx.x & 3, par = (blockIdx.x >> 2) & 1, rk = blockIdx.x >> 3, nb = gridDim.x >> 3;
    if (rk >= nb) return;
    PG8_LAS unsigned char* wl = (PG8_LAS unsigned char*)smem + w * 16384;
    PG8_LAS unsigned char* wo = (PG8_LAS unsigned char*)smem + 8 * 16384 + w * 1024;
    const int dc0 = (l & 7) ^ (rr >> 1);
    const unsigned char* vbase0 = V4 + (size_t)sl * NEXP * 128 + dc0 * 16;
    const unsigned char* vbase1 = V4 + (size_t)sl * NEXP * 128 + (dc0 ^ 4) * 16;
    const unsigned char* abase = (const unsigned char*)(ws + OFF_A8) + ((i & 3) == 1 ? 2 * MBy : 0) + 16 * g4;
    const int* ebase = (const int*)(ws + OFF_A8 + 4 * MBy);
    const unsigned kb = 16u * (unsigned)((i >> 1) ^ (4 * (g4 & 1)));
    const unsigned rbase = (unsigned)(size_t)wl + 128u * (unsigned)(32 * g4 + i);
    const unsigned wob = (unsigned)(size_t)wo;
    const int stride = nb * NW;
    int ti = rk * NW + w;
    if (ti >= TOK / 2) return;
    u32x4 idA[2], idB[2];
    u32x4 aA[2], aB[2];
    int eA, eB;
    u32x2 hA, hB;
    auto load_ids = [&](int tt, u32x4 (&idq)[2]) {
        const unsigned short* ip = ids + (size_t)tt * 128 + 16 * rr;
        asm volatile("global_load_dwordx4 %0, %2, off\n\tglobal_load_dwordx4 %1, %2, off offset:16" : "=&v"(idq[0]), "=&v"(idq[1]) : "v"(ip));
    };
    auto load_tok = [&](int tt, u32x4 (&ax)[2], int& ex, u32x2& hx) {
        const unsigned char* ap = abase + (size_t)tt * 128;
        const int* ep = ebase + tt;
        const bf16* hp = hbin + (size_t)tt * LDH + 256 * sl + 4 * l;
        asm volatile("global_load_dwordx4 %0, %4, off\n\tglobal_load_dwordx4 %1, %4, off offset:64\n\tglobal_load_dword %2, %5, off\n\tglobal_load_dwordx2 %3, %6, off"
                     : "=&v"(ax[0]), "=&v"(ax[1]), "=&v"(ex), "=&v"(hx) : "v"(ap), "v"(ep), "v"(hp));
    };
    auto dma_all = [&](const u32x4 (&idq)[2]) {
#pragma unroll
        for (int j = 0; j < 16; ++j) {
            const unsigned char* vb = (((j ^ (j >> 2)) & 1) ? vbase1 : vbase0);
            __builtin_amdgcn_global_load_lds((const unsigned*)(vb + (size_t)idof16(idq, j) * 128), (PG8_LAS unsigned*)(wl + 1024 * j), 16, 0, 0);
        }
    };
    u32x2 pend_h = {0u, 0u}; float pend_ss = 0.f; int pend_t = -1;
    auto step = [&](int tcur, int tnext, int tnext2, u32x4 (&idn)[2], u32x4 (&idl)[2], u32x4 (&ac)[2], int& ec, u32x2& hc, u32x4 (&an)[2], int& en, u32x2& hn) {
        __builtin_amdgcn_sched_barrier(0);
        GU_WAIT_V(0);
        asm volatile("" : "+v"(idn[0]), "+v"(idn[1]), "+v"(ac[0]), "+v"(ac[1]), "+v"(ec), "+v"(hc));
        __builtin_amdgcn_sched_barrier(0);
        u32x2 bq[16][2];
#pragma unroll
        for (int c = 0; c < 8; ++c) {
            const unsigned ad = rbase + ((16u * c) ^ kb);
            asm volatile("ds_read_b64_tr_b4 %0, %4\n\tds_read_b64_tr_b4 %1, %4 offset:2048\n\tds_read_b64_tr_b4 %2, %4 offset:8\n\tds_read_b64_tr_b4 %3, %4 offset:2056"
                         : "=&v"(bq[2 * c][0]), "=&v"(bq[2 * c][1]), "=&v"(bq[2 * c + 1][0]), "=&v"(bq[2 * c + 1][1]) : "v"(ad));
        }
        asm volatile("s_waitcnt lgkmcnt(0)" ::: "memory");
#pragma unroll
        for (int c = 0; c < 16; ++c) asm volatile("" : "+v"(bq[c][0]), "+v"(bq[c][1]));
        __builtin_amdgcn_sched_barrier(0);
        if (pend_t >= 0) {
            bf16* op = hb_out + (size_t)pend_t * LDH + 256 * sl + 4 * l;
            asm volatile("global_store_dwordx2 %0, %1, off" :: "v"(op), "v"(pend_h) : "memory");
            if (l == 0) {
                float* sp = ss_ple + (size_t)pend_t * 8 + sl;
                const float zf = 0.f;
                asm volatile("global_store_dword %0, %1, off\n\tglobal_store_dword %0, %2, off offset:16" :: "v"(sp), "v"(pend_ss), "v"(zf) : "memory");
            }
        }
        __builtin_amdgcn_sched_barrier(0);
        dma_all(idn);
        __builtin_amdgcn_sched_barrier(0);
        load_ids(tnext2, idl);
        load_tok(tnext, an, en, hn);
        __builtin_amdgcn_sched_barrier(0);
        const int sca = 127 - ec - (((i & 3) == 1) ? 4 : 0);
        const i32x8 A = {(int)ac[0].x, (int)ac[0].y, (int)ac[0].z, (int)ac[0].w, (int)ac[1].x, (int)ac[1].y, (int)ac[1].z, (int)ac[1].w};
        f32x4 acc[16];
#pragma unroll
        for (int cb = 0; cb < 16; ++cb) {
            const i32x8 B = {(int)bq[cb][0].x, (int)bq[cb][0].y, (int)bq[cb][1].x, (int)bq[cb][1].y, 0, 0, 0, 0};
            const f32x4 z = {0.f, 0.f, 0.f, 0.f};
            acc[cb] = __builtin_amdgcn_mfma_scale_f32_16x16x128_f8f6f4(A, B, z, 0, 4, 0, sca, 0, 127);
        }
#pragma unroll
        for (int q = 0; q < 4; ++q) {
            float v = 0.f;
#pragma unroll
            for (int g = 0; g < 4; ++g) { const float t2 = acc[4 * g + q][0] + acc[4 * g + q][1]; v = (g4 == g) ? t2 : v; }
            const unsigned wa = wob + 4u * (unsigned)(64 * g4 + 16 * q + i);
            asm volatile("ds_write_b32 %0, %1" :: "v"(wa), "v"(v) : "memory");
        }
        f32x4 ov;
        {
            const unsigned ra = wob + 16u * (unsigned)l;
            asm volatile("s_waitcnt lgkmcnt(0)\n\tds_read_b128 %0, %1\n\ts_waitcnt lgkmcnt(0)" : "=&v"(ov) : "v"(ra) : "memory");
        }
        f32x4 hv = {bflo(hc.x) + ov[0], bfhi(hc.x) + ov[1], bflo(hc.y) + ov[2], bfhi(hc.y) + ov[3]};
        pend_h.x = pack2(hv.x, hv.y); pend_h.y = pack2(hv.z, hv.w);
        float ssq = hv.x * hv.x + hv.y * hv.y + hv.z * hv.z + hv.w * hv.w;
        pend_ss = wave_sum(ssq);
        pend_t = tcur;
        __builtin_amdgcn_sched_barrier(0);
    };
    auto tok = [&](int tidx, int fb) { return 2 * (tidx < TOK / 2 ? tidx : fb) + par; };
    load_ids(tok(ti, ti), idA);
    __builtin_amdgcn_sched_barrier(0);
    GU_WAIT_V(0);
    asm volatile("" : "+v"(idA[0]), "+v"(idA[1]));
    __builtin_amdgcn_sched_barrier(0);
    dma_all(idA);
    __builtin_amdgcn_sched_barrier(0);
    load_ids(tok(ti + stride, ti), idB);
    load_tok(tok(ti, ti), aA, eA, hA);
    __builtin_amdgcn_sched_barrier(0);
    for (;;) {
        int tn = ti + stride, tn2 = ti + 2 * stride;
        step(tok(ti, ti), tok(tn, ti), tok(tn2, ti), idB, idA, aA, eA, hA, aB, eB, hB);
        if (tn >= TOK / 2) break;
        ti = tn; tn = ti + stride; tn2 = ti + 2 * stride;
        step(tok(ti, ti), tok(tn, ti), tok(tn2, ti), idA, idB, aB, eB, hB, aA, eA, hA);
        if (tn >= TOK / 2) break;
        ti = tn;
    }
    asm volatile("s_waitcnt vmcnt(0)" : "+v"(pend_t), "+v"(pend_h), "+v"(pend_ss) :: "memory");
    asm volatile("" :: "v"(idA[0]), "v"(idA[1]), "v"(idB[0]), "v"(idB[1]), "v"(aA[0]), "v"(aA[1]), "v"(aB[0]), "v"(aB[1]), "v"(eA), "v"(eB), "v"(hA), "v"(hB));
    {
        bf16* op = hb_out + (size_t)pend_t * LDH + 256 * sl + 4 * l;
        *(u32x2*)op = pend_h;
        if (l == 0) { ss_ple[(size_t)pend_t * 8 + sl] = pend_ss; ss_ple[(size_t)pend_t * 8 + 4 + sl] = 0.f; }
    }
}

struct EpiStoreBf16 {
    static constexpr bool PERM = true, AFTER_DRAIN = false;
    bf16* O;
    __device__ __forceinline__ void khook(int, f32x4 (&)[2][2][4][2], int, int) const {}
    __device__ __forceinline__ void operator()(const f32x4 (&acc)[2][2][4][2], const pg8::Unit& u, int wr, int wc, int fr, int fqd) const {
        const int row0 = u.pm * 256 + wr * 64 + fr, col0 = u.pn * 256 + wc * 32 + 8 * fqd;
#pragma unroll
        for (int ai = 0; ai < 2; ++ai)
#pragma unroll
            for (int m = 0; m < 4; ++m) {
                bf16* rowp = O + (size_t)(row0 + ai * 128 + m * 16) * 1024 + col0;
#pragma unroll
                for (int bj = 0; bj < 2; ++bj) {
                    const f32x4 v0 = acc[ai][bj][m][0], v1 = acc[ai][bj][m][1];
                    u32x4 wv = {pack2(v0[0], v0[1]), pack2(v0[2], v0[3]), pack2(v1[0], v1[1]), pack2(v1[2], v1[3])};
                    *(u32x4*)(rowp + bj * 128) = wv;
                }
            }
    }
};
__device__ __forceinline__ void phase_pw(const Params& P) {
    char* ws = opq(P.ws);
    pg8::StaticOrder S; S.init(TOK, 1024, gridDim.x, blockIdx.x);
    for (int L = 0; L < 2; ++L) {
        pg8::Gemm g{(const bf16*)(ws + OFF_PB) + (size_t)L * TOK * LDP, (const bf16*)(ws + OFF_WP) + (size_t)L * 1024 * LDP, LDP, LDP, TOK, 1024, 256};
        EpiStoreBf16 E{(bf16*)(ws + (L ? OFF_PW1 : OFF_PW0))};
        pg8::gemm_phase((PG8_LAS unsigned char*)smem, g, S, E, nullptr);
        __syncthreads();
    }
}
struct EpiPle {
    static constexpr bool PERM = true, AFTER_DRAIN = true;
    const bf16* PW; const bf16* hb_in; bf16* hb_out; float* gss;
    __device__ __forceinline__ void khook(int, f32x4 (&)[2][2][4][2], int, int) const {}
    __device__ __forceinline__ void operator()(const f32x4 (&)[2][2][4][2], const pg8::Unit&, int, int, int, int) const {}
    __device__ __forceinline__ void fused(const f32x4 (&acc)[2][2][4][2], const pg8::Unit& u, int wr, int wc, int fr, int fqd, PG8_LAS unsigned char*, int, int) const {
        residual_fused<true, false>(acc, u, wr, wc, fr, fqd, (const float*)(smem + LDS_AUX), PW, hb_in, hb_out, gss);
    }
};
__device__ __forceinline__ void phase_ple(const Params& P, int L, int hsel, int ss_slot_in, int ss_slot_out, int fake = 0) {
    char* ws = opq(P.ws);
    const float* ss_ple = (const float*)(ws + OFF_SSA) + (size_t)ss_slot_in * TOK * 8;
    float* ss_out = (float*)(ws + OFF_SSA) + (size_t)ss_slot_out * TOK * 8;
    const bf16* hb_in = (const bf16*)(ws + (hsel ? OFF_HB1 : OFF_HB0));
    bf16* hb_out = (bf16*)(ws + (hsel ? OFF_HB0 : OFF_HB1));
    const bf16* Wg = (const bf16*)(ws + OFF_WG) + (size_t)L * 1024 * LDH;
    float* aux = (float*)(smem + LDS_AUX);
    const int tid = opaque_tid();
    pg8::Gemm g{hb_in, Wg, LDH, LDH, TOK, 1024, 1024};
    pg8::StaticOrder S; S.init(TOK, 1024, gridDim.x, blockIdx.x);
    pg8::Unit u0;
    if (S.next(0, u0) && tid < 256) aux[tid] = row_rs8(ss_ple, u0.pm * 256 + tid);
    __syncthreads();
    EpiPle E{(const bf16*)(ws + (L ? OFF_PW1 : OFF_PW0)), hb_in, fake ? (bf16*)(ws + OFF_PART) : hb_out, fake ? (float*)(ws + OFF_FQ) : ss_out};
    pg8::gemm_phase((PG8_LAS unsigned char*)smem, g, S, E, nullptr);
    __syncthreads();
}

__device__ __forceinline__ void phase_final(const Params& P, int ss_slot, int hsel) {
    char* ws = opq(P.ws);
    float* out = opq(P.out);
    const bf16* hbin = (const bf16*)(ws + (hsel ? OFF_HB1 : OFF_HB0));
    const float* ss = (const float*)(ws + OFF_SSA) + (size_t)ss_slot * TOK * 8;
    const int tid = opaque_tid(), w = tid >> 6, l = tid & 63;
    const float4* g4 = (const float4*)P.final_norm_g;
    for (int t = blockIdx.x * NW + w; t < TOK; t += gridDim.x * NW) {
        float rs = row_rs8(ss, t);
        float4* o4 = (float4*)(out + (size_t)t * 1024);
#pragma unroll
        for (int i = 0; i < 2; ++i) {
            u32x4 hq = *(const u32x4*)(hbin + (size_t)t * LDH + (i * 64 + l) * 8);
            float4 ga = g4[(i * 64 + l) * 2], gb = g4[(i * 64 + l) * 2 + 1];
            float4 va = {bflo(hq.x) * rs * ga.x, bfhi(hq.x) * rs * ga.y, bflo(hq.y) * rs * ga.z, bfhi(hq.y) * rs * ga.w};
            float4 vb = {bflo(hq.z) * rs * gb.x, bfhi(hq.z) * rs * gb.y, bflo(hq.w) * rs * gb.z, bfhi(hq.w) * rs * gb.w};
            o4[(i * 64 + l) * 2] = va; o4[(i * 64 + l) * 2 + 1] = vb;
        }
    }
}

#define XB_TMO      128
#define XB_XCNT(j)  (256  + 64 * (j))
#define XB_XSUB(j)  (1280 + 64 * (j))
#define XB_XGEN(j)  (2304 + 64 * (j))
#define XB_TOP      3328
#define XB_TOPGEN   3392
#define XCD_BAR_WORDS 3456
#define XB_SPIN_CAP (1u << 22)
__device__ __forceinline__ unsigned xb_ld(unsigned* p) { return __hip_atomic_load(p, __ATOMIC_RELAXED, __HIP_MEMORY_SCOPE_AGENT); }
__device__ __forceinline__ unsigned xb_add(unsigned* p, unsigned v) { return __hip_atomic_fetch_add(p, v, __ATOMIC_RELAXED, __HIP_MEMORY_SCOPE_AGENT); }
__device__ __forceinline__ unsigned xb_xcc_id() { return (unsigned)__builtin_amdgcn_s_getreg((3 << 11) | 20) & 0xFu; }
#define XB_SPIN(cond, bar) do { unsigned _sp = 0; while (cond) { __builtin_amdgcn_s_sleep(1); \
    if ((++_sp & 255u) == 0u) { if (xb_ld(&(bar)[XB_TMO])) break; if (_sp > XB_SPIN_CAP) { atomicAdd(&(bar)[XB_TMO], 1u); break; } } } } while (0)
#define XB_LDS_OFF (LDS_BYTES - 64)
__device__ __forceinline__ void xcd_barrier_post(const Params& P) {
    if (threadIdx.x == 0) {
        unsigned* bar = (unsigned*)(P.ws + OFF_BAR);
        volatile __attribute__((address_space(3))) unsigned* st = (volatile __attribute__((address_space(3))) unsigned*)(smem + XB_LDS_OFF);
        st[0] = 0u; st[1] = 0u;
        (void)xb_add(&bar[XB_XCNT(xb_xcc_id())], 1u);
    }
}
__device__ __forceinline__ void xcd_barrier_complete(unsigned* bar, unsigned x, unsigned& nloc, unsigned& nx) {
    const unsigned G = gridDim.x;
    unsigned sum, cnt, mine, sp = 0u;
    for (;;) {
        sum = 0u; cnt = 0u; mine = 0u;
#pragma unroll
        for (unsigned j = 0; j < 16; ++j) { const unsigned c = xb_ld(&bar[XB_XCNT(j)]); sum += c; cnt += (c > 0u) ? 1u : 0u; mine = (j == x) ? c : mine; }
        if (sum == G) break;
        __builtin_amdgcn_s_sleep(1);
        if ((++sp & 255u) == 0u) { if (xb_ld(&bar[XB_TMO])) break; if (sp > XB_SPIN_CAP) { atomicAdd(&bar[XB_TMO], 1u); break; } }
    }
    nloc = mine > 0u ? mine : 1u; nx = cnt > 0u ? cnt : 1u;
}
__device__ __forceinline__ void grid_barrier(const Params& P) {
    asm volatile("s_waitcnt vmcnt(0)" ::: "memory");
    __syncthreads();
    if (threadIdx.x == 0) {
        unsigned* bar = (unsigned*)(P.ws + OFF_BAR);
        volatile __attribute__((address_space(3))) unsigned* st = (volatile __attribute__((address_space(3))) unsigned*)(smem + XB_LDS_OFF);
        const unsigned x = xb_xcc_id();
        __builtin_amdgcn_s_waitcnt(0);
        unsigned nloc = st[0], nx = st[1];
        if (nloc == 0u) { xcd_barrier_complete(bar, x, nloc, nx); st[0] = nloc; st[1] = nx; }
        const unsigned old = xb_add(&bar[XB_XSUB(x)], 1u);
        const unsigned gen = old / nloc;
        if (old + 1u == (gen + 1u) * nloc) {
            __builtin_amdgcn_fence(__ATOMIC_RELEASE, "agent");
            asm volatile("s_waitcnt vmcnt(0)" ::: "memory");
            const unsigned og = xb_add(&bar[XB_TOP], 1u);
            const unsigned tg = og / nx;
            if (og + 1u == (tg + 1u) * nx) xb_add(&bar[XB_TOPGEN], 1u);
            else XB_SPIN(xb_ld(&bar[XB_TOPGEN]) == tg, bar);
            __builtin_amdgcn_fence(__ATOMIC_ACQUIRE, "agent");
            xb_add(&bar[XB_XGEN(x)], 1u);
            asm volatile("s_waitcnt vmcnt(0)" ::: "memory");
        } else {
            XB_SPIN(xb_ld(&bar[XB_XGEN(x)]) == gen, bar);
            __builtin_amdgcn_fence(__ATOMIC_ACQUIRE, "agent");
            asm volatile("s_waitcnt vmcnt(0)" ::: "memory");
        }
    }
    __syncthreads();
}

__global__ void __launch_bounds__(NTHR, 2) hymba_megakernel(Params P) {
    cg::grid_group grid = cg::this_grid();
    char* ws = opq(P.ws);
    xcd_barrier_post(P);
#define BAR() do { grid_barrier(P); if (DUP == 20) grid_barrier(P); } while (0)
    phase0(P);
    if (DUP == 0) { asm volatile("s_waitcnt vmcnt(0)" ::: "memory"); __syncthreads(); grid_barrier(P); phase0(P); }
    asm volatile("s_waitcnt vmcnt(0)" ::: "memory");
    __syncthreads();
    grid.sync();
    BAR();
    phase_pw(P);
    BAR();
    if (DUP == 11) { phase_pw(P); BAR(); }
    int cur = 0;
    for (int L = 0; L < 2; ++L) {
        const int ss_mix = (L == 0) ? 0 : 3, ss_ffn = 1 + L, ss_next = (L == 0) ? 3 : 4, ss_ple = 5 + L;
        phase_proj(P, L, cur, ss_mix);
        BAR();
        if (DUP == 1) { phase_proj(P, L, cur, ss_mix); BAR(); }
        phase_mla_up(P, L);
        BAR();
        if (DUP == 2) { phase_mla_up(P, L); BAR(); }
        phase_attn(P, L, 0);
        BAR();
        if (DUP == 3) { phase_attn(P, L, 1); BAR(); }
        if (DUP >= 30 && DUP < 34) { phase_attn(P, L, 1, DUP - 30); BAR(); }
        phase_wo(P, L, cur ^ 1, ss_ffn);
        BAR();
        if (DUP == 4 && L == 0) { phase_wo(P, L, cur ^ 1, ss_ffn); BAR(); }
        phase_pq(P, L, cur ^ 1, ss_ffn);
        BAR();
        if (DUP == 5) { phase_pq(P, L, cur ^ 1, ss_ffn); BAR(); }
        phase_topk(P, L);
        BAR();
        if (DUP == 6) { phase_topk(P, L); BAR(); }
        phase_gather_u(P, L);
        BAR();
        if (DUP == 7) { phase_gather_u(P, L); BAR(); }
        if (DUP == 10) { phase_gather_act(P, L, ss_ffn, 1); BAR(); }
        phase_gather_act(P, L, ss_ffn);
        BAR();
        if (DUP == 8) { phase_gather_v(P, L, cur, ss_ple, 1); BAR(); }
        phase_gather_v(P, L, cur, ss_ple);
        BAR();
        if (DUP == 9) { phase_ple(P, L, cur, ss_ple, ss_next, 1); BAR(); }
        phase_ple(P, L, cur, ss_ple, ss_next);
        BAR();
        cur ^= 1;
    }
    phase_final(P, 4, cur);
}

extern "C" void kernel_launch(void* const* d_in, const int* in_sizes, int n_in, void* d_out, int out_size, void* d_ws,
                              size_t ws_size, hipStream_t stream) {
    static int grid_blocks = 0;
    if (!grid_blocks) {
        int dev = 0, cus = 0, per_cu = 0;
        hipGetDevice(&dev);
        hipDeviceGetAttribute(&cus, hipDeviceAttributeMultiprocessorCount, dev);
        hipOccupancyMaxActiveBlocksPerMultiprocessor(&per_cu, hymba_megakernel, NTHR, 0);
        if (per_cu > 1) per_cu = 1;
        if (per_cu < 1) per_cu = 1;
        grid_blocks = cus * per_cu;
        if (ws_size < WS_END) fprintf(stderr, "workspace too small: %zu < %zu\n", ws_size, (size_t)WS_END);
    }
    Params P{};
    P.x = (const float*)d_in[0]; P.p = (const float*)d_in[1]; P.pos = (const int*)d_in[2];
    P.norm_mix_g = (const float*)d_in[3]; P.w_in = (const float*)d_in[4]; P.b_forget = (const float*)d_in[5];
    P.mla_q_norm_g = (const float*)d_in[6]; P.w_uq = (const float*)d_in[7]; P.mla_kv_norm_g = (const float*)d_in[8];
    P.w_ukv = (const float*)d_in[9]; P.mix_out_norm_g = (const float*)d_in[10]; P.w_o = (const float*)d_in[11];
    P.norm_ffn_g = (const float*)d_in[12]; P.w_query = (const float*)d_in[13]; P.sub_keys = (const float*)d_in[14];
    P.peer_u = (const float*)d_in[15]; P.peer_v = (const float*)d_in[16]; P.w_ple = (const float*)d_in[17];
    P.ple_norm_g = (const float*)d_in[18]; P.w_ple_gate = (const float*)d_in[19]; P.final_norm_g = (const float*)d_in[20];
    P.out = (float*)d_out; P.ws = (char*)d_ws;
    hipMemsetAsync((char*)d_ws + OFF_BAR, 0, 16384 + 4096, stream);
    void* args[] = {&P};
    hipError_t e = hipLaunchCooperativeKernel((void*)hymba_megakernel, dim3(grid_blocks), dim3(NTHR), args, 0, stream);
    if (e != hipSuccess) fprintf(stderr, "cooperative launch failed: %s (grid %d)\n", hipGetErrorString(e), grid_blocks);
}
```

```cpp
#include <hip/hip_runtime.h>
#include <hip/hip_cooperative_groups.h>
#include <cstdio>
#include <cstdint>
#include <math.h>
#include <climits>
namespace cg = cooperative_groups;

typedef __bf16 bf16;
typedef __bf16 bf16x8 __attribute__((ext_vector_type(8)));
typedef __bf16 bf16x4 __attribute__((ext_vector_type(4)));
typedef __bf16 bf16x2 __attribute__((ext_vector_type(2)));
typedef float f32x16 __attribute__((ext_vector_type(16)));
typedef float f32x4 __attribute__((ext_vector_type(4)));
typedef float f32x2 __attribute__((ext_vector_type(2)));
typedef unsigned u32x4 __attribute__((ext_vector_type(4)));
typedef unsigned u32x2 __attribute__((ext_vector_type(2)));

#define SEQ 2048
#define BATCH 8
#define TOK 16384
#define DM 1024
#define IN_W 1956
#define NEXP 16384
#define EPSF 1e-6f
#define LOG2E 1.4426950408889634f
#define NTHR 512
#define NW 8
#define LDS_BYTES 151808
#define STAGE_BYTES 49152
#define LDS_AUX 147456
#ifndef DUP
#define DUP -1
#endif

constexpr size_t MBy = 1ull << 20;
constexpr size_t OFF_UB = 0;
constexpr size_t OFF_VB = 16 * MBy;
constexpr size_t OFF_PART = 32 * MBy;
constexpr size_t OFF_PW1 = 96 * MBy;
#define LDH 1088
#define LDP 320
#define LDC 192
constexpr size_t OFF_WIN = 128 * MBy;
constexpr size_t OFF_WO = 137 * MBy;
constexpr size_t OFF_WQ = 142 * MBy;
constexpr size_t OFF_WG = 147 * MBy;
constexpr size_t OFF_WP = 152 * MBy;
constexpr size_t OFF_WUQ = 154 * MBy;
constexpr size_t OFF_WUKV = 155 * MBy;
constexpr size_t OFF_SKB = 156 * MBy;
constexpr size_t OFF_CS = 157 * MBy;
constexpr size_t OFF_TSC = 159 * MBy;
constexpr size_t OFF_SSA = 160 * MBy;
constexpr size_t OFF_HB0 = 164 * MBy;
constexpr size_t OFF_HB1 = 200 * MBy;
constexpr size_t OFF_FQ = 236 * MBy;
constexpr size_t OFF_FK = 244 * MBy;
constexpr size_t OFF_FVT = 252 * MBy;
constexpr size_t OFF_SQ = 260 * MBy;
constexpr size_t OFF_SKK = 268 * MBy;
constexpr size_t OFF_SVT = 276 * MBy;
constexpr size_t OFF_CQ = 284 * MBy;
constexpr size_t OFF_CKV = 295 * MBy;
constexpr size_t OFF_FLOG = 302 * MBy;
constexpr size_t OFF_CUMF = 303 * MBy;
constexpr size_t OFF_MQ = 304 * MBy;
constexpr size_t OFF_MK = 316 * MBy;
constexpr size_t OFF_MVT = 328 * MBy;
constexpr size_t OFF_Y = 344 * MBy;
constexpr size_t OFF_PQ = 380 * MBy;
constexpr size_t OFF_IDS = 412 * MBy;
constexpr size_t OFF_GATE = 420 * MBy;
constexpr size_t OFF_BAR = 428 * MBy;
constexpr size_t OFF_CNT = OFF_BAR + 16384;
constexpr size_t OFF_SSY = 429 * MBy;
constexpr size_t OFF_PB = 431 * MBy;
constexpr size_t OFF_PW0 = 452 * MBy;
constexpr size_t OFF_A8 = OFF_PQ;
constexpr size_t OFF_XH = OFF_FQ;
constexpr size_t OFF_XL = OFF_FQ + 16 * MBy;
constexpr size_t WS_END = 484 * MBy;

struct Params {
    const float* x; const float* p; const int* pos;
    const float* norm_mix_g; const float* w_in; const float* b_forget; const float* mla_q_norm_g; const float* w_uq;
    const float* mla_kv_norm_g; const float* w_ukv; const float* mix_out_norm_g; const float* w_o; const float* norm_ffn_g;
    const float* w_query; const float* sub_keys; const float* peer_u; const float* peer_v; const float* w_ple;
    const float* ple_norm_g; const float* w_ple_gate; const float* final_norm_g;
    float* out; char* ws;
};

__shared__ __attribute__((aligned(16))) char smem[LDS_BYTES];

__device__ __forceinline__ int opaque_tid() { int t = threadIdx.x; asm volatile("" : "+v"(t)); return t; }
template <typename T> __device__ __forceinline__ T* opq(T* p) { size_t z = 0; asm volatile("" : "+s"(z)); return (T*)((char*)p + z); }

__device__ __forceinline__ unsigned pack2(float a, float b) {
    f32x2 v = {a, b};
    bf16x2 r = __builtin_convertvector(v, bf16x2);
    return __builtin_bit_cast(unsigned, r);
}
__device__ __forceinline__ float bflo(unsigned u) { return __uint_as_float(u << 16); }
__device__ __forceinline__ float bfhi(unsigned u) { return __uint_as_float(u & 0xffff0000u); }
__device__ __forceinline__ float4 ntload4(const float4* p) {
    const f32x4 t = __builtin_nontemporal_load((const f32x4*)p);
    return make_float4(t.x, t.y, t.z, t.w);
}
__device__ __forceinline__ float wave_sum(float v) {
#pragma unroll
    for (int o = 32; o > 0; o >>= 1) v += __shfl_xor(v, o);
    return v;
}
template <int CTRL> __device__ __forceinline__ float dpp_add(float v) {
    return v + __builtin_bit_cast(float, __builtin_amdgcn_update_dpp(0, __builtin_bit_cast(int, v), CTRL, 0xf, 0xf, true));
}
__device__ __forceinline__ float sum8_dpp(float v) { v = dpp_add<0xB1>(v); v = dpp_add<0x4E>(v); v = dpp_add<0x141>(v); return v; }
__device__ __forceinline__ float sumg_dpp(float v) {
    v = dpp_add<0x128>(v);
    float a = v, b = v;
    asm volatile("s_nop 1\n\tv_permlane16_swap_b32 %0, %1\n\ts_nop 1" : "+v"(a), "+v"(b));
    v = a + b;
    a = v; b = v;
    asm volatile("s_nop 1\n\tv_permlane32_swap_b32 %0, %1\n\ts_nop 1" : "+v"(a), "+v"(b));
    return a + b;
}
template <int CTRL> __device__ __forceinline__ float dpp_max0(float v) {
    return fmaxf(v, __builtin_bit_cast(float, __builtin_amdgcn_update_dpp(0, __builtin_bit_cast(int, v), CTRL, 0xf, 0xf, true)));
}
__device__ __forceinline__ float wave_max0(float v) {
    v = dpp_max0<0xB1>(v); v = dpp_max0<0x4E>(v); v = dpp_max0<0x141>(v); v = dpp_max0<0x140>(v);
    float a = v, b = v;
    asm volatile("s_nop 1\n\tv_permlane16_swap_b32 %0, %1\n\ts_nop 1" : "+v"(a), "+v"(b));
    v = fmaxf(a, b); a = v; b = v;
    asm volatile("s_nop 1\n\tv_permlane32_swap_b32 %0, %1\n\ts_nop 1" : "+v"(a), "+v"(b));
    return fmaxf(a, b);
}
__device__ __forceinline__ int partner32(int v, int hh) {
    int a = v, b = v;
    asm volatile("s_nop 1\n\tv_permlane32_swap_b32 %0, %1\n\ts_nop 1" : "+v"(a), "+v"(b));
    return hh ? a : b;
}
__device__ __forceinline__ float fexp2(float x) { return __builtin_amdgcn_exp2f(x); }
__device__ __forceinline__ float flog2(float x) { return __builtin_amdgcn_logf(x); }
__device__ __forceinline__ float log_sigmoid_f(float z) { return fminf(z, 0.f) - 0.6931471805599453f * flog2(1.f + fexp2(-1.4426950408889634f * fabsf(z))); }

struct WJob { const float* src; int lds; int K; int Np; bf16* dst; int ldd; const float* gain; int map; };

__device__ __forceinline__ int src_col_map(int map, int c) {
    if (map == 0) return c;
    if (map == 1) {
        if (c < 768) return c;
        if (c < 1952) return c + 4;
        if (c < 1956) return c - 1952 + 768;
        return -1;
    }
    if (c < 256) return 192 * (c >> 6) + (c & 63);
    int e = c - 256;
    return 192 * (e >> 7) + 64 + (e & 127);
}

__device__ __forceinline__ void wconv_group(const WJob& j, int t0, int tstride, int ntiles) {
    float* tl = (float*)smem;
    const int ktiles = j.K >> 5;
    const int tx = opaque_tid() & 31, ty = opaque_tid() >> 5;
    float v[8][2];
#pragma unroll
    for (int u = 0; u < 8; ++u) {
        const int tile = t0 + u * tstride;
        v[u][0] = 0.f; v[u][1] = 0.f;
        if (tile < ntiles) {
            const int nt = tile / ktiles, kt = tile % ktiles;
            const int sc = src_col_map(j.map, nt * 32 + tx);
            if (sc >= 0) {
#pragma unroll
                for (int i = 0; i < 2; ++i) {
                    const int k = kt * 32 + ty + 16 * i;
                    v[u][i] = __builtin_nontemporal_load(j.src + (size_t)k * j.lds + sc) * (j.gain ? j.gain[k] : 1.f);
                }
            }
        }
    }
#pragma unroll
    for (int u = 0; u < 8; ++u)
#pragma unroll
        for (int i = 0; i < 2; ++i) tl[u * 1056 + (ty + 16 * i) * 33 + tx] = v[u][i];
    __syncthreads();
#pragma unroll
    for (int u = 0; u < 8; ++u) {
        const int tile = t0 + u * tstride;
        if (tile < ntiles) {
            const int nt = tile / ktiles, kt = tile % ktiles;
#pragma unroll
            for (int i = 0; i < 2; ++i) {
                const int n = nt * 32 + ty + 16 * i;
                j.dst[(size_t)n * j.ldd + kt * 32 + tx] = (bf16)tl[u * 1056 + tx * 33 + ty + 16 * i];
            }
        }
    }
    __syncthreads();
}

__device__ __forceinline__ void phase0(const Params& P) {
    char* ws = opq(P.ws);
    const int G = gridDim.x, bid = blockIdx.x, tid = opaque_tid();
    if (DUP == 23) {
        const int w = tid >> 6, l = tid & 63;
        float4 accp = {0.f, 0.f, 0.f, 0.f};
        for (int it = (bid * NW + w) * 4; it < 4 * NEXP; it += G * NW * 4) {
            float4 v[16];
            const int tb = it >> 14, e = it & (NEXP - 1);
            const float4* src = (const float4*)((tb < 2 ? P.peer_u : P.peer_v) + ((size_t)(tb & 1) * NEXP + e) * DM) + l;
#pragma unroll
            for (int q = 0; q < 16; ++q) v[q] = ntload4(src + 64 * q);
#pragma unroll
            for (int q = 0; q < 16; ++q) { accp.x += v[q].x; accp.y += v[q].y; accp.z += v[q].z; accp.w += v[q].w; }
        }
        ((float4*)(ws + OFF_PART))[bid * NTHR + tid] = accp;
    }
    for (int rep = 0; rep < (DUP == 20 ? 2 : 1); ++rep) {
        const int w = tid >> 6, l = tid & 63;
        float* tsc = (float*)(ws + OFF_TSC);
        for (int it = (bid * NW + w) * 4; it < 4 * NEXP; it += G * NW * 4) {
            const int tb = it >> 14, e0 = it & (NEXP - 1);
            const float4* src = (const float4*)((tb < 2 ? P.peer_u : P.peer_v) + ((size_t)(tb & 1) * NEXP + e0) * DM) + l;
            unsigned char* dst = (unsigned char*)(ws + (tb < 2 ? OFF_UB : OFF_VB)) + (size_t)(tb & 1) * NEXP * 512 + (size_t)e0 * 128 + 2 * l;
            float4 v[4][4];
#pragma unroll
            for (int r = 0; r < 4; ++r)
#pragma unroll
                for (int q = 0; q < 4; ++q) v[r][q] = ntload4(src + 256 * r + 64 * q);
            if (tb < 2) {
                const float4* g4 = (const float4*)(P.norm_ffn_g + (tb & 1) * 1024) + l;
#pragma unroll
                for (int q = 0; q < 4; ++q) {
                    const float4 g = g4[64 * q];
#pragma unroll
                    for (int r = 0; r < 4; ++r) { v[r][q].x *= g.x; v[r][q].y *= g.y; v[r][q].z *= g.z; v[r][q].w *= g.w; }
                }
            }
            float am[4];
#pragma unroll
            for (int r = 0; r < 4; ++r) {
                float m = 0.f;
#pragma unroll
                for (int q = 0; q < 4; ++q) m = fmaxf(m, fmaxf(fmaxf(fabsf(v[r][q].x), fabsf(v[r][q].y)), fmaxf(fabsf(v[r][q].z), fabsf(v[r][q].w))));
                am[r] = wave_max0(m);
            }
#pragma unroll
            for (int r = 0; r < 4; ++r) {
                const float sc = (am[r] > 0.f) ? (6.0f / am[r]) : 1.f, isc = (am[r] > 0.f) ? (am[r] * (1.f / 6.0f)) : 1.f;
#pragma unroll
                for (int q = 0; q < 4; ++q) {
                    unsigned wq = 0;
                    wq = __builtin_amdgcn_cvt_scalef32_pk_fp4_f32(wq, v[r][q].x * sc, v[r][q].y * sc, 1.0f, 0);
                    wq = __builtin_amdgcn_cvt_scalef32_pk_fp4_f32(wq, v[r][q].z * sc, v[r][q].w * sc, 1.0f, 1);
                    *(unsigned short*)(dst + (size_t)q * NEXP * 128 + r * 128) = (unsigned short)(wq & 0xffffu);
                }
                if (l == 0) tsc[tb * NEXP + e0 + r] = isc;
            }
        }
    }
    if (DUP == 22) {
        const int w = tid >> 6, l = tid & 63;
        float4 accp = {0.f, 0.f, 0.f, 0.f};
        for (int it = (bid * NW + w) * 4; it < 4 * NEXP; it += G * NW * 4) {
            float4 v[16];
#pragma unroll
            for (int r = 0; r < 4; ++r) {
                const int tb = (it + r) >> 14, e = (it + r) & (NEXP - 1);
                const float4* src = (const float4*)((tb < 2 ? P.peer_u : P.peer_v) + ((size_t)(tb & 1) * NEXP + e) * DM) + l;
#pragma unroll
                for (int q = 0; q < 4; ++q) v[4 * r + q] = src[64 * q];
            }
#pragma unroll
            for (int q = 0; q < 16; ++q) { accp.x += v[q].x; accp.y += v[q].y; accp.z += v[q].z; accp.w += v[q].w; }
        }
        ((float4*)(ws + OFF_PART))[bid * NTHR + tid] = accp;
    }
    for (int rep = 0; rep < (DUP == 21 ? 2 : 1); ++rep) {
        for (int L = 0; L < 2; ++L) {
            WJob jobs[7];
            jobs[0] = {P.w_in + (size_t)L * 1024 * IN_W, IN_W, 1024, 2048, (bf16*)(ws + OFF_WIN) + (size_t)L * 2048 * LDH, LDH, P.norm_mix_g + L * 1024, 1};
            jobs[1] = {P.w_o + (size_t)L * 1024 * 1024, 1024, 1024, 1024, (bf16*)(ws + OFF_WO) + (size_t)L * 1024 * LDH, LDH, P.mix_out_norm_g + L * 1024, 0};
            jobs[2] = {P.w_query + (size_t)L * 1024 * 1024, 1024, 1024, 1024, (bf16*)(ws + OFF_WQ) + (size_t)L * 1024 * LDH, LDH, P.norm_ffn_g + L * 1024, 0};
            jobs[3] = {P.w_ple_gate + (size_t)L * 1024 * 1024, 1024, 1024, 1024, (bf16*)(ws + OFF_WG) + (size_t)L * 1024 * LDH, LDH, P.ple_norm_g + L * 1024, 0};
            jobs[4] = {P.w_ple + (size_t)L * 256 * 1024, 1024, 256, 1024, (bf16*)(ws + OFF_WP) + (size_t)L * 1024 * LDP, LDP, nullptr, 0};
            jobs[5] = {P.w_uq + (size_t)L * 256 * 384, 384, 256, 384, (bf16*)(ws + OFF_WUQ) + (size_t)L * 384 * LDP, LDP, P.mla_q_norm_g + L * 256, 0};
            jobs[6] = {P.w_ukv + (size_t)L * 128 * 768, 768, 128, 768, (bf16*)(ws + OFF_WUKV) + (size_t)L * 768 * LDC, LDC, P.mla_kv_norm_g + L * 128, 2};
#pragma unroll
            for (int q = 0; q < 7; ++q) {
                int nt = (jobs[q].Np >> 5) * (jobs[q].K >> 5);
                for (int it = bid; it < nt; it += 8 * G) wconv_group(jobs[q], it, G, nt);
            }
        }
    }
    {
        const float* src = P.sub_keys;
        bf16* dst = (bf16*)(ws + OFF_SKB);
        for (int i = bid * NTHR + tid; i < 262144 / 2; i += G * NTHR) {
            float2 v = ((const float2*)src)[i];
            ((unsigned*)dst)[i] = pack2(v.x, v.y);
        }
    }
    {
        const float4* src = (const float4*)P.p;
        bf16* dst = (bf16*)(ws + OFF_PB);
        for (int i0 = bid * NTHR + tid; i0 < 2 * TOK * 256 / 4; i0 += 4 * G * NTHR) {
            float4 a[4];
#pragma unroll
            for (int u = 0; u < 4; ++u) a[u] = ntload4(src + ((i0 + u * G * NTHR < 2 * TOK * 64) ? (i0 + u * G * NTHR) : i0));
#pragma unroll
            for (int u = 0; u < 4; ++u) {
                const int i = i0 + u * G * NTHR;
                if (i >= 2 * TOK * 64) break;
                u32x2 o = {pack2(a[u].x, a[u].y), pack2(a[u].z, a[u].w)};
                *(u32x2*)(dst + (size_t)(i >> 6) * LDP + (i & 63) * 4) = o;
            }
        }
    }
    {
        bf16* hb = (bf16*)(ws + OFF_HB0);
        float* ss0 = (float*)(ws + OFF_SSA);
        int w = tid >> 6, l = tid & 63;
        for (int row0 = (bid * NW + w) * 4; row0 < TOK; row0 += G * NW * 4) {
            const float4* xr = (const float4*)(P.x + (size_t)row0 * DM) + l;
            float4 a[4][4];
#pragma unroll
            for (int r = 0; r < 4; ++r)
#pragma unroll
                for (int i = 0; i < 4; ++i) a[r][i] = ntload4(xr + 256 * r + 64 * i);
#pragma unroll
            for (int r = 0; r < 4; ++r) {
                const int row = row0 + r;
                float ss = 0.f;
#pragma unroll
                for (int i = 0; i < 4; ++i) {
                    ss += a[r][i].x * a[r][i].x + a[r][i].y * a[r][i].y + a[r][i].z * a[r][i].z + a[r][i].w * a[r][i].w;
                    u32x2 o = {pack2(a[r][i].x, a[r][i].y), pack2(a[r][i].z, a[r][i].w)};
                    ((u32x2*)(hb + (size_t)row * LDH))[i * 64 + l] = o;
                }
                ss = wave_sum(ss);
                if (l == 0) {
                    *(float4*)(ss0 + (size_t)row * 8) = make_float4(ss, 0.f, 0.f, 0.f);
                    *(float4*)(ss0 + (size_t)row * 8 + 4) = make_float4(0.f, 0.f, 0.f, 0.f);
                }
            }
        }
    }
    {
        float* cs = (float*)(ws + OFF_CS);
        for (int i = bid * NTHR + tid; i < TOK * 16; i += G * NTHR) {
            int t = i >> 4, k = i & 15;
            float inv = powf(10000.0f, -(float)k / 16.0f);
            float ang = (float)P.pos[t] * inv;
            cs[2 * i] = cosf(ang);
            cs[2 * i + 1] = sinf(ang);
        }
    }
}

struct NoHook { static constexpr bool nodma = false; __device__ __forceinline__ void operator()(int, f32x16 (&)[2][2]) const {} };
struct NoDmaHook { static constexpr bool nodma = true; __device__ __forceinline__ void operator()(int, f32x16 (&)[2][2]) const {} };
template <typename HOOK>
__device__ __forceinline__ void gemm_core(f32x16 (&acc)[2][2], const bf16* A, int lda, const bf16* Bt, int ldb, int K,
                                          int m0, int n0, HOOK hook) {
    const int tid = opaque_tid(), w = tid >> 6, l = tid & 63, r = l & 31, hh = l >> 5;
    const int wm = w >> 1, wn = w & 1;
    const int dp = (tid & 15) ^ ((tid >> 4) & 15);
    const int drow = 2 * (tid >> 4) + (dp >> 3), dgc = (dp & 7) * 8;
    const bf16* asrc = A + (size_t)(m0 + drow) * lda + dgc;
    const bf16* bsrc = Bt + (size_t)(n0 + drow) * ldb + dgc;
    auto dma = [&](int buf, int k0) {
        if (HOOK::nodma) return;
        char* base = smem + buf * STAGE_BYTES + tid * 16;
#pragma unroll
        for (int i = 0; i < 4; ++i)
            __builtin_amdgcn_global_load_lds((const unsigned*)(asrc + (size_t)(64 * i) * lda + k0), (unsigned*)(base + i * 8192), 16, 0, 0);
#pragma unroll
        for (int i = 0; i < 2; ++i)
            __builtin_amdgcn_global_load_lds((const unsigned*)(bsrc + (size_t)(64 * i) * ldb + k0), (unsigned*)(base + 32768 + i * 8192), 16, 0, 0);
    };
    int offA[2], offB[2];
#pragma unroll
    for (int i = 0; i < 2; ++i) { offA[i] = ((wm * 64 + i * 32 + r) >> 1) * 256; offB[i] = 32768 + ((wn * 64 + i * 32 + r) >> 1) * 256; }
    const int pbase = ((r & 1) << 3), lx = (r >> 1) & 15;
    const int nk = K >> 6;
    const unsigned ldsbase = (unsigned)(size_t)(__attribute__((address_space(3))) char*)smem;
    auto ldfrag = [&](int stage, int s, bf16x8 (&af)[2], bf16x8 (&bfr)[2]) {
        unsigned ch = (unsigned)((((pbase | (2 * s + hh)) ^ lx) << 4)) + ldsbase + (unsigned)(stage * STAGE_BYTES);
        unsigned a0a = ch + offA[0], a1a = ch + offA[1], b0a = ch + offB[0], b1a = ch + offB[1];
        asm volatile("ds_read_b128 %0, %4\n\tds_read_b128 %1, %5\n\tds_read_b128 %2, %6\n\tds_read_b128 %3, %7"
                     : "=&v"(af[0]), "=&v"(af[1]), "=&v"(bfr[0]), "=&v"(bfr[1]) : "v"(a0a), "v"(a1a), "v"(b0a), "v"(b1a) : "memory");
    };
    auto mma = [&](bf16x8 (&af)[2], bf16x8 (&bfr)[2]) {
#pragma unroll
        for (int i = 0; i < 2; ++i)
#pragma unroll
            for (int j = 0; j < 2; ++j) acc[i][j] = __builtin_amdgcn_mfma_f32_32x32x16_bf16(af[i], bfr[j], acc[i][j], 0, 0, 0);
    };
#define LGKM_WAIT(n) do { asm volatile("s_waitcnt lgkmcnt(" #n ")" ::: "memory"); __builtin_amdgcn_sched_barrier(0); } while (0)
    asm volatile("s_waitcnt vmcnt(0)" ::: "memory");
    dma(0, 0);
    dma(1, 64);
    if (nk > 2) { dma(2, 128); asm volatile("s_waitcnt vmcnt(12)" ::: "memory"); }
    else asm volatile("s_waitcnt vmcnt(6)" ::: "memory");
    __builtin_amdgcn_s_barrier();
    bf16x8 a0[2], b0[2], a1[2], b1[2];
    ldfrag(0, 0, a0, b0);
    int cur = 0;
    for (int kt = 0; kt < nk; ++kt) {
        const int nxt = (cur == 2) ? 0 : cur + 1;
        if (kt == 4 || kt == 8) { LGKM_WAIT(0); hook(kt, acc); }
        ldfrag(cur, 1, a1, b1);
        LGKM_WAIT(4);
        mma(a0, b0);
        ldfrag(cur, 2, a0, b0);
        LGKM_WAIT(4);
        mma(a1, b1);
        ldfrag(cur, 3, a1, b1);
        LGKM_WAIT(4);
        mma(a0, b0);
        if (kt + 1 < nk) {
            if (kt + 2 < nk) asm volatile("s_waitcnt vmcnt(6) lgkmcnt(0)" ::: "memory");
            else asm volatile("s_waitcnt vmcnt(0) lgkmcnt(0)" ::: "memory");
            __builtin_amdgcn_s_barrier();
            __builtin_amdgcn_sched_barrier(0);
            if (kt + 3 < nk) dma(cur, (kt + 3) << 6);
            ldfrag(nxt, 0, a0, b0);
        } else {
            LGKM_WAIT(0);
        }
        mma(a1, b1);
        cur = nxt;
    }
    __syncthreads();
}
__device__ __forceinline__ float row_rs8(const float* part, int row) {
    float4 a = *(const float4*)(part + (size_t)row * 8), b = *(const float4*)(part + (size_t)row * 8 + 4);
    float ss = ((a.x + a.y) + (a.z + a.w)) + ((b.x + b.y) + (b.z + b.w));
    return rsqrtf(ss * (1.f / 1024.f) + EPSF);
}
__device__ __forceinline__ bool xcd_tile(int it, int MT, int NT, int& mt, int& nt) {
    const int G = gridDim.x, bid = blockIdx.x;
    if ((G & 7) == 0 && (MT & 7) == 0) {
        const int nbx = G >> 3, q = (bid >> 3) + it * nbx, per = (MT >> 3) * NT;
        if (q >= per) return false;
        mt = (bid & 7) * (MT >> 3) + q / NT; nt = q % NT;
        return true;
    }
    const int q = bid + it * G;
    if (q >= MT * NT) return false;
    mt = q / NT; nt = q % NT;
    return true;
}
struct NoScale { __device__ __forceinline__ float operator()(int, int) const { return 1.f; } };

#define ZERO_ACC(acc)                                  \
    _Pragma("unroll") for (int _i = 0; _i < 2; ++_i)   \
    _Pragma("unroll") for (int _j = 0; _j < 2; ++_j)   \
    _Pragma("unroll") for (int _r = 0; _r < 16; ++_r) acc[_i][_j][_r] = 0.f;


namespace pg8 {
#define PG8_LAS __attribute__((address_space(3)))
typedef unsigned short bf16_t;
constexpr int BM = 256, BK = 64, HALF = 128, HTB = HALF * BK * 2  , NXCD = 8, WGM = 8;

__host__ __device__ __forceinline__ int lds_byte(int r, int c) { const int st = (r >> 4) * 2 + (c >> 5), rr = r & 15, cc = c & 31, ob = rr * 64 + cc * 2; return st * 1024 + (ob ^ (((ob >> 9) & 1) << 5)); }
__host__ __device__ __forceinline__ void stage_rc(int b, int& R, int& C) { const int st = b / 1024, sb = b % 1024, swz = sb ^ (((sb >> 9) & 1) << 5); R = (st >> 1) * 16 + swz / 64; C = (st & 1) * 32 + (swz % 64) / 2; }
__host__ __device__ __forceinline__ int perm32(int rho) { const int n = rho >> 4, i = rho & 15; return 8 * (i >> 2) + 4 * n + (i & 3); }
struct Unit { int pm, pn; };
struct Gemm { const bf16* A; const bf16* Bt; int lda, ldb, M, N, K; };
struct StaticOrder {
    int nM, nN, nwg, G, c;
    __device__ void init(int M, int N, int G_, int c_) { nM = M / BM; nN = N / BM; nwg = nM * nN; G = G_; c = c_; }
    __device__ bool next(int i, Unit& u) const {
        const long L = (long)i * G + c; if (L >= nwg) return false;
        int wgid = (int)L; { const int q = nwg / NXCD, r = nwg % NXCD, xcd = wgid % NXCD, off = wgid / NXCD; wgid = (xcd < r ? xcd * (q + 1) : r * (q + 1) + (xcd - r) * q) + off; }
        const int nig = WGM * nN, gid = wgid / nig, fm = gid * WGM, gsz = (nM - fm) < WGM ? (nM - fm) : WGM;
        u.pm = fm + ((wgid % nig) % gsz); u.pn = (wgid % nig) / gsz; return true;
    }
    __device__ __forceinline__ void a_ready(const Unit&) const {}
    __device__ __forceinline__ void done(const Unit&) const {}
};
template <class Epi, class Sched, bool STAMP = false>
__device__ __forceinline__ void gemm_phase(PG8_LAS unsigned char* lds, const Gemm g, const Sched& S, const Epi& E, unsigned long long* stamps) {
    const int tid = opaque_tid(), wid = __builtin_amdgcn_readfirstlane(tid >> 6), lane = tid & 63, wr = wid >> 2, wc = wid & 3, fr = lane & 15, fq = lane >> 4;
    const int K = g.K, nt = K / BK;
    int ts_lo = 0, ts_hi = 0, nts = 0; const unsigned long long rt_entry = STAMP ? (unsigned long long)wall_clock64() : 0ull;
#define PG8_STAMP() do { if (STAMP && wid == 0 && nts < 64) { const unsigned long long _c = (unsigned long long)clock64(); \
        ts_lo = (lane == nts) ? (int)(unsigned)_c : ts_lo; ts_hi = (lane == nts) ? (int)(unsigned)(_c >> 32) : ts_hi; ++nts; } } while (0)
    PG8_STAMP();
    unsigned voffA[2], voffB[2];
#pragma unroll
    for (int i = 0; i < 2; ++i) { int R, C; stage_rc(tid * 16 + i * 8192, R, C); const int Rb = Epi::PERM ? ((R & ~31) + perm32(R & 31)) : R;
        voffA[i] = (unsigned)(R * g.lda + C) * 2u; voffB[i] = (unsigned)(Rb * g.ldb + C) * 2u; }
    const size_t kstep = (size_t)(BK * 2);
    const size_t hstepA = (size_t)HALF * g.lda * 2, hstepB = (size_t)HALF * g.ldb * 2;
    const size_t tstepA = 2 * hstepA, tstepB = 2 * hstepB;
    const unsigned ldsw = (unsigned)wid * 1024u;
    const int aoff = lds_byte(wr * 64 + fr, fq * 8), boff = lds_byte(wc * 32 + fr, fq * 8);
#define PG8_SA(b, h) (((b) * 2 + (h)) * HTB)
#define PG8_SB(b, h) ((4 + (b) * 2 + (h)) * HTB)
#define PG8_STAGE(bufoff, gbase, voff) do { _Pragma("unroll") for (int _i = 0; _i < 2; ++_i) \
        __builtin_amdgcn_global_load_lds((const unsigned*)((const char*)(gbase) + (voff)[_i]), (PG8_LAS unsigned*)(lds + (bufoff) + ldsw + _i * 8192), 16, 0, 0); } while (0)
#define PG8_LDA(dst, b, h) do { _Pragma("unroll") for (int m = 0; m < 4; ++m) _Pragma("unroll") for (int k = 0; k < 2; ++k) dst[m][k] = *(const PG8_LAS bf16x8*)(lds + PG8_SA(b, h) + aoff + m * 2048 + k * 1024); } while (0)
#define PG8_LDB(dst, b, h) do { _Pragma("unroll") for (int n = 0; n < 2; ++n) _Pragma("unroll") for (int k = 0; k < 2; ++k) dst[n][k] = *(const PG8_LAS bf16x8*)(lds + PG8_SB(b, h) + boff + n * 2048 + k * 1024); } while (0)
#define PG8_MMA(ai, bj, At, Bt) do { __builtin_amdgcn_s_setprio(1); _Pragma("unroll") for (int m = 0; m < 4; ++m) _Pragma("unroll") for (int n = 0; n < 2; ++n) _Pragma("unroll") for (int k = 0; k < 2; ++k) \
        acc[ai][bj][m][n] = __builtin_amdgcn_mfma_f32_16x16x32_bf16(Bt[n][k], At[m][k], acc[ai][bj][m][n], 0, 0, 0); __builtin_amdgcn_s_setprio(0); } while (0)
#define PG8_WAIT_V(n) asm volatile("s_waitcnt vmcnt(" #n ")" ::: "memory")
#define PG8_WAIT_L(n) asm volatile("s_waitcnt lgkmcnt(" #n ")" ::: "memory")
#define PG8_BAR __builtin_amdgcn_s_barrier()
#define PG8_SCHED __builtin_amdgcn_sched_barrier(0)
    Unit cur, nxt; int ui = 0;
    if (!S.next(0, cur)) return;
    f32x4 acc[2][2][4][2];
#pragma unroll
    for (int a = 0; a < 2; ++a)
#pragma unroll
        for (int b = 0; b < 2; ++b)
#pragma unroll
            for (int m = 0; m < 4; ++m)
#pragma unroll
                for (int n = 0; n < 2; ++n) acc[a][b][m][n] = (f32x4){0.f, 0.f, 0.f, 0.f};
    bf16x8 At[4][2], B0[2][2], B1[2][2];
    const char* cA = (const char*)g.A + (size_t)cur.pm * tstepA; const char* cB = (const char*)g.Bt + (size_t)cur.pn * tstepB;
    S.a_ready(cur);
    PG8_STAGE(PG8_SB(0, 0), cB, voffB); PG8_STAGE(PG8_SA(0, 0), cA, voffA); PG8_STAGE(PG8_SB(0, 1), cB + hstepB, voffB); PG8_STAGE(PG8_SA(0, 1), cA + hstepA, voffA);
    if (wr == 1) PG8_BAR;
    PG8_WAIT_V(4); PG8_BAR;
    PG8_STAGE(PG8_SB(1, 0), cB + kstep, voffB); PG8_STAGE(PG8_SA(1, 0), cA + kstep, voffA); PG8_STAGE(PG8_SB(1, 1), cB + hstepB + kstep, voffB);
    PG8_WAIT_V(6); PG8_BAR;
    PG8_STAMP();
    for (;;) {
        const bool has_next = S.next(ui + 1, nxt);
        const char* nA = has_next ? (const char*)g.A + (size_t)nxt.pm * tstepA : cA; const char* nB = has_next ? (const char*)g.Bt + (size_t)nxt.pn * tstepB : cB;
        for (int t = 0; t < nt; t += 2) {
            const bool last = (t == nt - 2);
            const char* a1 = cA + (size_t)(t + 1) * kstep;
            const char* a2 = last ? nA : cA + (size_t)(t + 2) * kstep; const char* b2 = last ? nB : cB + (size_t)(t + 2) * kstep;
            const char* a3 = a2 + kstep; const char* b3 = b2 + kstep;
            if (last && has_next) S.a_ready(nxt);
            E.khook(t, acc, wr, fr);
            PG8_LDB(B0, 0, 0); PG8_SCHED; PG8_LDA(At, 0, 0); PG8_STAGE(PG8_SA(1, 1), a1 + hstepA, voffA);
            PG8_WAIT_L(8); PG8_BAR; PG8_WAIT_L(0); PG8_MMA(0, 0, At, B0); PG8_BAR; PG8_SCHED;
            PG8_LDB(B1, 0, 1); PG8_STAGE(PG8_SB(0, 0), b2, voffB);
            PG8_BAR; PG8_WAIT_L(0); PG8_MMA(0, 1, At, B1); PG8_BAR;
            PG8_LDA(At, 0, 1); PG8_STAGE(PG8_SA(0, 0), a2, voffA);
            PG8_BAR; PG8_WAIT_L(0); PG8_MMA(1, 0, At, B0); PG8_BAR; PG8_SCHED;
            PG8_STAGE(PG8_SB(0, 1), b2 + hstepB, voffB);
            PG8_WAIT_V(6); PG8_BAR; PG8_MMA(1, 1, At, B1); PG8_BAR;
            PG8_LDB(B0, 1, 0); PG8_SCHED; PG8_LDA(At, 1, 0); PG8_STAGE(PG8_SA(0, 1), a2 + hstepA, voffA);
            PG8_WAIT_L(8); PG8_BAR; PG8_WAIT_L(0); PG8_MMA(0, 0, At, B0); PG8_BAR; PG8_SCHED;
            PG8_LDB(B1, 1, 1); PG8_STAGE(PG8_SB(1, 0), b3, voffB);
            PG8_BAR; PG8_WAIT_L(0); PG8_MMA(0, 1, At, B1); PG8_BAR;
            PG8_LDA(At, 1, 1); PG8_STAGE(PG8_SA(1, 0), a3, voffA);
            PG8_BAR; PG8_WAIT_L(0); PG8_MMA(1, 0, At, B0); PG8_BAR; PG8_SCHED;
            PG8_STAGE(PG8_SB(1, 1), b3 + hstepB, voffB);
            PG8_WAIT_V(6); PG8_BAR; PG8_MMA(1, 1, At, B1); PG8_BAR;
        }
        PG8_STAMP();
        if constexpr (!Epi::AFTER_DRAIN) { E(acc, cur, wr, wc, fr, fq); S.done(cur); }
        PG8_STAMP();
        if (!has_next) break;
#pragma unroll
        for (int a = 0; a < 2; ++a)
#pragma unroll
            for (int b = 0; b < 2; ++b)
#pragma unroll
                for (int m = 0; m < 4; ++m)
#pragma unroll
                    for (int n = 0; n < 2; ++n) acc[a][b][m][n] = (f32x4){0.f, 0.f, 0.f, 0.f};
        cur = nxt; cA = nA; cB = nB; ++ui;
    }
    PG8_WAIT_V(0);
    if (wr == 0) PG8_BAR;
    PG8_BAR;
    if constexpr (Epi::AFTER_DRAIN) { E.fused(acc, cur, wr, wc, fr, fq, lds, wid, lane); S.done(cur); }
    PG8_STAMP();
    if (STAMP && wid == 0) { stamps[lane] = lane < nts ? (((unsigned long long)(unsigned)ts_hi << 32) | (unsigned)ts_lo) : 0ull;
        if (lane == 62) stamps[62] = rt_entry; if (lane == 63) stamps[63] = (unsigned long long)wall_clock64(); }
#undef PG8_STAMP
#undef PG8_SA
#undef PG8_SB
#undef PG8_STAGE
#undef PG8_LDA
#undef PG8_LDB
#undef PG8_MMA
#undef PG8_WAIT_V
#undef PG8_WAIT_L
#undef PG8_BAR
#undef PG8_SCHED
}
}

#define TB_LD 136
#define TF_LD 132
template <bool SCALE>
__device__ __forceinline__ void stage_bf16(const f32x16 (&acc)[2][2], const float* rsl) {
    bf16* T = (bf16*)smem;
    const int tid = opaque_tid(), w = tid >> 6, l = tid & 63, hh = l >> 5, wm = w >> 1, wn = w & 1;
#pragma unroll
    for (int i = 0; i < 2; ++i)
#pragma unroll
        for (int rr = 0; rr < 16; ++rr) {
            int row = wm * 64 + i * 32 + (rr & 3) + 8 * (rr >> 2) + 4 * hh;
            float sc = SCALE ? rsl[row] : 1.f;
#pragma unroll
            for (int j = 0; j < 2; ++j) T[row * TB_LD + wn * 64 + j * 32 + (l & 31)] = (bf16)(acc[i][j][rr] * sc);
        }
    __syncthreads();
}
template <bool SCALE>
__device__ __forceinline__ void stage_f32(const f32x16 (&acc)[2][2], const float* rsl) {
    float* T = (float*)smem;
    const int tid = opaque_tid(), w = tid >> 6, l = tid & 63, hh = l >> 5, wm = w >> 1, wn = w & 1;
#pragma unroll
    for (int i = 0; i < 2; ++i)
#pragma unroll
        for (int rr = 0; rr < 16; ++rr) {
            int row = wm * 64 + i * 32 + (rr & 3) + 8 * (rr >> 2) + 4 * hh;
            float sc = SCALE ? rsl[row] : 1.f;
#pragma unroll
            for (int j = 0; j < 2; ++j) T[row * TF_LD + wn * 64 + j * 32 + (l & 31)] = acc[i][j][rr] * sc;
        }
    __syncthreads();
}
template <typename CMAP>
__device__ __forceinline__ void store_rows_bf16(bf16* dst, int ld, int m0, CMAP cmap) {
    const bf16* T = (const bf16*)smem;
    const int tid = opaque_tid();
#pragma unroll
    for (int q = 0; q < 8; ++q) {
        int id = tid + 512 * q, row = id >> 4, ch = id & 15;
        u32x4 v = *(const u32x4*)(T + row * TB_LD + ch * 8);
        *(u32x4*)(dst + (size_t)(m0 + row) * ld + cmap(ch * 8)) = v;
    }
}
__device__ __forceinline__ void store_cols_bf16(bf16* vt, size_t crow0, int s0) {
    const unsigned short* T = (const unsigned short*)smem;
    const int tid = opaque_tid();
#pragma unroll
    for (int q = 0; q < 8; ++q) {
        int id = tid + 512 * q, c = id & 127, sg = id >> 7;
        unsigned e[8];
#pragma unroll
        for (int k = 0; k < 8; ++k) e[k] = T[(8 * sg + k) * TB_LD + c];
        u32x4 v = {e[0] | (e[1] << 16), e[2] | (e[3] << 16), e[4] | (e[5] << 16), e[6] | (e[7] << 16)};
        *(u32x4*)(vt + (crow0 + c) * SEQ + s0 + 8 * sg) = v;
    }
}
__device__ __forceinline__ void residual_store(const float* hin, float* hout, bf16* hb_out, float* gss, int m0, int n0, int nt) {
    const float* T = (const float*)smem;
    const int tid = opaque_tid(), l = tid & 63;
#pragma unroll 4
    for (int q = 0; q < 16; ++q) {
        int id = tid + 512 * q, row = id >> 5, ch = id & 31;
        f32x4 d = *(const f32x4*)(T + row * TF_LD + ch * 4);
        size_t gi = (size_t)(m0 + row) * 1024 + n0 + ch * 4;
        f32x4 h = *(const f32x4*)(hin + gi);
        f32x4 v = h + d;
        *(f32x4*)(hout + gi) = v;
        u32x2 b = {pack2(v.x, v.y), pack2(v.z, v.w)};
        *(u32x2*)(hb_out + (size_t)(m0 + row) * LDH + n0 + ch * 4) = b;
        float ss = v.x * v.x + v.y * v.y + v.z * v.z + v.w * v.w;
        ss = dpp_add<0xB1>(ss); ss = dpp_add<0x4E>(ss); ss = dpp_add<0x141>(ss); ss = dpp_add<0x140>(ss);
        ss += __shfl_xor(ss, 16);
        if ((l & 31) == 0) gss[(size_t)(m0 + row) * 8 + nt] = ss;
    }
}
struct ColAdd { int off; __device__ __forceinline__ int operator()(int c) const { return c + off; } };
struct ColHead96 { __device__ __forceinline__ int operator()(int c) const { return (c >> 6) * 96 + (c & 63); } };

struct EpiProj {
    static constexpr bool PERM = true, AFTER_DRAIN = false;
    const float* ssrow; char* ws;
    __device__ __forceinline__ void khook(int, f32x4 (&)[2][2][4][2], int, int) const {}
    __device__ __forceinline__ void operator()(const f32x4 (&acc)[2][2][4][2], const pg8::Unit& u, int wr, int wc, int fr, int fqd) const {
        asm volatile("" : "+v"(fr), "+v"(fqd));
        const int row0 = u.pm * 256 + wr * 64 + fr, lc0 = wc * 32 + 8 * fqd, pn = u.pn;
        size_t doff; int ld = 256;
        if (pn == 0) doff = OFF_FQ; else if (pn == 1) doff = OFF_FK; else if (pn == 2) doff = OFF_PART;
        else if (pn == 3) doff = OFF_SQ; else if (pn == 4) doff = OFF_SKK; else if (pn == 5) doff = OFF_PART + 8 * MBy;
        else if (pn == 6) { doff = OFF_CQ; ld = LDP; } else { doff = OFF_CKV; ld = LDC; }
        bf16* dst = (bf16*)(ws + doff);
        bf16* mk = (bf16*)(ws + OFF_MK); float* flog = (float*)(ws + OFF_FLOG); const float* cs = (const float*)(ws + OFF_CS);
#pragma unroll
        for (int ai = 0; ai < 2; ++ai)
#pragma unroll
            for (int m = 0; m < 4; ++m) {
                const int row = row0 + ai * 128 + m * 16;
                const float rs = row_rs8(ssrow, row);
#pragma unroll
                for (int bj = 0; bj < 2; ++bj) {
                    f32x4 v0 = acc[ai][bj][m][0] * rs, v1 = acc[ai][bj][m][1] * rs;
                    if (pn < 7 || bj == 0) {
                        u32x4 wv = {pack2(v0[0], v0[1]), pack2(v0[2], v0[3]), pack2(v1[0], v1[1]), pack2(v1[2], v1[3])};
                        *(u32x4*)(dst + (size_t)row * ld + bj * 128 + lc0) = wv;
                    } else if (wc == 0) {
                        const int hh = fqd >> 1, pi = 8 * (fqd & 1);
                        float vv[8] = {v0[0], v0[1], v0[2], v0[3], v1[0], v1[1], v1[2], v1[3]}, ov[8];
                        const f32x4* c4 = (const f32x4*)(cs + ((size_t)row * 16 + pi) * 2);
                        f32x4 t0 = c4[0], t1 = c4[1], t2 = c4[2], t3 = c4[3];
                        float cc[8] = {t0.x, t0.z, t1.x, t1.z, t2.x, t2.z, t3.x, t3.z}, sn[8] = {t0.y, t0.w, t1.y, t1.w, t2.y, t2.w, t3.y, t3.w};
#pragma unroll
                        for (int e = 0; e < 8; ++e) {
                            float pv = __builtin_bit_cast(float, partner32(__builtin_bit_cast(int, vv[e]), hh));
                            ov[e] = hh ? (pv * sn[e] + vv[e] * cc[e]) : (vv[e] * cc[e] - pv * sn[e]);
                        }
                        u32x4 wv = {pack2(ov[0], ov[1]), pack2(ov[2], ov[3]), pack2(ov[4], ov[5]), pack2(ov[6], ov[7])};
#pragma unroll
                        for (int h = 0; h < 4; ++h) *(u32x4*)(mk + (size_t)row * 384 + h * 96 + 64 + 8 * fqd) = wv;
                    } else if (wc == 1 && fqd == 0) {
                        *(f32x4*)(flog + (size_t)row * 4) = v0;
                    }
                }
            }
    }
};
__device__ __forceinline__ void phase_proj(const Params& P, int L, int hsel, int ss_slot) {
    char* ws = opq(P.ws);
    const float* ssrow = (const float*)(ws + OFF_SSA) + (size_t)ss_slot * TOK * 8;
    const bf16* hb = (const bf16*)(ws + (hsel ? OFF_HB1 : OFF_HB0));
    const bf16* Bt = (const bf16*)(ws + OFF_WIN) + (size_t)L * 2048 * LDH;
    pg8::Gemm g{hb, Bt, LDH, LDH, TOK, 2048, 1024};
    pg8::StaticOrder S; S.init(TOK, 2048, gridDim.x, blockIdx.x);
    EpiProj E{ssrow, ws};
    pg8::gemm_phase((PG8_LAS unsigned char*)smem, g, S, E, nullptr);
    __syncthreads();
}

template <int KW>
__device__ __forceinline__ void row_rms_to_lds(const bf16* A, int lda, int m0) {
    const int tid = opaque_tid(), row = tid >> 1, half = tid & 1;
    float ss = 0.f;
    const u32x4* p = (const u32x4*)(A + (size_t)(m0 + row) * lda + half * (KW / 2));
#pragma unroll
    for (int q = 0; q < KW / 16; ++q) {
        u32x4 v = p[q];
        float a;
        a = bflo(v.x); ss += a * a; a = bfhi(v.x); ss += a * a;
        a = bflo(v.y); ss += a * a; a = bfhi(v.y); ss += a * a;
        a = bflo(v.z); ss += a * a; a = bfhi(v.z); ss += a * a;
        a = bflo(v.w); ss += a * a; a = bfhi(v.w); ss += a * a;
    }
    ss += __shfl_xor(ss, 1);
    if (half == 0) ((float*)(smem + LDS_AUX))[row] = rsqrtf(ss * (1.f / (float)KW) + EPSF);
}

__device__ __forceinline__ void phase_mla_up(const Params& P, int L) {
    char* ws = opq(P.ws);
    const bf16* cq = (const bf16*)(ws + OFF_CQ); const bf16* ckv = (const bf16*)(ws + OFF_CKV);
    const bf16* wuq = (const bf16*)(ws + OFF_WUQ) + (size_t)L * 384 * LDP;
    const bf16* wukv = (const bf16*)(ws + OFF_WUKV) + (size_t)L * 768 * LDC;
    bf16* mq = (bf16*)(ws + OFF_MQ); bf16* mk = (bf16*)(ws + OFF_MK); bf16* mvt = (bf16*)(ws + OFF_MVT);
    const float* cs = (const float*)(ws + OFF_CS);
    const float* flog = (const float*)(ws + OFF_FLOG);
    float* cumF = (float*)(ws + OFF_CUMF);
    const int tid = opaque_tid(), w = tid >> 6, l = tid & 63, hh = l >> 5, wm = w >> 1, wn = w & 1;
    const int NQ = 64 * 3, NKV = 64 * 6, NCF = 4;
    const float* aux = (const float*)(smem + LDS_AUX);
    for (int gw = blockIdx.x * NW + w; gw < 2048; gw += gridDim.x * NW) {
        const int type = gw >> 10, bh = (gw >> 5) & 31, tb = gw & 31, b = bh >> 2, h = bh & 3;
        const bf16* src = (const bf16*)(ws + OFF_PART + (type ? 8 * MBy : 0)) + ((size_t)(b * SEQ + tb * 64 + l) * 256 + h * 64);
        unsigned short* dst = (unsigned short*)(ws + (type ? OFF_SVT : OFF_FVT)) + (size_t)bh * 64 * SEQ + tb * 64 + l;
        u32x4 rv8[8];
#pragma unroll
        for (int q = 0; q < 8; ++q) rv8[q] = ((const u32x4*)src)[q];
#pragma unroll
        for (int q = 0; q < 8; ++q) {
            dst[(size_t)(8 * q + 0) * SEQ] = (unsigned short)(rv8[q].x & 0xffffu); dst[(size_t)(8 * q + 1) * SEQ] = (unsigned short)(rv8[q].x >> 16);
            dst[(size_t)(8 * q + 2) * SEQ] = (unsigned short)(rv8[q].y & 0xffffu); dst[(size_t)(8 * q + 3) * SEQ] = (unsigned short)(rv8[q].y >> 16);
            dst[(size_t)(8 * q + 4) * SEQ] = (unsigned short)(rv8[q].z & 0xffffu); dst[(size_t)(8 * q + 5) * SEQ] = (unsigned short)(rv8[q].z >> 16);
            dst[(size_t)(8 * q + 6) * SEQ] = (unsigned short)(rv8[q].w & 0xffffu); dst[(size_t)(8 * q + 7) * SEQ] = (unsigned short)(rv8[q].w >> 16);
        }
    }
    const bool deal = (gridDim.x == 256);
    const int nslot = deal ? 4 : (NQ + NKV + NCF + (int)gridDim.x - 1) / (int)gridDim.x;
    for (int slot = 0; slot < nslot; ++slot) {
        int item;
        if (deal) {
            const int bx = blockIdx.x;
            if (bx < 192) item = (slot == 0) ? bx : (slot == 1) ? (NQ + bx) : (slot == 2 && bx < NCF) ? (NQ + NKV + bx) : -1;
            else item = (slot < 3) ? (NQ + 192 + 3 * (bx - 192) + slot) : -1;
        } else {
            item = blockIdx.x + slot * gridDim.x;
            if (item >= NQ + NKV + NCF) item = -1;
        }
        if (item < 0) continue;
        if (item < NQ) {
            int mt = item / 3, nt = item % 3;
            int m0 = mt * 256, n0 = nt * 128;
            __syncthreads();
            row_rms_to_lds<256>(cq, LDP, m0);
            f32x16 acc[2][2];
            ZERO_ACC(acc);
            gemm_core(acc, cq, LDP, wuq, LDP, 256, m0, n0, NoHook());
#pragma unroll
            for (int i = 0; i < 2; ++i)
#pragma unroll
                for (int j = 0; j < 2; ++j) {
                    int c0 = n0 + wn * 64 + j * 32;
                    int rloc = wm * 64 + i * 32 + 4 * hh;
                    bool rot = (c0 % 96) == 64;
                    int ci = l & 31, pi = ci & 15;
#pragma unroll
                    for (int rr = 0; rr < 16; ++rr) {
                        int rl = rloc + (rr & 3) + 8 * (rr >> 2);
                        float v = acc[i][j][rr] * aux[rl];
                        if (rot) {
                            float pv = __shfl_xor(v, 16);
                            float2 c_s = *(const float2*)(cs + ((size_t)(m0 + rl) * 16 + pi) * 2);
                            v = (ci < 16) ? (v * c_s.x - pv * c_s.y) : (pv * c_s.y + v * c_s.x);
                        }
                        acc[i][j][rr] = v;
                    }
                }
            stage_bf16<false>(acc, nullptr);
            store_rows_bf16(mq, 384, m0, ColAdd{n0});
        } else if (item < NQ + NKV) {
            int it2 = item - NQ;
            int mt = it2 / 6, nt = it2 % 6;
            int m0 = mt * 256, n0 = nt * 128;
            __syncthreads();
            row_rms_to_lds<128>(ckv, LDC, m0);
            f32x16 acc[2][2];
            ZERO_ACC(acc);
            gemm_core(acc, ckv, LDC, wukv, LDC, 128, m0, n0, NoHook());
            stage_bf16<true>(acc, aux);
            if (nt < 2) {
                const int nb0 = n0;
                struct CM { int n0; __device__ __forceinline__ int operator()(int c) const { int col = n0 + c; return (col >> 6) * 96 + (col & 63); } };
                store_rows_bf16(mk, 384, m0, CM{nb0});
            } else {
                store_cols_bf16(mvt, (size_t)(m0 >> 11) * 512 + (n0 - 256), m0 & 2047);
            }
        } else {
            int seq = (item - NQ - NKV) * NW + w;
            int b = seq >> 2, h = seq & 3;
            float bfv = P.b_forget[L * 4 + h];
            float vals[32];
            float run = 0.f;
#pragma unroll
            for (int i = 0; i < 32; ++i) {
                int s = l * 32 + i;
                float z = flog[((size_t)b * SEQ + s) * 4 + h] + bfv;
                run += log_sigmoid_f(z);
                vals[i] = run;
            }
            float tot = run, incl = tot;
#pragma unroll
            for (int o = 1; o < 64; o <<= 1) {
                float t = __shfl_up(incl, o);
                if (l >= o) incl += t;
            }
            float excl = incl - tot;
#pragma unroll
            for (int i = 0; i < 32; ++i) cumF[(size_t)seq * SEQ + l * 32 + i] = vals[i] + excl;
        }
    }
}

template <int MODE, int DK, int DV>
__device__ __forceinline__ void attn_item(const bf16* __restrict__ Q, int ldq, const bf16* __restrict__ Kg, int ldk,
                          const bf16* __restrict__ Vt, const float* __restrict__ cumF, bf16* __restrict__ Y,
                          float* __restrict__ ssy, int b, int h, int qb, float c1, char* lds, int fake = 0) {
    constexpr int KSTR = DK * 2 + 16;
    constexpr int VSTR = 144;
    constexpr int KBYTES = 64 * KSTR, VBYTES = DV * VSTR;
    constexpr int BUF = (KBYTES + VBYTES + 256 + 255) & ~255;
    static_assert(2 * BUF <= 65536, "lds");
    constexpr int KCH = DK / 8, KPT = (64 * KCH) / 256, VPT = (DV * 8) / 256;
    const int tid = opaque_tid() & 255, w = tid >> 6, l = tid & 63, r = l & 31, hh = l >> 5;
    const int q0 = qb * 128;
    const int qrow = q0 + 32 * w + r;
    const size_t tok = (size_t)b * SEQ + qrow;
    const int bh = b * 4 + h;
    bf16x8 qf[DK / 16];
#pragma unroll
    for (int s = 0; s < DK / 16; ++s) qf[s] = *(const bf16x8*)(Q + tok * ldq + h * DK + 16 * s + 8 * hh);
    f32x16 o[DV / 32];
    const f32x16 zero16 = {0.f, 0.f, 0.f, 0.f, 0.f, 0.f, 0.f, 0.f, 0.f, 0.f, 0.f, 0.f, 0.f, 0.f, 0.f, 0.f};
#pragma unroll
    for (int d = 0; d < DV / 32; ++d) o[d] = zero16;
    float m = -1e30f, lsum = 0.f, R = 0.f;
    bool sbdead = false;
    int* dmask = (int*)(smem + LDS_BYTES - 32);
    float Fq = 0.f;
    if (MODE == 0) Fq = cumF[(size_t)bh * SEQ + qrow] * LOG2E;
    const int nkt = (q0 + 128) >> 6;
    u32x4 kregA[KPT], vregA[VPT], kregB[KPT], vregB[VPT];
    float4 fregA = {0.f, 0.f, 0.f, 0.f}, fregB = {0.f, 0.f, 0.f, 0.f};
    auto gload = [&](int kt, u32x4 (&kreg)[KPT], u32x4 (&vreg)[VPT], float4& freg) {
#pragma unroll
        for (int i = 0; i < KPT; ++i) {
            int e = tid + 256 * i;
            int row = e / KCH, ch = e % KCH;
            kreg[i] = *(const u32x4*)(Kg + ((size_t)b * SEQ + kt * 64 + row) * ldk + h * DK + ch * 8);
        }
#pragma unroll
        for (int i = 0; i < VPT; ++i) {
            int e = tid + 256 * i;
            int row = e >> 3, ch = e & 7;
            vreg[i] = *(const u32x4*)(Vt + ((size_t)bh * DV + row) * SEQ + kt * 64 + ch * 8);
        }
        if (MODE == 0 && tid < 16) freg = *(const float4*)(cumF + (size_t)bh * SEQ + kt * 64 + tid * 4);
    };
    auto lwrite = [&](int buf, u32x4 (&kreg)[KPT], u32x4 (&vreg)[VPT], float4& freg) {
        char* base = lds + buf * BUF;
#pragma unroll
        for (int i = 0; i < KPT; ++i) {
            int e = tid + 256 * i;
            int row = e / KCH, ch = e % KCH;
            *(u32x4*)(base + row * KSTR + ch * 16) = kreg[i];
        }
#pragma unroll
        for (int i = 0; i < VPT; ++i) {
            int e = tid + 256 * i;
            int row = e >> 3, ch = e & 7;
            *(u32x4*)(base + KBYTES + row * VSTR + ch * 16) = vreg[i];
        }
        if (MODE == 0 && tid < 16) { float4 fn = {-freg.x * LOG2E, -freg.y * LOG2E, -freg.z * LOG2E, -freg.w * LOG2E}; *(float4*)(base + KBYTES + VBYTES + tid * 16) = fn; }
    };
    const int prow = (r & 0x13) | ((r & 4) << 1) | ((r & 8) >> 1);
    auto ktof = [&](int it) { return (MODE == 1) ? (nkt - 1 - it) : it; };
    gload(ktof(0), kregA, vregA, fregA);
    lwrite(0, kregA, vregA, fregA);
    constexpr bool D2 = (MODE != 2);
    if (D2 && nkt > 1) gload(ktof(1), kregB, vregB, fregB);
    __syncthreads();
    auto tile = [&](int it, u32x4 (&kn)[KPT], u32x4 (&vn)[VPT], float4& fn2, u32x4 (&kf)[KPT], u32x4 (&vf2)[VPT], float4& ff) {
        const int kt = ktof(it);
        if (!(fake & 1)) {
        if (D2) { if (it + 2 < nkt) gload(ktof(it + 2), kf, vf2, ff); }
        else { if (it + 1 < nkt) gload(ktof(it + 1), kf, vf2, ff); }
        }
        const char* base = lds + (it & 1) * BUF;
        bool active = (kt * 64) <= (q0 + 32 * w + 31);
        if (MODE == 1) {
            if (sbdead) { active = false; atomicOr(&dmask[it & 1], 1 << (opaque_tid() >> 6)); }
        }
        if (active) {
            const bool needmask = (kt * 64 + 63) >= (q0 + 32 * w);
            f32x16 s[2];
#pragma unroll
            for (int sub = 0; sub < 2; ++sub) {
                s[sub] = zero16;
#pragma unroll
                for (int ks = 0; ks < DK / 16; ++ks) {
                    bf16x8 kf = *(const bf16x8*)(base + (sub * 32 + prow) * KSTR + (2 * ks + hh) * 16);
                    s[sub] = __builtin_amdgcn_mfma_f32_32x32x16_bf16(kf, qf[ks], s[sub], 0, 0, 0);
                }
            }
            bf16x8 pf[2][2];
            if (fake & 2) {
#pragma unroll
                for (int sub = 0; sub < 2; ++sub)
#pragma unroll
                    for (int a = 0; a < 2; ++a) {
                        uint4 u;
                        u.x = pack2(s[sub][8 * a], s[sub][8 * a + 1]); u.y = pack2(s[sub][8 * a + 2], s[sub][8 * a + 3]);
                        u.z = pack2(s[sub][8 * a + 4], s[sub][8 * a + 5]); u.w = pack2(s[sub][8 * a + 6], s[sub][8 * a + 7]);
                        pf[sub][a] = __builtin_bit_cast(bf16x8, u);
                    }
                lsum = 1.f;
            } else if (MODE != 1) {
                const float* Ft = (const float*)(base + KBYTES + VBYTES);
                float mx = -INFINITY;
                float tv[2][16];
#pragma unroll
                for (int sub = 0; sub < 2; ++sub)
#pragma unroll
                    for (int a = 0; a < 2; ++a) {
                        int kofs = sub * 32 + 16 * a + 8 * hh;
                        float fk[8];
                        if (MODE == 0) {
                            float4 f0 = *(const float4*)(Ft + kofs), f1 = *(const float4*)(Ft + kofs + 4);
                            fk[0] = f0.x; fk[1] = f0.y; fk[2] = f0.z; fk[3] = f0.w; fk[4] = f1.x; fk[5] = f1.y; fk[6] = f1.z; fk[7] = f1.w;
                        }
#pragma unroll
                        for (int j = 0; j < 8; ++j) {
                            int rr = 8 * a + j;
                            float v = (MODE == 0) ? fmaf(s[sub][rr], c1, fk[j]) : s[sub][rr] * c1;
                            tv[sub][rr] = v;
                        }
                    }
                if (needmask) {
#pragma unroll
                    for (int sub = 0; sub < 2; ++sub)
#pragma unroll
                        for (int rr = 0; rr < 16; ++rr) {
                            int key = kt * 64 + sub * 32 + 16 * (rr >> 3) + 8 * hh + (rr & 7);
                            if (key > qrow) tv[sub][rr] = -INFINITY;
                        }
                }
#pragma unroll
                for (int sub = 0; sub < 2; ++sub)
#pragma unroll
                    for (int rr = 0; rr < 16; ++rr) mx = fmaxf(mx, tv[sub][rr]);
                mx = fmaxf(mx, __builtin_bit_cast(float, partner32(__builtin_bit_cast(int, mx), hh)));
                float mnew = fmaxf(m, mx);
                float rsum = 0.f;
#pragma unroll
                for (int sub = 0; sub < 2; ++sub)
#pragma unroll
                    for (int a = 0; a < 2; ++a) {
                        float pv[8];
#pragma unroll
                        for (int j = 0; j < 8; ++j) { pv[j] = fexp2(tv[sub][8 * a + j] - mnew); rsum += pv[j]; }
                        uint4 u;
                        u.x = pack2(pv[0], pv[1]); u.y = pack2(pv[2], pv[3]); u.z = pack2(pv[4], pv[5]); u.w = pack2(pv[6], pv[7]);
                        pf[sub][a] = __builtin_bit_cast(bf16x8, u);
                    }
                rsum += __builtin_bit_cast(float, partner32(__builtin_bit_cast(int, rsum), hh));
                if (__builtin_amdgcn_ballot_w64(mnew != m) != 0ull) {
                    float alpha = fexp2(m - mnew);
                    lsum *= alpha;
#pragma unroll
                    for (int d = 0; d < DV / 32; ++d) o[d] = o[d] * alpha;
                    m = mnew;
                }
                lsum += rsum;
            } else {
#pragma unroll
                for (int sb = 0; sb < 2; ++sb) {
                    const int sub = 1 - sb;
                    float lsig[16], lneg[16];
                    float A0 = 0.f, A1 = 0.f;
#pragma unroll
                    for (int rr = 0; rr < 16; ++rr) {
                        int key = kt * 64 + sub * 32 + 16 * (rr >> 3) + 8 * hh + (rr & 7);
                        bool valid = key < qrow;
                        float z = s[sub][rr] * c1;
                        float e = fexp2(-fabsf(z));
                        float l1p = flog2(1.f + e);
                        float ls = fminf(z, 0.f) - l1p;
                        float ln = valid ? (ls - z) : 0.f;
                        lsig[rr] = valid ? ls : -INFINITY;
                        lneg[rr] = ln;
                        if (rr < 8) A0 += ln; else A1 += ln;
                    }
                    float B0 = __shfl_xor(A0, 32), B1 = __shfl_xor(A1, 32);
                    float base1 = (hh == 0) ? (R + B1) : R;
                    float base0 = (hh == 0) ? (R + B1 + A1 + B0) : (R + A1 + B1);
                    float wv[16];
                    float run = base1;
#pragma unroll
                    for (int j = 7; j >= 0; --j) { wv[8 + j] = fexp2(lsig[8 + j] + run); run += lneg[8 + j]; }
                    run = base0;
#pragma unroll
                    for (int j = 7; j >= 0; --j) { wv[j] = fexp2(lsig[j] + run); run += lneg[j]; }
                    R += A0 + A1 + B0 + B1;
#pragma unroll
                    for (int a = 0; a < 2; ++a) {
                        uint4 u;
                        u.x = pack2(wv[8 * a], wv[8 * a + 1]); u.y = pack2(wv[8 * a + 2], wv[8 * a + 3]);
                        u.z = pack2(wv[8 * a + 4], wv[8 * a + 5]); u.w = pack2(wv[8 * a + 6], wv[8 * a + 7]);
                        pf[sub][a] = __builtin_bit_cast(bf16x8, u);
                    }
                }
            }
            if (MODE == 1) {
                if (__builtin_amdgcn_ballot_w64(R > -150.f) == 0ull) { sbdead = true; atomicOr(&dmask[it & 1], 1 << (opaque_tid() >> 6)); }
            }
#pragma unroll
            for (int d = 0; d < DV / 32; ++d)
#pragma unroll
                for (int sub = 0; sub < 2; ++sub)
#pragma unroll
                    for (int a = 0; a < 2; ++a) {
                        bf16x8 vf = *(const bf16x8*)(base + KBYTES + (d * 32 + r) * VSTR + (sub * 32 + 16 * a + 8 * hh) * 2);
                        o[d] = __builtin_amdgcn_mfma_f32_32x32x16_bf16(vf, pf[sub][a], o[d], 0, 0, 0);
                    }
        }
        if (!(fake & 1)) { if (it + 1 < nkt) lwrite((it + 1) & 1, kn, vn, fn2); }
        __syncthreads();
    };
    if (D2) {
        for (int it = 0; it < nkt; it += 2) {
            if (MODE == 1 && it > 0 && ((volatile int*)dmask)[(it - 1) & 1] == 0xFF) break;
            tile(it, kregB, vregB, fregB, kregA, vregA, fregA);
            if (it + 1 < nkt) {
                if (MODE == 1 && ((volatile int*)dmask)[it & 1] == 0xFF) break;
                tile(it + 1, kregA, vregA, fregA, kregB, vregB, fregB);
            }
        }
    } else {
        for (int it = 0; it < nkt; ++it) tile(it, kregA, vregA, fregA, kregA, vregA, fregA);
    }
    float inv = (MODE == 1) ? 1.f : (1.f / lsum);
    float ssq = 0.f;
#pragma unroll
    for (int d = 0; d < DV / 32; ++d)
#pragma unroll
        for (int g = 0; g < 4; ++g) {
            float v0 = o[d][4 * g] * inv, v1 = o[d][4 * g + 1] * inv, v2 = o[d][4 * g + 2] * inv, v3 = o[d][4 * g + 3] * inv;
            ssq += v0 * v0 + v1 * v1 + v2 * v2 + v3 * v3;
            uint2 u; u.x = pack2(v0, v1); u.y = pack2(v2, v3);
            *(uint2*)(Y + tok * LDH + h * DV + d * 32 + 8 * g + 4 * hh) = u;
        }
    ssq += __shfl_xor(ssq, 32);
    if (hh == 0) ssy[tok * 16 + h] = ssq;
}

__device__ __forceinline__ void phase_attn(const Params& P, int L, int rep = 0, int fake = 0) {
    char* ws = opq(P.ws);
    int* cnt = (int*)(ws + OFF_CNT) + L * 64 + rep * 16;
    int* s_item = (int*)(smem + LDS_BYTES - 16);
    const float* cumF = (const float*)(ws + OFF_CUMF);
    bf16* Y = (bf16*)(ws + (fake ? OFF_PART : OFF_Y));
    float* ssy = fake ? (float*)(ws + OFF_PART + 40 * MBy) : (float*)(ws + OFF_SSY) + (size_t)L * TOK * 16;
    const int half = opaque_tid() >> 8;
    char* lds = smem + half * 65536;
    for (;;) {
        if (opaque_tid() == 0) { int z0 = 0; asm volatile("" : "+v"(z0)); *s_item = atomicAdd(cnt, 1); s_item[-4] = z0; s_item[-3] = z0; }
        __syncthreads();
        int pair = *s_item;
        __syncthreads();
        if (pair >= 768) break;
        int item = pair * 2 + half;
        int qb, type, bh;
        if (item < 1024) { qb = 15 - (item >> 6); type = (item & 32) ? 2 : 0; bh = item & 31; }
        else { const int j2 = item - 1024; qb = 15 - (j2 >> 5); type = 1; bh = j2 & 31; }
        int b = bh >> 2, h = bh & 3;
        if (type == 0) {
            attn_item<2, 96, 128>((const bf16*)(ws + OFF_MQ), 384, (const bf16*)(ws + OFF_MK), 384, (const bf16*)(ws + OFF_MVT), cumF,
                                  Y + 512, ssy + 8, b, h, qb, 0.10206207261596577f * LOG2E, lds, fake);
        } else if (type == 1) {
            attn_item<1, 64, 64>((const bf16*)(ws + OFF_SQ), 256, (const bf16*)(ws + OFF_SKK), 256, (const bf16*)(ws + OFF_SVT), cumF,
                                 Y + 256, ssy + 4, b, h, qb, 0.125f * LOG2E, lds, fake);
        } else {
            attn_item<0, 64, 64>((const bf16*)(ws + OFF_FQ), 256, (const bf16*)(ws + OFF_FK), 256, (const bf16*)(ws + OFF_FVT), cumF,
                                 Y + 0, ssy + 0, b, h, qb, 0.125f * LOG2E, lds, fake);
        }
    }
}

__device__ __forceinline__ void rowss_flush(float (&part)[2][16], float* gss, int m0, int nt) {
    float* lss = (float*)smem;
    const int tid = opaque_tid(), w = tid >> 6, l = tid & 63, hh = l >> 5, wm = w >> 1, wn = w & 1;
#pragma unroll
    for (int i = 0; i < 2; ++i)
#pragma unroll
        for (int rr = 0; rr < 16; ++rr) {
            float v = part[i][rr];
            v = dpp_add<0xB1>(v); v = dpp_add<0x4E>(v); v = dpp_add<0x141>(v); v = dpp_add<0x140>(v);
            v += __shfl_xor(v, 16);
            if ((l & 31) == 0) lss[wn * 256 + wm * 64 + i * 32 + (rr & 3) + 8 * (rr >> 2) + 4 * hh] = v;
        }
    __syncthreads();
    if (tid < 256) gss[(size_t)(m0 + tid) * 8 + nt] = lss[tid] + lss[256 + tid];
    __syncthreads();
}

__device__ __forceinline__ float sum_fq(float v) {
    float a = v, b = v;
    asm volatile("s_nop 1\n\tv_permlane16_swap_b32 %0, %1\n\ts_nop 1" : "+v"(a), "+v"(b));
    v = a + b; a = v; b = v;
    asm volatile("s_nop 1\n\tv_permlane32_swap_b32 %0, %1\n\ts_nop 1" : "+v"(a), "+v"(b));
    return a + b;
}
template <bool SIG, bool XQ>
__device__ __forceinline__ void residual_fused(const f32x4 (&acc)[2][2][4][2], const pg8::Unit& u, int wr, int wc, int fr, int fqd,
                                               const float* rowscale  , const bf16* gate  ,
                                               const bf16* hb_in, bf16* hb_out, float* gss, unsigned char* xq = nullptr) {
    float* lss = (float*)smem;
#pragma unroll
    for (int ai = 0; ai < 2; ++ai)
#pragma unroll
        for (int m = 0; m < 4; ++m) {
            const int rl = 128 * ai + 64 * wr + 16 * m + fr, row = u.pm * 256 + rl;
            const float sc = rowscale ? rowscale[rl] : 1.f;
#pragma unroll
            for (int bj = 0; bj < 2; ++bj) {
                const int col = u.pn * 256 + 128 * bj + 32 * wc + 8 * fqd;
                const u32x4 hq = *(const u32x4*)(hb_in + (size_t)row * LDH + col);
                const f32x4 hp0 = {bflo(hq.x), bfhi(hq.x), bflo(hq.y), bfhi(hq.y)}, hp1 = {bflo(hq.z), bfhi(hq.z), bflo(hq.w), bfhi(hq.w)};
                f32x4 d0 = acc[ai][bj][m][0] * sc, d1 = acc[ai][bj][m][1] * sc;
                if (SIG) {
#pragma unroll
                    for (int e = 0; e < 4; ++e) {
                        d0[e] = __builtin_amdgcn_rcpf(1.f + fexp2(-LOG2E * d0[e]));
                        d1[e] = __builtin_amdgcn_rcpf(1.f + fexp2(-LOG2E * d1[e]));
                    }
                }
                if (gate) {
                    u32x4 gq = *(const u32x4*)(gate + (size_t)row * 1024 + col);
                    f32x4 g0 = {bflo(gq.x), bfhi(gq.x), bflo(gq.y), bfhi(gq.y)}, g1 = {bflo(gq.z), bfhi(gq.z), bflo(gq.w), bfhi(gq.w)};
                    d0 = d0 * g0; d1 = d1 * g1;
                }
                f32x4 v0 = hp0 + d0, v1 = hp1 + d1;
                u32x4 wv = {pack2(v0[0], v0[1]), pack2(v0[2], v0[3]), pack2(v1[0], v1[1]), pack2(v1[2], v1[3])};
                *(u32x4*)(hb_out + (size_t)row * LDH + col) = wv;
                if (XQ) {
                    f32x4 c0, c1;
#pragma unroll
                    for (int e = 0; e < 4; ++e) { c0[e] = __builtin_amdgcn_fmed3f(v0[e], -448.f, 448.f); c1[e] = __builtin_amdgcn_fmed3f(v1[e], -448.f, 448.f); }
                    int h0 = __builtin_amdgcn_cvt_pk_fp8_f32(c0[0], c0[1], 0, false); h0 = __builtin_amdgcn_cvt_pk_fp8_f32(c0[2], c0[3], h0, true);
                    int h1 = __builtin_amdgcn_cvt_pk_fp8_f32(c1[0], c1[1], 0, false); h1 = __builtin_amdgcn_cvt_pk_fp8_f32(c1[2], c1[3], h1, true);
                    const f32x2 b0 = __builtin_amdgcn_cvt_pk_f32_fp8(h0, false), b1 = __builtin_amdgcn_cvt_pk_f32_fp8(h0, true);
                    const f32x2 b2 = __builtin_amdgcn_cvt_pk_f32_fp8(h1, false), b3 = __builtin_amdgcn_cvt_pk_f32_fp8(h1, true);
                    int l0 = __builtin_amdgcn_cvt_pk_fp8_f32((c0[0] - b0.x) * 16.f, (c0[1] - b0.y) * 16.f, 0, false);
                    l0 = __builtin_amdgcn_cvt_pk_fp8_f32((c0[2] - b1.x) * 16.f, (c0[3] - b1.y) * 16.f, l0, true);
                    int l1 = __builtin_amdgcn_cvt_pk_fp8_f32((c1[0] - b2.x) * 16.f, (c1[1] - b2.y) * 16.f, 0, false);
                    l1 = __builtin_amdgcn_cvt_pk_fp8_f32((c1[2] - b3.x) * 16.f, (c1[3] - b3.y) * 16.f, l1, true);
                    u32x2 hh = {(unsigned)h0, (unsigned)h1}, ll = {(unsigned)l0, (unsigned)l1};
                    *(u32x2*)(xq + (size_t)row * 1024 + col) = hh;
                    *(u32x2*)(xq + 16 * MBy + (size_t)row * 1024 + col) = ll;
                }
                float ss = (v0[0] * v0[0] + v0[1] * v0[1]) + (v0[2] * v0[2] + v0[3] * v0[3]) + (v1[0] * v1[0] + v1[1] * v1[1]) + (v1[2] * v1[2] + v1[3] * v1[3]);
                ss = sum_fq(ss);
                if (fqd == 0) lss[(wc * 256 + rl) * 2 + bj] = ss;
            }
        }
    __syncthreads();
    const int tid = opaque_tid();
    if (tid < 256) {
        const int row = u.pm * 256 + tid;
#pragma unroll
        for (int bj = 0; bj < 2; ++bj)
            gss[(size_t)row * 8 + u.pn * 2 + bj] = (lss[(0 * 256 + tid) * 2 + bj] + lss[(1 * 256 + tid) * 2 + bj]) + (lss[(2 * 256 + tid) * 2 + bj] + lss[(3 * 256 + tid) * 2 + bj]);
    }
    __syncthreads();
}
struct EpiWo {
    static constexpr bool PERM = true, AFTER_DRAIN = true;
    const bf16* hb_in; bf16* hb_out; float* gss; unsigned char* xq;
    __device__ __forceinline__ void khook(int t, f32x4 (&acc)[2][2][4][2], int wr, int fr) const {
        if (t == 4 || t == 8) {
            const float* fac = (const float*)(smem + LDS_AUX) + (t == 4 ? 0 : 256);
#pragma unroll
            for (int ai = 0; ai < 2; ++ai)
#pragma unroll
                for (int m = 0; m < 4; ++m) {
                    const float f = fac[128 * ai + 64 * wr + 16 * m + fr];
#pragma unroll
                    for (int bj = 0; bj < 2; ++bj) { acc[ai][bj][m][0] *= f; acc[ai][bj][m][1] *= f; }
                }
        }
    }
    __device__ __forceinline__ void operator()(const f32x4 (&)[2][2][4][2], const pg8::Unit&, int, int, int, int) const {}
    __device__ __forceinline__ void fused(const f32x4 (&acc)[2][2][4][2], const pg8::Unit& u, int wr, int wc, int fr, int fqd, PG8_LAS unsigned char*, int, int) const {
        residual_fused<false, true>(acc, u, wr, wc, fr, fqd, (const float*)(smem + LDS_AUX) + 512, nullptr, hb_in, hb_out, gss, xq);
    }
};
__device__ __forceinline__ void phase_wo(const Params& P, int L, int hsel, int ss_slot) {
    char* ws = opq(P.ws);
    float* ss_out = (float*)(ws + OFF_SSA) + (size_t)ss_slot * TOK * 8;
    bf16* hb_out = (bf16*)(ws + (hsel ? OFF_HB1 : OFF_HB0));
    const bf16* hb_in = (const bf16*)(ws + (hsel ? OFF_HB0 : OFF_HB1));
    const bf16* Y = (const bf16*)(ws + OFF_Y);
    const bf16* Bt = (const bf16*)(ws + OFF_WO) + (size_t)L * 1024 * LDH;
    const float* ssy = (const float*)(ws + OFF_SSY) + (size_t)L * TOK * 16;
    float* aux = (float*)(smem + LDS_AUX);
    const int tid = opaque_tid();
    pg8::Gemm g{Y, Bt, LDH, LDH, TOK, 1024, 1024};
    pg8::StaticOrder S; S.init(TOK, 1024, gridDim.x, blockIdx.x);
    pg8::Unit u0;
    if (S.next(0, u0) && tid < 256) {
        int row = u0.pm * 256 + tid;
        float4 v0 = *(const float4*)(ssy + (size_t)row * 16), v1 = *(const float4*)(ssy + (size_t)row * 16 + 4), v2 = *(const float4*)(ssy + (size_t)row * 16 + 8);
        float r0 = rsqrtf(((v0.x + v0.y) + (v0.z + v0.w)) * (1.f / 256.f) + EPSF);
        float r1 = rsqrtf(((v1.x + v1.y) + (v1.z + v1.w)) * (1.f / 256.f) + EPSF);
        float r2 = rsqrtf(((v2.x + v2.y) + (v2.z + v2.w)) * (1.f / 512.f) + EPSF);
        aux[tid] = r0 / r1; aux[256 + tid] = r1 / r2; aux[512 + tid] = r2;
    }
    __syncthreads();
    EpiWo E{hb_in, hb_out, ss_out, (unsigned char*)(ws + OFF_XH)};
    pg8::gemm_phase((PG8_LAS unsigned char*)smem, g, S, E, nullptr);
    __syncthreads();
}

struct EpiPq {
    static constexpr bool PERM = true, AFTER_DRAIN = false;
    bf16* O; const float* ssrow;
    __device__ __forceinline__ void khook(int, f32x4 (&)[2][2][4][2], int, int) const {}
    __device__ __forceinline__ void operator()(const f32x4 (&acc)[2][2][4][2], const pg8::Unit& u, int wr, int wc, int fr, int fq) const {
        const int row0 = u.pm * 256 + wr * 64 + fr, col0 = u.pn * 256 + wc * 32 + 8 * fq;
#pragma unroll
        for (int ai = 0; ai < 2; ++ai)
#pragma unroll
            for (int m = 0; m < 4; ++m) {
                const int row = row0 + ai * 128 + m * 16;
                const float rs = row_rs8(ssrow, row);
                bf16* rowp = O + (size_t)row * 1024 + col0;
#pragma unroll
                for (int bj = 0; bj < 2; ++bj) {
                    f32x4 v0 = acc[ai][bj][m][0] * rs, v1 = acc[ai][bj][m][1] * rs;
                    u32x4 wv = {pack2(v0[0], v0[1]), pack2(v0[2], v0[3]), pack2(v1[0], v1[1]), pack2(v1[2], v1[3])};
                    *(u32x4*)(rowp + bj * 128) = wv;
                }
            }
    }
};
__device__ __forceinline__ void phase_pq(const Params& P, int L, int hsel, int ss_slot) {
    char* ws = opq(P.ws);
    const float* ssrow = (const float*)(ws + OFF_SSA) + (size_t)ss_slot * TOK * 8;
    const bf16* hb = (const bf16*)(ws + (hsel ? OFF_HB1 : OFF_HB0));
    const bf16* Bt = (const bf16*)(ws + OFF_WQ) + (size_t)L * 1024 * LDH;
    pg8::Gemm g{hb, Bt, LDH, LDH, TOK, 1024, 1024};
    pg8::StaticOrder S; S.init(TOK, 1024, gridDim.x, blockIdx.x);
    EpiPq E{(bf16*)(ws + OFF_PQ), ssrow};
    pg8::gemm_phase((PG8_LAS unsigned char*)smem, g, S, E, nullptr);
    __syncthreads();
}

__device__ __forceinline__ void cswap(int& a, int& b) { int mx = max(a, b), mn = min(a, b); a = mx; b = mn; }
__device__ __forceinline__ void bitonic_sort16(int (&v)[16]) {
#pragma unroll
    for (int k = 2; k <= 16; k <<= 1)
#pragma unroll
        for (int j = k >> 1; j > 0; j >>= 1)
#pragma unroll
            for (int i = 0; i < 16; ++i) {
                int q = i ^ j;
                if (q > i) {
                    if ((i & k) == 0) cswap(v[i], v[q]); else cswap(v[q], v[i]);
                }
            }
}
__device__ __forceinline__ void merge_top16(int (&Lv)[16], const int (&Rv)[16]) {
#pragma unroll
    for (int i = 0; i < 16; ++i) Lv[i] = max(Lv[i], Rv[15 - i]);
#pragma unroll
    for (int j = 8; j > 0; j >>= 1)
#pragma unroll
        for (int i = 0; i < 16; ++i) {
            int q = i ^ j;
            if (q > i) cswap(Lv[i], Lv[q]);
        }
}
__device__ __forceinline__ int f2key(float v, int low, int mask) {
    int b = __float_as_int(v);
    b ^= (b >> 31) & 0x7fffffff;
    return (b & ~mask) | low;
}
__device__ __forceinline__ float key2f(int k, int mask) {
    int b = k & ~mask;
    b ^= (b >> 31) & 0x7fffffff;
    return __int_as_float(b);
}

__device__ __forceinline__ void phase_topk(const Params& P, int L) {
    char* ws = opq(P.ws);
    const bf16* pq = (const bf16*)(ws + OFF_PQ);
    const bf16* skb = (const bf16*)(ws + OFF_SKB) + (size_t)L * 16 * 128 * 64;
    unsigned short* ids = (unsigned short*)(ws + OFF_IDS);
    float* gates = (float*)(ws + OFF_GATE);
    const int tid = opaque_tid(), w = tid >> 6, l = tid & 63, r = l & 31, hh = l >> 5;
    unsigned char* lidx = (unsigned char*)(smem + w * 1024 + r * 32);
    for (int task = blockIdx.x * NW + w; task < (TOK / 32) * 8; task += gridDim.x * NW) {
        const int t0 = (task >> 3) * 32, h = task & 7;
        int F[2][16];
#pragma unroll
        for (int p = 0; p < 2; ++p) {
            const int hp = h * 2 + p;
            f32x16 acc[4];
            const f32x16 z16 = {0.f, 0.f, 0.f, 0.f, 0.f, 0.f, 0.f, 0.f, 0.f, 0.f, 0.f, 0.f, 0.f, 0.f, 0.f, 0.f};
#pragma unroll
            for (int kt = 0; kt < 4; ++kt) acc[kt] = z16;
#pragma unroll
            for (int s4 = 0; s4 < 4; ++s4) {
                bf16x8 bfr = *(const bf16x8*)(pq + (size_t)(t0 + r) * 1024 + hp * 64 + 16 * s4 + 8 * hh);
#pragma unroll
                for (int kt = 0; kt < 4; ++kt) {
                    bf16x8 af = *(const bf16x8*)(skb + ((size_t)hp * 128 + 32 * kt + r) * 64 + 16 * s4 + 8 * hh);
                    acc[kt] = __builtin_amdgcn_mfma_f32_32x32x16_bf16(af, bfr, acc[kt], 0, 0, 0);
                }
            }
            int K0[16], K1[16], K2[16], K3[16];
#pragma unroll
            for (int rr = 0; rr < 16; ++rr) {
                const int nb = (rr & 3) + 8 * (rr >> 2) + 4 * hh;
                K0[rr] = f2key(acc[0][rr], 127 - nb, 127);
                K1[rr] = f2key(acc[1][rr], 127 - (32 + nb), 127);
                K2[rr] = f2key(acc[2][rr], 127 - (64 + nb), 127);
                K3[rr] = f2key(acc[3][rr], 127 - (96 + nb), 127);
            }
            bitonic_sort16(K0); bitonic_sort16(K1); bitonic_sort16(K2); bitonic_sort16(K3);
            merge_top16(K0, K1);
            merge_top16(K2, K3);
            merge_top16(K0, K2);
#pragma unroll
            for (int i = 0; i < 16; ++i) K1[i] = partner32(K0[i], hh);
            merge_top16(K0, K1);
#pragma unroll
            for (int i = 0; i < 16; ++i) F[p][i] = K0[i];
        }
        if (hh == 0) {
#pragma unroll
            for (int q = 0; q < 4; ++q) {
                unsigned w1 = 0, w2 = 0;
#pragma unroll
                for (int e = 0; e < 4; ++e) {
                    w1 |= (unsigned)(127 - (F[0][4 * q + e] & 127)) << (8 * e);
                    w2 |= (unsigned)(127 - (F[1][4 * q + e] & 127)) << (8 * e);
                }
                ((unsigned*)lidx)[q] = w1;
                ((unsigned*)lidx)[4 + q] = w2;
            }
        }
        {
            float s1[16], s2[16];
#pragma unroll
            for (int i = 0; i < 16; ++i) { s1[i] = key2f(F[0][i], 127); s2[i] = key2f(F[1][i], 127); }
            int Lc[16], X[16];
#pragma unroll
            for (int b2 = 0; b2 < 16; ++b2) Lc[b2] = f2key(s1[0] + s2[b2], 255 - b2, 255);
#pragma unroll
            for (int a2 = 1; a2 < 16; ++a2) X[a2 - 1] = f2key(s1[a2] + s2[0], 255 - a2 * 16, 255);
            X[15] = INT_MIN;
            merge_top16(Lc, X);
            X[0] = f2key(s1[1] + s2[1], 255 - 17, 255); X[1] = f2key(s1[1] + s2[2], 255 - 18, 255); X[2] = f2key(s1[1] + s2[3], 255 - 19, 255);
            X[3] = f2key(s1[1] + s2[4], 255 - 20, 255); X[4] = f2key(s1[1] + s2[5], 255 - 21, 255); X[5] = f2key(s1[1] + s2[6], 255 - 22, 255);
            X[6] = f2key(s1[1] + s2[7], 255 - 23, 255);
            X[7] = f2key(s1[2] + s2[1], 255 - 33, 255); X[8] = f2key(s1[2] + s2[2], 255 - 34, 255); X[9] = f2key(s1[2] + s2[3], 255 - 35, 255);
            X[10] = f2key(s1[2] + s2[4], 255 - 36, 255);
            X[11] = f2key(s1[3] + s2[1], 255 - 49, 255); X[12] = f2key(s1[3] + s2[2], 255 - 50, 255); X[13] = f2key(s1[3] + s2[3], 255 - 51, 255);
            X[14] = f2key(s1[4] + s2[1], 255 - 65, 255); X[15] = f2key(s1[4] + s2[2], 255 - 66, 255);
            bitonic_sort16(X);
            merge_top16(Lc, X);
            X[0] = f2key(s1[5] + s2[1], 255 - 81, 255);
            X[1] = f2key(s1[6] + s2[1], 255 - 97, 255);
            X[2] = f2key(s1[7] + s2[1], 255 - 113, 255);
#pragma unroll
            for (int i = 3; i < 16; ++i) X[i] = INT_MIN;
            merge_top16(Lc, X);
            if (hh == 0) {
                float mx = key2f(Lc[0], 255);
                float ev[16], sum = 0.f;
#pragma unroll
                for (int k = 0; k < 16; ++k) { ev[k] = __expf(key2f(Lc[k], 255) - mx); sum += ev[k]; }
                float inv = 1.f / sum;
                size_t ob = (size_t)(t0 + r) * 128 + h * 16;
                unsigned idw[8];
#pragma unroll
                for (int k = 0; k < 16; ++k) {
                    int cidx = 255 - (Lc[k] & 255);
                    int i1 = lidx[cidx >> 4], i2 = lidx[16 + (cidx & 15)];
                    unsigned idv = (unsigned)(i1 * 128 + i2);
                    if (k & 1) idw[k >> 1] |= idv << 16; else idw[k >> 1] = idv;
                }
                u32x4 o0 = {idw[0], idw[1], idw[2], idw[3]}, o1 = {idw[4], idw[5], idw[6], idw[7]};
                *(u32x4*)(ids + ob) = o0;
                *(u32x4*)(ids + ob + 8) = o1;
#pragma unroll
                for (int q = 0; q < 4; ++q) {
                    f32x4 g4 = {ev[4 * q] * inv, ev[4 * q + 1] * inv, ev[4 * q + 2] * inv, ev[4 * q + 3] * inv};
                    *(f32x4*)(gates + ob + 4 * q) = g4;
                }
            }
        }
    }
}

__device__ __forceinline__ float gelu_exact(float x) { return 0.5f * x * (1.f + erff(x * 0.70710678118654752f)); }

__device__ __forceinline__ void dec16(const u32x4& v, float (&f)[16]) {
    f32x2 t;
    t = __builtin_amdgcn_cvt_pk_f32_fp8((int)v.x, false); f[0] = t.x; f[1] = t.y;
    t = __builtin_amdgcn_cvt_pk_f32_fp8((int)v.x, true);  f[2] = t.x; f[3] = t.y;
    t = __builtin_amdgcn_cvt_pk_f32_fp8((int)v.y, false); f[4] = t.x; f[5] = t.y;
    t = __builtin_amdgcn_cvt_pk_f32_fp8((int)v.y, true);  f[6] = t.x; f[7] = t.y;
    t = __builtin_amdgcn_cvt_pk_f32_fp8((int)v.z, false); f[8] = t.x; f[9] = t.y;
    t = __builtin_amdgcn_cvt_pk_f32_fp8((int)v.z, true);  f[10] = t.x; f[11] = t.y;
    t = __builtin_amdgcn_cvt_pk_f32_fp8((int)v.w, false); f[12] = t.x; f[13] = t.y;
    t = __builtin_amdgcn_cvt_pk_f32_fp8((int)v.w, true);  f[14] = t.x; f[15] = t.y;
}

__device__ __forceinline__ void dec32(const u32x4& v, f32x2 (&f)[16]) {
    f[0] = __builtin_amdgcn_cvt_scalef32_pk_f32_fp4(v.x, 1.0f, 0); f[1] = __builtin_amdgcn_cvt_scalef32_pk_f32_fp4(v.x, 1.0f, 1);
    f[2] = __builtin_amdgcn_cvt_scalef32_pk_f32_fp4(v.x, 1.0f, 2); f[3] = __builtin_amdgcn_cvt_scalef32_pk_f32_fp4(v.x, 1.0f, 3);
    f[4] = __builtin_amdgcn_cvt_scalef32_pk_f32_fp4(v.y, 1.0f, 0); f[5] = __builtin_amdgcn_cvt_scalef32_pk_f32_fp4(v.y, 1.0f, 1);
    f[6] = __builtin_amdgcn_cvt_scalef32_pk_f32_fp4(v.y, 1.0f, 2); f[7] = __builtin_amdgcn_cvt_scalef32_pk_f32_fp4(v.y, 1.0f, 3);
    f[8] = __builtin_amdgcn_cvt_scalef32_pk_f32_fp4(v.z, 1.0f, 0); f[9] = __builtin_amdgcn_cvt_scalef32_pk_f32_fp4(v.z, 1.0f, 1);
    f[10] = __builtin_amdgcn_cvt_scalef32_pk_f32_fp4(v.z, 1.0f, 2); f[11] = __builtin_amdgcn_cvt_scalef32_pk_f32_fp4(v.z, 1.0f, 3);
    f[12] = __builtin_amdgcn_cvt_scalef32_pk_f32_fp4(v.w, 1.0f, 0); f[13] = __builtin_amdgcn_cvt_scalef32_pk_f32_fp4(v.w, 1.0f, 1);
    f[14] = __builtin_amdgcn_cvt_scalef32_pk_f32_fp4(v.w, 1.0f, 2); f[15] = __builtin_amdgcn_cvt_scalef32_pk_f32_fp4(v.w, 1.0f, 3);
}

typedef _Float16 f16x2 __attribute__((ext_vector_type(2)));
__device__ __forceinline__ void dec8_f16(unsigned x, f16x2 (&wv)[4]) {
    const unsigned lo = x & 0x07070707u, hi = (x >> 4) & 0x07070707u;
    const unsigned Lb = __builtin_amdgcn_perm(0x46444240u, 0x3E3C3800u, lo) | ((x & 0x08080808u) << 4);
    const unsigned Hb = __builtin_amdgcn_perm(0x46444240u, 0x3E3C3800u, hi) | (x & 0x80808080u);
    wv[0] = __builtin_bit_cast(f16x2, __builtin_amdgcn_perm(Hb, Lb, 0x040c000cu));
    wv[1] = __builtin_bit_cast(f16x2, __builtin_amdgcn_perm(Hb, Lb, 0x050c010cu));
    wv[2] = __builtin_bit_cast(f16x2, __builtin_amdgcn_perm(Hb, Lb, 0x060c020cu));
    wv[3] = __builtin_bit_cast(f16x2, __builtin_amdgcn_perm(Hb, Lb, 0x070c030cu));
}

typedef _Float16 f16x2 __attribute__((ext_vector_type(2)));
__device__ __forceinline__ void dec32h(const u32x4& v, f16x2 (&f)[16]) {
    f[0] = __builtin_amdgcn_cvt_scalef32_pk_f16_fp4(v.x, 1.0f, 0); f[1] = __builtin_amdgcn_cvt_scalef32_pk_f16_fp4(v.x, 1.0f, 1);
    f[2] = __builtin_amdgcn_cvt_scalef32_pk_f16_fp4(v.x, 1.0f, 2); f[3] = __builtin_amdgcn_cvt_scalef32_pk_f16_fp4(v.x, 1.0f, 3);
    f[4] = __builtin_amdgcn_cvt_scalef32_pk_f16_fp4(v.y, 1.0f, 0); f[5] = __builtin_amdgcn_cvt_scalef32_pk_f16_fp4(v.y, 1.0f, 1);
    f[6] = __builtin_amdgcn_cvt_scalef32_pk_f16_fp4(v.y, 1.0f, 2); f[7] = __builtin_amdgcn_cvt_scalef32_pk_f16_fp4(v.y, 1.0f, 3);
    f[8] = __builtin_amdgcn_cvt_scalef32_pk_f16_fp4(v.z, 1.0f, 0); f[9] = __builtin_amdgcn_cvt_scalef32_pk_f16_fp4(v.z, 1.0f, 1);
    f[10] = __builtin_amdgcn_cvt_scalef32_pk_f16_fp4(v.z, 1.0f, 2); f[11] = __builtin_amdgcn_cvt_scalef32_pk_f16_fp4(v.z, 1.0f, 3);
    f[12] = __builtin_amdgcn_cvt_scalef32_pk_f16_fp4(v.w, 1.0f, 0); f[13] = __builtin_amdgcn_cvt_scalef32_pk_f16_fp4(v.w, 1.0f, 1);
    f[14] = __builtin_amdgcn_cvt_scalef32_pk_f16_fp4(v.w, 1.0f, 2); f[15] = __builtin_amdgcn_cvt_scalef32_pk_f16_fp4(v.w, 1.0f, 3);
}

__device__ __forceinline__ int idof16(const u32x4 (&q)[2], int i) {
    unsigned wv = (i >> 1) == 0 ? q[0].x : (i >> 1) == 1 ? q[0].y : (i >> 1) == 2 ? q[0].z : (i >> 1) == 3 ? q[0].w
                : (i >> 1) == 4 ? q[1].x : (i >> 1) == 5 ? q[1].y : (i >> 1) == 6 ? q[1].z : q[1].w;
    return (i & 1) ? (int)(wv >> 16) : (int)(wv & 0xffffu);
}
typedef int i32x8 __attribute__((ext_vector_type(8)));
#define GU_WAIT_V(n) asm volatile("s_waitcnt vmcnt(" #n ")" ::: "memory")
#define GU_WAIT_L0() asm volatile("s_waitcnt lgkmcnt(0)" ::: "memory")
__device__ __forceinline__ void phase_gather_u(const Params& P, int L) {
    char* ws = opq(P.ws);
    const unsigned char* U4 = (const unsigned char*)(ws + OFF_UB) + (size_t)L * NEXP * 512;
    float* part = (float*)(ws + OFF_PART);
    const unsigned short* ids = (const unsigned short*)(ws + OFF_IDS);
    const int tid = opaque_tid(), w = tid >> 6, l = tid & 63, i = l & 15, g4 = l >> 4, rr = l >> 3, dc = (l & 7) ^ rr;
    const int sl = blockIdx.x & 3, par = (blockIdx.x >> 2) & 1, rk = blockIdx.x >> 3, nb = gridDim.x >> 3;
    if (rk >= nb) return;
    PG8_LAS unsigned char* wl = (PG8_LAS unsigned char*)smem + w * 16384;
    const unsigned char* ubase = U4 + (size_t)sl * NEXP * 128 + dc * 16;
    const unsigned char* xbase = (const unsigned char*)(ws + OFF_XH) + (i == 1 ? 16 * MBy : 0) + 256 * sl + 16 * g4;
    const int scb = (i == 1) ? 123 : 127;
    const unsigned a0 = 1024u * (i >> 3) + 128u * (i & 7) + 16u * (g4 ^ (i & 7)), a1 = a0 ^ 64u;
    const int stride = nb * NW;
    int ti = rk * NW + w;
    if (ti >= TOK / 2) return;
    u32x4 idA[2], idB[2];
    u32x4 xA[4], xB[4];
    auto load_ids = [&](int tt, u32x4 (&idq)[2]) {
        const unsigned short* ip = ids + (size_t)tt * 128 + 16 * rr;
        asm volatile("global_load_dwordx4 %0, %2, off\n\tglobal_load_dwordx4 %1, %2, off offset:16" : "=&v"(idq[0]), "=&v"(idq[1]) : "v"(ip));
    };
    auto load_x = [&](int tt, u32x4 (&xx)[4]) {
        const unsigned char* p = xbase + (size_t)tt * 1024;
        asm volatile("global_load_dwordx4 %0, %4, off\n\tglobal_load_dwordx4 %1, %4, off offset:64\n\t"
                     "global_load_dwordx4 %2, %4, off offset:128\n\tglobal_load_dwordx4 %3, %4, off offset:192"
                     : "=&v"(xx[0]), "=&v"(xx[1]), "=&v"(xx[2]), "=&v"(xx[3]) : "v"(p));
    };
    auto pin = [&](u32x4 (&idq)[2], u32x4 (&xx)[4]) {
        asm volatile("" : "+v"(idq[0]), "+v"(idq[1]), "+v"(xx[0]), "+v"(xx[1]), "+v"(xx[2]), "+v"(xx[3]));
    };
    auto dma_half = [&](const u32x4 (&idq)[2], int h) {
#pragma unroll
        for (int jj = 0; jj < 8; ++jj) {
            const int j = 8 * h + jj;
            __builtin_amdgcn_global_load_lds((const unsigned*)(ubase + (size_t)idof16(idq, j) * 128), (PG8_LAS unsigned*)(wl + 1024 * j), 16, 0, 0);
        }
    };
    const unsigned la0 = (unsigned)(size_t)wl + a0, la1 = (unsigned)(size_t)wl + a1;
    auto mma_half = [&](f32x4 (&acc)[8], const u32x4 (&xc)[4], int h) {
        u32x4 av[8];
        if (h == 0)
            asm volatile("ds_read_b128 %0, %8\n\tds_read_b128 %1, %9\n\tds_read_b128 %2, %8 offset:2048\n\tds_read_b128 %3, %9 offset:2048\n\t"
                         "ds_read_b128 %4, %8 offset:4096\n\tds_read_b128 %5, %9 offset:4096\n\tds_read_b128 %6, %8 offset:6144\n\tds_read_b128 %7, %9 offset:6144\n\t"
                         "s_waitcnt lgkmcnt(0)"
                         : "=&v"(av[0]), "=&v"(av[1]), "=&v"(av[2]), "=&v"(av[3]), "=&v"(av[4]), "=&v"(av[5]), "=&v"(av[6]), "=&v"(av[7]) : "v"(la0), "v"(la1));
        else
            asm volatile("ds_read_b128 %0, %8 offset:8192\n\tds_read_b128 %1, %9 offset:8192\n\tds_read_b128 %2, %8 offset:10240\n\tds_read_b128 %3, %9 offset:10240\n\t"
                         "ds_read_b128 %4, %8 offset:12288\n\tds_read_b128 %5, %9 offset:12288\n\tds_read_b128 %6, %8 offset:14336\n\tds_read_b128 %7, %9 offset:14336\n\t"
                         "s_waitcnt lgkmcnt(0)"
                         : "=&v"(av[0]), "=&v"(av[1]), "=&v"(av[2]), "=&v"(av[3]), "=&v"(av[4]), "=&v"(av[5]), "=&v"(av[6]), "=&v"(av[7]) : "v"(la0), "v"(la1));
#pragma unroll
        for (int qq = 0; qq < 4; ++qq) {
#pragma unroll
            for (int hf = 0; hf < 2; ++hf) {
                const u32x4 a = av[2 * qq + hf];
                const i32x8 A = {(int)a.x, (int)a.y, (int)a.z, (int)a.w, 0, 0, 0, 0};
                const u32x4 b0 = xc[2 * hf], b1 = xc[2 * hf + 1];
                const i32x8 B = {(int)b0.x, (int)b0.y, (int)b0.z, (int)b0.w, (int)b1.x, (int)b1.y, (int)b1.z, (int)b1.w};
                f32x4 c = {0.f, 0.f, 0.f, 0.f};
                if (hf) c = acc[4 * h + qq];
                acc[4 * h + qq] = __builtin_amdgcn_mfma_scale_f32_16x16x128_f8f6f4(A, B, c, 4, 0, 0, 127, 0, scb);
            }
        }
    };
    auto step = [&](int tcur, int tnext, int tnext2, u32x4 (&idn)[2], u32x4 (&idl)[2], u32x4 (&xc)[4], u32x4 (&xn)[4]) {
        f32x4 acc[8];
        __builtin_amdgcn_sched_barrier(0);
        GU_WAIT_V(8);
        pin(idn, xc);
        __builtin_amdgcn_sched_barrier(0);
        mma_half(acc, xc, 0);
        __builtin_amdgcn_sched_barrier(0);
        dma_half(idn, 0);
        __builtin_amdgcn_sched_barrier(0);
        load_ids(tnext2, idl);
        load_x(tnext, xn);
        __builtin_amdgcn_sched_barrier(0);
        GU_WAIT_V(14);
        __builtin_amdgcn_sched_barrier(0);
        mma_half(acc, xc, 1);
        __builtin_amdgcn_sched_barrier(0);
#pragma unroll
        for (int q = 0; q < 8; ++q)
#pragma unroll
            for (int r = 0; r < 4; ++r) acc[q][r] = dpp_add<0xB1>(acc[q][r]);
        if (i == 0) {
            float* o = part + ((size_t)sl * TOK + tcur) * 128 + 32 * g4;
#pragma unroll
            for (int r = 0; r < 4; ++r)
#pragma unroll
                for (int gh = 0; gh < 2; ++gh) {
                    f32x4 ov = {acc[4 * gh][r], acc[4 * gh + 1][r], acc[4 * gh + 2][r], acc[4 * gh + 3][r]};
                    asm volatile("global_store_dwordx4 %0, %1, off offset:%2" :: "v"(o), "v"(ov), "n"(32 * r + 16 * gh) : "memory");
                }
        }
        __builtin_amdgcn_sched_barrier(0);
        dma_half(idn, 1);
        __builtin_amdgcn_sched_barrier(0);
    };
    auto tok = [&](int tidx, int fb) { return 2 * (tidx < TOK / 2 ? tidx : fb) + par; };
    load_ids(tok(ti, ti), idA);
    __builtin_amdgcn_sched_barrier(0);
    GU_WAIT_V(0);
    asm volatile("" : "+v"(idA[0]), "+v"(idA[1]));
    __builtin_amdgcn_sched_barrier(0);
    dma_half(idA, 0);
    __builtin_amdgcn_sched_barrier(0);
    load_ids(tok(ti + stride, ti), idB);
    load_x(tok(ti, ti), xA);
    __builtin_amdgcn_sched_barrier(0);
    dma_half(idA, 1);
    __builtin_amdgcn_sched_barrier(0);
    for (;;) {
        int tn = ti + stride, tn2 = ti + 2 * stride;
        step(tok(ti, ti), tok(tn, ti), tok(tn2, ti), idB, idA, xA, xB);
        if (tn >= TOK / 2) break;
        ti = tn; tn = ti + stride; tn2 = ti + 2 * stride;
        step(tok(ti, ti), tok(tn, ti), tok(tn2, ti), idA, idB, xB, xA);
        if (tn >= TOK / 2) break;
        ti = tn;
    }
    GU_WAIT_V(0);
    asm volatile("" :: "v"(idA[0]), "v"(idA[1]), "v"(idB[0]), "v"(idB[1]), "v"(xA[0]), "v"(xA[1]), "v"(xA[2]), "v"(xA[3]), "v"(xB[0]), "v"(xB[1]), "v"(xB[2]), "v"(xB[3]));
}

__device__ __forceinline__ void phase_gather_act(const Params& P, int L, int ss_slot, int fake = 0) {
    char* ws = opq(P.ws);
    const float* ss_ffn = (const float*)(ws + OFF_SSA) + (size_t)ss_slot * TOK * 8;
    const float* part = (const float*)(ws + OFF_PART);
    const unsigned short* ids = (const unsigned short*)(ws + OFF_IDS);
    const float* gates = (const float*)(ws + OFF_GATE);
    const float* uinv = (const float*)(ws + OFF_TSC) + L * NEXP;
    const float* vinv = (const float*)(ws + OFF_TSC) + (2 + L) * NEXP;
    const int tid = opaque_tid(), w = tid >> 6, l = tid & 63;
    const int stride = gridDim.x * NW;
    for (int t0 = blockIdx.x * NW + w; t0 < TOK; t0 += 4 * stride) {
        f32x2 pa[4][4], gt[4];
        unsigned idw[4];
        f32x4 s0[4], s1[4];
#pragma unroll
        for (int q = 0; q < 4; ++q) {
            const int t = (t0 + q * stride < TOK) ? (t0 + q * stride) : t0;
#pragma unroll
            for (int j = 0; j < 4; ++j) { pa[q][j].x = part[((size_t)j * TOK + t) * 128 + l]; pa[q][j].y = part[((size_t)j * TOK + t) * 128 + 64 + l]; }
            idw[q] = *(const unsigned*)(ids + (size_t)t * 128 + 2 * l);
            gt[q] = *(const f32x2*)(gates + (size_t)t * 128 + 2 * l);
            s0[q] = *(const f32x4*)(ss_ffn + (size_t)t * 8); s1[q] = *(const f32x4*)(ss_ffn + (size_t)t * 8 + 4);
        }
        float ui[4][2], vi[4][2];
#pragma unroll
        for (int q = 0; q < 4; ++q) {
            const int i0 = (int)(idw[q] & 0xffffu), i1 = (int)(idw[q] >> 16);
            ui[q][0] = uinv[i0]; ui[q][1] = uinv[i1]; vi[q][0] = vinv[i0]; vi[q][1] = vinv[i1];
        }
#pragma unroll
        for (int q = 0; q < 4; ++q) {
            const int t = t0 + q * stride;
            if (t < TOK) {
                const float ssum = ((s0[q].x + s0[q].y) + (s0[q].z + s0[q].w)) + ((s1[q].x + s1[q].y) + (s1[q].z + s1[q].w));
                const float rs = rsqrtf(ssum * (1.f / 1024.f) + EPSF);
                f32x2 sa = (pa[q][0] + pa[q][1]) + (pa[q][2] + pa[q][3]);
                f32x2 o;
                o.x = gt[q].x * gelu_exact(sa.x * rs * ui[q][0]) * vi[q][0];
                o.y = gt[q].y * gelu_exact(sa.y * rs * ui[q][1]) * vi[q][1];
                float am = fmaxf(fabsf(o.x), fabsf(o.y));
#pragma unroll
                for (int sh = 32; sh > 0; sh >>= 1) am = fmaxf(am, __shfl_xor(am, sh));
                int ex = (int)((__builtin_bit_cast(unsigned, am) >> 23) & 0xffu) - 127;
                int e = 7 - ex; e = e > 100 ? 100 : (e < -100 ? -100 : e);
                if (!(am > 0.f)) e = 0;
                const float sc2 = __builtin_bit_cast(float, (unsigned)(127 + e) << 23);
                const float s0 = __builtin_amdgcn_fmed3f(o.x * sc2, -448.f, 448.f), s1 = __builtin_amdgcn_fmed3f(o.y * sc2, -448.f, 448.f);
                const int h8 = __builtin_amdgcn_cvt_pk_fp8_f32(s0, s1, 0, false);
                const f32x2 hb2 = __builtin_amdgcn_cvt_pk_f32_fp8(h8, false);
                const int l8 = __builtin_amdgcn_cvt_pk_fp8_f32((s0 - hb2.x) * 16.f, (s1 - hb2.y) * 16.f, 0, false);
                unsigned char* a8 = (unsigned char*)(ws + (fake ? OFF_Y : OFF_A8)) + (size_t)t * 128 + 16 * (l & 7) + (l >> 3);
                a8[0] = (unsigned char)(h8 & 0xff); a8[8] = (unsigned char)((h8 >> 8) & 0xff);
                a8[2 * MBy] = (unsigned char)(l8 & 0xff); a8[2 * MBy + 8] = (unsigned char)((l8 >> 8) & 0xff);
                if (l == 0) ((int*)(ws + (fake ? OFF_Y : OFF_A8) + 4 * MBy))[t] = e;
            }
        }
    }
}

__device__ __forceinline__ void phase_gather_v(const Params& P, int L, int hsel, int ss_slot, int fake = 0) {
    char* ws = opq(P.ws);
    float* ss_ple = fake ? (float*)(ws + OFF_FQ) : (float*)(ws + OFF_SSA) + (size_t)ss_slot * TOK * 8;
    bf16* hb_out = fake ? (bf16*)(ws + OFF_PART) : (bf16*)(ws + (hsel ? OFF_HB1 : OFF_HB0));
    const bf16* hbin = (const bf16*)(ws + (hsel ? OFF_HB0 : OFF_HB1));
    const unsigned char* V4 = (const unsigned char*)(ws + OFF_VB) + (size_t)L * NEXP * 512;
    const unsigned short* ids = (const unsigned short*)(ws + OFF_IDS);
    const int tid = opaque_tid(), w = tid >> 6, l = tid & 63, i = l & 15, g4 = l >> 4, rr = l >> 3;
    const int sl = blockIdx.x & 3, par = (blockIdx.x >> 2) & 1, rk = blockIdx.x >> 3, nb = gridDim.x >> 3;
    if (rk >= nb) return;
    PG8_LAS unsigned char* wl = (PG8_LAS unsigned char*)smem + w * 16384;
    PG8_LAS unsigned char* wo = (PG8_LAS unsigned char*)smem + 8 * 16384 + w * 1024;
    const int dc0 = (l & 7) ^ (rr >> 1);
    const unsigned char* vbase0 = V4 + (size_t)sl * NEXP * 128 + dc0 * 16;
    const unsigned char* vbase1 = V4 + (size_t)sl * NEXP * 128 + (dc0 ^ 4) * 16;
    const unsigned char* abase = (const unsigned char*)(ws + OFF_A8) + ((i & 3) == 1 ? 2 * MBy : 0) + 16 * g4;
    const int* ebase = (const int*)(ws + OFF_A8 + 4 * MBy);
    const unsigned kb = 16u * (unsigned)((i >> 1) ^ (4 * (g4 & 1)));
    const unsigned rbase = (unsigned)(size_t)wl + 128u * (unsigned)(32 * g4 + i);
    const unsigned wob = (unsigned)(size_t)wo;
    const int stride = nb * NW;
    int ti = rk * NW + w;
    if (ti >= TOK / 2) return;
    u32x4 idA[2], idB[2];
    u32x4 aA[2], aB[2];
    int eA, eB;
    u32x2 hA, hB;
    auto load_ids = [&](int tt, u32x4 (&idq)[2]) {
        const unsigned short* ip = ids + (size_t)tt * 128 + 16 * rr;
        asm volatile("global_load_dwordx4 %0, %2, off\n\tglobal_load_dwordx4 %1, %2, off offset:16" : "=&v"(idq[0]), "=&v"(idq[1]) : "v"(ip));
    };
    auto load_tok = [&](int tt, u32x4 (&ax)[2], int& ex, u32x2& hx) {
        const unsigned char* ap = abase + (size_t)tt * 128;
        const int* ep = ebase + tt;
        const bf16* hp = hbin + (size_t)tt * LDH + 256 * sl + 4 * l;
        asm volatile("global_load_dwordx4 %0, %4, off\n\tglobal_load_dwordx4 %1, %4, off offset:64\n\tglobal_load_dword %2, %5, off\n\tglobal_load_dwordx2 %3, %6, off"
                     : "=&v"(ax[0]), "=&v"(ax[1]), "=&v"(ex), "=&v"(hx) : "v"(ap), "v"(ep), "v"(hp));
    };
    auto dma_all = [&](const u32x4 (&idq)[2]) {
#pragma unroll
        for (int j = 0; j < 16; ++j) {
            const unsigned char* vb = (((j ^ (j >> 2)) & 1) ? vbase1 : vbase0);
            __builtin_amdgcn_global_load_lds((const unsigned*)(vb + (size_t)idof16(idq, j) * 128), (PG8_LAS unsigned*)(wl + 1024 * j), 16, 0, 0);
        }
    };
    u32x2 pend_h = {0u, 0u}; float pend_ss = 0.f; int pend_t = -1;
    auto step = [&](int tcur, int tnext, int tnext2, u32x4 (&idn)[2], u32x4 (&idl)[2], u32x4 (&ac)[2], int& ec, u32x2& hc, u32x4 (&an)[2], int& en, u32x2& hn) {
        __builtin_amdgcn_sched_barrier(0);
        GU_WAIT_V(0);
        asm volatile("" : "+v"(idn[0]), "+v"(idn[1]), "+v"(ac[0]), "+v"(ac[1]), "+v"(ec), "+v"(hc));
        __builtin_amdgcn_sched_barrier(0);
        u32x2 bq[16][2];
#pragma unroll
        for (int c = 0; c < 8; ++c) {
            const unsigned ad = rbase + ((16u * c) ^ kb);
            asm volatile("ds_read_b64_tr_b4 %0, %4\n\tds_read_b64_tr_b4 %1, %4 offset:2048\n\tds_read_b64_tr_b4 %2, %4 offset:8\n\tds_read_b64_tr_b4 %3, %4 offset:2056"
                         : "=&v"(bq[2 * c][0]), "=&v"(bq[2 * c][1]), "=&v"(bq[2 * c + 1][0]), "=&v"(bq[2 * c + 1][1]) : "v"(ad));
        }
        asm volatile("s_waitcnt lgkmcnt(0)" ::: "memory");
#pragma unroll
        for (int c = 0; c < 16; ++c) asm volatile("" : "+v"(bq[c][0]), "+v"(bq[c][1]));
        __builtin_amdgcn_sched_barrier(0);
        if (pend_t >= 0) {
            bf16* op = hb_out + (size_t)pend_t * LDH + 256 * sl + 4 * l;
            asm volatile("global_store_dwordx2 %0, %1, off" :: "v"(op), "v"(pend_h) : "memory");
            if (l == 0) {
                float* sp = ss_ple + (size_t)pend_t * 8 + sl;
                const float zf = 0.f;
                asm volatile("global_store_dword %0, %1, off\n\tglobal_store_dword %0, %2, off offset:16" :: "v"(sp), "v"(pend_ss), "v"(zf) : "memory");
            }
        }
        __builtin_amdgcn_sched_barrier(0);
        dma_all(idn);
        __builtin_amdgcn_sched_barrier(0);
        load_ids(tnext2, idl);
        load_tok(tnext, an, en, hn);
        __builtin_amdgcn_sched_barrier(0);
        const int sca = 127 - ec - (((i & 3) == 1) ? 4 : 0);
        const i32x8 A = {(int)ac[0].x, (int)ac[0].y, (int)ac[0].z, (int)ac[0].w, (int)ac[1].x, (int)ac[1].y, (int)ac[1].z, (int)ac[1].w};
        f32x4 acc[16];
#pragma unroll
        for (int cb = 0; cb < 16; ++cb) {
            const i32x8 B = {(int)bq[cb][0].x, (int)bq[cb][0].y, (int)bq[cb][1].x, (int)bq[cb][1].y, 0, 0, 0, 0};
            const f32x4 z = {0.f, 0.f, 0.f, 0.f};
            acc[cb] = __builtin_amdgcn_mfma_scale_f32_16x16x128_f8f6f4(A, B, z, 0, 4, 0, sca, 0, 127);
        }
#pragma unroll
        for (int q = 0; q < 4; ++q) {
            float v = 0.f;
#pragma unroll
            for (int g = 0; g < 4; ++g) { const float t2 = acc[4 * g + q][0] + acc[4 * g + q][1]; v = (g4 == g) ? t2 : v; }
            const unsigned wa = wob + 4u * (unsigned)(64 * g4 + 16 * q + i);
            asm volatile("ds_write_b32 %0, %1" :: "v"(wa), "v"(v) : "memory");
        }
        f32x4 ov;
        {
            const unsigned ra = wob + 16u * (unsigned)l;
            asm volatile("s_waitcnt lgkmcnt(0)\n\tds_read_b128 %0, %1\n\ts_waitcnt lgkmcnt(0)" : "=&v"(ov) : "v"(ra) : "memory");
        }
        f32x4 hv = {bflo(hc.x) + ov[0], bfhi(hc.x) + ov[1], bflo(hc.y) + ov[2], bfhi(hc.y) + ov[3]};
        pend_h.x = pack2(hv.x, hv.y); pend_h.y = pack2(hv.z, hv.w);
        float ssq = hv.x * hv.x + hv.y * hv.y + hv.z * hv.z + hv.w * hv.w;
        pend_ss = wave_sum(ssq);
        pend_t = tcur;
        __builtin_amdgcn_sched_barrier(0);
    };
    auto tok = [&](int tidx, int fb) { return 2 * (tidx < TOK / 2 ? tidx : fb) + par; };
    load_ids(tok(ti, ti), idA);
    __builtin_amdgcn_sched_barrier(0);
    GU_WAIT_V(0);
    asm volatile("" : "+v"(idA[0]), "+v"(idA[1]));
    __builtin_amdgcn_sched_barrier(0);
    dma_all(idA);
    __builtin_amdgcn_sched_barrier(0);
    load_ids(tok(ti + stride, ti), idB);
    load_tok(tok(ti, ti), aA, eA, hA);
    __builtin_amdgcn_sched_barrier(0);
    for (;;) {
        int tn = ti + stride, tn2 = ti + 2 * stride;
        step(tok(ti, ti), tok(tn, ti), tok(tn2, ti), idB, idA, aA, eA, hA, aB, eB, hB);
        if (tn >= TOK / 2) break;
        ti = tn; tn = ti + stride; tn2 = ti + 2 * stride;
        step(tok(ti, ti), tok(tn, ti), tok(tn2, ti), idA, idB, aB, eB, hB, aA, eA, hA);
        if (tn >= TOK / 2) break;
        ti = tn;
    }
    asm volatile("s_waitcnt vmcnt(0)" : "+v"(pend_t), "+v"(pend_h), "+v"(pend_ss) :: "memory");
    asm volatile("" :: "v"(idA[0]), "v"(idA[1]), "v"(idB[0]), "v"(idB[1]), "v"(aA[0]), "v"(aA[1]), "v"(aB[0]), "v"(aB[1]), "v"(eA), "v"(eB), "v"(hA), "v"(hB));
    {
        bf16* op = hb_out + (size_t)pend_t * LDH + 256 * sl + 4 * l;
        *(u32x2*)op = pend_h;
        if (l == 0) { ss_ple[(size_t)pend_t * 8 + sl] = pend_ss; ss_ple[(size_t)pend_t * 8 + 4 + sl] = 0.f; }
    }
}

struct EpiStoreBf16 {
    static constexpr bool PERM = true, AFTER_DRAIN = false;
    bf16* O;
    __device__ __forceinline__ void khook(int, f32x4 (&)[2][2][4][2], int, int) const {}
    __device__ __forceinline__ void operator()(const f32x4 (&acc)[2][2][4][2], const pg8::Unit& u, int wr, int wc, int fr, int fqd) const {
        const int row0 = u.pm * 256 + wr * 64 + fr, col0 = u.pn * 256 + wc * 32 + 8 * fqd;
#pragma unroll
        for (int ai = 0; ai < 2; ++ai)
#pragma unroll
            for (int m = 0; m < 4; ++m) {
                bf16* rowp = O + (size_t)(row0 + ai * 128 + m * 16) * 1024 + col0;
#pragma unroll
                for (int bj = 0; bj < 2; ++bj) {
                    const f32x4 v0 = acc[ai][bj][m][0], v1 = acc[ai][bj][m][1];
                    u32x4 wv = {pack2(v0[0], v0[1]), pack2(v0[2], v0[3]), pack2(v1[0], v1[1]), pack2(v1[2], v1[3])};
                    *(u32x4*)(rowp + bj * 128) = wv;
                }
            }
    }
};
__device__ __forceinline__ void phase_pw(const Params& P) {
    char* ws = opq(P.ws);
    pg8::StaticOrder S; S.init(TOK, 1024, gridDim.x, blockIdx.x);
    for (int L = 0; L < 2; ++L) {
        pg8::Gemm g{(const bf16*)(ws + OFF_PB) + (size_t)L * TOK * LDP, (const bf16*)(ws + OFF_WP) + (size_t)L * 1024 * LDP, LDP, LDP, TOK, 1024, 256};
        EpiStoreBf16 E{(bf16*)(ws + (L ? OFF_PW1 : OFF_PW0))};
        pg8::gemm_phase((PG8_LAS unsigned char*)smem, g, S, E, nullptr);
        __syncthreads();
    }
}
struct EpiPle {
    static constexpr bool PERM = true, AFTER_DRAIN = true;
    const bf16* PW; const bf16* hb_in; bf16* hb_out; float* gss;
    __device__ __forceinline__ void khook(int, f32x4 (&)[2][2][4][2], int, int) const {}
    __device__ __forceinline__ void operator()(const f32x4 (&)[2][2][4][2], const pg8::Unit&, int, int, int, int) const {}
    __device__ __forceinline__ void fused(const f32x4 (&acc)[2][2][4][2], const pg8::Unit& u, int wr, int wc, int fr, int fqd, PG8_LAS unsigned char*, int, int) const {
        residual_fused<true, false>(acc, u, wr, wc, fr, fqd, (const float*)(smem + LDS_AUX), PW, hb_in, hb_out, gss);
    }
};
__device__ __forceinline__ void phase_ple(const Params& P, int L, int hsel, int ss_slot_in, int ss_slot_out, int fake = 0) {
    char* ws = opq(P.ws);
    const float* ss_ple = (const float*)(ws + OFF_SSA) + (size_t)ss_slot_in * TOK * 8;
    float* ss_out = (float*)(ws + OFF_SSA) + (size_t)ss_slot_out * TOK * 8;
    const bf16* hb_in = (const bf16*)(ws + (hsel ? OFF_HB1 : OFF_HB0));
    bf16* hb_out = (bf16*)(ws + (hsel ? OFF_HB0 : OFF_HB1));
    const bf16* Wg = (const bf16*)(ws + OFF_WG) + (size_t)L * 1024 * LDH;
    float* aux = (float*)(smem + LDS_AUX);
    const int tid = opaque_tid();
    pg8::Gemm g{hb_in, Wg, LDH, LDH, TOK, 1024, 1024};
    pg8::StaticOrder S; S.init(TOK, 1024, gridDim.x, blockIdx.x);
    pg8::Unit u0;
    if (S.next(0, u0) && tid < 256) aux[tid] = row_rs8(ss_ple, u0.pm * 256 + tid);
    __syncthreads();
    EpiPle E{(const bf16*)(ws + (L ? OFF_PW1 : OFF_PW0)), hb_in, fake ? (bf16*)(ws + OFF_PART) : hb_out, fake ? (float*)(ws + OFF_FQ) : ss_out};
    pg8::gemm_phase((PG8_LAS unsigned char*)smem, g, S, E, nullptr);
    __syncthreads();
}

__device__ __forceinline__ void phase_final(const Params& P, int ss_slot, int hsel) {
    char* ws = opq(P.ws);
    float* out = opq(P.out);
    const bf16* hbin = (const bf16*)(ws + (hsel ? OFF_HB1 : OFF_HB0));
    const float* ss = (const float*)(ws + OFF_SSA) + (size_t)ss_slot * TOK * 8;
    const int tid = opaque_tid(), w = tid >> 6, l = tid & 63;
    const float4* g4 = (const float4*)P.final_norm_g;
    for (int t = blockIdx.x * NW + w; t < TOK; t += gridDim.x * NW) {
        float rs = row_rs8(ss, t);
        float4* o4 = (float4*)(out + (size_t)t * 1024);
#pragma unroll
        for (int i = 0; i < 2; ++i) {
            u32x4 hq = *(const u32x4*)(hbin + (size_t)t * LDH + (i * 64 + l) * 8);
            float4 ga = g4[(i * 64 + l) * 2], gb = g4[(i * 64 + l) * 2 + 1];
            float4 va = {bflo(hq.x) * rs * ga.x, bfhi(hq.x) * rs * ga.y, bflo(hq.y) * rs * ga.z, bfhi(hq.y) * rs * ga.w};
            float4 vb = {bflo(hq.z) * rs * gb.x, bfhi(hq.z) * rs * gb.y, bflo(hq.w) * rs * gb.z, bfhi(hq.w) * rs * gb.w};
            o4[(i * 64 + l) * 2] = va; o4[(i * 64 + l) * 2 + 1] = vb;
        }
    }
}

#define XB_TMO      128
#define XB_XCNT(j)  (256  + 64 * (j))
#define XB_XSUB(j)  (1280 + 64 * (j))
#define XB_XGEN(j)  (2304 + 64 * (j))
#define XB_TOP      3328
#define XB_TOPGEN   3392
#define XCD_BAR_WORDS 3456
#define XB_SPIN_CAP (1u << 22)
__device__ __forceinline__ unsigned xb_ld(unsigned* p) { return __hip_atomic_load(p, __ATOMIC_RELAXED, __HIP_MEMORY_SCOPE_AGENT); }
__device__ __forceinline__ unsigned xb_add(unsigned* p, unsigned v) { return __hip_atomic_fetch_add(p, v, __ATOMIC_RELAXED, __HIP_MEMORY_SCOPE_AGENT); }
__device__ __forceinline__ unsigned xb_xcc_id() { return (unsigned)__builtin_amdgcn_s_getreg((3 << 11) | 20) & 0xFu; }
#define XB_SPIN(cond, bar) do { unsigned _sp = 0; while (cond) { __builtin_amdgcn_s_sleep(1); \
    if ((++_sp & 255u) == 0u) { if (xb_ld(&(bar)[XB_TMO])) break; if (_sp > XB_SPIN_CAP) { atomicAdd(&(bar)[XB_TMO], 1u); break; } } } } while (0)
#define XB_LDS_OFF (LDS_BYTES - 64)
__device__ __forceinline__ void xcd_barrier_post(const Params& P) {
    if (threadIdx.x == 0) {
        unsigned* bar = (unsigned*)(P.ws + OFF_BAR);
        volatile __attribute__((address_space(3))) unsigned* st = (volatile __attribute__((address_space(3))) unsigned*)(smem + XB_LDS_OFF);
        st[0] = 0u; st[1] = 0u;
        (void)xb_add(&bar[XB_XCNT(xb_xcc_id())], 1u);
    }
}
__device__ __forceinline__ void xcd_barrier_complete(unsigned* bar, unsigned x, unsigned& nloc, unsigned& nx) {
    const unsigned G = gridDim.x;
    unsigned sum, cnt, mine, sp = 0u;
    for (;;) {
        sum = 0u; cnt = 0u; mine = 0u;
#pragma unroll
        for (unsigned j = 0; j < 16; ++j) { const unsigned c = xb_ld(&bar[XB_XCNT(j)]); sum += c; cnt += (c > 0u) ? 1u : 0u; mine = (j == x) ? c : mine; }
        if (sum == G) break;
        __builtin_amdgcn_s_sleep(1);
        if ((++sp & 255u) == 0u) { if (xb_ld(&bar[XB_TMO])) break; if (sp > XB_SPIN_CAP) { atomicAdd(&bar[XB_TMO], 1u); break; } }
    }
    nloc = mine > 0u ? mine : 1u; nx = cnt > 0u ? cnt : 1u;
}
__device__ __forceinline__ void grid_barrier(const Params& P) {
    asm volatile("s_waitcnt vmcnt(0)" ::: "memory");
    __syncthreads();
    if (threadIdx.x == 0) {
        unsigned* bar = (unsigned*)(P.ws + OFF_BAR);
        volatile __attribute__((address_space(3))) unsigned* st = (volatile __attribute__((address_space(3))) unsigned*)(smem + XB_LDS_OFF);
        const unsigned x = xb_xcc_id();
        __builtin_amdgcn_s_waitcnt(0);
        unsigned nloc = st[0], nx = st[1];
        if (nloc == 0u) { xcd_barrier_complete(bar, x, nloc, nx); st[0] = nloc; st[1] = nx; }
        const unsigned old = xb_add(&bar[XB_XSUB(x)], 1u);
        const unsigned gen = old / nloc;
        if (old + 1u == (gen + 1u) * nloc) {
            __builtin_amdgcn_fence(__ATOMIC_RELEASE, "agent");
            asm volatile("s_waitcnt vmcnt(0)" ::: "memory");
            const unsigned og = xb_add(&bar[XB_TOP], 1u);
            const unsigned tg = og / nx;
            if (og + 1u == (tg + 1u) * nx) xb_add(&bar[XB_TOPGEN], 1u);
            else XB_SPIN(xb_ld(&bar[XB_TOPGEN]) == tg, bar);
            __builtin_amdgcn_fence(__ATOMIC_ACQUIRE, "agent");
            xb_add(&bar[XB_XGEN(x)], 1u);
            asm volatile("s_waitcnt vmcnt(0)" ::: "memory");
        } else {
            XB_SPIN(xb_ld(&bar[XB_XGEN(x)]) == gen, bar);
            __builtin_amdgcn_fence(__ATOMIC_ACQUIRE, "agent");
            asm volatile("s_waitcnt vmcnt(0)" ::: "memory");
        }
    }
    __syncthreads();
}

__global__ void __launch_bounds__(NTHR, 2) hymba_megakernel(Params P) {
    cg::grid_group grid = cg::this_grid();
    char* ws = opq(P.ws);
    xcd_barrier_post(P);
#define BAR() do { grid_barrier(P); if (DUP == 20) grid_barrier(P); } while (0)
    phase0(P);
    if (DUP == 0) { asm volatile("s_waitcnt vmcnt(0)" ::: "memory"); __syncthreads(); grid_barrier(P); phase0(P); }
    asm volatile("s_waitcnt vmcnt(0)" ::: "memory");
    __syncthreads();
    grid.sync();
    BAR();
    phase_pw(P);
    BAR();
    if (DUP == 11) { phase_pw(P); BAR(); }
    int cur = 0;
    for (int L = 0; L < 2; ++L) {
        const int ss_mix = (L == 0) ? 0 : 3, ss_ffn = 1 + L, ss_next = (L == 0) ? 3 : 4, ss_ple = 5 + L;
        phase_proj(P, L, cur, ss_mix);
        BAR();
        if (DUP == 1) { phase_proj(P, L, cur, ss_mix); BAR(); }
        phase_mla_up(P, L);
        BAR();
        if (DUP == 2) { phase_mla_up(P, L); BAR(); }
        phase_attn(P, L, 0);
        BAR();
        if (DUP == 3) { phase_attn(P, L, 1); BAR(); }
        if (DUP >= 30 && DUP < 34) { phase_attn(P, L, 1, DUP - 30); BAR(); }
        phase_wo(P, L, cur ^ 1, ss_ffn);
        BAR();
        if (DUP == 4 && L == 0) { phase_wo(P, L, cur ^ 1, ss_ffn); BAR(); }
        phase_pq(P, L, cur ^ 1, ss_ffn);
        BAR();
        if (DUP == 5) { phase_pq(P, L, cur ^ 1, ss_ffn); BAR(); }
        phase_topk(P, L);
        BAR();
        if (DUP == 6) { phase_topk(P, L); BAR(); }
        phase_gather_u(P, L);
        BAR();
        if (DUP == 7) { phase_gather_u(P, L); BAR(); }
        if (DUP == 10) { phase_gather_act(P, L, ss_ffn, 1); BAR(); }
        phase_gather_act(P, L, ss_ffn);
        BAR();
        if (DUP == 8) { phase_gather_v(P, L, cur, ss_ple, 1); BAR(); }
        phase_gather_v(P, L, cur, ss_ple);
        BAR();
        if (DUP == 9) { phase_ple(P, L, cur, ss_ple, ss_next, 1); BAR(); }
        phase_ple(P, L, cur, ss_ple, ss_next);
        BAR();
        cur ^= 1;
    }
    phase_final(P, 4, cur);
}

extern "C" void kernel_launch(void* const* d_in, const int* in_sizes, int n_in, void* d_out, int out_size, void* d_ws,
                              size_t ws_size, hipStream_t stream) {
    static int grid_blocks = 0;
    if (!grid_blocks) {
        int dev = 0, cus = 0, per_cu = 0;
        hipGetDevice(&dev);
        hipDeviceGetAttribute(&cus, hipDeviceAttributeMultiprocessorCount, dev);
        hipOccupancyMaxActiveBlocksPerMultiprocessor(&per_cu, hymba_megakernel, NTHR, 0);
        if (per_cu > 1) per_cu = 1;
        if (per_cu < 1) per_cu = 1;
        grid_blocks = cus * per_cu;
        if (ws_size < WS_END) fprintf(stderr, "workspace too small: %zu < %zu\n", ws_size, (size_t)WS_END);
    }
    Params P{};
    P.x = (const float*)d_in[0]; P.p = (const float*)d_in[1]; P.pos = (const int*)d_in[2];
    P.norm_mix_g = (const float*)d_in[3]; P.w_in = (const float*)d_in[4]; P.b_forget = (const float*)d_in[5];
    P.mla_q_norm_g = (const float*)d_in[6]; P.w_uq = (const float*)d_in[7]; P.mla_kv_norm_g = (const float*)d_in[8];
    P.w_ukv = (const float*)d_in[9]; P.mix_out_norm_g = (const float*)d_in[10]; P.w_o = (const float*)d_in[11];
    P.norm_ffn_g = (const float*)d_in[12]; P.w_query = (const float*)d_in[13]; P.sub_keys = (const float*)d_in[14];
    P.peer_u = (const float*)d_in[15]; P.peer_v = (const float*)d_in[16]; P.w_ple = (const float*)d_in[17];
    P.ple_norm_g = (const float*)d_in[18]; P.w_ple_gate = (const float*)d_in[19]; P.final_norm_g = (const float*)d_in[20];
    P.out = (float*)d_out; P.ws = (char*)d_ws;
    hipMemsetAsync((char*)d_ws + OFF_BAR, 0, 16384 + 4096, stream);
    void* args[] = {&P};
    hipError_t e = hipLaunchCooperativeKernel((void*)hymba_megakernel, dim3(grid_blocks), dim3(NTHR), args, 0, stream);
    if (e != hipSuccess) fprintf(stderr, "cooperative launch failed: %s (grid %d)\n", hipGetErrorString(e), grid_blocks);
}
```

```cpp
#include <hip/hip_runtime.h>
#include <hip/hip_cooperative_groups.h>
#include <cstdio>
#include <cstdint>
#include <math.h>
#include <climits>
namespace cg = cooperative_groups;

typedef __bf16 bf16;
typedef __bf16 bf16x8 __attribute__((ext_vector_type(8)));
typedef __bf16 bf16x4 __attribute__((ext_vector_type(4)));
typedef __bf16 bf16x2 __attribute__((ext_vector_type(2)));
typedef float f32x16 __attribute__((ext_vector_type(16)));
typedef float f32x4 __attribute__((ext_vector_type(4)));
typedef float f32x2 __attribute__((ext_vector_type(2)));
typedef unsigned u32x4 __attribute__((ext_vector_type(4)));
typedef unsigned u32x2 __attribute__((ext_vector_type(2)));

#define SEQ 2048
#define BATCH 8
#define TOK 16384
#define DM 1024
#define IN_W 1956
#define NEXP 16384
#define EPSF 1e-6f
#define LOG2E 1.4426950408889634f
#define NTHR 512
#define NW 8
#define LDS_BYTES 151808
#define STAGE_BYTES 49152
#define LDS_AUX 147456
#ifndef DUP
#define DUP -1
#endif

constexpr size_t MBy = 1ull << 20;
constexpr size_t OFF_UB = 0;
constexpr size_t OFF_VB = 16 * MBy;
constexpr size_t OFF_PART = 32 * MBy;
constexpr size_t OFF_PW1 = 96 * MBy;
#define LDH 1088
#define LDP 320
#define LDC 192
constexpr size_t OFF_WIN = 128 * MBy;
constexpr size_t OFF_WO = 137 * MBy;
constexpr size_t OFF_WQ = 142 * MBy;
constexpr size_t OFF_WG = 147 * MBy;
constexpr size_t OFF_WP = 152 * MBy;
constexpr size_t OFF_WUQ = 154 * MBy;
constexpr size_t OFF_WUKV = 155 * MBy;
constexpr size_t OFF_SKB = 156 * MBy;
constexpr size_t OFF_CS = 157 * MBy;
constexpr size_t OFF_TSC = 159 * MBy;
constexpr size_t OFF_SSA = 160 * MBy;
constexpr size_t OFF_HB0 = 164 * MBy;
constexpr size_t OFF_HB1 = 200 * MBy;
constexpr size_t OFF_FQ = 236 * MBy;
constexpr size_t OFF_FK = 244 * MBy;
constexpr size_t OFF_FVT = 252 * MBy;
constexpr size_t OFF_SQ = 260 * MBy;
constexpr size_t OFF_SKK = 268 * MBy;
constexpr size_t OFF_SVT = 276 * MBy;
constexpr size_t OFF_CQ = 284 * MBy;
constexpr size_t OFF_CKV = 295 * MBy;
constexpr size_t OFF_FLOG = 302 * MBy;
constexpr size_t OFF_CUMF = 303 * MBy;
constexpr size_t OFF_MQ = 304 * MBy;
constexpr size_t OFF_MK = 316 * MBy;
constexpr size_t OFF_MVT = 328 * MBy;
constexpr size_t OFF_Y = 344 * MBy;
constexpr size_t OFF_PQ = 380 * MBy;
constexpr size_t OFF_IDS = 412 * MBy;
constexpr size_t OFF_GATE = 420 * MBy;
constexpr size_t OFF_BAR = 428 * MBy;
constexpr size_t OFF_CNT = OFF_BAR + 16384;
constexpr size_t OFF_SSY = 429 * MBy;
constexpr size_t OFF_PB = 431 * MBy;
constexpr size_t OFF_PW0 = 452 * MBy;
constexpr size_t OFF_A8 = OFF_PQ;
constexpr size_t OFF_XH = OFF_FQ;
constexpr size_t OFF_XL = OFF_FQ + 16 * MBy;
constexpr size_t WS_END = 484 * MBy;

struct Params {
    const float* x; const float* p; const int* pos;
    const float* norm_mix_g; const float* w_in; const float* b_forget; const float* mla_q_norm_g; const float* w_uq;
    const float* mla_kv_norm_g; const float* w_ukv; const float* mix_out_norm_g; const float* w_o; const float* norm_ffn_g;
    const float* w_query; const float* sub_keys; const float* peer_u; const float* peer_v; const float* w_ple;
    const float* ple_norm_g; const float* w_ple_gate; const float* final_norm_g;
    float* out; char* ws;
};

__shared__ __attribute__((aligned(16))) char smem[LDS_BYTES];

__device__ __forceinline__ int opaque_tid() { int t = threadIdx.x; asm volatile("" : "+v"(t)); return t; }
template <typename T> __device__ __forceinline__ T* opq(T* p) { size_t z = 0; asm volatile("" : "+s"(z)); return (T*)((char*)p + z); }

__device__ __forceinline__ unsigned pack2(float a, float b) {
    f32x2 v = {a, b};
    bf16x2 r = __builtin_convertvector(v, bf16x2);
    return __builtin_bit_cast(unsigned, r);
}
__device__ __forceinline__ float bflo(unsigned u) { return __uint_as_float(u << 16); }
__device__ __forceinline__ float bfhi(unsigned u) { return __uint_as_float(u & 0xffff0000u); }
__device__ __forceinline__ float4 ntload4(const float4* p) {
    const f32x4 t = __builtin_nontemporal_load((const f32x4*)p);
    return make_float4(t.x, t.y, t.z, t.w);
}
__device__ __forceinline__ float wave_sum(float v) {
#pragma unroll
    for (int o = 32; o > 0; o >>= 1) v += __shfl_xor(v, o);
    return v;
}
template <int CTRL> __device__ __forceinline__ float dpp_add(float v) {
    return v + __builtin_bit_cast(float, __builtin_amdgcn_update_dpp(0, __builtin_bit_cast(int, v), CTRL, 0xf, 0xf, true));
}
__device__ __forceinline__ float sum8_dpp(float v) { v = dpp_add<0xB1>(v); v = dpp_add<0x4E>(v); v = dpp_add<0x141>(v); return v; }
__device__ __forceinline__ float sumg_dpp(float v) {
    v = dpp_add<0x128>(v);
    float a = v, b = v;
    asm volatile("s_nop 1\n\tv_permlane16_swap_b32 %0, %1\n\ts_nop 1" : "+v"(a), "+v"(b));
    v = a + b;
    a = v; b = v;
    asm volatile("s_nop 1\n\tv_permlane32_swap_b32 %0, %1\n\ts_nop 1" : "+v"(a), "+v"(b));
    return a + b;
}
template <int CTRL> __device__ __forceinline__ float dpp_max0(float v) {
    return fmaxf(v, __builtin_bit_cast(float, __builtin_amdgcn_update_dpp(0, __builtin_bit_cast(int, v), CTRL, 0xf, 0xf, true)));
}
__device__ __forceinline__ float wave_max0(float v) {
    v = dpp_max0<0xB1>(v); v = dpp_max0<0x4E>(v); v = dpp_max0<0x141>(v); v = dpp_max0<0x140>(v);
    float a = v, b = v;
    asm volatile("s_nop 1\n\tv_permlane16_swap_b32 %0, %1\n\ts_nop 1" : "+v"(a), "+v"(b));
    v = fmaxf(a, b); a = v; b = v;
    asm volatile("s_nop 1\n\tv_permlane32_swap_b32 %0, %1\n\ts_nop 1" : "+v"(a), "+v"(b));
    return fmaxf(a, b);
}
__device__ __forceinline__ int partner32(int v, int hh) {
    int a = v, b = v;
    asm volatile("s_nop 1\n\tv_permlane32_swap_b32 %0, %1\n\ts_nop 1" : "+v"(a), "+v"(b));
    return hh ? a : b;
}
__device__ __forceinline__ float fexp2(float x) { return __builtin_amdgcn_exp2f(x); }
__device__ __forceinline__ float flog2(float x) { return __builtin_amdgcn_logf(x); }
__device__ __forceinline__ float log_sigmoid_f(float z) { return fminf(z, 0.f) - 0.6931471805599453f * flog2(1.f + fexp2(-1.4426950408889634f * fabsf(z))); }

struct WJob { const float* src; int lds; int K; int Np; bf16* dst; int ldd; const float* gain; int map; };

__device__ __forceinline__ int src_col_map(int map, int c) {
    if (map == 0) return c;
    if (map == 1) {
        if (c < 768) return c;
        if (c < 1952) return c + 4;
        if (c < 1956) return c - 1952 + 768;
        return -1;
    }
    if (c < 256) return 192 * (c >> 6) + (c & 63);
    int e = c - 256;
    return 192 * (e >> 7) + 64 + (e & 127);
}

__device__ __forceinline__ void wconv_group(const WJob& j, int t0, int tstride, int ntiles) {
    float* tl = (float*)smem;
    const int ktiles = j.K >> 5;
    const int tx = opaque_tid() & 31, ty = opaque_tid() >> 5;
    float v[8][2];
#pragma unroll
    for (int u = 0; u < 8; ++u) {
        const int tile = t0 + u * tstride;
        v[u][0] = 0.f; v[u][1] = 0.f;
        if (tile < ntiles) {
            const int nt = tile / ktiles, kt = tile % ktiles;
            const int sc = src_col_map(j.map, nt * 32 + tx);
            if (sc >= 0) {
#pragma unroll
                for (int i = 0; i < 2; ++i) {
                    const int k = kt * 32 + ty + 16 * i;
                    v[u][i] = __builtin_nontemporal_load(j.src + (size_t)k * j.lds + sc) * (j.gain ? j.gain[k] : 1.f);
                }
            }
        }
    }
#pragma unroll
    for (int u = 0; u < 8; ++u)
#pragma unroll
        for (int i = 0; i < 2; ++i) tl[u * 1056 + (ty + 16 * i) * 33 + tx] = v[u][i];
    __syncthreads();
#pragma unroll
    for (int u = 0; u < 8; ++u) {
        const int tile = t0 + u * tstride;
        if (tile < ntiles) {
            const int nt = tile / ktiles, kt = tile % ktiles;
#pragma unroll
            for (int i = 0; i < 2; ++i) {
                const int n = nt * 32 + ty + 16 * i;
                j.dst[(size_t)n * j.ldd + kt * 32 + tx] = (bf16)tl[u * 1056 + tx * 33 + ty + 16 * i];
            }
        }
    }
    __syncthreads();
}

__device__ __forceinline__ void phase0(const Params& P) {
    char* ws = opq(P.ws);
    const int G = gridDim.x, bid = blockIdx.x, tid = opaque_tid();
    if (DUP == 23) {
        const int w = tid >> 6, l = tid & 63;
        float4 accp = {0.f, 0.f, 0.f, 0.f};
        for (int it = (bid * NW + w) * 4; it < 4 * NEXP; it += G * NW * 4) {
            float4 v[16];
            const int tb = it >> 14, e = it & (NEXP - 1);
            const float4* src = (const float4*)((tb < 2 ? P.peer_u : P.peer_v) + ((size_t)(tb & 1) * NEXP + e) * DM) + l;
#pragma unroll
            for (int q = 0; q < 16; ++q) v[q] = ntload4(src + 64 * q);
#pragma unroll
            for (int q = 0; q < 16; ++q) { accp.x += v[q].x; accp.y += v[q].y; accp.z += v[q].z; accp.w += v[q].w; }
        }
        ((float4*)(ws + OFF_PART))[bid * NTHR + tid] = accp;
    }
    for (int rep = 0; rep < (DUP == 20 ? 2 : 1); ++rep) {
        const int w = tid >> 6, l = tid & 63;
        float* tsc = (float*)(ws + OFF_TSC);
        for (int it = (bid * NW + w) * 4; it < 4 * NEXP; it += G * NW * 4) {
            const int tb = it >> 14, e0 = it & (NEXP - 1);
            const float4* src = (const float4*)((tb < 2 ? P.peer_u : P.peer_v) + ((size_t)(tb & 1) * NEXP + e0) * DM) + l;
            unsigned char* dst = (unsigned char*)(ws + (tb < 2 ? OFF_UB : OFF_VB)) + (size_t)(tb & 1) * NEXP * 512 + (size_t)e0 * 128 + 2 * l;
            float4 v[4][4];
#pragma unroll
            for (int r = 0; r < 4; ++r)
#pragma unroll
                for (int q = 0; q < 4; ++q) v[r][q] = ntload4(src + 256 * r + 64 * q);
            if (tb < 2) {
                const float4* g4 = (const float4*)(P.norm_ffn_g + (tb & 1) * 1024) + l;
#pragma unroll
                for (int q = 0; q < 4; ++q) {
                    const float4 g = g4[64 * q];
#pragma unroll
                    for (int r = 0; r < 4; ++r) { v[r][q].x *= g.x; v[r][q].y *= g.y; v[r][q].z *= g.z; v[r][q].w *= g.w; }
                }
            }
            float am[4];
#pragma unroll
            for (int r = 0; r < 4; ++r) {
                float m = 0.f;
#pragma unroll
                for (int q = 0; q < 4; ++q) m = fmaxf(m, fmaxf(fmaxf(fabsf(v[r][q].x), fabsf(v[r][q].y)), fmaxf(fabsf(v[r][q].z), fabsf(v[r][q].w))));
                am[r] = wave_max0(m);
            }
#pragma unroll
            for (int r = 0; r < 4; ++r) {
                const float sc = (am[r] > 0.f) ? (6.0f / am[r]) : 1.f, isc = (am[r] > 0.f) ? (am[r] * (1.f / 6.0f)) : 1.f;
#pragma unroll
                for (int q = 0; q < 4; ++q) {
                    unsigned wq = 0;
                    wq = __builtin_amdgcn_cvt_scalef32_pk_fp4_f32(wq, v[r][q].x * sc, v[r][q].y * sc, 1.0f, 0);
                    wq = __builtin_amdgcn_cvt_scalef32_pk_fp4_f32(wq, v[r][q].z * sc, v[r][q].w * sc, 1.0f, 1);
                    *(unsigned short*)(dst + (size_t)q * NEXP * 128 + r * 128) = (unsigned short)(wq & 0xffffu);
                }
                if (l == 0) tsc[tb * NEXP + e0 + r] = isc;
            }
        }
    }
    if (DUP == 22) {
        const int w = tid >> 6, l = tid & 63;
        float4 accp = {0.f, 0.f, 0.f, 0.f};
        for (int it = (bid * NW + w) * 4; it < 4 * NEXP; it += G * NW * 4) {
            float4 v[16];
#pragma unroll
            for (int r = 0; r < 4; ++r) {
                const int tb = (it + r) >> 14, e = (it + r) & (NEXP - 1);
                const float4* src = (const float4*)((tb < 2 ? P.peer_u : P.peer_v) + ((size_t)(tb & 1) * NEXP + e) * DM) + l;
#pragma unroll
                for (int q = 0; q < 4; ++q) v[4 * r + q] = src[64 * q];
            }
#pragma unroll
            for (int q = 0; q < 16; ++q) { accp.x += v[q].x; accp.y += v[q].y; accp.z += v[q].z; accp.w += v[q].w; }
        }
        ((float4*)(ws + OFF_PART))[bid * NTHR + tid] = accp;
    }
    for (int rep = 0; rep < (DUP == 21 ? 2 : 1); ++rep) {
        for (int L = 0; L < 2; ++L) {
            WJob jobs[7];
            jobs[0] = {P.w_in + (size_t)L * 1024 * IN_W, IN_W, 1024, 2048, (bf16*)(ws + OFF_WIN) + (size_t)L * 2048 * LDH, LDH, P.norm_mix_g + L * 1024, 1};
            jobs[1] = {P.w_o + (size_t)L * 1024 * 1024, 1024, 1024, 1024, (bf16*)(ws + OFF_WO) + (size_t)L * 1024 * LDH, LDH, P.mix_out_norm_g + L * 1024, 0};
            jobs[2] = {P.w_query + (size_t)L * 1024 * 1024, 1024, 1024, 1024, (bf16*)(ws + OFF_WQ) + (size_t)L * 1024 * LDH, LDH, P.norm_ffn_g + L * 1024, 0};
            jobs[3] = {P.w_ple_gate + (size_t)L * 1024 * 1024, 1024, 1024, 1024, (bf16*)(ws + OFF_WG) + (size_t)L * 1024 * LDH, LDH, P.ple_norm_g + L * 1024, 0};
            jobs[4] = {P.w_ple + (size_t)L * 256 * 1024, 1024, 256, 1024, (bf16*)(ws + OFF_WP) + (size_t)L * 1024 * LDP, LDP, nullptr, 0};
            jobs[5] = {P.w_uq + (size_t)L * 256 * 384, 384, 256, 384, (bf16*)(ws + OFF_WUQ) + (size_t)L * 384 * LDP, LDP, P.mla_q_norm_g + L * 256, 0};
            jobs[6] = {P.w_ukv + (size_t)L * 128 * 768, 768, 128, 768, (bf16*)(ws + OFF_WUKV) + (size_t)L * 768 * LDC, LDC, P.mla_kv_norm_g + L * 128, 2};
#pragma unroll
            for (int q = 0; q < 7; ++q) {
                int nt = (jobs[q].Np >> 5) * (jobs[q].K >> 5);
                for (int it = bid; it < nt; it += 8 * G) wconv_group(jobs[q], it, G, nt);
            }
        }
    }
    {
        const float* src = P.sub_keys;
        bf16* dst = (bf16*)(ws + OFF_SKB);
        for (int i = bid * NTHR + tid; i < 262144 / 2; i += G * NTHR) {
            float2 v = ((const float2*)src)[i];
            ((unsigned*)dst)[i] = pack2(v.x, v.y);
        }
    }
    {
        const float4* src = (const float4*)P.p;
        bf16* dst = (bf16*)(ws + OFF_PB);
        for (int i0 = bid * NTHR + tid; i0 < 2 * TOK * 256 / 4; i0 += 4 * G * NTHR) {
            float4 a[4];
#pragma unroll
            for (int u = 0; u < 4; ++u) a[u] = ntload4(src + ((i0 + u * G * NTHR < 2 * TOK * 64) ? (i0 + u * G * NTHR) : i0));
#pragma unroll
            for (int u = 0; u < 4; ++u) {
                const int i = i0 + u * G * NTHR;
                if (i >= 2 * TOK * 64) break;
                u32x2 o = {pack2(a[u].x, a[u].y), pack2(a[u].z, a[u].w)};
                *(u32x2*)(dst + (size_t)(i >> 6) * LDP + (i & 63) * 4) = o;
            }
        }
    }
    {
        bf16* hb = (bf16*)(ws + OFF_HB0);
        float* ss0 = (float*)(ws + OFF_SSA);
        int w = tid >> 6, l = tid & 63;
        for (int row0 = (bid * NW + w) * 4; row0 < TOK; row0 += G * NW * 4) {
            const float4* xr = (const float4*)(P.x + (size_t)row0 * DM) + l;
            float4 a[4][4];
#pragma unroll
            for (int r = 0; r < 4; ++r)
#pragma unroll
                for (int i = 0; i < 4; ++i) a[r][i] = ntload4(xr + 256 * r + 64 * i);
#pragma unroll
            for (int r = 0; r < 4; ++r) {
                const int row = row0 + r;
                float ss = 0.f;
#pragma unroll
                for (int i = 0; i < 4; ++i) {
                    ss += a[r][i].x * a[r][i].x + a[r][i].y * a[r][i].y + a[r][i].z * a[r][i].z + a[r][i].w * a[r][i].w;
                    u32x2 o = {pack2(a[r][i].x, a[r][i].y), pack2(a[r][i].z, a[r][i].w)};
                    ((u32x2*)(hb + (size_t)row * LDH))[i * 64 + l] = o;
                }
                ss = wave_sum(ss);
                if (l == 0) {
                    *(float4*)(ss0 + (size_t)row * 8) = make_float4(ss, 0.f, 0.f, 0.f);
                    *(float4*)(ss0 + (size_t)row * 8 + 4) = make_float4(0.f, 0.f, 0.f, 0.f);
                }
            }
        }
    }
    {
        float* cs = (float*)(ws + OFF_CS);
        for (int i = bid * NTHR + tid; i < TOK * 16; i += G * NTHR) {
            int t = i >> 4, k = i & 15;
            float inv = powf(10000.0f, -(float)k / 16.0f);
            float ang = (float)P.pos[t] * inv;
            cs[2 * i] = cosf(ang);
            cs[2 * i + 1] = sinf(ang);
        }
    }
}

struct NoHook { static constexpr bool nodma = false; __device__ __forceinline__ void operator()(int, f32x16 (&)[2][2]) const {} };
struct NoDmaHook { static constexpr bool nodma = true; __device__ __forceinline__ void operator()(int, f32x16 (&)[2][2]) const {} };
template <typename HOOK>
__device__ __forceinline__ void gemm_core(f32x16 (&acc)[2][2], const bf16* A, int lda, const bf16* Bt, int ldb, int K,
                                          int m0, int n0, HOOK hook) {
    const int tid = opaque_tid(), w = tid >> 6, l = tid & 63, r = l & 31, hh = l >> 5;
    const int wm = w >> 1, wn = w & 1;
    const int dp = (tid & 15) ^ ((tid >> 4) & 15);
    const int drow = 2 * (tid >> 4) + (dp >> 3), dgc = (dp & 7) * 8;
    const bf16* asrc = A + (size_t)(m0 + drow) * lda + dgc;
    const bf16* bsrc = Bt + (size_t)(n0 + drow) * ldb + dgc;
    auto dma = [&](int buf, int k0) {
        if (HOOK::nodma) return;
        char* base = smem + buf * STAGE_BYTES + tid * 16;
#pragma unroll
        for (int i = 0; i < 4; ++i)
            __builtin_amdgcn_global_load_lds((const unsigned*)(asrc + (size_t)(64 * i) * lda + k0), (unsigned*)(base + i * 8192), 16, 0, 0);
#pragma unroll
        for (int i = 0; i < 2; ++i)
            __builtin_amdgcn_global_load_lds((const unsigned*)(bsrc + (size_t)(64 * i) * ldb + k0), (unsigned*)(base + 32768 + i * 8192), 16, 0, 0);
    };
    int offA[2], offB[2];
#pragma unroll
    for (int i = 0; i < 2; ++i) { offA[i] = ((wm * 64 + i * 32 + r) >> 1) * 256; offB[i] = 32768 + ((wn * 64 + i * 32 + r) >> 1) * 256; }
    const int pbase = ((r & 1) << 3), lx = (r >> 1) & 15;
    const int nk = K >> 6;
    const unsigned ldsbase = (unsigned)(size_t)(__attribute__((address_space(3))) char*)smem;
    auto ldfrag = [&](int stage, int s, bf16x8 (&af)[2], bf16x8 (&bfr)[2]) {
        unsigned ch = (unsigned)((((pbase | (2 * s + hh)) ^ lx) << 4)) + ldsbase + (unsigned)(stage * STAGE_BYTES);
        unsigned a0a = ch + offA[0], a1a = ch + offA[1], b0a = ch + offB[0], b1a = ch + offB[1];
        asm volatile("ds_read_b128 %0, %4\n\tds_read_b128 %1, %5\n\tds_read_b128 %2, %6\n\tds_read_b128 %3, %7"
                     : "=&v"(af[0]), "=&v"(af[1]), "=&v"(bfr[0]), "=&v"(bfr[1]) : "v"(a0a), "v"(a1a), "v"(b0a), "v"(b1a) : "memory");
    };
    auto mma = [&](bf16x8 (&af)[2], bf16x8 (&bfr)[2]) {
#pragma unroll
        for (int i = 0; i < 2; ++i)
#pragma unroll
            for (int j = 0; j < 2; ++j) acc[i][j] = __builtin_amdgcn_mfma_f32_32x32x16_bf16(af[i], bfr[j], acc[i][j], 0, 0, 0);
    };
#define LGKM_WAIT(n) do { asm volatile("s_waitcnt lgkmcnt(" #n ")" ::: "memory"); __builtin_amdgcn_sched_barrier(0); } while (0)
    asm volatile("s_waitcnt vmcnt(0)" ::: "memory");
    dma(0, 0);
    dma(1, 64);
    if (nk > 2) { dma(2, 128); asm volatile("s_waitcnt vmcnt(12)" ::: "memory"); }
    else asm volatile("s_waitcnt vmcnt(6)" ::: "memory");
    __builtin_amdgcn_s_barrier();
    bf16x8 a0[2], b0[2], a1[2], b1[2];
    ldfrag(0, 0, a0, b0);
    int cur = 0;
    for (int kt = 0; kt < nk; ++kt) {
        const int nxt = (cur == 2) ? 0 : cur + 1;
        if (kt == 4 || kt == 8) { LGKM_WAIT(0); hook(kt, acc); }
        ldfrag(cur, 1, a1, b1);
        LGKM_WAIT(4);
        mma(a0, b0);
        ldfrag(cur, 2, a0, b0);
        LGKM_WAIT(4);
        mma(a1, b1);
        ldfrag(cur, 3, a1, b1);
        LGKM_WAIT(4);
        mma(a0, b0);
        if (kt + 1 < nk) {
            if (kt + 2 < nk) asm volatile("s_waitcnt vmcnt(6) lgkmcnt(0)" ::: "memory");
            else asm volatile("s_waitcnt vmcnt(0) lgkmcnt(0)" ::: "memory");
            __builtin_amdgcn_s_barrier();
            __builtin_amdgcn_sched_barrier(0);
            if (kt + 3 < nk) dma(cur, (kt + 3) << 6);
            ldfrag(nxt, 0, a0, b0);
        } else {
            LGKM_WAIT(0);
        }
        mma(a1, b1);
        cur = nxt;
    }
    __syncthreads();
}
__device__ __forceinline__ float row_rs8(const float* part, int row) {
    float4 a = *(const float4*)(part + (size_t)row * 8), b = *(const float4*)(part + (size_t)row * 8 + 4);
    float ss = ((a.x + a.y) + (a.z + a.w)) + ((b.x + b.y) + (b.z + b.w));
    return rsqrtf(ss * (1.f / 1024.f) + EPSF);
}
__device__ __forceinline__ bool xcd_tile(int it, int MT, int NT, int& mt, int& nt) {
    const int G = gridDim.x, bid = blockIdx.x;
    if ((G & 7) == 0 && (MT & 7) == 0) {
        const int nbx = G >> 3, q = (bid >> 3) + it * nbx, per = (MT >> 3) * NT;
        if (q >= per) return false;
        mt = (bid & 7) * (MT >> 3) + q / NT; nt = q % NT;
        return true;
    }
    const int q = bid + it * G;
    if (q >= MT * NT) return false;
    mt = q / NT; nt = q % NT;
    return true;
}
struct NoScale { __device__ __forceinline__ float operator()(int, int) const { return 1.f; } };

#define ZERO_ACC(acc)                                  \
    _Pragma("unroll") for (int _i = 0; _i < 2; ++_i)   \
    _Pragma("unroll") for (int _j = 0; _j < 2; ++_j)   \
    _Pragma("unroll") for (int _r = 0; _r < 16; ++_r) acc[_i][_j][_r] = 0.f;


namespace pg8 {
#define PG8_LAS __attribute__((address_space(3)))
typedef unsigned short bf16_t;
constexpr int BM = 256, BK = 64, HALF = 128, HTB = HALF * BK * 2  , NXCD = 8, WGM = 8;

__host__ __device__ __forceinline__ int lds_byte(int r, int c) { const int st = (r >> 4) * 2 + (c >> 5), rr = r & 15, cc = c & 31, ob = rr * 64 + cc * 2; return st * 1024 + (ob ^ (((ob >> 9) & 1) << 5)); }
__host__ __device__ __forceinline__ void stage_rc(int b, int& R, int& C) { const int st = b / 1024, sb = b % 1024, swz = sb ^ (((sb >> 9) & 1) << 5); R = (st >> 1) * 16 + swz / 64; C = (st & 1) * 32 + (swz % 64) / 2; }
__host__ __device__ __forceinline__ int perm32(int rho) { const int n = rho >> 4, i = rho & 15; return 8 * (i >> 2) + 4 * n + (i & 3); }
struct Unit { int pm, pn; };
struct Gemm { const bf16* A; const bf16* Bt; int lda, ldb, M, N, K; };
struct StaticOrder {
    int nM, nN, nwg, G, c;
    __device__ void init(int M, int N, int G_, int c_) { nM = M / BM; nN = N / BM; nwg = nM * nN; G = G_; c = c_; }
    __device__ bool next(int i, Unit& u) const {
        const long L = (long)i * G + c; if (L >= nwg) return false;
        int wgid = (int)L; { const int q = nwg / NXCD, r = nwg % NXCD, xcd = wgid % NXCD, off = wgid / NXCD; wgid = (xcd < r ? xcd * (q + 1) : r * (q + 1) + (xcd - r) * q) + off; }
        const int nig = WGM * nN, gid = wgid / nig, fm = gid * WGM, gsz = (nM - fm) < WGM ? (nM - fm) : WGM;
        u.pm = fm + ((wgid % nig) % gsz); u.pn = (wgid % nig) / gsz; return true;
    }
    __device__ __forceinline__ void a_ready(const Unit&) const {}
    __device__ __forceinline__ void done(const Unit&) const {}
};
template <class Epi, class Sched, bool STAMP = false>
__device__ __forceinline__ void gemm_phase(PG8_LAS unsigned char* lds, const Gemm g, const Sched& S, const Epi& E, unsigned long long* stamps) {
    const int tid = opaque_tid(), wid = __builtin_amdgcn_readfirstlane(tid >> 6), lane = tid & 63, wr = wid >> 2, wc = wid & 3, fr = lane & 15, fq = lane >> 4;
    const int K = g.K, nt = K / BK;
    int ts_lo = 0, ts_hi = 0, nts = 0; const unsigned long long rt_entry = STAMP ? (unsigned long long)wall_clock64() : 0ull;
#define PG8_STAMP() do { if (STAMP && wid == 0 && nts < 64) { const unsigned long long _c = (unsigned long long)clock64(); \
        ts_lo = (lane == nts) ? (int)(unsigned)_c : ts_lo; ts_hi = (lane == nts) ? (int)(unsigned)(_c >> 32) : ts_hi; ++nts; } } while (0)
    PG8_STAMP();
    unsigned voffA[2], voffB[2];
#pragma unroll
    for (int i = 0; i < 2; ++i) { int R, C; stage_rc(tid * 16 + i * 8192, R, C); const int Rb = Epi::PERM ? ((R & ~31) + perm32(R & 31)) : R;
        voffA[i] = (unsigned)(R * g.lda + C) * 2u; voffB[i] = (unsigned)(Rb * g.ldb + C) * 2u; }
    const size_t kstep = (size_t)(BK * 2);
    const size_t hstepA = (size_t)HALF * g.lda * 2, hstepB = (size_t)HALF * g.ldb * 2;
    const size_t tstepA = 2 * hstepA, tstepB = 2 * hstepB;
    const unsigned ldsw = (unsigned)wid * 1024u;
    const int aoff = lds_byte(wr * 64 + fr, fq * 8), boff = lds_byte(wc * 32 + fr, fq * 8);
#define PG8_SA(b, h) (((b) * 2 + (h)) * HTB)
#define PG8_SB(b, h) ((4 + (b) * 2 + (h)) * HTB)
#define PG8_STAGE(bufoff, gbase, voff) do { _Pragma("unroll") for (int _i = 0; _i < 2; ++_i) \
        __builtin_amdgcn_global_load_lds((const unsigned*)((const char*)(gbase) + (voff)[_i]), (PG8_LAS unsigned*)(lds + (bufoff) + ldsw + _i * 8192), 16, 0, 0); } while (0)
#define PG8_LDA(dst, b, h) do { _Pragma("unroll") for (int m = 0; m < 4; ++m) _Pragma("unroll") for (int k = 0; k < 2; ++k) dst[m][k] = *(const PG8_LAS bf16x8*)(lds + PG8_SA(b, h) + aoff + m * 2048 + k * 1024); } while (0)
#define PG8_LDB(dst, b, h) do { _Pragma("unroll") for (int n = 0; n < 2; ++n) _Pragma("unroll") for (int k = 0; k < 2; ++k) dst[n][k] = *(const PG8_LAS bf16x8*)(lds + PG8_SB(b, h) + boff + n * 2048 + k * 1024); } while (0)
#define PG8_MMA(ai, bj, At, Bt) do { __builtin_amdgcn_s_setprio(1); _Pragma("unroll") for (int m = 0; m < 4; ++m) _Pragma("unroll") for (int n = 0; n < 2; ++n) _Pragma("unroll") for (int k = 0; k < 2; ++k) \
        acc[ai][bj][m][n] = __builtin_amdgcn_mfma_f32_16x16x32_bf16(Bt[n][k], At[m][k], acc[ai][bj][m][n], 0, 0, 0); __builtin_amdgcn_s_setprio(0); } while (0)
#define PG8_WAIT_V(n) asm volatile("s_waitcnt vmcnt(" #n ")" ::: "memory")
#define PG8_WAIT_L(n) asm volatile("s_waitcnt lgkmcnt(" #n ")" ::: "memory")
#define PG8_BAR __builtin_amdgcn_s_barrier()
#define PG8_SCHED __builtin_amdgcn_sched_barrier(0)
    Unit cur, nxt; int ui = 0;
    if (!S.next(0, cur)) return;
    f32x4 acc[2][2][4][2];
#pragma unroll
    for (int a = 0; a < 2; ++a)
#pragma unroll
        for (int b = 0; b < 2; ++b)
#pragma unroll
            for (int m = 0; m < 4; ++m)
#pragma unroll
                for (int n = 0; n < 2; ++n) acc[a][b][m][n] = (f32x4){0.f, 0.f, 0.f, 0.f};
    bf16x8 At[4][2], B0[2][2], B1[2][2];
    const char* cA = (const char*)g.A + (size_t)cur.pm * tstepA; const char* cB = (const char*)g.Bt + (size_t)cur.pn * tstepB;
    S.a_ready(cur);
    PG8_STAGE(PG8_SB(0, 0), cB, voffB); PG8_STAGE(PG8_SA(0, 0), cA, voffA); PG8_STAGE(PG8_SB(0, 1), cB + hstepB, voffB); PG8_STAGE(PG8_SA(0, 1), cA + hstepA, voffA);
    if (wr == 1) PG8_BAR;
    PG8_WAIT_V(4); PG8_BAR;
    PG8_STAGE(PG8_SB(1, 0), cB + kstep, voffB); PG8_STAGE(PG8_SA(1, 0), cA + kstep, voffA); PG8_STAGE(PG8_SB(1, 1), cB + hstepB + kstep, voffB);
    PG8_WAIT_V(6); PG8_BAR;
    PG8_STAMP();
    for (;;) {
        const bool has_next = S.next(ui + 1, nxt);
        const char* nA = has_next ? (const char*)g.A + (size_t)nxt.pm * tstepA : cA; const char* nB = has_next ? (const char*)g.Bt + (size_t)nxt.pn * tstepB : cB;
        for (int t = 0; t < nt; t += 2) {
            const bool last = (t == nt - 2);
            const char* a1 = cA + (size_t)(t + 1) * kstep;
            const char* a2 = last ? nA : cA + (size_t)(t + 2) * kstep; const char* b2 = last ? nB : cB + (size_t)(t + 2) * kstep;
            const char* a3 = a2 + kstep; const char* b3 = b2 + kstep;
            if (last && has_next) S.a_ready(nxt);
            E.khook(t, acc, wr, fr);
            PG8_LDB(B0, 0, 0); PG8_SCHED; PG8_LDA(At, 0, 0); PG8_STAGE(PG8_SA(1, 1), a1 + hstepA, voffA);
            PG8_WAIT_L(8); PG8_BAR; PG8_WAIT_L(0); PG8_MMA(0, 0, At, B0); PG8_BAR; PG8_SCHED;
            PG8_LDB(B1, 0, 1); PG8_STAGE(PG8_SB(0, 0), b2, voffB);
            PG8_BAR; PG8_WAIT_L(0); PG8_MMA(0, 1, At, B1); PG8_BAR;
            PG8_LDA(At, 0, 1); PG8_STAGE(PG8_SA(0, 0), a2, voffA);
            PG8_BAR; PG8_WAIT_L(0); PG8_MMA(1, 0, At, B0); PG8_BAR; PG8_SCHED;
            PG8_STAGE(PG8_SB(0, 1), b2 + hstepB, voffB);
            PG8_WAIT_V(6); PG8_BAR; PG8_MMA(1, 1, At, B1); PG8_BAR;
            PG8_LDB(B0, 1, 0); PG8_SCHED; PG8_LDA(At, 1, 0); PG8_STAGE(PG8_SA(0, 1), a2 + hstepA, voffA);
            PG8_WAIT_L(8); PG8_BAR; PG8_WAIT_L(0); PG8_MMA(0, 0, At, B0); PG8_BAR; PG8_SCHED;
            PG8_LDB(B1, 1, 1); PG8_STAGE(PG8_SB(1, 0), b3, voffB);
            PG8_BAR; PG8_WAIT_L(0); PG8_MMA(0, 1, At, B1); PG8_BAR;
            PG8_LDA(At, 1, 1); PG8_STAGE(PG8_SA(1, 0), a3, voffA);
            PG8_BAR; PG8_WAIT_L(0); PG8_MMA(1, 0, At, B0); PG8_BAR; PG8_SCHED;
            PG8_STAGE(PG8_SB(1, 1), b3 + hstepB, voffB);
            PG8_WAIT_V(6); PG8_BAR; PG8_MMA(1, 1, At, B1); PG8_BAR;
        }
        PG8_STAMP();
        if constexpr (!Epi::AFTER_DRAIN) { E(acc, cur, wr, wc, fr, fq); S.done(cur); }
        PG8_STAMP();
        if (!has_next) break;
#pragma unroll
        for (int a = 0; a < 2; ++a)
#pragma unroll
            for (int b = 0; b < 2; ++b)
#pragma unroll
                for (int m = 0; m < 4; ++m)
#pragma unroll
                    for (int n = 0; n < 2; ++n) acc[a][b][m][n] = (f32x4){0.f, 0.f, 0.f, 0.f};
        cur = nxt; cA = nA; cB = nB; ++ui;
    }
    PG8_WAIT_V(0);
    if (wr == 0) PG8_BAR;
    PG8_BAR;
    if constexpr (Epi::AFTER_DRAIN) { E.fused(acc, cur, wr, wc, fr, fq, lds, wid, lane); S.done(cur); }
    PG8_STAMP();
    if (STAMP && wid == 0) { stamps[lane] = lane < nts ? (((unsigned long long)(unsigned)ts_hi << 32) | (unsigned)ts_lo) : 0ull;
        if (lane == 62) stamps[62] = rt_entry; if (lane == 63) stamps[63] = (unsigned long long)wall_clock64(); }
#undef PG8_STAMP
#undef PG8_SA
#undef PG8_SB
#undef PG8_STAGE
#undef PG8_LDA
#undef PG8_LDB
#undef PG8_MMA
#undef PG8_WAIT_V
#undef PG8_WAIT_L
#undef PG8_BAR
#undef PG8_SCHED
}
}

#define TB_LD 136
#define TF_LD 132
template <bool SCALE>
__device__ __forceinline__ void stage_bf16(const f32x16 (&acc)[2][2], const float* rsl) {
    bf16* T = (bf16*)smem;
    const int tid = opaque_tid(), w = tid >> 6, l = tid & 63, hh = l >> 5, wm = w >> 1, wn = w & 1;
#pragma unroll
    for (int i = 0; i < 2; ++i)
#pragma unroll
        for (int rr = 0; rr < 16; ++rr) {
            int row = wm * 64 + i * 32 + (rr & 3) + 8 * (rr >> 2) + 4 * hh;
            float sc = SCALE ? rsl[row] : 1.f;
#pragma unroll
            for (int j = 0; j < 2; ++j) T[row * TB_LD + wn * 64 + j * 32 + (l & 31)] = (bf16)(acc[i][j][rr] * sc);
        }
    __syncthreads();
}
template <bool SCALE>
__device__ __forceinline__ void stage_f32(const f32x16 (&acc)[2][2], const float* rsl) {
    float* T = (float*)smem;
    const int tid = opaque_tid(), w = tid >> 6, l = tid & 63, hh = l >> 5, wm = w >> 1, wn = w & 1;
#pragma unroll
    for (int i = 0; i < 2; ++i)
#pragma unroll
        for (int rr = 0; rr < 16; ++rr) {
            int row = wm * 64 + i * 32 + (rr & 3) + 8 * (rr >> 2) + 4 * hh;
            float sc = SCALE ? rsl[row] : 1.f;
#pragma unroll
            for (int j = 0; j < 2; ++j) T[row * TF_LD + wn * 64 + j * 32 + (l & 31)] = acc[i][j][rr] * sc;
        }
    __syncthreads();
}
template <typename CMAP>
__device__ __forceinline__ void store_rows_bf16(bf16* dst, int ld, int m0, CMAP cmap) {
    const bf16* T = (const bf16*)smem;
    const int tid = opaque_tid();
#pragma unroll
    for (int q = 0; q < 8; ++q) {
        int id = tid + 512 * q, row = id >> 4, ch = id & 15;
        u32x4 v = *(const u32x4*)(T + row * TB_LD + ch * 8);
        *(u32x4*)(dst + (size_t)(m0 + row) * ld + cmap(ch * 8)) = v;
    }
}
__device__ __forceinline__ void store_cols_bf16(bf16* vt, size_t crow0, int s0) {
    const unsigned short* T = (const unsigned short*)smem;
    const int tid = opaque_tid();
#pragma unroll
    for (int q = 0; q < 8; ++q) {
        int id = tid + 512 * q, c = id & 127, sg = id >> 7;
        unsigned e[8];
#pragma unroll
        for (int k = 0; k < 8; ++k) e[k] = T[(8 * sg + k) * TB_LD + c];
        u32x4 v = {e[0] | (e[1] << 16), e[2] | (e[3] << 16), e[4] | (e[5] << 16), e[6] | (e[7] << 16)};
        *(u32x4*)(vt + (crow0 + c) * SEQ + s0 + 8 * sg) = v;
    }
}
__device__ __forceinline__ void residual_store(const float* hin, float* hout, bf16* hb_out, float* gss, int m0, int n0, int nt) {
    const float* T = (const float*)smem;
    const int tid = opaque_tid(), l = tid & 63;
#pragma unroll 4
    for (int q = 0; q < 16; ++q) {
        int id = tid + 512 * q, row = id >> 5, ch = id & 31;
        f32x4 d = *(const f32x4*)(T + row * TF_LD + ch * 4);
        size_t gi = (size_t)(m0 + row) * 1024 + n0 + ch * 4;
        f32x4 h = *(const f32x4*)(hin + gi);
        f32x4 v = h + d;
        *(f32x4*)(hout + gi) = v;
        u32x2 b = {pack2(v.x, v.y), pack2(v.z, v.w)};
        *(u32x2*)(hb_out + (size_t)(m0 + row) * LDH + n0 + ch * 4) = b;
        float ss = v.x * v.x + v.y * v.y + v.z * v.z + v.w * v.w;
        ss = dpp_add<0xB1>(ss); ss = dpp_add<0x4E>(ss); ss = dpp_add<0x141>(ss); ss = dpp_add<0x140>(ss);
        ss += __shfl_xor(ss, 16);
        if ((l & 31) == 0) gss[(size_t)(m0 + row) * 8 + nt] = ss;
    }
}
struct ColAdd { int off; __device__ __forceinline__ int operator()(int c) const { return c + off; } };
struct ColHead96 { __device__ __forceinline__ int operator()(int c) const { return (c >> 6) * 96 + (c & 63); } };

struct EpiProj {
    static constexpr bool PERM = true, AFTER_DRAIN = false;
    const float* ssrow; char* ws;
    __device__ __forceinline__ void khook(int, f32x4 (&)[2][2][4][2], int, int) const {}
    __device__ __forceinline__ void operator()(const f32x4 (&acc)[2][2][4][2], const pg8::Unit& u, int wr, int wc, int fr, int fqd) const {
        asm volatile("" : "+v"(fr), "+v"(fqd));
        const int row0 = u.pm * 256 + wr * 64 + fr, lc0 = wc * 32 + 8 * fqd, pn = u.pn;
        size_t doff; int ld = 256;
        if (pn == 0) doff = OFF_FQ; else if (pn == 1) doff = OFF_FK; else if (pn == 2) doff = OFF_PART;
        else if (pn == 3) doff = OFF_SQ; else if (pn == 4) doff = OFF_SKK; else if (pn == 5) doff = OFF_PART + 8 * MBy;
        else if (pn == 6) { doff = OFF_CQ; ld = LDP; } else { doff = OFF_CKV; ld = LDC; }
        bf16* dst = (bf16*)(ws + doff);
        bf16* mk = (bf16*)(ws + OFF_MK); float* flog = (float*)(ws + OFF_FLOG); const float* cs = (const float*)(ws + OFF_CS);
#pragma unroll
        for (int ai = 0; ai < 2; ++ai)
#pragma unroll
            for (int m = 0; m < 4; ++m) {
                const int row = row0 + ai * 128 + m * 16;
                const float rs = row_rs8(ssrow, row);
#pragma unroll
                for (int bj = 0; bj < 2; ++bj) {
                    f32x4 v0 = acc[ai][bj][m][0] * rs, v1 = acc[ai][bj][m][1] * rs;
                    if (pn < 7 || bj == 0) {
                        u32x4 wv = {pack2(v0[0], v0[1]), pack2(v0[2], v0[3]), pack2(v1[0], v1[1]), pack2(v1[2], v1[3])};
                        *(u32x4*)(dst + (size_t)row * ld + bj * 128 + lc0) = wv;
                    } else if (wc == 0) {
                        const int hh = fqd >> 1, pi = 8 * (fqd & 1);
                        float vv[8] = {v0[0], v0[1], v0[2], v0[3], v1[0], v1[1], v1[2], v1[3]}, ov[8];
                        const f32x4* c4 = (const f32x4*)(cs + ((size_t)row * 16 + pi) * 2);
                        f32x4 t0 = c4[0], t1 = c4[1], t2 = c4[2], t3 = c4[3];
                        float cc[8] = {t0.x, t0.z, t1.x, t1.z, t2.x, t2.z, t3.x, t3.z}, sn[8] = {t0.y, t0.w, t1.y, t1.w, t2.y, t2.w, t3.y, t3.w};
#pragma unroll
                        for (int e = 0; e < 8; ++e) {
                            float pv = __builtin_bit_cast(float, partner32(__builtin_bit_cast(int, vv[e]), hh));
                            ov[e] = hh ? (pv * sn[e] + vv[e] * cc[e]) : (vv[e] * cc[e] - pv * sn[e]);
                        }
                        u32x4 wv = {pack2(ov[0], ov[1]), pack2(ov[2], ov[3]), pack2(ov[4], ov[5]), pack2(ov[6], ov[7])};
#pragma unroll
                        for (int h = 0; h < 4; ++h) *(u32x4*)(mk + (size_t)row * 384 + h * 96 + 64 + 8 * fqd) = wv;
                    } else if (wc == 1 && fqd == 0) {
                        *(f32x4*)(flog + (size_t)row * 4) = v0;
                    }
                }
            }
    }
};
__device__ __forceinline__ void phase_proj(const Params& P, int L, int hsel, int ss_slot) {
    char* ws = opq(P.ws);
    const float* ssrow = (const float*)(ws + OFF_SSA) + (size_t)ss_slot * TOK * 8;
    const bf16* hb = (const bf16*)(ws + (hsel ? OFF_HB1 : OFF_HB0));
    const bf16* Bt = (const bf16*)(ws + OFF_WIN) + (size_t)L * 2048 * LDH;
    pg8::Gemm g{hb, Bt, LDH, LDH, TOK, 2048, 1024};
    pg8::StaticOrder S; S.init(TOK, 2048, gridDim.x, blockIdx.x);
    EpiProj E{ssrow, ws};
    pg8::gemm_phase((PG8_LAS unsigned char*)smem, g, S, E, nullptr);
    __syncthreads();
}

template <int KW>
__device__ __forceinline__ void row_rms_to_lds(const bf16* A, int lda, int m0) {
    const int tid = opaque_tid(), row = tid >> 1, half = tid & 1;
    float ss = 0.f;
    const u32x4* p = (const u32x4*)(A + (size_t)(m0 + row) * lda + half * (KW / 2));
#pragma unroll
    for (int q = 0; q < KW / 16; ++q) {
        u32x4 v = p[q];
        float a;
        a = bflo(v.x); ss += a * a; a = bfhi(v.x); ss += a * a;
        a = bflo(v.y); ss += a * a; a = bfhi(v.y); ss += a * a;
        a = bflo(v.z); ss += a * a; a = bfhi(v.z); ss += a * a;
        a = bflo(v.w); ss += a * a; a = bfhi(v.w); ss += a * a;
    }
    ss += __shfl_xor(ss, 1);
    if (half == 0) ((float*)(smem + LDS_AUX))[row] = rsqrtf(ss * (1.f / (float)KW) + EPSF);
}

__device__ __forceinline__ void phase_mla_up(const Params& P, int L) {
    char* ws = opq(P.ws);
    const bf16* cq = (const bf16*)(ws + OFF_CQ); const bf16* ckv = (const bf16*)(ws + OFF_CKV);
    const bf16* wuq = (const bf16*)(ws + OFF_WUQ) + (size_t)L * 384 * LDP;
    const bf16* wukv = (const bf16*)(ws + OFF_WUKV) + (size_t)L * 768 * LDC;
    bf16* mq = (bf16*)(ws + OFF_MQ); bf16* mk = (bf16*)(ws + OFF_MK); bf16* mvt = (bf16*)(ws + OFF_MVT);
    const float* cs = (const float*)(ws + OFF_CS);
    const float* flog = (const float*)(ws + OFF_FLOG);
    float* cumF = (float*)(ws + OFF_CUMF);
    const int tid = opaque_tid(), w = tid >> 6, l = tid & 63, hh = l >> 5, wm = w >> 1, wn = w & 1;
    const int NQ = 64 * 3, NKV = 64 * 6, NCF = 4;
    const float* aux = (const float*)(smem + LDS_AUX);
    for (int gw = blockIdx.x * NW + w; gw < 2048; gw += gridDim.x * NW) {
        const int type = gw >> 10, bh = (gw >> 5) & 31, tb = gw & 31, b = bh >> 2, h = bh & 3;
        const bf16* src = (const bf16*)(ws + OFF_PART + (type ? 8 * MBy : 0)) + ((size_t)(b * SEQ + tb * 64 + l) * 256 + h * 64);
        unsigned short* dst = (unsigned short*)(ws + (type ? OFF_SVT : OFF_FVT)) + (size_t)bh * 64 * SEQ + tb * 64 + l;
        u32x4 rv8[8];
#pragma unroll
        for (int q = 0; q < 8; ++q) rv8[q] = ((const u32x4*)src)[q];
#pragma unroll
        for (int q = 0; q < 8; ++q) {
            dst[(size_t)(8 * q + 0) * SEQ] = (unsigned short)(rv8[q].x & 0xffffu); dst[(size_t)(8 * q + 1) * SEQ] = (unsigned short)(rv8[q].x >> 16);
            dst[(size_t)(8 * q + 2) * SEQ] = (unsigned short)(rv8[q].y & 0xffffu); dst[(size_t)(8 * q + 3) * SEQ] = (unsigned short)(rv8[q].y >> 16);
            dst[(size_t)(8 * q + 4) * SEQ] = (unsigned short)(rv8[q].z & 0xffffu); dst[(size_t)(8 * q + 5) * SEQ] = (unsigned short)(rv8[q].z >> 16);
            dst[(size_t)(8 * q + 6) * SEQ] = (unsigned short)(rv8[q].w & 0xffffu); dst[(size_t)(8 * q + 7) * SEQ] = (unsigned short)(rv8[q].w >> 16);
        }
    }
    const bool deal = (gridDim.x == 256);
    const int nslot = deal ? 4 : (NQ + NKV + NCF + (int)gridDim.x - 1) / (int)gridDim.x;
    for (int slot = 0; slot < nslot; ++slot) {
        int item;
        if (deal) {
            const int bx = blockIdx.x;
            if (bx < 192) item = (slot == 0) ? bx : (slot == 1) ? (NQ + bx) : (slot == 2 && bx < NCF) ? (NQ + NKV + bx) : -1;
            else item = (slot < 3) ? (NQ + 192 + 3 * (bx - 192) + slot) : -1;
        } else {
            item = blockIdx.x + slot * gridDim.x;
            if (item >= NQ + NKV + NCF) item = -1;
        }
        if (item < 0) continue;
        if (item < NQ) {
            int mt = item / 3, nt = item % 3;
            int m0 = mt * 256, n0 = nt * 128;
            __syncthreads();
            row_rms_to_lds<256>(cq, LDP, m0);
            f32x16 acc[2][2];
            ZERO_ACC(acc);
            gemm_core(acc, cq, LDP, wuq, LDP, 256, m0, n0, NoHook());
#pragma unroll
            for (int i = 0; i < 2; ++i)
#pragma unroll
                for (int j = 0; j < 2; ++j) {
                    int c0 = n0 + wn * 64 + j * 32;
                    int rloc = wm * 64 + i * 32 + 4 * hh;
                    bool rot = (c0 % 96) == 64;
                    int ci = l & 31, pi = ci & 15;
#pragma unroll
                    for (int rr = 0; rr < 16; ++rr) {
                        int rl = rloc + (rr & 3) + 8 * (rr >> 2);
                        float v = acc[i][j][rr] * aux[rl];
                        if (rot) {
                            float pv = __shfl_xor(v, 16);
                            float2 c_s = *(const float2*)(cs + ((size_t)(m0 + rl) * 16 + pi) * 2);
                            v = (ci < 16) ? (v * c_s.x - pv * c_s.y) : (pv * c_s.y + v * c_s.x);
                        }
                        acc[i][j][rr] = v;
                    }
                }
            stage_bf16<false>(acc, nullptr);
            store_rows_bf16(mq, 384, m0, ColAdd{n0});
        } else if (item < NQ + NKV) {
            int it2 = item - NQ;
            int mt = it2 / 6, nt = it2 % 6;
            int m0 = mt * 256, n0 = nt * 128;
            __syncthreads();
            row_rms_to_lds<128>(ckv, LDC, m0);
            f32x16 acc[2][2];
            ZERO_ACC(acc);
            gemm_core(acc, ckv, LDC, wukv, LDC, 128, m0, n0, NoHook());
            stage_bf16<true>(acc, aux);
            if (nt < 2) {
                const int nb0 = n0;
                struct CM { int n0; __device__ __forceinline__ int operator()(int c) const { int col = n0 + c; return (col >> 6) * 96 + (col & 63); } };
                store_rows_bf16(mk, 384, m0, CM{nb0});
            } else {
                store_cols_bf16(mvt, (size_t)(m0 >> 11) * 512 + (n0 - 256), m0 & 2047);
            }
        } else {
            int seq = (item - NQ - NKV) * NW + w;
            int b = seq >> 2, h = seq & 3;
            float bfv = P.b_forget[L * 4 + h];
            float vals[32];
            float run = 0.f;
#pragma unroll
            for (int i = 0; i < 32; ++i) {
                int s = l * 32 + i;
                float z = flog[((size_t)b * SEQ + s) * 4 + h] + bfv;
                run += log_sigmoid_f(z);
                vals[i] = run;
            }
            float tot = run, incl = tot;
#pragma unroll
            for (int o = 1; o < 64; o <<= 1) {
                float t = __shfl_up(incl, o);
                if (l >= o) incl += t;
            }
            float excl = incl - tot;
#pragma unroll
            for (int i = 0; i < 32; ++i) cumF[(size_t)seq * SEQ + l * 32 + i] = vals[i] + excl;
        }
    }
}

template <int MODE, int DK, int DV>
__device__ __forceinline__ void attn_item(const bf16* __restrict__ Q, int ldq, const bf16* __restrict__ Kg, int ldk,
                          const bf16* __restrict__ Vt, const float* __restrict__ cumF, bf16* __restrict__ Y,
                          float* __restrict__ ssy, int b, int h, int qb, float c1, char* lds, int fake = 0) {
    constexpr int KSTR = DK * 2 + 16;
    constexpr int VSTR = 144;
    constexpr int KBYTES = 64 * KSTR, VBYTES = DV * VSTR;
    constexpr int BUF = (KBYTES + VBYTES + 256 + 255) & ~255;
    static_assert(2 * BUF <= 65536, "lds");
    constexpr int KCH = DK / 8, KPT = (64 * KCH) / 256, VPT = (DV * 8) / 256;
    const int tid = opaque_tid() & 255, w = tid >> 6, l = tid & 63, r = l & 31, hh = l >> 5;
    const int q0 = qb * 128;
    const int qrow = q0 + 32 * w + r;
    const size_t tok = (size_t)b * SEQ + qrow;
    const int bh = b * 4 + h;
    bf16x8 qf[DK / 16];
#pragma unroll
    for (int s = 0; s < DK / 16; ++s) qf[s] = *(const bf16x8*)(Q + tok * ldq + h * DK + 16 * s + 8 * hh);
    f32x16 o[DV / 32];
    const f32x16 zero16 = {0.f, 0.f, 0.f, 0.f, 0.f, 0.f, 0.f, 0.f, 0.f, 0.f, 0.f, 0.f, 0.f, 0.f, 0.f, 0.f};
#pragma unroll
    for (int d = 0; d < DV / 32; ++d) o[d] = zero16;
    float m = -1e30f, lsum = 0.f, R = 0.f;
    bool sbdead = false;
    int* dmask = (int*)(smem + LDS_BYTES - 32);
    float Fq = 0.f;
    if (MODE == 0) Fq = cumF[(size_t)bh * SEQ + qrow] * LOG2E;
    const int nkt = (q0 + 128) >> 6;
    u32x4 kregA[KPT], vregA[VPT], kregB[KPT], vregB[VPT];
    float4 fregA = {0.f, 0.f, 0.f, 0.f}, fregB = {0.f, 0.f, 0.f, 0.f};
    auto gload = [&](int kt, u32x4 (&kreg)[KPT], u32x4 (&vreg)[VPT], float4& freg) {
#pragma unroll
        for (int i = 0; i < KPT; ++i) {
            int e = tid + 256 * i;
            int row = e / KCH, ch = e % KCH;
            kreg[i] = *(const u32x4*)(Kg + ((size_t)b * SEQ + kt * 64 + row) * ldk + h * DK + ch * 8);
        }
#pragma unroll
        for (int i = 0; i < VPT; ++i) {
            int e = tid + 256 * i;
            int row = e >> 3, ch = e & 7;
            vreg[i] = *(const u32x4*)(Vt + ((size_t)bh * DV + row) * SEQ + kt * 64 + ch * 8);
        }
        if (MODE == 0 && tid < 16) freg = *(const float4*)(cumF + (size_t)bh * SEQ + kt * 64 + tid * 4);
    };
    auto lwrite = [&](int buf, u32x4 (&kreg)[KPT], u32x4 (&vreg)[VPT], float4& freg) {
        char* base = lds + buf * BUF;
#pragma unroll
        for (int i = 0; i < KPT; ++i) {
            int e = tid + 256 * i;
            int row = e / KCH, ch = e % KCH;
            *(u32x4*)(base + row * KSTR + ch * 16) = kreg[i];
        }
#pragma unroll
        for (int i = 0; i < VPT; ++i) {
            int e = tid + 256 * i;
            int row = e >> 3, ch = e & 7;
            *(u32x4*)(base + KBYTES + row * VSTR + ch * 16) = vreg[i];
        }
        if (MODE == 0 && tid < 16) { float4 fn = {-freg.x * LOG2E, -freg.y * LOG2E, -freg.z * LOG2E, -freg.w * LOG2E}; *(float4*)(base + KBYTES + VBYTES + tid * 16) = fn; }
    };
    const int prow = (r & 0x13) | ((r & 4) << 1) | ((r & 8) >> 1);
    auto ktof = [&](int it) { return (MODE == 1) ? (nkt - 1 - it) : it; };
    gload(ktof(0), kregA, vregA, fregA);
    lwrite(0, kregA, vregA, fregA);
    constexpr bool D2 = (MODE != 2);
    if (D2 && nkt > 1) gload(ktof(1), kregB, vregB, fregB);
    __syncthreads();
    auto tile = [&](int it, u32x4 (&kn)[KPT], u32x4 (&vn)[VPT], float4& fn2, u32x4 (&kf)[KPT], u32x4 (&vf2)[VPT], float4& ff) {
        const int kt = ktof(it);
        if (!(fake & 1)) {
        if (D2) { if (it + 2 < nkt) gload(ktof(it + 2), kf, vf2, ff); }
        else { if (it + 1 < nkt) gload(ktof(it + 1), kf, vf2, ff); }
        }
        const char* base = lds + (it & 1) * BUF;
        bool active = (kt * 64) <= (q0 + 32 * w + 31);
        if (MODE == 1) {
            if (sbdead) { active = false; atomicOr(&dmask[it & 1], 1 << (opaque_tid() >> 6)); }
        }
        if (active) {
            const bool needmask = (kt * 64 + 63) >= (q0 + 32 * w);
            f32x16 s[2];
#pragma unroll
            for (int sub = 0; sub < 2; ++sub) {
                s[sub] = zero16;
#pragma unroll
                for (int ks = 0; ks < DK / 16; ++ks) {
                    bf16x8 kf = *(const bf16x8*)(base + (sub * 32 + prow) * KSTR + (2 * ks + hh) * 16);
                    s[sub] = __builtin_amdgcn_mfma_f32_32x32x16_bf16(kf, qf[ks], s[sub], 0, 0, 0);
                }
            }
            bf16x8 pf[2][2];
            if (fake & 2) {
#pragma unroll
                for (int sub = 0; sub < 2; ++sub)
#pragma unroll
                    for (int a = 0; a < 2; ++a) {
                        uint4 u;
                        u.x = pack2(s[sub][8 * a], s[sub][8 * a + 1]); u.y = pack2(s[sub][8 * a + 2], s[sub][8 * a + 3]);
                        u.z = pack2(s[sub][8 * a + 4], s[sub][8 * a + 5]); u.w = pack2(s[sub][8 * a + 6], s[sub][8 * a + 7]);
                        pf[sub][a] = __builtin_bit_cast(bf16x8, u);
                    }
                lsum = 1.f;
            } else if (MODE != 1) {
                const float* Ft = (const float*)(base + KBYTES + VBYTES);
                float mx = -INFINITY;
                float tv[2][16];
#pragma unroll
                for (int sub = 0; sub < 2; ++sub)
#pragma unroll
                    for (int a = 0; a < 2; ++a) {
                        int kofs = sub * 32 + 16 * a + 8 * hh;
                        float fk[8];
                        if (MODE == 0) {
                            float4 f0 = *(const float4*)(Ft + kofs), f1 = *(const float4*)(Ft + kofs + 4);
                            fk[0] = f0.x; fk[1] = f0.y; fk[2] = f0.z; fk[3] = f0.w; fk[4] = f1.x; fk[5] = f1.y; fk[6] = f1.z; fk[7] = f1.w;
                        }
#pragma unroll
                        for (int j = 0; j < 8; ++j) {
                            int rr = 8 * a + j;
                            float v = (MODE == 0) ? fmaf(s[sub][rr], c1, fk[j]) : s[sub][rr] * c1;
                            tv[sub][rr] = v;
                        }
                    }
                if (needmask) {
#pragma unroll
                    for (int sub = 0; sub < 2; ++sub)
#pragma unroll
                        for (int rr = 0; rr < 16; ++rr) {
                            int key = kt * 64 + sub * 32 + 16 * (rr >> 3) + 8 * hh + (rr & 7);
                            if (key > qrow) tv[sub][rr] = -INFINITY;
                        }
                }
#pragma unroll
                for (int sub = 0; sub < 2; ++sub)
#pragma unroll
                    for (int rr = 0; rr < 16; ++rr) mx = fmaxf(mx, tv[sub][rr]);
                mx = fmaxf(mx, __builtin_bit_cast(float, partner32(__builtin_bit_cast(int, mx), hh)));
                float mnew = fmaxf(m, mx);
                float rsum = 0.f;
#pragma unroll
                for (int sub = 0; sub < 2; ++sub)
#pragma unroll
                    for (int a = 0; a < 2; ++a) {
                        float pv[8];
#pragma unroll
                        for (int j = 0; j < 8; ++j) { pv[j] = fexp2(tv[sub][8 * a + j] - mnew); rsum += pv[j]; }
                        uint4 u;
                        u.x = pack2(pv[0], pv[1]); u.y = pack2(pv[2], pv[3]); u.z = pack2(pv[4], pv[5]); u.w = pack2(pv[6], pv[7]);
                        pf[sub][a] = __builtin_bit_cast(bf16x8, u);
                    }
                rsum += __builtin_bit_cast(float, partner32(__builtin_bit_cast(int, rsum), hh));
                if (__builtin_amdgcn_ballot_w64(mnew != m) != 0ull) {
                    float alpha = fexp2(m - mnew);
                    lsum *= alpha;
#pragma unroll
                    for (int d = 0; d < DV / 32; ++d) o[d] = o[d] * alpha;
                    m = mnew;
                }
                lsum += rsum;
            } else {
#pragma unroll
                for (int sb = 0; sb < 2; ++sb) {
                    const int sub = 1 - sb;
                    float lsig[16], lneg[16];
                    float A0 = 0.f, A1 = 0.f;
#pragma unroll
                    for (int rr = 0; rr < 16; ++rr) {
                        int key = kt * 64 + sub * 32 + 16 * (rr >> 3) + 8 * hh + (rr & 7);
                        bool valid = key < qrow;
                        float z = s[sub][rr] * c1;
                        float e = fexp2(-fabsf(z));
                        float l1p = flog2(1.f + e);
                        float ls = fminf(z, 0.f) - l1p;
                        float ln = valid ? (ls - z) : 0.f;
                        lsig[rr] = valid ? ls : -INFINITY;
                        lneg[rr] = ln;
                        if (rr < 8) A0 += ln; else A1 += ln;
                    }
                    float B0 = __shfl_xor(A0, 32), B1 = __shfl_xor(A1, 32);
                    float base1 = (hh == 0) ? (R + B1) : R;
                    float base0 = (hh == 0) ? (R + B1 + A1 + B0) : (R + A1 + B1);
                    float wv[16];
                    float run = base1;
#pragma unroll
                    for (int j = 7; j >= 0; --j) { wv[8 + j] = fexp2(lsig[8 + j] + run); run += lneg[8 + j]; }
                    run = base0;
#pragma unroll
                    for (int j = 7; j >= 0; --j) { wv[j] = fexp2(lsig[j] + run); run += lneg[j]; }
                    R += A0 + A1 + B0 + B1;
#pragma unroll
                    for (int a = 0; a < 2; ++a) {
                        uint4 u;
                        u.x = pack2(wv[8 * a], wv[8 * a + 1]); u.y = pack2(wv[8 * a + 2], wv[8 * a + 3]);
                        u.z = pack2(wv[8 * a + 4], wv[8 * a + 5]); u.w = pack2(wv[8 * a + 6], wv[8 * a + 7]);
                        pf[sub][a] = __builtin_bit_cast(bf16x8, u);
                    }
                }
            }
            if (MODE == 1) {
                if (__builtin_amdgcn_ballot_w64(R > -150.f) == 0ull) { sbdead = true; atomicOr(&dmask[it & 1], 1 << (opaque_tid() >> 6)); }
            }
#pragma unroll
            for (int d = 0; d < DV / 32; ++d)
#pragma unroll
                for (int sub = 0; sub < 2; ++sub)
#pragma unroll
                    for (int a = 0; a < 2; ++a) {
                        bf16x8 vf = *(const bf16x8*)(base + KBYTES + (d * 32 + r) * VSTR + (sub * 32 + 16 * a + 8 * hh) * 2);
                        o[d] = __builtin_amdgcn_mfma_f32_32x32x16_bf16(vf, pf[sub][a], o[d], 0, 0, 0);
                    }
        }
        if (!(fake & 1)) { if (it + 1 < nkt) lwrite((it + 1) & 1, kn, vn, fn2); }
        __syncthreads();
    };
    if (D2) {
        for (int it = 0; it < nkt; it += 2) {
            if (MODE == 1 && it > 0 && ((volatile int*)dmask)[(it - 1) & 1] == 0xFF) break;
            tile(it, kregB, vregB, fregB, kregA, vregA, fregA);
            if (it + 1 < nkt) {
                if (MODE == 1 && ((volatile int*)dmask)[it & 1] == 0xFF) break;
                tile(it + 1, kregA, vregA, fregA, kregB, vregB, fregB);
            }
        }
    } else {
        for (int it = 0; it < nkt; ++it) tile(it, kregA, vregA, fregA, kregA, vregA, fregA);
    }
    float inv = (MODE == 1) ? 1.f : (1.f / lsum);
    float ssq = 0.f;
#pragma unroll
    for (int d = 0; d < DV / 32; ++d)
#pragma unroll
        for (int g = 0; g < 4; ++g) {
            float v0 = o[d][4 * g] * inv, v1 = o[d][4 * g + 1] * inv, v2 = o[d][4 * g + 2] * inv, v3 = o[d][4 * g + 3] * inv;
            ssq += v0 * v0 + v1 * v1 + v2 * v2 + v3 * v3;
            uint2 u; u.x = pack2(v0, v1); u.y = pack2(v2, v3);
            *(uint2*)(Y + tok * LDH + h * DV + d * 32 + 8 * g + 4 * hh) = u;
        }
    ssq += __shfl_xor(ssq, 32);
    if (hh == 0) ssy[tok * 16 + h] = ssq;
}

__device__ __forceinline__ void phase_attn(const Params& P, int L, int rep = 0, int fake = 0) {
    char* ws = opq(P.ws);
    int* cnt = (int*)(ws + OFF_CNT) + L * 64 + rep * 16;
    int* s_item = (int*)(smem + LDS_BYTES - 16);
    const float* cumF = (const float*)(ws + OFF_CUMF);
    bf16* Y = (bf16*)(ws + (fake ? OFF_PART : OFF_Y));
    float* ssy = fake ? (float*)(ws + OFF_PART + 40 * MBy) : (float*)(ws + OFF_SSY) + (size_t)L * TOK * 16;
    const int half = opaque_tid() >> 8;
    char* lds = smem + half * 65536;
    for (;;) {
        if (opaque_tid() == 0) { int z0 = 0; asm volatile("" : "+v"(z0)); *s_item = atomicAdd(cnt, 1); s_item[-4] = z0; s_item[-3] = z0; }
        __syncthreads();
        int pair = *s_item;
        __syncthreads();
        if (pair >= 768) break;
        int item = pair * 2 + half;
        int qb, type, bh;
        if (item < 1024) { qb = 15 - (item >> 6); type = (item & 32) ? 2 : 0; bh = item & 31; }
        else { const int j2 = item - 1024; qb = 15 - (j2 >> 5); type = 1; bh = j2 & 31; }
        int b = bh >> 2, h = bh & 3;
        if (type == 0) {
            attn_item<2, 96, 128>((const bf16*)(ws + OFF_MQ), 384, (const bf16*)(ws + OFF_MK), 384, (const bf16*)(ws + OFF_MVT), cumF,
                                  Y + 512, ssy + 8, b, h, qb, 0.10206207261596577f * LOG2E, lds, fake);
        } else if (type == 1) {
            attn_item<1, 64, 64>((const bf16*)(ws + OFF_SQ), 256, (const bf16*)(ws + OFF_SKK), 256, (const bf16*)(ws + OFF_SVT), cumF,
                                 Y + 256, ssy + 4, b, h, qb, 0.125f * LOG2E, lds, fake);
        } else {
            attn_item<0, 64, 64>((const bf16*)(ws + OFF_FQ), 256, (const bf16*)(ws + OFF_FK), 256, (const bf16*)(ws + OFF_FVT), cumF,
                                 Y + 0, ssy + 0, b, h, qb, 0.125f * LOG2E, lds, fake);
        }
    }
}

__device__ __forceinline__ void rowss_flush(float (&part)[2][16], float* gss, int m0, int nt) {
    float* lss = (float*)smem;
    const int tid = opaque_tid(), w = tid >> 6, l = tid & 63, hh = l >> 5, wm = w >> 1, wn = w & 1;
#pragma unroll
    for (int i = 0; i < 2; ++i)
#pragma unroll
        for (int rr = 0; rr < 16; ++rr) {
            float v = part[i][rr];
            v = dpp_add<0xB1>(v); v = dpp_add<0x4E>(v); v = dpp_add<0x141>(v); v = dpp_add<0x140>(v);
            v += __shfl_xor(v, 16);
            if ((l & 31) == 0) lss[wn * 256 + wm * 64 + i * 32 + (rr & 3) + 8 * (rr >> 2) + 4 * hh] = v;
        }
    __syncthreads();
    if (tid < 256) gss[(size_t)(m0 + tid) * 8 + nt] = lss[tid] + lss[256 + tid];
    __syncthreads();
}

__device__ __forceinline__ float sum_fq(float v) {
    float a = v, b = v;
    asm volatile("s_nop 1\n\tv_permlane16_swap_b32 %0, %1\n\ts_nop 1" : "+v"(a), "+v"(b));
    v = a + b; a = v; b = v;
    asm volatile("s_nop 1\n\tv_permlane32_swap_b32 %0, %1\n\ts_nop 1" : "+v"(a), "+v"(b));
    return a + b;
}
template <bool SIG, bool XQ>
__device__ __forceinline__ void residual_fused(const f32x4 (&acc)[2][2][4][2], const pg8::Unit& u, int wr, int wc, int fr, int fqd,
                                               const float* rowscale  , const bf16* gate  ,
                                               const bf16* hb_in, bf16* hb_out, float* gss, unsigned char* xq = nullptr) {
    float* lss = (float*)smem;
#pragma unroll
    for (int ai = 0; ai < 2; ++ai)
#pragma unroll
        for (int m = 0; m < 4; ++m) {
            const int rl = 128 * ai + 64 * wr + 16 * m + fr, row = u.pm * 256 + rl;
            const float sc = rowscale ? rowscale[rl] : 1.f;
#pragma unroll
            for (int bj = 0; bj < 2; ++bj) {
                const int col = u.pn * 256 + 128 * bj + 32 * wc + 8 * fqd;
                const u32x4 hq = *(const u32x4*)(hb_in + (size_t)row * LDH + col);
                const f32x4 hp0 = {bflo(hq.x), bfhi(hq.x), bflo(hq.y), bfhi(hq.y)}, hp1 = {bflo(hq.z), bfhi(hq.z), bflo(hq.w), bfhi(hq.w)};
                f32x4 d0 = acc[ai][bj][m][0] * sc, d1 = acc[ai][bj][m][1] * sc;
                if (SIG) {
#pragma unroll
                    for (int e = 0; e < 4; ++e) {
                        d0[e] = __builtin_amdgcn_rcpf(1.f + fexp2(-LOG2E * d0[e]));
                        d1[e] = __builtin_amdgcn_rcpf(1.f + fexp2(-LOG2E * d1[e]));
                    }
                }
                if (gate) {
                    u32x4 gq = *(const u32x4*)(gate + (size_t)row * 1024 + col);
                    f32x4 g0 = {bflo(gq.x), bfhi(gq.x), bflo(gq.y), bfhi(gq.y)}, g1 = {bflo(gq.z), bfhi(gq.z), bflo(gq.w), bfhi(gq.w)};
                    d0 = d0 * g0; d1 = d1 * g1;
                }
                f32x4 v0 = hp0 + d0, v1 = hp1 + d1;
                u32x4 wv = {pack2(v0[0], v0[1]), pack2(v0[2], v0[3]), pack2(v1[0], v1[1]), pack2(v1[2], v1[3])};
                *(u32x4*)(hb_out + (size_t)row * LDH + col) = wv;
                if (XQ) {
                    f32x4 c0, c1;
#pragma unroll
                    for (int e = 0; e < 4; ++e) { c0[e] = __builtin_amdgcn_fmed3f(v0[e], -448.f, 448.f); c1[e] = __builtin_amdgcn_fmed3f(v1[e], -448.f, 448.f); }
                    int h0 = __builtin_amdgcn_cvt_pk_fp8_f32(c0[0], c0[1], 0, false); h0 = __builtin_amdgcn_cvt_pk_fp8_f32(c0[2], c0[3], h0, true);
                    int h1 = __builtin_amdgcn_cvt_pk_fp8_f32(c1[0], c1[1], 0, false); h1 = __builtin_amdgcn_cvt_pk_fp8_f32(c1[2], c1[3], h1, true);
                    const f32x2 b0 = __builtin_amdgcn_cvt_pk_f32_fp8(h0, false), b1 = __builtin_amdgcn_cvt_pk_f32_fp8(h0, true);
                    const f32x2 b2 = __builtin_amdgcn_cvt_pk_f32_fp8(h1, false), b3 = __builtin_amdgcn_cvt_pk_f32_fp8(h1, true);
                    int l0 = __builtin_amdgcn_cvt_pk_fp8_f32((c0[0] - b0.x) * 16.f, (c0[1] - b0.y) * 16.f, 0, false);
                    l0 = __builtin_amdgcn_cvt_pk_fp8_f32((c0[2] - b1.x) * 16.f, (c0[3] - b1.y) * 16.f, l0, true);
                    int l1 = __builtin_amdgcn_cvt_pk_fp8_f32((c1[0] - b2.x) * 16.f, (c1[1] - b2.y) * 16.f, 0, false);
                    l1 = __builtin_amdgcn_cvt_pk_fp8_f32((c1[2] - b3.x) * 16.f, (c1[3] - b3.y) * 16.f, l1, true);
                    u32x2 hh = {(unsigned)h0, (unsigned)h1}, ll = {(unsigned)l0, (unsigned)l1};
                    *(u32x2*)(xq + (size_t)row * 1024 + col) = hh;
                    *(u32x2*)(xq + 16 * MBy + (size_t)row * 1024 + col) = ll;
                }
                float ss = (v0[0] * v0[0] + v0[1] * v0[1]) + (v0[2] * v0[2] + v0[3] * v0[3]) + (v1[0] * v1[0] + v1[1] * v1[1]) + (v1[2] * v1[2] + v1[3] * v1[3]);
                ss = sum_fq(ss);
                if (fqd == 0) lss[(wc * 256 + rl) * 2 + bj] = ss;
            }
        }
    __syncthreads();
    const int tid = opaque_tid();
    if (tid < 256) {
        const int row = u.pm * 256 + tid;
#pragma unroll
        for (int bj = 0; bj < 2; ++bj)
            gss[(size_t)row * 8 + u.pn * 2 + bj] = (lss[(0 * 256 + tid) * 2 + bj] + lss[(1 * 256 + tid) * 2 + bj]) + (lss[(2 * 256 + tid) * 2 + bj] + lss[(3 * 256 + tid) * 2 + bj]);
    }
    __syncthreads();
}
struct EpiWo {
    static constexpr bool PERM = true, AFTER_DRAIN = true;
    const bf16* hb_in; bf16* hb_out; float* gss; unsigned char* xq;
    __device__ __forceinline__ void khook(int t, f32x4 (&acc)[2][2][4][2], int wr, int fr) const {
        if (t == 4 || t == 8) {
            const float* fac = (const float*)(smem + LDS_AUX) + (t == 4 ? 0 : 256);
#pragma unroll
            for (int ai = 0; ai < 2; ++ai)
#pragma unroll
                for (int m = 0; m < 4; ++m) {
                    const float f = fac[128 * ai + 64 * wr + 16 * m + fr];
#pragma unroll
                    for (int bj = 0; bj < 2; ++bj) { acc[ai][bj][m][0] *= f; acc[ai][bj][m][1] *= f; }
                }
        }
    }
    __device__ __forceinline__ void operator()(const f32x4 (&)[2][2][4][2], const pg8::Unit&, int, int, int, int) const {}
    __device__ __forceinline__ void fused(const f32x4 (&acc)[2][2][4][2], const pg8::Unit& u, int wr, int wc, int fr, int fqd, PG8_LAS unsigned char*, int, int) const {
        residual_fused<false, true>(acc, u, wr, wc, fr, fqd, (const float*)(smem + LDS_AUX) + 512, nullptr, hb_in, hb_out, gss, xq);
    }
};
__device__ __forceinline__ void phase_wo(const Params& P, int L, int hsel, int ss_slot) {
    char* ws = opq(P.ws);
    float* ss_out = (float*)(ws + OFF_SSA) + (size_t)ss_slot * TOK * 8;
    bf16* hb_out = (bf16*)(ws + (hsel ? OFF_HB1 : OFF_HB0));
    const bf16* hb_in = (const bf16*)(ws + (hsel ? OFF_HB0 : OFF_HB1));
    const bf16* Y = (const bf16*)(ws + OFF_Y);
    const bf16* Bt = (const bf16*)(ws + OFF_WO) + (size_t)L * 1024 * LDH;
    const float* ssy = (const float*)(ws + OFF_SSY) + (size_t)L * TOK * 16;
    float* aux = (float*)(smem + LDS_AUX);
    const int tid = opaque_tid();
    pg8::Gemm g{Y, Bt, LDH, LDH, TOK, 1024, 1024};
    pg8::StaticOrder S; S.init(TOK, 1024, gridDim.x, blockIdx.x);
    pg8::Unit u0;
    if (S.next(0, u0) && tid < 256) {
        int row = u0.pm * 256 + tid;
        float4 v0 = *(const float4*)(ssy + (size_t)row * 16), v1 = *(const float4*)(ssy + (size_t)row * 16 + 4), v2 = *(const float4*)(ssy + (size_t)row * 16 + 8);
        float r0 = rsqrtf(((v0.x + v0.y) + (v0.z + v0.w)) * (1.f / 256.f) + EPSF);
        float r1 = rsqrtf(((v1.x + v1.y) + (v1.z + v1.w)) * (1.f / 256.f) + EPSF);
        float r2 = rsqrtf(((v2.x + v2.y) + (v2.z + v2.w)) * (1.f / 512.f) + EPSF);
        aux[tid] = r0 / r1; aux[256 + tid] = r1 / r2; aux[512 + tid] = r2;
    }
    __syncthreads();
    EpiWo E{hb_in, hb_out, ss_out, (unsigned char*)(ws + OFF_XH)};
    pg8::gemm_phase((PG8_LAS unsigned char*)smem, g, S, E, nullptr);
    __syncthreads();
}

struct EpiPq {
    static constexpr bool PERM = true, AFTER_DRAIN = false;
    bf16* O; const float* ssrow;
    __device__ __forceinline__ void khook(int, f32x4 (&)[2][2][4][2], int, int) const {}
    __device__ __forceinline__ void operator()(const f32x4 (&acc)[2][2][4][2], const pg8::Unit& u, int wr, int wc, int fr, int fq) const {
        const int row0 = u.pm * 256 + wr * 64 + fr, col0 = u.pn * 256 + wc * 32 + 8 * fq;
#pragma unroll
        for (int ai = 0; ai < 2; ++ai)
#pragma unroll
            for (int m = 0; m < 4; ++m) {
                const int row = row0 + ai * 128 + m * 16;
                const float rs = row_rs8(ssrow, row);
                bf16* rowp = O + (size_t)row * 1024 + col0;
#pragma unroll
                for (int bj = 0; bj < 2; ++bj) {
                    f32x4 v0 = acc[ai][bj][m][0] * rs, v1 = acc[ai][bj][m][1] * rs;
                    u32x4 wv = {pack2(v0[0], v0[1]), pack2(v0[2], v0[3]), pack2(v1[0], v1[1]), pack2(v1[2], v1[3])};
                    *(u32x4*)(rowp + bj * 128) = wv;
                }
            }
    }
};
__device__ __forceinline__ void topk_task(const Params& P, int L, int t0, int h);
__device__ __forceinline__ void phase_pq(const Params& P, int L, int hsel, int ss_slot) {
    char* ws = opq(P.ws);
    const float* ssrow = (const float*)(ws + OFF_SSA) + (size_t)ss_slot * TOK * 8;
    const bf16* hb = (const bf16*)(ws + (hsel ? OFF_HB1 : OFF_HB0));
    const bf16* Bt = (const bf16*)(ws + OFF_WQ) + (size_t)L * 1024 * LDH;
    pg8::Gemm g{hb, Bt, LDH, LDH, TOK, 1024, 1024};
    pg8::StaticOrder S; S.init(TOK, 1024, gridDim.x, blockIdx.x);
    EpiPq E{(bf16*)(ws + OFF_PQ), ssrow};
    pg8::gemm_phase((PG8_LAS unsigned char*)smem, g, S, E, nullptr);
    asm volatile("s_waitcnt vmcnt(0)" ::: "memory");
    __syncthreads();
    const int w = opaque_tid() >> 6;
    pg8::Unit u;
    for (int i = 0; S.next(i, u); ++i)
        for (int q = 0; q < 2; ++q) topk_task(P, L, u.pm * 256 + 32 * w, 2 * u.pn + q);
    __syncthreads();
}

__device__ __forceinline__ void cswap(int& a, int& b) { int mx = max(a, b), mn = min(a, b); a = mx; b = mn; }
__device__ __forceinline__ void bitonic_sort16(int (&v)[16]) {
#pragma unroll
    for (int k = 2; k <= 16; k <<= 1)
#pragma unroll
        for (int j = k >> 1; j > 0; j >>= 1)
#pragma unroll
            for (int i = 0; i < 16; ++i) {
                int q = i ^ j;
                if (q > i) {
                    if ((i & k) == 0) cswap(v[i], v[q]); else cswap(v[q], v[i]);
                }
            }
}
__device__ __forceinline__ void merge_top16(int (&Lv)[16], const int (&Rv)[16]) {
#pragma unroll
    for (int i = 0; i < 16; ++i) Lv[i] = max(Lv[i], Rv[15 - i]);
#pragma unroll
    for (int j = 8; j > 0; j >>= 1)
#pragma unroll
        for (int i = 0; i < 16; ++i) {
            int q = i ^ j;
            if (q > i) cswap(Lv[i], Lv[q]);
        }
}
__device__ __forceinline__ int f2key(float v, int low, int mask) {
    int b = __float_as_int(v);
    b ^= (b >> 31) & 0x7fffffff;
    return (b & ~mask) | low;
}
__device__ __forceinline__ float key2f(int k, int mask) {
    int b = k & ~mask;
    b ^= (b >> 31) & 0x7fffffff;
    return __int_as_float(b);
}

__device__ __forceinline__ void topk_task(const Params& P, int L, int t0, int h) {
    char* ws = opq(P.ws);
    const bf16* pq = (const bf16*)(ws + OFF_PQ);
    const bf16* skb = (const bf16*)(ws + OFF_SKB) + (size_t)L * 16 * 128 * 64;
    unsigned short* ids = (unsigned short*)(ws + OFF_IDS);
    float* gates = (float*)(ws + OFF_GATE);
    const int tid = opaque_tid(), w = tid >> 6, l = tid & 63, r = l & 31, hh = l >> 5;
    unsigned char* lidx = (unsigned char*)(smem + w * 1024 + r * 32);
    {
        int F[2][16];
#pragma unroll
        for (int p = 0; p < 2; ++p) {
            const int hp = h * 2 + p;
            f32x16 acc[4];
            const f32x16 z16 = {0.f, 0.f, 0.f, 0.f, 0.f, 0.f, 0.f, 0.f, 0.f, 0.f, 0.f, 0.f, 0.f, 0.f, 0.f, 0.f};
#pragma unroll
            for (int kt = 0; kt < 4; ++kt) acc[kt] = z16;
#pragma unroll
            for (int s4 = 0; s4 < 4; ++s4) {
                bf16x8 bfr = *(const bf16x8*)(pq + (size_t)(t0 + r) * 1024 + hp * 64 + 16 * s4 + 8 * hh);
#pragma unroll
                for (int kt = 0; kt < 4; ++kt) {
                    bf16x8 af = *(const bf16x8*)(skb + ((size_t)hp * 128 + 32 * kt + r) * 64 + 16 * s4 + 8 * hh);
                    acc[kt] = __builtin_amdgcn_mfma_f32_32x32x16_bf16(af, bfr, acc[kt], 0, 0, 0);
                }
            }
            int K0[16], K1[16], K2[16], K3[16];
#pragma unroll
            for (int rr = 0; rr < 16; ++rr) {
                const int nb = (rr & 3) + 8 * (rr >> 2) + 4 * hh;
                K0[rr] = f2key(acc[0][rr], 127 - nb, 127);
                K1[rr] = f2key(acc[1][rr], 127 - (32 + nb), 127);
                K2[rr] = f2key(acc[2][rr], 127 - (64 + nb), 127);
                K3[rr] = f2key(acc[3][rr], 127 - (96 + nb), 127);
            }
            bitonic_sort16(K0); bitonic_sort16(K1); bitonic_sort16(K2); bitonic_sort16(K3);
            merge_top16(K0, K1);
            merge_top16(K2, K3);
            merge_top16(K0, K2);
#pragma unroll
            for (int i = 0; i < 16; ++i) K1[i] = partner32(K0[i], hh);
            merge_top16(K0, K1);
#pragma unroll
            for (int i = 0; i < 16; ++i) F[p][i] = K0[i];
        }
        if (hh == 0) {
#pragma unroll
            for (int q = 0; q < 4; ++q) {
                unsigned w1 = 0, w2 = 0;
#pragma unroll
                for (int e = 0; e < 4; ++e) {
                    w1 |= (unsigned)(127 - (F[0][4 * q + e] & 127)) << (8 * e);
                    w2 |= (unsigned)(127 - (F[1][4 * q + e] & 127)) << (8 * e);
                }
                ((unsigned*)lidx)[q] = w1;
                ((unsigned*)lidx)[4 + q] = w2;
            }
        }
        {
            float s1[16], s2[16];
#pragma unroll
            for (int i = 0; i < 16; ++i) { s1[i] = key2f(F[0][i], 127); s2[i] = key2f(F[1][i], 127); }
            int Lc[16], X[16];
#pragma unroll
            for (int b2 = 0; b2 < 16; ++b2) Lc[b2] = f2key(s1[0] + s2[b2], 255 - b2, 255);
#pragma unroll
            for (int a2 = 1; a2 < 16; ++a2) X[a2 - 1] = f2key(s1[a2] + s2[0], 255 - a2 * 16, 255);
            X[15] = INT_MIN;
            merge_top16(Lc, X);
            X[0] = f2key(s1[1] + s2[1], 255 - 17, 255); X[1] = f2key(s1[1] + s2[2], 255 - 18, 255); X[2] = f2key(s1[1] + s2[3], 255 - 19, 255);
            X[3] = f2key(s1[1] + s2[4], 255 - 20, 255); X[4] = f2key(s1[1] + s2[5], 255 - 21, 255); X[5] = f2key(s1[1] + s2[6], 255 - 22, 255);
            X[6] = f2key(s1[1] + s2[7], 255 - 23, 255);
            X[7] = f2key(s1[2] + s2[1], 255 - 33, 255); X[8] = f2key(s1[2] + s2[2], 255 - 34, 255); X[9] = f2key(s1[2] + s2[3], 255 - 35, 255);
            X[10] = f2key(s1[2] + s2[4], 255 - 36, 255);
            X[11] = f2key(s1[3] + s2[1], 255 - 49, 255); X[12] = f2key(s1[3] + s2[2], 255 - 50, 255); X[13] = f2key(s1[3] + s2[3], 255 - 51, 255);
            X[14] = f2key(s1[4] + s2[1], 255 - 65, 255); X[15] = f2key(s1[4] + s2[2], 255 - 66, 255);
            bitonic_sort16(X);
            merge_top16(Lc, X);
            X[0] = f2key(s1[5] + s2[1], 255 - 81, 255);
            X[1] = f2key(s1[6] + s2[1], 255 - 97, 255);
            X[2] = f2key(s1[7] + s2[1], 255 - 113, 255);
#pragma unroll
            for (int i = 3; i < 16; ++i) X[i] = INT_MIN;
            merge_top16(Lc, X);
            if (hh == 0) {
                float mx = key2f(Lc[0], 255);
                float ev[16], sum = 0.f;
#pragma unroll
                for (int k = 0; k < 16; ++k) { ev[k] = __expf(key2f(Lc[k], 255) - mx); sum += ev[k]; }
                float inv = 1.f / sum;
                size_t ob = (size_t)(t0 + r) * 128 + h * 16;
                unsigned idw[8];
#pragma unroll
                for (int k = 0; k < 16; ++k) {
                    int cidx = 255 - (Lc[k] & 255);
                    int i1 = lidx[cidx >> 4], i2 = lidx[16 + (cidx & 15)];
                    unsigned idv = (unsigned)(i1 * 128 + i2);
                    if (k & 1) idw[k >> 1] |= idv << 16; else idw[k >> 1] = idv;
                }
                u32x4 o0 = {idw[0], idw[1], idw[2], idw[3]}, o1 = {idw[4], idw[5], idw[6], idw[7]};
                *(u32x4*)(ids + ob) = o0;
                *(u32x4*)(ids + ob + 8) = o1;
#pragma unroll
                for (int q = 0; q < 4; ++q) {
                    f32x4 g4 = {ev[4 * q] * inv, ev[4 * q + 1] * inv, ev[4 * q + 2] * inv, ev[4 * q + 3] * inv};
                    *(f32x4*)(gates + ob + 4 * q) = g4;
                }
            }
        }
    }
}
__device__ __forceinline__ void phase_topk(const Params& P, int L) {
    const int w = opaque_tid() >> 6;
    for (int task = blockIdx.x * NW + w; task < (TOK / 32) * 8; task += gridDim.x * NW) topk_task(P, L, (task >> 3) * 32, task & 7);
}

__device__ __forceinline__ float gelu_exact(float x) { return 0.5f * x * (1.f + erff(x * 0.70710678118654752f)); }

__device__ __forceinline__ void dec16(const u32x4& v, float (&f)[16]) {
    f32x2 t;
    t = __builtin_amdgcn_cvt_pk_f32_fp8((int)v.x, false); f[0] = t.x; f[1] = t.y;
    t = __builtin_amdgcn_cvt_pk_f32_fp8((int)v.x, true);  f[2] = t.x; f[3] = t.y;
    t = __builtin_amdgcn_cvt_pk_f32_fp8((int)v.y, false); f[4] = t.x; f[5] = t.y;
    t = __builtin_amdgcn_cvt_pk_f32_fp8((int)v.y, true);  f[6] = t.x; f[7] = t.y;
    t = __builtin_amdgcn_cvt_pk_f32_fp8((int)v.z, false); f[8] = t.x; f[9] = t.y;
    t = __builtin_amdgcn_cvt_pk_f32_fp8((int)v.z, true);  f[10] = t.x; f[11] = t.y;
    t = __builtin_amdgcn_cvt_pk_f32_fp8((int)v.w, false); f[12] = t.x; f[13] = t.y;
    t = __builtin_amdgcn_cvt_pk_f32_fp8((int)v.w, true);  f[14] = t.x; f[15] = t.y;
}

__device__ __forceinline__ void dec32(const u32x4& v, f32x2 (&f)[16]) {
    f[0] = __builtin_amdgcn_cvt_scalef32_pk_f32_fp4(v.x, 1.0f, 0); f[1] = __builtin_amdgcn_cvt_scalef32_pk_f32_fp4(v.x, 1.0f, 1);
    f[2] = __builtin_amdgcn_cvt_scalef32_pk_f32_fp4(v.x, 1.0f, 2); f[3] = __builtin_amdgcn_cvt_scalef32_pk_f32_fp4(v.x, 1.0f, 3);
    f[4] = __builtin_amdgcn_cvt_scalef32_pk_f32_fp4(v.y, 1.0f, 0); f[5] = __builtin_amdgcn_cvt_scalef32_pk_f32_fp4(v.y, 1.0f, 1);
    f[6] = __builtin_amdgcn_cvt_scalef32_pk_f32_fp4(v.y, 1.0f, 2); f[7] = __builtin_amdgcn_cvt_scalef32_pk_f32_fp4(v.y, 1.0f, 3);
    f[8] = __builtin_amdgcn_cvt_scalef32_pk_f32_fp4(v.z, 1.0f, 0); f[9] = __builtin_amdgcn_cvt_scalef32_pk_f32_fp4(v.z, 1.0f, 1);
    f[10] = __builtin_amdgcn_cvt_scalef32_pk_f32_fp4(v.z, 1.0f, 2); f[11] = __builtin_amdgcn_cvt_scalef32_pk_f32_fp4(v.z, 1.0f, 3);
    f[12] = __builtin_amdgcn_cvt_scalef32_pk_f32_fp4(v.w, 1.0f, 0); f[13] = __builtin_amdgcn_cvt_scalef32_pk_f32_fp4(v.w, 1.0f, 1);
    f[14] = __builtin_amdgcn_cvt_scalef32_pk_f32_fp4(v.w, 1.0f, 2); f[15] = __builtin_amdgcn_cvt_scalef32_pk_f32_fp4(v.w, 1.0f, 3);
}

typedef _Float16 f16x2 __attribute__((ext_vector_type(2)));
__device__ __forceinline__ void dec8_f16(unsigned x, f16x2 (&wv)[4]) {
    const unsigned lo = x & 0x07070707u, hi = (x >> 4) & 0x07070707u;
    const unsigned Lb = __builtin_amdgcn_perm(0x46444240u, 0x3E3C3800u, lo) | ((x & 0x08080808u) << 4);
    const unsigned Hb = __builtin_amdgcn_perm(0x46444240u, 0x3E3C3800u, hi) | (x & 0x80808080u);
    wv[0] = __builtin_bit_cast(f16x2, __builtin_amdgcn_perm(Hb, Lb, 0x040c000cu));
    wv[1] = __builtin_bit_cast(f16x2, __builtin_amdgcn_perm(Hb, Lb, 0x050c010cu));
    wv[2] = __builtin_bit_cast(f16x2, __builtin_amdgcn_perm(Hb, Lb, 0x060c020cu));
    wv[3] = __builtin_bit_cast(f16x2, __builtin_amdgcn_perm(Hb, Lb, 0x070c030cu));
}

typedef _Float16 f16x2 __attribute__((ext_vector_type(2)));
__device__ __forceinline__ void dec32h(const u32x4& v, f16x2 (&f)[16]) {
    f[0] = __builtin_amdgcn_cvt_scalef32_pk_f16_fp4(v.x, 1.0f, 0); f[1] = __builtin_amdgcn_cvt_scalef32_pk_f16_fp4(v.x, 1.0f, 1);
    f[2] = __builtin_amdgcn_cvt_scalef32_pk_f16_fp4(v.x, 1.0f, 2); f[3] = __builtin_amdgcn_cvt_scalef32_pk_f16_fp4(v.x, 1.0f, 3);
    f[4] = __builtin_amdgcn_cvt_scalef32_pk_f16_fp4(v.y, 1.0f, 0); f[5] = __builtin_amdgcn_cvt_scalef32_pk_f16_fp4(v.y, 1.0f, 1);
    f[6] = __builtin_amdgcn_cvt_scalef32_pk_f16_fp4(v.y, 1.0f, 2); f[7] = __builtin_amdgcn_cvt_scalef32_pk_f16_fp4(v.y, 1.0f, 3);
    f[8] = __builtin_amdgcn_cvt_scalef32_pk_f16_fp4(v.z, 1.0f, 0); f[9] = __builtin_amdgcn_cvt_scalef32_pk_f16_fp4(v.z, 1.0f, 1);
    f[10] = __builtin_amdgcn_cvt_scalef32_pk_f16_fp4(v.z, 1.0f, 2); f[11] = __builtin_amdgcn_cvt_scalef32_pk_f16_fp4(v.z, 1.0f, 3);
    f[12] = __builtin_amdgcn_cvt_scalef32_pk_f16_fp4(v.w, 1.0f, 0); f[13] = __builtin_amdgcn_cvt_scalef32_pk_f16_fp4(v.w, 1.0f, 1);
    f[14] = __builtin_amdgcn_cvt_scalef32_pk_f16_fp4(v.w, 1.0f, 2); f[15] = __builtin_amdgcn_cvt_scalef32_pk_f16_fp4(v.w, 1.0f, 3);
}

__device__ __forceinline__ int idof16(const u32x4 (&q)[2], int i) {
    unsigned wv = (i >> 1) == 0 ? q[0].x : (i >> 1) == 1 ? q[0].y : (i >> 1) == 2 ? q[0].z : (i >> 1) == 3 ? q[0].w
                : (i >> 1) == 4 ? q[1].x : (i >> 1) == 5 ? q[1].y : (i >> 1) == 6 ? q[1].z : q[1].w;
    return (i & 1) ? (int)(wv >> 16) : (int)(wv & 0xffffu);
}
typedef int i32x8 __attribute__((ext_vector_type(8)));
#define GU_WAIT_V(n) asm volatile("s_waitcnt vmcnt(" #n ")" ::: "memory")
#define GU_WAIT_L0() asm volatile("s_waitcnt lgkmcnt(0)" ::: "memory")
__device__ __forceinline__ void phase_gather_u(const Params& P, int L) {
    char* ws = opq(P.ws);
    const unsigned char* U4 = (const unsigned char*)(ws + OFF_UB) + (size_t)L * NEXP * 512;
    float* part = (float*)(ws + OFF_PART);
    const unsigned short* ids = (const unsigned short*)(ws + OFF_IDS);
    const int tid = opaque_tid(), w = tid >> 6, l = tid & 63, i = l & 15, g4 = l >> 4, rr = l >> 3, dc = (l & 7) ^ rr;
    const int sl = blockIdx.x & 3, par = (blockIdx.x >> 2) & 1, rk = blockIdx.x >> 3, nb = gridDim.x >> 3;
    if (rk >= nb) return;
    PG8_LAS unsigned char* wl = (PG8_LAS unsigned char*)smem + w * 16384;
    const unsigned char* ubase = U4 + (size_t)sl * NEXP * 128 + dc * 16;
    const unsigned char* xbase = (const unsigned char*)(ws + OFF_XH) + (i == 1 ? 16 * MBy : 0) + 256 * sl + 16 * g4;
    const int scb = (i == 1) ? 123 : 127;
    const unsigned a0 = 1024u * (i >> 3) + 128u * (i & 7) + 16u * (g4 ^ (i & 7)), a1 = a0 ^ 64u;
    const int stride = nb * NW;
    int ti = rk * NW + w;
    if (ti >= TOK / 2) return;
    u32x4 idA[2], idB[2];
    u32x4 xA[4], xB[4];
    auto load_ids = [&](int tt, u32x4 (&idq)[2]) {
        const unsigned short* ip = ids + (size_t)tt * 128 + 16 * rr;
        asm volatile("global_load_dwordx4 %0, %2, off\n\tglobal_load_dwordx4 %1, %2, off offset:16" : "=&v"(idq[0]), "=&v"(idq[1]) : "v"(ip));
    };
    auto load_x = [&](int tt, u32x4 (&xx)[4]) {
        const unsigned char* p = xbase + (size_t)tt * 1024;
        asm volatile("global_load_dwordx4 %0, %4, off\n\tglobal_load_dwordx4 %1, %4, off offset:64\n\t"
                     "global_load_dwordx4 %2, %4, off offset:128\n\tglobal_load_dwordx4 %3, %4, off offset:192"
                     : "=&v"(xx[0]), "=&v"(xx[1]), "=&v"(xx[2]), "=&v"(xx[3]) : "v"(p));
    };
    auto pin = [&](u32x4 (&idq)[2], u32x4 (&xx)[4]) {
        asm volatile("" : "+v"(idq[0]), "+v"(idq[1]), "+v"(xx[0]), "+v"(xx[1]), "+v"(xx[2]), "+v"(xx[3]));
    };
    auto dma_half = [&](const u32x4 (&idq)[2], int h) {
#pragma unroll
        for (int jj = 0; jj < 8; ++jj) {
            const int j = 8 * h + jj;
            __builtin_amdgcn_global_load_lds((const unsigned*)(ubase + (size_t)idof16(idq, j) * 128), (PG8_LAS unsigned*)(wl + 1024 * j), 16, 0, 0);
        }
    };
    const unsigned la0 = (unsigned)(size_t)wl + a0, la1 = (unsigned)(size_t)wl + a1;
    auto mma_half = [&](f32x4 (&acc)[8], const u32x4 (&xc)[4], int h) {
        u32x4 av[8];
        if (h == 0)
            asm volatile("ds_read_b128 %0, %8\n\tds_read_b128 %1, %9\n\tds_read_b128 %2, %8 offset:2048\n\tds_read_b128 %3, %9 offset:2048\n\t"
                         "ds_read_b128 %4, %8 offset:4096\n\tds_read_b128 %5, %9 offset:4096\n\tds_read_b128 %6, %8 offset:6144\n\tds_read_b128 %7, %9 offset:6144\n\t"
                         "s_waitcnt lgkmcnt(0)"
                         : "=&v"(av[0]), "=&v"(av[1]), "=&v"(av[2]), "=&v"(av[3]), "=&v"(av[4]), "=&v"(av[5]), "=&v"(av[6]), "=&v"(av[7]) : "v"(la0), "v"(la1));
        else
            asm volatile("ds_read_b128 %0, %8 offset:8192\n\tds_read_b128 %1, %9 offset:8192\n\tds_read_b128 %2, %8 offset:10240\n\tds_read_b128 %3, %9 offset:10240\n\t"
                         "ds_read_b128 %4, %8 offset:12288\n\tds_read_b128 %5, %9 offset:12288\n\tds_read_b128 %6, %8 offset:14336\n\tds_read_b128 %7, %9 offset:14336\n\t"
                         "s_waitcnt lgkmcnt(0)"
                         : "=&v"(av[0]), "=&v"(av[1]), "=&v"(av[2]), "=&v"(av[3]), "=&v"(av[4]), "=&v"(av[5]), "=&v"(av[6]), "=&v"(av[7]) : "v"(la0), "v"(la1));
#pragma unroll
        for (int qq = 0; qq < 4; ++qq) {
#pragma unroll
            for (int hf = 0; hf < 2; ++hf) {
                const u32x4 a = av[2 * qq + hf];
                const i32x8 A = {(int)a.x, (int)a.y, (int)a.z, (int)a.w, 0, 0, 0, 0};
                const u32x4 b0 = xc[2 * hf], b1 = xc[2 * hf + 1];
                const i32x8 B = {(int)b0.x, (int)b0.y, (int)b0.z, (int)b0.w, (int)b1.x, (int)b1.y, (int)b1.z, (int)b1.w};
                f32x4 c = {0.f, 0.f, 0.f, 0.f};
                if (hf) c = acc[4 * h + qq];
                acc[4 * h + qq] = __builtin_amdgcn_mfma_scale_f32_16x16x128_f8f6f4(A, B, c, 4, 0, 0, 127, 0, scb);
            }
        }
    };
    auto step = [&](int tcur, int tnext, int tnext2, u32x4 (&idn)[2], u32x4 (&idl)[2], u32x4 (&xc)[4], u32x4 (&xn)[4]) {
        f32x4 acc[8];
        __builtin_amdgcn_sched_barrier(0);
        GU_WAIT_V(8);
        pin(idn, xc);
        __builtin_amdgcn_sched_barrier(0);
        mma_half(acc, xc, 0);
        __builtin_amdgcn_sched_barrier(0);
        dma_half(idn, 0);
        __builtin_amdgcn_sched_barrier(0);
        load_ids(tnext2, idl);
        load_x(tnext, xn);
        __builtin_amdgcn_sched_barrier(0);
        GU_WAIT_V(14);
        __builtin_amdgcn_sched_barrier(0);
        mma_half(acc, xc, 1);
        __builtin_amdgcn_sched_barrier(0);
#pragma unroll
        for (int q = 0; q < 8; ++q)
#pragma unroll
            for (int r = 0; r < 4; ++r) acc[q][r] = dpp_add<0xB1>(acc[q][r]);
        if (i == 0) {
            float* o = part + ((size_t)sl * TOK + tcur) * 128 + 32 * g4;
#pragma unroll
            for (int r = 0; r < 4; ++r)
#pragma unroll
                for (int gh = 0; gh < 2; ++gh) {
                    f32x4 ov = {acc[4 * gh][r], acc[4 * gh + 1][r], acc[4 * gh + 2][r], acc[4 * gh + 3][r]};
                    asm volatile("global_store_dwordx4 %0, %1, off offset:%2" :: "v"(o), "v"(ov), "n"(32 * r + 16 * gh) : "memory");
                }
        }
        __builtin_amdgcn_sched_barrier(0);
        dma_half(idn, 1);
        __builtin_amdgcn_sched_barrier(0);
    };
    auto tok = [&](int tidx, int fb) { return 2 * (tidx < TOK / 2 ? tidx : fb) + par; };
    load_ids(tok(ti, ti), idA);
    __builtin_amdgcn_sched_barrier(0);
    GU_WAIT_V(0);
    asm volatile("" : "+v"(idA[0]), "+v"(idA[1]));
    __builtin_amdgcn_sched_barrier(0);
    dma_half(idA, 0);
    __builtin_amdgcn_sched_barrier(0);
    load_ids(tok(ti + stride, ti), idB);
    load_x(tok(ti, ti), xA);
    __builtin_amdgcn_sched_barrier(0);
    dma_half(idA, 1);
    __builtin_amdgcn_sched_barrier(0);
    for (;;) {
        int tn = ti + stride, tn2 = ti + 2 * stride;
        step(tok(ti, ti), tok(tn, ti), tok(tn2, ti), idB, idA, xA, xB);
        if (tn >= TOK / 2) break;
        ti = tn; tn = ti + stride; tn2 = ti + 2 * stride;
        step(tok(ti, ti), tok(tn, ti), tok(tn2, ti), idA, idB, xB, xA);
        if (tn >= TOK / 2) break;
        ti = tn;
    }
    GU_WAIT_V(0);
    asm volatile("" :: "v"(idA[0]), "v"(idA[1]), "v"(idB[0]), "v"(idB[1]), "v"(xA[0]), "v"(xA[1]), "v"(xA[2]), "v"(xA[3]), "v"(xB[0]), "v"(xB[1]), "v"(xB[2]), "v"(xB[3]));
}

__device__ __forceinline__ void phase_gather_act(const Params& P, int L, int ss_slot, int fake = 0) {
    char* ws = opq(P.ws);
    const float* ss_ffn = (const float*)(ws + OFF_SSA) + (size_t)ss_slot * TOK * 8;
    const float* part = (const float*)(ws + OFF_PART);
    const unsigned short* ids = (const unsigned short*)(ws + OFF_IDS);
    const float* gates = (const float*)(ws + OFF_GATE);
    const float* uinv = (const float*)(ws + OFF_TSC) + L * NEXP;
    const float* vinv = (const float*)(ws + OFF_TSC) + (2 + L) * NEXP;
    const int tid = opaque_tid(), w = tid >> 6, l = tid & 63;
    const int stride = gridDim.x * NW;
    for (int t0 = blockIdx.x * NW + w; t0 < TOK; t0 += 4 * stride) {
        f32x2 pa[4][4], gt[4];
        unsigned idw[4];
        f32x4 s0[4], s1[4];
#pragma unroll
        for (int q = 0; q < 4; ++q) {
            const int t = (t0 + q * stride < TOK) ? (t0 + q * stride) : t0;
#pragma unroll
            for (int j = 0; j < 4; ++j) { pa[q][j].x = part[((size_t)j * TOK + t) * 128 + l]; pa[q][j].y = part[((size_t)j * TOK + t) * 128 + 64 + l]; }
            idw[q] = *(const unsigned*)(ids + (size_t)t * 128 + 2 * l);
            gt[q] = *(const f32x2*)(gates + (size_t)t * 128 + 2 * l);
            s0[q] = *(const f32x4*)(ss_ffn + (size_t)t * 8); s1[q] = *(const f32x4*)(ss_ffn + (size_t)t * 8 + 4);
        }
        float ui[4][2], vi[4][2];
#pragma unroll
        for (int q = 0; q < 4; ++q) {
            const int i0 = (int)(idw[q] & 0xffffu), i1 = (int)(idw[q] >> 16);
            ui[q][0] = uinv[i0]; ui[q][1] = uinv[i1]; vi[q][0] = vinv[i0]; vi[q][1] = vinv[i1];
        }
#pragma unroll
        for (int q = 0; q < 4; ++q) {
            const int t = t0 + q * stride;
            if (t < TOK) {
                const float ssum = ((s0[q].x + s0[q].y) + (s0[q].z + s0[q].w)) + ((s1[q].x + s1[q].y) + (s1[q].z + s1[q].w));
                const float rs = rsqrtf(ssum * (1.f / 1024.f) + EPSF);
                f32x2 sa = (pa[q][0] + pa[q][1]) + (pa[q][2] + pa[q][3]);
                f32x2 o;
                o.x = gt[q].x * gelu_exact(sa.x * rs * ui[q][0]) * vi[q][0];
                o.y = gt[q].y * gelu_exact(sa.y * rs * ui[q][1]) * vi[q][1];
                float am = fmaxf(fabsf(o.x), fabsf(o.y));
#pragma unroll
                for (int sh = 32; sh > 0; sh >>= 1) am = fmaxf(am, __shfl_xor(am, sh));
                int ex = (int)((__builtin_bit_cast(unsigned, am) >> 23) & 0xffu) - 127;
                int e = 7 - ex; e = e > 100 ? 100 : (e < -100 ? -100 : e);
                if (!(am > 0.f)) e = 0;
                const float sc2 = __builtin_bit_cast(float, (unsigned)(127 + e) << 23);
                const float s0 = __builtin_amdgcn_fmed3f(o.x * sc2, -448.f, 448.f), s1 = __builtin_amdgcn_fmed3f(o.y * sc2, -448.f, 448.f);
                const int h8 = __builtin_amdgcn_cvt_pk_fp8_f32(s0, s1, 0, false);
                const f32x2 hb2 = __builtin_amdgcn_cvt_pk_f32_fp8(h8, false);
                const int l8 = __builtin_amdgcn_cvt_pk_fp8_f32((s0 - hb2.x) * 16.f, (s1 - hb2.y) * 16.f, 0, false);
                unsigned char* a8 = (unsigned char*)(ws + (fake ? OFF_Y : OFF_A8)) + (size_t)t * 128 + 16 * (l & 7) + (l >> 3);
                a8[0] = (unsigned char)(h8 & 0xff); a8[8] = (unsigned char)((h8 >> 8) & 0xff);
                a8[2 * MBy] = (unsigned char)(l8 & 0xff); a8[2 * MBy + 8] = (unsigned char)((l8 >> 8) & 0xff);
                if (l == 0) ((int*)(ws + (fake ? OFF_Y : OFF_A8) + 4 * MBy))[t] = e;
            }
        }
    }
}

__device__ __forceinline__ void phase_gather_v(const Params& P, int L, int hsel, int ss_slot, int fake = 0) {
    char* ws = opq(P.ws);
    float* ss_ple = fake ? (float*)(ws + OFF_FQ) : (float*)(ws + OFF_SSA) + (size_t)ss_slot * TOK * 8;
    bf16* hb_out = fake ? (bf16*)(ws + OFF_PART) : (bf16*)(ws + (hsel ? OFF_HB1 : OFF_HB0));
    const bf16* hbin = (const bf16*)(ws + (hsel ? OFF_HB0 : OFF_HB1));
    const unsigned char* V4 = (const unsigned char*)(ws + OFF_VB) + (size_t)L * NEXP * 512;
    const unsigned short* ids = (const unsigned short*)(ws + OFF_IDS);
    const int tid = opaque_tid(), w = tid >> 6, l = tid & 63, i = l & 15, g4 = l >> 4, rr = l >> 3;
    const int sl = blockIdx.x & 3, par = (blockIdx.x >> 2) & 1, rk = blockIdx.x >> 3, nb = gridDim.x >> 3;
    if (rk >= nb) return;
    PG8_LAS unsigned char* wl = (PG8_LAS unsigned char*)smem + w * 16384;
    PG8_LAS unsigned char* wo = (PG8_LAS unsigned char*)smem + 8 * 16384 + w * 1024;
    const int dc0 = (l & 7) ^ (rr >> 1);
    const unsigned char* vbase0 = V4 + (size_t)sl * NEXP * 128 + dc0 * 16;
    const unsigned char* vbase1 = V4 + (size_t)sl * NEXP * 128 + (dc0 ^ 4) * 16;
    const unsigned char* abase = (const unsigned char*)(ws + OFF_A8) + ((i & 3) == 1 ? 2 * MBy : 0) + 16 * g4;
    const int* ebase = (const int*)(ws + OFF_A8 + 4 * MBy);
    const unsigned kb = 16u * (unsigned)((i >> 1) ^ (4 * (g4 & 1)));
    const unsigned rbase = (unsigned)(size_t)wl + 128u * (unsigned)(32 * g4 + i);
    const unsigned wob = (unsigned)(size_t)wo;
    const int stride = nb * NW;
    int ti = rk * NW + w;
    if (ti >= TOK / 2) return;
    u32x4 idA[2], idB[2];
    u32x4 aA[2], aB[2];
    int eA, eB;
    u32x2 hA, hB;
    auto load_ids = [&](int tt, u32x4 (&idq)[2]) {
        const unsigned short* ip = ids + (size_t)tt * 128 + 16 * rr;
        asm volatile("global_load_dwordx4 %0, %2, off\n\tglobal_load_dwordx4 %1, %2, off offset:16" : "=&v"(idq[0]), "=&v"(idq[1]) : "v"(ip));
    };
    auto load_tok = [&](int tt, u32x4 (&ax)[2], int& ex, u32x2& hx) {
        const unsigned char* ap = abase + (size_t)tt * 128;
        const int* ep = ebase + tt;
        const bf16* hp = hbin + (size_t)tt * LDH + 256 * sl + 4 * l;
        asm volatile("global_load_dwordx4 %0, %4, off\n\tglobal_load_dwordx4 %1, %4, off offset:64\n\tglobal_load_dword %2, %5, off\n\tglobal_load_dwordx2 %3, %6, off"
                     : "=&v"(ax[0]), "=&v"(ax[1]), "=&v"(ex), "=&v"(hx) : "v"(ap), "v"(ep), "v"(hp));
    };
    auto dma_all = [&](const u32x4 (&idq)[2]) {
#pragma unroll
        for (int j = 0; j < 16; ++j) {
            const unsigned char* vb = (((j ^ (j >> 2)) & 1) ? vbase1 : vbase0);
            __builtin_amdgcn_global_load_lds((const unsigned*)(vb + (size_t)idof16(idq, j) * 128), (PG8_LAS unsigned*)(wl + 1024 * j), 16, 0, 0);
        }
    };
    u32x2 pend_h = {0u, 0u}; float pend_ss = 0.f; int pend_t = -1;
    auto step = [&](int tcur, int tnext, int tnext2, u32x4 (&idn)[2], u32x4 (&idl)[2], u32x4 (&ac)[2], int& ec, u32x2& hc, u32x4 (&an)[2], int& en, u32x2& hn) {
        __builtin_amdgcn_sched_barrier(0);
        GU_WAIT_V(0);
        asm volatile("" : "+v"(idn[0]), "+v"(idn[1]), "+v"(ac[0]), "+v"(ac[1]), "+v"(ec), "+v"(hc));
        __builtin_amdgcn_sched_barrier(0);
        u32x2 bq[16][2];
#pragma unroll
        for (int c = 0; c < 8; ++c) {
            const unsigned ad = rbase + ((16u * c) ^ kb);
            asm volatile("ds_read_b64_tr_b4 %0, %4\n\tds_read_b64_tr_b4 %1, %4 offset:2048\n\tds_read_b64_tr_b4 %2, %4 offset:8\n\tds_read_b64_tr_b4 %3, %4 offset:2056"
                         : "=&v"(bq[2 * c][0]), "=&v"(bq[2 * c][1]), "=&v"(bq[2 * c + 1][0]), "=&v"(bq[2 * c + 1][1]) : "v"(ad));
        }
        asm volatile("s_waitcnt lgkmcnt(0)" ::: "memory");
#pragma unroll
        for (int c = 0; c < 16; ++c) asm volatile("" : "+v"(bq[c][0]), "+v"(bq[c][1]));
        __builtin_amdgcn_sched_barrier(0);
        if (pend_t >= 0) {
            bf16* op = hb_out + (size_t)pend_t * LDH + 256 * sl + 4 * l;
            asm volatile("global_store_dwordx2 %0, %1, off" :: "v"(op), "v"(pend_h) : "memory");
            if (l == 0) {
                float* sp = ss_ple + (size_t)pend_t * 8 + sl;
                const float zf = 0.f;
                asm volatile("global_store_dword %0, %1, off\n\tglobal_store_dword %0, %2, off offset:16" :: "v"(sp), "v"(pend_ss), "v"(zf) : "memory");
            }
        }
        __builtin_amdgcn_sched_barrier(0);
        dma_all(idn);
        __builtin_amdgcn_sched_barrier(0);
        load_ids(tnext2, idl);
        load_tok(tnext, an, en, hn);
        __builtin_amdgcn_sched_barrier(0);
        const int sca = 127 - ec - (((i & 3) == 1) ? 4 : 0);
        const i32x8 A = {(int)ac[0].x, (int)ac[0].y, (int)ac[0].z, (int)ac[0].w, (int)ac[1].x, (int)ac[1].y, (int)ac[1].z, (int)ac[1].w};
        f32x4 acc[16];
#pragma unroll
        for (int cb = 0; cb < 16; ++cb) {
            const i32x8 B = {(int)bq[cb][0].x, (int)bq[cb][0].y, (int)bq[cb][1].x, (int)bq[cb][1].y, 0, 0, 0, 0};
            const f32x4 z = {0.f, 0.f, 0.f, 0.f};
            acc[cb] = __builtin_amdgcn_mfma_scale_f32_16x16x128_f8f6f4(A, B, z, 0, 4, 0, sca, 0, 127);
        }
#pragma unroll
        for (int q = 0; q < 4; ++q) {
            float v = 0.f;
#pragma unroll
            for (int g = 0; g < 4; ++g) { const float t2 = acc[4 * g + q][0] + acc[4 * g + q][1]; v = (g4 == g) ? t2 : v; }
            const unsigned wa = wob + 4u * (unsigned)(64 * g4 + 16 * q + i);
            asm volatile("ds_write_b32 %0, %1" :: "v"(wa), "v"(v) : "memory");
        }
        f32x4 ov;
        {
            const unsigned ra = wob + 16u * (unsigned)l;
            asm volatile("s_waitcnt lgkmcnt(0)\n\tds_read_b128 %0, %1\n\ts_waitcnt lgkmcnt(0)" : "=&v"(ov) : "v"(ra) : "memory");
        }
        f32x4 hv = {bflo(hc.x) + ov[0], bfhi(hc.x) + ov[1], bflo(hc.y) + ov[2], bfhi(hc.y) + ov[3]};
        pend_h.x = pack2(hv.x, hv.y); pend_h.y = pack2(hv.z, hv.w);
        float ssq = hv.x * hv.x + hv.y * hv.y + hv.z * hv.z + hv.w * hv.w;
        pend_ss = wave_sum(ssq);
        pend_t = tcur;
        __builtin_amdgcn_sched_barrier(0);
    };
    auto tok = [&](int tidx, int fb) { return 2 * (tidx < TOK / 2 ? tidx : fb) + par; };
    load_ids(tok(ti, ti), idA);
    __builtin_amdgcn_sched_barrier(0);
    GU_WAIT_V(0);
    asm volatile("" : "+v"(idA[0]), "+v"(idA[1]));
    __builtin_amdgcn_sched_barrier(0);
    dma_all(idA);
    __builtin_amdgcn_sched_barrier(0);
    load_ids(tok(ti + stride, ti), idB);
    load_tok(tok(ti, ti), aA, eA, hA);
    __builtin_amdgcn_sched_barrier(0);
    for (;;) {
        int tn = ti + stride, tn2 = ti + 2 * stride;
        step(tok(ti, ti), tok(tn, ti), tok(tn2, ti), idB, idA, aA, eA, hA, aB, eB, hB);
        if (tn >= TOK / 2) break;
        ti = tn; tn = ti + stride; tn2 = ti + 2 * stride;
        step(tok(ti, ti), tok(tn, ti), tok(tn2, ti), idA, idB, aB, eB, hB, aA, eA, hA);
        if (tn >= TOK / 2) break;
        ti = tn;
    }
    asm volatile("s_waitcnt vmcnt(0)" : "+v"(pend_t), "+v"(pend_h), "+v"(pend_ss) :: "memory");
    asm volatile("" :: "v"(idA[0]), "v"(idA[1]), "v"(idB[0]), "v"(idB[1]), "v"(aA[0]), "v"(aA[1]), "v"(aB[0]), "v"(aB[1]), "v"(eA), "v"(eB), "v"(hA), "v"(hB));
    {
        bf16* op = hb_out + (size_t)pend_t * LDH + 256 * sl + 4 * l;
        *(u32x2*)op = pend_h;
        if (l == 0) { ss_ple[(size_t)pend_t * 8 + sl] = pend_ss; ss_ple[(size_t)pend_t * 8 + 4 + sl] = 0.f; }
    }
}

struct EpiStoreBf16 {
    static constexpr bool PERM = true, AFTER_DRAIN = false;
    bf16* O;
    __device__ __forceinline__ void khook(int, f32x4 (&)[2][2][4][2], int, int) const {}
    __device__ __forceinline__ void operator()(const f32x4 (&acc)[2][2][4][2], const pg8::Unit& u, int wr, int wc, int fr, int fqd) const {
        const int row0 = u.pm * 256 + wr * 64 + fr, col0 = u.pn * 256 + wc * 32 + 8 * fqd;
#pragma unroll
        for (int ai = 0; ai < 2; ++ai)
#pragma unroll
            for (int m = 0; m < 4; ++m) {
                bf16* rowp = O + (size_t)(row0 + ai * 128 + m * 16) * 1024 + col0;
#pragma unroll
                for (int bj = 0; bj < 2; ++bj) {
                    const f32x4 v0 = acc[ai][bj][m][0], v1 = acc[ai][bj][m][1];
                    u32x4 wv = {pack2(v0[0], v0[1]), pack2(v0[2], v0[3]), pack2(v1[0], v1[1]), pack2(v1[2], v1[3])};
                    *(u32x4*)(rowp + bj * 128) = wv;
                }
            }
    }
};
__device__ __forceinline__ void phase_pw(const Params& P) {
    char* ws = opq(P.ws);
    pg8::StaticOrder S; S.init(TOK, 1024, gridDim.x, blockIdx.x);
    for (int L = 0; L < 2; ++L) {
        pg8::Gemm g{(const bf16*)(ws + OFF_PB) + (size_t)L * TOK * LDP, (const bf16*)(ws + OFF_WP) + (size_t)L * 1024 * LDP, LDP, LDP, TOK, 1024, 256};
        EpiStoreBf16 E{(bf16*)(ws + (L ? OFF_PW1 : OFF_PW0))};
        pg8::gemm_phase((PG8_LAS unsigned char*)smem, g, S, E, nullptr);
        __syncthreads();
    }
}
struct EpiPle {
    static constexpr bool PERM = true, AFTER_DRAIN = true;
    const bf16* PW; const bf16* hb_in; bf16* hb_out; float* gss;
    __device__ __forceinline__ void khook(int, f32x4 (&)[2][2][4][2], int, int) const {}
    __device__ __forceinline__ void operator()(const f32x4 (&)[2][2][4][2], const pg8::Unit&, int, int, int, int) const {}
    __device__ __forceinline__ void fused(const f32x4 (&acc)[2][2][4][2], const pg8::Unit& u, int wr, int wc, int fr, int fqd, PG8_LAS unsigned char*, int, int) const {
        residual_fused<true, false>(acc, u, wr, wc, fr, fqd, (const float*)(smem + LDS_AUX), PW, hb_in, hb_out, gss);
    }
};
__device__ __forceinline__ void phase_ple(const Params& P, int L, int hsel, int ss_slot_in, int ss_slot_out, int fake = 0) {
    char* ws = opq(P.ws);
    const float* ss_ple = (const float*)(ws + OFF_SSA) + (size_t)ss_slot_in * TOK * 8;
    float* ss_out = (float*)(ws + OFF_SSA) + (size_t)ss_slot_out * TOK * 8;
    const bf16* hb_in = (const bf16*)(ws + (hsel ? OFF_HB1 : OFF_HB0));
    bf16* hb_out = (bf16*)(ws + (hsel ? OFF_HB0 : OFF_HB1));
    const bf16* Wg = (const bf16*)(ws + OFF_WG) + (size_t)L * 1024 * LDH;
    float* aux = (float*)(smem + LDS_AUX);
    const int tid = opaque_tid();
    pg8::Gemm g{hb_in, Wg, LDH, LDH, TOK, 1024, 1024};
    pg8::StaticOrder S; S.init(TOK, 1024, gridDim.x, blockIdx.x);
    pg8::Unit u0;
    if (S.next(0, u0) && tid < 256) aux[tid] = row_rs8(ss_ple, u0.pm * 256 + tid);
    __syncthreads();
    EpiPle E{(const bf16*)(ws + (L ? OFF_PW1 : OFF_PW0)), hb_in, fake ? (bf16*)(ws + OFF_PART) : hb_out, fake ? (float*)(ws + OFF_FQ) : ss_out};
    pg8::gemm_phase((PG8_LAS unsigned char*)smem, g, S, E, nullptr);
    __syncthreads();
}

__device__ __forceinline__ void phase_final(const Params& P, int ss_slot, int hsel) {
    char* ws = opq(P.ws);
    float* out = opq(P.out);
    const bf16* hbin = (const bf16*)(ws + (hsel ? OFF_HB1 : OFF_HB0));
    const float* ss = (const float*)(ws + OFF_SSA) + (size_t)ss_slot * TOK * 8;
    const int tid = opaque_tid(), w = tid >> 6, l = tid & 63;
    const float4* g4 = (const float4*)P.final_norm_g;
    for (int t = blockIdx.x * NW + w; t < TOK; t += gridDim.x * NW) {
        float rs = row_rs8(ss, t);
        float4* o4 = (float4*)(out + (size_t)t * 1024);
#pragma unroll
        for (int i = 0; i < 2; ++i) {
            u32x4 hq = *(const u32x4*)(hbin + (size_t)t * LDH + (i * 64 + l) * 8);
            float4 ga = g4[(i * 64 + l) * 2], gb = g4[(i * 64 + l) * 2 + 1];
            float4 va = {bflo(hq.x) * rs * ga.x, bfhi(hq.x) * rs * ga.y, bflo(hq.y) * rs * ga.z, bfhi(hq.y) * rs * ga.w};
            float4 vb = {bflo(hq.z) * rs * gb.x, bfhi(hq.z) * rs * gb.y, bflo(hq.w) * rs * gb.z, bfhi(hq.w) * rs * gb.w};
            {
                const f32x4 na = {va.x, va.y, va.z, va.w}, nb2 = {vb.x, vb.y, vb.z, vb.w};
                __builtin_nontemporal_store(na, (f32x4*)(o4 + (i * 64 + l) * 2));
                __builtin_nontemporal_store(nb2, (f32x4*)(o4 + (i * 64 + l) * 2 + 1));
            }
        }
    }
}

#define XB_TMO      128
#define XB_XCNT(j)  (256  + 64 * (j))
#define XB_XSUB(j)  (1280 + 64 * (j))
#define XB_XGEN(j)  (2304 + 64 * (j))
#define XB_TOP      3328
#define XB_TOPGEN   3392
#define XCD_BAR_WORDS 3456
#define XB_SPIN_CAP (1u << 22)
__device__ __forceinline__ unsigned xb_ld(unsigned* p) { return __hip_atomic_load(p, __ATOMIC_RELAXED, __HIP_MEMORY_SCOPE_AGENT); }
__device__ __forceinline__ unsigned xb_add(unsigned* p, unsigned v) { return __hip_atomic_fetch_add(p, v, __ATOMIC_RELAXED, __HIP_MEMORY_SCOPE_AGENT); }
__device__ __forceinline__ unsigned xb_xcc_id() { return (unsigned)__builtin_amdgcn_s_getreg((3 << 11) | 20) & 0xFu; }
#define XB_SPIN(cond, bar) do { unsigned _sp = 0; while (cond) { __builtin_amdgcn_s_sleep(1); \
    if ((++_sp & 255u) == 0u) { if (xb_ld(&(bar)[XB_TMO])) break; if (_sp > XB_SPIN_CAP) { atomicAdd(&(bar)[XB_TMO], 1u); break; } } } } while (0)
#define XB_LDS_OFF (LDS_BYTES - 64)
__device__ __forceinline__ void xcd_barrier_post(const Params& P) {
    if (threadIdx.x == 0) {
        unsigned* bar = (unsigned*)(P.ws + OFF_BAR);
        volatile __attribute__((address_space(3))) unsigned* st = (volatile __attribute__((address_space(3))) unsigned*)(smem + XB_LDS_OFF);
        st[0] = 0u; st[1] = 0u;
        (void)xb_add(&bar[XB_XCNT(xb_xcc_id())], 1u);
    }
}
__device__ __forceinline__ void xcd_barrier_complete(unsigned* bar, unsigned x, unsigned& nloc, unsigned& nx) {
    const unsigned G = gridDim.x;
    unsigned sum, cnt, mine, sp = 0u;
    for (;;) {
        sum = 0u; cnt = 0u; mine = 0u;
#pragma unroll
        for (unsigned j = 0; j < 16; ++j) { const unsigned c = xb_ld(&bar[XB_XCNT(j)]); sum += c; cnt += (c > 0u) ? 1u : 0u; mine = (j == x) ? c : mine; }
        if (sum == G) break;
        __builtin_amdgcn_s_sleep(1);
        if ((++sp & 255u) == 0u) { if (xb_ld(&bar[XB_TMO])) break; if (sp > XB_SPIN_CAP) { atomicAdd(&bar[XB_TMO], 1u); break; } }
    }
    nloc = mine > 0u ? mine : 1u; nx = cnt > 0u ? cnt : 1u;
}
__device__ __forceinline__ void grid_barrier(const Params& P) {
    asm volatile("s_waitcnt vmcnt(0)" ::: "memory");
    __syncthreads();
    if (threadIdx.x == 0) {
        unsigned* bar = (unsigned*)(P.ws + OFF_BAR);
        volatile __attribute__((address_space(3))) unsigned* st = (volatile __attribute__((address_space(3))) unsigned*)(smem + XB_LDS_OFF);
        const unsigned x = xb_xcc_id();
        __builtin_amdgcn_s_waitcnt(0);
        unsigned nloc = st[0], nx = st[1];
        if (nloc == 0u) { xcd_barrier_complete(bar, x, nloc, nx); st[0] = nloc; st[1] = nx; }
        const unsigned old = xb_add(&bar[XB_XSUB(x)], 1u);
        const unsigned gen = old / nloc;
        if (old + 1u == (gen + 1u) * nloc) {
            __builtin_amdgcn_fence(__ATOMIC_RELEASE, "agent");
            asm volatile("s_waitcnt vmcnt(0)" ::: "memory");
            const unsigned og = xb_add(&bar[XB_TOP], 1u);
            const unsigned tg = og / nx;
            if (og + 1u == (tg + 1u) * nx) xb_add(&bar[XB_TOPGEN], 1u);
            else XB_SPIN(xb_ld(&bar[XB_TOPGEN]) == tg, bar);
            __builtin_amdgcn_fence(__ATOMIC_ACQUIRE, "agent");
            xb_add(&bar[XB_XGEN(x)], 1u);
            asm volatile("s_waitcnt vmcnt(0)" ::: "memory");
        } else {
            XB_SPIN(xb_ld(&bar[XB_XGEN(x)]) == gen, bar);
            __builtin_amdgcn_fence(__ATOMIC_ACQUIRE, "agent");
            asm volatile("s_waitcnt vmcnt(0)" ::: "memory");
        }
    }
    __syncthreads();
}

__global__ void __launch_bounds__(NTHR, 2) hymba_megakernel(Params P) {
    cg::grid_group grid = cg::this_grid();
    char* ws = opq(P.ws);
    xcd_barrier_post(P);
#define BAR() do { grid_barrier(P); if (DUP == 20) grid_barrier(P); } while (0)
    phase0(P);
    if (DUP == 0) { asm volatile("s_waitcnt vmcnt(0)" ::: "memory"); __syncthreads(); grid_barrier(P); phase0(P); }
    asm volatile("s_waitcnt vmcnt(0)" ::: "memory");
    __syncthreads();
    grid.sync();
    BAR();
    phase_pw(P);
    asm volatile("s_waitcnt vmcnt(0)" ::: "memory");
    __syncthreads();
    if (DUP == 11) { BAR(); phase_pw(P); BAR(); }
    int cur = 0;
    for (int L = 0; L < 2; ++L) {
        const int ss_mix = (L == 0) ? 0 : 3, ss_ffn = 1 + L, ss_next = (L == 0) ? 3 : 4, ss_ple = 5 + L;
        phase_proj(P, L, cur, ss_mix);
        BAR();
        if (DUP == 1) { phase_proj(P, L, cur, ss_mix); BAR(); }
        phase_mla_up(P, L);
        BAR();
        if (DUP == 2) { phase_mla_up(P, L); BAR(); }
        phase_attn(P, L, 0);
        BAR();
        if (DUP == 3) { phase_attn(P, L, 1); BAR(); }
        if (DUP >= 30 && DUP < 34) { phase_attn(P, L, 1, DUP - 30); BAR(); }
        phase_wo(P, L, cur ^ 1, ss_ffn);
        BAR();
        if (DUP == 4 && L == 0) { phase_wo(P, L, cur ^ 1, ss_ffn); BAR(); }
        phase_pq(P, L, cur ^ 1, ss_ffn);
        BAR();
        if (DUP == 5) { phase_pq(P, L, cur ^ 1, ss_ffn); BAR(); }
        if (DUP == 6) { phase_topk(P, L); BAR(); }
        phase_gather_u(P, L);
        BAR();
        if (DUP == 7) { phase_gather_u(P, L); BAR(); }
        if (DUP == 10) { phase_gather_act(P, L, ss_ffn, 1); BAR(); }
        phase_gather_act(P, L, ss_ffn);
        BAR();
        if (DUP == 8) { phase_gather_v(P, L, cur, ss_ple, 1); BAR(); }
        phase_gather_v(P, L, cur, ss_ple);
        BAR();
        if (DUP == 9) { phase_ple(P, L, cur, ss_ple, ss_next, 1); BAR(); }
        phase_ple(P, L, cur, ss_ple, ss_next);
        BAR();
        cur ^= 1;
    }
    phase_final(P, 4, cur);
}

extern "C" void kernel_launch(void* const* d_in, const int* in_sizes, int n_in, void* d_out, int out_size, void* d_ws,
                              size_t ws_size, hipStream_t stream) {
    static int grid_blocks = 0;
    if (!grid_blocks) {
        int dev = 0, cus = 0, per_cu = 0;
        hipGetDevice(&dev);
        hipDeviceGetAttribute(&cus, hipDeviceAttributeMultiprocessorCount, dev);
        hipOccupancyMaxActiveBlocksPerMultiprocessor(&per_cu, hymba_megakernel, NTHR, 0);
        if (per_cu > 1) per_cu = 1;
        if (per_cu < 1) per_cu = 1;
        grid_blocks = cus * per_cu;
        if (ws_size < WS_END) fprintf(stderr, "workspace too small: %zu < %zu\n", ws_size, (size_t)WS_END);
    }
    Params P{};
    P.x = (const float*)d_in[0]; P.p = (const float*)d_in[1]; P.pos = (const int*)d_in[2];
    P.norm_mix_g = (const float*)d_in[3]; P.w_in = (const float*)d_in[4]; P.b_forget = (const float*)d_in[5];
    P.mla_q_norm_g = (const float*)d_in[6]; P.w_uq = (const float*)d_in[7]; P.mla_kv_norm_g = (const float*)d_in[8];
    P.w_ukv = (const float*)d_in[9]; P.mix_out_norm_g = (const float*)d_in[10]; P.w_o = (const float*)d_in[11];
    P.norm_ffn_g = (const float*)d_in[12]; P.w_query = (const float*)d_in[13]; P.sub_keys = (const float*)d_in[14];
    P.peer_u = (const float*)d_in[15]; P.peer_v = (const float*)d_in[16]; P.w_ple = (const float*)d_in[17];
    P.ple_norm_g = (const float*)d_in[18]; P.w_ple_gate = (const float*)d_in[19]; P.final_norm_g = (const float*)d_in[20];
    P.out = (float*)d_out; P.ws = (char*)d_ws;
    hipMemsetAsync((char*)d_ws + OFF_BAR, 0, 16384 + 4096, stream);
    void* args[] = {&P};
    hipError_t e = hipLaunchCooperativeKernel((void*)hymba_megakernel, dim3(grid_blocks), dim3(NTHR), args, 0, stream);
    if (e != hipSuccess) fprintf(stderr, "cooperative launch failed: %s (grid %d)\n", hipGetErrorString(e), grid_blocks);
}
```

```cpp
#define EARLY_ACQ 1
#include <hip/hip_runtime.h>
#include <hip/hip_cooperative_groups.h>
#include <cstdio>
#include <cstdint>
#include <math.h>
#include <climits>
namespace cg = cooperative_groups;

typedef __bf16 bf16;
typedef __bf16 bf16x8 __attribute__((ext_vector_type(8)));
typedef __bf16 bf16x4 __attribute__((ext_vector_type(4)));
typedef __bf16 bf16x2 __attribute__((ext_vector_type(2)));
typedef float f32x16 __attribute__((ext_vector_type(16)));
typedef float f32x4 __attribute__((ext_vector_type(4)));
typedef float f32x2 __attribute__((ext_vector_type(2)));
typedef unsigned u32x4 __attribute__((ext_vector_type(4)));
typedef unsigned u32x2 __attribute__((ext_vector_type(2)));

#define SEQ 2048
#define BATCH 8
#define TOK 16384
#define DM 1024
#define IN_W 1956
#define NEXP 16384
#define EPSF 1e-6f
#define LOG2E 1.4426950408889634f
#define NTHR 512
#define NW 8
#define LDS_BYTES 151808
#define STAGE_BYTES 49152
#define LDS_AUX 147456
#ifndef DUP
#define DUP -1
#endif

constexpr size_t MBy = 1ull << 20;
constexpr size_t OFF_UB = 0;
constexpr size_t OFF_VB = 16 * MBy;
constexpr size_t OFF_PART = 32 * MBy;
constexpr size_t OFF_PW1 = 96 * MBy;
#define LDH 1088
#define LDP 320
#define LDC 192
constexpr size_t OFF_WIN = 128 * MBy;
constexpr size_t OFF_WO = 137 * MBy;
constexpr size_t OFF_WQ = 142 * MBy;
constexpr size_t OFF_WG = 147 * MBy;
constexpr size_t OFF_WP = 152 * MBy;
constexpr size_t OFF_WUQ = 154 * MBy;
constexpr size_t OFF_WUKV = 155 * MBy;
constexpr size_t OFF_SKB = 156 * MBy;
constexpr size_t OFF_CS = 157 * MBy;
constexpr size_t OFF_TSC = 159 * MBy;
constexpr size_t OFF_SSA = 160 * MBy;
constexpr size_t OFF_HB0 = 164 * MBy;
constexpr size_t OFF_HB1 = 200 * MBy;
constexpr size_t OFF_FQ = 236 * MBy;
constexpr size_t OFF_FK = 244 * MBy;
constexpr size_t OFF_FVT = 252 * MBy;
constexpr size_t OFF_SQ = 260 * MBy;
constexpr size_t OFF_SKK = 268 * MBy;
constexpr size_t OFF_SVT = 276 * MBy;
constexpr size_t OFF_CQ = 284 * MBy;
constexpr size_t OFF_CKV = 295 * MBy;
constexpr size_t OFF_FLOG = 302 * MBy;
constexpr size_t OFF_CUMF = 303 * MBy;
constexpr size_t OFF_MQ = 304 * MBy;
constexpr size_t OFF_MK = 316 * MBy;
constexpr size_t OFF_MVT = 328 * MBy;
constexpr size_t OFF_Y = 344 * MBy;
constexpr size_t OFF_PQ = 380 * MBy;
constexpr size_t OFF_IDS = 412 * MBy;
constexpr size_t OFF_GATE = 420 * MBy;
constexpr size_t OFF_BAR = 428 * MBy;
constexpr size_t OFF_CNT = OFF_BAR + 16384;
constexpr size_t OFF_SSY = 429 * MBy;
constexpr size_t OFF_PB = 431 * MBy;
constexpr size_t OFF_PW0 = 452 * MBy;
constexpr size_t OFF_A8 = OFF_PQ;
constexpr size_t OFF_XH = OFF_FQ;
constexpr size_t OFF_XL = OFF_FQ + 16 * MBy;
constexpr size_t WS_END = 484 * MBy;

struct Params {
    const float* x; const float* p; const int* pos;
    const float* norm_mix_g; const float* w_in; const float* b_forget; const float* mla_q_norm_g; const float* w_uq;
    const float* mla_kv_norm_g; const float* w_ukv; const float* mix_out_norm_g; const float* w_o; const float* norm_ffn_g;
    const float* w_query; const float* sub_keys; const float* peer_u; const float* peer_v; const float* w_ple;
    const float* ple_norm_g; const float* w_ple_gate; const float* final_norm_g;
    float* out; char* ws;
};

__shared__ __attribute__((aligned(16))) char smem[LDS_BYTES];

__device__ __forceinline__ int opaque_tid() { int t = threadIdx.x; asm volatile("" : "+v"(t)); return t; }
template <typename T> __device__ __forceinline__ T* opq(T* p) { size_t z = 0; asm volatile("" : "+s"(z)); return (T*)((char*)p + z); }

__device__ __forceinline__ unsigned pack2(float a, float b) {
    f32x2 v = {a, b};
    bf16x2 r = __builtin_convertvector(v, bf16x2);
    return __builtin_bit_cast(unsigned, r);
}
__device__ __forceinline__ float bflo(unsigned u) { return __uint_as_float(u << 16); }
__device__ __forceinline__ float bfhi(unsigned u) { return __uint_as_float(u & 0xffff0000u); }
__device__ __forceinline__ float4 ntload4(const float4* p) {
    const f32x4 t = __builtin_nontemporal_load((const f32x4*)p);
    return make_float4(t.x, t.y, t.z, t.w);
}
__device__ __forceinline__ float wave_sum(float v) {
#pragma unroll
    for (int o = 32; o > 0; o >>= 1) v += __shfl_xor(v, o);
    return v;
}
template <int CTRL> __device__ __forceinline__ float dpp_add(float v) {
    return v + __builtin_bit_cast(float, __builtin_amdgcn_update_dpp(0, __builtin_bit_cast(int, v), CTRL, 0xf, 0xf, true));
}
__device__ __forceinline__ float sum8_dpp(float v) { v = dpp_add<0xB1>(v); v = dpp_add<0x4E>(v); v = dpp_add<0x141>(v); return v; }
__device__ __forceinline__ float sumg_dpp(float v) {
    v = dpp_add<0x128>(v);
    float a = v, b = v;
    asm volatile("s_nop 1\n\tv_permlane16_swap_b32 %0, %1\n\ts_nop 1" : "+v"(a), "+v"(b));
    v = a + b;
    a = v; b = v;
    asm volatile("s_nop 1\n\tv_permlane32_swap_b32 %0, %1\n\ts_nop 1" : "+v"(a), "+v"(b));
    return a + b;
}
template <int CTRL> __device__ __forceinline__ float dpp_max0(float v) {
    return fmaxf(v, __builtin_bit_cast(float, __builtin_amdgcn_update_dpp(0, __builtin_bit_cast(int, v), CTRL, 0xf, 0xf, true)));
}
__device__ __forceinline__ float wave_max0(float v) {
    v = dpp_max0<0xB1>(v); v = dpp_max0<0x4E>(v); v = dpp_max0<0x141>(v); v = dpp_max0<0x140>(v);
    float a = v, b = v;
    asm volatile("s_nop 1\n\tv_permlane16_swap_b32 %0, %1\n\ts_nop 1" : "+v"(a), "+v"(b));
    v = fmaxf(a, b); a = v; b = v;
    asm volatile("s_nop 1\n\tv_permlane32_swap_b32 %0, %1\n\ts_nop 1" : "+v"(a), "+v"(b));
    return fmaxf(a, b);
}
__device__ __forceinline__ int partner32(int v, int hh) {
    int a = v, b = v;
    asm volatile("s_nop 1\n\tv_permlane32_swap_b32 %0, %1\n\ts_nop 1" : "+v"(a), "+v"(b));
    return hh ? a : b;
}
__device__ __forceinline__ float fexp2(float x) { return __builtin_amdgcn_exp2f(x); }
__device__ __forceinline__ float flog2(float x) { return __builtin_amdgcn_logf(x); }
__device__ __forceinline__ float log_sigmoid_f(float z) { return fminf(z, 0.f) - 0.6931471805599453f * flog2(1.f + fexp2(-1.4426950408889634f * fabsf(z))); }

struct WJob { const float* src; int lds; int K; int Np; bf16* dst; int ldd; const float* gain; int map; };

__device__ __forceinline__ int src_col_map(int map, int c) {
    if (map == 0) return c;
    if (map == 1) {
        if (c < 768) return c;
        if (c < 1952) return c + 4;
        if (c < 1956) return c - 1952 + 768;
        return -1;
    }
    if (c < 256) return 192 * (c >> 6) + (c & 63);
    int e = c - 256;
    return 192 * (e >> 7) + 64 + (e & 127);
}

__device__ __forceinline__ void wconv_group(const WJob& j, int t0, int tstride, int ntiles) {
    float* tl = (float*)smem;
    const int ktiles = j.K >> 5;
    const int tx = opaque_tid() & 31, ty = opaque_tid() >> 5;
    float v[8][2];
#pragma unroll
    for (int u = 0; u < 8; ++u) {
        const int tile = t0 + u * tstride;
        v[u][0] = 0.f; v[u][1] = 0.f;
        if (tile < ntiles) {
            const int nt = tile / ktiles, kt = tile % ktiles;
            const int sc = src_col_map(j.map, nt * 32 + tx);
            if (sc >= 0) {
#pragma unroll
                for (int i = 0; i < 2; ++i) {
                    const int k = kt * 32 + ty + 16 * i;
                    v[u][i] = __builtin_nontemporal_load(j.src + (size_t)k * j.lds + sc) * (j.gain ? j.gain[k] : 1.f);
                }
            }
        }
    }
#pragma unroll
    for (int u = 0; u < 8; ++u)
#pragma unroll
        for (int i = 0; i < 2; ++i) tl[u * 1056 + (ty + 16 * i) * 33 + tx] = v[u][i];
    __syncthreads();
#pragma unroll
    for (int u = 0; u < 8; ++u) {
        const int tile = t0 + u * tstride;
        if (tile < ntiles) {
            const int nt = tile / ktiles, kt = tile % ktiles;
#pragma unroll
            for (int i = 0; i < 2; ++i) {
                const int n = nt * 32 + ty + 16 * i;
                j.dst[(size_t)n * j.ldd + kt * 32 + tx] = (bf16)tl[u * 1056 + tx * 33 + ty + 16 * i];
            }
        }
    }
    __syncthreads();
}

__device__ __forceinline__ void phase0(const Params& P) {
    char* ws = opq(P.ws);
    const int G = gridDim.x, bid = blockIdx.x, tid = opaque_tid();
    if (DUP == 23) {
        const int w = tid >> 6, l = tid & 63;
        float4 accp = {0.f, 0.f, 0.f, 0.f};
        for (int it = (bid * NW + w) * 4; it < 4 * NEXP; it += G * NW * 4) {
            float4 v[16];
            const int tb = it >> 14, e = it & (NEXP - 1);
            const float4* src = (const float4*)((tb < 2 ? P.peer_u : P.peer_v) + ((size_t)(tb & 1) * NEXP + e) * DM) + l;
#pragma unroll
            for (int q = 0; q < 16; ++q) v[q] = ntload4(src + 64 * q);
#pragma unroll
            for (int q = 0; q < 16; ++q) { accp.x += v[q].x; accp.y += v[q].y; accp.z += v[q].z; accp.w += v[q].w; }
        }
        ((float4*)(ws + OFF_PART))[bid * NTHR + tid] = accp;
    }
    for (int rep = 0; rep < (DUP == 20 ? 2 : 1); ++rep) {
        const int w = tid >> 6, l = tid & 63;
        float* tsc = (float*)(ws + OFF_TSC);
        for (int it = (bid * NW + w) * 4; it < 4 * NEXP; it += G * NW * 4) {
            const int tb = it >> 14, e0 = it & (NEXP - 1);
            const float4* src = (const float4*)((tb < 2 ? P.peer_u : P.peer_v) + ((size_t)(tb & 1) * NEXP + e0) * DM) + l;
            unsigned char* dst = (unsigned char*)(ws + (tb < 2 ? OFF_UB : OFF_VB)) + (size_t)(tb & 1) * NEXP * 512 + (size_t)e0 * 128 + 2 * l;
            float4 v[4][4];
#pragma unroll
            for (int r = 0; r < 4; ++r)
#pragma unroll
                for (int q = 0; q < 4; ++q) v[r][q] = ntload4(src + 256 * r + 64 * q);
            if (tb < 2) {
                const float4* g4 = (const float4*)(P.norm_ffn_g + (tb & 1) * 1024) + l;
#pragma unroll
                for (int q = 0; q < 4; ++q) {
                    const float4 g = g4[64 * q];
#pragma unroll
                    for (int r = 0; r < 4; ++r) { v[r][q].x *= g.x; v[r][q].y *= g.y; v[r][q].z *= g.z; v[r][q].w *= g.w; }
                }
            }
            float am[4];
#pragma unroll
            for (int r = 0; r < 4; ++r) {
                float m = 0.f;
#pragma unroll
                for (int q = 0; q < 4; ++q) m = fmaxf(m, fmaxf(fmaxf(fabsf(v[r][q].x), fabsf(v[r][q].y)), fmaxf(fabsf(v[r][q].z), fabsf(v[r][q].w))));
                am[r] = wave_max0(m);
            }
#pragma unroll
            for (int r = 0; r < 4; ++r) {
                const float sc = (am[r] > 0.f) ? (6.0f / am[r]) : 1.f, isc = (am[r] > 0.f) ? (am[r] * (1.f / 6.0f)) : 1.f;
#pragma unroll
                for (int q = 0; q < 4; ++q) {
                    unsigned wq = 0;
                    wq = __builtin_amdgcn_cvt_scalef32_pk_fp4_f32(wq, v[r][q].x * sc, v[r][q].y * sc, 1.0f, 0);
                    wq = __builtin_amdgcn_cvt_scalef32_pk_fp4_f32(wq, v[r][q].z * sc, v[r][q].w * sc, 1.0f, 1);
                    *(unsigned short*)(dst + (size_t)q * NEXP * 128 + r * 128) = (unsigned short)(wq & 0xffffu);
                }
                if (l == 0) tsc[tb * NEXP + e0 + r] = isc;
            }
        }
    }
    if (DUP == 22) {
        const int w = tid >> 6, l = tid & 63;
        float4 accp = {0.f, 0.f, 0.f, 0.f};
        for (int it = (bid * NW + w) * 4; it < 4 * NEXP; it += G * NW * 4) {
            float4 v[16];
#pragma unroll
            for (int r = 0; r < 4; ++r) {
                const int tb = (it + r) >> 14, e = (it + r) & (NEXP - 1);
                const float4* src = (const float4*)((tb < 2 ? P.peer_u : P.peer_v) + ((size_t)(tb & 1) * NEXP + e) * DM) + l;
#pragma unroll
                for (int q = 0; q < 4; ++q) v[4 * r + q] = src[64 * q];
            }
#pragma unroll
            for (int q = 0; q < 16; ++q) { accp.x += v[q].x; accp.y += v[q].y; accp.z += v[q].z; accp.w += v[q].w; }
        }
        ((float4*)(ws + OFF_PART))[bid * NTHR + tid] = accp;
    }
    for (int rep = 0; rep < (DUP == 21 ? 2 : 1); ++rep) {
        for (int L = 0; L < 2; ++L) {
            WJob jobs[7];
            jobs[0] = {P.w_in + (size_t)L * 1024 * IN_W, IN_W, 1024, 2048, (bf16*)(ws + OFF_WIN) + (size_t)L * 2048 * LDH, LDH, P.norm_mix_g + L * 1024, 1};
            jobs[1] = {P.w_o + (size_t)L * 1024 * 1024, 1024, 1024, 1024, (bf16*)(ws + OFF_WO) + (size_t)L * 1024 * LDH, LDH, P.mix_out_norm_g + L * 1024, 0};
            jobs[2] = {P.w_query + (size_t)L * 1024 * 1024, 1024, 1024, 1024, (bf16*)(ws + OFF_WQ) + (size_t)L * 1024 * LDH, LDH, P.norm_ffn_g + L * 1024, 0};
            jobs[3] = {P.w_ple_gate + (size_t)L * 1024 * 1024, 1024, 1024, 1024, (bf16*)(ws + OFF_WG) + (size_t)L * 1024 * LDH, LDH, P.ple_norm_g + L * 1024, 0};
            jobs[4] = {P.w_ple + (size_t)L * 256 * 1024, 1024, 256, 1024, (bf16*)(ws + OFF_WP) + (size_t)L * 1024 * LDP, LDP, nullptr, 0};
            jobs[5] = {P.w_uq + (size_t)L * 256 * 384, 384, 256, 384, (bf16*)(ws + OFF_WUQ) + (size_t)L * 384 * LDP, LDP, P.mla_q_norm_g + L * 256, 0};
            jobs[6] = {P.w_ukv + (size_t)L * 128 * 768, 768, 128, 768, (bf16*)(ws + OFF_WUKV) + (size_t)L * 768 * LDC, LDC, P.mla_kv_norm_g + L * 128, 2};
#pragma unroll
            for (int q = 0; q < 7; ++q) {
                int nt = (jobs[q].Np >> 5) * (jobs[q].K >> 5);
                for (int it = bid; it < nt; it += 8 * G) wconv_group(jobs[q], it, G, nt);
            }
        }
    }
    {
        const float* src = P.sub_keys;
        bf16* dst = (bf16*)(ws + OFF_SKB);
        for (int i = bid * NTHR + tid; i < 262144 / 2; i += G * NTHR) {
            float2 v = ((const float2*)src)[i];
            ((unsigned*)dst)[i] = pack2(v.x, v.y);
        }
    }
    {
        const float4* src = (const float4*)P.p;
        bf16* dst = (bf16*)(ws + OFF_PB);
        for (int i0 = bid * NTHR + tid; i0 < 2 * TOK * 256 / 4; i0 += 4 * G * NTHR) {
            float4 a[4];
#pragma unroll
            for (int u = 0; u < 4; ++u) a[u] = ntload4(src + ((i0 + u * G * NTHR < 2 * TOK * 64) ? (i0 + u * G * NTHR) : i0));
#pragma unroll
            for (int u = 0; u < 4; ++u) {
                const int i = i0 + u * G * NTHR;
                if (i >= 2 * TOK * 64) break;
                u32x2 o = {pack2(a[u].x, a[u].y), pack2(a[u].z, a[u].w)};
                *(u32x2*)(dst + (size_t)(i >> 6) * LDP + (i & 63) * 4) = o;
            }
        }
    }
    {
        bf16* hb = (bf16*)(ws + OFF_HB0);
        float* ss0 = (float*)(ws + OFF_SSA);
        int w = tid >> 6, l = tid & 63;
        for (int row0 = (bid * NW + w) * 4; row0 < TOK; row0 += G * NW * 4) {
            const float4* xr = (const float4*)(P.x + (size_t)row0 * DM) + l;
            float4 a[4][4];
#pragma unroll
            for (int r = 0; r < 4; ++r)
#pragma unroll
                for (int i = 0; i < 4; ++i) a[r][i] = ntload4(xr + 256 * r + 64 * i);
#pragma unroll
            for (int r = 0; r < 4; ++r) {
                const int row = row0 + r;
                float ss = 0.f;
#pragma unroll
                for (int i = 0; i < 4; ++i) {
                    ss += a[r][i].x * a[r][i].x + a[r][i].y * a[r][i].y + a[r][i].z * a[r][i].z + a[r][i].w * a[r][i].w;
                    u32x2 o = {pack2(a[r][i].x, a[r][i].y), pack2(a[r][i].z, a[r][i].w)};
                    ((u32x2*)(hb + (size_t)row * LDH))[i * 64 + l] = o;
                }
                ss = wave_sum(ss);
                if (l == 0) {
                    *(float4*)(ss0 + (size_t)row * 8) = make_float4(ss, 0.f, 0.f, 0.f);
                    *(float4*)(ss0 + (size_t)row * 8 + 4) = make_float4(0.f, 0.f, 0.f, 0.f);
                }
            }
        }
    }
    {
        float* cs = (float*)(ws + OFF_CS);
        for (int i = bid * NTHR + tid; i < TOK * 16; i += G * NTHR) {
            int t = i >> 4, k = i & 15;
            float inv = fexp2(-(float)k * (13.287712379549449f / 16.0f));
            float rev = (float)P.pos[t] * inv * 0.15915494309189535f;
            rev -= floorf(rev);
            cs[2 * i] = __builtin_amdgcn_cosf(rev);
            cs[2 * i + 1] = __builtin_amdgcn_sinf(rev);
        }
    }
}

struct NoHook { static constexpr bool nodma = false, ssq = false; __device__ __forceinline__ void operator()(int, f32x16 (&)[2][2]) const {} };
struct SsqHook { static constexpr bool nodma = false, ssq = true; __device__ __forceinline__ void operator()(int, f32x16 (&)[2][2]) const {} };
struct NoDmaHook { static constexpr bool nodma = true, ssq = false; __device__ __forceinline__ void operator()(int, f32x16 (&)[2][2]) const {} };
template <typename HOOK>
__device__ __forceinline__ void gemm_core(f32x16 (&acc)[2][2], const bf16* A, int lda, const bf16* Bt, int ldb, int K,
                                          int m0, int n0, HOOK hook, float (&ssq)[2]) {
    const int tid = opaque_tid(), w = tid >> 6, l = tid & 63, r = l & 31, hh = l >> 5;
    const int wm = w >> 1, wn = w & 1;
    const int dp = (tid & 15) ^ ((tid >> 4) & 15);
    const int drow = 2 * (tid >> 4) + (dp >> 3), dgc = (dp & 7) * 8;
    const bf16* asrc = A + (size_t)(m0 + drow) * lda + dgc;
    const bf16* bsrc = Bt + (size_t)(n0 + drow) * ldb + dgc;
    auto dma = [&](int buf, int k0) {
        if (HOOK::nodma) return;
        char* base = smem + buf * STAGE_BYTES + tid * 16;
#pragma unroll
        for (int i = 0; i < 4; ++i)
            __builtin_amdgcn_global_load_lds((const unsigned*)(asrc + (size_t)(64 * i) * lda + k0), (unsigned*)(base + i * 8192), 16, 0, 0);
#pragma unroll
        for (int i = 0; i < 2; ++i)
            __builtin_amdgcn_global_load_lds((const unsigned*)(bsrc + (size_t)(64 * i) * ldb + k0), (unsigned*)(base + 32768 + i * 8192), 16, 0, 0);
    };
    int offA[2], offB[2];
#pragma unroll
    for (int i = 0; i < 2; ++i) { offA[i] = ((wm * 64 + i * 32 + r) >> 1) * 256; offB[i] = 32768 + ((wn * 64 + i * 32 + r) >> 1) * 256; }
    const int pbase = ((r & 1) << 3), lx = (r >> 1) & 15;
    const int nk = K >> 6;
    const unsigned ldsbase = (unsigned)(size_t)(__attribute__((address_space(3))) char*)smem;
    auto ldfrag = [&](int stage, int s, bf16x8 (&af)[2], bf16x8 (&bfr)[2]) {
        unsigned ch = (unsigned)((((pbase | (2 * s + hh)) ^ lx) << 4)) + ldsbase + (unsigned)(stage * STAGE_BYTES);
        unsigned a0a = ch + offA[0], a1a = ch + offA[1], b0a = ch + offB[0], b1a = ch + offB[1];
        asm volatile("ds_read_b128 %0, %4\n\tds_read_b128 %1, %5\n\tds_read_b128 %2, %6\n\tds_read_b128 %3, %7"
                     : "=&v"(af[0]), "=&v"(af[1]), "=&v"(bfr[0]), "=&v"(bfr[1]) : "v"(a0a), "v"(a1a), "v"(b0a), "v"(b1a) : "memory");
    };
    auto mma = [&](bf16x8 (&af)[2], bf16x8 (&bfr)[2]) {
#pragma unroll
        for (int i = 0; i < 2; ++i)
#pragma unroll
            for (int j = 0; j < 2; ++j) acc[i][j] = __builtin_amdgcn_mfma_f32_32x32x16_bf16(af[i], bfr[j], acc[i][j], 0, 0, 0);
        if (HOOK::ssq) {
#pragma unroll
            for (int i = 0; i < 2; ++i) {
                const u32x4 rw = __builtin_bit_cast(u32x4, af[i]);
                float a;
                a = bflo(rw.x); ssq[i] += a * a; a = bfhi(rw.x); ssq[i] += a * a; a = bflo(rw.y); ssq[i] += a * a; a = bfhi(rw.y); ssq[i] += a * a;
                a = bflo(rw.z); ssq[i] += a * a; a = bfhi(rw.z); ssq[i] += a * a; a = bflo(rw.w); ssq[i] += a * a; a = bfhi(rw.w); ssq[i] += a * a;
            }
        }
    };
#define LGKM_WAIT(n) do { asm volatile("s_waitcnt lgkmcnt(" #n ")" ::: "memory"); __builtin_amdgcn_sched_barrier(0); } while (0)
    asm volatile("s_waitcnt vmcnt(0)" ::: "memory");
    dma(0, 0);
    dma(1, 64);
    if (nk > 2) { dma(2, 128); asm volatile("s_waitcnt vmcnt(12)" ::: "memory"); }
    else asm volatile("s_waitcnt vmcnt(6)" ::: "memory");
    __builtin_amdgcn_s_barrier();
    bf16x8 a0[2], b0[2], a1[2], b1[2];
    ldfrag(0, 0, a0, b0);
    int cur = 0;
    for (int kt = 0; kt < nk; ++kt) {
        const int nxt = (cur == 2) ? 0 : cur + 1;
        if (kt == 4 || kt == 8) { LGKM_WAIT(0); hook(kt, acc); }
        ldfrag(cur, 1, a1, b1);
        LGKM_WAIT(4);
        mma(a0, b0);
        ldfrag(cur, 2, a0, b0);
        LGKM_WAIT(4);
        mma(a1, b1);
        ldfrag(cur, 3, a1, b1);
        LGKM_WAIT(4);
        mma(a0, b0);
        if (kt + 1 < nk) {
            if (kt + 2 < nk) asm volatile("s_waitcnt vmcnt(6) lgkmcnt(0)" ::: "memory");
            else asm volatile("s_waitcnt vmcnt(0) lgkmcnt(0)" ::: "memory");
            __builtin_amdgcn_s_barrier();
            __builtin_amdgcn_sched_barrier(0);
            if (kt + 3 < nk) dma(cur, (kt + 3) << 6);
            ldfrag(nxt, 0, a0, b0);
        } else {
            LGKM_WAIT(0);
        }
        mma(a1, b1);
        cur = nxt;
    }
    __syncthreads();
}
__device__ __forceinline__ float row_rs8(const float* part, int row) {
    float4 a = *(const float4*)(part + (size_t)row * 8), b = *(const float4*)(part + (size_t)row * 8 + 4);
    float ss = ((a.x + a.y) + (a.z + a.w)) + ((b.x + b.y) + (b.z + b.w));
    return rsqrtf(ss * (1.f / 1024.f) + EPSF);
}
__device__ __forceinline__ bool xcd_tile(int it, int MT, int NT, int& mt, int& nt) {
    const int G = gridDim.x, bid = blockIdx.x;
    if ((G & 7) == 0 && (MT & 7) == 0) {
        const int nbx = G >> 3, q = (bid >> 3) + it * nbx, per = (MT >> 3) * NT;
        if (q >= per) return false;
        mt = (bid & 7) * (MT >> 3) + q / NT; nt = q % NT;
        return true;
    }
    const int q = bid + it * G;
    if (q >= MT * NT) return false;
    mt = q / NT; nt = q % NT;
    return true;
}
struct NoScale { __device__ __forceinline__ float operator()(int, int) const { return 1.f; } };

#define ZERO_ACC(acc)                                  \
    _Pragma("unroll") for (int _i = 0; _i < 2; ++_i)   \
    _Pragma("unroll") for (int _j = 0; _j < 2; ++_j)   \
    _Pragma("unroll") for (int _r = 0; _r < 16; ++_r) acc[_i][_j][_r] = 0.f;


namespace pg8 {
#define PG8_LAS __attribute__((address_space(3)))
typedef unsigned short bf16_t;
constexpr int BM = 256, BK = 64, HALF = 128, HTB = HALF * BK * 2  , NXCD = 8, WGM = 8;

__host__ __device__ __forceinline__ int lds_byte(int r, int c) { const int st = (r >> 4) * 2 + (c >> 5), rr = r & 15, cc = c & 31, ob = rr * 64 + cc * 2; return st * 1024 + (ob ^ (((ob >> 9) & 1) << 5)); }
__host__ __device__ __forceinline__ void stage_rc(int b, int& R, int& C) { const int st = b / 1024, sb = b % 1024, swz = sb ^ (((sb >> 9) & 1) << 5); R = (st >> 1) * 16 + swz / 64; C = (st & 1) * 32 + (swz % 64) / 2; }
__host__ __device__ __forceinline__ int perm32(int rho) { const int n = rho >> 4, i = rho & 15; return 8 * (i >> 2) + 4 * n + (i & 3); }
struct Unit { int pm, pn; };
struct Gemm { const bf16* A; const bf16* Bt; int lda, ldb, M, N, K; };
struct StaticOrder {
    int nM, nN, nwg, G, c;
    __device__ void init(int M, int N, int G_, int c_) { nM = M / BM; nN = N / BM; nwg = nM * nN; G = G_; c = c_; }
    __device__ bool next(int i, Unit& u) const {
        const long L = (long)i * G + c; if (L >= nwg) return false;
        int wgid = (int)L; { const int q = nwg / NXCD, r = nwg % NXCD, xcd = wgid % NXCD, off = wgid / NXCD; wgid = (xcd < r ? xcd * (q + 1) : r * (q + 1) + (xcd - r) * q) + off; }
        const int nig = WGM * nN, gid = wgid / nig, fm = gid * WGM, gsz = (nM - fm) < WGM ? (nM - fm) : WGM;
        u.pm = fm + ((wgid % nig) % gsz); u.pn = (wgid % nig) / gsz; return true;
    }
    __device__ __forceinline__ void a_ready(const Unit&) const {}
    __device__ __forceinline__ void done(const Unit&) const {}
};
template <class Epi, class Sched, bool STAMP = false>
__device__ __forceinline__ void gemm_phase(PG8_LAS unsigned char* lds, const Gemm g, const Sched& S, const Epi& E, unsigned long long* stamps) {
    const int tid = opaque_tid(), wid = __builtin_amdgcn_readfirstlane(tid >> 6), lane = tid & 63, wr = wid >> 2, wc = wid & 3, fr = lane & 15, fq = lane >> 4;
    const int K = g.K, nt = K / BK;
    int ts_lo = 0, ts_hi = 0, nts = 0; const unsigned long long rt_entry = STAMP ? (unsigned long long)wall_clock64() : 0ull;
#define PG8_STAMP() do { if (STAMP && wid == 0 && nts < 64) { const unsigned long long _c = (unsigned long long)clock64(); \
        ts_lo = (lane == nts) ? (int)(unsigned)_c : ts_lo; ts_hi = (lane == nts) ? (int)(unsigned)(_c >> 32) : ts_hi; ++nts; } } while (0)
    PG8_STAMP();
    unsigned voffA[2], voffB[2];
#pragma unroll
    for (int i = 0; i < 2; ++i) { int R, C; stage_rc(tid * 16 + i * 8192, R, C); const int Rb = Epi::PERM ? ((R & ~31) + perm32(R & 31)) : R;
        voffA[i] = (unsigned)(R * g.lda + C) * 2u; voffB[i] = (unsigned)(Rb * g.ldb + C) * 2u; }
    const size_t kstep = (size_t)(BK * 2);
    const size_t hstepA = (size_t)HALF * g.lda * 2, hstepB = (size_t)HALF * g.ldb * 2;
    const size_t tstepA = 2 * hstepA, tstepB = 2 * hstepB;
    const unsigned ldsw = (unsigned)wid * 1024u;
    const int aoff = lds_byte(wr * 64 + fr, fq * 8), boff = lds_byte(wc * 32 + fr, fq * 8);
#define PG8_SA(b, h) (((b) * 2 + (h)) * HTB)
#define PG8_SB(b, h) ((4 + (b) * 2 + (h)) * HTB)
#define PG8_STAGE(bufoff, gbase, voff) do { _Pragma("unroll") for (int _i = 0; _i < 2; ++_i) \
        __builtin_amdgcn_global_load_lds((const unsigned*)((const char*)(gbase) + (voff)[_i]), (PG8_LAS unsigned*)(lds + (bufoff) + ldsw + _i * 8192), 16, 0, 0); } while (0)
#define PG8_LDA(dst, b, h) do { _Pragma("unroll") for (int m = 0; m < 4; ++m) _Pragma("unroll") for (int k = 0; k < 2; ++k) dst[m][k] = *(const PG8_LAS bf16x8*)(lds + PG8_SA(b, h) + aoff + m * 2048 + k * 1024); } while (0)
#define PG8_LDB(dst, b, h) do { _Pragma("unroll") for (int n = 0; n < 2; ++n) _Pragma("unroll") for (int k = 0; k < 2; ++k) dst[n][k] = *(const PG8_LAS bf16x8*)(lds + PG8_SB(b, h) + boff + n * 2048 + k * 1024); } while (0)
#define PG8_MMA(ai, bj, At, Bt) do { __builtin_amdgcn_s_setprio(1); _Pragma("unroll") for (int m = 0; m < 4; ++m) _Pragma("unroll") for (int n = 0; n < 2; ++n) _Pragma("unroll") for (int k = 0; k < 2; ++k) \
        acc[ai][bj][m][n] = __builtin_amdgcn_mfma_f32_16x16x32_bf16(Bt[n][k], At[m][k], acc[ai][bj][m][n], 0, 0, 0); __builtin_amdgcn_s_setprio(0); } while (0)
#define PG8_WAIT_V(n) asm volatile("s_waitcnt vmcnt(" #n ")" ::: "memory")
#define PG8_WAIT_L(n) asm volatile("s_waitcnt lgkmcnt(" #n ")" ::: "memory")
#define PG8_BAR __builtin_amdgcn_s_barrier()
#define PG8_SCHED __builtin_amdgcn_sched_barrier(0)
    Unit cur, nxt; int ui = 0;
    if (!S.next(0, cur)) return;
    f32x4 acc[2][2][4][2];
#pragma unroll
    for (int a = 0; a < 2; ++a)
#pragma unroll
        for (int b = 0; b < 2; ++b)
#pragma unroll
            for (int m = 0; m < 4; ++m)
#pragma unroll
                for (int n = 0; n < 2; ++n) acc[a][b][m][n] = (f32x4){0.f, 0.f, 0.f, 0.f};
    bf16x8 At[4][2], B0[2][2], B1[2][2];
    const char* cA = (const char*)g.A + (size_t)cur.pm * tstepA; const char* cB = (const char*)g.Bt + (size_t)cur.pn * tstepB;
    S.a_ready(cur);
    PG8_STAGE(PG8_SB(0, 0), cB, voffB); PG8_STAGE(PG8_SA(0, 0), cA, voffA); PG8_STAGE(PG8_SB(0, 1), cB + hstepB, voffB); PG8_STAGE(PG8_SA(0, 1), cA + hstepA, voffA);
    if (wr == 1) PG8_BAR;
    PG8_WAIT_V(4); PG8_BAR;
    PG8_STAGE(PG8_SB(1, 0), cB + kstep, voffB); PG8_STAGE(PG8_SA(1, 0), cA + kstep, voffA); PG8_STAGE(PG8_SB(1, 1), cB + hstepB + kstep, voffB);
    PG8_WAIT_V(6); PG8_BAR;
    PG8_STAMP();
    for (;;) {
        const bool has_next = S.next(ui + 1, nxt);
        const char* nA = has_next ? (const char*)g.A + (size_t)nxt.pm * tstepA : cA; const char* nB = has_next ? (const char*)g.Bt + (size_t)nxt.pn * tstepB : cB;
        for (int t = 0; t < nt; t += 2) {
            const bool last = (t == nt - 2);
            const char* a1 = cA + (size_t)(t + 1) * kstep;
            const char* a2 = last ? nA : cA + (size_t)(t + 2) * kstep; const char* b2 = last ? nB : cB + (size_t)(t + 2) * kstep;
            const char* a3 = a2 + kstep; const char* b3 = b2 + kstep;
            if (last && has_next) S.a_ready(nxt);
            E.khook(t, acc, wr, fr);
            PG8_LDB(B0, 0, 0); PG8_SCHED; PG8_LDA(At, 0, 0); PG8_STAGE(PG8_SA(1, 1), a1 + hstepA, voffA);
            PG8_WAIT_L(8); PG8_BAR; PG8_WAIT_L(0); PG8_MMA(0, 0, At, B0); PG8_BAR; PG8_SCHED;
            PG8_LDB(B1, 0, 1); PG8_STAGE(PG8_SB(0, 0), b2, voffB);
            PG8_BAR; PG8_WAIT_L(0); PG8_MMA(0, 1, At, B1); PG8_BAR;
            PG8_LDA(At, 0, 1); PG8_STAGE(PG8_SA(0, 0), a2, voffA);
            PG8_BAR; PG8_WAIT_L(0); PG8_MMA(1, 0, At, B0); PG8_BAR; PG8_SCHED;
            PG8_STAGE(PG8_SB(0, 1), b2 + hstepB, voffB);
            PG8_WAIT_V(6); PG8_BAR; PG8_MMA(1, 1, At, B1); PG8_BAR;
            PG8_LDB(B0, 1, 0); PG8_SCHED; PG8_LDA(At, 1, 0); PG8_STAGE(PG8_SA(0, 1), a2 + hstepA, voffA);
            PG8_WAIT_L(8); PG8_BAR; PG8_WAIT_L(0); PG8_MMA(0, 0, At, B0); PG8_BAR; PG8_SCHED;
            PG8_LDB(B1, 1, 1); PG8_STAGE(PG8_SB(1, 0), b3, voffB);
            PG8_BAR; PG8_WAIT_L(0); PG8_MMA(0, 1, At, B1); PG8_BAR;
            PG8_LDA(At, 1, 1); PG8_STAGE(PG8_SA(1, 0), a3, voffA);
            PG8_BAR; PG8_WAIT_L(0); PG8_MMA(1, 0, At, B0); PG8_BAR; PG8_SCHED;
            PG8_STAGE(PG8_SB(1, 1), b3 + hstepB, voffB);
            PG8_WAIT_V(6); PG8_BAR; PG8_MMA(1, 1, At, B1); PG8_BAR;
        }
        PG8_STAMP();
        if constexpr (!Epi::AFTER_DRAIN) { E(acc, cur, wr, wc, fr, fq); S.done(cur); }
        PG8_STAMP();
        if (!has_next) break;
#pragma unroll
        for (int a = 0; a < 2; ++a)
#pragma unroll
            for (int b = 0; b < 2; ++b)
#pragma unroll
                for (int m = 0; m < 4; ++m)
#pragma unroll
                    for (int n = 0; n < 2; ++n) acc[a][b][m][n] = (f32x4){0.f, 0.f, 0.f, 0.f};
        cur = nxt; cA = nA; cB = nB; ++ui;
    }
    PG8_WAIT_V(0);
    if (wr == 0) PG8_BAR;
    PG8_BAR;
    if constexpr (Epi::AFTER_DRAIN) { E.fused(acc, cur, wr, wc, fr, fq, lds, wid, lane); S.done(cur); }
    PG8_STAMP();
    if (STAMP && wid == 0) { stamps[lane] = lane < nts ? (((unsigned long long)(unsigned)ts_hi << 32) | (unsigned)ts_lo) : 0ull;
        if (lane == 62) stamps[62] = rt_entry; if (lane == 63) stamps[63] = (unsigned long long)wall_clock64(); }
#undef PG8_STAMP
#undef PG8_SA
#undef PG8_SB
#undef PG8_STAGE
#undef PG8_LDA
#undef PG8_LDB
#undef PG8_MMA
#undef PG8_WAIT_V
#undef PG8_WAIT_L
#undef PG8_BAR
#undef PG8_SCHED
}
}

#define TB_LD 136
#define TF_LD 132
template <bool SCALE>
__device__ __forceinline__ void stage_bf16(const f32x16 (&acc)[2][2], const float* rsl) {
    bf16* T = (bf16*)smem;
    const int tid = opaque_tid(), w = tid >> 6, l = tid & 63, hh = l >> 5, wm = w >> 1, wn = w & 1;
#pragma unroll
    for (int i = 0; i < 2; ++i)
#pragma unroll
        for (int rr = 0; rr < 16; ++rr) {
            int row = wm * 64 + i * 32 + (rr & 3) + 8 * (rr >> 2) + 4 * hh;
            float sc = SCALE ? rsl[row] : 1.f;
#pragma unroll
            for (int j = 0; j < 2; ++j) T[row * TB_LD + wn * 64 + j * 32 + (l & 31)] = (bf16)(acc[i][j][rr] * sc);
        }
    __syncthreads();
}
template <bool SCALE>
__device__ __forceinline__ void stage_f32(const f32x16 (&acc)[2][2], const float* rsl) {
    float* T = (float*)smem;
    const int tid = opaque_tid(), w = tid >> 6, l = tid & 63, hh = l >> 5, wm = w >> 1, wn = w & 1;
#pragma unroll
    for (int i = 0; i < 2; ++i)
#pragma unroll
        for (int rr = 0; rr < 16; ++rr) {
            int row = wm * 64 + i * 32 + (rr & 3) + 8 * (rr >> 2) + 4 * hh;
            float sc = SCALE ? rsl[row] : 1.f;
#pragma unroll
            for (int j = 0; j < 2; ++j) T[row * TF_LD + wn * 64 + j * 32 + (l & 31)] = acc[i][j][rr] * sc;
        }
    __syncthreads();
}
template <typename CMAP>
__device__ __forceinline__ void store_rows_bf16(bf16* dst, int ld, int m0, CMAP cmap) {
    const bf16* T = (const bf16*)smem;
    const int tid = opaque_tid();
#pragma unroll
    for (int q = 0; q < 8; ++q) {
        int id = tid + 512 * q, row = id >> 4, ch = id & 15;
        u32x4 v = *(const u32x4*)(T + row * TB_LD + ch * 8);
        *(u32x4*)(dst + (size_t)(m0 + row) * ld + cmap(ch * 8)) = v;
    }
}
__device__ __forceinline__ void store_cols_bf16(bf16* vt, size_t crow0, int s0) {
    const unsigned short* T = (const unsigned short*)smem;
    const int tid = opaque_tid();
#pragma unroll
    for (int q = 0; q < 8; ++q) {
        int id = tid + 512 * q, c = id & 127, sg = id >> 7;
        unsigned e[8];
#pragma unroll
        for (int k = 0; k < 8; ++k) e[k] = T[(8 * sg + k) * TB_LD + c];
        u32x4 v = {e[0] | (e[1] << 16), e[2] | (e[3] << 16), e[4] | (e[5] << 16), e[6] | (e[7] << 16)};
        *(u32x4*)(vt + (crow0 + c) * SEQ + s0 + 8 * sg) = v;
    }
}
__device__ __forceinline__ void residual_store(const float* hin, float* hout, bf16* hb_out, float* gss, int m0, int n0, int nt) {
    const float* T = (const float*)smem;
    const int tid = opaque_tid(), l = tid & 63;
#pragma unroll 4
    for (int q = 0; q < 16; ++q) {
        int id = tid + 512 * q, row = id >> 5, ch = id & 31;
        f32x4 d = *(const f32x4*)(T + row * TF_LD + ch * 4);
        size_t gi = (size_t)(m0 + row) * 1024 + n0 + ch * 4;
        f32x4 h = *(const f32x4*)(hin + gi);
        f32x4 v = h + d;
        *(f32x4*)(hout + gi) = v;
        u32x2 b = {pack2(v.x, v.y), pack2(v.z, v.w)};
        *(u32x2*)(hb_out + (size_t)(m0 + row) * LDH + n0 + ch * 4) = b;
        float ss = v.x * v.x + v.y * v.y + v.z * v.z + v.w * v.w;
        ss = dpp_add<0xB1>(ss); ss = dpp_add<0x4E>(ss); ss = dpp_add<0x141>(ss); ss = dpp_add<0x140>(ss);
        ss += __shfl_xor(ss, 16);
        if ((l & 31) == 0) gss[(size_t)(m0 + row) * 8 + nt] = ss;
    }
}
struct ColAdd { int off; __device__ __forceinline__ int operator()(int c) const { return c + off; } };
struct ColHead96 { __device__ __forceinline__ int operator()(int c) const { return (c >> 6) * 96 + (c & 63); } };

struct EpiProj {
    static constexpr bool PERM = true, AFTER_DRAIN = false;
    const float* ssrow; char* ws;
    __device__ __forceinline__ void khook(int, f32x4 (&)[2][2][4][2], int, int) const {}
    __device__ __forceinline__ void operator()(const f32x4 (&acc)[2][2][4][2], const pg8::Unit& u, int wr, int wc, int fr, int fqd) const {
        asm volatile("" : "+v"(fr), "+v"(fqd));
        const int row0 = u.pm * 256 + wr * 64 + fr, lc0 = wc * 32 + 8 * fqd, pn = u.pn;
        size_t doff; int ld = 256;
        if (pn == 0) doff = OFF_FQ; else if (pn == 1) doff = OFF_FK; else if (pn == 2) doff = OFF_PART;
        else if (pn == 3) doff = OFF_SQ; else if (pn == 4) doff = OFF_SKK; else if (pn == 5) doff = OFF_PART + 8 * MBy;
        else if (pn == 6) { doff = OFF_CQ; ld = LDP; } else { doff = OFF_CKV; ld = LDC; }
        bf16* dst = (bf16*)(ws + doff);
        bf16* mk = (bf16*)(ws + OFF_MK); float* flog = (float*)(ws + OFF_FLOG); const float* cs = (const float*)(ws + OFF_CS);
#pragma unroll
        for (int ai = 0; ai < 2; ++ai)
#pragma unroll
            for (int m = 0; m < 4; ++m) {
                const int row = row0 + ai * 128 + m * 16;
                const float rs = row_rs8(ssrow, row);
#pragma unroll
                for (int bj = 0; bj < 2; ++bj) {
                    f32x4 v0 = acc[ai][bj][m][0] * rs, v1 = acc[ai][bj][m][1] * rs;
                    if (pn == 2 || pn == 5) {
                        const int c0 = bj * 128 + lc0;
                        unsigned short* vt = (unsigned short*)(ws + (pn == 2 ? OFF_FVT : OFF_SVT)) + ((size_t)((row >> 11) * 4 + (c0 >> 6)) * 64 + (c0 & 63)) * SEQ + (row & 2047);
                        const unsigned w0 = pack2(v0[0], v0[1]), w1 = pack2(v0[2], v0[3]), w2 = pack2(v1[0], v1[1]), w3 = pack2(v1[2], v1[3]);
                        vt[0 * SEQ] = (unsigned short)(w0 & 0xffffu); vt[1 * SEQ] = (unsigned short)(w0 >> 16);
                        vt[2 * SEQ] = (unsigned short)(w1 & 0xffffu); vt[3 * SEQ] = (unsigned short)(w1 >> 16);
                        vt[4 * SEQ] = (unsigned short)(w2 & 0xffffu); vt[5 * SEQ] = (unsigned short)(w2 >> 16);
                        vt[6 * SEQ] = (unsigned short)(w3 & 0xffffu); vt[7 * SEQ] = (unsigned short)(w3 >> 16);
                    } else if (pn < 7 || bj == 0) {
                        u32x4 wv = {pack2(v0[0], v0[1]), pack2(v0[2], v0[3]), pack2(v1[0], v1[1]), pack2(v1[2], v1[3])};
                        *(u32x4*)(dst + (size_t)row * ld + bj * 128 + lc0) = wv;
                    } else if (wc == 0) {
                        const int hh = fqd >> 1, pi = 8 * (fqd & 1);
                        float vv[8] = {v0[0], v0[1], v0[2], v0[3], v1[0], v1[1], v1[2], v1[3]}, ov[8];
                        const f32x4* c4 = (const f32x4*)(cs + ((size_t)row * 16 + pi) * 2);
                        f32x4 t0 = c4[0], t1 = c4[1], t2 = c4[2], t3 = c4[3];
                        float cc[8] = {t0.x, t0.z, t1.x, t1.z, t2.x, t2.z, t3.x, t3.z}, sn[8] = {t0.y, t0.w, t1.y, t1.w, t2.y, t2.w, t3.y, t3.w};
#pragma unroll
                        for (int e = 0; e < 8; ++e) {
                            float pv = __builtin_bit_cast(float, partner32(__builtin_bit_cast(int, vv[e]), hh));
                            ov[e] = hh ? (pv * sn[e] + vv[e] * cc[e]) : (vv[e] * cc[e] - pv * sn[e]);
                        }
                        u32x4 wv = {pack2(ov[0], ov[1]), pack2(ov[2], ov[3]), pack2(ov[4], ov[5]), pack2(ov[6], ov[7])};
#pragma unroll
                        for (int h = 0; h < 4; ++h) *(u32x4*)(mk + (size_t)row * 384 + h * 96 + 64 + 8 * fqd) = wv;
                    } else if (wc == 1 && fqd == 0) {
                        *(f32x4*)(flog + (size_t)row * 4) = v0;
                    }
                }
            }
    }
};
__device__ __forceinline__ void phase_proj(const Params& P, int L, int hsel, int ss_slot) {
    char* ws = opq(P.ws);
    const float* ssrow = (const float*)(ws + OFF_SSA) + (size_t)ss_slot * TOK * 8;
    const bf16* hb = (const bf16*)(ws + (hsel ? OFF_HB1 : OFF_HB0));
    const bf16* Bt = (const bf16*)(ws + OFF_WIN) + (size_t)L * 2048 * LDH;
    pg8::Gemm g{hb, Bt, LDH, LDH, TOK, 2048, 1024};
    pg8::StaticOrder S; S.init(TOK, 2048, gridDim.x, blockIdx.x);
    EpiProj E{ssrow, ws};
    pg8::gemm_phase((PG8_LAS unsigned char*)smem, g, S, E, nullptr);
    __syncthreads();
}

template <int KW>
__device__ __forceinline__ void row_rms_to_lds(const bf16* A, int lda, int m0) {
    const int tid = opaque_tid(), row = tid >> 1, half = tid & 1;
    float ss = 0.f;
    const u32x4* p = (const u32x4*)(A + (size_t)(m0 + row) * lda + half * (KW / 2));
#pragma unroll
    for (int q = 0; q < KW / 16; ++q) {
        u32x4 v = p[q];
        float a;
        a = bflo(v.x); ss += a * a; a = bfhi(v.x); ss += a * a;
        a = bflo(v.y); ss += a * a; a = bfhi(v.y); ss += a * a;
        a = bflo(v.z); ss += a * a; a = bfhi(v.z); ss += a * a;
        a = bflo(v.w); ss += a * a; a = bfhi(v.w); ss += a * a;
    }
    ss += __shfl_xor(ss, 1);
    if (half == 0) ((float*)(smem + LDS_AUX))[row] = rsqrtf(ss * (1.f / (float)KW) + EPSF);
}

__device__ __forceinline__ void phase_mla_up(const Params& P, int L) {
    char* ws = opq(P.ws);
    const bf16* cq = (const bf16*)(ws + OFF_CQ); const bf16* ckv = (const bf16*)(ws + OFF_CKV);
    const bf16* wuq = (const bf16*)(ws + OFF_WUQ) + (size_t)L * 384 * LDP;
    const bf16* wukv = (const bf16*)(ws + OFF_WUKV) + (size_t)L * 768 * LDC;
    bf16* mq = (bf16*)(ws + OFF_MQ); bf16* mk = (bf16*)(ws + OFF_MK); bf16* mvt = (bf16*)(ws + OFF_MVT);
    const float* cs = (const float*)(ws + OFF_CS);
    const float* flog = (const float*)(ws + OFF_FLOG);
    float* cumF = (float*)(ws + OFF_CUMF);
    const int tid = opaque_tid(), w = tid >> 6, l = tid & 63, hh = l >> 5, wm = w >> 1, wn = w & 1;
    const int NQ = 64 * 3, NKV = 64 * 6, NCF = 8;
    const float* aux = (const float*)(smem + LDS_AUX);
    const bool deal = (gridDim.x == 256);
    const int nslot = deal ? 4 : (NQ + NKV + NCF + (int)gridDim.x - 1) / (int)gridDim.x;
    for (int slot = 0; slot < nslot; ++slot) {
        int item;
        if (deal) {
            const int bx = blockIdx.x;
            if (bx < 192) item = (slot == 0) ? bx : (slot == 1) ? (NQ + bx) : (slot == 2 && bx < NCF) ? (NQ + NKV + bx) : -1;
            else item = (slot < 3) ? (NQ + 192 + 3 * (bx - 192) + slot) : -1;
        } else {
            item = blockIdx.x + slot * gridDim.x;
            if (item >= NQ + NKV + NCF) item = -1;
        }
        if (item < 0) continue;
        if (item < NQ) {
            int mt = item / 3, nt = item % 3;
            int m0 = mt * 256, n0 = nt * 128;
            __syncthreads();
            f32x16 acc[2][2];
            ZERO_ACC(acc);
            float ssq[2] = {0.f, 0.f};
            gemm_core(acc, cq, LDP, wuq, LDP, 256, m0, n0, SsqHook(), ssq);
#pragma unroll
            for (int i = 0; i < 2; ++i) {
                const float st = ssq[i] + __shfl_xor(ssq[i], 32);
                ((float*)(smem + LDS_AUX))[wm * 64 + i * 32 + (l & 31)] = rsqrtf(st * (1.f / 256.f) + EPSF);
            }
#pragma unroll
            for (int i = 0; i < 2; ++i)
#pragma unroll
                for (int j = 0; j < 2; ++j) {
                    int c0 = n0 + wn * 64 + j * 32;
                    int rloc = wm * 64 + i * 32 + 4 * hh;
                    bool rot = (c0 % 96) == 64;
                    int ci = l & 31, pi = ci & 15;
#pragma unroll
                    for (int rr = 0; rr < 16; ++rr) {
                        int rl = rloc + (rr & 3) + 8 * (rr >> 2);
                        float v = acc[i][j][rr] * (aux[rl] * (0.10206207261596577f * LOG2E));
                        if (rot) {
                            float pv = __shfl_xor(v, 16);
                            float2 c_s = *(const float2*)(cs + ((size_t)(m0 + rl) * 16 + pi) * 2);
                            v = (ci < 16) ? (v * c_s.x - pv * c_s.y) : (pv * c_s.y + v * c_s.x);
                        }
                        acc[i][j][rr] = v;
                    }
                }
            stage_bf16<false>(acc, nullptr);
            store_rows_bf16(mq, 384, m0, ColAdd{n0});
        } else if (item < NQ + NKV) {
            int it2 = item - NQ;
            int mt = it2 / 6, nt = it2 % 6;
            int m0 = mt * 256, n0 = nt * 128;
            __syncthreads();
            f32x16 acc[2][2];
            ZERO_ACC(acc);
            float ssq[2] = {0.f, 0.f};
            gemm_core(acc, ckv, LDC, wukv, LDC, 128, m0, n0, SsqHook(), ssq);
#pragma unroll
            for (int i = 0; i < 2; ++i) {
                const float st = ssq[i] + __shfl_xor(ssq[i], 32);
                ((float*)(smem + LDS_AUX))[wm * 64 + i * 32 + (l & 31)] = rsqrtf(st * (1.f / 128.f) + EPSF);
            }
            stage_bf16<true>(acc, aux);
            if (nt < 2) {
                const int nb0 = n0;
                struct CM { int n0; __device__ __forceinline__ int operator()(int c) const { int col = n0 + c; return (col >> 6) * 96 + (col & 63); } };
                store_rows_bf16(mk, 384, m0, CM{nb0});
            } else {
                store_cols_bf16(mvt, (size_t)(m0 >> 11) * 512 + (n0 - 256), m0 & 2047);
            }
        } else {
            const int b = item - NQ - NKV;
            f32x4 zz[4];
#pragma unroll
            for (int i = 0; i < 4; ++i) zz[i] = *(const f32x4*)(flog + ((size_t)b * SEQ + tid * 4 + i) * 4);
            const f32x4 bf4 = *(const f32x4*)(P.b_forget + L * 4);
            float run[4] = {0.f, 0.f, 0.f, 0.f};
            float vals[4][4];
#pragma unroll
            for (int i = 0; i < 4; ++i)
#pragma unroll
                for (int hd = 0; hd < 4; ++hd) { run[hd] += log_sigmoid_f(zz[i][hd] + bf4[hd]); vals[i][hd] = run[hd]; }
            float* wtot = (float*)(smem + LDS_AUX) + 1024;
            float excl[4];
#pragma unroll
            for (int hd = 0; hd < 4; ++hd) {
                float incl = run[hd];
#pragma unroll
                for (int o = 1; o < 64; o <<= 1) {
                    float t = __shfl_up(incl, o);
                    if (l >= o) incl += t;
                }
                excl[hd] = incl - run[hd];
                if (l == 63) wtot[w * 4 + hd] = incl;
            }
            __syncthreads();
#pragma unroll
            for (int hd = 0; hd < 4; ++hd) {
                float pre = 0.f;
                for (int ww = 0; ww < 8; ++ww) pre += (ww < w) ? wtot[ww * 4 + hd] : 0.f;
                const f32x4 o4 = {vals[0][hd] + excl[hd] + pre, vals[1][hd] + excl[hd] + pre, vals[2][hd] + excl[hd] + pre, vals[3][hd] + excl[hd] + pre};
                *(f32x4*)(cumF + (size_t)(b * 4 + hd) * SEQ + tid * 4) = o4;
            }
            __syncthreads();
        }
    }
}

template <int MODE, int DK, int DV>
__device__ __forceinline__ void attn_item(const bf16* __restrict__ Q, int ldq, const bf16* __restrict__ Kg, int ldk,
                          const bf16* __restrict__ Vt, const float* __restrict__ cumF, bf16* __restrict__ Y,
                          float* __restrict__ ssy, int b, int h, int qb, float c1, char* lds, int fake = 0) {
    constexpr int KSTR = DK * 2 + 16;
    constexpr int VSTR = 144;
    constexpr int KBYTES = 64 * KSTR, VBYTES = DV * VSTR;
    constexpr int BUF = (KBYTES + VBYTES + 256 + 255) & ~255;
    static_assert(2 * BUF <= 65536, "lds");
    constexpr int KCH = DK / 8, KPT = (64 * KCH) / 256, VPT = (DV * 8) / 256;
    const int tid = opaque_tid() & 255, w = tid >> 6, l = tid & 63, r = l & 31, hh = l >> 5;
    const int q0 = qb * 128;
    const int qrow = q0 + 32 * w + r;
    const size_t tok = (size_t)b * SEQ + qrow;
    const int bh = b * 4 + h;
    bf16x8 qf[DK / 16];
#pragma unroll
    for (int s = 0; s < DK / 16; ++s) qf[s] = *(const bf16x8*)(Q + tok * ldq + h * DK + 16 * s + 8 * hh);
    f32x16 o[DV / 32];
    const f32x16 zero16 = {0.f, 0.f, 0.f, 0.f, 0.f, 0.f, 0.f, 0.f, 0.f, 0.f, 0.f, 0.f, 0.f, 0.f, 0.f, 0.f};
#pragma unroll
    for (int d = 0; d < DV / 32; ++d) o[d] = zero16;
    float m = -1e30f, lsum = 0.f, R = 0.f;
    bool sbdead = false;
    int* dmask = (int*)(smem + LDS_BYTES - 32);
    float Fq = 0.f;
    if (MODE == 0) Fq = cumF[(size_t)bh * SEQ + qrow] * LOG2E;
    const int nkt = (q0 + 128) >> 6;
    u32x4 kregA[KPT], vregA[VPT], kregB[KPT], vregB[VPT];
    float4 fregA = {0.f, 0.f, 0.f, 0.f}, fregB = {0.f, 0.f, 0.f, 0.f};
    auto gload = [&](int kt, u32x4 (&kreg)[KPT], u32x4 (&vreg)[VPT], float4& freg) {
#pragma unroll
        for (int i = 0; i < KPT; ++i) {
            int e = tid + 256 * i;
            int row = e / KCH, ch = e % KCH;
            kreg[i] = *(const u32x4*)(Kg + ((size_t)b * SEQ + kt * 64 + row) * ldk + h * DK + ch * 8);
        }
#pragma unroll
        for (int i = 0; i < VPT; ++i) {
            int e = tid + 256 * i;
            int row = e >> 3, ch = e & 7;
            vreg[i] = *(const u32x4*)(Vt + ((size_t)bh * DV + row) * SEQ + kt * 64 + ch * 8);
        }
        if (MODE == 0 && tid < 16) freg = *(const float4*)(cumF + (size_t)bh * SEQ + kt * 64 + tid * 4);
    };
    auto lwrite = [&](int buf, u32x4 (&kreg)[KPT], u32x4 (&vreg)[VPT], float4& freg) {
        char* base = lds + buf * BUF;
#pragma unroll
        for (int i = 0; i < KPT; ++i) {
            int e = tid + 256 * i;
            int row = e / KCH, ch = e % KCH;
            *(u32x4*)(base + row * KSTR + ch * 16) = kreg[i];
        }
#pragma unroll
        for (int i = 0; i < VPT; ++i) {
            int e = tid + 256 * i;
            int row = e >> 3, ch = e & 7;
            *(u32x4*)(base + KBYTES + row * VSTR + ch * 16) = vreg[i];
        }
        if (MODE == 0 && tid < 16) { float4 fn = {-freg.x * LOG2E, -freg.y * LOG2E, -freg.z * LOG2E, -freg.w * LOG2E}; *(float4*)(base + KBYTES + VBYTES + tid * 16) = fn; }
    };
    const int prow = (r & 0x13) | ((r & 4) << 1) | ((r & 8) >> 1);
    auto ktof = [&](int it) { return (MODE == 1) ? (nkt - 1 - it) : it; };
    gload(ktof(0), kregA, vregA, fregA);
    lwrite(0, kregA, vregA, fregA);
    constexpr bool D2 = (MODE != 2);
    if (D2 && nkt > 1) gload(ktof(1), kregB, vregB, fregB);
    __syncthreads();
    auto tile = [&](int it, u32x4 (&kn)[KPT], u32x4 (&vn)[VPT], float4& fn2, u32x4 (&kf)[KPT], u32x4 (&vf2)[VPT], float4& ff) {
        const int kt = ktof(it);
        if (!(fake & 1)) {
        if (D2) { if (it + 2 < nkt) gload(ktof(it + 2), kf, vf2, ff); }
        else { if (it + 1 < nkt) gload(ktof(it + 1), kf, vf2, ff); }
        }
        const char* base = lds + (it & 1) * BUF;
        bool active = (kt * 64) <= (q0 + 32 * w + 31);
        if (MODE == 1) {
            if (sbdead) { active = false; atomicOr(&dmask[it & 1], 1 << (opaque_tid() >> 6)); }
        }
        if (active) {
            const bool needmask = (kt * 64 + 63) >= (q0 + 32 * w);
            f32x16 s[2];
#pragma unroll
            for (int sub = 0; sub < 2; ++sub) {
                s[sub] = zero16;
#pragma unroll
                for (int ks = 0; ks < DK / 16; ++ks) {
                    bf16x8 kf = *(const bf16x8*)(base + (sub * 32 + prow) * KSTR + (2 * ks + hh) * 16);
                    s[sub] = __builtin_amdgcn_mfma_f32_32x32x16_bf16(kf, qf[ks], s[sub], 0, 0, 0);
                }
            }
            bf16x8 pf[2][2];
            if (fake & 2) {
#pragma unroll
                for (int sub = 0; sub < 2; ++sub)
#pragma unroll
                    for (int a = 0; a < 2; ++a) {
                        uint4 u;
                        u.x = pack2(s[sub][8 * a], s[sub][8 * a + 1]); u.y = pack2(s[sub][8 * a + 2], s[sub][8 * a + 3]);
                        u.z = pack2(s[sub][8 * a + 4], s[sub][8 * a + 5]); u.w = pack2(s[sub][8 * a + 6], s[sub][8 * a + 7]);
                        pf[sub][a] = __builtin_bit_cast(bf16x8, u);
                    }
                lsum = 1.f;
            } else if (MODE != 1) {
                const float* Ft = (const float*)(base + KBYTES + VBYTES);
                float mx = -INFINITY;
                float tv[2][16];
#pragma unroll
                for (int sub = 0; sub < 2; ++sub)
#pragma unroll
                    for (int a = 0; a < 2; ++a) {
                        int kofs = sub * 32 + 16 * a + 8 * hh;
                        float fk[8];
                        if (MODE == 0) {
                            float4 f0 = *(const float4*)(Ft + kofs), f1 = *(const float4*)(Ft + kofs + 4);
                            fk[0] = f0.x; fk[1] = f0.y; fk[2] = f0.z; fk[3] = f0.w; fk[4] = f1.x; fk[5] = f1.y; fk[6] = f1.z; fk[7] = f1.w;
                        }
#pragma unroll
                        for (int j = 0; j < 8; ++j) {
                            int rr = 8 * a + j;
                            float v = (MODE == 0) ? fmaf(s[sub][rr], c1, fk[j]) : s[sub][rr] * c1;
                            tv[sub][rr] = v;
                        }
                    }
                if (needmask) {
#pragma unroll
                    for (int sub = 0; sub < 2; ++sub)
#pragma unroll
                        for (int rr = 0; rr < 16; ++rr) {
                            int key = kt * 64 + sub * 32 + 16 * (rr >> 3) + 8 * hh + (rr & 7);
                            if (key > qrow) tv[sub][rr] = -INFINITY;
                        }
                }
#pragma unroll
                for (int sub = 0; sub < 2; ++sub)
#pragma unroll
                    for (int rr = 0; rr < 16; ++rr) mx = fmaxf(mx, tv[sub][rr]);
                mx = fmaxf(mx, __builtin_bit_cast(float, partner32(__builtin_bit_cast(int, mx), hh)));
                float mnew = fmaxf(m, mx);
                float rsum = 0.f;
#pragma unroll
                for (int sub = 0; sub < 2; ++sub)
#pragma unroll
                    for (int a = 0; a < 2; ++a) {
                        float pv[8];
#pragma unroll
                        for (int j = 0; j < 8; ++j) { pv[j] = fexp2(tv[sub][8 * a + j] - mnew); rsum += pv[j]; }
                        uint4 u;
                        u.x = pack2(pv[0], pv[1]); u.y = pack2(pv[2], pv[3]); u.z = pack2(pv[4], pv[5]); u.w = pack2(pv[6], pv[7]);
                        pf[sub][a] = __builtin_bit_cast(bf16x8, u);
                    }
                rsum += __builtin_bit_cast(float, partner32(__builtin_bit_cast(int, rsum), hh));
                if (__builtin_amdgcn_ballot_w64(mnew != m) != 0ull) {
                    float alpha = fexp2(m - mnew);
                    lsum *= alpha;
#pragma unroll
                    for (int d = 0; d < DV / 32; ++d) o[d] = o[d] * alpha;
                    m = mnew;
                }
                lsum += rsum;
            } else {
#pragma unroll
                for (int sb = 0; sb < 2; ++sb) {
                    const int sub = 1 - sb;
                    float lsig[16], lneg[16];
                    float A0 = 0.f, A1 = 0.f;
#pragma unroll
                    for (int rr = 0; rr < 16; ++rr) {
                        int key = kt * 64 + sub * 32 + 16 * (rr >> 3) + 8 * hh + (rr & 7);
                        bool valid = key < qrow;
                        float z = s[sub][rr] * c1;
                        float e = fexp2(-fabsf(z));
                        float l1p = flog2(1.f + e);
                        float ls = fminf(z, 0.f) - l1p;
                        float ln = valid ? (ls - z) : 0.f;
                        lsig[rr] = valid ? ls : -INFINITY;
                        lneg[rr] = ln;
                        if (rr < 8) A0 += ln; else A1 += ln;
                    }
                    float B0 = __shfl_xor(A0, 32), B1 = __shfl_xor(A1, 32);
                    float base1 = (hh == 0) ? (R + B1) : R;
                    float base0 = (hh == 0) ? (R + B1 + A1 + B0) : (R + A1 + B1);
                    float wv[16];
                    float run = base1;
#pragma unroll
                    for (int j = 7; j >= 0; --j) { wv[8 + j] = fexp2(lsig[8 + j] + run); run += lneg[8 + j]; }
                    run = base0;
#pragma unroll
                    for (int j = 7; j >= 0; --j) { wv[j] = fexp2(lsig[j] + run); run += lneg[j]; }
                    R += A0 + A1 + B0 + B1;
#pragma unroll
                    for (int a = 0; a < 2; ++a) {
                        uint4 u;
                        u.x = pack2(wv[8 * a], wv[8 * a + 1]); u.y = pack2(wv[8 * a + 2], wv[8 * a + 3]);
                        u.z = pack2(wv[8 * a + 4], wv[8 * a + 5]); u.w = pack2(wv[8 * a + 6], wv[8 * a + 7]);
                        pf[sub][a] = __builtin_bit_cast(bf16x8, u);
                    }
                }
            }
            if (MODE == 1) {
                if (__builtin_amdgcn_ballot_w64(R > -150.f) == 0ull) { sbdead = true; atomicOr(&dmask[it & 1], 1 << (opaque_tid() >> 6)); }
            }
#pragma unroll
            for (int d = 0; d < DV / 32; ++d)
#pragma unroll
                for (int sub = 0; sub < 2; ++sub)
#pragma unroll
                    for (int a = 0; a < 2; ++a) {
                        bf16x8 vf = *(const bf16x8*)(base + KBYTES + (d * 32 + r) * VSTR + (sub * 32 + 16 * a + 8 * hh) * 2);
                        o[d] = __builtin_amdgcn_mfma_f32_32x32x16_bf16(vf, pf[sub][a], o[d], 0, 0, 0);
                    }
        }
        if (!(fake & 1)) { if (it + 1 < nkt) lwrite((it + 1) & 1, kn, vn, fn2); }
        __syncthreads();
    };
    if (D2) {
        for (int it = 0; it < nkt; it += 2) {
            if (MODE == 1 && it > 0 && ((volatile int*)dmask)[(it - 1) & 1] == 0xFF) break;
            tile(it, kregB, vregB, fregB, kregA, vregA, fregA);
            if (it + 1 < nkt) {
                if (MODE == 1 && ((volatile int*)dmask)[it & 1] == 0xFF) break;
                tile(it + 1, kregA, vregA, fregA, kregB, vregB, fregB);
            }
        }
    } else {
        for (int it = 0; it < nkt; ++it) tile(it, kregA, vregA, fregA, kregA, vregA, fregA);
    }
    float inv = (MODE == 1) ? 1.f : (1.f / lsum);
    float ssq = 0.f;
#pragma unroll
    for (int d = 0; d < DV / 32; ++d)
#pragma unroll
        for (int g = 0; g < 4; ++g) {
            float v0 = o[d][4 * g] * inv, v1 = o[d][4 * g + 1] * inv, v2 = o[d][4 * g + 2] * inv, v3 = o[d][4 * g + 3] * inv;
            ssq += v0 * v0 + v1 * v1 + v2 * v2 + v3 * v3;
            uint2 u; u.x = pack2(v0, v1); u.y = pack2(v2, v3);
            *(uint2*)(Y + tok * LDH + h * DV + d * 32 + 8 * g + 4 * hh) = u;
        }
    ssq += __shfl_xor(ssq, 32);
    if (hh == 0) ssy[tok * 16 + h] = ssq;
}

__device__ __forceinline__ void phase_attn(const Params& P, int L, int rep = 0, int fake = 0) {
    char* ws = opq(P.ws);
    int* cnt = (int*)(ws + OFF_CNT) + L * 64 + rep * 16;
    int* s_item = (int*)(smem + LDS_BYTES - 16);
    const float* cumF = (const float*)(ws + OFF_CUMF);
    bf16* Y = (bf16*)(ws + (fake ? OFF_PART : OFF_Y));
    float* ssy = fake ? (float*)(ws + OFF_PART + 40 * MBy) : (float*)(ws + OFF_SSY) + (size_t)L * TOK * 16;
    const int half = opaque_tid() >> 8;
    char* lds = smem + half * 65536;
    for (;;) {
        if (opaque_tid() == 0) { int z0 = 0; asm volatile("" : "+v"(z0)); *s_item = atomicAdd(cnt, 1); s_item[-4] = z0; s_item[-3] = z0; }
        __syncthreads();
        int pair = *s_item;
        __syncthreads();
        if (pair >= 768) break;
        int item = pair * 2 + half;
        int qb, type, bh;
        if (item < 1024) { qb = 15 - (item >> 6); type = (item & 32) ? 2 : 0; bh = item & 31; }
        else { const int j2 = item - 1024; qb = 15 - (j2 >> 5); type = 1; bh = j2 & 31; }
        int b = bh >> 2, h = bh & 3;
        if (type == 0) {
            attn_item<2, 96, 128>((const bf16*)(ws + OFF_MQ), 384, (const bf16*)(ws + OFF_MK), 384, (const bf16*)(ws + OFF_MVT), cumF,
                                  Y + 512, ssy + 8, b, h, qb, 1.0f, lds, fake);
        } else if (type == 1) {
            attn_item<1, 64, 64>((const bf16*)(ws + OFF_SQ), 256, (const bf16*)(ws + OFF_SKK), 256, (const bf16*)(ws + OFF_SVT), cumF,
                                 Y + 256, ssy + 4, b, h, qb, 0.125f * LOG2E, lds, fake);
        } else {
            attn_item<0, 64, 64>((const bf16*)(ws + OFF_FQ), 256, (const bf16*)(ws + OFF_FK), 256, (const bf16*)(ws + OFF_FVT), cumF,
                                 Y + 0, ssy + 0, b, h, qb, 0.125f * LOG2E, lds, fake);
        }
    }
}

__device__ __forceinline__ void rowss_flush(float (&part)[2][16], float* gss, int m0, int nt) {
    float* lss = (float*)smem;
    const int tid = opaque_tid(), w = tid >> 6, l = tid & 63, hh = l >> 5, wm = w >> 1, wn = w & 1;
#pragma unroll
    for (int i = 0; i < 2; ++i)
#pragma unroll
        for (int rr = 0; rr < 16; ++rr) {
            float v = part[i][rr];
            v = dpp_add<0xB1>(v); v = dpp_add<0x4E>(v); v = dpp_add<0x141>(v); v = dpp_add<0x140>(v);
            v += __shfl_xor(v, 16);
            if ((l & 31) == 0) lss[wn * 256 + wm * 64 + i * 32 + (rr & 3) + 8 * (rr >> 2) + 4 * hh] = v;
        }
    __syncthreads();
    if (tid < 256) gss[(size_t)(m0 + tid) * 8 + nt] = lss[tid] + lss[256 + tid];
    __syncthreads();
}

__device__ __forceinline__ float sum_fq(float v) {
    float a = v, b = v;
    asm volatile("s_nop 1\n\tv_permlane16_swap_b32 %0, %1\n\ts_nop 1" : "+v"(a), "+v"(b));
    v = a + b; a = v; b = v;
    asm volatile("s_nop 1\n\tv_permlane32_swap_b32 %0, %1\n\ts_nop 1" : "+v"(a), "+v"(b));
    return a + b;
}
template <bool SIG, bool XQ>
__device__ __forceinline__ void residual_fused(const f32x4 (&acc)[2][2][4][2], const pg8::Unit& u, int wr, int wc, int fr, int fqd,
                                               const float* rowscale  , const bf16* gate  ,
                                               const bf16* hb_in, bf16* hb_out, float* gss, unsigned char* xq = nullptr) {
    float* lss = (float*)smem;
#pragma unroll
    for (int ai = 0; ai < 2; ++ai)
#pragma unroll
        for (int m = 0; m < 4; ++m) {
            const int rl = 128 * ai + 64 * wr + 16 * m + fr, row = u.pm * 256 + rl;
            const float sc = rowscale ? rowscale[rl] : 1.f;
#pragma unroll
            for (int bj = 0; bj < 2; ++bj) {
                const int col = u.pn * 256 + 128 * bj + 32 * wc + 8 * fqd;
                const u32x4 hq = *(const u32x4*)(hb_in + (size_t)row * LDH + col);
                const f32x4 hp0 = {bflo(hq.x), bfhi(hq.x), bflo(hq.y), bfhi(hq.y)}, hp1 = {bflo(hq.z), bfhi(hq.z), bflo(hq.w), bfhi(hq.w)};
                f32x4 d0 = acc[ai][bj][m][0] * sc, d1 = acc[ai][bj][m][1] * sc;
                if (SIG) {
#pragma unroll
                    for (int e = 0; e < 4; ++e) {
                        d0[e] = __builtin_amdgcn_rcpf(1.f + fexp2(-LOG2E * d0[e]));
                        d1[e] = __builtin_amdgcn_rcpf(1.f + fexp2(-LOG2E * d1[e]));
                    }
                }
                if (gate) {
                    u32x4 gq = *(const u32x4*)(gate + (size_t)row * 1024 + col);
                    f32x4 g0 = {bflo(gq.x), bfhi(gq.x), bflo(gq.y), bfhi(gq.y)}, g1 = {bflo(gq.z), bfhi(gq.z), bflo(gq.w), bfhi(gq.w)};
                    d0 = d0 * g0; d1 = d1 * g1;
                }
                f32x4 v0 = hp0 + d0, v1 = hp1 + d1;
                u32x4 wv = {pack2(v0[0], v0[1]), pack2(v0[2], v0[3]), pack2(v1[0], v1[1]), pack2(v1[2], v1[3])};
                *(u32x4*)(hb_out + (size_t)row * LDH + col) = wv;
                if (XQ) {
                    f32x4 c0, c1;
#pragma unroll
                    for (int e = 0; e < 4; ++e) { c0[e] = __builtin_amdgcn_fmed3f(v0[e], -448.f, 448.f); c1[e] = __builtin_amdgcn_fmed3f(v1[e], -448.f, 448.f); }
                    int h0 = __builtin_amdgcn_cvt_pk_fp8_f32(c0[0], c0[1], 0, false); h0 = __builtin_amdgcn_cvt_pk_fp8_f32(c0[2], c0[3], h0, true);
                    int h1 = __builtin_amdgcn_cvt_pk_fp8_f32(c1[0], c1[1], 0, false); h1 = __builtin_amdgcn_cvt_pk_fp8_f32(c1[2], c1[3], h1, true);
                    const f32x2 b0 = __builtin_amdgcn_cvt_pk_f32_fp8(h0, false), b1 = __builtin_amdgcn_cvt_pk_f32_fp8(h0, true);
                    const f32x2 b2 = __builtin_amdgcn_cvt_pk_f32_fp8(h1, false), b3 = __builtin_amdgcn_cvt_pk_f32_fp8(h1, true);
                    int l0 = __builtin_amdgcn_cvt_pk_fp8_f32((c0[0] - b0.x) * 16.f, (c0[1] - b0.y) * 16.f, 0, false);
                    l0 = __builtin_amdgcn_cvt_pk_fp8_f32((c0[2] - b1.x) * 16.f, (c0[3] - b1.y) * 16.f, l0, true);
                    int l1 = __builtin_amdgcn_cvt_pk_fp8_f32((c1[0] - b2.x) * 16.f, (c1[1] - b2.y) * 16.f, 0, false);
                    l1 = __builtin_amdgcn_cvt_pk_fp8_f32((c1[2] - b3.x) * 16.f, (c1[3] - b3.y) * 16.f, l1, true);
                    u32x2 hh = {(unsigned)h0, (unsigned)h1}, ll = {(unsigned)l0, (unsigned)l1};
                    *(u32x2*)(xq + (size_t)row * 1024 + col) = hh;
                    *(u32x2*)(xq + 16 * MBy + (size_t)row * 1024 + col) = ll;
                }
                float ss = (v0[0] * v0[0] + v0[1] * v0[1]) + (v0[2] * v0[2] + v0[3] * v0[3]) + (v1[0] * v1[0] + v1[1] * v1[1]) + (v1[2] * v1[2] + v1[3] * v1[3]);
                ss = sum_fq(ss);
                if (fqd == 0) lss[(wc * 256 + rl) * 2 + bj] = ss;
            }
        }
    __syncthreads();
    const int tid = opaque_tid();
    if (tid < 256) {
        const int row = u.pm * 256 + tid;
#pragma unroll
        for (int bj = 0; bj < 2; ++bj)
            gss[(size_t)row * 8 + u.pn * 2 + bj] = (lss[(0 * 256 + tid) * 2 + bj] + lss[(1 * 256 + tid) * 2 + bj]) + (lss[(2 * 256 + tid) * 2 + bj] + lss[(3 * 256 + tid) * 2 + bj]);
    }
    __syncthreads();
}
struct EpiWo {
    static constexpr bool PERM = true, AFTER_DRAIN = true;
    const bf16* hb_in; bf16* hb_out; float* gss; unsigned char* xq;
    __device__ __forceinline__ void khook(int t, f32x4 (&acc)[2][2][4][2], int wr, int fr) const {
        if (t == 4 || t == 8) {
            const float* fac = (const float*)(smem + LDS_AUX) + (t == 4 ? 0 : 256);
#pragma unroll
            for (int ai = 0; ai < 2; ++ai)
#pragma unroll
                for (int m = 0; m < 4; ++m) {
                    const float f = fac[128 * ai + 64 * wr + 16 * m + fr];
#pragma unroll
                    for (int bj = 0; bj < 2; ++bj) { acc[ai][bj][m][0] *= f; acc[ai][bj][m][1] *= f; }
                }
        }
    }
    __device__ __forceinline__ void operator()(const f32x4 (&)[2][2][4][2], const pg8::Unit&, int, int, int, int) const {}
    __device__ __forceinline__ void fused(const f32x4 (&acc)[2][2][4][2], const pg8::Unit& u, int wr, int wc, int fr, int fqd, PG8_LAS unsigned char*, int, int) const {
        residual_fused<false, true>(acc, u, wr, wc, fr, fqd, (const float*)(smem + LDS_AUX) + 512, nullptr, hb_in, hb_out, gss, xq);
    }
};
__device__ __forceinline__ void phase_wo(const Params& P, int L, int hsel, int ss_slot) {
    char* ws = opq(P.ws);
    float* ss_out = (float*)(ws + OFF_SSA) + (size_t)ss_slot * TOK * 8;
    bf16* hb_out = (bf16*)(ws + (hsel ? OFF_HB1 : OFF_HB0));
    const bf16* hb_in = (const bf16*)(ws + (hsel ? OFF_HB0 : OFF_HB1));
    const bf16* Y = (const bf16*)(ws + OFF_Y);
    const bf16* Bt = (const bf16*)(ws + OFF_WO) + (size_t)L * 1024 * LDH;
    const float* ssy = (const float*)(ws + OFF_SSY) + (size_t)L * TOK * 16;
    float* aux = (float*)(smem + LDS_AUX);
    const int tid = opaque_tid();
    pg8::Gemm g{Y, Bt, LDH, LDH, TOK, 1024, 1024};
    pg8::StaticOrder S; S.init(TOK, 1024, gridDim.x, blockIdx.x);
    pg8::Unit u0;
    if (S.next(0, u0) && tid < 256) {
        int row = u0.pm * 256 + tid;
        float4 v0 = *(const float4*)(ssy + (size_t)row * 16), v1 = *(const float4*)(ssy + (size_t)row * 16 + 4), v2 = *(const float4*)(ssy + (size_t)row * 16 + 8);
        float r0 = rsqrtf(((v0.x + v0.y) + (v0.z + v0.w)) * (1.f / 256.f) + EPSF);
        float r1 = rsqrtf(((v1.x + v1.y) + (v1.z + v1.w)) * (1.f / 256.f) + EPSF);
        float r2 = rsqrtf(((v2.x + v2.y) + (v2.z + v2.w)) * (1.f / 512.f) + EPSF);
        aux[tid] = r0 / r1; aux[256 + tid] = r1 / r2; aux[512 + tid] = r2;
    }
    __syncthreads();
    EpiWo E{hb_in, hb_out, ss_out, (unsigned char*)(ws + OFF_XH)};
    pg8::gemm_phase((PG8_LAS unsigned char*)smem, g, S, E, nullptr);
    __syncthreads();
}

struct EpiPq {
    static constexpr bool PERM = true, AFTER_DRAIN = false;
    bf16* O; const float* ssrow;
    __device__ __forceinline__ void khook(int, f32x4 (&)[2][2][4][2], int, int) const {}
    __device__ __forceinline__ void operator()(const f32x4 (&acc)[2][2][4][2], const pg8::Unit& u, int wr, int wc, int fr, int fq) const {
        const int row0 = u.pm * 256 + wr * 64 + fr, col0 = u.pn * 256 + wc * 32 + 8 * fq;
#pragma unroll
        for (int ai = 0; ai < 2; ++ai)
#pragma unroll
            for (int m = 0; m < 4; ++m) {
                const int row = row0 + ai * 128 + m * 16;
                const float rs = row_rs8(ssrow, row);
                bf16* rowp = O + (size_t)row * 1024 + col0;
#pragma unroll
                for (int bj = 0; bj < 2; ++bj) {
                    f32x4 v0 = acc[ai][bj][m][0] * rs, v1 = acc[ai][bj][m][1] * rs;
                    u32x4 wv = {pack2(v0[0], v0[1]), pack2(v0[2], v0[3]), pack2(v1[0], v1[1]), pack2(v1[2], v1[3])};
                    *(u32x4*)(rowp + bj * 128) = wv;
                }
            }
    }
};
__device__ __forceinline__ void topk_task(const Params& P, int L, int t0, int h);
__device__ __forceinline__ void phase_pq(const Params& P, int L, int hsel, int ss_slot) {
    char* ws = opq(P.ws);
    const float* ssrow = (const float*)(ws + OFF_SSA) + (size_t)ss_slot * TOK * 8;
    const bf16* hb = (const bf16*)(ws + (hsel ? OFF_HB1 : OFF_HB0));
    const bf16* Bt = (const bf16*)(ws + OFF_WQ) + (size_t)L * 1024 * LDH;
    pg8::Gemm g{hb, Bt, LDH, LDH, TOK, 1024, 1024};
    pg8::StaticOrder S; S.init(TOK, 1024, gridDim.x, blockIdx.x);
    EpiPq E{(bf16*)(ws + OFF_PQ), ssrow};
    pg8::gemm_phase((PG8_LAS unsigned char*)smem, g, S, E, nullptr);
    asm volatile("s_waitcnt vmcnt(0)" ::: "memory");
    __syncthreads();
    const int w = opaque_tid() >> 6;
    pg8::Unit u;
    for (int i = 0; S.next(i, u); ++i)
        for (int q = 0; q < 2; ++q) topk_task(P, L, u.pm * 256 + 32 * w, 2 * u.pn + q);
    __syncthreads();
}

__device__ __forceinline__ void cswap(int& a, int& b) { int mx = max(a, b), mn = min(a, b); a = mx; b = mn; }
__device__ __forceinline__ void bitonic_sort16(int (&v)[16]) {
#pragma unroll
    for (int k = 2; k <= 16; k <<= 1)
#pragma unroll
        for (int j = k >> 1; j > 0; j >>= 1)
#pragma unroll
            for (int i = 0; i < 16; ++i) {
                int q = i ^ j;
                if (q > i) {
                    if ((i & k) == 0) cswap(v[i], v[q]); else cswap(v[q], v[i]);
                }
            }
}
__device__ __forceinline__ void merge_top16(int (&Lv)[16], const int (&Rv)[16]) {
#pragma unroll
    for (int i = 0; i < 16; ++i) Lv[i] = max(Lv[i], Rv[15 - i]);
#pragma unroll
    for (int j = 8; j > 0; j >>= 1)
#pragma unroll
        for (int i = 0; i < 16; ++i) {
            int q = i ^ j;
            if (q > i) cswap(Lv[i], Lv[q]);
        }
}
__device__ __forceinline__ int f2key(float v, int low, int mask) {
    int b = __float_as_int(v);
    b ^= (b >> 31) & 0x7fffffff;
    return (b & ~mask) | low;
}
__device__ __forceinline__ float key2f(int k, int mask) {
    int b = k & ~mask;
    b ^= (b >> 31) & 0x7fffffff;
    return __int_as_float(b);
}

__device__ __forceinline__ void topk_task(const Params& P, int L, int t0, int h) {
    char* ws = opq(P.ws);
    const bf16* pq = (const bf16*)(ws + OFF_PQ);
    const bf16* skb = (const bf16*)(ws + OFF_SKB) + (size_t)L * 16 * 128 * 64;
    unsigned short* ids = (unsigned short*)(ws + OFF_IDS);
    float* gates = (float*)(ws + OFF_GATE);
    const int tid = opaque_tid(), w = tid >> 6, l = tid & 63, r = l & 31, hh = l >> 5;
    unsigned char* lidx = (unsigned char*)(smem + w * 1024 + r * 32);
    {
        int F[2][16];
#pragma unroll
        for (int p = 0; p < 2; ++p) {
            const int hp = h * 2 + p;
            f32x16 acc[4];
            const f32x16 z16 = {0.f, 0.f, 0.f, 0.f, 0.f, 0.f, 0.f, 0.f, 0.f, 0.f, 0.f, 0.f, 0.f, 0.f, 0.f, 0.f};
#pragma unroll
            for (int kt = 0; kt < 4; ++kt) acc[kt] = z16;
#pragma unroll
            for (int s4 = 0; s4 < 4; ++s4) {
                bf16x8 bfr = *(const bf16x8*)(pq + (size_t)(t0 + r) * 1024 + hp * 64 + 16 * s4 + 8 * hh);
#pragma unroll
                for (int kt = 0; kt < 4; ++kt) {
                    bf16x8 af = *(const bf16x8*)(skb + ((size_t)hp * 128 + 32 * kt + r) * 64 + 16 * s4 + 8 * hh);
                    acc[kt] = __builtin_amdgcn_mfma_f32_32x32x16_bf16(af, bfr, acc[kt], 0, 0, 0);
                }
            }
            int K0[16], K1[16], K2[16], K3[16];
#pragma unroll
            for (int rr = 0; rr < 16; ++rr) {
                const int nb = (rr & 3) + 8 * (rr >> 2) + 4 * hh;
                K0[rr] = f2key(acc[0][rr], 127 - nb, 127);
                K1[rr] = f2key(acc[1][rr], 127 - (32 + nb), 127);
                K2[rr] = f2key(acc[2][rr], 127 - (64 + nb), 127);
                K3[rr] = f2key(acc[3][rr], 127 - (96 + nb), 127);
            }
            bitonic_sort16(K0); bitonic_sort16(K1); bitonic_sort16(K2); bitonic_sort16(K3);
            merge_top16(K0, K1);
            merge_top16(K2, K3);
            merge_top16(K0, K2);
#pragma unroll
            for (int i = 0; i < 16; ++i) K1[i] = partner32(K0[i], hh);
            merge_top16(K0, K1);
#pragma unroll
            for (int i = 0; i < 16; ++i) F[p][i] = K0[i];
        }
        if (hh == 0) {
#pragma unroll
            for (int q = 0; q < 4; ++q) {
                unsigned w1 = 0, w2 = 0;
#pragma unroll
                for (int e = 0; e < 4; ++e) {
                    w1 |= (unsigned)(127 - (F[0][4 * q + e] & 127)) << (8 * e);
                    w2 |= (unsigned)(127 - (F[1][4 * q + e] & 127)) << (8 * e);
                }
                ((unsigned*)lidx)[q] = w1;
                ((unsigned*)lidx)[4 + q] = w2;
            }
        }
        {
            float s1[16], s2[16];
#pragma unroll
            for (int i = 0; i < 16; ++i) { s1[i] = key2f(F[0][i], 127); s2[i] = key2f(F[1][i], 127); }
            int Lc[16], X[16];
#pragma unroll
            for (int b2 = 0; b2 < 16; ++b2) Lc[b2] = f2key(s1[0] + s2[b2], 255 - b2, 255);
#pragma unroll
            for (int a2 = 1; a2 < 16; ++a2) X[a2 - 1] = f2key(s1[a2] + s2[0], 255 - a2 * 16, 255);
            X[15] = INT_MIN;
            merge_top16(Lc, X);
            X[0] = f2key(s1[1] + s2[1], 255 - 17, 255); X[1] = f2key(s1[1] + s2[2], 255 - 18, 255); X[2] = f2key(s1[1] + s2[3], 255 - 19, 255);
            X[3] = f2key(s1[1] + s2[4], 255 - 20, 255); X[4] = f2key(s1[1] + s2[5], 255 - 21, 255); X[5] = f2key(s1[1] + s2[6], 255 - 22, 255);
            X[6] = f2key(s1[1] + s2[7], 255 - 23, 255);
            X[7] = f2key(s1[2] + s2[1], 255 - 33, 255); X[8] = f2key(s1[2] + s2[2], 255 - 34, 255); X[9] = f2key(s1[2] + s2[3], 255 - 35, 255);
            X[10] = f2key(s1[2] + s2[4], 255 - 36, 255);
            X[11] = f2key(s1[3] + s2[1], 255 - 49, 255); X[12] = f2key(s1[3] + s2[2], 255 - 50, 255); X[13] = f2key(s1[3] + s2[3], 255 - 51, 255);
            X[14] = f2key(s1[4] + s2[1], 255 - 65, 255); X[15] = f2key(s1[4] + s2[2], 255 - 66, 255);
            bitonic_sort16(X);
            merge_top16(Lc, X);
            X[0] = f2key(s1[5] + s2[1], 255 - 81, 255);
            X[1] = f2key(s1[6] + s2[1], 255 - 97, 255);
            X[2] = f2key(s1[7] + s2[1], 255 - 113, 255);
#pragma unroll
            for (int i = 3; i < 16; ++i) X[i] = INT_MIN;
            merge_top16(Lc, X);
            if (hh == 0) {
                float mx = key2f(Lc[0], 255);
                float ev[16], sum = 0.f;
#pragma unroll
                for (int k = 0; k < 16; ++k) { ev[k] = __expf(key2f(Lc[k], 255) - mx); sum += ev[k]; }
                float inv = 1.f / sum;
                size_t ob = (size_t)(t0 + r) * 128 + h * 16;
                unsigned idw[8];
#pragma unroll
                for (int k = 0; k < 16; ++k) {
                    int cidx = 255 - (Lc[k] & 255);
                    int i1 = lidx[cidx >> 4], i2 = lidx[16 + (cidx & 15)];
                    unsigned idv = (unsigned)(i1 * 128 + i2);
                    if (k & 1) idw[k >> 1] |= idv << 16; else idw[k >> 1] = idv;
                }
                u32x4 o0 = {idw[0], idw[1], idw[2], idw[3]}, o1 = {idw[4], idw[5], idw[6], idw[7]};
                *(u32x4*)(ids + ob) = o0;
                *(u32x4*)(ids + ob + 8) = o1;
#pragma unroll
                for (int q = 0; q < 4; ++q) {
                    f32x4 g4 = {ev[4 * q] * inv, ev[4 * q + 1] * inv, ev[4 * q + 2] * inv, ev[4 * q + 3] * inv};
                    *(f32x4*)(gates + ob + 4 * q) = g4;
                }
            }
        }
    }
}
__device__ __forceinline__ void phase_topk(const Params& P, int L) {
    const int w = opaque_tid() >> 6;
    for (int task = blockIdx.x * NW + w; task < (TOK / 32) * 8; task += gridDim.x * NW) topk_task(P, L, (task >> 3) * 32, task & 7);
}

__device__ __forceinline__ float gelu_exact(float x) { return 0.5f * x * (1.f + erff(x * 0.70710678118654752f)); }

__device__ __forceinline__ void dec16(const u32x4& v, float (&f)[16]) {
    f32x2 t;
    t = __builtin_amdgcn_cvt_pk_f32_fp8((int)v.x, false); f[0] = t.x; f[1] = t.y;
    t = __builtin_amdgcn_cvt_pk_f32_fp8((int)v.x, true);  f[2] = t.x; f[3] = t.y;
    t = __builtin_amdgcn_cvt_pk_f32_fp8((int)v.y, false); f[4] = t.x; f[5] = t.y;
    t = __builtin_amdgcn_cvt_pk_f32_fp8((int)v.y, true);  f[6] = t.x; f[7] = t.y;
    t = __builtin_amdgcn_cvt_pk_f32_fp8((int)v.z, false); f[8] = t.x; f[9] = t.y;
    t = __builtin_amdgcn_cvt_pk_f32_fp8((int)v.z, true);  f[10] = t.x; f[11] = t.y;
    t = __builtin_amdgcn_cvt_pk_f32_fp8((int)v.w, false); f[12] = t.x; f[13] = t.y;
    t = __builtin_amdgcn_cvt_pk_f32_fp8((int)v.w, true);  f[14] = t.x; f[15] = t.y;
}

__device__ __forceinline__ void dec32(const u32x4& v, f32x2 (&f)[16]) {
    f[0] = __builtin_amdgcn_cvt_scalef32_pk_f32_fp4(v.x, 1.0f, 0); f[1] = __builtin_amdgcn_cvt_scalef32_pk_f32_fp4(v.x, 1.0f, 1);
    f[2] = __builtin_amdgcn_cvt_scalef32_pk_f32_fp4(v.x, 1.0f, 2); f[3] = __builtin_amdgcn_cvt_scalef32_pk_f32_fp4(v.x, 1.0f, 3);
    f[4] = __builtin_amdgcn_cvt_scalef32_pk_f32_fp4(v.y, 1.0f, 0); f[5] = __builtin_amdgcn_cvt_scalef32_pk_f32_fp4(v.y, 1.0f, 1);
    f[6] = __builtin_amdgcn_cvt_scalef32_pk_f32_fp4(v.y, 1.0f, 2); f[7] = __builtin_amdgcn_cvt_scalef32_pk_f32_fp4(v.y, 1.0f, 3);
    f[8] = __builtin_amdgcn_cvt_scalef32_pk_f32_fp4(v.z, 1.0f, 0); f[9] = __builtin_amdgcn_cvt_scalef32_pk_f32_fp4(v.z, 1.0f, 1);
    f[10] = __builtin_amdgcn_cvt_scalef32_pk_f32_fp4(v.z, 1.0f, 2); f[11] = __builtin_amdgcn_cvt_scalef32_pk_f32_fp4(v.z, 1.0f, 3);
    f[12] = __builtin_amdgcn_cvt_scalef32_pk_f32_fp4(v.w, 1.0f, 0); f[13] = __builtin_amdgcn_cvt_scalef32_pk_f32_fp4(v.w, 1.0f, 1);
    f[14] = __builtin_amdgcn_cvt_scalef32_pk_f32_fp4(v.w, 1.0f, 2); f[15] = __builtin_amdgcn_cvt_scalef32_pk_f32_fp4(v.w, 1.0f, 3);
}

typedef _Float16 f16x2 __attribute__((ext_vector_type(2)));
__device__ __forceinline__ void dec8_f16(unsigned x, f16x2 (&wv)[4]) {
    const unsigned lo = x & 0x07070707u, hi = (x >> 4) & 0x07070707u;
    const unsigned Lb = __builtin_amdgcn_perm(0x46444240u, 0x3E3C3800u, lo) | ((x & 0x08080808u) << 4);
    const unsigned Hb = __builtin_amdgcn_perm(0x46444240u, 0x3E3C3800u, hi) | (x & 0x80808080u);
    wv[0] = __builtin_bit_cast(f16x2, __builtin_amdgcn_perm(Hb, Lb, 0x040c000cu));
    wv[1] = __builtin_bit_cast(f16x2, __builtin_amdgcn_perm(Hb, Lb, 0x050c010cu));
    wv[2] = __builtin_bit_cast(f16x2, __builtin_amdgcn_perm(Hb, Lb, 0x060c020cu));
    wv[3] = __builtin_bit_cast(f16x2, __builtin_amdgcn_perm(Hb, Lb, 0x070c030cu));
}

typedef _Float16 f16x2 __attribute__((ext_vector_type(2)));
__device__ __forceinline__ void dec32h(const u32x4& v, f16x2 (&f)[16]) {
    f[0] = __builtin_amdgcn_cvt_scalef32_pk_f16_fp4(v.x, 1.0f, 0); f[1] = __builtin_amdgcn_cvt_scalef32_pk_f16_fp4(v.x, 1.0f, 1);
    f[2] = __builtin_amdgcn_cvt_scalef32_pk_f16_fp4(v.x, 1.0f, 2); f[3] = __builtin_amdgcn_cvt_scalef32_pk_f16_fp4(v.x, 1.0f, 3);
    f[4] = __builtin_amdgcn_cvt_scalef32_pk_f16_fp4(v.y, 1.0f, 0); f[5] = __builtin_amdgcn_cvt_scalef32_pk_f16_fp4(v.y, 1.0f, 1);
    f[6] = __builtin_amdgcn_cvt_scalef32_pk_f16_fp4(v.y, 1.0f, 2); f[7] = __builtin_amdgcn_cvt_scalef32_pk_f16_fp4(v.y, 1.0f, 3);
    f[8] = __builtin_amdgcn_cvt_scalef32_pk_f16_fp4(v.z, 1.0f, 0); f[9] = __builtin_amdgcn_cvt_scalef32_pk_f16_fp4(v.z, 1.0f, 1);
    f[10] = __builtin_amdgcn_cvt_scalef32_pk_f16_fp4(v.z, 1.0f, 2); f[11] = __builtin_amdgcn_cvt_scalef32_pk_f16_fp4(v.z, 1.0f, 3);
    f[12] = __builtin_amdgcn_cvt_scalef32_pk_f16_fp4(v.w, 1.0f, 0); f[13] = __builtin_amdgcn_cvt_scalef32_pk_f16_fp4(v.w, 1.0f, 1);
    f[14] = __builtin_amdgcn_cvt_scalef32_pk_f16_fp4(v.w, 1.0f, 2); f[15] = __builtin_amdgcn_cvt_scalef32_pk_f16_fp4(v.w, 1.0f, 3);
}

__device__ __forceinline__ int idof16(const u32x4 (&q)[2], int i) {
    unsigned wv = (i >> 1) == 0 ? q[0].x : (i >> 1) == 1 ? q[0].y : (i >> 1) == 2 ? q[0].z : (i >> 1) == 3 ? q[0].w
                : (i >> 1) == 4 ? q[1].x : (i >> 1) == 5 ? q[1].y : (i >> 1) == 6 ? q[1].z : q[1].w;
    return (i & 1) ? (int)(wv >> 16) : (int)(wv & 0xffffu);
}
typedef int i32x8 __attribute__((ext_vector_type(8)));
#define GU_WAIT_V(n) asm volatile("s_waitcnt vmcnt(" #n ")" ::: "memory")
#define GU_WAIT_L0() asm volatile("s_waitcnt lgkmcnt(0)" ::: "memory")
__device__ __forceinline__ void phase_gather_u(const Params& P, int L) {
    char* ws = opq(P.ws);
    const unsigned char* U4 = (const unsigned char*)(ws + OFF_UB) + (size_t)L * NEXP * 512;
    float* part = (float*)(ws + OFF_PART);
    const unsigned short* ids = (const unsigned short*)(ws + OFF_IDS);
    const int tid = opaque_tid(), w = tid >> 6, l = tid & 63, i = l & 15, g4 = l >> 4, rr = l >> 3, dc = (l & 7) ^ rr;
    const int sl = blockIdx.x & 3, par = (blockIdx.x >> 2) & 1, rk = blockIdx.x >> 3, nb = gridDim.x >> 3;
    if (rk >= nb) return;
    PG8_LAS unsigned char* wl = (PG8_LAS unsigned char*)smem + w * 16384;
    const unsigned char* ubase = U4 + (size_t)sl * NEXP * 128 + dc * 16;
    const unsigned char* xbase = (const unsigned char*)(ws + OFF_XH) + (i == 1 ? 16 * MBy : 0) + 256 * sl + 16 * g4;
    const int scb = (i == 1) ? 123 : 127;
    const unsigned a0 = 1024u * (i >> 3) + 128u * (i & 7) + 16u * (g4 ^ (i & 7)), a1 = a0 ^ 64u;
    const int stride = nb * NW;
    int ti = rk * NW + w;
    if (ti >= TOK / 2) return;
    u32x4 idA[2], idB[2];
    u32x4 xA[4], xB[4];
    auto load_ids = [&](int tt, u32x4 (&idq)[2]) {
        const unsigned short* ip = ids + (size_t)tt * 128 + 16 * rr;
        asm volatile("global_load_dwordx4 %0, %2, off\n\tglobal_load_dwordx4 %1, %2, off offset:16" : "=&v"(idq[0]), "=&v"(idq[1]) : "v"(ip));
    };
    auto load_x = [&](int tt, u32x4 (&xx)[4]) {
        const unsigned char* p = xbase + (size_t)tt * 1024;
        asm volatile("global_load_dwordx4 %0, %4, off\n\tglobal_load_dwordx4 %1, %4, off offset:64\n\t"
                     "global_load_dwordx4 %2, %4, off offset:128\n\tglobal_load_dwordx4 %3, %4, off offset:192"
                     : "=&v"(xx[0]), "=&v"(xx[1]), "=&v"(xx[2]), "=&v"(xx[3]) : "v"(p));
    };
    auto pin = [&](u32x4 (&idq)[2], u32x4 (&xx)[4]) {
        asm volatile("" : "+v"(idq[0]), "+v"(idq[1]), "+v"(xx[0]), "+v"(xx[1]), "+v"(xx[2]), "+v"(xx[3]));
    };
    auto dma_half = [&](const u32x4 (&idq)[2], int h) {
#pragma unroll
        for (int jj = 0; jj < 8; ++jj) {
            const int j = 8 * h + jj;
            __builtin_amdgcn_global_load_lds((const unsigned*)(ubase + (size_t)idof16(idq, j) * 128), (PG8_LAS unsigned*)(wl + 1024 * j), 16, 0, 0);
        }
    };
    const unsigned la0 = (unsigned)(size_t)wl + a0, la1 = (unsigned)(size_t)wl + a1;
    auto mma_half = [&](f32x4 (&acc)[8], const u32x4 (&xc)[4], int h) {
        u32x4 av[8];
        if (h == 0)
            asm volatile("ds_read_b128 %0, %8\n\tds_read_b128 %1, %9\n\tds_read_b128 %2, %8 offset:2048\n\tds_read_b128 %3, %9 offset:2048\n\t"
                         "ds_read_b128 %4, %8 offset:4096\n\tds_read_b128 %5, %9 offset:4096\n\tds_read_b128 %6, %8 offset:6144\n\tds_read_b128 %7, %9 offset:6144\n\t"
                         "s_waitcnt lgkmcnt(0)"
                         : "=&v"(av[0]), "=&v"(av[1]), "=&v"(av[2]), "=&v"(av[3]), "=&v"(av[4]), "=&v"(av[5]), "=&v"(av[6]), "=&v"(av[7]) : "v"(la0), "v"(la1));
        else
            asm volatile("ds_read_b128 %0, %8 offset:8192\n\tds_read_b128 %1, %9 offset:8192\n\tds_read_b128 %2, %8 offset:10240\n\tds_read_b128 %3, %9 offset:10240\n\t"
                         "ds_read_b128 %4, %8 offset:12288\n\tds_read_b128 %5, %9 offset:12288\n\tds_read_b128 %6, %8 offset:14336\n\tds_read_b128 %7, %9 offset:14336\n\t"
                         "s_waitcnt lgkmcnt(0)"
                         : "=&v"(av[0]), "=&v"(av[1]), "=&v"(av[2]), "=&v"(av[3]), "=&v"(av[4]), "=&v"(av[5]), "=&v"(av[6]), "=&v"(av[7]) : "v"(la0), "v"(la1));
#pragma unroll
        for (int qq = 0; qq < 4; ++qq) {
#pragma unroll
            for (int hf = 0; hf < 2; ++hf) {
                const u32x4 a = av[2 * qq + hf];
                const i32x8 A = {(int)a.x, (int)a.y, (int)a.z, (int)a.w, 0, 0, 0, 0};
                const u32x4 b0 = xc[2 * hf], b1 = xc[2 * hf + 1];
                const i32x8 B = {(int)b0.x, (int)b0.y, (int)b0.z, (int)b0.w, (int)b1.x, (int)b1.y, (int)b1.z, (int)b1.w};
                f32x4 c = {0.f, 0.f, 0.f, 0.f};
                if (hf) c = acc[4 * h + qq];
                acc[4 * h + qq] = __builtin_amdgcn_mfma_scale_f32_16x16x128_f8f6f4(A, B, c, 4, 0, 0, 127, 0, scb);
            }
        }
    };
    auto step = [&](int tcur, int tnext, int tnext2, u32x4 (&idn)[2], u32x4 (&idl)[2], u32x4 (&xc)[4], u32x4 (&xn)[4]) {
        f32x4 acc[8];
        __builtin_amdgcn_sched_barrier(0);
        GU_WAIT_V(8);
        pin(idn, xc);
        __builtin_amdgcn_sched_barrier(0);
        mma_half(acc, xc, 0);
        __builtin_amdgcn_sched_barrier(0);
        dma_half(idn, 0);
        __builtin_amdgcn_sched_barrier(0);
        load_ids(tnext2, idl);
        load_x(tnext, xn);
        __builtin_amdgcn_sched_barrier(0);
        GU_WAIT_V(14);
        __builtin_amdgcn_sched_barrier(0);
        mma_half(acc, xc, 1);
        __builtin_amdgcn_sched_barrier(0);
#pragma unroll
        for (int q = 0; q < 8; ++q)
#pragma unroll
            for (int r = 0; r < 4; ++r) acc[q][r] = dpp_add<0xB1>(acc[q][r]);
        if (i == 0) {
            float* o = part + ((size_t)sl * TOK + tcur) * 128 + 32 * g4;
#pragma unroll
            for (int r = 0; r < 4; ++r)
#pragma unroll
                for (int gh = 0; gh < 2; ++gh) {
                    f32x4 ov = {acc[4 * gh][r], acc[4 * gh + 1][r], acc[4 * gh + 2][r], acc[4 * gh + 3][r]};
                    asm volatile("global_store_dwordx4 %0, %1, off offset:%2" :: "v"(o), "v"(ov), "n"(32 * r + 16 * gh) : "memory");
                }
        }
        __builtin_amdgcn_sched_barrier(0);
        dma_half(idn, 1);
        __builtin_amdgcn_sched_barrier(0);
    };
    auto tok = [&](int tidx, int fb) { return 2 * (tidx < TOK / 2 ? tidx : fb) + par; };
    load_ids(tok(ti, ti), idA);
    __builtin_amdgcn_sched_barrier(0);
    GU_WAIT_V(0);
    asm volatile("" : "+v"(idA[0]), "+v"(idA[1]));
    __builtin_amdgcn_sched_barrier(0);
    dma_half(idA, 0);
    __builtin_amdgcn_sched_barrier(0);
    load_ids(tok(ti + stride, ti), idB);
    load_x(tok(ti, ti), xA);
    __builtin_amdgcn_sched_barrier(0);
    dma_half(idA, 1);
    __builtin_amdgcn_sched_barrier(0);
    for (;;) {
        int tn = ti + stride, tn2 = ti + 2 * stride;
        step(tok(ti, ti), tok(tn, ti), tok(tn2, ti), idB, idA, xA, xB);
        if (tn >= TOK / 2) break;
        ti = tn; tn = ti + stride; tn2 = ti + 2 * stride;
        step(tok(ti, ti), tok(tn, ti), tok(tn2, ti), idA, idB, xB, xA);
        if (tn >= TOK / 2) break;
        ti = tn;
    }
    GU_WAIT_V(0);
    asm volatile("" :: "v"(idA[0]), "v"(idA[1]), "v"(idB[0]), "v"(idB[1]), "v"(xA[0]), "v"(xA[1]), "v"(xA[2]), "v"(xA[3]), "v"(xB[0]), "v"(xB[1]), "v"(xB[2]), "v"(xB[3]));
}

__device__ __forceinline__ void phase_gather_act(const Params& P, int L, int ss_slot, int fake = 0) {
    char* ws = opq(P.ws);
    const float* ss_ffn = (const float*)(ws + OFF_SSA) + (size_t)ss_slot * TOK * 8;
    const float* part = (const float*)(ws + OFF_PART);
    const unsigned short* ids = (const unsigned short*)(ws + OFF_IDS);
    const float* gates = (const float*)(ws + OFF_GATE);
    const float* uinv = (const float*)(ws + OFF_TSC) + L * NEXP;
    const float* vinv = (const float*)(ws + OFF_TSC) + (2 + L) * NEXP;
    const int tid = opaque_tid(), w = tid >> 6, l = tid & 63;
    const int stride = gridDim.x * NW;
    for (int t0 = blockIdx.x * NW + w; t0 < TOK; t0 += 4 * stride) {
        f32x2 pa[4][4], gt[4];
        unsigned idw[4];
        f32x4 s0[4], s1[4];
#pragma unroll
        for (int q = 0; q < 4; ++q) {
            const int t = (t0 + q * stride < TOK) ? (t0 + q * stride) : t0;
#pragma unroll
            for (int j = 0; j < 4; ++j) { pa[q][j].x = part[((size_t)j * TOK + t) * 128 + l]; pa[q][j].y = part[((size_t)j * TOK + t) * 128 + 64 + l]; }
            idw[q] = *(const unsigned*)(ids + (size_t)t * 128 + 2 * l);
            gt[q] = *(const f32x2*)(gates + (size_t)t * 128 + 2 * l);
            s0[q] = *(const f32x4*)(ss_ffn + (size_t)t * 8); s1[q] = *(const f32x4*)(ss_ffn + (size_t)t * 8 + 4);
        }
        float ui[4][2], vi[4][2];
#pragma unroll
        for (int q = 0; q < 4; ++q) {
            const int i0 = (int)(idw[q] & 0xffffu), i1 = (int)(idw[q] >> 16);
            ui[q][0] = uinv[i0]; ui[q][1] = uinv[i1]; vi[q][0] = vinv[i0]; vi[q][1] = vinv[i1];
        }
#pragma unroll
        for (int q = 0; q < 4; ++q) {
            const int t = t0 + q * stride;
            if (t < TOK) {
                const float ssum = ((s0[q].x + s0[q].y) + (s0[q].z + s0[q].w)) + ((s1[q].x + s1[q].y) + (s1[q].z + s1[q].w));
                const float rs = rsqrtf(ssum * (1.f / 1024.f) + EPSF);
                f32x2 sa = (pa[q][0] + pa[q][1]) + (pa[q][2] + pa[q][3]);
                f32x2 o;
                o.x = gt[q].x * gelu_exact(sa.x * rs * ui[q][0]) * vi[q][0];
                o.y = gt[q].y * gelu_exact(sa.y * rs * ui[q][1]) * vi[q][1];
                float am = fmaxf(fabsf(o.x), fabsf(o.y));
#pragma unroll
                for (int sh = 32; sh > 0; sh >>= 1) am = fmaxf(am, __shfl_xor(am, sh));
                int ex = (int)((__builtin_bit_cast(unsigned, am) >> 23) & 0xffu) - 127;
                int e = 7 - ex; e = e > 100 ? 100 : (e < -100 ? -100 : e);
                if (!(am > 0.f)) e = 0;
                const float sc2 = __builtin_bit_cast(float, (unsigned)(127 + e) << 23);
                const float s0 = __builtin_amdgcn_fmed3f(o.x * sc2, -448.f, 448.f), s1 = __builtin_amdgcn_fmed3f(o.y * sc2, -448.f, 448.f);
                const int h8 = __builtin_amdgcn_cvt_pk_fp8_f32(s0, s1, 0, false);
                const f32x2 hb2 = __builtin_amdgcn_cvt_pk_f32_fp8(h8, false);
                const int l8 = __builtin_amdgcn_cvt_pk_fp8_f32((s0 - hb2.x) * 16.f, (s1 - hb2.y) * 16.f, 0, false);
                unsigned char* a8 = (unsigned char*)(ws + (fake ? OFF_Y : OFF_A8)) + (size_t)t * 128 + 16 * (l & 7) + (l >> 3);
                a8[0] = (unsigned char)(h8 & 0xff); a8[8] = (unsigned char)((h8 >> 8) & 0xff);
                a8[2 * MBy] = (unsigned char)(l8 & 0xff); a8[2 * MBy + 8] = (unsigned char)((l8 >> 8) & 0xff);
                if (l == 0) ((int*)(ws + (fake ? OFF_Y : OFF_A8) + 4 * MBy))[t] = e;
            }
        }
    }
}

__device__ __forceinline__ void phase_gather_v(const Params& P, int L, int hsel, int ss_slot, int fake = 0) {
    char* ws = opq(P.ws);
    float* ss_ple = fake ? (float*)(ws + OFF_FQ) : (float*)(ws + OFF_SSA) + (size_t)ss_slot * TOK * 8;
    bf16* hb_out = fake ? (bf16*)(ws + OFF_PART) : (bf16*)(ws + (hsel ? OFF_HB1 : OFF_HB0));
    const bf16* hbin = (const bf16*)(ws + (hsel ? OFF_HB0 : OFF_HB1));
    const unsigned char* V4 = (const unsigned char*)(ws + OFF_VB) + (size_t)L * NEXP * 512;
    const unsigned short* ids = (const unsigned short*)(ws + OFF_IDS);
    const int tid = opaque_tid(), w = tid >> 6, l = tid & 63, i = l & 15, g4 = l >> 4, rr = l >> 3;
    const int sl = blockIdx.x & 3, par = (blockIdx.x >> 2) & 1, rk = blockIdx.x >> 3, nb = gridDim.x >> 3;
    if (rk >= nb) return;
    PG8_LAS unsigned char* wl = (PG8_LAS unsigned char*)smem + w * 16384;
    PG8_LAS unsigned char* wo = (PG8_LAS unsigned char*)smem + 8 * 16384 + w * 1024;
    const int dc0 = (l & 7) ^ (rr >> 1);
    const unsigned char* vbase0 = V4 + (size_t)sl * NEXP * 128 + dc0 * 16;
    const unsigned char* vbase1 = V4 + (size_t)sl * NEXP * 128 + (dc0 ^ 4) * 16;
    const unsigned char* abase = (const unsigned char*)(ws + OFF_A8) + ((i & 3) == 1 ? 2 * MBy : 0) + 16 * g4;
    const int* ebase = (const int*)(ws + OFF_A8 + 4 * MBy);
    const unsigned kb = 16u * (unsigned)((i >> 1) ^ (4 * (g4 & 1)));
    const unsigned rbase = (unsigned)(size_t)wl + 128u * (unsigned)(32 * g4 + i);
    const unsigned wob = (unsigned)(size_t)wo;
    const int stride = nb * NW;
    int ti = rk * NW + w;
    if (ti >= TOK / 2) return;
    u32x4 idA[2], idB[2];
    u32x4 aA[2], aB[2];
    int eA, eB;
    u32x2 hA, hB;
    auto load_ids = [&](int tt, u32x4 (&idq)[2]) {
        const unsigned short* ip = ids + (size_t)tt * 128 + 16 * rr;
        asm volatile("global_load_dwordx4 %0, %2, off\n\tglobal_load_dwordx4 %1, %2, off offset:16" : "=&v"(idq[0]), "=&v"(idq[1]) : "v"(ip));
    };
    auto load_tok = [&](int tt, u32x4 (&ax)[2], int& ex, u32x2& hx) {
        const unsigned char* ap = abase + (size_t)tt * 128;
        const int* ep = ebase + tt;
        const bf16* hp = hbin + (size_t)tt * LDH + 256 * sl + 4 * l;
        asm volatile("global_load_dwordx4 %0, %4, off\n\tglobal_load_dwordx4 %1, %4, off offset:64\n\tglobal_load_dword %2, %5, off\n\tglobal_load_dwordx2 %3, %6, off"
                     : "=&v"(ax[0]), "=&v"(ax[1]), "=&v"(ex), "=&v"(hx) : "v"(ap), "v"(ep), "v"(hp));
    };
    auto dma_all = [&](const u32x4 (&idq)[2]) {
#pragma unroll
        for (int j = 0; j < 16; ++j) {
            const unsigned char* vb = (((j ^ (j >> 2)) & 1) ? vbase1 : vbase0);
            __builtin_amdgcn_global_load_lds((const unsigned*)(vb + (size_t)idof16(idq, j) * 128), (PG8_LAS unsigned*)(wl + 1024 * j), 16, 0, 0);
        }
    };
    u32x2 pend_h = {0u, 0u}; float pend_ss = 0.f; int pend_t = -1;
    auto step = [&](int tcur, int tnext, int tnext2, u32x4 (&idn)[2], u32x4 (&idl)[2], u32x4 (&ac)[2], int& ec, u32x2& hc, u32x4 (&an)[2], int& en, u32x2& hn) {
        __builtin_amdgcn_sched_barrier(0);
        GU_WAIT_V(0);
        asm volatile("" : "+v"(idn[0]), "+v"(idn[1]), "+v"(ac[0]), "+v"(ac[1]), "+v"(ec), "+v"(hc));
        __builtin_amdgcn_sched_barrier(0);
        u32x2 bq[16][2];
#pragma unroll
        for (int c = 0; c < 8; ++c) {
            const unsigned ad = rbase + ((16u * c) ^ kb);
            asm volatile("ds_read_b64_tr_b4 %0, %4\n\tds_read_b64_tr_b4 %1, %4 offset:2048\n\tds_read_b64_tr_b4 %2, %4 offset:8\n\tds_read_b64_tr_b4 %3, %4 offset:2056"
                         : "=&v"(bq[2 * c][0]), "=&v"(bq[2 * c][1]), "=&v"(bq[2 * c + 1][0]), "=&v"(bq[2 * c + 1][1]) : "v"(ad));
        }
        asm volatile("s_waitcnt lgkmcnt(0)" ::: "memory");
#pragma unroll
        for (int c = 0; c < 16; ++c) asm volatile("" : "+v"(bq[c][0]), "+v"(bq[c][1]));
        __builtin_amdgcn_sched_barrier(0);
        if (pend_t >= 0) {
            bf16* op = hb_out + (size_t)pend_t * LDH + 256 * sl + 4 * l;
            asm volatile("global_store_dwordx2 %0, %1, off" :: "v"(op), "v"(pend_h) : "memory");
            if (l == 0) {
                float* sp = ss_ple + (size_t)pend_t * 8 + sl;
                const float zf = 0.f;
                asm volatile("global_store_dword %0, %1, off\n\tglobal_store_dword %0, %2, off offset:16" :: "v"(sp), "v"(pend_ss), "v"(zf) : "memory");
            }
        }
        __builtin_amdgcn_sched_barrier(0);
        dma_all(idn);
        __builtin_amdgcn_sched_barrier(0);
        load_ids(tnext2, idl);
        load_tok(tnext, an, en, hn);
        __builtin_amdgcn_sched_barrier(0);
        const int sca = 127 - ec - (((i & 3) == 1) ? 4 : 0);
        const i32x8 A = {(int)ac[0].x, (int)ac[0].y, (int)ac[0].z, (int)ac[0].w, (int)ac[1].x, (int)ac[1].y, (int)ac[1].z, (int)ac[1].w};
        f32x4 acc[16];
#pragma unroll
        for (int cb = 0; cb < 16; ++cb) {
            const i32x8 B = {(int)bq[cb][0].x, (int)bq[cb][0].y, (int)bq[cb][1].x, (int)bq[cb][1].y, 0, 0, 0, 0};
            const f32x4 z = {0.f, 0.f, 0.f, 0.f};
            acc[cb] = __builtin_amdgcn_mfma_scale_f32_16x16x128_f8f6f4(A, B, z, 0, 4, 0, sca, 0, 127);
        }
#pragma unroll
        for (int q = 0; q < 4; ++q) {
            float v = 0.f;
#pragma unroll
            for (int g = 0; g < 4; ++g) { const float t2 = acc[4 * g + q][0] + acc[4 * g + q][1]; v = (g4 == g) ? t2 : v; }
            const unsigned wa = wob + 4u * (unsigned)(64 * g4 + 16 * q + i);
            asm volatile("ds_write_b32 %0, %1" :: "v"(wa), "v"(v) : "memory");
        }
        f32x4 ov;
        {
            const unsigned ra = wob + 16u * (unsigned)l;
            asm volatile("s_waitcnt lgkmcnt(0)\n\tds_read_b128 %0, %1\n\ts_waitcnt lgkmcnt(0)" : "=&v"(ov) : "v"(ra) : "memory");
        }
        f32x4 hv = {bflo(hc.x) + ov[0], bfhi(hc.x) + ov[1], bflo(hc.y) + ov[2], bfhi(hc.y) + ov[3]};
        pend_h.x = pack2(hv.x, hv.y); pend_h.y = pack2(hv.z, hv.w);
        float ssq = hv.x * hv.x + hv.y * hv.y + hv.z * hv.z + hv.w * hv.w;
        pend_ss = wave_sum(ssq);
        pend_t = tcur;
        __builtin_amdgcn_sched_barrier(0);
    };
    auto tok = [&](int tidx, int fb) { return 2 * (tidx < TOK / 2 ? tidx : fb) + par; };
    load_ids(tok(ti, ti), idA);
    __builtin_amdgcn_sched_barrier(0);
    GU_WAIT_V(0);
    asm volatile("" : "+v"(idA[0]), "+v"(idA[1]));
    __builtin_amdgcn_sched_barrier(0);
    dma_all(idA);
    __builtin_amdgcn_sched_barrier(0);
    load_ids(tok(ti + stride, ti), idB);
    load_tok(tok(ti, ti), aA, eA, hA);
    __builtin_amdgcn_sched_barrier(0);
    for (;;) {
        int tn = ti + stride, tn2 = ti + 2 * stride;
        step(tok(ti, ti), tok(tn, ti), tok(tn2, ti), idB, idA, aA, eA, hA, aB, eB, hB);
        if (tn >= TOK / 2) break;
        ti = tn; tn = ti + stride; tn2 = ti + 2 * stride;
        step(tok(ti, ti), tok(tn, ti), tok(tn2, ti), idA, idB, aB, eB, hB, aA, eA, hA);
        if (tn >= TOK / 2) break;
        ti = tn;
    }
    asm volatile("s_waitcnt vmcnt(0)" : "+v"(pend_t), "+v"(pend_h), "+v"(pend_ss) :: "memory");
    asm volatile("" :: "v"(idA[0]), "v"(idA[1]), "v"(idB[0]), "v"(idB[1]), "v"(aA[0]), "v"(aA[1]), "v"(aB[0]), "v"(aB[1]), "v"(eA), "v"(eB), "v"(hA), "v"(hB));
    {
        bf16* op = hb_out + (size_t)pend_t * LDH + 256 * sl + 4 * l;
        *(u32x2*)op = pend_h;
        if (l == 0) { ss_ple[(size_t)pend_t * 8 + sl] = pend_ss; ss_ple[(size_t)pend_t * 8 + 4 + sl] = 0.f; }
    }
}

struct EpiStoreBf16 {
    static constexpr bool PERM = true, AFTER_DRAIN = false;
    bf16* O;
    __device__ __forceinline__ void khook(int, f32x4 (&)[2][2][4][2], int, int) const {}
    __device__ __forceinline__ void operator()(const f32x4 (&acc)[2][2][4][2], const pg8::Unit& u, int wr, int wc, int fr, int fqd) const {
        const int row0 = u.pm * 256 + wr * 64 + fr, col0 = u.pn * 256 + wc * 32 + 8 * fqd;
#pragma unroll
        for (int ai = 0; ai < 2; ++ai)
#pragma unroll
            for (int m = 0; m < 4; ++m) {
                bf16* rowp = O + (size_t)(row0 + ai * 128 + m * 16) * 1024 + col0;
#pragma unroll
                for (int bj = 0; bj < 2; ++bj) {
                    const f32x4 v0 = acc[ai][bj][m][0], v1 = acc[ai][bj][m][1];
                    u32x4 wv = {pack2(v0[0], v0[1]), pack2(v0[2], v0[3]), pack2(v1[0], v1[1]), pack2(v1[2], v1[3])};
                    *(u32x4*)(rowp + bj * 128) = wv;
                }
            }
    }
};
__device__ __forceinline__ void phase_pw(const Params& P) {
    char* ws = opq(P.ws);
    pg8::StaticOrder S; S.init(TOK, 1024, gridDim.x, blockIdx.x);
    for (int L = 0; L < 2; ++L) {
        pg8::Gemm g{(const bf16*)(ws + OFF_PB) + (size_t)L * TOK * LDP, (const bf16*)(ws + OFF_WP) + (size_t)L * 1024 * LDP, LDP, LDP, TOK, 1024, 256};
        EpiStoreBf16 E{(bf16*)(ws + (L ? OFF_PW1 : OFF_PW0))};
        pg8::gemm_phase((PG8_LAS unsigned char*)smem, g, S, E, nullptr);
        __syncthreads();
    }
}
struct EpiPle {
    static constexpr bool PERM = true, AFTER_DRAIN = true;
    const bf16* PW; const bf16* hb_in; bf16* hb_out; float* gss;
    __device__ __forceinline__ void khook(int, f32x4 (&)[2][2][4][2], int, int) const {}
    __device__ __forceinline__ void operator()(const f32x4 (&)[2][2][4][2], const pg8::Unit&, int, int, int, int) const {}
    __device__ __forceinline__ void fused(const f32x4 (&acc)[2][2][4][2], const pg8::Unit& u, int wr, int wc, int fr, int fqd, PG8_LAS unsigned char*, int, int) const {
        residual_fused<true, false>(acc, u, wr, wc, fr, fqd, (const float*)(smem + LDS_AUX), PW, hb_in, hb_out, gss);
    }
};
__device__ __forceinline__ void phase_ple(const Params& P, int L, int hsel, int ss_slot_in, int ss_slot_out, int fake = 0) {
    char* ws = opq(P.ws);
    const float* ss_ple = (const float*)(ws + OFF_SSA) + (size_t)ss_slot_in * TOK * 8;
    float* ss_out = (float*)(ws + OFF_SSA) + (size_t)ss_slot_out * TOK * 8;
    const bf16* hb_in = (const bf16*)(ws + (hsel ? OFF_HB1 : OFF_HB0));
    bf16* hb_out = (bf16*)(ws + (hsel ? OFF_HB0 : OFF_HB1));
    const bf16* Wg = (const bf16*)(ws + OFF_WG) + (size_t)L * 1024 * LDH;
    float* aux = (float*)(smem + LDS_AUX);
    const int tid = opaque_tid();
    pg8::Gemm g{hb_in, Wg, LDH, LDH, TOK, 1024, 1024};
    pg8::StaticOrder S; S.init(TOK, 1024, gridDim.x, blockIdx.x);
    pg8::Unit u0;
    if (S.next(0, u0) && tid < 256) aux[tid] = row_rs8(ss_ple, u0.pm * 256 + tid);
    __syncthreads();
    EpiPle E{(const bf16*)(ws + (L ? OFF_PW1 : OFF_PW0)), hb_in, fake ? (bf16*)(ws + OFF_PART) : hb_out, fake ? (float*)(ws + OFF_FQ) : ss_out};
    pg8::gemm_phase((PG8_LAS unsigned char*)smem, g, S, E, nullptr);
    __syncthreads();
}

__device__ __forceinline__ void phase_final(const Params& P, int ss_slot, int hsel) {
    char* ws = opq(P.ws);
    float* out = opq(P.out);
    const bf16* hbin = (const bf16*)(ws + (hsel ? OFF_HB1 : OFF_HB0));
    const float* ss = (const float*)(ws + OFF_SSA) + (size_t)ss_slot * TOK * 8;
    const int tid = opaque_tid(), w = tid >> 6, l = tid & 63;
    const float4* g4 = (const float4*)P.final_norm_g;
    for (int t = blockIdx.x * NW + w; t < TOK; t += gridDim.x * NW) {
        float rs = row_rs8(ss, t);
        float4* o4 = (float4*)(out + (size_t)t * 1024);
#pragma unroll
        for (int i = 0; i < 2; ++i) {
            u32x4 hq = *(const u32x4*)(hbin + (size_t)t * LDH + (i * 64 + l) * 8);
            float4 ga = g4[(i * 64 + l) * 2], gb = g4[(i * 64 + l) * 2 + 1];
            float4 va = {bflo(hq.x) * rs * ga.x, bfhi(hq.x) * rs * ga.y, bflo(hq.y) * rs * ga.z, bfhi(hq.y) * rs * ga.w};
            float4 vb = {bflo(hq.z) * rs * gb.x, bfhi(hq.z) * rs * gb.y, bflo(hq.w) * rs * gb.z, bfhi(hq.w) * rs * gb.w};
            {
                const f32x4 na = {va.x, va.y, va.z, va.w}, nb2 = {vb.x, vb.y, vb.z, vb.w};
                __builtin_nontemporal_store(na, (f32x4*)(o4 + (i * 64 + l) * 2));
                __builtin_nontemporal_store(nb2, (f32x4*)(o4 + (i * 64 + l) * 2 + 1));
            }
        }
    }
}

#ifndef EARLY_ACQ
#define EARLY_ACQ 0
#endif
#ifndef EARLY_WB
#define EARLY_WB 0
#endif
#define XB_TMO      128
#define XB_XCNT(j)  (256  + 64 * (j))
#define XB_XSUB(j)  (1280 + 64 * (j))
#define XB_XGEN(j)  (2304 + 64 * (j))
#define XB_TOP      3328
#define XB_TOPGEN   3392
#define XCD_BAR_WORDS 3456
#define XB_SPIN_CAP (1u << 22)
__device__ __forceinline__ unsigned xb_ld(unsigned* p) { return __hip_atomic_load(p, __ATOMIC_RELAXED, __HIP_MEMORY_SCOPE_AGENT); }
__device__ __forceinline__ unsigned xb_add(unsigned* p, unsigned v) { return __hip_atomic_fetch_add(p, v, __ATOMIC_RELAXED, __HIP_MEMORY_SCOPE_AGENT); }
__device__ __forceinline__ unsigned xb_xcc_id() { return (unsigned)__builtin_amdgcn_s_getreg((3 << 11) | 20) & 0xFu; }
#define XB_SPIN(cond, bar) do { unsigned _sp = 0; while (cond) { __builtin_amdgcn_s_sleep(1); \
    if ((++_sp & 255u) == 0u) { if (xb_ld(&(bar)[XB_TMO])) break; if (_sp > XB_SPIN_CAP) { atomicAdd(&(bar)[XB_TMO], 1u); break; } } } } while (0)
#define XB_LDS_OFF (LDS_BYTES - 64)
__device__ __forceinline__ void xcd_barrier_post(const Params& P) {
    if (threadIdx.x == 0) {
        unsigned* bar = (unsigned*)(P.ws + OFF_BAR);
        volatile __attribute__((address_space(3))) unsigned* st = (volatile __attribute__((address_space(3))) unsigned*)(smem + XB_LDS_OFF);
        st[0] = 0u; st[1] = 0u;
        (void)xb_add(&bar[XB_XCNT(xb_xcc_id())], 1u);
    }
}
__device__ __forceinline__ void xcd_barrier_complete(unsigned* bar, unsigned x, unsigned& nloc, unsigned& nx) {
    const unsigned G = gridDim.x;
    unsigned sum, cnt, mine, sp = 0u;
    for (;;) {
        sum = 0u; cnt = 0u; mine = 0u;
#pragma unroll
        for (unsigned j = 0; j < 16; ++j) { const unsigned c = xb_ld(&bar[XB_XCNT(j)]); sum += c; cnt += (c > 0u) ? 1u : 0u; mine = (j == x) ? c : mine; }
        if (sum == G) break;
        __builtin_amdgcn_s_sleep(1);
        if ((++sp & 255u) == 0u) { if (xb_ld(&bar[XB_TMO])) break; if (sp > XB_SPIN_CAP) { atomicAdd(&bar[XB_TMO], 1u); break; } }
    }
    nloc = mine > 0u ? mine : 1u; nx = cnt > 0u ? cnt : 1u;
}
__device__ __forceinline__ void grid_barrier(const Params& P) {
    asm volatile("s_waitcnt vmcnt(0)" ::: "memory");
    __syncthreads();
    if (threadIdx.x == 0) {
        unsigned* bar = (unsigned*)(P.ws + OFF_BAR);
        volatile __attribute__((address_space(3))) unsigned* st = (volatile __attribute__((address_space(3))) unsigned*)(smem + XB_LDS_OFF);
        const unsigned x = xb_xcc_id();
        __builtin_amdgcn_s_waitcnt(0);
        unsigned nloc = st[0], nx = st[1];
        if (nloc == 0u) { xcd_barrier_complete(bar, x, nloc, nx); st[0] = nloc; st[1] = nx; }
#if EARLY_WB
        asm volatile("buffer_wbl2 sc1" ::: "memory");
#endif
        const unsigned old = xb_add(&bar[XB_XSUB(x)], 1u);
        const unsigned gen = old / nloc;
#if EARLY_ACQ
        asm volatile("buffer_inv sc1" ::: "memory");
#endif
        if (old + 1u == (gen + 1u) * nloc) {
            __builtin_amdgcn_fence(__ATOMIC_RELEASE, "agent");
            asm volatile("s_waitcnt vmcnt(0)" ::: "memory");
            const unsigned og = xb_add(&bar[XB_TOP], 1u);
            const unsigned tg = og / nx;
            if (og + 1u == (tg + 1u) * nx) xb_add(&bar[XB_TOPGEN], 1u);
            else XB_SPIN(xb_ld(&bar[XB_TOPGEN]) == tg, bar);
#if !EARLY_ACQ
            __builtin_amdgcn_fence(__ATOMIC_ACQUIRE, "agent");
#endif
            xb_add(&bar[XB_XGEN(x)], 1u);
            asm volatile("s_waitcnt vmcnt(0)" ::: "memory");
        } else {
            XB_SPIN(xb_ld(&bar[XB_XGEN(x)]) == gen, bar);
#if !EARLY_ACQ
            __builtin_amdgcn_fence(__ATOMIC_ACQUIRE, "agent");
#endif
            asm volatile("s_waitcnt vmcnt(0)" ::: "memory");
        }
    }
    __syncthreads();
}

__global__ void __launch_bounds__(NTHR, 2) hymba_megakernel(Params P) {
    cg::grid_group grid = cg::this_grid();
    char* ws = opq(P.ws);
    xcd_barrier_post(P);
#define BAR() do { grid_barrier(P); if (DUP == 20) grid_barrier(P); } while (0)
    phase0(P);
    if (DUP == 0) { asm volatile("s_waitcnt vmcnt(0)" ::: "memory"); __syncthreads(); grid_barrier(P); phase0(P); }
    if (DUP == 13) { asm volatile("s_waitcnt vmcnt(0)" ::: "memory"); __syncthreads(); grid.sync(); }
    BAR();
    phase_pw(P);
    asm volatile("s_waitcnt vmcnt(0)" ::: "memory");
    __syncthreads();
    if (DUP == 11) { BAR(); phase_pw(P); BAR(); }
    int cur = 0;
    for (int L = 0; L < 2; ++L) {
        const int ss_mix = (L == 0) ? 0 : 3, ss_ffn = 1 + L, ss_next = (L == 0) ? 3 : 4, ss_ple = 5 + L;
        phase_proj(P, L, cur, ss_mix);
        BAR();
        if (DUP == 1) { phase_proj(P, L, cur, ss_mix); BAR(); }
        phase_mla_up(P, L);
        BAR();
        if (DUP == 2) { phase_mla_up(P, L); BAR(); }
        phase_attn(P, L, 0);
        BAR();
        if (DUP == 3) { phase_attn(P, L, 1); BAR(); }
        if (DUP >= 30 && DUP < 34) { phase_attn(P, L, 1, DUP - 30); BAR(); }
        phase_wo(P, L, cur ^ 1, ss_ffn);
        BAR();
        if (DUP == 4 && L == 0) { phase_wo(P, L, cur ^ 1, ss_ffn); BAR(); }
        phase_pq(P, L, cur ^ 1, ss_ffn);
        BAR();
        if (DUP == 5) { phase_pq(P, L, cur ^ 1, ss_ffn); BAR(); }
        if (DUP == 6) { phase_topk(P, L); BAR(); }
        phase_gather_u(P, L);
        BAR();
        if (DUP == 7) { phase_gather_u(P, L); BAR(); }
        if (DUP == 10) { phase_gather_act(P, L, ss_ffn, 1); BAR(); }
        phase_gather_act(P, L, ss_ffn);
        BAR();
        if (DUP == 8) { phase_gather_v(P, L, cur, ss_ple, 1); BAR(); }
        phase_gather_v(P, L, cur, ss_ple);
        BAR();
        if (DUP == 9) { phase_ple(P, L, cur, ss_ple, ss_next, 1); BAR(); }
        phase_ple(P, L, cur, ss_ple, ss_next);
        BAR();
        cur ^= 1;
    }
    phase_final(P, 4, cur);
}

extern "C" void kernel_launch(void* const* d_in, const int* in_sizes, int n_in, void* d_out, int out_size, void* d_ws,
                              size_t ws_size, hipStream_t stream) {
    static int grid_blocks = 0;
    if (!grid_blocks) {
        int dev = 0, cus = 0, per_cu = 0;
        hipGetDevice(&dev);
        hipDeviceGetAttribute(&cus, hipDeviceAttributeMultiprocessorCount, dev);
        hipOccupancyMaxActiveBlocksPerMultiprocessor(&per_cu, hymba_megakernel, NTHR, 0);
        if (per_cu > 1) per_cu = 1;
        if (per_cu < 1) per_cu = 1;
        grid_blocks = cus * per_cu;
        if (ws_size < WS_END) fprintf(stderr, "workspace too small: %zu < %zu\n", ws_size, (size_t)WS_END);
    }
    Params P{};
    P.x = (const float*)d_in[0]; P.p = (const float*)d_in[1]; P.pos = (const int*)d_in[2];
    P.norm_mix_g = (const float*)d_in[3]; P.w_in = (const float*)d_in[4]; P.b_forget = (const float*)d_in[5];
    P.mla_q_norm_g = (const float*)d_in[6]; P.w_uq = (const float*)d_in[7]; P.mla_kv_norm_g = (const float*)d_in[8];
    P.w_ukv = (const float*)d_in[9]; P.mix_out_norm_g = (const float*)d_in[10]; P.w_o = (const float*)d_in[11];
    P.norm_ffn_g = (const float*)d_in[12]; P.w_query = (const float*)d_in[13]; P.sub_keys = (const float*)d_in[14];
    P.peer_u = (const float*)d_in[15]; P.peer_v = (const float*)d_in[16]; P.w_ple = (const float*)d_in[17];
    P.ple_norm_g = (const float*)d_in[18]; P.w_ple_gate = (const float*)d_in[19]; P.final_norm_g = (const float*)d_in[20];
    P.out = (float*)d_out; P.ws = (char*)d_ws;
    hipMemsetAsync((char*)d_ws + OFF_BAR, 0, 16384 + 4096, stream);
    void* args[] = {&P};
    hipError_t e = hipLaunchCooperativeKernel((void*)hymba_megakernel, dim3(grid_blocks), dim3(NTHR), args, 0, stream);
    if (e != hipSuccess) fprintf(stderr, "cooperative launch failed: %s (grid %d)\n", hipGetErrorString(e), grid_blocks);
}
```

```cpp
#define EARLY_ACQ 1
#include <hip/hip_runtime.h>
#include <hip/hip_cooperative_groups.h>
#include <cstdio>
#include <cstdint>
#include <math.h>
#include <climits>
namespace cg = cooperative_groups;

typedef __bf16 bf16;
typedef __bf16 bf16x8 __attribute__((ext_vector_type(8)));
typedef __bf16 bf16x4 __attribute__((ext_vector_type(4)));
typedef __bf16 bf16x2 __attribute__((ext_vector_type(2)));
typedef float f32x16 __attribute__((ext_vector_type(16)));
typedef float f32x4 __attribute__((ext_vector_type(4)));
typedef float f32x2 __attribute__((ext_vector_type(2)));
typedef unsigned u32x4 __attribute__((ext_vector_type(4)));
typedef unsigned u32x2 __attribute__((ext_vector_type(2)));

#define SEQ 2048
#define BATCH 8
#define TOK 16384
#define DM 1024
#define IN_W 1956
#define NEXP 16384
#define EPSF 1e-6f
#define LOG2E 1.4426950408889634f
#define NTHR 512
#define NW 8
#define LDS_BYTES 151808
#define STAGE_BYTES 49152
#define LDS_AUX 147456
#ifndef DUP
#define DUP -1
#endif

constexpr size_t MBy = 1ull << 20;
constexpr size_t OFF_UB = 0;
constexpr size_t OFF_VB = 16 * MBy;
constexpr size_t OFF_PART = 32 * MBy;
constexpr size_t OFF_PW1 = 96 * MBy;
#define LDH 1088
#define LDP 320
#define LDC 192
constexpr size_t OFF_WIN = 128 * MBy;
constexpr size_t OFF_WO = 137 * MBy;
constexpr size_t OFF_WQ = 142 * MBy;
constexpr size_t OFF_WG = 147 * MBy;
constexpr size_t OFF_WP = 152 * MBy;
constexpr size_t OFF_WUQ = 154 * MBy;
constexpr size_t OFF_WUKV = 155 * MBy;
constexpr size_t OFF_SKB = 156 * MBy;
constexpr size_t OFF_CS = 157 * MBy;
constexpr size_t OFF_TSC = 159 * MBy;
constexpr size_t OFF_SSA = 160 * MBy;
constexpr size_t OFF_HB0 = 164 * MBy;
constexpr size_t OFF_HB1 = 200 * MBy;
constexpr size_t OFF_FQ = 236 * MBy;
constexpr size_t OFF_FK = 244 * MBy;
constexpr size_t OFF_FVT = 252 * MBy;
constexpr size_t OFF_SQ = 260 * MBy;
constexpr size_t OFF_SKK = 268 * MBy;
constexpr size_t OFF_SVT = 276 * MBy;
constexpr size_t OFF_CQ = 284 * MBy;
constexpr size_t OFF_CKV = 295 * MBy;
constexpr size_t OFF_FLOG = 302 * MBy;
constexpr size_t OFF_CUMF = 303 * MBy;
constexpr size_t OFF_MQ = 304 * MBy;
constexpr size_t OFF_MK = 316 * MBy;
constexpr size_t OFF_MVT = 328 * MBy;
constexpr size_t OFF_Y = 344 * MBy;
constexpr size_t OFF_PQ = 380 * MBy;
constexpr size_t OFF_IDS = 412 * MBy;
constexpr size_t OFF_GATE = 420 * MBy;
constexpr size_t OFF_BAR = 428 * MBy;
constexpr size_t OFF_CNT = OFF_BAR + 16384;
constexpr size_t OFF_SSY = 429 * MBy;
constexpr size_t OFF_PB = 431 * MBy;
constexpr size_t OFF_PW0 = 452 * MBy;
constexpr size_t OFF_A8 = OFF_PQ;
constexpr size_t OFF_XH = OFF_FQ;
constexpr size_t OFF_XL = OFF_FQ + 16 * MBy;
constexpr size_t WS_END = 484 * MBy;

struct Params {
    const float* x; const float* p; const int* pos;
    const float* norm_mix_g; const float* w_in; const float* b_forget; const float* mla_q_norm_g; const float* w_uq;
    const float* mla_kv_norm_g; const float* w_ukv; const float* mix_out_norm_g; const float* w_o; const float* norm_ffn_g;
    const float* w_query; const float* sub_keys; const float* peer_u; const float* peer_v; const float* w_ple;
    const float* ple_norm_g; const float* w_ple_gate; const float* final_norm_g;
    float* out; char* ws;
};

__shared__ __attribute__((aligned(16))) char smem[LDS_BYTES];

__device__ __forceinline__ int opaque_tid() { int t = threadIdx.x; asm volatile("" : "+v"(t)); return t; }
template <typename T> __device__ __forceinline__ T* opq(T* p) { size_t z = 0; asm volatile("" : "+s"(z)); return (T*)((char*)p + z); }

__device__ __forceinline__ unsigned pack2(float a, float b) {
    f32x2 v = {a, b};
    bf16x2 r = __builtin_convertvector(v, bf16x2);
    return __builtin_bit_cast(unsigned, r);
}
__device__ __forceinline__ float bflo(unsigned u) { return __uint_as_float(u << 16); }
__device__ __forceinline__ float bfhi(unsigned u) { return __uint_as_float(u & 0xffff0000u); }
__device__ __forceinline__ float4 ntload4(const float4* p) {
    const f32x4 t = __builtin_nontemporal_load((const f32x4*)p);
    return make_float4(t.x, t.y, t.z, t.w);
}
__device__ __forceinline__ float wave_sum(float v) {
#pragma unroll
    for (int o = 32; o > 0; o >>= 1) v += __shfl_xor(v, o);
    return v;
}
template <int CTRL> __device__ __forceinline__ float dpp_add(float v) {
    return v + __builtin_bit_cast(float, __builtin_amdgcn_update_dpp(0, __builtin_bit_cast(int, v), CTRL, 0xf, 0xf, true));
}
__device__ __forceinline__ float sum8_dpp(float v) { v = dpp_add<0xB1>(v); v = dpp_add<0x4E>(v); v = dpp_add<0x141>(v); return v; }
__device__ __forceinline__ float sumg_dpp(float v) {
    v = dpp_add<0x128>(v);
    float a = v, b = v;
    asm volatile("s_nop 1\n\tv_permlane16_swap_b32 %0, %1\n\ts_nop 1" : "+v"(a), "+v"(b));
    v = a + b;
    a = v; b = v;
    asm volatile("s_nop 1\n\tv_permlane32_swap_b32 %0, %1\n\ts_nop 1" : "+v"(a), "+v"(b));
    return a + b;
}
template <int CTRL> __device__ __forceinline__ float dpp_max0(float v) {
    return fmaxf(v, __builtin_bit_cast(float, __builtin_amdgcn_update_dpp(0, __builtin_bit_cast(int, v), CTRL, 0xf, 0xf, true)));
}
__device__ __forceinline__ float wave_max0(float v) {
    v = dpp_max0<0xB1>(v); v = dpp_max0<0x4E>(v); v = dpp_max0<0x141>(v); v = dpp_max0<0x140>(v);
    float a = v, b = v;
    asm volatile("s_nop 1\n\tv_permlane16_swap_b32 %0, %1\n\ts_nop 1" : "+v"(a), "+v"(b));
    v = fmaxf(a, b); a = v; b = v;
    asm volatile("s_nop 1\n\tv_permlane32_swap_b32 %0, %1\n\ts_nop 1" : "+v"(a), "+v"(b));
    return fmaxf(a, b);
}
__device__ __forceinline__ int partner32(int v, int hh) {
    int a = v, b = v;
    asm volatile("s_nop 1\n\tv_permlane32_swap_b32 %0, %1\n\ts_nop 1" : "+v"(a), "+v"(b));
    return hh ? a : b;
}
__device__ __forceinline__ float fexp2(float x) { return __builtin_amdgcn_exp2f(x); }
__device__ __forceinline__ float flog2(float x) { return __builtin_amdgcn_logf(x); }
__device__ __forceinline__ float log_sigmoid_f(float z) { return fminf(z, 0.f) - 0.6931471805599453f * flog2(1.f + fexp2(-1.4426950408889634f * fabsf(z))); }

struct WJob { const float* src; int lds; int K; int Np; bf16* dst; int ldd; const float* gain; int map; };

__device__ __forceinline__ int src_col_map(int map, int c) {
    if (map == 0) return c;
    if (map == 1) {
        if (c < 768) return c;
        if (c < 1952) return c + 4;
        if (c < 1956) return c - 1952 + 768;
        return -1;
    }
    if (c < 256) return 192 * (c >> 6) + (c & 63);
    int e = c - 256;
    return 192 * (e >> 7) + 64 + (e & 127);
}

__device__ __forceinline__ void wconv_group(const WJob& j, int t0, int tstride, int ntiles) {
    float* tl = (float*)smem;
    const int ktiles = j.K >> 5;
    const int tx = opaque_tid() & 31, ty = opaque_tid() >> 5;
    float v[8][2];
#pragma unroll
    for (int u = 0; u < 8; ++u) {
        const int tile = t0 + u * tstride;
        v[u][0] = 0.f; v[u][1] = 0.f;
        if (tile < ntiles) {
            const int nt = tile / ktiles, kt = tile % ktiles;
            const int sc = src_col_map(j.map, nt * 32 + tx);
            if (sc >= 0) {
#pragma unroll
                for (int i = 0; i < 2; ++i) {
                    const int k = kt * 32 + ty + 16 * i;
                    v[u][i] = __builtin_nontemporal_load(j.src + (size_t)k * j.lds + sc) * (j.gain ? j.gain[k] : 1.f);
                }
            }
        }
    }
#pragma unroll
    for (int u = 0; u < 8; ++u)
#pragma unroll
        for (int i = 0; i < 2; ++i) tl[u * 1056 + (ty + 16 * i) * 33 + tx] = v[u][i];
    __syncthreads();
#pragma unroll
    for (int u = 0; u < 8; ++u) {
        const int tile = t0 + u * tstride;
        if (tile < ntiles) {
            const int nt = tile / ktiles, kt = tile % ktiles;
#pragma unroll
            for (int i = 0; i < 2; ++i) {
                const int n = nt * 32 + ty + 16 * i;
                j.dst[(size_t)n * j.ldd + kt * 32 + tx] = (bf16)tl[u * 1056 + tx * 33 + ty + 16 * i];
            }
        }
    }
    __syncthreads();
}

__device__ __forceinline__ void phase0(const Params& P) {
    char* ws = opq(P.ws);
    const int G = gridDim.x, bid = blockIdx.x, tid = opaque_tid();
    if (DUP == 23) {
        const int w = tid >> 6, l = tid & 63;
        float4 accp = {0.f, 0.f, 0.f, 0.f};
        for (int it = (bid * NW + w) * 4; it < 4 * NEXP; it += G * NW * 4) {
            float4 v[16];
            const int tb = it >> 14, e = it & (NEXP - 1);
            const float4* src = (const float4*)((tb < 2 ? P.peer_u : P.peer_v) + ((size_t)(tb & 1) * NEXP + e) * DM) + l;
#pragma unroll
            for (int q = 0; q < 16; ++q) v[q] = ntload4(src + 64 * q);
#pragma unroll
            for (int q = 0; q < 16; ++q) { accp.x += v[q].x; accp.y += v[q].y; accp.z += v[q].z; accp.w += v[q].w; }
        }
        ((float4*)(ws + OFF_PART))[bid * NTHR + tid] = accp;
    }
    for (int rep = 0; rep < (DUP == 20 ? 2 : 1); ++rep) {
        const int w = tid >> 6, l = tid & 63;
        float* tsc = (float*)(ws + OFF_TSC);
        for (int it = (bid * NW + w) * 4; it < 4 * NEXP; it += G * NW * 4) {
            const int tb = it >> 14, e0 = it & (NEXP - 1);
            const float4* src = (const float4*)((tb < 2 ? P.peer_u : P.peer_v) + ((size_t)(tb & 1) * NEXP + e0) * DM) + l;
            unsigned char* dst = (unsigned char*)(ws + (tb < 2 ? OFF_UB : OFF_VB)) + (size_t)(tb & 1) * NEXP * 512 + (size_t)e0 * 128 + 2 * l;
            float4 v[4][4];
#pragma unroll
            for (int r = 0; r < 4; ++r)
#pragma unroll
                for (int q = 0; q < 4; ++q) v[r][q] = ntload4(src + 256 * r + 64 * q);
            if (tb < 2) {
                const float4* g4 = (const float4*)(P.norm_ffn_g + (tb & 1) * 1024) + l;
#pragma unroll
                for (int q = 0; q < 4; ++q) {
                    const float4 g = g4[64 * q];
#pragma unroll
                    for (int r = 0; r < 4; ++r) { v[r][q].x *= g.x; v[r][q].y *= g.y; v[r][q].z *= g.z; v[r][q].w *= g.w; }
                }
            }
            float am[4];
#pragma unroll
            for (int r = 0; r < 4; ++r) {
                float m = 0.f;
#pragma unroll
                for (int q = 0; q < 4; ++q) m = fmaxf(m, fmaxf(fmaxf(fabsf(v[r][q].x), fabsf(v[r][q].y)), fmaxf(fabsf(v[r][q].z), fabsf(v[r][q].w))));
                am[r] = wave_max0(m);
            }
#pragma unroll
            for (int r = 0; r < 4; ++r) {
                const float sc = (am[r] > 0.f) ? (6.0f / am[r]) : 1.f, isc = (am[r] > 0.f) ? (am[r] * (1.f / 6.0f)) : 1.f;
#pragma unroll
                for (int q = 0; q < 4; ++q) {
                    unsigned wq = 0;
                    wq = __builtin_amdgcn_cvt_scalef32_pk_fp4_f32(wq, v[r][q].x * sc, v[r][q].y * sc, 1.0f, 0);
                    wq = __builtin_amdgcn_cvt_scalef32_pk_fp4_f32(wq, v[r][q].z * sc, v[r][q].w * sc, 1.0f, 1);
                    *(unsigned short*)(dst + (size_t)q * NEXP * 128 + r * 128) = (unsigned short)(wq & 0xffffu);
                }
                if (l == 0) tsc[tb * NEXP + e0 + r] = isc;
            }
        }
    }
    if (DUP == 22) {
        const int w = tid >> 6, l = tid & 63;
        float4 accp = {0.f, 0.f, 0.f, 0.f};
        for (int it = (bid * NW + w) * 4; it < 4 * NEXP; it += G * NW * 4) {
            float4 v[16];
#pragma unroll
            for (int r = 0; r < 4; ++r) {
                const int tb = (it + r) >> 14, e = (it + r) & (NEXP - 1);
                const float4* src = (const float4*)((tb < 2 ? P.peer_u : P.peer_v) + ((size_t)(tb & 1) * NEXP + e) * DM) + l;
#pragma unroll
                for (int q = 0; q < 4; ++q) v[4 * r + q] = src[64 * q];
            }
#pragma unroll
            for (int q = 0; q < 16; ++q) { accp.x += v[q].x; accp.y += v[q].y; accp.z += v[q].z; accp.w += v[q].w; }
        }
        ((float4*)(ws + OFF_PART))[bid * NTHR + tid] = accp;
    }
    for (int rep = 0; rep < (DUP == 21 ? 2 : 1); ++rep) {
        for (int L = 0; L < 2; ++L) {
            WJob jobs[7];
            jobs[0] = {P.w_in + (size_t)L * 1024 * IN_W, IN_W, 1024, 2048, (bf16*)(ws + OFF_WIN) + (size_t)L * 2048 * LDH, LDH, P.norm_mix_g + L * 1024, 1};
            jobs[1] = {P.w_o + (size_t)L * 1024 * 1024, 1024, 1024, 1024, (bf16*)(ws + OFF_WO) + (size_t)L * 1024 * LDH, LDH, P.mix_out_norm_g + L * 1024, 0};
            jobs[2] = {P.w_query + (size_t)L * 1024 * 1024, 1024, 1024, 1024, (bf16*)(ws + OFF_WQ) + (size_t)L * 1024 * LDH, LDH, P.norm_ffn_g + L * 1024, 0};
            jobs[3] = {P.w_ple_gate + (size_t)L * 1024 * 1024, 1024, 1024, 1024, (bf16*)(ws + OFF_WG) + (size_t)L * 1024 * LDH, LDH, P.ple_norm_g + L * 1024, 0};
            jobs[4] = {P.w_ple + (size_t)L * 256 * 1024, 1024, 256, 1024, (bf16*)(ws + OFF_WP) + (size_t)L * 1024 * LDP, LDP, nullptr, 0};
            jobs[5] = {P.w_uq + (size_t)L * 256 * 384, 384, 256, 384, (bf16*)(ws + OFF_WUQ) + (size_t)L * 384 * LDP, LDP, P.mla_q_norm_g + L * 256, 0};
            jobs[6] = {P.w_ukv + (size_t)L * 128 * 768, 768, 128, 768, (bf16*)(ws + OFF_WUKV) + (size_t)L * 768 * LDC, LDC, P.mla_kv_norm_g + L * 128, 2};
#pragma unroll
            for (int q = 0; q < 7; ++q) {
                int nt = (jobs[q].Np >> 5) * (jobs[q].K >> 5);
                for (int it = bid; it < nt; it += 8 * G) wconv_group(jobs[q], it, G, nt);
            }
        }
    }
    {
        const float* src = P.sub_keys;
        bf16* dst = (bf16*)(ws + OFF_SKB);
        for (int i = bid * NTHR + tid; i < 262144 / 2; i += G * NTHR) {
            float2 v = ((const float2*)src)[i];
            ((unsigned*)dst)[i] = pack2(v.x, v.y);
        }
    }
    {
        const float4* src = (const float4*)P.p;
        bf16* dst = (bf16*)(ws + OFF_PB);
        for (int i0 = bid * NTHR + tid; i0 < 2 * TOK * 256 / 4; i0 += 4 * G * NTHR) {
            float4 a[4];
#pragma unroll
            for (int u = 0; u < 4; ++u) a[u] = ntload4(src + ((i0 + u * G * NTHR < 2 * TOK * 64) ? (i0 + u * G * NTHR) : i0));
#pragma unroll
            for (int u = 0; u < 4; ++u) {
                const int i = i0 + u * G * NTHR;
                if (i >= 2 * TOK * 64) break;
                u32x2 o = {pack2(a[u].x, a[u].y), pack2(a[u].z, a[u].w)};
                *(u32x2*)(dst + (size_t)(i >> 6) * LDP + (i & 63) * 4) = o;
            }
        }
    }
    {
        bf16* hb = (bf16*)(ws + OFF_HB0);
        float* ss0 = (float*)(ws + OFF_SSA);
        int w = tid >> 6, l = tid & 63;
        for (int row0 = (bid * NW + w) * 4; row0 < TOK; row0 += G * NW * 4) {
            const float4* xr = (const float4*)(P.x + (size_t)row0 * DM) + l;
            float4 a[4][4];
#pragma unroll
            for (int r = 0; r < 4; ++r)
#pragma unroll
                for (int i = 0; i < 4; ++i) a[r][i] = ntload4(xr + 256 * r + 64 * i);
#pragma unroll
            for (int r = 0; r < 4; ++r) {
                const int row = row0 + r;
                float ss = 0.f;
#pragma unroll
                for (int i = 0; i < 4; ++i) {
                    ss += a[r][i].x * a[r][i].x + a[r][i].y * a[r][i].y + a[r][i].z * a[r][i].z + a[r][i].w * a[r][i].w;
                    u32x2 o = {pack2(a[r][i].x, a[r][i].y), pack2(a[r][i].z, a[r][i].w)};
                    ((u32x2*)(hb + (size_t)row * LDH))[i * 64 + l] = o;
                }
                ss = wave_sum(ss);
                if (l == 0) {
                    *(float4*)(ss0 + (size_t)row * 8) = make_float4(ss, 0.f, 0.f, 0.f);
                    *(float4*)(ss0 + (size_t)row * 8 + 4) = make_float4(0.f, 0.f, 0.f, 0.f);
                }
            }
        }
    }
    {
        float* cs = (float*)(ws + OFF_CS);
        for (int i = bid * NTHR + tid; i < TOK * 16; i += G * NTHR) {
            int t = i >> 4, k = i & 15;
            float inv = fexp2(-(float)k * (13.287712379549449f / 16.0f));
            float rev = (float)P.pos[t] * inv * 0.15915494309189535f;
            rev -= floorf(rev);
            cs[2 * i] = __builtin_amdgcn_cosf(rev);
            cs[2 * i + 1] = __builtin_amdgcn_sinf(rev);
        }
    }
}

struct NoHook { static constexpr bool nodma = false, ssq = false; __device__ __forceinline__ void operator()(int, f32x16 (&)[2][2]) const {} };
struct SsqHook { static constexpr bool nodma = false, ssq = true; __device__ __forceinline__ void operator()(int, f32x16 (&)[2][2]) const {} };
struct NoDmaHook { static constexpr bool nodma = true, ssq = false; __device__ __forceinline__ void operator()(int, f32x16 (&)[2][2]) const {} };
template <typename HOOK>
__device__ __forceinline__ void gemm_core(f32x16 (&acc)[2][2], const bf16* A, int lda, const bf16* Bt, int ldb, int K,
                                          int m0, int n0, HOOK hook, float (&ssq)[2]) {
    const int tid = opaque_tid(), w = tid >> 6, l = tid & 63, r = l & 31, hh = l >> 5;
    const int wm = w >> 1, wn = w & 1;
    const int dp = (tid & 15) ^ ((tid >> 4) & 15);
    const int drow = 2 * (tid >> 4) + (dp >> 3), dgc = (dp & 7) * 8;
    const bf16* asrc = A + (size_t)(m0 + drow) * lda + dgc;
    const bf16* bsrc = Bt + (size_t)(n0 + drow) * ldb + dgc;
    auto dma = [&](int buf, int k0) {
        if (HOOK::nodma) return;
        char* base = smem + buf * STAGE_BYTES + tid * 16;
#pragma unroll
        for (int i = 0; i < 4; ++i)
            __builtin_amdgcn_global_load_lds((const unsigned*)(asrc + (size_t)(64 * i) * lda + k0), (unsigned*)(base + i * 8192), 16, 0, 0);
#pragma unroll
        for (int i = 0; i < 2; ++i)
            __builtin_amdgcn_global_load_lds((const unsigned*)(bsrc + (size_t)(64 * i) * ldb + k0), (unsigned*)(base + 32768 + i * 8192), 16, 0, 0);
    };
    int offA[2], offB[2];
#pragma unroll
    for (int i = 0; i < 2; ++i) { offA[i] = ((wm * 64 + i * 32 + r) >> 1) * 256; offB[i] = 32768 + ((wn * 64 + i * 32 + r) >> 1) * 256; }
    const int pbase = ((r & 1) << 3), lx = (r >> 1) & 15;
    const int nk = K >> 6;
    const unsigned ldsbase = (unsigned)(size_t)(__attribute__((address_space(3))) char*)smem;
    auto ldfrag = [&](int stage, int s, bf16x8 (&af)[2], bf16x8 (&bfr)[2]) {
        unsigned ch = (unsigned)((((pbase | (2 * s + hh)) ^ lx) << 4)) + ldsbase + (unsigned)(stage * STAGE_BYTES);
        unsigned a0a = ch + offA[0], a1a = ch + offA[1], b0a = ch + offB[0], b1a = ch + offB[1];
        asm volatile("ds_read_b128 %0, %4\n\tds_read_b128 %1, %5\n\tds_read_b128 %2, %6\n\tds_read_b128 %3, %7"
                     : "=&v"(af[0]), "=&v"(af[1]), "=&v"(bfr[0]), "=&v"(bfr[1]) : "v"(a0a), "v"(a1a), "v"(b0a), "v"(b1a) : "memory");
    };
    auto mma = [&](bf16x8 (&af)[2], bf16x8 (&bfr)[2]) {
#pragma unroll
        for (int i = 0; i < 2; ++i)
#pragma unroll
            for (int j = 0; j < 2; ++j) acc[i][j] = __builtin_amdgcn_mfma_f32_32x32x16_bf16(af[i], bfr[j], acc[i][j], 0, 0, 0);
        if (HOOK::ssq) {
#pragma unroll
            for (int i = 0; i < 2; ++i) {
                const u32x4 rw = __builtin_bit_cast(u32x4, af[i]);
                float a;
                a = bflo(rw.x); ssq[i] += a * a; a = bfhi(rw.x); ssq[i] += a * a; a = bflo(rw.y); ssq[i] += a * a; a = bfhi(rw.y); ssq[i] += a * a;
                a = bflo(rw.z); ssq[i] += a * a; a = bfhi(rw.z); ssq[i] += a * a; a = bflo(rw.w); ssq[i] += a * a; a = bfhi(rw.w); ssq[i] += a * a;
            }
        }
    };
#define LGKM_WAIT(n) do { asm volatile("s_waitcnt lgkmcnt(" #n ")" ::: "memory"); __builtin_amdgcn_sched_barrier(0); } while (0)
    asm volatile("s_waitcnt vmcnt(0)" ::: "memory");
    dma(0, 0);
    dma(1, 64);
    if (nk > 2) { dma(2, 128); asm volatile("s_waitcnt vmcnt(12)" ::: "memory"); }
    else asm volatile("s_waitcnt vmcnt(6)" ::: "memory");
    __builtin_amdgcn_s_barrier();
    bf16x8 a0[2], b0[2], a1[2], b1[2];
    ldfrag(0, 0, a0, b0);
    int cur = 0;
    for (int kt = 0; kt < nk; ++kt) {
        const int nxt = (cur == 2) ? 0 : cur + 1;
        if (kt == 4 || kt == 8) { LGKM_WAIT(0); hook(kt, acc); }
        ldfrag(cur, 1, a1, b1);
        LGKM_WAIT(4);
        mma(a0, b0);
        ldfrag(cur, 2, a0, b0);
        LGKM_WAIT(4);
        mma(a1, b1);
        ldfrag(cur, 3, a1, b1);
        LGKM_WAIT(4);
        mma(a0, b0);
        if (kt + 1 < nk) {
            if (kt + 2 < nk) asm volatile("s_waitcnt vmcnt(6) lgkmcnt(0)" ::: "memory");
            else asm volatile("s_waitcnt vmcnt(0) lgkmcnt(0)" ::: "memory");
            __builtin_amdgcn_s_barrier();
            __builtin_amdgcn_sched_barrier(0);
            if (kt + 3 < nk) dma(cur, (kt + 3) << 6);
            ldfrag(nxt, 0, a0, b0);
        } else {
            LGKM_WAIT(0);
        }
        mma(a1, b1);
        cur = nxt;
    }
    __syncthreads();
}
__device__ __forceinline__ float row_rs8(const float* part, int row) {
    float4 a = *(const float4*)(part + (size_t)row * 8), b = *(const float4*)(part + (size_t)row * 8 + 4);
    float ss = ((a.x + a.y) + (a.z + a.w)) + ((b.x + b.y) + (b.z + b.w));
    return rsqrtf(ss * (1.f / 1024.f) + EPSF);
}
__device__ __forceinline__ bool xcd_tile(int it, int MT, int NT, int& mt, int& nt) {
    const int G = gridDim.x, bid = blockIdx.x;
    if ((G & 7) == 0 && (MT & 7) == 0) {
        const int nbx = G >> 3, q = (bid >> 3) + it * nbx, per = (MT >> 3) * NT;
        if (q >= per) return false;
        mt = (bid & 7) * (MT >> 3) + q / NT; nt = q % NT;
        return true;
    }
    const int q = bid + it * G;
    if (q >= MT * NT) return false;
    mt = q / NT; nt = q % NT;
    return true;
}
struct NoScale { __device__ __forceinline__ float operator()(int, int) const { return 1.f; } };

#define ZERO_ACC(acc)                                  \
    _Pragma("unroll") for (int _i = 0; _i < 2; ++_i)   \
    _Pragma("unroll") for (int _j = 0; _j < 2; ++_j)   \
    _Pragma("unroll") for (int _r = 0; _r < 16; ++_r) acc[_i][_j][_r] = 0.f;


namespace pg8 {
#define PG8_LAS __attribute__((address_space(3)))
typedef unsigned short bf16_t;
constexpr int BM = 256, BK = 64, HALF = 128, HTB = HALF * BK * 2  , NXCD = 8, WGM = 8;

__host__ __device__ __forceinline__ int lds_byte(int r, int c) { const int st = (r >> 4) * 2 + (c >> 5), rr = r & 15, cc = c & 31, ob = rr * 64 + cc * 2; return st * 1024 + (ob ^ (((ob >> 9) & 1) << 5)); }
__host__ __device__ __forceinline__ void stage_rc(int b, int& R, int& C) { const int st = b / 1024, sb = b % 1024, swz = sb ^ (((sb >> 9) & 1) << 5); R = (st >> 1) * 16 + swz / 64; C = (st & 1) * 32 + (swz % 64) / 2; }
__host__ __device__ __forceinline__ int perm32(int rho) { const int n = rho >> 4, i = rho & 15; return 8 * (i >> 2) + 4 * n + (i & 3); }
struct Unit { int pm, pn; };
struct Gemm { const bf16* A; const bf16* Bt; int lda, ldb, M, N, K; };
struct StaticOrder {
    int nM, nN, nwg, G, c;
    __device__ void init(int M, int N, int G_, int c_) { nM = M / BM; nN = N / BM; nwg = nM * nN; G = G_; c = c_; }
    __device__ bool next(int i, Unit& u) const {
        const long L = (long)i * G + c; if (L >= nwg) return false;
        int wgid = (int)L; { const int q = nwg / NXCD, r = nwg % NXCD, xcd = wgid % NXCD, off = wgid / NXCD; wgid = (xcd < r ? xcd * (q + 1) : r * (q + 1) + (xcd - r) * q) + off; }
        const int nig = WGM * nN, gid = wgid / nig, fm = gid * WGM, gsz = (nM - fm) < WGM ? (nM - fm) : WGM;
        u.pm = fm + ((wgid % nig) % gsz); u.pn = (wgid % nig) / gsz; return true;
    }
    __device__ __forceinline__ void a_ready(const Unit&) const {}
    __device__ __forceinline__ void done(const Unit&) const {}
};
template <class Epi, class Sched, bool STAMP = false>
__device__ __forceinline__ void gemm_phase(PG8_LAS unsigned char* lds, const Gemm g, const Sched& S, const Epi& E, unsigned long long* stamps) {
    const int tid = opaque_tid(), wid = __builtin_amdgcn_readfirstlane(tid >> 6), lane = tid & 63, wr = wid >> 2, wc = wid & 3, fr = lane & 15, fq = lane >> 4;
    const int K = g.K, nt = K / BK;
    int ts_lo = 0, ts_hi = 0, nts = 0; const unsigned long long rt_entry = STAMP ? (unsigned long long)wall_clock64() : 0ull;
#define PG8_STAMP() do { if (STAMP && wid == 0 && nts < 64) { const unsigned long long _c = (unsigned long long)clock64(); \
        ts_lo = (lane == nts) ? (int)(unsigned)_c : ts_lo; ts_hi = (lane == nts) ? (int)(unsigned)(_c >> 32) : ts_hi; ++nts; } } while (0)
    PG8_STAMP();
    unsigned voffA[2], voffB[2];
#pragma unroll
    for (int i = 0; i < 2; ++i) { int R, C; stage_rc(tid * 16 + i * 8192, R, C); const int Rb = Epi::PERM ? ((R & ~31) + perm32(R & 31)) : R;
        voffA[i] = (unsigned)(R * g.lda + C) * 2u; voffB[i] = (unsigned)(Rb * g.ldb + C) * 2u; }
    const size_t kstep = (size_t)(BK * 2);
    const size_t hstepA = (size_t)HALF * g.lda * 2, hstepB = (size_t)HALF * g.ldb * 2;
    const size_t tstepA = 2 * hstepA, tstepB = 2 * hstepB;
    const unsigned ldsw = (unsigned)wid * 1024u;
    const int aoff = lds_byte(wr * 64 + fr, fq * 8), boff = lds_byte(wc * 32 + fr, fq * 8);
#define PG8_SA(b, h) (((b) * 2 + (h)) * HTB)
#define PG8_SB(b, h) ((4 + (b) * 2 + (h)) * HTB)
#define PG8_STAGE(bufoff, gbase, voff) do { _Pragma("unroll") for (int _i = 0; _i < 2; ++_i) \
        __builtin_amdgcn_global_load_lds((const unsigned*)((const char*)(gbase) + (voff)[_i]), (PG8_LAS unsigned*)(lds + (bufoff) + ldsw + _i * 8192), 16, 0, 0); } while (0)
#define PG8_LDA(dst, b, h) do { _Pragma("unroll") for (int m = 0; m < 4; ++m) _Pragma("unroll") for (int k = 0; k < 2; ++k) dst[m][k] = *(const PG8_LAS bf16x8*)(lds + PG8_SA(b, h) + aoff + m * 2048 + k * 1024); } while (0)
#define PG8_LDB(dst, b, h) do { _Pragma("unroll") for (int n = 0; n < 2; ++n) _Pragma("unroll") for (int k = 0; k < 2; ++k) dst[n][k] = *(const PG8_LAS bf16x8*)(lds + PG8_SB(b, h) + boff + n * 2048 + k * 1024); } while (0)
#define PG8_MMA(ai, bj, At, Bt) do { __builtin_amdgcn_s_setprio(1); _Pragma("unroll") for (int m = 0; m < 4; ++m) _Pragma("unroll") for (int n = 0; n < 2; ++n) _Pragma("unroll") for (int k = 0; k < 2; ++k) \
        acc[ai][bj][m][n] = __builtin_amdgcn_mfma_f32_16x16x32_bf16(Bt[n][k], At[m][k], acc[ai][bj][m][n], 0, 0, 0); __builtin_amdgcn_s_setprio(0); } while (0)
#define PG8_WAIT_V(n) asm volatile("s_waitcnt vmcnt(" #n ")" ::: "memory")
#define PG8_WAIT_L(n) asm volatile("s_waitcnt lgkmcnt(" #n ")" ::: "memory")
#define PG8_BAR __builtin_amdgcn_s_barrier()
#define PG8_SCHED __builtin_amdgcn_sched_barrier(0)
    Unit cur, nxt; int ui = 0;
    if (!S.next(0, cur)) return;
    f32x4 acc[2][2][4][2];
#pragma unroll
    for (int a = 0; a < 2; ++a)
#pragma unroll
        for (int b = 0; b < 2; ++b)
#pragma unroll
            for (int m = 0; m < 4; ++m)
#pragma unroll
                for (int n = 0; n < 2; ++n) acc[a][b][m][n] = (f32x4){0.f, 0.f, 0.f, 0.f};
    bf16x8 At[4][2], B0[2][2], B1[2][2];
    const char* cA = (const char*)g.A + (size_t)cur.pm * tstepA; const char* cB = (const char*)g.Bt + (size_t)cur.pn * tstepB;
    S.a_ready(cur);
    PG8_STAGE(PG8_SB(0, 0), cB, voffB); PG8_STAGE(PG8_SA(0, 0), cA, voffA); PG8_STAGE(PG8_SB(0, 1), cB + hstepB, voffB); PG8_STAGE(PG8_SA(0, 1), cA + hstepA, voffA);
    if (wr == 1) PG8_BAR;
    PG8_WAIT_V(4); PG8_BAR;
    PG8_STAGE(PG8_SB(1, 0), cB + kstep, voffB); PG8_STAGE(PG8_SA(1, 0), cA + kstep, voffA); PG8_STAGE(PG8_SB(1, 1), cB + hstepB + kstep, voffB);
    PG8_WAIT_V(6); PG8_BAR;
    PG8_STAMP();
    for (;;) {
        const bool has_next = S.next(ui + 1, nxt);
        const char* nA = has_next ? (const char*)g.A + (size_t)nxt.pm * tstepA : cA; const char* nB = has_next ? (const char*)g.Bt + (size_t)nxt.pn * tstepB : cB;
        for (int t = 0; t < nt; t += 2) {
            const bool last = (t == nt - 2);
            const char* a1 = cA + (size_t)(t + 1) * kstep;
            const char* a2 = last ? nA : cA + (size_t)(t + 2) * kstep; const char* b2 = last ? nB : cB + (size_t)(t + 2) * kstep;
            const char* a3 = a2 + kstep; const char* b3 = b2 + kstep;
            if (last && has_next) S.a_ready(nxt);
            E.khook(t, acc, wr, fr);
            PG8_LDB(B0, 0, 0); PG8_SCHED; PG8_LDA(At, 0, 0); PG8_STAGE(PG8_SA(1, 1), a1 + hstepA, voffA);
            PG8_WAIT_L(8); PG8_BAR; PG8_WAIT_L(0); PG8_MMA(0, 0, At, B0); PG8_BAR; PG8_SCHED;
            PG8_LDB(B1, 0, 1); PG8_STAGE(PG8_SB(0, 0), b2, voffB);
            PG8_BAR; PG8_WAIT_L(0); PG8_MMA(0, 1, At, B1); PG8_BAR;
            PG8_LDA(At, 0, 1); PG8_STAGE(PG8_SA(0, 0), a2, voffA);
            PG8_BAR; PG8_WAIT_L(0); PG8_MMA(1, 0, At, B0); PG8_BAR; PG8_SCHED;
            PG8_STAGE(PG8_SB(0, 1), b2 + hstepB, voffB);
            PG8_WAIT_V(6); PG8_BAR; PG8_MMA(1, 1, At, B1); PG8_BAR;
            PG8_LDB(B0, 1, 0); PG8_SCHED; PG8_LDA(At, 1, 0); PG8_STAGE(PG8_SA(0, 1), a2 + hstepA, voffA);
            PG8_WAIT_L(8); PG8_BAR; PG8_WAIT_L(0); PG8_MMA(0, 0, At, B0); PG8_BAR; PG8_SCHED;
            PG8_LDB(B1, 1, 1); PG8_STAGE(PG8_SB(1, 0), b3, voffB);
            PG8_BAR; PG8_WAIT_L(0); PG8_MMA(0, 1, At, B1); PG8_BAR;
            PG8_LDA(At, 1, 1); PG8_STAGE(PG8_SA(1, 0), a3, voffA);
            PG8_BAR; PG8_WAIT_L(0); PG8_MMA(1, 0, At, B0); PG8_BAR; PG8_SCHED;
            PG8_STAGE(PG8_SB(1, 1), b3 + hstepB, voffB);
            PG8_WAIT_V(6); PG8_BAR; PG8_MMA(1, 1, At, B1); PG8_BAR;
        }
        PG8_STAMP();
        if constexpr (!Epi::AFTER_DRAIN) { E(acc, cur, wr, wc, fr, fq); S.done(cur); }
        PG8_STAMP();
        if (!has_next) break;
#pragma unroll
        for (int a = 0; a < 2; ++a)
#pragma unroll
            for (int b = 0; b < 2; ++b)
#pragma unroll
                for (int m = 0; m < 4; ++m)
#pragma unroll
                    for (int n = 0; n < 2; ++n) acc[a][b][m][n] = (f32x4){0.f, 0.f, 0.f, 0.f};
        cur = nxt; cA = nA; cB = nB; ++ui;
    }
    PG8_WAIT_V(0);
    if (wr == 0) PG8_BAR;
    PG8_BAR;
    if constexpr (Epi::AFTER_DRAIN) { E.fused(acc, cur, wr, wc, fr, fq, lds, wid, lane); S.done(cur); }
    PG8_STAMP();
    if (STAMP && wid == 0) { stamps[lane] = lane < nts ? (((unsigned long long)(unsigned)ts_hi << 32) | (unsigned)ts_lo) : 0ull;
        if (lane == 62) stamps[62] = rt_entry; if (lane == 63) stamps[63] = (unsigned long long)wall_clock64(); }
#undef PG8_STAMP
#undef PG8_SA
#undef PG8_SB
#undef PG8_STAGE
#undef PG8_LDA
#undef PG8_LDB
#undef PG8_MMA
#undef PG8_WAIT_V
#undef PG8_WAIT_L
#undef PG8_BAR
#undef PG8_SCHED
}
}

#define TB_LD 136
#define TF_LD 132
template <bool SCALE>
__device__ __forceinline__ void stage_bf16(const f32x16 (&acc)[2][2], const float* rsl) {
    bf16* T = (bf16*)smem;
    const int tid = opaque_tid(), w = tid >> 6, l = tid & 63, hh = l >> 5, wm = w >> 1, wn = w & 1;
#pragma unroll
    for (int i = 0; i < 2; ++i)
#pragma unroll
        for (int rr = 0; rr < 16; ++rr) {
            int row = wm * 64 + i * 32 + (rr & 3) + 8 * (rr >> 2) + 4 * hh;
            float sc = SCALE ? rsl[row] : 1.f;
#pragma unroll
            for (int j = 0; j < 2; ++j) T[row * TB_LD + wn * 64 + j * 32 + (l & 31)] = (bf16)(acc[i][j][rr] * sc);
        }
    __syncthreads();
}
template <bool SCALE>
__device__ __forceinline__ void stage_f32(const f32x16 (&acc)[2][2], const float* rsl) {
    float* T = (float*)smem;
    const int tid = opaque_tid(), w = tid >> 6, l = tid & 63, hh = l >> 5, wm = w >> 1, wn = w & 1;
#pragma unroll
    for (int i = 0; i < 2; ++i)
#pragma unroll
        for (int rr = 0; rr < 16; ++rr) {
            int row = wm * 64 + i * 32 + (rr & 3) + 8 * (rr >> 2) + 4 * hh;
            float sc = SCALE ? rsl[row] : 1.f;
#pragma unroll
            for (int j = 0; j < 2; ++j) T[row * TF_LD + wn * 64 + j * 32 + (l & 31)] = acc[i][j][rr] * sc;
        }
    __syncthreads();
}
template <typename CMAP>
__device__ __forceinline__ void store_rows_bf16(bf16* dst, int ld, int m0, CMAP cmap) {
    const bf16* T = (const bf16*)smem;
    const int tid = opaque_tid();
#pragma unroll
    for (int q = 0; q < 8; ++q) {
        int id = tid + 512 * q, row = id >> 4, ch = id & 15;
        u32x4 v = *(const u32x4*)(T + row * TB_LD + ch * 8);
        *(u32x4*)(dst + (size_t)(m0 + row) * ld + cmap(ch * 8)) = v;
    }
}
__device__ __forceinline__ void store_cols_bf16(bf16* vt, size_t crow0, int s0) {
    const unsigned short* T = (const unsigned short*)smem;
    const int tid = opaque_tid();
#pragma unroll
    for (int q = 0; q < 8; ++q) {
        int id = tid + 512 * q, c = id & 127, sg = id >> 7;
        unsigned e[8];
#pragma unroll
        for (int k = 0; k < 8; ++k) e[k] = T[(8 * sg + k) * TB_LD + c];
        u32x4 v = {e[0] | (e[1] << 16), e[2] | (e[3] << 16), e[4] | (e[5] << 16), e[6] | (e[7] << 16)};
        *(u32x4*)(vt + (crow0 + c) * SEQ + s0 + 8 * sg) = v;
    }
}
__device__ __forceinline__ void residual_store(const float* hin, float* hout, bf16* hb_out, float* gss, int m0, int n0, int nt) {
    const float* T = (const float*)smem;
    const int tid = opaque_tid(), l = tid & 63;
#pragma unroll 4
    for (int q = 0; q < 16; ++q) {
        int id = tid + 512 * q, row = id >> 5, ch = id & 31;
        f32x4 d = *(const f32x4*)(T + row * TF_LD + ch * 4);
        size_t gi = (size_t)(m0 + row) * 1024 + n0 + ch * 4;
        f32x4 h = *(const f32x4*)(hin + gi);
        f32x4 v = h + d;
        *(f32x4*)(hout + gi) = v;
        u32x2 b = {pack2(v.x, v.y), pack2(v.z, v.w)};
        *(u32x2*)(hb_out + (size_t)(m0 + row) * LDH + n0 + ch * 4) = b;
        float ss = v.x * v.x + v.y * v.y + v.z * v.z + v.w * v.w;
        ss = dpp_add<0xB1>(ss); ss = dpp_add<0x4E>(ss); ss = dpp_add<0x141>(ss); ss = dpp_add<0x140>(ss);
        ss += __shfl_xor(ss, 16);
        if ((l & 31) == 0) gss[(size_t)(m0 + row) * 8 + nt] = ss;
    }
}
struct ColAdd { int off; __device__ __forceinline__ int operator()(int c) const { return c + off; } };
struct ColHead96 { __device__ __forceinline__ int operator()(int c) const { return (c >> 6) * 96 + (c & 63); } };

struct EpiProj {
    static constexpr bool PERM = true, AFTER_DRAIN = false;
    const float* ssrow; char* ws;
    __device__ __forceinline__ void khook(int, f32x4 (&)[2][2][4][2], int, int) const {}
    __device__ __forceinline__ void operator()(const f32x4 (&acc)[2][2][4][2], const pg8::Unit& u, int wr, int wc, int fr, int fqd) const {
        asm volatile("" : "+v"(fr), "+v"(fqd));
        const int row0 = u.pm * 256 + wr * 64 + fr, lc0 = wc * 32 + 8 * fqd, pn = u.pn;
        size_t doff; int ld = 256;
        if (pn == 0) doff = OFF_FQ; else if (pn == 1) doff = OFF_FK; else if (pn == 2) doff = OFF_PART;
        else if (pn == 3) doff = OFF_SQ; else if (pn == 4) doff = OFF_SKK; else if (pn == 5) doff = OFF_PART + 8 * MBy;
        else if (pn == 6) { doff = OFF_CQ; ld = LDP; } else { doff = OFF_CKV; ld = LDC; }
        bf16* dst = (bf16*)(ws + doff);
        bf16* mk = (bf16*)(ws + OFF_MK); float* flog = (float*)(ws + OFF_FLOG); const float* cs = (const float*)(ws + OFF_CS);
#pragma unroll
        for (int ai = 0; ai < 2; ++ai)
#pragma unroll
            for (int m = 0; m < 4; ++m) {
                const int row = row0 + ai * 128 + m * 16;
                const float rs = row_rs8(ssrow, row);
#pragma unroll
                for (int bj = 0; bj < 2; ++bj) {
                    f32x4 v0 = acc[ai][bj][m][0] * rs, v1 = acc[ai][bj][m][1] * rs;
                    if (pn == 2 || pn == 5) {
                        const int c0 = bj * 128 + lc0;
                        unsigned short* vt = (unsigned short*)(ws + (pn == 2 ? OFF_FVT : OFF_SVT)) + ((size_t)((row >> 11) * 4 + (c0 >> 6)) * 64 + (c0 & 63)) * SEQ + (row & 2047);
                        const unsigned w0 = pack2(v0[0], v0[1]), w1 = pack2(v0[2], v0[3]), w2 = pack2(v1[0], v1[1]), w3 = pack2(v1[2], v1[3]);
                        vt[0 * SEQ] = (unsigned short)(w0 & 0xffffu); vt[1 * SEQ] = (unsigned short)(w0 >> 16);
                        vt[2 * SEQ] = (unsigned short)(w1 & 0xffffu); vt[3 * SEQ] = (unsigned short)(w1 >> 16);
                        vt[4 * SEQ] = (unsigned short)(w2 & 0xffffu); vt[5 * SEQ] = (unsigned short)(w2 >> 16);
                        vt[6 * SEQ] = (unsigned short)(w3 & 0xffffu); vt[7 * SEQ] = (unsigned short)(w3 >> 16);
                    } else if (pn < 7 || bj == 0) {
                        u32x4 wv = {pack2(v0[0], v0[1]), pack2(v0[2], v0[3]), pack2(v1[0], v1[1]), pack2(v1[2], v1[3])};
                        *(u32x4*)(dst + (size_t)row * ld + bj * 128 + lc0) = wv;
                    } else if (wc == 0) {
                        const int hh = fqd >> 1, pi = 8 * (fqd & 1);
                        float vv[8] = {v0[0], v0[1], v0[2], v0[3], v1[0], v1[1], v1[2], v1[3]}, ov[8];
                        const f32x4* c4 = (const f32x4*)(cs + ((size_t)row * 16 + pi) * 2);
                        f32x4 t0 = c4[0], t1 = c4[1], t2 = c4[2], t3 = c4[3];
                        float cc[8] = {t0.x, t0.z, t1.x, t1.z, t2.x, t2.z, t3.x, t3.z}, sn[8] = {t0.y, t0.w, t1.y, t1.w, t2.y, t2.w, t3.y, t3.w};
#pragma unroll
                        for (int e = 0; e < 8; ++e) {
                            float pv = __builtin_bit_cast(float, partner32(__builtin_bit_cast(int, vv[e]), hh));
                            ov[e] = hh ? (pv * sn[e] + vv[e] * cc[e]) : (vv[e] * cc[e] - pv * sn[e]);
                        }
                        u32x4 wv = {pack2(ov[0], ov[1]), pack2(ov[2], ov[3]), pack2(ov[4], ov[5]), pack2(ov[6], ov[7])};
#pragma unroll
                        for (int h = 0; h < 4; ++h) *(u32x4*)(mk + (size_t)row * 384 + h * 96 + 64 + 8 * fqd) = wv;
                    } else if (wc == 1 && fqd == 0) {
                        *(f32x4*)(flog + (size_t)row * 4) = v0;
                    }
                }
            }
    }
};
__device__ __forceinline__ void phase_proj(const Params& P, int L, int hsel, int ss_slot) {
    char* ws = opq(P.ws);
    const float* ssrow = (const float*)(ws + OFF_SSA) + (size_t)ss_slot * TOK * 8;
    const bf16* hb = (const bf16*)(ws + (hsel ? OFF_HB1 : OFF_HB0));
    const bf16* Bt = (const bf16*)(ws + OFF_WIN) + (size_t)L * 2048 * LDH;
    pg8::Gemm g{hb, Bt, LDH, LDH, TOK, 2048, 1024};
    pg8::StaticOrder S; S.init(TOK, 2048, gridDim.x, blockIdx.x);
    EpiProj E{ssrow, ws};
    pg8::gemm_phase((PG8_LAS unsigned char*)smem, g, S, E, nullptr);
    __syncthreads();
}

template <int KW>
__device__ __forceinline__ void row_rms_to_lds(const bf16* A, int lda, int m0) {
    const int tid = opaque_tid(), row = tid >> 1, half = tid & 1;
    float ss = 0.f;
    const u32x4* p = (const u32x4*)(A + (size_t)(m0 + row) * lda + half * (KW / 2));
#pragma unroll
    for (int q = 0; q < KW / 16; ++q) {
        u32x4 v = p[q];
        float a;
        a = bflo(v.x); ss += a * a; a = bfhi(v.x); ss += a * a;
        a = bflo(v.y); ss += a * a; a = bfhi(v.y); ss += a * a;
        a = bflo(v.z); ss += a * a; a = bfhi(v.z); ss += a * a;
        a = bflo(v.w); ss += a * a; a = bfhi(v.w); ss += a * a;
    }
    ss += __shfl_xor(ss, 1);
    if (half == 0) ((float*)(smem + LDS_AUX))[row] = rsqrtf(ss * (1.f / (float)KW) + EPSF);
}

__device__ __forceinline__ void phase_mla_up(const Params& P, int L) {
    char* ws = opq(P.ws);
    const bf16* cq = (const bf16*)(ws + OFF_CQ); const bf16* ckv = (const bf16*)(ws + OFF_CKV);
    const bf16* wuq = (const bf16*)(ws + OFF_WUQ) + (size_t)L * 384 * LDP;
    const bf16* wukv = (const bf16*)(ws + OFF_WUKV) + (size_t)L * 768 * LDC;
    bf16* mq = (bf16*)(ws + OFF_MQ); bf16* mk = (bf16*)(ws + OFF_MK); bf16* mvt = (bf16*)(ws + OFF_MVT);
    const float* cs = (const float*)(ws + OFF_CS);
    const float* flog = (const float*)(ws + OFF_FLOG);
    float* cumF = (float*)(ws + OFF_CUMF);
    const int tid = opaque_tid(), w = tid >> 6, l = tid & 63, hh = l >> 5, wm = w >> 1, wn = w & 1;
    const int NQ = 64 * 3, NKV = 64 * 6, NCF = 8;
    const float* aux = (const float*)(smem + LDS_AUX);
    const bool deal = (gridDim.x == 256);
    const int nslot = deal ? 4 : (NQ + NKV + NCF + (int)gridDim.x - 1) / (int)gridDim.x;
    for (int slot = 0; slot < nslot; ++slot) {
        int item;
        if (deal) {
            const int bx = blockIdx.x;
            if (bx < 192) item = (slot == 0) ? bx : (slot == 1) ? (NQ + bx) : (slot == 2 && bx < NCF) ? (NQ + NKV + bx) : -1;
            else item = (slot < 3) ? (NQ + 192 + 3 * (bx - 192) + slot) : -1;
        } else {
            item = blockIdx.x + slot * gridDim.x;
            if (item >= NQ + NKV + NCF) item = -1;
        }
        if (item < 0) continue;
        if (item < NQ) {
            int mt = item / 3, nt = item % 3;
            int m0 = mt * 256, n0 = nt * 128;
            __syncthreads();
            f32x16 acc[2][2];
            ZERO_ACC(acc);
            float ssq[2] = {0.f, 0.f};
            gemm_core(acc, cq, LDP, wuq, LDP, 256, m0, n0, SsqHook(), ssq);
#pragma unroll
            for (int i = 0; i < 2; ++i) {
                const float st = ssq[i] + __shfl_xor(ssq[i], 32);
                ((float*)(smem + LDS_AUX))[wm * 64 + i * 32 + (l & 31)] = rsqrtf(st * (1.f / 256.f) + EPSF);
            }
#pragma unroll
            for (int i = 0; i < 2; ++i)
#pragma unroll
                for (int j = 0; j < 2; ++j) {
                    int c0 = n0 + wn * 64 + j * 32;
                    int rloc = wm * 64 + i * 32 + 4 * hh;
                    bool rot = (c0 % 96) == 64;
                    int ci = l & 31, pi = ci & 15;
#pragma unroll
                    for (int rr = 0; rr < 16; ++rr) {
                        int rl = rloc + (rr & 3) + 8 * (rr >> 2);
                        float v = acc[i][j][rr] * (aux[rl] * (0.10206207261596577f * LOG2E));
                        if (rot) {
                            float pv = __shfl_xor(v, 16);
                            float2 c_s = *(const float2*)(cs + ((size_t)(m0 + rl) * 16 + pi) * 2);
                            v = (ci < 16) ? (v * c_s.x - pv * c_s.y) : (pv * c_s.y + v * c_s.x);
                        }
                        acc[i][j][rr] = v;
                    }
                }
            stage_bf16<false>(acc, nullptr);
            store_rows_bf16(mq, 384, m0, ColAdd{n0});
        } else if (item < NQ + NKV) {
            int it2 = item - NQ;
            int mt = it2 / 6, nt = it2 % 6;
            int m0 = mt * 256, n0 = nt * 128;
            __syncthreads();
            f32x16 acc[2][2];
            ZERO_ACC(acc);
            float ssq[2] = {0.f, 0.f};
            gemm_core(acc, ckv, LDC, wukv, LDC, 128, m0, n0, SsqHook(), ssq);
#pragma unroll
            for (int i = 0; i < 2; ++i) {
                const float st = ssq[i] + __shfl_xor(ssq[i], 32);
                ((float*)(smem + LDS_AUX))[wm * 64 + i * 32 + (l & 31)] = rsqrtf(st * (1.f / 128.f) + EPSF);
            }
            stage_bf16<true>(acc, aux);
            if (nt < 2) {
                const int nb0 = n0;
                struct CM { int n0; __device__ __forceinline__ int operator()(int c) const { int col = n0 + c; return (col >> 6) * 96 + (col & 63); } };
                store_rows_bf16(mk, 384, m0, CM{nb0});
            } else {
                store_cols_bf16(mvt, (size_t)(m0 >> 11) * 512 + (n0 - 256), m0 & 2047);
            }
        } else {
            const int b = item - NQ - NKV;
            f32x4 zz[4];
#pragma unroll
            for (int i = 0; i < 4; ++i) zz[i] = *(const f32x4*)(flog + ((size_t)b * SEQ + tid * 4 + i) * 4);
            const f32x4 bf4 = *(const f32x4*)(P.b_forget + L * 4);
            float run[4] = {0.f, 0.f, 0.f, 0.f};
            float vals[4][4];
#pragma unroll
            for (int i = 0; i < 4; ++i)
#pragma unroll
                for (int hd = 0; hd < 4; ++hd) { run[hd] += log_sigmoid_f(zz[i][hd] + bf4[hd]); vals[i][hd] = run[hd]; }
            float* wtot = (float*)(smem + LDS_AUX) + 1024;
            float excl[4];
#pragma unroll
            for (int hd = 0; hd < 4; ++hd) {
                float incl = run[hd];
#pragma unroll
                for (int o = 1; o < 64; o <<= 1) {
                    float t = __shfl_up(incl, o);
                    if (l >= o) incl += t;
                }
                excl[hd] = incl - run[hd];
                if (l == 63) wtot[w * 4 + hd] = incl;
            }
            __syncthreads();
#pragma unroll
            for (int hd = 0; hd < 4; ++hd) {
                float pre = 0.f;
                for (int ww = 0; ww < 8; ++ww) pre += (ww < w) ? wtot[ww * 4 + hd] : 0.f;
                const f32x4 o4 = {vals[0][hd] + excl[hd] + pre, vals[1][hd] + excl[hd] + pre, vals[2][hd] + excl[hd] + pre, vals[3][hd] + excl[hd] + pre};
                *(f32x4*)(cumF + (size_t)(b * 4 + hd) * SEQ + tid * 4) = o4;
            }
            __syncthreads();
        }
    }
}

template <int MODE, int DK, int DV>
__device__ __forceinline__ void attn_item(const bf16* __restrict__ Q, int ldq, const bf16* __restrict__ Kg, int ldk,
                          const bf16* __restrict__ Vt, const float* __restrict__ cumF, bf16* __restrict__ Y,
                          float* __restrict__ ssy, int b, int h, int qb, float c1, char* lds, int fake = 0) {
    constexpr int KSTR = DK * 2 + 16;
    constexpr int VSTR = 144;
    constexpr int KBYTES = 64 * KSTR, VBYTES = DV * VSTR;
    constexpr int BUF = (KBYTES + VBYTES + 256 + 255) & ~255;
    static_assert(2 * BUF <= 65536, "lds");
    constexpr int KCH = DK / 8, KPT = (64 * KCH) / 256, VPT = (DV * 8) / 256;
    const int tid = opaque_tid() & 255, w = tid >> 6, l = tid & 63, r = l & 31, hh = l >> 5;
    const int q0 = qb * 128;
    const int qrow = q0 + 32 * w + r;
    const size_t tok = (size_t)b * SEQ + qrow;
    const int bh = b * 4 + h;
    bf16x8 qf[DK / 16];
#pragma unroll
    for (int s = 0; s < DK / 16; ++s) qf[s] = *(const bf16x8*)(Q + tok * ldq + h * DK + 16 * s + 8 * hh);
    f32x16 o[DV / 32];
    const f32x16 zero16 = {0.f, 0.f, 0.f, 0.f, 0.f, 0.f, 0.f, 0.f, 0.f, 0.f, 0.f, 0.f, 0.f, 0.f, 0.f, 0.f};
#pragma unroll
    for (int d = 0; d < DV / 32; ++d) o[d] = zero16;
    float m = -1e30f, lsum = 0.f, R = 0.f;
    bool sbdead = false;
    int* dmask = (int*)(smem + LDS_BYTES - 32);
    float Fq = 0.f;
    if (MODE == 0) Fq = cumF[(size_t)bh * SEQ + qrow] * LOG2E;
    const int nkt = (q0 + 128) >> 6;
    u32x4 kregA[KPT], vregA[VPT], kregB[KPT], vregB[VPT];
    float4 fregA = {0.f, 0.f, 0.f, 0.f}, fregB = {0.f, 0.f, 0.f, 0.f};
    auto gload = [&](int kt, u32x4 (&kreg)[KPT], u32x4 (&vreg)[VPT], float4& freg) {
#pragma unroll
        for (int i = 0; i < KPT; ++i) {
            int e = tid + 256 * i;
            int row = e / KCH, ch = e % KCH;
            kreg[i] = *(const u32x4*)(Kg + ((size_t)b * SEQ + kt * 64 + row) * ldk + h * DK + ch * 8);
        }
#pragma unroll
        for (int i = 0; i < VPT; ++i) {
            int e = tid + 256 * i;
            int row = e >> 3, ch = e & 7;
            vreg[i] = *(const u32x4*)(Vt + ((size_t)bh * DV + row) * SEQ + kt * 64 + ch * 8);
        }
        if (MODE == 0 && tid < 16) freg = *(const float4*)(cumF + (size_t)bh * SEQ + kt * 64 + tid * 4);
    };
    auto lwrite = [&](int buf, u32x4 (&kreg)[KPT], u32x4 (&vreg)[VPT], float4& freg) {
        char* base = lds + buf * BUF;
#pragma unroll
        for (int i = 0; i < KPT; ++i) {
            int e = tid + 256 * i;
            int row = e / KCH, ch = e % KCH;
            *(u32x4*)(base + row * KSTR + ch * 16) = kreg[i];
        }
#pragma unroll
        for (int i = 0; i < VPT; ++i) {
            int e = tid + 256 * i;
            int row = e >> 3, ch = e & 7;
            *(u32x4*)(base + KBYTES + row * VSTR + ch * 16) = vreg[i];
        }
        if (MODE == 0 && tid < 16) { float4 fn = {-freg.x * LOG2E, -freg.y * LOG2E, -freg.z * LOG2E, -freg.w * LOG2E}; *(float4*)(base + KBYTES + VBYTES + tid * 16) = fn; }
    };
    const int prow = (r & 0x13) | ((r & 4) << 1) | ((r & 8) >> 1);
    auto ktof = [&](int it) { return (MODE == 1) ? (nkt - 1 - it) : it; };
    gload(ktof(0), kregA, vregA, fregA);
    lwrite(0, kregA, vregA, fregA);
    constexpr bool D2 = (MODE != 2);
    if (D2 && nkt > 1) gload(ktof(1), kregB, vregB, fregB);
    __syncthreads();
    auto tile = [&](int it, u32x4 (&kn)[KPT], u32x4 (&vn)[VPT], float4& fn2, u32x4 (&kf)[KPT], u32x4 (&vf2)[VPT], float4& ff) {
        const int kt = ktof(it);
        if (!(fake & 1)) {
        if (D2) { if (it + 2 < nkt) gload(ktof(it + 2), kf, vf2, ff); }
        else { if (it + 1 < nkt) gload(ktof(it + 1), kf, vf2, ff); }
        }
        const char* base = lds + (it & 1) * BUF;
        bool active = (kt * 64) <= (q0 + 32 * w + 31);
        if (MODE == 1) {
            if (sbdead) { active = false; atomicOr(&dmask[it & 1], 1 << (opaque_tid() >> 6)); }
        }
        if (active) {
            const bool needmask = (kt * 64 + 63) >= (q0 + 32 * w);
            f32x16 s[2];
#pragma unroll
            for (int sub = 0; sub < 2; ++sub) {
                s[sub] = zero16;
#pragma unroll
                for (int ks = 0; ks < DK / 16; ++ks) {
                    bf16x8 kf = *(const bf16x8*)(base + (sub * 32 + prow) * KSTR + (2 * ks + hh) * 16);
                    s[sub] = __builtin_amdgcn_mfma_f32_32x32x16_bf16(kf, qf[ks], s[sub], 0, 0, 0);
                }
            }
            bf16x8 pf[2][2];
            if (fake & 2) {
#pragma unroll
                for (int sub = 0; sub < 2; ++sub)
#pragma unroll
                    for (int a = 0; a < 2; ++a) {
                        uint4 u;
                        u.x = pack2(s[sub][8 * a], s[sub][8 * a + 1]); u.y = pack2(s[sub][8 * a + 2], s[sub][8 * a + 3]);
                        u.z = pack2(s[sub][8 * a + 4], s[sub][8 * a + 5]); u.w = pack2(s[sub][8 * a + 6], s[sub][8 * a + 7]);
                        pf[sub][a] = __builtin_bit_cast(bf16x8, u);
                    }
                lsum = 1.f;
            } else if (MODE != 1) {
                const float* Ft = (const float*)(base + KBYTES + VBYTES);
                float mx = -INFINITY;
                float tv[2][16];
#pragma unroll
                for (int sub = 0; sub < 2; ++sub)
#pragma unroll
                    for (int a = 0; a < 2; ++a) {
                        int kofs = sub * 32 + 16 * a + 8 * hh;
                        float fk[8];
                        if (MODE == 0) {
                            float4 f0 = *(const float4*)(Ft + kofs), f1 = *(const float4*)(Ft + kofs + 4);
                            fk[0] = f0.x; fk[1] = f0.y; fk[2] = f0.z; fk[3] = f0.w; fk[4] = f1.x; fk[5] = f1.y; fk[6] = f1.z; fk[7] = f1.w;
                        }
#pragma unroll
                        for (int j = 0; j < 8; ++j) {
                            int rr = 8 * a + j;
                            float v = (MODE == 0) ? fmaf(s[sub][rr], c1, fk[j]) : s[sub][rr] * c1;
                            tv[sub][rr] = v;
                        }
                    }
                if (needmask) {
#pragma unroll
                    for (int sub = 0; sub < 2; ++sub)
#pragma unroll
                        for (int rr = 0; rr < 16; ++rr) {
                            int key = kt * 64 + sub * 32 + 16 * (rr >> 3) + 8 * hh + (rr & 7);
                            if (key > qrow) tv[sub][rr] = -INFINITY;
                        }
                }
#pragma unroll
                for (int sub = 0; sub < 2; ++sub)
#pragma unroll
                    for (int rr = 0; rr < 16; ++rr) mx = fmaxf(mx, tv[sub][rr]);
                mx = fmaxf(mx, __builtin_bit_cast(float, partner32(__builtin_bit_cast(int, mx), hh)));
                float mnew = fmaxf(m, mx);
                float rsum = 0.f;
#pragma unroll
                for (int sub = 0; sub < 2; ++sub)
#pragma unroll
                    for (int a = 0; a < 2; ++a) {
                        float pv[8];
#pragma unroll
                        for (int j = 0; j < 8; ++j) { pv[j] = fexp2(tv[sub][8 * a + j] - mnew); rsum += pv[j]; }
                        uint4 u;
                        u.x = pack2(pv[0], pv[1]); u.y = pack2(pv[2], pv[3]); u.z = pack2(pv[4], pv[5]); u.w = pack2(pv[6], pv[7]);
                        pf[sub][a] = __builtin_bit_cast(bf16x8, u);
                    }
                rsum += __builtin_bit_cast(float, partner32(__builtin_bit_cast(int, rsum), hh));
                if (__builtin_amdgcn_ballot_w64(mnew != m) != 0ull) {
                    float alpha = fexp2(m - mnew);
                    lsum *= alpha;
#pragma unroll
                    for (int d = 0; d < DV / 32; ++d) o[d] = o[d] * alpha;
                    m = mnew;
                }
                lsum += rsum;
            } else {
#pragma unroll
                for (int sb = 0; sb < 2; ++sb) {
                    const int sub = 1 - sb;
                    float lsig[16], lneg[16];
                    float A0 = 0.f, A1 = 0.f;
#pragma unroll
                    for (int rr = 0; rr < 16; ++rr) {
                        int key = kt * 64 + sub * 32 + 16 * (rr >> 3) + 8 * hh + (rr & 7);
                        bool valid = key < qrow;
                        float z = s[sub][rr] * c1;
                        float e = fexp2(-fabsf(z));
                        float l1p = flog2(1.f + e);
                        float ls = fminf(z, 0.f) - l1p;
                        float ln = valid ? (ls - z) : 0.f;
                        lsig[rr] = valid ? ls : -INFINITY;
                        lneg[rr] = ln;
                        if (rr < 8) A0 += ln; else A1 += ln;
                    }
                    float B0 = __shfl_xor(A0, 32), B1 = __shfl_xor(A1, 32);
                    float base1 = (hh == 0) ? (R + B1) : R;
                    float base0 = (hh == 0) ? (R + B1 + A1 + B0) : (R + A1 + B1);
                    float wv[16];
                    float run = base1;
#pragma unroll
                    for (int j = 7; j >= 0; --j) { wv[8 + j] = fexp2(lsig[8 + j] + run); run += lneg[8 + j]; }
                    run = base0;
#pragma unroll
                    for (int j = 7; j >= 0; --j) { wv[j] = fexp2(lsig[j] + run); run += lneg[j]; }
                    R += A0 + A1 + B0 + B1;
#pragma unroll
                    for (int a = 0; a < 2; ++a) {
                        uint4 u;
                        u.x = pack2(wv[8 * a], wv[8 * a + 1]); u.y = pack2(wv[8 * a + 2], wv[8 * a + 3]);
                        u.z = pack2(wv[8 * a + 4], wv[8 * a + 5]); u.w = pack2(wv[8 * a + 6], wv[8 * a + 7]);
                        pf[sub][a] = __builtin_bit_cast(bf16x8, u);
                    }
                }
            }
            if (MODE == 1) {
                if (__builtin_amdgcn_ballot_w64(R > -150.f) == 0ull) { sbdead = true; atomicOr(&dmask[it & 1], 1 << (opaque_tid() >> 6)); }
            }
#pragma unroll
            for (int d = 0; d < DV / 32; ++d)
#pragma unroll
                for (int sub = 0; sub < 2; ++sub)
#pragma unroll
                    for (int a = 0; a < 2; ++a) {
                        bf16x8 vf = *(const bf16x8*)(base + KBYTES + (d * 32 + r) * VSTR + (sub * 32 + 16 * a + 8 * hh) * 2);
                        o[d] = __builtin_amdgcn_mfma_f32_32x32x16_bf16(vf, pf[sub][a], o[d], 0, 0, 0);
                    }
        }
        if (!(fake & 1)) { if (it + 1 < nkt) lwrite((it + 1) & 1, kn, vn, fn2); }
        __syncthreads();
    };
    if (D2) {
        for (int it = 0; it < nkt; it += 2) {
            if (MODE == 1 && it > 0 && ((volatile int*)dmask)[(it - 1) & 1] == 0xFF) break;
            tile(it, kregB, vregB, fregB, kregA, vregA, fregA);
            if (it + 1 < nkt) {
                if (MODE == 1 && ((volatile int*)dmask)[it & 1] == 0xFF) break;
                tile(it + 1, kregA, vregA, fregA, kregB, vregB, fregB);
            }
        }
    } else {
        for (int it = 0; it < nkt; ++it) tile(it, kregA, vregA, fregA, kregA, vregA, fregA);
    }
    float inv = (MODE == 1) ? 1.f : (1.f / lsum);
    float ssq = 0.f;
#pragma unroll
    for (int d = 0; d < DV / 32; ++d)
#pragma unroll
        for (int g = 0; g < 4; ++g) {
            float v0 = o[d][4 * g] * inv, v1 = o[d][4 * g + 1] * inv, v2 = o[d][4 * g + 2] * inv, v3 = o[d][4 * g + 3] * inv;
            ssq += v0 * v0 + v1 * v1 + v2 * v2 + v3 * v3;
            uint2 u; u.x = pack2(v0, v1); u.y = pack2(v2, v3);
            *(uint2*)(Y + tok * LDH + h * DV + d * 32 + 8 * g + 4 * hh) = u;
        }
    ssq += __shfl_xor(ssq, 32);
    if (hh == 0) ssy[tok * 16 + h] = ssq;
}

__device__ __forceinline__ void phase_attn(const Params& P, int L, int rep = 0, int fake = 0) {
    char* ws = opq(P.ws);
    int* cnt = (int*)(ws + OFF_CNT) + L * 64 + rep * 16;
    int* s_item = (int*)(smem + LDS_BYTES - 16);
    const float* cumF = (const float*)(ws + OFF_CUMF);
    bf16* Y = (bf16*)(ws + (fake ? OFF_PART : OFF_Y));
    float* ssy = fake ? (float*)(ws + OFF_PART + 40 * MBy) : (float*)(ws + OFF_SSY) + (size_t)L * TOK * 16;
    const int half = opaque_tid() >> 8;
    char* lds = smem + half * 65536;
    for (;;) {
        if (opaque_tid() == 0) { int z0 = 0; asm volatile("" : "+v"(z0)); *s_item = atomicAdd(cnt, 1); s_item[-4] = z0; s_item[-3] = z0; }
        __syncthreads();
        int pair = *s_item;
        __syncthreads();
        if (pair >= 768) break;
        int item = pair * 2 + half;
        int qb, type, bh;
        if (item < 1024) { qb = 15 - (item >> 6); type = (item & 32) ? 2 : 0; bh = item & 31; }
        else { const int j2 = item - 1024; qb = 15 - (j2 >> 5); type = 1; bh = j2 & 31; }
        int b = bh >> 2, h = bh & 3;
        if (type == 0) {
            attn_item<2, 96, 128>((const bf16*)(ws + OFF_MQ), 384, (const bf16*)(ws + OFF_MK), 384, (const bf16*)(ws + OFF_MVT), cumF,
                                  Y + 512, ssy + 8, b, h, qb, 1.0f, lds, fake);
        } else if (type == 1) {
            attn_item<1, 64, 64>((const bf16*)(ws + OFF_SQ), 256, (const bf16*)(ws + OFF_SKK), 256, (const bf16*)(ws + OFF_SVT), cumF,
                                 Y + 256, ssy + 4, b, h, qb, 0.125f * LOG2E, lds, fake);
        } else {
            attn_item<0, 64, 64>((const bf16*)(ws + OFF_FQ), 256, (const bf16*)(ws + OFF_FK), 256, (const bf16*)(ws + OFF_FVT), cumF,
                                 Y + 0, ssy + 0, b, h, qb, 0.125f * LOG2E, lds, fake);
        }
    }
}

__device__ __forceinline__ void rowss_flush(float (&part)[2][16], float* gss, int m0, int nt) {
    float* lss = (float*)smem;
    const int tid = opaque_tid(), w = tid >> 6, l = tid & 63, hh = l >> 5, wm = w >> 1, wn = w & 1;
#pragma unroll
    for (int i = 0; i < 2; ++i)
#pragma unroll
        for (int rr = 0; rr < 16; ++rr) {
            float v = part[i][rr];
            v = dpp_add<0xB1>(v); v = dpp_add<0x4E>(v); v = dpp_add<0x141>(v); v = dpp_add<0x140>(v);
            v += __shfl_xor(v, 16);
            if ((l & 31) == 0) lss[wn * 256 + wm * 64 + i * 32 + (rr & 3) + 8 * (rr >> 2) + 4 * hh] = v;
        }
    __syncthreads();
    if (tid < 256) gss[(size_t)(m0 + tid) * 8 + nt] = lss[tid] + lss[256 + tid];
    __syncthreads();
}

__device__ __forceinline__ float sum_fq(float v) {
    float a = v, b = v;
    asm volatile("s_nop 1\n\tv_permlane16_swap_b32 %0, %1\n\ts_nop 1" : "+v"(a), "+v"(b));
    v = a + b; a = v; b = v;
    asm volatile("s_nop 1\n\tv_permlane32_swap_b32 %0, %1\n\ts_nop 1" : "+v"(a), "+v"(b));
    return a + b;
}
template <bool SIG, bool XQ>
__device__ __forceinline__ void residual_fused(const f32x4 (&acc)[2][2][4][2], const pg8::Unit& u, int wr, int wc, int fr, int fqd,
                                               const float* rowscale  , const bf16* gate  ,
                                               const bf16* hb_in, bf16* hb_out, float* gss, unsigned char* xq = nullptr) {
    float* lss = (float*)smem;
#pragma unroll
    for (int ai = 0; ai < 2; ++ai)
#pragma unroll
        for (int m = 0; m < 4; ++m) {
            const int rl = 128 * ai + 64 * wr + 16 * m + fr, row = u.pm * 256 + rl;
            const float sc = rowscale ? rowscale[rl] : 1.f;
#pragma unroll
            for (int bj = 0; bj < 2; ++bj) {
                const int col = u.pn * 256 + 128 * bj + 32 * wc + 8 * fqd;
                const u32x4 hq = *(const u32x4*)(hb_in + (size_t)row * LDH + col);
                const f32x4 hp0 = {bflo(hq.x), bfhi(hq.x), bflo(hq.y), bfhi(hq.y)}, hp1 = {bflo(hq.z), bfhi(hq.z), bflo(hq.w), bfhi(hq.w)};
                f32x4 d0 = acc[ai][bj][m][0] * sc, d1 = acc[ai][bj][m][1] * sc;
                if (SIG) {
#pragma unroll
                    for (int e = 0; e < 4; ++e) {
                        d0[e] = __builtin_amdgcn_rcpf(1.f + fexp2(-LOG2E * d0[e]));
                        d1[e] = __builtin_amdgcn_rcpf(1.f + fexp2(-LOG2E * d1[e]));
                    }
                }
                if (gate) {
                    u32x4 gq = *(const u32x4*)(gate + (size_t)row * 1024 + col);
                    f32x4 g0 = {bflo(gq.x), bfhi(gq.x), bflo(gq.y), bfhi(gq.y)}, g1 = {bflo(gq.z), bfhi(gq.z), bflo(gq.w), bfhi(gq.w)};
                    d0 = d0 * g0; d1 = d1 * g1;
                }
                f32x4 v0 = hp0 + d0, v1 = hp1 + d1;
                u32x4 wv = {pack2(v0[0], v0[1]), pack2(v0[2], v0[3]), pack2(v1[0], v1[1]), pack2(v1[2], v1[3])};
                *(u32x4*)(hb_out + (size_t)row * LDH + col) = wv;
                if (XQ) {
                    f32x4 c0, c1;
#pragma unroll
                    for (int e = 0; e < 4; ++e) { c0[e] = __builtin_amdgcn_fmed3f(v0[e], -448.f, 448.f); c1[e] = __builtin_amdgcn_fmed3f(v1[e], -448.f, 448.f); }
                    int h0 = __builtin_amdgcn_cvt_pk_fp8_f32(c0[0], c0[1], 0, false); h0 = __builtin_amdgcn_cvt_pk_fp8_f32(c0[2], c0[3], h0, true);
                    int h1 = __builtin_amdgcn_cvt_pk_fp8_f32(c1[0], c1[1], 0, false); h1 = __builtin_amdgcn_cvt_pk_fp8_f32(c1[2], c1[3], h1, true);
                    const f32x2 b0 = __builtin_amdgcn_cvt_pk_f32_fp8(h0, false), b1 = __builtin_amdgcn_cvt_pk_f32_fp8(h0, true);
                    const f32x2 b2 = __builtin_amdgcn_cvt_pk_f32_fp8(h1, false), b3 = __builtin_amdgcn_cvt_pk_f32_fp8(h1, true);
                    int l0 = __builtin_amdgcn_cvt_pk_fp8_f32((c0[0] - b0.x) * 16.f, (c0[1] - b0.y) * 16.f, 0, false);
                    l0 = __builtin_amdgcn_cvt_pk_fp8_f32((c0[2] - b1.x) * 16.f, (c0[3] - b1.y) * 16.f, l0, true);
                    int l1 = __builtin_amdgcn_cvt_pk_fp8_f32((c1[0] - b2.x) * 16.f, (c1[1] - b2.y) * 16.f, 0, false);
                    l1 = __builtin_amdgcn_cvt_pk_fp8_f32((c1[2] - b3.x) * 16.f, (c1[3] - b3.y) * 16.f, l1, true);
                    u32x2 hh = {(unsigned)h0, (unsigned)h1}, ll = {(unsigned)l0, (unsigned)l1};
                    *(u32x2*)(xq + (size_t)row * 1024 + col) = hh;
                    *(u32x2*)(xq + 16 * MBy + (size_t)row * 1024 + col) = ll;
                }
                float ss = (v0[0] * v0[0] + v0[1] * v0[1]) + (v0[2] * v0[2] + v0[3] * v0[3]) + (v1[0] * v1[0] + v1[1] * v1[1]) + (v1[2] * v1[2] + v1[3] * v1[3]);
                ss = sum_fq(ss);
                if (fqd == 0) lss[(wc * 256 + rl) * 2 + bj] = ss;
            }
        }
    __syncthreads();
    const int tid = opaque_tid();
    if (tid < 256) {
        const int row = u.pm * 256 + tid;
#pragma unroll
        for (int bj = 0; bj < 2; ++bj)
            gss[(size_t)row * 8 + u.pn * 2 + bj] = (lss[(0 * 256 + tid) * 2 + bj] + lss[(1 * 256 + tid) * 2 + bj]) + (lss[(2 * 256 + tid) * 2 + bj] + lss[(3 * 256 + tid) * 2 + bj]);
    }
    __syncthreads();
}
struct EpiWo {
    static constexpr bool PERM = true, AFTER_DRAIN = true;
    const bf16* hb_in; bf16* hb_out; float* gss; unsigned char* xq;
    __device__ __forceinline__ void khook(int t, f32x4 (&acc)[2][2][4][2], int wr, int fr) const {
        if (t == 4 || t == 8) {
            const float* fac = (const float*)(smem + LDS_AUX) + (t == 4 ? 0 : 256);
#pragma unroll
            for (int ai = 0; ai < 2; ++ai)
#pragma unroll
                for (int m = 0; m < 4; ++m) {
                    const float f = fac[128 * ai + 64 * wr + 16 * m + fr];
#pragma unroll
                    for (int bj = 0; bj < 2; ++bj) { acc[ai][bj][m][0] *= f; acc[ai][bj][m][1] *= f; }
                }
        }
    }
    __device__ __forceinline__ void operator()(const f32x4 (&)[2][2][4][2], const pg8::Unit&, int, int, int, int) const {}
    __device__ __forceinline__ void fused(const f32x4 (&acc)[2][2][4][2], const pg8::Unit& u, int wr, int wc, int fr, int fqd, PG8_LAS unsigned char*, int, int) const {
        residual_fused<false, true>(acc, u, wr, wc, fr, fqd, (const float*)(smem + LDS_AUX) + 512, nullptr, hb_in, hb_out, gss, xq);
    }
};
__device__ __forceinline__ void phase_wo(const Params& P, int L, int hsel, int ss_slot) {
    char* ws = opq(P.ws);
    float* ss_out = (float*)(ws + OFF_SSA) + (size_t)ss_slot * TOK * 8;
    bf16* hb_out = (bf16*)(ws + (hsel ? OFF_HB1 : OFF_HB0));
    const bf16* hb_in = (const bf16*)(ws + (hsel ? OFF_HB0 : OFF_HB1));
    const bf16* Y = (const bf16*)(ws + OFF_Y);
    const bf16* Bt = (const bf16*)(ws + OFF_WO) + (size_t)L * 1024 * LDH;
    const float* ssy = (const float*)(ws + OFF_SSY) + (size_t)L * TOK * 16;
    float* aux = (float*)(smem + LDS_AUX);
    const int tid = opaque_tid();
    pg8::Gemm g{Y, Bt, LDH, LDH, TOK, 1024, 1024};
    pg8::StaticOrder S; S.init(TOK, 1024, gridDim.x, blockIdx.x);
    pg8::Unit u0;
    if (S.next(0, u0) && tid < 256) {
        int row = u0.pm * 256 + tid;
        float4 v0 = *(const float4*)(ssy + (size_t)row * 16), v1 = *(const float4*)(ssy + (size_t)row * 16 + 4), v2 = *(const float4*)(ssy + (size_t)row * 16 + 8);
        float r0 = rsqrtf(((v0.x + v0.y) + (v0.z + v0.w)) * (1.f / 256.f) + EPSF);
        float r1 = rsqrtf(((v1.x + v1.y) + (v1.z + v1.w)) * (1.f / 256.f) + EPSF);
        float r2 = rsqrtf(((v2.x + v2.y) + (v2.z + v2.w)) * (1.f / 512.f) + EPSF);
        aux[tid] = r0 / r1; aux[256 + tid] = r1 / r2; aux[512 + tid] = r2;
    }
    __syncthreads();
    EpiWo E{hb_in, hb_out, ss_out, (unsigned char*)(ws + OFF_XH)};
    pg8::gemm_phase((PG8_LAS unsigned char*)smem, g, S, E, nullptr);
    __syncthreads();
}

struct EpiPq {
    static constexpr bool PERM = true, AFTER_DRAIN = false;
    bf16* O; const float* ssrow;
    __device__ __forceinline__ void khook(int, f32x4 (&)[2][2][4][2], int, int) const {}
    __device__ __forceinline__ void operator()(const f32x4 (&acc)[2][2][4][2], const pg8::Unit& u, int wr, int wc, int fr, int fq) const {
        const int row0 = u.pm * 256 + wr * 64 + fr, col0 = u.pn * 256 + wc * 32 + 8 * fq;
#pragma unroll
        for (int ai = 0; ai < 2; ++ai)
#pragma unroll
            for (int m = 0; m < 4; ++m) {
                const int row = row0 + ai * 128 + m * 16;
                const float rs = row_rs8(ssrow, row);
                bf16* rowp = O + (size_t)row * 1024 + col0;
#pragma unroll
                for (int bj = 0; bj < 2; ++bj) {
                    f32x4 v0 = acc[ai][bj][m][0] * rs, v1 = acc[ai][bj][m][1] * rs;
                    u32x4 wv = {pack2(v0[0], v0[1]), pack2(v0[2], v0[3]), pack2(v1[0], v1[1]), pack2(v1[2], v1[3])};
                    *(u32x4*)(rowp + bj * 128) = wv;
                }
            }
    }
};
__device__ __forceinline__ void topk_task(const Params& P, int L, int t0, int h);
__device__ __forceinline__ void phase_pq(const Params& P, int L, int hsel, int ss_slot) {
    char* ws = opq(P.ws);
    const float* ssrow = (const float*)(ws + OFF_SSA) + (size_t)ss_slot * TOK * 8;
    const bf16* hb = (const bf16*)(ws + (hsel ? OFF_HB1 : OFF_HB0));
    const bf16* Bt = (const bf16*)(ws + OFF_WQ) + (size_t)L * 1024 * LDH;
    pg8::Gemm g{hb, Bt, LDH, LDH, TOK, 1024, 1024};
    pg8::StaticOrder S; S.init(TOK, 1024, gridDim.x, blockIdx.x);
    EpiPq E{(bf16*)(ws + OFF_PQ), ssrow};
    pg8::gemm_phase((PG8_LAS unsigned char*)smem, g, S, E, nullptr);
    asm volatile("s_waitcnt vmcnt(0)" ::: "memory");
    __syncthreads();
    const int w = opaque_tid() >> 6;
    pg8::Unit u;
    for (int i = 0; S.next(i, u); ++i)
        for (int q = 0; q < 2; ++q) topk_task(P, L, u.pm * 256 + 32 * w, 2 * u.pn + q);
    __syncthreads();
}

__device__ __forceinline__ void cswap(int& a, int& b) { int mx = max(a, b), mn = min(a, b); a = mx; b = mn; }
__device__ __forceinline__ void bitonic_sort16(int (&v)[16]) {
    cswap(v[0], v[1]); cswap(v[2], v[3]); cswap(v[0], v[2]); cswap(v[1], v[3]); cswap(v[1], v[2]); cswap(v[4], v[5]); cswap(v[6], v[7]); cswap(v[4], v[6]);
    cswap(v[5], v[7]); cswap(v[5], v[6]); cswap(v[0], v[4]); cswap(v[2], v[6]); cswap(v[2], v[4]); cswap(v[1], v[5]); cswap(v[3], v[7]); cswap(v[3], v[5]);
    cswap(v[1], v[2]); cswap(v[3], v[4]); cswap(v[5], v[6]); cswap(v[8], v[9]); cswap(v[10], v[11]); cswap(v[8], v[10]); cswap(v[9], v[11]); cswap(v[9], v[10]);
    cswap(v[12], v[13]); cswap(v[14], v[15]); cswap(v[12], v[14]); cswap(v[13], v[15]); cswap(v[13], v[14]); cswap(v[8], v[12]); cswap(v[10], v[14]); cswap(v[10], v[12]);
    cswap(v[9], v[13]); cswap(v[11], v[15]); cswap(v[11], v[13]); cswap(v[9], v[10]); cswap(v[11], v[12]); cswap(v[13], v[14]); cswap(v[0], v[8]); cswap(v[4], v[12]);
    cswap(v[4], v[8]); cswap(v[2], v[10]); cswap(v[6], v[14]); cswap(v[6], v[10]); cswap(v[2], v[4]); cswap(v[6], v[8]); cswap(v[10], v[12]); cswap(v[1], v[9]);
    cswap(v[5], v[13]); cswap(v[5], v[9]); cswap(v[3], v[11]); cswap(v[7], v[15]); cswap(v[7], v[11]); cswap(v[3], v[5]); cswap(v[7], v[9]); cswap(v[11], v[13]);
    cswap(v[1], v[2]); cswap(v[3], v[4]); cswap(v[5], v[6]); cswap(v[7], v[8]); cswap(v[9], v[10]); cswap(v[11], v[12]); cswap(v[13], v[14]);
}
__device__ __forceinline__ void merge_top16(int (&Lv)[16], const int (&Rv)[16]) {
#pragma unroll
    for (int i = 0; i < 16; ++i) Lv[i] = max(Lv[i], Rv[15 - i]);
#pragma unroll
    for (int j = 8; j > 0; j >>= 1)
#pragma unroll
        for (int i = 0; i < 16; ++i) {
            int q = i ^ j;
            if (q > i) cswap(Lv[i], Lv[q]);
        }
}
__device__ __forceinline__ int f2key(float v, int low, int mask) {
    int b = __float_as_int(v);
    b ^= (b >> 31) & 0x7fffffff;
    return (b & ~mask) | low;
}
__device__ __forceinline__ float key2f(int k, int mask) {
    int b = k & ~mask;
    b ^= (b >> 31) & 0x7fffffff;
    return __int_as_float(b);
}

__device__ __forceinline__ void topk_task(const Params& P, int L, int t0, int h) {
    char* ws = opq(P.ws);
    const bf16* pq = (const bf16*)(ws + OFF_PQ);
    const bf16* skb = (const bf16*)(ws + OFF_SKB) + (size_t)L * 16 * 128 * 64;
    unsigned short* ids = (unsigned short*)(ws + OFF_IDS);
    float* gates = (float*)(ws + OFF_GATE);
    const int tid = opaque_tid(), w = tid >> 6, l = tid & 63, r = l & 31, hh = l >> 5;
    unsigned char* lidx = (unsigned char*)(smem + w * 1024 + r * 32);
    {
        int F[2][16];
#pragma unroll
        for (int p = 0; p < 2; ++p) {
            const int hp = h * 2 + p;
            f32x16 acc[4];
            const f32x16 z16 = {0.f, 0.f, 0.f, 0.f, 0.f, 0.f, 0.f, 0.f, 0.f, 0.f, 0.f, 0.f, 0.f, 0.f, 0.f, 0.f};
#pragma unroll
            for (int kt = 0; kt < 4; ++kt) acc[kt] = z16;
#pragma unroll
            for (int s4 = 0; s4 < 4; ++s4) {
                bf16x8 bfr = *(const bf16x8*)(pq + (size_t)(t0 + r) * 1024 + hp * 64 + 16 * s4 + 8 * hh);
#pragma unroll
                for (int kt = 0; kt < 4; ++kt) {
                    bf16x8 af = *(const bf16x8*)(skb + ((size_t)hp * 128 + 32 * kt + r) * 64 + 16 * s4 + 8 * hh);
                    acc[kt] = __builtin_amdgcn_mfma_f32_32x32x16_bf16(af, bfr, acc[kt], 0, 0, 0);
                }
            }
            int K0[16], K1[16], K2[16], K3[16];
#pragma unroll
            for (int rr = 0; rr < 16; ++rr) {
                const int nb = (rr & 3) + 8 * (rr >> 2) + 4 * hh;
                K0[rr] = f2key(acc[0][rr], 127 - nb, 127);
                K1[rr] = f2key(acc[1][rr], 127 - (32 + nb), 127);
                K2[rr] = f2key(acc[2][rr], 127 - (64 + nb), 127);
                K3[rr] = f2key(acc[3][rr], 127 - (96 + nb), 127);
            }
            bitonic_sort16(K0); bitonic_sort16(K1); bitonic_sort16(K2); bitonic_sort16(K3);
            merge_top16(K0, K1);
            merge_top16(K2, K3);
            merge_top16(K0, K2);
#pragma unroll
            for (int i = 0; i < 16; ++i) K1[i] = partner32(K0[i], hh);
            merge_top16(K0, K1);
#pragma unroll
            for (int i = 0; i < 16; ++i) F[p][i] = K0[i];
        }
        if (hh == 0) {
#pragma unroll
            for (int q = 0; q < 4; ++q) {
                unsigned w1 = 0, w2 = 0;
#pragma unroll
                for (int e = 0; e < 4; ++e) {
                    w1 |= (unsigned)(127 - (F[0][4 * q + e] & 127)) << (8 * e);
                    w2 |= (unsigned)(127 - (F[1][4 * q + e] & 127)) << (8 * e);
                }
                ((unsigned*)lidx)[q] = w1;
                ((unsigned*)lidx)[4 + q] = w2;
            }
        }
        {
            float s1[16], s2[16];
#pragma unroll
            for (int i = 0; i < 16; ++i) { s1[i] = key2f(F[0][i], 127); s2[i] = key2f(F[1][i], 127); }
            int Lc[16], X[16];
#pragma unroll
            for (int b2 = 0; b2 < 16; ++b2) Lc[b2] = f2key(s1[0] + s2[b2], 255 - b2, 255);
#pragma unroll
            for (int a2 = 1; a2 < 16; ++a2) X[a2 - 1] = f2key(s1[a2] + s2[0], 255 - a2 * 16, 255);
            X[15] = INT_MIN;
            merge_top16(Lc, X);
            X[0] = f2key(s1[1] + s2[1], 255 - 17, 255); X[1] = f2key(s1[1] + s2[2], 255 - 18, 255); X[2] = f2key(s1[1] + s2[3], 255 - 19, 255);
            X[3] = f2key(s1[1] + s2[4], 255 - 20, 255); X[4] = f2key(s1[1] + s2[5], 255 - 21, 255); X[5] = f2key(s1[1] + s2[6], 255 - 22, 255);
            X[6] = f2key(s1[1] + s2[7], 255 - 23, 255);
            X[7] = f2key(s1[2] + s2[1], 255 - 33, 255); X[8] = f2key(s1[2] + s2[2], 255 - 34, 255); X[9] = f2key(s1[2] + s2[3], 255 - 35, 255);
            X[10] = f2key(s1[2] + s2[4], 255 - 36, 255);
            X[11] = f2key(s1[3] + s2[1], 255 - 49, 255); X[12] = f2key(s1[3] + s2[2], 255 - 50, 255); X[13] = f2key(s1[3] + s2[3], 255 - 51, 255);
            X[14] = f2key(s1[4] + s2[1], 255 - 65, 255); X[15] = f2key(s1[4] + s2[2], 255 - 66, 255);
            bitonic_sort16(X);
            merge_top16(Lc, X);
            X[0] = f2key(s1[5] + s2[1], 255 - 81, 255);
            X[1] = f2key(s1[6] + s2[1], 255 - 97, 255);
            X[2] = f2key(s1[7] + s2[1], 255 - 113, 255);
#pragma unroll
            for (int i = 3; i < 16; ++i) X[i] = INT_MIN;
            merge_top16(Lc, X);
            if (hh == 0) {
                float mx = key2f(Lc[0], 255);
                float ev[16], sum = 0.f;
#pragma unroll
                for (int k = 0; k < 16; ++k) { ev[k] = __expf(key2f(Lc[k], 255) - mx); sum += ev[k]; }
                float inv = 1.f / sum;
                size_t ob = (size_t)(t0 + r) * 128 + h * 16;
                unsigned idw[8];
#pragma unroll
                for (int k = 0; k < 16; ++k) {
                    int cidx = 255 - (Lc[k] & 255);
                    int i1 = lidx[cidx >> 4], i2 = lidx[16 + (cidx & 15)];
                    unsigned idv = (unsigned)(i1 * 128 + i2);
                    if (k & 1) idw[k >> 1] |= idv << 16; else idw[k >> 1] = idv;
                }
                u32x4 o0 = {idw[0], idw[1], idw[2], idw[3]}, o1 = {idw[4], idw[5], idw[6], idw[7]};
                *(u32x4*)(ids + ob) = o0;
                *(u32x4*)(ids + ob + 8) = o1;
#pragma unroll
                for (int q = 0; q < 4; ++q) {
                    f32x4 g4 = {ev[4 * q] * inv, ev[4 * q + 1] * inv, ev[4 * q + 2] * inv, ev[4 * q + 3] * inv};
                    *(f32x4*)(gates + ob + 4 * q) = g4;
                }
            }
        }
    }
}
__device__ __forceinline__ void phase_topk(const Params& P, int L) {
    const int w = opaque_tid() >> 6;
    for (int task = blockIdx.x * NW + w; task < (TOK / 32) * 8; task += gridDim.x * NW) topk_task(P, L, (task >> 3) * 32, task & 7);
}

__device__ __forceinline__ float gelu_exact(float x) { return 0.5f * x * (1.f + erff(x * 0.70710678118654752f)); }

__device__ __forceinline__ void dec16(const u32x4& v, float (&f)[16]) {
    f32x2 t;
    t = __builtin_amdgcn_cvt_pk_f32_fp8((int)v.x, false); f[0] = t.x; f[1] = t.y;
    t = __builtin_amdgcn_cvt_pk_f32_fp8((int)v.x, true);  f[2] = t.x; f[3] = t.y;
    t = __builtin_amdgcn_cvt_pk_f32_fp8((int)v.y, false); f[4] = t.x; f[5] = t.y;
    t = __builtin_amdgcn_cvt_pk_f32_fp8((int)v.y, true);  f[6] = t.x; f[7] = t.y;
    t = __builtin_amdgcn_cvt_pk_f32_fp8((int)v.z, false); f[8] = t.x; f[9] = t.y;
    t = __builtin_amdgcn_cvt_pk_f32_fp8((int)v.z, true);  f[10] = t.x; f[11] = t.y;
    t = __builtin_amdgcn_cvt_pk_f32_fp8((int)v.w, false); f[12] = t.x; f[13] = t.y;
    t = __builtin_amdgcn_cvt_pk_f32_fp8((int)v.w, true);  f[14] = t.x; f[15] = t.y;
}

__device__ __forceinline__ void dec32(const u32x4& v, f32x2 (&f)[16]) {
    f[0] = __builtin_amdgcn_cvt_scalef32_pk_f32_fp4(v.x, 1.0f, 0); f[1] = __builtin_amdgcn_cvt_scalef32_pk_f32_fp4(v.x, 1.0f, 1);
    f[2] = __builtin_amdgcn_cvt_scalef32_pk_f32_fp4(v.x, 1.0f, 2); f[3] = __builtin_amdgcn_cvt_scalef32_pk_f32_fp4(v.x, 1.0f, 3);
    f[4] = __builtin_amdgcn_cvt_scalef32_pk_f32_fp4(v.y, 1.0f, 0); f[5] = __builtin_amdgcn_cvt_scalef32_pk_f32_fp4(v.y, 1.0f, 1);
    f[6] = __builtin_amdgcn_cvt_scalef32_pk_f32_fp4(v.y, 1.0f, 2); f[7] = __builtin_amdgcn_cvt_scalef32_pk_f32_fp4(v.y, 1.0f, 3);
    f[8] = __builtin_amdgcn_cvt_scalef32_pk_f32_fp4(v.z, 1.0f, 0); f[9] = __builtin_amdgcn_cvt_scalef32_pk_f32_fp4(v.z, 1.0f, 1);
    f[10] = __builtin_amdgcn_cvt_scalef32_pk_f32_fp4(v.z, 1.0f, 2); f[11] = __builtin_amdgcn_cvt_scalef32_pk_f32_fp4(v.z, 1.0f, 3);
    f[12] = __builtin_amdgcn_cvt_scalef32_pk_f32_fp4(v.w, 1.0f, 0); f[13] = __builtin_amdgcn_cvt_scalef32_pk_f32_fp4(v.w, 1.0f, 1);
    f[14] = __builtin_amdgcn_cvt_scalef32_pk_f32_fp4(v.w, 1.0f, 2); f[15] = __builtin_amdgcn_cvt_scalef32_pk_f32_fp4(v.w, 1.0f, 3);
}

typedef _Float16 f16x2 __attribute__((ext_vector_type(2)));
__device__ __forceinline__ void dec8_f16(unsigned x, f16x2 (&wv)[4]) {
    const unsigned lo = x & 0x07070707u, hi = (x >> 4) & 0x07070707u;
    const unsigned Lb = __builtin_amdgcn_perm(0x46444240u, 0x3E3C3800u, lo) | ((x & 0x08080808u) << 4);
    const unsigned Hb = __builtin_amdgcn_perm(0x46444240u, 0x3E3C3800u, hi) | (x & 0x80808080u);
    wv[0] = __builtin_bit_cast(f16x2, __builtin_amdgcn_perm(Hb, Lb, 0x040c000cu));
    wv[1] = __builtin_bit_cast(f16x2, __builtin_amdgcn_perm(Hb, Lb, 0x050c010cu));
    wv[2] = __builtin_bit_cast(f16x2, __builtin_amdgcn_perm(Hb, Lb, 0x060c020cu));
    wv[3] = __builtin_bit_cast(f16x2, __builtin_amdgcn_perm(Hb, Lb, 0x070c030cu));
}

typedef _Float16 f16x2 __attribute__((ext_vector_type(2)));
__device__ __forceinline__ void dec32h(const u32x4& v, f16x2 (&f)[16]) {
    f[0] = __builtin_amdgcn_cvt_scalef32_pk_f16_fp4(v.x, 1.0f, 0); f[1] = __builtin_amdgcn_cvt_scalef32_pk_f16_fp4(v.x, 1.0f, 1);
    f[2] = __builtin_amdgcn_cvt_scalef32_pk_f16_fp4(v.x, 1.0f, 2); f[3] = __builtin_amdgcn_cvt_scalef32_pk_f16_fp4(v.x, 1.0f, 3);
    f[4] = __builtin_amdgcn_cvt_scalef32_pk_f16_fp4(v.y, 1.0f, 0); f[5] = __builtin_amdgcn_cvt_scalef32_pk_f16_fp4(v.y, 1.0f, 1);
    f[6] = __builtin_amdgcn_cvt_scalef32_pk_f16_fp4(v.y, 1.0f, 2); f[7] = __builtin_amdgcn_cvt_scalef32_pk_f16_fp4(v.y, 1.0f, 3);
    f[8] = __builtin_amdgcn_cvt_scalef32_pk_f16_fp4(v.z, 1.0f, 0); f[9] = __builtin_amdgcn_cvt_scalef32_pk_f16_fp4(v.z, 1.0f, 1);
    f[10] = __builtin_amdgcn_cvt_scalef32_pk_f16_fp4(v.z, 1.0f, 2); f[11] = __builtin_amdgcn_cvt_scalef32_pk_f16_fp4(v.z, 1.0f, 3);
    f[12] = __builtin_amdgcn_cvt_scalef32_pk_f16_fp4(v.w, 1.0f, 0); f[13] = __builtin_amdgcn_cvt_scalef32_pk_f16_fp4(v.w, 1.0f, 1);
    f[14] = __builtin_amdgcn_cvt_scalef32_pk_f16_fp4(v.w, 1.0f, 2); f[15] = __builtin_amdgcn_cvt_scalef32_pk_f16_fp4(v.w, 1.0f, 3);
}

__device__ __forceinline__ int idof16(const u32x4 (&q)[2], int i) {
    unsigned wv = (i >> 1) == 0 ? q[0].x : (i >> 1) == 1 ? q[0].y : (i >> 1) == 2 ? q[0].z : (i >> 1) == 3 ? q[0].w
                : (i >> 1) == 4 ? q[1].x : (i >> 1) == 5 ? q[1].y : (i >> 1) == 6 ? q[1].z : q[1].w;
    return (i & 1) ? (int)(wv >> 16) : (int)(wv & 0xffffu);
}
typedef int i32x8 __attribute__((ext_vector_type(8)));
#define GU_WAIT_V(n) asm volatile("s_waitcnt vmcnt(" #n ")" ::: "memory")
#define GU_WAIT_L0() asm volatile("s_waitcnt lgkmcnt(0)" ::: "memory")
__device__ __forceinline__ void phase_gather_u(const Params& P, int L) {
    char* ws = opq(P.ws);
    const unsigned char* U4 = (const unsigned char*)(ws + OFF_UB) + (size_t)L * NEXP * 512;
    float* part = (float*)(ws + OFF_PART);
    const unsigned short* ids = (const unsigned short*)(ws + OFF_IDS);
    const int tid = opaque_tid(), w = tid >> 6, l = tid & 63, i = l & 15, g4 = l >> 4, rr = l >> 3, dc = (l & 7) ^ rr;
    const int sl = blockIdx.x & 3, par = (blockIdx.x >> 2) & 1, rk = blockIdx.x >> 3, nb = gridDim.x >> 3;
    if (rk >= nb) return;
    PG8_LAS unsigned char* wl = (PG8_LAS unsigned char*)smem + w * 16384;
    const unsigned char* ubase = U4 + (size_t)sl * NEXP * 128 + dc * 16;
    const unsigned char* xbase = (const unsigned char*)(ws + OFF_XH) + (i == 1 ? 16 * MBy : 0) + 256 * sl + 16 * g4;
    const int scb = (i == 1) ? 123 : 127;
    const unsigned a0 = 1024u * (i >> 3) + 128u * (i & 7) + 16u * (g4 ^ (i & 7)), a1 = a0 ^ 64u;
    const int stride = nb * NW;
    int ti = rk * NW + w;
    if (ti >= TOK / 2) return;
    u32x4 idA[2], idB[2];
    u32x4 xA[4], xB[4];
    auto load_ids = [&](int tt, u32x4 (&idq)[2]) {
        const unsigned short* ip = ids + (size_t)tt * 128 + 16 * rr;
        asm volatile("global_load_dwordx4 %0, %2, off\n\tglobal_load_dwordx4 %1, %2, off offset:16" : "=&v"(idq[0]), "=&v"(idq[1]) : "v"(ip));
    };
    auto load_x = [&](int tt, u32x4 (&xx)[4]) {
        const unsigned char* p = xbase + (size_t)tt * 1024;
        asm volatile("global_load_dwordx4 %0, %4, off\n\tglobal_load_dwordx4 %1, %4, off offset:64\n\t"
                     "global_load_dwordx4 %2, %4, off offset:128\n\tglobal_load_dwordx4 %3, %4, off offset:192"
                     : "=&v"(xx[0]), "=&v"(xx[1]), "=&v"(xx[2]), "=&v"(xx[3]) : "v"(p));
    };
    auto pin = [&](u32x4 (&idq)[2], u32x4 (&xx)[4]) {
        asm volatile("" : "+v"(idq[0]), "+v"(idq[1]), "+v"(xx[0]), "+v"(xx[1]), "+v"(xx[2]), "+v"(xx[3]));
    };
    auto dma_half = [&](const u32x4 (&idq)[2], int h) {
#pragma unroll
        for (int jj = 0; jj < 8; ++jj) {
            const int j = 8 * h + jj;
            __builtin_amdgcn_global_load_lds((const unsigned*)(ubase + (size_t)idof16(idq, j) * 128), (PG8_LAS unsigned*)(wl + 1024 * j), 16, 0, 0);
        }
    };
    const unsigned la0 = (unsigned)(size_t)wl + a0, la1 = (unsigned)(size_t)wl + a1;
    auto mma_half = [&](f32x4 (&acc)[8], const u32x4 (&xc)[4], int h) {
        u32x4 av[8];
        if (h == 0)
            asm volatile("ds_read_b128 %0, %8\n\tds_read_b128 %1, %9\n\tds_read_b128 %2, %8 offset:2048\n\tds_read_b128 %3, %9 offset:2048\n\t"
                         "ds_read_b128 %4, %8 offset:4096\n\tds_read_b128 %5, %9 offset:4096\n\tds_read_b128 %6, %8 offset:6144\n\tds_read_b128 %7, %9 offset:6144\n\t"
                         "s_waitcnt lgkmcnt(0)"
                         : "=&v"(av[0]), "=&v"(av[1]), "=&v"(av[2]), "=&v"(av[3]), "=&v"(av[4]), "=&v"(av[5]), "=&v"(av[6]), "=&v"(av[7]) : "v"(la0), "v"(la1));
        else
            asm volatile("ds_read_b128 %0, %8 offset:8192\n\tds_read_b128 %1, %9 offset:8192\n\tds_read_b128 %2, %8 offset:10240\n\tds_read_b128 %3, %9 offset:10240\n\t"
                         "ds_read_b128 %4, %8 offset:12288\n\tds_read_b128 %5, %9 offset:12288\n\tds_read_b128 %6, %8 offset:14336\n\tds_read_b128 %7, %9 offset:14336\n\t"
                         "s_waitcnt lgkmcnt(0)"
                         : "=&v"(av[0]), "=&v"(av[1]), "=&v"(av[2]), "=&v"(av[3]), "=&v"(av[4]), "=&v"(av[5]), "=&v"(av[6]), "=&v"(av[7]) : "v"(la0), "v"(la1));
#pragma unroll
        for (int qq = 0; qq < 4; ++qq) {
#pragma unroll
            for (int hf = 0; hf < 2; ++hf) {
                const u32x4 a = av[2 * qq + hf];
                const i32x8 A = {(int)a.x, (int)a.y, (int)a.z, (int)a.w, 0, 0, 0, 0};
                const u32x4 b0 = xc[2 * hf], b1 = xc[2 * hf + 1];
                const i32x8 B = {(int)b0.x, (int)b0.y, (int)b0.z, (int)b0.w, (int)b1.x, (int)b1.y, (int)b1.z, (int)b1.w};
                f32x4 c = {0.f, 0.f, 0.f, 0.f};
                if (hf) c = acc[4 * h + qq];
                acc[4 * h + qq] = __builtin_amdgcn_mfma_scale_f32_16x16x128_f8f6f4(A, B, c, 4, 0, 0, 127, 0, scb);
            }
        }
    };
    auto step = [&](int tcur, int tnext, int tnext2, u32x4 (&idn)[2], u32x4 (&idl)[2], u32x4 (&xc)[4], u32x4 (&xn)[4]) {
        f32x4 acc[8];
        __builtin_amdgcn_sched_barrier(0);
        GU_WAIT_V(8);
        pin(idn, xc);
        __builtin_amdgcn_sched_barrier(0);
        mma_half(acc, xc, 0);
        __builtin_amdgcn_sched_barrier(0);
        dma_half(idn, 0);
        __builtin_amdgcn_sched_barrier(0);
        load_ids(tnext2, idl);
        load_x(tnext, xn);
        __builtin_amdgcn_sched_barrier(0);
        GU_WAIT_V(14);
        __builtin_amdgcn_sched_barrier(0);
        mma_half(acc, xc, 1);
        __builtin_amdgcn_sched_barrier(0);
#pragma unroll
        for (int q = 0; q < 8; ++q)
#pragma unroll
            for (int r = 0; r < 4; ++r) acc[q][r] = dpp_add<0xB1>(acc[q][r]);
        if (i == 0) {
            float* o = part + ((size_t)sl * TOK + tcur) * 128 + 32 * g4;
#pragma unroll
            for (int r = 0; r < 4; ++r)
#pragma unroll
                for (int gh = 0; gh < 2; ++gh) {
                    f32x4 ov = {acc[4 * gh][r], acc[4 * gh + 1][r], acc[4 * gh + 2][r], acc[4 * gh + 3][r]};
                    asm volatile("global_store_dwordx4 %0, %1, off offset:%2" :: "v"(o), "v"(ov), "n"(32 * r + 16 * gh) : "memory");
                }
        }
        __builtin_amdgcn_sched_barrier(0);
        dma_half(idn, 1);
        __builtin_amdgcn_sched_barrier(0);
    };
    auto tok = [&](int tidx, int fb) { return 2 * (tidx < TOK / 2 ? tidx : fb) + par; };
    load_ids(tok(ti, ti), idA);
    __builtin_amdgcn_sched_barrier(0);
    GU_WAIT_V(0);
    asm volatile("" : "+v"(idA[0]), "+v"(idA[1]));
    __builtin_amdgcn_sched_barrier(0);
    dma_half(idA, 0);
    __builtin_amdgcn_sched_barrier(0);
    load_ids(tok(ti + stride, ti), idB);
    load_x(tok(ti, ti), xA);
    __builtin_amdgcn_sched_barrier(0);
    dma_half(idA, 1);
    __builtin_amdgcn_sched_barrier(0);
    for (;;) {
        int tn = ti + stride, tn2 = ti + 2 * stride;
        step(tok(ti, ti), tok(tn, ti), tok(tn2, ti), idB, idA, xA, xB);
        if (tn >= TOK / 2) break;
        ti = tn; tn = ti + stride; tn2 = ti + 2 * stride;
        step(tok(ti, ti), tok(tn, ti), tok(tn2, ti), idA, idB, xB, xA);
        if (tn >= TOK / 2) break;
        ti = tn;
    }
    GU_WAIT_V(0);
    asm volatile("" :: "v"(idA[0]), "v"(idA[1]), "v"(idB[0]), "v"(idB[1]), "v"(xA[0]), "v"(xA[1]), "v"(xA[2]), "v"(xA[3]), "v"(xB[0]), "v"(xB[1]), "v"(xB[2]), "v"(xB[3]));
}

__device__ __forceinline__ void phase_gather_act(const Params& P, int L, int ss_slot, int fake = 0) {
    char* ws = opq(P.ws);
    const float* ss_ffn = (const float*)(ws + OFF_SSA) + (size_t)ss_slot * TOK * 8;
    const float* part = (const float*)(ws + OFF_PART);
    const unsigned short* ids = (const unsigned short*)(ws + OFF_IDS);
    const float* gates = (const float*)(ws + OFF_GATE);
    const float* uinv = (const float*)(ws + OFF_TSC) + L * NEXP;
    const float* vinv = (const float*)(ws + OFF_TSC) + (2 + L) * NEXP;
    const int tid = opaque_tid(), w = tid >> 6, l = tid & 63;
    const int stride = gridDim.x * NW;
    for (int t0 = blockIdx.x * NW + w; t0 < TOK; t0 += 4 * stride) {
        f32x2 pa[4][4], gt[4];
        unsigned idw[4];
        f32x4 s0[4], s1[4];
#pragma unroll
        for (int q = 0; q < 4; ++q) {
            const int t = (t0 + q * stride < TOK) ? (t0 + q * stride) : t0;
#pragma unroll
            for (int j = 0; j < 4; ++j) { pa[q][j].x = part[((size_t)j * TOK + t) * 128 + l]; pa[q][j].y = part[((size_t)j * TOK + t) * 128 + 64 + l]; }
            idw[q] = *(const unsigned*)(ids + (size_t)t * 128 + 2 * l);
            gt[q] = *(const f32x2*)(gates + (size_t)t * 128 + 2 * l);
            s0[q] = *(const f32x4*)(ss_ffn + (size_t)t * 8); s1[q] = *(const f32x4*)(ss_ffn + (size_t)t * 8 + 4);
        }
        float ui[4][2], vi[4][2];
#pragma unroll
        for (int q = 0; q < 4; ++q) {
            const int i0 = (int)(idw[q] & 0xffffu), i1 = (int)(idw[q] >> 16);
            ui[q][0] = uinv[i0]; ui[q][1] = uinv[i1]; vi[q][0] = vinv[i0]; vi[q][1] = vinv[i1];
        }
#pragma unroll
        for (int q = 0; q < 4; ++q) {
            const int t = t0 + q * stride;
            if (t < TOK) {
                const float ssum = ((s0[q].x + s0[q].y) + (s0[q].z + s0[q].w)) + ((s1[q].x + s1[q].y) + (s1[q].z + s1[q].w));
                const float rs = rsqrtf(ssum * (1.f / 1024.f) + EPSF);
                f32x2 sa = (pa[q][0] + pa[q][1]) + (pa[q][2] + pa[q][3]);
                f32x2 o;
                o.x = gt[q].x * gelu_exact(sa.x * rs * ui[q][0]) * vi[q][0];
                o.y = gt[q].y * gelu_exact(sa.y * rs * ui[q][1]) * vi[q][1];
                float am = fmaxf(fabsf(o.x), fabsf(o.y));
#pragma unroll
                for (int sh = 32; sh > 0; sh >>= 1) am = fmaxf(am, __shfl_xor(am, sh));
                int ex = (int)((__builtin_bit_cast(unsigned, am) >> 23) & 0xffu) - 127;
                int e = 7 - ex; e = e > 100 ? 100 : (e < -100 ? -100 : e);
                if (!(am > 0.f)) e = 0;
                const float sc2 = __builtin_bit_cast(float, (unsigned)(127 + e) << 23);
                const float s0 = __builtin_amdgcn_fmed3f(o.x * sc2, -448.f, 448.f), s1 = __builtin_amdgcn_fmed3f(o.y * sc2, -448.f, 448.f);
                const int h8 = __builtin_amdgcn_cvt_pk_fp8_f32(s0, s1, 0, false);
                const f32x2 hb2 = __builtin_amdgcn_cvt_pk_f32_fp8(h8, false);
                const int l8 = __builtin_amdgcn_cvt_pk_fp8_f32((s0 - hb2.x) * 16.f, (s1 - hb2.y) * 16.f, 0, false);
                unsigned char* a8 = (unsigned char*)(ws + (fake ? OFF_Y : OFF_A8)) + (size_t)t * 128 + 16 * (l & 7) + (l >> 3);
                a8[0] = (unsigned char)(h8 & 0xff); a8[8] = (unsigned char)((h8 >> 8) & 0xff);
                a8[2 * MBy] = (unsigned char)(l8 & 0xff); a8[2 * MBy + 8] = (unsigned char)((l8 >> 8) & 0xff);
                if (l == 0) ((int*)(ws + (fake ? OFF_Y : OFF_A8) + 4 * MBy))[t] = e;
            }
        }
    }
}

__device__ __forceinline__ void phase_gather_v(const Params& P, int L, int hsel, int ss_slot, int fake = 0) {
    char* ws = opq(P.ws);
    float* ss_ple = fake ? (float*)(ws + OFF_FQ) : (float*)(ws + OFF_SSA) + (size_t)ss_slot * TOK * 8;
    bf16* hb_out = fake ? (bf16*)(ws + OFF_PART) : (bf16*)(ws + (hsel ? OFF_HB1 : OFF_HB0));
    const bf16* hbin = (const bf16*)(ws + (hsel ? OFF_HB0 : OFF_HB1));
    const unsigned char* V4 = (const unsigned char*)(ws + OFF_VB) + (size_t)L * NEXP * 512;
    const unsigned short* ids = (const unsigned short*)(ws + OFF_IDS);
    const int tid = opaque_tid(), w = tid >> 6, l = tid & 63, i = l & 15, g4 = l >> 4, rr = l >> 3;
    const int sl = blockIdx.x & 3, par = (blockIdx.x >> 2) & 1, rk = blockIdx.x >> 3, nb = gridDim.x >> 3;
    if (rk >= nb) return;
    PG8_LAS unsigned char* wl = (PG8_LAS unsigned char*)smem + w * 16384;
    PG8_LAS unsigned char* wo = (PG8_LAS unsigned char*)smem + 8 * 16384 + w * 1024;
    const int dc0 = (l & 7) ^ (rr >> 1);
    const unsigned char* vbase0 = V4 + (size_t)sl * NEXP * 128 + dc0 * 16;
    const unsigned char* vbase1 = V4 + (size_t)sl * NEXP * 128 + (dc0 ^ 4) * 16;
    const unsigned char* abase = (const unsigned char*)(ws + OFF_A8) + ((i & 3) == 1 ? 2 * MBy : 0) + 16 * g4;
    const int* ebase = (const int*)(ws + OFF_A8 + 4 * MBy);
    const unsigned kb = 16u * (unsigned)((i >> 1) ^ (4 * (g4 & 1)));
    const unsigned rbase = (unsigned)(size_t)wl + 128u * (unsigned)(32 * g4 + i);
    const unsigned wob = (unsigned)(size_t)wo;
    const int stride = nb * NW;
    int ti = rk * NW + w;
    if (ti >= TOK / 2) return;
    u32x4 idA[2], idB[2];
    u32x4 aA[2], aB[2];
    int eA, eB;
    u32x2 hA, hB;
    auto load_ids = [&](int tt, u32x4 (&idq)[2]) {
        const unsigned short* ip = ids + (size_t)tt * 128 + 16 * rr;
        asm volatile("global_load_dwordx4 %0, %2, off\n\tglobal_load_dwordx4 %1, %2, off offset:16" : "=&v"(idq[0]), "=&v"(idq[1]) : "v"(ip));
    };
    auto load_tok = [&](int tt, u32x4 (&ax)[2], int& ex, u32x2& hx) {
        const unsigned char* ap = abase + (size_t)tt * 128;
        const int* ep = ebase + tt;
        const bf16* hp = hbin + (size_t)tt * LDH + 256 * sl + 4 * l;
        asm volatile("global_load_dwordx4 %0, %4, off\n\tglobal_load_dwordx4 %1, %4, off offset:64\n\tglobal_load_dword %2, %5, off\n\tglobal_load_dwordx2 %3, %6, off"
                     : "=&v"(ax[0]), "=&v"(ax[1]), "=&v"(ex), "=&v"(hx) : "v"(ap), "v"(ep), "v"(hp));
    };
    auto dma_all = [&](const u32x4 (&idq)[2]) {
#pragma unroll
        for (int j = 0; j < 16; ++j) {
            const unsigned char* vb = (((j ^ (j >> 2)) & 1) ? vbase1 : vbase0);
            __builtin_amdgcn_global_load_lds((const unsigned*)(vb + (size_t)idof16(idq, j) * 128), (PG8_LAS unsigned*)(wl + 1024 * j), 16, 0, 0);
        }
    };
    u32x2 pend_h = {0u, 0u}; float pend_ss = 0.f; int pend_t = -1;
    auto step = [&](int tcur, int tnext, int tnext2, u32x4 (&idn)[2], u32x4 (&idl)[2], u32x4 (&ac)[2], int& ec, u32x2& hc, u32x4 (&an)[2], int& en, u32x2& hn) {
        __builtin_amdgcn_sched_barrier(0);
        GU_WAIT_V(0);
        asm volatile("" : "+v"(idn[0]), "+v"(idn[1]), "+v"(ac[0]), "+v"(ac[1]), "+v"(ec), "+v"(hc));
        __builtin_amdgcn_sched_barrier(0);
        u32x2 bq[16][2];
#pragma unroll
        for (int c = 0; c < 8; ++c) {
            const unsigned ad = rbase + ((16u * c) ^ kb);
            asm volatile("ds_read_b64_tr_b4 %0, %4\n\tds_read_b64_tr_b4 %1, %4 offset:2048\n\tds_read_b64_tr_b4 %2, %4 offset:8\n\tds_read_b64_tr_b4 %3, %4 offset:2056"
                         : "=&v"(bq[2 * c][0]), "=&v"(bq[2 * c][1]), "=&v"(bq[2 * c + 1][0]), "=&v"(bq[2 * c + 1][1]) : "v"(ad));
        }
        asm volatile("s_waitcnt lgkmcnt(0)" ::: "memory");
#pragma unroll
        for (int c = 0; c < 16; ++c) asm volatile("" : "+v"(bq[c][0]), "+v"(bq[c][1]));
        __builtin_amdgcn_sched_barrier(0);
        if (pend_t >= 0) {
            bf16* op = hb_out + (size_t)pend_t * LDH + 256 * sl + 4 * l;
            asm volatile("global_store_dwordx2 %0, %1, off" :: "v"(op), "v"(pend_h) : "memory");
            if (l == 0) {
                float* sp = ss_ple + (size_t)pend_t * 8 + sl;
                const float zf = 0.f;
                asm volatile("global_store_dword %0, %1, off\n\tglobal_store_dword %0, %2, off offset:16" :: "v"(sp), "v"(pend_ss), "v"(zf) : "memory");
            }
        }
        __builtin_amdgcn_sched_barrier(0);
        dma_all(idn);
        __builtin_amdgcn_sched_barrier(0);
        load_ids(tnext2, idl);
        load_tok(tnext, an, en, hn);
        __builtin_amdgcn_sched_barrier(0);
        const int sca = 127 - ec - (((i & 3) == 1) ? 4 : 0);
        const i32x8 A = {(int)ac[0].x, (int)ac[0].y, (int)ac[0].z, (int)ac[0].w, (int)ac[1].x, (int)ac[1].y, (int)ac[1].z, (int)ac[1].w};
        f32x4 acc[16];
#pragma unroll
        for (int cb = 0; cb < 16; ++cb) {
            const i32x8 B = {(int)bq[cb][0].x, (int)bq[cb][0].y, (int)bq[cb][1].x, (int)bq[cb][1].y, 0, 0, 0, 0};
            const f32x4 z = {0.f, 0.f, 0.f, 0.f};
            acc[cb] = __builtin_amdgcn_mfma_scale_f32_16x16x128_f8f6f4(A, B, z, 0, 4, 0, sca, 0, 127);
        }
#pragma unroll
        for (int q = 0; q < 4; ++q) {
            float v = 0.f;
#pragma unroll
            for (int g = 0; g < 4; ++g) { const float t2 = acc[4 * g + q][0] + acc[4 * g + q][1]; v = (g4 == g) ? t2 : v; }
            const unsigned wa = wob + 4u * (unsigned)(64 * g4 + 16 * q + i);
            asm volatile("ds_write_b32 %0, %1" :: "v"(wa), "v"(v) : "memory");
        }
        f32x4 ov;
        {
            const unsigned ra = wob + 16u * (unsigned)l;
            asm volatile("s_waitcnt lgkmcnt(0)\n\tds_read_b128 %0, %1\n\ts_waitcnt lgkmcnt(0)" : "=&v"(ov) : "v"(ra) : "memory");
        }
        f32x4 hv = {bflo(hc.x) + ov[0], bfhi(hc.x) + ov[1], bflo(hc.y) + ov[2], bfhi(hc.y) + ov[3]};
        pend_h.x = pack2(hv.x, hv.y); pend_h.y = pack2(hv.z, hv.w);
        float ssq = hv.x * hv.x + hv.y * hv.y + hv.z * hv.z + hv.w * hv.w;
        pend_ss = wave_sum(ssq);
        pend_t = tcur;
        __builtin_amdgcn_sched_barrier(0);
    };
    auto tok = [&](int tidx, int fb) { return 2 * (tidx < TOK / 2 ? tidx : fb) + par; };
    load_ids(tok(ti, ti), idA);
    __builtin_amdgcn_sched_barrier(0);
    GU_WAIT_V(0);
    asm volatile("" : "+v"(idA[0]), "+v"(idA[1]));
    __builtin_amdgcn_sched_barrier(0);
    dma_all(idA);
    __builtin_amdgcn_sched_barrier(0);
    load_ids(tok(ti + stride, ti), idB);
    load_tok(tok(ti, ti), aA, eA, hA);
    __builtin_amdgcn_sched_barrier(0);
    for (;;) {
        int tn = ti + stride, tn2 = ti + 2 * stride;
        step(tok(ti, ti), tok(tn, ti), tok(tn2, ti), idB, idA, aA, eA, hA, aB, eB, hB);
        if (tn >= TOK / 2) break;
        ti = tn; tn = ti + stride; tn2 = ti + 2 * stride;
        step(tok(ti, ti), tok(tn, ti), tok(tn2, ti), idA, idB, aB, eB, hB, aA, eA, hA);
        if (tn >= TOK / 2) break;
        ti = tn;
    }
    asm volatile("s_waitcnt vmcnt(0)" : "+v"(pend_t), "+v"(pend_h), "+v"(pend_ss) :: "memory");
    asm volatile("" :: "v"(idA[0]), "v"(idA[1]), "v"(idB[0]), "v"(idB[1]), "v"(aA[0]), "v"(aA[1]), "v"(aB[0]), "v"(aB[1]), "v"(eA), "v"(eB), "v"(hA), "v"(hB));
    {
        bf16* op = hb_out + (size_t)pend_t * LDH + 256 * sl + 4 * l;
        *(u32x2*)op = pend_h;
        if (l == 0) { ss_ple[(size_t)pend_t * 8 + sl] = pend_ss; ss_ple[(size_t)pend_t * 8 + 4 + sl] = 0.f; }
    }
}

struct EpiStoreBf16 {
    static constexpr bool PERM = true, AFTER_DRAIN = false;
    bf16* O;
    __device__ __forceinline__ void khook(int, f32x4 (&)[2][2][4][2], int, int) const {}
    __device__ __forceinline__ void operator()(const f32x4 (&acc)[2][2][4][2], const pg8::Unit& u, int wr, int wc, int fr, int fqd) const {
        const int row0 = u.pm * 256 + wr * 64 + fr, col0 = u.pn * 256 + wc * 32 + 8 * fqd;
#pragma unroll
        for (int ai = 0; ai < 2; ++ai)
#pragma unroll
            for (int m = 0; m < 4; ++m) {
                bf16* rowp = O + (size_t)(row0 + ai * 128 + m * 16) * 1024 + col0;
#pragma unroll
                for (int bj = 0; bj < 2; ++bj) {
                    const f32x4 v0 = acc[ai][bj][m][0], v1 = acc[ai][bj][m][1];
                    u32x4 wv = {pack2(v0[0], v0[1]), pack2(v0[2], v0[3]), pack2(v1[0], v1[1]), pack2(v1[2], v1[3])};
                    *(u32x4*)(rowp + bj * 128) = wv;
                }
            }
    }
};
__device__ __forceinline__ void phase_pw(const Params& P) {
    char* ws = opq(P.ws);
    pg8::StaticOrder S; S.init(TOK, 1024, gridDim.x, blockIdx.x);
    for (int L = 0; L < 2; ++L) {
        pg8::Gemm g{(const bf16*)(ws + OFF_PB) + (size_t)L * TOK * LDP, (const bf16*)(ws + OFF_WP) + (size_t)L * 1024 * LDP, LDP, LDP, TOK, 1024, 256};
        EpiStoreBf16 E{(bf16*)(ws + (L ? OFF_PW1 : OFF_PW0))};
        pg8::gemm_phase((PG8_LAS unsigned char*)smem, g, S, E, nullptr);
        __syncthreads();
    }
}
struct EpiPle {
    static constexpr bool PERM = true, AFTER_DRAIN = true;
    const bf16* PW; const bf16* hb_in; bf16* hb_out; float* gss;
    __device__ __forceinline__ void khook(int, f32x4 (&)[2][2][4][2], int, int) const {}
    __device__ __forceinline__ void operator()(const f32x4 (&)[2][2][4][2], const pg8::Unit&, int, int, int, int) const {}
    __device__ __forceinline__ void fused(const f32x4 (&acc)[2][2][4][2], const pg8::Unit& u, int wr, int wc, int fr, int fqd, PG8_LAS unsigned char*, int, int) const {
        residual_fused<true, false>(acc, u, wr, wc, fr, fqd, (const float*)(smem + LDS_AUX), PW, hb_in, hb_out, gss);
    }
};
__device__ __forceinline__ void phase_ple(const Params& P, int L, int hsel, int ss_slot_in, int ss_slot_out, int fake = 0) {
    char* ws = opq(P.ws);
    const float* ss_ple = (const float*)(ws + OFF_SSA) + (size_t)ss_slot_in * TOK * 8;
    float* ss_out = (float*)(ws + OFF_SSA) + (size_t)ss_slot_out * TOK * 8;
    const bf16* hb_in = (const bf16*)(ws + (hsel ? OFF_HB1 : OFF_HB0));
    bf16* hb_out = (bf16*)(ws + (hsel ? OFF_HB0 : OFF_HB1));
    const bf16* Wg = (const bf16*)(ws + OFF_WG) + (size_t)L * 1024 * LDH;
    float* aux = (float*)(smem + LDS_AUX);
    const int tid = opaque_tid();
    pg8::Gemm g{hb_in, Wg, LDH, LDH, TOK, 1024, 1024};
    pg8::StaticOrder S; S.init(TOK, 1024, gridDim.x, blockIdx.x);
    pg8::Unit u0;
    if (S.next(0, u0) && tid < 256) aux[tid] = row_rs8(ss_ple, u0.pm * 256 + tid);
    __syncthreads();
    EpiPle E{(const bf16*)(ws + (L ? OFF_PW1 : OFF_PW0)), hb_in, fake ? (bf16*)(ws + OFF_PART) : hb_out, fake ? (float*)(ws + OFF_FQ) : ss_out};
    pg8::gemm_phase((PG8_LAS unsigned char*)smem, g, S, E, nullptr);
    __syncthreads();
}

__device__ __forceinline__ void phase_final(const Params& P, int ss_slot, int hsel) {
    char* ws = opq(P.ws);
    float* out = opq(P.out);
    const bf16* hbin = (const bf16*)(ws + (hsel ? OFF_HB1 : OFF_HB0));
    const float* ss = (const float*)(ws + OFF_SSA) + (size_t)ss_slot * TOK * 8;
    const int tid = opaque_tid(), w = tid >> 6, l = tid & 63;
    const float4* g4 = (const float4*)P.final_norm_g;
    for (int t = blockIdx.x * NW + w; t < TOK; t += gridDim.x * NW) {
        float rs = row_rs8(ss, t);
        float4* o4 = (float4*)(out + (size_t)t * 1024);
#pragma unroll
        for (int i = 0; i < 2; ++i) {
            u32x4 hq = *(const u32x4*)(hbin + (size_t)t * LDH + (i * 64 + l) * 8);
            float4 ga = g4[(i * 64 + l) * 2], gb = g4[(i * 64 + l) * 2 + 1];
            float4 va = {bflo(hq.x) * rs * ga.x, bfhi(hq.x) * rs * ga.y, bflo(hq.y) * rs * ga.z, bfhi(hq.y) * rs * ga.w};
            float4 vb = {bflo(hq.z) * rs * gb.x, bfhi(hq.z) * rs * gb.y, bflo(hq.w) * rs * gb.z, bfhi(hq.w) * rs * gb.w};
            {
                const f32x4 na = {va.x, va.y, va.z, va.w}, nb2 = {vb.x, vb.y, vb.z, vb.w};
                __builtin_nontemporal_store(na, (f32x4*)(o4 + (i * 64 + l) * 2));
                __builtin_nontemporal_store(nb2, (f32x4*)(o4 + (i * 64 + l) * 2 + 1));
            }
        }
    }
}

#ifndef EARLY_ACQ
#define EARLY_ACQ 0
#endif
#ifndef EARLY_WB
#define EARLY_WB 0
#endif
#define XB_TMO      128
#define XB_XCNT(j)  (256  + 64 * (j))
#define XB_XSUB(j)  (1280 + 64 * (j))
#define XB_XGEN(j)  (2304 + 64 * (j))
#define XB_TOP      3328
#define XB_TOPGEN   3392
#define XCD_BAR_WORDS 3456
#define XB_SPIN_CAP (1u << 22)
__device__ __forceinline__ unsigned xb_ld(unsigned* p) { return __hip_atomic_load(p, __ATOMIC_RELAXED, __HIP_MEMORY_SCOPE_AGENT); }
__device__ __forceinline__ unsigned xb_add(unsigned* p, unsigned v) { return __hip_atomic_fetch_add(p, v, __ATOMIC_RELAXED, __HIP_MEMORY_SCOPE_AGENT); }
__device__ __forceinline__ unsigned xb_xcc_id() { return (unsigned)__builtin_amdgcn_s_getreg((3 << 11) | 20) & 0xFu; }
#define XB_SPIN(cond, bar) do { unsigned _sp = 0; while (cond) { __builtin_amdgcn_s_sleep(1); \
    if ((++_sp & 255u) == 0u) { if (xb_ld(&(bar)[XB_TMO])) break; if (_sp > XB_SPIN_CAP) { atomicAdd(&(bar)[XB_TMO], 1u); break; } } } } while (0)
#define XB_LDS_OFF (LDS_BYTES - 64)
__device__ __forceinline__ void xcd_barrier_post(const Params& P) {
    if (threadIdx.x == 0) {
        unsigned* bar = (unsigned*)(P.ws + OFF_BAR);
        volatile __attribute__((address_space(3))) unsigned* st = (volatile __attribute__((address_space(3))) unsigned*)(smem + XB_LDS_OFF);
        st[0] = 0u; st[1] = 0u;
        (void)xb_add(&bar[XB_XCNT(xb_xcc_id())], 1u);
    }
}
__device__ __forceinline__ void xcd_barrier_complete(unsigned* bar, unsigned x, unsigned& nloc, unsigned& nx) {
    const unsigned G = gridDim.x;
    unsigned sum, cnt, mine, sp = 0u;
    for (;;) {
        sum = 0u; cnt = 0u; mine = 0u;
#pragma unroll
        for (unsigned j = 0; j < 16; ++j) { const unsigned c = xb_ld(&bar[XB_XCNT(j)]); sum += c; cnt += (c > 0u) ? 1u : 0u; mine = (j == x) ? c : mine; }
        if (sum == G) break;
        __builtin_amdgcn_s_sleep(1);
        if ((++sp & 255u) == 0u) { if (xb_ld(&bar[XB_TMO])) break; if (sp > XB_SPIN_CAP) { atomicAdd(&bar[XB_TMO], 1u); break; } }
    }
    nloc = mine > 0u ? mine : 1u; nx = cnt > 0u ? cnt : 1u;
}
__device__ __forceinline__ void grid_barrier(const Params& P) {
    asm volatile("s_waitcnt vmcnt(0)" ::: "memory");
    __syncthreads();
    if (threadIdx.x == 0) {
        unsigned* bar = (unsigned*)(P.ws + OFF_BAR);
        volatile __attribute__((address_space(3))) unsigned* st = (volatile __attribute__((address_space(3))) unsigned*)(smem + XB_LDS_OFF);
        const unsigned x = xb_xcc_id();
        __builtin_amdgcn_s_waitcnt(0);
        unsigned nloc = st[0], nx = st[1];
        if (nloc == 0u) { xcd_barrier_complete(bar, x, nloc, nx); st[0] = nloc; st[1] = nx; }
#if EARLY_WB
        asm volatile("buffer_wbl2 sc1" ::: "memory");
#endif
        const unsigned old = xb_add(&bar[XB_XSUB(x)], 1u);
        const unsigned gen = old / nloc;
#if EARLY_ACQ
        asm volatile("buffer_inv sc1" ::: "memory");
#endif
        if (old + 1u == (gen + 1u) * nloc) {
            __builtin_amdgcn_fence(__ATOMIC_RELEASE, "agent");
            asm volatile("s_waitcnt vmcnt(0)" ::: "memory");
            const unsigned og = xb_add(&bar[XB_TOP], 1u);
            const unsigned tg = og / nx;
            if (og + 1u == (tg + 1u) * nx) xb_add(&bar[XB_TOPGEN], 1u);
            else XB_SPIN(xb_ld(&bar[XB_TOPGEN]) == tg, bar);
#if !EARLY_ACQ
            __builtin_amdgcn_fence(__ATOMIC_ACQUIRE, "agent");
#endif
            xb_add(&bar[XB_XGEN(x)], 1u);
            asm volatile("s_waitcnt vmcnt(0)" ::: "memory");
        } else {
            XB_SPIN(xb_ld(&bar[XB_XGEN(x)]) == gen, bar);
#if !EARLY_ACQ
            __builtin_amdgcn_fence(__ATOMIC_ACQUIRE, "agent");
#endif
            asm volatile("s_waitcnt vmcnt(0)" ::: "memory");
        }
    }
    __syncthreads();
}

__global__ void __launch_bounds__(NTHR, 2) hymba_megakernel(Params P) {
    cg::grid_group grid = cg::this_grid();
    char* ws = opq(P.ws);
    xcd_barrier_post(P);
#define BAR() do { grid_barrier(P); if (DUP == 20) grid_barrier(P); } while (0)
    phase0(P);
    if (DUP == 0) { asm volatile("s_waitcnt vmcnt(0)" ::: "memory"); __syncthreads(); grid_barrier(P); phase0(P); }
    if (DUP == 13) { asm volatile("s_waitcnt vmcnt(0)" ::: "memory"); __syncthreads(); grid.sync(); }
    BAR();
    phase_pw(P);
    asm volatile("s_waitcnt vmcnt(0)" ::: "memory");
    __syncthreads();
    if (DUP == 11) { BAR(); phase_pw(P); BAR(); }
    int cur = 0;
    for (int L = 0; L < 2; ++L) {
        const int ss_mix = (L == 0) ? 0 : 3, ss_ffn = 1 + L, ss_next = (L == 0) ? 3 : 4, ss_ple = 5 + L;
        phase_proj(P, L, cur, ss_mix);
        BAR();
        if (DUP == 1) { phase_proj(P, L, cur, ss_mix); BAR(); }
        phase_mla_up(P, L);
        BAR();
        if (DUP == 2) { phase_mla_up(P, L); BAR(); }
        phase_attn(P, L, 0);
        BAR();
        if (DUP == 3) { phase_attn(P, L, 1); BAR(); }
        if (DUP >= 30 && DUP < 34) { phase_attn(P, L, 1, DUP - 30); BAR(); }
        phase_wo(P, L, cur ^ 1, ss_ffn);
        BAR();
        if (DUP == 4 && L == 0) { phase_wo(P, L, cur ^ 1, ss_ffn); BAR(); }
        phase_pq(P, L, cur ^ 1, ss_ffn);
        BAR();
        if (DUP == 5) { phase_pq(P, L, cur ^ 1, ss_ffn); BAR(); }
        if (DUP == 6) { phase_topk(P, L); BAR(); }
        phase_gather_u(P, L);
        BAR();
        if (DUP == 7) { phase_gather_u(P, L); BAR(); }
        if (DUP == 10) { phase_gather_act(P, L, ss_ffn, 1); BAR(); }
        phase_gather_act(P, L, ss_ffn);
        BAR();
        if (DUP == 8) { phase_gather_v(P, L, cur, ss_ple, 1); BAR(); }
        phase_gather_v(P, L, cur, ss_ple);
        BAR();
        if (DUP == 9) { phase_ple(P, L, cur, ss_ple, ss_next, 1); BAR(); }
        phase_ple(P, L, cur, ss_ple, ss_next);
        BAR();
        cur ^= 1;
    }
    phase_final(P, 4, cur);
}

extern "C" void kernel_launch(void* const* d_in, const int* in_sizes, int n_in, void* d_out, int out_size, void* d_ws,
                              size_t ws_size, hipStream_t stream) {
    static int grid_blocks = 0;
    if (!grid_blocks) {
        int dev = 0, cus = 0, per_cu = 0;
        hipGetDevice(&dev);
        hipDeviceGetAttribute(&cus, hipDeviceAttributeMultiprocessorCount, dev);
        hipOccupancyMaxActiveBlocksPerMultiprocessor(&per_cu, hymba_megakernel, NTHR, 0);
        if (per_cu > 1) per_cu = 1;
        if (per_cu < 1) per_cu = 1;
        grid_blocks = cus * per_cu;
        if (ws_size < WS_END) fprintf(stderr, "workspace too small: %zu < %zu\n", ws_size, (size_t)WS_END);
    }
    Params P{};
    P.x = (const float*)d_in[0]; P.p = (const float*)d_in[1]; P.pos = (const int*)d_in[2];
    P.norm_mix_g = (const float*)d_in[3]; P.w_in = (const float*)d_in[4]; P.b_forget = (const float*)d_in[5];
    P.mla_q_norm_g = (const float*)d_in[6]; P.w_uq = (const float*)d_in[7]; P.mla_kv_norm_g = (const float*)d_in[8];
    P.w_ukv = (const float*)d_in[9]; P.mix_out_norm_g = (const float*)d_in[10]; P.w_o = (const float*)d_in[11];
    P.norm_ffn_g = (const float*)d_in[12]; P.w_query = (const float*)d_in[13]; P.sub_keys = (const float*)d_in[14];
    P.peer_u = (const float*)d_in[15]; P.peer_v = (const float*)d_in[16]; P.w_ple = (const float*)d_in[17];
    P.ple_norm_g = (const float*)d_in[18]; P.w_ple_gate = (const float*)d_in[19]; P.final_norm_g = (const float*)d_in[20];
    P.out = (float*)d_out; P.ws = (char*)d_ws;
    hipMemsetAsync((char*)d_ws + OFF_BAR, 0, 16384 + 4096, stream);
    void* args[] = {&P};
    hipError_t e = hipLaunchCooperativeKernel((void*)hymba_megakernel, dim3(grid_blocks), dim3(NTHR), args, 0, stream);
    if (e != hipSuccess) fprintf(stderr, "cooperative launch failed: %s (grid %d)\n", hipGetErrorString(e), grid_blocks);
}
```
